# Optimizing an MI355X kernel written in HIP

```python
import math
import jax, jax.numpy as jnp
from jax import lax
import numpy as np

D_MODEL = 1024
BATCH = 8
SEQ = 4096
DEPTH = 1

MLSTM_HEADS = 4
MLSTM_HEAD_DIM = 256
MLSTM_WIDTH = MLSTM_HEADS * MLSTM_HEAD_DIM
MLSTM_CHUNK = 128
N_GATE_COLS = 4 * MLSTM_HEADS
LRU_WIDTH = D_MODEL
LRU_BLOCKS = 8
LRU_BLOCK_DIM = LRU_WIDTH // LRU_BLOCKS
LRU_C = 8.0
CONV_WIDTH = 4
CONV_PAD = (2, 1)
PEER_HEADS = 8
PEER_N_KEYS = 128
PEER_N_EXPERTS = PEER_N_KEYS * PEER_N_KEYS
PEER_QUERY_DIM = 256
PEER_HALF = PEER_QUERY_DIM // 2
PEER_TOPK = 16
PEER_TOKEN_BLOCK = 128
EPS = 1e-6

IN_SPLIT_SIZES = (MLSTM_WIDTH, MLSTM_WIDTH, N_GATE_COLS, LRU_WIDTH, LRU_WIDTH, 2 * D_MODEL)
D_IN = MLSTM_WIDTH * 2 + N_GATE_COLS + LRU_WIDTH * 2 + 2 * D_MODEL

kernel_name = "hybrid_mlstm_rglru_peer_encoder"


def rms_norm(x, g):
    x32 = x.astype(jnp.float32)
    y = x32 * lax.rsqrt(jnp.mean(x32 * x32, axis=-1, keepdims=True) + EPS)
    return (y * g.astype(jnp.float32)).astype(x.dtype)


def dwconv_centred(x, w, b):
    y = lax.conv_general_dilated(
        x, w[:, None, :].astype(x.dtype), window_strides=(1,), padding=[CONV_PAD],
        dimension_numbers=("NWC", "WIO", "NWC"), feature_group_count=x.shape[-1])
    return y + b.astype(x.dtype)


def mlstm_scan(q, k, v, log_i, log_f):
    B, H, S, d = q.shape
    nc = S // MLSTM_CHUNK

    def to_chunks(t):
        return jnp.moveaxis(t.reshape((B, H, nc, MLSTM_CHUNK) + t.shape[3:]), 2, 0)

    tril = jnp.tril(jnp.ones((MLSTM_CHUNK, MLSTM_CHUNK), dtype=bool))

    def body(carry, xs):
        C, n, m = carry
        qc, kc, vc, ic, fc = xs
        b = jnp.cumsum(fc, axis=-1)
        d_log = jnp.where(tril, b[..., :, None] - b[..., None, :] + ic[..., None, :], -jnp.inf)
        inter = b + m[..., None]
        m_t = jnp.maximum(inter, jnp.max(d_log, axis=-1))
        w_intra = jnp.exp(d_log - m_t[..., None])
        w_inter = jnp.exp(inter - m_t)
        s = jnp.einsum("bhtd,bhsd->bhts", qc, kc) * w_intra
        num = w_inter[..., None] * jnp.einsum("bhtd,bhde->bhte", qc, C) + jnp.einsum("bhts,bhse->bhte", s, vc)
        den = w_inter * jnp.einsum("bhtd,bhd->bht", qc, n) + jnp.sum(s, axis=-1)
        h = num / jnp.maximum(jnp.abs(den), jnp.exp(-m_t))[..., None]
        g = b[..., -1]
        w_log = g[..., None] - b + ic
        m_new = jnp.maximum(g + m, jnp.max(w_log, axis=-1))
        decay = jnp.exp(g + m - m_new)
        w_state = jnp.exp(w_log - m_new[..., None])
        kw = kc * w_state[..., None]
        C_new = decay[..., None, None] * C + jnp.einsum("bhsd,bhse->bhde", kw, vc)
        n_new = decay[..., None] * n + jnp.sum(kw, axis=2)
        return (C_new, n_new, m_new), h

    init = (jnp.zeros((B, H, d, d), jnp.float32), jnp.zeros((B, H, d), jnp.float32),
            jnp.zeros((B, H), jnp.float32))
    _, h = lax.scan(body, init, (to_chunks(q), to_chunks(k), to_chunks(v), to_chunks(log_i), to_chunks(log_f)))
    return jnp.moveaxis(h, 0, 2).reshape(B, H, S, d)


def mlstm_branch(xm, o_pre, gate_pre, conv_w, conv_b, w_q, w_k, w_v, norm_g):
    B, S, _ = xm.shape
    H, d = MLSTM_HEADS, MLSTM_HEAD_DIM
    xc = jax.nn.silu(dwconv_centred(xm, conv_w, conv_b)).reshape(B, S, H, d)
    xv = xm.reshape(B, S, H, d)
    q = jnp.einsum("bshd,hde->bhse", xc, w_q).astype(jnp.float32)
    k = (jnp.einsum("bshd,hde->bhse", xc, w_k) / math.sqrt(d)).astype(jnp.float32)
    v = jnp.einsum("bshd,hde->bhse", xv, w_v).astype(jnp.float32)
    gates = gate_pre.astype(jnp.float32).reshape(B, S, 4, H).transpose(2, 0, 3, 1)
    i_f, f_f, i_b, f_b = gates[0], gates[1], gates[2], gates[3]
    flip = lambda t: jnp.flip(t, axis=2)
    h_fwd = mlstm_scan(q, k, v, i_f, jax.nn.log_sigmoid(f_f))
    h_bwd = flip(mlstm_scan(flip(q), flip(k), flip(v), flip(i_b), flip(jax.nn.log_sigmoid(f_b))))
    h = jnp.transpose(h_fwd + h_bwd, (0, 2, 1, 3))
    h = rms_norm(h, norm_g.reshape(H, d)).reshape(B, S, MLSTM_WIDTH)
    return (jax.nn.sigmoid(o_pre.astype(jnp.float32)) * h.astype(jnp.float32)).astype(xm.dtype)


def rglru_dir(x, w_r, b_r, w_i, b_i, lam):
    B, S, C = x.shape
    xb = x.reshape(B, S, LRU_BLOCKS, LRU_BLOCK_DIM)
    r = jax.nn.sigmoid(jnp.einsum("bsnc,ncd->bsnd", xb, w_r).reshape(B, S, C) + b_r)
    i = jax.nn.sigmoid(jnp.einsum("bsnc,ncd->bsnd", xb, w_i).reshape(B, S, C) + b_i)
    log_a = -LRU_C * r * jax.nn.softplus(-lam)
    a = jnp.exp(log_a)
    u = jnp.sqrt(-jnp.expm1(2.0 * log_a)) * (i * x)

    def combine(left, right):
        a1, b1 = left
        a2, b2 = right
        return a1 * a2, a2 * b1 + b2

    _, h = lax.associative_scan(combine, (a, u), axis=1)
    return h


def lru_branch(xl, gate_pre, conv_w, conv_b, w_r, b_r, w_i, b_i, lam):
    xc = dwconv_centred(xl, conv_w, conv_b).astype(jnp.float32)
    w_r, b_r, w_i, b_i, lam = (t.astype(jnp.float32) for t in (w_r, b_r, w_i, b_i, lam))
    h_fwd = rglru_dir(xc, w_r[0], b_r[0], w_i[0], b_i[0], lam[0])
    h_bwd = jnp.flip(rglru_dir(jnp.flip(xc, axis=1), w_r[1], b_r[1], w_i[1], b_i[1], lam[1]), axis=1)
    y = (h_fwd + h_bwd) * jax.nn.gelu(gate_pre.astype(jnp.float32), approximate=False)
    return y.astype(xl.dtype)


def peer(h, w_q, sub_keys, expert_u, expert_v):
    B, S, D = h.shape
    nb = (B * S) // PEER_TOKEN_BLOCK
    keys32 = sub_keys.astype(jnp.float32)

    def block_fn(hb):
        tb = hb.shape[0]
        q = jnp.einsum("td,de->te", hb, w_q).astype(jnp.float32).reshape(tb, PEER_HEADS, 2, PEER_HALF)
        scores = jnp.einsum("thpc,hpnc->thpn", q, keys32)
        s_top, i_top = lax.top_k(scores, PEER_TOPK)
        cand = (s_top[:, :, 0, :, None] + s_top[:, :, 1, None, :]).reshape(tb, PEER_HEADS, PEER_TOPK * PEER_TOPK)
        cand_idx = (i_top[:, :, 0, :, None] * PEER_N_KEYS + i_top[:, :, 1, None, :]).reshape(tb, PEER_HEADS, PEER_TOPK * PEER_TOPK)
        best, pos = lax.top_k(cand, PEER_TOPK)
        idx = jnp.take_along_axis(cand_idx, pos, axis=-1).reshape(tb, PEER_HEADS * PEER_TOPK)
        gate = jax.nn.softmax(best, axis=-1).reshape(tb, PEER_HEADS * PEER_TOPK)
        u = jnp.take(expert_u, idx, axis=0)
        act = jax.nn.gelu(jnp.einsum("tkd,td->tk", u, hb).astype(jnp.float32), approximate=False)
        vv = jnp.take(expert_v, idx, axis=0)
        return jnp.einsum("tk,tkd->td", (gate * act).astype(hb.dtype), vv)

    out = lax.map(block_fn, h.reshape(nb, PEER_TOKEN_BLOCK, D))
    return out.reshape(B, S, D)


def setup_inputs(seed: int = 0) -> dict:
    key = jax.random.key(seed)
    ks = jax.random.split(key, 32)
    nrm = lambda k, shape, scale: jax.random.normal(k, shape, jnp.float32) * scale
    L = DEPTH
    f_base = jnp.linspace(3.0, 6.0, MLSTM_HEADS)
    z = jnp.zeros((MLSTM_HEADS,), jnp.float32)
    gate_base = jnp.stack([z, f_base, z, f_base])
    b_gates = (gate_base[None] + nrm(ks[3], (L, 4, MLSTM_HEADS), 0.1)).reshape(L, N_GATE_COLS)
    a0 = jax.random.uniform(ks[16], (L, 2, LRU_WIDTH), jnp.float32, 0.9, 0.999) ** (1.0 / LRU_C)
    lru_lambda = jnp.log(a0) - jnp.log1p(-a0)
    return {
        "x": nrm(ks[0], (BATCH, SEQ, D_MODEL), 1.0),
        "norm1_g": 1.0 + nrm(ks[1], (L, D_MODEL), 0.02),
        "w_in": nrm(ks[2], (L, D_MODEL, D_IN), D_MODEL ** -0.5),
        "b_gates": b_gates,
        "mlstm_conv_w": nrm(ks[4], (L, CONV_WIDTH, MLSTM_WIDTH), CONV_WIDTH ** -0.5),
        "mlstm_conv_b": nrm(ks[5], (L, MLSTM_WIDTH), 0.02),
        "mlstm_w_q": nrm(ks[6], (L, MLSTM_HEADS, MLSTM_HEAD_DIM, MLSTM_HEAD_DIM), MLSTM_HEAD_DIM ** -0.5),
        "mlstm_w_k": nrm(ks[7], (L, MLSTM_HEADS, MLSTM_HEAD_DIM, MLSTM_HEAD_DIM), MLSTM_HEAD_DIM ** -0.5),
        "mlstm_w_v": nrm(ks[8], (L, MLSTM_HEADS, MLSTM_HEAD_DIM, MLSTM_HEAD_DIM), MLSTM_HEAD_DIM ** -0.5),
        "mlstm_norm_g": 1.0 + nrm(ks[9], (L, MLSTM_WIDTH), 0.02),
        "lru_conv_w": nrm(ks[10], (L, CONV_WIDTH, LRU_WIDTH), CONV_WIDTH ** -0.5),
        "lru_conv_b": nrm(ks[11], (L, LRU_WIDTH), 0.02),
        "lru_w_r": nrm(ks[12], (L, 2, LRU_BLOCKS, LRU_BLOCK_DIM, LRU_BLOCK_DIM), LRU_BLOCK_DIM ** -0.5),
        "lru_b_r": nrm(ks[13], (L, 2, LRU_WIDTH), 0.02),
        "lru_w_i": nrm(ks[14], (L, 2, LRU_BLOCKS, LRU_BLOCK_DIM, LRU_BLOCK_DIM), LRU_BLOCK_DIM ** -0.5),
        "lru_b_i": nrm(ks[15], (L, 2, LRU_WIDTH), 0.02),
        "lru_lambda": lru_lambda,
        "w_branch_mlstm": nrm(ks[17], (L, MLSTM_WIDTH, D_MODEL), MLSTM_WIDTH ** -0.5),
        "w_branch_lru": nrm(ks[18], (L, LRU_WIDTH, D_MODEL), LRU_WIDTH ** -0.5),
        "w_out": nrm(ks[19], (L, D_MODEL, D_MODEL), D_MODEL ** -0.5),
        "norm2_g": 1.0 + nrm(ks[20], (L, D_MODEL), 0.02),
        "peer_w_q": nrm(ks[21], (L, D_MODEL, PEER_HEADS * PEER_QUERY_DIM), D_MODEL ** -0.5),
        "peer_sub_keys": nrm(ks[22], (L, PEER_HEADS, 2, PEER_N_KEYS, PEER_HALF), PEER_HALF ** -0.5),
        "peer_u": nrm(ks[23], (L, PEER_N_EXPERTS, D_MODEL), D_MODEL ** -0.5),
        "peer_v": nrm(ks[24], (L, PEER_N_EXPERTS, D_MODEL), PEER_HEADS ** -0.5),
        "final_norm_g": 1.0 + nrm(ks[25], (D_MODEL,), 0.02),
    }


def reference(x, norm1_g, w_in, b_gates, mlstm_conv_w, mlstm_conv_b, mlstm_w_q, mlstm_w_k, mlstm_w_v,
              mlstm_norm_g, lru_conv_w, lru_conv_b, lru_w_r, lru_b_r, lru_w_i, lru_b_i, lru_lambda,
              w_branch_mlstm, w_branch_lru, w_out, norm2_g, peer_w_q, peer_sub_keys, peer_u, peer_v,
              final_norm_g):
    split_points = np.cumsum(IN_SPLIT_SIZES)[:-1].tolist()
    for l in range(DEPTH):
        h = rms_norm(x, norm1_g[l])
        proj = jnp.einsum("bsd,de->bse", h, w_in[l])
        xm, o_pre, gate_pre, xl, lru_gate, merge_pre = jnp.split(proj, split_points, axis=-1)
        gate_pre = gate_pre + b_gates[l].astype(gate_pre.dtype)
        y_m = mlstm_branch(xm, o_pre, gate_pre, mlstm_conv_w[l], mlstm_conv_b[l], mlstm_w_q[l],
                           mlstm_w_k[l], mlstm_w_v[l], mlstm_norm_g[l])
        y_l = lru_branch(xl, lru_gate, lru_conv_w[l], lru_conv_b[l], lru_w_r[l], lru_b_r[l],
                         lru_w_i[l], lru_b_i[l], lru_lambda[l])
        g_m, g_l = jnp.split(jax.nn.sigmoid(merge_pre), 2, axis=-1)
        merged = (g_m * jnp.einsum("bsc,cd->bsd", y_m, w_branch_mlstm[l])
                  + g_l * jnp.einsum("bsc,cd->bsd", y_l, w_branch_lru[l]))
        x = x + jnp.einsum("bsd,de->bse", merged, w_out[l])
        h2 = rms_norm(x, norm2_g[l])
        x = x + peer(h2, peer_w_q[l], peer_sub_keys[l], peer_u[l], peer_v[l])
    return rms_norm(x, final_norm_g)
```

```cpp
#include <hip/hip_runtime.h>
#include <cstdio>
#include <cstdint>
#include <math.h>

#ifndef MK_N_LAUNCHES
#define MK_N_LAUNCHES 1
#endif

constexpr int BATCH = 8, SEQ = 4096, DM = 1024, MTOK = BATCH * SEQ;
constexpr int DIN = 6160;
constexpr int NEXP = 16384;
constexpr float EPS = 1e-6f;

constexpr size_t MiB = 1u << 20;
constexpr size_t WS_CTL = 0, CTL_ZERO_BYTES = 1 * MiB;
constexpr size_t WS_WIN = 1 * MiB;
constexpr size_t WS_WQKV = 13 * MiB;
constexpr size_t WS_KEYS = 14 * MiB + 512 * 1024;
constexpr size_t WS_WLRU = 15 * MiB;
constexpr size_t WS_WB2 = 16 * MiB;
constexpr size_t WS_WOUT2 = 20 * MiB;
constexpr size_t WS_WPQ = 24 * MiB;
constexpr size_t WS_GATE = 28 * MiB;
constexpr size_t WS_XM = 32 * MiB;
constexpr size_t WS_OP = 96 * MiB;
constexpr size_t WS_XL = 160 * MiB;
constexpr size_t WS_LG = 224 * MiB;
constexpr size_t WS_MG = 288 * MiB;
constexpr size_t WS_K = 416 * MiB;
constexpr size_t WS_AGG = 480 * MiB;
constexpr size_t WS_SS = 488 * MiB;
constexpr size_t WS_END = 489 * MiB;

constexpr int CW_BAR = 4096;

constexpr int RING_BYTES = 131072;
constexpr int LDS_BYTES = 147456;
constexpr int LDSCTL_OFF = LDS_BYTES - 512, MISC_OFF = LDSCTL_OFF + 320;
constexpr int NWAVES = 8, NTHR = 512;

#define GAS __attribute__((address_space(1)))
#define LAS __attribute__((address_space(3)))
typedef unsigned short bf16;
typedef unsigned v4u __attribute__((ext_vector_type(4)));
typedef unsigned v2u __attribute__((ext_vector_type(2)));
typedef float f32x4 __attribute__((ext_vector_type(4)));
typedef float f32x2 __attribute__((ext_vector_type(2)));
typedef short bf16x8 __attribute__((ext_vector_type(8)));
typedef GAS unsigned gu32;
#define RLX_AGENT __ATOMIC_RELAXED, __HIP_MEMORY_SCOPE_AGENT
#define LDS_WAIT() asm volatile("s_waitcnt lgkmcnt(0)" ::: "memory")
#define VM_WAIT() asm volatile("s_waitcnt vmcnt(0)" ::: "memory")

__device__ __forceinline__ unsigned f2bf(float f) { unsigned u = __builtin_bit_cast(unsigned, f); return (u + 0x7fffu + ((u >> 16) & 1u)) >> 16; }
__device__ __forceinline__ unsigned pk2(float lo, float hi) { return f2bf(lo) | (f2bf(hi) << 16); }
__device__ __forceinline__ float bf2f(unsigned short h) { return __builtin_bit_cast(float, (unsigned)h << 16); }
__device__ __forceinline__ float bflo(unsigned w) { return __builtin_bit_cast(float, w << 16); }
__device__ __forceinline__ float bfhi(unsigned w) { return __builtin_bit_cast(float, w & 0xffff0000u); }
__device__ __forceinline__ float wave_sum(float v) {
#pragma unroll
  for (int o = 1; o < 64; o <<= 1) v += __shfl_xor(v, o);
  return v;
}
__device__ __forceinline__ float sigmoidf_(float x) { return 1.f / (1.f + __expf(-x)); }
__device__ __forceinline__ float gelu_erf(float x) { return 0.5f * x * (1.f + erff(x * 0.70710678118654752f)); }
__device__ __forceinline__ float gelu_fast(float v) {
    const float av = fabsf(v), t = __builtin_amdgcn_rcpf(av * 0.2316418882f + 1.0f);
    float q = t * 0.5307027145f + (-0.7265760135f); q = q * t + 0.7107068705f; q = q * t + (-0.142248368f); q = q * t + 0.127414796f; q = q * t;
    const float e = __builtin_amdgcn_exp2f((v * v) * (-0.72134752044f));
    const float m = v * (q * e);
    return v < 0.f ? m : v - m;
}
__device__ __forceinline__ float softplusf_(float x) { return fmaxf(x, 0.f) + log1pf(expf(-fabsf(x))); }

namespace pg8 {
#define PG8_LAS __attribute__((address_space(3)))
typedef unsigned short bf16_t;
typedef unsigned u32x4 __attribute__((ext_vector_type(4)));
constexpr int BM = 256, BK = 64, HALF = 128, HTB = HALF * BK * 2, STAGE_BYTES = 8 * HTB, NXCD = 8, WGM = 8;

__host__ __device__ __forceinline__ int lds_byte(int r, int c) { const int st = (r >> 4) * 2 + (c >> 5), rr = r & 15, cc = c & 31, ob = rr * 64 + cc * 2; return st * 1024 + (ob ^ (((ob >> 9) & 1) << 5)); }
__host__ __device__ __forceinline__ void stage_rc(int b, int& R, int& C) { const int st = b / 1024, sb = b % 1024, swz = sb ^ (((sb >> 9) & 1) << 5); R = (st >> 1) * 16 + swz / 64; C = (st & 1) * 32 + (swz % 64) / 2; }
__host__ __device__ __forceinline__ int perm32(int rho) { const int n = rho >> 4, i = rho & 15; return 8 * (i >> 2) + 4 * n + (i & 3); }

struct Unit { int pm, pn; };
struct StaticOrder {
    int nM, nN, nwg, G, c;
    __host__ __device__ void init(int M, int N, int G_, int c_) { nM = M / BM; nN = N / BM; nwg = nM * nN; G = G_; c = c_; }
    __host__ __device__ bool next(int i, Unit& u) const {
        const long L = (long)i * G + c; if (L >= nwg) return false;
        int wgid = (int)L; { const int q = nwg / NXCD, r = nwg % NXCD, xcd = wgid % NXCD, off = wgid / NXCD; wgid = (xcd < r ? xcd * (q + 1) : r * (q + 1) + (xcd - r) * q) + off; }
        const int nig = WGM * nN, gid = wgid / nig, fm = gid * WGM, gsz = (nM - fm) < WGM ? (nM - fm) : WGM;
        u.pm = fm + ((wgid % nig) % gsz); u.pn = (wgid % nig) / gsz; return true;
    }
};

__device__ __forceinline__ unsigned cvt_pk_bf16(float lo, float hi) { unsigned r; asm volatile("v_cvt_pk_bf16_f32 %0, %1, %2" : "=v"(r) : "v"(lo), "v"(hi)); return r; }

template <class Epi, class Addr>
__device__ __forceinline__ void gemm_phase(PG8_LAS unsigned char* lds, const Addr g, const StaticOrder& S, const Epi& E) {
    const int tid = threadIdx.x, wid = __builtin_amdgcn_readfirstlane(tid >> 6), lane = tid & 63, wr = wid >> 2, wc = wid & 3, fr = lane & 15, fq = lane >> 4;
    const int K = g.K, nt = K / BK;
    unsigned voffA[2], voffB[2];
#pragma unroll
    for (int i = 0; i < 2; ++i) { int R, C; stage_rc(tid * 16 + i * 8192, R, C); const int Rb = Epi::PERM ? ((R & ~31) + perm32(R & 31)) : R;
        voffA[i] = (unsigned)(R * g.lda + C) * 2u; voffB[i] = (unsigned)(Rb * g.ldb + C) * 2u; }
    const size_t kstep = (size_t)(BK * 2);
    const size_t hsA = (size_t)HALF * g.lda * 2, hsB = (size_t)HALF * g.ldb * 2;
    const unsigned ldsw = (unsigned)wid * 1024u;
    const int aoff = lds_byte(wr * 64 + fr, fq * 8), boff = lds_byte(wc * 32 + fr, fq * 8);
#define PG8_SA(b, h) (((b) * 2 + (h)) * HTB)
#define PG8_SB(b, h) ((4 + (b) * 2 + (h)) * HTB)
#define PG8_STAGE(bufoff, gbase, voff) do { _Pragma("unroll") for (int _i = 0; _i < 2; ++_i) \
        __builtin_amdgcn_global_load_lds((const unsigned*)((const char*)(gbase) + (voff)[_i]), (PG8_LAS unsigned*)(lds + (bufoff) + ldsw + _i * 8192), 16, 0, 0); } while (0)
#define PG8_LDA(dst, b, h) do { _Pragma("unroll") for (int m = 0; m < 4; ++m) _Pragma("unroll") for (int k = 0; k < 2; ++k) dst[m][k] = *(const PG8_LAS bf16x8*)(lds + PG8_SA(b, h) + aoff + m * 2048 + k * 1024); } while (0)
#define PG8_LDB(dst, b, h) do { _Pragma("unroll") for (int n = 0; n < 2; ++n) _Pragma("unroll") for (int k = 0; k < 2; ++k) dst[n][k] = *(const PG8_LAS bf16x8*)(lds + PG8_SB(b, h) + boff + n * 2048 + k * 1024); } while (0)
#define PG8_MMA(ai, bj, At, Bt) do { __builtin_amdgcn_s_setprio(1); _Pragma("unroll") for (int m = 0; m < 4; ++m) _Pragma("unroll") for (int n = 0; n < 2; ++n) _Pragma("unroll") for (int k = 0; k < 2; ++k) \
        acc[ai][bj][m][n] = __builtin_amdgcn_mfma_f32_16x16x32_bf16(Bt[n][k], At[m][k], acc[ai][bj][m][n], 0, 0, 0); __builtin_amdgcn_s_setprio(0); } while (0)
#define PG8_WAIT_V(n) asm volatile("s_waitcnt vmcnt(" #n ")" ::: "memory")
#define PG8_WAIT_L(n) asm volatile("s_waitcnt lgkmcnt(" #n ")" ::: "memory")
#define PG8_BAR __builtin_amdgcn_s_barrier()
#define PG8_SCHED __builtin_amdgcn_sched_barrier(0)
    Unit cur, nxt; int ui = 0;
    if (!S.next(0, cur)) return;
    f32x4 acc[2][2][4][2];
#pragma unroll
    for (int a = 0; a < 2; ++a)
#pragma unroll
        for (int b = 0; b < 2; ++b)
#pragma unroll
            for (int m = 0; m < 4; ++m)
#pragma unroll
                for (int n = 0; n < 2; ++n) acc[a][b][m][n] = (f32x4){0.f, 0.f, 0.f, 0.f};
    bf16x8 At[4][2], B0[2][2], B1[2][2];
    const char* cA = g.a(cur); const char* cB = g.b(cur);
    PG8_STAGE(PG8_SB(0, 0), cB, voffB); PG8_STAGE(PG8_SB(0, 1), cB + hsB, voffB); PG8_STAGE(PG8_SA(0, 0), cA, voffA); PG8_STAGE(PG8_SA(0, 1), cA + hsA, voffA);
    if (wr == 1) PG8_BAR;
    PG8_WAIT_V(2); PG8_BAR;
    PG8_STAGE(PG8_SB(1, 0), cB + kstep, voffB); PG8_STAGE(PG8_SA(1, 0), cA + kstep, voffA); PG8_STAGE(PG8_SB(1, 1), cB + hsB + kstep, voffB);
    PG8_WAIT_V(6); PG8_BAR;
    for (;;) {
        const bool has_next = S.next(ui + 1, nxt);
        const char* nA = has_next ? g.a(nxt) : cA; const char* nB = has_next ? g.b(nxt) : cB;
#pragma unroll 1
        for (int t = 0; t < nt; t += 2) {
            const bool last = (t == nt - 2);
            const char* a1 = cA + (size_t)(t + 1) * kstep;
            const char* a2 = last ? nA : cA + (size_t)(t + 2) * kstep; const char* b2 = last ? nB : cB + (size_t)(t + 2) * kstep;
            const char* a3 = a2 + kstep; const char* b3 = b2 + kstep;
            PG8_LDB(B0, 0, 0); PG8_LDB(B1, 0, 1); PG8_SCHED; PG8_LDA(At, 0, 0); PG8_STAGE(PG8_SA(1, 1), a1 + hsA, voffA);
            PG8_WAIT_V(8); PG8_WAIT_L(0); PG8_BAR; PG8_MMA(0, 0, At, B0); PG8_MMA(0, 1, At, B1); PG8_BAR; PG8_SCHED;
            PG8_LDA(At, 0, 1); PG8_STAGE(PG8_SB(0, 0), b2, voffB); PG8_STAGE(PG8_SB(0, 1), b2 + hsB, voffB); PG8_STAGE(PG8_SA(0, 0), a2, voffA);
            PG8_WAIT_V(8); PG8_WAIT_L(0); PG8_BAR; PG8_MMA(1, 0, At, B0); PG8_MMA(1, 1, At, B1); PG8_BAR; PG8_SCHED;
            PG8_LDB(B0, 1, 0); PG8_LDB(B1, 1, 1); PG8_SCHED; PG8_LDA(At, 1, 0); PG8_STAGE(PG8_SA(0, 1), a2 + hsA, voffA);
            PG8_WAIT_V(8); PG8_WAIT_L(0); PG8_BAR; PG8_MMA(0, 0, At, B0); PG8_MMA(0, 1, At, B1); PG8_BAR; PG8_SCHED;
            PG8_LDA(At, 1, 1); PG8_STAGE(PG8_SB(1, 0), b3, voffB); PG8_STAGE(PG8_SB(1, 1), b3 + hsB, voffB); PG8_STAGE(PG8_SA(1, 0), a3, voffA);
            PG8_WAIT_V(8); PG8_WAIT_L(0); PG8_BAR; PG8_MMA(1, 0, At, B0); PG8_MMA(1, 1, At, B1); PG8_BAR; PG8_SCHED;
        }
        if (wr == 0) PG8_BAR;
        E(acc, cur, wr, wc, fr, fq);
        if (!has_next) break;
#pragma unroll
        for (int a = 0; a < 2; ++a)
#pragma unroll
            for (int b = 0; b < 2; ++b)
#pragma unroll
                for (int m = 0; m < 4; ++m)
#pragma unroll
                    for (int n = 0; n < 2; ++n) acc[a][b][m][n] = (f32x4){0.f, 0.f, 0.f, 0.f};
        cur = nxt; cA = nA; cB = nB; ++ui;
        if (wr == 1) PG8_BAR;
    }
    PG8_WAIT_V(0);
    PG8_BAR;
#undef PG8_SA
#undef PG8_SB
#undef PG8_STAGE
#undef PG8_LDA
#undef PG8_LDB
#undef PG8_MMA
#undef PG8_WAIT_V
#undef PG8_WAIT_L
#undef PG8_BAR
#undef PG8_SCHED
}
}

#define XB_TMO      128
#define XB_XCNT(j)  (256  + 64 * (j))
#define XB_XSUB(j)  (1280 + 64 * (j))
#define XB_XGEN(j)  (2304 + 64 * (j))
#define XB_TOP      3328
#define XB_TOPGEN   3392
#define XCD_BAR_WORDS 3456
#define XB_SPIN_CAP (1u << 18)
__device__ __forceinline__ unsigned xb_ld(unsigned* p)              { return __hip_atomic_load(p, __ATOMIC_RELAXED, __HIP_MEMORY_SCOPE_AGENT); }
__device__ __forceinline__ unsigned xb_add(unsigned* p, unsigned v) { return __hip_atomic_fetch_add(p, v, __ATOMIC_RELAXED, __HIP_MEMORY_SCOPE_AGENT); }
__device__ __forceinline__ unsigned xb_xcc_id() { return (unsigned)__builtin_amdgcn_s_getreg((3 << 11) | 20) & 0xFu; }
#define XB_SPIN(cond, bar) do { unsigned _sp = 0; while (cond) { __builtin_amdgcn_s_sleep(1); \
    if ((++_sp & 255u) == 0u) { if (xb_ld(&(bar)[XB_TMO])) break; if (_sp > XB_SPIN_CAP) { atomicAdd(&(bar)[XB_TMO], 1u); break; } } } } while (0)
struct XcdBarrier { unsigned* bar; unsigned x; volatile LAS unsigned* st; };
__device__ __forceinline__ XcdBarrier xcd_barrier_post(unsigned* bar, volatile LAS unsigned* st) {
    XcdBarrier b; b.bar = bar; b.x = xb_xcc_id(); b.st = st;
    if (threadIdx.x == 0) (void)xb_add(&bar[XB_XCNT(b.x)], 1u);
    return b;
}
__device__ __forceinline__ void xcd_barrier_complete(unsigned* bar, unsigned x, unsigned& nloc, unsigned& nx) {
    const unsigned G = gridDim.x * gridDim.y * gridDim.z;
    unsigned sum, cnt, mine, sp = 0u;
    for (;;) {
        sum = 0u; cnt = 0u; mine = 0u;
#pragma unroll
        for (unsigned j = 0; j < 16; ++j) { const unsigned c = xb_ld(&bar[XB_XCNT(j)]); sum += c; cnt += (c > 0u) ? 1u : 0u; mine = (j == x) ? c : mine; }
        if (sum == G) break;
        __builtin_amdgcn_s_sleep(1);
        if ((++sp & 255u) == 0u) { if (xb_ld(&bar[XB_TMO])) break; if (sp > XB_SPIN_CAP) { atomicAdd(&bar[XB_TMO], 1u); break; } }
    }
    nloc = mine > 0u ? mine : 1u; nx = cnt > 0u ? cnt : 1u;
}
__device__ __forceinline__ void xcd_barrier(const XcdBarrier& b) {
    asm volatile("s_waitcnt vmcnt(0)" ::: "memory");
    __syncthreads();
    if (threadIdx.x == 0) {
        unsigned* bar = b.bar;
        __builtin_amdgcn_s_waitcnt(0);
        unsigned nloc = b.st[0], nx = b.st[1];
        if (nloc == 0u) { xcd_barrier_complete(bar, b.x, nloc, nx); b.st[0] = nloc; b.st[1] = nx; }
        const unsigned old = xb_add(&bar[XB_XSUB(b.x)], 1u);
        const unsigned gen = old / nloc;
        if (old + 1u == (gen + 1u) * nloc) {
            __builtin_amdgcn_fence(__ATOMIC_RELEASE, "agent");
            asm volatile("s_waitcnt vmcnt(0)" ::: "memory");
            const unsigned og = xb_add(&bar[XB_TOP], 1u);
            const unsigned tg = og / nx;
            if (og + 1u == (tg + 1u) * nx) xb_add(&bar[XB_TOPGEN], 1u);
            else XB_SPIN(xb_ld(&bar[XB_TOPGEN]) == tg, bar);
            __builtin_amdgcn_fence(__ATOMIC_ACQUIRE, "agent");
            xb_add(&bar[XB_XGEN(b.x)], 1u);
            asm volatile("s_waitcnt vmcnt(0)" ::: "memory");
        } else {
            XB_SPIN(xb_ld(&bar[XB_XGEN(b.x)]) == gen, bar);
            __builtin_amdgcn_fence(__ATOMIC_ACQUIRE, "agent");
            asm volatile("s_waitcnt vmcnt(0)" ::: "memory");
        }
    }
    __syncthreads();
}

struct Args { const float* in[26]; float* out; unsigned char* ws; int ph_lo, ph_hi; };
struct Frame {
    LAS unsigned char* lds;
    int tid, lane, wave, G, bid;
    const float* const* in; float* out; unsigned char* ws;
};

__device__ __forceinline__ void tr_item(const float* W, int ldw, bf16* WT, int ldt, float scale, const float* kscale, LAS float* scr, int k0, int lane) {
#pragma unroll 8
    for (int i = 0; i < 32; ++i) { const int kk = 2 * i + (lane >> 5); float v = W[(size_t)(k0 + kk) * ldw + (lane & 31)] * scale; if (kscale) v *= kscale[k0 + kk]; scr[kk * 33 + (lane & 31)] = v; }
    LDS_WAIT(); asm volatile("" ::: "memory");
    const int c = lane & 7;
#pragma unroll
    for (int j = 0; j < 4; ++j) { const int n = (lane >> 3) + 8 * j; const LAS float* s = scr + (8 * c) * 33 + n;
        v4u o; o.x = pk2(s[0 * 33], s[1 * 33]); o.y = pk2(s[2 * 33], s[3 * 33]); o.z = pk2(s[4 * 33], s[5 * 33]); o.w = pk2(s[6 * 33], s[7 * 33]);
        *(GAS v4u*)(WT + (size_t)n * ldt + k0 + 8 * c) = o; }
    LDS_WAIT(); asm volatile("" ::: "memory");
}

__device__ __forceinline__ void p0_prologue(Frame& F) {
    LAS float* scr = (LAS float*)(F.lds + F.wave * 16384);
    const int gw = F.bid * NWAVES + F.wave, NGW = F.G * NWAVES;
    unsigned char* ws = F.ws;
    const float* w_in = F.in[2];
    constexpr int I_WIN = 16 * 192, I_QKV = 12 * 32, I_LRU = 32 * 8, I_WB = 2 * 512, I_WO = 2 * 512, I_PQ = 16 * 64;
    constexpr int NITEMS = I_WIN + I_QKV + I_LRU + I_WB + I_WO + I_PQ;
    for (int it = gw; it < NITEMS; it += NGW) {
        int r = it;
        if (r < I_WIN) { const int kb = r / 192, nb = r % 192, n0 = nb * 32, sc = n0 < 2048 ? n0 : n0 + 16;
            tr_item(w_in + sc, DIN, (bf16*)(ws + WS_WIN) + (size_t)n0 * 1024, 1024, 1.f, nullptr, scr, kb * 64, F.lane); continue; }
        r -= I_WIN;
        if (r < I_QKV) { const int mat = r / 32, rr = r % 32, kb = rr / 8, nb = rr % 8, g = mat >> 2, h = mat & 3;
            const float* W = F.in[6 + g] + (size_t)h * 65536 + nb * 32;
            tr_item(W, 256, (bf16*)(ws + WS_WQKV) + (size_t)mat * 65536 + (size_t)(nb * 32) * 256, 256, g == 1 ? 0.0625f : 1.f, nullptr, scr, kb * 64, F.lane); continue; }
        r -= I_QKV;
        if (r < I_LRU) { const int mat = r / 8, rr = r % 8, kb = rr / 4, nb = rr % 4, gate = mat & 1, db = mat >> 1;
            const float* W = F.in[gate ? 14 : 12] + (size_t)db * 16384 + nb * 32;
            tr_item(W, 128, (bf16*)(ws + WS_WLRU) + (size_t)mat * 16384 + (size_t)(nb * 32) * 128, 128, 1.f, nullptr, scr, kb * 64, F.lane); continue; }
        r -= I_LRU;
        if (r < I_WB) { const int mat = r / 512, rr = r % 512, kb = rr / 32, nb = rr % 32;
            const float* W = F.in[17 + mat] + nb * 32;
            tr_item(W, 1024, (bf16*)(ws + WS_WB2) + (size_t)(mat * 1024 + nb * 32) * 1024, 1024, 1.f, nullptr, scr, kb * 64, F.lane); continue; }
        r -= I_WB;
        if (r < I_WO) { const int cp = r / 512, rr = r % 512, kb = rr / 32, nb = rr % 32;
            const float* W = F.in[19] + nb * 32;
            tr_item(W, 1024, (bf16*)(ws + WS_WOUT2) + (size_t)(nb * 32) * 2048 + cp * 1024, 2048, 1.f, nullptr, scr, kb * 64, F.lane); continue; }
        r -= I_WO;
        { const int kb = r / 64, nb = r % 64;
            const float* W = F.in[21] + nb * 32;
            tr_item(W, 2048, (bf16*)(ws + WS_WPQ) + (size_t)(nb * 32) * 1024, 1024, 1.f, F.in[20], scr, kb * 64, F.lane); }
    }
    { const int gt = F.bid * NTHR + F.tid, NGT = F.G * NTHR;
      const float4* ks = (const float4*)F.in[22]; v2u* kd = (v2u*)(ws + WS_KEYS);
      for (int i = gt; i < 8 * 2 * 128 * 128 / 4; i += NGT) { const float4 v = ks[i]; v2u o; o.x = pk2(v.x, v.y); o.y = pk2(v.z, v.w); kd[i] = o; }
      float* ss = (float*)(ws + WS_SS);
      for (int i = gt; i < MTOK; i += NGT) ss[i] = 0.f; }
    const float* x = F.in[0]; const float* g1 = F.in[1]; const float* bg = F.in[3];
    bf16* XN = (bf16*)F.out;
    float* GT = (float*)(ws + WS_GATE);
    f32x4 gv[4];
#pragma unroll
    for (int j = 0; j < 4; ++j) gv[j] = ((const f32x4*)g1)[F.lane + 64 * j];
    for (int m = gw; m < MTOK; m += NGW) {
        const f32x4* xr = (const f32x4*)(x + (size_t)m * DM) + F.lane;
        f32x4 v[4]; float s = 0.f;
#pragma unroll
        for (int j = 0; j < 4; ++j) { v[j] = xr[64 * j]; s += (v[j].x * v[j].x + v[j].y * v[j].y) + (v[j].z * v[j].z + v[j].w * v[j].w); }
        const float rstd = rsqrtf(wave_sum(s) * (1.f / DM) + EPS);
        unsigned long long* o8 = (unsigned long long*)(XN + (size_t)m * DM) + F.lane;
        float pg[16];
#pragma unroll
        for (int c = 0; c < 16; ++c) pg[c] = 0.f;
#pragma unroll
        for (int j = 0; j < 4; ++j) {
            v[j] = v[j] * rstd * gv[j];
            o8[64 * j] = (unsigned long long)pk2(v[j].x, v[j].y) | ((unsigned long long)pk2(v[j].z, v[j].w) << 32);
#pragma unroll
            for (int e = 0; e < 4; ++e) {
                const int k = 4 * (F.lane + 64 * j) + e;
                const f32x4* wr = (const f32x4*)(w_in + (size_t)k * DIN + 2048);
                const float hv = v[j][e];
#pragma unroll
                for (int q = 0; q < 4; ++q) { const f32x4 w4 = wr[q]; pg[4 * q] += hv * w4.x; pg[4 * q + 1] += hv * w4.y; pg[4 * q + 2] += hv * w4.z; pg[4 * q + 3] += hv * w4.w; }
            }
        }
        float mine = 0.f;
#pragma unroll
        for (int c = 0; c < 16; ++c) { const float t = wave_sum(pg[c]); if (F.lane == c) mine = t; }
        if (F.lane < 16) GT[(size_t)m * 16 + F.lane] = mine + bg[F.lane];
    }
}

struct AddrPlain {
    const char* A; const char* Bt; int lda, ldb, K;
    __device__ __forceinline__ const char* a(const pg8::Unit& u) const { return A + (size_t)u.pm * 256 * lda * 2; }
    __device__ __forceinline__ const char* b(const pg8::Unit& u) const { return Bt + (size_t)u.pn * 256 * ldb * 2; }
};
struct AddrQKV {
    const char* XC; long dXM; const char* W; int lda, ldb, K;
    __device__ __forceinline__ const char* a(const pg8::Unit& u) const { return XC + (u.pn < 8 ? 0l : dXM) + ((size_t)u.pm * 256 * 1024 + (u.pn & 3) * 256) * 2; }
    __device__ __forceinline__ const char* b(const pg8::Unit& u) const { return W + (size_t)u.pn * 65536 * 2; }
};
struct AddrBranch {
    const char* YM; long dYL; const char* W; int lda, ldb, K;
    __device__ __forceinline__ const char* a(const pg8::Unit& u) const { return YM + (u.pn < 4 ? 0l : dYL) + (size_t)u.pm * 256 * 1024 * 2; }
    __device__ __forceinline__ const char* b(const pg8::Unit& u) const { return W + (size_t)u.pn * 256 * 1024 * 2; }
};

struct DstP1 { unsigned char* ws;
    __device__ __forceinline__ bf16* get(int pn, int& ld, int& col0) const {
        const bool mg = pn >= 16; ld = mg ? 2048 : 1024; col0 = mg ? (pn - 16) * 256 : (pn & 3) * 256;
        return (bf16*)(ws + (mg ? WS_MG : WS_XM + (size_t)(pn >> 2) * 64 * MiB)); } };
struct DstQKV { char* q; long dk, dv;
    __device__ __forceinline__ bf16* get(int pn, int& ld, int& col0) const { ld = 1024; col0 = (pn & 3) * 256; return (bf16*)(q + (pn >= 4 ? (pn >= 8 ? dv : dk) : 0l)); } };
template <class Dst> struct EpiBf16 {
    static constexpr bool PERM = true;
    Dst dst;
    __device__ __forceinline__ void operator()(const f32x4 (&acc)[2][2][4][2], const pg8::Unit& u, int wr, int wc, int fr, int fq) const {
        int ld, colt; bf16* base = dst.get(u.pn, ld, colt);
        const int row0 = u.pm * 256 + wr * 64 + fr, col0 = colt + wc * 32 + 8 * fq;
#pragma unroll
        for (int ai = 0; ai < 2; ++ai)
#pragma unroll
            for (int m = 0; m < 4; ++m) { bf16* rowp = base + (size_t)(row0 + ai * 128 + m * 16) * ld + col0;
#pragma unroll
                for (int bj = 0; bj < 2; ++bj) { const f32x4 v0 = acc[ai][bj][m][0], v1 = acc[ai][bj][m][1];
                    v4u w; w.x = pg8::cvt_pk_bf16(v0[0], v0[1]); w.y = pg8::cvt_pk_bf16(v0[2], v0[3]); w.z = pg8::cvt_pk_bf16(v1[0], v1[1]); w.w = pg8::cvt_pk_bf16(v1[2], v1[3]);
                    *(v4u*)(rowp + bj * 128) = w; } }
    }
};
struct EpiGate {
    static constexpr bool PERM = true;
    bf16* G;
    __device__ __forceinline__ void operator()(const f32x4 (&acc)[2][2][4][2], const pg8::Unit& u, int wr, int wc, int fr, int fq) const {
        const int row0 = u.pm * 256 + wr * 64 + fr, col0 = u.pn * 256 + wc * 32 + 8 * fq;
#pragma unroll
        for (int ai = 0; ai < 2; ++ai)
#pragma unroll
            for (int m = 0; m < 4; ++m) { bf16* rowp = G + (size_t)(row0 + ai * 128 + m * 16) * 2048 + col0;
#pragma unroll
                for (int bj = 0; bj < 2; ++bj) { const f32x4 v0 = acc[ai][bj][m][0], v1 = acc[ai][bj][m][1];
                    const v4u g = *(const v4u*)(rowp + bj * 128);
                    v4u w;
                    w.x = pg8::cvt_pk_bf16(v0[0] * sigmoidf_(bflo(g.x)), v0[1] * sigmoidf_(bfhi(g.x)));
                    w.y = pg8::cvt_pk_bf16(v0[2] * sigmoidf_(bflo(g.y)), v0[3] * sigmoidf_(bfhi(g.y)));
                    w.z = pg8::cvt_pk_bf16(v1[0] * sigmoidf_(bflo(g.z)), v1[1] * sigmoidf_(bfhi(g.z)));
                    w.w = pg8::cvt_pk_bf16(v1[2] * sigmoidf_(bflo(g.w)), v1[3] * sigmoidf_(bfhi(g.w)));
                    *(v4u*)(rowp + bj * 128) = w; } }
    }
};
struct EpiResid {
    static constexpr bool PERM = false;
    const float* x; float* x1; bf16* x1b; float* ss;
    __device__ __forceinline__ void operator()(const f32x4 (&acc)[2][2][4][2], const pg8::Unit& u, int wr, int wc, int fr, int fq) const {
        const int row0 = u.pm * 256 + wr * 64 + fr, col0 = u.pn * 256 + wc * 32 + 4 * fq;
#pragma unroll
        for (int ai = 0; ai < 2; ++ai)
#pragma unroll
            for (int m = 0; m < 4; ++m) { const int row = row0 + ai * 128 + m * 16; const size_t off = (size_t)row * DM + col0; float s = 0.f;
#pragma unroll
                for (int bj = 0; bj < 2; ++bj)
#pragma unroll
                    for (int n = 0; n < 2; ++n) { const size_t o = off + bj * 128 + n * 16; const f32x4 v = *(const f32x4*)(x + o) + acc[ai][bj][m][n];
                        *(f32x4*)(x1 + o) = v; v2u w; w.x = pg8::cvt_pk_bf16(v[0], v[1]); w.y = pg8::cvt_pk_bf16(v[2], v[3]); *(v2u*)(x1b + o) = w;
                        s += (v[0] * v[0] + v[1] * v[1]) + (v[2] * v[2] + v[3] * v[3]); }
                s += __shfl_xor(s, 16); s += __shfl_xor(s, 32);
                if (fq == 0) atomicAdd(ss + row, s); }
    }
};
struct EpiPQ {
    static constexpr bool PERM = true;
    bf16* pq; const float* ss;
    __device__ __forceinline__ void operator()(const f32x4 (&acc)[2][2][4][2], const pg8::Unit& u, int wr, int wc, int fr, int fq) const {
        const int row0 = u.pm * 256 + wr * 64 + fr, col0 = u.pn * 256 + wc * 32 + 8 * fq;
#pragma unroll
        for (int ai = 0; ai < 2; ++ai)
#pragma unroll
            for (int m = 0; m < 4; ++m) { const int row = row0 + ai * 128 + m * 16; bf16* rowp = pq + (size_t)row * 2048 + col0;
                const float r = rsqrtf(ss[row] * (1.f / DM) + EPS);
#pragma unroll
                for (int bj = 0; bj < 2; ++bj) { const f32x4 v0 = acc[ai][bj][m][0] * r, v1 = acc[ai][bj][m][1] * r;
                    v4u w; w.x = pg8::cvt_pk_bf16(v0[0], v0[1]); w.y = pg8::cvt_pk_bf16(v0[2], v0[3]); w.z = pg8::cvt_pk_bf16(v1[0], v1[1]); w.w = pg8::cvt_pk_bf16(v1[2], v1[3]);
                    *(v4u*)(rowp + bj * 128) = w; } }
    }
};

__device__ __forceinline__ void lru_ref(Frame& F) {
    const bf16* XL = (const bf16*)(F.ws + WS_XL); const bf16* LG = (const bf16*)(F.ws + WS_LG); bf16* YL = (bf16*)F.out;
    const bf16* WL = (const bf16*)(F.ws + WS_WLRU);
    const float* cw = F.in[10]; const float* cb = F.in[11];
    LAS float* sxc = (LAS float*)F.lds;
    LAS float* sp = (LAS float*)(F.lds + 1024);
    const int c = F.tid & 127, part = F.tid >> 7;
    for (int item = F.bid; item < 64; item += F.G) {
        const int b = item >> 3, blk = item & 7, ch = blk * 128 + c;
        const float w0 = cw[0 * DM + ch], w1 = cw[1 * DM + ch], w2 = cw[2 * DM + ch], w3 = cw[3 * DM + ch], bb = cb[ch];
        for (int dir = 0; dir < 2; ++dir) {
            v4u wr[4], wi[4];
            { const v4u* pr = (const v4u*)(WL + ((size_t)((dir * 8 + blk) * 2 + 0) * 128 + c) * 128 + part * 32);
              const v4u* pi = (const v4u*)(WL + ((size_t)((dir * 8 + blk) * 2 + 1) * 128 + c) * 128 + part * 32);
#pragma unroll
              for (int q = 0; q < 4; ++q) { wr[q] = pr[q]; wi[q] = pi[q]; } }
            const float br = F.in[13][dir * DM + ch], bi = F.in[15][dir * DM + ch];
            const float spl = softplusf_(-F.in[16][dir * DM + ch]);
            float h = 0.f;
            for (int step = 0; step < SEQ; ++step) {
                const int t = dir ? (SEQ - 1 - step) : step;
                const size_t m = (size_t)b * SEQ + t;
                float xc = 0.f;
                if (part == 0) {
                    xc = bb;
                    if (t >= 2) xc += w0 * bf2f(XL[(m - 2) * DM + ch]);
                    if (t >= 1) xc += w1 * bf2f(XL[(m - 1) * DM + ch]);
                    xc += w2 * bf2f(XL[m * DM + ch]);
                    if (t + 1 < SEQ) xc += w3 * bf2f(XL[(m + 1) * DM + ch]);
                    sxc[c] = xc;
                }
                __syncthreads();
                float pr_ = 0.f, pi_ = 0.f;
#pragma unroll
                for (int q = 0; q < 4; ++q) {
                    const f32x4 x0 = *(const LAS f32x4*)(sxc + part * 32 + q * 8), x1 = *(const LAS f32x4*)(sxc + part * 32 + q * 8 + 4);
                    pr_ += x0[0] * bflo(wr[q].x) + x0[1] * bfhi(wr[q].x) + x0[2] * bflo(wr[q].y) + x0[3] * bfhi(wr[q].y)
                         + x1[0] * bflo(wr[q].z) + x1[1] * bfhi(wr[q].z) + x1[2] * bflo(wr[q].w) + x1[3] * bfhi(wr[q].w);
                    pi_ += x0[0] * bflo(wi[q].x) + x0[1] * bfhi(wi[q].x) + x0[2] * bflo(wi[q].y) + x0[3] * bfhi(wi[q].y)
                         + x1[0] * bflo(wi[q].z) + x1[1] * bfhi(wi[q].z) + x1[2] * bflo(wi[q].w) + x1[3] * bfhi(wi[q].w);
                }
                sp[(part * 2 + 0) * 128 + c] = pr_; sp[(part * 2 + 1) * 128 + c] = pi_;
                __syncthreads();
                if (part == 0) {
                    const float rp = sp[0 * 128 + c] + sp[2 * 128 + c] + sp[4 * 128 + c] + sp[6 * 128 + c] + br;
                    const float ip = sp[1 * 128 + c] + sp[3 * 128 + c] + sp[5 * 128 + c] + sp[7 * 128 + c] + bi;
                    const float r = sigmoidf_(rp), ig = sigmoidf_(ip);
                    const float log_a = -8.f * r * spl;
                    const float a = __expf(log_a);
                    const float u = sqrtf(-expm1f(2.f * log_a)) * (ig * xc);
                    h = a * h + u;
                    if (dir == 0) YL[m * DM + ch] = (bf16)f2bf(h);
                    else { const float y = (bf2f(YL[m * DM + ch]) + h) * gelu_erf(bf2f(LG[m * DM + ch])); YL[m * DM + ch] = (bf16)f2bf(y); }
                }
            }
            __syncthreads();
        }
    }
}


template <bool PB> __device__ __forceinline__ void lru_phase(Frame& F) {
    const bf16* XL = (const bf16*)(F.ws + WS_XL); const bf16* LG = (const bf16*)(F.ws + WS_LG); bf16* YL = (bf16*)F.out;
    f32x2* AGG = (f32x2*)(F.ws + WS_AGG);
    const bf16* WL = (const bf16*)(F.ws + WS_WLRU);
    const float* cw = F.in[10]; const float* cb = F.in[11];
    constexpr int O_XCB = 0, O_XCF = 17408, O_A = 50176, O_U = 82944;
    LAS unsigned char* L = F.lds;
    const int tid = F.tid, lane = F.lane, w = F.wave, fr = lane & 15, fq = lane >> 4;
    int cur_blk = -1;
    bf16x8 wf[2][2][4];
    f32x4 br4[2], bi4[2], sp4[2];
    for (int i = 0;; ++i) {
        const int idx = i * F.G + F.bid; if (idx >= 4096) break;
        const int blk = idx & 7, j = idx >> 3, b = j >> 6, seg = j & 63, t0 = seg * 64;
        const size_t mrow0 = (size_t)b * SEQ + t0;
        if (blk != cur_blk) {
            cur_blk = blk;
#pragma unroll
            for (int d = 0; d < 2; ++d) {
#pragma unroll
                for (int g = 0; g < 2; ++g)
#pragma unroll
                    for (int ks = 0; ks < 4; ++ks)
                        wf[d][g][ks] = *(const bf16x8*)(WL + ((size_t)((d * 8 + blk) * 2 + g) * 128 + 16 * w + fr) * 128 + 32 * ks + 8 * fq);
                const int ch = blk * 128 + 16 * w + 4 * fq;
                br4[d] = *(const f32x4*)(F.in[13] + d * DM + ch); bi4[d] = *(const f32x4*)(F.in[15] + d * DM + ch);
                const f32x4 lm = *(const f32x4*)(F.in[16] + d * DM + ch);
#pragma unroll
                for (int e = 0; e < 4; ++e) sp4[d][e] = softplusf_(-lm[e]);
            }
        }
        for (int e = tid; e < 68 * 16; e += NTHR) { const int row = e >> 4, c16 = e & 15, t = t0 - 2 + row;
            v4u v = {0u, 0u, 0u, 0u};
            if (t >= 0 && t < SEQ) v = *(const v4u*)(XL + ((size_t)b * SEQ + t) * DM + blk * 128 + c16 * 8);
            *(LAS v4u*)(L + O_A + row * 256 + c16 * 16) = v; }
        __syncthreads();
        for (int e = tid; e < 64 * 16; e += NTHR) { const int tl = e >> 4, c16 = e & 15, c0 = blk * 128 + c16 * 8;
            float y[8];
            { const f32x4 a = *(const f32x4*)(cb + c0), bq = *(const f32x4*)(cb + c0 + 4); y[0] = a[0]; y[1] = a[1]; y[2] = a[2]; y[3] = a[3]; y[4] = bq[0]; y[5] = bq[1]; y[6] = bq[2]; y[7] = bq[3]; }
#pragma unroll
            for (int jt = 0; jt < 4; ++jt) { const v4u r = *(const LAS v4u*)(L + O_A + (tl + jt) * 256 + c16 * 16);
                const f32x4 wa = *(const f32x4*)(cw + jt * DM + c0), wb = *(const f32x4*)(cw + jt * DM + c0 + 4);
                y[0] += wa[0] * bflo(r.x); y[1] += wa[1] * bfhi(r.x); y[2] += wa[2] * bflo(r.y); y[3] += wa[3] * bfhi(r.y);
                y[4] += wb[0] * bflo(r.z); y[5] += wb[1] * bfhi(r.z); y[6] += wb[2] * bflo(r.w); y[7] += wb[3] * bfhi(r.w); }
            *(LAS f32x4*)(L + O_XCF + tl * 512 + c16 * 32) = (f32x4){y[0], y[1], y[2], y[3]};
            *(LAS f32x4*)(L + O_XCF + tl * 512 + c16 * 32 + 16) = (f32x4){y[4], y[5], y[6], y[7]};
            v4u o; o.x = pk2(y[0], y[1]); o.y = pk2(y[2], y[3]); o.z = pk2(y[4], y[5]); o.w = pk2(y[6], y[7]);
            *(LAS v4u*)(L + O_XCB + tl * 272 + c16 * 16) = o; }
        __syncthreads();
        float carry0 = 0.f, carry1 = 0.f;
        if (PB && tid < 128) {
            const int ch = blk * 128 + tid;
            float h = 0.f;
            for (int js = 0; js < seg; ++js) { const f32x2 ah = AGG[((size_t)(b * 64 + js) * 2 + 0) * DM + ch]; h = ah[0] * h + ah[1]; }
            carry0 = h; h = 0.f;
            for (int js = 63; js > seg; --js) { const f32x2 ah = AGG[((size_t)(b * 64 + js) * 2 + 1) * DM + ch]; h = ah[0] * h + ah[1]; }
            carry1 = h;
        }
#pragma unroll
        for (int d = 0; d < 2; ++d) {
            const int o_a = (d == 0) ? O_A : O_XCF;
            f32x4 aR[4], aI[4];
#pragma unroll
            for (int mt = 0; mt < 4; ++mt) { aR[mt] = (f32x4){0.f, 0.f, 0.f, 0.f}; aI[mt] = (f32x4){0.f, 0.f, 0.f, 0.f}; }
#pragma unroll
            for (int ks = 0; ks < 4; ++ks)
#pragma unroll
                for (int mt = 0; mt < 4; ++mt) { const bf16x8 xb = *(const LAS bf16x8*)(L + O_XCB + (16 * mt + fr) * 272 + (32 * ks + 8 * fq) * 2);
                    aR[mt] = __builtin_amdgcn_mfma_f32_16x16x32_bf16(wf[d][0][ks], xb, aR[mt], 0, 0, 0);
                    aI[mt] = __builtin_amdgcn_mfma_f32_16x16x32_bf16(wf[d][1][ks], xb, aI[mt], 0, 0, 0); }
#pragma unroll
            for (int mt = 0; mt < 4; ++mt) { const int tl = 16 * mt + fr, cl = 16 * w + 4 * fq;
                const f32x4 xc = *(const LAS f32x4*)(L + O_XCF + tl * 512 + cl * 4);
                f32x4 av, uv;
#pragma unroll
                for (int e = 0; e < 4; ++e) { const float r = sigmoidf_(aR[mt][e] + br4[d][e]), ig = sigmoidf_(aI[mt][e] + bi4[d][e]);
                    const float la = -8.f * r * sp4[d][e]; av[e] = __expf(la); uv[e] = sqrtf(-expm1f(2.f * la)) * (ig * xc[e]); }
                *(LAS f32x4*)(L + o_a + tl * 512 + cl * 4) = av; *(LAS f32x4*)(L + O_U + tl * 512 + cl * 4) = uv; }
            __syncthreads();
            if (tid < 128) {
                LAS float* pa = (LAS float*)(L + o_a) + tid; const LAS float* pu = (const LAS float*)(L + O_U) + tid;
                if (!PB) {
                    float h = 0.f, A = 1.f;
#pragma unroll 8
                    for (int s2 = 0; s2 < 64; ++s2) { const int tl = d ? 63 - s2 : s2; const float a = pa[tl * 128], u = pu[tl * 128]; h = a * h + u; A *= a; }
                    AGG[((size_t)(b * 64 + seg) * 2 + d) * DM + blk * 128 + tid] = (f32x2){A, h};
                } else if (d == 0) {
                    float h = carry0;
#pragma unroll 8
                    for (int tl = 0; tl < 64; ++tl) { h = pa[tl * 128] * h + pu[tl * 128]; pa[tl * 128] = h; }
                } else {
                    float h = carry1;
                    LAS float* ph = (LAS float*)(L + O_A) + tid;
#pragma unroll 8
                    for (int s2 = 0; s2 < 64; ++s2) { const int tl = 63 - s2; h = pa[tl * 128] * h + pu[tl * 128]; ph[tl * 128] += h; }
                }
            }
            __syncthreads();
        }
        if (PB) {
            for (int e = tid; e < 64 * 16; e += NTHR) { const int row = e >> 4, c16 = e & 15;
                const v4u g = *(const v4u*)(LG + (mrow0 + row) * DM + blk * 128 + c16 * 8);
                const f32x4 h0 = *(const LAS f32x4*)(L + O_A + row * 512 + c16 * 32), h1 = *(const LAS f32x4*)(L + O_A + row * 512 + c16 * 32 + 16);
                v4u o;
                o.x = pk2(h0[0] * gelu_fast(bflo(g.x)), h0[1] * gelu_fast(bfhi(g.x))); o.y = pk2(h0[2] * gelu_fast(bflo(g.y)), h0[3] * gelu_fast(bfhi(g.y)));
                o.z = pk2(h1[0] * gelu_fast(bflo(g.z)), h1[1] * gelu_fast(bfhi(g.z))); o.w = pk2(h1[2] * gelu_fast(bflo(g.w)), h1[3] * gelu_fast(bfhi(g.w)));
                *(v4u*)(YL + (mrow0 + row) * DM + blk * 128 + c16 * 8) = o; }
            __syncthreads();
        }
    }
}

__device__ __forceinline__ void mconv_phase(Frame& F) {
    const bf16* XM = (const bf16*)(F.ws + WS_XM); bf16* XC = (bf16*)(F.ws + WS_XL);
    const float* cw = F.in[4]; const float* cb = F.in[5];
    const int NT = MTOK / 32 * 128;
    for (int g = F.bid * NTHR + F.tid; g < NT; g += F.G * NTHR) {
        const int chunk = g & 127, run = g >> 7, c0 = chunk * 8, m0 = run * 32, t0 = m0 & (SEQ - 1);
        float w[4][8], bias[8];
#pragma unroll
        for (int j = 0; j < 4; ++j) { const f32x4 a = *(const f32x4*)(cw + j * DM + c0), b = *(const f32x4*)(cw + j * DM + c0 + 4);
            w[j][0] = a[0]; w[j][1] = a[1]; w[j][2] = a[2]; w[j][3] = a[3]; w[j][4] = b[0]; w[j][5] = b[1]; w[j][6] = b[2]; w[j][7] = b[3]; }
        { const f32x4 a = *(const f32x4*)(cb + c0), b = *(const f32x4*)(cb + c0 + 4);
            bias[0] = a[0]; bias[1] = a[1]; bias[2] = a[2]; bias[3] = a[3]; bias[4] = b[0]; bias[5] = b[1]; bias[6] = b[2]; bias[7] = b[3]; }
        v4u win[4];
        const v4u zero = {0u, 0u, 0u, 0u};
        win[0] = zero;
        win[1] = (t0 >= 2) ? *(const v4u*)(XM + (size_t)(m0 - 2) * DM + c0) : zero;
        win[2] = (t0 >= 1) ? *(const v4u*)(XM + (size_t)(m0 - 1) * DM + c0) : zero;
        win[3] = *(const v4u*)(XM + (size_t)m0 * DM + c0);
#pragma unroll 4
        for (int i = 0; i < 32; ++i) {
            win[0] = win[1]; win[1] = win[2]; win[2] = win[3];
            win[3] = (t0 + i + 1 < SEQ) ? *(const v4u*)(XM + (size_t)(m0 + i + 1) * DM + c0) : zero;
            float y[8];
#pragma unroll
            for (int e = 0; e < 8; ++e) y[e] = bias[e];
#pragma unroll
            for (int j = 0; j < 4; ++j) {
                const unsigned p0 = win[j].x, p1 = win[j].y, p2 = win[j].z, p3 = win[j].w;
                y[0] += w[j][0] * bflo(p0); y[1] += w[j][1] * bfhi(p0); y[2] += w[j][2] * bflo(p1); y[3] += w[j][3] * bfhi(p1);
                y[4] += w[j][4] * bflo(p2); y[5] += w[j][5] * bfhi(p2); y[6] += w[j][6] * bflo(p3); y[7] += w[j][7] * bfhi(p3);
            }
#pragma unroll
            for (int e = 0; e < 8; ++e) y[e] = y[e] * sigmoidf_(y[e]);
            v4u o; o.x = pk2(y[0], y[1]); o.y = pk2(y[2], y[3]); o.z = pk2(y[4], y[5]); o.w = pk2(y[6], y[7]);
            *(v4u*)(XC + (size_t)(m0 + i) * DM + c0) = o;
        }
    }
}

__device__ __forceinline__ void mscan_ref(Frame& F) {
    const bf16* Q = (const bf16*)(F.ws + WS_LG); const bf16* K = (const bf16*)(F.ws + WS_K); const bf16* V = (const bf16*)F.out + (size_t)MTOK * DM;
    const float* GT = (const float*)(F.ws + WS_GATE);
    LAS float* sq = (LAS float*)F.lds; LAS float* sk = sq + 256; LAS float* sv = sk + 256; LAS float* spart = sv + 32; LAS float* sdw = spart + 256;
    const int e = F.tid & 31, dg = F.tid >> 5;
    for (int item = F.bid; item < 512; item += F.G) {
        const int es = item & 7, dir = (item >> 3) & 1, h = (item >> 4) & 3, b = item >> 6;
        bf16* H = (bf16*)(F.ws + (dir ? WS_XL : WS_XM));
        float C[16];
#pragma unroll
        for (int j = 0; j < 16; ++j) C[j] = 0.f;
        float nreg = 0.f, mst = 0.f;
        for (int step = 0; step < SEQ; ++step) {
            const int t = dir ? (SEQ - 1 - step) : step;
            const size_t m = (size_t)b * SEQ + t, ro = m * DM + h * 256;
            if (F.tid < 256) { sq[F.tid] = bf2f(Q[ro + F.tid]); sk[F.tid] = bf2f(K[ro + F.tid]); }
            if (F.tid < 32) sv[F.tid] = bf2f(V[ro + es * 32 + F.tid]);
            const float ip = GT[m * 16 + (dir * 2 + 0) * 4 + h], fp = GT[m * 16 + (dir * 2 + 1) * 4 + h];
            const float logf = -softplusf_(-fp);
            const float mn = fmaxf(logf + mst, ip);
            const float fd = __expf(logf + mst - mn), iw = __expf(ip - mn);
            mst = mn;
            __syncthreads();
            const float ve = sv[e] * iw;
            float part = 0.f;
#pragma unroll
            for (int j = 0; j < 16; ++j) { const int d = dg * 16 + j; C[j] = fd * C[j] + sk[d] * ve; part += sq[d] * C[j]; }
            part += __shfl_xor(part, 32);
            if (F.lane < 32) spart[F.wave * 32 + e] = part;
            if (F.tid < 256) { nreg = fd * nreg + iw * sk[F.tid]; const float ds = wave_sum(nreg * sq[F.tid]); if (F.lane == 0) sdw[F.wave] = ds; }
            __syncthreads();
            if (F.tid < 32) {
                float num = 0.f;
#pragma unroll
                for (int w = 0; w < 8; ++w) num += spart[w * 32 + F.tid];
                const float den = sdw[0] + sdw[1] + sdw[2] + sdw[3];
                H[ro + es * 32 + F.tid] = (bf16)f2bf(num / fmaxf(fabsf(den), __expf(-mn)));
            }
        }
        __syncthreads();
    }
}


typedef short s16x4 __attribute__((ext_vector_type(4)));
__device__ __forceinline__ bf16x8 tr_read_pair(unsigned a0, unsigned a1) {
    s16x4 r0, r1;
    asm volatile("ds_read_b64_tr_b16 %0, %2\n\tds_read_b64_tr_b16 %1, %3\n\ts_waitcnt lgkmcnt(0)" : "=&v"(r0), "=&v"(r1) : "v"(a0), "v"(a1) : "memory");
    return __builtin_shufflevector(r0, r1, 0, 1, 2, 3, 4, 5, 6, 7);
}
__device__ __forceinline__ float wave_incl_sum(float x, int lane) {
#pragma unroll
    for (int o = 1; o < 64; o <<= 1) { const float t = __shfl_up(x, o); if (lane >= o) x += t; }
    return x;
}
__device__ __forceinline__ float wave_incl_max(float x, int lane) {
#pragma unroll
    for (int o = 1; o < 64; o <<= 1) { const float t = __shfl_up(x, o); if (lane >= o) x = fmaxf(x, t); }
    return x;
}
__device__ __forceinline__ void mscan_phase(Frame& F) {
    const bf16* Q = (const bf16*)(F.ws + WS_LG); const bf16* K = (const bf16*)(F.ws + WS_K); const bf16* V = (const bf16*)F.out + (size_t)MTOK * DM;
    const float* GT = (const float*)(F.ws + WS_GATE);
    constexpr int KS = 0, CTI = 33792, VT = 67584, VWT = 86016, PB = 104448, TAB = 113664, NT = 116736, NPART = 117760, DENT = 119808;
    constexpr int KST = 528, VST = 144, TABSZ = 1536;
    LAS unsigned char* L = F.lds;
    const int tid = F.tid, lane = F.lane, w = F.wave, fr = lane & 15, fq = lane >> 4, pt = w & 3, wg = w >> 2;
    for (int item = F.bid; item < 256; item += F.G) {
        const int es = item & 3, dir = (item >> 2) & 1, h = (item >> 3) & 3, b = item >> 5;
        bf16* H = (bf16*)(F.ws + (dir ? WS_XL : WS_XM));
        const size_t rowbase = (size_t)b * SEQ;
#define TOF(c, p) (dir ? (SEQ - 1 - 64 * (c) - (p)) : (64 * (c) + (p)))
        for (int e = tid; e < (33792 + 1024) / 4; e += NTHR) { if (e < 33792 / 4) ((LAS unsigned*)(L + CTI))[e] = 0u; else ((LAS unsigned*)(L + NT))[e - 33792 / 4] = 0u; }
        float m_run = 0.f;
        float gi_n = 0.f, gf_n = 0.f;
        if (w == 0) { const size_t m = rowbase + TOF(0, lane); gi_n = GT[m * 16 + dir * 8 + h]; gf_n = GT[m * 16 + dir * 8 + 4 + h]; }
#define G1_TABLES(setp) do { \
            const float logf_ = -softplusf_(-gf_n); const float b_ = wave_incl_sum(logf_, lane); const float a_ = gi_n - b_; \
            const float M_ = fmaxf(m_run, wave_incl_max(a_, lane)); const float Mend_ = __shfl(M_, 63), g_ = __shfl(b_, 63); \
            LAS float* T_ = (LAS float*)(setp); T_[lane] = a_; T_[64 + lane] = M_; T_[128 + lane] = expf(m_run - M_); T_[192 + lane] = expf(-(b_ + M_)); T_[256 + lane] = expf(a_ - Mend_); \
            if (lane == 0) { T_[320] = expf(m_run - Mend_); T_[321] = g_ + Mend_; } \
            m_run = g_ + Mend_; } while (0)
        if (w == 0) G1_TABLES(L + TAB);
        __syncthreads();
        bf16x8 qf[8];
        v4u kreg[4]; v4u vreg;
#define LOAD_KV(c) do { _Pragma("unroll") for (int r_ = 0; r_ < 4; ++r_) { const int i_ = tid + NTHR * r_, s_ = i_ >> 5, c16_ = i_ & 31; \
                kreg[r_] = *(const v4u*)(K + (rowbase + TOF(c, s_)) * DM + h * 256 + c16_ * 8); } \
            { const int s_ = tid >> 3, e8_ = tid & 7; vreg = *(const v4u*)(V + (rowbase + TOF(c, s_)) * DM + h * 256 + es * 64 + e8_ * 8); } } while (0)
#define STORE_KV(setidx) do { _Pragma("unroll") for (int r_ = 0; r_ < 4; ++r_) { const int i_ = tid + NTHR * r_, s_ = i_ >> 5, c16_ = i_ & 31; \
                *(LAS v4u*)(L + KS + s_ * KST + c16_ * 16) = kreg[r_]; } \
            { const int s_ = tid >> 3, e8_ = tid & 7; const float ws_ = ((const LAS float*)(L + TAB + (setidx) * TABSZ))[256 + s_]; \
              LAS bf16* vt_ = (LAS bf16*)(L + VT + (setidx) * 9216); LAS bf16* vw_ = (LAS bf16*)(L + VWT + (setidx) * 9216); \
              const unsigned wv_[4] = {vreg.x, vreg.y, vreg.z, vreg.w}; \
              _Pragma("unroll") for (int j_ = 0; j_ < 4; ++j_) { const float lo_ = bflo(wv_[j_]), hi_ = bfhi(wv_[j_]); const int e_ = e8_ * 8 + 2 * j_; \
                vt_[e_ * 72 + s_] = (bf16)(wv_[j_] & 0xffffu); vt_[(e_ + 1) * 72 + s_] = (bf16)(wv_[j_] >> 16); \
                vw_[e_ * 72 + s_] = (bf16)f2bf(lo_ * ws_); vw_[(e_ + 1) * 72 + s_] = (bf16)f2bf(hi_ * ws_); } } } while (0)
#define LOAD_Q(c) do { const size_t m_ = rowbase + TOF(c, 16 * pt + fr); _Pragma("unroll") for (int ks_ = 0; ks_ < 8; ++ks_) \
                qf[ks_] = *(const bf16x8*)(Q + m_ * DM + h * 256 + 32 * ks_ + 8 * fq); } while (0)
        LOAD_KV(0); LOAD_Q(0);
        STORE_KV(0);
        f32x4 Cacc[8];
#pragma unroll
        for (int i = 0; i < 8; ++i) Cacc[i] = (f32x4){0.f, 0.f, 0.f, 0.f};
        __syncthreads();
        for (int c = 0; c < 64; ++c) {
            const int cur = c & 1, nxt = cur ^ 1;
            const bool has_next = (c + 1 < 64);
            const LAS float* T = (const LAS float*)(L + TAB + cur * TABSZ);
            if (has_next) { LOAD_KV(c + 1); if (w == 0) { const size_t m = rowbase + TOF(c + 1, lane); gi_n = GT[m * 16 + dir * 8 + h]; gf_n = GT[m * 16 + dir * 8 + 4 + h]; } }
            const int p = 16 * pt + fr;
            const float Mp = T[64 + p], wi_p = T[128 + p];
            float cs = 0.f;
#pragma unroll
            for (int i = 0; i < 2; ++i) { const int st = 2 * wg + i;
                v2u pw = {0u, 0u};
                if (st <= pt) {
                    f32x4 sa = (f32x4){0.f, 0.f, 0.f, 0.f};
#pragma unroll
                    for (int ks = 0; ks < 8; ++ks) { const bf16x8 kf = *(const LAS bf16x8*)(L + KS + (16 * st + fr) * KST + (32 * ks + 8 * fq) * 2);
                        sa = __builtin_amdgcn_mfma_f32_16x16x32_bf16(kf, qf[ks], sa, 0, 0, 0); }
                    const f32x4 a4 = *(const LAS f32x4*)(T + 16 * st + 4 * fq);
                    float pv[4];
#pragma unroll
                    for (int r = 0; r < 4; ++r) { const int s_ = 16 * st + 4 * fq + r; const float wgt = (s_ <= p) ? __expf(a4[r] - Mp) : 0.f; pv[r] = sa[r] * wgt; cs += pv[r]; }
                    pw.x = pk2(pv[0], pv[1]); pw.y = pk2(pv[2], pv[3]);
                }
                *(LAS v2u*)(L + PB + p * VST + (16 * st + 4 * fq) * 2) = pw; }
            f32x4 O[2];
#pragma unroll
            for (int i = 0; i < 2; ++i) { const int et = 2 * wg + i; O[i] = (f32x4){0.f, 0.f, 0.f, 0.f};
#pragma unroll
                for (int ks = 0; ks < 8; ++ks) { const bf16x8 cf = *(const LAS bf16x8*)(L + CTI + (16 * et + fr) * KST + (32 * ks + 8 * fq) * 2);
                    O[i] = __builtin_amdgcn_mfma_f32_16x16x32_bf16(cf, qf[ks], O[i], 0, 0, 0); } }
            float di = 0.f;
#pragma unroll
            for (int k2 = 0; k2 < 4; ++k2) { const int ks = 4 * wg + k2;
                const f32x4 n0 = *(const LAS f32x4*)(L + NT + (32 * ks + 8 * fq) * 4), n1 = *(const LAS f32x4*)(L + NT + (32 * ks + 8 * fq) * 4 + 16);
                const v4u qw = __builtin_bit_cast(v4u, qf[ks]);
                di += bflo(qw.x) * n0[0] + bfhi(qw.x) * n0[1] + bflo(qw.y) * n0[2] + bfhi(qw.y) * n0[3] + bflo(qw.z) * n1[0] + bfhi(qw.z) * n1[1] + bflo(qw.w) * n1[2] + bfhi(qw.w) * n1[3]; }
            di += __shfl_xor(di, 16); di += __shfl_xor(di, 32);
            cs += __shfl_xor(cs, 16); cs += __shfl_xor(cs, 32);
            if (fq == 0) ((LAS float*)(L + DENT))[wg * 64 + p] = wi_p * di + cs;
            if (has_next) LOAD_Q(c + 1);
            if (has_next && w == 0) G1_TABLES(L + TAB + nxt * TABSZ);
            __syncthreads();
#pragma unroll
            for (int i = 0; i < 2; ++i) { const int et = 2 * wg + i; O[i] = O[i] * wi_p;
#pragma unroll
                for (int ks = 0; ks < 2; ++ks) { const bf16x8 vf = *(const LAS bf16x8*)(L + VT + cur * 9216 + (16 * et + fr) * VST + (32 * ks + 8 * fq) * 2);
                    const bf16x8 pf = *(const LAS bf16x8*)(L + PB + p * VST + (32 * ks + 8 * fq) * 2);
                    O[i] = __builtin_amdgcn_mfma_f32_16x16x32_bf16(vf, pf, O[i], 0, 0, 0); } }
            { const float den = ((const LAS float*)(L + DENT))[p] + ((const LAS float*)(L + DENT))[64 + p];
              const float inv = 1.f / fmaxf(fabsf(den), T[192 + p]);
              const size_t m = rowbase + TOF(c, p);
#pragma unroll
              for (int i = 0; i < 2; ++i) { const int et = 2 * wg + i; v2u o; o.x = pk2(O[i][0] * inv, O[i][1] * inv); o.y = pk2(O[i][2] * inv, O[i][3] * inv);
                  *(v2u*)(H + m * DM + h * 256 + es * 64 + 16 * et + 4 * fq) = o; } }
            { const float decay = T[320];
              const bf16x8 vw0 = *(const LAS bf16x8*)(L + VWT + cur * 9216 + (16 * pt + fr) * VST + (8 * fq) * 2);
              const bf16x8 vw1 = *(const LAS bf16x8*)(L + VWT + cur * 9216 + (16 * pt + fr) * VST + (32 + 8 * fq) * 2);
              const int l16 = lane & 15, q4 = l16 >> 2, p4 = l16 & 3;
              const unsigned kb = (unsigned)(uintptr_t)(L + KS) + (unsigned)((8 * fq + q4) * KST + 4 * p4 * 2);
#pragma unroll
              for (int dtl = 0; dtl < 8; ++dtl) { const int dt = 8 * wg + dtl; const unsigned a0 = kb + dt * 32;
                  const bf16x8 k0 = tr_read_pair(a0, a0 + 4 * KST), k1 = tr_read_pair(a0 + 32 * KST, a0 + 36 * KST);
                  Cacc[dtl] = Cacc[dtl] * decay;
                  Cacc[dtl] = __builtin_amdgcn_mfma_f32_16x16x32_bf16(k0, vw0, Cacc[dtl], 0, 0, 0);
                  Cacc[dtl] = __builtin_amdgcn_mfma_f32_16x16x32_bf16(k1, vw1, Cacc[dtl], 0, 0, 0); } }
            { const int d = tid & 255, hf2 = tid >> 8; float np = 0.f;
#pragma unroll 8
              for (int s2 = 0; s2 < 32; ++s2) { const int s_ = hf2 * 32 + s2; np += T[256 + s_] * bf2f(*(const LAS bf16*)(L + KS + s_ * KST + d * 2)); }
              ((LAS float*)(L + NPART))[hf2 * 256 + d] = np; }
            __syncthreads();
            { const float decay = T[320];
#pragma unroll
              for (int dtl = 0; dtl < 8; ++dtl) { const int dt = 8 * wg + dtl; v2u o; o.x = pk2(Cacc[dtl][0], Cacc[dtl][1]); o.y = pk2(Cacc[dtl][2], Cacc[dtl][3]);
                  *(LAS v2u*)(L + CTI + (16 * pt + fr) * KST + (16 * dt + 4 * fq) * 2) = o; }
              if (tid < 256) { LAS float* nt = (LAS float*)(L + NT); const LAS float* np = (const LAS float*)(L + NPART); nt[tid] = decay * nt[tid] + np[tid] + np[256 + tid]; } }
            if (has_next) STORE_KV(nxt);
            __syncthreads();
        }
#undef TOF
#undef G1_TABLES
#undef LOAD_KV
#undef STORE_KV
#undef LOAD_Q
    }
}

__device__ __forceinline__ void ym_phase(Frame& F) {
    const bf16* HF = (const bf16*)(F.ws + WS_XM); const bf16* HB = (const bf16*)(F.ws + WS_XL); bf16* OP = (bf16*)(F.ws + WS_OP);
    const float* ng = F.in[9];
    const int gw = F.bid * NWAVES + F.wave, NGW = F.G * NWAVES;
    for (int m = gw; m < MTOK; m += NGW) {
#pragma unroll
        for (int hd = 0; hd < 4; ++hd) {
            const size_t o = (size_t)m * DM + hd * 256 + F.lane * 4;
            const v2u a = *(const v2u*)(HF + o), b = *(const v2u*)(HB + o), op = *(const v2u*)(OP + o);
            const float v0 = bflo(a.x) + bflo(b.x), v1 = bfhi(a.x) + bfhi(b.x), v2 = bflo(a.y) + bflo(b.y), v3 = bfhi(a.y) + bfhi(b.y);
            const float r = rsqrtf(wave_sum((v0 * v0 + v1 * v1) + (v2 * v2 + v3 * v3)) * (1.f / 256.f) + EPS);
            const f32x4 g = *(const f32x4*)(ng + hd * 256 + F.lane * 4);
            v2u w; w.x = pk2(sigmoidf_(bflo(op.x)) * v0 * r * g[0], sigmoidf_(bfhi(op.x)) * v1 * r * g[1]);
            w.y = pk2(sigmoidf_(bflo(op.y)) * v2 * r * g[2], sigmoidf_(bfhi(op.y)) * v3 * r * g[3]);
            *(v2u*)(OP + o) = w;
        }
    }
    const int gt = F.bid * NTHR + F.tid, NGT = F.G * NTHR;
    const f32x4* us = (const f32x4*)F.in[23]; const f32x4* vs = (const f32x4*)F.in[24];
    v2u* ud = (v2u*)(F.ws + WS_LG); v2u* vd = (v2u*)(F.ws + WS_LG + 32 * MiB);
    for (int i = gt; i < NEXP * DM / 4; i += NGT) {
        const f32x4 a = us[i], b = vs[i];
        v2u o; o.x = pk2(a[0], a[1]); o.y = pk2(a[2], a[3]); ud[i] = o;
        v2u p; p.x = pk2(b[0], b[1]); p.y = pk2(b[2], b[3]); vd[i] = p;
    }
}

__device__ __forceinline__ void select_ref(Frame& F) {
    const bf16* PQ = (const bf16*)(F.ws + WS_MG); const bf16* KEYS = (const bf16*)(F.ws + WS_KEYS);
    int* IDX = (int*)(F.ws + WS_K); float* GW = (float*)(F.ws + WS_K + 16 * MiB);
    LAS float* base = (LAS float*)(F.lds + F.wave * 2048);
    LAS float* sq = base;
    LAS float* sl = base + 256;
    LAS int* il = (LAS int*)(base + 288);
    LAS float* sbest = base + 320;
    LAS int* spos = (LAS int*)(base + 336);
    const int lane = F.lane;
    const int gw = F.bid * NWAVES + F.wave, NGW = F.G * NWAVES;
    for (int it = gw; it < MTOK * 8; it += NGW) {
        const int t = it >> 3, h = it & 7;
        { const v2u q4 = *(const v2u*)(PQ + (size_t)t * 2048 + h * 256 + lane * 4);
          sq[lane * 4 + 0] = bflo(q4.x); sq[lane * 4 + 1] = bfhi(q4.x); sq[lane * 4 + 2] = bflo(q4.y); sq[lane * 4 + 3] = bfhi(q4.y); }
        LDS_WAIT();
        for (int p = 0; p < 2; ++p) {
            float v0 = 0.f, v1 = 0.f;
            const v4u* k0 = (const v4u*)(KEYS + ((size_t)(h * 2 + p) * 128 + lane) * 128);
            const v4u* k1 = k0 + 64 * 16;
#pragma unroll 4
            for (int c8 = 0; c8 < 16; ++c8) {
                const v4u a = k0[c8], b = k1[c8];
                const f32x4 q0 = *(const LAS f32x4*)(sq + p * 128 + c8 * 8), q1 = *(const LAS f32x4*)(sq + p * 128 + c8 * 8 + 4);
                v0 += q0[0] * bflo(a.x) + q0[1] * bfhi(a.x) + q0[2] * bflo(a.y) + q0[3] * bfhi(a.y) + q1[0] * bflo(a.z) + q1[1] * bfhi(a.z) + q1[2] * bflo(a.w) + q1[3] * bfhi(a.w);
                v1 += q0[0] * bflo(b.x) + q0[1] * bfhi(b.x) + q0[2] * bflo(b.y) + q0[3] * bfhi(b.y) + q1[0] * bflo(b.z) + q1[1] * bfhi(b.z) + q1[2] * bflo(b.w) + q1[3] * bfhi(b.w);
            }
            for (int k = 0; k < 16; ++k) {
                float bv; int bi;
                if (v0 >= v1) { bv = v0; bi = lane; } else { bv = v1; bi = lane + 64; }
#pragma unroll
                for (int off = 32; off >= 1; off >>= 1) {
                    const float ov = __shfl_xor(bv, off); const int oi = __shfl_xor(bi, off);
                    if (ov > bv || (ov == bv && oi < bi)) { bv = ov; bi = oi; }
                }
                if (lane == 0) { sl[p * 16 + k] = bv; il[p * 16 + k] = bi; }
                if (bi == lane) v0 = -INFINITY;
                if (bi == lane + 64) v1 = -INFINITY;
            }
        }
        LDS_WAIT();
        float cv[4];
#pragma unroll
        for (int r = 0; r < 4; ++r) { const int pos = lane + 64 * r; cv[r] = sl[pos >> 4] + sl[16 + (pos & 15)]; }
        for (int k = 0; k < 16; ++k) {
            float bv = cv[0]; int bi = lane;
#pragma unroll
            for (int r = 1; r < 4; ++r) if (cv[r] > bv) { bv = cv[r]; bi = lane + 64 * r; }
#pragma unroll
            for (int off = 32; off >= 1; off >>= 1) {
                const float ov = __shfl_xor(bv, off); const int oi = __shfl_xor(bi, off);
                if (ov > bv || (ov == bv && oi < bi)) { bv = ov; bi = oi; }
            }
            if (lane == 0) { sbest[k] = bv; spos[k] = bi; }
#pragma unroll
            for (int r = 0; r < 4; ++r) if (bi == lane + 64 * r) cv[r] = -INFINITY;
        }
        LDS_WAIT();
        if (lane < 16) {
            const float mx = sbest[0];
            float sum = 0.f;
            for (int k = 0; k < 16; ++k) sum += __expf(sbest[k] - mx);
            const int pos = spos[lane];
            IDX[(size_t)t * 128 + h * 16 + lane] = il[pos >> 4] * 128 + il[16 + (pos & 15)];
            GW[(size_t)t * 128 + h * 16 + lane] = __expf(sbest[lane] - mx) / sum;
        }
        LDS_WAIT();
    }
}

typedef __bf16 bf2_t __attribute__((ext_vector_type(2)));
__device__ __forceinline__ float dot2bf(unsigned a, unsigned b, float c) { return __builtin_amdgcn_fdot2_f32_bf16(__builtin_bit_cast(bf2_t, a), __builtin_bit_cast(bf2_t, b), c, false); }
__device__ __forceinline__ void apply_phase(Frame& F) {
    const bf16* UT = (const bf16*)(F.ws + WS_LG); const bf16* VT = (const bf16*)(F.ws + WS_LG + 32 * MiB);
    const int* IDX = (const int*)(F.ws + WS_K); const float* GW = (const float*)(F.ws + WS_K + 16 * MiB);
    const float* g2 = F.in[20]; const float* gf = F.in[25];
    float* X1 = F.out;
    const int lane = F.lane;
    const int gw = F.bid * NWAVES + F.wave, NGW = F.G * NWAVES;
    const bool b5 = (lane & 32) != 0, b4 = (lane & 16) != 0, b3 = (lane & 8) != 0;
    const int eid = ((lane >> 5) & 1) * 4 + ((lane >> 4) & 1) * 2 + ((lane >> 3) & 1);
    for (int m = gw; m < MTOK; m += NGW) {
        float xr[16]; float s = 0.f;
#pragma unroll
        for (int q = 0; q < 4; ++q) { const int c = (q >> 1) * 512 + lane * 8 + (q & 1) * 4; const f32x4 a = *(const f32x4*)(X1 + (size_t)m * DM + c);
#pragma unroll
            for (int e = 0; e < 4; ++e) { xr[q * 4 + e] = a[e]; s += a[e] * a[e]; } }
        const float r2 = rsqrtf(wave_sum(s) * (1.f / DM) + EPS);
        unsigned hp[8];
#pragma unroll
        for (int q = 0; q < 4; ++q) { const int c = (q >> 1) * 512 + lane * 8 + (q & 1) * 4; const f32x4 g = *(const f32x4*)(g2 + c);
            hp[q * 2] = pk2(xr[q * 4] * r2 * g[0], xr[q * 4 + 1] * r2 * g[1]); hp[q * 2 + 1] = pk2(xr[q * 4 + 2] * r2 * g[2], xr[q * 4 + 3] * r2 * g[3]); }
        const int i0 = IDX[(size_t)m * 128 + lane], i1 = IDX[(size_t)m * 128 + 64 + lane];
        const float gw0 = GW[(size_t)m * 128 + lane], gw1 = GW[(size_t)m * 128 + 64 + lane];
        float acc[16];
#pragma unroll
        for (int i = 0; i < 16; ++i) acc[i] = 0.f;
#pragma unroll 1
        for (int bt = 0; bt < 16; ++bt) {
            const int k0 = bt * 8;
            const int isel = (k0 < 64) ? i0 : i1;
            v4u ua[8], ub[8], va[8], vb[8];
            int idx[8];
#pragma unroll
            for (int e = 0; e < 8; ++e) idx[e] = __builtin_amdgcn_readlane(isel, (k0 + e) & 63);
#pragma unroll
            for (int e = 0; e < 8; ++e) { const bf16* ur = UT + (size_t)idx[e] * DM + lane * 8; ua[e] = *(const v4u*)ur; ub[e] = *(const v4u*)(ur + 512); }
#pragma unroll
            for (int e = 0; e < 8; ++e) { const bf16* vr = VT + (size_t)idx[e] * DM + lane * 8; va[e] = *(const v4u*)vr; vb[e] = *(const v4u*)(vr + 512); }
            float x[8];
#pragma unroll
            for (int e = 0; e < 8; ++e) { float d = dot2bf(ua[e].x, hp[0], 0.f); d = dot2bf(ua[e].y, hp[1], d); d = dot2bf(ua[e].z, hp[2], d); d = dot2bf(ua[e].w, hp[3], d);
                d = dot2bf(ub[e].x, hp[4], d); d = dot2bf(ub[e].y, hp[5], d); d = dot2bf(ub[e].z, hp[6], d); d = dot2bf(ub[e].w, hp[7], d); x[e] = d; }
            float y[4], z[2], t;
#pragma unroll
            for (int j = 0; j < 4; ++j) { const float keep = b5 ? x[4 + j] : x[j], send = b5 ? x[j] : x[4 + j]; y[j] = keep + __shfl_xor(send, 32); }
#pragma unroll
            for (int j = 0; j < 2; ++j) { const float keep = b4 ? y[2 + j] : y[j], send = b4 ? y[j] : y[2 + j]; z[j] = keep + __shfl_xor(send, 16); }
            { const float keep = b3 ? z[1] : z[0], send = b3 ? z[0] : z[1]; t = keep + __shfl_xor(send, 8); }
            t += __shfl_xor(t, 4); t += __shfl_xor(t, 2); t += __shfl_xor(t, 1);
            const float gk = __shfl((k0 < 64) ? gw0 : gw1, (k0 + eid) & 63);
            const float wl = gk * gelu_fast(t);
            float wv[8];
#pragma unroll
            for (int e = 0; e < 8; ++e) wv[e] = __builtin_bit_cast(float, __builtin_amdgcn_readlane(__builtin_bit_cast(int, wl), 32 * (e >> 2) + 16 * ((e >> 1) & 1) + 8 * (e & 1)));
#pragma unroll
            for (int e = 0; e < 8; e += 2) {
                const unsigned wp = pk2(wv[e], wv[e + 1]);
                const unsigned A[8] = {va[e].x, va[e].y, va[e].z, va[e].w, vb[e].x, vb[e].y, vb[e].z, vb[e].w};
                const unsigned B[8] = {va[e + 1].x, va[e + 1].y, va[e + 1].z, va[e + 1].w, vb[e + 1].x, vb[e + 1].y, vb[e + 1].z, vb[e + 1].w};
#pragma unroll
                for (int j = 0; j < 8; ++j) {
                    const unsigned lo = __builtin_amdgcn_perm(B[j], A[j], 0x05040100u);
                    const unsigned hi = __builtin_amdgcn_perm(B[j], A[j], 0x07060302u);
                    acc[2 * j] = dot2bf(lo, wp, acc[2 * j]); acc[2 * j + 1] = dot2bf(hi, wp, acc[2 * j + 1]);
                }
            }
        }
        float s2 = 0.f;
#pragma unroll
        for (int i = 0; i < 16; ++i) { acc[i] += xr[i]; s2 += acc[i] * acc[i]; }
        const float rf = rsqrtf(wave_sum(s2) * (1.f / DM) + EPS);
#pragma unroll
        for (int q = 0; q < 4; ++q) { const int c = (q >> 1) * 512 + lane * 8 + (q & 1) * 4; const f32x4 g = *(const f32x4*)(gf + c);
            f32x4 o;
#pragma unroll
            for (int e = 0; e < 4; ++e) o[e] = acc[q * 4 + e] * rf * g[e];
            *(f32x4*)(X1 + (size_t)m * DM + c) = o; }
    }
}

constexpr int N_PHASES = 13;
__global__ void __launch_bounds__(NTHR, 2) mega_fwd(Args args) {
    extern __shared__ __attribute__((aligned(16))) unsigned char lds[];
    Frame F;
    F.lds = (LAS unsigned char*)lds;
    F.tid = threadIdx.x; F.lane = F.tid & 63; F.wave = __builtin_amdgcn_readfirstlane(F.tid >> 6);
    F.G = gridDim.x; F.bid = blockIdx.x;
    F.in = args.in; F.out = args.out; F.ws = args.ws;
    volatile LAS unsigned* MISC = (volatile LAS unsigned*)(F.lds + MISC_OFF);
    for (int u = F.tid; u < (LDS_BYTES - LDSCTL_OFF) / 4; u += NTHR) ((LAS unsigned*)(F.lds + LDSCTL_OFF))[u] = 0u;
    __syncthreads();
    XcdBarrier bar; bar.bar = (unsigned*)(args.ws + WS_CTL) + CW_BAR; bar.x = 0; bar.st = nullptr;
    const bool one_launch = (args.ph_hi - args.ph_lo) > 1;
    if (one_launch) bar = xcd_barrier_post((unsigned*)(args.ws + WS_CTL) + CW_BAR, MISC + 8);
    const int lo = args.ph_lo, hi = args.ph_hi;
#define IN(k) (lo <= (k) && (k) < hi)
#define SEAM(k) do { if (IN(k) && IN((k) + 1)) xcd_barrier(bar); } while (0)
    unsigned char* ws = args.ws;

    if (IN(0)) { p0_prologue(F); } SEAM(0);
    if (IN(1)) {
        AddrPlain g{(const char*)F.out, (const char*)(ws + WS_WIN), 1024, 1024, 1024};
        pg8::StaticOrder S; S.init(MTOK, 6144, F.G, F.bid);
        EpiBf16<DstP1> E{DstP1{ws}};
        pg8::gemm_phase(F.lds, g, S, E);
    } SEAM(1);
    if (IN(2)) { lru_phase<false>(F); } SEAM(2);
    if (IN(3)) { lru_phase<true>(F); } SEAM(3);
    if (IN(4)) { mconv_phase(F); } SEAM(4);
    if (IN(5)) {
        AddrQKV g{(const char*)(ws + WS_XL), (long)WS_XM - (long)WS_XL, (const char*)(ws + WS_WQKV), 1024, 256, 256};
        pg8::StaticOrder S; S.init(MTOK, 12 * 256, F.G, F.bid);
        EpiBf16<DstQKV> E{DstQKV{(char*)(ws + WS_LG), (long)WS_K - (long)WS_LG, (long)((char*)F.out + (size_t)MTOK * DM * 2 - (char*)(ws + WS_LG))}};
        pg8::gemm_phase(F.lds, g, S, E);
    } SEAM(5);
    if (IN(6)) { mscan_phase(F); } SEAM(6);
    if (IN(7)) { ym_phase(F); } SEAM(7);
    if (IN(8)) {
        AddrBranch g{(const char*)(ws + WS_OP), (long)((const char*)F.out - (const char*)(ws + WS_OP)), (const char*)(ws + WS_WB2), 1024, 1024, 1024};
        pg8::StaticOrder S; S.init(MTOK, 2048, F.G, F.bid);
        EpiGate E{(bf16*)(ws + WS_MG)};
        pg8::gemm_phase(F.lds, g, S, E);
    } SEAM(8);
    if (IN(9)) {
        AddrPlain g{(const char*)(ws + WS_MG), (const char*)(ws + WS_WOUT2), 2048, 2048, 2048};
        pg8::StaticOrder S; S.init(MTOK, 1024, F.G, F.bid);
        EpiResid E{F.in[0], F.out, (bf16*)(ws + WS_XM), (float*)(ws + WS_SS)};
        pg8::gemm_phase(F.lds, g, S, E);
    } SEAM(9);
    if (IN(10)) {
        AddrPlain g{(const char*)(ws + WS_XM), (const char*)(ws + WS_WPQ), 1024, 1024, 1024};
        pg8::StaticOrder S; S.init(MTOK, 2048, F.G, F.bid);
        EpiPQ E{(bf16*)(ws + WS_MG), (const float*)(ws + WS_SS)};
        pg8::gemm_phase(F.lds, g, S, E);
    } SEAM(10);
    if (IN(11)) { select_ref(F); } SEAM(11);
    if (IN(12)) { apply_phase(F); }
#undef IN
#undef SEAM
}

extern "C" void kernel_launch(void* const* d_in, const int* in_sizes, int n_in, void* d_out, int out_size, void* d_ws, size_t ws_size, hipStream_t stream) {
    static int grid = 0;
    if (grid == 0) {
        if (n_in != 26 || in_sizes[0] != MTOK * DM || out_size != MTOK * DM || ws_size < WS_END) { fprintf(stderr, "kernel_launch: unexpected shapes / workspace (%zu < %zu)\n", ws_size, (size_t)WS_END); grid = -1; return; }
        int dev = 0, cus = 0, per_cu = 0;
        if (hipGetDevice(&dev) != hipSuccess || hipDeviceGetAttribute(&cus, hipDeviceAttributeMultiprocessorCount, dev) != hipSuccess) { grid = -1; return; }
        if (hipFuncSetAttribute((const void*)mega_fwd, hipFuncAttributeMaxDynamicSharedMemorySize, LDS_BYTES) != hipSuccess) { fprintf(stderr, "kernel_launch: hipFuncSetAttribute failed\n"); grid = -1; return; }
        if (hipOccupancyMaxActiveBlocksPerMultiprocessor(&per_cu, (const void*)mega_fwd, NTHR, LDS_BYTES) != hipSuccess || per_cu < 1) { fprintf(stderr, "kernel_launch: occupancy query says %d blocks/CU\n", per_cu); (void)hipGetLastError(); grid = -1; return; }
        grid = cus;
    }
    if (grid < 0) return;
    (void)hipMemsetAsync((char*)d_ws + WS_CTL, 0, CTL_ZERO_BYTES, stream);
    Args a{};
    for (int i = 0; i < 26; ++i) a.in[i] = (const float*)d_in[i];
    a.out = (float*)d_out; a.ws = (unsigned char*)d_ws;
#if MK_N_LAUNCHES == 1
    a.ph_lo = 0; a.ph_hi = N_PHASES;
    void* kargs[] = {&a};
    hipError_t e = hipLaunchCooperativeKernel((const void*)mega_fwd, dim3(grid), dim3(NTHR), kargs, LDS_BYTES, stream);
    if (e != hipSuccess) fprintf(stderr, "kernel_launch: cooperative launch failed: %s (grid %d)\n", hipGetErrorString(e), grid);
#else
    for (int p = 0; p < N_PHASES; ++p) { a.ph_lo = p; a.ph_hi = p + 1; hipLaunchKernelGGL(mega_fwd, dim3(grid), dim3(NTHR), LDS_BYTES, stream, a); }
#endif
}
```

```cpp
#include <hip/hip_runtime.h>
#include <cstdio>
#include <cstdint>
#include <math.h>

#ifndef MK_N_LAUNCHES
#define MK_N_LAUNCHES 1
#endif

constexpr int BATCH = 8, SEQ = 4096, DM = 1024, MTOK = BATCH * SEQ;
constexpr int DIN = 6160;
constexpr int NEXP = 16384;
constexpr float EPS = 1e-6f;

constexpr size_t MiB = 1u << 20;
constexpr size_t WS_CTL = 0, CTL_ZERO_BYTES = 1 * MiB;
constexpr size_t WS_WIN = 1 * MiB;
constexpr size_t WS_WQKV = 13 * MiB;
constexpr size_t WS_KEYS = 14 * MiB + 512 * 1024;
constexpr size_t WS_WLRU = 15 * MiB;
constexpr size_t WS_WB2 = 16 * MiB;
constexpr size_t WS_WOUT2 = 20 * MiB;
constexpr size_t WS_WPQ = 24 * MiB;
constexpr size_t WS_GATE = 28 * MiB;
constexpr size_t WS_XM = 32 * MiB;
constexpr size_t WS_OP = 96 * MiB;
constexpr size_t WS_XL = 160 * MiB;
constexpr size_t WS_LG = 224 * MiB;
constexpr size_t WS_MG = 288 * MiB;
constexpr size_t WS_K = 416 * MiB;
constexpr size_t WS_AGG = 480 * MiB;
constexpr size_t WS_SS = 488 * MiB;
constexpr size_t WS_END = 489 * MiB;

constexpr int CW_BAR = 4096;

constexpr int RING_BYTES = 131072;
constexpr int LDS_BYTES = 147456;
constexpr int LDSCTL_OFF = LDS_BYTES - 512, MISC_OFF = LDSCTL_OFF + 320;
constexpr int NWAVES = 8, NTHR = 512;

#define GAS __attribute__((address_space(1)))
#define LAS __attribute__((address_space(3)))
typedef unsigned short bf16;
typedef unsigned v4u __attribute__((ext_vector_type(4)));
typedef unsigned v2u __attribute__((ext_vector_type(2)));
typedef float f32x4 __attribute__((ext_vector_type(4)));
typedef float f32x2 __attribute__((ext_vector_type(2)));
typedef short bf16x8 __attribute__((ext_vector_type(8)));
typedef GAS unsigned gu32;
#define RLX_AGENT __ATOMIC_RELAXED, __HIP_MEMORY_SCOPE_AGENT
#define LDS_WAIT() asm volatile("s_waitcnt lgkmcnt(0)" ::: "memory")
#define VM_WAIT() asm volatile("s_waitcnt vmcnt(0)" ::: "memory")

__device__ __forceinline__ unsigned f2bf(float f) { unsigned u = __builtin_bit_cast(unsigned, f); return (u + 0x7fffu + ((u >> 16) & 1u)) >> 16; }
__device__ __forceinline__ unsigned pk2(float lo, float hi) { return f2bf(lo) | (f2bf(hi) << 16); }
__device__ __forceinline__ float bf2f(unsigned short h) { return __builtin_bit_cast(float, (unsigned)h << 16); }
__device__ __forceinline__ float bflo(unsigned w) { return __builtin_bit_cast(float, w << 16); }
__device__ __forceinline__ float bfhi(unsigned w) { return __builtin_bit_cast(float, w & 0xffff0000u); }
__device__ __forceinline__ float wave_sum(float v) {
#pragma unroll
  for (int o = 1; o < 64; o <<= 1) v += __shfl_xor(v, o);
  return v;
}
__device__ __forceinline__ float sigmoidf_(float x) { return 1.f / (1.f + __expf(-x)); }
__device__ __forceinline__ float gelu_erf(float x) { return 0.5f * x * (1.f + erff(x * 0.70710678118654752f)); }
__device__ __forceinline__ float gelu_fast(float v) {
    const float av = fabsf(v), t = __builtin_amdgcn_rcpf(av * 0.2316418882f + 1.0f);
    float q = t * 0.5307027145f + (-0.7265760135f); q = q * t + 0.7107068705f; q = q * t + (-0.142248368f); q = q * t + 0.127414796f; q = q * t;
    const float e = __builtin_amdgcn_exp2f((v * v) * (-0.72134752044f));
    const float m = v * (q * e);
    return v < 0.f ? m : v - m;
}
__device__ __forceinline__ float softplusf_(float x) { return fmaxf(x, 0.f) + log1pf(expf(-fabsf(x))); }

namespace pg8 {
#define PG8_LAS __attribute__((address_space(3)))
typedef unsigned short bf16_t;
typedef unsigned u32x4 __attribute__((ext_vector_type(4)));
constexpr int BM = 256, BK = 64, HALF = 128, HTB = HALF * BK * 2, STAGE_BYTES = 8 * HTB, NXCD = 8, WGM = 8;

__host__ __device__ __forceinline__ int lds_byte(int r, int c) { const int st = (r >> 4) * 2 + (c >> 5), rr = r & 15, cc = c & 31, ob = rr * 64 + cc * 2; return st * 1024 + (ob ^ (((ob >> 9) & 1) << 5)); }
__host__ __device__ __forceinline__ void stage_rc(int b, int& R, int& C) { const int st = b / 1024, sb = b % 1024, swz = sb ^ (((sb >> 9) & 1) << 5); R = (st >> 1) * 16 + swz / 64; C = (st & 1) * 32 + (swz % 64) / 2; }
__host__ __device__ __forceinline__ int perm32(int rho) { const int n = rho >> 4, i = rho & 15; return 8 * (i >> 2) + 4 * n + (i & 3); }

struct Unit { int pm, pn; };
struct StaticOrder {
    int nM, nN, nwg, G, c;
    __host__ __device__ void init(int M, int N, int G_, int c_) { nM = M / BM; nN = N / BM; nwg = nM * nN; G = G_; c = c_; }
    __host__ __device__ bool next(int i, Unit& u) const {
        const long L = (long)i * G + c; if (L >= nwg) return false;
        int wgid = (int)L; { const int q = nwg / NXCD, r = nwg % NXCD, xcd = wgid % NXCD, off = wgid / NXCD; wgid = (xcd < r ? xcd * (q + 1) : r * (q + 1) + (xcd - r) * q) + off; }
        const int nig = WGM * nN, gid = wgid / nig, fm = gid * WGM, gsz = (nM - fm) < WGM ? (nM - fm) : WGM;
        u.pm = fm + ((wgid % nig) % gsz); u.pn = (wgid % nig) / gsz; return true;
    }
};

__device__ __forceinline__ unsigned cvt_pk_bf16(float lo, float hi) { unsigned r; asm volatile("v_cvt_pk_bf16_f32 %0, %1, %2" : "=v"(r) : "v"(lo), "v"(hi)); return r; }

template <class Epi, class Addr>
__device__ __forceinline__ void gemm_phase(PG8_LAS unsigned char* lds, const Addr g, const StaticOrder& S, const Epi& E) {
    const int tid = threadIdx.x, wid = __builtin_amdgcn_readfirstlane(tid >> 6), lane = tid & 63, wr = wid >> 2, wc = wid & 3, fr = lane & 15, fq = lane >> 4;
    const int K = g.K, nt = K / BK;
    unsigned voffA[2], voffB[2];
#pragma unroll
    for (int i = 0; i < 2; ++i) { int R, C; stage_rc(tid * 16 + i * 8192, R, C); const int Rb = Epi::PERM ? ((R & ~31) + perm32(R & 31)) : R;
        voffA[i] = (unsigned)(R * g.lda + C) * 2u; voffB[i] = (unsigned)(Rb * g.ldb + C) * 2u; }
    const size_t kstep = (size_t)(BK * 2);
    const size_t hsA = (size_t)HALF * g.lda * 2, hsB = (size_t)HALF * g.ldb * 2;
    const unsigned ldsw = (unsigned)wid * 1024u;
    const int aoff = lds_byte(wr * 64 + fr, fq * 8), boff = lds_byte(wc * 32 + fr, fq * 8);
#define PG8_SA(b, h) (((b) * 2 + (h)) * HTB)
#define PG8_SB(b, h) ((4 + (b) * 2 + (h)) * HTB)
#define PG8_STAGE(bufoff, gbase, voff) do { _Pragma("unroll") for (int _i = 0; _i < 2; ++_i) \
        __builtin_amdgcn_global_load_lds((const unsigned*)((const char*)(gbase) + (voff)[_i]), (PG8_LAS unsigned*)(lds + (bufoff) + ldsw + _i * 8192), 16, 0, 0); } while (0)
#define PG8_LDA(dst, b, h) do { _Pragma("unroll") for (int m = 0; m < 4; ++m) _Pragma("unroll") for (int k = 0; k < 2; ++k) dst[m][k] = *(const PG8_LAS bf16x8*)(lds + PG8_SA(b, h) + aoff + m * 2048 + k * 1024); } while (0)
#define PG8_LDB(dst, b, h) do { _Pragma("unroll") for (int n = 0; n < 2; ++n) _Pragma("unroll") for (int k = 0; k < 2; ++k) dst[n][k] = *(const PG8_LAS bf16x8*)(lds + PG8_SB(b, h) + boff + n * 2048 + k * 1024); } while (0)
#define PG8_MMA(ai, bj, At, Bt) do { __builtin_amdgcn_s_setprio(1); _Pragma("unroll") for (int m = 0; m < 4; ++m) _Pragma("unroll") for (int n = 0; n < 2; ++n) _Pragma("unroll") for (int k = 0; k < 2; ++k) \
        acc[ai][bj][m][n] = __builtin_amdgcn_mfma_f32_16x16x32_bf16(Bt[n][k], At[m][k], acc[ai][bj][m][n], 0, 0, 0); __builtin_amdgcn_s_setprio(0); } while (0)
#define PG8_WAIT_V(n) asm volatile("s_waitcnt vmcnt(" #n ")" ::: "memory")
#define PG8_WAIT_L(n) asm volatile("s_waitcnt lgkmcnt(" #n ")" ::: "memory")
#define PG8_BAR __builtin_amdgcn_s_barrier()
#define PG8_SCHED __builtin_amdgcn_sched_barrier(0)
    Unit cur, nxt; int ui = 0;
    if (!S.next(0, cur)) return;
    f32x4 acc[2][2][4][2];
#pragma unroll
    for (int a = 0; a < 2; ++a)
#pragma unroll
        for (int b = 0; b < 2; ++b)
#pragma unroll
            for (int m = 0; m < 4; ++m)
#pragma unroll
                for (int n = 0; n < 2; ++n) acc[a][b][m][n] = (f32x4){0.f, 0.f, 0.f, 0.f};
    bf16x8 At[4][2], B0[2][2], B1[2][2];
    const char* cA = g.a(cur); const char* cB = g.b(cur);
    PG8_STAGE(PG8_SB(0, 0), cB, voffB); PG8_STAGE(PG8_SB(0, 1), cB + hsB, voffB); PG8_STAGE(PG8_SA(0, 0), cA, voffA); PG8_STAGE(PG8_SA(0, 1), cA + hsA, voffA);
    if (wr == 1) PG8_BAR;
    PG8_WAIT_V(2); PG8_BAR;
    PG8_STAGE(PG8_SB(1, 0), cB + kstep, voffB); PG8_STAGE(PG8_SA(1, 0), cA + kstep, voffA); PG8_STAGE(PG8_SB(1, 1), cB + hsB + kstep, voffB);
    PG8_WAIT_V(6); PG8_BAR;
    for (;;) {
        const bool has_next = S.next(ui + 1, nxt);
        const char* nA = has_next ? g.a(nxt) : cA; const char* nB = has_next ? g.b(nxt) : cB;
#pragma unroll 1
        for (int t = 0; t < nt; t += 2) {
            const bool last = (t == nt - 2);
            const char* a1 = cA + (size_t)(t + 1) * kstep;
            const char* a2 = last ? nA : cA + (size_t)(t + 2) * kstep; const char* b2 = last ? nB : cB + (size_t)(t + 2) * kstep;
            const char* a3 = a2 + kstep; const char* b3 = b2 + kstep;
            PG8_LDB(B0, 0, 0); PG8_LDB(B1, 0, 1); PG8_SCHED; PG8_LDA(At, 0, 0); PG8_STAGE(PG8_SA(1, 1), a1 + hsA, voffA);
            PG8_WAIT_V(8); PG8_WAIT_L(0); PG8_BAR; PG8_MMA(0, 0, At, B0); PG8_MMA(0, 1, At, B1); PG8_BAR; PG8_SCHED;
            PG8_LDA(At, 0, 1); PG8_STAGE(PG8_SB(0, 0), b2, voffB); PG8_STAGE(PG8_SB(0, 1), b2 + hsB, voffB); PG8_STAGE(PG8_SA(0, 0), a2, voffA);
            PG8_WAIT_V(8); PG8_WAIT_L(0); PG8_BAR; PG8_MMA(1, 0, At, B0); PG8_MMA(1, 1, At, B1); PG8_BAR; PG8_SCHED;
            PG8_LDB(B0, 1, 0); PG8_LDB(B1, 1, 1); PG8_SCHED; PG8_LDA(At, 1, 0); PG8_STAGE(PG8_SA(0, 1), a2 + hsA, voffA);
            PG8_WAIT_V(8); PG8_WAIT_L(0); PG8_BAR; PG8_MMA(0, 0, At, B0); PG8_MMA(0, 1, At, B1); PG8_BAR; PG8_SCHED;
            PG8_LDA(At, 1, 1); PG8_STAGE(PG8_SB(1, 0), b3, voffB); PG8_STAGE(PG8_SB(1, 1), b3 + hsB, voffB); PG8_STAGE(PG8_SA(1, 0), a3, voffA);
            PG8_WAIT_V(8); PG8_WAIT_L(0); PG8_BAR; PG8_MMA(1, 0, At, B0); PG8_MMA(1, 1, At, B1); PG8_BAR; PG8_SCHED;
        }
        if (wr == 0) PG8_BAR;
        E(acc, cur, wr, wc, fr, fq);
        if (!has_next) break;
#pragma unroll
        for (int a = 0; a < 2; ++a)
#pragma unroll
            for (int b = 0; b < 2; ++b)
#pragma unroll
                for (int m = 0; m < 4; ++m)
#pragma unroll
                    for (int n = 0; n < 2; ++n) acc[a][b][m][n] = (f32x4){0.f, 0.f, 0.f, 0.f};
        cur = nxt; cA = nA; cB = nB; ++ui;
        if (wr == 1) PG8_BAR;
    }
    PG8_WAIT_V(0);
    PG8_BAR;
#undef PG8_SA
#undef PG8_SB
#undef PG8_STAGE
#undef PG8_LDA
#undef PG8_LDB
#undef PG8_MMA
#undef PG8_WAIT_V
#undef PG8_WAIT_L
#undef PG8_BAR
#undef PG8_SCHED
}
}

#define XB_TMO      128
#define XB_XCNT(j)  (256  + 64 * (j))
#define XB_XSUB(j)  (1280 + 64 * (j))
#define XB_XGEN(j)  (2304 + 64 * (j))
#define XB_TOP      3328
#define XB_TOPGEN   3392
#define XCD_BAR_WORDS 3456
#define XB_SPIN_CAP (1u << 18)
__device__ __forceinline__ unsigned xb_ld(unsigned* p)              { return __hip_atomic_load(p, __ATOMIC_RELAXED, __HIP_MEMORY_SCOPE_AGENT); }
__device__ __forceinline__ unsigned xb_add(unsigned* p, unsigned v) { return __hip_atomic_fetch_add(p, v, __ATOMIC_RELAXED, __HIP_MEMORY_SCOPE_AGENT); }
__device__ __forceinline__ unsigned xb_xcc_id() { return (unsigned)__builtin_amdgcn_s_getreg((3 << 11) | 20) & 0xFu; }
#define XB_SPIN(cond, bar) do { unsigned _sp = 0; while (cond) { __builtin_amdgcn_s_sleep(1); \
    if ((++_sp & 255u) == 0u) { if (xb_ld(&(bar)[XB_TMO])) break; if (_sp > XB_SPIN_CAP) { atomicAdd(&(bar)[XB_TMO], 1u); break; } } } } while (0)
struct XcdBarrier { unsigned* bar; unsigned x; volatile LAS unsigned* st; };
__device__ __forceinline__ XcdBarrier xcd_barrier_post(unsigned* bar, volatile LAS unsigned* st) {
    XcdBarrier b; b.bar = bar; b.x = xb_xcc_id(); b.st = st;
    if (threadIdx.x == 0) (void)xb_add(&bar[XB_XCNT(b.x)], 1u);
    return b;
}
__device__ __forceinline__ void xcd_barrier_complete(unsigned* bar, unsigned x, unsigned& nloc, unsigned& nx) {
    const unsigned G = gridDim.x * gridDim.y * gridDim.z;
    unsigned sum, cnt, mine, sp = 0u;
    for (;;) {
        sum = 0u; cnt = 0u; mine = 0u;
#pragma unroll
        for (unsigned j = 0; j < 16; ++j) { const unsigned c = xb_ld(&bar[XB_XCNT(j)]); sum += c; cnt += (c > 0u) ? 1u : 0u; mine = (j == x) ? c : mine; }
        if (sum == G) break;
        __builtin_amdgcn_s_sleep(1);
        if ((++sp & 255u) == 0u) { if (xb_ld(&bar[XB_TMO])) break; if (sp > XB_SPIN_CAP) { atomicAdd(&bar[XB_TMO], 1u); break; } }
    }
    nloc = mine > 0u ? mine : 1u; nx = cnt > 0u ? cnt : 1u;
}
__device__ __forceinline__ void xcd_barrier(const XcdBarrier& b) {
    asm volatile("s_waitcnt vmcnt(0)" ::: "memory");
    __syncthreads();
    if (threadIdx.x == 0) {
        unsigned* bar = b.bar;
        __builtin_amdgcn_s_waitcnt(0);
        unsigned nloc = b.st[0], nx = b.st[1];
        if (nloc == 0u) { xcd_barrier_complete(bar, b.x, nloc, nx); b.st[0] = nloc; b.st[1] = nx; }
        const unsigned old = xb_add(&bar[XB_XSUB(b.x)], 1u);
        const unsigned gen = old / nloc;
        if (old + 1u == (gen + 1u) * nloc) {
            __builtin_amdgcn_fence(__ATOMIC_RELEASE, "agent");
            asm volatile("s_waitcnt vmcnt(0)" ::: "memory");
            const unsigned og = xb_add(&bar[XB_TOP], 1u);
            const unsigned tg = og / nx;
            if (og + 1u == (tg + 1u) * nx) xb_add(&bar[XB_TOPGEN], 1u);
            else XB_SPIN(xb_ld(&bar[XB_TOPGEN]) == tg, bar);
            __builtin_amdgcn_fence(__ATOMIC_ACQUIRE, "agent");
            xb_add(&bar[XB_XGEN(b.x)], 1u);
            asm volatile("s_waitcnt vmcnt(0)" ::: "memory");
        } else {
            XB_SPIN(xb_ld(&bar[XB_XGEN(b.x)]) == gen, bar);
            __builtin_amdgcn_fence(__ATOMIC_ACQUIRE, "agent");
            asm volatile("s_waitcnt vmcnt(0)" ::: "memory");
        }
    }
    __syncthreads();
}

struct Args { const float* in[26]; float* out; unsigned char* ws; int ph_lo, ph_hi; };
struct Frame {
    LAS unsigned char* lds;
    int tid, lane, wave, G, bid;
    const float* const* in; float* out; unsigned char* ws;
};

__device__ __forceinline__ void tr_item(const float* W, int ldw, bf16* WT, int ldt, float scale, const float* kscale, LAS float* scr, int k0, int lane) {
#pragma unroll 8
    for (int i = 0; i < 32; ++i) { const int kk = 2 * i + (lane >> 5); float v = W[(size_t)(k0 + kk) * ldw + (lane & 31)] * scale; if (kscale) v *= kscale[k0 + kk]; scr[kk * 33 + (lane & 31)] = v; }
    LDS_WAIT(); asm volatile("" ::: "memory");
    const int c = lane & 7;
#pragma unroll
    for (int j = 0; j < 4; ++j) { const int n = (lane >> 3) + 8 * j; const LAS float* s = scr + (8 * c) * 33 + n;
        v4u o; o.x = pk2(s[0 * 33], s[1 * 33]); o.y = pk2(s[2 * 33], s[3 * 33]); o.z = pk2(s[4 * 33], s[5 * 33]); o.w = pk2(s[6 * 33], s[7 * 33]);
        *(GAS v4u*)(WT + (size_t)n * ldt + k0 + 8 * c) = o; }
    LDS_WAIT(); asm volatile("" ::: "memory");
}

__device__ __forceinline__ void p0_prologue(Frame& F) {
    LAS float* scr = (LAS float*)(F.lds + F.wave * 16384);
    const int gw = F.bid * NWAVES + F.wave, NGW = F.G * NWAVES;
    unsigned char* ws = F.ws;
    const float* w_in = F.in[2];
    constexpr int I_WIN = 16 * 192, I_QKV = 12 * 32, I_LRU = 32 * 8, I_WB = 2 * 512, I_WO = 2 * 512, I_PQ = 16 * 64;
    constexpr int NITEMS = I_WIN + I_QKV + I_LRU + I_WB + I_WO + I_PQ;
    for (int it = gw; it < NITEMS; it += NGW) {
        int r = it;
        if (r < I_WIN) { const int kb = r / 192, nb = r % 192, n0 = nb * 32, sc = n0 < 2048 ? n0 : n0 + 16;
            tr_item(w_in + sc, DIN, (bf16*)(ws + WS_WIN) + (size_t)n0 * 1024, 1024, 1.f, nullptr, scr, kb * 64, F.lane); continue; }
        r -= I_WIN;
        if (r < I_QKV) { const int mat = r / 32, rr = r % 32, kb = rr / 8, nb = rr % 8, g = mat >> 2, h = mat & 3;
            const float* W = F.in[6 + g] + (size_t)h * 65536 + nb * 32;
            tr_item(W, 256, (bf16*)(ws + WS_WQKV) + (size_t)mat * 65536 + (size_t)(nb * 32) * 256, 256, g == 1 ? 0.0625f : 1.f, nullptr, scr, kb * 64, F.lane); continue; }
        r -= I_QKV;
        if (r < I_LRU) { const int mat = r / 8, rr = r % 8, kb = rr / 4, nb = rr % 4, gate = mat & 1, db = mat >> 1;
            const float* W = F.in[gate ? 14 : 12] + (size_t)db * 16384 + nb * 32;
            tr_item(W, 128, (bf16*)(ws + WS_WLRU) + (size_t)mat * 16384 + (size_t)(nb * 32) * 128, 128, 1.f, nullptr, scr, kb * 64, F.lane); continue; }
        r -= I_LRU;
        if (r < I_WB) { const int mat = r / 512, rr = r % 512, kb = rr / 32, nb = rr % 32;
            const float* W = F.in[17 + mat] + nb * 32;
            tr_item(W, 1024, (bf16*)(ws + WS_WB2) + (size_t)(mat * 1024 + nb * 32) * 1024, 1024, 1.f, nullptr, scr, kb * 64, F.lane); continue; }
        r -= I_WB;
        if (r < I_WO) { const int cp = r / 512, rr = r % 512, kb = rr / 32, nb = rr % 32;
            const float* W = F.in[19] + nb * 32;
            tr_item(W, 1024, (bf16*)(ws + WS_WOUT2) + (size_t)(nb * 32) * 2048 + cp * 1024, 2048, 1.f, nullptr, scr, kb * 64, F.lane); continue; }
        r -= I_WO;
        { const int kb = r / 64, nb = r % 64;
            const float* W = F.in[21] + nb * 32;
            tr_item(W, 2048, (bf16*)(ws + WS_WPQ) + (size_t)(nb * 32) * 1024, 1024, 1.f, F.in[20], scr, kb * 64, F.lane); }
    }
    { const int gt = F.bid * NTHR + F.tid, NGT = F.G * NTHR;
      const float4* ks = (const float4*)F.in[22]; v2u* kd = (v2u*)(ws + WS_KEYS);
      for (int i = gt; i < 8 * 2 * 128 * 128 / 4; i += NGT) { const float4 v = ks[i]; v2u o; o.x = pk2(v.x, v.y); o.y = pk2(v.z, v.w); kd[i] = o; }
      float* ss = (float*)(ws + WS_SS);
      for (int i = gt; i < MTOK; i += NGT) ss[i] = 0.f; }
    const float* x = F.in[0]; const float* g1 = F.in[1]; const float* bg = F.in[3];
    bf16* XN = (bf16*)F.out;
    float* GT = (float*)(ws + WS_GATE);
    f32x4 gv[4];
#pragma unroll
    for (int j = 0; j < 4; ++j) gv[j] = ((const f32x4*)g1)[F.lane + 64 * j];
    for (int m = gw; m < MTOK; m += NGW) {
        const f32x4* xr = (const f32x4*)(x + (size_t)m * DM) + F.lane;
        f32x4 v[4]; float s = 0.f;
#pragma unroll
        for (int j = 0; j < 4; ++j) { v[j] = xr[64 * j]; s += (v[j].x * v[j].x + v[j].y * v[j].y) + (v[j].z * v[j].z + v[j].w * v[j].w); }
        const float rstd = rsqrtf(wave_sum(s) * (1.f / DM) + EPS);
        unsigned long long* o8 = (unsigned long long*)(XN + (size_t)m * DM) + F.lane;
        float pg[16];
#pragma unroll
        for (int c = 0; c < 16; ++c) pg[c] = 0.f;
#pragma unroll
        for (int j = 0; j < 4; ++j) {
            v[j] = v[j] * rstd * gv[j];
            o8[64 * j] = (unsigned long long)pk2(v[j].x, v[j].y) | ((unsigned long long)pk2(v[j].z, v[j].w) << 32);
#pragma unroll
            for (int e = 0; e < 4; ++e) {
                const int k = 4 * (F.lane + 64 * j) + e;
                const f32x4* wr = (const f32x4*)(w_in + (size_t)k * DIN + 2048);
                const float hv = v[j][e];
#pragma unroll
                for (int q = 0; q < 4; ++q) { const f32x4 w4 = wr[q]; pg[4 * q] += hv * w4.x; pg[4 * q + 1] += hv * w4.y; pg[4 * q + 2] += hv * w4.z; pg[4 * q + 3] += hv * w4.w; }
            }
        }
        float mine = 0.f;
#pragma unroll
        for (int c = 0; c < 16; ++c) { const float t = wave_sum(pg[c]); if (F.lane == c) mine = t; }
        if (F.lane < 16) GT[(size_t)m * 16 + F.lane] = mine + bg[F.lane];
    }
}

struct AddrPlain {
    const char* A; const char* Bt; int lda, ldb, K;
    __device__ __forceinline__ const char* a(const pg8::Unit& u) const { return A + (size_t)u.pm * 256 * lda * 2; }
    __device__ __forceinline__ const char* b(const pg8::Unit& u) const { return Bt + (size_t)u.pn * 256 * ldb * 2; }
};
struct AddrQKV {
    const char* XC; long dXM; const char* W; int lda, ldb, K;
    __device__ __forceinline__ const char* a(const pg8::Unit& u) const { return XC + (u.pn < 8 ? 0l : dXM) + ((size_t)u.pm * 256 * 1024 + (u.pn & 3) * 256) * 2; }
    __device__ __forceinline__ const char* b(const pg8::Unit& u) const { return W + (size_t)u.pn * 65536 * 2; }
};
struct AddrBranch {
    const char* YM; long dYL; const char* W; int lda, ldb, K;
    __device__ __forceinline__ const char* a(const pg8::Unit& u) const { return YM + (u.pn < 4 ? 0l : dYL) + (size_t)u.pm * 256 * 1024 * 2; }
    __device__ __forceinline__ const char* b(const pg8::Unit& u) const { return W + (size_t)u.pn * 256 * 1024 * 2; }
};

struct DstP1 { unsigned char* ws;
    __device__ __forceinline__ bf16* get(int pn, int& ld, int& col0) const {
        const bool mg = pn >= 16; ld = mg ? 2048 : 1024; col0 = mg ? (pn - 16) * 256 : (pn & 3) * 256;
        return (bf16*)(ws + (mg ? WS_MG : WS_XM + (size_t)(pn >> 2) * 64 * MiB)); } };
struct DstQKV { char* q; long dk, dv;
    __device__ __forceinline__ bf16* get(int pn, int& ld, int& col0) const { ld = 1024; col0 = (pn & 3) * 256; return (bf16*)(q + (pn >= 4 ? (pn >= 8 ? dv : dk) : 0l)); } };
template <class Dst> struct EpiBf16 {
    static constexpr bool PERM = true;
    Dst dst;
    __device__ __forceinline__ void operator()(const f32x4 (&acc)[2][2][4][2], const pg8::Unit& u, int wr, int wc, int fr, int fq) const {
        int ld, colt; bf16* base = dst.get(u.pn, ld, colt);
        const int row0 = u.pm * 256 + wr * 64 + fr, col0 = colt + wc * 32 + 8 * fq;
#pragma unroll
        for (int ai = 0; ai < 2; ++ai)
#pragma unroll
            for (int m = 0; m < 4; ++m) { bf16* rowp = base + (size_t)(row0 + ai * 128 + m * 16) * ld + col0;
#pragma unroll
                for (int bj = 0; bj < 2; ++bj) { const f32x4 v0 = acc[ai][bj][m][0], v1 = acc[ai][bj][m][1];
                    v4u w; w.x = pg8::cvt_pk_bf16(v0[0], v0[1]); w.y = pg8::cvt_pk_bf16(v0[2], v0[3]); w.z = pg8::cvt_pk_bf16(v1[0], v1[1]); w.w = pg8::cvt_pk_bf16(v1[2], v1[3]);
                    *(v4u*)(rowp + bj * 128) = w; } }
    }
};
struct EpiGate {
    static constexpr bool PERM = true;
    bf16* G;
    __device__ __forceinline__ void operator()(const f32x4 (&acc)[2][2][4][2], const pg8::Unit& u, int wr, int wc, int fr, int fq) const {
        const int row0 = u.pm * 256 + wr * 64 + fr, col0 = u.pn * 256 + wc * 32 + 8 * fq;
#pragma unroll
        for (int ai = 0; ai < 2; ++ai)
#pragma unroll
            for (int m = 0; m < 4; ++m) { bf16* rowp = G + (size_t)(row0 + ai * 128 + m * 16) * 2048 + col0;
#pragma unroll
                for (int bj = 0; bj < 2; ++bj) { const f32x4 v0 = acc[ai][bj][m][0], v1 = acc[ai][bj][m][1];
                    const v4u g = *(const v4u*)(rowp + bj * 128);
                    v4u w;
                    w.x = pg8::cvt_pk_bf16(v0[0] * sigmoidf_(bflo(g.x)), v0[1] * sigmoidf_(bfhi(g.x)));
                    w.y = pg8::cvt_pk_bf16(v0[2] * sigmoidf_(bflo(g.y)), v0[3] * sigmoidf_(bfhi(g.y)));
                    w.z = pg8::cvt_pk_bf16(v1[0] * sigmoidf_(bflo(g.z)), v1[1] * sigmoidf_(bfhi(g.z)));
                    w.w = pg8::cvt_pk_bf16(v1[2] * sigmoidf_(bflo(g.w)), v1[3] * sigmoidf_(bfhi(g.w)));
                    *(v4u*)(rowp + bj * 128) = w; } }
    }
};
struct EpiResid {
    static constexpr bool PERM = false;
    const float* x; float* x1; bf16* x1b; float* ss;
    __device__ __forceinline__ void operator()(const f32x4 (&acc)[2][2][4][2], const pg8::Unit& u, int wr, int wc, int fr, int fq) const {
        const int row0 = u.pm * 256 + wr * 64 + fr, col0 = u.pn * 256 + wc * 32 + 4 * fq;
#pragma unroll
        for (int ai = 0; ai < 2; ++ai)
#pragma unroll
            for (int m = 0; m < 4; ++m) { const int row = row0 + ai * 128 + m * 16; const size_t off = (size_t)row * DM + col0; float s = 0.f;
#pragma unroll
                for (int bj = 0; bj < 2; ++bj)
#pragma unroll
                    for (int n = 0; n < 2; ++n) { const size_t o = off + bj * 128 + n * 16; const f32x4 v = *(const f32x4*)(x + o) + acc[ai][bj][m][n];
                        *(f32x4*)(x1 + o) = v; v2u w; w.x = pg8::cvt_pk_bf16(v[0], v[1]); w.y = pg8::cvt_pk_bf16(v[2], v[3]); *(v2u*)(x1b + o) = w;
                        s += (v[0] * v[0] + v[1] * v[1]) + (v[2] * v[2] + v[3] * v[3]); }
                s += __shfl_xor(s, 16); s += __shfl_xor(s, 32);
                if (fq == 0) atomicAdd(ss + row, s); }
    }
};
struct EpiPQ {
    static constexpr bool PERM = true;
    bf16* pq; const float* ss;
    __device__ __forceinline__ void operator()(const f32x4 (&acc)[2][2][4][2], const pg8::Unit& u, int wr, int wc, int fr, int fq) const {
        const int row0 = u.pm * 256 + wr * 64 + fr, col0 = u.pn * 256 + wc * 32 + 8 * fq;
#pragma unroll
        for (int ai = 0; ai < 2; ++ai)
#pragma unroll
            for (int m = 0; m < 4; ++m) { const int row = row0 + ai * 128 + m * 16; bf16* rowp = pq + (size_t)row * 2048 + col0;
                const float r = rsqrtf(ss[row] * (1.f / DM) + EPS);
#pragma unroll
                for (int bj = 0; bj < 2; ++bj) { const f32x4 v0 = acc[ai][bj][m][0] * r, v1 = acc[ai][bj][m][1] * r;
                    v4u w; w.x = pg8::cvt_pk_bf16(v0[0], v0[1]); w.y = pg8::cvt_pk_bf16(v0[2], v0[3]); w.z = pg8::cvt_pk_bf16(v1[0], v1[1]); w.w = pg8::cvt_pk_bf16(v1[2], v1[3]);
                    *(v4u*)(rowp + bj * 128) = w; } }
    }
};

__device__ __forceinline__ void lru_ref(Frame& F) {
    const bf16* XL = (const bf16*)(F.ws + WS_XL); const bf16* LG = (const bf16*)(F.ws + WS_LG); bf16* YL = (bf16*)F.out;
    const bf16* WL = (const bf16*)(F.ws + WS_WLRU);
    const float* cw = F.in[10]; const float* cb = F.in[11];
    LAS float* sxc = (LAS float*)F.lds;
    LAS float* sp = (LAS float*)(F.lds + 1024);
    const int c = F.tid & 127, part = F.tid >> 7;
    for (int item = F.bid; item < 64; item += F.G) {
        const int b = item >> 3, blk = item & 7, ch = blk * 128 + c;
        const float w0 = cw[0 * DM + ch], w1 = cw[1 * DM + ch], w2 = cw[2 * DM + ch], w3 = cw[3 * DM + ch], bb = cb[ch];
        for (int dir = 0; dir < 2; ++dir) {
            v4u wr[4], wi[4];
            { const v4u* pr = (const v4u*)(WL + ((size_t)((dir * 8 + blk) * 2 + 0) * 128 + c) * 128 + part * 32);
              const v4u* pi = (const v4u*)(WL + ((size_t)((dir * 8 + blk) * 2 + 1) * 128 + c) * 128 + part * 32);
#pragma unroll
              for (int q = 0; q < 4; ++q) { wr[q] = pr[q]; wi[q] = pi[q]; } }
            const float br = F.in[13][dir * DM + ch], bi = F.in[15][dir * DM + ch];
            const float spl = softplusf_(-F.in[16][dir * DM + ch]);
            float h = 0.f;
            for (int step = 0; step < SEQ; ++step) {
                const int t = dir ? (SEQ - 1 - step) : step;
                const size_t m = (size_t)b * SEQ + t;
                float xc = 0.f;
                if (part == 0) {
                    xc = bb;
                    if (t >= 2) xc += w0 * bf2f(XL[(m - 2) * DM + ch]);
                    if (t >= 1) xc += w1 * bf2f(XL[(m - 1) * DM + ch]);
                    xc += w2 * bf2f(XL[m * DM + ch]);
                    if (t + 1 < SEQ) xc += w3 * bf2f(XL[(m + 1) * DM + ch]);
                    sxc[c] = xc;
                }
                __syncthreads();
                float pr_ = 0.f, pi_ = 0.f;
#pragma unroll
                for (int q = 0; q < 4; ++q) {
                    const f32x4 x0 = *(const LAS f32x4*)(sxc + part * 32 + q * 8), x1 = *(const LAS f32x4*)(sxc + part * 32 + q * 8 + 4);
                    pr_ += x0[0] * bflo(wr[q].x) + x0[1] * bfhi(wr[q].x) + x0[2] * bflo(wr[q].y) + x0[3] * bfhi(wr[q].y)
                         + x1[0] * bflo(wr[q].z) + x1[1] * bfhi(wr[q].z) + x1[2] * bflo(wr[q].w) + x1[3] * bfhi(wr[q].w);
                    pi_ += x0[0] * bflo(wi[q].x) + x0[1] * bfhi(wi[q].x) + x0[2] * bflo(wi[q].y) + x0[3] * bfhi(wi[q].y)
                         + x1[0] * bflo(wi[q].z) + x1[1] * bfhi(wi[q].z) + x1[2] * bflo(wi[q].w) + x1[3] * bfhi(wi[q].w);
                }
                sp[(part * 2 + 0) * 128 + c] = pr_; sp[(part * 2 + 1) * 128 + c] = pi_;
                __syncthreads();
                if (part == 0) {
                    const float rp = sp[0 * 128 + c] + sp[2 * 128 + c] + sp[4 * 128 + c] + sp[6 * 128 + c] + br;
                    const float ip = sp[1 * 128 + c] + sp[3 * 128 + c] + sp[5 * 128 + c] + sp[7 * 128 + c] + bi;
                    const float r = sigmoidf_(rp), ig = sigmoidf_(ip);
                    const float log_a = -8.f * r * spl;
                    const float a = __expf(log_a);
                    const float u = sqrtf(-expm1f(2.f * log_a)) * (ig * xc);
                    h = a * h + u;
                    if (dir == 0) YL[m * DM + ch] = (bf16)f2bf(h);
                    else { const float y = (bf2f(YL[m * DM + ch]) + h) * gelu_erf(bf2f(LG[m * DM + ch])); YL[m * DM + ch] = (bf16)f2bf(y); }
                }
            }
            __syncthreads();
        }
    }
}


template <bool PB> __device__ __forceinline__ void lru_phase(Frame& F) {
    const bf16* XL = (const bf16*)(F.ws + WS_XL); const bf16* LG = (const bf16*)(F.ws + WS_LG); bf16* YL = (bf16*)F.out;
    f32x2* AGG = (f32x2*)(F.ws + WS_AGG);
    const bf16* WL = (const bf16*)(F.ws + WS_WLRU);
    const float* cw = F.in[10]; const float* cb = F.in[11];
    constexpr int O_XCB = 0, O_XCF = 17408, O_A = 50176, O_U = 82944;
    LAS unsigned char* L = F.lds;
    const int tid = F.tid, lane = F.lane, w = F.wave, fr = lane & 15, fq = lane >> 4;
    int cur_blk = -1;
    bf16x8 wf[2][2][4];
    f32x4 br4[2], bi4[2], sp4[2];
    for (int i = 0;; ++i) {
        const int idx = i * F.G + F.bid; if (idx >= 4096) break;
        const int blk = idx & 7, j = idx >> 3, b = j >> 6, seg = j & 63, t0 = seg * 64;
        const size_t mrow0 = (size_t)b * SEQ + t0;
        if (blk != cur_blk) {
            cur_blk = blk;
#pragma unroll
            for (int d = 0; d < 2; ++d) {
#pragma unroll
                for (int g = 0; g < 2; ++g)
#pragma unroll
                    for (int ks = 0; ks < 4; ++ks)
                        wf[d][g][ks] = *(const bf16x8*)(WL + ((size_t)((d * 8 + blk) * 2 + g) * 128 + 16 * w + fr) * 128 + 32 * ks + 8 * fq);
                const int ch = blk * 128 + 16 * w + 4 * fq;
                br4[d] = *(const f32x4*)(F.in[13] + d * DM + ch); bi4[d] = *(const f32x4*)(F.in[15] + d * DM + ch);
                const f32x4 lm = *(const f32x4*)(F.in[16] + d * DM + ch);
#pragma unroll
                for (int e = 0; e < 4; ++e) sp4[d][e] = softplusf_(-lm[e]);
            }
        }
        for (int e = tid; e < 68 * 16; e += NTHR) { const int row = e >> 4, c16 = e & 15, t = t0 - 2 + row;
            v4u v = {0u, 0u, 0u, 0u};
            if (t >= 0 && t < SEQ) v = *(const v4u*)(XL + ((size_t)b * SEQ + t) * DM + blk * 128 + c16 * 8);
            *(LAS v4u*)(L + O_A + row * 256 + c16 * 16) = v; }
        __syncthreads();
        for (int e = tid; e < 64 * 16; e += NTHR) { const int tl = e >> 4, c16 = e & 15, c0 = blk * 128 + c16 * 8;
            float y[8];
            { const f32x4 a = *(const f32x4*)(cb + c0), bq = *(const f32x4*)(cb + c0 + 4); y[0] = a[0]; y[1] = a[1]; y[2] = a[2]; y[3] = a[3]; y[4] = bq[0]; y[5] = bq[1]; y[6] = bq[2]; y[7] = bq[3]; }
#pragma unroll
            for (int jt = 0; jt < 4; ++jt) { const v4u r = *(const LAS v4u*)(L + O_A + (tl + jt) * 256 + c16 * 16);
                const f32x4 wa = *(const f32x4*)(cw + jt * DM + c0), wb = *(const f32x4*)(cw + jt * DM + c0 + 4);
                y[0] += wa[0] * bflo(r.x); y[1] += wa[1] * bfhi(r.x); y[2] += wa[2] * bflo(r.y); y[3] += wa[3] * bfhi(r.y);
                y[4] += wb[0] * bflo(r.z); y[5] += wb[1] * bfhi(r.z); y[6] += wb[2] * bflo(r.w); y[7] += wb[3] * bfhi(r.w); }
            *(LAS f32x4*)(L + O_XCF + tl * 512 + c16 * 32) = (f32x4){y[0], y[1], y[2], y[3]};
            *(LAS f32x4*)(L + O_XCF + tl * 512 + c16 * 32 + 16) = (f32x4){y[4], y[5], y[6], y[7]};
            v4u o; o.x = pk2(y[0], y[1]); o.y = pk2(y[2], y[3]); o.z = pk2(y[4], y[5]); o.w = pk2(y[6], y[7]);
            *(LAS v4u*)(L + O_XCB + tl * 272 + c16 * 16) = o; }
        __syncthreads();
        float carry0 = 0.f, carry1 = 0.f;
        if (PB && tid < 128) {
            const int ch = blk * 128 + tid;
            float h = 0.f;
            for (int js = 0; js < seg; ++js) { const f32x2 ah = AGG[((size_t)(b * 64 + js) * 2 + 0) * DM + ch]; h = ah[0] * h + ah[1]; }
            carry0 = h; h = 0.f;
            for (int js = 63; js > seg; --js) { const f32x2 ah = AGG[((size_t)(b * 64 + js) * 2 + 1) * DM + ch]; h = ah[0] * h + ah[1]; }
            carry1 = h;
        }
#pragma unroll
        for (int d = 0; d < 2; ++d) {
            const int o_a = (d == 0) ? O_A : O_XCF;
            f32x4 aR[4], aI[4];
#pragma unroll
            for (int mt = 0; mt < 4; ++mt) { aR[mt] = (f32x4){0.f, 0.f, 0.f, 0.f}; aI[mt] = (f32x4){0.f, 0.f, 0.f, 0.f}; }
#pragma unroll
            for (int ks = 0; ks < 4; ++ks)
#pragma unroll
                for (int mt = 0; mt < 4; ++mt) { const bf16x8 xb = *(const LAS bf16x8*)(L + O_XCB + (16 * mt + fr) * 272 + (32 * ks + 8 * fq) * 2);
                    aR[mt] = __builtin_amdgcn_mfma_f32_16x16x32_bf16(wf[d][0][ks], xb, aR[mt], 0, 0, 0);
                    aI[mt] = __builtin_amdgcn_mfma_f32_16x16x32_bf16(wf[d][1][ks], xb, aI[mt], 0, 0, 0); }
#pragma unroll
            for (int mt = 0; mt < 4; ++mt) { const int tl = 16 * mt + fr, cl = 16 * w + 4 * fq;
                const f32x4 xc = *(const LAS f32x4*)(L + O_XCF + tl * 512 + cl * 4);
                f32x4 av, uv;
#pragma unroll
                for (int e = 0; e < 4; ++e) { const float r = sigmoidf_(aR[mt][e] + br4[d][e]), ig = sigmoidf_(aI[mt][e] + bi4[d][e]);
                    const float la = -8.f * r * sp4[d][e]; av[e] = __expf(la); uv[e] = sqrtf(-expm1f(2.f * la)) * (ig * xc[e]); }
                *(LAS f32x4*)(L + o_a + tl * 512 + cl * 4) = av; *(LAS f32x4*)(L + O_U + tl * 512 + cl * 4) = uv; }
            __syncthreads();
            if (tid < 128) {
                LAS float* pa = (LAS float*)(L + o_a) + tid; const LAS float* pu = (const LAS float*)(L + O_U) + tid;
                if (!PB) {
                    float h = 0.f, A = 1.f;
#pragma unroll 8
                    for (int s2 = 0; s2 < 64; ++s2) { const int tl = d ? 63 - s2 : s2; const float a = pa[tl * 128], u = pu[tl * 128]; h = a * h + u; A *= a; }
                    AGG[((size_t)(b * 64 + seg) * 2 + d) * DM + blk * 128 + tid] = (f32x2){A, h};
                } else if (d == 0) {
                    float h = carry0;
#pragma unroll 8
                    for (int tl = 0; tl < 64; ++tl) { h = pa[tl * 128] * h + pu[tl * 128]; pa[tl * 128] = h; }
                } else {
                    float h = carry1;
                    LAS float* ph = (LAS float*)(L + O_A) + tid;
#pragma unroll 8
                    for (int s2 = 0; s2 < 64; ++s2) { const int tl = 63 - s2; h = pa[tl * 128] * h + pu[tl * 128]; ph[tl * 128] += h; }
                }
            }
            __syncthreads();
        }
        if (PB) {
            for (int e = tid; e < 64 * 16; e += NTHR) { const int row = e >> 4, c16 = e & 15;
                const v4u g = *(const v4u*)(LG + (mrow0 + row) * DM + blk * 128 + c16 * 8);
                const f32x4 h0 = *(const LAS f32x4*)(L + O_A + row * 512 + c16 * 32), h1 = *(const LAS f32x4*)(L + O_A + row * 512 + c16 * 32 + 16);
                v4u o;
                o.x = pk2(h0[0] * gelu_fast(bflo(g.x)), h0[1] * gelu_fast(bfhi(g.x))); o.y = pk2(h0[2] * gelu_fast(bflo(g.y)), h0[3] * gelu_fast(bfhi(g.y)));
                o.z = pk2(h1[0] * gelu_fast(bflo(g.z)), h1[1] * gelu_fast(bfhi(g.z))); o.w = pk2(h1[2] * gelu_fast(bflo(g.w)), h1[3] * gelu_fast(bfhi(g.w)));
                *(v4u*)(YL + (mrow0 + row) * DM + blk * 128 + c16 * 8) = o; }
            __syncthreads();
        }
    }
}

__device__ __forceinline__ void mconv_phase(Frame& F) {
    const bf16* XM = (const bf16*)(F.ws + WS_XM); bf16* XC = (bf16*)(F.ws + WS_XL);
    const float* cw = F.in[4]; const float* cb = F.in[5];
    const int NT = MTOK / 32 * 128;
    for (int g = F.bid * NTHR + F.tid; g < NT; g += F.G * NTHR) {
        const int chunk = g & 127, run = g >> 7, c0 = chunk * 8, m0 = run * 32, t0 = m0 & (SEQ - 1);
        float w[4][8], bias[8];
#pragma unroll
        for (int j = 0; j < 4; ++j) { const f32x4 a = *(const f32x4*)(cw + j * DM + c0), b = *(const f32x4*)(cw + j * DM + c0 + 4);
            w[j][0] = a[0]; w[j][1] = a[1]; w[j][2] = a[2]; w[j][3] = a[3]; w[j][4] = b[0]; w[j][5] = b[1]; w[j][6] = b[2]; w[j][7] = b[3]; }
        { const f32x4 a = *(const f32x4*)(cb + c0), b = *(const f32x4*)(cb + c0 + 4);
            bias[0] = a[0]; bias[1] = a[1]; bias[2] = a[2]; bias[3] = a[3]; bias[4] = b[0]; bias[5] = b[1]; bias[6] = b[2]; bias[7] = b[3]; }
        v4u win[4];
        const v4u zero = {0u, 0u, 0u, 0u};
        win[0] = zero;
        win[1] = (t0 >= 2) ? *(const v4u*)(XM + (size_t)(m0 - 2) * DM + c0) : zero;
        win[2] = (t0 >= 1) ? *(const v4u*)(XM + (size_t)(m0 - 1) * DM + c0) : zero;
        win[3] = *(const v4u*)(XM + (size_t)m0 * DM + c0);
#pragma unroll 4
        for (int i = 0; i < 32; ++i) {
            win[0] = win[1]; win[1] = win[2]; win[2] = win[3];
            win[3] = (t0 + i + 1 < SEQ) ? *(const v4u*)(XM + (size_t)(m0 + i + 1) * DM + c0) : zero;
            float y[8];
#pragma unroll
            for (int e = 0; e < 8; ++e) y[e] = bias[e];
#pragma unroll
            for (int j = 0; j < 4; ++j) {
                const unsigned p0 = win[j].x, p1 = win[j].y, p2 = win[j].z, p3 = win[j].w;
                y[0] += w[j][0] * bflo(p0); y[1] += w[j][1] * bfhi(p0); y[2] += w[j][2] * bflo(p1); y[3] += w[j][3] * bfhi(p1);
                y[4] += w[j][4] * bflo(p2); y[5] += w[j][5] * bfhi(p2); y[6] += w[j][6] * bflo(p3); y[7] += w[j][7] * bfhi(p3);
            }
#pragma unroll
            for (int e = 0; e < 8; ++e) y[e] = y[e] * sigmoidf_(y[e]);
            v4u o; o.x = pk2(y[0], y[1]); o.y = pk2(y[2], y[3]); o.z = pk2(y[4], y[5]); o.w = pk2(y[6], y[7]);
            *(v4u*)(XC + (size_t)(m0 + i) * DM + c0) = o;
        }
    }
}

__device__ __forceinline__ void mscan_ref(Frame& F) {
    const bf16* Q = (const bf16*)(F.ws + WS_LG); const bf16* K = (const bf16*)(F.ws + WS_K); const bf16* V = (const bf16*)F.out + (size_t)MTOK * DM;
    const float* GT = (const float*)(F.ws + WS_GATE);
    LAS float* sq = (LAS float*)F.lds; LAS float* sk = sq + 256; LAS float* sv = sk + 256; LAS float* spart = sv + 32; LAS float* sdw = spart + 256;
    const int e = F.tid & 31, dg = F.tid >> 5;
    for (int item = F.bid; item < 512; item += F.G) {
        const int es = item & 7, dir = (item >> 3) & 1, h = (item >> 4) & 3, b = item >> 6;
        bf16* H = (bf16*)(F.ws + (dir ? WS_XL : WS_XM));
        float C[16];
#pragma unroll
        for (int j = 0; j < 16; ++j) C[j] = 0.f;
        float nreg = 0.f, mst = 0.f;
        for (int step = 0; step < SEQ; ++step) {
            const int t = dir ? (SEQ - 1 - step) : step;
            const size_t m = (size_t)b * SEQ + t, ro = m * DM + h * 256;
            if (F.tid < 256) { sq[F.tid] = bf2f(Q[ro + F.tid]); sk[F.tid] = bf2f(K[ro + F.tid]); }
            if (F.tid < 32) sv[F.tid] = bf2f(V[ro + es * 32 + F.tid]);
            const float ip = GT[m * 16 + (dir * 2 + 0) * 4 + h], fp = GT[m * 16 + (dir * 2 + 1) * 4 + h];
            const float logf = -softplusf_(-fp);
            const float mn = fmaxf(logf + mst, ip);
            const float fd = __expf(logf + mst - mn), iw = __expf(ip - mn);
            mst = mn;
            __syncthreads();
            const float ve = sv[e] * iw;
            float part = 0.f;
#pragma unroll
            for (int j = 0; j < 16; ++j) { const int d = dg * 16 + j; C[j] = fd * C[j] + sk[d] * ve; part += sq[d] * C[j]; }
            part += __shfl_xor(part, 32);
            if (F.lane < 32) spart[F.wave * 32 + e] = part;
            if (F.tid < 256) { nreg = fd * nreg + iw * sk[F.tid]; const float ds = wave_sum(nreg * sq[F.tid]); if (F.lane == 0) sdw[F.wave] = ds; }
            __syncthreads();
            if (F.tid < 32) {
                float num = 0.f;
#pragma unroll
                for (int w = 0; w < 8; ++w) num += spart[w * 32 + F.tid];
                const float den = sdw[0] + sdw[1] + sdw[2] + sdw[3];
                H[ro + es * 32 + F.tid] = (bf16)f2bf(num / fmaxf(fabsf(den), __expf(-mn)));
            }
        }
        __syncthreads();
    }
}


typedef short s16x4 __attribute__((ext_vector_type(4)));
__device__ __forceinline__ bf16x8 tr_read_pair(unsigned a0, unsigned a1) {
    s16x4 r0, r1;
    asm volatile("ds_read_b64_tr_b16 %0, %2\n\tds_read_b64_tr_b16 %1, %3\n\ts_waitcnt lgkmcnt(0)" : "=&v"(r0), "=&v"(r1) : "v"(a0), "v"(a1) : "memory");
    return __builtin_shufflevector(r0, r1, 0, 1, 2, 3, 4, 5, 6, 7);
}
__device__ __forceinline__ float wave_incl_sum(float x, int lane) {
#pragma unroll
    for (int o = 1; o < 64; o <<= 1) { const float t = __shfl_up(x, o); if (lane >= o) x += t; }
    return x;
}
__device__ __forceinline__ float wave_incl_max(float x, int lane) {
#pragma unroll
    for (int o = 1; o < 64; o <<= 1) { const float t = __shfl_up(x, o); if (lane >= o) x = fmaxf(x, t); }
    return x;
}
__device__ __forceinline__ void mscan_phase(Frame& F) {
    const bf16* Q = (const bf16*)(F.ws + WS_LG); const bf16* K = (const bf16*)(F.ws + WS_K); const bf16* V = (const bf16*)F.out + (size_t)MTOK * DM;
    const float* GT = (const float*)(F.ws + WS_GATE);
    constexpr int KS = 0, CTI = 33792, VT = 67584, VWT = 86016, PB = 104448, TAB = 113664, NT = 116736, NPART = 117760, DENT = 119808;
    constexpr int KST = 528, VST = 144, TABSZ = 1536;
    LAS unsigned char* L = F.lds;
    const int tid = F.tid, lane = F.lane, w = F.wave, fr = lane & 15, fq = lane >> 4, pt = w & 3, wg = w >> 2;
    for (int item = F.bid; item < 256; item += F.G) {
        const int es = item & 3, dir = (item >> 2) & 1, h = (item >> 3) & 3, b = item >> 5;
        bf16* H = (bf16*)(F.ws + (dir ? WS_XL : WS_XM));
        const size_t rowbase = (size_t)b * SEQ;
#define TOF(c, p) (dir ? (SEQ - 1 - 64 * (c) - (p)) : (64 * (c) + (p)))
        for (int e = tid; e < (33792 + 1024) / 4; e += NTHR) { if (e < 33792 / 4) ((LAS unsigned*)(L + CTI))[e] = 0u; else ((LAS unsigned*)(L + NT))[e - 33792 / 4] = 0u; }
        float m_run = 0.f;
        float gi_n = 0.f, gf_n = 0.f;
        if (w == 0) { const size_t m = rowbase + TOF(0, lane); gi_n = GT[m * 16 + dir * 8 + h]; gf_n = GT[m * 16 + dir * 8 + 4 + h]; }
#define G1_TABLES(setp) do { \
            const float logf_ = -softplusf_(-gf_n); const float b_ = wave_incl_sum(logf_, lane); const float a_ = gi_n - b_; \
            const float M_ = fmaxf(m_run, wave_incl_max(a_, lane)); const float Mend_ = __shfl(M_, 63), g_ = __shfl(b_, 63); \
            LAS float* T_ = (LAS float*)(setp); T_[lane] = a_; T_[64 + lane] = M_; T_[128 + lane] = expf(m_run - M_); T_[192 + lane] = expf(-(b_ + M_)); T_[256 + lane] = expf(a_ - Mend_); \
            if (lane == 0) { T_[320] = expf(m_run - Mend_); T_[321] = g_ + Mend_; } \
            m_run = g_ + Mend_; } while (0)
        if (w == 0) G1_TABLES(L + TAB);
        __syncthreads();
        bf16x8 qf[8];
        v4u kreg[4]; v4u vreg;
#define LOAD_KV(c) do { _Pragma("unroll") for (int r_ = 0; r_ < 4; ++r_) { const int i_ = tid + NTHR * r_, s_ = i_ >> 5, c16_ = i_ & 31; \
                kreg[r_] = *(const v4u*)(K + (rowbase + TOF(c, s_)) * DM + h * 256 + c16_ * 8); } \
            { const int s_ = tid >> 3, e8_ = tid & 7; vreg = *(const v4u*)(V + (rowbase + TOF(c, s_)) * DM + h * 256 + es * 64 + e8_ * 8); } } while (0)
#define STORE_KV(setidx) do { _Pragma("unroll") for (int r_ = 0; r_ < 4; ++r_) { const int i_ = tid + NTHR * r_, s_ = i_ >> 5, c16_ = i_ & 31; \
                *(LAS v4u*)(L + KS + s_ * KST + c16_ * 16) = kreg[r_]; } \
            { const int s_ = tid >> 3, e8_ = tid & 7; const float ws_ = ((const LAS float*)(L + TAB + (setidx) * TABSZ))[256 + s_]; \
              LAS bf16* vt_ = (LAS bf16*)(L + VT + (setidx) * 9216); LAS bf16* vw_ = (LAS bf16*)(L + VWT + (setidx) * 9216); \
              const unsigned wv_[4] = {vreg.x, vreg.y, vreg.z, vreg.w}; \
              _Pragma("unroll") for (int j_ = 0; j_ < 4; ++j_) { const float lo_ = bflo(wv_[j_]), hi_ = bfhi(wv_[j_]); const int e_ = e8_ * 8 + 2 * j_; \
                vt_[e_ * 72 + s_] = (bf16)(wv_[j_] & 0xffffu); vt_[(e_ + 1) * 72 + s_] = (bf16)(wv_[j_] >> 16); \
                vw_[e_ * 72 + s_] = (bf16)f2bf(lo_ * ws_); vw_[(e_ + 1) * 72 + s_] = (bf16)f2bf(hi_ * ws_); } } } while (0)
#define LOAD_Q(c) do { const size_t m_ = rowbase + TOF(c, 16 * pt + fr); _Pragma("unroll") for (int ks_ = 0; ks_ < 8; ++ks_) \
                qf[ks_] = *(const bf16x8*)(Q + m_ * DM + h * 256 + 32 * ks_ + 8 * fq); } while (0)
        LOAD_KV(0); LOAD_Q(0);
        STORE_KV(0);
        f32x4 Cacc[8];
#pragma unroll
        for (int i = 0; i < 8; ++i) Cacc[i] = (f32x4){0.f, 0.f, 0.f, 0.f};
        __syncthreads();
        for (int c = 0; c < 64; ++c) {
            const int cur = c & 1, nxt = cur ^ 1;
            const bool has_next = (c + 1 < 64);
            const LAS float* T = (const LAS float*)(L + TAB + cur * TABSZ);
            if (has_next) { LOAD_KV(c + 1); if (w == 0) { const size_t m = rowbase + TOF(c + 1, lane); gi_n = GT[m * 16 + dir * 8 + h]; gf_n = GT[m * 16 + dir * 8 + 4 + h]; } }
            const int p = 16 * pt + fr;
            const float Mp = T[64 + p], wi_p = T[128 + p];
            float cs = 0.f;
#pragma unroll
            for (int i = 0; i < 2; ++i) { const int st = 2 * wg + i;
                v2u pw = {0u, 0u};
                if (st <= pt) {
                    f32x4 sa = (f32x4){0.f, 0.f, 0.f, 0.f};
#pragma unroll
                    for (int ks = 0; ks < 8; ++ks) { const bf16x8 kf = *(const LAS bf16x8*)(L + KS + (16 * st + fr) * KST + (32 * ks + 8 * fq) * 2);
                        sa = __builtin_amdgcn_mfma_f32_16x16x32_bf16(kf, qf[ks], sa, 0, 0, 0); }
                    const f32x4 a4 = *(const LAS f32x4*)(T + 16 * st + 4 * fq);
                    float pv[4];
#pragma unroll
                    for (int r = 0; r < 4; ++r) { const int s_ = 16 * st + 4 * fq + r; const float wgt = (s_ <= p) ? __expf(a4[r] - Mp) : 0.f; pv[r] = sa[r] * wgt; cs += pv[r]; }
                    pw.x = pk2(pv[0], pv[1]); pw.y = pk2(pv[2], pv[3]);
                }
                *(LAS v2u*)(L + PB + p * VST + (16 * st + 4 * fq) * 2) = pw; }
            f32x4 O[2];
#pragma unroll
            for (int i = 0; i < 2; ++i) { const int et = 2 * wg + i; O[i] = (f32x4){0.f, 0.f, 0.f, 0.f};
#pragma unroll
                for (int ks = 0; ks < 8; ++ks) { const bf16x8 cf = *(const LAS bf16x8*)(L + CTI + (16 * et + fr) * KST + (32 * ks + 8 * fq) * 2);
                    O[i] = __builtin_amdgcn_mfma_f32_16x16x32_bf16(cf, qf[ks], O[i], 0, 0, 0); } }
            float di = 0.f;
#pragma unroll
            for (int k2 = 0; k2 < 4; ++k2) { const int ks = 4 * wg + k2;
                const f32x4 n0 = *(const LAS f32x4*)(L + NT + (32 * ks + 8 * fq) * 4), n1 = *(const LAS f32x4*)(L + NT + (32 * ks + 8 * fq) * 4 + 16);
                const v4u qw = __builtin_bit_cast(v4u, qf[ks]);
                di += bflo(qw.x) * n0[0] + bfhi(qw.x) * n0[1] + bflo(qw.y) * n0[2] + bfhi(qw.y) * n0[3] + bflo(qw.z) * n1[0] + bfhi(qw.z) * n1[1] + bflo(qw.w) * n1[2] + bfhi(qw.w) * n1[3]; }
            di += __shfl_xor(di, 16); di += __shfl_xor(di, 32);
            cs += __shfl_xor(cs, 16); cs += __shfl_xor(cs, 32);
            if (fq == 0) ((LAS float*)(L + DENT))[wg * 64 + p] = wi_p * di + cs;
            if (has_next) LOAD_Q(c + 1);
            if (has_next && w == 0) G1_TABLES(L + TAB + nxt * TABSZ);
            __syncthreads();
#pragma unroll
            for (int i = 0; i < 2; ++i) { const int et = 2 * wg + i; O[i] = O[i] * wi_p;
#pragma unroll
                for (int ks = 0; ks < 2; ++ks) { const bf16x8 vf = *(const LAS bf16x8*)(L + VT + cur * 9216 + (16 * et + fr) * VST + (32 * ks + 8 * fq) * 2);
                    const bf16x8 pf = *(const LAS bf16x8*)(L + PB + p * VST + (32 * ks + 8 * fq) * 2);
                    O[i] = __builtin_amdgcn_mfma_f32_16x16x32_bf16(vf, pf, O[i], 0, 0, 0); } }
            { const float den = ((const LAS float*)(L + DENT))[p] + ((const LAS float*)(L + DENT))[64 + p];
              const float inv = 1.f / fmaxf(fabsf(den), T[192 + p]);
              const size_t m = rowbase + TOF(c, p);
#pragma unroll
              for (int i = 0; i < 2; ++i) { const int et = 2 * wg + i; v2u o; o.x = pk2(O[i][0] * inv, O[i][1] * inv); o.y = pk2(O[i][2] * inv, O[i][3] * inv);
                  *(v2u*)(H + m * DM + h * 256 + es * 64 + 16 * et + 4 * fq) = o; } }
            { const float decay = T[320];
              const bf16x8 vw0 = *(const LAS bf16x8*)(L + VWT + cur * 9216 + (16 * pt + fr) * VST + (8 * fq) * 2);
              const bf16x8 vw1 = *(const LAS bf16x8*)(L + VWT + cur * 9216 + (16 * pt + fr) * VST + (32 + 8 * fq) * 2);
              const int l16 = lane & 15, q4 = l16 >> 2, p4 = l16 & 3;
              const unsigned kb = (unsigned)(uintptr_t)(L + KS) + (unsigned)((8 * fq + q4) * KST + 4 * p4 * 2);
#pragma unroll
              for (int dtl = 0; dtl < 8; ++dtl) { const int dt = 8 * wg + dtl; const unsigned a0 = kb + dt * 32;
                  const bf16x8 k0 = tr_read_pair(a0, a0 + 4 * KST), k1 = tr_read_pair(a0 + 32 * KST, a0 + 36 * KST);
                  Cacc[dtl] = Cacc[dtl] * decay;
                  Cacc[dtl] = __builtin_amdgcn_mfma_f32_16x16x32_bf16(k0, vw0, Cacc[dtl], 0, 0, 0);
                  Cacc[dtl] = __builtin_amdgcn_mfma_f32_16x16x32_bf16(k1, vw1, Cacc[dtl], 0, 0, 0); } }
            { const int d = tid & 255, hf2 = tid >> 8; float np = 0.f;
#pragma unroll 8
              for (int s2 = 0; s2 < 32; ++s2) { const int s_ = hf2 * 32 + s2; np += T[256 + s_] * bf2f(*(const LAS bf16*)(L + KS + s_ * KST + d * 2)); }
              ((LAS float*)(L + NPART))[hf2 * 256 + d] = np; }
            __syncthreads();
            { const float decay = T[320];
#pragma unroll
              for (int dtl = 0; dtl < 8; ++dtl) { const int dt = 8 * wg + dtl; v2u o; o.x = pk2(Cacc[dtl][0], Cacc[dtl][1]); o.y = pk2(Cacc[dtl][2], Cacc[dtl][3]);
                  *(LAS v2u*)(L + CTI + (16 * pt + fr) * KST + (16 * dt + 4 * fq) * 2) = o; }
              if (tid < 256) { LAS float* nt = (LAS float*)(L + NT); const LAS float* np = (const LAS float*)(L + NPART); nt[tid] = decay * nt[tid] + np[tid] + np[256 + tid]; } }
            if (has_next) STORE_KV(nxt);
            __syncthreads();
        }
#undef TOF
#undef G1_TABLES
#undef LOAD_KV
#undef STORE_KV
#undef LOAD_Q
    }
}

__device__ __forceinline__ void ym_phase(Frame& F) {
    const bf16* HF = (const bf16*)(F.ws + WS_XM); const bf16* HB = (const bf16*)(F.ws + WS_XL); bf16* OP = (bf16*)(F.ws + WS_OP);
    const float* ng = F.in[9];
    const int gw = F.bid * NWAVES + F.wave, NGW = F.G * NWAVES;
    for (int m = gw; m < MTOK; m += NGW) {
#pragma unroll
        for (int hd = 0; hd < 4; ++hd) {
            const size_t o = (size_t)m * DM + hd * 256 + F.lane * 4;
            const v2u a = *(const v2u*)(HF + o), b = *(const v2u*)(HB + o), op = *(const v2u*)(OP + o);
            const float v0 = bflo(a.x) + bflo(b.x), v1 = bfhi(a.x) + bfhi(b.x), v2 = bflo(a.y) + bflo(b.y), v3 = bfhi(a.y) + bfhi(b.y);
            const float r = rsqrtf(wave_sum((v0 * v0 + v1 * v1) + (v2 * v2 + v3 * v3)) * (1.f / 256.f) + EPS);
            const f32x4 g = *(const f32x4*)(ng + hd * 256 + F.lane * 4);
            v2u w; w.x = pk2(sigmoidf_(bflo(op.x)) * v0 * r * g[0], sigmoidf_(bfhi(op.x)) * v1 * r * g[1]);
            w.y = pk2(sigmoidf_(bflo(op.y)) * v2 * r * g[2], sigmoidf_(bfhi(op.y)) * v3 * r * g[3]);
            *(v2u*)(OP + o) = w;
        }
    }
    const int gt = F.bid * NTHR + F.tid, NGT = F.G * NTHR;
    const f32x4* us = (const f32x4*)F.in[23]; const f32x4* vs = (const f32x4*)F.in[24];
    v2u* ud = (v2u*)(F.ws + WS_LG); v2u* vd = (v2u*)(F.ws + WS_LG + 32 * MiB);
    for (int i = gt; i < NEXP * DM / 4; i += NGT) {
        const f32x4 a = us[i], b = vs[i];
        v2u o; o.x = pk2(a[0], a[1]); o.y = pk2(a[2], a[3]); ud[i] = o;
        v2u p; p.x = pk2(b[0], b[1]); p.y = pk2(b[2], b[3]); vd[i] = p;
    }
}

__device__ __forceinline__ void select_ref(Frame& F) {
    const bf16* PQ = (const bf16*)(F.ws + WS_MG); const bf16* KEYS = (const bf16*)(F.ws + WS_KEYS);
    int* IDX = (int*)(F.ws + WS_K); float* GW = (float*)(F.ws + WS_K + 16 * MiB);
    LAS float* base = (LAS float*)(F.lds + F.wave * 2048);
    LAS float* sq = base;
    LAS float* sl = base + 256;
    LAS int* il = (LAS int*)(base + 288);
    LAS float* sbest = base + 320;
    LAS int* spos = (LAS int*)(base + 336);
    const int lane = F.lane;
    const int gw = F.bid * NWAVES + F.wave, NGW = F.G * NWAVES;
    for (int it = gw; it < MTOK * 8; it += NGW) {
        const int t = it >> 3, h = it & 7;
        { const v2u q4 = *(const v2u*)(PQ + (size_t)t * 2048 + h * 256 + lane * 4);
          sq[lane * 4 + 0] = bflo(q4.x); sq[lane * 4 + 1] = bfhi(q4.x); sq[lane * 4 + 2] = bflo(q4.y); sq[lane * 4 + 3] = bfhi(q4.y); }
        LDS_WAIT();
        for (int p = 0; p < 2; ++p) {
            float v0 = 0.f, v1 = 0.f;
            const v4u* k0 = (const v4u*)(KEYS + ((size_t)(h * 2 + p) * 128 + lane) * 128);
            const v4u* k1 = k0 + 64 * 16;
#pragma unroll 4
            for (int c8 = 0; c8 < 16; ++c8) {
                const v4u a = k0[c8], b = k1[c8];
                const f32x4 q0 = *(const LAS f32x4*)(sq + p * 128 + c8 * 8), q1 = *(const LAS f32x4*)(sq + p * 128 + c8 * 8 + 4);
                v0 += q0[0] * bflo(a.x) + q0[1] * bfhi(a.x) + q0[2] * bflo(a.y) + q0[3] * bfhi(a.y) + q1[0] * bflo(a.z) + q1[1] * bfhi(a.z) + q1[2] * bflo(a.w) + q1[3] * bfhi(a.w);
                v1 += q0[0] * bflo(b.x) + q0[1] * bfhi(b.x) + q0[2] * bflo(b.y) + q0[3] * bfhi(b.y) + q1[0] * bflo(b.z) + q1[1] * bfhi(b.z) + q1[2] * bflo(b.w) + q1[3] * bfhi(b.w);
            }
            for (int k = 0; k < 16; ++k) {
                float bv; int bi;
                if (v0 >= v1) { bv = v0; bi = lane; } else { bv = v1; bi = lane + 64; }
#pragma unroll
                for (int off = 32; off >= 1; off >>= 1) {
                    const float ov = __shfl_xor(bv, off); const int oi = __shfl_xor(bi, off);
                    if (ov > bv || (ov == bv && oi < bi)) { bv = ov; bi = oi; }
                }
                if (lane == 0) { sl[p * 16 + k] = bv; il[p * 16 + k] = bi; }
                if (bi == lane) v0 = -INFINITY;
                if (bi == lane + 64) v1 = -INFINITY;
            }
        }
        LDS_WAIT();
        float cv[4];
#pragma unroll
        for (int r = 0; r < 4; ++r) { const int pos = lane + 64 * r; cv[r] = sl[pos >> 4] + sl[16 + (pos & 15)]; }
        for (int k = 0; k < 16; ++k) {
            float bv = cv[0]; int bi = lane;
#pragma unroll
            for (int r = 1; r < 4; ++r) if (cv[r] > bv) { bv = cv[r]; bi = lane + 64 * r; }
#pragma unroll
            for (int off = 32; off >= 1; off >>= 1) {
                const float ov = __shfl_xor(bv, off); const int oi = __shfl_xor(bi, off);
                if (ov > bv || (ov == bv && oi < bi)) { bv = ov; bi = oi; }
            }
            if (lane == 0) { sbest[k] = bv; spos[k] = bi; }
#pragma unroll
            for (int r = 0; r < 4; ++r) if (bi == lane + 64 * r) cv[r] = -INFINITY;
        }
        LDS_WAIT();
        if (lane < 16) {
            const float mx = sbest[0];
            float sum = 0.f;
            for (int k = 0; k < 16; ++k) sum += __expf(sbest[k] - mx);
            const int pos = spos[lane];
            IDX[(size_t)t * 128 + h * 16 + lane] = il[pos >> 4] * 128 + il[16 + (pos & 15)];
            GW[(size_t)t * 128 + h * 16 + lane] = __expf(sbest[lane] - mx) / sum;
        }
        LDS_WAIT();
    }
}


typedef float f32x16 __attribute__((ext_vector_type(16)));
#define TOPK_INSERT(L, xv) do { const float x_ = (xv); \
    L[15] = __builtin_amdgcn_fmed3f(L[14], L[15], x_); L[14] = __builtin_amdgcn_fmed3f(L[13], L[14], x_); L[13] = __builtin_amdgcn_fmed3f(L[12], L[13], x_); L[12] = __builtin_amdgcn_fmed3f(L[11], L[12], x_); \
    L[11] = __builtin_amdgcn_fmed3f(L[10], L[11], x_); L[10] = __builtin_amdgcn_fmed3f(L[9], L[10], x_); L[9] = __builtin_amdgcn_fmed3f(L[8], L[9], x_); L[8] = __builtin_amdgcn_fmed3f(L[7], L[8], x_); \
    L[7] = __builtin_amdgcn_fmed3f(L[6], L[7], x_); L[6] = __builtin_amdgcn_fmed3f(L[5], L[6], x_); L[5] = __builtin_amdgcn_fmed3f(L[4], L[5], x_); L[4] = __builtin_amdgcn_fmed3f(L[3], L[4], x_); \
    L[3] = __builtin_amdgcn_fmed3f(L[2], L[3], x_); L[2] = __builtin_amdgcn_fmed3f(L[1], L[2], x_); L[1] = __builtin_amdgcn_fmed3f(L[0], L[1], x_); L[0] = fmaxf(L[0], x_); } while (0)
template <int I> struct CandRow {
    static __device__ __forceinline__ void run(const float (&L0)[16], const float (&L1)[16], float (&R)[16]) {
        constexpr int NJ = 16 / (I + 1);
#pragma unroll
        for (int j = 0; j < NJ; ++j) { const float sm = L0[I] + L1[j];
            const float pk = __builtin_bit_cast(float, (__builtin_bit_cast(unsigned, sm) & 0xffffff00u) | (unsigned)(I * 16 + j)); TOPK_INSERT(R, pk); }
        if constexpr (I < 15) CandRow<I + 1>::run(L0, L1, R);
    }
};
__device__ __forceinline__ unsigned pick4(unsigned d0, unsigned d1, unsigned d2, unsigned d3, int i) {
    const int q = i >> 2; unsigned d = d0; d = (q == 1) ? d1 : d; d = (q == 2) ? d2 : d; d = (q == 3) ? d3 : d; return (d >> (8 * (i & 3))) & 127u;
}
__device__ __forceinline__ void select_phase(Frame& F) {
    const bf16* PQ = (const bf16*)(F.ws + WS_MG); const bf16* KEYS = (const bf16*)(F.ws + WS_KEYS);
    int* IDX = (int*)(F.ws + WS_K); float* GW = (float*)(F.ws + WS_K + 16 * MiB);
    LAS unsigned char* L = F.lds;
    const int tid = F.tid, lane = F.lane, w = F.wave, l31 = lane & 31, hh = lane >> 5;
    const float NEG_INF = -INFINITY;
    for (int grp = F.bid; grp < MTOK / 128; grp += F.G) {
        const int tb = grp * 4 + (w & 3);
        const size_t m = (size_t)tb * 32 + l31;
        for (int hp = 0; hp < 4; ++hp) {
            __syncthreads();
#pragma unroll 4
            for (int r = 0; r < 16; ++r) { const int e = tid + NTHR * r, R = e >> 4, c = e & 15;
                *(LAS v4u*)(L + R * 256 + ((c ^ (R & 15)) * 16)) = *(const v4u*)(KEYS + ((size_t)(hp * 512 + R) * 128 + c * 8)); }
            __syncthreads();
            const int hl = w >> 2, h = 2 * hp + hl;
            float L0[16], L1[16];
#pragma unroll
            for (int p = 0; p < 2; ++p) {
                bf16x8 qf[8];
#pragma unroll
                for (int ks = 0; ks < 8; ++ks) qf[ks] = *(const bf16x8*)(PQ + m * 2048 + h * 256 + p * 128 + 16 * ks + 8 * hh);
                f32x16 acc[4];
#pragma unroll
                for (int kb = 0; kb < 4; ++kb)
#pragma unroll
                    for (int r = 0; r < 16; ++r) acc[kb][r] = 0.f;
#pragma unroll
                for (int ks = 0; ks < 8; ++ks)
#pragma unroll
                    for (int kb = 0; kb < 4; ++kb) { const int R = (hl * 2 + p) * 128 + 32 * kb + l31;
                        const bf16x8 kf = *(const LAS bf16x8*)(L + R * 256 + (((2 * ks + hh) ^ (lane & 15)) * 16));
                        acc[kb] = __builtin_amdgcn_mfma_f32_32x32x16_bf16(kf, qf[ks], acc[kb], 0, 0, 0); }
                float Lc[16];
#pragma unroll
                for (int i = 0; i < 16; ++i) Lc[i] = NEG_INF;
                const unsigned hh4 = (unsigned)hh << 2;
#pragma unroll
                for (int kb = 0; kb < 4; ++kb)
#pragma unroll
                    for (int r = 0; r < 16; ++r) { const unsigned nlo = (unsigned)(32 * kb + (r & 3) + 8 * (r >> 2));
                        const float av_ = acc[kb][r];
                        const float pk = __uint_as_float(((__float_as_uint(av_) & 0xffffff80u) | hh4) | nlo); TOPK_INSERT(Lc, pk); }
                float Lo[16];
#pragma unroll
                for (int i = 0; i < 16; ++i) Lo[i] = __shfl_xor(Lc[i], 32);
#pragma unroll
                for (int i = 0; i < 16; ++i) TOPK_INSERT(Lc, Lo[i]);
#pragma unroll
                for (int i = 0; i < 16; ++i) { if (p == 0) L0[i] = Lc[i]; else L1[i] = Lc[i]; }
            }
            float R[16];
#pragma unroll
            for (int i = 0; i < 16; ++i) R[i] = NEG_INF;
            CandRow<0>::run(L0, L1, R);
            unsigned a0 = 0, a1 = 0, a2 = 0, a3 = 0, b0 = 0, b1 = 0, b2 = 0, b3 = 0;
#pragma unroll
            for (int i = 0; i < 4; ++i) { a0 |= (__builtin_bit_cast(unsigned, L0[i]) & 127u) << (8 * i); a1 |= (__builtin_bit_cast(unsigned, L0[4 + i]) & 127u) << (8 * i);
                a2 |= (__builtin_bit_cast(unsigned, L0[8 + i]) & 127u) << (8 * i); a3 |= (__builtin_bit_cast(unsigned, L0[12 + i]) & 127u) << (8 * i);
                b0 |= (__builtin_bit_cast(unsigned, L1[i]) & 127u) << (8 * i); b1 |= (__builtin_bit_cast(unsigned, L1[4 + i]) & 127u) << (8 * i);
                b2 |= (__builtin_bit_cast(unsigned, L1[8 + i]) & 127u) << (8 * i); b3 |= (__builtin_bit_cast(unsigned, L1[12 + i]) & 127u) << (8 * i); }
            float ex[16]; float sum = 0.f; int id[16];
#pragma unroll
            for (int r = 0; r < 16; ++r) { ex[r] = __expf(R[r] - R[0]); sum += ex[r];
                const unsigned cid = __builtin_bit_cast(unsigned, R[r]) & 255u;
                id[r] = (int)(pick4(a0, a1, a2, a3, (int)(cid >> 4)) * 128u + pick4(b0, b1, b2, b3, (int)(cid & 15u))); }
            const float inv = 1.f / sum;
            if (hh == 0) {
#pragma unroll
                for (int q = 0; q < 4; ++q) {
                    *(int4*)(IDX + m * 128 + h * 16 + 4 * q) = make_int4(id[4 * q], id[4 * q + 1], id[4 * q + 2], id[4 * q + 3]);
                    *(f32x4*)(GW + m * 128 + h * 16 + 4 * q) = (f32x4){ex[4 * q] * inv, ex[4 * q + 1] * inv, ex[4 * q + 2] * inv, ex[4 * q + 3] * inv}; }
            }
        }
    }
}

typedef __bf16 bf2_t __attribute__((ext_vector_type(2)));
__device__ __forceinline__ float dot2bf(unsigned a, unsigned b, float c) { return __builtin_amdgcn_fdot2_f32_bf16(__builtin_bit_cast(bf2_t, a), __builtin_bit_cast(bf2_t, b), c, false); }
__device__ __forceinline__ void apply_phase(Frame& F) {
    const bf16* UT = (const bf16*)(F.ws + WS_LG); const bf16* VT = (const bf16*)(F.ws + WS_LG + 32 * MiB);
    const int* IDX = (const int*)(F.ws + WS_K); const float* GW = (const float*)(F.ws + WS_K + 16 * MiB);
    const float* g2 = F.in[20]; const float* gf = F.in[25];
    float* X1 = F.out;
    const int lane = F.lane;
    const int gw = F.bid * NWAVES + F.wave, NGW = F.G * NWAVES;
    const bool b5 = (lane & 32) != 0, b4 = (lane & 16) != 0, b3 = (lane & 8) != 0;
    const int eid = ((lane >> 5) & 1) * 4 + ((lane >> 4) & 1) * 2 + ((lane >> 3) & 1);
    for (int m = gw; m < MTOK; m += NGW) {
        float xr[16]; float s = 0.f;
#pragma unroll
        for (int q = 0; q < 4; ++q) { const int c = (q >> 1) * 512 + lane * 8 + (q & 1) * 4; const f32x4 a = *(const f32x4*)(X1 + (size_t)m * DM + c);
#pragma unroll
            for (int e = 0; e < 4; ++e) { xr[q * 4 + e] = a[e]; s += a[e] * a[e]; } }
        const float r2 = rsqrtf(wave_sum(s) * (1.f / DM) + EPS);
        unsigned hp[8];
#pragma unroll
        for (int q = 0; q < 4; ++q) { const int c = (q >> 1) * 512 + lane * 8 + (q & 1) * 4; const f32x4 g = *(const f32x4*)(g2 + c);
            hp[q * 2] = pk2(xr[q * 4] * r2 * g[0], xr[q * 4 + 1] * r2 * g[1]); hp[q * 2 + 1] = pk2(xr[q * 4 + 2] * r2 * g[2], xr[q * 4 + 3] * r2 * g[3]); }
        const int i0 = IDX[(size_t)m * 128 + lane], i1 = IDX[(size_t)m * 128 + 64 + lane];
        const float gw0 = GW[(size_t)m * 128 + lane], gw1 = GW[(size_t)m * 128 + 64 + lane];
        float acc[16];
#pragma unroll
        for (int i = 0; i < 16; ++i) acc[i] = 0.f;
#pragma unroll 1
        for (int bt = 0; bt < 16; ++bt) {
            const int k0 = bt * 8;
            const int isel = (k0 < 64) ? i0 : i1;
            v4u ua[8], ub[8], va[8], vb[8];
            int idx[8];
#pragma unroll
            for (int e = 0; e < 8; ++e) idx[e] = __builtin_amdgcn_readlane(isel, (k0 + e) & 63);
#pragma unroll
            for (int e = 0; e < 8; ++e) { const bf16* ur = UT + (size_t)idx[e] * DM + lane * 8; ua[e] = *(const v4u*)ur; ub[e] = *(const v4u*)(ur + 512); }
#pragma unroll
            for (int e = 0; e < 8; ++e) { const bf16* vr = VT + (size_t)idx[e] * DM + lane * 8; va[e] = *(const v4u*)vr; vb[e] = *(const v4u*)(vr + 512); }
            float x[8];
#pragma unroll
            for (int e = 0; e < 8; ++e) { float d = dot2bf(ua[e].x, hp[0], 0.f); d = dot2bf(ua[e].y, hp[1], d); d = dot2bf(ua[e].z, hp[2], d); d = dot2bf(ua[e].w, hp[3], d);
                d = dot2bf(ub[e].x, hp[4], d); d = dot2bf(ub[e].y, hp[5], d); d = dot2bf(ub[e].z, hp[6], d); d = dot2bf(ub[e].w, hp[7], d); x[e] = d; }
            float y[4], z[2], t;
#pragma unroll
            for (int j = 0; j < 4; ++j) { const float keep = b5 ? x[4 + j] : x[j], send = b5 ? x[j] : x[4 + j]; y[j] = keep + __shfl_xor(send, 32); }
#pragma unroll
            for (int j = 0; j < 2; ++j) { const float keep = b4 ? y[2 + j] : y[j], send = b4 ? y[j] : y[2 + j]; z[j] = keep + __shfl_xor(send, 16); }
            { const float keep = b3 ? z[1] : z[0], send = b3 ? z[0] : z[1]; t = keep + __shfl_xor(send, 8); }
            t += __shfl_xor(t, 4); t += __shfl_xor(t, 2); t += __shfl_xor(t, 1);
            const float gk = __shfl((k0 < 64) ? gw0 : gw1, (k0 + eid) & 63);
            const float wl = gk * gelu_fast(t);
            float wv[8];
#pragma unroll
            for (int e = 0; e < 8; ++e) wv[e] = __builtin_bit_cast(float, __builtin_amdgcn_readlane(__builtin_bit_cast(int, wl), 32 * (e >> 2) + 16 * ((e >> 1) & 1) + 8 * (e & 1)));
#pragma unroll
            for (int e = 0; e < 8; e += 2) {
                const unsigned wp = pk2(wv[e], wv[e + 1]);
                const unsigned A[8] = {va[e].x, va[e].y, va[e].z, va[e].w, vb[e].x, vb[e].y, vb[e].z, vb[e].w};
                const unsigned B[8] = {va[e + 1].x, va[e + 1].y, va[e + 1].z, va[e + 1].w, vb[e + 1].x, vb[e + 1].y, vb[e + 1].z, vb[e + 1].w};
#pragma unroll
                for (int j = 0; j < 8; ++j) {
                    const unsigned lo = __builtin_amdgcn_perm(B[j], A[j], 0x05040100u);
                    const unsigned hi = __builtin_amdgcn_perm(B[j], A[j], 0x07060302u);
                    acc[2 * j] = dot2bf(lo, wp, acc[2 * j]); acc[2 * j + 1] = dot2bf(hi, wp, acc[2 * j + 1]);
                }
            }
        }
        float s2 = 0.f;
#pragma unroll
        for (int i = 0; i < 16; ++i) { acc[i] += xr[i]; s2 += acc[i] * acc[i]; }
        const float rf = rsqrtf(wave_sum(s2) * (1.f / DM) + EPS);
#pragma unroll
        for (int q = 0; q < 4; ++q) { const int c = (q >> 1) * 512 + lane * 8 + (q & 1) * 4; const f32x4 g = *(const f32x4*)(gf + c);
            f32x4 o;
#pragma unroll
            for (int e = 0; e < 4; ++e) o[e] = acc[q * 4 + e] * rf * g[e];
            *(f32x4*)(X1 + (size_t)m * DM + c) = o; }
    }
}

constexpr int N_PHASES = 13;
__global__ void __launch_bounds__(NTHR, 2) mega_fwd(Args args) {
    extern __shared__ __attribute__((aligned(16))) unsigned char lds[];
    Frame F;
    F.lds = (LAS unsigned char*)lds;
    F.tid = threadIdx.x; F.lane = F.tid & 63; F.wave = __builtin_amdgcn_readfirstlane(F.tid >> 6);
    F.G = gridDim.x; F.bid = blockIdx.x;
    F.in = args.in; F.out = args.out; F.ws = args.ws;
    volatile LAS unsigned* MISC = (volatile LAS unsigned*)(F.lds + MISC_OFF);
    for (int u = F.tid; u < (LDS_BYTES - LDSCTL_OFF) / 4; u += NTHR) ((LAS unsigned*)(F.lds + LDSCTL_OFF))[u] = 0u;
    __syncthreads();
    XcdBarrier bar; bar.bar = (unsigned*)(args.ws + WS_CTL) + CW_BAR; bar.x = 0; bar.st = nullptr;
    const bool one_launch = (args.ph_hi - args.ph_lo) > 1;
    if (one_launch) bar = xcd_barrier_post((unsigned*)(args.ws + WS_CTL) + CW_BAR, MISC + 8);
    const int lo = args.ph_lo, hi = args.ph_hi;
#define IN(k) (lo <= (k) && (k) < hi)
#define SEAM(k) do { if (IN(k) && IN((k) + 1)) xcd_barrier(bar); } while (0)
    unsigned char* ws = args.ws;

    if (IN(0)) { p0_prologue(F); } SEAM(0);
    if (IN(1)) {
        AddrPlain g{(const char*)F.out, (const char*)(ws + WS_WIN), 1024, 1024, 1024};
        pg8::StaticOrder S; S.init(MTOK, 6144, F.G, F.bid);
        EpiBf16<DstP1> E{DstP1{ws}};
        pg8::gemm_phase(F.lds, g, S, E);
    } SEAM(1);
    if (IN(2)) { lru_phase<false>(F); } SEAM(2);
    if (IN(3)) { lru_phase<true>(F); } SEAM(3);
    if (IN(4)) { mconv_phase(F); } SEAM(4);
    if (IN(5)) {
        AddrQKV g{(const char*)(ws + WS_XL), (long)WS_XM - (long)WS_XL, (const char*)(ws + WS_WQKV), 1024, 256, 256};
        pg8::StaticOrder S; S.init(MTOK, 12 * 256, F.G, F.bid);
        EpiBf16<DstQKV> E{DstQKV{(char*)(ws + WS_LG), (long)WS_K - (long)WS_LG, (long)((char*)F.out + (size_t)MTOK * DM * 2 - (char*)(ws + WS_LG))}};
        pg8::gemm_phase(F.lds, g, S, E);
    } SEAM(5);
    if (IN(6)) { mscan_phase(F); } SEAM(6);
    if (IN(7)) { ym_phase(F); } SEAM(7);
    if (IN(8)) {
        AddrBranch g{(const char*)(ws + WS_OP), (long)((const char*)F.out - (const char*)(ws + WS_OP)), (const char*)(ws + WS_WB2), 1024, 1024, 1024};
        pg8::StaticOrder S; S.init(MTOK, 2048, F.G, F.bid);
        EpiGate E{(bf16*)(ws + WS_MG)};
        pg8::gemm_phase(F.lds, g, S, E);
    } SEAM(8);
    if (IN(9)) {
        AddrPlain g{(const char*)(ws + WS_MG), (const char*)(ws + WS_WOUT2), 2048, 2048, 2048};
        pg8::StaticOrder S; S.init(MTOK, 1024, F.G, F.bid);
        EpiResid E{F.in[0], F.out, (bf16*)(ws + WS_XM), (float*)(ws + WS_SS)};
        pg8::gemm_phase(F.lds, g, S, E);
    } SEAM(9);
    if (IN(10)) {
        AddrPlain g{(const char*)(ws + WS_XM), (const char*)(ws + WS_WPQ), 1024, 1024, 1024};
        pg8::StaticOrder S; S.init(MTOK, 2048, F.G, F.bid);
        EpiPQ E{(bf16*)(ws + WS_MG), (const float*)(ws + WS_SS)};
        pg8::gemm_phase(F.lds, g, S, E);
    } SEAM(10);
    if (IN(11)) { select_phase(F); } SEAM(11);
    if (IN(12)) { apply_phase(F); }
#undef IN
#undef SEAM
}

extern "C" void kernel_launch(void* const* d_in, const int* in_sizes, int n_in, void* d_out, int out_size, void* d_ws, size_t ws_size, hipStream_t stream) {
    static int grid = 0;
    if (grid == 0) {
        if (n_in != 26 || in_sizes[0] != MTOK * DM || out_size != MTOK * DM || ws_size < WS_END) { fprintf(stderr, "kernel_launch: unexpected shapes / workspace (%zu < %zu)\n", ws_size, (size_t)WS_END); grid = -1; return; }
        int dev = 0, cus = 0, per_cu = 0;
        if (hipGetDevice(&dev) != hipSuccess || hipDeviceGetAttribute(&cus, hipDeviceAttributeMultiprocessorCount, dev) != hipSuccess) { grid = -1; return; }
        if (hipFuncSetAttribute((const void*)mega_fwd, hipFuncAttributeMaxDynamicSharedMemorySize, LDS_BYTES) != hipSuccess) { fprintf(stderr, "kernel_launch: hipFuncSetAttribute failed\n"); grid = -1; return; }
        if (hipOccupancyMaxActiveBlocksPerMultiprocessor(&per_cu, (const void*)mega_fwd, NTHR, LDS_BYTES) != hipSuccess || per_cu < 1) { fprintf(stderr, "kernel_launch: occupancy query says %d blocks/CU\n", per_cu); (void)hipGetLastError(); grid = -1; return; }
        grid = cus;
    }
    if (grid < 0) return;
    (void)hipMemsetAsync((char*)d_ws + WS_CTL, 0, CTL_ZERO_BYTES, stream);
    Args a{};
    for (int i = 0; i < 26; ++i) a.in[i] = (const float*)d_in[i];
    a.out = (float*)d_out; a.ws = (unsigned char*)d_ws;
#if MK_N_LAUNCHES == 1
    a.ph_lo = 0; a.ph_hi = N_PHASES;
    void* kargs[] = {&a};
    hipError_t e = hipLaunchCooperativeKernel((const void*)mega_fwd, dim3(grid), dim3(NTHR), kargs, LDS_BYTES, stream);
    if (e != hipSuccess) fprintf(stderr, "kernel_launch: cooperative launch failed: %s (grid %d)\n", hipGetErrorString(e), grid);
#else
    for (int p = 0; p < N_PHASES; ++p) { a.ph_lo = p; a.ph_hi = p + 1; hipLaunchKernelGGL(mega_fwd, dim3(grid), dim3(NTHR), LDS_BYTES, stream, a); }
#endif
}
```

```cpp
#include <hip/hip_runtime.h>
#include <cstdio>
#include <cstdint>
#include <math.h>

#ifndef MK_N_LAUNCHES
#define MK_N_LAUNCHES 1
#endif

constexpr int BATCH = 8, SEQ = 4096, DM = 1024, MTOK = BATCH * SEQ;
constexpr int DIN = 6160;
constexpr int NEXP = 16384;
constexpr float EPS = 1e-6f;

constexpr size_t MiB = 1u << 20;
constexpr size_t WS_CTL = 0, CTL_ZERO_BYTES = 1 * MiB;
constexpr size_t WS_WIN = 1 * MiB;
constexpr size_t WS_WQKV = 13 * MiB;
constexpr size_t WS_KEYS = 14 * MiB + 512 * 1024;
constexpr size_t WS_WLRU = 15 * MiB;
constexpr size_t WS_WB2 = 16 * MiB;
constexpr size_t WS_WOUT2 = 20 * MiB;
constexpr size_t WS_WPQ = 24 * MiB;
constexpr size_t WS_GATE = 28 * MiB;
constexpr size_t WS_XM = 32 * MiB;
constexpr size_t WS_OP = 96 * MiB;
constexpr size_t WS_XL = 160 * MiB;
constexpr size_t WS_LG = 224 * MiB;
constexpr size_t WS_MG = 288 * MiB;
constexpr size_t WS_K = 416 * MiB;
constexpr size_t WS_AGG = 480 * MiB;
constexpr size_t WS_SS = 488 * MiB;
constexpr size_t WS_END = 489 * MiB;

constexpr int CW_BAR = 4096;

constexpr int RING_BYTES = 131072;
constexpr int LDS_BYTES = 147456;
constexpr int LDSCTL_OFF = LDS_BYTES - 512, MISC_OFF = LDSCTL_OFF + 320;
constexpr int NWAVES = 8, NTHR = 512;

#define GAS __attribute__((address_space(1)))
#define LAS __attribute__((address_space(3)))
typedef unsigned short bf16;
typedef unsigned v4u __attribute__((ext_vector_type(4)));
typedef unsigned v2u __attribute__((ext_vector_type(2)));
typedef float f32x4 __attribute__((ext_vector_type(4)));
typedef float f32x2 __attribute__((ext_vector_type(2)));
typedef short bf16x8 __attribute__((ext_vector_type(8)));
typedef GAS unsigned gu32;
#define RLX_AGENT __ATOMIC_RELAXED, __HIP_MEMORY_SCOPE_AGENT
#define LDS_WAIT() asm volatile("s_waitcnt lgkmcnt(0)" ::: "memory")
#define VM_WAIT() asm volatile("s_waitcnt vmcnt(0)" ::: "memory")

__device__ __forceinline__ unsigned f2bf(float f) { unsigned u = __builtin_bit_cast(unsigned, f); return (u + 0x7fffu + ((u >> 16) & 1u)) >> 16; }
__device__ __forceinline__ unsigned pk2(float lo, float hi) { return f2bf(lo) | (f2bf(hi) << 16); }
__device__ __forceinline__ float bf2f(unsigned short h) { return __builtin_bit_cast(float, (unsigned)h << 16); }
__device__ __forceinline__ float bflo(unsigned w) { return __builtin_bit_cast(float, w << 16); }
__device__ __forceinline__ float bfhi(unsigned w) { return __builtin_bit_cast(float, w & 0xffff0000u); }
__device__ __forceinline__ float wave_sum(float v) {
#pragma unroll
  for (int o = 1; o < 64; o <<= 1) v += __shfl_xor(v, o);
  return v;
}
__device__ __forceinline__ float sigmoidf_(float x) { return 1.f / (1.f + __expf(-x)); }
__device__ __forceinline__ float gelu_erf(float x) { return 0.5f * x * (1.f + erff(x * 0.70710678118654752f)); }
__device__ __forceinline__ float gelu_fast(float v) {
    const float av = fabsf(v), t = __builtin_amdgcn_rcpf(av * 0.2316418882f + 1.0f);
    float q = t * 0.5307027145f + (-0.7265760135f); q = q * t + 0.7107068705f; q = q * t + (-0.142248368f); q = q * t + 0.127414796f; q = q * t;
    const float e = __builtin_amdgcn_exp2f((v * v) * (-0.72134752044f));
    const float m = v * (q * e);
    return v < 0.f ? m : v - m;
}
__device__ __forceinline__ float softplusf_(float x) { return fmaxf(x, 0.f) + log1pf(expf(-fabsf(x))); }

namespace pg8 {
#define PG8_LAS __attribute__((address_space(3)))
typedef unsigned short bf16_t;
typedef unsigned u32x4 __attribute__((ext_vector_type(4)));
constexpr int BM = 256, BK = 64, HALF = 128, HTB = HALF * BK * 2, STAGE_BYTES = 8 * HTB, NXCD = 8, WGM = 8;

__host__ __device__ __forceinline__ int lds_byte(int r, int c) { const int st = (r >> 4) * 2 + (c >> 5), rr = r & 15, cc = c & 31, ob = rr * 64 + cc * 2; return st * 1024 + (ob ^ (((ob >> 9) & 1) << 5)); }
__host__ __device__ __forceinline__ void stage_rc(int b, int& R, int& C) { const int st = b / 1024, sb = b % 1024, swz = sb ^ (((sb >> 9) & 1) << 5); R = (st >> 1) * 16 + swz / 64; C = (st & 1) * 32 + (swz % 64) / 2; }
__host__ __device__ __forceinline__ int perm32(int rho) { const int n = rho >> 4, i = rho & 15; return 8 * (i >> 2) + 4 * n + (i & 3); }

struct Unit { int pm, pn; };
struct StaticOrder {
    int nM, nN, nwg, G, c;
    __host__ __device__ void init(int M, int N, int G_, int c_) { nM = M / BM; nN = N / BM; nwg = nM * nN; G = G_; c = c_; }
    __host__ __device__ bool next(int i, Unit& u) const {
        const long L = (long)i * G + c; if (L >= nwg) return false;
        int wgid = (int)L; { const int q = nwg / NXCD, r = nwg % NXCD, xcd = wgid % NXCD, off = wgid / NXCD; wgid = (xcd < r ? xcd * (q + 1) : r * (q + 1) + (xcd - r) * q) + off; }
        const int nig = WGM * nN, gid = wgid / nig, fm = gid * WGM, gsz = (nM - fm) < WGM ? (nM - fm) : WGM;
        u.pm = fm + ((wgid % nig) % gsz); u.pn = (wgid % nig) / gsz; return true;
    }
};

__device__ __forceinline__ unsigned cvt_pk_bf16(float lo, float hi) { unsigned r; asm volatile("v_cvt_pk_bf16_f32 %0, %1, %2" : "=v"(r) : "v"(lo), "v"(hi)); return r; }

template <class Epi, class Addr>
__device__ __forceinline__ void gemm_phase(PG8_LAS unsigned char* lds, const Addr g, const StaticOrder& S, const Epi& E) {
    const int tid = threadIdx.x, wid = __builtin_amdgcn_readfirstlane(tid >> 6), lane = tid & 63, wr = wid >> 2, wc = wid & 3, fr = lane & 15, fq = lane >> 4;
    const int K = g.K, nt = K / BK;
    unsigned voffA[2], voffB[2];
#pragma unroll
    for (int i = 0; i < 2; ++i) { int R, C; stage_rc(tid * 16 + i * 8192, R, C); const int Rb = Epi::PERM ? ((R & ~31) + perm32(R & 31)) : R;
        voffA[i] = (unsigned)(R * g.lda + C) * 2u; voffB[i] = (unsigned)(Rb * g.ldb + C) * 2u; }
    const size_t kstep = (size_t)(BK * 2);
    const size_t hsA = (size_t)HALF * g.lda * 2, hsB = (size_t)HALF * g.ldb * 2;
    const unsigned ldsw = (unsigned)wid * 1024u;
    const int aoff = lds_byte(wr * 64 + fr, fq * 8), boff = lds_byte(wc * 32 + fr, fq * 8);
#define PG8_SA(b, h) (((b) * 2 + (h)) * HTB)
#define PG8_SB(b, h) ((4 + (b) * 2 + (h)) * HTB)
#define PG8_STAGE(bufoff, gbase, voff) do { _Pragma("unroll") for (int _i = 0; _i < 2; ++_i) \
        __builtin_amdgcn_global_load_lds((const unsigned*)((const char*)(gbase) + (voff)[_i]), (PG8_LAS unsigned*)(lds + (bufoff) + ldsw + _i * 8192), 16, 0, 0); } while (0)
#define PG8_LDA(dst, b, h) do { _Pragma("unroll") for (int m = 0; m < 4; ++m) _Pragma("unroll") for (int k = 0; k < 2; ++k) dst[m][k] = *(const PG8_LAS bf16x8*)(lds + PG8_SA(b, h) + aoff + m * 2048 + k * 1024); } while (0)
#define PG8_LDB(dst, b, h) do { _Pragma("unroll") for (int n = 0; n < 2; ++n) _Pragma("unroll") for (int k = 0; k < 2; ++k) dst[n][k] = *(const PG8_LAS bf16x8*)(lds + PG8_SB(b, h) + boff + n * 2048 + k * 1024); } while (0)
#define PG8_MMA(ai, bj, At, Bt) do { __builtin_amdgcn_s_setprio(1); _Pragma("unroll") for (int m = 0; m < 4; ++m) _Pragma("unroll") for (int n = 0; n < 2; ++n) _Pragma("unroll") for (int k = 0; k < 2; ++k) \
        acc[ai][bj][m][n] = __builtin_amdgcn_mfma_f32_16x16x32_bf16(Bt[n][k], At[m][k], acc[ai][bj][m][n], 0, 0, 0); __builtin_amdgcn_s_setprio(0); } while (0)
#define PG8_WAIT_V(n) asm volatile("s_waitcnt vmcnt(" #n ")" ::: "memory")
#define PG8_WAIT_L(n) asm volatile("s_waitcnt lgkmcnt(" #n ")" ::: "memory")
#define PG8_BAR __builtin_amdgcn_s_barrier()
#define PG8_SCHED __builtin_amdgcn_sched_barrier(0)
    Unit cur, nxt; int ui = 0;
    if (!S.next(0, cur)) return;
    f32x4 acc[2][2][4][2];
#pragma unroll
    for (int a = 0; a < 2; ++a)
#pragma unroll
        for (int b = 0; b < 2; ++b)
#pragma unroll
            for (int m = 0; m < 4; ++m)
#pragma unroll
                for (int n = 0; n < 2; ++n) acc[a][b][m][n] = (f32x4){0.f, 0.f, 0.f, 0.f};
    bf16x8 At[4][2], B0[2][2], B1[2][2];
    const char* cA = g.a(cur); const char* cB = g.b(cur);
    PG8_STAGE(PG8_SB(0, 0), cB, voffB); PG8_STAGE(PG8_SB(0, 1), cB + hsB, voffB); PG8_STAGE(PG8_SA(0, 0), cA, voffA); PG8_STAGE(PG8_SA(0, 1), cA + hsA, voffA);
    if (wr == 1) PG8_BAR;
    PG8_WAIT_V(2); PG8_BAR;
    PG8_STAGE(PG8_SB(1, 0), cB + kstep, voffB); PG8_STAGE(PG8_SA(1, 0), cA + kstep, voffA); PG8_STAGE(PG8_SB(1, 1), cB + hsB + kstep, voffB);
    PG8_WAIT_V(6); PG8_BAR;
    for (;;) {
        const bool has_next = S.next(ui + 1, nxt);
        const char* nA = has_next ? g.a(nxt) : cA; const char* nB = has_next ? g.b(nxt) : cB;
#pragma unroll 1
        for (int t = 0; t < nt; t += 2) {
            const bool last = (t == nt - 2);
            const char* a1 = cA + (size_t)(t + 1) * kstep;
            const char* a2 = last ? nA : cA + (size_t)(t + 2) * kstep; const char* b2 = last ? nB : cB + (size_t)(t + 2) * kstep;
            const char* a3 = a2 + kstep; const char* b3 = b2 + kstep;
            PG8_LDB(B0, 0, 0); PG8_LDB(B1, 0, 1); PG8_SCHED; PG8_LDA(At, 0, 0); PG8_STAGE(PG8_SA(1, 1), a1 + hsA, voffA);
            PG8_WAIT_V(8); PG8_WAIT_L(0); PG8_BAR; PG8_MMA(0, 0, At, B0); PG8_MMA(0, 1, At, B1); PG8_BAR; PG8_SCHED;
            PG8_LDA(At, 0, 1); PG8_STAGE(PG8_SB(0, 0), b2, voffB); PG8_STAGE(PG8_SB(0, 1), b2 + hsB, voffB); PG8_STAGE(PG8_SA(0, 0), a2, voffA);
            PG8_WAIT_V(8); PG8_WAIT_L(0); PG8_BAR; PG8_MMA(1, 0, At, B0); PG8_MMA(1, 1, At, B1); PG8_BAR; PG8_SCHED;
            PG8_LDB(B0, 1, 0); PG8_LDB(B1, 1, 1); PG8_SCHED; PG8_LDA(At, 1, 0); PG8_STAGE(PG8_SA(0, 1), a2 + hsA, voffA);
            PG8_WAIT_V(8); PG8_WAIT_L(0); PG8_BAR; PG8_MMA(0, 0, At, B0); PG8_MMA(0, 1, At, B1); PG8_BAR; PG8_SCHED;
            PG8_LDA(At, 1, 1); PG8_STAGE(PG8_SB(1, 0), b3, voffB); PG8_STAGE(PG8_SB(1, 1), b3 + hsB, voffB); PG8_STAGE(PG8_SA(1, 0), a3, voffA);
            PG8_WAIT_V(8); PG8_WAIT_L(0); PG8_BAR; PG8_MMA(1, 0, At, B0); PG8_MMA(1, 1, At, B1); PG8_BAR; PG8_SCHED;
        }
        if (wr == 0) PG8_BAR;
        E(acc, cur, wr, wc, fr, fq);
        if (!has_next) break;
#pragma unroll
        for (int a = 0; a < 2; ++a)
#pragma unroll
            for (int b = 0; b < 2; ++b)
#pragma unroll
                for (int m = 0; m < 4; ++m)
#pragma unroll
                    for (int n = 0; n < 2; ++n) acc[a][b][m][n] = (f32x4){0.f, 0.f, 0.f, 0.f};
        cur = nxt; cA = nA; cB = nB; ++ui;
        if (wr == 1) PG8_BAR;
    }
    PG8_WAIT_V(0);
    PG8_BAR;
#undef PG8_SA
#undef PG8_SB
#undef PG8_STAGE
#undef PG8_LDA
#undef PG8_LDB
#undef PG8_MMA
#undef PG8_WAIT_V
#undef PG8_WAIT_L
#undef PG8_BAR
#undef PG8_SCHED
}
}

#define XB_TMO      128
#define XB_XCNT(j)  (256  + 64 * (j))
#define XB_XSUB(j)  (1280 + 64 * (j))
#define XB_XGEN(j)  (2304 + 64 * (j))
#define XB_TOP      3328
#define XB_TOPGEN   3392
#define XCD_BAR_WORDS 3456
#define XB_SPIN_CAP (1u << 18)
__device__ __forceinline__ unsigned xb_ld(unsigned* p)              { return __hip_atomic_load(p, __ATOMIC_RELAXED, __HIP_MEMORY_SCOPE_AGENT); }
__device__ __forceinline__ unsigned xb_add(unsigned* p, unsigned v) { return __hip_atomic_fetch_add(p, v, __ATOMIC_RELAXED, __HIP_MEMORY_SCOPE_AGENT); }
__device__ __forceinline__ unsigned xb_xcc_id() { return (unsigned)__builtin_amdgcn_s_getreg((3 << 11) | 20) & 0xFu; }
#define XB_SPIN(cond, bar) do { unsigned _sp = 0; while (cond) { __builtin_amdgcn_s_sleep(1); \
    if ((++_sp & 255u) == 0u) { if (xb_ld(&(bar)[XB_TMO])) break; if (_sp > XB_SPIN_CAP) { atomicAdd(&(bar)[XB_TMO], 1u); break; } } } } while (0)
struct XcdBarrier { unsigned* bar; unsigned x; volatile LAS unsigned* st; };
__device__ __forceinline__ XcdBarrier xcd_barrier_post(unsigned* bar, volatile LAS unsigned* st) {
    XcdBarrier b; b.bar = bar; b.x = xb_xcc_id(); b.st = st;
    if (threadIdx.x == 0) (void)xb_add(&bar[XB_XCNT(b.x)], 1u);
    return b;
}
__device__ __forceinline__ void xcd_barrier_complete(unsigned* bar, unsigned x, unsigned& nloc, unsigned& nx) {
    const unsigned G = gridDim.x * gridDim.y * gridDim.z;
    unsigned sum, cnt, mine, sp = 0u;
    for (;;) {
        sum = 0u; cnt = 0u; mine = 0u;
#pragma unroll
        for (unsigned j = 0; j < 16; ++j) { const unsigned c = xb_ld(&bar[XB_XCNT(j)]); sum += c; cnt += (c > 0u) ? 1u : 0u; mine = (j == x) ? c : mine; }
        if (sum == G) break;
        __builtin_amdgcn_s_sleep(1);
        if ((++sp & 255u) == 0u) { if (xb_ld(&bar[XB_TMO])) break; if (sp > XB_SPIN_CAP) { atomicAdd(&bar[XB_TMO], 1u); break; } }
    }
    nloc = mine > 0u ? mine : 1u; nx = cnt > 0u ? cnt : 1u;
}
__device__ __forceinline__ void xcd_barrier(const XcdBarrier& b) {
    asm volatile("s_waitcnt vmcnt(0)" ::: "memory");
    __syncthreads();
    if (threadIdx.x == 0) {
        unsigned* bar = b.bar;
        __builtin_amdgcn_s_waitcnt(0);
        unsigned nloc = b.st[0], nx = b.st[1];
        if (nloc == 0u) { xcd_barrier_complete(bar, b.x, nloc, nx); b.st[0] = nloc; b.st[1] = nx; }
        const unsigned old = xb_add(&bar[XB_XSUB(b.x)], 1u);
        const unsigned gen = old / nloc;
        if (old + 1u == (gen + 1u) * nloc) {
            __builtin_amdgcn_fence(__ATOMIC_RELEASE, "agent");
            asm volatile("s_waitcnt vmcnt(0)" ::: "memory");
            const unsigned og = xb_add(&bar[XB_TOP], 1u);
            const unsigned tg = og / nx;
            if (og + 1u == (tg + 1u) * nx) xb_add(&bar[XB_TOPGEN], 1u);
            else XB_SPIN(xb_ld(&bar[XB_TOPGEN]) == tg, bar);
            __builtin_amdgcn_fence(__ATOMIC_ACQUIRE, "agent");
            xb_add(&bar[XB_XGEN(b.x)], 1u);
            asm volatile("s_waitcnt vmcnt(0)" ::: "memory");
        } else {
            XB_SPIN(xb_ld(&bar[XB_XGEN(b.x)]) == gen, bar);
            __builtin_amdgcn_fence(__ATOMIC_ACQUIRE, "agent");
            asm volatile("s_waitcnt vmcnt(0)" ::: "memory");
        }
    }
    __syncthreads();
}

struct Args { const float* in[26]; float* out; unsigned char* ws; int ph_lo, ph_hi; };
struct Frame {
    LAS unsigned char* lds;
    int tid, lane, wave, G, bid;
    const float* const* in; float* out; unsigned char* ws;
};

__device__ __forceinline__ void tr_item(const float* W, int ldw, bf16* WT, int ldt, float scale, const float* kscale, LAS float* scr, int k0, int lane) {
#pragma unroll 8
    for (int i = 0; i < 32; ++i) { const int kk = 2 * i + (lane >> 5); float v = W[(size_t)(k0 + kk) * ldw + (lane & 31)] * scale; if (kscale) v *= kscale[k0 + kk]; scr[kk * 33 + (lane & 31)] = v; }
    LDS_WAIT(); asm volatile("" ::: "memory");
    const int c = lane & 7;
#pragma unroll
    for (int j = 0; j < 4; ++j) { const int n = (lane >> 3) + 8 * j; const LAS float* s = scr + (8 * c) * 33 + n;
        v4u o; o.x = pk2(s[0 * 33], s[1 * 33]); o.y = pk2(s[2 * 33], s[3 * 33]); o.z = pk2(s[4 * 33], s[5 * 33]); o.w = pk2(s[6 * 33], s[7 * 33]);
        *(GAS v4u*)(WT + (size_t)n * ldt + k0 + 8 * c) = o; }
    LDS_WAIT(); asm volatile("" ::: "memory");
}

__device__ __forceinline__ void p0_prologue(Frame& F) {
    LAS float* scr = (LAS float*)(F.lds + F.wave * 16384);
    const int gw = F.bid * NWAVES + F.wave, NGW = F.G * NWAVES;
    unsigned char* ws = F.ws;
    const float* w_in = F.in[2];
    constexpr int I_WIN = 16 * 192, I_QKV = 12 * 32, I_LRU = 32 * 8, I_WB = 2 * 512, I_WO = 2 * 512, I_PQ = 16 * 64;
    constexpr int NITEMS = I_WIN + I_QKV + I_LRU + I_WB + I_WO + I_PQ;
    for (int it = gw; it < NITEMS; it += NGW) {
        int r = it;
        if (r < I_WIN) { const int kb = r / 192, nb = r % 192, n0 = nb * 32, sc = n0 < 2048 ? n0 : n0 + 16;
            tr_item(w_in + sc, DIN, (bf16*)(ws + WS_WIN) + (size_t)n0 * 1024, 1024, 1.f, nullptr, scr, kb * 64, F.lane); continue; }
        r -= I_WIN;
        if (r < I_QKV) { const int mat = r / 32, rr = r % 32, kb = rr / 8, nb = rr % 8, g = mat >> 2, h = mat & 3;
            const float* W = F.in[6 + g] + (size_t)h * 65536 + nb * 32;
            tr_item(W, 256, (bf16*)(ws + WS_WQKV) + (size_t)mat * 65536 + (size_t)(nb * 32) * 256, 256, g == 1 ? 0.0625f : 1.f, nullptr, scr, kb * 64, F.lane); continue; }
        r -= I_QKV;
        if (r < I_LRU) { const int mat = r / 8, rr = r % 8, kb = rr / 4, nb = rr % 4, gate = mat & 1, db = mat >> 1;
            const float* W = F.in[gate ? 14 : 12] + (size_t)db * 16384 + nb * 32;
            tr_item(W, 128, (bf16*)(ws + WS_WLRU) + (size_t)mat * 16384 + (size_t)(nb * 32) * 128, 128, 1.f, nullptr, scr, kb * 64, F.lane); continue; }
        r -= I_LRU;
        if (r < I_WB) { const int mat = r / 512, rr = r % 512, kb = rr / 32, nb = rr % 32;
            const float* W = F.in[17 + mat] + nb * 32;
            tr_item(W, 1024, (bf16*)(ws + WS_WB2) + (size_t)(mat * 1024 + nb * 32) * 1024, 1024, 1.f, nullptr, scr, kb * 64, F.lane); continue; }
        r -= I_WB;
        if (r < I_WO) { const int cp = r / 512, rr = r % 512, kb = rr / 32, nb = rr % 32;
            const float* W = F.in[19] + nb * 32;
            tr_item(W, 1024, (bf16*)(ws + WS_WOUT2) + (size_t)(nb * 32) * 2048 + cp * 1024, 2048, 1.f, nullptr, scr, kb * 64, F.lane); continue; }
        r -= I_WO;
        { const int kb = r / 64, nb = r % 64;
            const float* W = F.in[21] + nb * 32;
            tr_item(W, 2048, (bf16*)(ws + WS_WPQ) + (size_t)(nb * 32) * 1024, 1024, 1.f, F.in[20], scr, kb * 64, F.lane); }
    }
    { const int gt = F.bid * NTHR + F.tid, NGT = F.G * NTHR;
      const float4* ks = (const float4*)F.in[22]; v2u* kd = (v2u*)(ws + WS_KEYS);
      for (int i = gt; i < 8 * 2 * 128 * 128 / 4; i += NGT) { const float4 v = ks[i]; v2u o; o.x = pk2(v.x, v.y); o.y = pk2(v.z, v.w); kd[i] = o; }
      float* ss = (float*)(ws + WS_SS);
      for (int i = gt; i < MTOK; i += NGT) ss[i] = 0.f; }
    const float* x = F.in[0]; const float* g1 = F.in[1]; const float* bg = F.in[3];
    bf16* XN = (bf16*)F.out;
    float* GT = (float*)(ws + WS_GATE);
    f32x4 gv[4];
#pragma unroll
    for (int j = 0; j < 4; ++j) gv[j] = ((const f32x4*)g1)[F.lane + 64 * j];
    for (int m = gw; m < MTOK; m += NGW) {
        const f32x4* xr = (const f32x4*)(x + (size_t)m * DM) + F.lane;
        f32x4 v[4]; float s = 0.f;
#pragma unroll
        for (int j = 0; j < 4; ++j) { v[j] = xr[64 * j]; s += (v[j].x * v[j].x + v[j].y * v[j].y) + (v[j].z * v[j].z + v[j].w * v[j].w); }
        const float rstd = rsqrtf(wave_sum(s) * (1.f / DM) + EPS);
        unsigned long long* o8 = (unsigned long long*)(XN + (size_t)m * DM) + F.lane;
        float pg[16];
#pragma unroll
        for (int c = 0; c < 16; ++c) pg[c] = 0.f;
#pragma unroll
        for (int j = 0; j < 4; ++j) {
            v[j] = v[j] * rstd * gv[j];
            o8[64 * j] = (unsigned long long)pk2(v[j].x, v[j].y) | ((unsigned long long)pk2(v[j].z, v[j].w) << 32);
#pragma unroll
            for (int e = 0; e < 4; ++e) {
                const int k = 4 * (F.lane + 64 * j) + e;
                const f32x4* wr = (const f32x4*)(w_in + (size_t)k * DIN + 2048);
                const float hv = v[j][e];
#pragma unroll
                for (int q = 0; q < 4; ++q) { const f32x4 w4 = wr[q]; pg[4 * q] += hv * w4.x; pg[4 * q + 1] += hv * w4.y; pg[4 * q + 2] += hv * w4.z; pg[4 * q + 3] += hv * w4.w; }
            }
        }
        float mine = 0.f;
#pragma unroll
        for (int c = 0; c < 16; ++c) { const float t = wave_sum(pg[c]); if (F.lane == c) mine = t; }
        if (F.lane < 16) GT[(size_t)m * 16 + F.lane] = mine + bg[F.lane];
    }
}

struct AddrPlain {
    const char* A; const char* Bt; int lda, ldb, K;
    __device__ __forceinline__ const char* a(const pg8::Unit& u) const { return A + (size_t)u.pm * 256 * lda * 2; }
    __device__ __forceinline__ const char* b(const pg8::Unit& u) const { return Bt + (size_t)u.pn * 256 * ldb * 2; }
};
struct AddrQKV {
    const char* XC; long dXM; const char* W; int lda, ldb, K;
    __device__ __forceinline__ const char* a(const pg8::Unit& u) const { return XC + (u.pn < 8 ? 0l : dXM) + ((size_t)u.pm * 256 * 1024 + (u.pn & 3) * 256) * 2; }
    __device__ __forceinline__ const char* b(const pg8::Unit& u) const { return W + (size_t)u.pn * 65536 * 2; }
};
struct AddrBranch {
    const char* YM; long dYL; const char* W; int lda, ldb, K;
    __device__ __forceinline__ const char* a(const pg8::Unit& u) const { return YM + (u.pn < 4 ? 0l : dYL) + (size_t)u.pm * 256 * 1024 * 2; }
    __device__ __forceinline__ const char* b(const pg8::Unit& u) const { return W + (size_t)u.pn * 256 * 1024 * 2; }
};

struct DstP1 { unsigned char* ws;
    __device__ __forceinline__ bf16* get(int pn, int& ld, int& col0) const {
        const bool mg = pn >= 16; ld = mg ? 2048 : 1024; col0 = mg ? (pn - 16) * 256 : (pn & 3) * 256;
        return (bf16*)(ws + (mg ? WS_MG : WS_XM + (size_t)(pn >> 2) * 64 * MiB)); } };
struct DstQKV { char* q; long dk, dv;
    __device__ __forceinline__ bf16* get(int pn, int& ld, int& col0) const { ld = 1024; col0 = (pn & 3) * 256; return (bf16*)(q + (pn >= 4 ? (pn >= 8 ? dv : dk) : 0l)); } };
template <class Dst> struct EpiBf16 {
    static constexpr bool PERM = true;
    Dst dst;
    __device__ __forceinline__ void operator()(const f32x4 (&acc)[2][2][4][2], const pg8::Unit& u, int wr, int wc, int fr, int fq) const {
        int ld, colt; bf16* base = dst.get(u.pn, ld, colt);
        const int row0 = u.pm * 256 + wr * 64 + fr, col0 = colt + wc * 32 + 8 * fq;
#pragma unroll
        for (int ai = 0; ai < 2; ++ai)
#pragma unroll
            for (int m = 0; m < 4; ++m) { bf16* rowp = base + (size_t)(row0 + ai * 128 + m * 16) * ld + col0;
#pragma unroll
                for (int bj = 0; bj < 2; ++bj) { const f32x4 v0 = acc[ai][bj][m][0], v1 = acc[ai][bj][m][1];
                    v4u w; w.x = pg8::cvt_pk_bf16(v0[0], v0[1]); w.y = pg8::cvt_pk_bf16(v0[2], v0[3]); w.z = pg8::cvt_pk_bf16(v1[0], v1[1]); w.w = pg8::cvt_pk_bf16(v1[2], v1[3]);
                    *(v4u*)(rowp + bj * 128) = w; } }
    }
};
struct EpiGate {
    static constexpr bool PERM = true;
    bf16* G;
    __device__ __forceinline__ void operator()(const f32x4 (&acc)[2][2][4][2], const pg8::Unit& u, int wr, int wc, int fr, int fq) const {
        const int row0 = u.pm * 256 + wr * 64 + fr, col0 = u.pn * 256 + wc * 32 + 8 * fq;
#pragma unroll
        for (int ai = 0; ai < 2; ++ai)
#pragma unroll
            for (int m = 0; m < 4; ++m) { bf16* rowp = G + (size_t)(row0 + ai * 128 + m * 16) * 2048 + col0;
#pragma unroll
                for (int bj = 0; bj < 2; ++bj) { const f32x4 v0 = acc[ai][bj][m][0], v1 = acc[ai][bj][m][1];
                    const v4u g = *(const v4u*)(rowp + bj * 128);
                    v4u w;
                    w.x = pg8::cvt_pk_bf16(v0[0] * sigmoidf_(bflo(g.x)), v0[1] * sigmoidf_(bfhi(g.x)));
                    w.y = pg8::cvt_pk_bf16(v0[2] * sigmoidf_(bflo(g.y)), v0[3] * sigmoidf_(bfhi(g.y)));
                    w.z = pg8::cvt_pk_bf16(v1[0] * sigmoidf_(bflo(g.z)), v1[1] * sigmoidf_(bfhi(g.z)));
                    w.w = pg8::cvt_pk_bf16(v1[2] * sigmoidf_(bflo(g.w)), v1[3] * sigmoidf_(bfhi(g.w)));
                    *(v4u*)(rowp + bj * 128) = w; } }
    }
};
struct EpiResid {
    static constexpr bool PERM = false;
    const float* x; float* x1; bf16* x1b; float* ss;
    __device__ __forceinline__ void operator()(const f32x4 (&acc)[2][2][4][2], const pg8::Unit& u, int wr, int wc, int fr, int fq) const {
        const int row0 = u.pm * 256 + wr * 64 + fr, col0 = u.pn * 256 + wc * 32 + 4 * fq;
#pragma unroll
        for (int ai = 0; ai < 2; ++ai)
#pragma unroll
            for (int m = 0; m < 4; ++m) { const int row = row0 + ai * 128 + m * 16; const size_t off = (size_t)row * DM + col0; float s = 0.f;
#pragma unroll
                for (int bj = 0; bj < 2; ++bj)
#pragma unroll
                    for (int n = 0; n < 2; ++n) { const size_t o = off + bj * 128 + n * 16; const f32x4 v = *(const f32x4*)(x + o) + acc[ai][bj][m][n];
                        *(f32x4*)(x1 + o) = v; v2u w; w.x = pg8::cvt_pk_bf16(v[0], v[1]); w.y = pg8::cvt_pk_bf16(v[2], v[3]); *(v2u*)(x1b + o) = w;
                        s += (v[0] * v[0] + v[1] * v[1]) + (v[2] * v[2] + v[3] * v[3]); }
                s += __shfl_xor(s, 16); s += __shfl_xor(s, 32);
                if (fq == 0) atomicAdd(ss + row, s); }
    }
};
struct EpiPQ {
    static constexpr bool PERM = true;
    bf16* pq; const float* ss;
    __device__ __forceinline__ void operator()(const f32x4 (&acc)[2][2][4][2], const pg8::Unit& u, int wr, int wc, int fr, int fq) const {
        const int row0 = u.pm * 256 + wr * 64 + fr, col0 = u.pn * 256 + wc * 32 + 8 * fq;
#pragma unroll
        for (int ai = 0; ai < 2; ++ai)
#pragma unroll
            for (int m = 0; m < 4; ++m) { const int row = row0 + ai * 128 + m * 16; bf16* rowp = pq + (size_t)row * 2048 + col0;
                const float r = rsqrtf(ss[row] * (1.f / DM) + EPS);
#pragma unroll
                for (int bj = 0; bj < 2; ++bj) { const f32x4 v0 = acc[ai][bj][m][0] * r, v1 = acc[ai][bj][m][1] * r;
                    v4u w; w.x = pg8::cvt_pk_bf16(v0[0], v0[1]); w.y = pg8::cvt_pk_bf16(v0[2], v0[3]); w.z = pg8::cvt_pk_bf16(v1[0], v1[1]); w.w = pg8::cvt_pk_bf16(v1[2], v1[3]);
                    *(v4u*)(rowp + bj * 128) = w; } }
    }
};

__device__ __forceinline__ void lru_ref(Frame& F) {
    const bf16* XL = (const bf16*)(F.ws + WS_XL); const bf16* LG = (const bf16*)(F.ws + WS_LG); bf16* YL = (bf16*)F.out;
    const bf16* WL = (const bf16*)(F.ws + WS_WLRU);
    const float* cw = F.in[10]; const float* cb = F.in[11];
    LAS float* sxc = (LAS float*)F.lds;
    LAS float* sp = (LAS float*)(F.lds + 1024);
    const int c = F.tid & 127, part = F.tid >> 7;
    for (int item = F.bid; item < 64; item += F.G) {
        const int b = item >> 3, blk = item & 7, ch = blk * 128 + c;
        const float w0 = cw[0 * DM + ch], w1 = cw[1 * DM + ch], w2 = cw[2 * DM + ch], w3 = cw[3 * DM + ch], bb = cb[ch];
        for (int dir = 0; dir < 2; ++dir) {
            v4u wr[4], wi[4];
            { const v4u* pr = (const v4u*)(WL + ((size_t)((dir * 8 + blk) * 2 + 0) * 128 + c) * 128 + part * 32);
              const v4u* pi = (const v4u*)(WL + ((size_t)((dir * 8 + blk) * 2 + 1) * 128 + c) * 128 + part * 32);
#pragma unroll
              for (int q = 0; q < 4; ++q) { wr[q] = pr[q]; wi[q] = pi[q]; } }
            const float br = F.in[13][dir * DM + ch], bi = F.in[15][dir * DM + ch];
            const float spl = softplusf_(-F.in[16][dir * DM + ch]);
            float h = 0.f;
            for (int step = 0; step < SEQ; ++step) {
                const int t = dir ? (SEQ - 1 - step) : step;
                const size_t m = (size_t)b * SEQ + t;
                float xc = 0.f;
                if (part == 0) {
                    xc = bb;
                    if (t >= 2) xc += w0 * bf2f(XL[(m - 2) * DM + ch]);
                    if (t >= 1) xc += w1 * bf2f(XL[(m - 1) * DM + ch]);
                    xc += w2 * bf2f(XL[m * DM + ch]);
                    if (t + 1 < SEQ) xc += w3 * bf2f(XL[(m + 1) * DM + ch]);
                    sxc[c] = xc;
                }
                __syncthreads();
                float pr_ = 0.f, pi_ = 0.f;
#pragma unroll
                for (int q = 0; q < 4; ++q) {
                    const f32x4 x0 = *(const LAS f32x4*)(sxc + part * 32 + q * 8), x1 = *(const LAS f32x4*)(sxc + part * 32 + q * 8 + 4);
                    pr_ += x0[0] * bflo(wr[q].x) + x0[1] * bfhi(wr[q].x) + x0[2] * bflo(wr[q].y) + x0[3] * bfhi(wr[q].y)
                         + x1[0] * bflo(wr[q].z) + x1[1] * bfhi(wr[q].z) + x1[2] * bflo(wr[q].w) + x1[3] * bfhi(wr[q].w);
                    pi_ += x0[0] * bflo(wi[q].x) + x0[1] * bfhi(wi[q].x) + x0[2] * bflo(wi[q].y) + x0[3] * bfhi(wi[q].y)
                         + x1[0] * bflo(wi[q].z) + x1[1] * bfhi(wi[q].z) + x1[2] * bflo(wi[q].w) + x1[3] * bfhi(wi[q].w);
                }
                sp[(part * 2 + 0) * 128 + c] = pr_; sp[(part * 2 + 1) * 128 + c] = pi_;
                __syncthreads();
                if (part == 0) {
                    const float rp = sp[0 * 128 + c] + sp[2 * 128 + c] + sp[4 * 128 + c] + sp[6 * 128 + c] + br;
                    const float ip = sp[1 * 128 + c] + sp[3 * 128 + c] + sp[5 * 128 + c] + sp[7 * 128 + c] + bi;
                    const float r = sigmoidf_(rp), ig = sigmoidf_(ip);
                    const float log_a = -8.f * r * spl;
                    const float a = __expf(log_a);
                    const float u = sqrtf(-expm1f(2.f * log_a)) * (ig * xc);
                    h = a * h + u;
                    if (dir == 0) YL[m * DM + ch] = (bf16)f2bf(h);
                    else { const float y = (bf2f(YL[m * DM + ch]) + h) * gelu_erf(bf2f(LG[m * DM + ch])); YL[m * DM + ch] = (bf16)f2bf(y); }
                }
            }
            __syncthreads();
        }
    }
}


template <bool PB> __device__ __forceinline__ void lru_phase(Frame& F) {
    const bf16* XL = (const bf16*)(F.ws + WS_XL); const bf16* LG = (const bf16*)(F.ws + WS_LG); bf16* YL = (bf16*)F.out;
    f32x2* AGG = (f32x2*)(F.ws + WS_AGG);
    const bf16* WL = (const bf16*)(F.ws + WS_WLRU);
    const float* cw = F.in[10]; const float* cb = F.in[11];
    constexpr int O_XCB = 0, O_XCF = 17408, O_A = 50176, O_U = 82944;
    LAS unsigned char* L = F.lds;
    const int tid = F.tid, lane = F.lane, w = F.wave, fr = lane & 15, fq = lane >> 4;
    int cur_blk = -1;
    bf16x8 wf[2][2][4];
    f32x4 br4[2], bi4[2], sp4[2];
    for (int i = 0;; ++i) {
        const int idx = i * F.G + F.bid; if (idx >= 4096) break;
        const int blk = idx & 7, j = idx >> 3, b = j >> 6, seg = j & 63, t0 = seg * 64;
        const size_t mrow0 = (size_t)b * SEQ + t0;
        if (blk != cur_blk) {
            cur_blk = blk;
#pragma unroll
            for (int d = 0; d < 2; ++d) {
#pragma unroll
                for (int g = 0; g < 2; ++g)
#pragma unroll
                    for (int ks = 0; ks < 4; ++ks)
                        wf[d][g][ks] = *(const bf16x8*)(WL + ((size_t)((d * 8 + blk) * 2 + g) * 128 + 16 * w + fr) * 128 + 32 * ks + 8 * fq);
                const int ch = blk * 128 + 16 * w + 4 * fq;
                br4[d] = *(const f32x4*)(F.in[13] + d * DM + ch); bi4[d] = *(const f32x4*)(F.in[15] + d * DM + ch);
                const f32x4 lm = *(const f32x4*)(F.in[16] + d * DM + ch);
#pragma unroll
                for (int e = 0; e < 4; ++e) sp4[d][e] = softplusf_(-lm[e]);
            }
        }
        for (int e = tid; e < 68 * 16; e += NTHR) { const int row = e >> 4, c16 = e & 15, t = t0 - 2 + row;
            v4u v = {0u, 0u, 0u, 0u};
            if (t >= 0 && t < SEQ) v = *(const v4u*)(XL + ((size_t)b * SEQ + t) * DM + blk * 128 + c16 * 8);
            *(LAS v4u*)(L + O_A + row * 256 + c16 * 16) = v; }
        __syncthreads();
        for (int e = tid; e < 64 * 16; e += NTHR) { const int tl = e >> 4, c16 = e & 15, c0 = blk * 128 + c16 * 8;
            float y[8];
            { const f32x4 a = *(const f32x4*)(cb + c0), bq = *(const f32x4*)(cb + c0 + 4); y[0] = a[0]; y[1] = a[1]; y[2] = a[2]; y[3] = a[3]; y[4] = bq[0]; y[5] = bq[1]; y[6] = bq[2]; y[7] = bq[3]; }
#pragma unroll
            for (int jt = 0; jt < 4; ++jt) { const v4u r = *(const LAS v4u*)(L + O_A + (tl + jt) * 256 + c16 * 16);
                const f32x4 wa = *(const f32x4*)(cw + jt * DM + c0), wb = *(const f32x4*)(cw + jt * DM + c0 + 4);
                y[0] += wa[0] * bflo(r.x); y[1] += wa[1] * bfhi(r.x); y[2] += wa[2] * bflo(r.y); y[3] += wa[3] * bfhi(r.y);
                y[4] += wb[0] * bflo(r.z); y[5] += wb[1] * bfhi(r.z); y[6] += wb[2] * bflo(r.w); y[7] += wb[3] * bfhi(r.w); }
            *(LAS f32x4*)(L + O_XCF + tl * 512 + c16 * 32) = (f32x4){y[0], y[1], y[2], y[3]};
            *(LAS f32x4*)(L + O_XCF + tl * 512 + c16 * 32 + 16) = (f32x4){y[4], y[5], y[6], y[7]};
            v4u o; o.x = pk2(y[0], y[1]); o.y = pk2(y[2], y[3]); o.z = pk2(y[4], y[5]); o.w = pk2(y[6], y[7]);
            *(LAS v4u*)(L + O_XCB + tl * 272 + c16 * 16) = o; }
        __syncthreads();
        float carry0 = 0.f, carry1 = 0.f;
        if (PB && tid < 128) {
            const int ch = blk * 128 + tid;
            float h = 0.f;
            for (int js = 0; js < seg; ++js) { const f32x2 ah = AGG[((size_t)(b * 64 + js) * 2 + 0) * DM + ch]; h = ah[0] * h + ah[1]; }
            carry0 = h; h = 0.f;
            for (int js = 63; js > seg; --js) { const f32x2 ah = AGG[((size_t)(b * 64 + js) * 2 + 1) * DM + ch]; h = ah[0] * h + ah[1]; }
            carry1 = h;
        }
#pragma unroll
        for (int d = 0; d < 2; ++d) {
            const int o_a = (d == 0) ? O_A : O_XCF;
            f32x4 aR[4], aI[4];
#pragma unroll
            for (int mt = 0; mt < 4; ++mt) { aR[mt] = (f32x4){0.f, 0.f, 0.f, 0.f}; aI[mt] = (f32x4){0.f, 0.f, 0.f, 0.f}; }
#pragma unroll
            for (int ks = 0; ks < 4; ++ks)
#pragma unroll
                for (int mt = 0; mt < 4; ++mt) { const bf16x8 xb = *(const LAS bf16x8*)(L + O_XCB + (16 * mt + fr) * 272 + (32 * ks + 8 * fq) * 2);
                    aR[mt] = __builtin_amdgcn_mfma_f32_16x16x32_bf16(wf[d][0][ks], xb, aR[mt], 0, 0, 0);
                    aI[mt] = __builtin_amdgcn_mfma_f32_16x16x32_bf16(wf[d][1][ks], xb, aI[mt], 0, 0, 0); }
#pragma unroll
            for (int mt = 0; mt < 4; ++mt) { const int tl = 16 * mt + fr, cl = 16 * w + 4 * fq;
                const f32x4 xc = *(const LAS f32x4*)(L + O_XCF + tl * 512 + cl * 4);
                f32x4 av, uv;
#pragma unroll
                for (int e = 0; e < 4; ++e) { const float r = sigmoidf_(aR[mt][e] + br4[d][e]), ig = sigmoidf_(aI[mt][e] + bi4[d][e]);
                    const float la = -8.f * r * sp4[d][e]; av[e] = __expf(la); uv[e] = sqrtf(-expm1f(2.f * la)) * (ig * xc[e]); }
                *(LAS f32x4*)(L + o_a + tl * 512 + cl * 4) = av; *(LAS f32x4*)(L + O_U + tl * 512 + cl * 4) = uv; }
            __syncthreads();
            if (tid < 128) {
                LAS float* pa = (LAS float*)(L + o_a) + tid; const LAS float* pu = (const LAS float*)(L + O_U) + tid;
                if (!PB) {
                    float h = 0.f, A = 1.f;
#pragma unroll 8
                    for (int s2 = 0; s2 < 64; ++s2) { const int tl = d ? 63 - s2 : s2; const float a = pa[tl * 128], u = pu[tl * 128]; h = a * h + u; A *= a; }
                    AGG[((size_t)(b * 64 + seg) * 2 + d) * DM + blk * 128 + tid] = (f32x2){A, h};
                } else if (d == 0) {
                    float h = carry0;
#pragma unroll 8
                    for (int tl = 0; tl < 64; ++tl) { h = pa[tl * 128] * h + pu[tl * 128]; pa[tl * 128] = h; }
                } else {
                    float h = carry1;
                    LAS float* ph = (LAS float*)(L + O_A) + tid;
#pragma unroll 8
                    for (int s2 = 0; s2 < 64; ++s2) { const int tl = 63 - s2; h = pa[tl * 128] * h + pu[tl * 128]; ph[tl * 128] += h; }
                }
            }
            __syncthreads();
        }
        if (PB) {
            for (int e = tid; e < 64 * 16; e += NTHR) { const int row = e >> 4, c16 = e & 15;
                const v4u g = *(const v4u*)(LG + (mrow0 + row) * DM + blk * 128 + c16 * 8);
                const f32x4 h0 = *(const LAS f32x4*)(L + O_A + row * 512 + c16 * 32), h1 = *(const LAS f32x4*)(L + O_A + row * 512 + c16 * 32 + 16);
                v4u o;
                o.x = pk2(h0[0] * gelu_fast(bflo(g.x)), h0[1] * gelu_fast(bfhi(g.x))); o.y = pk2(h0[2] * gelu_fast(bflo(g.y)), h0[3] * gelu_fast(bfhi(g.y)));
                o.z = pk2(h1[0] * gelu_fast(bflo(g.z)), h1[1] * gelu_fast(bfhi(g.z))); o.w = pk2(h1[2] * gelu_fast(bflo(g.w)), h1[3] * gelu_fast(bfhi(g.w)));
                *(v4u*)(YL + (mrow0 + row) * DM + blk * 128 + c16 * 8) = o; }
            __syncthreads();
        }
    }
}

__device__ __forceinline__ void mconv_phase(Frame& F) {
    const bf16* XM = (const bf16*)(F.ws + WS_XM); bf16* XC = (bf16*)(F.ws + WS_XL);
    const float* cw = F.in[4]; const float* cb = F.in[5];
    const int NT = MTOK / 32 * 128;
    for (int g = F.bid * NTHR + F.tid; g < NT; g += F.G * NTHR) {
        const int chunk = g & 127, run = g >> 7, c0 = chunk * 8, m0 = run * 32, t0 = m0 & (SEQ - 1);
        float w[4][8], bias[8];
#pragma unroll
        for (int j = 0; j < 4; ++j) { const f32x4 a = *(const f32x4*)(cw + j * DM + c0), b = *(const f32x4*)(cw + j * DM + c0 + 4);
            w[j][0] = a[0]; w[j][1] = a[1]; w[j][2] = a[2]; w[j][3] = a[3]; w[j][4] = b[0]; w[j][5] = b[1]; w[j][6] = b[2]; w[j][7] = b[3]; }
        { const f32x4 a = *(const f32x4*)(cb + c0), b = *(const f32x4*)(cb + c0 + 4);
            bias[0] = a[0]; bias[1] = a[1]; bias[2] = a[2]; bias[3] = a[3]; bias[4] = b[0]; bias[5] = b[1]; bias[6] = b[2]; bias[7] = b[3]; }
        v4u win[4];
        const v4u zero = {0u, 0u, 0u, 0u};
        win[0] = zero;
        win[1] = (t0 >= 2) ? *(const v4u*)(XM + (size_t)(m0 - 2) * DM + c0) : zero;
        win[2] = (t0 >= 1) ? *(const v4u*)(XM + (size_t)(m0 - 1) * DM + c0) : zero;
        win[3] = *(const v4u*)(XM + (size_t)m0 * DM + c0);
#pragma unroll 4
        for (int i = 0; i < 32; ++i) {
            win[0] = win[1]; win[1] = win[2]; win[2] = win[3];
            win[3] = (t0 + i + 1 < SEQ) ? *(const v4u*)(XM + (size_t)(m0 + i + 1) * DM + c0) : zero;
            float y[8];
#pragma unroll
            for (int e = 0; e < 8; ++e) y[e] = bias[e];
#pragma unroll
            for (int j = 0; j < 4; ++j) {
                const unsigned p0 = win[j].x, p1 = win[j].y, p2 = win[j].z, p3 = win[j].w;
                y[0] += w[j][0] * bflo(p0); y[1] += w[j][1] * bfhi(p0); y[2] += w[j][2] * bflo(p1); y[3] += w[j][3] * bfhi(p1);
                y[4] += w[j][4] * bflo(p2); y[5] += w[j][5] * bfhi(p2); y[6] += w[j][6] * bflo(p3); y[7] += w[j][7] * bfhi(p3);
            }
#pragma unroll
            for (int e = 0; e < 8; ++e) y[e] = y[e] * sigmoidf_(y[e]);
            v4u o; o.x = pk2(y[0], y[1]); o.y = pk2(y[2], y[3]); o.z = pk2(y[4], y[5]); o.w = pk2(y[6], y[7]);
            *(v4u*)(XC + (size_t)(m0 + i) * DM + c0) = o;
        }
    }
}

__device__ __forceinline__ void mscan_ref(Frame& F) {
    const bf16* Q = (const bf16*)(F.ws + WS_LG); const bf16* K = (const bf16*)(F.ws + WS_K); const bf16* V = (const bf16*)F.out + (size_t)MTOK * DM;
    const float* GT = (const float*)(F.ws + WS_GATE);
    LAS float* sq = (LAS float*)F.lds; LAS float* sk = sq + 256; LAS float* sv = sk + 256; LAS float* spart = sv + 32; LAS float* sdw = spart + 256;
    const int e = F.tid & 31, dg = F.tid >> 5;
    for (int item = F.bid; item < 512; item += F.G) {
        const int es = item & 7, dir = (item >> 3) & 1, h = (item >> 4) & 3, b = item >> 6;
        bf16* H = (bf16*)(F.ws + (dir ? WS_XL : WS_XM));
        float C[16];
#pragma unroll
        for (int j = 0; j < 16; ++j) C[j] = 0.f;
        float nreg = 0.f, mst = 0.f;
        for (int step = 0; step < SEQ; ++step) {
            const int t = dir ? (SEQ - 1 - step) : step;
            const size_t m = (size_t)b * SEQ + t, ro = m * DM + h * 256;
            if (F.tid < 256) { sq[F.tid] = bf2f(Q[ro + F.tid]); sk[F.tid] = bf2f(K[ro + F.tid]); }
            if (F.tid < 32) sv[F.tid] = bf2f(V[ro + es * 32 + F.tid]);
            const float ip = GT[m * 16 + (dir * 2 + 0) * 4 + h], fp = GT[m * 16 + (dir * 2 + 1) * 4 + h];
            const float logf = -softplusf_(-fp);
            const float mn = fmaxf(logf + mst, ip);
            const float fd = __expf(logf + mst - mn), iw = __expf(ip - mn);
            mst = mn;
            __syncthreads();
            const float ve = sv[e] * iw;
            float part = 0.f;
#pragma unroll
            for (int j = 0; j < 16; ++j) { const int d = dg * 16 + j; C[j] = fd * C[j] + sk[d] * ve; part += sq[d] * C[j]; }
            part += __shfl_xor(part, 32);
            if (F.lane < 32) spart[F.wave * 32 + e] = part;
            if (F.tid < 256) { nreg = fd * nreg + iw * sk[F.tid]; const float ds = wave_sum(nreg * sq[F.tid]); if (F.lane == 0) sdw[F.wave] = ds; }
            __syncthreads();
            if (F.tid < 32) {
                float num = 0.f;
#pragma unroll
                for (int w = 0; w < 8; ++w) num += spart[w * 32 + F.tid];
                const float den = sdw[0] + sdw[1] + sdw[2] + sdw[3];
                H[ro + es * 32 + F.tid] = (bf16)f2bf(num / fmaxf(fabsf(den), __expf(-mn)));
            }
        }
        __syncthreads();
    }
}


typedef short s16x4 __attribute__((ext_vector_type(4)));
__device__ __forceinline__ bf16x8 tr_read_pair(unsigned a0, unsigned a1) {
    s16x4 r0, r1;
    asm volatile("ds_read_b64_tr_b16 %0, %2\n\tds_read_b64_tr_b16 %1, %3\n\ts_waitcnt lgkmcnt(0)" : "=&v"(r0), "=&v"(r1) : "v"(a0), "v"(a1) : "memory");
    return __builtin_shufflevector(r0, r1, 0, 1, 2, 3, 4, 5, 6, 7);
}
__device__ __forceinline__ float wave_incl_sum(float x, int lane) {
#pragma unroll
    for (int o = 1; o < 64; o <<= 1) { const float t = __shfl_up(x, o); if (lane >= o) x += t; }
    return x;
}
__device__ __forceinline__ float wave_incl_max(float x, int lane) {
#pragma unroll
    for (int o = 1; o < 64; o <<= 1) { const float t = __shfl_up(x, o); if (lane >= o) x = fmaxf(x, t); }
    return x;
}
__device__ __forceinline__ void mscan_phase(Frame& F) {
    const bf16* Q = (const bf16*)(F.ws + WS_LG); const bf16* K = (const bf16*)(F.ws + WS_K); const bf16* V = (const bf16*)F.out + (size_t)MTOK * DM;
    const float* GT = (const float*)(F.ws + WS_GATE);
    constexpr int KS = 0, CTI = 33792, VT = 67584, VWT = 86016, PB = 104448, TAB = 113664, NT = 116736, NPART = 117760, DENT = 119808;
    constexpr int KST = 528, VST = 144, TABSZ = 1536;
    LAS unsigned char* L = F.lds;
    const int tid = F.tid, lane = F.lane, w = F.wave, fr = lane & 15, fq = lane >> 4, pt = w & 3, wg = w >> 2;
    for (int item = F.bid; item < 256; item += F.G) {
        const int es = item & 3, dir = (item >> 2) & 1, h = (item >> 3) & 3, b = item >> 5;
        bf16* H = (bf16*)(F.ws + (dir ? WS_XL : WS_XM));
        const size_t rowbase = (size_t)b * SEQ;
#define TOF(c, p) (dir ? (SEQ - 1 - 64 * (c) - (p)) : (64 * (c) + (p)))
        for (int e = tid; e < (33792 + 1024) / 4; e += NTHR) { if (e < 33792 / 4) ((LAS unsigned*)(L + CTI))[e] = 0u; else ((LAS unsigned*)(L + NT))[e - 33792 / 4] = 0u; }
        float m_run = 0.f;
        float gi_n = 0.f, gf_n = 0.f;
        if (w == 0) { const size_t m = rowbase + TOF(0, lane); gi_n = GT[m * 16 + dir * 8 + h]; gf_n = GT[m * 16 + dir * 8 + 4 + h]; }
#define G1_TABLES(setp) do { \
            const float logf_ = -softplusf_(-gf_n); const float b_ = wave_incl_sum(logf_, lane); const float a_ = gi_n - b_; \
            const float M_ = fmaxf(m_run, wave_incl_max(a_, lane)); const float Mend_ = __shfl(M_, 63), g_ = __shfl(b_, 63); \
            LAS float* T_ = (LAS float*)(setp); T_[lane] = a_; T_[64 + lane] = M_; T_[128 + lane] = expf(m_run - M_); T_[192 + lane] = expf(-(b_ + M_)); T_[256 + lane] = expf(a_ - Mend_); \
            if (lane == 0) { T_[320] = expf(m_run - Mend_); T_[321] = g_ + Mend_; } \
            m_run = g_ + Mend_; } while (0)
        if (w == 0) G1_TABLES(L + TAB);
        __syncthreads();
        bf16x8 qf[8];
        v4u kreg[4]; v4u vreg;
#define LOAD_KV(c) do { _Pragma("unroll") for (int r_ = 0; r_ < 4; ++r_) { const int i_ = tid + NTHR * r_, s_ = i_ >> 5, c16_ = i_ & 31; \
                kreg[r_] = *(const v4u*)(K + (rowbase + TOF(c, s_)) * DM + h * 256 + c16_ * 8); } \
            { const int s_ = tid >> 3, e8_ = tid & 7; vreg = *(const v4u*)(V + (rowbase + TOF(c, s_)) * DM + h * 256 + es * 64 + e8_ * 8); } } while (0)
#define STORE_KV(setidx) do { _Pragma("unroll") for (int r_ = 0; r_ < 4; ++r_) { const int i_ = tid + NTHR * r_, s_ = i_ >> 5, c16_ = i_ & 31; \
                *(LAS v4u*)(L + KS + s_ * KST + c16_ * 16) = kreg[r_]; } \
            { const int s_ = tid >> 3, e8_ = tid & 7; const float ws_ = ((const LAS float*)(L + TAB + (setidx) * TABSZ))[256 + s_]; \
              LAS bf16* vt_ = (LAS bf16*)(L + VT + (setidx) * 9216); LAS bf16* vw_ = (LAS bf16*)(L + VWT + (setidx) * 9216); \
              const unsigned wv_[4] = {vreg.x, vreg.y, vreg.z, vreg.w}; \
              _Pragma("unroll") for (int j_ = 0; j_ < 4; ++j_) { const float lo_ = bflo(wv_[j_]), hi_ = bfhi(wv_[j_]); const int e_ = e8_ * 8 + 2 * j_; \
                vt_[e_ * 72 + s_] = (bf16)(wv_[j_] & 0xffffu); vt_[(e_ + 1) * 72 + s_] = (bf16)(wv_[j_] >> 16); \
                vw_[e_ * 72 + s_] = (bf16)f2bf(lo_ * ws_); vw_[(e_ + 1) * 72 + s_] = (bf16)f2bf(hi_ * ws_); } } } while (0)
#define LOAD_Q(c) do { const size_t m_ = rowbase + TOF(c, 16 * pt + fr); _Pragma("unroll") for (int ks_ = 0; ks_ < 8; ++ks_) \
                qf[ks_] = *(const bf16x8*)(Q + m_ * DM + h * 256 + 32 * ks_ + 8 * fq); } while (0)
        LOAD_KV(0); LOAD_Q(0);
        STORE_KV(0);
        f32x4 Cacc[8];
#pragma unroll
        for (int i = 0; i < 8; ++i) Cacc[i] = (f32x4){0.f, 0.f, 0.f, 0.f};
        __syncthreads();
        for (int c = 0; c < 64; ++c) {
            const int cur = c & 1, nxt = cur ^ 1;
            const bool has_next = (c + 1 < 64);
            const LAS float* T = (const LAS float*)(L + TAB + cur * TABSZ);
            if (has_next) { LOAD_KV(c + 1); if (w == 0) { const size_t m = rowbase + TOF(c + 1, lane); gi_n = GT[m * 16 + dir * 8 + h]; gf_n = GT[m * 16 + dir * 8 + 4 + h]; } }
            const int p = 16 * pt + fr;
            const float Mp = T[64 + p], wi_p = T[128 + p];
            float cs = 0.f;
#pragma unroll
            for (int i = 0; i < 2; ++i) { const int st = 2 * wg + i;
                v2u pw = {0u, 0u};
                if (st <= pt) {
                    f32x4 sa = (f32x4){0.f, 0.f, 0.f, 0.f};
#pragma unroll
                    for (int ks = 0; ks < 8; ++ks) { const bf16x8 kf = *(const LAS bf16x8*)(L + KS + (16 * st + fr) * KST + (32 * ks + 8 * fq) * 2);
                        sa = __builtin_amdgcn_mfma_f32_16x16x32_bf16(kf, qf[ks], sa, 0, 0, 0); }
                    const f32x4 a4 = *(const LAS f32x4*)(T + 16 * st + 4 * fq);
                    float pv[4];
#pragma unroll
                    for (int r = 0; r < 4; ++r) { const int s_ = 16 * st + 4 * fq + r; const float wgt = (s_ <= p) ? __expf(a4[r] - Mp) : 0.f; pv[r] = sa[r] * wgt; cs += pv[r]; }
                    pw.x = pk2(pv[0], pv[1]); pw.y = pk2(pv[2], pv[3]);
                }
                *(LAS v2u*)(L + PB + p * VST + (16 * st + 4 * fq) * 2) = pw; }
            f32x4 O[2];
#pragma unroll
            for (int i = 0; i < 2; ++i) { const int et = 2 * wg + i; O[i] = (f32x4){0.f, 0.f, 0.f, 0.f};
#pragma unroll
                for (int ks = 0; ks < 8; ++ks) { const bf16x8 cf = *(const LAS bf16x8*)(L + CTI + (16 * et + fr) * KST + (32 * ks + 8 * fq) * 2);
                    O[i] = __builtin_amdgcn_mfma_f32_16x16x32_bf16(cf, qf[ks], O[i], 0, 0, 0); } }
            float di = 0.f;
#define DEN_INTER(ks) do { const f32x4 n0 = *(const LAS f32x4*)(L + NT + (32 * (ks) + 8 * fq) * 4), n1 = *(const LAS f32x4*)(L + NT + (32 * (ks) + 8 * fq) * 4 + 16); \
                const v4u qw = __builtin_bit_cast(v4u, qf[ks]); \
                di += bflo(qw.x) * n0[0] + bfhi(qw.x) * n0[1] + bflo(qw.y) * n0[2] + bfhi(qw.y) * n0[3] + bflo(qw.z) * n1[0] + bfhi(qw.z) * n1[1] + bflo(qw.w) * n1[2] + bfhi(qw.w) * n1[3]; } while (0)
            if (wg == 0) { DEN_INTER(0); DEN_INTER(1); DEN_INTER(2); DEN_INTER(3); }
            else { DEN_INTER(4); DEN_INTER(5); DEN_INTER(6); DEN_INTER(7); }
#undef DEN_INTER
            di += __shfl_xor(di, 16); di += __shfl_xor(di, 32);
            cs += __shfl_xor(cs, 16); cs += __shfl_xor(cs, 32);
            if (fq == 0) ((LAS float*)(L + DENT))[wg * 64 + p] = wi_p * di + cs;
            if (has_next) LOAD_Q(c + 1);
            if (has_next && w == 0) G1_TABLES(L + TAB + nxt * TABSZ);
            __syncthreads();
#pragma unroll
            for (int i = 0; i < 2; ++i) { const int et = 2 * wg + i; O[i] = O[i] * wi_p;
#pragma unroll
                for (int ks = 0; ks < 2; ++ks) { const bf16x8 vf = *(const LAS bf16x8*)(L + VT + cur * 9216 + (16 * et + fr) * VST + (32 * ks + 8 * fq) * 2);
                    const bf16x8 pf = *(const LAS bf16x8*)(L + PB + p * VST + (32 * ks + 8 * fq) * 2);
                    O[i] = __builtin_amdgcn_mfma_f32_16x16x32_bf16(vf, pf, O[i], 0, 0, 0); } }
            { const float den = ((const LAS float*)(L + DENT))[p] + ((const LAS float*)(L + DENT))[64 + p];
              const float inv = 1.f / fmaxf(fabsf(den), T[192 + p]);
              const size_t m = rowbase + TOF(c, p);
#pragma unroll
              for (int i = 0; i < 2; ++i) { const int et = 2 * wg + i; v2u o; o.x = pk2(O[i][0] * inv, O[i][1] * inv); o.y = pk2(O[i][2] * inv, O[i][3] * inv);
                  *(v2u*)(H + m * DM + h * 256 + es * 64 + 16 * et + 4 * fq) = o; } }
            { const float decay = T[320];
              const bf16x8 vw0 = *(const LAS bf16x8*)(L + VWT + cur * 9216 + (16 * pt + fr) * VST + (8 * fq) * 2);
              const bf16x8 vw1 = *(const LAS bf16x8*)(L + VWT + cur * 9216 + (16 * pt + fr) * VST + (32 + 8 * fq) * 2);
              const int l16 = lane & 15, q4 = l16 >> 2, p4 = l16 & 3;
              const unsigned kb = (unsigned)(uintptr_t)(L + KS) + (unsigned)((8 * fq + q4) * KST + 4 * p4 * 2);
#pragma unroll
              for (int dtl = 0; dtl < 8; ++dtl) { const int dt = 8 * wg + dtl; const unsigned a0 = kb + dt * 32;
                  const bf16x8 k0 = tr_read_pair(a0, a0 + 4 * KST), k1 = tr_read_pair(a0 + 32 * KST, a0 + 36 * KST);
                  Cacc[dtl] = Cacc[dtl] * decay;
                  Cacc[dtl] = __builtin_amdgcn_mfma_f32_16x16x32_bf16(k0, vw0, Cacc[dtl], 0, 0, 0);
                  Cacc[dtl] = __builtin_amdgcn_mfma_f32_16x16x32_bf16(k1, vw1, Cacc[dtl], 0, 0, 0); } }
            { const int d = tid & 255, hf2 = tid >> 8; float np = 0.f;
#pragma unroll 8
              for (int s2 = 0; s2 < 32; ++s2) { const int s_ = hf2 * 32 + s2; np += T[256 + s_] * bf2f(*(const LAS bf16*)(L + KS + s_ * KST + d * 2)); }
              ((LAS float*)(L + NPART))[hf2 * 256 + d] = np; }
            __syncthreads();
            { const float decay = T[320];
#pragma unroll
              for (int dtl = 0; dtl < 8; ++dtl) { const int dt = 8 * wg + dtl; v2u o; o.x = pk2(Cacc[dtl][0], Cacc[dtl][1]); o.y = pk2(Cacc[dtl][2], Cacc[dtl][3]);
                  *(LAS v2u*)(L + CTI + (16 * pt + fr) * KST + (16 * dt + 4 * fq) * 2) = o; }
              if (tid < 256) { LAS float* nt = (LAS float*)(L + NT); const LAS float* np = (const LAS float*)(L + NPART); nt[tid] = decay * nt[tid] + np[tid] + np[256 + tid]; } }
            if (has_next) STORE_KV(nxt);
            __syncthreads();
        }
#undef TOF
#undef G1_TABLES
#undef LOAD_KV
#undef STORE_KV
#undef LOAD_Q
    }
}

__device__ __forceinline__ void ym_phase(Frame& F) {
    const bf16* HF = (const bf16*)(F.ws + WS_XM); const bf16* HB = (const bf16*)(F.ws + WS_XL); bf16* OP = (bf16*)(F.ws + WS_OP);
    const float* ng = F.in[9];
    const int gw = F.bid * NWAVES + F.wave, NGW = F.G * NWAVES;
    for (int m = gw; m < MTOK; m += NGW) {
#pragma unroll
        for (int hd = 0; hd < 4; ++hd) {
            const size_t o = (size_t)m * DM + hd * 256 + F.lane * 4;
            const v2u a = *(const v2u*)(HF + o), b = *(const v2u*)(HB + o), op = *(const v2u*)(OP + o);
            const float v0 = bflo(a.x) + bflo(b.x), v1 = bfhi(a.x) + bfhi(b.x), v2 = bflo(a.y) + bflo(b.y), v3 = bfhi(a.y) + bfhi(b.y);
            const float r = rsqrtf(wave_sum((v0 * v0 + v1 * v1) + (v2 * v2 + v3 * v3)) * (1.f / 256.f) + EPS);
            const f32x4 g = *(const f32x4*)(ng + hd * 256 + F.lane * 4);
            v2u w; w.x = pk2(sigmoidf_(bflo(op.x)) * v0 * r * g[0], sigmoidf_(bfhi(op.x)) * v1 * r * g[1]);
            w.y = pk2(sigmoidf_(bflo(op.y)) * v2 * r * g[2], sigmoidf_(bfhi(op.y)) * v3 * r * g[3]);
            *(v2u*)(OP + o) = w;
        }
    }
    const int gt = F.bid * NTHR + F.tid, NGT = F.G * NTHR;
    const f32x4* us = (const f32x4*)F.in[23]; const f32x4* vs = (const f32x4*)F.in[24];
    v4u* ud = (v4u*)(F.ws + WS_LG); v4u* vd = (v4u*)(F.ws + WS_LG + 16 * MiB);
    for (int i = gt; i < NEXP * DM / 16; i += NGT) {
        v4u o, q;
#pragma unroll
        for (int j = 0; j < 4; ++j) { const f32x4 a = us[4 * i + j] * 32.f, b = vs[4 * i + j] * 4.f;
            int pa = 0, pb = 0;
            pa = __builtin_amdgcn_cvt_pk_fp8_f32(a[0], a[1], pa, false); pa = __builtin_amdgcn_cvt_pk_fp8_f32(a[2], a[3], pa, true);
            pb = __builtin_amdgcn_cvt_pk_fp8_f32(b[0], b[1], pb, false); pb = __builtin_amdgcn_cvt_pk_fp8_f32(b[2], b[3], pb, true);
            o[j] = (unsigned)pa; q[j] = (unsigned)pb; }
        ud[i] = o; vd[i] = q;
    }
}

__device__ __forceinline__ void select_ref(Frame& F) {
    const bf16* PQ = (const bf16*)(F.ws + WS_MG); const bf16* KEYS = (const bf16*)(F.ws + WS_KEYS);
    int* IDX = (int*)(F.ws + WS_K); float* GW = (float*)(F.ws + WS_K + 16 * MiB);
    LAS float* base = (LAS float*)(F.lds + F.wave * 2048);
    LAS float* sq = base;
    LAS float* sl = base + 256;
    LAS int* il = (LAS int*)(base + 288);
    LAS float* sbest = base + 320;
    LAS int* spos = (LAS int*)(base + 336);
    const int lane = F.lane;
    const int gw = F.bid * NWAVES + F.wave, NGW = F.G * NWAVES;
    for (int it = gw; it < MTOK * 8; it += NGW) {
        const int t = it >> 3, h = it & 7;
        { const v2u q4 = *(const v2u*)(PQ + (size_t)t * 2048 + h * 256 + lane * 4);
          sq[lane * 4 + 0] = bflo(q4.x); sq[lane * 4 + 1] = bfhi(q4.x); sq[lane * 4 + 2] = bflo(q4.y); sq[lane * 4 + 3] = bfhi(q4.y); }
        LDS_WAIT();
        for (int p = 0; p < 2; ++p) {
            float v0 = 0.f, v1 = 0.f;
            const v4u* k0 = (const v4u*)(KEYS + ((size_t)(h * 2 + p) * 128 + lane) * 128);
            const v4u* k1 = k0 + 64 * 16;
#pragma unroll 4
            for (int c8 = 0; c8 < 16; ++c8) {
                const v4u a = k0[c8], b = k1[c8];
                const f32x4 q0 = *(const LAS f32x4*)(sq + p * 128 + c8 * 8), q1 = *(const LAS f32x4*)(sq + p * 128 + c8 * 8 + 4);
                v0 += q0[0] * bflo(a.x) + q0[1] * bfhi(a.x) + q0[2] * bflo(a.y) + q0[3] * bfhi(a.y) + q1[0] * bflo(a.z) + q1[1] * bfhi(a.z) + q1[2] * bflo(a.w) + q1[3] * bfhi(a.w);
                v1 += q0[0] * bflo(b.x) + q0[1] * bfhi(b.x) + q0[2] * bflo(b.y) + q0[3] * bfhi(b.y) + q1[0] * bflo(b.z) + q1[1] * bfhi(b.z) + q1[2] * bflo(b.w) + q1[3] * bfhi(b.w);
            }
            for (int k = 0; k < 16; ++k) {
                float bv; int bi;
                if (v0 >= v1) { bv = v0; bi = lane; } else { bv = v1; bi = lane + 64; }
#pragma unroll
                for (int off = 32; off >= 1; off >>= 1) {
                    const float ov = __shfl_xor(bv, off); const int oi = __shfl_xor(bi, off);
                    if (ov > bv || (ov == bv && oi < bi)) { bv = ov; bi = oi; }
                }
                if (lane == 0) { sl[p * 16 + k] = bv; il[p * 16 + k] = bi; }
                if (bi == lane) v0 = -INFINITY;
                if (bi == lane + 64) v1 = -INFINITY;
            }
        }
        LDS_WAIT();
        float cv[4];
#pragma unroll
        for (int r = 0; r < 4; ++r) { const int pos = lane + 64 * r; cv[r] = sl[pos >> 4] + sl[16 + (pos & 15)]; }
        for (int k = 0; k < 16; ++k) {
            float bv = cv[0]; int bi = lane;
#pragma unroll
            for (int r = 1; r < 4; ++r) if (cv[r] > bv) { bv = cv[r]; bi = lane + 64 * r; }
#pragma unroll
            for (int off = 32; off >= 1; off >>= 1) {
                const float ov = __shfl_xor(bv, off); const int oi = __shfl_xor(bi, off);
                if (ov > bv || (ov == bv && oi < bi)) { bv = ov; bi = oi; }
            }
            if (lane == 0) { sbest[k] = bv; spos[k] = bi; }
#pragma unroll
            for (int r = 0; r < 4; ++r) if (bi == lane + 64 * r) cv[r] = -INFINITY;
        }
        LDS_WAIT();
        if (lane < 16) {
            const float mx = sbest[0];
            float sum = 0.f;
            for (int k = 0; k < 16; ++k) sum += __expf(sbest[k] - mx);
            const int pos = spos[lane];
            IDX[(size_t)t * 128 + h * 16 + lane] = il[pos >> 4] * 128 + il[16 + (pos & 15)];
            GW[(size_t)t * 128 + h * 16 + lane] = __expf(sbest[lane] - mx) / sum;
        }
        LDS_WAIT();
    }
}


typedef float f32x16 __attribute__((ext_vector_type(16)));
#define TOPK_INSERT(L, xv) do { const float x_ = (xv); \
    L[15] = __builtin_amdgcn_fmed3f(L[14], L[15], x_); L[14] = __builtin_amdgcn_fmed3f(L[13], L[14], x_); L[13] = __builtin_amdgcn_fmed3f(L[12], L[13], x_); L[12] = __builtin_amdgcn_fmed3f(L[11], L[12], x_); \
    L[11] = __builtin_amdgcn_fmed3f(L[10], L[11], x_); L[10] = __builtin_amdgcn_fmed3f(L[9], L[10], x_); L[9] = __builtin_amdgcn_fmed3f(L[8], L[9], x_); L[8] = __builtin_amdgcn_fmed3f(L[7], L[8], x_); \
    L[7] = __builtin_amdgcn_fmed3f(L[6], L[7], x_); L[6] = __builtin_amdgcn_fmed3f(L[5], L[6], x_); L[5] = __builtin_amdgcn_fmed3f(L[4], L[5], x_); L[4] = __builtin_amdgcn_fmed3f(L[3], L[4], x_); \
    L[3] = __builtin_amdgcn_fmed3f(L[2], L[3], x_); L[2] = __builtin_amdgcn_fmed3f(L[1], L[2], x_); L[1] = __builtin_amdgcn_fmed3f(L[0], L[1], x_); L[0] = fmaxf(L[0], x_); } while (0)
template <int I> struct CandRow {
    static __device__ __forceinline__ void run(const float (&L0)[16], const float (&L1)[16], float (&R)[16]) {
        constexpr int NJ = 16 / (I + 1);
#pragma unroll
        for (int j = 0; j < NJ; ++j) { const float sm = L0[I] + L1[j];
            const float pk = __builtin_bit_cast(float, (__builtin_bit_cast(unsigned, sm) & 0xffffff00u) | (unsigned)(I * 16 + j)); TOPK_INSERT(R, pk); }
        if constexpr (I < 15) CandRow<I + 1>::run(L0, L1, R);
    }
};
__device__ __forceinline__ unsigned pick4(unsigned d0, unsigned d1, unsigned d2, unsigned d3, int i) {
    const int q = i >> 2; unsigned d = d0; d = (q == 1) ? d1 : d; d = (q == 2) ? d2 : d; d = (q == 3) ? d3 : d; return (d >> (8 * (i & 3))) & 127u;
}
__device__ __forceinline__ void select_phase(Frame& F) {
    const bf16* PQ = (const bf16*)(F.ws + WS_MG); const bf16* KEYS = (const bf16*)(F.ws + WS_KEYS);
    int* IDX = (int*)(F.ws + WS_K); float* GW = (float*)(F.ws + WS_K + 16 * MiB);
    LAS unsigned char* L = F.lds;
    const int tid = F.tid, lane = F.lane, w = F.wave, l31 = lane & 31, hh = lane >> 5;
    const float NEG_INF = -INFINITY;
    for (int grp = F.bid; grp < MTOK / 128; grp += F.G) {
        const int tb = grp * 4 + (w & 3);
        const size_t m = (size_t)tb * 32 + l31;
        for (int hp = 0; hp < 4; ++hp) {
            __syncthreads();
#pragma unroll 4
            for (int r = 0; r < 16; ++r) { const int e = tid + NTHR * r, R = e >> 4, c = e & 15;
                *(LAS v4u*)(L + R * 256 + ((c ^ (R & 15)) * 16)) = *(const v4u*)(KEYS + ((size_t)(hp * 512 + R) * 128 + c * 8)); }
            __syncthreads();
            const int hl = w >> 2, h = 2 * hp + hl;
            float L0[16], L1[16];
#pragma unroll
            for (int p = 0; p < 2; ++p) {
                bf16x8 qf[8];
#pragma unroll
                for (int ks = 0; ks < 8; ++ks) qf[ks] = *(const bf16x8*)(PQ + m * 2048 + h * 256 + p * 128 + 16 * ks + 8 * hh);
                f32x16 acc[4];
#pragma unroll
                for (int kb = 0; kb < 4; ++kb)
#pragma unroll
                    for (int r = 0; r < 16; ++r) acc[kb][r] = 0.f;
#pragma unroll
                for (int ks = 0; ks < 8; ++ks)
#pragma unroll
                    for (int kb = 0; kb < 4; ++kb) { const int R = (hl * 2 + p) * 128 + 32 * kb + l31;
                        const bf16x8 kf = *(const LAS bf16x8*)(L + R * 256 + (((2 * ks + hh) ^ (lane & 15)) * 16));
                        acc[kb] = __builtin_amdgcn_mfma_f32_32x32x16_bf16(kf, qf[ks], acc[kb], 0, 0, 0); }
                float Lc[16];
#pragma unroll
                for (int i = 0; i < 16; ++i) Lc[i] = NEG_INF;
                const unsigned hh4 = (unsigned)hh << 2;
#pragma unroll
                for (int kb = 0; kb < 4; ++kb)
#pragma unroll
                    for (int r = 0; r < 16; ++r) { const unsigned nlo = (unsigned)(32 * kb + (r & 3) + 8 * (r >> 2));
                        const float av_ = acc[kb][r];
                        const float pk = __uint_as_float(((__float_as_uint(av_) & 0xffffff80u) | hh4) | nlo); TOPK_INSERT(Lc, pk); }
                float Lo[16];
#pragma unroll
                for (int i = 0; i < 16; ++i) Lo[i] = __shfl_xor(Lc[i], 32);
#pragma unroll
                for (int i = 0; i < 16; ++i) TOPK_INSERT(Lc, Lo[i]);
#pragma unroll
                for (int i = 0; i < 16; ++i) { if (p == 0) L0[i] = Lc[i]; else L1[i] = Lc[i]; }
            }
            float R[16];
#pragma unroll
            for (int i = 0; i < 16; ++i) R[i] = NEG_INF;
            CandRow<0>::run(L0, L1, R);
            unsigned a0 = 0, a1 = 0, a2 = 0, a3 = 0, b0 = 0, b1 = 0, b2 = 0, b3 = 0;
#pragma unroll
            for (int i = 0; i < 4; ++i) { a0 |= (__builtin_bit_cast(unsigned, L0[i]) & 127u) << (8 * i); a1 |= (__builtin_bit_cast(unsigned, L0[4 + i]) & 127u) << (8 * i);
                a2 |= (__builtin_bit_cast(unsigned, L0[8 + i]) & 127u) << (8 * i); a3 |= (__builtin_bit_cast(unsigned, L0[12 + i]) & 127u) << (8 * i);
                b0 |= (__builtin_bit_cast(unsigned, L1[i]) & 127u) << (8 * i); b1 |= (__builtin_bit_cast(unsigned, L1[4 + i]) & 127u) << (8 * i);
                b2 |= (__builtin_bit_cast(unsigned, L1[8 + i]) & 127u) << (8 * i); b3 |= (__builtin_bit_cast(unsigned, L1[12 + i]) & 127u) << (8 * i); }
            float ex[16]; float sum = 0.f; int id[16];
#pragma unroll
            for (int r = 0; r < 16; ++r) { ex[r] = __expf(R[r] - R[0]); sum += ex[r];
                const unsigned cid = __builtin_bit_cast(unsigned, R[r]) & 255u;
                id[r] = (int)(pick4(a0, a1, a2, a3, (int)(cid >> 4)) * 128u + pick4(b0, b1, b2, b3, (int)(cid & 15u))); }
            const float inv = 1.f / sum;
            if (hh == 0) {
#pragma unroll
                for (int q = 0; q < 4; ++q) {
                    *(int4*)(IDX + m * 128 + h * 16 + 4 * q) = make_int4(id[4 * q], id[4 * q + 1], id[4 * q + 2], id[4 * q + 3]);
                    *(f32x4*)(GW + m * 128 + h * 16 + 4 * q) = (f32x4){ex[4 * q] * inv, ex[4 * q + 1] * inv, ex[4 * q + 2] * inv, ex[4 * q + 3] * inv}; }
            }
        }
    }
}

__device__ __forceinline__ f32x2 fp8lo(unsigned w) { return __builtin_amdgcn_cvt_pk_f32_fp8((int)w, false); }
__device__ __forceinline__ f32x2 fp8hi(unsigned w) { return __builtin_amdgcn_cvt_pk_f32_fp8((int)w, true); }
__device__ __forceinline__ void apply_phase(Frame& F, float* OUTP) {
    const unsigned char* U8 = F.ws + WS_LG; const unsigned char* V8 = F.ws + WS_LG + 16 * MiB;
    const int* IDX = (const int*)(F.ws + WS_K); const float* GW = (const float*)(F.ws + WS_K + 16 * MiB);
    const float* g2 = F.in[20]; const float* gf = F.in[25];
    const float* X1 = F.out;
    const int lane = F.lane;
    const int gw = F.bid * NWAVES + F.wave, NGW = F.G * NWAVES;
    const bool b5 = (lane & 32) != 0, b4 = (lane & 16) != 0, b3 = (lane & 8) != 0, b2 = (lane & 4) != 0;
    const int eid = ((lane >> 5) & 1) * 8 + ((lane >> 4) & 1) * 4 + ((lane >> 3) & 1) * 2 + ((lane >> 2) & 1);
    for (int m = gw; m < MTOK; m += NGW) {
        f32x2 hv[8]; float s = 0.f;
#pragma unroll
        for (int q = 0; q < 4; ++q) { const f32x4 a = *(const f32x4*)(X1 + (size_t)m * DM + lane * 16 + q * 4);
            s += (a[0] * a[0] + a[1] * a[1]) + (a[2] * a[2] + a[3] * a[3]); hv[2 * q] = (f32x2){a[0], a[1]}; hv[2 * q + 1] = (f32x2){a[2], a[3]}; }
        const float r2 = rsqrtf(wave_sum(s) * (1.f / DM) + EPS) * (1.f / 32.f);
#pragma unroll
        for (int q = 0; q < 4; ++q) { const f32x4 g = *(const f32x4*)(g2 + lane * 16 + q * 4);
            hv[2 * q] = hv[2 * q] * (f32x2){g[0] * r2, g[1] * r2}; hv[2 * q + 1] = hv[2 * q + 1] * (f32x2){g[2] * r2, g[3] * r2}; }
        const int i0 = IDX[(size_t)m * 128 + lane], i1 = IDX[(size_t)m * 128 + 64 + lane];
        const float gw0 = GW[(size_t)m * 128 + lane], gw1 = GW[(size_t)m * 128 + 64 + lane];
        f32x2 acc[8];
#pragma unroll
        for (int i = 0; i < 8; ++i) acc[i] = (f32x2){0.f, 0.f};
#pragma unroll 1
        for (int bt = 0; bt < 8; ++bt) {
            const int k0 = bt * 16;
            const int isel = (k0 < 64) ? i0 : i1;
            v4u uu[16], vv[16];
#pragma unroll
            for (int e = 0; e < 16; ++e) { const size_t ro = (size_t)__builtin_amdgcn_readlane(isel, (k0 + e) & 63) * DM + lane * 16;
                uu[e] = *(const v4u*)(U8 + ro); vv[e] = *(const v4u*)(V8 + ro); }
            float x[16];
#pragma unroll
            for (int e = 0; e < 16; ++e) { f32x2 d = fp8lo(uu[e].x) * hv[0];
                d = __builtin_elementwise_fma(fp8hi(uu[e].x), hv[1], d); d = __builtin_elementwise_fma(fp8lo(uu[e].y), hv[2], d); d = __builtin_elementwise_fma(fp8hi(uu[e].y), hv[3], d);
                d = __builtin_elementwise_fma(fp8lo(uu[e].z), hv[4], d); d = __builtin_elementwise_fma(fp8hi(uu[e].z), hv[5], d); d = __builtin_elementwise_fma(fp8lo(uu[e].w), hv[6], d);
                d = __builtin_elementwise_fma(fp8hi(uu[e].w), hv[7], d); x[e] = d[0] + d[1]; }
            float y[8], z[4], u2[2], t;
#pragma unroll
            for (int j = 0; j < 8; ++j) { const float keep = b5 ? x[8 + j] : x[j], send = b5 ? x[j] : x[8 + j]; y[j] = keep + __shfl_xor(send, 32); }
#pragma unroll
            for (int j = 0; j < 4; ++j) { const float keep = b4 ? y[4 + j] : y[j], send = b4 ? y[j] : y[4 + j]; z[j] = keep + __shfl_xor(send, 16); }
#pragma unroll
            for (int j = 0; j < 2; ++j) { const float keep = b3 ? z[2 + j] : z[j], send = b3 ? z[j] : z[2 + j]; u2[j] = keep + __shfl_xor(send, 8); }
            { const float keep = b2 ? u2[1] : u2[0], send = b2 ? u2[0] : u2[1]; t = keep + __shfl_xor(send, 4); }
            t += __shfl_xor(t, 2); t += __shfl_xor(t, 1);
            const float gk = __shfl((k0 < 64) ? gw0 : gw1, (k0 + eid) & 63);
            const float wl = gk * gelu_fast(t) * 0.25f;
#pragma unroll
            for (int e = 0; e < 16; ++e) {
                const float we = __builtin_bit_cast(float, __builtin_amdgcn_readlane(__builtin_bit_cast(int, wl), 32 * (e >> 3) + 16 * ((e >> 2) & 1) + 8 * ((e >> 1) & 1) + 4 * (e & 1)));
                const f32x2 w2 = (f32x2){we, we};
                acc[0] = __builtin_elementwise_fma(fp8lo(vv[e].x), w2, acc[0]); acc[1] = __builtin_elementwise_fma(fp8hi(vv[e].x), w2, acc[1]);
                acc[2] = __builtin_elementwise_fma(fp8lo(vv[e].y), w2, acc[2]); acc[3] = __builtin_elementwise_fma(fp8hi(vv[e].y), w2, acc[3]);
                acc[4] = __builtin_elementwise_fma(fp8lo(vv[e].z), w2, acc[4]); acc[5] = __builtin_elementwise_fma(fp8hi(vv[e].z), w2, acc[5]);
                acc[6] = __builtin_elementwise_fma(fp8lo(vv[e].w), w2, acc[6]); acc[7] = __builtin_elementwise_fma(fp8hi(vv[e].w), w2, acc[7]);
            }
        }
        float s2 = 0.f;
#pragma unroll
        for (int q = 0; q < 4; ++q) { const f32x4 a = *(const f32x4*)(X1 + (size_t)m * DM + lane * 16 + q * 4);
            acc[2 * q] = acc[2 * q] + (f32x2){a[0], a[1]}; acc[2 * q + 1] = acc[2 * q + 1] + (f32x2){a[2], a[3]};
            s2 += (acc[2 * q][0] * acc[2 * q][0] + acc[2 * q][1] * acc[2 * q][1]) + (acc[2 * q + 1][0] * acc[2 * q + 1][0] + acc[2 * q + 1][1] * acc[2 * q + 1][1]); }
        const float rf = rsqrtf(wave_sum(s2) * (1.f / DM) + EPS);
#pragma unroll
        for (int q = 0; q < 4; ++q) { const f32x4 g = *(const f32x4*)(gf + lane * 16 + q * 4);
            *(f32x4*)(OUTP + (size_t)m * DM + lane * 16 + q * 4) = (f32x4){acc[2 * q][0] * rf * g[0], acc[2 * q][1] * rf * g[1], acc[2 * q + 1][0] * rf * g[2], acc[2 * q + 1][1] * rf * g[3]}; }
    }
}

constexpr int N_PHASES = 13;
__global__ void __launch_bounds__(NTHR, 2) mega_fwd(Args args) {
    extern __shared__ __attribute__((aligned(16))) unsigned char lds[];
    Frame F;
    F.lds = (LAS unsigned char*)lds;
    F.tid = threadIdx.x; F.lane = F.tid & 63; F.wave = __builtin_amdgcn_readfirstlane(F.tid >> 6);
    F.G = gridDim.x; F.bid = blockIdx.x;
    F.in = args.in; F.out = args.out; F.ws = args.ws;
    volatile LAS unsigned* MISC = (volatile LAS unsigned*)(F.lds + MISC_OFF);
    for (int u = F.tid; u < (LDS_BYTES - LDSCTL_OFF) / 4; u += NTHR) ((LAS unsigned*)(F.lds + LDSCTL_OFF))[u] = 0u;
    __syncthreads();
    XcdBarrier bar; bar.bar = (unsigned*)(args.ws + WS_CTL) + CW_BAR; bar.x = 0; bar.st = nullptr;
    const bool one_launch = (args.ph_hi - args.ph_lo) > 1;
    if (one_launch) bar = xcd_barrier_post((unsigned*)(args.ws + WS_CTL) + CW_BAR, MISC + 8);
    const int lo = args.ph_lo, hi = args.ph_hi;
#define IN(k) (lo <= (k) && (k) < hi)
#define SEAM(k) do { if (IN(k) && IN((k) + 1)) xcd_barrier(bar); } while (0)
    unsigned char* ws = args.ws;

#ifndef PROBE_MASK
#define PROBE_MASK 0
#endif
#define REP(k) for (int rep_ = 0; rep_ < (((PROBE_MASK >> (k)) & 1) ? 2 : 1); ++rep_)
    if (IN(0)) REP(0) { p0_prologue(F); if (rep_ == 0 && ((PROBE_MASK >> 0) & 1)) xcd_barrier(bar); } SEAM(0);
    if (IN(1)) REP(1) {
        AddrPlain g{(const char*)F.out, (const char*)(ws + WS_WIN), 1024, 1024, 1024};
        pg8::StaticOrder S; S.init(MTOK, 6144, F.G, F.bid);
        EpiBf16<DstP1> E{DstP1{ws}};
        pg8::gemm_phase(F.lds, g, S, E);
    } SEAM(1);
    if (IN(2)) REP(2) { lru_phase<false>(F); } SEAM(2);
    if (IN(3)) REP(3) { lru_phase<true>(F); } SEAM(3);
    if (IN(4)) REP(4) { mconv_phase(F); } SEAM(4);
    if (IN(5)) REP(5) {
        AddrQKV g{(const char*)(ws + WS_XL), (long)WS_XM - (long)WS_XL, (const char*)(ws + WS_WQKV), 1024, 256, 256};
        pg8::StaticOrder S; S.init(MTOK, 12 * 256, F.G, F.bid);
        EpiBf16<DstQKV> E{DstQKV{(char*)(ws + WS_LG), (long)WS_K - (long)WS_LG, (long)((char*)F.out + (size_t)MTOK * DM * 2 - (char*)(ws + WS_LG))}};
        pg8::gemm_phase(F.lds, g, S, E);
    } SEAM(5);
    if (IN(6)) REP(6) { mscan_phase(F); } SEAM(6);
    if (IN(7)) { ym_phase(F); } SEAM(7);
    if (IN(8)) {
        AddrBranch g{(const char*)(ws + WS_OP), (long)((const char*)F.out - (const char*)(ws + WS_OP)), (const char*)(ws + WS_WB2), 1024, 1024, 1024};
        pg8::StaticOrder S; S.init(MTOK, 2048, F.G, F.bid);
        EpiGate E{(bf16*)(ws + WS_MG)};
        pg8::gemm_phase(F.lds, g, S, E);
    } SEAM(8);
    if (IN(9)) {
        AddrPlain g{(const char*)(ws + WS_MG), (const char*)(ws + WS_WOUT2), 2048, 2048, 2048};
        pg8::StaticOrder S; S.init(MTOK, 1024, F.G, F.bid);
        EpiResid E{F.in[0], F.out, (bf16*)(ws + WS_XM), (float*)(ws + WS_SS)};
        pg8::gemm_phase(F.lds, g, S, E);
    } SEAM(9);
    if (IN(10)) REP(10) {
        AddrPlain g{(const char*)(ws + WS_XM), (const char*)(ws + WS_WPQ), 1024, 1024, 1024};
        pg8::StaticOrder S; S.init(MTOK, 2048, F.G, F.bid);
        EpiPQ E{(bf16*)(ws + WS_MG), (const float*)(ws + WS_SS)};
        pg8::gemm_phase(F.lds, g, S, E);
    } SEAM(10);
    if (IN(11)) REP(11) { select_phase(F); } SEAM(11);
    if (IN(12)) { if ((PROBE_MASK >> 12) & 1) { apply_phase(F, (float*)(ws + WS_MG)); xcd_barrier(bar); } apply_phase(F, F.out); }
#undef REP
#undef IN
#undef SEAM
}

extern "C" void kernel_launch(void* const* d_in, const int* in_sizes, int n_in, void* d_out, int out_size, void* d_ws, size_t ws_size, hipStream_t stream) {
    static int grid = 0;
    if (grid == 0) {
        if (n_in != 26 || in_sizes[0] != MTOK * DM || out_size != MTOK * DM || ws_size < WS_END) { fprintf(stderr, "kernel_launch: unexpected shapes / workspace (%zu < %zu)\n", ws_size, (size_t)WS_END); grid = -1; return; }
        int dev = 0, cus = 0, per_cu = 0;
        if (hipGetDevice(&dev) != hipSuccess || hipDeviceGetAttribute(&cus, hipDeviceAttributeMultiprocessorCount, dev) != hipSuccess) { grid = -1; return; }
        if (hipFuncSetAttribute((const void*)mega_fwd, hipFuncAttributeMaxDynamicSharedMemorySize, LDS_BYTES) != hipSuccess) { fprintf(stderr, "kernel_launch: hipFuncSetAttribute failed\n"); grid = -1; return; }
        if (hipOccupancyMaxActiveBlocksPerMultiprocessor(&per_cu, (const void*)mega_fwd, NTHR, LDS_BYTES) != hipSuccess || per_cu < 1) { fprintf(stderr, "kernel_launch: occupancy query says %d blocks/CU\n", per_cu); (void)hipGetLastError(); grid = -1; return; }
        grid = cus;
    }
    if (grid < 0) return;
    (void)hipMemsetAsync((char*)d_ws + WS_CTL, 0, CTL_ZERO_BYTES, stream);
    Args a{};
    for (int i = 0; i < 26; ++i) a.in[i] = (const float*)d_in[i];
    a.out = (float*)d_out; a.ws = (unsigned char*)d_ws;
#if MK_N_LAUNCHES == 1
    a.ph_lo = 0; a.ph_hi = N_PHASES;
    void* kargs[] = {&a};
    hipError_t e = hipLaunchCooperativeKernel((const void*)mega_fwd, dim3(grid), dim3(NTHR), kargs, LDS_BYTES, stream);
    if (e != hipSuccess) fprintf(stderr, "kernel_launch: cooperative launch failed: %s (grid %d)\n", hipGetErrorString(e), grid);
#else
    for (int p = 0; p < N_PHASES; ++p) { a.ph_lo = p; a.ph_hi = p + 1; hipLaunchKernelGGL(mega_fwd, dim3(grid), dim3(NTHR), LDS_BYTES, stream, a); }
#endif
}
```

```cpp
#include <hip/hip_runtime.h>
#include <cstdio>
#include <cstdint>
#include <math.h>

#ifndef MK_N_LAUNCHES
#define MK_N_LAUNCHES 1
#endif

constexpr int BATCH = 8, SEQ = 4096, DM = 1024, MTOK = BATCH * SEQ;
constexpr int DIN = 6160;
constexpr int NEXP = 16384;
constexpr float EPS = 1e-6f;

constexpr size_t MiB = 1u << 20;
constexpr size_t WS_CTL = 0, CTL_ZERO_BYTES = 1 * MiB;
constexpr size_t WS_WIN = 1 * MiB;
constexpr size_t WS_WQKV = 13 * MiB;
constexpr size_t WS_KEYS = 14 * MiB + 512 * 1024;
constexpr size_t WS_WLRU = 15 * MiB;
constexpr size_t WS_WB2 = 16 * MiB;
constexpr size_t WS_WOUT2 = 20 * MiB;
constexpr size_t WS_WPQ = 24 * MiB;
constexpr size_t WS_GATE = 28 * MiB;
constexpr size_t WS_XM = 32 * MiB;
constexpr size_t WS_OP = 96 * MiB;
constexpr size_t WS_XL = 160 * MiB;
constexpr size_t WS_LG = 224 * MiB;
constexpr size_t WS_MG = 288 * MiB;
constexpr size_t WS_K = 416 * MiB;
constexpr size_t WS_AGG = 480 * MiB;
constexpr size_t WS_SS = 488 * MiB;
constexpr size_t WS_END = 489 * MiB;

constexpr int CW_BAR = 4096;

constexpr int RING_BYTES = 131072;
constexpr int LDS_BYTES = 147456;
constexpr int LDSCTL_OFF = LDS_BYTES - 512, MISC_OFF = LDSCTL_OFF + 320;
constexpr int NWAVES = 8, NTHR = 512;

#define GAS __attribute__((address_space(1)))
#define LAS __attribute__((address_space(3)))
typedef unsigned short bf16;
typedef unsigned v4u __attribute__((ext_vector_type(4)));
typedef unsigned v2u __attribute__((ext_vector_type(2)));
typedef float f32x4 __attribute__((ext_vector_type(4)));
typedef float f32x2 __attribute__((ext_vector_type(2)));
typedef short bf16x8 __attribute__((ext_vector_type(8)));
typedef GAS unsigned gu32;
#define RLX_AGENT __ATOMIC_RELAXED, __HIP_MEMORY_SCOPE_AGENT
#define LDS_WAIT() asm volatile("s_waitcnt lgkmcnt(0)" ::: "memory")
#define VM_WAIT() asm volatile("s_waitcnt vmcnt(0)" ::: "memory")

__device__ __forceinline__ unsigned f2bf(float f) { unsigned u = __builtin_bit_cast(unsigned, f); return (u + 0x7fffu + ((u >> 16) & 1u)) >> 16; }
__device__ __forceinline__ unsigned pk2(float lo, float hi) { return f2bf(lo) | (f2bf(hi) << 16); }
__device__ __forceinline__ float bf2f(unsigned short h) { return __builtin_bit_cast(float, (unsigned)h << 16); }
__device__ __forceinline__ float bflo(unsigned w) { return __builtin_bit_cast(float, w << 16); }
__device__ __forceinline__ float bfhi(unsigned w) { return __builtin_bit_cast(float, w & 0xffff0000u); }
__device__ __forceinline__ float wave_sum(float v) {
#pragma unroll
  for (int o = 1; o < 64; o <<= 1) v += __shfl_xor(v, o);
  return v;
}
__device__ __forceinline__ float sigmoidf_(float x) { return __builtin_amdgcn_rcpf(1.f + __builtin_amdgcn_exp2f(x * -1.44269504089f)); }
__device__ __forceinline__ float gelu_erf(float x) { return 0.5f * x * (1.f + erff(x * 0.70710678118654752f)); }
__device__ __forceinline__ float gelu_fast(float v) {
    const float av = fabsf(v), t = __builtin_amdgcn_rcpf(av * 0.2316418882f + 1.0f);
    float q = t * 0.5307027145f + (-0.7265760135f); q = q * t + 0.7107068705f; q = q * t + (-0.142248368f); q = q * t + 0.127414796f; q = q * t;
    const float e = __builtin_amdgcn_exp2f((v * v) * (-0.72134752044f));
    const float m = v * (q * e);
    return v < 0.f ? m : v - m;
}
__device__ __forceinline__ float softplusf_(float x) { return fmaxf(x, 0.f) + log1pf(expf(-fabsf(x))); }

namespace pg8 {
#define PG8_LAS __attribute__((address_space(3)))
typedef unsigned short bf16_t;
typedef unsigned u32x4 __attribute__((ext_vector_type(4)));
constexpr int BM = 256, BK = 64, HALF = 128, HTB = HALF * BK * 2, STAGE_BYTES = 8 * HTB, NXCD = 8, WGM = 8;

__host__ __device__ __forceinline__ int lds_byte(int r, int c) { const int st = (r >> 4) * 2 + (c >> 5), rr = r & 15, cc = c & 31, ob = rr * 64 + cc * 2; return st * 1024 + (ob ^ (((ob >> 9) & 1) << 5)); }
__host__ __device__ __forceinline__ void stage_rc(int b, int& R, int& C) { const int st = b / 1024, sb = b % 1024, swz = sb ^ (((sb >> 9) & 1) << 5); R = (st >> 1) * 16 + swz / 64; C = (st & 1) * 32 + (swz % 64) / 2; }
__host__ __device__ __forceinline__ int perm32(int rho) { const int n = rho >> 4, i = rho & 15; return 8 * (i >> 2) + 4 * n + (i & 3); }

struct Unit { int pm, pn; };
struct StaticOrder {
    int nM, nN, nwg, G, c;
    __host__ __device__ void init(int M, int N, int G_, int c_) { nM = M / BM; nN = N / BM; nwg = nM * nN; G = G_; c = c_; }
    __host__ __device__ bool next(int i, Unit& u) const {
        const long L = (long)i * G + c; if (L >= nwg) return false;
        int wgid = (int)L; { const int q = nwg / NXCD, r = nwg % NXCD, xcd = wgid % NXCD, off = wgid / NXCD; wgid = (xcd < r ? xcd * (q + 1) : r * (q + 1) + (xcd - r) * q) + off; }
        const int nig = WGM * nN, gid = wgid / nig, fm = gid * WGM, gsz = (nM - fm) < WGM ? (nM - fm) : WGM;
        u.pm = fm + ((wgid % nig) % gsz); u.pn = (wgid % nig) / gsz; return true;
    }
};

__device__ __forceinline__ unsigned cvt_pk_bf16(float lo, float hi) { unsigned r; asm volatile("v_cvt_pk_bf16_f32 %0, %1, %2" : "=v"(r) : "v"(lo), "v"(hi)); return r; }

template <class Epi, class Addr>
__device__ __forceinline__ void gemm_phase(PG8_LAS unsigned char* lds, const Addr g, const StaticOrder& S, const Epi& E) {
    const int tid = threadIdx.x, wid = __builtin_amdgcn_readfirstlane(tid >> 6), lane = tid & 63, wr = wid >> 2, wc = wid & 3, fr = lane & 15, fq = lane >> 4;
    const int K = g.K, nt = K / BK;
    unsigned voffA[2], voffB[2];
#pragma unroll
    for (int i = 0; i < 2; ++i) { int R, C; stage_rc(tid * 16 + i * 8192, R, C); const int Rb = Epi::PERM ? ((R & ~31) + perm32(R & 31)) : R;
        voffA[i] = (unsigned)(R * g.lda + C) * 2u; voffB[i] = (unsigned)(Rb * g.ldb + C) * 2u; }
    const size_t kstep = (size_t)(BK * 2);
    const size_t hsA = (size_t)HALF * g.lda * 2, hsB = (size_t)HALF * g.ldb * 2;
    const unsigned ldsw = (unsigned)wid * 1024u;
    const int aoff = lds_byte(wr * 64 + fr, fq * 8), boff = lds_byte(wc * 32 + fr, fq * 8);
#define PG8_SA(b, h) (((b) * 2 + (h)) * HTB)
#define PG8_SB(b, h) ((4 + (b) * 2 + (h)) * HTB)
#define PG8_STAGE(bufoff, gbase, voff) do { _Pragma("unroll") for (int _i = 0; _i < 2; ++_i) \
        __builtin_amdgcn_global_load_lds((const unsigned*)((const char*)(gbase) + (voff)[_i]), (PG8_LAS unsigned*)(lds + (bufoff) + ldsw + _i * 8192), 16, 0, 0); } while (0)
#define PG8_LDA(dst, b, h) do { _Pragma("unroll") for (int m = 0; m < 4; ++m) _Pragma("unroll") for (int k = 0; k < 2; ++k) dst[m][k] = *(const PG8_LAS bf16x8*)(lds + PG8_SA(b, h) + aoff + m * 2048 + k * 1024); } while (0)
#define PG8_LDB(dst, b, h) do { _Pragma("unroll") for (int n = 0; n < 2; ++n) _Pragma("unroll") for (int k = 0; k < 2; ++k) dst[n][k] = *(const PG8_LAS bf16x8*)(lds + PG8_SB(b, h) + boff + n * 2048 + k * 1024); } while (0)
#define PG8_MMA(ai, bj, At, Bt) do { __builtin_amdgcn_s_setprio(1); _Pragma("unroll") for (int m = 0; m < 4; ++m) _Pragma("unroll") for (int n = 0; n < 2; ++n) _Pragma("unroll") for (int k = 0; k < 2; ++k) \
        acc[ai][bj][m][n] = __builtin_amdgcn_mfma_f32_16x16x32_bf16(Bt[n][k], At[m][k], acc[ai][bj][m][n], 0, 0, 0); __builtin_amdgcn_s_setprio(0); } while (0)
#define PG8_WAIT_V(n) asm volatile("s_waitcnt vmcnt(" #n ")" ::: "memory")
#define PG8_WAIT_L(n) asm volatile("s_waitcnt lgkmcnt(" #n ")" ::: "memory")
#define PG8_BAR __builtin_amdgcn_s_barrier()
#define PG8_SCHED __builtin_amdgcn_sched_barrier(0)
    Unit cur, nxt; int ui = 0;
    if (!S.next(0, cur)) return;
    f32x4 acc[2][2][4][2];
#pragma unroll
    for (int a = 0; a < 2; ++a)
#pragma unroll
        for (int b = 0; b < 2; ++b)
#pragma unroll
            for (int m = 0; m < 4; ++m)
#pragma unroll
                for (int n = 0; n < 2; ++n) acc[a][b][m][n] = (f32x4){0.f, 0.f, 0.f, 0.f};
    bf16x8 At[4][2], B0[2][2], B1[2][2];
    const char* cA = g.a(cur); const char* cB = g.b(cur);
    PG8_STAGE(PG8_SB(0, 0), cB, voffB); PG8_STAGE(PG8_SB(0, 1), cB + hsB, voffB); PG8_STAGE(PG8_SA(0, 0), cA, voffA); PG8_STAGE(PG8_SA(0, 1), cA + hsA, voffA);
    if (wr == 1) PG8_BAR;
    PG8_WAIT_V(2); PG8_BAR;
    PG8_STAGE(PG8_SB(1, 0), cB + kstep, voffB); PG8_STAGE(PG8_SA(1, 0), cA + kstep, voffA); PG8_STAGE(PG8_SB(1, 1), cB + hsB + kstep, voffB);
    PG8_WAIT_V(6); PG8_BAR;
    for (;;) {
        const bool has_next = S.next(ui + 1, nxt);
        const char* nA = has_next ? g.a(nxt) : cA; const char* nB = has_next ? g.b(nxt) : cB;
#pragma unroll 1
        for (int t = 0; t < nt; t += 2) {
            const bool last = (t == nt - 2);
            const char* a1 = cA + (size_t)(t + 1) * kstep;
            const char* a2 = last ? nA : cA + (size_t)(t + 2) * kstep; const char* b2 = last ? nB : cB + (size_t)(t + 2) * kstep;
            const char* a3 = a2 + kstep; const char* b3 = b2 + kstep;
            PG8_LDB(B0, 0, 0); PG8_LDB(B1, 0, 1); PG8_SCHED; PG8_LDA(At, 0, 0); PG8_STAGE(PG8_SA(1, 1), a1 + hsA, voffA);
            PG8_WAIT_V(8); PG8_WAIT_L(0); PG8_BAR; PG8_MMA(0, 0, At, B0); PG8_MMA(0, 1, At, B1); PG8_BAR; PG8_SCHED;
            PG8_LDA(At, 0, 1); PG8_STAGE(PG8_SB(0, 0), b2, voffB); PG8_STAGE(PG8_SB(0, 1), b2 + hsB, voffB); PG8_STAGE(PG8_SA(0, 0), a2, voffA);
            PG8_WAIT_V(8); PG8_WAIT_L(0); PG8_BAR; PG8_MMA(1, 0, At, B0); PG8_MMA(1, 1, At, B1); PG8_BAR; PG8_SCHED;
            PG8_LDB(B0, 1, 0); PG8_LDB(B1, 1, 1); PG8_SCHED; PG8_LDA(At, 1, 0); PG8_STAGE(PG8_SA(0, 1), a2 + hsA, voffA);
            PG8_WAIT_V(8); PG8_WAIT_L(0); PG8_BAR; PG8_MMA(0, 0, At, B0); PG8_MMA(0, 1, At, B1); PG8_BAR; PG8_SCHED;
            PG8_LDA(At, 1, 1); PG8_STAGE(PG8_SB(1, 0), b3, voffB); PG8_STAGE(PG8_SB(1, 1), b3 + hsB, voffB); PG8_STAGE(PG8_SA(1, 0), a3, voffA);
            PG8_WAIT_V(8); PG8_WAIT_L(0); PG8_BAR; PG8_MMA(1, 0, At, B0); PG8_MMA(1, 1, At, B1); PG8_BAR; PG8_SCHED;
        }
        if (wr == 0) PG8_BAR;
        E(acc, cur, wr, wc, fr, fq);
        if (!has_next) break;
#pragma unroll
        for (int a = 0; a < 2; ++a)
#pragma unroll
            for (int b = 0; b < 2; ++b)
#pragma unroll
                for (int m = 0; m < 4; ++m)
#pragma unroll
                    for (int n = 0; n < 2; ++n) acc[a][b][m][n] = (f32x4){0.f, 0.f, 0.f, 0.f};
        cur = nxt; cA = nA; cB = nB; ++ui;
        if (wr == 1) PG8_BAR;
    }
    PG8_WAIT_V(0);
    PG8_BAR;
#undef PG8_SA
#undef PG8_SB
#undef PG8_STAGE
#undef PG8_LDA
#undef PG8_LDB
#undef PG8_MMA
#undef PG8_WAIT_V
#undef PG8_WAIT_L
#undef PG8_BAR
#undef PG8_SCHED
}
}

#define XB_TMO      128
#define XB_XCNT(j)  (256  + 64 * (j))
#define XB_XSUB(j)  (1280 + 64 * (j))
#define XB_XGEN(j)  (2304 + 64 * (j))
#define XB_TOP      3328
#define XB_TOPGEN   3392
#define XCD_BAR_WORDS 3456
#define XB_SPIN_CAP (1u << 18)
__device__ __forceinline__ unsigned xb_ld(unsigned* p)              { return __hip_atomic_load(p, __ATOMIC_RELAXED, __HIP_MEMORY_SCOPE_AGENT); }
__device__ __forceinline__ unsigned xb_add(unsigned* p, unsigned v) { return __hip_atomic_fetch_add(p, v, __ATOMIC_RELAXED, __HIP_MEMORY_SCOPE_AGENT); }
__device__ __forceinline__ unsigned xb_xcc_id() { return (unsigned)__builtin_amdgcn_s_getreg((3 << 11) | 20) & 0xFu; }
#define XB_SPIN(cond, bar) do { unsigned _sp = 0; while (cond) { __builtin_amdgcn_s_sleep(1); \
    if ((++_sp & 255u) == 0u) { if (xb_ld(&(bar)[XB_TMO])) break; if (_sp > XB_SPIN_CAP) { atomicAdd(&(bar)[XB_TMO], 1u); break; } } } } while (0)
struct XcdBarrier { unsigned* bar; unsigned x; volatile LAS unsigned* st; };
__device__ __forceinline__ XcdBarrier xcd_barrier_post(unsigned* bar, volatile LAS unsigned* st) {
    XcdBarrier b; b.bar = bar; b.x = xb_xcc_id(); b.st = st;
    if (threadIdx.x == 0) (void)xb_add(&bar[XB_XCNT(b.x)], 1u);
    return b;
}
__device__ __forceinline__ void xcd_barrier_complete(unsigned* bar, unsigned x, unsigned& nloc, unsigned& nx) {
    const unsigned G = gridDim.x * gridDim.y * gridDim.z;
    unsigned sum, cnt, mine, sp = 0u;
    for (;;) {
        sum = 0u; cnt = 0u; mine = 0u;
#pragma unroll
        for (unsigned j = 0; j < 16; ++j) { const unsigned c = xb_ld(&bar[XB_XCNT(j)]); sum += c; cnt += (c > 0u) ? 1u : 0u; mine = (j == x) ? c : mine; }
        if (sum == G) break;
        __builtin_amdgcn_s_sleep(1);
        if ((++sp & 255u) == 0u) { if (xb_ld(&bar[XB_TMO])) break; if (sp > XB_SPIN_CAP) { atomicAdd(&bar[XB_TMO], 1u); break; } }
    }
    nloc = mine > 0u ? mine : 1u; nx = cnt > 0u ? cnt : 1u;
}
__device__ __forceinline__ void xcd_barrier(const XcdBarrier& b) {
    asm volatile("s_waitcnt vmcnt(0)" ::: "memory");
    __syncthreads();
    if (threadIdx.x == 0) {
        unsigned* bar = b.bar;
        __builtin_amdgcn_s_waitcnt(0);
        unsigned nloc = b.st[0], nx = b.st[1];
        if (nloc == 0u) { xcd_barrier_complete(bar, b.x, nloc, nx); b.st[0] = nloc; b.st[1] = nx; }
        const unsigned old = xb_add(&bar[XB_XSUB(b.x)], 1u);
        const unsigned gen = old / nloc;
        if (old + 1u == (gen + 1u) * nloc) {
            __builtin_amdgcn_fence(__ATOMIC_RELEASE, "agent");
            asm volatile("s_waitcnt vmcnt(0)" ::: "memory");
            const unsigned og = xb_add(&bar[XB_TOP], 1u);
            const unsigned tg = og / nx;
            if (og + 1u == (tg + 1u) * nx) xb_add(&bar[XB_TOPGEN], 1u);
            else XB_SPIN(xb_ld(&bar[XB_TOPGEN]) == tg, bar);
            __builtin_amdgcn_fence(__ATOMIC_ACQUIRE, "agent");
            xb_add(&bar[XB_XGEN(b.x)], 1u);
            asm volatile("s_waitcnt vmcnt(0)" ::: "memory");
        } else {
            XB_SPIN(xb_ld(&bar[XB_XGEN(b.x)]) == gen, bar);
            __builtin_amdgcn_fence(__ATOMIC_ACQUIRE, "agent");
            asm volatile("s_waitcnt vmcnt(0)" ::: "memory");
        }
    }
    __syncthreads();
}

struct Args { const float* in[26]; float* out; unsigned char* ws; int ph_lo, ph_hi; };
struct Frame {
    LAS unsigned char* lds;
    int tid, lane, wave, G, bid;
    const float* const* in; float* out; unsigned char* ws;
};

__device__ __forceinline__ void tr_item(const float* W, int ldw, bf16* WT, int ldt, float scale, const float* kscale, LAS float* scr, int k0, int lane) {
#pragma unroll 8
    for (int i = 0; i < 32; ++i) { const int kk = 2 * i + (lane >> 5); float v = W[(size_t)(k0 + kk) * ldw + (lane & 31)] * scale; if (kscale) v *= kscale[k0 + kk]; scr[kk * 33 + (lane & 31)] = v; }
    LDS_WAIT(); asm volatile("" ::: "memory");
    const int c = lane & 7;
#pragma unroll
    for (int j = 0; j < 4; ++j) { const int n = (lane >> 3) + 8 * j; const LAS float* s = scr + (8 * c) * 33 + n;
        v4u o; o.x = pk2(s[0 * 33], s[1 * 33]); o.y = pk2(s[2 * 33], s[3 * 33]); o.z = pk2(s[4 * 33], s[5 * 33]); o.w = pk2(s[6 * 33], s[7 * 33]);
        *(GAS v4u*)(WT + (size_t)n * ldt + k0 + 8 * c) = o; }
    LDS_WAIT(); asm volatile("" ::: "memory");
}

__device__ __forceinline__ void p0_prologue(Frame& F) {
    LAS float* scr = (LAS float*)(F.lds + F.wave * 16384);
    const int gw = F.bid * NWAVES + F.wave, NGW = F.G * NWAVES;
    unsigned char* ws = F.ws;
    const float* w_in = F.in[2];
    constexpr int I_WIN = 16 * 192, I_QKV = 12 * 32, I_LRU = 32 * 8, I_WB = 2 * 512, I_WO = 2 * 512, I_PQ = 16 * 64;
    constexpr int NITEMS = I_WIN + I_QKV + I_LRU + I_WB + I_WO + I_PQ;
    for (int it = gw; it < NITEMS; it += NGW) {
        int r = it;
        if (r < I_WIN) { const int kb = r / 192, nb = r % 192, n0 = nb * 32, sc = n0 < 2048 ? n0 : n0 + 16;
            tr_item(w_in + sc, DIN, (bf16*)(ws + WS_WIN) + (size_t)n0 * 1024, 1024, 1.f, nullptr, scr, kb * 64, F.lane); continue; }
        r -= I_WIN;
        if (r < I_QKV) { const int mat = r / 32, rr = r % 32, kb = rr / 8, nb = rr % 8, g = mat >> 2, h = mat & 3;
            const float* W = F.in[6 + g] + (size_t)h * 65536 + nb * 32;
            tr_item(W, 256, (bf16*)(ws + WS_WQKV) + (size_t)mat * 65536 + (size_t)(nb * 32) * 256, 256, g == 1 ? 0.0625f : 1.f, nullptr, scr, kb * 64, F.lane); continue; }
        r -= I_QKV;
        if (r < I_LRU) { const int mat = r / 8, rr = r % 8, kb = rr / 4, nb = rr % 4, gate = mat & 1, db = mat >> 1;
            const float* W = F.in[gate ? 14 : 12] + (size_t)db * 16384 + nb * 32;
            tr_item(W, 128, (bf16*)(ws + WS_WLRU) + (size_t)mat * 16384 + (size_t)(nb * 32) * 128, 128, 1.f, nullptr, scr, kb * 64, F.lane); continue; }
        r -= I_LRU;
        if (r < I_WB) { const int mat = r / 512, rr = r % 512, kb = rr / 32, nb = rr % 32;
            const float* W = F.in[17 + mat] + nb * 32;
            tr_item(W, 1024, (bf16*)(ws + WS_WB2) + (size_t)(mat * 1024 + nb * 32) * 1024, 1024, 1.f, nullptr, scr, kb * 64, F.lane); continue; }
        r -= I_WB;
        if (r < I_WO) { const int cp = r / 512, rr = r % 512, kb = rr / 32, nb = rr % 32;
            const float* W = F.in[19] + nb * 32;
            tr_item(W, 1024, (bf16*)(ws + WS_WOUT2) + (size_t)(nb * 32) * 2048 + cp * 1024, 2048, 1.f, nullptr, scr, kb * 64, F.lane); continue; }
        r -= I_WO;
        { const int kb = r / 64, nb = r % 64;
            const float* W = F.in[21] + nb * 32;
            tr_item(W, 2048, (bf16*)(ws + WS_WPQ) + (size_t)(nb * 32) * 1024, 1024, 1.f, F.in[20], scr, kb * 64, F.lane); }
    }
    { const int gt = F.bid * NTHR + F.tid, NGT = F.G * NTHR;
      const float4* ks = (const float4*)F.in[22]; v2u* kd = (v2u*)(ws + WS_KEYS);
      for (int i = gt; i < 8 * 2 * 128 * 128 / 4; i += NGT) { const float4 v = ks[i]; v2u o; o.x = pk2(v.x, v.y); o.y = pk2(v.z, v.w); kd[i] = o; }
      float* ss = (float*)(ws + WS_SS);
      for (int i = gt; i < MTOK; i += NGT) ss[i] = 0.f; }
    const float* x = F.in[0]; const float* g1 = F.in[1]; const float* bg = F.in[3];
    bf16* XN = (bf16*)F.out;
    float* GT = (float*)(ws + WS_GATE);
    f32x4 gv[4];
#pragma unroll
    for (int j = 0; j < 4; ++j) gv[j] = ((const f32x4*)g1)[F.lane + 64 * j];
    for (int m = gw; m < MTOK; m += NGW) {
        const f32x4* xr = (const f32x4*)(x + (size_t)m * DM) + F.lane;
        f32x4 v[4]; float s = 0.f;
#pragma unroll
        for (int j = 0; j < 4; ++j) { v[j] = xr[64 * j]; s += (v[j].x * v[j].x + v[j].y * v[j].y) + (v[j].z * v[j].z + v[j].w * v[j].w); }
        const float rstd = rsqrtf(wave_sum(s) * (1.f / DM) + EPS);
        unsigned long long* o8 = (unsigned long long*)(XN + (size_t)m * DM) + F.lane;
        float pg[16];
#pragma unroll
        for (int c = 0; c < 16; ++c) pg[c] = 0.f;
#pragma unroll
        for (int j = 0; j < 4; ++j) {
            v[j] = v[j] * rstd * gv[j];
            o8[64 * j] = (unsigned long long)pk2(v[j].x, v[j].y) | ((unsigned long long)pk2(v[j].z, v[j].w) << 32);
#pragma unroll
            for (int e = 0; e < 4; ++e) {
                const int k = 4 * (F.lane + 64 * j) + e;
                const f32x4* wr = (const f32x4*)(w_in + (size_t)k * DIN + 2048);
                const float hv = v[j][e];
#pragma unroll
                for (int q = 0; q < 4; ++q) { const f32x4 w4 = wr[q]; pg[4 * q] += hv * w4.x; pg[4 * q + 1] += hv * w4.y; pg[4 * q + 2] += hv * w4.z; pg[4 * q + 3] += hv * w4.w; }
            }
        }
        float mine = 0.f;
#pragma unroll
        for (int c = 0; c < 16; ++c) { const float t = wave_sum(pg[c]); if (F.lane == c) mine = t; }
        if (F.lane < 16) GT[(size_t)m * 16 + F.lane] = mine + bg[F.lane];
    }
}

struct AddrPlain {
    const char* A; const char* Bt; int lda, ldb, K;
    __device__ __forceinline__ const char* a(const pg8::Unit& u) const { return A + (size_t)u.pm * 256 * lda * 2; }
    __device__ __forceinline__ const char* b(const pg8::Unit& u) const { return Bt + (size_t)u.pn * 256 * ldb * 2; }
};
struct AddrQKV {
    const char* XC; long dXM; const char* W; int lda, ldb, K;
    __device__ __forceinline__ const char* a(const pg8::Unit& u) const { return XC + (u.pn < 8 ? 0l : dXM) + ((size_t)u.pm * 256 * 1024 + (u.pn & 3) * 256) * 2; }
    __device__ __forceinline__ const char* b(const pg8::Unit& u) const { return W + (size_t)u.pn * 65536 * 2; }
};
struct AddrBranch {
    const char* YM; long dYL; const char* W; int lda, ldb, K;
    __device__ __forceinline__ const char* a(const pg8::Unit& u) const { return YM + (u.pn < 4 ? 0l : dYL) + (size_t)u.pm * 256 * 1024 * 2; }
    __device__ __forceinline__ const char* b(const pg8::Unit& u) const { return W + (size_t)u.pn * 256 * 1024 * 2; }
};

struct DstP1 { unsigned char* ws;
    __device__ __forceinline__ bf16* get(int pn, int& ld, int& col0) const {
        const bool mg = pn >= 16; ld = mg ? 2048 : 1024; col0 = mg ? (pn - 16) * 256 : (pn & 3) * 256;
        return (bf16*)(ws + (mg ? WS_MG : WS_XM + (size_t)(pn >> 2) * 64 * MiB)); } };
struct DstQKV { char* q; long dk, dv;
    __device__ __forceinline__ bf16* get(int pn, int& ld, int& col0) const { ld = 1024; col0 = (pn & 3) * 256; return (bf16*)(q + (pn >= 4 ? (pn >= 8 ? dv : dk) : 0l)); } };
template <class Dst> struct EpiBf16 {
    static constexpr bool PERM = true;
    Dst dst;
    __device__ __forceinline__ void operator()(const f32x4 (&acc)[2][2][4][2], const pg8::Unit& u, int wr, int wc, int fr, int fq) const {
        int ld, colt; bf16* base = dst.get(u.pn, ld, colt);
        const int row0 = u.pm * 256 + wr * 64 + fr, col0 = colt + wc * 32 + 8 * fq;
#pragma unroll
        for (int ai = 0; ai < 2; ++ai)
#pragma unroll
            for (int m = 0; m < 4; ++m) { bf16* rowp = base + (size_t)(row0 + ai * 128 + m * 16) * ld + col0;
#pragma unroll
                for (int bj = 0; bj < 2; ++bj) { const f32x4 v0 = acc[ai][bj][m][0], v1 = acc[ai][bj][m][1];
                    v4u w; w.x = pg8::cvt_pk_bf16(v0[0], v0[1]); w.y = pg8::cvt_pk_bf16(v0[2], v0[3]); w.z = pg8::cvt_pk_bf16(v1[0], v1[1]); w.w = pg8::cvt_pk_bf16(v1[2], v1[3]);
                    *(v4u*)(rowp + bj * 128) = w; } }
    }
};
struct EpiGate {
    static constexpr bool PERM = true;
    bf16* G;
    __device__ __forceinline__ void operator()(const f32x4 (&acc)[2][2][4][2], const pg8::Unit& u, int wr, int wc, int fr, int fq) const {
        const int row0 = u.pm * 256 + wr * 64 + fr, col0 = u.pn * 256 + wc * 32 + 8 * fq;
#pragma unroll
        for (int ai = 0; ai < 2; ++ai)
#pragma unroll
            for (int m = 0; m < 4; ++m) { bf16* rowp = G + (size_t)(row0 + ai * 128 + m * 16) * 2048 + col0;
#pragma unroll
                for (int bj = 0; bj < 2; ++bj) { const f32x4 v0 = acc[ai][bj][m][0], v1 = acc[ai][bj][m][1];
                    const v4u g = *(const v4u*)(rowp + bj * 128);
                    v4u w;
                    w.x = pg8::cvt_pk_bf16(v0[0] * sigmoidf_(bflo(g.x)), v0[1] * sigmoidf_(bfhi(g.x)));
                    w.y = pg8::cvt_pk_bf16(v0[2] * sigmoidf_(bflo(g.y)), v0[3] * sigmoidf_(bfhi(g.y)));
                    w.z = pg8::cvt_pk_bf16(v1[0] * sigmoidf_(bflo(g.z)), v1[1] * sigmoidf_(bfhi(g.z)));
                    w.w = pg8::cvt_pk_bf16(v1[2] * sigmoidf_(bflo(g.w)), v1[3] * sigmoidf_(bfhi(g.w)));
                    *(v4u*)(rowp + bj * 128) = w; } }
    }
};
struct EpiResid {
    static constexpr bool PERM = false;
    const float* x; float* x1; bf16* x1b; float* ss;
    __device__ __forceinline__ void operator()(const f32x4 (&acc)[2][2][4][2], const pg8::Unit& u, int wr, int wc, int fr, int fq) const {
        const int row0 = u.pm * 256 + wr * 64 + fr, col0 = u.pn * 256 + wc * 32 + 4 * fq;
#pragma unroll
        for (int ai = 0; ai < 2; ++ai)
#pragma unroll
            for (int m = 0; m < 4; ++m) { const int row = row0 + ai * 128 + m * 16; const size_t off = (size_t)row * DM + col0; float s = 0.f;
#pragma unroll
                for (int bj = 0; bj < 2; ++bj)
#pragma unroll
                    for (int n = 0; n < 2; ++n) { const size_t o = off + bj * 128 + n * 16; const f32x4 v = *(const f32x4*)(x + o) + acc[ai][bj][m][n];
                        *(f32x4*)(x1 + o) = v; v2u w; w.x = pg8::cvt_pk_bf16(v[0], v[1]); w.y = pg8::cvt_pk_bf16(v[2], v[3]); *(v2u*)(x1b + o) = w;
                        s += (v[0] * v[0] + v[1] * v[1]) + (v[2] * v[2] + v[3] * v[3]); }
                s += __shfl_xor(s, 16); s += __shfl_xor(s, 32);
                if (fq == 0) atomicAdd(ss + row, s); }
    }
};
struct EpiPQ {
    static constexpr bool PERM = true;
    bf16* pq; const float* ss;
    __device__ __forceinline__ void operator()(const f32x4 (&acc)[2][2][4][2], const pg8::Unit& u, int wr, int wc, int fr, int fq) const {
        const int row0 = u.pm * 256 + wr * 64 + fr, col0 = u.pn * 256 + wc * 32 + 8 * fq;
#pragma unroll
        for (int ai = 0; ai < 2; ++ai)
#pragma unroll
            for (int m = 0; m < 4; ++m) { const int row = row0 + ai * 128 + m * 16; bf16* rowp = pq + (size_t)row * 2048 + col0;
                const float r = rsqrtf(ss[row] * (1.f / DM) + EPS);
#pragma unroll
                for (int bj = 0; bj < 2; ++bj) { const f32x4 v0 = acc[ai][bj][m][0] * r, v1 = acc[ai][bj][m][1] * r;
                    v4u w; w.x = pg8::cvt_pk_bf16(v0[0], v0[1]); w.y = pg8::cvt_pk_bf16(v0[2], v0[3]); w.z = pg8::cvt_pk_bf16(v1[0], v1[1]); w.w = pg8::cvt_pk_bf16(v1[2], v1[3]);
                    *(v4u*)(rowp + bj * 128) = w; } }
    }
};

__device__ __forceinline__ void lru_ref(Frame& F) {
    const bf16* XL = (const bf16*)(F.ws + WS_XL); const bf16* LG = (const bf16*)(F.ws + WS_LG); bf16* YL = (bf16*)F.out;
    const bf16* WL = (const bf16*)(F.ws + WS_WLRU);
    const float* cw = F.in[10]; const float* cb = F.in[11];
    LAS float* sxc = (LAS float*)F.lds;
    LAS float* sp = (LAS float*)(F.lds + 1024);
    const int c = F.tid & 127, part = F.tid >> 7;
    for (int item = F.bid; item < 64; item += F.G) {
        const int b = item >> 3, blk = item & 7, ch = blk * 128 + c;
        const float w0 = cw[0 * DM + ch], w1 = cw[1 * DM + ch], w2 = cw[2 * DM + ch], w3 = cw[3 * DM + ch], bb = cb[ch];
        for (int dir = 0; dir < 2; ++dir) {
            v4u wr[4], wi[4];
            { const v4u* pr = (const v4u*)(WL + ((size_t)((dir * 8 + blk) * 2 + 0) * 128 + c) * 128 + part * 32);
              const v4u* pi = (const v4u*)(WL + ((size_t)((dir * 8 + blk) * 2 + 1) * 128 + c) * 128 + part * 32);
#pragma unroll
              for (int q = 0; q < 4; ++q) { wr[q] = pr[q]; wi[q] = pi[q]; } }
            const float br = F.in[13][dir * DM + ch], bi = F.in[15][dir * DM + ch];
            const float spl = softplusf_(-F.in[16][dir * DM + ch]);
            float h = 0.f;
            for (int step = 0; step < SEQ; ++step) {
                const int t = dir ? (SEQ - 1 - step) : step;
                const size_t m = (size_t)b * SEQ + t;
                float xc = 0.f;
                if (part == 0) {
                    xc = bb;
                    if (t >= 2) xc += w0 * bf2f(XL[(m - 2) * DM + ch]);
                    if (t >= 1) xc += w1 * bf2f(XL[(m - 1) * DM + ch]);
                    xc += w2 * bf2f(XL[m * DM + ch]);
                    if (t + 1 < SEQ) xc += w3 * bf2f(XL[(m + 1) * DM + ch]);
                    sxc[c] = xc;
                }
                __syncthreads();
                float pr_ = 0.f, pi_ = 0.f;
#pragma unroll
                for (int q = 0; q < 4; ++q) {
                    const f32x4 x0 = *(const LAS f32x4*)(sxc + part * 32 + q * 8), x1 = *(const LAS f32x4*)(sxc + part * 32 + q * 8 + 4);
                    pr_ += x0[0] * bflo(wr[q].x) + x0[1] * bfhi(wr[q].x) + x0[2] * bflo(wr[q].y) + x0[3] * bfhi(wr[q].y)
                         + x1[0] * bflo(wr[q].z) + x1[1] * bfhi(wr[q].z) + x1[2] * bflo(wr[q].w) + x1[3] * bfhi(wr[q].w);
                    pi_ += x0[0] * bflo(wi[q].x) + x0[1] * bfhi(wi[q].x) + x0[2] * bflo(wi[q].y) + x0[3] * bfhi(wi[q].y)
                         + x1[0] * bflo(wi[q].z) + x1[1] * bfhi(wi[q].z) + x1[2] * bflo(wi[q].w) + x1[3] * bfhi(wi[q].w);
                }
                sp[(part * 2 + 0) * 128 + c] = pr_; sp[(part * 2 + 1) * 128 + c] = pi_;
                __syncthreads();
                if (part == 0) {
                    const float rp = sp[0 * 128 + c] + sp[2 * 128 + c] + sp[4 * 128 + c] + sp[6 * 128 + c] + br;
                    const float ip = sp[1 * 128 + c] + sp[3 * 128 + c] + sp[5 * 128 + c] + sp[7 * 128 + c] + bi;
                    const float r = sigmoidf_(rp), ig = sigmoidf_(ip);
                    const float log_a = -8.f * r * spl;
                    const float a = __expf(log_a);
                    const float u = sqrtf(-expm1f(2.f * log_a)) * (ig * xc);
                    h = a * h + u;
                    if (dir == 0) YL[m * DM + ch] = (bf16)f2bf(h);
                    else { const float y = (bf2f(YL[m * DM + ch]) + h) * gelu_erf(bf2f(LG[m * DM + ch])); YL[m * DM + ch] = (bf16)f2bf(y); }
                }
            }
            __syncthreads();
        }
    }
}


template <bool PB> __device__ __forceinline__ void lru_phase(Frame& F) {
    const bf16* XL = (const bf16*)(F.ws + WS_XL); const bf16* LG = (const bf16*)(F.ws + WS_LG); bf16* YL = (bf16*)F.out;
    f32x2* AGG = (f32x2*)(F.ws + WS_AGG);
    const bf16* WL = (const bf16*)(F.ws + WS_WLRU);
    const float* cw = F.in[10]; const float* cb = F.in[11];
    constexpr int O_XCB = 0, O_XCF = 17408, O_A = 50176, O_U = 82944;
    LAS unsigned char* L = F.lds;
    const int tid = F.tid, lane = F.lane, w = F.wave, fr = lane & 15, fq = lane >> 4;
    int cur_blk = -1;
    bf16x8 wf[2][2][4];
    f32x4 br4[2], bi4[2], sp4[2];
    for (int i = 0;; ++i) {
        const int idx = i * F.G + F.bid; if (idx >= 4096) break;
        const int blk = idx & 7, j = idx >> 3, b = j >> 6, seg = j & 63, t0 = seg * 64;
        const size_t mrow0 = (size_t)b * SEQ + t0;
        if (blk != cur_blk) {
            cur_blk = blk;
#pragma unroll
            for (int d = 0; d < 2; ++d) {
#pragma unroll
                for (int g = 0; g < 2; ++g)
#pragma unroll
                    for (int ks = 0; ks < 4; ++ks)
                        wf[d][g][ks] = *(const bf16x8*)(WL + ((size_t)((d * 8 + blk) * 2 + g) * 128 + 16 * w + fr) * 128 + 32 * ks + 8 * fq);
                const int ch = blk * 128 + 16 * w + 4 * fq;
                br4[d] = *(const f32x4*)(F.in[13] + d * DM + ch); bi4[d] = *(const f32x4*)(F.in[15] + d * DM + ch);
                const f32x4 lm = *(const f32x4*)(F.in[16] + d * DM + ch);
#pragma unroll
                for (int e = 0; e < 4; ++e) sp4[d][e] = -8.f * 1.44269504089f * softplusf_(-lm[e]);
            }
        }
        for (int e = tid; e < 68 * 16; e += NTHR) { const int row = e >> 4, c16 = e & 15, t = t0 - 2 + row;
            v4u v = {0u, 0u, 0u, 0u};
            if (t >= 0 && t < SEQ) v = *(const v4u*)(XL + ((size_t)b * SEQ + t) * DM + blk * 128 + c16 * 8);
            *(LAS v4u*)(L + O_A + row * 256 + c16 * 16) = v; }
        __syncthreads();
        for (int e = tid; e < 64 * 16; e += NTHR) { const int tl = e >> 4, c16 = e & 15, c0 = blk * 128 + c16 * 8;
            float y[8];
            { const f32x4 a = *(const f32x4*)(cb + c0), bq = *(const f32x4*)(cb + c0 + 4); y[0] = a[0]; y[1] = a[1]; y[2] = a[2]; y[3] = a[3]; y[4] = bq[0]; y[5] = bq[1]; y[6] = bq[2]; y[7] = bq[3]; }
#pragma unroll
            for (int jt = 0; jt < 4; ++jt) { const v4u r = *(const LAS v4u*)(L + O_A + (tl + jt) * 256 + c16 * 16);
                const f32x4 wa = *(const f32x4*)(cw + jt * DM + c0), wb = *(const f32x4*)(cw + jt * DM + c0 + 4);
                y[0] += wa[0] * bflo(r.x); y[1] += wa[1] * bfhi(r.x); y[2] += wa[2] * bflo(r.y); y[3] += wa[3] * bfhi(r.y);
                y[4] += wb[0] * bflo(r.z); y[5] += wb[1] * bfhi(r.z); y[6] += wb[2] * bflo(r.w); y[7] += wb[3] * bfhi(r.w); }
            *(LAS f32x4*)(L + O_XCF + tl * 512 + c16 * 32) = (f32x4){y[0], y[1], y[2], y[3]};
            *(LAS f32x4*)(L + O_XCF + tl * 512 + c16 * 32 + 16) = (f32x4){y[4], y[5], y[6], y[7]};
            v4u o; o.x = pk2(y[0], y[1]); o.y = pk2(y[2], y[3]); o.z = pk2(y[4], y[5]); o.w = pk2(y[6], y[7]);
            *(LAS v4u*)(L + O_XCB + tl * 272 + c16 * 16) = o; }
        __syncthreads();
        float carry0 = 0.f, carry1 = 0.f;
        if (PB && tid < 128) {
            const int ch = blk * 128 + tid;
            float h = 0.f;
            for (int js = 0; js < seg; ++js) { const f32x2 ah = AGG[((size_t)(b * 64 + js) * 2 + 0) * DM + ch]; h = ah[0] * h + ah[1]; }
            carry0 = h; h = 0.f;
            for (int js = 63; js > seg; --js) { const f32x2 ah = AGG[((size_t)(b * 64 + js) * 2 + 1) * DM + ch]; h = ah[0] * h + ah[1]; }
            carry1 = h;
        }
#pragma unroll
        for (int d = 0; d < 2; ++d) {
            const int o_a = (d == 0) ? O_A : O_XCF;
            f32x4 aR[4], aI[4];
#pragma unroll
            for (int mt = 0; mt < 4; ++mt) { aR[mt] = (f32x4){0.f, 0.f, 0.f, 0.f}; aI[mt] = (f32x4){0.f, 0.f, 0.f, 0.f}; }
#pragma unroll
            for (int ks = 0; ks < 4; ++ks)
#pragma unroll
                for (int mt = 0; mt < 4; ++mt) { const bf16x8 xb = *(const LAS bf16x8*)(L + O_XCB + (16 * mt + fr) * 272 + (32 * ks + 8 * fq) * 2);
                    aR[mt] = __builtin_amdgcn_mfma_f32_16x16x32_bf16(wf[d][0][ks], xb, aR[mt], 0, 0, 0);
                    aI[mt] = __builtin_amdgcn_mfma_f32_16x16x32_bf16(wf[d][1][ks], xb, aI[mt], 0, 0, 0); }
#pragma unroll
            for (int mt = 0; mt < 4; ++mt) { const int tl = 16 * mt + fr, cl = 16 * w + 4 * fq;
                const f32x4 xc = *(const LAS f32x4*)(L + O_XCF + tl * 512 + cl * 4);
                f32x4 av, uv;
#pragma unroll
                for (int e = 0; e < 4; ++e) { const float r = sigmoidf_(aR[mt][e] + br4[d][e]), ig = sigmoidf_(aI[mt][e] + bi4[d][e]);
                    const float a_ = __builtin_amdgcn_exp2f(r * sp4[d][e]); av[e] = a_; uv[e] = __builtin_amdgcn_sqrtf(fmaxf(1.f - a_ * a_, 0.f)) * (ig * xc[e]); }
                *(LAS f32x4*)(L + o_a + tl * 512 + cl * 4) = av; *(LAS f32x4*)(L + O_U + tl * 512 + cl * 4) = uv; }
            __syncthreads();
            if (tid < 128) {
                LAS float* pa = (LAS float*)(L + o_a) + tid; const LAS float* pu = (const LAS float*)(L + O_U) + tid;
                if (!PB) {
                    float h = 0.f, A = 1.f;
#pragma unroll 8
                    for (int s2 = 0; s2 < 64; ++s2) { const int tl = d ? 63 - s2 : s2; const float a = pa[tl * 128], u = pu[tl * 128]; h = a * h + u; A *= a; }
                    AGG[((size_t)(b * 64 + seg) * 2 + d) * DM + blk * 128 + tid] = (f32x2){A, h};
                } else if (d == 0) {
                    float h = carry0;
#pragma unroll 8
                    for (int tl = 0; tl < 64; ++tl) { h = pa[tl * 128] * h + pu[tl * 128]; pa[tl * 128] = h; }
                } else {
                    float h = carry1;
                    LAS float* ph = (LAS float*)(L + O_A) + tid;
#pragma unroll 8
                    for (int s2 = 0; s2 < 64; ++s2) { const int tl = 63 - s2; h = pa[tl * 128] * h + pu[tl * 128]; ph[tl * 128] += h; }
                }
            }
            __syncthreads();
        }
        if (PB) {
            for (int e = tid; e < 64 * 16; e += NTHR) { const int row = e >> 4, c16 = e & 15;
                const v4u g = *(const v4u*)(LG + (mrow0 + row) * DM + blk * 128 + c16 * 8);
                const f32x4 h0 = *(const LAS f32x4*)(L + O_A + row * 512 + c16 * 32), h1 = *(const LAS f32x4*)(L + O_A + row * 512 + c16 * 32 + 16);
                v4u o;
                o.x = pk2(h0[0] * gelu_fast(bflo(g.x)), h0[1] * gelu_fast(bfhi(g.x))); o.y = pk2(h0[2] * gelu_fast(bflo(g.y)), h0[3] * gelu_fast(bfhi(g.y)));
                o.z = pk2(h1[0] * gelu_fast(bflo(g.z)), h1[1] * gelu_fast(bfhi(g.z))); o.w = pk2(h1[2] * gelu_fast(bflo(g.w)), h1[3] * gelu_fast(bfhi(g.w)));
                *(v4u*)(YL + (mrow0 + row) * DM + blk * 128 + c16 * 8) = o; }
            __syncthreads();
        }
    }
}

__device__ __forceinline__ void mconv_phase(Frame& F) {
    const bf16* XM = (const bf16*)(F.ws + WS_XM); bf16* XC = (bf16*)(F.ws + WS_XL);
    const float* cw = F.in[4]; const float* cb = F.in[5];
    const int NT = MTOK / 32 * 128;
    for (int g = F.bid * NTHR + F.tid; g < NT; g += F.G * NTHR) {
        const int chunk = g & 127, run = g >> 7, c0 = chunk * 8, m0 = run * 32, t0 = m0 & (SEQ - 1);
        float w[4][8], bias[8];
#pragma unroll
        for (int j = 0; j < 4; ++j) { const f32x4 a = *(const f32x4*)(cw + j * DM + c0), b = *(const f32x4*)(cw + j * DM + c0 + 4);
            w[j][0] = a[0]; w[j][1] = a[1]; w[j][2] = a[2]; w[j][3] = a[3]; w[j][4] = b[0]; w[j][5] = b[1]; w[j][6] = b[2]; w[j][7] = b[3]; }
        { const f32x4 a = *(const f32x4*)(cb + c0), b = *(const f32x4*)(cb + c0 + 4);
            bias[0] = a[0]; bias[1] = a[1]; bias[2] = a[2]; bias[3] = a[3]; bias[4] = b[0]; bias[5] = b[1]; bias[6] = b[2]; bias[7] = b[3]; }
        v4u win[4];
        const v4u zero = {0u, 0u, 0u, 0u};
        win[0] = zero;
        win[1] = (t0 >= 2) ? *(const v4u*)(XM + (size_t)(m0 - 2) * DM + c0) : zero;
        win[2] = (t0 >= 1) ? *(const v4u*)(XM + (size_t)(m0 - 1) * DM + c0) : zero;
        win[3] = *(const v4u*)(XM + (size_t)m0 * DM + c0);
#pragma unroll 4
        for (int i = 0; i < 32; ++i) {
            win[0] = win[1]; win[1] = win[2]; win[2] = win[3];
            win[3] = (t0 + i + 1 < SEQ) ? *(const v4u*)(XM + (size_t)(m0 + i + 1) * DM + c0) : zero;
            float y[8];
#pragma unroll
            for (int e = 0; e < 8; ++e) y[e] = bias[e];
#pragma unroll
            for (int j = 0; j < 4; ++j) {
                const unsigned p0 = win[j].x, p1 = win[j].y, p2 = win[j].z, p3 = win[j].w;
                y[0] += w[j][0] * bflo(p0); y[1] += w[j][1] * bfhi(p0); y[2] += w[j][2] * bflo(p1); y[3] += w[j][3] * bfhi(p1);
                y[4] += w[j][4] * bflo(p2); y[5] += w[j][5] * bfhi(p2); y[6] += w[j][6] * bflo(p3); y[7] += w[j][7] * bfhi(p3);
            }
#pragma unroll
            for (int e = 0; e < 8; ++e) y[e] = y[e] * sigmoidf_(y[e]);
            v4u o; o.x = pk2(y[0], y[1]); o.y = pk2(y[2], y[3]); o.z = pk2(y[4], y[5]); o.w = pk2(y[6], y[7]);
            *(v4u*)(XC + (size_t)(m0 + i) * DM + c0) = o;
        }
    }
}

__device__ __forceinline__ void mscan_ref(Frame& F) {
    const bf16* Q = (const bf16*)(F.ws + WS_LG); const bf16* K = (const bf16*)(F.ws + WS_K); const bf16* V = (const bf16*)F.out + (size_t)MTOK * DM;
    const float* GT = (const float*)(F.ws + WS_GATE);
    LAS float* sq = (LAS float*)F.lds; LAS float* sk = sq + 256; LAS float* sv = sk + 256; LAS float* spart = sv + 32; LAS float* sdw = spart + 256;
    const int e = F.tid & 31, dg = F.tid >> 5;
    for (int item = F.bid; item < 512; item += F.G) {
        const int es = item & 7, dir = (item >> 3) & 1, h = (item >> 4) & 3, b = item >> 6;
        bf16* H = (bf16*)(F.ws + (dir ? WS_XL : WS_XM));
        float C[16];
#pragma unroll
        for (int j = 0; j < 16; ++j) C[j] = 0.f;
        float nreg = 0.f, mst = 0.f;
        for (int step = 0; step < SEQ; ++step) {
            const int t = dir ? (SEQ - 1 - step) : step;
            const size_t m = (size_t)b * SEQ + t, ro = m * DM + h * 256;
            if (F.tid < 256) { sq[F.tid] = bf2f(Q[ro + F.tid]); sk[F.tid] = bf2f(K[ro + F.tid]); }
            if (F.tid < 32) sv[F.tid] = bf2f(V[ro + es * 32 + F.tid]);
            const float ip = GT[m * 16 + (dir * 2 + 0) * 4 + h], fp = GT[m * 16 + (dir * 2 + 1) * 4 + h];
            const float logf = -softplusf_(-fp);
            const float mn = fmaxf(logf + mst, ip);
            const float fd = __expf(logf + mst - mn), iw = __expf(ip - mn);
            mst = mn;
            __syncthreads();
            const float ve = sv[e] * iw;
            float part = 0.f;
#pragma unroll
            for (int j = 0; j < 16; ++j) { const int d = dg * 16 + j; C[j] = fd * C[j] + sk[d] * ve; part += sq[d] * C[j]; }
            part += __shfl_xor(part, 32);
            if (F.lane < 32) spart[F.wave * 32 + e] = part;
            if (F.tid < 256) { nreg = fd * nreg + iw * sk[F.tid]; const float ds = wave_sum(nreg * sq[F.tid]); if (F.lane == 0) sdw[F.wave] = ds; }
            __syncthreads();
            if (F.tid < 32) {
                float num = 0.f;
#pragma unroll
                for (int w = 0; w < 8; ++w) num += spart[w * 32 + F.tid];
                const float den = sdw[0] + sdw[1] + sdw[2] + sdw[3];
                H[ro + es * 32 + F.tid] = (bf16)f2bf(num / fmaxf(fabsf(den), __expf(-mn)));
            }
        }
        __syncthreads();
    }
}


typedef short s16x4 __attribute__((ext_vector_type(4)));
__device__ __forceinline__ bf16x8 tr_read_pair(unsigned a0, unsigned a1) {
    s16x4 r0, r1;
    asm volatile("ds_read_b64_tr_b16 %0, %2\n\tds_read_b64_tr_b16 %1, %3\n\ts_waitcnt lgkmcnt(0)" : "=&v"(r0), "=&v"(r1) : "v"(a0), "v"(a1) : "memory");
    return __builtin_shufflevector(r0, r1, 0, 1, 2, 3, 4, 5, 6, 7);
}
__device__ __forceinline__ float wave_incl_sum(float x, int lane) {
#pragma unroll
    for (int o = 1; o < 64; o <<= 1) { const float t = __shfl_up(x, o); if (lane >= o) x += t; }
    return x;
}
__device__ __forceinline__ float wave_incl_max(float x, int lane) {
#pragma unroll
    for (int o = 1; o < 64; o <<= 1) { const float t = __shfl_up(x, o); if (lane >= o) x = fmaxf(x, t); }
    return x;
}
__device__ __forceinline__ void mscan_phase(Frame& F) {
    const bf16* Q = (const bf16*)(F.ws + WS_LG); const bf16* K = (const bf16*)(F.ws + WS_K); const bf16* V = (const bf16*)F.out + (size_t)MTOK * DM;
    const float* GT = (const float*)(F.ws + WS_GATE);
    constexpr int KS = 0, CTI = 33792, VT = 67584, VWT = 86016, PB = 104448, TAB = 113664, NT = 116736, NPART = 117760, DENT = 119808;
    constexpr int KST = 528, VST = 144, TABSZ = 1536;
    LAS unsigned char* L = F.lds;
    const int tid = F.tid, lane = F.lane, w = F.wave, fr = lane & 15, fq = lane >> 4, pt = w & 3, wg = w >> 2;
    for (int item = F.bid; item < 256; item += F.G) {
        const int es = item & 3, dir = (item >> 2) & 1, h = (item >> 3) & 3, b = item >> 5;
        bf16* H = (bf16*)(F.ws + (dir ? WS_XL : WS_XM));
        const size_t rowbase = (size_t)b * SEQ;
#define TOF(c, p) (dir ? (SEQ - 1 - 64 * (c) - (p)) : (64 * (c) + (p)))
        for (int e = tid; e < (33792 + 1024) / 4; e += NTHR) { if (e < 33792 / 4) ((LAS unsigned*)(L + CTI))[e] = 0u; else ((LAS unsigned*)(L + NT))[e - 33792 / 4] = 0u; }
        float m_run = 0.f;
        float gi_n = 0.f, gf_n = 0.f;
        if (w == 0) { const size_t m = rowbase + TOF(0, lane); gi_n = GT[m * 16 + dir * 8 + h]; gf_n = GT[m * 16 + dir * 8 + 4 + h]; }
#define G1_TABLES(setp) do { \
            const float logf_ = -softplusf_(-gf_n); const float b_ = wave_incl_sum(logf_, lane); const float a_ = gi_n - b_; \
            const float M_ = fmaxf(m_run, wave_incl_max(a_, lane)); const float Mend_ = __shfl(M_, 63), g_ = __shfl(b_, 63); \
            LAS float* T_ = (LAS float*)(setp); T_[lane] = a_; T_[64 + lane] = M_; T_[128 + lane] = expf(m_run - M_); T_[192 + lane] = expf(-(b_ + M_)); T_[256 + lane] = expf(a_ - Mend_); \
            if (lane == 0) { T_[320] = expf(m_run - Mend_); T_[321] = g_ + Mend_; } \
            m_run = g_ + Mend_; } while (0)
        if (w == 0) G1_TABLES(L + TAB);
        __syncthreads();
        bf16x8 qf[8];
        v4u kreg[4]; v4u vreg;
#define LOAD_KV(c) do { _Pragma("unroll") for (int r_ = 0; r_ < 4; ++r_) { const int i_ = tid + NTHR * r_, s_ = i_ >> 5, c16_ = i_ & 31; \
                kreg[r_] = *(const v4u*)(K + (rowbase + TOF(c, s_)) * DM + h * 256 + c16_ * 8); } \
            { const int s_ = tid >> 3, e8_ = tid & 7; vreg = *(const v4u*)(V + (rowbase + TOF(c, s_)) * DM + h * 256 + es * 64 + e8_ * 8); } } while (0)
#define STORE_KV(setidx) do { _Pragma("unroll") for (int r_ = 0; r_ < 4; ++r_) { const int i_ = tid + NTHR * r_, s_ = i_ >> 5, c16_ = i_ & 31; \
                *(LAS v4u*)(L + KS + s_ * KST + c16_ * 16) = kreg[r_]; } \
            { const int s_ = tid >> 3, e8_ = tid & 7; const float ws_ = ((const LAS float*)(L + TAB + (setidx) * TABSZ))[256 + s_]; \
              LAS bf16* vt_ = (LAS bf16*)(L + VT + (setidx) * 9216); LAS bf16* vw_ = (LAS bf16*)(L + VWT + (setidx) * 9216); \
              const unsigned wv_[4] = {vreg.x, vreg.y, vreg.z, vreg.w}; \
              _Pragma("unroll") for (int j_ = 0; j_ < 4; ++j_) { const float lo_ = bflo(wv_[j_]), hi_ = bfhi(wv_[j_]); const int e_ = e8_ * 8 + 2 * j_; \
                vt_[e_ * 72 + s_] = (bf16)(wv_[j_] & 0xffffu); vt_[(e_ + 1) * 72 + s_] = (bf16)(wv_[j_] >> 16); \
                vw_[e_ * 72 + s_] = (bf16)f2bf(lo_ * ws_); vw_[(e_ + 1) * 72 + s_] = (bf16)f2bf(hi_ * ws_); } } } while (0)
#define LOAD_Q(c) do { const size_t m_ = rowbase + TOF(c, 16 * pt + fr); _Pragma("unroll") for (int ks_ = 0; ks_ < 8; ++ks_) \
                qf[ks_] = *(const bf16x8*)(Q + m_ * DM + h * 256 + 32 * ks_ + 8 * fq); } while (0)
        LOAD_KV(0); LOAD_Q(0);
        STORE_KV(0);
        f32x4 Cacc[8];
#pragma unroll
        for (int i = 0; i < 8; ++i) Cacc[i] = (f32x4){0.f, 0.f, 0.f, 0.f};
        __syncthreads();
        for (int c = 0; c < 64; ++c) {
            const int cur = c & 1, nxt = cur ^ 1;
            const bool has_next = (c + 1 < 64);
            const LAS float* T = (const LAS float*)(L + TAB + cur * TABSZ);
            if (has_next) { LOAD_KV(c + 1); if (w == 0) { const size_t m = rowbase + TOF(c + 1, lane); gi_n = GT[m * 16 + dir * 8 + h]; gf_n = GT[m * 16 + dir * 8 + 4 + h]; } }
            const int p = 16 * pt + fr;
            const float Mp = T[64 + p], wi_p = T[128 + p];
            float cs = 0.f;
#pragma unroll
            for (int i = 0; i < 2; ++i) { const int st = 2 * wg + i;
                v2u pw = {0u, 0u};
                if (st <= pt) {
                    f32x4 sa = (f32x4){0.f, 0.f, 0.f, 0.f};
#pragma unroll
                    for (int ks = 0; ks < 8; ++ks) { const bf16x8 kf = *(const LAS bf16x8*)(L + KS + (16 * st + fr) * KST + (32 * ks + 8 * fq) * 2);
                        sa = __builtin_amdgcn_mfma_f32_16x16x32_bf16(kf, qf[ks], sa, 0, 0, 0); }
                    const f32x4 a4 = *(const LAS f32x4*)(T + 16 * st + 4 * fq);
                    float pv[4];
#pragma unroll
                    for (int r = 0; r < 4; ++r) { const int s_ = 16 * st + 4 * fq + r; const float wgt = (s_ <= p) ? __expf(a4[r] - Mp) : 0.f; pv[r] = sa[r] * wgt; cs += pv[r]; }
                    pw.x = pk2(pv[0], pv[1]); pw.y = pk2(pv[2], pv[3]);
                }
                *(LAS v2u*)(L + PB + p * VST + (16 * st + 4 * fq) * 2) = pw; }
            f32x4 O[2];
#pragma unroll
            for (int i = 0; i < 2; ++i) { const int et = 2 * wg + i; O[i] = (f32x4){0.f, 0.f, 0.f, 0.f};
#pragma unroll
                for (int ks = 0; ks < 8; ++ks) { const bf16x8 cf = *(const LAS bf16x8*)(L + CTI + (16 * et + fr) * KST + (32 * ks + 8 * fq) * 2);
                    O[i] = __builtin_amdgcn_mfma_f32_16x16x32_bf16(cf, qf[ks], O[i], 0, 0, 0); } }
            float di = 0.f;
#define DEN_INTER(ks) do { const f32x4 n0 = *(const LAS f32x4*)(L + NT + (32 * (ks) + 8 * fq) * 4), n1 = *(const LAS f32x4*)(L + NT + (32 * (ks) + 8 * fq) * 4 + 16); \
                const v4u qw = __builtin_bit_cast(v4u, qf[ks]); \
                di += bflo(qw.x) * n0[0] + bfhi(qw.x) * n0[1] + bflo(qw.y) * n0[2] + bfhi(qw.y) * n0[3] + bflo(qw.z) * n1[0] + bfhi(qw.z) * n1[1] + bflo(qw.w) * n1[2] + bfhi(qw.w) * n1[3]; } while (0)
            if (wg == 0) { DEN_INTER(0); DEN_INTER(1); DEN_INTER(2); DEN_INTER(3); }
            else { DEN_INTER(4); DEN_INTER(5); DEN_INTER(6); DEN_INTER(7); }
#undef DEN_INTER
            di += __shfl_xor(di, 16); di += __shfl_xor(di, 32);
            cs += __shfl_xor(cs, 16); cs += __shfl_xor(cs, 32);
            if (fq == 0) ((LAS float*)(L + DENT))[wg * 64 + p] = wi_p * di + cs;
            if (has_next) LOAD_Q(c + 1);
            if (has_next && w == 0) G1_TABLES(L + TAB + nxt * TABSZ);
            __syncthreads();
#pragma unroll
            for (int i = 0; i < 2; ++i) { const int et = 2 * wg + i; O[i] = O[i] * wi_p;
#pragma unroll
                for (int ks = 0; ks < 2; ++ks) { const bf16x8 vf = *(const LAS bf16x8*)(L + VT + cur * 9216 + (16 * et + fr) * VST + (32 * ks + 8 * fq) * 2);
                    const bf16x8 pf = *(const LAS bf16x8*)(L + PB + p * VST + (32 * ks + 8 * fq) * 2);
                    O[i] = __builtin_amdgcn_mfma_f32_16x16x32_bf16(vf, pf, O[i], 0, 0, 0); } }
            { const float den = ((const LAS float*)(L + DENT))[p] + ((const LAS float*)(L + DENT))[64 + p];
              const float inv = 1.f / fmaxf(fabsf(den), T[192 + p]);
              const size_t m = rowbase + TOF(c, p);
#pragma unroll
              for (int i = 0; i < 2; ++i) { const int et = 2 * wg + i; v2u o; o.x = pk2(O[i][0] * inv, O[i][1] * inv); o.y = pk2(O[i][2] * inv, O[i][3] * inv);
                  *(v2u*)(H + m * DM + h * 256 + es * 64 + 16 * et + 4 * fq) = o; } }
            { const float decay = T[320];
              const bf16x8 vw0 = *(const LAS bf16x8*)(L + VWT + cur * 9216 + (16 * pt + fr) * VST + (8 * fq) * 2);
              const bf16x8 vw1 = *(const LAS bf16x8*)(L + VWT + cur * 9216 + (16 * pt + fr) * VST + (32 + 8 * fq) * 2);
              const int l16 = lane & 15, q4 = l16 >> 2, p4 = l16 & 3;
              const unsigned kb = (unsigned)(uintptr_t)(L + KS) + (unsigned)((8 * fq + q4) * KST + 4 * p4 * 2);
#pragma unroll
              for (int dtl = 0; dtl < 8; ++dtl) { const int dt = 8 * wg + dtl; const unsigned a0 = kb + dt * 32;
                  const bf16x8 k0 = tr_read_pair(a0, a0 + 4 * KST), k1 = tr_read_pair(a0 + 32 * KST, a0 + 36 * KST);
                  Cacc[dtl] = Cacc[dtl] * decay;
                  Cacc[dtl] = __builtin_amdgcn_mfma_f32_16x16x32_bf16(k0, vw0, Cacc[dtl], 0, 0, 0);
                  Cacc[dtl] = __builtin_amdgcn_mfma_f32_16x16x32_bf16(k1, vw1, Cacc[dtl], 0, 0, 0); } }
            { const int d = tid & 255, hf2 = tid >> 8; float np = 0.f;
#pragma unroll 8
              for (int s2 = 0; s2 < 32; ++s2) { const int s_ = hf2 * 32 + s2; np += T[256 + s_] * bf2f(*(const LAS bf16*)(L + KS + s_ * KST + d * 2)); }
              ((LAS float*)(L + NPART))[hf2 * 256 + d] = np; }
            __syncthreads();
            { const float decay = T[320];
#pragma unroll
              for (int dtl = 0; dtl < 8; ++dtl) { const int dt = 8 * wg + dtl; v2u o; o.x = pk2(Cacc[dtl][0], Cacc[dtl][1]); o.y = pk2(Cacc[dtl][2], Cacc[dtl][3]);
                  *(LAS v2u*)(L + CTI + (16 * pt + fr) * KST + (16 * dt + 4 * fq) * 2) = o; }
              if (tid < 256) { LAS float* nt = (LAS float*)(L + NT); const LAS float* np = (const LAS float*)(L + NPART); nt[tid] = decay * nt[tid] + np[tid] + np[256 + tid]; } }
            if (has_next) STORE_KV(nxt);
            __syncthreads();
        }
#undef TOF
#undef G1_TABLES
#undef LOAD_KV
#undef STORE_KV
#undef LOAD_Q
    }
}

__device__ __forceinline__ void ym_phase(Frame& F) {
    const bf16* HF = (const bf16*)(F.ws + WS_XM); const bf16* HB = (const bf16*)(F.ws + WS_XL); bf16* OP = (bf16*)(F.ws + WS_OP);
    const float* ng = F.in[9];
    const int gw = F.bid * NWAVES + F.wave, NGW = F.G * NWAVES;
    for (int m = gw; m < MTOK; m += NGW) {
#pragma unroll
        for (int hd = 0; hd < 4; ++hd) {
            const size_t o = (size_t)m * DM + hd * 256 + F.lane * 4;
            const v2u a = *(const v2u*)(HF + o), b = *(const v2u*)(HB + o), op = *(const v2u*)(OP + o);
            const float v0 = bflo(a.x) + bflo(b.x), v1 = bfhi(a.x) + bfhi(b.x), v2 = bflo(a.y) + bflo(b.y), v3 = bfhi(a.y) + bfhi(b.y);
            const float r = rsqrtf(wave_sum((v0 * v0 + v1 * v1) + (v2 * v2 + v3 * v3)) * (1.f / 256.f) + EPS);
            const f32x4 g = *(const f32x4*)(ng + hd * 256 + F.lane * 4);
            v2u w; w.x = pk2(sigmoidf_(bflo(op.x)) * v0 * r * g[0], sigmoidf_(bfhi(op.x)) * v1 * r * g[1]);
            w.y = pk2(sigmoidf_(bflo(op.y)) * v2 * r * g[2], sigmoidf_(bfhi(op.y)) * v3 * r * g[3]);
            *(v2u*)(OP + o) = w;
        }
    }
    const int gt = F.bid * NTHR + F.tid, NGT = F.G * NTHR;
    const f32x4* us = (const f32x4*)F.in[23]; const f32x4* vs = (const f32x4*)F.in[24];
    v4u* ud = (v4u*)(F.ws + WS_LG); v4u* vd = (v4u*)(F.ws + WS_LG + 16 * MiB);
    for (int i = gt; i < NEXP * DM / 16; i += NGT) {
        v4u o, q;
#pragma unroll
        for (int j = 0; j < 4; ++j) { const f32x4 a = us[4 * i + j] * 32.f, b = vs[4 * i + j] * 4.f;
            int pa = 0, pb = 0;
            pa = __builtin_amdgcn_cvt_pk_fp8_f32(a[0], a[1], pa, false); pa = __builtin_amdgcn_cvt_pk_fp8_f32(a[2], a[3], pa, true);
            pb = __builtin_amdgcn_cvt_pk_fp8_f32(b[0], b[1], pb, false); pb = __builtin_amdgcn_cvt_pk_fp8_f32(b[2], b[3], pb, true);
            o[j] = (unsigned)pa; q[j] = (unsigned)pb; }
        ud[i] = o; vd[i] = q;
    }
}

__device__ __forceinline__ void select_ref(Frame& F) {
    const bf16* PQ = (const bf16*)(F.ws + WS_MG); const bf16* KEYS = (const bf16*)(F.ws + WS_KEYS);
    int* IDX = (int*)(F.ws + WS_K); float* GW = (float*)(F.ws + WS_K + 16 * MiB);
    LAS float* base = (LAS float*)(F.lds + F.wave * 2048);
    LAS float* sq = base;
    LAS float* sl = base + 256;
    LAS int* il = (LAS int*)(base + 288);
    LAS float* sbest = base + 320;
    LAS int* spos = (LAS int*)(base + 336);
    const int lane = F.lane;
    const int gw = F.bid * NWAVES + F.wave, NGW = F.G * NWAVES;
    for (int it = gw; it < MTOK * 8; it += NGW) {
        const int t = it >> 3, h = it & 7;
        { const v2u q4 = *(const v2u*)(PQ + (size_t)t * 2048 + h * 256 + lane * 4);
          sq[lane * 4 + 0] = bflo(q4.x); sq[lane * 4 + 1] = bfhi(q4.x); sq[lane * 4 + 2] = bflo(q4.y); sq[lane * 4 + 3] = bfhi(q4.y); }
        LDS_WAIT();
        for (int p = 0; p < 2; ++p) {
            float v0 = 0.f, v1 = 0.f;
            const v4u* k0 = (const v4u*)(KEYS + ((size_t)(h * 2 + p) * 128 + lane) * 128);
            const v4u* k1 = k0 + 64 * 16;
#pragma unroll 4
            for (int c8 = 0; c8 < 16; ++c8) {
                const v4u a = k0[c8], b = k1[c8];
                const f32x4 q0 = *(const LAS f32x4*)(sq + p * 128 + c8 * 8), q1 = *(const LAS f32x4*)(sq + p * 128 + c8 * 8 + 4);
                v0 += q0[0] * bflo(a.x) + q0[1] * bfhi(a.x) + q0[2] * bflo(a.y) + q0[3] * bfhi(a.y) + q1[0] * bflo(a.z) + q1[1] * bfhi(a.z) + q1[2] * bflo(a.w) + q1[3] * bfhi(a.w);
                v1 += q0[0] * bflo(b.x) + q0[1] * bfhi(b.x) + q0[2] * bflo(b.y) + q0[3] * bfhi(b.y) + q1[0] * bflo(b.z) + q1[1] * bfhi(b.z) + q1[2] * bflo(b.w) + q1[3] * bfhi(b.w);
            }
            for (int k = 0; k < 16; ++k) {
                float bv; int bi;
                if (v0 >= v1) { bv = v0; bi = lane; } else { bv = v1; bi = lane + 64; }
#pragma unroll
                for (int off = 32; off >= 1; off >>= 1) {
                    const float ov = __shfl_xor(bv, off); const int oi = __shfl_xor(bi, off);
                    if (ov > bv || (ov == bv && oi < bi)) { bv = ov; bi = oi; }
                }
                if (lane == 0) { sl[p * 16 + k] = bv; il[p * 16 + k] = bi; }
                if (bi == lane) v0 = -INFINITY;
                if (bi == lane + 64) v1 = -INFINITY;
            }
        }
        LDS_WAIT();
        float cv[4];
#pragma unroll
        for (int r = 0; r < 4; ++r) { const int pos = lane + 64 * r; cv[r] = sl[pos >> 4] + sl[16 + (pos & 15)]; }
        for (int k = 0; k < 16; ++k) {
            float bv = cv[0]; int bi = lane;
#pragma unroll
            for (int r = 1; r < 4; ++r) if (cv[r] > bv) { bv = cv[r]; bi = lane + 64 * r; }
#pragma unroll
            for (int off = 32; off >= 1; off >>= 1) {
                const float ov = __shfl_xor(bv, off); const int oi = __shfl_xor(bi, off);
                if (ov > bv || (ov == bv && oi < bi)) { bv = ov; bi = oi; }
            }
            if (lane == 0) { sbest[k] = bv; spos[k] = bi; }
#pragma unroll
            for (int r = 0; r < 4; ++r) if (bi == lane + 64 * r) cv[r] = -INFINITY;
        }
        LDS_WAIT();
        if (lane < 16) {
            const float mx = sbest[0];
            float sum = 0.f;
            for (int k = 0; k < 16; ++k) sum += __expf(sbest[k] - mx);
            const int pos = spos[lane];
            IDX[(size_t)t * 128 + h * 16 + lane] = il[pos >> 4] * 128 + il[16 + (pos & 15)];
            GW[(size_t)t * 128 + h * 16 + lane] = __expf(sbest[lane] - mx) / sum;
        }
        LDS_WAIT();
    }
}


typedef float f32x16 __attribute__((ext_vector_type(16)));
#define TOPK_INSERT(L, xv) do { const float x_ = (xv); \
    L[15] = __builtin_amdgcn_fmed3f(L[14], L[15], x_); L[14] = __builtin_amdgcn_fmed3f(L[13], L[14], x_); L[13] = __builtin_amdgcn_fmed3f(L[12], L[13], x_); L[12] = __builtin_amdgcn_fmed3f(L[11], L[12], x_); \
    L[11] = __builtin_amdgcn_fmed3f(L[10], L[11], x_); L[10] = __builtin_amdgcn_fmed3f(L[9], L[10], x_); L[9] = __builtin_amdgcn_fmed3f(L[8], L[9], x_); L[8] = __builtin_amdgcn_fmed3f(L[7], L[8], x_); \
    L[7] = __builtin_amdgcn_fmed3f(L[6], L[7], x_); L[6] = __builtin_amdgcn_fmed3f(L[5], L[6], x_); L[5] = __builtin_amdgcn_fmed3f(L[4], L[5], x_); L[4] = __builtin_amdgcn_fmed3f(L[3], L[4], x_); \
    L[3] = __builtin_amdgcn_fmed3f(L[2], L[3], x_); L[2] = __builtin_amdgcn_fmed3f(L[1], L[2], x_); L[1] = __builtin_amdgcn_fmed3f(L[0], L[1], x_); L[0] = fmaxf(L[0], x_); } while (0)
template <int I> struct CandRow {
    static __device__ __forceinline__ void run(const float (&L0)[16], const float (&L1)[16], float (&R)[16]) {
        constexpr int NJ = 16 / (I + 1);
#pragma unroll
        for (int j = 0; j < NJ; ++j) { const float sm = L0[I] + L1[j];
            const float pk = __builtin_bit_cast(float, (__builtin_bit_cast(unsigned, sm) & 0xffffff00u) | (unsigned)(I * 16 + j)); TOPK_INSERT(R, pk); }
        if constexpr (I < 15) CandRow<I + 1>::run(L0, L1, R);
    }
};
__device__ __forceinline__ unsigned pick4(unsigned d0, unsigned d1, unsigned d2, unsigned d3, int i) {
    const int q = i >> 2; unsigned d = d0; d = (q == 1) ? d1 : d; d = (q == 2) ? d2 : d; d = (q == 3) ? d3 : d; return (d >> (8 * (i & 3))) & 127u;
}
__device__ __forceinline__ void select_phase(Frame& F) {
    const bf16* PQ = (const bf16*)(F.ws + WS_MG); const bf16* KEYS = (const bf16*)(F.ws + WS_KEYS);
    int* IDX = (int*)(F.ws + WS_K); float* GW = (float*)(F.ws + WS_K + 16 * MiB);
    LAS unsigned char* L = F.lds;
    const int tid = F.tid, lane = F.lane, w = F.wave, l31 = lane & 31, hh = lane >> 5;
    const float NEG_INF = -INFINITY;
    for (int grp = F.bid; grp < MTOK / 128; grp += F.G) {
        const int tb = grp * 4 + (w & 3);
        const size_t m = (size_t)tb * 32 + l31;
        for (int hp = 0; hp < 4; ++hp) {
            __syncthreads();
#pragma unroll 4
            for (int r = 0; r < 16; ++r) { const int e = tid + NTHR * r, R = e >> 4, c = e & 15;
                *(LAS v4u*)(L + R * 256 + ((c ^ (R & 15)) * 16)) = *(const v4u*)(KEYS + ((size_t)(hp * 512 + R) * 128 + c * 8)); }
            __syncthreads();
            const int hl = w >> 2, h = 2 * hp + hl;
            float L0[16], L1[16];
#pragma unroll
            for (int p = 0; p < 2; ++p) {
                bf16x8 qf[8];
#pragma unroll
                for (int ks = 0; ks < 8; ++ks) qf[ks] = *(const bf16x8*)(PQ + m * 2048 + h * 256 + p * 128 + 16 * ks + 8 * hh);
                f32x16 acc[4];
#pragma unroll
                for (int kb = 0; kb < 4; ++kb)
#pragma unroll
                    for (int r = 0; r < 16; ++r) acc[kb][r] = 0.f;
#pragma unroll
                for (int ks = 0; ks < 8; ++ks)
#pragma unroll
                    for (int kb = 0; kb < 4; ++kb) { const int R = (hl * 2 + p) * 128 + 32 * kb + l31;
                        const bf16x8 kf = *(const LAS bf16x8*)(L + R * 256 + (((2 * ks + hh) ^ (lane & 15)) * 16));
                        acc[kb] = __builtin_amdgcn_mfma_f32_32x32x16_bf16(kf, qf[ks], acc[kb], 0, 0, 0); }
                float Lc[16];
#pragma unroll
                for (int i = 0; i < 16; ++i) Lc[i] = NEG_INF;
                const unsigned hh4 = (unsigned)hh << 2;
#pragma unroll
                for (int kb = 0; kb < 4; ++kb)
#pragma unroll
                    for (int r = 0; r < 16; ++r) { const unsigned nlo = (unsigned)(32 * kb + (r & 3) + 8 * (r >> 2));
                        const float av_ = acc[kb][r];
                        const float pk = __uint_as_float(((__float_as_uint(av_) & 0xffffff80u) | hh4) | nlo); TOPK_INSERT(Lc, pk); }
                float Lo[16];
#pragma unroll
                for (int i = 0; i < 16; ++i) Lo[i] = __shfl_xor(Lc[i], 32);
#pragma unroll
                for (int i = 0; i < 16; ++i) TOPK_INSERT(Lc, Lo[i]);
#pragma unroll
                for (int i = 0; i < 16; ++i) { if (p == 0) L0[i] = Lc[i]; else L1[i] = Lc[i]; }
            }
            float R[16];
#pragma unroll
            for (int i = 0; i < 16; ++i) R[i] = NEG_INF;
            CandRow<0>::run(L0, L1, R);
            unsigned a0 = 0, a1 = 0, a2 = 0, a3 = 0, b0 = 0, b1 = 0, b2 = 0, b3 = 0;
#pragma unroll
            for (int i = 0; i < 4; ++i) { a0 |= (__builtin_bit_cast(unsigned, L0[i]) & 127u) << (8 * i); a1 |= (__builtin_bit_cast(unsigned, L0[4 + i]) & 127u) << (8 * i);
                a2 |= (__builtin_bit_cast(unsigned, L0[8 + i]) & 127u) << (8 * i); a3 |= (__builtin_bit_cast(unsigned, L0[12 + i]) & 127u) << (8 * i);
                b0 |= (__builtin_bit_cast(unsigned, L1[i]) & 127u) << (8 * i); b1 |= (__builtin_bit_cast(unsigned, L1[4 + i]) & 127u) << (8 * i);
                b2 |= (__builtin_bit_cast(unsigned, L1[8 + i]) & 127u) << (8 * i); b3 |= (__builtin_bit_cast(unsigned, L1[12 + i]) & 127u) << (8 * i); }
            float ex[16]; float sum = 0.f; int id[16];
#pragma unroll
            for (int r = 0; r < 16; ++r) { ex[r] = __expf(R[r] - R[0]); sum += ex[r];
                const unsigned cid = __builtin_bit_cast(unsigned, R[r]) & 255u;
                id[r] = (int)(pick4(a0, a1, a2, a3, (int)(cid >> 4)) * 128u + pick4(b0, b1, b2, b3, (int)(cid & 15u))); }
            const float inv = 1.f / sum;
            if (hh == 0) {
#pragma unroll
                for (int q = 0; q < 4; ++q) {
                    *(int4*)(IDX + m * 128 + h * 16 + 4 * q) = make_int4(id[4 * q], id[4 * q + 1], id[4 * q + 2], id[4 * q + 3]);
                    *(f32x4*)(GW + m * 128 + h * 16 + 4 * q) = (f32x4){ex[4 * q] * inv, ex[4 * q + 1] * inv, ex[4 * q + 2] * inv, ex[4 * q + 3] * inv}; }
            }
        }
    }
}

__device__ __forceinline__ f32x2 fp8lo(unsigned w) { return __builtin_amdgcn_cvt_pk_f32_fp8((int)w, false); }
__device__ __forceinline__ f32x2 fp8hi(unsigned w) { return __builtin_amdgcn_cvt_pk_f32_fp8((int)w, true); }
__device__ __forceinline__ void apply_phase(Frame& F, float* OUTP) {
    const unsigned char* U8 = F.ws + WS_LG; const unsigned char* V8 = F.ws + WS_LG + 16 * MiB;
    const int* IDX = (const int*)(F.ws + WS_K); const float* GW = (const float*)(F.ws + WS_K + 16 * MiB);
    const float* g2 = F.in[20]; const float* gf = F.in[25];
    const float* X1 = F.out;
    const int lane = F.lane;
    const int gw = F.bid * NWAVES + F.wave, NGW = F.G * NWAVES;
    const bool b5 = (lane & 32) != 0, b4 = (lane & 16) != 0, b3 = (lane & 8) != 0, b2 = (lane & 4) != 0;
    const int eid = ((lane >> 5) & 1) * 8 + ((lane >> 4) & 1) * 4 + ((lane >> 3) & 1) * 2 + ((lane >> 2) & 1);
    for (int m = gw; m < MTOK; m += NGW) {
        f32x2 hv[8]; float s = 0.f;
#pragma unroll
        for (int q = 0; q < 4; ++q) { const f32x4 a = *(const f32x4*)(X1 + (size_t)m * DM + lane * 16 + q * 4);
            s += (a[0] * a[0] + a[1] * a[1]) + (a[2] * a[2] + a[3] * a[3]); hv[2 * q] = (f32x2){a[0], a[1]}; hv[2 * q + 1] = (f32x2){a[2], a[3]}; }
        const float r2 = rsqrtf(wave_sum(s) * (1.f / DM) + EPS) * (1.f / 32.f);
#pragma unroll
        for (int q = 0; q < 4; ++q) { const f32x4 g = *(const f32x4*)(g2 + lane * 16 + q * 4);
            hv[2 * q] = hv[2 * q] * (f32x2){g[0] * r2, g[1] * r2}; hv[2 * q + 1] = hv[2 * q + 1] * (f32x2){g[2] * r2, g[3] * r2}; }
        const int i0 = IDX[(size_t)m * 128 + lane], i1 = IDX[(size_t)m * 128 + 64 + lane];
        const float gw0 = GW[(size_t)m * 128 + lane], gw1 = GW[(size_t)m * 128 + 64 + lane];
        f32x2 acc[8];
#pragma unroll
        for (int i = 0; i < 8; ++i) acc[i] = (f32x2){0.f, 0.f};
#pragma unroll 1
        for (int bt = 0; bt < 8; ++bt) {
            const int k0 = bt * 16;
            const int isel = (k0 < 64) ? i0 : i1;
            v4u uu[16], vv[16];
#pragma unroll
            for (int e = 0; e < 16; ++e) { const size_t ro = (size_t)__builtin_amdgcn_readlane(isel, (k0 + e) & 63) * DM + lane * 16;
                uu[e] = *(const v4u*)(U8 + ro); vv[e] = *(const v4u*)(V8 + ro); }
            float x[16];
#pragma unroll
            for (int e = 0; e < 16; ++e) { f32x2 d = fp8lo(uu[e].x) * hv[0];
                d = __builtin_elementwise_fma(fp8hi(uu[e].x), hv[1], d); d = __builtin_elementwise_fma(fp8lo(uu[e].y), hv[2], d); d = __builtin_elementwise_fma(fp8hi(uu[e].y), hv[3], d);
                d = __builtin_elementwise_fma(fp8lo(uu[e].z), hv[4], d); d = __builtin_elementwise_fma(fp8hi(uu[e].z), hv[5], d); d = __builtin_elementwise_fma(fp8lo(uu[e].w), hv[6], d);
                d = __builtin_elementwise_fma(fp8hi(uu[e].w), hv[7], d); x[e] = d[0] + d[1]; }
            float y[8], z[4], u2[2], t;
#pragma unroll
            for (int j = 0; j < 8; ++j) { const float keep = b5 ? x[8 + j] : x[j], send = b5 ? x[j] : x[8 + j]; y[j] = keep + __shfl_xor(send, 32); }
#pragma unroll
            for (int j = 0; j < 4; ++j) { const float keep = b4 ? y[4 + j] : y[j], send = b4 ? y[j] : y[4 + j]; z[j] = keep + __shfl_xor(send, 16); }
#pragma unroll
            for (int j = 0; j < 2; ++j) { const float keep = b3 ? z[2 + j] : z[j], send = b3 ? z[j] : z[2 + j]; u2[j] = keep + __shfl_xor(send, 8); }
            { const float keep = b2 ? u2[1] : u2[0], send = b2 ? u2[0] : u2[1]; t = keep + __shfl_xor(send, 4); }
            t += __shfl_xor(t, 2); t += __shfl_xor(t, 1);
            const float gk = __shfl((k0 < 64) ? gw0 : gw1, (k0 + eid) & 63);
            const float wl = gk * gelu_fast(t) * 0.25f;
#pragma unroll
            for (int e = 0; e < 16; ++e) {
                const float we = __builtin_bit_cast(float, __builtin_amdgcn_readlane(__builtin_bit_cast(int, wl), 32 * (e >> 3) + 16 * ((e >> 2) & 1) + 8 * ((e >> 1) & 1) + 4 * (e & 1)));
                const f32x2 w2 = (f32x2){we, we};
                acc[0] = __builtin_elementwise_fma(fp8lo(vv[e].x), w2, acc[0]); acc[1] = __builtin_elementwise_fma(fp8hi(vv[e].x), w2, acc[1]);
                acc[2] = __builtin_elementwise_fma(fp8lo(vv[e].y), w2, acc[2]); acc[3] = __builtin_elementwise_fma(fp8hi(vv[e].y), w2, acc[3]);
                acc[4] = __builtin_elementwise_fma(fp8lo(vv[e].z), w2, acc[4]); acc[5] = __builtin_elementwise_fma(fp8hi(vv[e].z), w2, acc[5]);
                acc[6] = __builtin_elementwise_fma(fp8lo(vv[e].w), w2, acc[6]); acc[7] = __builtin_elementwise_fma(fp8hi(vv[e].w), w2, acc[7]);
            }
        }
        float s2 = 0.f;
#pragma unroll
        for (int q = 0; q < 4; ++q) { const f32x4 a = *(const f32x4*)(X1 + (size_t)m * DM + lane * 16 + q * 4);
            acc[2 * q] = acc[2 * q] + (f32x2){a[0], a[1]}; acc[2 * q + 1] = acc[2 * q + 1] + (f32x2){a[2], a[3]};
            s2 += (acc[2 * q][0] * acc[2 * q][0] + acc[2 * q][1] * acc[2 * q][1]) + (acc[2 * q + 1][0] * acc[2 * q + 1][0] + acc[2 * q + 1][1] * acc[2 * q + 1][1]); }
        const float rf = rsqrtf(wave_sum(s2) * (1.f / DM) + EPS);
#pragma unroll
        for (int q = 0; q < 4; ++q) { const f32x4 g = *(const f32x4*)(gf + lane * 16 + q * 4);
            *(f32x4*)(OUTP + (size_t)m * DM + lane * 16 + q * 4) = (f32x4){acc[2 * q][0] * rf * g[0], acc[2 * q][1] * rf * g[1], acc[2 * q + 1][0] * rf * g[2], acc[2 * q + 1][1] * rf * g[3]}; }
    }
}

constexpr int N_PHASES = 13;
__global__ void __launch_bounds__(NTHR, 2) mega_fwd(Args args) {
    extern __shared__ __attribute__((aligned(16))) unsigned char lds[];
    Frame F;
    F.lds = (LAS unsigned char*)lds;
    F.tid = threadIdx.x; F.lane = F.tid & 63; F.wave = __builtin_amdgcn_readfirstlane(F.tid >> 6);
    F.G = gridDim.x; F.bid = blockIdx.x;
    F.in = args.in; F.out = args.out; F.ws = args.ws;
    volatile LAS unsigned* MISC = (volatile LAS unsigned*)(F.lds + MISC_OFF);
    for (int u = F.tid; u < (LDS_BYTES - LDSCTL_OFF) / 4; u += NTHR) ((LAS unsigned*)(F.lds + LDSCTL_OFF))[u] = 0u;
    __syncthreads();
    XcdBarrier bar; bar.bar = (unsigned*)(args.ws + WS_CTL) + CW_BAR; bar.x = 0; bar.st = nullptr;
    const bool one_launch = (args.ph_hi - args.ph_lo) > 1;
    if (one_launch) bar = xcd_barrier_post((unsigned*)(args.ws + WS_CTL) + CW_BAR, MISC + 8);
    const int lo = args.ph_lo, hi = args.ph_hi;
#define IN(k) (lo <= (k) && (k) < hi)
#define SEAM(k) do { if (IN(k) && IN((k) + 1)) xcd_barrier(bar); } while (0)
    unsigned char* ws = args.ws;

#ifndef PROBE_MASK
#define PROBE_MASK 0
#endif
#define REP(k) for (int rep_ = 0; rep_ < (((PROBE_MASK >> (k)) & 1) ? 2 : 1); ++rep_)
    if (IN(0)) REP(0) { p0_prologue(F); if (rep_ == 0 && ((PROBE_MASK >> 0) & 1)) xcd_barrier(bar); } SEAM(0);
    if (IN(1)) REP(1) {
        AddrPlain g{(const char*)F.out, (const char*)(ws + WS_WIN), 1024, 1024, 1024};
        pg8::StaticOrder S; S.init(MTOK, 6144, F.G, F.bid);
        EpiBf16<DstP1> E{DstP1{ws}};
        pg8::gemm_phase(F.lds, g, S, E);
    } SEAM(1);
    if (IN(2)) REP(2) { lru_phase<false>(F); } SEAM(2);
    if (IN(3)) REP(3) { lru_phase<true>(F); } SEAM(3);
    if (IN(4)) REP(4) { mconv_phase(F); } SEAM(4);
    if (IN(5)) REP(5) {
        AddrQKV g{(const char*)(ws + WS_XL), (long)WS_XM - (long)WS_XL, (const char*)(ws + WS_WQKV), 1024, 256, 256};
        pg8::StaticOrder S; S.init(MTOK, 12 * 256, F.G, F.bid);
        EpiBf16<DstQKV> E{DstQKV{(char*)(ws + WS_LG), (long)WS_K - (long)WS_LG, (long)((char*)F.out + (size_t)MTOK * DM * 2 - (char*)(ws + WS_LG))}};
        pg8::gemm_phase(F.lds, g, S, E);
    } SEAM(5);
    if (IN(6)) REP(6) { mscan_phase(F); } SEAM(6);
    if (IN(7)) { ym_phase(F); } SEAM(7);
    if (IN(8)) {
        AddrBranch g{(const char*)(ws + WS_OP), (long)((const char*)F.out - (const char*)(ws + WS_OP)), (const char*)(ws + WS_WB2), 1024, 1024, 1024};
        pg8::StaticOrder S; S.init(MTOK, 2048, F.G, F.bid);
        EpiGate E{(bf16*)(ws + WS_MG)};
        pg8::gemm_phase(F.lds, g, S, E);
    } SEAM(8);
    if (IN(9)) {
        AddrPlain g{(const char*)(ws + WS_MG), (const char*)(ws + WS_WOUT2), 2048, 2048, 2048};
        pg8::StaticOrder S; S.init(MTOK, 1024, F.G, F.bid);
        EpiResid E{F.in[0], F.out, (bf16*)(ws + WS_XM), (float*)(ws + WS_SS)};
        pg8::gemm_phase(F.lds, g, S, E);
    } SEAM(9);
    if (IN(10)) REP(10) {
        AddrPlain g{(const char*)(ws + WS_XM), (const char*)(ws + WS_WPQ), 1024, 1024, 1024};
        pg8::StaticOrder S; S.init(MTOK, 2048, F.G, F.bid);
        EpiPQ E{(bf16*)(ws + WS_MG), (const float*)(ws + WS_SS)};
        pg8::gemm_phase(F.lds, g, S, E);
    } SEAM(10);
    if (IN(11)) REP(11) { select_phase(F); } SEAM(11);
    if (IN(12)) { if ((PROBE_MASK >> 12) & 1) { apply_phase(F, (float*)(ws + WS_MG)); xcd_barrier(bar); } apply_phase(F, F.out); }
#undef REP
#undef IN
#undef SEAM
}

extern "C" void kernel_launch(void* const* d_in, const int* in_sizes, int n_in, void* d_out, int out_size, void* d_ws, size_t ws_size, hipStream_t stream) {
    static int grid = 0;
    if (grid == 0) {
        if (n_in != 26 || in_sizes[0] != MTOK * DM || out_size != MTOK * DM || ws_size < WS_END) { fprintf(stderr, "kernel_launch: unexpected shapes / workspace (%zu < %zu)\n", ws_size, (size_t)WS_END); grid = -1; return; }
        int dev = 0, cus = 0, per_cu = 0;
        if (hipGetDevice(&dev) != hipSuccess || hipDeviceGetAttribute(&cus, hipDeviceAttributeMultiprocessorCount, dev) != hipSuccess) { grid = -1; return; }
        if (hipFuncSetAttribute((const void*)mega_fwd, hipFuncAttributeMaxDynamicSharedMemorySize, LDS_BYTES) != hipSuccess) { fprintf(stderr, "kernel_launch: hipFuncSetAttribute failed\n"); grid = -1; return; }
        if (hipOccupancyMaxActiveBlocksPerMultiprocessor(&per_cu, (const void*)mega_fwd, NTHR, LDS_BYTES) != hipSuccess || per_cu < 1) { fprintf(stderr, "kernel_launch: occupancy query says %d blocks/CU\n", per_cu); (void)hipGetLastError(); grid = -1; return; }
        grid = cus;
    }
    if (grid < 0) return;
    (void)hipMemsetAsync((char*)d_ws + WS_CTL, 0, CTL_ZERO_BYTES, stream);
    Args a{};
    for (int i = 0; i < 26; ++i) a.in[i] = (const float*)d_in[i];
    a.out = (float*)d_out; a.ws = (unsigned char*)d_ws;
#if MK_N_LAUNCHES == 1
    a.ph_lo = 0; a.ph_hi = N_PHASES;
    void* kargs[] = {&a};
    hipError_t e = hipLaunchCooperativeKernel((const void*)mega_fwd, dim3(grid), dim3(NTHR), kargs, LDS_BYTES, stream);
    if (e != hipSuccess) fprintf(stderr, "kernel_launch: cooperative launch failed: %s (grid %d)\n", hipGetErrorString(e), grid);
#else
    for (int p = 0; p < N_PHASES; ++p) { a.ph_lo = p; a.ph_hi = p + 1; hipLaunchKernelGGL(mega_fwd, dim3(grid), dim3(NTHR), LDS_BYTES, stream, a); }
#endif
}
```

```cpp
#include <hip/hip_runtime.h>
#include <cstdio>
#include <cstdint>
#include <math.h>

#ifndef MK_N_LAUNCHES
#define MK_N_LAUNCHES 1
#endif

constexpr int BATCH = 8, SEQ = 4096, DM = 1024, MTOK = BATCH * SEQ;
constexpr int DIN = 6160;
constexpr int NEXP = 16384;
constexpr float EPS = 1e-6f;

constexpr size_t MiB = 1u << 20;
constexpr size_t WS_CTL = 0, CTL_ZERO_BYTES = 1 * MiB;
constexpr size_t WS_WIN = 1 * MiB;
constexpr size_t WS_WQKV = 13 * MiB;
constexpr size_t WS_KEYS = 14 * MiB + 512 * 1024;
constexpr size_t WS_WLRU = 15 * MiB;
constexpr size_t WS_WB2 = 16 * MiB;
constexpr size_t WS_WOUT2 = 20 * MiB;
constexpr size_t WS_WPQ = 24 * MiB;
constexpr size_t WS_GATE = 28 * MiB;
constexpr size_t WS_WGT = 30 * MiB;
constexpr size_t WS_XM = 32 * MiB;
constexpr size_t WS_OP = 96 * MiB;
constexpr size_t WS_XL = 160 * MiB;
constexpr size_t WS_LG = 224 * MiB;
constexpr size_t WS_MG = 288 * MiB;
constexpr size_t WS_K = 416 * MiB;
constexpr size_t WS_AGG = 480 * MiB;
constexpr size_t WS_SS = 488 * MiB;
constexpr size_t WS_END = 489 * MiB;

constexpr int CW_BAR = 4096;

constexpr int RING_BYTES = 131072;
constexpr int LDS_BYTES = 147456;
constexpr int LDSCTL_OFF = LDS_BYTES - 512, MISC_OFF = LDSCTL_OFF + 320;
constexpr int NWAVES = 8, NTHR = 512;

#define GAS __attribute__((address_space(1)))
#define LAS __attribute__((address_space(3)))
typedef unsigned short bf16;
typedef unsigned v4u __attribute__((ext_vector_type(4)));
typedef unsigned v2u __attribute__((ext_vector_type(2)));
typedef float f32x4 __attribute__((ext_vector_type(4)));
typedef float f32x2 __attribute__((ext_vector_type(2)));
typedef short bf16x8 __attribute__((ext_vector_type(8)));
typedef GAS unsigned gu32;
#define RLX_AGENT __ATOMIC_RELAXED, __HIP_MEMORY_SCOPE_AGENT
#define LDS_WAIT() asm volatile("s_waitcnt lgkmcnt(0)" ::: "memory")
#define VM_WAIT() asm volatile("s_waitcnt vmcnt(0)" ::: "memory")

__device__ __forceinline__ unsigned f2bf(float f) { unsigned u = __builtin_bit_cast(unsigned, f); return (u + 0x7fffu + ((u >> 16) & 1u)) >> 16; }
__device__ __forceinline__ unsigned pk2(float lo, float hi) { return f2bf(lo) | (f2bf(hi) << 16); }
__device__ __forceinline__ float bf2f(unsigned short h) { return __builtin_bit_cast(float, (unsigned)h << 16); }
__device__ __forceinline__ float bflo(unsigned w) { return __builtin_bit_cast(float, w << 16); }
__device__ __forceinline__ float bfhi(unsigned w) { return __builtin_bit_cast(float, w & 0xffff0000u); }
__device__ __forceinline__ float wave_sum(float v) {
#pragma unroll
  for (int o = 1; o < 64; o <<= 1) v += __shfl_xor(v, o);
  return v;
}
__device__ __forceinline__ float sigmoidf_(float x) { return __builtin_amdgcn_rcpf(1.f + __builtin_amdgcn_exp2f(x * -1.44269504089f)); }
__device__ __forceinline__ float gelu_erf(float x) { return 0.5f * x * (1.f + erff(x * 0.70710678118654752f)); }
__device__ __forceinline__ float gelu_fast(float v) {
    const float av = fabsf(v), t = __builtin_amdgcn_rcpf(av * 0.2316418882f + 1.0f);
    float q = t * 0.5307027145f + (-0.7265760135f); q = q * t + 0.7107068705f; q = q * t + (-0.142248368f); q = q * t + 0.127414796f; q = q * t;
    const float e = __builtin_amdgcn_exp2f((v * v) * (-0.72134752044f));
    const float m = v * (q * e);
    return v < 0.f ? m : v - m;
}
__device__ __forceinline__ float softplusf_(float x) { return fmaxf(x, 0.f) + log1pf(expf(-fabsf(x))); }

namespace pg8 {
#define PG8_LAS __attribute__((address_space(3)))
typedef unsigned short bf16_t;
typedef unsigned u32x4 __attribute__((ext_vector_type(4)));
constexpr int BM = 256, BK = 64, HALF = 128, HTB = HALF * BK * 2, STAGE_BYTES = 8 * HTB, NXCD = 8;

__host__ __device__ __forceinline__ int lds_byte(int r, int c) { const int st = (r >> 4) * 2 + (c >> 5), rr = r & 15, cc = c & 31, ob = rr * 64 + cc * 2; return st * 1024 + (ob ^ (((ob >> 9) & 1) << 5)); }
__host__ __device__ __forceinline__ void stage_rc(int b, int& R, int& C) { const int st = b / 1024, sb = b % 1024, swz = sb ^ (((sb >> 9) & 1) << 5); R = (st >> 1) * 16 + swz / 64; C = (st & 1) * 32 + (swz % 64) / 2; }
__host__ __device__ __forceinline__ int perm32(int rho) { const int n = rho >> 4, i = rho & 15; return 8 * (i >> 2) + 4 * n + (i & 3); }

struct Unit { int pm, pn; };
struct StaticOrder {
    int nM, nN, nwg, G, c, WGM;
    __host__ __device__ void init(int M, int N, int G_, int c_, int wgm = 8) { nM = M / BM; nN = N / BM; nwg = nM * nN; G = G_; c = c_; WGM = wgm; }
    __host__ __device__ bool next(int i, Unit& u) const {
        const long L = (long)i * G + c; if (L >= nwg) return false;
        int wgid = (int)L; { const int q = nwg / NXCD, r = nwg % NXCD, xcd = wgid % NXCD, off = wgid / NXCD; wgid = (xcd < r ? xcd * (q + 1) : r * (q + 1) + (xcd - r) * q) + off; }
        const int nig = WGM * nN, gid = wgid / nig, fm = gid * WGM, gsz = (nM - fm) < WGM ? (nM - fm) : WGM;
        u.pm = fm + ((wgid % nig) % gsz); u.pn = (wgid % nig) / gsz; return true;
    }
};

__device__ __forceinline__ unsigned cvt_pk_bf16(float lo, float hi) { unsigned r; asm volatile("v_cvt_pk_bf16_f32 %0, %1, %2" : "=v"(r) : "v"(lo), "v"(hi)); return r; }

template <class Epi, class Addr>
__device__ __forceinline__ void gemm_phase(PG8_LAS unsigned char* lds, const Addr g, const StaticOrder& S, const Epi& E) {
    const int tid = threadIdx.x, wid = __builtin_amdgcn_readfirstlane(tid >> 6), lane = tid & 63, wr = wid >> 2, wc = wid & 3, fr = lane & 15, fq = lane >> 4;
    const int K = g.K, nt = K / BK;
    unsigned voffA[2], voffB[2];
#pragma unroll
    for (int i = 0; i < 2; ++i) { int R, C; stage_rc(tid * 16 + i * 8192, R, C); const int Rb = Epi::PERM ? ((R & ~31) + perm32(R & 31)) : R;
        voffA[i] = (unsigned)(R * g.lda + C) * 2u; voffB[i] = (unsigned)(Rb * g.ldb + C) * 2u; }
    const size_t kstep = (size_t)(BK * 2);
    const size_t hsA = (size_t)HALF * g.lda * 2, hsB = (size_t)HALF * g.ldb * 2;
    const unsigned ldsw = (unsigned)wid * 1024u;
    const int aoff = lds_byte(wr * 64 + fr, fq * 8), boff = lds_byte(wc * 32 + fr, fq * 8);
#define PG8_SA(b, h) (((b) * 2 + (h)) * HTB)
#define PG8_SB(b, h) ((4 + (b) * 2 + (h)) * HTB)
#define PG8_STAGE(bufoff, gbase, voff) do { _Pragma("unroll") for (int _i = 0; _i < 2; ++_i) \
        __builtin_amdgcn_global_load_lds((const unsigned*)((const char*)(gbase) + (voff)[_i]), (PG8_LAS unsigned*)(lds + (bufoff) + ldsw + _i * 8192), 16, 0, 0); } while (0)
#define PG8_LDA(dst, b, h) do { _Pragma("unroll") for (int m = 0; m < 4; ++m) _Pragma("unroll") for (int k = 0; k < 2; ++k) dst[m][k] = *(const PG8_LAS bf16x8*)(lds + PG8_SA(b, h) + aoff + m * 2048 + k * 1024); } while (0)
#define PG8_LDB(dst, b, h) do { _Pragma("unroll") for (int n = 0; n < 2; ++n) _Pragma("unroll") for (int k = 0; k < 2; ++k) dst[n][k] = *(const PG8_LAS bf16x8*)(lds + PG8_SB(b, h) + boff + n * 2048 + k * 1024); } while (0)
#define PG8_MMA(ai, bj, At, Bt) do { __builtin_amdgcn_s_setprio(1); _Pragma("unroll") for (int m = 0; m < 4; ++m) _Pragma("unroll") for (int n = 0; n < 2; ++n) _Pragma("unroll") for (int k = 0; k < 2; ++k) \
        acc[ai][bj][m][n] = __builtin_amdgcn_mfma_f32_16x16x32_bf16(Bt[n][k], At[m][k], acc[ai][bj][m][n], 0, 0, 0); __builtin_amdgcn_s_setprio(0); } while (0)
#define PG8_WAIT_V(n) asm volatile("s_waitcnt vmcnt(" #n ")" ::: "memory")
#define PG8_WAIT_L(n) asm volatile("s_waitcnt lgkmcnt(" #n ")" ::: "memory")
#define PG8_BAR __builtin_amdgcn_s_barrier()
#define PG8_SCHED __builtin_amdgcn_sched_barrier(0)
    Unit cur, nxt; int ui = 0;
    if (!S.next(0, cur)) return;
    f32x4 acc[2][2][4][2];
#pragma unroll
    for (int a = 0; a < 2; ++a)
#pragma unroll
        for (int b = 0; b < 2; ++b)
#pragma unroll
            for (int m = 0; m < 4; ++m)
#pragma unroll
                for (int n = 0; n < 2; ++n) acc[a][b][m][n] = (f32x4){0.f, 0.f, 0.f, 0.f};
    bf16x8 At[4][2], B0[2][2], B1[2][2];
    const char* cA = g.a(cur); const char* cB = g.b(cur);
    PG8_STAGE(PG8_SB(0, 0), cB, voffB); PG8_STAGE(PG8_SB(0, 1), cB + hsB, voffB); PG8_STAGE(PG8_SA(0, 0), cA, voffA); PG8_STAGE(PG8_SA(0, 1), cA + hsA, voffA);
    if (wr == 1) PG8_BAR;
    PG8_WAIT_V(2); PG8_BAR;
    PG8_STAGE(PG8_SB(1, 0), cB + kstep, voffB); PG8_STAGE(PG8_SA(1, 0), cA + kstep, voffA); PG8_STAGE(PG8_SB(1, 1), cB + hsB + kstep, voffB);
    PG8_WAIT_V(6); PG8_BAR;
    for (;;) {
        const bool has_next = S.next(ui + 1, nxt);
        const char* nA = has_next ? g.a(nxt) : cA; const char* nB = has_next ? g.b(nxt) : cB;
#pragma unroll 1
        for (int t = 0; t < nt; t += 2) {
            const bool last = (t == nt - 2);
            const char* a1 = cA + (size_t)(t + 1) * kstep;
            const char* a2 = last ? nA : cA + (size_t)(t + 2) * kstep; const char* b2 = last ? nB : cB + (size_t)(t + 2) * kstep;
            const char* a3 = a2 + kstep; const char* b3 = b2 + kstep;
            PG8_LDB(B0, 0, 0); PG8_LDB(B1, 0, 1); PG8_SCHED; PG8_LDA(At, 0, 0); PG8_STAGE(PG8_SA(1, 1), a1 + hsA, voffA);
            PG8_WAIT_V(8); PG8_WAIT_L(0); PG8_BAR; PG8_MMA(0, 0, At, B0); PG8_MMA(0, 1, At, B1); PG8_BAR; PG8_SCHED;
            PG8_LDA(At, 0, 1); PG8_STAGE(PG8_SB(0, 0), b2, voffB); PG8_STAGE(PG8_SB(0, 1), b2 + hsB, voffB); PG8_STAGE(PG8_SA(0, 0), a2, voffA);
            PG8_WAIT_V(8); PG8_WAIT_L(0); PG8_BAR; PG8_MMA(1, 0, At, B0); PG8_MMA(1, 1, At, B1); PG8_BAR; PG8_SCHED;
            PG8_LDB(B0, 1, 0); PG8_LDB(B1, 1, 1); PG8_SCHED; PG8_LDA(At, 1, 0); PG8_STAGE(PG8_SA(0, 1), a2 + hsA, voffA);
            PG8_WAIT_V(8); PG8_WAIT_L(0); PG8_BAR; PG8_MMA(0, 0, At, B0); PG8_MMA(0, 1, At, B1); PG8_BAR; PG8_SCHED;
            PG8_LDA(At, 1, 1); PG8_STAGE(PG8_SB(1, 0), b3, voffB); PG8_STAGE(PG8_SB(1, 1), b3 + hsB, voffB); PG8_STAGE(PG8_SA(1, 0), a3, voffA);
            PG8_WAIT_V(8); PG8_WAIT_L(0); PG8_BAR; PG8_MMA(1, 0, At, B0); PG8_MMA(1, 1, At, B1); PG8_BAR; PG8_SCHED;
        }
        if (wr == 0) PG8_BAR;
        E(acc, cur, wr, wc, fr, fq);
        if (!has_next) break;
#pragma unroll
        for (int a = 0; a < 2; ++a)
#pragma unroll
            for (int b = 0; b < 2; ++b)
#pragma unroll
                for (int m = 0; m < 4; ++m)
#pragma unroll
                    for (int n = 0; n < 2; ++n) acc[a][b][m][n] = (f32x4){0.f, 0.f, 0.f, 0.f};
        cur = nxt; cA = nA; cB = nB; ++ui;
        if (wr == 1) PG8_BAR;
    }
    PG8_WAIT_V(0);
    PG8_BAR;
#undef PG8_SA
#undef PG8_SB
#undef PG8_STAGE
#undef PG8_LDA
#undef PG8_LDB
#undef PG8_MMA
#undef PG8_WAIT_V
#undef PG8_WAIT_L
#undef PG8_BAR
#undef PG8_SCHED
}
}

#define XB_TMO      128
#define XB_XCNT(j)  (256  + 64 * (j))
#define XB_XSUB(j)  (1280 + 64 * (j))
#define XB_XGEN(j)  (2304 + 64 * (j))
#define XB_TOP      3328
#define XB_TOPGEN   3392
#define XCD_BAR_WORDS 3456
#define XB_SPIN_CAP (1u << 18)
__device__ __forceinline__ unsigned xb_ld(unsigned* p)              { return __hip_atomic_load(p, __ATOMIC_RELAXED, __HIP_MEMORY_SCOPE_AGENT); }
__device__ __forceinline__ unsigned xb_add(unsigned* p, unsigned v) { return __hip_atomic_fetch_add(p, v, __ATOMIC_RELAXED, __HIP_MEMORY_SCOPE_AGENT); }
__device__ __forceinline__ unsigned xb_xcc_id() { return (unsigned)__builtin_amdgcn_s_getreg((3 << 11) | 20) & 0xFu; }
#define XB_SPIN(cond, bar) do { unsigned _sp = 0; while (cond) { __builtin_amdgcn_s_sleep(1); \
    if ((++_sp & 255u) == 0u) { if (xb_ld(&(bar)[XB_TMO])) break; if (_sp > XB_SPIN_CAP) { atomicAdd(&(bar)[XB_TMO], 1u); break; } } } } while (0)
struct XcdBarrier { unsigned* bar; unsigned x; volatile LAS unsigned* st; };
__device__ __forceinline__ XcdBarrier xcd_barrier_post(unsigned* bar, volatile LAS unsigned* st) {
    XcdBarrier b; b.bar = bar; b.x = xb_xcc_id(); b.st = st;
    if (threadIdx.x == 0) (void)xb_add(&bar[XB_XCNT(b.x)], 1u);
    return b;
}
__device__ __forceinline__ void xcd_barrier_complete(unsigned* bar, unsigned x, unsigned& nloc, unsigned& nx) {
    const unsigned G = gridDim.x * gridDim.y * gridDim.z;
    unsigned sum, cnt, mine, sp = 0u;
    for (;;) {
        sum = 0u; cnt = 0u; mine = 0u;
#pragma unroll
        for (unsigned j = 0; j < 16; ++j) { const unsigned c = xb_ld(&bar[XB_XCNT(j)]); sum += c; cnt += (c > 0u) ? 1u : 0u; mine = (j == x) ? c : mine; }
        if (sum == G) break;
        __builtin_amdgcn_s_sleep(1);
        if ((++sp & 255u) == 0u) { if (xb_ld(&bar[XB_TMO])) break; if (sp > XB_SPIN_CAP) { atomicAdd(&bar[XB_TMO], 1u); break; } }
    }
    nloc = mine > 0u ? mine : 1u; nx = cnt > 0u ? cnt : 1u;
}
__device__ __forceinline__ void xcd_barrier(const XcdBarrier& b) {
    asm volatile("s_waitcnt vmcnt(0)" ::: "memory");
    __syncthreads();
    if (threadIdx.x == 0) {
        unsigned* bar = b.bar;
        __builtin_amdgcn_s_waitcnt(0);
        unsigned nloc = b.st[0], nx = b.st[1];
        if (nloc == 0u) { xcd_barrier_complete(bar, b.x, nloc, nx); b.st[0] = nloc; b.st[1] = nx; }
        const unsigned old = xb_add(&bar[XB_XSUB(b.x)], 1u);
        const unsigned gen = old / nloc;
        if (old + 1u == (gen + 1u) * nloc) {
            __builtin_amdgcn_fence(__ATOMIC_RELEASE, "agent");
            asm volatile("s_waitcnt vmcnt(0)" ::: "memory");
            const unsigned og = xb_add(&bar[XB_TOP], 1u);
            const unsigned tg = og / nx;
            if (og + 1u == (tg + 1u) * nx) xb_add(&bar[XB_TOPGEN], 1u);
            else XB_SPIN(xb_ld(&bar[XB_TOPGEN]) == tg, bar);
            __builtin_amdgcn_fence(__ATOMIC_ACQUIRE, "agent");
            xb_add(&bar[XB_XGEN(b.x)], 1u);
            asm volatile("s_waitcnt vmcnt(0)" ::: "memory");
        } else {
            XB_SPIN(xb_ld(&bar[XB_XGEN(b.x)]) == gen, bar);
            __builtin_amdgcn_fence(__ATOMIC_ACQUIRE, "agent");
            asm volatile("s_waitcnt vmcnt(0)" ::: "memory");
        }
    }
    __syncthreads();
}

struct Args { const float* in[26]; float* out; unsigned char* ws; int ph_lo, ph_hi; };
struct Frame {
    LAS unsigned char* lds;
    int tid, lane, wave, G, bid;
    const float* const* in; float* out; unsigned char* ws;
};

__device__ __forceinline__ void tr_item(const float* W, int ldw, bf16* WT, int ldt, float scale, const float* kscale, LAS float* scr, int k0, int lane) {
#pragma unroll 8
    for (int i = 0; i < 32; ++i) { const int kk = 2 * i + (lane >> 5); float v = W[(size_t)(k0 + kk) * ldw + (lane & 31)] * scale; if (kscale) v *= kscale[k0 + kk]; scr[kk * 33 + (lane & 31)] = v; }
    LDS_WAIT(); asm volatile("" ::: "memory");
    const int c = lane & 7;
#pragma unroll
    for (int j = 0; j < 4; ++j) { const int n = (lane >> 3) + 8 * j; const LAS float* s = scr + (8 * c) * 33 + n;
        v4u o; o.x = pk2(s[0 * 33], s[1 * 33]); o.y = pk2(s[2 * 33], s[3 * 33]); o.z = pk2(s[4 * 33], s[5 * 33]); o.w = pk2(s[6 * 33], s[7 * 33]);
        *(GAS v4u*)(WT + (size_t)n * ldt + k0 + 8 * c) = o; }
    LDS_WAIT(); asm volatile("" ::: "memory");
}

__device__ __forceinline__ void p0_prologue(Frame& F) {
    LAS float* scr = (LAS float*)(F.lds + F.wave * 16384);
    const int gw = F.bid * NWAVES + F.wave, NGW = F.G * NWAVES;
    unsigned char* ws = F.ws;
    const float* w_in = F.in[2];
    constexpr int I_WIN = 16 * 192, I_QKV = 12 * 32, I_LRU = 32 * 8, I_WB = 2 * 512, I_WO = 2 * 512, I_PQ = 16 * 64;
    constexpr int NITEMS = I_WIN + I_QKV + I_LRU + I_WB + I_WO + I_PQ;
    for (int it = gw; it < NITEMS; it += NGW) {
        int r = it;
        if (r < I_WIN) { const int kb = r / 192, nb = r % 192, n0 = nb * 32, sc = n0 < 2048 ? n0 : n0 + 16;
            tr_item(w_in + sc, DIN, (bf16*)(ws + WS_WIN) + (size_t)n0 * 1024, 1024, 1.f, nullptr, scr, kb * 64, F.lane); continue; }
        r -= I_WIN;
        if (r < I_QKV) { const int mat = r / 32, rr = r % 32, kb = rr / 8, nb = rr % 8, g = mat >> 2, h = mat & 3;
            const float* W = F.in[6 + g] + (size_t)h * 65536 + nb * 32;
            tr_item(W, 256, (bf16*)(ws + WS_WQKV) + (size_t)mat * 65536 + (size_t)(nb * 32) * 256, 256, g == 1 ? 0.0625f : 1.f, nullptr, scr, kb * 64, F.lane); continue; }
        r -= I_QKV;
        if (r < I_LRU) { const int mat = r / 8, rr = r % 8, kb = rr / 4, nb = rr % 4, gate = mat & 1, db = mat >> 1;
            const float* W = F.in[gate ? 14 : 12] + (size_t)db * 16384 + nb * 32;
            tr_item(W, 128, (bf16*)(ws + WS_WLRU) + (size_t)mat * 16384 + (size_t)(nb * 32) * 128, 128, 1.f, nullptr, scr, kb * 64, F.lane); continue; }
        r -= I_LRU;
        if (r < I_WB) { const int mat = r / 512, rr = r % 512, kb = rr / 32, nb = rr % 32;
            const float* W = F.in[17 + mat] + nb * 32;
            tr_item(W, 1024, (bf16*)(ws + WS_WB2) + (size_t)(mat * 1024 + nb * 32) * 1024, 1024, 1.f, nullptr, scr, kb * 64, F.lane); continue; }
        r -= I_WB;
        if (r < I_WO) { const int cp = r / 512, rr = r % 512, kb = rr / 32, nb = rr % 32;
            const float* W = F.in[19] + nb * 32;
            tr_item(W, 1024, (bf16*)(ws + WS_WOUT2) + (size_t)(nb * 32) * 2048 + cp * 1024, 2048, 1.f, nullptr, scr, kb * 64, F.lane); continue; }
        r -= I_WO;
        { const int kb = r / 64, nb = r % 64;
            const float* W = F.in[21] + nb * 32;
            tr_item(W, 2048, (bf16*)(ws + WS_WPQ) + (size_t)(nb * 32) * 1024, 1024, 1.f, F.in[20], scr, kb * 64, F.lane); }
    }
    { const int gt = F.bid * NTHR + F.tid, NGT = F.G * NTHR;
      const float4* ks = (const float4*)F.in[22]; v2u* kd = (v2u*)(ws + WS_KEYS);
      for (int i = gt; i < 8 * 2 * 128 * 128 / 4; i += NGT) { const float4 v = ks[i]; v2u o; o.x = pk2(v.x, v.y); o.y = pk2(v.z, v.w); kd[i] = o; }
      float* ss = (float*)(ws + WS_SS);
      for (int i = gt; i < MTOK; i += NGT) ss[i] = 0.f; }
    { const int gt = F.bid * NTHR + F.tid;
      if (gt < 16 * 128) { const int c = gt >> 7, k8 = gt & 127; v4u o; unsigned wv[4];
#pragma unroll
          for (int j = 0; j < 4; ++j) wv[j] = pk2(w_in[(size_t)(k8 * 8 + 2 * j) * DIN + 2048 + c], w_in[(size_t)(k8 * 8 + 2 * j + 1) * DIN + 2048 + c]);
          o.x = wv[0]; o.y = wv[1]; o.z = wv[2]; o.w = wv[3]; *(v4u*)((bf16*)(ws + WS_WGT) + c * 1024 + k8 * 8) = o; } }
    const float* x = F.in[0]; const float* g1 = F.in[1];
    bf16* XN = (bf16*)(ws + WS_K);
    f32x4 gv[4];
#pragma unroll
    for (int j = 0; j < 4; ++j) gv[j] = ((const f32x4*)g1)[F.lane + 64 * j];
    for (int m = 2 * gw; m < MTOK; m += 2 * NGW) {
        const f32x4* xr0 = (const f32x4*)(x + (size_t)m * DM) + F.lane; const f32x4* xr1 = xr0 + DM / 4;
        f32x4 v0[4], v1[4]; float s0 = 0.f, s1 = 0.f;
#pragma unroll
        for (int j = 0; j < 4; ++j) { v0[j] = xr0[64 * j]; v1[j] = xr1[64 * j]; }
#pragma unroll
        for (int j = 0; j < 4; ++j) { s0 += (v0[j].x * v0[j].x + v0[j].y * v0[j].y) + (v0[j].z * v0[j].z + v0[j].w * v0[j].w); s1 += (v1[j].x * v1[j].x + v1[j].y * v1[j].y) + (v1[j].z * v1[j].z + v1[j].w * v1[j].w); }
        const float r0 = rsqrtf(wave_sum(s0) * (1.f / DM) + EPS), r1 = rsqrtf(wave_sum(s1) * (1.f / DM) + EPS);
        unsigned long long* o0 = (unsigned long long*)(XN + (size_t)m * DM) + F.lane; unsigned long long* o1 = o0 + DM / 4;
#pragma unroll
        for (int j = 0; j < 4; ++j) { const f32x4 a = v0[j] * r0 * gv[j], c = v1[j] * r1 * gv[j];
            o0[64 * j] = (unsigned long long)pk2(a.x, a.y) | ((unsigned long long)pk2(a.z, a.w) << 32);
            o1[64 * j] = (unsigned long long)pk2(c.x, c.y) | ((unsigned long long)pk2(c.z, c.w) << 32); }
    }
}
__device__ __forceinline__ void gates_phase(Frame& F) {
    const bf16* XN = (const bf16*)(F.ws + WS_K); const bf16* WGT = (const bf16*)(F.ws + WS_WGT); float* GT = (float*)(F.ws + WS_GATE);
    const int lane = F.lane, fr = lane & 15, fq = lane >> 4;
    const f32x4 bg4 = *(const f32x4*)(F.in[3] + 4 * fq);
    for (int task = F.bid * NWAVES + F.wave; task < MTOK / 16; task += F.G * NWAVES) {
        const size_t m0 = (size_t)task * 16;
        f32x4 acc = (f32x4){0.f, 0.f, 0.f, 0.f};
#pragma unroll 8
        for (int ks = 0; ks < 32; ++ks) {
            const bf16x8 wfr = *(const bf16x8*)(WGT + fr * 1024 + 32 * ks + 8 * fq);
            const bf16x8 xfr = *(const bf16x8*)(XN + (m0 + fr) * DM + 32 * ks + 8 * fq);
            acc = __builtin_amdgcn_mfma_f32_16x16x32_bf16(wfr, xfr, acc, 0, 0, 0);
        }
        *(f32x4*)(GT + (m0 + fr) * 16 + 4 * fq) = acc + bg4;
    }
}

struct AddrPlain {
    const char* A; const char* Bt; int lda, ldb, K;
    __device__ __forceinline__ const char* a(const pg8::Unit& u) const { return A + (size_t)u.pm * 256 * lda * 2; }
    __device__ __forceinline__ const char* b(const pg8::Unit& u) const { return Bt + (size_t)u.pn * 256 * ldb * 2; }
};
struct AddrQKV {
    const char* XC; long dXM; const char* W; int lda, ldb, K;
    __device__ __forceinline__ const char* a(const pg8::Unit& u) const { return XC + (u.pn < 8 ? 0l : dXM) + ((size_t)u.pm * 256 * 1024 + (u.pn & 3) * 256) * 2; }
    __device__ __forceinline__ const char* b(const pg8::Unit& u) const { return W + (size_t)u.pn * 65536 * 2; }
};
struct AddrBranch {
    const char* YM; long dYL; const char* W; int lda, ldb, K;
    __device__ __forceinline__ const char* a(const pg8::Unit& u) const { return YM + (u.pn < 4 ? 0l : dYL) + (size_t)u.pm * 256 * 1024 * 2; }
    __device__ __forceinline__ const char* b(const pg8::Unit& u) const { return W + (size_t)u.pn * 256 * 1024 * 2; }
};

struct DstP1 { unsigned char* ws;
    __device__ __forceinline__ bf16* get(int pn, int& ld, int& col0) const {
        const bool mg = pn >= 16; ld = mg ? 2048 : 1024; col0 = mg ? (pn - 16) * 256 : (pn & 3) * 256;
        return (bf16*)(ws + (mg ? WS_MG : WS_XM + (size_t)(pn >> 2) * 64 * MiB)); } };
struct DstQKV { char* q; long dk, dv;
    __device__ __forceinline__ bf16* get(int pn, int& ld, int& col0) const { ld = 1024; col0 = (pn & 3) * 256; return (bf16*)(q + (pn >= 4 ? (pn >= 8 ? dv : dk) : 0l)); } };
template <class Dst> struct EpiBf16 {
    static constexpr bool PERM = true;
    Dst dst;
    __device__ __forceinline__ void operator()(const f32x4 (&acc)[2][2][4][2], const pg8::Unit& u, int wr, int wc, int fr, int fq) const {
        int ld, colt; bf16* base = dst.get(u.pn, ld, colt);
        const int row0 = u.pm * 256 + wr * 64 + fr, col0 = colt + wc * 32 + 8 * fq;
#pragma unroll
        for (int ai = 0; ai < 2; ++ai)
#pragma unroll
            for (int m = 0; m < 4; ++m) { bf16* rowp = base + (size_t)(row0 + ai * 128 + m * 16) * ld + col0;
#pragma unroll
                for (int bj = 0; bj < 2; ++bj) { const f32x4 v0 = acc[ai][bj][m][0], v1 = acc[ai][bj][m][1];
                    v4u w; w.x = pg8::cvt_pk_bf16(v0[0], v0[1]); w.y = pg8::cvt_pk_bf16(v0[2], v0[3]); w.z = pg8::cvt_pk_bf16(v1[0], v1[1]); w.w = pg8::cvt_pk_bf16(v1[2], v1[3]);
                    *(v4u*)(rowp + bj * 128) = w; } }
    }
};
struct EpiGate {
    static constexpr bool PERM = true;
    bf16* G;
    __device__ __forceinline__ void operator()(const f32x4 (&acc)[2][2][4][2], const pg8::Unit& u, int wr, int wc, int fr, int fq) const {
        const int row0 = u.pm * 256 + wr * 64 + fr, col0 = u.pn * 256 + wc * 32 + 8 * fq;
#pragma unroll
        for (int ai = 0; ai < 2; ++ai)
#pragma unroll
            for (int m = 0; m < 4; ++m) { bf16* rowp = G + (size_t)(row0 + ai * 128 + m * 16) * 2048 + col0;
#pragma unroll
                for (int bj = 0; bj < 2; ++bj) { const f32x4 v0 = acc[ai][bj][m][0], v1 = acc[ai][bj][m][1];
                    const v4u g = *(const v4u*)(rowp + bj * 128);
                    v4u w;
                    w.x = pg8::cvt_pk_bf16(v0[0] * sigmoidf_(bflo(g.x)), v0[1] * sigmoidf_(bfhi(g.x)));
                    w.y = pg8::cvt_pk_bf16(v0[2] * sigmoidf_(bflo(g.y)), v0[3] * sigmoidf_(bfhi(g.y)));
                    w.z = pg8::cvt_pk_bf16(v1[0] * sigmoidf_(bflo(g.z)), v1[1] * sigmoidf_(bfhi(g.z)));
                    w.w = pg8::cvt_pk_bf16(v1[2] * sigmoidf_(bflo(g.w)), v1[3] * sigmoidf_(bfhi(g.w)));
                    *(v4u*)(rowp + bj * 128) = w; } }
    }
};
struct EpiResid {
    static constexpr bool PERM = false;
    const float* x; float* x1; bf16* x1b; float* ss;
    __device__ __forceinline__ void operator()(const f32x4 (&acc)[2][2][4][2], const pg8::Unit& u, int wr, int wc, int fr, int fq) const {
        const int row0 = u.pm * 256 + wr * 64 + fr, col0 = u.pn * 256 + wc * 32 + 4 * fq;
#pragma unroll
        for (int ai = 0; ai < 2; ++ai)
#pragma unroll
            for (int m = 0; m < 4; ++m) { const int row = row0 + ai * 128 + m * 16; const size_t off = (size_t)row * DM + col0; float s = 0.f;
#pragma unroll
                for (int bj = 0; bj < 2; ++bj)
#pragma unroll
                    for (int n = 0; n < 2; ++n) { const size_t o = off + bj * 128 + n * 16; const f32x4 v = *(const f32x4*)(x + o) + acc[ai][bj][m][n];
                        *(f32x4*)(x1 + o) = v; v2u w; w.x = pg8::cvt_pk_bf16(v[0], v[1]); w.y = pg8::cvt_pk_bf16(v[2], v[3]); *(v2u*)(x1b + o) = w;
                        s += (v[0] * v[0] + v[1] * v[1]) + (v[2] * v[2] + v[3] * v[3]); }
                s += __shfl_xor(s, 16); s += __shfl_xor(s, 32);
                if (fq == 0) atomicAdd(ss + row, s); }
    }
};
struct EpiPQ {
    static constexpr bool PERM = true;
    bf16* pq; const float* ss;
    __device__ __forceinline__ void operator()(const f32x4 (&acc)[2][2][4][2], const pg8::Unit& u, int wr, int wc, int fr, int fq) const {
        const int row0 = u.pm * 256 + wr * 64 + fr, col0 = u.pn * 256 + wc * 32 + 8 * fq;
#pragma unroll
        for (int ai = 0; ai < 2; ++ai)
#pragma unroll
            for (int m = 0; m < 4; ++m) { const int row = row0 + ai * 128 + m * 16; bf16* rowp = pq + (size_t)row * 2048 + col0;
                const float r = rsqrtf(ss[row] * (1.f / DM) + EPS);
#pragma unroll
                for (int bj = 0; bj < 2; ++bj) { const f32x4 v0 = acc[ai][bj][m][0] * r, v1 = acc[ai][bj][m][1] * r;
                    v4u w; w.x = pg8::cvt_pk_bf16(v0[0], v0[1]); w.y = pg8::cvt_pk_bf16(v0[2], v0[3]); w.z = pg8::cvt_pk_bf16(v1[0], v1[1]); w.w = pg8::cvt_pk_bf16(v1[2], v1[3]);
                    *(v4u*)(rowp + bj * 128) = w; } }
    }
};

__device__ __forceinline__ void lru_ref(Frame& F) {
    const bf16* XL = (const bf16*)(F.ws + WS_XL); const bf16* LG = (const bf16*)(F.ws + WS_LG); bf16* YL = (bf16*)F.out;
    const bf16* WL = (const bf16*)(F.ws + WS_WLRU);
    const float* cw = F.in[10]; const float* cb = F.in[11];
    LAS float* sxc = (LAS float*)F.lds;
    LAS float* sp = (LAS float*)(F.lds + 1024);
    const int c = F.tid & 127, part = F.tid >> 7;
    for (int item = F.bid; item < 64; item += F.G) {
        const int b = item >> 3, blk = item & 7, ch = blk * 128 + c;
        const float w0 = cw[0 * DM + ch], w1 = cw[1 * DM + ch], w2 = cw[2 * DM + ch], w3 = cw[3 * DM + ch], bb = cb[ch];
        for (int dir = 0; dir < 2; ++dir) {
            v4u wr[4], wi[4];
            { const v4u* pr = (const v4u*)(WL + ((size_t)((dir * 8 + blk) * 2 + 0) * 128 + c) * 128 + part * 32);
              const v4u* pi = (const v4u*)(WL + ((size_t)((dir * 8 + blk) * 2 + 1) * 128 + c) * 128 + part * 32);
#pragma unroll
              for (int q = 0; q < 4; ++q) { wr[q] = pr[q]; wi[q] = pi[q]; } }
            const float br = F.in[13][dir * DM + ch], bi = F.in[15][dir * DM + ch];
            const float spl = softplusf_(-F.in[16][dir * DM + ch]);
            float h = 0.f;
            for (int step = 0; step < SEQ; ++step) {
                const int t = dir ? (SEQ - 1 - step) : step;
                const size_t m = (size_t)b * SEQ + t;
                float xc = 0.f;
                if (part == 0) {
                    xc = bb;
                    if (t >= 2) xc += w0 * bf2f(XL[(m - 2) * DM + ch]);
                    if (t >= 1) xc += w1 * bf2f(XL[(m - 1) * DM + ch]);
                    xc += w2 * bf2f(XL[m * DM + ch]);
                    if (t + 1 < SEQ) xc += w3 * bf2f(XL[(m + 1) * DM + ch]);
                    sxc[c] = xc;
                }
                __syncthreads();
                float pr_ = 0.f, pi_ = 0.f;
#pragma unroll
                for (int q = 0; q < 4; ++q) {
                    const f32x4 x0 = *(const LAS f32x4*)(sxc + part * 32 + q * 8), x1 = *(const LAS f32x4*)(sxc + part * 32 + q * 8 + 4);
                    pr_ += x0[0] * bflo(wr[q].x) + x0[1] * bfhi(wr[q].x) + x0[2] * bflo(wr[q].y) + x0[3] * bfhi(wr[q].y)
                         + x1[0] * bflo(wr[q].z) + x1[1] * bfhi(wr[q].z) + x1[2] * bflo(wr[q].w) + x1[3] * bfhi(wr[q].w);
                    pi_ += x0[0] * bflo(wi[q].x) + x0[1] * bfhi(wi[q].x) + x0[2] * bflo(wi[q].y) + x0[3] * bfhi(wi[q].y)
                         + x1[0] * bflo(wi[q].z) + x1[1] * bfhi(wi[q].z) + x1[2] * bflo(wi[q].w) + x1[3] * bfhi(wi[q].w);
                }
                sp[(part * 2 + 0) * 128 + c] = pr_; sp[(part * 2 + 1) * 128 + c] = pi_;
                __syncthreads();
                if (part == 0) {
                    const float rp = sp[0 * 128 + c] + sp[2 * 128 + c] + sp[4 * 128 + c] + sp[6 * 128 + c] + br;
                    const float ip = sp[1 * 128 + c] + sp[3 * 128 + c] + sp[5 * 128 + c] + sp[7 * 128 + c] + bi;
                    const float r = sigmoidf_(rp), ig = sigmoidf_(ip);
                    const float log_a = -8.f * r * spl;
                    const float a = __expf(log_a);
                    const float u = sqrtf(-expm1f(2.f * log_a)) * (ig * xc);
                    h = a * h + u;
                    if (dir == 0) YL[m * DM + ch] = (bf16)f2bf(h);
                    else { const float y = (bf2f(YL[m * DM + ch]) + h) * gelu_erf(bf2f(LG[m * DM + ch])); YL[m * DM + ch] = (bf16)f2bf(y); }
                }
            }
            __syncthreads();
        }
    }
}


template <bool PB> __device__ __forceinline__ void lru_phase(Frame& F) {
    const bf16* XL = (const bf16*)(F.ws + WS_XL); const bf16* LG = (const bf16*)(F.ws + WS_LG); bf16* YL = (bf16*)F.out;
    f32x2* AGG = (f32x2*)(F.ws + WS_AGG);
    const bf16* WL = (const bf16*)(F.ws + WS_WLRU);
    const float* cw = F.in[10]; const float* cb = F.in[11];
    constexpr int O_XCB = 0, O_XCF = 17408, O_A = 50176, O_U = 82944;
    LAS unsigned char* L = F.lds;
    const int tid = F.tid, lane = F.lane, w = F.wave, fr = lane & 15, fq = lane >> 4;
    int cur_blk = -1;
    bf16x8 wf[2][2][4];
    f32x4 br4[2], bi4[2], sp4[2];
    for (int i = 0;; ++i) {
        const int idx = i * F.G + F.bid; if (idx >= 4096) break;
        const int blk = idx & 7, j = idx >> 3, b = j >> 6, seg = j & 63, t0 = seg * 64;
        const size_t mrow0 = (size_t)b * SEQ + t0;
        if (blk != cur_blk) {
            cur_blk = blk;
#pragma unroll
            for (int d = 0; d < 2; ++d) {
#pragma unroll
                for (int g = 0; g < 2; ++g)
#pragma unroll
                    for (int ks = 0; ks < 4; ++ks)
                        wf[d][g][ks] = *(const bf16x8*)(WL + ((size_t)((d * 8 + blk) * 2 + g) * 128 + 16 * w + fr) * 128 + 32 * ks + 8 * fq);
                const int ch = blk * 128 + 16 * w + 4 * fq;
                br4[d] = *(const f32x4*)(F.in[13] + d * DM + ch); bi4[d] = *(const f32x4*)(F.in[15] + d * DM + ch);
                const f32x4 lm = *(const f32x4*)(F.in[16] + d * DM + ch);
#pragma unroll
                for (int e = 0; e < 4; ++e) sp4[d][e] = -8.f * 1.44269504089f * softplusf_(-lm[e]);
            }
        }
        for (int e = tid; e < 68 * 16; e += NTHR) { const int row = e >> 4, c16 = e & 15, t = t0 - 2 + row;
            v4u v = {0u, 0u, 0u, 0u};
            if (t >= 0 && t < SEQ) v = *(const v4u*)(XL + ((size_t)b * SEQ + t) * DM + blk * 128 + c16 * 8);
            *(LAS v4u*)(L + O_A + row * 256 + c16 * 16) = v; }
        __syncthreads();
        for (int e = tid; e < 64 * 16; e += NTHR) { const int tl = e >> 4, c16 = e & 15, c0 = blk * 128 + c16 * 8;
            float y[8];
            { const f32x4 a = *(const f32x4*)(cb + c0), bq = *(const f32x4*)(cb + c0 + 4); y[0] = a[0]; y[1] = a[1]; y[2] = a[2]; y[3] = a[3]; y[4] = bq[0]; y[5] = bq[1]; y[6] = bq[2]; y[7] = bq[3]; }
#pragma unroll
            for (int jt = 0; jt < 4; ++jt) { const v4u r = *(const LAS v4u*)(L + O_A + (tl + jt) * 256 + c16 * 16);
                const f32x4 wa = *(const f32x4*)(cw + jt * DM + c0), wb = *(const f32x4*)(cw + jt * DM + c0 + 4);
                y[0] += wa[0] * bflo(r.x); y[1] += wa[1] * bfhi(r.x); y[2] += wa[2] * bflo(r.y); y[3] += wa[3] * bfhi(r.y);
                y[4] += wb[0] * bflo(r.z); y[5] += wb[1] * bfhi(r.z); y[6] += wb[2] * bflo(r.w); y[7] += wb[3] * bfhi(r.w); }
            *(LAS f32x4*)(L + O_XCF + tl * 512 + c16 * 32) = (f32x4){y[0], y[1], y[2], y[3]};
            *(LAS f32x4*)(L + O_XCF + tl * 512 + c16 * 32 + 16) = (f32x4){y[4], y[5], y[6], y[7]};
            v4u o; o.x = pk2(y[0], y[1]); o.y = pk2(y[2], y[3]); o.z = pk2(y[4], y[5]); o.w = pk2(y[6], y[7]);
            *(LAS v4u*)(L + O_XCB + tl * 272 + c16 * 16) = o; }
        __syncthreads();
        float carry0 = 0.f, carry1 = 0.f;
        if (PB && tid < 128) {
            const int ch = blk * 128 + tid;
            float h = 0.f;
            const f32x2* ag0 = AGG + ((size_t)(b * 64) * 2 + 0) * DM + ch; const f32x2* ag1 = AGG + ((size_t)(b * 64) * 2 + 1) * DM + ch;
            int js = 0;
            for (; js + 8 <= seg; js += 8) { f32x2 ah[8];
#pragma unroll
                for (int q = 0; q < 8; ++q) ah[q] = ag0[(size_t)(js + q) * 2 * DM];
#pragma unroll
                for (int q = 0; q < 8; ++q) h = ah[q][0] * h + ah[q][1]; }
            for (; js < seg; ++js) { const f32x2 ah = ag0[(size_t)js * 2 * DM]; h = ah[0] * h + ah[1]; }
            carry0 = h; h = 0.f;
            js = 63;
            for (; js - 8 >= seg; js -= 8) { f32x2 ah[8];
#pragma unroll
                for (int q = 0; q < 8; ++q) ah[q] = ag1[(size_t)(js - q) * 2 * DM];
#pragma unroll
                for (int q = 0; q < 8; ++q) h = ah[q][0] * h + ah[q][1]; }
            for (; js > seg; --js) { const f32x2 ah = ag1[(size_t)js * 2 * DM]; h = ah[0] * h + ah[1]; }
            carry1 = h;
        }
#pragma unroll
        for (int d = 0; d < 2; ++d) {
            const int o_a = (d == 0) ? O_A : O_XCF;
            f32x4 aR[4], aI[4];
#pragma unroll
            for (int mt = 0; mt < 4; ++mt) { aR[mt] = (f32x4){0.f, 0.f, 0.f, 0.f}; aI[mt] = (f32x4){0.f, 0.f, 0.f, 0.f}; }
#pragma unroll
            for (int ks = 0; ks < 4; ++ks)
#pragma unroll
                for (int mt = 0; mt < 4; ++mt) { const bf16x8 xb = *(const LAS bf16x8*)(L + O_XCB + (16 * mt + fr) * 272 + (32 * ks + 8 * fq) * 2);
                    aR[mt] = __builtin_amdgcn_mfma_f32_16x16x32_bf16(wf[d][0][ks], xb, aR[mt], 0, 0, 0);
                    aI[mt] = __builtin_amdgcn_mfma_f32_16x16x32_bf16(wf[d][1][ks], xb, aI[mt], 0, 0, 0); }
#pragma unroll
            for (int mt = 0; mt < 4; ++mt) { const int tl = 16 * mt + fr, cl = 16 * w + 4 * fq;
                const f32x4 xc = *(const LAS f32x4*)(L + O_XCF + tl * 512 + cl * 4);
                f32x4 av, uv;
#pragma unroll
                for (int e = 0; e < 4; ++e) { const float r = sigmoidf_(aR[mt][e] + br4[d][e]), ig = sigmoidf_(aI[mt][e] + bi4[d][e]);
                    const float a_ = __builtin_amdgcn_exp2f(r * sp4[d][e]); av[e] = a_; uv[e] = __builtin_amdgcn_sqrtf(fmaxf(1.f - a_ * a_, 0.f)) * (ig * xc[e]); }
                *(LAS f32x4*)(L + o_a + tl * 512 + cl * 4) = av; *(LAS f32x4*)(L + O_U + tl * 512 + cl * 4) = uv; }
            __syncthreads();
            if (tid < 128) {
                LAS float* pa = (LAS float*)(L + o_a) + tid; const LAS float* pu = (const LAS float*)(L + O_U) + tid;
                if (!PB) {
                    float h = 0.f, A = 1.f;
#pragma unroll 8
                    for (int s2 = 0; s2 < 64; ++s2) { const int tl = d ? 63 - s2 : s2; const float a = pa[tl * 128], u = pu[tl * 128]; h = a * h + u; A *= a; }
                    AGG[((size_t)(b * 64 + seg) * 2 + d) * DM + blk * 128 + tid] = (f32x2){A, h};
                } else if (d == 0) {
                    float h = carry0;
#pragma unroll 8
                    for (int tl = 0; tl < 64; ++tl) { h = pa[tl * 128] * h + pu[tl * 128]; pa[tl * 128] = h; }
                } else {
                    float h = carry1;
                    LAS float* ph = (LAS float*)(L + O_A) + tid;
#pragma unroll 8
                    for (int s2 = 0; s2 < 64; ++s2) { const int tl = 63 - s2; h = pa[tl * 128] * h + pu[tl * 128]; ph[tl * 128] += h; }
                }
            }
            __syncthreads();
        }
        if (PB) {
            for (int e = tid; e < 64 * 16; e += NTHR) { const int row = e >> 4, c16 = e & 15;
                const v4u g = *(const v4u*)(LG + (mrow0 + row) * DM + blk * 128 + c16 * 8);
                const f32x4 h0 = *(const LAS f32x4*)(L + O_A + row * 512 + c16 * 32), h1 = *(const LAS f32x4*)(L + O_A + row * 512 + c16 * 32 + 16);
                v4u o;
                o.x = pk2(h0[0] * gelu_fast(bflo(g.x)), h0[1] * gelu_fast(bfhi(g.x))); o.y = pk2(h0[2] * gelu_fast(bflo(g.y)), h0[3] * gelu_fast(bfhi(g.y)));
                o.z = pk2(h1[0] * gelu_fast(bflo(g.z)), h1[1] * gelu_fast(bfhi(g.z))); o.w = pk2(h1[2] * gelu_fast(bflo(g.w)), h1[3] * gelu_fast(bfhi(g.w)));
                *(v4u*)(YL + (mrow0 + row) * DM + blk * 128 + c16 * 8) = o; }
            __syncthreads();
        }
    }
}

__device__ __forceinline__ void mconv_phase(Frame& F) {
    const bf16* XM = (const bf16*)(F.ws + WS_XM); bf16* XC = (bf16*)(F.ws + WS_XL);
    const float* cw = F.in[4]; const float* cb = F.in[5];
    const int NT = MTOK / 32 * 128;
    for (int g = F.bid * NTHR + F.tid; g < NT; g += F.G * NTHR) {
        const int chunk = g & 127, run = g >> 7, c0 = chunk * 8, m0 = run * 32, t0 = m0 & (SEQ - 1);
        float w[4][8], bias[8];
#pragma unroll
        for (int j = 0; j < 4; ++j) { const f32x4 a = *(const f32x4*)(cw + j * DM + c0), b = *(const f32x4*)(cw + j * DM + c0 + 4);
            w[j][0] = a[0]; w[j][1] = a[1]; w[j][2] = a[2]; w[j][3] = a[3]; w[j][4] = b[0]; w[j][5] = b[1]; w[j][6] = b[2]; w[j][7] = b[3]; }
        { const f32x4 a = *(const f32x4*)(cb + c0), b = *(const f32x4*)(cb + c0 + 4);
            bias[0] = a[0]; bias[1] = a[1]; bias[2] = a[2]; bias[3] = a[3]; bias[4] = b[0]; bias[5] = b[1]; bias[6] = b[2]; bias[7] = b[3]; }
        v4u win[4];
        const v4u zero = {0u, 0u, 0u, 0u};
        win[0] = zero;
        win[1] = (t0 >= 2) ? *(const v4u*)(XM + (size_t)(m0 - 2) * DM + c0) : zero;
        win[2] = (t0 >= 1) ? *(const v4u*)(XM + (size_t)(m0 - 1) * DM + c0) : zero;
        win[3] = *(const v4u*)(XM + (size_t)m0 * DM + c0);
#pragma unroll 4
        for (int i = 0; i < 32; ++i) {
            win[0] = win[1]; win[1] = win[2]; win[2] = win[3];
            win[3] = (t0 + i + 1 < SEQ) ? *(const v4u*)(XM + (size_t)(m0 + i + 1) * DM + c0) : zero;
            float y[8];
#pragma unroll
            for (int e = 0; e < 8; ++e) y[e] = bias[e];
#pragma unroll
            for (int j = 0; j < 4; ++j) {
                const unsigned p0 = win[j].x, p1 = win[j].y, p2 = win[j].z, p3 = win[j].w;
                y[0] += w[j][0] * bflo(p0); y[1] += w[j][1] * bfhi(p0); y[2] += w[j][2] * bflo(p1); y[3] += w[j][3] * bfhi(p1);
                y[4] += w[j][4] * bflo(p2); y[5] += w[j][5] * bfhi(p2); y[6] += w[j][6] * bflo(p3); y[7] += w[j][7] * bfhi(p3);
            }
#pragma unroll
            for (int e = 0; e < 8; ++e) y[e] = y[e] * sigmoidf_(y[e]);
            v4u o; o.x = pk2(y[0], y[1]); o.y = pk2(y[2], y[3]); o.z = pk2(y[4], y[5]); o.w = pk2(y[6], y[7]);
            *(v4u*)(XC + (size_t)(m0 + i) * DM + c0) = o;
        }
    }
}

__device__ __forceinline__ void mscan_ref(Frame& F) {
    const bf16* Q = (const bf16*)(F.ws + WS_LG); const bf16* K = (const bf16*)(F.ws + WS_K); const bf16* V = (const bf16*)F.out + (size_t)MTOK * DM;
    const float* GT = (const float*)(F.ws + WS_GATE);
    LAS float* sq = (LAS float*)F.lds; LAS float* sk = sq + 256; LAS float* sv = sk + 256; LAS float* spart = sv + 32; LAS float* sdw = spart + 256;
    const int e = F.tid & 31, dg = F.tid >> 5;
    for (int item = F.bid; item < 512; item += F.G) {
        const int es = item & 7, dir = (item >> 3) & 1, h = (item >> 4) & 3, b = item >> 6;
        bf16* H = (bf16*)(F.ws + (dir ? WS_XL : WS_XM));
        float C[16];
#pragma unroll
        for (int j = 0; j < 16; ++j) C[j] = 0.f;
        float nreg = 0.f, mst = 0.f;
        for (int step = 0; step < SEQ; ++step) {
            const int t = dir ? (SEQ - 1 - step) : step;
            const size_t m = (size_t)b * SEQ + t, ro = m * DM + h * 256;
            if (F.tid < 256) { sq[F.tid] = bf2f(Q[ro + F.tid]); sk[F.tid] = bf2f(K[ro + F.tid]); }
            if (F.tid < 32) sv[F.tid] = bf2f(V[ro + es * 32 + F.tid]);
            const float ip = GT[m * 16 + (dir * 2 + 0) * 4 + h], fp = GT[m * 16 + (dir * 2 + 1) * 4 + h];
            const float logf = -softplusf_(-fp);
            const float mn = fmaxf(logf + mst, ip);
            const float fd = __expf(logf + mst - mn), iw = __expf(ip - mn);
            mst = mn;
            __syncthreads();
            const float ve = sv[e] * iw;
            float part = 0.f;
#pragma unroll
            for (int j = 0; j < 16; ++j) { const int d = dg * 16 + j; C[j] = fd * C[j] + sk[d] * ve; part += sq[d] * C[j]; }
            part += __shfl_xor(part, 32);
            if (F.lane < 32) spart[F.wave * 32 + e] = part;
            if (F.tid < 256) { nreg = fd * nreg + iw * sk[F.tid]; const float ds = wave_sum(nreg * sq[F.tid]); if (F.lane == 0) sdw[F.wave] = ds; }
            __syncthreads();
            if (F.tid < 32) {
                float num = 0.f;
#pragma unroll
                for (int w = 0; w < 8; ++w) num += spart[w * 32 + F.tid];
                const float den = sdw[0] + sdw[1] + sdw[2] + sdw[3];
                H[ro + es * 32 + F.tid] = (bf16)f2bf(num / fmaxf(fabsf(den), __expf(-mn)));
            }
        }
        __syncthreads();
    }
}


typedef short s16x4 __attribute__((ext_vector_type(4)));
__device__ __forceinline__ bf16x8 tr_read_pair(unsigned a0, unsigned a1) {
    s16x4 r0, r1;
    asm volatile("ds_read_b64_tr_b16 %0, %2\n\tds_read_b64_tr_b16 %1, %3\n\ts_waitcnt lgkmcnt(0)" : "=&v"(r0), "=&v"(r1) : "v"(a0), "v"(a1) : "memory");
    return __builtin_shufflevector(r0, r1, 0, 1, 2, 3, 4, 5, 6, 7);
}
__device__ __forceinline__ float wave_incl_sum(float x, int lane) {
#pragma unroll
    for (int o = 1; o < 64; o <<= 1) { const float t = __shfl_up(x, o); if (lane >= o) x += t; }
    return x;
}
__device__ __forceinline__ float wave_incl_max(float x, int lane) {
#pragma unroll
    for (int o = 1; o < 64; o <<= 1) { const float t = __shfl_up(x, o); if (lane >= o) x = fmaxf(x, t); }
    return x;
}
__device__ __forceinline__ void mscan_phase(Frame& F) {
    const bf16* Q = (const bf16*)(F.ws + WS_LG); const bf16* K = (const bf16*)(F.ws + WS_K); const bf16* V = (const bf16*)F.out + (size_t)MTOK * DM;
    const float* GT = (const float*)(F.ws + WS_GATE);
    constexpr int KS = 0, CTI = 33792, VT = 67584, VWT = 86016, PB = 104448, TAB = 113664, NT = 116736, NPART = 117760, DENT = 119808;
    constexpr int KST = 528, VST = 144, TABSZ = 1536;
    LAS unsigned char* L = F.lds;
    const int tid = F.tid, lane = F.lane, w = F.wave, fr = lane & 15, fq = lane >> 4, pt = w & 3, wg = w >> 2;
    for (int item = F.bid; item < 256; item += F.G) {
        const int es = item & 3, dir = (item >> 2) & 1, h = (item >> 3) & 3, b = item >> 5;
        bf16* H = (bf16*)(F.ws + (dir ? WS_XL : WS_XM));
        const size_t rowbase = (size_t)b * SEQ;
#define TOF(c, p) (dir ? (SEQ - 1 - 64 * (c) - (p)) : (64 * (c) + (p)))
        for (int e = tid; e < (33792 + 1024) / 4; e += NTHR) { if (e < 33792 / 4) ((LAS unsigned*)(L + CTI))[e] = 0u; else ((LAS unsigned*)(L + NT))[e - 33792 / 4] = 0u; }
        float m_run = 0.f;
        float gi_n = 0.f, gf_n = 0.f;
        if (w == 0) { const size_t m = rowbase + TOF(0, lane); gi_n = GT[m * 16 + dir * 8 + h]; gf_n = GT[m * 16 + dir * 8 + 4 + h]; }
#define G1_TABLES(setp) do { \
            const float logf_ = -softplusf_(-gf_n); const float b_ = wave_incl_sum(logf_, lane); const float a_ = gi_n - b_; \
            const float M_ = fmaxf(m_run, wave_incl_max(a_, lane)); const float Mend_ = __shfl(M_, 63), g_ = __shfl(b_, 63); \
            LAS float* T_ = (LAS float*)(setp); T_[lane] = a_; T_[64 + lane] = M_; T_[128 + lane] = expf(m_run - M_); T_[192 + lane] = expf(-(b_ + M_)); T_[256 + lane] = expf(a_ - Mend_); \
            if (lane == 0) { T_[320] = expf(m_run - Mend_); T_[321] = g_ + Mend_; } \
            m_run = g_ + Mend_; } while (0)
        if (w == 0) G1_TABLES(L + TAB);
        __syncthreads();
        bf16x8 qf[8];
        v4u kreg[4]; v4u vreg;
#define LOAD_KV(c) do { _Pragma("unroll") for (int r_ = 0; r_ < 4; ++r_) { const int i_ = tid + NTHR * r_, s_ = i_ >> 5, c16_ = i_ & 31; \
                kreg[r_] = *(const v4u*)(K + (rowbase + TOF(c, s_)) * DM + h * 256 + c16_ * 8); } \
            { const int s_ = tid >> 3, e8_ = tid & 7; vreg = *(const v4u*)(V + (rowbase + TOF(c, s_)) * DM + h * 256 + es * 64 + e8_ * 8); } } while (0)
#define STORE_KV(setidx) do { _Pragma("unroll") for (int r_ = 0; r_ < 4; ++r_) { const int i_ = tid + NTHR * r_, s_ = i_ >> 5, c16_ = i_ & 31; \
                *(LAS v4u*)(L + KS + s_ * KST + c16_ * 16) = kreg[r_]; } \
            { const int s_ = tid >> 3, e8_ = tid & 7; const float ws_ = ((const LAS float*)(L + TAB + (setidx) * TABSZ))[256 + s_]; \
              LAS bf16* vt_ = (LAS bf16*)(L + VT + (setidx) * 9216); LAS bf16* vw_ = (LAS bf16*)(L + VWT + (setidx) * 9216); \
              const unsigned wv_[4] = {vreg.x, vreg.y, vreg.z, vreg.w}; \
              _Pragma("unroll") for (int j_ = 0; j_ < 4; ++j_) { const float lo_ = bflo(wv_[j_]), hi_ = bfhi(wv_[j_]); const int e_ = e8_ * 8 + 2 * j_; \
                vt_[e_ * 72 + s_] = (bf16)(wv_[j_] & 0xffffu); vt_[(e_ + 1) * 72 + s_] = (bf16)(wv_[j_] >> 16); \
                vw_[e_ * 72 + s_] = (bf16)f2bf(lo_ * ws_); vw_[(e_ + 1) * 72 + s_] = (bf16)f2bf(hi_ * ws_); } } } while (0)
#define LOAD_Q(c) do { const size_t m_ = rowbase + TOF(c, 16 * pt + fr); _Pragma("unroll") for (int ks_ = 0; ks_ < 8; ++ks_) \
                qf[ks_] = *(const bf16x8*)(Q + m_ * DM + h * 256 + 32 * ks_ + 8 * fq); } while (0)
        LOAD_KV(0); LOAD_Q(0);
        STORE_KV(0);
        f32x4 Cacc[8];
#pragma unroll
        for (int i = 0; i < 8; ++i) Cacc[i] = (f32x4){0.f, 0.f, 0.f, 0.f};
        __syncthreads();
        for (int c = 0; c < 64; ++c) {
            const int cur = c & 1, nxt = cur ^ 1;
            const bool has_next = (c + 1 < 64);
            const LAS float* T = (const LAS float*)(L + TAB + cur * TABSZ);
            if (has_next) { LOAD_KV(c + 1); if (w == 0) { const size_t m = rowbase + TOF(c + 1, lane); gi_n = GT[m * 16 + dir * 8 + h]; gf_n = GT[m * 16 + dir * 8 + 4 + h]; } }
            const int p = 16 * pt + fr;
            const float Mp = T[64 + p], wi_p = T[128 + p];
            float cs = 0.f;
#pragma unroll
            for (int i = 0; i < 2; ++i) { const int st = 2 * wg + i;
                v2u pw = {0u, 0u};
                if (st <= pt) {
                    f32x4 sa = (f32x4){0.f, 0.f, 0.f, 0.f};
#pragma unroll
                    for (int ks = 0; ks < 8; ++ks) { const bf16x8 kf = *(const LAS bf16x8*)(L + KS + (16 * st + fr) * KST + (32 * ks + 8 * fq) * 2);
                        sa = __builtin_amdgcn_mfma_f32_16x16x32_bf16(kf, qf[ks], sa, 0, 0, 0); }
                    const f32x4 a4 = *(const LAS f32x4*)(T + 16 * st + 4 * fq);
                    float pv[4];
#pragma unroll
                    for (int r = 0; r < 4; ++r) { const int s_ = 16 * st + 4 * fq + r; const float wgt = (s_ <= p) ? __expf(a4[r] - Mp) : 0.f; pv[r] = sa[r] * wgt; cs += pv[r]; }
                    pw.x = pk2(pv[0], pv[1]); pw.y = pk2(pv[2], pv[3]);
                }
                *(LAS v2u*)(L + PB + p * VST + (16 * st + 4 * fq) * 2) = pw; }
            f32x4 O[2];
#pragma unroll
            for (int i = 0; i < 2; ++i) { const int et = 2 * wg + i; O[i] = (f32x4){0.f, 0.f, 0.f, 0.f};
#pragma unroll
                for (int ks = 0; ks < 8; ++ks) { const bf16x8 cf = *(const LAS bf16x8*)(L + CTI + (16 * et + fr) * KST + (32 * ks + 8 * fq) * 2);
                    O[i] = __builtin_amdgcn_mfma_f32_16x16x32_bf16(cf, qf[ks], O[i], 0, 0, 0); } }
            float di = 0.f;
#define DEN_INTER(ks) do { const f32x4 n0 = *(const LAS f32x4*)(L + NT + (32 * (ks) + 8 * fq) * 4), n1 = *(const LAS f32x4*)(L + NT + (32 * (ks) + 8 * fq) * 4 + 16); \
                const v4u qw = __builtin_bit_cast(v4u, qf[ks]); \
                di += bflo(qw.x) * n0[0] + bfhi(qw.x) * n0[1] + bflo(qw.y) * n0[2] + bfhi(qw.y) * n0[3] + bflo(qw.z) * n1[0] + bfhi(qw.z) * n1[1] + bflo(qw.w) * n1[2] + bfhi(qw.w) * n1[3]; } while (0)
            if (wg == 0) { DEN_INTER(0); DEN_INTER(1); DEN_INTER(2); DEN_INTER(3); }
            else { DEN_INTER(4); DEN_INTER(5); DEN_INTER(6); DEN_INTER(7); }
#undef DEN_INTER
            di += __shfl_xor(di, 16); di += __shfl_xor(di, 32);
            cs += __shfl_xor(cs, 16); cs += __shfl_xor(cs, 32);
            if (fq == 0) ((LAS float*)(L + DENT))[wg * 64 + p] = wi_p * di + cs;
            if (has_next) LOAD_Q(c + 1);
            if (has_next && w == 0) G1_TABLES(L + TAB + nxt * TABSZ);
            __syncthreads();
#pragma unroll
            for (int i = 0; i < 2; ++i) { const int et = 2 * wg + i; O[i] = O[i] * wi_p;
#pragma unroll
                for (int ks = 0; ks < 2; ++ks) { const bf16x8 vf = *(const LAS bf16x8*)(L + VT + cur * 9216 + (16 * et + fr) * VST + (32 * ks + 8 * fq) * 2);
                    const bf16x8 pf = *(const LAS bf16x8*)(L + PB + p * VST + (32 * ks + 8 * fq) * 2);
                    O[i] = __builtin_amdgcn_mfma_f32_16x16x32_bf16(vf, pf, O[i], 0, 0, 0); } }
            { const float den = ((const LAS float*)(L + DENT))[p] + ((const LAS float*)(L + DENT))[64 + p];
              const float inv = 1.f / fmaxf(fabsf(den), T[192 + p]);
              const size_t m = rowbase + TOF(c, p);
#pragma unroll
              for (int i = 0; i < 2; ++i) { const int et = 2 * wg + i; v2u o; o.x = pk2(O[i][0] * inv, O[i][1] * inv); o.y = pk2(O[i][2] * inv, O[i][3] * inv);
                  *(v2u*)(H + m * DM + h * 256 + es * 64 + 16 * et + 4 * fq) = o; } }
            { const float decay = T[320];
              const bf16x8 vw0 = *(const LAS bf16x8*)(L + VWT + cur * 9216 + (16 * pt + fr) * VST + (8 * fq) * 2);
              const bf16x8 vw1 = *(const LAS bf16x8*)(L + VWT + cur * 9216 + (16 * pt + fr) * VST + (32 + 8 * fq) * 2);
              const int l16 = lane & 15, q4 = l16 >> 2, p4 = l16 & 3;
              const unsigned kb = (unsigned)(uintptr_t)(L + KS) + (unsigned)((8 * fq + q4) * KST + 4 * p4 * 2);
#pragma unroll
              for (int dtl = 0; dtl < 8; ++dtl) { const int dt = 8 * wg + dtl; const unsigned a0 = kb + dt * 32;
                  const bf16x8 k0 = tr_read_pair(a0, a0 + 4 * KST), k1 = tr_read_pair(a0 + 32 * KST, a0 + 36 * KST);
                  Cacc[dtl] = Cacc[dtl] * decay;
                  Cacc[dtl] = __builtin_amdgcn_mfma_f32_16x16x32_bf16(k0, vw0, Cacc[dtl], 0, 0, 0);
                  Cacc[dtl] = __builtin_amdgcn_mfma_f32_16x16x32_bf16(k1, vw1, Cacc[dtl], 0, 0, 0); } }
            { const int d = tid & 255, hf2 = tid >> 8; float np = 0.f;
#pragma unroll 8
              for (int s2 = 0; s2 < 32; ++s2) { const int s_ = hf2 * 32 + s2; np += T[256 + s_] * bf2f(*(const LAS bf16*)(L + KS + s_ * KST + d * 2)); }
              ((LAS float*)(L + NPART))[hf2 * 256 + d] = np; }
            __syncthreads();
            { const float decay = T[320];
#pragma unroll
              for (int dtl = 0; dtl < 8; ++dtl) { const int dt = 8 * wg + dtl; v2u o; o.x = pk2(Cacc[dtl][0], Cacc[dtl][1]); o.y = pk2(Cacc[dtl][2], Cacc[dtl][3]);
                  *(LAS v2u*)(L + CTI + (16 * pt + fr) * KST + (16 * dt + 4 * fq) * 2) = o; }
              if (tid < 256) { LAS float* nt = (LAS float*)(L + NT); const LAS float* np = (const LAS float*)(L + NPART); nt[tid] = decay * nt[tid] + np[tid] + np[256 + tid]; } }
            if (has_next) STORE_KV(nxt);
            __syncthreads();
        }
#undef TOF
#undef G1_TABLES
#undef LOAD_KV
#undef STORE_KV
#undef LOAD_Q
    }
}

__device__ __forceinline__ void ym_phase(Frame& F) {
    const bf16* HF = (const bf16*)(F.ws + WS_XM); const bf16* HB = (const bf16*)(F.ws + WS_XL); bf16* OP = (bf16*)(F.ws + WS_OP);
    const float* ng = F.in[9];
    const int gw = F.bid * NWAVES + F.wave, NGW = F.G * NWAVES;
    for (int m = gw; m < MTOK; m += NGW) {
#pragma unroll
        for (int hd = 0; hd < 4; ++hd) {
            const size_t o = (size_t)m * DM + hd * 256 + F.lane * 4;
            const v2u a = *(const v2u*)(HF + o), b = *(const v2u*)(HB + o), op = *(const v2u*)(OP + o);
            const float v0 = bflo(a.x) + bflo(b.x), v1 = bfhi(a.x) + bfhi(b.x), v2 = bflo(a.y) + bflo(b.y), v3 = bfhi(a.y) + bfhi(b.y);
            const float r = rsqrtf(wave_sum((v0 * v0 + v1 * v1) + (v2 * v2 + v3 * v3)) * (1.f / 256.f) + EPS);
            const f32x4 g = *(const f32x4*)(ng + hd * 256 + F.lane * 4);
            v2u w; w.x = pk2(sigmoidf_(bflo(op.x)) * v0 * r * g[0], sigmoidf_(bfhi(op.x)) * v1 * r * g[1]);
            w.y = pk2(sigmoidf_(bflo(op.y)) * v2 * r * g[2], sigmoidf_(bfhi(op.y)) * v3 * r * g[3]);
            *(v2u*)(OP + o) = w;
        }
    }
    const int gt = F.bid * NTHR + F.tid, NGT = F.G * NTHR;
    const f32x4* us = (const f32x4*)F.in[23]; const f32x4* vs = (const f32x4*)F.in[24];
    v4u* ud = (v4u*)(F.ws + WS_LG); v4u* vd = (v4u*)(F.ws + WS_LG + 16 * MiB);
    for (int i = gt; i < NEXP * DM / 16; i += NGT) {
        v4u o, q;
#pragma unroll
        for (int j = 0; j < 4; ++j) { const f32x4 a = us[4 * i + j] * 32.f, b = vs[4 * i + j] * 4.f;
            int pa = 0, pb = 0;
            pa = __builtin_amdgcn_cvt_pk_fp8_f32(a[0], a[1], pa, false); pa = __builtin_amdgcn_cvt_pk_fp8_f32(a[2], a[3], pa, true);
            pb = __builtin_amdgcn_cvt_pk_fp8_f32(b[0], b[1], pb, false); pb = __builtin_amdgcn_cvt_pk_fp8_f32(b[2], b[3], pb, true);
            o[j] = (unsigned)pa; q[j] = (unsigned)pb; }
        ud[i] = o; vd[i] = q;
    }
}

__device__ __forceinline__ void select_ref(Frame& F) {
    const bf16* PQ = (const bf16*)(F.ws + WS_MG); const bf16* KEYS = (const bf16*)(F.ws + WS_KEYS);
    int* IDX = (int*)(F.ws + WS_K); float* GW = (float*)(F.ws + WS_K + 16 * MiB);
    LAS float* base = (LAS float*)(F.lds + F.wave * 2048);
    LAS float* sq = base;
    LAS float* sl = base + 256;
    LAS int* il = (LAS int*)(base + 288);
    LAS float* sbest = base + 320;
    LAS int* spos = (LAS int*)(base + 336);
    const int lane = F.lane;
    const int gw = F.bid * NWAVES + F.wave, NGW = F.G * NWAVES;
    for (int it = gw; it < MTOK * 8; it += NGW) {
        const int t = it >> 3, h = it & 7;
        { const v2u q4 = *(const v2u*)(PQ + (size_t)t * 2048 + h * 256 + lane * 4);
          sq[lane * 4 + 0] = bflo(q4.x); sq[lane * 4 + 1] = bfhi(q4.x); sq[lane * 4 + 2] = bflo(q4.y); sq[lane * 4 + 3] = bfhi(q4.y); }
        LDS_WAIT();
        for (int p = 0; p < 2; ++p) {
            float v0 = 0.f, v1 = 0.f;
            const v4u* k0 = (const v4u*)(KEYS + ((size_t)(h * 2 + p) * 128 + lane) * 128);
            const v4u* k1 = k0 + 64 * 16;
#pragma unroll 4
            for (int c8 = 0; c8 < 16; ++c8) {
                const v4u a = k0[c8], b = k1[c8];
                const f32x4 q0 = *(const LAS f32x4*)(sq + p * 128 + c8 * 8), q1 = *(const LAS f32x4*)(sq + p * 128 + c8 * 8 + 4);
                v0 += q0[0] * bflo(a.x) + q0[1] * bfhi(a.x) + q0[2] * bflo(a.y) + q0[3] * bfhi(a.y) + q1[0] * bflo(a.z) + q1[1] * bfhi(a.z) + q1[2] * bflo(a.w) + q1[3] * bfhi(a.w);
                v1 += q0[0] * bflo(b.x) + q0[1] * bfhi(b.x) + q0[2] * bflo(b.y) + q0[3] * bfhi(b.y) + q1[0] * bflo(b.z) + q1[1] * bfhi(b.z) + q1[2] * bflo(b.w) + q1[3] * bfhi(b.w);
            }
            for (int k = 0; k < 16; ++k) {
                float bv; int bi;
                if (v0 >= v1) { bv = v0; bi = lane; } else { bv = v1; bi = lane + 64; }
#pragma unroll
                for (int off = 32; off >= 1; off >>= 1) {
                    const float ov = __shfl_xor(bv, off); const int oi = __shfl_xor(bi, off);
                    if (ov > bv || (ov == bv && oi < bi)) { bv = ov; bi = oi; }
                }
                if (lane == 0) { sl[p * 16 + k] = bv; il[p * 16 + k] = bi; }
                if (bi == lane) v0 = -INFINITY;
                if (bi == lane + 64) v1 = -INFINITY;
            }
        }
        LDS_WAIT();
        float cv[4];
#pragma unroll
        for (int r = 0; r < 4; ++r) { const int pos = lane + 64 * r; cv[r] = sl[pos >> 4] + sl[16 + (pos & 15)]; }
        for (int k = 0; k < 16; ++k) {
            float bv = cv[0]; int bi = lane;
#pragma unroll
            for (int r = 1; r < 4; ++r) if (cv[r] > bv) { bv = cv[r]; bi = lane + 64 * r; }
#pragma unroll
            for (int off = 32; off >= 1; off >>= 1) {
                const float ov = __shfl_xor(bv, off); const int oi = __shfl_xor(bi, off);
                if (ov > bv || (ov == bv && oi < bi)) { bv = ov; bi = oi; }
            }
            if (lane == 0) { sbest[k] = bv; spos[k] = bi; }
#pragma unroll
            for (int r = 0; r < 4; ++r) if (bi == lane + 64 * r) cv[r] = -INFINITY;
        }
        LDS_WAIT();
        if (lane < 16) {
            const float mx = sbest[0];
            float sum = 0.f;
            for (int k = 0; k < 16; ++k) sum += __expf(sbest[k] - mx);
            const int pos = spos[lane];
            IDX[(size_t)t * 128 + h * 16 + lane] = il[pos >> 4] * 128 + il[16 + (pos & 15)];
            GW[(size_t)t * 128 + h * 16 + lane] = __expf(sbest[lane] - mx) / sum;
        }
        LDS_WAIT();
    }
}


typedef float f32x16 __attribute__((ext_vector_type(16)));
#define TOPK_INSERT(L, xv) do { const float x_ = (xv); \
    L[15] = __builtin_amdgcn_fmed3f(L[14], L[15], x_); L[14] = __builtin_amdgcn_fmed3f(L[13], L[14], x_); L[13] = __builtin_amdgcn_fmed3f(L[12], L[13], x_); L[12] = __builtin_amdgcn_fmed3f(L[11], L[12], x_); \
    L[11] = __builtin_amdgcn_fmed3f(L[10], L[11], x_); L[10] = __builtin_amdgcn_fmed3f(L[9], L[10], x_); L[9] = __builtin_amdgcn_fmed3f(L[8], L[9], x_); L[8] = __builtin_amdgcn_fmed3f(L[7], L[8], x_); \
    L[7] = __builtin_amdgcn_fmed3f(L[6], L[7], x_); L[6] = __builtin_amdgcn_fmed3f(L[5], L[6], x_); L[5] = __builtin_amdgcn_fmed3f(L[4], L[5], x_); L[4] = __builtin_amdgcn_fmed3f(L[3], L[4], x_); \
    L[3] = __builtin_amdgcn_fmed3f(L[2], L[3], x_); L[2] = __builtin_amdgcn_fmed3f(L[1], L[2], x_); L[1] = __builtin_amdgcn_fmed3f(L[0], L[1], x_); L[0] = fmaxf(L[0], x_); } while (0)
template <int I> struct CandRow {
    static __device__ __forceinline__ void run(const float (&L0)[16], const float (&L1)[16], float (&R)[16]) {
        constexpr int NJ = 16 / (I + 1);
#pragma unroll
        for (int j = 0; j < NJ; ++j) { const float sm = L0[I] + L1[j];
            const float pk = __builtin_bit_cast(float, (__builtin_bit_cast(unsigned, sm) & 0xffffff00u) | (unsigned)(I * 16 + j)); TOPK_INSERT(R, pk); }
        if constexpr (I < 15) CandRow<I + 1>::run(L0, L1, R);
    }
};
__device__ __forceinline__ unsigned pick4(unsigned d0, unsigned d1, unsigned d2, unsigned d3, int i) {
    const int q = i >> 2; unsigned d = d0; d = (q == 1) ? d1 : d; d = (q == 2) ? d2 : d; d = (q == 3) ? d3 : d; return (d >> (8 * (i & 3))) & 127u;
}
__device__ __forceinline__ void select_phase(Frame& F) {
    const bf16* PQ = (const bf16*)(F.ws + WS_MG); const bf16* KEYS = (const bf16*)(F.ws + WS_KEYS);
    int* IDX = (int*)(F.ws + WS_K); float* GW = (float*)(F.ws + WS_K + 16 * MiB);
    LAS unsigned char* L = F.lds;
    const int tid = F.tid, lane = F.lane, w = F.wave, l31 = lane & 31, hh = lane >> 5;
    const float NEG_INF = -INFINITY;
    for (int grp = F.bid; grp < MTOK / 128; grp += F.G) {
        const int tb = grp * 4 + (w & 3);
        const size_t m = (size_t)tb * 32 + l31;
        for (int hp = 0; hp < 4; ++hp) {
            __syncthreads();
#pragma unroll 4
            for (int r = 0; r < 16; ++r) { const int e = tid + NTHR * r, R = e >> 4, c = e & 15;
                *(LAS v4u*)(L + R * 256 + ((c ^ (R & 15)) * 16)) = *(const v4u*)(KEYS + ((size_t)(hp * 512 + R) * 128 + c * 8)); }
            __syncthreads();
            const int hl = w >> 2, h = 2 * hp + hl;
            float L0[16], L1[16];
#pragma unroll
            for (int p = 0; p < 2; ++p) {
                bf16x8 qf[8];
#pragma unroll
                for (int ks = 0; ks < 8; ++ks) qf[ks] = *(const bf16x8*)(PQ + m * 2048 + h * 256 + p * 128 + 16 * ks + 8 * hh);
                f32x16 acc[4];
#pragma unroll
                for (int kb = 0; kb < 4; ++kb)
#pragma unroll
                    for (int r = 0; r < 16; ++r) acc[kb][r] = 0.f;
#pragma unroll
                for (int ks = 0; ks < 8; ++ks)
#pragma unroll
                    for (int kb = 0; kb < 4; ++kb) { const int R = (hl * 2 + p) * 128 + 32 * kb + l31;
                        const bf16x8 kf = *(const LAS bf16x8*)(L + R * 256 + (((2 * ks + hh) ^ (lane & 15)) * 16));
                        acc[kb] = __builtin_amdgcn_mfma_f32_32x32x16_bf16(kf, qf[ks], acc[kb], 0, 0, 0); }
                float Lc[16];
#pragma unroll
                for (int i = 0; i < 16; ++i) Lc[i] = NEG_INF;
                const unsigned hh4 = (unsigned)hh << 2;
#pragma unroll
                for (int kb = 0; kb < 4; ++kb)
#pragma unroll
                    for (int r = 0; r < 16; ++r) { const unsigned nlo = (unsigned)(32 * kb + (r & 3) + 8 * (r >> 2));
                        const float av_ = acc[kb][r];
                        const float pk = __uint_as_float(((__float_as_uint(av_) & 0xffffff80u) | hh4) | nlo); TOPK_INSERT(Lc, pk); }
                float Lo[16];
#pragma unroll
                for (int i = 0; i < 16; ++i) Lo[i] = __shfl_xor(Lc[i], 32);
#pragma unroll
                for (int i = 0; i < 16; ++i) TOPK_INSERT(Lc, Lo[i]);
#pragma unroll
                for (int i = 0; i < 16; ++i) { if (p == 0) L0[i] = Lc[i]; else L1[i] = Lc[i]; }
            }
            float R[16];
#pragma unroll
            for (int i = 0; i < 16; ++i) R[i] = NEG_INF;
            CandRow<0>::run(L0, L1, R);
            unsigned a0 = 0, a1 = 0, a2 = 0, a3 = 0, b0 = 0, b1 = 0, b2 = 0, b3 = 0;
#pragma unroll
            for (int i = 0; i < 4; ++i) { a0 |= (__builtin_bit_cast(unsigned, L0[i]) & 127u) << (8 * i); a1 |= (__builtin_bit_cast(unsigned, L0[4 + i]) & 127u) << (8 * i);
                a2 |= (__builtin_bit_cast(unsigned, L0[8 + i]) & 127u) << (8 * i); a3 |= (__builtin_bit_cast(unsigned, L0[12 + i]) & 127u) << (8 * i);
                b0 |= (__builtin_bit_cast(unsigned, L1[i]) & 127u) << (8 * i); b1 |= (__builtin_bit_cast(unsigned, L1[4 + i]) & 127u) << (8 * i);
                b2 |= (__builtin_bit_cast(unsigned, L1[8 + i]) & 127u) << (8 * i); b3 |= (__builtin_bit_cast(unsigned, L1[12 + i]) & 127u) << (8 * i); }
            float ex[16]; float sum = 0.f; int id[16];
#pragma unroll
            for (int r = 0; r < 16; ++r) { ex[r] = __expf(R[r] - R[0]); sum += ex[r];
                const unsigned cid = __builtin_bit_cast(unsigned, R[r]) & 255u;
                id[r] = (int)(pick4(a0, a1, a2, a3, (int)(cid >> 4)) * 128u + pick4(b0, b1, b2, b3, (int)(cid & 15u))); }
            const float inv = 1.f / sum;
            if (hh == 0) {
#pragma unroll
                for (int q = 0; q < 4; ++q) {
                    *(int4*)(IDX + m * 128 + h * 16 + 4 * q) = make_int4(id[4 * q], id[4 * q + 1], id[4 * q + 2], id[4 * q + 3]);
                    *(f32x4*)(GW + m * 128 + h * 16 + 4 * q) = (f32x4){ex[4 * q] * inv, ex[4 * q + 1] * inv, ex[4 * q + 2] * inv, ex[4 * q + 3] * inv}; }
            }
        }
    }
}

__device__ __forceinline__ f32x2 fp8lo(unsigned w) { return __builtin_amdgcn_cvt_pk_f32_fp8((int)w, false); }
__device__ __forceinline__ f32x2 fp8hi(unsigned w) { return __builtin_amdgcn_cvt_pk_f32_fp8((int)w, true); }
__device__ __forceinline__ void apply_phase(Frame& F, float* OUTP) {
    const unsigned char* U8 = F.ws + WS_LG; const unsigned char* V8 = F.ws + WS_LG + 16 * MiB;
    const int* IDX = (const int*)(F.ws + WS_K); const float* GW = (const float*)(F.ws + WS_K + 16 * MiB);
    const float* g2 = F.in[20]; const float* gf = F.in[25];
    const float* X1 = F.out;
    const int lane = F.lane;
    const int gw = F.bid * NWAVES + F.wave, NGW = F.G * NWAVES;
    const bool b5 = (lane & 32) != 0, b4 = (lane & 16) != 0, b3 = (lane & 8) != 0, b2 = (lane & 4) != 0;
    const int eid = ((lane >> 5) & 1) * 8 + ((lane >> 4) & 1) * 4 + ((lane >> 3) & 1) * 2 + ((lane >> 2) & 1);
    for (int m = gw; m < MTOK; m += NGW) {
        f32x2 hv[8]; float s = 0.f;
#pragma unroll
        for (int q = 0; q < 4; ++q) { const f32x4 a = *(const f32x4*)(X1 + (size_t)m * DM + lane * 16 + q * 4);
            s += (a[0] * a[0] + a[1] * a[1]) + (a[2] * a[2] + a[3] * a[3]); hv[2 * q] = (f32x2){a[0], a[1]}; hv[2 * q + 1] = (f32x2){a[2], a[3]}; }
        const float r2 = rsqrtf(wave_sum(s) * (1.f / DM) + EPS) * (1.f / 32.f);
#pragma unroll
        for (int q = 0; q < 4; ++q) { const f32x4 g = *(const f32x4*)(g2 + lane * 16 + q * 4);
            hv[2 * q] = hv[2 * q] * (f32x2){g[0] * r2, g[1] * r2}; hv[2 * q + 1] = hv[2 * q + 1] * (f32x2){g[2] * r2, g[3] * r2}; }
        const int i0 = IDX[(size_t)m * 128 + lane], i1 = IDX[(size_t)m * 128 + 64 + lane];
        const float gw0 = GW[(size_t)m * 128 + lane], gw1 = GW[(size_t)m * 128 + 64 + lane];
        f32x2 acc[8];
#pragma unroll
        for (int i = 0; i < 8; ++i) acc[i] = (f32x2){0.f, 0.f};
#pragma unroll 1
        for (int bt = 0; bt < 8; ++bt) {
            const int k0 = bt * 16;
            const int isel = (k0 < 64) ? i0 : i1;
            v4u uu[16], vv[16];
#pragma unroll
            for (int e = 0; e < 16; ++e) { const size_t ro = (size_t)__builtin_amdgcn_readlane(isel, (k0 + e) & 63) * DM + lane * 16;
                uu[e] = *(const v4u*)(U8 + ro); vv[e] = *(const v4u*)(V8 + ro); }
            float x[16];
#pragma unroll
            for (int e = 0; e < 16; ++e) { f32x2 d = fp8lo(uu[e].x) * hv[0];
                d = __builtin_elementwise_fma(fp8hi(uu[e].x), hv[1], d); d = __builtin_elementwise_fma(fp8lo(uu[e].y), hv[2], d); d = __builtin_elementwise_fma(fp8hi(uu[e].y), hv[3], d);
                d = __builtin_elementwise_fma(fp8lo(uu[e].z), hv[4], d); d = __builtin_elementwise_fma(fp8hi(uu[e].z), hv[5], d); d = __builtin_elementwise_fma(fp8lo(uu[e].w), hv[6], d);
                d = __builtin_elementwise_fma(fp8hi(uu[e].w), hv[7], d); x[e] = d[0] + d[1]; }
            float y[8], z[4], u2[2], t;
#pragma unroll
            for (int j = 0; j < 8; ++j) { const float keep = b5 ? x[8 + j] : x[j], send = b5 ? x[j] : x[8 + j]; y[j] = keep + __shfl_xor(send, 32); }
#pragma unroll
            for (int j = 0; j < 4; ++j) { const float keep = b4 ? y[4 + j] : y[j], send = b4 ? y[j] : y[4 + j]; z[j] = keep + __shfl_xor(send, 16); }
#pragma unroll
            for (int j = 0; j < 2; ++j) { const float keep = b3 ? z[2 + j] : z[j], send = b3 ? z[j] : z[2 + j]; u2[j] = keep + __shfl_xor(send, 8); }
            { const float keep = b2 ? u2[1] : u2[0], send = b2 ? u2[0] : u2[1]; t = keep + __shfl_xor(send, 4); }
            t += __shfl_xor(t, 2); t += __shfl_xor(t, 1);
            const float gk = __shfl((k0 < 64) ? gw0 : gw1, (k0 + eid) & 63);
            const float wl = gk * gelu_fast(t) * 0.25f;
#pragma unroll
            for (int e = 0; e < 16; ++e) {
                const float we = __builtin_bit_cast(float, __builtin_amdgcn_readlane(__builtin_bit_cast(int, wl), 32 * (e >> 3) + 16 * ((e >> 2) & 1) + 8 * ((e >> 1) & 1) + 4 * (e & 1)));
                const f32x2 w2 = (f32x2){we, we};
                acc[0] = __builtin_elementwise_fma(fp8lo(vv[e].x), w2, acc[0]); acc[1] = __builtin_elementwise_fma(fp8hi(vv[e].x), w2, acc[1]);
                acc[2] = __builtin_elementwise_fma(fp8lo(vv[e].y), w2, acc[2]); acc[3] = __builtin_elementwise_fma(fp8hi(vv[e].y), w2, acc[3]);
                acc[4] = __builtin_elementwise_fma(fp8lo(vv[e].z), w2, acc[4]); acc[5] = __builtin_elementwise_fma(fp8hi(vv[e].z), w2, acc[5]);
                acc[6] = __builtin_elementwise_fma(fp8lo(vv[e].w), w2, acc[6]); acc[7] = __builtin_elementwise_fma(fp8hi(vv[e].w), w2, acc[7]);
            }
        }
        float s2 = 0.f;
#pragma unroll
        for (int q = 0; q < 4; ++q) { const f32x4 a = *(const f32x4*)(X1 + (size_t)m * DM + lane * 16 + q * 4);
            acc[2 * q] = acc[2 * q] + (f32x2){a[0], a[1]}; acc[2 * q + 1] = acc[2 * q + 1] + (f32x2){a[2], a[3]};
            s2 += (acc[2 * q][0] * acc[2 * q][0] + acc[2 * q][1] * acc[2 * q][1]) + (acc[2 * q + 1][0] * acc[2 * q + 1][0] + acc[2 * q + 1][1] * acc[2 * q + 1][1]); }
        const float rf = rsqrtf(wave_sum(s2) * (1.f / DM) + EPS);
#pragma unroll
        for (int q = 0; q < 4; ++q) { const f32x4 g = *(const f32x4*)(gf + lane * 16 + q * 4);
            *(f32x4*)(OUTP + (size_t)m * DM + lane * 16 + q * 4) = (f32x4){acc[2 * q][0] * rf * g[0], acc[2 * q][1] * rf * g[1], acc[2 * q + 1][0] * rf * g[2], acc[2 * q + 1][1] * rf * g[3]}; }
    }
}

constexpr int N_PHASES = 13;
__global__ void __launch_bounds__(NTHR, 2) mega_fwd(Args args) {
    extern __shared__ __attribute__((aligned(16))) unsigned char lds[];
    Frame F;
    F.lds = (LAS unsigned char*)lds;
    F.tid = threadIdx.x; F.lane = F.tid & 63; F.wave = __builtin_amdgcn_readfirstlane(F.tid >> 6);
    F.G = gridDim.x; F.bid = blockIdx.x;
    F.in = args.in; F.out = args.out; F.ws = args.ws;
    volatile LAS unsigned* MISC = (volatile LAS unsigned*)(F.lds + MISC_OFF);
    for (int u = F.tid; u < (LDS_BYTES - LDSCTL_OFF) / 4; u += NTHR) ((LAS unsigned*)(F.lds + LDSCTL_OFF))[u] = 0u;
    __syncthreads();
    XcdBarrier bar; bar.bar = (unsigned*)(args.ws + WS_CTL) + CW_BAR; bar.x = 0; bar.st = nullptr;
    const bool one_launch = (args.ph_hi - args.ph_lo) > 1;
    if (one_launch) bar = xcd_barrier_post((unsigned*)(args.ws + WS_CTL) + CW_BAR, MISC + 8);
    const int lo = args.ph_lo, hi = args.ph_hi;
#define IN(k) (lo <= (k) && (k) < hi)
#define SEAM(k) do { if (IN(k) && IN((k) + 1)) xcd_barrier(bar); } while (0)
    unsigned char* ws = args.ws;

#ifndef PROBE_MASK
#define PROBE_MASK 0
#endif
#define REP(k) _Pragma("unroll") for (int rep_ = 0; rep_ < (((PROBE_MASK >> (k)) & 1) ? 2 : 1); ++rep_)
    if (IN(0)) REP(0) { p0_prologue(F); if (rep_ == 0 && ((PROBE_MASK >> 0) & 1)) xcd_barrier(bar); } SEAM(0);
    if (IN(1)) REP(1) {
        AddrPlain g{(const char*)(ws + WS_K), (const char*)(ws + WS_WIN), 1024, 1024, 1024};
        pg8::StaticOrder S; S.init(MTOK, 6144, F.G, F.bid, 4);
        EpiBf16<DstP1> E{DstP1{ws}};
        gates_phase(F);
        pg8::gemm_phase(F.lds, g, S, E);
    } SEAM(1);
    if (IN(2)) REP(2) { lru_phase<false>(F); } SEAM(2);
    if (IN(3)) REP(3) { lru_phase<true>(F); } SEAM(3);
    if (IN(4)) REP(4) { mconv_phase(F); } SEAM(4);
    if (IN(5)) REP(5) {
        AddrQKV g{(const char*)(ws + WS_XL), (long)WS_XM - (long)WS_XL, (const char*)(ws + WS_WQKV), 1024, 256, 256};
        pg8::StaticOrder S; S.init(MTOK, 12 * 256, F.G, F.bid);
        EpiBf16<DstQKV> E{DstQKV{(char*)(ws + WS_LG), (long)WS_K - (long)WS_LG, (long)((char*)F.out + (size_t)MTOK * DM * 2 - (char*)(ws + WS_LG))}};
        pg8::gemm_phase(F.lds, g, S, E);
    } SEAM(5);
    if (IN(6)) REP(6) { mscan_phase(F); } SEAM(6);
    if (IN(7)) { ym_phase(F); } SEAM(7);
    if (IN(8)) {
        AddrBranch g{(const char*)(ws + WS_OP), (long)((const char*)F.out - (const char*)(ws + WS_OP)), (const char*)(ws + WS_WB2), 1024, 1024, 1024};
        pg8::StaticOrder S; S.init(MTOK, 2048, F.G, F.bid);
        EpiGate E{(bf16*)(ws + WS_MG)};
        pg8::gemm_phase(F.lds, g, S, E);
    } SEAM(8);
    if (IN(9)) {
        AddrPlain g{(const char*)(ws + WS_MG), (const char*)(ws + WS_WOUT2), 2048, 2048, 2048};
        pg8::StaticOrder S; S.init(MTOK, 1024, F.G, F.bid);
        EpiResid E{F.in[0], F.out, (bf16*)(ws + WS_XM), (float*)(ws + WS_SS)};
        pg8::gemm_phase(F.lds, g, S, E);
    } SEAM(9);
    if (IN(10)) REP(10) {
        AddrPlain g{(const char*)(ws + WS_XM), (const char*)(ws + WS_WPQ), 1024, 1024, 1024};
        pg8::StaticOrder S; S.init(MTOK, 2048, F.G, F.bid);
        EpiPQ E{(bf16*)(ws + WS_MG), (const float*)(ws + WS_SS)};
        pg8::gemm_phase(F.lds, g, S, E);
    } SEAM(10);
    if (IN(11)) REP(11) { select_phase(F); } SEAM(11);
    if (IN(12)) { if ((PROBE_MASK >> 12) & 1) { apply_phase(F, (float*)(ws + WS_MG)); xcd_barrier(bar); } apply_phase(F, F.out); }
#undef REP
#undef IN
#undef SEAM
}

extern "C" void kernel_launch(void* const* d_in, const int* in_sizes, int n_in, void* d_out, int out_size, void* d_ws, size_t ws_size, hipStream_t stream) {
    static int grid = 0;
    if (grid == 0) {
        if (n_in != 26 || in_sizes[0] != MTOK * DM || out_size != MTOK * DM || ws_size < WS_END) { fprintf(stderr, "kernel_launch: unexpected shapes / workspace (%zu < %zu)\n", ws_size, (size_t)WS_END); grid = -1; return; }
        int dev = 0, cus = 0, per_cu = 0;
        if (hipGetDevice(&dev) != hipSuccess || hipDeviceGetAttribute(&cus, hipDeviceAttributeMultiprocessorCount, dev) != hipSuccess) { grid = -1; return; }
        if (hipFuncSetAttribute((const void*)mega_fwd, hipFuncAttributeMaxDynamicSharedMemorySize, LDS_BYTES) != hipSuccess) { fprintf(stderr, "kernel_launch: hipFuncSetAttribute failed\n"); grid = -1; return; }
        if (hipOccupancyMaxActiveBlocksPerMultiprocessor(&per_cu, (const void*)mega_fwd, NTHR, LDS_BYTES) != hipSuccess || per_cu < 1) { fprintf(stderr, "kernel_launch: occupancy query says %d blocks/CU\n", per_cu); (void)hipGetLastError(); grid = -1; return; }
        grid = cus;
    }
    if (grid < 0) return;
    (void)hipMemsetAsync((char*)d_ws + WS_CTL, 0, CTL_ZERO_BYTES, stream);
    Args a{};
    for (int i = 0; i < 26; ++i) a.in[i] = (const float*)d_in[i];
    a.out = (float*)d_out; a.ws = (unsigned char*)d_ws;
#if MK_N_LAUNCHES == 1
    a.ph_lo = 0; a.ph_hi = N_PHASES;
    void* kargs[] = {&a};
    hipError_t e = hipLaunchCooperativeKernel((const void*)mega_fwd, dim3(grid), dim3(NTHR), kargs, LDS_BYTES, stream);
    if (e != hipSuccess) fprintf(stderr, "kernel_launch: cooperative launch failed: %s (grid %d)\n", hipGetErrorString(e), grid);
#else
    for (int p = 0; p < N_PHASES; ++p) { a.ph_lo = p; a.ph_hi = p + 1; hipLaunchKernelGGL(mega_fwd, dim3(grid), dim3(NTHR), LDS_BYTES, stream, a); }
#endif
}
```

```cpp
#include <hip/hip_runtime.h>
#include <cstdio>
#include <cstdint>
#include <math.h>

#ifndef MK_N_LAUNCHES
#define MK_N_LAUNCHES 1
#endif

constexpr int BATCH = 8, SEQ = 4096, DM = 1024, MTOK = BATCH * SEQ;
constexpr int DIN = 6160;
constexpr int NEXP = 16384;
constexpr float EPS = 1e-6f;

constexpr size_t MiB = 1u << 20;
constexpr size_t WS_CTL = 0, CTL_ZERO_BYTES = 1 * MiB;
constexpr size_t WS_WIN = 1 * MiB;
constexpr size_t WS_WQKV = 13 * MiB;
constexpr size_t WS_KEYS = 14 * MiB + 512 * 1024;
constexpr size_t WS_WLRU = 15 * MiB;
constexpr size_t WS_WB2 = 16 * MiB;
constexpr size_t WS_WOUT2 = 20 * MiB;
constexpr size_t WS_WPQ = 24 * MiB;
constexpr size_t WS_GATE = 28 * MiB;
constexpr size_t WS_WGT = 30 * MiB;
constexpr size_t WS_XM = 32 * MiB;
constexpr size_t WS_OP = 96 * MiB;
constexpr size_t WS_XL = 160 * MiB;
constexpr size_t WS_LG = 224 * MiB;
constexpr size_t WS_MG = 288 * MiB;
constexpr size_t WS_K = 416 * MiB;
constexpr size_t WS_AGG = 480 * MiB;
constexpr size_t WS_SS = 488 * MiB;
constexpr size_t WS_END = 489 * MiB;

constexpr int CW_BAR = 4096;

constexpr int RING_BYTES = 131072;
constexpr int LDS_BYTES = 147456;
constexpr int LDSCTL_OFF = LDS_BYTES - 512, MISC_OFF = LDSCTL_OFF + 320;
constexpr int NWAVES = 8, NTHR = 512;

#define GAS __attribute__((address_space(1)))
#define LAS __attribute__((address_space(3)))
typedef unsigned short bf16;
typedef unsigned v4u __attribute__((ext_vector_type(4)));
typedef unsigned v2u __attribute__((ext_vector_type(2)));
typedef float f32x4 __attribute__((ext_vector_type(4)));
typedef float f32x2 __attribute__((ext_vector_type(2)));
typedef short bf16x8 __attribute__((ext_vector_type(8)));
typedef GAS unsigned gu32;
#define RLX_AGENT __ATOMIC_RELAXED, __HIP_MEMORY_SCOPE_AGENT
#define LDS_WAIT() asm volatile("s_waitcnt lgkmcnt(0)" ::: "memory")
#define VM_WAIT() asm volatile("s_waitcnt vmcnt(0)" ::: "memory")

__device__ __forceinline__ unsigned f2bf(float f) { unsigned u = __builtin_bit_cast(unsigned, f); return (u + 0x7fffu + ((u >> 16) & 1u)) >> 16; }
__device__ __forceinline__ unsigned pk2(float lo, float hi) { return f2bf(lo) | (f2bf(hi) << 16); }
__device__ __forceinline__ float bf2f(unsigned short h) { return __builtin_bit_cast(float, (unsigned)h << 16); }
__device__ __forceinline__ float bflo(unsigned w) { return __builtin_bit_cast(float, w << 16); }
__device__ __forceinline__ float bfhi(unsigned w) { return __builtin_bit_cast(float, w & 0xffff0000u); }
__device__ __forceinline__ float wave_sum(float v) {
#pragma unroll
  for (int o = 1; o < 64; o <<= 1) v += __shfl_xor(v, o);
  return v;
}
__device__ __forceinline__ float sigmoidf_(float x) { return __builtin_amdgcn_rcpf(1.f + __builtin_amdgcn_exp2f(x * -1.44269504089f)); }
__device__ __forceinline__ float gelu_erf(float x) { return 0.5f * x * (1.f + erff(x * 0.70710678118654752f)); }
__device__ __forceinline__ float gelu_fast(float v) {
    const float av = fabsf(v), t = __builtin_amdgcn_rcpf(av * 0.2316418882f + 1.0f);
    float q = t * 0.5307027145f + (-0.7265760135f); q = q * t + 0.7107068705f; q = q * t + (-0.142248368f); q = q * t + 0.127414796f; q = q * t;
    const float e = __builtin_amdgcn_exp2f((v * v) * (-0.72134752044f));
    const float m = v * (q * e);
    return v < 0.f ? m : v - m;
}
__device__ __forceinline__ float softplusf_(float x) { return fmaxf(x, 0.f) + log1pf(expf(-fabsf(x))); }

namespace pg8 {
#define PG8_LAS __attribute__((address_space(3)))
typedef unsigned short bf16_t;
typedef unsigned u32x4 __attribute__((ext_vector_type(4)));
constexpr int BM = 256, BK = 64, HALF = 128, HTB = HALF * BK * 2, STAGE_BYTES = 8 * HTB, NXCD = 8;

__host__ __device__ __forceinline__ int lds_byte(int r, int c) { const int st = (r >> 4) * 2 + (c >> 5), rr = r & 15, cc = c & 31, ob = rr * 64 + cc * 2; return st * 1024 + (ob ^ (((ob >> 9) & 1) << 5)); }
__host__ __device__ __forceinline__ void stage_rc(int b, int& R, int& C) { const int st = b / 1024, sb = b % 1024, swz = sb ^ (((sb >> 9) & 1) << 5); R = (st >> 1) * 16 + swz / 64; C = (st & 1) * 32 + (swz % 64) / 2; }
__host__ __device__ __forceinline__ int perm32(int rho) { const int n = rho >> 4, i = rho & 15; return 8 * (i >> 2) + 4 * n + (i & 3); }

struct Unit { int pm, pn; };
struct StaticOrder {
    int nM, nN, nwg, G, c, WGM;
    __host__ __device__ void init(int M, int N, int G_, int c_, int wgm = 8) { nM = M / BM; nN = N / BM; nwg = nM * nN; G = G_; c = c_; WGM = wgm; }
    __host__ __device__ bool next(int i, Unit& u) const {
        const long L = (long)i * G + c; if (L >= nwg) return false;
        int wgid = (int)L; { const int q = nwg / NXCD, r = nwg % NXCD, xcd = wgid % NXCD, off = wgid / NXCD; wgid = (xcd < r ? xcd * (q + 1) : r * (q + 1) + (xcd - r) * q) + off; }
        const int nig = WGM * nN, gid = wgid / nig, fm = gid * WGM, gsz = (nM - fm) < WGM ? (nM - fm) : WGM;
        u.pm = fm + ((wgid % nig) % gsz); u.pn = (wgid % nig) / gsz; return true;
    }
};

__device__ __forceinline__ unsigned cvt_pk_bf16(float lo, float hi) { unsigned r; asm volatile("v_cvt_pk_bf16_f32 %0, %1, %2" : "=v"(r) : "v"(lo), "v"(hi)); return r; }

template <class Epi, class Addr>
__device__ __forceinline__ void gemm_phase(PG8_LAS unsigned char* lds, const Addr g, const StaticOrder& S, const Epi& E) {
    const int tid = threadIdx.x, wid = __builtin_amdgcn_readfirstlane(tid >> 6), lane = tid & 63, wr = wid >> 2, wc = wid & 3, fr = lane & 15, fq = lane >> 4;
    const int K = g.K, nt = K / BK;
    unsigned voffA[2], voffB[2];
#pragma unroll
    for (int i = 0; i < 2; ++i) { int R, C; stage_rc(tid * 16 + i * 8192, R, C); const int Rb = Epi::PERM ? ((R & ~31) + perm32(R & 31)) : R;
        voffA[i] = (unsigned)(R * g.lda + C) * 2u; voffB[i] = (unsigned)(Rb * g.ldb + C) * 2u; }
    const size_t kstep = (size_t)(BK * 2);
    const size_t hsA = (size_t)HALF * g.lda * 2, hsB = (size_t)HALF * g.ldb * 2;
    const unsigned ldsw = (unsigned)wid * 1024u;
    const int aoff = lds_byte(wr * 64 + fr, fq * 8), boff = lds_byte(wc * 32 + fr, fq * 8);
#define PG8_SA(b, h) (((b) * 2 + (h)) * HTB)
#define PG8_SB(b, h) ((4 + (b) * 2 + (h)) * HTB)
#define PG8_STAGE(bufoff, gbase, voff) do { _Pragma("unroll") for (int _i = 0; _i < 2; ++_i) \
        __builtin_amdgcn_global_load_lds((const unsigned*)((const char*)(gbase) + (voff)[_i]), (PG8_LAS unsigned*)(lds + (bufoff) + ldsw + _i * 8192), 16, 0, 0); } while (0)
#define PG8_LDA(dst, b, h) do { _Pragma("unroll") for (int m = 0; m < 4; ++m) _Pragma("unroll") for (int k = 0; k < 2; ++k) dst[m][k] = *(const PG8_LAS bf16x8*)(lds + PG8_SA(b, h) + aoff + m * 2048 + k * 1024); } while (0)
#define PG8_LDB(dst, b, h) do { _Pragma("unroll") for (int n = 0; n < 2; ++n) _Pragma("unroll") for (int k = 0; k < 2; ++k) dst[n][k] = *(const PG8_LAS bf16x8*)(lds + PG8_SB(b, h) + boff + n * 2048 + k * 1024); } while (0)
#define PG8_MMA(ai, bj, At, Bt) do { __builtin_amdgcn_s_setprio(1); _Pragma("unroll") for (int m = 0; m < 4; ++m) _Pragma("unroll") for (int n = 0; n < 2; ++n) _Pragma("unroll") for (int k = 0; k < 2; ++k) \
        acc[ai][bj][m][n] = __builtin_amdgcn_mfma_f32_16x16x32_bf16(Bt[n][k], At[m][k], acc[ai][bj][m][n], 0, 0, 0); __builtin_amdgcn_s_setprio(0); } while (0)
#define PG8_WAIT_V(n) asm volatile("s_waitcnt vmcnt(" #n ")" ::: "memory")
#define PG8_WAIT_L(n) asm volatile("s_waitcnt lgkmcnt(" #n ")" ::: "memory")
#define PG8_BAR __builtin_amdgcn_s_barrier()
#define PG8_SCHED __builtin_amdgcn_sched_barrier(0)
    Unit cur, nxt; int ui = 0;
    if (!S.next(0, cur)) return;
    f32x4 acc[2][2][4][2];
#pragma unroll
    for (int a = 0; a < 2; ++a)
#pragma unroll
        for (int b = 0; b < 2; ++b)
#pragma unroll
            for (int m = 0; m < 4; ++m)
#pragma unroll
                for (int n = 0; n < 2; ++n) acc[a][b][m][n] = (f32x4){0.f, 0.f, 0.f, 0.f};
    bf16x8 At[4][2], B0[2][2], B1[2][2];
    const char* cA = g.a(cur); const char* cB = g.b(cur);
    PG8_STAGE(PG8_SB(0, 0), cB, voffB); PG8_STAGE(PG8_SB(0, 1), cB + hsB, voffB); PG8_STAGE(PG8_SA(0, 0), cA, voffA); PG8_STAGE(PG8_SA(0, 1), cA + hsA, voffA);
    if (wr == 1) PG8_BAR;
    PG8_WAIT_V(2); PG8_BAR;
    PG8_STAGE(PG8_SB(1, 0), cB + kstep, voffB); PG8_STAGE(PG8_SA(1, 0), cA + kstep, voffA); PG8_STAGE(PG8_SB(1, 1), cB + hsB + kstep, voffB);
    PG8_WAIT_V(6); PG8_BAR;
    for (;;) {
        const bool has_next = S.next(ui + 1, nxt);
        const char* nA = has_next ? g.a(nxt) : cA; const char* nB = has_next ? g.b(nxt) : cB;
#pragma unroll 1
        for (int t = 0; t < nt; t += 2) {
            const bool last = (t == nt - 2);
            const char* a1 = cA + (size_t)(t + 1) * kstep;
            const char* a2 = last ? nA : cA + (size_t)(t + 2) * kstep; const char* b2 = last ? nB : cB + (size_t)(t + 2) * kstep;
            const char* a3 = a2 + kstep; const char* b3 = b2 + kstep;
            PG8_LDB(B0, 0, 0); PG8_LDB(B1, 0, 1); PG8_SCHED; PG8_LDA(At, 0, 0); PG8_STAGE(PG8_SA(1, 1), a1 + hsA, voffA);
            PG8_WAIT_V(8); PG8_WAIT_L(0); PG8_BAR; PG8_MMA(0, 0, At, B0); PG8_MMA(0, 1, At, B1); PG8_BAR; PG8_SCHED;
            PG8_LDA(At, 0, 1); PG8_STAGE(PG8_SB(0, 0), b2, voffB); PG8_STAGE(PG8_SB(0, 1), b2 + hsB, voffB); PG8_STAGE(PG8_SA(0, 0), a2, voffA);
            PG8_WAIT_V(8); PG8_WAIT_L(0); PG8_BAR; PG8_MMA(1, 0, At, B0); PG8_MMA(1, 1, At, B1); PG8_BAR; PG8_SCHED;
            PG8_LDB(B0, 1, 0); PG8_LDB(B1, 1, 1); PG8_SCHED; PG8_LDA(At, 1, 0); PG8_STAGE(PG8_SA(0, 1), a2 + hsA, voffA);
            PG8_WAIT_V(8); PG8_WAIT_L(0); PG8_BAR; PG8_MMA(0, 0, At, B0); PG8_MMA(0, 1, At, B1); PG8_BAR; PG8_SCHED;
            PG8_LDA(At, 1, 1); PG8_STAGE(PG8_SB(1, 0), b3, voffB); PG8_STAGE(PG8_SB(1, 1), b3 + hsB, voffB); PG8_STAGE(PG8_SA(1, 0), a3, voffA);
            PG8_WAIT_V(8); PG8_WAIT_L(0); PG8_BAR; PG8_MMA(1, 0, At, B0); PG8_MMA(1, 1, At, B1); PG8_BAR; PG8_SCHED;
        }
        if (wr == 0) PG8_BAR;
        E(acc, cur, wr, wc, fr, fq);
        if (!has_next) break;
#pragma unroll
        for (int a = 0; a < 2; ++a)
#pragma unroll
            for (int b = 0; b < 2; ++b)
#pragma unroll
                for (int m = 0; m < 4; ++m)
#pragma unroll
                    for (int n = 0; n < 2; ++n) acc[a][b][m][n] = (f32x4){0.f, 0.f, 0.f, 0.f};
        cur = nxt; cA = nA; cB = nB; ++ui;
        if (wr == 1) PG8_BAR;
    }
    PG8_WAIT_V(0);
    PG8_BAR;
#undef PG8_SA
#undef PG8_SB
#undef PG8_STAGE
#undef PG8_LDA
#undef PG8_LDB
#undef PG8_MMA
#undef PG8_WAIT_V
#undef PG8_WAIT_L
#undef PG8_BAR
#undef PG8_SCHED
}
}

#define XB_TMO      128
#define XB_XCNT(j)  (256  + 64 * (j))
#define XB_XSUB(j)  (1280 + 64 * (j))
#define XB_XGEN(j)  (2304 + 64 * (j))
#define XB_TOP      3328
#define XB_TOPGEN   3392
#define XCD_BAR_WORDS 3456
#define XB_SPIN_CAP (1u << 18)
__device__ __forceinline__ unsigned xb_ld(unsigned* p)              { return __hip_atomic_load(p, __ATOMIC_RELAXED, __HIP_MEMORY_SCOPE_AGENT); }
__device__ __forceinline__ unsigned xb_add(unsigned* p, unsigned v) { return __hip_atomic_fetch_add(p, v, __ATOMIC_RELAXED, __HIP_MEMORY_SCOPE_AGENT); }
__device__ __forceinline__ unsigned xb_xcc_id() { return (unsigned)__builtin_amdgcn_s_getreg((3 << 11) | 20) & 0xFu; }
#define XB_SPIN(cond, bar) do { unsigned _sp = 0; while (cond) { __builtin_amdgcn_s_sleep(1); \
    if ((++_sp & 255u) == 0u) { if (xb_ld(&(bar)[XB_TMO])) break; if (_sp > XB_SPIN_CAP) { atomicAdd(&(bar)[XB_TMO], 1u); break; } } } } while (0)
struct XcdBarrier { unsigned* bar; unsigned x; volatile LAS unsigned* st; };
__device__ __forceinline__ XcdBarrier xcd_barrier_post(unsigned* bar, volatile LAS unsigned* st) {
    XcdBarrier b; b.bar = bar; b.x = xb_xcc_id(); b.st = st;
    if (threadIdx.x == 0) (void)xb_add(&bar[XB_XCNT(b.x)], 1u);
    return b;
}
__device__ __forceinline__ void xcd_barrier_complete(unsigned* bar, unsigned x, unsigned& nloc, unsigned& nx) {
    const unsigned G = gridDim.x * gridDim.y * gridDim.z;
    unsigned sum, cnt, mine, sp = 0u;
    for (;;) {
        sum = 0u; cnt = 0u; mine = 0u;
#pragma unroll
        for (unsigned j = 0; j < 16; ++j) { const unsigned c = xb_ld(&bar[XB_XCNT(j)]); sum += c; cnt += (c > 0u) ? 1u : 0u; mine = (j == x) ? c : mine; }
        if (sum == G) break;
        __builtin_amdgcn_s_sleep(1);
        if ((++sp & 255u) == 0u) { if (xb_ld(&bar[XB_TMO])) break; if (sp > XB_SPIN_CAP) { atomicAdd(&bar[XB_TMO], 1u); break; } }
    }
    nloc = mine > 0u ? mine : 1u; nx = cnt > 0u ? cnt : 1u;
}
__device__ __forceinline__ void xcd_barrier(const XcdBarrier& b) {
    asm volatile("s_waitcnt vmcnt(0)" ::: "memory");
    __syncthreads();
    if (threadIdx.x == 0) {
        unsigned* bar = b.bar;
        __builtin_amdgcn_s_waitcnt(0);
        unsigned nloc = b.st[0], nx = b.st[1];
        if (nloc == 0u) { xcd_barrier_complete(bar, b.x, nloc, nx); b.st[0] = nloc; b.st[1] = nx; }
        const unsigned old = xb_add(&bar[XB_XSUB(b.x)], 1u);
        const unsigned gen = old / nloc;
        if (old + 1u == (gen + 1u) * nloc) {
            __builtin_amdgcn_fence(__ATOMIC_RELEASE, "agent");
            asm volatile("s_waitcnt vmcnt(0)" ::: "memory");
            const unsigned og = xb_add(&bar[XB_TOP], 1u);
            const unsigned tg = og / nx;
            if (og + 1u == (tg + 1u) * nx) xb_add(&bar[XB_TOPGEN], 1u);
            else XB_SPIN(xb_ld(&bar[XB_TOPGEN]) == tg, bar);
            __builtin_amdgcn_fence(__ATOMIC_ACQUIRE, "agent");
            xb_add(&bar[XB_XGEN(b.x)], 1u);
            asm volatile("s_waitcnt vmcnt(0)" ::: "memory");
        } else {
            XB_SPIN(xb_ld(&bar[XB_XGEN(b.x)]) == gen, bar);
            __builtin_amdgcn_fence(__ATOMIC_ACQUIRE, "agent");
            asm volatile("s_waitcnt vmcnt(0)" ::: "memory");
        }
    }
    __syncthreads();
}

struct Args { const float* in[26]; float* out; unsigned char* ws; int ph_lo, ph_hi; };
struct Frame {
    LAS unsigned char* lds;
    int tid, lane, wave, G, bid;
    const float* const* in; float* out; unsigned char* ws;
};

__device__ __forceinline__ void tr_item(const float* W, int ldw, bf16* WT, int ldt, float scale, const float* kscale, LAS float* scr, int k0, int lane) {
#pragma unroll 8
    for (int i = 0; i < 32; ++i) { const int kk = 2 * i + (lane >> 5); float v = W[(size_t)(k0 + kk) * ldw + (lane & 31)] * scale; if (kscale) v *= kscale[k0 + kk]; scr[kk * 33 + (lane & 31)] = v; }
    LDS_WAIT(); asm volatile("" ::: "memory");
    const int c = lane & 7;
#pragma unroll
    for (int j = 0; j < 4; ++j) { const int n = (lane >> 3) + 8 * j; const LAS float* s = scr + (8 * c) * 33 + n;
        v4u o; o.x = pk2(s[0 * 33], s[1 * 33]); o.y = pk2(s[2 * 33], s[3 * 33]); o.z = pk2(s[4 * 33], s[5 * 33]); o.w = pk2(s[6 * 33], s[7 * 33]);
        *(GAS v4u*)(WT + (size_t)n * ldt + k0 + 8 * c) = o; }
    LDS_WAIT(); asm volatile("" ::: "memory");
}

__device__ __forceinline__ void p0_prologue(Frame& F) {
    LAS float* scr = (LAS float*)(F.lds + F.wave * 16384);
    const int gw = F.bid * NWAVES + F.wave, NGW = F.G * NWAVES;
    unsigned char* ws = F.ws;
    const float* w_in = F.in[2];
    constexpr int I_WIN = 16 * 192, I_QKV = 12 * 32, I_LRU = 32 * 8, I_WB = 2 * 512, I_WO = 2 * 512, I_PQ = 16 * 64;
    constexpr int NITEMS = I_WIN + I_QKV + I_LRU + I_WB + I_WO + I_PQ;
    for (int it = gw; it < NITEMS; it += NGW) {
        int r = it;
        if (r < I_WIN) { const int kb = r / 192, nb = r % 192, n0 = nb * 32, sc = n0 < 2048 ? n0 : n0 + 16;
            tr_item(w_in + sc, DIN, (bf16*)(ws + WS_WIN) + (size_t)n0 * 1024, 1024, 1.f, nullptr, scr, kb * 64, F.lane); continue; }
        r -= I_WIN;
        if (r < I_QKV) { const int mat = r / 32, rr = r % 32, kb = rr / 8, nb = rr % 8, g = mat >> 2, h = mat & 3;
            const float* W = F.in[6 + g] + (size_t)h * 65536 + nb * 32;
            tr_item(W, 256, (bf16*)(ws + WS_WQKV) + (size_t)mat * 65536 + (size_t)(nb * 32) * 256, 256, g == 1 ? 0.0625f : 1.f, nullptr, scr, kb * 64, F.lane); continue; }
        r -= I_QKV;
        if (r < I_LRU) { const int mat = r / 8, rr = r % 8, kb = rr / 4, nb = rr % 4, gate = mat & 1, db = mat >> 1;
            const float* W = F.in[gate ? 14 : 12] + (size_t)db * 16384 + nb * 32;
            tr_item(W, 128, (bf16*)(ws + WS_WLRU) + (size_t)mat * 16384 + (size_t)(nb * 32) * 128, 128, 1.f, nullptr, scr, kb * 64, F.lane); continue; }
        r -= I_LRU;
        if (r < I_WB) { const int mat = r / 512, rr = r % 512, kb = rr / 32, nb = rr % 32;
            const float* W = F.in[17 + mat] + nb * 32;
            tr_item(W, 1024, (bf16*)(ws + WS_WB2) + (size_t)(mat * 1024 + nb * 32) * 1024, 1024, 1.f, nullptr, scr, kb * 64, F.lane); continue; }
        r -= I_WB;
        if (r < I_WO) { const int cp = r / 512, rr = r % 512, kb = rr / 32, nb = rr % 32;
            const float* W = F.in[19] + nb * 32;
            tr_item(W, 1024, (bf16*)(ws + WS_WOUT2) + (size_t)(nb * 32) * 2048 + cp * 1024, 2048, 1.f, nullptr, scr, kb * 64, F.lane); continue; }
        r -= I_WO;
        { const int kb = r / 64, nb = r % 64;
            const float* W = F.in[21] + nb * 32;
            tr_item(W, 2048, (bf16*)(ws + WS_WPQ) + (size_t)(nb * 32) * 1024, 1024, 1.f, F.in[20], scr, kb * 64, F.lane); }
    }
    { const int gt = F.bid * NTHR + F.tid, NGT = F.G * NTHR;
      const float4* ks = (const float4*)F.in[22]; v2u* kd = (v2u*)(ws + WS_KEYS);
      for (int i = gt; i < 8 * 2 * 128 * 128 / 4; i += NGT) { const float4 v = ks[i]; v2u o; o.x = pk2(v.x, v.y); o.y = pk2(v.z, v.w); kd[i] = o; }
      float* ss = (float*)(ws + WS_SS);
      for (int i = gt; i < MTOK; i += NGT) ss[i] = 0.f; }
    { const int gt = F.bid * NTHR + F.tid;
      if (gt < 16 * 128) { const int c = gt >> 7, k8 = gt & 127; v4u o; unsigned wv[4];
#pragma unroll
          for (int j = 0; j < 4; ++j) wv[j] = pk2(w_in[(size_t)(k8 * 8 + 2 * j) * DIN + 2048 + c], w_in[(size_t)(k8 * 8 + 2 * j + 1) * DIN + 2048 + c]);
          o.x = wv[0]; o.y = wv[1]; o.z = wv[2]; o.w = wv[3]; *(v4u*)((bf16*)(ws + WS_WGT) + c * 1024 + k8 * 8) = o; } }
    const float* x = F.in[0]; const float* g1 = F.in[1];
    bf16* XN = (bf16*)(ws + WS_K);
    f32x4 gv[4];
#pragma unroll
    for (int j = 0; j < 4; ++j) gv[j] = ((const f32x4*)g1)[F.lane + 64 * j];
    for (int m = 2 * gw; m < MTOK; m += 2 * NGW) {
        const f32x4* xr0 = (const f32x4*)(x + (size_t)m * DM) + F.lane; const f32x4* xr1 = xr0 + DM / 4;
        f32x4 v0[4], v1[4]; float s0 = 0.f, s1 = 0.f;
#pragma unroll
        for (int j = 0; j < 4; ++j) { v0[j] = xr0[64 * j]; v1[j] = xr1[64 * j]; }
#pragma unroll
        for (int j = 0; j < 4; ++j) { s0 += (v0[j].x * v0[j].x + v0[j].y * v0[j].y) + (v0[j].z * v0[j].z + v0[j].w * v0[j].w); s1 += (v1[j].x * v1[j].x + v1[j].y * v1[j].y) + (v1[j].z * v1[j].z + v1[j].w * v1[j].w); }
        const float r0 = rsqrtf(wave_sum(s0) * (1.f / DM) + EPS), r1 = rsqrtf(wave_sum(s1) * (1.f / DM) + EPS);
        unsigned long long* o0 = (unsigned long long*)(XN + (size_t)m * DM) + F.lane; unsigned long long* o1 = o0 + DM / 4;
#pragma unroll
        for (int j = 0; j < 4; ++j) { const f32x4 a = v0[j] * r0 * gv[j], c = v1[j] * r1 * gv[j];
            o0[64 * j] = (unsigned long long)pk2(a.x, a.y) | ((unsigned long long)pk2(a.z, a.w) << 32);
            o1[64 * j] = (unsigned long long)pk2(c.x, c.y) | ((unsigned long long)pk2(c.z, c.w) << 32); }
    }
}
__device__ __forceinline__ void gates_phase(Frame& F) {
    const bf16* XN = (const bf16*)(F.ws + WS_K); const bf16* WGT = (const bf16*)(F.ws + WS_WGT); float* GT = (float*)(F.ws + WS_GATE);
    const int lane = F.lane, fr = lane & 15, fq = lane >> 4;
    const f32x4 bg4 = *(const f32x4*)(F.in[3] + 4 * fq);
    for (int task = F.bid * NWAVES + F.wave; task < MTOK / 16; task += F.G * NWAVES) {
        const size_t m0 = (size_t)task * 16;
        f32x4 acc = (f32x4){0.f, 0.f, 0.f, 0.f};
#pragma unroll 8
        for (int ks = 0; ks < 32; ++ks) {
            const bf16x8 wfr = *(const bf16x8*)(WGT + fr * 1024 + 32 * ks + 8 * fq);
            const bf16x8 xfr = *(const bf16x8*)(XN + (m0 + fr) * DM + 32 * ks + 8 * fq);
            acc = __builtin_amdgcn_mfma_f32_16x16x32_bf16(wfr, xfr, acc, 0, 0, 0);
        }
        *(f32x4*)(GT + (m0 + fr) * 16 + 4 * fq) = acc + bg4;
    }
}

struct AddrPlain {
    const char* A; const char* Bt; int lda, ldb, K;
    __device__ __forceinline__ const char* a(const pg8::Unit& u) const { return A + (size_t)u.pm * 256 * lda * 2; }
    __device__ __forceinline__ const char* b(const pg8::Unit& u) const { return Bt + (size_t)u.pn * 256 * ldb * 2; }
};
struct AddrQKV {
    const char* XC; long dXM; const char* W; int lda, ldb, K;
    __device__ __forceinline__ const char* a(const pg8::Unit& u) const { return XC + (u.pn < 8 ? 0l : dXM) + ((size_t)u.pm * 256 * 1024 + (u.pn & 3) * 256) * 2; }
    __device__ __forceinline__ const char* b(const pg8::Unit& u) const { return W + (size_t)u.pn * 65536 * 2; }
};
struct AddrBranch {
    const char* YM; long dYL; const char* W; int lda, ldb, K;
    __device__ __forceinline__ const char* a(const pg8::Unit& u) const { return YM + (u.pn < 4 ? 0l : dYL) + (size_t)u.pm * 256 * 1024 * 2; }
    __device__ __forceinline__ const char* b(const pg8::Unit& u) const { return W + (size_t)u.pn * 256 * 1024 * 2; }
};

struct DstP1 { unsigned char* ws;
    __device__ __forceinline__ bf16* get(int pn, int& ld, int& col0) const {
        const bool mg = pn >= 16; ld = mg ? 2048 : 1024; col0 = mg ? (pn - 16) * 256 : (pn & 3) * 256;
        return (bf16*)(ws + (mg ? WS_MG : WS_XM + (size_t)(pn >> 2) * 64 * MiB)); } };
struct DstQKV { char* q; long dk, dv;
    __device__ __forceinline__ bf16* get(int pn, int& ld, int& col0) const { ld = 1024; col0 = (pn & 3) * 256; return (bf16*)(q + (pn >= 4 ? (pn >= 8 ? dv : dk) : 0l)); } };
template <class Dst> struct EpiBf16 {
    static constexpr bool PERM = true;
    Dst dst;
    __device__ __forceinline__ void operator()(const f32x4 (&acc)[2][2][4][2], const pg8::Unit& u, int wr, int wc, int fr, int fq) const {
        int ld, colt; bf16* base = dst.get(u.pn, ld, colt);
        const int row0 = u.pm * 256 + wr * 64 + fr, col0 = colt + wc * 32 + 8 * fq;
#pragma unroll
        for (int ai = 0; ai < 2; ++ai)
#pragma unroll
            for (int m = 0; m < 4; ++m) { bf16* rowp = base + (size_t)(row0 + ai * 128 + m * 16) * ld + col0;
#pragma unroll
                for (int bj = 0; bj < 2; ++bj) { const f32x4 v0 = acc[ai][bj][m][0], v1 = acc[ai][bj][m][1];
                    v4u w; w.x = pg8::cvt_pk_bf16(v0[0], v0[1]); w.y = pg8::cvt_pk_bf16(v0[2], v0[3]); w.z = pg8::cvt_pk_bf16(v1[0], v1[1]); w.w = pg8::cvt_pk_bf16(v1[2], v1[3]);
                    *(v4u*)(rowp + bj * 128) = w; } }
    }
};
struct EpiGate {
    static constexpr bool PERM = true;
    bf16* G;
    __device__ __forceinline__ void operator()(const f32x4 (&acc)[2][2][4][2], const pg8::Unit& u, int wr, int wc, int fr, int fq) const {
        const int row0 = u.pm * 256 + wr * 64 + fr, col0 = u.pn * 256 + wc * 32 + 8 * fq;
#pragma unroll
        for (int ai = 0; ai < 2; ++ai)
#pragma unroll
            for (int m = 0; m < 4; ++m) { bf16* rowp = G + (size_t)(row0 + ai * 128 + m * 16) * 2048 + col0;
#pragma unroll
                for (int bj = 0; bj < 2; ++bj) { const f32x4 v0 = acc[ai][bj][m][0], v1 = acc[ai][bj][m][1];
                    const v4u g = *(const v4u*)(rowp + bj * 128);
                    v4u w;
                    w.x = pg8::cvt_pk_bf16(v0[0] * sigmoidf_(bflo(g.x)), v0[1] * sigmoidf_(bfhi(g.x)));
                    w.y = pg8::cvt_pk_bf16(v0[2] * sigmoidf_(bflo(g.y)), v0[3] * sigmoidf_(bfhi(g.y)));
                    w.z = pg8::cvt_pk_bf16(v1[0] * sigmoidf_(bflo(g.z)), v1[1] * sigmoidf_(bfhi(g.z)));
                    w.w = pg8::cvt_pk_bf16(v1[2] * sigmoidf_(bflo(g.w)), v1[3] * sigmoidf_(bfhi(g.w)));
                    *(v4u*)(rowp + bj * 128) = w; } }
    }
};
struct EpiResid {
    static constexpr bool PERM = false;
    const float* x; float* x1; bf16* x1b; float* ss;
    __device__ __forceinline__ void operator()(const f32x4 (&acc)[2][2][4][2], const pg8::Unit& u, int wr, int wc, int fr, int fq) const {
        const int row0 = u.pm * 256 + wr * 64 + fr, col0 = u.pn * 256 + wc * 32 + 4 * fq;
#pragma unroll
        for (int ai = 0; ai < 2; ++ai)
#pragma unroll
            for (int m = 0; m < 4; ++m) { const int row = row0 + ai * 128 + m * 16; const size_t off = (size_t)row * DM + col0; float s = 0.f;
#pragma unroll
                for (int bj = 0; bj < 2; ++bj)
#pragma unroll
                    for (int n = 0; n < 2; ++n) { const size_t o = off + bj * 128 + n * 16; const f32x4 v = *(const f32x4*)(x + o) + acc[ai][bj][m][n];
                        *(f32x4*)(x1 + o) = v; v2u w; w.x = pg8::cvt_pk_bf16(v[0], v[1]); w.y = pg8::cvt_pk_bf16(v[2], v[3]); *(v2u*)(x1b + o) = w;
                        s += (v[0] * v[0] + v[1] * v[1]) + (v[2] * v[2] + v[3] * v[3]); }
                s += __shfl_xor(s, 16); s += __shfl_xor(s, 32);
                if (fq == 0) atomicAdd(ss + row, s); }
    }
};
struct EpiPQ {
    static constexpr bool PERM = true;
    bf16* pq; const float* ss;
    __device__ __forceinline__ void operator()(const f32x4 (&acc)[2][2][4][2], const pg8::Unit& u, int wr, int wc, int fr, int fq) const {
        const int row0 = u.pm * 256 + wr * 64 + fr, col0 = u.pn * 256 + wc * 32 + 8 * fq;
#pragma unroll
        for (int ai = 0; ai < 2; ++ai)
#pragma unroll
            for (int m = 0; m < 4; ++m) { const int row = row0 + ai * 128 + m * 16; bf16* rowp = pq + (size_t)row * 2048 + col0;
                const float r = rsqrtf(ss[row] * (1.f / DM) + EPS);
#pragma unroll
                for (int bj = 0; bj < 2; ++bj) { const f32x4 v0 = acc[ai][bj][m][0] * r, v1 = acc[ai][bj][m][1] * r;
                    v4u w; w.x = pg8::cvt_pk_bf16(v0[0], v0[1]); w.y = pg8::cvt_pk_bf16(v0[2], v0[3]); w.z = pg8::cvt_pk_bf16(v1[0], v1[1]); w.w = pg8::cvt_pk_bf16(v1[2], v1[3]);
                    *(v4u*)(rowp + bj * 128) = w; } }
    }
};

__device__ __forceinline__ void lru_ref(Frame& F) {
    const bf16* XL = (const bf16*)(F.ws + WS_XL); const bf16* LG = (const bf16*)(F.ws + WS_LG); bf16* YL = (bf16*)F.out;
    const bf16* WL = (const bf16*)(F.ws + WS_WLRU);
    const float* cw = F.in[10]; const float* cb = F.in[11];
    LAS float* sxc = (LAS float*)F.lds;
    LAS float* sp = (LAS float*)(F.lds + 1024);
    const int c = F.tid & 127, part = F.tid >> 7;
    for (int item = F.bid; item < 64; item += F.G) {
        const int b = item >> 3, blk = item & 7, ch = blk * 128 + c;
        const float w0 = cw[0 * DM + ch], w1 = cw[1 * DM + ch], w2 = cw[2 * DM + ch], w3 = cw[3 * DM + ch], bb = cb[ch];
        for (int dir = 0; dir < 2; ++dir) {
            v4u wr[4], wi[4];
            { const v4u* pr = (const v4u*)(WL + ((size_t)((dir * 8 + blk) * 2 + 0) * 128 + c) * 128 + part * 32);
              const v4u* pi = (const v4u*)(WL + ((size_t)((dir * 8 + blk) * 2 + 1) * 128 + c) * 128 + part * 32);
#pragma unroll
              for (int q = 0; q < 4; ++q) { wr[q] = pr[q]; wi[q] = pi[q]; } }
            const float br = F.in[13][dir * DM + ch], bi = F.in[15][dir * DM + ch];
            const float spl = softplusf_(-F.in[16][dir * DM + ch]);
            float h = 0.f;
            for (int step = 0; step < SEQ; ++step) {
                const int t = dir ? (SEQ - 1 - step) : step;
                const size_t m = (size_t)b * SEQ + t;
                float xc = 0.f;
                if (part == 0) {
                    xc = bb;
                    if (t >= 2) xc += w0 * bf2f(XL[(m - 2) * DM + ch]);
                    if (t >= 1) xc += w1 * bf2f(XL[(m - 1) * DM + ch]);
                    xc += w2 * bf2f(XL[m * DM + ch]);
                    if (t + 1 < SEQ) xc += w3 * bf2f(XL[(m + 1) * DM + ch]);
                    sxc[c] = xc;
                }
                __syncthreads();
                float pr_ = 0.f, pi_ = 0.f;
#pragma unroll
                for (int q = 0; q < 4; ++q) {
                    const f32x4 x0 = *(const LAS f32x4*)(sxc + part * 32 + q * 8), x1 = *(const LAS f32x4*)(sxc + part * 32 + q * 8 + 4);
                    pr_ += x0[0] * bflo(wr[q].x) + x0[1] * bfhi(wr[q].x) + x0[2] * bflo(wr[q].y) + x0[3] * bfhi(wr[q].y)
                         + x1[0] * bflo(wr[q].z) + x1[1] * bfhi(wr[q].z) + x1[2] * bflo(wr[q].w) + x1[3] * bfhi(wr[q].w);
                    pi_ += x0[0] * bflo(wi[q].x) + x0[1] * bfhi(wi[q].x) + x0[2] * bflo(wi[q].y) + x0[3] * bfhi(wi[q].y)
                         + x1[0] * bflo(wi[q].z) + x1[1] * bfhi(wi[q].z) + x1[2] * bflo(wi[q].w) + x1[3] * bfhi(wi[q].w);
                }
                sp[(part * 2 + 0) * 128 + c] = pr_; sp[(part * 2 + 1) * 128 + c] = pi_;
                __syncthreads();
                if (part == 0) {
                    const float rp = sp[0 * 128 + c] + sp[2 * 128 + c] + sp[4 * 128 + c] + sp[6 * 128 + c] + br;
                    const float ip = sp[1 * 128 + c] + sp[3 * 128 + c] + sp[5 * 128 + c] + sp[7 * 128 + c] + bi;
                    const float r = sigmoidf_(rp), ig = sigmoidf_(ip);
                    const float log_a = -8.f * r * spl;
                    const float a = __expf(log_a);
                    const float u = sqrtf(-expm1f(2.f * log_a)) * (ig * xc);
                    h = a * h + u;
                    if (dir == 0) YL[m * DM + ch] = (bf16)f2bf(h);
                    else { const float y = (bf2f(YL[m * DM + ch]) + h) * gelu_erf(bf2f(LG[m * DM + ch])); YL[m * DM + ch] = (bf16)f2bf(y); }
                }
            }
            __syncthreads();
        }
    }
}


template <bool PB> __device__ __forceinline__ void lru_phase(Frame& F) {
    const bf16* XL = (const bf16*)(F.ws + WS_XL); const bf16* LG = (const bf16*)(F.ws + WS_LG); bf16* YL = (bf16*)F.out;
    f32x2* AGG = (f32x2*)(F.ws + WS_AGG);
    const bf16* WL = (const bf16*)(F.ws + WS_WLRU);
    const float* cw = F.in[10]; const float* cb = F.in[11];
    constexpr int O_XCB = 0, O_XCF = 17408, O_A = 51200, O_U = 84992, FST = 528;
    LAS unsigned char* L = F.lds;
    const int tid = F.tid, lane = F.lane, w = F.wave, fr = lane & 15, fq = lane >> 4;
    int cur_blk = -1;
    bf16x8 wf[2][2][4];
    f32x4 br4[2], bi4[2], sp4[2];
    v4u rawreg[3];
#define RAW_LOAD(bb, tt0, bk) do { _Pragma("unroll") for (int r_ = 0; r_ < 3; ++r_) { const int e_ = tid + NTHR * r_, row_ = e_ >> 4, c16_ = e_ & 15, t_ = (tt0) - 2 + row_; \
            v4u v_ = {0u, 0u, 0u, 0u}; if (e_ < 68 * 16 && t_ >= 0 && t_ < SEQ) v_ = *(const v4u*)(XL + ((size_t)(bb) * SEQ + t_) * DM + (bk) * 128 + c16_ * 8); rawreg[r_] = v_; } } while (0)
    constexpr int O_CARRY = 118784, O_CW = 135168;
    const bool carry_tab = PB && (F.G == 256);
    if (carry_tab) {
        const int ch = tid & 127, bq = tid >> 7, s0 = F.bid >> 3, blk0 = F.bid & 7;
        LAS float* CT = (LAS float*)(L + O_CARRY);
#define FOLD(agp, j0, j1, stp, hv) do { int js_ = (j0); const int n_ = ((j1) - (j0)) * (stp); int k_ = 0; \
            for (; k_ + 8 <= n_; k_ += 8) { f32x2 ah_[8]; _Pragma("unroll") for (int q_ = 0; q_ < 8; ++q_) ah_[q_] = (agp)[(size_t)(js_ + q_ * (stp)) * 2 * DM]; \
                _Pragma("unroll") for (int q_ = 0; q_ < 8; ++q_) hv = ah_[q_][0] * hv + ah_[q_][1]; js_ += 8 * (stp); } \
            for (; k_ < n_; ++k_) { const f32x2 a1_ = (agp)[(size_t)js_ * 2 * DM]; hv = a1_[0] * hv + a1_[1]; js_ += (stp); } } while (0)
        for (int bb = 2 * bq; bb < 2 * bq + 2; ++bb) {
            const f32x2* ag0 = AGG + ((size_t)(bb * 64) * 2 + 0) * DM + blk0 * 128 + ch; const f32x2* ag1 = AGG + ((size_t)(bb * 64) * 2 + 1) * DM + blk0 * 128 + ch;
            float h = 0.f;
            FOLD(ag0, 0, s0, 1, h); CT[((bb * 2 + 0) * 2 + 0) * 128 + ch] = h;
            FOLD(ag0, s0, s0 + 32, 1, h); CT[((bb * 2 + 1) * 2 + 0) * 128 + ch] = h;
            h = 0.f;
            FOLD(ag1, 63, s0 + 32, -1, h); CT[((bb * 2 + 1) * 2 + 1) * 128 + ch] = h;
            FOLD(ag1, s0 + 32, s0, -1, h); CT[((bb * 2 + 0) * 2 + 1) * 128 + ch] = h;
        }
        __syncthreads();
#undef FOLD
    }
    for (int i = 0;; ++i) {
        const int idx = i * F.G + F.bid; if (idx >= 4096) break;
        const int blk = idx & 7, j = idx >> 3, b = j >> 6, seg = j & 63, t0 = seg * 64;
        const size_t mrow0 = (size_t)b * SEQ + t0;
        if (blk != cur_blk) {
            cur_blk = blk;
#pragma unroll
            for (int d = 0; d < 2; ++d) {
#pragma unroll
                for (int g = 0; g < 2; ++g)
#pragma unroll
                    for (int ks = 0; ks < 4; ++ks)
                        wf[d][g][ks] = *(const bf16x8*)(WL + ((size_t)((d * 8 + blk) * 2 + g) * 128 + 16 * w + fr) * 128 + 32 * ks + 8 * fq);
                const int ch = blk * 128 + 16 * w + 4 * fq;
                br4[d] = *(const f32x4*)(F.in[13] + d * DM + ch); bi4[d] = *(const f32x4*)(F.in[15] + d * DM + ch);
                const f32x4 lm = *(const f32x4*)(F.in[16] + d * DM + ch);
#pragma unroll
                for (int e = 0; e < 4; ++e) sp4[d][e] = -8.f * 1.44269504089f * softplusf_(-lm[e]);
            }
            __syncthreads();
            for (int e = tid; e < 5 * 128; e += NTHR) { const int jt = e >> 7, cc = e & 127; ((LAS float*)(L + O_CW))[e] = (jt < 4) ? cw[jt * DM + blk * 128 + cc] : cb[blk * 128 + cc]; }
        }
        if (i == 0) RAW_LOAD(b, t0, blk);
#pragma unroll
        for (int r = 0; r < 3; ++r) { const int e = tid + NTHR * r; if (e < 68 * 16) *(LAS v4u*)(L + O_A + (e >> 4) * 256 + (e & 15) * 16) = rawreg[r]; }
        __syncthreads();
        { const int idx2 = (i + 1) * F.G + F.bid; if (idx2 < 4096) { const int j2 = idx2 >> 3; RAW_LOAD(j2 >> 6, (j2 & 63) * 64, idx2 & 7); } }
        v4u lgreg[2];
        if (PB) {
#pragma unroll
            for (int r = 0; r < 2; ++r) { const int e = tid + NTHR * r; lgreg[r] = *(const v4u*)(LG + (mrow0 + (e >> 4)) * DM + blk * 128 + (e & 15) * 8); } }
        for (int e = tid; e < 64 * 16; e += NTHR) { const int tl = e >> 4, c16 = e & 15;
            float y[8];
            { const f32x4 a = *(const LAS f32x4*)(L + O_CW + 4 * 512 + c16 * 32), bq = *(const LAS f32x4*)(L + O_CW + 4 * 512 + c16 * 32 + 16); y[0] = a[0]; y[1] = a[1]; y[2] = a[2]; y[3] = a[3]; y[4] = bq[0]; y[5] = bq[1]; y[6] = bq[2]; y[7] = bq[3]; }
#pragma unroll
            for (int jt = 0; jt < 4; ++jt) { const v4u r = *(const LAS v4u*)(L + O_A + (tl + jt) * 256 + c16 * 16);
                const f32x4 wa = *(const LAS f32x4*)(L + O_CW + jt * 512 + c16 * 32), wb = *(const LAS f32x4*)(L + O_CW + jt * 512 + c16 * 32 + 16);
                y[0] += wa[0] * bflo(r.x); y[1] += wa[1] * bfhi(r.x); y[2] += wa[2] * bflo(r.y); y[3] += wa[3] * bfhi(r.y);
                y[4] += wb[0] * bflo(r.z); y[5] += wb[1] * bfhi(r.z); y[6] += wb[2] * bflo(r.w); y[7] += wb[3] * bfhi(r.w); }
            *(LAS f32x4*)(L + O_XCF + tl * FST + c16 * 32) = (f32x4){y[0], y[1], y[2], y[3]};
            *(LAS f32x4*)(L + O_XCF + tl * FST + c16 * 32 + 16) = (f32x4){y[4], y[5], y[6], y[7]};
            v4u o; o.x = pk2(y[0], y[1]); o.y = pk2(y[2], y[3]); o.z = pk2(y[4], y[5]); o.w = pk2(y[6], y[7]);
            *(LAS v4u*)(L + O_XCB + tl * 272 + c16 * 16) = o; }
        __syncthreads();
        float carry0 = 0.f, carry1 = 0.f;
        if (carry_tab) { if (tid < 128) { const LAS float* CT = (const LAS float*)(L + O_CARRY); carry0 = CT[((b * 2 + (seg >> 5)) * 2 + 0) * 128 + tid]; carry1 = CT[((b * 2 + (seg >> 5)) * 2 + 1) * 128 + tid]; } }
        else if (PB && tid < 128) {
            const int ch = blk * 128 + tid;
            float h = 0.f;
            const f32x2* ag0 = AGG + ((size_t)(b * 64) * 2 + 0) * DM + ch; const f32x2* ag1 = AGG + ((size_t)(b * 64) * 2 + 1) * DM + ch;
            int js = 0;
            for (; js + 8 <= seg; js += 8) { f32x2 ah[8];
#pragma unroll
                for (int q = 0; q < 8; ++q) ah[q] = ag0[(size_t)(js + q) * 2 * DM];
#pragma unroll
                for (int q = 0; q < 8; ++q) h = ah[q][0] * h + ah[q][1]; }
            for (; js < seg; ++js) { const f32x2 ah = ag0[(size_t)js * 2 * DM]; h = ah[0] * h + ah[1]; }
            carry0 = h; h = 0.f;
            js = 63;
            for (; js - 8 >= seg; js -= 8) { f32x2 ah[8];
#pragma unroll
                for (int q = 0; q < 8; ++q) ah[q] = ag1[(size_t)(js - q) * 2 * DM];
#pragma unroll
                for (int q = 0; q < 8; ++q) h = ah[q][0] * h + ah[q][1]; }
            for (; js > seg; --js) { const f32x2 ah = ag1[(size_t)js * 2 * DM]; h = ah[0] * h + ah[1]; }
            carry1 = h;
        }
#pragma unroll
        for (int d = 0; d < 2; ++d) {
            const int o_a = (d == 0) ? O_A : O_XCF;
            f32x4 aR[4], aI[4];
#pragma unroll
            for (int mt = 0; mt < 4; ++mt) { aR[mt] = (f32x4){0.f, 0.f, 0.f, 0.f}; aI[mt] = (f32x4){0.f, 0.f, 0.f, 0.f}; }
#pragma unroll
            for (int ks = 0; ks < 4; ++ks)
#pragma unroll
                for (int mt = 0; mt < 4; ++mt) { const bf16x8 xb = *(const LAS bf16x8*)(L + O_XCB + (16 * mt + fr) * 272 + (32 * ks + 8 * fq) * 2);
                    aR[mt] = __builtin_amdgcn_mfma_f32_16x16x32_bf16(wf[d][0][ks], xb, aR[mt], 0, 0, 0);
                    aI[mt] = __builtin_amdgcn_mfma_f32_16x16x32_bf16(wf[d][1][ks], xb, aI[mt], 0, 0, 0); }
#pragma unroll
            for (int mt = 0; mt < 4; ++mt) { const int tl = 16 * mt + fr, cl = 16 * w + 4 * fq;
                const f32x4 xc = *(const LAS f32x4*)(L + O_XCF + tl * FST + cl * 4);
                f32x4 av, uv;
#pragma unroll
                for (int e = 0; e < 4; ++e) { const float r = sigmoidf_(aR[mt][e] + br4[d][e]), ig = sigmoidf_(aI[mt][e] + bi4[d][e]);
                    const float a_ = __builtin_amdgcn_exp2f(r * sp4[d][e]); av[e] = a_; uv[e] = __builtin_amdgcn_sqrtf(fmaxf(1.f - a_ * a_, 0.f)) * (ig * xc[e]); }
                *(LAS f32x4*)(L + o_a + tl * FST + cl * 4) = av; *(LAS f32x4*)(L + O_U + tl * FST + cl * 4) = uv; }
            __syncthreads();
            if (tid < 128) {
                LAS float* pa = (LAS float*)(L + o_a) + tid; const LAS float* pu = (const LAS float*)(L + O_U) + tid;
                if (!PB) {
                    float h = 0.f, A = 1.f;
#pragma unroll 8
                    for (int s2 = 0; s2 < 64; ++s2) { const int tl = d ? 63 - s2 : s2; const float a = pa[tl * 132], u = pu[tl * 132]; h = a * h + u; A *= a; }
                    AGG[((size_t)(b * 64 + seg) * 2 + d) * DM + blk * 128 + tid] = (f32x2){A, h};
                } else if (d == 0) {
                    float h = carry0;
#pragma unroll 8
                    for (int tl = 0; tl < 64; ++tl) { h = pa[tl * 132] * h + pu[tl * 132]; pa[tl * 132] = h; }
                } else {
                    float h = carry1;
                    LAS float* ph = (LAS float*)(L + O_A) + tid;
#pragma unroll 8
                    for (int s2 = 0; s2 < 64; ++s2) { const int tl = 63 - s2; h = pa[tl * 132] * h + pu[tl * 132]; ph[tl * 132] += h; }
                }
            }
            __syncthreads();
        }
        if (PB) {
#pragma unroll
            for (int r = 0; r < 2; ++r) { const int e = tid + NTHR * r, row = e >> 4, c16 = e & 15;
                const v4u g = lgreg[r];
                const f32x4 h0 = *(const LAS f32x4*)(L + O_A + row * FST + c16 * 32), h1 = *(const LAS f32x4*)(L + O_A + row * FST + c16 * 32 + 16);
                v4u o;
                o.x = pk2(h0[0] * gelu_fast(bflo(g.x)), h0[1] * gelu_fast(bfhi(g.x))); o.y = pk2(h0[2] * gelu_fast(bflo(g.y)), h0[3] * gelu_fast(bfhi(g.y)));
                o.z = pk2(h1[0] * gelu_fast(bflo(g.z)), h1[1] * gelu_fast(bfhi(g.z))); o.w = pk2(h1[2] * gelu_fast(bflo(g.w)), h1[3] * gelu_fast(bfhi(g.w)));
                *(v4u*)(YL + (mrow0 + row) * DM + blk * 128 + c16 * 8) = o; }
            __syncthreads();
        }
    }
#undef RAW_LOAD
}

__device__ __forceinline__ void mconv_phase(Frame& F) {
    const bf16* XM = (const bf16*)(F.ws + WS_XM); bf16* XC = (bf16*)(F.ws + WS_XL);
    const float* cw = F.in[4]; const float* cb = F.in[5];
    const int NT = MTOK / 32 * 128;
    for (int g = F.bid * NTHR + F.tid; g < NT; g += F.G * NTHR) {
        const int chunk = g & 127, run = g >> 7, c0 = chunk * 8, m0 = run * 32, t0 = m0 & (SEQ - 1);
        float w[4][8], bias[8];
#pragma unroll
        for (int j = 0; j < 4; ++j) { const f32x4 a = *(const f32x4*)(cw + j * DM + c0), b = *(const f32x4*)(cw + j * DM + c0 + 4);
            w[j][0] = a[0]; w[j][1] = a[1]; w[j][2] = a[2]; w[j][3] = a[3]; w[j][4] = b[0]; w[j][5] = b[1]; w[j][6] = b[2]; w[j][7] = b[3]; }
        { const f32x4 a = *(const f32x4*)(cb + c0), b = *(const f32x4*)(cb + c0 + 4);
            bias[0] = a[0]; bias[1] = a[1]; bias[2] = a[2]; bias[3] = a[3]; bias[4] = b[0]; bias[5] = b[1]; bias[6] = b[2]; bias[7] = b[3]; }
        v4u win[4];
        const v4u zero = {0u, 0u, 0u, 0u};
        win[0] = zero;
        win[1] = (t0 >= 2) ? *(const v4u*)(XM + (size_t)(m0 - 2) * DM + c0) : zero;
        win[2] = (t0 >= 1) ? *(const v4u*)(XM + (size_t)(m0 - 1) * DM + c0) : zero;
        win[3] = *(const v4u*)(XM + (size_t)m0 * DM + c0);
#pragma unroll 4
        for (int i = 0; i < 32; ++i) {
            win[0] = win[1]; win[1] = win[2]; win[2] = win[3];
            win[3] = (t0 + i + 1 < SEQ) ? *(const v4u*)(XM + (size_t)(m0 + i + 1) * DM + c0) : zero;
            float y[8];
#pragma unroll
            for (int e = 0; e < 8; ++e) y[e] = bias[e];
#pragma unroll
            for (int j = 0; j < 4; ++j) {
                const unsigned p0 = win[j].x, p1 = win[j].y, p2 = win[j].z, p3 = win[j].w;
                y[0] += w[j][0] * bflo(p0); y[1] += w[j][1] * bfhi(p0); y[2] += w[j][2] * bflo(p1); y[3] += w[j][3] * bfhi(p1);
                y[4] += w[j][4] * bflo(p2); y[5] += w[j][5] * bfhi(p2); y[6] += w[j][6] * bflo(p3); y[7] += w[j][7] * bfhi(p3);
            }
#pragma unroll
            for (int e = 0; e < 8; ++e) y[e] = y[e] * sigmoidf_(y[e]);
            v4u o; o.x = pk2(y[0], y[1]); o.y = pk2(y[2], y[3]); o.z = pk2(y[4], y[5]); o.w = pk2(y[6], y[7]);
            *(v4u*)(XC + (size_t)(m0 + i) * DM + c0) = o;
        }
    }
}

__device__ __forceinline__ void mscan_ref(Frame& F) {
    const bf16* Q = (const bf16*)(F.ws + WS_LG); const bf16* K = (const bf16*)(F.ws + WS_K); const bf16* V = (const bf16*)F.out + (size_t)MTOK * DM;
    const float* GT = (const float*)(F.ws + WS_GATE);
    LAS float* sq = (LAS float*)F.lds; LAS float* sk = sq + 256; LAS float* sv = sk + 256; LAS float* spart = sv + 32; LAS float* sdw = spart + 256;
    const int e = F.tid & 31, dg = F.tid >> 5;
    for (int item = F.bid; item < 512; item += F.G) {
        const int es = item & 7, dir = (item >> 3) & 1, h = (item >> 4) & 3, b = item >> 6;
        bf16* H = (bf16*)(F.ws + (dir ? WS_XL : WS_XM));
        float C[16];
#pragma unroll
        for (int j = 0; j < 16; ++j) C[j] = 0.f;
        float nreg = 0.f, mst = 0.f;
        for (int step = 0; step < SEQ; ++step) {
            const int t = dir ? (SEQ - 1 - step) : step;
            const size_t m = (size_t)b * SEQ + t, ro = m * DM + h * 256;
            if (F.tid < 256) { sq[F.tid] = bf2f(Q[ro + F.tid]); sk[F.tid] = bf2f(K[ro + F.tid]); }
            if (F.tid < 32) sv[F.tid] = bf2f(V[ro + es * 32 + F.tid]);
            const float ip = GT[m * 16 + (dir * 2 + 0) * 4 + h], fp = GT[m * 16 + (dir * 2 + 1) * 4 + h];
            const float logf = -softplusf_(-fp);
            const float mn = fmaxf(logf + mst, ip);
            const float fd = __expf(logf + mst - mn), iw = __expf(ip - mn);
            mst = mn;
            __syncthreads();
            const float ve = sv[e] * iw;
            float part = 0.f;
#pragma unroll
            for (int j = 0; j < 16; ++j) { const int d = dg * 16 + j; C[j] = fd * C[j] + sk[d] * ve; part += sq[d] * C[j]; }
            part += __shfl_xor(part, 32);
            if (F.lane < 32) spart[F.wave * 32 + e] = part;
            if (F.tid < 256) { nreg = fd * nreg + iw * sk[F.tid]; const float ds = wave_sum(nreg * sq[F.tid]); if (F.lane == 0) sdw[F.wave] = ds; }
            __syncthreads();
            if (F.tid < 32) {
                float num = 0.f;
#pragma unroll
                for (int w = 0; w < 8; ++w) num += spart[w * 32 + F.tid];
                const float den = sdw[0] + sdw[1] + sdw[2] + sdw[3];
                H[ro + es * 32 + F.tid] = (bf16)f2bf(num / fmaxf(fabsf(den), __expf(-mn)));
            }
        }
        __syncthreads();
    }
}


typedef short s16x4 __attribute__((ext_vector_type(4)));
__device__ __forceinline__ bf16x8 tr_read_pair(unsigned a0, unsigned a1) {
    s16x4 r0, r1;
    asm volatile("ds_read_b64_tr_b16 %0, %2\n\tds_read_b64_tr_b16 %1, %3\n\ts_waitcnt lgkmcnt(0)" : "=&v"(r0), "=&v"(r1) : "v"(a0), "v"(a1) : "memory");
    return __builtin_shufflevector(r0, r1, 0, 1, 2, 3, 4, 5, 6, 7);
}
__device__ __forceinline__ float wave_incl_sum(float x, int lane) {
#pragma unroll
    for (int o = 1; o < 64; o <<= 1) { const float t = __shfl_up(x, o); if (lane >= o) x += t; }
    return x;
}
__device__ __forceinline__ float wave_incl_max(float x, int lane) {
#pragma unroll
    for (int o = 1; o < 64; o <<= 1) { const float t = __shfl_up(x, o); if (lane >= o) x = fmaxf(x, t); }
    return x;
}
__device__ __forceinline__ void mscan_phase(Frame& F) {
    const bf16* Q = (const bf16*)(F.ws + WS_LG); const bf16* K = (const bf16*)(F.ws + WS_K); const bf16* V = (const bf16*)F.out + (size_t)MTOK * DM;
    const float* GT = (const float*)(F.ws + WS_GATE);
    constexpr int KS = 0, CTI = 33792, VT = 67584, VWT = 86016, PB = 104448, TAB = 113664, NT = 116736, NPART = 117760, DENT = 119808;
    constexpr int KST = 528, VST = 144, TABSZ = 1536;
    LAS unsigned char* L = F.lds;
    const int tid = F.tid, lane = F.lane, w = F.wave, fr = lane & 15, fq = lane >> 4, pt = w & 3, wg = w >> 2;
    for (int item = F.bid; item < 256; item += F.G) {
        const int es = item & 3, dir = (item >> 2) & 1, h = (item >> 3) & 3, b = item >> 5;
        bf16* H = (bf16*)(F.ws + (dir ? WS_XL : WS_XM));
        const size_t rowbase = (size_t)b * SEQ;
#define TOF(c, p) (dir ? (SEQ - 1 - 64 * (c) - (p)) : (64 * (c) + (p)))
        for (int e = tid; e < (33792 + 1024) / 4; e += NTHR) { if (e < 33792 / 4) ((LAS unsigned*)(L + CTI))[e] = 0u; else ((LAS unsigned*)(L + NT))[e - 33792 / 4] = 0u; }
        float m_run = 0.f;
        float gi_n = 0.f, gf_n = 0.f;
        if (w == 0) { const size_t m = rowbase + TOF(0, lane); gi_n = GT[m * 16 + dir * 8 + h]; gf_n = GT[m * 16 + dir * 8 + 4 + h]; }
#define G1_TABLES(setp) do { \
            const float logf_ = fminf(gf_n, 0.f) - __logf(1.f + __expf(-fabsf(gf_n))); const float b_ = wave_incl_sum(logf_, lane); const float a_ = gi_n - b_; \
            const float M_ = fmaxf(m_run, wave_incl_max(a_, lane)); const float Mend_ = __shfl(M_, 63), g_ = __shfl(b_, 63); \
            LAS float* T_ = (LAS float*)(setp); T_[lane] = a_; T_[64 + lane] = M_; T_[128 + lane] = __expf(m_run - M_); T_[192 + lane] = __expf(-(b_ + M_)); T_[256 + lane] = __expf(a_ - Mend_); \
            if (lane == 0) { T_[320] = __expf(m_run - Mend_); T_[321] = g_ + Mend_; } \
            m_run = g_ + Mend_; } while (0)
        if (w == 0) G1_TABLES(L + TAB);
        __syncthreads();
        bf16x8 qf[8];
        v4u kreg[4]; v4u vreg;
#define LOAD_KV(c) do { _Pragma("unroll") for (int r_ = 0; r_ < 4; ++r_) { const int i_ = tid + NTHR * r_, s_ = i_ >> 5, c16_ = i_ & 31; \
                kreg[r_] = *(const v4u*)(K + (rowbase + TOF(c, s_)) * DM + h * 256 + c16_ * 8); } \
            { const int s_ = tid & 63, e8_ = tid >> 6; vreg = *(const v4u*)(V + (rowbase + TOF(c, s_)) * DM + h * 256 + es * 64 + e8_ * 8); } } while (0)
#define STORE_KV(setidx) do { _Pragma("unroll") for (int r_ = 0; r_ < 4; ++r_) { const int i_ = tid + NTHR * r_, s_ = i_ >> 5, c16_ = i_ & 31; \
                *(LAS v4u*)(L + KS + s_ * KST + c16_ * 16) = kreg[r_]; } \
            { const int s_ = tid & 63, e8_ = tid >> 6; const float ws_ = ((const LAS float*)(L + TAB + (setidx) * TABSZ))[256 + s_]; \
              LAS bf16* vt_ = (LAS bf16*)(L + VT + (setidx) * 9216); LAS bf16* vw_ = (LAS bf16*)(L + VWT + (setidx) * 9216); \
              const unsigned wv_[4] = {vreg.x, vreg.y, vreg.z, vreg.w}; \
              _Pragma("unroll") for (int j_ = 0; j_ < 4; ++j_) { const float lo_ = bflo(wv_[j_]), hi_ = bfhi(wv_[j_]); const int e_ = e8_ * 8 + 2 * j_; \
                vt_[e_ * 72 + s_] = (bf16)(wv_[j_] & 0xffffu); vt_[(e_ + 1) * 72 + s_] = (bf16)(wv_[j_] >> 16); \
                vw_[e_ * 72 + s_] = (bf16)f2bf(lo_ * ws_); vw_[(e_ + 1) * 72 + s_] = (bf16)f2bf(hi_ * ws_); } } } while (0)
#define LOAD_Q(c) do { const size_t m_ = rowbase + TOF(c, 16 * pt + fr); _Pragma("unroll") for (int ks_ = 0; ks_ < 8; ++ks_) \
                qf[ks_] = *(const bf16x8*)(Q + m_ * DM + h * 256 + 32 * ks_ + 8 * fq); } while (0)
        LOAD_KV(0); LOAD_Q(0);
        STORE_KV(0);
        f32x4 Cacc[8];
#pragma unroll
        for (int i = 0; i < 8; ++i) Cacc[i] = (f32x4){0.f, 0.f, 0.f, 0.f};
        __syncthreads();
        for (int c = 0; c < 64; ++c) {
            const int cur = c & 1, nxt = cur ^ 1;
            const bool has_next = (c + 1 < 64);
            const LAS float* T = (const LAS float*)(L + TAB + cur * TABSZ);
            if (has_next) { LOAD_KV(c + 1); if (w == 0) { const size_t m = rowbase + TOF(c + 1, lane); gi_n = GT[m * 16 + dir * 8 + h]; gf_n = GT[m * 16 + dir * 8 + 4 + h]; } }
            const int p = 16 * pt + fr;
            const float Mp = T[64 + p], wi_p = T[128 + p];
            float cs = 0.f;
#pragma unroll
            for (int i = 0; i < 2; ++i) { const int st = 2 * wg + i;
                v2u pw = {0u, 0u};
                if (st <= pt) {
                    f32x4 sa = (f32x4){0.f, 0.f, 0.f, 0.f};
#pragma unroll
                    for (int ks = 0; ks < 8; ++ks) { const bf16x8 kf = *(const LAS bf16x8*)(L + KS + (16 * st + fr) * KST + (32 * ks + 8 * fq) * 2);
                        sa = __builtin_amdgcn_mfma_f32_16x16x32_bf16(kf, qf[ks], sa, 0, 0, 0); }
                    const f32x4 a4 = *(const LAS f32x4*)(T + 16 * st + 4 * fq);
                    float pv[4];
#pragma unroll
                    for (int r = 0; r < 4; ++r) { const int s_ = 16 * st + 4 * fq + r; const float wgt = (s_ <= p) ? __expf(a4[r] - Mp) : 0.f; pv[r] = sa[r] * wgt; cs += pv[r]; }
                    pw.x = pk2(pv[0], pv[1]); pw.y = pk2(pv[2], pv[3]);
                }
                *(LAS v2u*)(L + PB + p * VST + (16 * st + 4 * fq) * 2) = pw; }
            f32x4 O[2];
#pragma unroll
            for (int i = 0; i < 2; ++i) { const int et = 2 * wg + i; O[i] = (f32x4){0.f, 0.f, 0.f, 0.f};
#pragma unroll
                for (int ks = 0; ks < 8; ++ks) { const bf16x8 cf = *(const LAS bf16x8*)(L + CTI + (16 * et + fr) * KST + (32 * ks + 8 * fq) * 2);
                    O[i] = __builtin_amdgcn_mfma_f32_16x16x32_bf16(cf, qf[ks], O[i], 0, 0, 0); } }
            float di = 0.f;
#define DEN_INTER(ks) do { const f32x4 n0 = *(const LAS f32x4*)(L + NT + (32 * (ks) + 8 * fq) * 4), n1 = *(const LAS f32x4*)(L + NT + (32 * (ks) + 8 * fq) * 4 + 16); \
                const v4u qw = __builtin_bit_cast(v4u, qf[ks]); \
                di += bflo(qw.x) * n0[0] + bfhi(qw.x) * n0[1] + bflo(qw.y) * n0[2] + bfhi(qw.y) * n0[3] + bflo(qw.z) * n1[0] + bfhi(qw.z) * n1[1] + bflo(qw.w) * n1[2] + bfhi(qw.w) * n1[3]; } while (0)
            if (wg == 0) { DEN_INTER(0); DEN_INTER(1); DEN_INTER(2); DEN_INTER(3); }
            else { DEN_INTER(4); DEN_INTER(5); DEN_INTER(6); DEN_INTER(7); }
#undef DEN_INTER
            di += __shfl_xor(di, 16); di += __shfl_xor(di, 32);
            cs += __shfl_xor(cs, 16); cs += __shfl_xor(cs, 32);
            if (fq == 0) ((LAS float*)(L + DENT))[wg * 64 + p] = wi_p * di + cs;
            if (has_next) LOAD_Q(c + 1);
            if (has_next && w == 0) G1_TABLES(L + TAB + nxt * TABSZ);
            __syncthreads();
#pragma unroll
            for (int i = 0; i < 2; ++i) { const int et = 2 * wg + i; O[i] = O[i] * wi_p;
#pragma unroll
                for (int ks = 0; ks < 2; ++ks) { const bf16x8 vf = *(const LAS bf16x8*)(L + VT + cur * 9216 + (16 * et + fr) * VST + (32 * ks + 8 * fq) * 2);
                    const bf16x8 pf = *(const LAS bf16x8*)(L + PB + p * VST + (32 * ks + 8 * fq) * 2);
                    O[i] = __builtin_amdgcn_mfma_f32_16x16x32_bf16(vf, pf, O[i], 0, 0, 0); } }
            { const float den = ((const LAS float*)(L + DENT))[p] + ((const LAS float*)(L + DENT))[64 + p];
              const float inv = 1.f / fmaxf(fabsf(den), T[192 + p]);
              const size_t m = rowbase + TOF(c, p);
#pragma unroll
              for (int i = 0; i < 2; ++i) { const int et = 2 * wg + i; v2u o; o.x = pk2(O[i][0] * inv, O[i][1] * inv); o.y = pk2(O[i][2] * inv, O[i][3] * inv);
                  *(v2u*)(H + m * DM + h * 256 + es * 64 + 16 * et + 4 * fq) = o; } }
            { const float decay = T[320];
              const bf16x8 vw0 = *(const LAS bf16x8*)(L + VWT + cur * 9216 + (16 * pt + fr) * VST + (8 * fq) * 2);
              const bf16x8 vw1 = *(const LAS bf16x8*)(L + VWT + cur * 9216 + (16 * pt + fr) * VST + (32 + 8 * fq) * 2);
              const int l16 = lane & 15, q4 = l16 >> 2, p4 = l16 & 3;
              const unsigned kb = (unsigned)(uintptr_t)(L + KS) + (unsigned)((8 * fq + q4) * KST + 4 * p4 * 2);
#pragma unroll
              for (int dtl = 0; dtl < 8; dtl += 2) { const int dt = 8 * wg + dtl; const unsigned a0 = kb + dt * 32;
                  s16x4 r0, r1, r2, r3, r4, r5, r6, r7;
                  asm volatile("ds_read_b64_tr_b16 %0, %8\n\tds_read_b64_tr_b16 %1, %8 offset:2112\n\tds_read_b64_tr_b16 %2, %8 offset:16896\n\tds_read_b64_tr_b16 %3, %8 offset:19008\n\t"
                               "ds_read_b64_tr_b16 %4, %8 offset:32\n\tds_read_b64_tr_b16 %5, %8 offset:2144\n\tds_read_b64_tr_b16 %6, %8 offset:16928\n\tds_read_b64_tr_b16 %7, %8 offset:19040\n\ts_waitcnt lgkmcnt(0)"
                               : "=&v"(r0), "=&v"(r1), "=&v"(r2), "=&v"(r3), "=&v"(r4), "=&v"(r5), "=&v"(r6), "=&v"(r7) : "v"(a0) : "memory");
                  const bf16x8 k0 = __builtin_shufflevector(r0, r1, 0, 1, 2, 3, 4, 5, 6, 7), k1 = __builtin_shufflevector(r2, r3, 0, 1, 2, 3, 4, 5, 6, 7);
                  const bf16x8 k2 = __builtin_shufflevector(r4, r5, 0, 1, 2, 3, 4, 5, 6, 7), k3 = __builtin_shufflevector(r6, r7, 0, 1, 2, 3, 4, 5, 6, 7);
                  Cacc[dtl] = Cacc[dtl] * decay; Cacc[dtl + 1] = Cacc[dtl + 1] * decay;
                  Cacc[dtl] = __builtin_amdgcn_mfma_f32_16x16x32_bf16(k0, vw0, Cacc[dtl], 0, 0, 0);
                  Cacc[dtl + 1] = __builtin_amdgcn_mfma_f32_16x16x32_bf16(k2, vw0, Cacc[dtl + 1], 0, 0, 0);
                  Cacc[dtl] = __builtin_amdgcn_mfma_f32_16x16x32_bf16(k1, vw1, Cacc[dtl], 0, 0, 0);
                  Cacc[dtl + 1] = __builtin_amdgcn_mfma_f32_16x16x32_bf16(k3, vw1, Cacc[dtl + 1], 0, 0, 0); } }
            { const int d = tid & 255, hf2 = tid >> 8; float np = 0.f;
#pragma unroll 8
              for (int s2 = 0; s2 < 32; ++s2) { const int s_ = hf2 * 32 + s2; np += T[256 + s_] * bf2f(*(const LAS bf16*)(L + KS + s_ * KST + d * 2)); }
              ((LAS float*)(L + NPART))[hf2 * 256 + d] = np; }
            __syncthreads();
            { const float decay = T[320];
#pragma unroll
              for (int dtl = 0; dtl < 8; ++dtl) { const int dt = 8 * wg + dtl; v2u o; o.x = pk2(Cacc[dtl][0], Cacc[dtl][1]); o.y = pk2(Cacc[dtl][2], Cacc[dtl][3]);
                  *(LAS v2u*)(L + CTI + (16 * pt + fr) * KST + (16 * dt + 4 * fq) * 2) = o; }
              if (tid < 256) { LAS float* nt = (LAS float*)(L + NT); const LAS float* np = (const LAS float*)(L + NPART); nt[tid] = decay * nt[tid] + np[tid] + np[256 + tid]; } }
            if (has_next) STORE_KV(nxt);
            __syncthreads();
        }
#undef TOF
#undef G1_TABLES
#undef LOAD_KV
#undef STORE_KV
#undef LOAD_Q
    }
}

__device__ __forceinline__ void ym_phase(Frame& F) {
    const bf16* HF = (const bf16*)(F.ws + WS_XM); const bf16* HB = (const bf16*)(F.ws + WS_XL); bf16* OP = (bf16*)(F.ws + WS_OP);
    const float* ng = F.in[9];
    const int gw = F.bid * NWAVES + F.wave, NGW = F.G * NWAVES;
    for (int m = gw; m < MTOK; m += NGW) {
#pragma unroll
        for (int hd = 0; hd < 4; ++hd) {
            const size_t o = (size_t)m * DM + hd * 256 + F.lane * 4;
            const v2u a = *(const v2u*)(HF + o), b = *(const v2u*)(HB + o), op = *(const v2u*)(OP + o);
            const float v0 = bflo(a.x) + bflo(b.x), v1 = bfhi(a.x) + bfhi(b.x), v2 = bflo(a.y) + bflo(b.y), v3 = bfhi(a.y) + bfhi(b.y);
            const float r = rsqrtf(wave_sum((v0 * v0 + v1 * v1) + (v2 * v2 + v3 * v3)) * (1.f / 256.f) + EPS);
            const f32x4 g = *(const f32x4*)(ng + hd * 256 + F.lane * 4);
            v2u w; w.x = pk2(sigmoidf_(bflo(op.x)) * v0 * r * g[0], sigmoidf_(bfhi(op.x)) * v1 * r * g[1]);
            w.y = pk2(sigmoidf_(bflo(op.y)) * v2 * r * g[2], sigmoidf_(bfhi(op.y)) * v3 * r * g[3]);
            *(v2u*)(OP + o) = w;
        }
    }
    const int gt = F.bid * NTHR + F.tid, NGT = F.G * NTHR;
    const f32x4* us = (const f32x4*)F.in[23]; const f32x4* vs = (const f32x4*)F.in[24];
    v4u* ud = (v4u*)(F.ws + WS_LG); v4u* vd = (v4u*)(F.ws + WS_LG + 16 * MiB);
    for (int i = gt; i < NEXP * DM / 16; i += NGT) {
        v4u o, q;
#pragma unroll
        for (int j = 0; j < 4; ++j) { const f32x4 a = us[4 * i + j] * 32.f, b = vs[4 * i + j] * 4.f;
            int pa = 0, pb = 0;
            pa = __builtin_amdgcn_cvt_pk_fp8_f32(a[0], a[1], pa, false); pa = __builtin_amdgcn_cvt_pk_fp8_f32(a[2], a[3], pa, true);
            pb = __builtin_amdgcn_cvt_pk_fp8_f32(b[0], b[1], pb, false); pb = __builtin_amdgcn_cvt_pk_fp8_f32(b[2], b[3], pb, true);
            o[j] = (unsigned)pa; q[j] = (unsigned)pb; }
        ud[i] = o; vd[i] = q;
    }
}

__device__ __forceinline__ void select_ref(Frame& F) {
    const bf16* PQ = (const bf16*)(F.ws + WS_MG); const bf16* KEYS = (const bf16*)(F.ws + WS_KEYS);
    int* IDX = (int*)(F.ws + WS_K); float* GW = (float*)(F.ws + WS_K + 16 * MiB);
    LAS float* base = (LAS float*)(F.lds + F.wave * 2048);
    LAS float* sq = base;
    LAS float* sl = base + 256;
    LAS int* il = (LAS int*)(base + 288);
    LAS float* sbest = base + 320;
    LAS int* spos = (LAS int*)(base + 336);
    const int lane = F.lane;
    const int gw = F.bid * NWAVES + F.wave, NGW = F.G * NWAVES;
    for (int it = gw; it < MTOK * 8; it += NGW) {
        const int t = it >> 3, h = it & 7;
        { const v2u q4 = *(const v2u*)(PQ + (size_t)t * 2048 + h * 256 + lane * 4);
          sq[lane * 4 + 0] = bflo(q4.x); sq[lane * 4 + 1] = bfhi(q4.x); sq[lane * 4 + 2] = bflo(q4.y); sq[lane * 4 + 3] = bfhi(q4.y); }
        LDS_WAIT();
        for (int p = 0; p < 2; ++p) {
            float v0 = 0.f, v1 = 0.f;
            const v4u* k0 = (const v4u*)(KEYS + ((size_t)(h * 2 + p) * 128 + lane) * 128);
            const v4u* k1 = k0 + 64 * 16;
#pragma unroll 4
            for (int c8 = 0; c8 < 16; ++c8) {
                const v4u a = k0[c8], b = k1[c8];
                const f32x4 q0 = *(const LAS f32x4*)(sq + p * 128 + c8 * 8), q1 = *(const LAS f32x4*)(sq + p * 128 + c8 * 8 + 4);
                v0 += q0[0] * bflo(a.x) + q0[1] * bfhi(a.x) + q0[2] * bflo(a.y) + q0[3] * bfhi(a.y) + q1[0] * bflo(a.z) + q1[1] * bfhi(a.z) + q1[2] * bflo(a.w) + q1[3] * bfhi(a.w);
                v1 += q0[0] * bflo(b.x) + q0[1] * bfhi(b.x) + q0[2] * bflo(b.y) + q0[3] * bfhi(b.y) + q1[0] * bflo(b.z) + q1[1] * bfhi(b.z) + q1[2] * bflo(b.w) + q1[3] * bfhi(b.w);
            }
            for (int k = 0; k < 16; ++k) {
                float bv; int bi;
                if (v0 >= v1) { bv = v0; bi = lane; } else { bv = v1; bi = lane + 64; }
#pragma unroll
                for (int off = 32; off >= 1; off >>= 1) {
                    const float ov = __shfl_xor(bv, off); const int oi = __shfl_xor(bi, off);
                    if (ov > bv || (ov == bv && oi < bi)) { bv = ov; bi = oi; }
                }
                if (lane == 0) { sl[p * 16 + k] = bv; il[p * 16 + k] = bi; }
                if (bi == lane) v0 = -INFINITY;
                if (bi == lane + 64) v1 = -INFINITY;
            }
        }
        LDS_WAIT();
        float cv[4];
#pragma unroll
        for (int r = 0; r < 4; ++r) { const int pos = lane + 64 * r; cv[r] = sl[pos >> 4] + sl[16 + (pos & 15)]; }
        for (int k = 0; k < 16; ++k) {
            float bv = cv[0]; int bi = lane;
#pragma unroll
            for (int r = 1; r < 4; ++r) if (cv[r] > bv) { bv = cv[r]; bi = lane + 64 * r; }
#pragma unroll
            for (int off = 32; off >= 1; off >>= 1) {
                const float ov = __shfl_xor(bv, off); const int oi = __shfl_xor(bi, off);
                if (ov > bv || (ov == bv && oi < bi)) { bv = ov; bi = oi; }
            }
            if (lane == 0) { sbest[k] = bv; spos[k] = bi; }
#pragma unroll
            for (int r = 0; r < 4; ++r) if (bi == lane + 64 * r) cv[r] = -INFINITY;
        }
        LDS_WAIT();
        if (lane < 16) {
            const float mx = sbest[0];
            float sum = 0.f;
            for (int k = 0; k < 16; ++k) sum += __expf(sbest[k] - mx);
            const int pos = spos[lane];
            IDX[(size_t)t * 128 + h * 16 + lane] = il[pos >> 4] * 128 + il[16 + (pos & 15)];
            GW[(size_t)t * 128 + h * 16 + lane] = __expf(sbest[lane] - mx) / sum;
        }
        LDS_WAIT();
    }
}


typedef float f32x16 __attribute__((ext_vector_type(16)));
#define TOPK_INSERT(L, xv) do { const float x_ = (xv); \
    L[15] = __builtin_amdgcn_fmed3f(L[14], L[15], x_); L[14] = __builtin_amdgcn_fmed3f(L[13], L[14], x_); L[13] = __builtin_amdgcn_fmed3f(L[12], L[13], x_); L[12] = __builtin_amdgcn_fmed3f(L[11], L[12], x_); \
    L[11] = __builtin_amdgcn_fmed3f(L[10], L[11], x_); L[10] = __builtin_amdgcn_fmed3f(L[9], L[10], x_); L[9] = __builtin_amdgcn_fmed3f(L[8], L[9], x_); L[8] = __builtin_amdgcn_fmed3f(L[7], L[8], x_); \
    L[7] = __builtin_amdgcn_fmed3f(L[6], L[7], x_); L[6] = __builtin_amdgcn_fmed3f(L[5], L[6], x_); L[5] = __builtin_amdgcn_fmed3f(L[4], L[5], x_); L[4] = __builtin_amdgcn_fmed3f(L[3], L[4], x_); \
    L[3] = __builtin_amdgcn_fmed3f(L[2], L[3], x_); L[2] = __builtin_amdgcn_fmed3f(L[1], L[2], x_); L[1] = __builtin_amdgcn_fmed3f(L[0], L[1], x_); L[0] = fmaxf(L[0], x_); } while (0)
template <int I> struct CandRow {
    static __device__ __forceinline__ void run(const float (&L0)[16], const float (&L1)[16], float (&R)[16]) {
        constexpr int NJ = 16 / (I + 1);
#pragma unroll
        for (int j = 0; j < NJ; ++j) { const float sm = L0[I] + L1[j];
            const float pk = __builtin_bit_cast(float, (__builtin_bit_cast(unsigned, sm) & 0xffffff00u) | (unsigned)(I * 16 + j)); TOPK_INSERT(R, pk); }
        if constexpr (I < 15) CandRow<I + 1>::run(L0, L1, R);
    }
};
__device__ __forceinline__ unsigned pick4(unsigned d0, unsigned d1, unsigned d2, unsigned d3, int i) {
    const int q = i >> 2; unsigned d = d0; d = (q == 1) ? d1 : d; d = (q == 2) ? d2 : d; d = (q == 3) ? d3 : d; return (d >> (8 * (i & 3))) & 127u;
}
__device__ __forceinline__ void select_phase(Frame& F) {
    const bf16* PQ = (const bf16*)(F.ws + WS_MG); const bf16* KEYS = (const bf16*)(F.ws + WS_KEYS);
    int* IDX = (int*)(F.ws + WS_K); float* GW = (float*)(F.ws + WS_K + 16 * MiB);
    LAS unsigned char* L = F.lds;
    const int tid = F.tid, lane = F.lane, w = F.wave, l31 = lane & 31, hh = lane >> 5;
    const float NEG_INF = -INFINITY;
    for (int grp = F.bid; grp < MTOK / 128; grp += F.G) {
        const int tb = grp * 4 + (w & 3);
        const size_t m = (size_t)tb * 32 + l31;
        for (int hp = 0; hp < 4; ++hp) {
            __syncthreads();
#pragma unroll 4
            for (int r = 0; r < 16; ++r) { const int e = tid + NTHR * r, R = e >> 4, c = e & 15;
                *(LAS v4u*)(L + R * 256 + ((c ^ (R & 15)) * 16)) = *(const v4u*)(KEYS + ((size_t)(hp * 512 + R) * 128 + c * 8)); }
            __syncthreads();
            const int hl = w >> 2, h = 2 * hp + hl;
            float L0[16], L1[16];
#pragma unroll
            for (int p = 0; p < 2; ++p) {
                bf16x8 qf[8];
#pragma unroll
                for (int ks = 0; ks < 8; ++ks) qf[ks] = *(const bf16x8*)(PQ + m * 2048 + h * 256 + p * 128 + 16 * ks + 8 * hh);
                f32x16 acc[4];
#pragma unroll
                for (int kb = 0; kb < 4; ++kb)
#pragma unroll
                    for (int r = 0; r < 16; ++r) acc[kb][r] = 0.f;
#pragma unroll
                for (int ks = 0; ks < 8; ++ks)
#pragma unroll
                    for (int kb = 0; kb < 4; ++kb) { const int R = (hl * 2 + p) * 128 + 32 * kb + l31;
                        const bf16x8 kf = *(const LAS bf16x8*)(L + R * 256 + (((2 * ks + hh) ^ (lane & 15)) * 16));
                        acc[kb] = __builtin_amdgcn_mfma_f32_32x32x16_bf16(kf, qf[ks], acc[kb], 0, 0, 0); }
                float Lc[16];
#pragma unroll
                for (int i = 0; i < 16; ++i) Lc[i] = NEG_INF;
                const unsigned hh4 = (unsigned)hh << 2;
#pragma unroll
                for (int kb = 0; kb < 4; ++kb)
#pragma unroll
                    for (int r = 0; r < 16; ++r) { const unsigned nlo = (unsigned)(32 * kb + (r & 3) + 8 * (r >> 2));
                        const float av_ = acc[kb][r];
                        const float pk = __uint_as_float(((__float_as_uint(av_) & 0xffffff80u) | hh4) | nlo); TOPK_INSERT(Lc, pk); }
                float Lo[16];
#pragma unroll
                for (int i = 0; i < 16; ++i) Lo[i] = __shfl_xor(Lc[i], 32);
#pragma unroll
                for (int i = 0; i < 16; ++i) TOPK_INSERT(Lc, Lo[i]);
#pragma unroll
                for (int i = 0; i < 16; ++i) { if (p == 0) L0[i] = Lc[i]; else L1[i] = Lc[i]; }
            }
            float R[16];
#pragma unroll
            for (int i = 0; i < 16; ++i) R[i] = NEG_INF;
            CandRow<0>::run(L0, L1, R);
            unsigned a0 = 0, a1 = 0, a2 = 0, a3 = 0, b0 = 0, b1 = 0, b2 = 0, b3 = 0;
#pragma unroll
            for (int i = 0; i < 4; ++i) { a0 |= (__builtin_bit_cast(unsigned, L0[i]) & 127u) << (8 * i); a1 |= (__builtin_bit_cast(unsigned, L0[4 + i]) & 127u) << (8 * i);
                a2 |= (__builtin_bit_cast(unsigned, L0[8 + i]) & 127u) << (8 * i); a3 |= (__builtin_bit_cast(unsigned, L0[12 + i]) & 127u) << (8 * i);
                b0 |= (__builtin_bit_cast(unsigned, L1[i]) & 127u) << (8 * i); b1 |= (__builtin_bit_cast(unsigned, L1[4 + i]) & 127u) << (8 * i);
                b2 |= (__builtin_bit_cast(unsigned, L1[8 + i]) & 127u) << (8 * i); b3 |= (__builtin_bit_cast(unsigned, L1[12 + i]) & 127u) << (8 * i); }
            float ex[16]; float sum = 0.f; int id[16];
#pragma unroll
            for (int r = 0; r < 16; ++r) { ex[r] = __expf(R[r] - R[0]); sum += ex[r];
                const unsigned cid = __builtin_bit_cast(unsigned, R[r]) & 255u;
                id[r] = (int)(pick4(a0, a1, a2, a3, (int)(cid >> 4)) * 128u + pick4(b0, b1, b2, b3, (int)(cid & 15u))); }
            const float inv = 1.f / sum;
            if (hh == 0) {
#pragma unroll
                for (int q = 0; q < 4; ++q) {
                    *(int4*)(IDX + m * 128 + h * 16 + 4 * q) = make_int4(id[4 * q], id[4 * q + 1], id[4 * q + 2], id[4 * q + 3]);
                    *(f32x4*)(GW + m * 128 + h * 16 + 4 * q) = (f32x4){ex[4 * q] * inv, ex[4 * q + 1] * inv, ex[4 * q + 2] * inv, ex[4 * q + 3] * inv}; }
            }
        }
    }
}

__device__ __forceinline__ f32x2 fp8lo(unsigned w) { return __builtin_amdgcn_cvt_pk_f32_fp8((int)w, false); }
__device__ __forceinline__ f32x2 fp8hi(unsigned w) { return __builtin_amdgcn_cvt_pk_f32_fp8((int)w, true); }
__device__ __forceinline__ void apply_phase(Frame& F, float* OUTP) {
    const unsigned char* U8 = F.ws + WS_LG; const unsigned char* V8 = F.ws + WS_LG + 16 * MiB;
    const int* IDX = (const int*)(F.ws + WS_K); const float* GW = (const float*)(F.ws + WS_K + 16 * MiB);
    const float* g2 = F.in[20]; const float* gf = F.in[25];
    const float* X1 = F.out;
    const int lane = F.lane;
    const int gw = F.bid * NWAVES + F.wave, NGW = F.G * NWAVES;
    const bool b5 = (lane & 32) != 0, b4 = (lane & 16) != 0, b3 = (lane & 8) != 0, b2 = (lane & 4) != 0;
    const int eid = ((lane >> 5) & 1) * 8 + ((lane >> 4) & 1) * 4 + ((lane >> 3) & 1) * 2 + ((lane >> 2) & 1);
    for (int m = gw; m < MTOK; m += NGW) {
        f32x2 hv[8]; float s = 0.f;
#pragma unroll
        for (int q = 0; q < 4; ++q) { const f32x4 a = *(const f32x4*)(X1 + (size_t)m * DM + lane * 16 + q * 4);
            s += (a[0] * a[0] + a[1] * a[1]) + (a[2] * a[2] + a[3] * a[3]); hv[2 * q] = (f32x2){a[0], a[1]}; hv[2 * q + 1] = (f32x2){a[2], a[3]}; }
        const float r2 = rsqrtf(wave_sum(s) * (1.f / DM) + EPS) * (1.f / 32.f);
#pragma unroll
        for (int q = 0; q < 4; ++q) { const f32x4 g = *(const f32x4*)(g2 + lane * 16 + q * 4);
            hv[2 * q] = hv[2 * q] * (f32x2){g[0] * r2, g[1] * r2}; hv[2 * q + 1] = hv[2 * q + 1] * (f32x2){g[2] * r2, g[3] * r2}; }
        const int i0 = IDX[(size_t)m * 128 + lane], i1 = IDX[(size_t)m * 128 + 64 + lane];
        const float gw0 = GW[(size_t)m * 128 + lane], gw1 = GW[(size_t)m * 128 + 64 + lane];
        f32x2 acc[8];
#pragma unroll
        for (int i = 0; i < 8; ++i) acc[i] = (f32x2){0.f, 0.f};
#pragma unroll 1
        for (int bt = 0; bt < 8; ++bt) {
            const int k0 = bt * 16;
            const int isel = (k0 < 64) ? i0 : i1;
            v4u uu[16], vv[16];
#pragma unroll
            for (int e = 0; e < 16; ++e) { const size_t ro = (size_t)__builtin_amdgcn_readlane(isel, (k0 + e) & 63) * DM + lane * 16;
                uu[e] = *(const v4u*)(U8 + ro); vv[e] = *(const v4u*)(V8 + ro); }
            float x[16];
#pragma unroll
            for (int e = 0; e < 16; ++e) { f32x2 d = fp8lo(uu[e].x) * hv[0];
                d = __builtin_elementwise_fma(fp8hi(uu[e].x), hv[1], d); d = __builtin_elementwise_fma(fp8lo(uu[e].y), hv[2], d); d = __builtin_elementwise_fma(fp8hi(uu[e].y), hv[3], d);
                d = __builtin_elementwise_fma(fp8lo(uu[e].z), hv[4], d); d = __builtin_elementwise_fma(fp8hi(uu[e].z), hv[5], d); d = __builtin_elementwise_fma(fp8lo(uu[e].w), hv[6], d);
                d = __builtin_elementwise_fma(fp8hi(uu[e].w), hv[7], d); x[e] = d[0] + d[1]; }
            float y[8], z[4], u2[2], t;
#pragma unroll
            for (int j = 0; j < 8; ++j) { const float keep = b5 ? x[8 + j] : x[j], send = b5 ? x[j] : x[8 + j]; y[j] = keep + __shfl_xor(send, 32); }
#pragma unroll
            for (int j = 0; j < 4; ++j) { const float keep = b4 ? y[4 + j] : y[j], send = b4 ? y[j] : y[4 + j]; z[j] = keep + __shfl_xor(send, 16); }
#pragma unroll
            for (int j = 0; j < 2; ++j) { const float keep = b3 ? z[2 + j] : z[j], send = b3 ? z[j] : z[2 + j]; u2[j] = keep + __shfl_xor(send, 8); }
            { const float keep = b2 ? u2[1] : u2[0], send = b2 ? u2[0] : u2[1]; t = keep + __shfl_xor(send, 4); }
            t += __shfl_xor(t, 2); t += __shfl_xor(t, 1);
            const float gk = __shfl((k0 < 64) ? gw0 : gw1, (k0 + eid) & 63);
            const float wl = gk * gelu_fast(t) * 0.25f;
#pragma unroll
            for (int e = 0; e < 16; ++e) {
                const float we = __builtin_bit_cast(float, __builtin_amdgcn_readlane(__builtin_bit_cast(int, wl), 32 * (e >> 3) + 16 * ((e >> 2) & 1) + 8 * ((e >> 1) & 1) + 4 * (e & 1)));
                const f32x2 w2 = (f32x2){we, we};
                acc[0] = __builtin_elementwise_fma(fp8lo(vv[e].x), w2, acc[0]); acc[1] = __builtin_elementwise_fma(fp8hi(vv[e].x), w2, acc[1]);
                acc[2] = __builtin_elementwise_fma(fp8lo(vv[e].y), w2, acc[2]); acc[3] = __builtin_elementwise_fma(fp8hi(vv[e].y), w2, acc[3]);
                acc[4] = __builtin_elementwise_fma(fp8lo(vv[e].z), w2, acc[4]); acc[5] = __builtin_elementwise_fma(fp8hi(vv[e].z), w2, acc[5]);
                acc[6] = __builtin_elementwise_fma(fp8lo(vv[e].w), w2, acc[6]); acc[7] = __builtin_elementwise_fma(fp8hi(vv[e].w), w2, acc[7]);
            }
        }
        float s2 = 0.f;
#pragma unroll
        for (int q = 0; q < 4; ++q) { const f32x4 a = *(const f32x4*)(X1 + (size_t)m * DM + lane * 16 + q * 4);
            acc[2 * q] = acc[2 * q] + (f32x2){a[0], a[1]}; acc[2 * q + 1] = acc[2 * q + 1] + (f32x2){a[2], a[3]};
            s2 += (acc[2 * q][0] * acc[2 * q][0] + acc[2 * q][1] * acc[2 * q][1]) + (acc[2 * q + 1][0] * acc[2 * q + 1][0] + acc[2 * q + 1][1] * acc[2 * q + 1][1]); }
        const float rf = rsqrtf(wave_sum(s2) * (1.f / DM) + EPS);
#pragma unroll
        for (int q = 0; q < 4; ++q) { const f32x4 g = *(const f32x4*)(gf + lane * 16 + q * 4);
            *(f32x4*)(OUTP + (size_t)m * DM + lane * 16 + q * 4) = (f32x4){acc[2 * q][0] * rf * g[0], acc[2 * q][1] * rf * g[1], acc[2 * q + 1][0] * rf * g[2], acc[2 * q + 1][1] * rf * g[3]}; }
    }
}

constexpr int N_PHASES = 13;
__global__ void __launch_bounds__(NTHR, 2) mega_fwd(Args args) {
    extern __shared__ __attribute__((aligned(16))) unsigned char lds[];
    Frame F;
    F.lds = (LAS unsigned char*)lds;
    F.tid = threadIdx.x; F.lane = F.tid & 63; F.wave = __builtin_amdgcn_readfirstlane(F.tid >> 6);
    F.G = gridDim.x; F.bid = blockIdx.x;
    F.in = args.in; F.out = args.out; F.ws = args.ws;
    volatile LAS unsigned* MISC = (volatile LAS unsigned*)(F.lds + MISC_OFF);
    for (int u = F.tid; u < (LDS_BYTES - LDSCTL_OFF) / 4; u += NTHR) ((LAS unsigned*)(F.lds + LDSCTL_OFF))[u] = 0u;
    __syncthreads();
    XcdBarrier bar; bar.bar = (unsigned*)(args.ws + WS_CTL) + CW_BAR; bar.x = 0; bar.st = nullptr;
    const bool one_launch = (args.ph_hi - args.ph_lo) > 1;
    if (one_launch) bar = xcd_barrier_post((unsigned*)(args.ws + WS_CTL) + CW_BAR, MISC + 8);
    const int lo = args.ph_lo, hi = args.ph_hi;
#define IN(k) (lo <= (k) && (k) < hi)
#define SEAM(k) do { if (IN(k) && IN((k) + 1)) xcd_barrier(bar); } while (0)
    unsigned char* ws = args.ws;

#ifndef PROBE_MASK
#define PROBE_MASK 0
#endif
#define REP(k) _Pragma("unroll") for (int rep_ = 0; rep_ < (((PROBE_MASK >> (k)) & 1) ? 2 : 1); ++rep_)
    if (IN(0)) REP(0) { p0_prologue(F); if (rep_ == 0 && ((PROBE_MASK >> 0) & 1)) xcd_barrier(bar); } SEAM(0);
    if (IN(1)) REP(1) {
        AddrPlain g{(const char*)(ws + WS_K), (const char*)(ws + WS_WIN), 1024, 1024, 1024};
        pg8::StaticOrder S; S.init(MTOK, 6144, F.G, F.bid, 4);
        EpiBf16<DstP1> E{DstP1{ws}};
        gates_phase(F);
        pg8::gemm_phase(F.lds, g, S, E);
    } SEAM(1);
    if (IN(2)) REP(2) { lru_phase<false>(F); } SEAM(2);
    if (IN(3)) REP(3) { lru_phase<true>(F); } SEAM(3);
    if (IN(4)) REP(4) { mconv_phase(F); } SEAM(4);
    if (IN(5)) REP(5) {
        AddrQKV g{(const char*)(ws + WS_XL), (long)WS_XM - (long)WS_XL, (const char*)(ws + WS_WQKV), 1024, 256, 256};
        pg8::StaticOrder S; S.init(MTOK, 12 * 256, F.G, F.bid);
        EpiBf16<DstQKV> E{DstQKV{(char*)(ws + WS_LG), (long)WS_K - (long)WS_LG, (long)((char*)F.out + (size_t)MTOK * DM * 2 - (char*)(ws + WS_LG))}};
        pg8::gemm_phase(F.lds, g, S, E);
    } SEAM(5);
    if (IN(6)) REP(6) { mscan_phase(F); } SEAM(6);
    if (IN(7)) { ym_phase(F); } SEAM(7);
    if (IN(8)) {
        AddrBranch g{(const char*)(ws + WS_OP), (long)((const char*)F.out - (const char*)(ws + WS_OP)), (const char*)(ws + WS_WB2), 1024, 1024, 1024};
        pg8::StaticOrder S; S.init(MTOK, 2048, F.G, F.bid);
        EpiGate E{(bf16*)(ws + WS_MG)};
        pg8::gemm_phase(F.lds, g, S, E);
    } SEAM(8);
    if (IN(9)) {
        AddrPlain g{(const char*)(ws + WS_MG), (const char*)(ws + WS_WOUT2), 2048, 2048, 2048};
        pg8::StaticOrder S; S.init(MTOK, 1024, F.G, F.bid);
        EpiResid E{F.in[0], F.out, (bf16*)(ws + WS_XM), (float*)(ws + WS_SS)};
        pg8::gemm_phase(F.lds, g, S, E);
    } SEAM(9);
    if (IN(10)) REP(10) {
        AddrPlain g{(const char*)(ws + WS_XM), (const char*)(ws + WS_WPQ), 1024, 1024, 1024};
        pg8::StaticOrder S; S.init(MTOK, 2048, F.G, F.bid);
        EpiPQ E{(bf16*)(ws + WS_MG), (const float*)(ws + WS_SS)};
        pg8::gemm_phase(F.lds, g, S, E);
    } SEAM(10);
    if (IN(11)) REP(11) { select_phase(F); } SEAM(11);
    if (IN(12)) { if ((PROBE_MASK >> 12) & 1) { apply_phase(F, (float*)(ws + WS_MG)); xcd_barrier(bar); } apply_phase(F, F.out); }
#undef REP
#undef IN
#undef SEAM
}

extern "C" void kernel_launch(void* const* d_in, const int* in_sizes, int n_in, void* d_out, int out_size, void* d_ws, size_t ws_size, hipStream_t stream) {
    static int grid = 0;
    if (grid == 0) {
        if (n_in != 26 || in_sizes[0] != MTOK * DM || out_size != MTOK * DM || ws_size < WS_END) { fprintf(stderr, "kernel_launch: unexpected shapes / workspace (%zu < %zu)\n", ws_size, (size_t)WS_END); grid = -1; return; }
        int dev = 0, cus = 0, per_cu = 0;
        if (hipGetDevice(&dev) != hipSuccess || hipDeviceGetAttribute(&cus, hipDeviceAttributeMultiprocessorCount, dev) != hipSuccess) { grid = -1; return; }
        if (hipFuncSetAttribute((const void*)mega_fwd, hipFuncAttributeMaxDynamicSharedMemorySize, LDS_BYTES) != hipSuccess) { fprintf(stderr, "kernel_launch: hipFuncSetAttribute failed\n"); grid = -1; return; }
        if (hipOccupancyMaxActiveBlocksPerMultiprocessor(&per_cu, (const void*)mega_fwd, NTHR, LDS_BYTES) != hipSuccess || per_cu < 1) { fprintf(stderr, "kernel_launch: occupancy query says %d blocks/CU\n", per_cu); (void)hipGetLastError(); grid = -1; return; }
        grid = cus;
    }
    if (grid < 0) return;
    (void)hipMemsetAsync((char*)d_ws + WS_CTL, 0, CTL_ZERO_BYTES, stream);
    Args a{};
    for (int i = 0; i < 26; ++i) a.in[i] = (const float*)d_in[i];
    a.out = (float*)d_out; a.ws = (unsigned char*)d_ws;
#if MK_N_LAUNCHES == 1
    a.ph_lo = 0; a.ph_hi = N_PHASES;
    void* kargs[] = {&a};
    hipError_t e = hipLaunchCooperativeKernel((const void*)mega_fwd, dim3(grid), dim3(NTHR), kargs, LDS_BYTES, stream);
    if (e != hipSuccess) fprintf(stderr, "kernel_launch: cooperative launch failed: %s (grid %d)\n", hipGetErrorString(e), grid);
#else
    for (int p = 0; p < N_PHASES; ++p) { a.ph_lo = p; a.ph_hi = p + 1; hipLaunchKernelGGL(mega_fwd, dim3(grid), dim3(NTHR), LDS_BYTES, stream, a); }
#endif
}
```

```cpp
#include <hip/hip_runtime.h>
#include <cstdio>
#include <cstdint>
#include <math.h>

#ifndef MK_N_LAUNCHES
#define MK_N_LAUNCHES 1
#endif

constexpr int BATCH = 8, SEQ = 4096, DM = 1024, MTOK = BATCH * SEQ;
constexpr int DIN = 6160;
constexpr int NEXP = 16384;
constexpr float EPS = 1e-6f;

constexpr size_t MiB = 1u << 20;
constexpr size_t WS_CTL = 0, CTL_ZERO_BYTES = 1 * MiB;
constexpr size_t WS_WIN = 1 * MiB;
constexpr size_t WS_WQKV = 13 * MiB;
constexpr size_t WS_KEYS = 14 * MiB + 512 * 1024;
constexpr size_t WS_WLRU = 15 * MiB;
constexpr size_t WS_WB2 = 16 * MiB;
constexpr size_t WS_WOUT2 = 20 * MiB;
constexpr size_t WS_WPQ = 24 * MiB;
constexpr size_t WS_GATE = 28 * MiB;
constexpr size_t WS_WGT = 30 * MiB;
constexpr size_t WS_XM = 32 * MiB;
constexpr size_t WS_OP = 96 * MiB;
constexpr size_t WS_XL = 160 * MiB;
constexpr size_t WS_LG = 224 * MiB;
constexpr size_t WS_MG = 288 * MiB;
constexpr size_t WS_K = 416 * MiB;
constexpr size_t WS_AGG = 480 * MiB;
constexpr size_t WS_SS = 488 * MiB;
constexpr size_t WS_END = 489 * MiB;

constexpr int CW_BAR = 4096;

constexpr int RING_BYTES = 131072;
constexpr int LDS_BYTES = 147456;
constexpr int LDSCTL_OFF = LDS_BYTES - 512, MISC_OFF = LDSCTL_OFF + 320;
constexpr int NWAVES = 8, NTHR = 512;

#define GAS __attribute__((address_space(1)))
#define LAS __attribute__((address_space(3)))
typedef unsigned short bf16;
typedef unsigned v4u __attribute__((ext_vector_type(4)));
typedef unsigned v2u __attribute__((ext_vector_type(2)));
typedef float f32x4 __attribute__((ext_vector_type(4)));
typedef float f32x2 __attribute__((ext_vector_type(2)));
typedef short bf16x8 __attribute__((ext_vector_type(8)));
typedef GAS unsigned gu32;
#define RLX_AGENT __ATOMIC_RELAXED, __HIP_MEMORY_SCOPE_AGENT
#define LDS_WAIT() asm volatile("s_waitcnt lgkmcnt(0)" ::: "memory")
#define VM_WAIT() asm volatile("s_waitcnt vmcnt(0)" ::: "memory")

__device__ __forceinline__ unsigned f2bf(float f) { unsigned u = __builtin_bit_cast(unsigned, f); return (u + 0x7fffu + ((u >> 16) & 1u)) >> 16; }
__device__ __forceinline__ unsigned pk2(float lo, float hi) { return f2bf(lo) | (f2bf(hi) << 16); }
__device__ __forceinline__ float bf2f(unsigned short h) { return __builtin_bit_cast(float, (unsigned)h << 16); }
__device__ __forceinline__ float bflo(unsigned w) { return __builtin_bit_cast(float, w << 16); }
__device__ __forceinline__ float bfhi(unsigned w) { return __builtin_bit_cast(float, w & 0xffff0000u); }
__device__ __forceinline__ float wave_sum(float v) {
#pragma unroll
  for (int o = 1; o < 64; o <<= 1) v += __shfl_xor(v, o);
  return v;
}
__device__ __forceinline__ float sigmoidf_(float x) { return __builtin_amdgcn_rcpf(1.f + __builtin_amdgcn_exp2f(x * -1.44269504089f)); }
__device__ __forceinline__ float gelu_erf(float x) { return 0.5f * x * (1.f + erff(x * 0.70710678118654752f)); }
__device__ __forceinline__ float gelu_fast(float v) {
    const float av = fabsf(v), t = __builtin_amdgcn_rcpf(av * 0.2316418882f + 1.0f);
    float q = t * 0.5307027145f + (-0.7265760135f); q = q * t + 0.7107068705f; q = q * t + (-0.142248368f); q = q * t + 0.127414796f; q = q * t;
    const float e = __builtin_amdgcn_exp2f((v * v) * (-0.72134752044f));
    const float m = v * (q * e);
    return v < 0.f ? m : v - m;
}
__device__ __forceinline__ float softplusf_(float x) { return fmaxf(x, 0.f) + log1pf(expf(-fabsf(x))); }

namespace pg8 {
#define PG8_LAS __attribute__((address_space(3)))
typedef unsigned short bf16_t;
typedef unsigned u32x4 __attribute__((ext_vector_type(4)));
constexpr int BM = 256, BK = 64, HALF = 128, HTB = HALF * BK * 2, STAGE_BYTES = 8 * HTB, NXCD = 8;

__host__ __device__ __forceinline__ int lds_byte(int r, int c) { const int st = (r >> 4) * 2 + (c >> 5), rr = r & 15, cc = c & 31, ob = rr * 64 + cc * 2; return st * 1024 + (ob ^ (((ob >> 9) & 1) << 5)); }
__host__ __device__ __forceinline__ void stage_rc(int b, int& R, int& C) { const int st = b / 1024, sb = b % 1024, swz = sb ^ (((sb >> 9) & 1) << 5); R = (st >> 1) * 16 + swz / 64; C = (st & 1) * 32 + (swz % 64) / 2; }
__host__ __device__ __forceinline__ int perm32(int rho) { const int n = rho >> 4, i = rho & 15; return 8 * (i >> 2) + 4 * n + (i & 3); }

struct Unit { int pm, pn; };
struct StaticOrder {
    int nM, nN, nwg, G, c, WGM;
    __host__ __device__ void init(int M, int N, int G_, int c_, int wgm = 8) { nM = M / BM; nN = N / BM; nwg = nM * nN; G = G_; c = c_; WGM = wgm; }
    __host__ __device__ bool next(int i, Unit& u) const {
        const long L = (long)i * G + c; if (L >= nwg) return false;
        int wgid = (int)L; { const int q = nwg / NXCD, r = nwg % NXCD, xcd = wgid % NXCD, off = wgid / NXCD; wgid = (xcd < r ? xcd * (q + 1) : r * (q + 1) + (xcd - r) * q) + off; }
        const int nig = WGM * nN, gid = wgid / nig, fm = gid * WGM, gsz = (nM - fm) < WGM ? (nM - fm) : WGM;
        u.pm = fm + ((wgid % nig) % gsz); u.pn = (wgid % nig) / gsz; return true;
    }
};

__device__ __forceinline__ unsigned cvt_pk_bf16(float lo, float hi) { unsigned r; asm volatile("v_cvt_pk_bf16_f32 %0, %1, %2" : "=v"(r) : "v"(lo), "v"(hi)); return r; }

template <class Epi, class Addr>
__device__ __forceinline__ void gemm_phase(PG8_LAS unsigned char* lds, const Addr g, const StaticOrder& S, const Epi& E) {
    const int tid = threadIdx.x, wid = __builtin_amdgcn_readfirstlane(tid >> 6), lane = tid & 63, wr = wid >> 2, wc = wid & 3, fr = lane & 15, fq = lane >> 4;
    const int K = g.K, nt = K / BK;
    unsigned voffA[2], voffB[2];
#pragma unroll
    for (int i = 0; i < 2; ++i) { int R, C; stage_rc(tid * 16 + i * 8192, R, C); const int Rb = Epi::PERM ? ((R & ~31) + perm32(R & 31)) : R;
        voffA[i] = (unsigned)(R * g.lda + C) * 2u; voffB[i] = (unsigned)(Rb * g.ldb + C) * 2u; }
    const size_t kstep = (size_t)(BK * 2);
    const size_t hsA = (size_t)HALF * g.lda * 2, hsB = (size_t)HALF * g.ldb * 2;
    const unsigned ldsw = (unsigned)wid * 1024u;
    const int aoff = lds_byte(wr * 64 + fr, fq * 8), boff = lds_byte(wc * 32 + fr, fq * 8);
#define PG8_SA(b, h) (((b) * 2 + (h)) * HTB)
#define PG8_SB(b, h) ((4 + (b) * 2 + (h)) * HTB)
#define PG8_STAGE(bufoff, gbase, voff) do { _Pragma("unroll") for (int _i = 0; _i < 2; ++_i) \
        __builtin_amdgcn_global_load_lds((const unsigned*)((const char*)(gbase) + (voff)[_i]), (PG8_LAS unsigned*)(lds + (bufoff) + ldsw + _i * 8192), 16, 0, 0); } while (0)
#define PG8_LDA(dst, b, h) do { _Pragma("unroll") for (int m = 0; m < 4; ++m) _Pragma("unroll") for (int k = 0; k < 2; ++k) dst[m][k] = *(const PG8_LAS bf16x8*)(lds + PG8_SA(b, h) + aoff + m * 2048 + k * 1024); } while (0)
#define PG8_LDB(dst, b, h) do { _Pragma("unroll") for (int n = 0; n < 2; ++n) _Pragma("unroll") for (int k = 0; k < 2; ++k) dst[n][k] = *(const PG8_LAS bf16x8*)(lds + PG8_SB(b, h) + boff + n * 2048 + k * 1024); } while (0)
#define PG8_MMA(ai, bj, At, Bt) do { __builtin_amdgcn_s_setprio(1); _Pragma("unroll") for (int m = 0; m < 4; ++m) _Pragma("unroll") for (int n = 0; n < 2; ++n) _Pragma("unroll") for (int k = 0; k < 2; ++k) \
        acc[ai][bj][m][n] = __builtin_amdgcn_mfma_f32_16x16x32_bf16(Bt[n][k], At[m][k], acc[ai][bj][m][n], 0, 0, 0); __builtin_amdgcn_s_setprio(0); } while (0)
#define PG8_WAIT_V(n) asm volatile("s_waitcnt vmcnt(" #n ")" ::: "memory")
#define PG8_WAIT_L(n) asm volatile("s_waitcnt lgkmcnt(" #n ")" ::: "memory")
#define PG8_BAR __builtin_amdgcn_s_barrier()
#define PG8_SCHED __builtin_amdgcn_sched_barrier(0)
    Unit cur, nxt; int ui = 0;
    if (!S.next(0, cur)) return;
    f32x4 acc[2][2][4][2];
#pragma unroll
    for (int a = 0; a < 2; ++a)
#pragma unroll
        for (int b = 0; b < 2; ++b)
#pragma unroll
            for (int m = 0; m < 4; ++m)
#pragma unroll
                for (int n = 0; n < 2; ++n) acc[a][b][m][n] = (f32x4){0.f, 0.f, 0.f, 0.f};
    bf16x8 At[4][2], B0[2][2], B1[2][2];
    const char* cA = g.a(cur); const char* cB = g.b(cur);
    PG8_STAGE(PG8_SB(0, 0), cB, voffB); PG8_STAGE(PG8_SB(0, 1), cB + hsB, voffB); PG8_STAGE(PG8_SA(0, 0), cA, voffA); PG8_STAGE(PG8_SA(0, 1), cA + hsA, voffA);
    if (wr == 1) PG8_BAR;
    PG8_WAIT_V(2); PG8_BAR;
    PG8_STAGE(PG8_SB(1, 0), cB + kstep, voffB); PG8_STAGE(PG8_SA(1, 0), cA + kstep, voffA); PG8_STAGE(PG8_SB(1, 1), cB + hsB + kstep, voffB);
    PG8_WAIT_V(6); PG8_BAR;
    for (;;) {
        const bool has_next = S.next(ui + 1, nxt);
        const char* nA = has_next ? g.a(nxt) : cA; const char* nB = has_next ? g.b(nxt) : cB;
#pragma unroll 1
        for (int t = 0; t < nt; t += 2) {
            const bool last = (t == nt - 2);
            const char* a1 = cA + (size_t)(t + 1) * kstep;
            const char* a2 = last ? nA : cA + (size_t)(t + 2) * kstep; const char* b2 = last ? nB : cB + (size_t)(t + 2) * kstep;
            const char* a3 = a2 + kstep; const char* b3 = b2 + kstep;
            PG8_LDB(B0, 0, 0); PG8_LDB(B1, 0, 1); PG8_SCHED; PG8_LDA(At, 0, 0); PG8_STAGE(PG8_SA(1, 1), a1 + hsA, voffA);
            PG8_WAIT_V(8); PG8_WAIT_L(0); PG8_BAR; PG8_MMA(0, 0, At, B0); PG8_MMA(0, 1, At, B1); PG8_BAR; PG8_SCHED;
            PG8_LDA(At, 0, 1); PG8_STAGE(PG8_SB(0, 0), b2, voffB); PG8_STAGE(PG8_SB(0, 1), b2 + hsB, voffB); PG8_STAGE(PG8_SA(0, 0), a2, voffA);
            PG8_WAIT_V(8); PG8_WAIT_L(0); PG8_BAR; PG8_MMA(1, 0, At, B0); PG8_MMA(1, 1, At, B1); PG8_BAR; PG8_SCHED;
            PG8_LDB(B0, 1, 0); PG8_LDB(B1, 1, 1); PG8_SCHED; PG8_LDA(At, 1, 0); PG8_STAGE(PG8_SA(0, 1), a2 + hsA, voffA);
            PG8_WAIT_V(8); PG8_WAIT_L(0); PG8_BAR; PG8_MMA(0, 0, At, B0); PG8_MMA(0, 1, At, B1); PG8_BAR; PG8_SCHED;
            PG8_LDA(At, 1, 1); PG8_STAGE(PG8_SB(1, 0), b3, voffB); PG8_STAGE(PG8_SB(1, 1), b3 + hsB, voffB); PG8_STAGE(PG8_SA(1, 0), a3, voffA);
            PG8_WAIT_V(8); PG8_WAIT_L(0); PG8_BAR; PG8_MMA(1, 0, At, B0); PG8_MMA(1, 1, At, B1); PG8_BAR; PG8_SCHED;
        }
        if (wr == 0) PG8_BAR;
        E(acc, cur, wr, wc, fr, fq);
        if (!has_next) break;
#pragma unroll
        for (int a = 0; a < 2; ++a)
#pragma unroll
            for (int b = 0; b < 2; ++b)
#pragma unroll
                for (int m = 0; m < 4; ++m)
#pragma unroll
                    for (int n = 0; n < 2; ++n) acc[a][b][m][n] = (f32x4){0.f, 0.f, 0.f, 0.f};
        cur = nxt; cA = nA; cB = nB; ++ui;
        if (wr == 1) PG8_BAR;
    }
    PG8_WAIT_V(0);
    PG8_BAR;
#undef PG8_SA
#undef PG8_SB
#undef PG8_STAGE
#undef PG8_LDA
#undef PG8_LDB
#undef PG8_MMA
#undef PG8_WAIT_V
#undef PG8_WAIT_L
#undef PG8_BAR
#undef PG8_SCHED
}
}

#define XB_TMO      128
#define XB_XCNT(j)  (256  + 64 * (j))
#define XB_XSUB(j)  (1280 + 64 * (j))
#define XB_XGEN(j)  (2304 + 64 * (j))
#define XB_TOP      3328
#define XB_TOPGEN   3392
#define XCD_BAR_WORDS 3456
#define XB_SPIN_CAP (1u << 18)
__device__ __forceinline__ unsigned xb_ld(unsigned* p)              { return __hip_atomic_load(p, __ATOMIC_RELAXED, __HIP_MEMORY_SCOPE_AGENT); }
__device__ __forceinline__ unsigned xb_add(unsigned* p, unsigned v) { return __hip_atomic_fetch_add(p, v, __ATOMIC_RELAXED, __HIP_MEMORY_SCOPE_AGENT); }
__device__ __forceinline__ unsigned xb_xcc_id() { return (unsigned)__builtin_amdgcn_s_getreg((3 << 11) | 20) & 0xFu; }
#define XB_SPIN(cond, bar) do { unsigned _sp = 0; while (cond) { __builtin_amdgcn_s_sleep(1); \
    if ((++_sp & 255u) == 0u) { if (xb_ld(&(bar)[XB_TMO])) break; if (_sp > XB_SPIN_CAP) { atomicAdd(&(bar)[XB_TMO], 1u); break; } } } } while (0)
struct XcdBarrier { unsigned* bar; unsigned x; volatile LAS unsigned* st; };
__device__ __forceinline__ XcdBarrier xcd_barrier_post(unsigned* bar, volatile LAS unsigned* st) {
    XcdBarrier b; b.bar = bar; b.x = xb_xcc_id(); b.st = st;
    if (threadIdx.x == 0) (void)xb_add(&bar[XB_XCNT(b.x)], 1u);
    return b;
}
__device__ __forceinline__ void xcd_barrier_complete(unsigned* bar, unsigned x, unsigned& nloc, unsigned& nx) {
    const unsigned G = gridDim.x * gridDim.y * gridDim.z;
    unsigned sum, cnt, mine, sp = 0u;
    for (;;) {
        sum = 0u; cnt = 0u; mine = 0u;
#pragma unroll
        for (unsigned j = 0; j < 16; ++j) { const unsigned c = xb_ld(&bar[XB_XCNT(j)]); sum += c; cnt += (c > 0u) ? 1u : 0u; mine = (j == x) ? c : mine; }
        if (sum == G) break;
        __builtin_amdgcn_s_sleep(1);
        if ((++sp & 255u) == 0u) { if (xb_ld(&bar[XB_TMO])) break; if (sp > XB_SPIN_CAP) { atomicAdd(&bar[XB_TMO], 1u); break; } }
    }
    nloc = mine > 0u ? mine : 1u; nx = cnt > 0u ? cnt : 1u;
}
__device__ __forceinline__ void xcd_barrier(const XcdBarrier& b) {
    asm volatile("s_waitcnt vmcnt(0)" ::: "memory");
    __syncthreads();
    if (threadIdx.x == 0) {
        unsigned* bar = b.bar;
        __builtin_amdgcn_s_waitcnt(0);
        unsigned nloc = b.st[0], nx = b.st[1];
        if (nloc == 0u) { xcd_barrier_complete(bar, b.x, nloc, nx); b.st[0] = nloc; b.st[1] = nx; }
        const unsigned old = xb_add(&bar[XB_XSUB(b.x)], 1u);
        const unsigned gen = old / nloc;
        if (old + 1u == (gen + 1u) * nloc) {
            __builtin_amdgcn_fence(__ATOMIC_RELEASE, "agent");
            asm volatile("s_waitcnt vmcnt(0)" ::: "memory");
            const unsigned og = xb_add(&bar[XB_TOP], 1u);
            const unsigned tg = og / nx;
            if (og + 1u == (tg + 1u) * nx) xb_add(&bar[XB_TOPGEN], 1u);
            else XB_SPIN(xb_ld(&bar[XB_TOPGEN]) == tg, bar);
            __builtin_amdgcn_fence(__ATOMIC_ACQUIRE, "agent");
            xb_add(&bar[XB_XGEN(b.x)], 1u);
            asm volatile("s_waitcnt vmcnt(0)" ::: "memory");
        } else {
            XB_SPIN(xb_ld(&bar[XB_XGEN(b.x)]) == gen, bar);
            __builtin_amdgcn_fence(__ATOMIC_ACQUIRE, "agent");
            asm volatile("s_waitcnt vmcnt(0)" ::: "memory");
        }
    }
    __syncthreads();
}

struct Args { const float* in[26]; float* out; unsigned char* ws; int ph_lo, ph_hi; };
struct Frame {
    LAS unsigned char* lds;
    int tid, lane, wave, G, bid;
    const float* const* in; float* out; unsigned char* ws;
};

__device__ __forceinline__ void tr_item(const float* W, int ldw, bf16* WT, int ldt, float scale, const float* kscale, LAS float* scr, int k0, int lane) {
#pragma unroll 8
    for (int i = 0; i < 32; ++i) { const int kk = 2 * i + (lane >> 5); float v = W[(size_t)(k0 + kk) * ldw + (lane & 31)] * scale; if (kscale) v *= kscale[k0 + kk]; scr[kk * 33 + (lane & 31)] = v; }
    LDS_WAIT(); asm volatile("" ::: "memory");
    const int c = lane & 7;
#pragma unroll
    for (int j = 0; j < 4; ++j) { const int n = (lane >> 3) + 8 * j; const LAS float* s = scr + (8 * c) * 33 + n;
        v4u o; o.x = pk2(s[0 * 33], s[1 * 33]); o.y = pk2(s[2 * 33], s[3 * 33]); o.z = pk2(s[4 * 33], s[5 * 33]); o.w = pk2(s[6 * 33], s[7 * 33]);
        *(GAS v4u*)(WT + (size_t)n * ldt + k0 + 8 * c) = o; }
    LDS_WAIT(); asm volatile("" ::: "memory");
}

__device__ __forceinline__ void p0_prologue(Frame& F) {
    LAS float* scr = (LAS float*)(F.lds + F.wave * 16384);
    const int gw = F.bid * NWAVES + F.wave, NGW = F.G * NWAVES;
    unsigned char* ws = F.ws;
    const float* w_in = F.in[2];
    constexpr int I_WIN = 16 * 192, I_QKV = 12 * 32, I_LRU = 32 * 8, I_WB = 2 * 512, I_WO = 2 * 512, I_PQ = 16 * 64;
    constexpr int NITEMS = I_WIN + I_QKV + I_LRU + I_WB + I_WO + I_PQ;
    for (int it = gw; it < NITEMS; it += NGW) {
        int r = it;
        if (r < I_WIN) { const int kb = r / 192, nb = r % 192, n0 = nb * 32, sc = n0 < 2048 ? n0 : n0 + 16;
            tr_item(w_in + sc, DIN, (bf16*)(ws + WS_WIN) + (size_t)n0 * 1024, 1024, 1.f, nullptr, scr, kb * 64, F.lane); continue; }
        r -= I_WIN;
        if (r < I_QKV) { const int mat = r / 32, rr = r % 32, kb = rr / 8, nb = rr % 8, g = mat >> 2, h = mat & 3;
            const float* W = F.in[6 + g] + (size_t)h * 65536 + nb * 32;
            tr_item(W, 256, (bf16*)(ws + WS_WQKV) + (size_t)mat * 65536 + (size_t)(nb * 32) * 256, 256, g == 1 ? 0.0625f : 1.f, nullptr, scr, kb * 64, F.lane); continue; }
        r -= I_QKV;
        if (r < I_LRU) { const int mat = r / 8, rr = r % 8, kb = rr / 4, nb = rr % 4, gate = mat & 1, db = mat >> 1;
            const float* W = F.in[gate ? 14 : 12] + (size_t)db * 16384 + nb * 32;
            tr_item(W, 128, (bf16*)(ws + WS_WLRU) + (size_t)mat * 16384 + (size_t)(nb * 32) * 128, 128, 1.f, nullptr, scr, kb * 64, F.lane); continue; }
        r -= I_LRU;
        if (r < I_WB) { const int mat = r / 512, rr = r % 512, kb = rr / 32, nb = rr % 32;
            const float* W = F.in[17 + mat] + nb * 32;
            tr_item(W, 1024, (bf16*)(ws + WS_WB2) + (size_t)(mat * 1024 + nb * 32) * 1024, 1024, 1.f, nullptr, scr, kb * 64, F.lane); continue; }
        r -= I_WB;
        if (r < I_WO) { const int cp = r / 512, rr = r % 512, kb = rr / 32, nb = rr % 32;
            const float* W = F.in[19] + nb * 32;
            tr_item(W, 1024, (bf16*)(ws + WS_WOUT2) + (size_t)(nb * 32) * 2048 + cp * 1024, 2048, 1.f, nullptr, scr, kb * 64, F.lane); continue; }
        r -= I_WO;
        { const int kb = r / 64, nb = r % 64;
            const float* W = F.in[21] + nb * 32;
            tr_item(W, 2048, (bf16*)(ws + WS_WPQ) + (size_t)(nb * 32) * 1024, 1024, 1.f, F.in[20], scr, kb * 64, F.lane); }
    }
    { const int gt = F.bid * NTHR + F.tid, NGT = F.G * NTHR;
      const float4* ks = (const float4*)F.in[22]; v2u* kd = (v2u*)(ws + WS_KEYS);
      for (int i = gt; i < 8 * 2 * 128 * 128 / 4; i += NGT) { const float4 v = ks[i]; v2u o; o.x = pk2(v.x, v.y); o.y = pk2(v.z, v.w); kd[i] = o; }
      float* ss = (float*)(ws + WS_SS);
      for (int i = gt; i < MTOK; i += NGT) ss[i] = 0.f; }
    { const int gt = F.bid * NTHR + F.tid;
      if (gt < 16 * 128) { const int c = gt >> 7, k8 = gt & 127; v4u o; unsigned wv[4];
#pragma unroll
          for (int j = 0; j < 4; ++j) wv[j] = pk2(w_in[(size_t)(k8 * 8 + 2 * j) * DIN + 2048 + c], w_in[(size_t)(k8 * 8 + 2 * j + 1) * DIN + 2048 + c]);
          o.x = wv[0]; o.y = wv[1]; o.z = wv[2]; o.w = wv[3]; *(v4u*)((bf16*)(ws + WS_WGT) + c * 1024 + k8 * 8) = o; } }
    const float* x = F.in[0]; const float* g1 = F.in[1];
    bf16* XN = (bf16*)(ws + WS_K);
    f32x4 gv[4];
#pragma unroll
    for (int j = 0; j < 4; ++j) gv[j] = ((const f32x4*)g1)[F.lane + 64 * j];
    for (int m = 2 * gw; m < MTOK; m += 2 * NGW) {
        const f32x4* xr0 = (const f32x4*)(x + (size_t)m * DM) + F.lane; const f32x4* xr1 = xr0 + DM / 4;
        f32x4 v0[4], v1[4]; float s0 = 0.f, s1 = 0.f;
#pragma unroll
        for (int j = 0; j < 4; ++j) { v0[j] = xr0[64 * j]; v1[j] = xr1[64 * j]; }
#pragma unroll
        for (int j = 0; j < 4; ++j) { s0 += (v0[j].x * v0[j].x + v0[j].y * v0[j].y) + (v0[j].z * v0[j].z + v0[j].w * v0[j].w); s1 += (v1[j].x * v1[j].x + v1[j].y * v1[j].y) + (v1[j].z * v1[j].z + v1[j].w * v1[j].w); }
        const float r0 = rsqrtf(wave_sum(s0) * (1.f / DM) + EPS), r1 = rsqrtf(wave_sum(s1) * (1.f / DM) + EPS);
        unsigned long long* o0 = (unsigned long long*)(XN + (size_t)m * DM) + F.lane; unsigned long long* o1 = o0 + DM / 4;
#pragma unroll
        for (int j = 0; j < 4; ++j) { const f32x4 a = v0[j] * r0 * gv[j], c = v1[j] * r1 * gv[j];
            o0[64 * j] = (unsigned long long)pk2(a.x, a.y) | ((unsigned long long)pk2(a.z, a.w) << 32);
            o1[64 * j] = (unsigned long long)pk2(c.x, c.y) | ((unsigned long long)pk2(c.z, c.w) << 32); }
    }
}
__device__ __forceinline__ void gates_phase(Frame& F) {
    const bf16* XN = (const bf16*)(F.ws + WS_K); const bf16* WGT = (const bf16*)(F.ws + WS_WGT); float* GT = (float*)(F.ws + WS_GATE);
    const int lane = F.lane, fr = lane & 15, fq = lane >> 4;
    const f32x4 bg4 = *(const f32x4*)(F.in[3] + 4 * fq);
    for (int task = F.bid * NWAVES + F.wave; task < MTOK / 16; task += F.G * NWAVES) {
        const size_t m0 = (size_t)task * 16;
        f32x4 acc = (f32x4){0.f, 0.f, 0.f, 0.f};
#pragma unroll 8
        for (int ks = 0; ks < 32; ++ks) {
            const bf16x8 wfr = *(const bf16x8*)(WGT + fr * 1024 + 32 * ks + 8 * fq);
            const bf16x8 xfr = *(const bf16x8*)(XN + (m0 + fr) * DM + 32 * ks + 8 * fq);
            acc = __builtin_amdgcn_mfma_f32_16x16x32_bf16(wfr, xfr, acc, 0, 0, 0);
        }
        *(f32x4*)(GT + (m0 + fr) * 16 + 4 * fq) = acc + bg4;
    }
}

struct AddrPlain {
    const char* A; const char* Bt; int lda, ldb, K;
    __device__ __forceinline__ const char* a(const pg8::Unit& u) const { return A + (size_t)u.pm * 256 * lda * 2; }
    __device__ __forceinline__ const char* b(const pg8::Unit& u) const { return Bt + (size_t)u.pn * 256 * ldb * 2; }
};
struct AddrQKV {
    const char* XC; long dXM; const char* W; int lda, ldb, K;
    __device__ __forceinline__ const char* a(const pg8::Unit& u) const { return XC + (u.pn < 8 ? 0l : dXM) + ((size_t)u.pm * 256 * 1024 + (u.pn & 3) * 256) * 2; }
    __device__ __forceinline__ const char* b(const pg8::Unit& u) const { return W + (size_t)u.pn * 65536 * 2; }
};
struct AddrBranch {
    const char* YM; long dYL; const char* W; int lda, ldb, K;
    __device__ __forceinline__ const char* a(const pg8::Unit& u) const { return YM + (u.pn < 4 ? 0l : dYL) + (size_t)u.pm * 256 * 1024 * 2; }
    __device__ __forceinline__ const char* b(const pg8::Unit& u) const { return W + (size_t)u.pn * 256 * 1024 * 2; }
};

struct DstP1 { unsigned char* ws;
    __device__ __forceinline__ bf16* get(int pn, int& ld, int& col0) const {
        const bool mg = pn >= 16; ld = mg ? 2048 : 1024; col0 = mg ? (pn - 16) * 256 : (pn & 3) * 256;
        return (bf16*)(ws + (mg ? WS_MG : WS_XM + (size_t)(pn >> 2) * 64 * MiB)); } };
struct DstQKV { char* q; long dk, dv;
    __device__ __forceinline__ bf16* get(int pn, int& ld, int& col0) const { ld = 1024; col0 = (pn & 3) * 256; return (bf16*)(q + (pn >= 4 ? (pn >= 8 ? dv : dk) : 0l)); } };
template <class Dst> struct EpiBf16 {
    static constexpr bool PERM = true;
    Dst dst;
    __device__ __forceinline__ void operator()(const f32x4 (&acc)[2][2][4][2], const pg8::Unit& u, int wr, int wc, int fr, int fq) const {
        int ld, colt; bf16* base = dst.get(u.pn, ld, colt);
        const int row0 = u.pm * 256 + wr * 64 + fr, col0 = colt + wc * 32 + 8 * fq;
#pragma unroll
        for (int ai = 0; ai < 2; ++ai)
#pragma unroll
            for (int m = 0; m < 4; ++m) { bf16* rowp = base + (size_t)(row0 + ai * 128 + m * 16) * ld + col0;
#pragma unroll
                for (int bj = 0; bj < 2; ++bj) { const f32x4 v0 = acc[ai][bj][m][0], v1 = acc[ai][bj][m][1];
                    v4u w; w.x = pg8::cvt_pk_bf16(v0[0], v0[1]); w.y = pg8::cvt_pk_bf16(v0[2], v0[3]); w.z = pg8::cvt_pk_bf16(v1[0], v1[1]); w.w = pg8::cvt_pk_bf16(v1[2], v1[3]);
                    *(v4u*)(rowp + bj * 128) = w; } }
    }
};
struct EpiGate {
    static constexpr bool PERM = true;
    bf16* G;
    __device__ __forceinline__ void operator()(const f32x4 (&acc)[2][2][4][2], const pg8::Unit& u, int wr, int wc, int fr, int fq) const {
        const int row0 = u.pm * 256 + wr * 64 + fr, col0 = u.pn * 256 + wc * 32 + 8 * fq;
#pragma unroll
        for (int ai = 0; ai < 2; ++ai)
#pragma unroll
            for (int m = 0; m < 4; ++m) { bf16* rowp = G + (size_t)(row0 + ai * 128 + m * 16) * 2048 + col0;
#pragma unroll
                for (int bj = 0; bj < 2; ++bj) { const f32x4 v0 = acc[ai][bj][m][0], v1 = acc[ai][bj][m][1];
                    const v4u g = *(const v4u*)(rowp + bj * 128);
                    v4u w;
                    w.x = pg8::cvt_pk_bf16(v0[0] * sigmoidf_(bflo(g.x)), v0[1] * sigmoidf_(bfhi(g.x)));
                    w.y = pg8::cvt_pk_bf16(v0[2] * sigmoidf_(bflo(g.y)), v0[3] * sigmoidf_(bfhi(g.y)));
                    w.z = pg8::cvt_pk_bf16(v1[0] * sigmoidf_(bflo(g.z)), v1[1] * sigmoidf_(bfhi(g.z)));
                    w.w = pg8::cvt_pk_bf16(v1[2] * sigmoidf_(bflo(g.w)), v1[3] * sigmoidf_(bfhi(g.w)));
                    *(v4u*)(rowp + bj * 128) = w; } }
    }
};
struct EpiResid {
    static constexpr bool PERM = false;
    const float* x; float* x1; bf16* x1b; float* ss;
    __device__ __forceinline__ void operator()(const f32x4 (&acc)[2][2][4][2], const pg8::Unit& u, int wr, int wc, int fr, int fq) const {
        const int row0 = u.pm * 256 + wr * 64 + fr, col0 = u.pn * 256 + wc * 32 + 4 * fq;
#pragma unroll
        for (int ai = 0; ai < 2; ++ai)
#pragma unroll
            for (int m = 0; m < 4; ++m) { const int row = row0 + ai * 128 + m * 16; const size_t off = (size_t)row * DM + col0; float s = 0.f;
#pragma unroll
                for (int bj = 0; bj < 2; ++bj)
#pragma unroll
                    for (int n = 0; n < 2; ++n) { const size_t o = off + bj * 128 + n * 16; const f32x4 v = *(const f32x4*)(x + o) + acc[ai][bj][m][n];
                        *(f32x4*)(x1 + o) = v; v2u w; w.x = pg8::cvt_pk_bf16(v[0], v[1]); w.y = pg8::cvt_pk_bf16(v[2], v[3]); *(v2u*)(x1b + o) = w;
                        s += (v[0] * v[0] + v[1] * v[1]) + (v[2] * v[2] + v[3] * v[3]); }
                s += __shfl_xor(s, 16); s += __shfl_xor(s, 32);
                if (fq == 0) atomicAdd(ss + row, s); }
    }
};
struct EpiPQ {
    static constexpr bool PERM = true;
    bf16* pq; const float* ss;
    __device__ __forceinline__ void operator()(const f32x4 (&acc)[2][2][4][2], const pg8::Unit& u, int wr, int wc, int fr, int fq) const {
        const int row0 = u.pm * 256 + wr * 64 + fr, col0 = u.pn * 256 + wc * 32 + 8 * fq;
#pragma unroll
        for (int ai = 0; ai < 2; ++ai)
#pragma unroll
            for (int m = 0; m < 4; ++m) { const int row = row0 + ai * 128 + m * 16; bf16* rowp = pq + (size_t)row * 2048 + col0;
                const float r = rsqrtf(ss[row] * (1.f / DM) + EPS);
#pragma unroll
                for (int bj = 0; bj < 2; ++bj) { const f32x4 v0 = acc[ai][bj][m][0] * r, v1 = acc[ai][bj][m][1] * r;
                    v4u w; w.x = pg8::cvt_pk_bf16(v0[0], v0[1]); w.y = pg8::cvt_pk_bf16(v0[2], v0[3]); w.z = pg8::cvt_pk_bf16(v1[0], v1[1]); w.w = pg8::cvt_pk_bf16(v1[2], v1[3]);
                    *(v4u*)(rowp + bj * 128) = w; } }
    }
};

__device__ __forceinline__ void lru_ref(Frame& F) {
    const bf16* XL = (const bf16*)(F.ws + WS_XL); const bf16* LG = (const bf16*)(F.ws + WS_LG); bf16* YL = (bf16*)F.out;
    const bf16* WL = (const bf16*)(F.ws + WS_WLRU);
    const float* cw = F.in[10]; const float* cb = F.in[11];
    LAS float* sxc = (LAS float*)F.lds;
    LAS float* sp = (LAS float*)(F.lds + 1024);
    const int c = F.tid & 127, part = F.tid >> 7;
    for (int item = F.bid; item < 64; item += F.G) {
        const int b = item >> 3, blk = item & 7, ch = blk * 128 + c;
        const float w0 = cw[0 * DM + ch], w1 = cw[1 * DM + ch], w2 = cw[2 * DM + ch], w3 = cw[3 * DM + ch], bb = cb[ch];
        for (int dir = 0; dir < 2; ++dir) {
            v4u wr[4], wi[4];
            { const v4u* pr = (const v4u*)(WL + ((size_t)((dir * 8 + blk) * 2 + 0) * 128 + c) * 128 + part * 32);
              const v4u* pi = (const v4u*)(WL + ((size_t)((dir * 8 + blk) * 2 + 1) * 128 + c) * 128 + part * 32);
#pragma unroll
              for (int q = 0; q < 4; ++q) { wr[q] = pr[q]; wi[q] = pi[q]; } }
            const float br = F.in[13][dir * DM + ch], bi = F.in[15][dir * DM + ch];
            const float spl = softplusf_(-F.in[16][dir * DM + ch]);
            float h = 0.f;
            for (int step = 0; step < SEQ; ++step) {
                const int t = dir ? (SEQ - 1 - step) : step;
                const size_t m = (size_t)b * SEQ + t;
                float xc = 0.f;
                if (part == 0) {
                    xc = bb;
                    if (t >= 2) xc += w0 * bf2f(XL[(m - 2) * DM + ch]);
                    if (t >= 1) xc += w1 * bf2f(XL[(m - 1) * DM + ch]);
                    xc += w2 * bf2f(XL[m * DM + ch]);
                    if (t + 1 < SEQ) xc += w3 * bf2f(XL[(m + 1) * DM + ch]);
                    sxc[c] = xc;
                }
                __syncthreads();
                float pr_ = 0.f, pi_ = 0.f;
#pragma unroll
                for (int q = 0; q < 4; ++q) {
                    const f32x4 x0 = *(const LAS f32x4*)(sxc + part * 32 + q * 8), x1 = *(const LAS f32x4*)(sxc + part * 32 + q * 8 + 4);
                    pr_ += x0[0] * bflo(wr[q].x) + x0[1] * bfhi(wr[q].x) + x0[2] * bflo(wr[q].y) + x0[3] * bfhi(wr[q].y)
                         + x1[0] * bflo(wr[q].z) + x1[1] * bfhi(wr[q].z) + x1[2] * bflo(wr[q].w) + x1[3] * bfhi(wr[q].w);
                    pi_ += x0[0] * bflo(wi[q].x) + x0[1] * bfhi(wi[q].x) + x0[2] * bflo(wi[q].y) + x0[3] * bfhi(wi[q].y)
                         + x1[0] * bflo(wi[q].z) + x1[1] * bfhi(wi[q].z) + x1[2] * bflo(wi[q].w) + x1[3] * bfhi(wi[q].w);
                }
                sp[(part * 2 + 0) * 128 + c] = pr_; sp[(part * 2 + 1) * 128 + c] = pi_;
                __syncthreads();
                if (part == 0) {
                    const float rp = sp[0 * 128 + c] + sp[2 * 128 + c] + sp[4 * 128 + c] + sp[6 * 128 + c] + br;
                    const float ip = sp[1 * 128 + c] + sp[3 * 128 + c] + sp[5 * 128 + c] + sp[7 * 128 + c] + bi;
                    const float r = sigmoidf_(rp), ig = sigmoidf_(ip);
                    const float log_a = -8.f * r * spl;
                    const float a = __expf(log_a);
                    const float u = sqrtf(-expm1f(2.f * log_a)) * (ig * xc);
                    h = a * h + u;
                    if (dir == 0) YL[m * DM + ch] = (bf16)f2bf(h);
                    else { const float y = (bf2f(YL[m * DM + ch]) + h) * gelu_erf(bf2f(LG[m * DM + ch])); YL[m * DM + ch] = (bf16)f2bf(y); }
                }
            }
            __syncthreads();
        }
    }
}


template <bool PB> __device__ __forceinline__ void lru_phase(Frame& F) {
    const bf16* XL = (const bf16*)(F.ws + WS_XL); const bf16* LG = (const bf16*)(F.ws + WS_LG); bf16* YL = (bf16*)F.out;
    f32x2* AGG = (f32x2*)(F.ws + WS_AGG);
    const bf16* WL = (const bf16*)(F.ws + WS_WLRU);
    const float* cw = F.in[10]; const float* cb = F.in[11];
    constexpr int O_XCB = 0, O_XCF = 17408, O_A = 51200, O_U = 84992, FST = 528;
    LAS unsigned char* L = F.lds;
    const int tid = F.tid, lane = F.lane, w = F.wave, fr = lane & 15, fq = lane >> 4;
    int cur_blk = -1;
    bf16x8 wf[2][2][4];
    f32x4 br4[2], bi4[2], sp4[2];
    v4u rawreg[3];
#define RAW_LOAD(bb, tt0, bk) do { _Pragma("unroll") for (int r_ = 0; r_ < 3; ++r_) { const int e_ = tid + NTHR * r_, row_ = e_ >> 4, c16_ = e_ & 15, t_ = (tt0) - 2 + row_; \
            v4u v_ = {0u, 0u, 0u, 0u}; if (e_ < 68 * 16 && t_ >= 0 && t_ < SEQ) v_ = *(const v4u*)(XL + ((size_t)(bb) * SEQ + t_) * DM + (bk) * 128 + c16_ * 8); rawreg[r_] = v_; } } while (0)
    constexpr int O_CARRY = 118784, O_CW = 135168, O_SUB = 137728;
    const bool carry_tab = PB && (F.G == 256);
    if (carry_tab) {
        const int ch = tid & 127, bq = tid >> 7, s0 = F.bid >> 3, blk0 = F.bid & 7;
        LAS float* CT = (LAS float*)(L + O_CARRY);
#define FOLD(agp, j0, j1, stp, hv) do { int js_ = (j0); const int n_ = ((j1) - (j0)) * (stp); int k_ = 0; \
            for (; k_ + 8 <= n_; k_ += 8) { f32x2 ah_[8]; _Pragma("unroll") for (int q_ = 0; q_ < 8; ++q_) ah_[q_] = (agp)[(size_t)(js_ + q_ * (stp)) * 2 * DM]; \
                _Pragma("unroll") for (int q_ = 0; q_ < 8; ++q_) hv = ah_[q_][0] * hv + ah_[q_][1]; js_ += 8 * (stp); } \
            for (; k_ < n_; ++k_) { const f32x2 a1_ = (agp)[(size_t)js_ * 2 * DM]; hv = a1_[0] * hv + a1_[1]; js_ += (stp); } } while (0)
        for (int bb = 2 * bq; bb < 2 * bq + 2; ++bb) {
            const f32x2* ag0 = AGG + ((size_t)(bb * 64) * 2 + 0) * DM + blk0 * 128 + ch; const f32x2* ag1 = AGG + ((size_t)(bb * 64) * 2 + 1) * DM + blk0 * 128 + ch;
            float h = 0.f;
            FOLD(ag0, 0, s0, 1, h); CT[((bb * 2 + 0) * 2 + 0) * 128 + ch] = h;
            FOLD(ag0, s0, s0 + 32, 1, h); CT[((bb * 2 + 1) * 2 + 0) * 128 + ch] = h;
            h = 0.f;
            FOLD(ag1, 63, s0 + 32, -1, h); CT[((bb * 2 + 1) * 2 + 1) * 128 + ch] = h;
            FOLD(ag1, s0 + 32, s0, -1, h); CT[((bb * 2 + 0) * 2 + 1) * 128 + ch] = h;
        }
        __syncthreads();
#undef FOLD
    }
    for (int i = 0;; ++i) {
        const int idx = i * F.G + F.bid; if (idx >= 4096) break;
        const int blk = idx & 7, j = idx >> 3, b = j >> 6, seg = j & 63, t0 = seg * 64;
        const size_t mrow0 = (size_t)b * SEQ + t0;
        if (blk != cur_blk) {
            cur_blk = blk;
#pragma unroll
            for (int d = 0; d < 2; ++d) {
#pragma unroll
                for (int g = 0; g < 2; ++g)
#pragma unroll
                    for (int ks = 0; ks < 4; ++ks)
                        wf[d][g][ks] = *(const bf16x8*)(WL + ((size_t)((d * 8 + blk) * 2 + g) * 128 + 16 * w + fr) * 128 + 32 * ks + 8 * fq);
                const int ch = blk * 128 + 16 * w + 4 * fq;
                br4[d] = *(const f32x4*)(F.in[13] + d * DM + ch); bi4[d] = *(const f32x4*)(F.in[15] + d * DM + ch);
                const f32x4 lm = *(const f32x4*)(F.in[16] + d * DM + ch);
#pragma unroll
                for (int e = 0; e < 4; ++e) sp4[d][e] = -8.f * 1.44269504089f * softplusf_(-lm[e]);
            }
            __syncthreads();
            for (int e = tid; e < 5 * 128; e += NTHR) { const int jt = e >> 7, cc = e & 127; ((LAS float*)(L + O_CW))[e] = (jt < 4) ? cw[jt * DM + blk * 128 + cc] : cb[blk * 128 + cc]; }
        }
        if (i == 0) RAW_LOAD(b, t0, blk);
#pragma unroll
        for (int r = 0; r < 3; ++r) { const int e = tid + NTHR * r; if (e < 68 * 16) *(LAS v4u*)(L + O_A + (e >> 4) * 256 + (e & 15) * 16) = rawreg[r]; }
        __syncthreads();
        { const int idx2 = (i + 1) * F.G + F.bid; if (idx2 < 4096) { const int j2 = idx2 >> 3; RAW_LOAD(j2 >> 6, (j2 & 63) * 64, idx2 & 7); } }
        v4u lgreg[2];
        if (PB) {
#pragma unroll
            for (int r = 0; r < 2; ++r) { const int e = tid + NTHR * r; lgreg[r] = *(const v4u*)(LG + (mrow0 + (e >> 4)) * DM + blk * 128 + (e & 15) * 8); } }
        for (int e = tid; e < 64 * 16; e += NTHR) { const int tl = e >> 4, c16 = e & 15;
            float y[8];
            { const f32x4 a = *(const LAS f32x4*)(L + O_CW + 4 * 512 + c16 * 32), bq = *(const LAS f32x4*)(L + O_CW + 4 * 512 + c16 * 32 + 16); y[0] = a[0]; y[1] = a[1]; y[2] = a[2]; y[3] = a[3]; y[4] = bq[0]; y[5] = bq[1]; y[6] = bq[2]; y[7] = bq[3]; }
#pragma unroll
            for (int jt = 0; jt < 4; ++jt) { const v4u r = *(const LAS v4u*)(L + O_A + (tl + jt) * 256 + c16 * 16);
                const f32x4 wa = *(const LAS f32x4*)(L + O_CW + jt * 512 + c16 * 32), wb = *(const LAS f32x4*)(L + O_CW + jt * 512 + c16 * 32 + 16);
                y[0] += wa[0] * bflo(r.x); y[1] += wa[1] * bfhi(r.x); y[2] += wa[2] * bflo(r.y); y[3] += wa[3] * bfhi(r.y);
                y[4] += wb[0] * bflo(r.z); y[5] += wb[1] * bfhi(r.z); y[6] += wb[2] * bflo(r.w); y[7] += wb[3] * bfhi(r.w); }
            *(LAS f32x4*)(L + O_XCF + tl * FST + c16 * 32) = (f32x4){y[0], y[1], y[2], y[3]};
            *(LAS f32x4*)(L + O_XCF + tl * FST + c16 * 32 + 16) = (f32x4){y[4], y[5], y[6], y[7]};
            v4u o; o.x = pk2(y[0], y[1]); o.y = pk2(y[2], y[3]); o.z = pk2(y[4], y[5]); o.w = pk2(y[6], y[7]);
            *(LAS v4u*)(L + O_XCB + tl * 272 + c16 * 16) = o; }
        __syncthreads();
        float carry0 = 0.f, carry1 = 0.f;
        if (carry_tab) { const LAS float* CT = (const LAS float*)(L + O_CARRY); carry0 = CT[((b * 2 + (seg >> 5)) * 2 + 0) * 128 + (tid & 127)]; carry1 = CT[((b * 2 + (seg >> 5)) * 2 + 1) * 128 + (tid & 127)]; }
        else if (PB) {
            const int ch = blk * 128 + (tid & 127);
            float h = 0.f;
            const f32x2* ag0 = AGG + ((size_t)(b * 64) * 2 + 0) * DM + ch; const f32x2* ag1 = AGG + ((size_t)(b * 64) * 2 + 1) * DM + ch;
            int js = 0;
            for (; js + 8 <= seg; js += 8) { f32x2 ah[8];
#pragma unroll
                for (int q = 0; q < 8; ++q) ah[q] = ag0[(size_t)(js + q) * 2 * DM];
#pragma unroll
                for (int q = 0; q < 8; ++q) h = ah[q][0] * h + ah[q][1]; }
            for (; js < seg; ++js) { const f32x2 ah = ag0[(size_t)js * 2 * DM]; h = ah[0] * h + ah[1]; }
            carry0 = h; h = 0.f;
            js = 63;
            for (; js - 8 >= seg; js -= 8) { f32x2 ah[8];
#pragma unroll
                for (int q = 0; q < 8; ++q) ah[q] = ag1[(size_t)(js - q) * 2 * DM];
#pragma unroll
                for (int q = 0; q < 8; ++q) h = ah[q][0] * h + ah[q][1]; }
            for (; js > seg; --js) { const f32x2 ah = ag1[(size_t)js * 2 * DM]; h = ah[0] * h + ah[1]; }
            carry1 = h;
        }
#pragma unroll
        for (int d = 0; d < 2; ++d) {
            const int o_a = (d == 0) ? O_A : O_XCF;
            f32x4 aR[4], aI[4];
#pragma unroll
            for (int mt = 0; mt < 4; ++mt) { aR[mt] = (f32x4){0.f, 0.f, 0.f, 0.f}; aI[mt] = (f32x4){0.f, 0.f, 0.f, 0.f}; }
#pragma unroll
            for (int ks = 0; ks < 4; ++ks)
#pragma unroll
                for (int mt = 0; mt < 4; ++mt) { const bf16x8 xb = *(const LAS bf16x8*)(L + O_XCB + (16 * mt + fr) * 272 + (32 * ks + 8 * fq) * 2);
                    aR[mt] = __builtin_amdgcn_mfma_f32_16x16x32_bf16(wf[d][0][ks], xb, aR[mt], 0, 0, 0);
                    aI[mt] = __builtin_amdgcn_mfma_f32_16x16x32_bf16(wf[d][1][ks], xb, aI[mt], 0, 0, 0); }
#pragma unroll
            for (int mt = 0; mt < 4; ++mt) { const int tl = 16 * mt + fr, cl = 16 * w + 4 * fq;
                const f32x4 xc = *(const LAS f32x4*)(L + O_XCF + tl * FST + cl * 4);
                f32x4 av, uv;
#pragma unroll
                for (int e = 0; e < 4; ++e) { const float r = sigmoidf_(aR[mt][e] + br4[d][e]), ig = sigmoidf_(aI[mt][e] + bi4[d][e]);
                    const float a_ = __builtin_amdgcn_exp2f(r * sp4[d][e]); av[e] = a_; uv[e] = __builtin_amdgcn_sqrtf(fmaxf(1.f - a_ * a_, 0.f)) * (ig * xc[e]); }
                *(LAS f32x4*)(L + o_a + tl * FST + cl * 4) = av; *(LAS f32x4*)(L + O_U + tl * FST + cl * 4) = uv; }
            __syncthreads();
            {
                const int c = tid & 127, sub = tid >> 7;
                LAS float* pa = (LAS float*)(L + o_a) + c; const LAS float* pu = (const LAS float*)(L + O_U) + c;
                LAS f32x2* SUBT = (LAS f32x2*)(L + O_SUB);
                float h = 0.f, A = 1.f;
#pragma unroll
                for (int s2 = 0; s2 < 16; ++s2) { const int tl = d ? (16 * sub + 15 - s2) : (16 * sub + s2); const float a = pa[tl * 132], u = pu[tl * 132]; h = a * h + u; A *= a; }
                SUBT[sub * 128 + c] = (f32x2){A, h};
                __syncthreads();
                if (!PB) {
                    if (sub == 0) { float HH = 0.f, AA = 1.f;
#pragma unroll
                        for (int q = 0; q < 4; ++q) { const f32x2 ah = SUBT[(d ? 3 - q : q) * 128 + c]; HH = ah[0] * HH + ah[1]; AA *= ah[0]; }
                        AGG[((size_t)(b * 64 + seg) * 2 + d) * DM + blk * 128 + c] = (f32x2){AA, HH}; }
                } else {
                    float hc = d ? carry1 : carry0;
#pragma unroll
                    for (int q = 0; q < 3; ++q) { const int jq = d ? 3 - q : q; const f32x2 ah = SUBT[jq * 128 + c]; if (d ? (jq > sub) : (jq < sub)) hc = ah[0] * hc + ah[1]; }
                    if (d == 0) {
#pragma unroll
                        for (int s2 = 0; s2 < 16; ++s2) { const int tl = 16 * sub + s2; hc = pa[tl * 132] * hc + pu[tl * 132]; pa[tl * 132] = hc; }
                    } else { LAS float* ph = (LAS float*)(L + O_A) + c;
#pragma unroll
                        for (int s2 = 0; s2 < 16; ++s2) { const int tl = 16 * sub + 15 - s2; hc = pa[tl * 132] * hc + pu[tl * 132]; ph[tl * 132] += hc; } }
                }
            }
            __syncthreads();
        }
        if (PB) {
#pragma unroll
            for (int r = 0; r < 2; ++r) { const int e = tid + NTHR * r, row = e >> 4, c16 = e & 15;
                const v4u g = lgreg[r];
                const f32x4 h0 = *(const LAS f32x4*)(L + O_A + row * FST + c16 * 32), h1 = *(const LAS f32x4*)(L + O_A + row * FST + c16 * 32 + 16);
                v4u o;
                o.x = pk2(h0[0] * gelu_fast(bflo(g.x)), h0[1] * gelu_fast(bfhi(g.x))); o.y = pk2(h0[2] * gelu_fast(bflo(g.y)), h0[3] * gelu_fast(bfhi(g.y)));
                o.z = pk2(h1[0] * gelu_fast(bflo(g.z)), h1[1] * gelu_fast(bfhi(g.z))); o.w = pk2(h1[2] * gelu_fast(bflo(g.w)), h1[3] * gelu_fast(bfhi(g.w)));
                *(v4u*)(YL + (mrow0 + row) * DM + blk * 128 + c16 * 8) = o; }
            __syncthreads();
        }
    }
#undef RAW_LOAD
}

__device__ __forceinline__ void mconv_phase(Frame& F) {
    const bf16* XM = (const bf16*)(F.ws + WS_XM); bf16* XC = (bf16*)F.out + (size_t)MTOK * DM;
    const float* cw = F.in[4]; const float* cb = F.in[5];
    const int NT = MTOK / 32 * 128;
    for (int g = F.bid * NTHR + F.tid; g < NT; g += F.G * NTHR) {
        const int chunk = g & 127, run = g >> 7, c0 = chunk * 8, m0 = run * 32, t0 = m0 & (SEQ - 1);
        float w[4][8], bias[8];
#pragma unroll
        for (int j = 0; j < 4; ++j) { const f32x4 a = *(const f32x4*)(cw + j * DM + c0), b = *(const f32x4*)(cw + j * DM + c0 + 4);
            w[j][0] = a[0]; w[j][1] = a[1]; w[j][2] = a[2]; w[j][3] = a[3]; w[j][4] = b[0]; w[j][5] = b[1]; w[j][6] = b[2]; w[j][7] = b[3]; }
        { const f32x4 a = *(const f32x4*)(cb + c0), b = *(const f32x4*)(cb + c0 + 4);
            bias[0] = a[0]; bias[1] = a[1]; bias[2] = a[2]; bias[3] = a[3]; bias[4] = b[0]; bias[5] = b[1]; bias[6] = b[2]; bias[7] = b[3]; }
        v4u win[4];
        const v4u zero = {0u, 0u, 0u, 0u};
        win[0] = zero;
        win[1] = (t0 >= 2) ? *(const v4u*)(XM + (size_t)(m0 - 2) * DM + c0) : zero;
        win[2] = (t0 >= 1) ? *(const v4u*)(XM + (size_t)(m0 - 1) * DM + c0) : zero;
        win[3] = *(const v4u*)(XM + (size_t)m0 * DM + c0);
#pragma unroll 4
        for (int i = 0; i < 32; ++i) {
            win[0] = win[1]; win[1] = win[2]; win[2] = win[3];
            win[3] = (t0 + i + 1 < SEQ) ? *(const v4u*)(XM + (size_t)(m0 + i + 1) * DM + c0) : zero;
            float y[8];
#pragma unroll
            for (int e = 0; e < 8; ++e) y[e] = bias[e];
#pragma unroll
            for (int j = 0; j < 4; ++j) {
                const unsigned p0 = win[j].x, p1 = win[j].y, p2 = win[j].z, p3 = win[j].w;
                y[0] += w[j][0] * bflo(p0); y[1] += w[j][1] * bfhi(p0); y[2] += w[j][2] * bflo(p1); y[3] += w[j][3] * bfhi(p1);
                y[4] += w[j][4] * bflo(p2); y[5] += w[j][5] * bfhi(p2); y[6] += w[j][6] * bflo(p3); y[7] += w[j][7] * bfhi(p3);
            }
#pragma unroll
            for (int e = 0; e < 8; ++e) y[e] = y[e] * sigmoidf_(y[e]);
            v4u o; o.x = pk2(y[0], y[1]); o.y = pk2(y[2], y[3]); o.z = pk2(y[4], y[5]); o.w = pk2(y[6], y[7]);
            *(v4u*)(XC + (size_t)(m0 + i) * DM + c0) = o;
        }
    }
}

__device__ __forceinline__ void mscan_ref(Frame& F) {
    const bf16* Q = (const bf16*)(F.ws + WS_LG); const bf16* K = (const bf16*)(F.ws + WS_K); const bf16* V = (const bf16*)F.out + (size_t)MTOK * DM;
    const float* GT = (const float*)(F.ws + WS_GATE);
    LAS float* sq = (LAS float*)F.lds; LAS float* sk = sq + 256; LAS float* sv = sk + 256; LAS float* spart = sv + 32; LAS float* sdw = spart + 256;
    const int e = F.tid & 31, dg = F.tid >> 5;
    for (int item = F.bid; item < 512; item += F.G) {
        const int es = item & 7, dir = (item >> 3) & 1, h = (item >> 4) & 3, b = item >> 6;
        bf16* H = (bf16*)(F.ws + (dir ? WS_XL : WS_XM));
        float C[16];
#pragma unroll
        for (int j = 0; j < 16; ++j) C[j] = 0.f;
        float nreg = 0.f, mst = 0.f;
        for (int step = 0; step < SEQ; ++step) {
            const int t = dir ? (SEQ - 1 - step) : step;
            const size_t m = (size_t)b * SEQ + t, ro = m * DM + h * 256;
            if (F.tid < 256) { sq[F.tid] = bf2f(Q[ro + F.tid]); sk[F.tid] = bf2f(K[ro + F.tid]); }
            if (F.tid < 32) sv[F.tid] = bf2f(V[ro + es * 32 + F.tid]);
            const float ip = GT[m * 16 + (dir * 2 + 0) * 4 + h], fp = GT[m * 16 + (dir * 2 + 1) * 4 + h];
            const float logf = -softplusf_(-fp);
            const float mn = fmaxf(logf + mst, ip);
            const float fd = __expf(logf + mst - mn), iw = __expf(ip - mn);
            mst = mn;
            __syncthreads();
            const float ve = sv[e] * iw;
            float part = 0.f;
#pragma unroll
            for (int j = 0; j < 16; ++j) { const int d = dg * 16 + j; C[j] = fd * C[j] + sk[d] * ve; part += sq[d] * C[j]; }
            part += __shfl_xor(part, 32);
            if (F.lane < 32) spart[F.wave * 32 + e] = part;
            if (F.tid < 256) { nreg = fd * nreg + iw * sk[F.tid]; const float ds = wave_sum(nreg * sq[F.tid]); if (F.lane == 0) sdw[F.wave] = ds; }
            __syncthreads();
            if (F.tid < 32) {
                float num = 0.f;
#pragma unroll
                for (int w = 0; w < 8; ++w) num += spart[w * 32 + F.tid];
                const float den = sdw[0] + sdw[1] + sdw[2] + sdw[3];
                H[ro + es * 32 + F.tid] = (bf16)f2bf(num / fmaxf(fabsf(den), __expf(-mn)));
            }
        }
        __syncthreads();
    }
}


typedef short s16x4 __attribute__((ext_vector_type(4)));
__device__ __forceinline__ bf16x8 tr_read_pair(unsigned a0, unsigned a1) {
    s16x4 r0, r1;
    asm volatile("ds_read_b64_tr_b16 %0, %2\n\tds_read_b64_tr_b16 %1, %3\n\ts_waitcnt lgkmcnt(0)" : "=&v"(r0), "=&v"(r1) : "v"(a0), "v"(a1) : "memory");
    return __builtin_shufflevector(r0, r1, 0, 1, 2, 3, 4, 5, 6, 7);
}
__device__ __forceinline__ float wave_incl_sum(float x, int lane) {
#pragma unroll
    for (int o = 1; o < 64; o <<= 1) { const float t = __shfl_up(x, o); if (lane >= o) x += t; }
    return x;
}
__device__ __forceinline__ float wave_incl_max(float x, int lane) {
#pragma unroll
    for (int o = 1; o < 64; o <<= 1) { const float t = __shfl_up(x, o); if (lane >= o) x = fmaxf(x, t); }
    return x;
}
__device__ __forceinline__ void mscan_phase(Frame& F) {
    const bf16* Q = (const bf16*)(F.ws + WS_LG); const bf16* K = (const bf16*)(F.ws + WS_K); const bf16* V = (const bf16*)(F.ws + WS_XL);
    const float* GT = (const float*)(F.ws + WS_GATE);
    constexpr int KS = 0, CTI = 33792, VT = 67584, VWT = 86016, PB = 104448, TAB = 113664, NT = 116736, NPART = 117760, DENT = 119808;
    constexpr int KST = 528, VST = 144, TABSZ = 1536;
    LAS unsigned char* L = F.lds;
    const int tid = F.tid, lane = F.lane, w = F.wave, fr = lane & 15, fq = lane >> 4, pt = w & 3, wg = w >> 2;
    for (int item = F.bid; item < 256; item += F.G) {
        const int es = item & 3, dir = (item >> 2) & 1, h = (item >> 3) & 3, b = item >> 5;
        bf16* H = dir ? ((bf16*)F.out + (size_t)MTOK * DM) : (bf16*)(F.ws + WS_XM);
        const size_t rowbase = (size_t)b * SEQ;
#define TOF(c, p) (dir ? (SEQ - 1 - 64 * (c) - (p)) : (64 * (c) + (p)))
        for (int e = tid; e < (33792 + 1024) / 4; e += NTHR) { if (e < 33792 / 4) ((LAS unsigned*)(L + CTI))[e] = 0u; else ((LAS unsigned*)(L + NT))[e - 33792 / 4] = 0u; }
        float m_run = 0.f;
        float gi_n = 0.f, gf_n = 0.f;
        if (w == 0) { const size_t m = rowbase + TOF(0, lane); gi_n = GT[m * 16 + dir * 8 + h]; gf_n = GT[m * 16 + dir * 8 + 4 + h]; }
#define G1_TABLES(setp) do { \
            const float logf_ = fminf(gf_n, 0.f) - __logf(1.f + __expf(-fabsf(gf_n))); const float b_ = wave_incl_sum(logf_, lane); const float a_ = gi_n - b_; \
            const float M_ = fmaxf(m_run, wave_incl_max(a_, lane)); const float Mend_ = __shfl(M_, 63), g_ = __shfl(b_, 63); \
            LAS float* T_ = (LAS float*)(setp); T_[lane] = a_; T_[64 + lane] = M_; T_[128 + lane] = __expf(m_run - M_); T_[192 + lane] = __expf(-(b_ + M_)); T_[256 + lane] = __expf(a_ - Mend_); \
            if (lane == 0) { T_[320] = __expf(m_run - Mend_); T_[321] = g_ + Mend_; } \
            m_run = g_ + Mend_; } while (0)
        if (w == 0) G1_TABLES(L + TAB);
        __syncthreads();
        bf16x8 qf[8];
        v4u kreg[4]; v4u vreg;
#define LOAD_KV(c) do { _Pragma("unroll") for (int r_ = 0; r_ < 4; ++r_) { const int i_ = tid + NTHR * r_, s_ = i_ >> 5, c16_ = i_ & 31; \
                kreg[r_] = *(const v4u*)(K + (rowbase + TOF(c, s_)) * DM + h * 256 + c16_ * 8); } \
            { const int s_ = tid & 63, e8_ = tid >> 6; vreg = *(const v4u*)(V + (rowbase + TOF(c, s_)) * DM + h * 256 + es * 64 + e8_ * 8); } } while (0)
#define STORE_KV(setidx) do { _Pragma("unroll") for (int r_ = 0; r_ < 4; ++r_) { const int i_ = tid + NTHR * r_, s_ = i_ >> 5, c16_ = i_ & 31; \
                *(LAS v4u*)(L + KS + s_ * KST + c16_ * 16) = kreg[r_]; } \
            { const int s_ = tid & 63, e8_ = tid >> 6; const float ws_ = ((const LAS float*)(L + TAB + (setidx) * TABSZ))[256 + s_]; \
              LAS bf16* vt_ = (LAS bf16*)(L + VT + (setidx) * 9216); LAS bf16* vw_ = (LAS bf16*)(L + VWT + (setidx) * 9216); \
              const unsigned wv_[4] = {vreg.x, vreg.y, vreg.z, vreg.w}; \
              _Pragma("unroll") for (int j_ = 0; j_ < 4; ++j_) { const float lo_ = bflo(wv_[j_]), hi_ = bfhi(wv_[j_]); const int e_ = e8_ * 8 + 2 * j_; \
                vt_[e_ * 72 + s_] = (bf16)(wv_[j_] & 0xffffu); vt_[(e_ + 1) * 72 + s_] = (bf16)(wv_[j_] >> 16); \
                vw_[e_ * 72 + s_] = (bf16)f2bf(lo_ * ws_); vw_[(e_ + 1) * 72 + s_] = (bf16)f2bf(hi_ * ws_); } } } while (0)
#define LOAD_Q(c) do { const size_t m_ = rowbase + TOF(c, 16 * pt + fr); _Pragma("unroll") for (int ks_ = 0; ks_ < 8; ++ks_) \
                qf[ks_] = *(const bf16x8*)(Q + m_ * DM + h * 256 + 32 * ks_ + 8 * fq); } while (0)
        LOAD_KV(0); LOAD_Q(0);
        STORE_KV(0);
        f32x4 Cacc[8];
#pragma unroll
        for (int i = 0; i < 8; ++i) Cacc[i] = (f32x4){0.f, 0.f, 0.f, 0.f};
        __syncthreads();
        for (int c = 0; c < 64; ++c) {
            const int cur = c & 1, nxt = cur ^ 1;
            const bool has_next = (c + 1 < 64);
            const LAS float* T = (const LAS float*)(L + TAB + cur * TABSZ);
            if (has_next) { LOAD_KV(c + 1); if (w == 0) { const size_t m = rowbase + TOF(c + 1, lane); gi_n = GT[m * 16 + dir * 8 + h]; gf_n = GT[m * 16 + dir * 8 + 4 + h]; } }
            const int p = 16 * pt + fr;
            const float Mp = T[64 + p], wi_p = T[128 + p];
            float cs = 0.f;
#pragma unroll
            for (int i = 0; i < 2; ++i) { const int st = 2 * wg + i;
                v2u pw = {0u, 0u};
                if (st <= pt) {
                    f32x4 sa = (f32x4){0.f, 0.f, 0.f, 0.f};
#pragma unroll
                    for (int ks = 0; ks < 8; ++ks) { const bf16x8 kf = *(const LAS bf16x8*)(L + KS + (16 * st + fr) * KST + (32 * ks + 8 * fq) * 2);
                        sa = __builtin_amdgcn_mfma_f32_16x16x32_bf16(kf, qf[ks], sa, 0, 0, 0); }
                    const f32x4 a4 = *(const LAS f32x4*)(T + 16 * st + 4 * fq);
                    float pv[4];
#pragma unroll
                    for (int r = 0; r < 4; ++r) { const int s_ = 16 * st + 4 * fq + r; const float wgt = (s_ <= p) ? __expf(a4[r] - Mp) : 0.f; pv[r] = sa[r] * wgt; cs += pv[r]; }
                    pw.x = pk2(pv[0], pv[1]); pw.y = pk2(pv[2], pv[3]);
                }
                *(LAS v2u*)(L + PB + p * VST + (16 * st + 4 * fq) * 2) = pw; }
            f32x4 O[2];
#pragma unroll
            for (int i = 0; i < 2; ++i) { const int et = 2 * wg + i; O[i] = (f32x4){0.f, 0.f, 0.f, 0.f};
#pragma unroll
                for (int ks = 0; ks < 8; ++ks) { const bf16x8 cf = *(const LAS bf16x8*)(L + CTI + (16 * et + fr) * KST + (32 * ks + 8 * fq) * 2);
                    O[i] = __builtin_amdgcn_mfma_f32_16x16x32_bf16(cf, qf[ks], O[i], 0, 0, 0); } }
            float di = 0.f;
#define DEN_INTER(ks) do { const f32x4 n0 = *(const LAS f32x4*)(L + NT + (32 * (ks) + 8 * fq) * 4), n1 = *(const LAS f32x4*)(L + NT + (32 * (ks) + 8 * fq) * 4 + 16); \
                const v4u qw = __builtin_bit_cast(v4u, qf[ks]); \
                di += bflo(qw.x) * n0[0] + bfhi(qw.x) * n0[1] + bflo(qw.y) * n0[2] + bfhi(qw.y) * n0[3] + bflo(qw.z) * n1[0] + bfhi(qw.z) * n1[1] + bflo(qw.w) * n1[2] + bfhi(qw.w) * n1[3]; } while (0)
            if (wg == 0) { DEN_INTER(0); DEN_INTER(1); DEN_INTER(2); DEN_INTER(3); }
            else { DEN_INTER(4); DEN_INTER(5); DEN_INTER(6); DEN_INTER(7); }
#undef DEN_INTER
            di += __shfl_xor(di, 16); di += __shfl_xor(di, 32);
            cs += __shfl_xor(cs, 16); cs += __shfl_xor(cs, 32);
            if (fq == 0) ((LAS float*)(L + DENT))[wg * 64 + p] = wi_p * di + cs;
            if (has_next) LOAD_Q(c + 1);
            if (has_next && w == 0) G1_TABLES(L + TAB + nxt * TABSZ);
            __syncthreads();
#pragma unroll
            for (int i = 0; i < 2; ++i) { const int et = 2 * wg + i; O[i] = O[i] * wi_p;
#pragma unroll
                for (int ks = 0; ks < 2; ++ks) { const bf16x8 vf = *(const LAS bf16x8*)(L + VT + cur * 9216 + (16 * et + fr) * VST + (32 * ks + 8 * fq) * 2);
                    const bf16x8 pf = *(const LAS bf16x8*)(L + PB + p * VST + (32 * ks + 8 * fq) * 2);
                    O[i] = __builtin_amdgcn_mfma_f32_16x16x32_bf16(vf, pf, O[i], 0, 0, 0); } }
            { const float den = ((const LAS float*)(L + DENT))[p] + ((const LAS float*)(L + DENT))[64 + p];
              const float inv = 1.f / fmaxf(fabsf(den), T[192 + p]);
              const size_t m = rowbase + TOF(c, p);
#pragma unroll
              for (int i = 0; i < 2; ++i) { const int et = 2 * wg + i; v2u o; o.x = pk2(O[i][0] * inv, O[i][1] * inv); o.y = pk2(O[i][2] * inv, O[i][3] * inv);
                  *(v2u*)(H + m * DM + h * 256 + es * 64 + 16 * et + 4 * fq) = o; } }
            { const float decay = T[320];
              const bf16x8 vw0 = *(const LAS bf16x8*)(L + VWT + cur * 9216 + (16 * pt + fr) * VST + (8 * fq) * 2);
              const bf16x8 vw1 = *(const LAS bf16x8*)(L + VWT + cur * 9216 + (16 * pt + fr) * VST + (32 + 8 * fq) * 2);
              const int l16 = lane & 15, q4 = l16 >> 2, p4 = l16 & 3;
              const unsigned kb = (unsigned)(uintptr_t)(L + KS) + (unsigned)((8 * fq + q4) * KST + 4 * p4 * 2);
#pragma unroll
              for (int dtl = 0; dtl < 8; dtl += 2) { const int dt = 8 * wg + dtl; const unsigned a0 = kb + dt * 32;
                  s16x4 r0, r1, r2, r3, r4, r5, r6, r7;
                  asm volatile("ds_read_b64_tr_b16 %0, %8\n\tds_read_b64_tr_b16 %1, %8 offset:2112\n\tds_read_b64_tr_b16 %2, %8 offset:16896\n\tds_read_b64_tr_b16 %3, %8 offset:19008\n\t"
                               "ds_read_b64_tr_b16 %4, %8 offset:32\n\tds_read_b64_tr_b16 %5, %8 offset:2144\n\tds_read_b64_tr_b16 %6, %8 offset:16928\n\tds_read_b64_tr_b16 %7, %8 offset:19040\n\ts_waitcnt lgkmcnt(0)"
                               : "=&v"(r0), "=&v"(r1), "=&v"(r2), "=&v"(r3), "=&v"(r4), "=&v"(r5), "=&v"(r6), "=&v"(r7) : "v"(a0) : "memory");
                  const bf16x8 k0 = __builtin_shufflevector(r0, r1, 0, 1, 2, 3, 4, 5, 6, 7), k1 = __builtin_shufflevector(r2, r3, 0, 1, 2, 3, 4, 5, 6, 7);
                  const bf16x8 k2 = __builtin_shufflevector(r4, r5, 0, 1, 2, 3, 4, 5, 6, 7), k3 = __builtin_shufflevector(r6, r7, 0, 1, 2, 3, 4, 5, 6, 7);
                  Cacc[dtl] = Cacc[dtl] * decay; Cacc[dtl + 1] = Cacc[dtl + 1] * decay;
                  Cacc[dtl] = __builtin_amdgcn_mfma_f32_16x16x32_bf16(k0, vw0, Cacc[dtl], 0, 0, 0);
                  Cacc[dtl + 1] = __builtin_amdgcn_mfma_f32_16x16x32_bf16(k2, vw0, Cacc[dtl + 1], 0, 0, 0);
                  Cacc[dtl] = __builtin_amdgcn_mfma_f32_16x16x32_bf16(k1, vw1, Cacc[dtl], 0, 0, 0);
                  Cacc[dtl + 1] = __builtin_amdgcn_mfma_f32_16x16x32_bf16(k3, vw1, Cacc[dtl + 1], 0, 0, 0); } }
            { const int d = tid & 255, hf2 = tid >> 8; float np = 0.f;
#pragma unroll 8
              for (int s2 = 0; s2 < 32; ++s2) { const int s_ = hf2 * 32 + s2; np += T[256 + s_] * bf2f(*(const LAS bf16*)(L + KS + s_ * KST + d * 2)); }
              ((LAS float*)(L + NPART))[hf2 * 256 + d] = np; }
            __syncthreads();
            { const float decay = T[320];
#pragma unroll
              for (int dtl = 0; dtl < 8; ++dtl) { const int dt = 8 * wg + dtl; v2u o; o.x = pk2(Cacc[dtl][0], Cacc[dtl][1]); o.y = pk2(Cacc[dtl][2], Cacc[dtl][3]);
                  *(LAS v2u*)(L + CTI + (16 * pt + fr) * KST + (16 * dt + 4 * fq) * 2) = o; }
              if (tid < 256) { LAS float* nt = (LAS float*)(L + NT); const LAS float* np = (const LAS float*)(L + NPART); nt[tid] = decay * nt[tid] + np[tid] + np[256 + tid]; } }
            if (has_next) STORE_KV(nxt);
            __syncthreads();
        }
#undef TOF
#undef G1_TABLES
#undef LOAD_KV
#undef STORE_KV
#undef LOAD_Q
    }
}

__device__ __forceinline__ void ym_phase(Frame& F) {
    const bf16* HF = (const bf16*)(F.ws + WS_XM); const bf16* HB = (const bf16*)F.out + (size_t)MTOK * DM; bf16* OP = (bf16*)(F.ws + WS_OP);
    const float* ng = F.in[9];
    const int gw = F.bid * NWAVES + F.wave, NGW = F.G * NWAVES;
    for (int m = gw; m < MTOK; m += NGW) {
#pragma unroll
        for (int hd = 0; hd < 4; ++hd) {
            const size_t o = (size_t)m * DM + hd * 256 + F.lane * 4;
            const v2u a = *(const v2u*)(HF + o), b = *(const v2u*)(HB + o), op = *(const v2u*)(OP + o);
            const float v0 = bflo(a.x) + bflo(b.x), v1 = bfhi(a.x) + bfhi(b.x), v2 = bflo(a.y) + bflo(b.y), v3 = bfhi(a.y) + bfhi(b.y);
            const float r = rsqrtf(wave_sum((v0 * v0 + v1 * v1) + (v2 * v2 + v3 * v3)) * (1.f / 256.f) + EPS);
            const f32x4 g = *(const f32x4*)(ng + hd * 256 + F.lane * 4);
            v2u w; w.x = pk2(sigmoidf_(bflo(op.x)) * v0 * r * g[0], sigmoidf_(bfhi(op.x)) * v1 * r * g[1]);
            w.y = pk2(sigmoidf_(bflo(op.y)) * v2 * r * g[2], sigmoidf_(bfhi(op.y)) * v3 * r * g[3]);
            *(v2u*)(OP + o) = w;
        }
    }
    {
        float* usc = (float*)(F.ws + WS_LG + 16 * MiB); float* vsc = usc + NEXP;
        for (int row = gw; row < 2 * NEXP; row += NGW) {
            const bool isv = row >= NEXP; const int r = isv ? row - NEXP : row;
            const f32x4* src = (const f32x4*)(F.in[isv ? 24 : 23] + (size_t)r * DM) + F.lane * 4;
            f32x4 a[4]; float ss = 0.f;
#pragma unroll
            for (int j = 0; j < 4; ++j) { a[j] = src[j]; ss += (a[j][0] * a[j][0] + a[j][1] * a[j][1]) + (a[j][2] * a[j][2] + a[j][3] * a[j][3]); }
            const float rms = sqrtf(wave_sum(ss) * (1.f / DM));
            const float sc = fmaxf(rms * 0.5f, 1e-30f), inv = 1.f / sc;
            unsigned o[2] = {0u, 0u};
#pragma unroll
            for (int j = 0; j < 4; ++j) { const f32x4 q = a[j] * inv;
                if (j & 1) { o[j >> 1] = __builtin_amdgcn_cvt_scalef32_pk_fp4_f32(o[j >> 1], q[0], q[1], 1.0f, 2); o[j >> 1] = __builtin_amdgcn_cvt_scalef32_pk_fp4_f32(o[j >> 1], q[2], q[3], 1.0f, 3); }
                else       { o[j >> 1] = __builtin_amdgcn_cvt_scalef32_pk_fp4_f32(o[j >> 1], q[0], q[1], 1.0f, 0); o[j >> 1] = __builtin_amdgcn_cvt_scalef32_pk_fp4_f32(o[j >> 1], q[2], q[3], 1.0f, 1); } }
            *(v2u*)(F.ws + WS_LG + (isv ? 8 * MiB : 0) + (size_t)r * (DM / 2) + F.lane * 8) = (v2u){o[0], o[1]};
            if (F.lane == 0) (isv ? vsc : usc)[r] = sc;
        }
    }
}

__device__ __forceinline__ void select_ref(Frame& F) {
    const bf16* PQ = (const bf16*)(F.ws + WS_MG); const bf16* KEYS = (const bf16*)(F.ws + WS_KEYS);
    int* IDX = (int*)(F.ws + WS_K); float* GW = (float*)(F.ws + WS_K + 16 * MiB);
    LAS float* base = (LAS float*)(F.lds + F.wave * 2048);
    LAS float* sq = base;
    LAS float* sl = base + 256;
    LAS int* il = (LAS int*)(base + 288);
    LAS float* sbest = base + 320;
    LAS int* spos = (LAS int*)(base + 336);
    const int lane = F.lane;
    const int gw = F.bid * NWAVES + F.wave, NGW = F.G * NWAVES;
    for (int it = gw; it < MTOK * 8; it += NGW) {
        const int t = it >> 3, h = it & 7;
        { const v2u q4 = *(const v2u*)(PQ + (size_t)t * 2048 + h * 256 + lane * 4);
          sq[lane * 4 + 0] = bflo(q4.x); sq[lane * 4 + 1] = bfhi(q4.x); sq[lane * 4 + 2] = bflo(q4.y); sq[lane * 4 + 3] = bfhi(q4.y); }
        LDS_WAIT();
        for (int p = 0; p < 2; ++p) {
            float v0 = 0.f, v1 = 0.f;
            const v4u* k0 = (const v4u*)(KEYS + ((size_t)(h * 2 + p) * 128 + lane) * 128);
            const v4u* k1 = k0 + 64 * 16;
#pragma unroll 4
            for (int c8 = 0; c8 < 16; ++c8) {
                const v4u a = k0[c8], b = k1[c8];
                const f32x4 q0 = *(const LAS f32x4*)(sq + p * 128 + c8 * 8), q1 = *(const LAS f32x4*)(sq + p * 128 + c8 * 8 + 4);
                v0 += q0[0] * bflo(a.x) + q0[1] * bfhi(a.x) + q0[2] * bflo(a.y) + q0[3] * bfhi(a.y) + q1[0] * bflo(a.z) + q1[1] * bfhi(a.z) + q1[2] * bflo(a.w) + q1[3] * bfhi(a.w);
                v1 += q0[0] * bflo(b.x) + q0[1] * bfhi(b.x) + q0[2] * bflo(b.y) + q0[3] * bfhi(b.y) + q1[0] * bflo(b.z) + q1[1] * bfhi(b.z) + q1[2] * bflo(b.w) + q1[3] * bfhi(b.w);
            }
            for (int k = 0; k < 16; ++k) {
                float bv; int bi;
                if (v0 >= v1) { bv = v0; bi = lane; } else { bv = v1; bi = lane + 64; }
#pragma unroll
                for (int off = 32; off >= 1; off >>= 1) {
                    const float ov = __shfl_xor(bv, off); const int oi = __shfl_xor(bi, off);
                    if (ov > bv || (ov == bv && oi < bi)) { bv = ov; bi = oi; }
                }
                if (lane == 0) { sl[p * 16 + k] = bv; il[p * 16 + k] = bi; }
                if (bi == lane) v0 = -INFINITY;
                if (bi == lane + 64) v1 = -INFINITY;
            }
        }
        LDS_WAIT();
        float cv[4];
#pragma unroll
        for (int r = 0; r < 4; ++r) { const int pos = lane + 64 * r; cv[r] = sl[pos >> 4] + sl[16 + (pos & 15)]; }
        for (int k = 0; k < 16; ++k) {
            float bv = cv[0]; int bi = lane;
#pragma unroll
            for (int r = 1; r < 4; ++r) if (cv[r] > bv) { bv = cv[r]; bi = lane + 64 * r; }
#pragma unroll
            for (int off = 32; off >= 1; off >>= 1) {
                const float ov = __shfl_xor(bv, off); const int oi = __shfl_xor(bi, off);
                if (ov > bv || (ov == bv && oi < bi)) { bv = ov; bi = oi; }
            }
            if (lane == 0) { sbest[k] = bv; spos[k] = bi; }
#pragma unroll
            for (int r = 0; r < 4; ++r) if (bi == lane + 64 * r) cv[r] = -INFINITY;
        }
        LDS_WAIT();
        if (lane < 16) {
            const float mx = sbest[0];
            float sum = 0.f;
            for (int k = 0; k < 16; ++k) sum += __expf(sbest[k] - mx);
            const int pos = spos[lane];
            IDX[(size_t)t * 128 + h * 16 + lane] = il[pos >> 4] * 128 + il[16 + (pos & 15)];
            GW[(size_t)t * 128 + h * 16 + lane] = __expf(sbest[lane] - mx) / sum;
        }
        LDS_WAIT();
    }
}


typedef float f32x16 __attribute__((ext_vector_type(16)));
#define TOPK_INSERT(L, xv) do { const float x_ = (xv); \
    L[15] = __builtin_amdgcn_fmed3f(L[14], L[15], x_); L[14] = __builtin_amdgcn_fmed3f(L[13], L[14], x_); L[13] = __builtin_amdgcn_fmed3f(L[12], L[13], x_); L[12] = __builtin_amdgcn_fmed3f(L[11], L[12], x_); \
    L[11] = __builtin_amdgcn_fmed3f(L[10], L[11], x_); L[10] = __builtin_amdgcn_fmed3f(L[9], L[10], x_); L[9] = __builtin_amdgcn_fmed3f(L[8], L[9], x_); L[8] = __builtin_amdgcn_fmed3f(L[7], L[8], x_); \
    L[7] = __builtin_amdgcn_fmed3f(L[6], L[7], x_); L[6] = __builtin_amdgcn_fmed3f(L[5], L[6], x_); L[5] = __builtin_amdgcn_fmed3f(L[4], L[5], x_); L[4] = __builtin_amdgcn_fmed3f(L[3], L[4], x_); \
    L[3] = __builtin_amdgcn_fmed3f(L[2], L[3], x_); L[2] = __builtin_amdgcn_fmed3f(L[1], L[2], x_); L[1] = __builtin_amdgcn_fmed3f(L[0], L[1], x_); L[0] = fmaxf(L[0], x_); } while (0)
template <int I> struct CandRow {
    static __device__ __forceinline__ void run(const float (&L0)[16], const float (&L1)[16], float (&R)[16]) {
        constexpr int NJ = 16 / (I + 1);
#pragma unroll
        for (int j = 0; j < NJ; ++j) { const float sm = L0[I] + L1[j];
            const float pk = __builtin_bit_cast(float, (__builtin_bit_cast(unsigned, sm) & 0xffffff00u) | (unsigned)(I * 16 + j)); TOPK_INSERT(R, pk); }
        if constexpr (I < 15) CandRow<I + 1>::run(L0, L1, R);
    }
};
__device__ __forceinline__ unsigned pick4(unsigned d0, unsigned d1, unsigned d2, unsigned d3, int i) {
    const int q = i >> 2; unsigned d = d0; d = (q == 1) ? d1 : d; d = (q == 2) ? d2 : d; d = (q == 3) ? d3 : d; return (d >> (8 * (i & 3))) & 127u;
}
__device__ __forceinline__ void select_phase(Frame& F) {
    const bf16* PQ = (const bf16*)(F.ws + WS_MG); const bf16* KEYS = (const bf16*)(F.ws + WS_KEYS);
    int* IDX = (int*)(F.ws + WS_K); float* GW = (float*)(F.ws + WS_K + 16 * MiB);
    LAS unsigned char* L = F.lds;
    const int tid = F.tid, lane = F.lane, w = F.wave, l31 = lane & 31, hh = lane >> 5;
    const float NEG_INF = -INFINITY;
    for (int grp = F.bid; grp < MTOK / 128; grp += F.G) {
        const int tb = grp * 4 + (w & 3);
        const size_t m = (size_t)tb * 32 + l31;
        for (int hp = 0; hp < 4; ++hp) {
            __syncthreads();
#pragma unroll 4
            for (int r = 0; r < 16; ++r) { const int e = tid + NTHR * r, R = e >> 4, c = e & 15;
                *(LAS v4u*)(L + R * 256 + ((c ^ (R & 15)) * 16)) = *(const v4u*)(KEYS + ((size_t)(hp * 512 + R) * 128 + c * 8)); }
            __syncthreads();
            const int hl = w >> 2, h = 2 * hp + hl;
            float L0[16], L1[16];
#pragma unroll
            for (int p = 0; p < 2; ++p) {
                bf16x8 qf[8];
#pragma unroll
                for (int ks = 0; ks < 8; ++ks) qf[ks] = *(const bf16x8*)(PQ + m * 2048 + h * 256 + p * 128 + 16 * ks + 8 * hh);
                f32x16 acc[4];
#pragma unroll
                for (int kb = 0; kb < 4; ++kb)
#pragma unroll
                    for (int r = 0; r < 16; ++r) acc[kb][r] = 0.f;
#pragma unroll
                for (int ks = 0; ks < 8; ++ks)
#pragma unroll
                    for (int kb = 0; kb < 4; ++kb) { const int R = (hl * 2 + p) * 128 + 32 * kb + l31;
                        const bf16x8 kf = *(const LAS bf16x8*)(L + R * 256 + (((2 * ks + hh) ^ (lane & 15)) * 16));
                        acc[kb] = __builtin_amdgcn_mfma_f32_32x32x16_bf16(kf, qf[ks], acc[kb], 0, 0, 0); }
                float Lc[16];
#pragma unroll
                for (int i = 0; i < 16; ++i) Lc[i] = NEG_INF;
                const unsigned hh4 = (unsigned)hh << 2;
#pragma unroll
                for (int kb = 0; kb < 4; ++kb)
#pragma unroll
                    for (int r = 0; r < 16; ++r) { const unsigned nlo = (unsigned)(32 * kb + (r & 3) + 8 * (r >> 2));
                        const float av_ = acc[kb][r];
                        const float pk = __uint_as_float(((__float_as_uint(av_) & 0xffffff80u) | hh4) | nlo); TOPK_INSERT(Lc, pk); }
                float Lo[16];
#pragma unroll
                for (int i = 0; i < 16; ++i) Lo[i] = __shfl_xor(Lc[i], 32);
#pragma unroll
                for (int i = 0; i < 16; ++i) TOPK_INSERT(Lc, Lo[i]);
#pragma unroll
                for (int i = 0; i < 16; ++i) { if (p == 0) L0[i] = Lc[i]; else L1[i] = Lc[i]; }
            }
            float R[16];
#pragma unroll
            for (int i = 0; i < 16; ++i) R[i] = NEG_INF;
            CandRow<0>::run(L0, L1, R);
            unsigned a0 = 0, a1 = 0, a2 = 0, a3 = 0, b0 = 0, b1 = 0, b2 = 0, b3 = 0;
#pragma unroll
            for (int i = 0; i < 4; ++i) { a0 |= (__builtin_bit_cast(unsigned, L0[i]) & 127u) << (8 * i); a1 |= (__builtin_bit_cast(unsigned, L0[4 + i]) & 127u) << (8 * i);
                a2 |= (__builtin_bit_cast(unsigned, L0[8 + i]) & 127u) << (8 * i); a3 |= (__builtin_bit_cast(unsigned, L0[12 + i]) & 127u) << (8 * i);
                b0 |= (__builtin_bit_cast(unsigned, L1[i]) & 127u) << (8 * i); b1 |= (__builtin_bit_cast(unsigned, L1[4 + i]) & 127u) << (8 * i);
                b2 |= (__builtin_bit_cast(unsigned, L1[8 + i]) & 127u) << (8 * i); b3 |= (__builtin_bit_cast(unsigned, L1[12 + i]) & 127u) << (8 * i); }
            float ex[16]; float sum = 0.f; int id[16];
#pragma unroll
            for (int r = 0; r < 16; ++r) { ex[r] = __expf(R[r] - R[0]); sum += ex[r];
                const unsigned cid = __builtin_bit_cast(unsigned, R[r]) & 255u;
                id[r] = (int)(pick4(a0, a1, a2, a3, (int)(cid >> 4)) * 128u + pick4(b0, b1, b2, b3, (int)(cid & 15u))); }
            const float inv = 1.f / sum;
            if (hh == 0) {
#pragma unroll
                for (int q = 0; q < 4; ++q) {
                    *(int4*)(IDX + m * 128 + h * 16 + 4 * q) = make_int4(id[4 * q], id[4 * q + 1], id[4 * q + 2], id[4 * q + 3]);
                    *(f32x4*)(GW + m * 128 + h * 16 + 4 * q) = (f32x4){ex[4 * q] * inv, ex[4 * q + 1] * inv, ex[4 * q + 2] * inv, ex[4 * q + 3] * inv}; }
            }
        }
    }
}

template <int B> __device__ __forceinline__ f32x2 fp4b(unsigned w) { return __builtin_amdgcn_cvt_scalef32_pk_f32_fp4(w, 1.0f, B); }
__device__ __forceinline__ void apply_phase(Frame& F, float* OUTP) {
    const unsigned char* U8 = F.ws + WS_LG; const unsigned char* V8 = F.ws + WS_LG + 8 * MiB;
    const float* USC = (const float*)(F.ws + WS_LG + 16 * MiB); const float* VSC = USC + NEXP;
    const int* IDX = (const int*)(F.ws + WS_K); const float* GW = (const float*)(F.ws + WS_K + 16 * MiB);
    const float* g2 = F.in[20]; const float* gf = F.in[25];
    const float* X1 = F.out;
    const int lane = F.lane;
    const int gw = F.bid * NWAVES + F.wave, NGW = F.G * NWAVES;
    const bool b5 = (lane & 32) != 0, b4 = (lane & 16) != 0, b3 = (lane & 8) != 0, b2 = (lane & 4) != 0;
    const int eid = ((lane >> 5) & 1) * 8 + ((lane >> 4) & 1) * 4 + ((lane >> 3) & 1) * 2 + ((lane >> 2) & 1);
    for (int grp = F.bid; grp < MTOK / 128; grp += F.G)
    for (int m = grp * 128 + F.wave; m < grp * 128 + 128; m += NWAVES) {
        f32x2 hv[8]; float s = 0.f;
#pragma unroll
        for (int q = 0; q < 4; ++q) { const f32x4 a = *(const f32x4*)(X1 + (size_t)m * DM + lane * 16 + q * 4);
            s += (a[0] * a[0] + a[1] * a[1]) + (a[2] * a[2] + a[3] * a[3]); hv[2 * q] = (f32x2){a[0], a[1]}; hv[2 * q + 1] = (f32x2){a[2], a[3]}; }
        const float r2 = rsqrtf(wave_sum(s) * (1.f / DM) + EPS) ;
#pragma unroll
        for (int q = 0; q < 4; ++q) { const f32x4 g = *(const f32x4*)(g2 + lane * 16 + q * 4);
            hv[2 * q] = hv[2 * q] * (f32x2){g[0] * r2, g[1] * r2}; hv[2 * q + 1] = hv[2 * q + 1] * (f32x2){g[2] * r2, g[3] * r2}; }
        const int i0 = IDX[(size_t)m * 128 + lane], i1 = IDX[(size_t)m * 128 + 64 + lane];
        const float gw0 = GW[(size_t)m * 128 + lane], gw1 = GW[(size_t)m * 128 + 64 + lane];
        f32x2 acc[8];
#pragma unroll
        for (int i = 0; i < 8; ++i) acc[i] = (f32x2){0.f, 0.f};
#pragma unroll 1
        for (int bt = 0; bt < 8; ++bt) {
            const int k0 = bt * 16;
            const int isel = (k0 < 64) ? i0 : i1;
            v2u uu[16], vv[16];
            const int myidx = __shfl(isel, (k0 + eid) & 63);
            const float su = USC[myidx], sv = VSC[myidx];
#pragma unroll
            for (int e = 0; e < 16; ++e) { const size_t ro = (size_t)__builtin_amdgcn_readlane(isel, (k0 + e) & 63) * (DM / 2) + lane * 8;
                uu[e] = *(const v2u*)(U8 + ro); vv[e] = *(const v2u*)(V8 + ro); }
            float x[16];
#pragma unroll
            for (int e = 0; e < 16; ++e) { f32x2 d = fp4b<0>(uu[e].x) * hv[0];
                d = __builtin_elementwise_fma(fp4b<1>(uu[e].x), hv[1], d); d = __builtin_elementwise_fma(fp4b<2>(uu[e].x), hv[2], d); d = __builtin_elementwise_fma(fp4b<3>(uu[e].x), hv[3], d);
                d = __builtin_elementwise_fma(fp4b<0>(uu[e].y), hv[4], d); d = __builtin_elementwise_fma(fp4b<1>(uu[e].y), hv[5], d); d = __builtin_elementwise_fma(fp4b<2>(uu[e].y), hv[6], d);
                d = __builtin_elementwise_fma(fp4b<3>(uu[e].y), hv[7], d); x[e] = d[0] + d[1]; }
            float y[8], z[4], u2[2], t;
#pragma unroll
            for (int j = 0; j < 8; ++j) { const float keep = b5 ? x[8 + j] : x[j], send = b5 ? x[j] : x[8 + j]; y[j] = keep + __shfl_xor(send, 32); }
#pragma unroll
            for (int j = 0; j < 4; ++j) { const float keep = b4 ? y[4 + j] : y[j], send = b4 ? y[j] : y[4 + j]; z[j] = keep + __shfl_xor(send, 16); }
#pragma unroll
            for (int j = 0; j < 2; ++j) { const float keep = b3 ? z[2 + j] : z[j], send = b3 ? z[j] : z[2 + j]; u2[j] = keep + __shfl_xor(send, 8); }
            { const float keep = b2 ? u2[1] : u2[0], send = b2 ? u2[0] : u2[1]; t = keep + __shfl_xor(send, 4); }
            t += __shfl_xor(t, 2); t += __shfl_xor(t, 1);
            const float gk = __shfl((k0 < 64) ? gw0 : gw1, (k0 + eid) & 63);
            const float wl = gk * gelu_fast(t * su) * sv;
#pragma unroll
            for (int e = 0; e < 16; ++e) {
                const float we = __builtin_bit_cast(float, __builtin_amdgcn_readlane(__builtin_bit_cast(int, wl), 32 * (e >> 3) + 16 * ((e >> 2) & 1) + 8 * ((e >> 1) & 1) + 4 * (e & 1)));
                const f32x2 w2 = (f32x2){we, we};
                acc[0] = __builtin_elementwise_fma(fp4b<0>(vv[e].x), w2, acc[0]); acc[1] = __builtin_elementwise_fma(fp4b<1>(vv[e].x), w2, acc[1]);
                acc[2] = __builtin_elementwise_fma(fp4b<2>(vv[e].x), w2, acc[2]); acc[3] = __builtin_elementwise_fma(fp4b<3>(vv[e].x), w2, acc[3]);
                acc[4] = __builtin_elementwise_fma(fp4b<0>(vv[e].y), w2, acc[4]); acc[5] = __builtin_elementwise_fma(fp4b<1>(vv[e].y), w2, acc[5]);
                acc[6] = __builtin_elementwise_fma(fp4b<2>(vv[e].y), w2, acc[6]); acc[7] = __builtin_elementwise_fma(fp4b<3>(vv[e].y), w2, acc[7]);
            }
        }
        float s2 = 0.f;
#pragma unroll
        for (int q = 0; q < 4; ++q) { const f32x4 a = *(const f32x4*)(X1 + (size_t)m * DM + lane * 16 + q * 4);
            acc[2 * q] = acc[2 * q] + (f32x2){a[0], a[1]}; acc[2 * q + 1] = acc[2 * q + 1] + (f32x2){a[2], a[3]};
            s2 += (acc[2 * q][0] * acc[2 * q][0] + acc[2 * q][1] * acc[2 * q][1]) + (acc[2 * q + 1][0] * acc[2 * q + 1][0] + acc[2 * q + 1][1] * acc[2 * q + 1][1]); }
        const float rf = rsqrtf(wave_sum(s2) * (1.f / DM) + EPS);
#pragma unroll
        for (int q = 0; q < 4; ++q) { const f32x4 g = *(const f32x4*)(gf + lane * 16 + q * 4);
            *(f32x4*)(OUTP + (size_t)m * DM + lane * 16 + q * 4) = (f32x4){acc[2 * q][0] * rf * g[0], acc[2 * q][1] * rf * g[1], acc[2 * q + 1][0] * rf * g[2], acc[2 * q + 1][1] * rf * g[3]}; }
    }
}

constexpr int N_PHASES = 13;
__global__ void __launch_bounds__(NTHR, 2) mega_fwd(Args args) {
    extern __shared__ __attribute__((aligned(16))) unsigned char lds[];
    Frame F;
    F.lds = (LAS unsigned char*)lds;
    F.tid = threadIdx.x; F.lane = F.tid & 63; F.wave = __builtin_amdgcn_readfirstlane(F.tid >> 6);
    F.G = gridDim.x; F.bid = blockIdx.x;
    F.in = args.in; F.out = args.out; F.ws = args.ws;
    volatile LAS unsigned* MISC = (volatile LAS unsigned*)(F.lds + MISC_OFF);
    for (int u = F.tid; u < (LDS_BYTES - LDSCTL_OFF) / 4; u += NTHR) ((LAS unsigned*)(F.lds + LDSCTL_OFF))[u] = 0u;
    __syncthreads();
    XcdBarrier bar; bar.bar = (unsigned*)(args.ws + WS_CTL) + CW_BAR; bar.x = 0; bar.st = nullptr;
    const bool one_launch = (args.ph_hi - args.ph_lo) > 1;
    if (one_launch) bar = xcd_barrier_post((unsigned*)(args.ws + WS_CTL) + CW_BAR, MISC + 8);
    const int lo = args.ph_lo, hi = args.ph_hi;
#define IN(k) (lo <= (k) && (k) < hi)
#define SEAM(k) do { if (IN(k) && IN((k) + 1)) xcd_barrier(bar); } while (0)
    unsigned char* ws = args.ws;

#ifndef PROBE_MASK
#define PROBE_MASK 0
#endif
#define REP(k) _Pragma("unroll") for (int rep_ = 0; rep_ < (((PROBE_MASK >> (k)) & 1) ? 2 : 1); ++rep_)
    if (IN(0)) REP(0) { p0_prologue(F); if (rep_ == 0 && ((PROBE_MASK >> 0) & 1)) xcd_barrier(bar); } SEAM(0);
    if (IN(1)) REP(1) {
        AddrPlain g{(const char*)(ws + WS_K), (const char*)(ws + WS_WIN), 1024, 1024, 1024};
        pg8::StaticOrder S; S.init(MTOK, 6144, F.G, F.bid, 4);
        EpiBf16<DstP1> E{DstP1{ws}};
        gates_phase(F);
        pg8::gemm_phase(F.lds, g, S, E);
    } SEAM(1);
    if (IN(2)) REP(2) { lru_phase<false>(F); mconv_phase(F); } SEAM(2);
    if (IN(3)) REP(3) { lru_phase<true>(F); } SEAM(3);
    if (IN(5)) REP(5) {
        const char* xc = (const char*)F.out + (size_t)MTOK * DM * 2;
        AddrQKV g{xc, (long)((const char*)(ws + WS_XM) - xc), (const char*)(ws + WS_WQKV), 1024, 256, 256};
        pg8::StaticOrder S; S.init(MTOK, 12 * 256, F.G, F.bid);
        EpiBf16<DstQKV> E{DstQKV{(char*)(ws + WS_LG), (long)WS_K - (long)WS_LG, (long)WS_XL - (long)WS_LG}};
        pg8::gemm_phase(F.lds, g, S, E);
    } SEAM(5);
    if (IN(6)) REP(6) { mscan_phase(F); } SEAM(6);
    if (IN(7)) { ym_phase(F); } SEAM(7);
    if (IN(8)) {
        AddrBranch g{(const char*)(ws + WS_OP), (long)((const char*)F.out - (const char*)(ws + WS_OP)), (const char*)(ws + WS_WB2), 1024, 1024, 1024};
        pg8::StaticOrder S; S.init(MTOK, 2048, F.G, F.bid);
        EpiGate E{(bf16*)(ws + WS_MG)};
        pg8::gemm_phase(F.lds, g, S, E);
    } SEAM(8);
    if (IN(9)) {
        AddrPlain g{(const char*)(ws + WS_MG), (const char*)(ws + WS_WOUT2), 2048, 2048, 2048};
        pg8::StaticOrder S; S.init(MTOK, 1024, F.G, F.bid);
        EpiResid E{F.in[0], F.out, (bf16*)(ws + WS_XM), (float*)(ws + WS_SS)};
        pg8::gemm_phase(F.lds, g, S, E);
    } SEAM(9);
    if (IN(10)) REP(10) {
        AddrPlain g{(const char*)(ws + WS_XM), (const char*)(ws + WS_WPQ), 1024, 1024, 1024};
        pg8::StaticOrder S; S.init(MTOK, 2048, F.G, F.bid);
        EpiPQ E{(bf16*)(ws + WS_MG), (const float*)(ws + WS_SS)};
        pg8::gemm_phase(F.lds, g, S, E);
    } SEAM(10);
    if (IN(11)) REP(11) { select_phase(F); }
    if (IN(11) && IN(12)) { asm volatile("s_waitcnt vmcnt(0)" ::: "memory"); __syncthreads(); }
    if (IN(12)) { if ((PROBE_MASK >> 12) & 1) { apply_phase(F, (float*)(ws + WS_MG)); xcd_barrier(bar); } apply_phase(F, F.out); }
#undef REP
#undef IN
#undef SEAM
}

extern "C" void kernel_launch(void* const* d_in, const int* in_sizes, int n_in, void* d_out, int out_size, void* d_ws, size_t ws_size, hipStream_t stream) {
    static int grid = 0;
    if (grid == 0) {
        if (n_in != 26 || in_sizes[0] != MTOK * DM || out_size != MTOK * DM || ws_size < WS_END) { fprintf(stderr, "kernel_launch: unexpected shapes / workspace (%zu < %zu)\n", ws_size, (size_t)WS_END); grid = -1; return; }
        int dev = 0, cus = 0, per_cu = 0;
        if (hipGetDevice(&dev) != hipSuccess || hipDeviceGetAttribute(&cus, hipDeviceAttributeMultiprocessorCount, dev) != hipSuccess) { grid = -1; return; }
        if (hipFuncSetAttribute((const void*)mega_fwd, hipFuncAttributeMaxDynamicSharedMemorySize, LDS_BYTES) != hipSuccess) { fprintf(stderr, "kernel_launch: hipFuncSetAttribute failed\n"); grid = -1; return; }
        if (hipOccupancyMaxActiveBlocksPerMultiprocessor(&per_cu, (const void*)mega_fwd, NTHR, LDS_BYTES) != hipSuccess || per_cu < 1) { fprintf(stderr, "kernel_launch: occupancy query says %d blocks/CU\n", per_cu); (void)hipGetLastError(); grid = -1; return; }
        grid = cus;
    }
    if (grid < 0) return;
    (void)hipMemsetAsync((char*)d_ws + WS_CTL, 0, CTL_ZERO_BYTES, stream);
    Args a{};
    for (int i = 0; i < 26; ++i) a.in[i] = (const float*)d_in[i];
    a.out = (float*)d_out; a.ws = (unsigned char*)d_ws;
#if MK_N_LAUNCHES == 1
    a.ph_lo = 0; a.ph_hi = N_PHASES;
    void* kargs[] = {&a};
    hipError_t e = hipLaunchCooperativeKernel((const void*)mega_fwd, dim3(grid), dim3(NTHR), kargs, LDS_BYTES, stream);
    if (e != hipSuccess) fprintf(stderr, "kernel_launch: cooperative launch failed: %s (grid %d)\n", hipGetErrorString(e), grid);
#else
    for (int p = 0; p < N_PHASES; ++p) { a.ph_lo = p; a.ph_hi = p + 1; hipLaunchKernelGGL(mega_fwd, dim3(grid), dim3(NTHR), LDS_BYTES, stream, a); }
#endif
}
```

```cpp
#include <hip/hip_runtime.h>
#include <cstdio>
#include <cstdint>
#include <math.h>

#ifndef MK_N_LAUNCHES
#define MK_N_LAUNCHES 1
#endif

constexpr int BATCH = 8, SEQ = 4096, DM = 1024, MTOK = BATCH * SEQ;
constexpr int DIN = 6160;
constexpr int NEXP = 16384;
constexpr float EPS = 1e-6f;

constexpr size_t MiB = 1u << 20;
constexpr size_t WS_CTL = 0, CTL_ZERO_BYTES = 1 * MiB;
constexpr size_t WS_WIN = 1 * MiB;
constexpr size_t WS_WQKV = 13 * MiB;
constexpr size_t WS_KEYS = 14 * MiB + 512 * 1024;
constexpr size_t WS_WLRU = 15 * MiB;
constexpr size_t WS_WB2 = 16 * MiB;
constexpr size_t WS_WOUT2 = 20 * MiB;
constexpr size_t WS_WPQ = 24 * MiB;
constexpr size_t WS_GATE = 28 * MiB;
constexpr size_t WS_WGT = 30 * MiB;
constexpr size_t WS_XM = 32 * MiB;
constexpr size_t WS_OP = 96 * MiB;
constexpr size_t WS_XL = 160 * MiB;
constexpr size_t WS_LG = 224 * MiB;
constexpr size_t WS_MG = 288 * MiB;
constexpr size_t WS_K = 416 * MiB;
constexpr size_t WS_AGG = 480 * MiB;
constexpr size_t WS_SS = 488 * MiB;
constexpr size_t WS_END = 489 * MiB;

constexpr int CW_BAR = 4096;

constexpr int RING_BYTES = 131072;
constexpr int LDS_BYTES = 147456;
constexpr int LDSCTL_OFF = LDS_BYTES - 512, MISC_OFF = LDSCTL_OFF + 320;
constexpr int NWAVES = 8, NTHR = 512;

#define GAS __attribute__((address_space(1)))
#define LAS __attribute__((address_space(3)))
typedef unsigned short bf16;
typedef unsigned v4u __attribute__((ext_vector_type(4)));
typedef unsigned v2u __attribute__((ext_vector_type(2)));
typedef float f32x4 __attribute__((ext_vector_type(4)));
typedef float f32x2 __attribute__((ext_vector_type(2)));
typedef short bf16x8 __attribute__((ext_vector_type(8)));
typedef GAS unsigned gu32;
#define RLX_AGENT __ATOMIC_RELAXED, __HIP_MEMORY_SCOPE_AGENT
#define LDS_WAIT() asm volatile("s_waitcnt lgkmcnt(0)" ::: "memory")
#define VM_WAIT() asm volatile("s_waitcnt vmcnt(0)" ::: "memory")

__device__ __forceinline__ unsigned f2bf(float f) { unsigned u = __builtin_bit_cast(unsigned, f); return (u + 0x7fffu + ((u >> 16) & 1u)) >> 16; }
__device__ __forceinline__ unsigned pk2(float lo, float hi) { return f2bf(lo) | (f2bf(hi) << 16); }
__device__ __forceinline__ float bf2f(unsigned short h) { return __builtin_bit_cast(float, (unsigned)h << 16); }
__device__ __forceinline__ float bflo(unsigned w) { return __builtin_bit_cast(float, w << 16); }
__device__ __forceinline__ float bfhi(unsigned w) { return __builtin_bit_cast(float, w & 0xffff0000u); }
__device__ __forceinline__ float wave_sum(float v) {
#pragma unroll
  for (int o = 1; o < 64; o <<= 1) v += __shfl_xor(v, o);
  return v;
}
__device__ __forceinline__ float sigmoidf_(float x) { return __builtin_amdgcn_rcpf(1.f + __builtin_amdgcn_exp2f(x * -1.44269504089f)); }
__device__ __forceinline__ float gelu_erf(float x) { return 0.5f * x * (1.f + erff(x * 0.70710678118654752f)); }
__device__ __forceinline__ float gelu_fast(float v) {
    const float av = fabsf(v), t = __builtin_amdgcn_rcpf(av * 0.2316418882f + 1.0f);
    float q = t * 0.5307027145f + (-0.7265760135f); q = q * t + 0.7107068705f; q = q * t + (-0.142248368f); q = q * t + 0.127414796f; q = q * t;
    const float e = __builtin_amdgcn_exp2f((v * v) * (-0.72134752044f));
    const float m = v * (q * e);
    return v < 0.f ? m : v - m;
}
__device__ __forceinline__ float softplusf_(float x) { return fmaxf(x, 0.f) + log1pf(expf(-fabsf(x))); }

namespace pg8 {
#define PG8_LAS __attribute__((address_space(3)))
typedef unsigned short bf16_t;
typedef unsigned u32x4 __attribute__((ext_vector_type(4)));
constexpr int BM = 256, BK = 64, HALF = 128, HTB = HALF * BK * 2, STAGE_BYTES = 8 * HTB, NXCD = 8;

__host__ __device__ __forceinline__ int lds_byte(int r, int c) { const int st = (r >> 4) * 2 + (c >> 5), rr = r & 15, cc = c & 31, ob = rr * 64 + cc * 2; return st * 1024 + (ob ^ (((ob >> 9) & 1) << 5)); }
__host__ __device__ __forceinline__ void stage_rc(int b, int& R, int& C) { const int st = b / 1024, sb = b % 1024, swz = sb ^ (((sb >> 9) & 1) << 5); R = (st >> 1) * 16 + swz / 64; C = (st & 1) * 32 + (swz % 64) / 2; }
__host__ __device__ __forceinline__ int perm32(int rho) { const int n = rho >> 4, i = rho & 15; return 8 * (i >> 2) + 4 * n + (i & 3); }

struct Unit { int pm, pn; };
struct StaticOrder {
    int nM, nN, nwg, G, c, WGM;
    __host__ __device__ void init(int M, int N, int G_, int c_, int wgm = 8) { nM = M / BM; nN = N / BM; nwg = nM * nN; G = G_; c = c_; WGM = wgm; }
    __host__ __device__ bool next(int i, Unit& u) const {
        const long L = (long)i * G + c; if (L >= nwg) return false;
        int wgid = (int)L; { const int q = nwg / NXCD, r = nwg % NXCD, xcd = wgid % NXCD, off = wgid / NXCD; wgid = (xcd < r ? xcd * (q + 1) : r * (q + 1) + (xcd - r) * q) + off; }
        const int nig = WGM * nN, gid = wgid / nig, fm = gid * WGM, gsz = (nM - fm) < WGM ? (nM - fm) : WGM;
        u.pm = fm + ((wgid % nig) % gsz); u.pn = (wgid % nig) / gsz; return true;
    }
};

__device__ __forceinline__ unsigned cvt_pk_bf16(float lo, float hi) { unsigned r; asm volatile("v_cvt_pk_bf16_f32 %0, %1, %2" : "=v"(r) : "v"(lo), "v"(hi)); return r; }

template <class Epi, class Addr>
__device__ __forceinline__ void gemm_phase(PG8_LAS unsigned char* lds, const Addr g, const StaticOrder& S, const Epi& E) {
    const int tid = threadIdx.x, wid = __builtin_amdgcn_readfirstlane(tid >> 6), lane = tid & 63, wr = wid >> 2, wc = wid & 3, fr = lane & 15, fq = lane >> 4;
    const int K = g.K, nt = K / BK;
    unsigned voffA[2], voffB[2];
#pragma unroll
    for (int i = 0; i < 2; ++i) { int R, C; stage_rc(tid * 16 + i * 8192, R, C); const int Rb = Epi::PERM ? ((R & ~31) + perm32(R & 31)) : R;
        voffA[i] = (unsigned)(R * g.lda + C) * 2u; voffB[i] = (unsigned)(Rb * g.ldb + C) * 2u; }
    const size_t kstep = (size_t)(BK * 2);
    const size_t hsA = (size_t)HALF * g.lda * 2, hsB = (size_t)HALF * g.ldb * 2;
    const unsigned ldsw = (unsigned)wid * 1024u;
    const int aoff = lds_byte(wr * 64 + fr, fq * 8), boff = lds_byte(wc * 32 + fr, fq * 8);
#define PG8_SA(b, h) (((b) * 2 + (h)) * HTB)
#define PG8_SB(b, h) ((4 + (b) * 2 + (h)) * HTB)
#define PG8_STAGE(bufoff, gbase, voff) do { _Pragma("unroll") for (int _i = 0; _i < 2; ++_i) \
        __builtin_amdgcn_global_load_lds((const unsigned*)((const char*)(gbase) + (voff)[_i]), (PG8_LAS unsigned*)(lds + (bufoff) + ldsw + _i * 8192), 16, 0, 0); } while (0)
#define PG8_LDA(dst, b, h) do { _Pragma("unroll") for (int m = 0; m < 4; ++m) _Pragma("unroll") for (int k = 0; k < 2; ++k) dst[m][k] = *(const PG8_LAS bf16x8*)(lds + PG8_SA(b, h) + aoff + m * 2048 + k * 1024); } while (0)
#define PG8_LDB(dst, b, h) do { _Pragma("unroll") for (int n = 0; n < 2; ++n) _Pragma("unroll") for (int k = 0; k < 2; ++k) dst[n][k] = *(const PG8_LAS bf16x8*)(lds + PG8_SB(b, h) + boff + n * 2048 + k * 1024); } while (0)
#define PG8_MMA(ai, bj, At, Bt) do { __builtin_amdgcn_s_setprio(1); _Pragma("unroll") for (int m = 0; m < 4; ++m) _Pragma("unroll") for (int n = 0; n < 2; ++n) _Pragma("unroll") for (int k = 0; k < 2; ++k) \
        acc[ai][bj][m][n] = __builtin_amdgcn_mfma_f32_16x16x32_bf16(Bt[n][k], At[m][k], acc[ai][bj][m][n], 0, 0, 0); __builtin_amdgcn_s_setprio(0); } while (0)
#define PG8_WAIT_V(n) asm volatile("s_waitcnt vmcnt(" #n ")" ::: "memory")
#define PG8_WAIT_L(n) asm volatile("s_waitcnt lgkmcnt(" #n ")" ::: "memory")
#define PG8_BAR __builtin_amdgcn_s_barrier()
#define PG8_SCHED __builtin_amdgcn_sched_barrier(0)
    Unit cur, nxt; int ui = 0;
    if (!S.next(0, cur)) return;
    f32x4 acc[2][2][4][2];
#pragma unroll
    for (int a = 0; a < 2; ++a)
#pragma unroll
        for (int b = 0; b < 2; ++b)
#pragma unroll
            for (int m = 0; m < 4; ++m)
#pragma unroll
                for (int n = 0; n < 2; ++n) acc[a][b][m][n] = (f32x4){0.f, 0.f, 0.f, 0.f};
    bf16x8 At[4][2], B0[2][2], B1[2][2];
    const char* cA = g.a(cur); const char* cB = g.b(cur);
    PG8_STAGE(PG8_SB(0, 0), cB, voffB); PG8_STAGE(PG8_SB(0, 1), cB + hsB, voffB); PG8_STAGE(PG8_SA(0, 0), cA, voffA); PG8_STAGE(PG8_SA(0, 1), cA + hsA, voffA);
    if (wr == 1) PG8_BAR;
    PG8_WAIT_V(2); PG8_BAR;
    PG8_STAGE(PG8_SB(1, 0), cB + kstep, voffB); PG8_STAGE(PG8_SA(1, 0), cA + kstep, voffA); PG8_STAGE(PG8_SB(1, 1), cB + hsB + kstep, voffB);
    PG8_WAIT_V(6); PG8_BAR;
    for (;;) {
        const bool has_next = S.next(ui + 1, nxt);
        const char* nA = has_next ? g.a(nxt) : cA; const char* nB = has_next ? g.b(nxt) : cB;
#pragma unroll 1
        for (int t = 0; t < nt; t += 2) {
            const bool last = (t == nt - 2);
            const char* a1 = cA + (size_t)(t + 1) * kstep;
            const char* a2 = last ? nA : cA + (size_t)(t + 2) * kstep; const char* b2 = last ? nB : cB + (size_t)(t + 2) * kstep;
            const char* a3 = a2 + kstep; const char* b3 = b2 + kstep;
            PG8_LDB(B0, 0, 0); PG8_LDB(B1, 0, 1); PG8_SCHED; PG8_LDA(At, 0, 0); PG8_STAGE(PG8_SA(1, 1), a1 + hsA, voffA);
            PG8_WAIT_V(8); PG8_WAIT_L(0); PG8_BAR; PG8_MMA(0, 0, At, B0); PG8_MMA(0, 1, At, B1); PG8_BAR; PG8_SCHED;
            PG8_LDA(At, 0, 1); PG8_STAGE(PG8_SB(0, 0), b2, voffB); PG8_STAGE(PG8_SB(0, 1), b2 + hsB, voffB); PG8_STAGE(PG8_SA(0, 0), a2, voffA);
            PG8_WAIT_V(8); PG8_WAIT_L(0); PG8_BAR; PG8_MMA(1, 0, At, B0); PG8_MMA(1, 1, At, B1); PG8_BAR; PG8_SCHED;
            PG8_LDB(B0, 1, 0); PG8_LDB(B1, 1, 1); PG8_SCHED; PG8_LDA(At, 1, 0); PG8_STAGE(PG8_SA(0, 1), a2 + hsA, voffA);
            PG8_WAIT_V(8); PG8_WAIT_L(0); PG8_BAR; PG8_MMA(0, 0, At, B0); PG8_MMA(0, 1, At, B1); PG8_BAR; PG8_SCHED;
            PG8_LDA(At, 1, 1); PG8_STAGE(PG8_SB(1, 0), b3, voffB); PG8_STAGE(PG8_SB(1, 1), b3 + hsB, voffB); PG8_STAGE(PG8_SA(1, 0), a3, voffA);
            PG8_WAIT_V(8); PG8_WAIT_L(0); PG8_BAR; PG8_MMA(1, 0, At, B0); PG8_MMA(1, 1, At, B1); PG8_BAR; PG8_SCHED;
        }
        if (wr == 0) PG8_BAR;
        E(acc, cur, wr, wc, fr, fq);
        if (!has_next) break;
#pragma unroll
        for (int a = 0; a < 2; ++a)
#pragma unroll
            for (int b = 0; b < 2; ++b)
#pragma unroll
                for (int m = 0; m < 4; ++m)
#pragma unroll
                    for (int n = 0; n < 2; ++n) acc[a][b][m][n] = (f32x4){0.f, 0.f, 0.f, 0.f};
        cur = nxt; cA = nA; cB = nB; ++ui;
        if (wr == 1) PG8_BAR;
    }
    PG8_WAIT_V(0);
    PG8_BAR;
#undef PG8_SA
#undef PG8_SB
#undef PG8_STAGE
#undef PG8_LDA
#undef PG8_LDB
#undef PG8_MMA
#undef PG8_WAIT_V
#undef PG8_WAIT_L
#undef PG8_BAR
#undef PG8_SCHED
}
}

#define XB_TMO      128
#define XB_XCNT(j)  (256  + 64 * (j))
#define XB_XSUB(j)  (1280 + 64 * (j))
#define XB_XGEN(j)  (2304 + 64 * (j))
#define XB_TOP      3328
#define XB_TOPGEN   3392
#define XCD_BAR_WORDS 3456
#define XB_SPIN_CAP (1u << 18)
__device__ __forceinline__ unsigned xb_ld(unsigned* p)              { return __hip_atomic_load(p, __ATOMIC_RELAXED, __HIP_MEMORY_SCOPE_AGENT); }
__device__ __forceinline__ unsigned xb_add(unsigned* p, unsigned v) { return __hip_atomic_fetch_add(p, v, __ATOMIC_RELAXED, __HIP_MEMORY_SCOPE_AGENT); }
__device__ __forceinline__ unsigned xb_xcc_id() { return (unsigned)__builtin_amdgcn_s_getreg((3 << 11) | 20) & 0xFu; }
#define XB_SPIN(cond, bar) do { unsigned _sp = 0; while (cond) { __builtin_amdgcn_s_sleep(1); \
    if ((++_sp & 255u) == 0u) { if (xb_ld(&(bar)[XB_TMO])) break; if (_sp > XB_SPIN_CAP) { atomicAdd(&(bar)[XB_TMO], 1u); break; } } } } while (0)
struct XcdBarrier { unsigned* bar; unsigned x; volatile LAS unsigned* st; };
__device__ __forceinline__ XcdBarrier xcd_barrier_post(unsigned* bar, volatile LAS unsigned* st) {
    XcdBarrier b; b.bar = bar; b.x = xb_xcc_id(); b.st = st;
    if (threadIdx.x == 0) (void)xb_add(&bar[XB_XCNT(b.x)], 1u);
    return b;
}
__device__ __forceinline__ void xcd_barrier_complete(unsigned* bar, unsigned x, unsigned& nloc, unsigned& nx) {
    const unsigned G = gridDim.x * gridDim.y * gridDim.z;
    unsigned sum, cnt, mine, sp = 0u;
    for (;;) {
        sum = 0u; cnt = 0u; mine = 0u;
#pragma unroll
        for (unsigned j = 0; j < 16; ++j) { const unsigned c = xb_ld(&bar[XB_XCNT(j)]); sum += c; cnt += (c > 0u) ? 1u : 0u; mine = (j == x) ? c : mine; }
        if (sum == G) break;
        __builtin_amdgcn_s_sleep(1);
        if ((++sp & 255u) == 0u) { if (xb_ld(&bar[XB_TMO])) break; if (sp > XB_SPIN_CAP) { atomicAdd(&bar[XB_TMO], 1u); break; } }
    }
    nloc = mine > 0u ? mine : 1u; nx = cnt > 0u ? cnt : 1u;
}
__device__ __forceinline__ void xcd_barrier(const XcdBarrier& b) {
    asm volatile("s_waitcnt vmcnt(0)" ::: "memory");
    __syncthreads();
    if (threadIdx.x == 0) {
        unsigned* bar = b.bar;
        __builtin_amdgcn_s_waitcnt(0);
        unsigned nloc = b.st[0], nx = b.st[1];
        if (nloc == 0u) { xcd_barrier_complete(bar, b.x, nloc, nx); b.st[0] = nloc; b.st[1] = nx; }
        const unsigned old = xb_add(&bar[XB_XSUB(b.x)], 1u);
        const unsigned gen = old / nloc;
        if (old + 1u == (gen + 1u) * nloc) {
            __builtin_amdgcn_fence(__ATOMIC_RELEASE, "agent");
            asm volatile("s_waitcnt vmcnt(0)" ::: "memory");
            const unsigned og = xb_add(&bar[XB_TOP], 1u);
            const unsigned tg = og / nx;
            if (og + 1u == (tg + 1u) * nx) xb_add(&bar[XB_TOPGEN], 1u);
            else XB_SPIN(xb_ld(&bar[XB_TOPGEN]) == tg, bar);
            __builtin_amdgcn_fence(__ATOMIC_ACQUIRE, "agent");
            xb_add(&bar[XB_XGEN(b.x)], 1u);
            asm volatile("s_waitcnt vmcnt(0)" ::: "memory");
        } else {
            XB_SPIN(xb_ld(&bar[XB_XGEN(b.x)]) == gen, bar);
            __builtin_amdgcn_fence(__ATOMIC_ACQUIRE, "agent");
            asm volatile("s_waitcnt vmcnt(0)" ::: "memory");
        }
    }
    __syncthreads();
}

struct Args { const float* in[26]; float* out; unsigned char* ws; int ph_lo, ph_hi; };
struct Frame {
    LAS unsigned char* lds;
    int tid, lane, wave, G, bid;
    const float* const* in; float* out; unsigned char* ws;
};

__device__ __forceinline__ void tr_item(const float* W, int ldw, bf16* WT, int ldt, float scale, const float* kscale, LAS float* scr, int k0, int lane) {
#pragma unroll 8
    for (int i = 0; i < 32; ++i) { const int kk = 2 * i + (lane >> 5); float v = W[(size_t)(k0 + kk) * ldw + (lane & 31)] * scale; if (kscale) v *= kscale[k0 + kk]; scr[kk * 33 + (lane & 31)] = v; }
    LDS_WAIT(); asm volatile("" ::: "memory");
    const int c = lane & 7;
#pragma unroll
    for (int j = 0; j < 4; ++j) { const int n = (lane >> 3) + 8 * j; const LAS float* s = scr + (8 * c) * 33 + n;
        v4u o; o.x = pk2(s[0 * 33], s[1 * 33]); o.y = pk2(s[2 * 33], s[3 * 33]); o.z = pk2(s[4 * 33], s[5 * 33]); o.w = pk2(s[6 * 33], s[7 * 33]);
        *(GAS v4u*)(WT + (size_t)n * ldt + k0 + 8 * c) = o; }
    LDS_WAIT(); asm volatile("" ::: "memory");
}

__device__ __forceinline__ void p0_prologue(Frame& F) {
    LAS float* scr = (LAS float*)(F.lds + F.wave * 16384);
    const int gw = F.bid * NWAVES + F.wave, NGW = F.G * NWAVES;
    unsigned char* ws = F.ws;
    const float* w_in = F.in[2];
    constexpr int I_WIN = 16 * 192, I_QKV = 12 * 32, I_LRU = 32 * 8, I_WB = 2 * 512, I_WO = 2 * 512, I_PQ = 16 * 64;
    constexpr int NITEMS = I_WIN + I_QKV + I_LRU + I_WB + I_WO + I_PQ;
    for (int it = gw; it < NITEMS; it += NGW) {
        int r = it;
        if (r < I_WIN) { const int kb = r / 192, nb = r % 192, n0 = nb * 32, sc = n0 < 2048 ? n0 : n0 + 16;
            tr_item(w_in + sc, DIN, (bf16*)(ws + WS_WIN) + (size_t)n0 * 1024, 1024, 1.f, nullptr, scr, kb * 64, F.lane); continue; }
        r -= I_WIN;
        if (r < I_QKV) { const int mat = r / 32, rr = r % 32, kb = rr / 8, nb = rr % 8, g = mat >> 2, h = mat & 3;
            const float* W = F.in[6 + g] + (size_t)h * 65536 + nb * 32;
            tr_item(W, 256, (bf16*)(ws + WS_WQKV) + (size_t)mat * 65536 + (size_t)(nb * 32) * 256, 256, g == 1 ? 0.0625f : 1.f, nullptr, scr, kb * 64, F.lane); continue; }
        r -= I_QKV;
        if (r < I_LRU) { const int mat = r / 8, rr = r % 8, kb = rr / 4, nb = rr % 4, gate = mat & 1, db = mat >> 1;
            const float* W = F.in[gate ? 14 : 12] + (size_t)db * 16384 + nb * 32;
            tr_item(W, 128, (bf16*)(ws + WS_WLRU) + (size_t)mat * 16384 + (size_t)(nb * 32) * 128, 128, 1.f, nullptr, scr, kb * 64, F.lane); continue; }
        r -= I_LRU;
        if (r < I_WB) { const int mat = r / 512, rr = r % 512, kb = rr / 32, nb = rr % 32;
            const float* W = F.in[17 + mat] + nb * 32;
            tr_item(W, 1024, (bf16*)(ws + WS_WB2) + (size_t)(mat * 1024 + nb * 32) * 1024, 1024, 1.f, nullptr, scr, kb * 64, F.lane); continue; }
        r -= I_WB;
        if (r < I_WO) { const int cp = r / 512, rr = r % 512, kb = rr / 32, nb = rr % 32;
            const float* W = F.in[19] + nb * 32;
            tr_item(W, 1024, (bf16*)(ws + WS_WOUT2) + (size_t)(nb * 32) * 2048 + cp * 1024, 2048, 1.f, nullptr, scr, kb * 64, F.lane); continue; }
        r -= I_WO;
        { const int kb = r / 64, nb = r % 64;
            const float* W = F.in[21] + nb * 32;
            tr_item(W, 2048, (bf16*)(ws + WS_WPQ) + (size_t)(nb * 32) * 1024, 1024, 1.f, F.in[20], scr, kb * 64, F.lane); }
    }
    { const int gt = F.bid * NTHR + F.tid, NGT = F.G * NTHR;
      const float4* ks = (const float4*)F.in[22]; v2u* kd = (v2u*)(ws + WS_KEYS);
      for (int i = gt; i < 8 * 2 * 128 * 128 / 4; i += NGT) { const float4 v = ks[i]; v2u o; o.x = pk2(v.x, v.y); o.y = pk2(v.z, v.w); kd[i] = o; }
      float* ss = (float*)(ws + WS_SS);
      for (int i = gt; i < MTOK; i += NGT) ss[i] = 0.f; }
    { const int gt = F.bid * NTHR + F.tid;
      if (gt < 16 * 128) { const int c = gt >> 7, k8 = gt & 127; v4u o; unsigned wv[4];
#pragma unroll
          for (int j = 0; j < 4; ++j) wv[j] = pk2(w_in[(size_t)(k8 * 8 + 2 * j) * DIN + 2048 + c], w_in[(size_t)(k8 * 8 + 2 * j + 1) * DIN + 2048 + c]);
          o.x = wv[0]; o.y = wv[1]; o.z = wv[2]; o.w = wv[3]; *(v4u*)((bf16*)(ws + WS_WGT) + c * 1024 + k8 * 8) = o; } }
    const float* x = F.in[0]; const float* g1 = F.in[1];
    bf16* XN = (bf16*)(ws + WS_K);
    f32x4 gv[4];
#pragma unroll
    for (int j = 0; j < 4; ++j) gv[j] = ((const f32x4*)g1)[F.lane + 64 * j];
    for (int m = 2 * gw; m < MTOK; m += 2 * NGW) {
        const f32x4* xr0 = (const f32x4*)(x + (size_t)m * DM) + F.lane; const f32x4* xr1 = xr0 + DM / 4;
        f32x4 v0[4], v1[4]; float s0 = 0.f, s1 = 0.f;
#pragma unroll
        for (int j = 0; j < 4; ++j) { v0[j] = xr0[64 * j]; v1[j] = xr1[64 * j]; }
#pragma unroll
        for (int j = 0; j < 4; ++j) { s0 += (v0[j].x * v0[j].x + v0[j].y * v0[j].y) + (v0[j].z * v0[j].z + v0[j].w * v0[j].w); s1 += (v1[j].x * v1[j].x + v1[j].y * v1[j].y) + (v1[j].z * v1[j].z + v1[j].w * v1[j].w); }
        const float r0 = rsqrtf(wave_sum(s0) * (1.f / DM) + EPS), r1 = rsqrtf(wave_sum(s1) * (1.f / DM) + EPS);
        unsigned long long* o0 = (unsigned long long*)(XN + (size_t)m * DM) + F.lane; unsigned long long* o1 = o0 + DM / 4;
#pragma unroll
        for (int j = 0; j < 4; ++j) { const f32x4 a = v0[j] * r0 * gv[j], c = v1[j] * r1 * gv[j];
            o0[64 * j] = (unsigned long long)pk2(a.x, a.y) | ((unsigned long long)pk2(a.z, a.w) << 32);
            o1[64 * j] = (unsigned long long)pk2(c.x, c.y) | ((unsigned long long)pk2(c.z, c.w) << 32); }
    }
}
__device__ __forceinline__ void gates_phase(Frame& F) {
    const bf16* XN = (const bf16*)(F.ws + WS_K); const bf16* WGT = (const bf16*)(F.ws + WS_WGT); float* GT = (float*)(F.ws + WS_GATE);
    const int lane = F.lane, fr = lane & 15, fq = lane >> 4;
    const f32x4 bg4 = *(const f32x4*)(F.in[3] + 4 * fq);
    for (int task = F.bid * NWAVES + F.wave; task < MTOK / 16; task += F.G * NWAVES) {
        const size_t m0 = (size_t)task * 16;
        f32x4 acc = (f32x4){0.f, 0.f, 0.f, 0.f};
#pragma unroll 8
        for (int ks = 0; ks < 32; ++ks) {
            const bf16x8 wfr = *(const bf16x8*)(WGT + fr * 1024 + 32 * ks + 8 * fq);
            const bf16x8 xfr = *(const bf16x8*)(XN + (m0 + fr) * DM + 32 * ks + 8 * fq);
            acc = __builtin_amdgcn_mfma_f32_16x16x32_bf16(wfr, xfr, acc, 0, 0, 0);
        }
        *(f32x4*)(GT + (m0 + fr) * 16 + 4 * fq) = acc + bg4;
    }
}

struct AddrPlain {
    const char* A; const char* Bt; int lda, ldb, K;
    __device__ __forceinline__ const char* a(const pg8::Unit& u) const { return A + (size_t)u.pm * 256 * lda * 2; }
    __device__ __forceinline__ const char* b(const pg8::Unit& u) const { return Bt + (size_t)u.pn * 256 * ldb * 2; }
};
struct AddrQKV {
    const char* XC; long dXM; const char* W; int lda, ldb, K;
    __device__ __forceinline__ const char* a(const pg8::Unit& u) const { return XC + (u.pn < 8 ? 0l : dXM) + ((size_t)u.pm * 256 * 1024 + (u.pn & 3) * 256) * 2; }
    __device__ __forceinline__ const char* b(const pg8::Unit& u) const { return W + (size_t)u.pn * 65536 * 2; }
};
struct AddrBranch {
    const char* YM; long dYL; const char* W; int lda, ldb, K;
    __device__ __forceinline__ const char* a(const pg8::Unit& u) const { return YM + (u.pn < 4 ? 0l : dYL) + (size_t)u.pm * 256 * 1024 * 2; }
    __device__ __forceinline__ const char* b(const pg8::Unit& u) const { return W + (size_t)u.pn * 256 * 1024 * 2; }
};

struct DstP1 { unsigned char* ws;
    __device__ __forceinline__ bf16* get(int pn, int& ld, int& col0) const {
        const bool mg = pn >= 16; ld = mg ? 2048 : 1024; col0 = mg ? (pn - 16) * 256 : (pn & 3) * 256;
        return (bf16*)(ws + (mg ? WS_MG : WS_XM + (size_t)(pn >> 2) * 64 * MiB)); } };
struct DstQKV { char* q; long dk, dv;
    __device__ __forceinline__ bf16* get(int pn, int& ld, int& col0) const { ld = 1024; col0 = (pn & 3) * 256; return (bf16*)(q + (pn >= 4 ? (pn >= 8 ? dv : dk) : 0l)); } };
template <class Dst> struct EpiBf16 {
    static constexpr bool PERM = true;
    Dst dst;
    __device__ __forceinline__ void operator()(const f32x4 (&acc)[2][2][4][2], const pg8::Unit& u, int wr, int wc, int fr, int fq) const {
        int ld, colt; bf16* base = dst.get(u.pn, ld, colt);
        const int row0 = u.pm * 256 + wr * 64 + fr, col0 = colt + wc * 32 + 8 * fq;
#pragma unroll
        for (int ai = 0; ai < 2; ++ai)
#pragma unroll
            for (int m = 0; m < 4; ++m) { bf16* rowp = base + (size_t)(row0 + ai * 128 + m * 16) * ld + col0;
#pragma unroll
                for (int bj = 0; bj < 2; ++bj) { const f32x4 v0 = acc[ai][bj][m][0], v1 = acc[ai][bj][m][1];
                    v4u w; w.x = pg8::cvt_pk_bf16(v0[0], v0[1]); w.y = pg8::cvt_pk_bf16(v0[2], v0[3]); w.z = pg8::cvt_pk_bf16(v1[0], v1[1]); w.w = pg8::cvt_pk_bf16(v1[2], v1[3]);
                    *(v4u*)(rowp + bj * 128) = w; } }
    }
};
template <bool ADD> struct EpiMerge {
    static constexpr bool PERM = true;
    bf16* MRG; const bf16* MG; int gcol;
    __device__ __forceinline__ void operator()(const f32x4 (&acc)[2][2][4][2], const pg8::Unit& u, int wr, int wc, int fr, int fq) const {
        const int row0 = u.pm * 256 + wr * 64 + fr, col0 = u.pn * 256 + wc * 32 + 8 * fq;
#pragma unroll
        for (int ai = 0; ai < 2; ++ai)
#pragma unroll
            for (int m = 0; m < 4; ++m) { const size_t row = (size_t)(row0 + ai * 128 + m * 16); bf16* rowp = MRG + row * 1024 + col0; const bf16* gp = MG + row * 2048 + gcol + col0;
#pragma unroll
                for (int bj = 0; bj < 2; ++bj) { const f32x4 v0 = acc[ai][bj][m][0], v1 = acc[ai][bj][m][1];
                    const v4u g = *(const v4u*)(gp + bj * 128);
                    float o[8] = {v0[0] * sigmoidf_(bflo(g.x)), v0[1] * sigmoidf_(bfhi(g.x)), v0[2] * sigmoidf_(bflo(g.y)), v0[3] * sigmoidf_(bfhi(g.y)),
                                  v1[0] * sigmoidf_(bflo(g.z)), v1[1] * sigmoidf_(bfhi(g.z)), v1[2] * sigmoidf_(bflo(g.w)), v1[3] * sigmoidf_(bfhi(g.w))};
                    if (ADD) { const v4u t = *(const v4u*)(rowp + bj * 128);
                        o[0] += bflo(t.x); o[1] += bfhi(t.x); o[2] += bflo(t.y); o[3] += bfhi(t.y); o[4] += bflo(t.z); o[5] += bfhi(t.z); o[6] += bflo(t.w); o[7] += bfhi(t.w); }
                    v4u w; w.x = pg8::cvt_pk_bf16(o[0], o[1]); w.y = pg8::cvt_pk_bf16(o[2], o[3]); w.z = pg8::cvt_pk_bf16(o[4], o[5]); w.w = pg8::cvt_pk_bf16(o[6], o[7]);
                    *(v4u*)(rowp + bj * 128) = w; } }
    }
};
struct EpiResid {
    static constexpr bool PERM = false;
    const float* x; float* x1; bf16* x1b; float* ss;
    __device__ __forceinline__ void operator()(const f32x4 (&acc)[2][2][4][2], const pg8::Unit& u, int wr, int wc, int fr, int fq) const {
        const int row0 = u.pm * 256 + wr * 64 + fr, col0 = u.pn * 256 + wc * 32 + 4 * fq;
#pragma unroll
        for (int ai = 0; ai < 2; ++ai)
#pragma unroll
            for (int m = 0; m < 4; ++m) { const int row = row0 + ai * 128 + m * 16; const size_t off = (size_t)row * DM + col0; float s = 0.f;
#pragma unroll
                for (int bj = 0; bj < 2; ++bj)
#pragma unroll
                    for (int n = 0; n < 2; ++n) { const size_t o = off + bj * 128 + n * 16; const f32x4 v = *(const f32x4*)(x + o) + acc[ai][bj][m][n];
                        *(f32x4*)(x1 + o) = v; v2u w; w.x = pg8::cvt_pk_bf16(v[0], v[1]); w.y = pg8::cvt_pk_bf16(v[2], v[3]); *(v2u*)(x1b + o) = w;
                        s += (v[0] * v[0] + v[1] * v[1]) + (v[2] * v[2] + v[3] * v[3]); }
                s += __shfl_xor(s, 16); s += __shfl_xor(s, 32);
                if (fq == 0) atomicAdd(ss + row, s); }
    }
};
struct EpiPQ {
    static constexpr bool PERM = true;
    bf16* pq; const float* ss;
    __device__ __forceinline__ void operator()(const f32x4 (&acc)[2][2][4][2], const pg8::Unit& u, int wr, int wc, int fr, int fq) const {
        const int row0 = u.pm * 256 + wr * 64 + fr, col0 = u.pn * 256 + wc * 32 + 8 * fq;
#pragma unroll
        for (int ai = 0; ai < 2; ++ai)
#pragma unroll
            for (int m = 0; m < 4; ++m) { const int row = row0 + ai * 128 + m * 16; bf16* rowp = pq + (size_t)row * 2048 + col0;
                const float r = rsqrtf(ss[row] * (1.f / DM) + EPS);
#pragma unroll
                for (int bj = 0; bj < 2; ++bj) { const f32x4 v0 = acc[ai][bj][m][0] * r, v1 = acc[ai][bj][m][1] * r;
                    v4u w; w.x = pg8::cvt_pk_bf16(v0[0], v0[1]); w.y = pg8::cvt_pk_bf16(v0[2], v0[3]); w.z = pg8::cvt_pk_bf16(v1[0], v1[1]); w.w = pg8::cvt_pk_bf16(v1[2], v1[3]);
                    *(v4u*)(rowp + bj * 128) = w; } }
    }
};

template <bool PB> __device__ __forceinline__ void lru_phase(Frame& F) {
    const bf16* XL = (const bf16*)(F.ws + WS_XL); const bf16* LG = (const bf16*)(F.ws + WS_LG); bf16* YL = (bf16*)F.out;
    f32x2* AGG = (f32x2*)(F.ws + WS_AGG);
    const bf16* WL = (const bf16*)(F.ws + WS_WLRU);
    const float* cw = F.in[10]; const float* cb = F.in[11];
    constexpr int O_XCB = 0, O_XCF = 17408, O_A = 51200, O_U = 84992, FST = 528;
    LAS unsigned char* L = F.lds;
    const int tid = F.tid, lane = F.lane, w = F.wave, fr = lane & 15, fq = lane >> 4;
    int cur_blk = -1;
    bf16x8 wf[2][2][4];
    f32x4 br4[2], bi4[2], sp4[2];
    v4u rawreg[3];
#define RAW_LOAD(bb, tt0, bk) do { _Pragma("unroll") for (int r_ = 0; r_ < 3; ++r_) { const int e_ = tid + NTHR * r_, row_ = e_ >> 4, c16_ = e_ & 15, t_ = (tt0) - 2 + row_; \
            v4u v_ = {0u, 0u, 0u, 0u}; if (e_ < 68 * 16 && t_ >= 0 && t_ < SEQ) v_ = *(const v4u*)(XL + ((size_t)(bb) * SEQ + t_) * DM + (bk) * 128 + c16_ * 8); rawreg[r_] = v_; } } while (0)
    constexpr int O_CARRY = 118784, O_CW = 135168, O_SUB = 137728;
    const bool carry_tab = PB && (F.G == 256);
    if (carry_tab) {
        const int ch = tid & 127, bq = tid >> 7, s0 = F.bid >> 3, blk0 = F.bid & 7;
        LAS float* CT = (LAS float*)(L + O_CARRY);
#define FOLD(agp, j0, j1, stp, hv) do { int js_ = (j0); const int n_ = ((j1) - (j0)) * (stp); int k_ = 0; \
            for (; k_ + 8 <= n_; k_ += 8) { f32x2 ah_[8]; _Pragma("unroll") for (int q_ = 0; q_ < 8; ++q_) ah_[q_] = (agp)[(size_t)(js_ + q_ * (stp)) * 2 * DM]; \
                _Pragma("unroll") for (int q_ = 0; q_ < 8; ++q_) hv = ah_[q_][0] * hv + ah_[q_][1]; js_ += 8 * (stp); } \
            for (; k_ < n_; ++k_) { const f32x2 a1_ = (agp)[(size_t)js_ * 2 * DM]; hv = a1_[0] * hv + a1_[1]; js_ += (stp); } } while (0)
        for (int bb = 2 * bq; bb < 2 * bq + 2; ++bb) {
            const f32x2* ag0 = AGG + ((size_t)(bb * 64) * 2 + 0) * DM + blk0 * 128 + ch; const f32x2* ag1 = AGG + ((size_t)(bb * 64) * 2 + 1) * DM + blk0 * 128 + ch;
            float h = 0.f;
            FOLD(ag0, 0, s0, 1, h); CT[((bb * 2 + 0) * 2 + 0) * 128 + ch] = h;
            FOLD(ag0, s0, s0 + 32, 1, h); CT[((bb * 2 + 1) * 2 + 0) * 128 + ch] = h;
            h = 0.f;
            FOLD(ag1, 63, s0 + 32, -1, h); CT[((bb * 2 + 1) * 2 + 1) * 128 + ch] = h;
            FOLD(ag1, s0 + 32, s0, -1, h); CT[((bb * 2 + 0) * 2 + 1) * 128 + ch] = h;
        }
        __syncthreads();
#undef FOLD
    }
    for (int i = 0;; ++i) {
        const int idx = i * F.G + F.bid; if (idx >= 4096) break;
        const int blk = idx & 7, j = idx >> 3, b = j >> 6, seg = j & 63, t0 = seg * 64;
        const size_t mrow0 = (size_t)b * SEQ + t0;
        if (blk != cur_blk) {
            cur_blk = blk;
#pragma unroll
            for (int d = 0; d < 2; ++d) {
#pragma unroll
                for (int g = 0; g < 2; ++g)
#pragma unroll
                    for (int ks = 0; ks < 4; ++ks)
                        wf[d][g][ks] = *(const bf16x8*)(WL + ((size_t)((d * 8 + blk) * 2 + g) * 128 + 16 * w + fr) * 128 + 32 * ks + 8 * fq);
                const int ch = blk * 128 + 16 * w + 4 * fq;
                br4[d] = *(const f32x4*)(F.in[13] + d * DM + ch); bi4[d] = *(const f32x4*)(F.in[15] + d * DM + ch);
                const f32x4 lm = *(const f32x4*)(F.in[16] + d * DM + ch);
#pragma unroll
                for (int e = 0; e < 4; ++e) sp4[d][e] = -8.f * 1.44269504089f * softplusf_(-lm[e]);
            }
            __syncthreads();
            for (int e = tid; e < 5 * 128; e += NTHR) { const int jt = e >> 7, cc = e & 127; ((LAS float*)(L + O_CW))[e] = (jt < 4) ? cw[jt * DM + blk * 128 + cc] : cb[blk * 128 + cc]; }
        }
        if (i == 0) RAW_LOAD(b, t0, blk);
#pragma unroll
        for (int r = 0; r < 3; ++r) { const int e = tid + NTHR * r; if (e < 68 * 16) *(LAS v4u*)(L + O_A + (e >> 4) * 256 + (e & 15) * 16) = rawreg[r]; }
        __syncthreads();
        { const int idx2 = (i + 1) * F.G + F.bid; if (idx2 < 4096) { const int j2 = idx2 >> 3; RAW_LOAD(j2 >> 6, (j2 & 63) * 64, idx2 & 7); } }
        v4u lgreg[2];
        if (PB) {
#pragma unroll
            for (int r = 0; r < 2; ++r) { const int e = tid + NTHR * r; lgreg[r] = *(const v4u*)(LG + (mrow0 + (e >> 4)) * DM + blk * 128 + (e & 15) * 8); } }
        for (int e = tid; e < 64 * 16; e += NTHR) { const int tl = e >> 4, c16 = e & 15;
            float y[8];
            { const f32x4 a = *(const LAS f32x4*)(L + O_CW + 4 * 512 + c16 * 32), bq = *(const LAS f32x4*)(L + O_CW + 4 * 512 + c16 * 32 + 16); y[0] = a[0]; y[1] = a[1]; y[2] = a[2]; y[3] = a[3]; y[4] = bq[0]; y[5] = bq[1]; y[6] = bq[2]; y[7] = bq[3]; }
#pragma unroll
            for (int jt = 0; jt < 4; ++jt) { const v4u r = *(const LAS v4u*)(L + O_A + (tl + jt) * 256 + c16 * 16);
                const f32x4 wa = *(const LAS f32x4*)(L + O_CW + jt * 512 + c16 * 32), wb = *(const LAS f32x4*)(L + O_CW + jt * 512 + c16 * 32 + 16);
                y[0] += wa[0] * bflo(r.x); y[1] += wa[1] * bfhi(r.x); y[2] += wa[2] * bflo(r.y); y[3] += wa[3] * bfhi(r.y);
                y[4] += wb[0] * bflo(r.z); y[5] += wb[1] * bfhi(r.z); y[6] += wb[2] * bflo(r.w); y[7] += wb[3] * bfhi(r.w); }
            *(LAS f32x4*)(L + O_XCF + tl * FST + c16 * 32) = (f32x4){y[0], y[1], y[2], y[3]};
            *(LAS f32x4*)(L + O_XCF + tl * FST + c16 * 32 + 16) = (f32x4){y[4], y[5], y[6], y[7]};
            v4u o; o.x = pk2(y[0], y[1]); o.y = pk2(y[2], y[3]); o.z = pk2(y[4], y[5]); o.w = pk2(y[6], y[7]);
            *(LAS v4u*)(L + O_XCB + tl * 272 + c16 * 16) = o; }
        __syncthreads();
        float carry0 = 0.f, carry1 = 0.f;
        if (carry_tab) { const LAS float* CT = (const LAS float*)(L + O_CARRY); carry0 = CT[((b * 2 + (seg >> 5)) * 2 + 0) * 128 + (tid & 127)]; carry1 = CT[((b * 2 + (seg >> 5)) * 2 + 1) * 128 + (tid & 127)]; }
        else if (PB) {
            const int ch = blk * 128 + (tid & 127);
            float h = 0.f;
            const f32x2* ag0 = AGG + ((size_t)(b * 64) * 2 + 0) * DM + ch; const f32x2* ag1 = AGG + ((size_t)(b * 64) * 2 + 1) * DM + ch;
            int js = 0;
            for (; js + 8 <= seg; js += 8) { f32x2 ah[8];
#pragma unroll
                for (int q = 0; q < 8; ++q) ah[q] = ag0[(size_t)(js + q) * 2 * DM];
#pragma unroll
                for (int q = 0; q < 8; ++q) h = ah[q][0] * h + ah[q][1]; }
            for (; js < seg; ++js) { const f32x2 ah = ag0[(size_t)js * 2 * DM]; h = ah[0] * h + ah[1]; }
            carry0 = h; h = 0.f;
            js = 63;
            for (; js - 8 >= seg; js -= 8) { f32x2 ah[8];
#pragma unroll
                for (int q = 0; q < 8; ++q) ah[q] = ag1[(size_t)(js - q) * 2 * DM];
#pragma unroll
                for (int q = 0; q < 8; ++q) h = ah[q][0] * h + ah[q][1]; }
            for (; js > seg; --js) { const f32x2 ah = ag1[(size_t)js * 2 * DM]; h = ah[0] * h + ah[1]; }
            carry1 = h;
        }
#pragma unroll
        for (int d = 0; d < 2; ++d) {
            const int o_a = (d == 0) ? O_A : O_XCF;
            f32x4 aR[4], aI[4];
#pragma unroll
            for (int mt = 0; mt < 4; ++mt) { aR[mt] = (f32x4){0.f, 0.f, 0.f, 0.f}; aI[mt] = (f32x4){0.f, 0.f, 0.f, 0.f}; }
#pragma unroll
            for (int ks = 0; ks < 4; ++ks)
#pragma unroll
                for (int mt = 0; mt < 4; ++mt) { const bf16x8 xb = *(const LAS bf16x8*)(L + O_XCB + (16 * mt + fr) * 272 + (32 * ks + 8 * fq) * 2);
                    aR[mt] = __builtin_amdgcn_mfma_f32_16x16x32_bf16(wf[d][0][ks], xb, aR[mt], 0, 0, 0);
                    aI[mt] = __builtin_amdgcn_mfma_f32_16x16x32_bf16(wf[d][1][ks], xb, aI[mt], 0, 0, 0); }
#pragma unroll
            for (int mt = 0; mt < 4; ++mt) { const int tl = 16 * mt + fr, cl = 16 * w + 4 * fq;
                const f32x4 xc = *(const LAS f32x4*)(L + O_XCF + tl * FST + cl * 4);
                f32x4 av, uv;
#pragma unroll
                for (int e = 0; e < 4; ++e) { const float r = sigmoidf_(aR[mt][e] + br4[d][e]), ig = sigmoidf_(aI[mt][e] + bi4[d][e]);
                    const float a_ = __builtin_amdgcn_exp2f(r * sp4[d][e]); av[e] = a_; uv[e] = __builtin_amdgcn_sqrtf(fmaxf(1.f - a_ * a_, 0.f)) * (ig * xc[e]); }
                *(LAS f32x4*)(L + o_a + tl * FST + cl * 4) = av; *(LAS f32x4*)(L + O_U + tl * FST + cl * 4) = uv; }
            __syncthreads();
            {
                const int c = tid & 127, sub = tid >> 7;
                LAS float* pa = (LAS float*)(L + o_a) + c; const LAS float* pu = (const LAS float*)(L + O_U) + c;
                LAS f32x2* SUBT = (LAS f32x2*)(L + O_SUB);
                float h = 0.f, A = 1.f;
#pragma unroll
                for (int s2 = 0; s2 < 16; ++s2) { const int tl = d ? (16 * sub + 15 - s2) : (16 * sub + s2); const float a = pa[tl * 132], u = pu[tl * 132]; h = a * h + u; A *= a; }
                SUBT[sub * 128 + c] = (f32x2){A, h};
                __syncthreads();
                if (!PB) {
                    if (sub == 0) { float HH = 0.f, AA = 1.f;
#pragma unroll
                        for (int q = 0; q < 4; ++q) { const f32x2 ah = SUBT[(d ? 3 - q : q) * 128 + c]; HH = ah[0] * HH + ah[1]; AA *= ah[0]; }
                        AGG[((size_t)(b * 64 + seg) * 2 + d) * DM + blk * 128 + c] = (f32x2){AA, HH}; }
                } else {
                    float hc = d ? carry1 : carry0;
#pragma unroll
                    for (int q = 0; q < 3; ++q) { const int jq = d ? 3 - q : q; const f32x2 ah = SUBT[jq * 128 + c]; if (d ? (jq > sub) : (jq < sub)) hc = ah[0] * hc + ah[1]; }
                    if (d == 0) {
#pragma unroll
                        for (int s2 = 0; s2 < 16; ++s2) { const int tl = 16 * sub + s2; hc = pa[tl * 132] * hc + pu[tl * 132]; pa[tl * 132] = hc; }
                    } else { LAS float* ph = (LAS float*)(L + O_A) + c;
#pragma unroll
                        for (int s2 = 0; s2 < 16; ++s2) { const int tl = 16 * sub + 15 - s2; hc = pa[tl * 132] * hc + pu[tl * 132]; ph[tl * 132] += hc; } }
                }
            }
            __syncthreads();
        }
        if (PB) {
#pragma unroll
            for (int r = 0; r < 2; ++r) { const int e = tid + NTHR * r, row = e >> 4, c16 = e & 15;
                const v4u g = lgreg[r];
                const f32x4 h0 = *(const LAS f32x4*)(L + O_A + row * FST + c16 * 32), h1 = *(const LAS f32x4*)(L + O_A + row * FST + c16 * 32 + 16);
                v4u o;
                o.x = pk2(h0[0] * gelu_fast(bflo(g.x)), h0[1] * gelu_fast(bfhi(g.x))); o.y = pk2(h0[2] * gelu_fast(bflo(g.y)), h0[3] * gelu_fast(bfhi(g.y)));
                o.z = pk2(h1[0] * gelu_fast(bflo(g.z)), h1[1] * gelu_fast(bfhi(g.z))); o.w = pk2(h1[2] * gelu_fast(bflo(g.w)), h1[3] * gelu_fast(bfhi(g.w)));
                *(v4u*)(YL + (mrow0 + row) * DM + blk * 128 + c16 * 8) = o; }
            __syncthreads();
        }
    }
#undef RAW_LOAD
}

__device__ __forceinline__ void mconv_phase(Frame& F) {
    const bf16* XM = (const bf16*)(F.ws + WS_XM); bf16* XC = (bf16*)F.out + (size_t)MTOK * DM;
    const float* cw = F.in[4]; const float* cb = F.in[5];
    const int NT = MTOK / 32 * 128;
    for (int g = F.bid * NTHR + F.tid; g < NT; g += F.G * NTHR) {
        const int chunk = g & 127, run = g >> 7, c0 = chunk * 8, m0 = run * 32, t0 = m0 & (SEQ - 1);
        float w[4][8], bias[8];
#pragma unroll
        for (int j = 0; j < 4; ++j) { const f32x4 a = *(const f32x4*)(cw + j * DM + c0), b = *(const f32x4*)(cw + j * DM + c0 + 4);
            w[j][0] = a[0]; w[j][1] = a[1]; w[j][2] = a[2]; w[j][3] = a[3]; w[j][4] = b[0]; w[j][5] = b[1]; w[j][6] = b[2]; w[j][7] = b[3]; }
        { const f32x4 a = *(const f32x4*)(cb + c0), b = *(const f32x4*)(cb + c0 + 4);
            bias[0] = a[0]; bias[1] = a[1]; bias[2] = a[2]; bias[3] = a[3]; bias[4] = b[0]; bias[5] = b[1]; bias[6] = b[2]; bias[7] = b[3]; }
        v4u win[4];
        const v4u zero = {0u, 0u, 0u, 0u};
        win[0] = zero;
        win[1] = (t0 >= 2) ? *(const v4u*)(XM + (size_t)(m0 - 2) * DM + c0) : zero;
        win[2] = (t0 >= 1) ? *(const v4u*)(XM + (size_t)(m0 - 1) * DM + c0) : zero;
        win[3] = *(const v4u*)(XM + (size_t)m0 * DM + c0);
#pragma unroll 4
        for (int i = 0; i < 32; ++i) {
            win[0] = win[1]; win[1] = win[2]; win[2] = win[3];
            win[3] = (t0 + i + 1 < SEQ) ? *(const v4u*)(XM + (size_t)(m0 + i + 1) * DM + c0) : zero;
            float y[8];
#pragma unroll
            for (int e = 0; e < 8; ++e) y[e] = bias[e];
#pragma unroll
            for (int j = 0; j < 4; ++j) {
                const unsigned p0 = win[j].x, p1 = win[j].y, p2 = win[j].z, p3 = win[j].w;
                y[0] += w[j][0] * bflo(p0); y[1] += w[j][1] * bfhi(p0); y[2] += w[j][2] * bflo(p1); y[3] += w[j][3] * bfhi(p1);
                y[4] += w[j][4] * bflo(p2); y[5] += w[j][5] * bfhi(p2); y[6] += w[j][6] * bflo(p3); y[7] += w[j][7] * bfhi(p3);
            }
#pragma unroll
            for (int e = 0; e < 8; ++e) y[e] = y[e] * sigmoidf_(y[e]);
            v4u o; o.x = pk2(y[0], y[1]); o.y = pk2(y[2], y[3]); o.z = pk2(y[4], y[5]); o.w = pk2(y[6], y[7]);
            *(v4u*)(XC + (size_t)(m0 + i) * DM + c0) = o;
        }
    }
}

typedef short s16x4 __attribute__((ext_vector_type(4)));
__device__ __forceinline__ bf16x8 tr_read_pair(unsigned a0, unsigned a1) {
    s16x4 r0, r1;
    asm volatile("ds_read_b64_tr_b16 %0, %2\n\tds_read_b64_tr_b16 %1, %3\n\ts_waitcnt lgkmcnt(0)" : "=&v"(r0), "=&v"(r1) : "v"(a0), "v"(a1) : "memory");
    return __builtin_shufflevector(r0, r1, 0, 1, 2, 3, 4, 5, 6, 7);
}
__device__ __forceinline__ float dpp_shr(float oldv, float x, int n) {
    const int o = __builtin_bit_cast(int, oldv), v = __builtin_bit_cast(int, x);
    int r;
    if (n == 1) r = __builtin_amdgcn_update_dpp(o, v, 0x111, 0xf, 0xf, false);
    else if (n == 2) r = __builtin_amdgcn_update_dpp(o, v, 0x112, 0xf, 0xf, false);
    else if (n == 4) r = __builtin_amdgcn_update_dpp(o, v, 0x114, 0xf, 0xf, false);
    else r = __builtin_amdgcn_update_dpp(o, v, 0x118, 0xf, 0xf, false);
    return __builtin_bit_cast(float, r);
}
__device__ __forceinline__ float rdlane(float x, int l) { return __builtin_bit_cast(float, __builtin_amdgcn_readlane(__builtin_bit_cast(int, x), l)); }
__device__ __forceinline__ float wave_incl_sum(float x, int lane) {
    x += dpp_shr(0.f, x, 1); x += dpp_shr(0.f, x, 2); x += dpp_shr(0.f, x, 4); x += dpp_shr(0.f, x, 8);
    const float t0 = rdlane(x, 15), t1 = rdlane(x, 31), t2 = rdlane(x, 47);
    return x + (lane >= 16 ? t0 : 0.f) + (lane >= 32 ? t1 : 0.f) + (lane >= 48 ? t2 : 0.f);
}
__device__ __forceinline__ float wave_incl_max(float x, int lane) {
    const float NI = -INFINITY;
    x = fmaxf(x, dpp_shr(NI, x, 1)); x = fmaxf(x, dpp_shr(NI, x, 2)); x = fmaxf(x, dpp_shr(NI, x, 4)); x = fmaxf(x, dpp_shr(NI, x, 8));
    const float t0 = rdlane(x, 15), t1 = rdlane(x, 31), t2 = rdlane(x, 47);
    return fmaxf(fmaxf(x, lane >= 16 ? t0 : NI), fmaxf(lane >= 32 ? t1 : NI, lane >= 48 ? t2 : NI));
}
__device__ __forceinline__ void mscan_phase(Frame& F) {
    const bf16* Q = (const bf16*)(F.ws + WS_LG); const bf16* K = (const bf16*)(F.ws + WS_K); const bf16* V = (const bf16*)(F.ws + WS_XL);
    const float* GT = (const float*)(F.ws + WS_GATE);
    constexpr int KS = 0, CTI = 33792, VT = 67584, VWT = 86016, PB = 104448, TAB = 113664, NT = 116736, NPART = 117760, DENT = 119808;
    constexpr int KST = 528, VST = 144, TABSZ = 1536;
    LAS unsigned char* L = F.lds;
    const int tid = F.tid, lane = F.lane, w = F.wave, fr = lane & 15, fq = lane >> 4, pt = w & 3, wg = w >> 2;
    for (int item = F.bid; item < 256; item += F.G) {
        const int es = item & 3, dir = (item >> 2) & 1, h = (item >> 3) & 3, b = item >> 5;
        bf16* H = dir ? ((bf16*)F.out + (size_t)MTOK * DM) : (bf16*)(F.ws + WS_XM);
        const size_t rowbase = (size_t)b * SEQ;
#define TOF(c, p) (dir ? (SEQ - 1 - 64 * (c) - (p)) : (64 * (c) + (p)))
        for (int e = tid; e < (33792 + 1024) / 4; e += NTHR) { if (e < 33792 / 4) ((LAS unsigned*)(L + CTI))[e] = 0u; else ((LAS unsigned*)(L + NT))[e - 33792 / 4] = 0u; }
        float m_run = 0.f;
        float gi_n = 0.f, gf_n = 0.f;
        if (w == 0) { const size_t m = rowbase + TOF(0, lane); gi_n = GT[m * 16 + dir * 8 + h]; gf_n = GT[m * 16 + dir * 8 + 4 + h]; }
#define G1_TABLES(setp) do { \
            const float logf_ = fminf(gf_n, 0.f) - __logf(1.f + __expf(-fabsf(gf_n))); const float b_ = wave_incl_sum(logf_, lane); const float a_ = gi_n - b_; \
            const float M_ = fmaxf(m_run, wave_incl_max(a_, lane)); const float Mend_ = rdlane(M_, 63), g_ = rdlane(b_, 63); \
            LAS float* T_ = (LAS float*)(setp); T_[lane] = a_; T_[64 + lane] = M_; T_[128 + lane] = __expf(m_run - M_); T_[192 + lane] = __expf(-(b_ + M_)); T_[256 + lane] = __expf(a_ - Mend_); \
            if (lane == 0) { T_[320] = __expf(m_run - Mend_); T_[321] = g_ + Mend_; } \
            m_run = g_ + Mend_; } while (0)
        if (w == 0) G1_TABLES(L + TAB);
        __syncthreads();
        bf16x8 qf[8];
        v4u kreg[4]; v4u vreg;
#define LOAD_KV(c) do { _Pragma("unroll") for (int r_ = 0; r_ < 4; ++r_) { const int i_ = tid + NTHR * r_, s_ = i_ >> 5, c16_ = i_ & 31; \
                kreg[r_] = *(const v4u*)(K + (rowbase + TOF(c, s_)) * DM + h * 256 + c16_ * 8); } \
            { const int s_ = tid & 63, e8_ = tid >> 6; vreg = *(const v4u*)(V + (rowbase + TOF(c, s_)) * DM + h * 256 + es * 64 + e8_ * 8); } } while (0)
#define STORE_KV(setidx) do { _Pragma("unroll") for (int r_ = 0; r_ < 4; ++r_) { const int i_ = tid + NTHR * r_, s_ = i_ >> 5, c16_ = i_ & 31; \
                *(LAS v4u*)(L + KS + s_ * KST + c16_ * 16) = kreg[r_]; } \
            { const int s_ = tid & 63, e8_ = tid >> 6; const float ws_ = ((const LAS float*)(L + TAB + (setidx) * TABSZ))[256 + s_]; \
              LAS bf16* vt_ = (LAS bf16*)(L + VT + (setidx) * 9216); LAS bf16* vw_ = (LAS bf16*)(L + VWT + (setidx) * 9216); \
              const unsigned wv_[4] = {vreg.x, vreg.y, vreg.z, vreg.w}; \
              _Pragma("unroll") for (int j_ = 0; j_ < 4; ++j_) { const float lo_ = bflo(wv_[j_]), hi_ = bfhi(wv_[j_]); const int e_ = e8_ * 8 + 2 * j_; \
                vt_[e_ * 72 + s_] = (bf16)(wv_[j_] & 0xffffu); vt_[(e_ + 1) * 72 + s_] = (bf16)(wv_[j_] >> 16); \
                vw_[e_ * 72 + s_] = (bf16)f2bf(lo_ * ws_); vw_[(e_ + 1) * 72 + s_] = (bf16)f2bf(hi_ * ws_); } } } while (0)
#define LOAD_Q(c) do { const size_t m_ = rowbase + TOF(c, 16 * pt + fr); _Pragma("unroll") for (int ks_ = 0; ks_ < 8; ++ks_) \
                qf[ks_] = *(const bf16x8*)(Q + m_ * DM + h * 256 + 32 * ks_ + 8 * fq); } while (0)
        LOAD_KV(0); LOAD_Q(0);
        STORE_KV(0);
        f32x4 Cacc[8];
#pragma unroll
        for (int i = 0; i < 8; ++i) Cacc[i] = (f32x4){0.f, 0.f, 0.f, 0.f};
        __syncthreads();
        for (int c = 0; c < 64; ++c) {
            const int cur = c & 1, nxt = cur ^ 1;
            const bool has_next = (c + 1 < 64);
            const LAS float* T = (const LAS float*)(L + TAB + cur * TABSZ);
            if (has_next) { LOAD_KV(c + 1); if (w == 0) { const size_t m = rowbase + TOF(c + 1, lane); gi_n = GT[m * 16 + dir * 8 + h]; gf_n = GT[m * 16 + dir * 8 + 4 + h]; } }
            const int p = 16 * pt + fr;
            const float Mp = T[64 + p], wi_p = T[128 + p];
            float cs = 0.f;
#pragma unroll
            for (int i = 0; i < 2; ++i) { const int st = 2 * wg + i;
                v2u pw = {0u, 0u};
                if (st <= pt) {
                    f32x4 sa = (f32x4){0.f, 0.f, 0.f, 0.f};
#pragma unroll
                    for (int ks = 0; ks < 8; ++ks) { const bf16x8 kf = *(const LAS bf16x8*)(L + KS + (16 * st + fr) * KST + (32 * ks + 8 * fq) * 2);
                        sa = __builtin_amdgcn_mfma_f32_16x16x32_bf16(kf, qf[ks], sa, 0, 0, 0); }
                    const f32x4 a4 = *(const LAS f32x4*)(T + 16 * st + 4 * fq);
                    float pv[4];
#pragma unroll
                    for (int r = 0; r < 4; ++r) { const int s_ = 16 * st + 4 * fq + r; const float wgt = (s_ <= p) ? __expf(a4[r] - Mp) : 0.f; pv[r] = sa[r] * wgt; cs += pv[r]; }
                    pw.x = pk2(pv[0], pv[1]); pw.y = pk2(pv[2], pv[3]);
                }
                *(LAS v2u*)(L + PB + p * VST + (16 * st + 4 * fq) * 2) = pw; }
            f32x4 O[2];
#pragma unroll
            for (int i = 0; i < 2; ++i) { const int et = 2 * wg + i; O[i] = (f32x4){0.f, 0.f, 0.f, 0.f};
#pragma unroll
                for (int ks = 0; ks < 8; ++ks) { const bf16x8 cf = *(const LAS bf16x8*)(L + CTI + (16 * et + fr) * KST + (32 * ks + 8 * fq) * 2);
                    O[i] = __builtin_amdgcn_mfma_f32_16x16x32_bf16(cf, qf[ks], O[i], 0, 0, 0); } }
            float di = 0.f;
#define DEN_INTER(ks) do { const f32x4 n0 = *(const LAS f32x4*)(L + NT + (32 * (ks) + 8 * fq) * 4), n1 = *(const LAS f32x4*)(L + NT + (32 * (ks) + 8 * fq) * 4 + 16); \
                const v4u qw = __builtin_bit_cast(v4u, qf[ks]); \
                di += bflo(qw.x) * n0[0] + bfhi(qw.x) * n0[1] + bflo(qw.y) * n0[2] + bfhi(qw.y) * n0[3] + bflo(qw.z) * n1[0] + bfhi(qw.z) * n1[1] + bflo(qw.w) * n1[2] + bfhi(qw.w) * n1[3]; } while (0)
            if (wg == 0) { DEN_INTER(0); DEN_INTER(1); DEN_INTER(2); DEN_INTER(3); }
            else { DEN_INTER(4); DEN_INTER(5); DEN_INTER(6); DEN_INTER(7); }
#undef DEN_INTER
            di += __shfl_xor(di, 16); di += __shfl_xor(di, 32);
            cs += __shfl_xor(cs, 16); cs += __shfl_xor(cs, 32);
            if (fq == 0) ((LAS float*)(L + DENT))[wg * 64 + p] = wi_p * di + cs;
            if (has_next) LOAD_Q(c + 1);
            if (has_next && w == 0) G1_TABLES(L + TAB + nxt * TABSZ);
            __syncthreads();
#pragma unroll
            for (int i = 0; i < 2; ++i) { const int et = 2 * wg + i; O[i] = O[i] * wi_p;
#pragma unroll
                for (int ks = 0; ks < 2; ++ks) { const bf16x8 vf = *(const LAS bf16x8*)(L + VT + cur * 9216 + (16 * et + fr) * VST + (32 * ks + 8 * fq) * 2);
                    const bf16x8 pf = *(const LAS bf16x8*)(L + PB + p * VST + (32 * ks + 8 * fq) * 2);
                    O[i] = __builtin_amdgcn_mfma_f32_16x16x32_bf16(vf, pf, O[i], 0, 0, 0); } }
            { const float den = ((const LAS float*)(L + DENT))[p] + ((const LAS float*)(L + DENT))[64 + p];
              const float inv = 1.f / fmaxf(fabsf(den), T[192 + p]);
              const size_t m = rowbase + TOF(c, p);
#pragma unroll
              for (int i = 0; i < 2; ++i) { const int et = 2 * wg + i; v2u o; o.x = pk2(O[i][0] * inv, O[i][1] * inv); o.y = pk2(O[i][2] * inv, O[i][3] * inv);
                  *(v2u*)(H + m * DM + h * 256 + es * 64 + 16 * et + 4 * fq) = o; } }
            { const float decay = T[320];
              const bf16x8 vw0 = *(const LAS bf16x8*)(L + VWT + cur * 9216 + (16 * pt + fr) * VST + (8 * fq) * 2);
              const bf16x8 vw1 = *(const LAS bf16x8*)(L + VWT + cur * 9216 + (16 * pt + fr) * VST + (32 + 8 * fq) * 2);
              const int l16 = lane & 15, q4 = l16 >> 2, p4 = l16 & 3;
              const unsigned kb = (unsigned)(uintptr_t)(L + KS) + (unsigned)((8 * fq + q4) * KST + 4 * p4 * 2);
#pragma unroll
              for (int dtl = 0; dtl < 8; dtl += 2) { const int dt = 8 * wg + dtl; const unsigned a0 = kb + dt * 32;
                  s16x4 r0, r1, r2, r3, r4, r5, r6, r7;
                  asm volatile("ds_read_b64_tr_b16 %0, %8\n\tds_read_b64_tr_b16 %1, %8 offset:2112\n\tds_read_b64_tr_b16 %2, %8 offset:16896\n\tds_read_b64_tr_b16 %3, %8 offset:19008\n\t"
                               "ds_read_b64_tr_b16 %4, %8 offset:32\n\tds_read_b64_tr_b16 %5, %8 offset:2144\n\tds_read_b64_tr_b16 %6, %8 offset:16928\n\tds_read_b64_tr_b16 %7, %8 offset:19040\n\ts_waitcnt lgkmcnt(0)"
                               : "=&v"(r0), "=&v"(r1), "=&v"(r2), "=&v"(r3), "=&v"(r4), "=&v"(r5), "=&v"(r6), "=&v"(r7) : "v"(a0) : "memory");
                  const bf16x8 k0 = __builtin_shufflevector(r0, r1, 0, 1, 2, 3, 4, 5, 6, 7), k1 = __builtin_shufflevector(r2, r3, 0, 1, 2, 3, 4, 5, 6, 7);
                  const bf16x8 k2 = __builtin_shufflevector(r4, r5, 0, 1, 2, 3, 4, 5, 6, 7), k3 = __builtin_shufflevector(r6, r7, 0, 1, 2, 3, 4, 5, 6, 7);
                  Cacc[dtl] = Cacc[dtl] * decay; Cacc[dtl + 1] = Cacc[dtl + 1] * decay;
                  Cacc[dtl] = __builtin_amdgcn_mfma_f32_16x16x32_bf16(k0, vw0, Cacc[dtl], 0, 0, 0);
                  Cacc[dtl + 1] = __builtin_amdgcn_mfma_f32_16x16x32_bf16(k2, vw0, Cacc[dtl + 1], 0, 0, 0);
                  Cacc[dtl] = __builtin_amdgcn_mfma_f32_16x16x32_bf16(k1, vw1, Cacc[dtl], 0, 0, 0);
                  Cacc[dtl + 1] = __builtin_amdgcn_mfma_f32_16x16x32_bf16(k3, vw1, Cacc[dtl + 1], 0, 0, 0); } }
            { const int d = tid & 255, hf2 = tid >> 8; float np = 0.f;
#pragma unroll 8
              for (int s2 = 0; s2 < 32; ++s2) { const int s_ = hf2 * 32 + s2; np += T[256 + s_] * bf2f(*(const LAS bf16*)(L + KS + s_ * KST + d * 2)); }
              ((LAS float*)(L + NPART))[hf2 * 256 + d] = np; }
            __syncthreads();
            { const float decay = T[320];
#pragma unroll
              for (int dtl = 0; dtl < 8; ++dtl) { const int dt = 8 * wg + dtl; v2u o; o.x = pk2(Cacc[dtl][0], Cacc[dtl][1]); o.y = pk2(Cacc[dtl][2], Cacc[dtl][3]);
                  *(LAS v2u*)(L + CTI + (16 * pt + fr) * KST + (16 * dt + 4 * fq) * 2) = o; }
              if (tid < 256) { LAS float* nt = (LAS float*)(L + NT); const LAS float* np = (const LAS float*)(L + NPART); nt[tid] = decay * nt[tid] + np[tid] + np[256 + tid]; } }
            if (has_next) STORE_KV(nxt);
            __syncthreads();
        }
#undef TOF
#undef G1_TABLES
#undef LOAD_KV
#undef STORE_KV
#undef LOAD_Q
    }
}

__device__ __forceinline__ void ym_phase(Frame& F) {
    const bf16* HF = (const bf16*)(F.ws + WS_XM); const bf16* HB = (const bf16*)F.out + (size_t)MTOK * DM; bf16* OP = (bf16*)(F.ws + WS_OP);
    const float* ng = F.in[9];
    const int gw = F.bid * NWAVES + F.wave, NGW = F.G * NWAVES;
    for (int m = gw; m < MTOK; m += NGW) {
#pragma unroll
        for (int hd = 0; hd < 4; ++hd) {
            const size_t o = (size_t)m * DM + hd * 256 + F.lane * 4;
            const v2u a = *(const v2u*)(HF + o), b = *(const v2u*)(HB + o), op = *(const v2u*)(OP + o);
            const float v0 = bflo(a.x) + bflo(b.x), v1 = bfhi(a.x) + bfhi(b.x), v2 = bflo(a.y) + bflo(b.y), v3 = bfhi(a.y) + bfhi(b.y);
            const float r = rsqrtf(wave_sum((v0 * v0 + v1 * v1) + (v2 * v2 + v3 * v3)) * (1.f / 256.f) + EPS);
            const f32x4 g = *(const f32x4*)(ng + hd * 256 + F.lane * 4);
            v2u w; w.x = pk2(sigmoidf_(bflo(op.x)) * v0 * r * g[0], sigmoidf_(bfhi(op.x)) * v1 * r * g[1]);
            w.y = pk2(sigmoidf_(bflo(op.y)) * v2 * r * g[2], sigmoidf_(bfhi(op.y)) * v3 * r * g[3]);
            *(v2u*)(OP + o) = w;
        }
    }
    {
        float* usc = (float*)(F.ws + WS_LG + 16 * MiB); float* vsc = usc + NEXP;
        for (int row = gw; row < 2 * NEXP; row += NGW) {
            const bool isv = row >= NEXP; const int r = isv ? row - NEXP : row;
            const f32x4* src = (const f32x4*)(F.in[isv ? 24 : 23] + (size_t)r * DM) + F.lane * 4;
            f32x4 a[4]; float ss = 0.f;
#pragma unroll
            for (int j = 0; j < 4; ++j) { a[j] = src[j]; ss += (a[j][0] * a[j][0] + a[j][1] * a[j][1]) + (a[j][2] * a[j][2] + a[j][3] * a[j][3]); }
            const float rms = sqrtf(wave_sum(ss) * (1.f / DM));
            const float sc = fmaxf(rms * 0.5f, 1e-30f), inv = 1.f / sc;
            unsigned o[2] = {0u, 0u};
#pragma unroll
            for (int j = 0; j < 4; ++j) { const f32x4 q = a[j] * inv;
                if (j & 1) { o[j >> 1] = __builtin_amdgcn_cvt_scalef32_pk_fp4_f32(o[j >> 1], q[0], q[1], 1.0f, 2); o[j >> 1] = __builtin_amdgcn_cvt_scalef32_pk_fp4_f32(o[j >> 1], q[2], q[3], 1.0f, 3); }
                else       { o[j >> 1] = __builtin_amdgcn_cvt_scalef32_pk_fp4_f32(o[j >> 1], q[0], q[1], 1.0f, 0); o[j >> 1] = __builtin_amdgcn_cvt_scalef32_pk_fp4_f32(o[j >> 1], q[2], q[3], 1.0f, 1); } }
            *(v2u*)(F.ws + WS_LG + (isv ? 8 * MiB : 0) + (size_t)r * (DM / 2) + F.lane * 8) = (v2u){o[0], o[1]};
            if (F.lane == 0) (isv ? vsc : usc)[r] = sc;
        }
    }
}

typedef float f32x16 __attribute__((ext_vector_type(16)));
#define TOPK_INSERT(L, xv) do { const float x_ = (xv); \
    L[15] = __builtin_amdgcn_fmed3f(L[14], L[15], x_); L[14] = __builtin_amdgcn_fmed3f(L[13], L[14], x_); L[13] = __builtin_amdgcn_fmed3f(L[12], L[13], x_); L[12] = __builtin_amdgcn_fmed3f(L[11], L[12], x_); \
    L[11] = __builtin_amdgcn_fmed3f(L[10], L[11], x_); L[10] = __builtin_amdgcn_fmed3f(L[9], L[10], x_); L[9] = __builtin_amdgcn_fmed3f(L[8], L[9], x_); L[8] = __builtin_amdgcn_fmed3f(L[7], L[8], x_); \
    L[7] = __builtin_amdgcn_fmed3f(L[6], L[7], x_); L[6] = __builtin_amdgcn_fmed3f(L[5], L[6], x_); L[5] = __builtin_amdgcn_fmed3f(L[4], L[5], x_); L[4] = __builtin_amdgcn_fmed3f(L[3], L[4], x_); \
    L[3] = __builtin_amdgcn_fmed3f(L[2], L[3], x_); L[2] = __builtin_amdgcn_fmed3f(L[1], L[2], x_); L[1] = __builtin_amdgcn_fmed3f(L[0], L[1], x_); L[0] = fmaxf(L[0], x_); } while (0)
template <int I> struct CandRow {
    static __device__ __forceinline__ void run(const float (&L0)[16], const float (&L1)[16], float (&R)[16]) {
        constexpr int NJ = 16 / (I + 1);
#pragma unroll
        for (int j = 0; j < NJ; ++j) { const float sm = L0[I] + L1[j];
            const float pk = __builtin_bit_cast(float, (__builtin_bit_cast(unsigned, sm) & 0xffffff00u) | (unsigned)(I * 16 + j)); TOPK_INSERT(R, pk); }
        if constexpr (I < 15) CandRow<I + 1>::run(L0, L1, R);
    }
};
__device__ __forceinline__ unsigned pick4(unsigned d0, unsigned d1, unsigned d2, unsigned d3, int i) {
    const int q = i >> 2; unsigned d = d0; d = (q == 1) ? d1 : d; d = (q == 2) ? d2 : d; d = (q == 3) ? d3 : d; return (d >> (8 * (i & 3))) & 127u;
}
__device__ __forceinline__ void select_phase(Frame& F) {
    const bf16* PQ = (const bf16*)(F.ws + WS_MG); const bf16* KEYS = (const bf16*)(F.ws + WS_KEYS);
    int* IDX = (int*)(F.ws + WS_K); float* GW = (float*)(F.ws + WS_K + 16 * MiB);
    LAS unsigned char* L = F.lds;
    const int tid = F.tid, lane = F.lane, w = F.wave, l31 = lane & 31, hh = lane >> 5;
    const float NEG_INF = -INFINITY;
    for (int grp = F.bid; grp < MTOK / 128; grp += F.G) {
        const int tb = grp * 4 + (w & 3);
        const size_t m = (size_t)tb * 32 + l31;
        for (int hp = 0; hp < 4; ++hp) {
            __syncthreads();
#pragma unroll 4
            for (int r = 0; r < 16; ++r) { const int e = tid + NTHR * r, R = e >> 4, c = e & 15;
                *(LAS v4u*)(L + R * 256 + ((c ^ (R & 15)) * 16)) = *(const v4u*)(KEYS + ((size_t)(hp * 512 + R) * 128 + c * 8)); }
            __syncthreads();
            const int hl = w >> 2, h = 2 * hp + hl;
            float L0[16], L1[16];
#pragma unroll
            for (int p = 0; p < 2; ++p) {
                bf16x8 qf[8];
#pragma unroll
                for (int ks = 0; ks < 8; ++ks) qf[ks] = *(const bf16x8*)(PQ + m * 2048 + h * 256 + p * 128 + 16 * ks + 8 * hh);
                f32x16 acc[4];
#pragma unroll
                for (int kb = 0; kb < 4; ++kb)
#pragma unroll
                    for (int r = 0; r < 16; ++r) acc[kb][r] = 0.f;
#pragma unroll
                for (int ks = 0; ks < 8; ++ks)
#pragma unroll
                    for (int kb = 0; kb < 4; ++kb) { const int R = (hl * 2 + p) * 128 + 32 * kb + l31;
                        const bf16x8 kf = *(const LAS bf16x8*)(L + R * 256 + (((2 * ks + hh) ^ (lane & 15)) * 16));
                        acc[kb] = __builtin_amdgcn_mfma_f32_32x32x16_bf16(kf, qf[ks], acc[kb], 0, 0, 0); }
                float Lc[16];
#pragma unroll
                for (int i = 0; i < 16; ++i) Lc[i] = NEG_INF;
                const unsigned hh4 = (unsigned)hh << 2;
#pragma unroll
                for (int kb = 0; kb < 4; ++kb)
#pragma unroll
                    for (int r = 0; r < 16; ++r) { const unsigned nlo = (unsigned)(32 * kb + (r & 3) + 8 * (r >> 2));
                        const float av_ = acc[kb][r];
                        const float pk = __uint_as_float(((__float_as_uint(av_) & 0xffffff80u) | hh4) | nlo); TOPK_INSERT(Lc, pk); }
                float Lo[16];
#pragma unroll
                for (int i = 0; i < 16; ++i) Lo[i] = __shfl_xor(Lc[i], 32);
#pragma unroll
                for (int i = 0; i < 16; ++i) TOPK_INSERT(Lc, Lo[i]);
#pragma unroll
                for (int i = 0; i < 16; ++i) { if (p == 0) L0[i] = Lc[i]; else L1[i] = Lc[i]; }
            }
            float R[16];
#pragma unroll
            for (int i = 0; i < 16; ++i) R[i] = NEG_INF;
            CandRow<0>::run(L0, L1, R);
            unsigned a0 = 0, a1 = 0, a2 = 0, a3 = 0, b0 = 0, b1 = 0, b2 = 0, b3 = 0;
#pragma unroll
            for (int i = 0; i < 4; ++i) { a0 |= (__builtin_bit_cast(unsigned, L0[i]) & 127u) << (8 * i); a1 |= (__builtin_bit_cast(unsigned, L0[4 + i]) & 127u) << (8 * i);
                a2 |= (__builtin_bit_cast(unsigned, L0[8 + i]) & 127u) << (8 * i); a3 |= (__builtin_bit_cast(unsigned, L0[12 + i]) & 127u) << (8 * i);
                b0 |= (__builtin_bit_cast(unsigned, L1[i]) & 127u) << (8 * i); b1 |= (__builtin_bit_cast(unsigned, L1[4 + i]) & 127u) << (8 * i);
                b2 |= (__builtin_bit_cast(unsigned, L1[8 + i]) & 127u) << (8 * i); b3 |= (__builtin_bit_cast(unsigned, L1[12 + i]) & 127u) << (8 * i); }
            float ex[16]; float sum = 0.f; int id[16];
#pragma unroll
            for (int r = 0; r < 16; ++r) { ex[r] = __expf(R[r] - R[0]); sum += ex[r];
                const unsigned cid = __builtin_bit_cast(unsigned, R[r]) & 255u;
                id[r] = (int)(pick4(a0, a1, a2, a3, (int)(cid >> 4)) * 128u + pick4(b0, b1, b2, b3, (int)(cid & 15u))); }
            const float inv = 1.f / sum;
            if (hh == 0) {
#pragma unroll
                for (int q = 0; q < 4; ++q) {
                    *(int4*)(IDX + m * 128 + h * 16 + 4 * q) = make_int4(id[4 * q], id[4 * q + 1], id[4 * q + 2], id[4 * q + 3]);
                    *(f32x4*)(GW + m * 128 + h * 16 + 4 * q) = (f32x4){ex[4 * q] * inv, ex[4 * q + 1] * inv, ex[4 * q + 2] * inv, ex[4 * q + 3] * inv}; }
            }
        }
    }
}

template <int B> __device__ __forceinline__ f32x2 fp4b(unsigned w) { return __builtin_amdgcn_cvt_scalef32_pk_f32_fp4(w, 1.0f, B); }
__device__ __forceinline__ void apply_phase(Frame& F, float* OUTP) {
    const unsigned char* U8 = F.ws + WS_LG; const unsigned char* V8 = F.ws + WS_LG + 8 * MiB;
    const float* USC = (const float*)(F.ws + WS_LG + 16 * MiB); const float* VSC = USC + NEXP;
    const int* IDX = (const int*)(F.ws + WS_K); const float* GW = (const float*)(F.ws + WS_K + 16 * MiB);
    const float* g2 = F.in[20]; const float* gf = F.in[25];
    const float* X1 = F.out;
    const int lane = F.lane;
    const int gw = F.bid * NWAVES + F.wave, NGW = F.G * NWAVES;
    const bool b5 = (lane & 32) != 0, b4 = (lane & 16) != 0, b3 = (lane & 8) != 0, b2 = (lane & 4) != 0;
    const int eid = ((lane >> 5) & 1) * 8 + ((lane >> 4) & 1) * 4 + ((lane >> 3) & 1) * 2 + ((lane >> 2) & 1);
    for (int grp = F.bid; grp < MTOK / 128; grp += F.G)
    for (int m = grp * 128 + F.wave; m < grp * 128 + 128; m += NWAVES) {
        f32x2 hv[8]; float s = 0.f;
#pragma unroll
        for (int q = 0; q < 4; ++q) { const f32x4 a = *(const f32x4*)(X1 + (size_t)m * DM + lane * 16 + q * 4);
            s += (a[0] * a[0] + a[1] * a[1]) + (a[2] * a[2] + a[3] * a[3]); hv[2 * q] = (f32x2){a[0], a[1]}; hv[2 * q + 1] = (f32x2){a[2], a[3]}; }
        const float r2 = rsqrtf(wave_sum(s) * (1.f / DM) + EPS) ;
#pragma unroll
        for (int q = 0; q < 4; ++q) { const f32x4 g = *(const f32x4*)(g2 + lane * 16 + q * 4);
            hv[2 * q] = hv[2 * q] * (f32x2){g[0] * r2, g[1] * r2}; hv[2 * q + 1] = hv[2 * q + 1] * (f32x2){g[2] * r2, g[3] * r2}; }
        const int i0 = IDX[(size_t)m * 128 + lane], i1 = IDX[(size_t)m * 128 + 64 + lane];
        const float gw0 = GW[(size_t)m * 128 + lane], gw1 = GW[(size_t)m * 128 + 64 + lane];
        f32x2 acc[8];
#pragma unroll
        for (int i = 0; i < 8; ++i) acc[i] = (f32x2){0.f, 0.f};
#pragma unroll 1
        for (int bt = 0; bt < 8; ++bt) {
            const int k0 = bt * 16;
            const int isel = (k0 < 64) ? i0 : i1;
            v2u uu[16], vv[16];
            const int myidx = __shfl(isel, (k0 + eid) & 63);
            const float su = USC[myidx], sv = VSC[myidx];
#pragma unroll
            for (int e = 0; e < 16; ++e) { const size_t ro = (size_t)__builtin_amdgcn_readlane(isel, (k0 + e) & 63) * (DM / 2) + lane * 8;
                uu[e] = *(const v2u*)(U8 + ro); vv[e] = *(const v2u*)(V8 + ro); }
            float x[16];
#pragma unroll
            for (int e = 0; e < 16; ++e) { f32x2 d = fp4b<0>(uu[e].x) * hv[0];
                d = __builtin_elementwise_fma(fp4b<1>(uu[e].x), hv[1], d); d = __builtin_elementwise_fma(fp4b<2>(uu[e].x), hv[2], d); d = __builtin_elementwise_fma(fp4b<3>(uu[e].x), hv[3], d);
                d = __builtin_elementwise_fma(fp4b<0>(uu[e].y), hv[4], d); d = __builtin_elementwise_fma(fp4b<1>(uu[e].y), hv[5], d); d = __builtin_elementwise_fma(fp4b<2>(uu[e].y), hv[6], d);
                d = __builtin_elementwise_fma(fp4b<3>(uu[e].y), hv[7], d); x[e] = d[0] + d[1]; }
            float y[8], z[4], u2[2], t;
#pragma unroll
            for (int j = 0; j < 8; ++j) { const float keep = b5 ? x[8 + j] : x[j], send = b5 ? x[j] : x[8 + j]; y[j] = keep + __shfl_xor(send, 32); }
#pragma unroll
            for (int j = 0; j < 4; ++j) { const float keep = b4 ? y[4 + j] : y[j], send = b4 ? y[j] : y[4 + j]; z[j] = keep + __shfl_xor(send, 16); }
#pragma unroll
            for (int j = 0; j < 2; ++j) { const float keep = b3 ? z[2 + j] : z[j], send = b3 ? z[j] : z[2 + j]; u2[j] = keep + __shfl_xor(send, 8); }
            { const float keep = b2 ? u2[1] : u2[0], send = b2 ? u2[0] : u2[1]; t = keep + __shfl_xor(send, 4); }
            t += __shfl_xor(t, 2); t += __shfl_xor(t, 1);
            const float gk = __shfl((k0 < 64) ? gw0 : gw1, (k0 + eid) & 63);
            const float wl = gk * gelu_fast(t * su) * sv;
#pragma unroll
            for (int e = 0; e < 16; ++e) {
                const float we = __builtin_bit_cast(float, __builtin_amdgcn_readlane(__builtin_bit_cast(int, wl), 32 * (e >> 3) + 16 * ((e >> 2) & 1) + 8 * ((e >> 1) & 1) + 4 * (e & 1)));
                const f32x2 w2 = (f32x2){we, we};
                acc[0] = __builtin_elementwise_fma(fp4b<0>(vv[e].x), w2, acc[0]); acc[1] = __builtin_elementwise_fma(fp4b<1>(vv[e].x), w2, acc[1]);
                acc[2] = __builtin_elementwise_fma(fp4b<2>(vv[e].x), w2, acc[2]); acc[3] = __builtin_elementwise_fma(fp4b<3>(vv[e].x), w2, acc[3]);
                acc[4] = __builtin_elementwise_fma(fp4b<0>(vv[e].y), w2, acc[4]); acc[5] = __builtin_elementwise_fma(fp4b<1>(vv[e].y), w2, acc[5]);
                acc[6] = __builtin_elementwise_fma(fp4b<2>(vv[e].y), w2, acc[6]); acc[7] = __builtin_elementwise_fma(fp4b<3>(vv[e].y), w2, acc[7]);
            }
        }
        float s2 = 0.f;
#pragma unroll
        for (int q = 0; q < 4; ++q) { const f32x4 a = *(const f32x4*)(X1 + (size_t)m * DM + lane * 16 + q * 4);
            acc[2 * q] = acc[2 * q] + (f32x2){a[0], a[1]}; acc[2 * q + 1] = acc[2 * q + 1] + (f32x2){a[2], a[3]};
            s2 += (acc[2 * q][0] * acc[2 * q][0] + acc[2 * q][1] * acc[2 * q][1]) + (acc[2 * q + 1][0] * acc[2 * q + 1][0] + acc[2 * q + 1][1] * acc[2 * q + 1][1]); }
        const float rf = rsqrtf(wave_sum(s2) * (1.f / DM) + EPS);
#pragma unroll
        for (int q = 0; q < 4; ++q) { const f32x4 g = *(const f32x4*)(gf + lane * 16 + q * 4);
            *(f32x4*)(OUTP + (size_t)m * DM + lane * 16 + q * 4) = (f32x4){acc[2 * q][0] * rf * g[0], acc[2 * q][1] * rf * g[1], acc[2 * q + 1][0] * rf * g[2], acc[2 * q + 1][1] * rf * g[3]}; }
    }
}

constexpr int N_PHASES = 13;
__global__ void __launch_bounds__(NTHR, 2) mega_fwd(Args args) {
    extern __shared__ __attribute__((aligned(16))) unsigned char lds[];
    Frame F;
    F.lds = (LAS unsigned char*)lds;
    F.tid = threadIdx.x; F.lane = F.tid & 63; F.wave = __builtin_amdgcn_readfirstlane(F.tid >> 6);
    F.G = gridDim.x; F.bid = blockIdx.x;
    F.in = args.in; F.out = args.out; F.ws = args.ws;
    volatile LAS unsigned* MISC = (volatile LAS unsigned*)(F.lds + MISC_OFF);
    for (int u = F.tid; u < (LDS_BYTES - LDSCTL_OFF) / 4; u += NTHR) ((LAS unsigned*)(F.lds + LDSCTL_OFF))[u] = 0u;
    __syncthreads();
    XcdBarrier bar; bar.bar = (unsigned*)(args.ws + WS_CTL) + CW_BAR; bar.x = 0; bar.st = nullptr;
    const bool one_launch = (args.ph_hi - args.ph_lo) > 1;
    if (one_launch) bar = xcd_barrier_post((unsigned*)(args.ws + WS_CTL) + CW_BAR, MISC + 8);
    const int lo = args.ph_lo, hi = args.ph_hi;
#define IN(k) (lo <= (k) && (k) < hi)
#define SEAM(k) do { if (IN(k) && IN((k) + 1)) xcd_barrier(bar); } while (0)
    unsigned char* ws = args.ws;

#ifndef PROBE_MASK
#define PROBE_MASK 0
#endif
#define REP(k) _Pragma("unroll") for (int rep_ = 0; rep_ < (((PROBE_MASK >> (k)) & 1) ? 2 : 1); ++rep_)
    if (IN(0)) REP(0) { p0_prologue(F); if (rep_ == 0 && ((PROBE_MASK >> 0) & 1)) xcd_barrier(bar); } SEAM(0);
    if (IN(1)) REP(1) {
        AddrPlain g{(const char*)(ws + WS_K), (const char*)(ws + WS_WIN), 1024, 1024, 1024};
        pg8::StaticOrder S; S.init(MTOK, 6144, F.G, F.bid, 4);
        EpiBf16<DstP1> E{DstP1{ws}};
        gates_phase(F);
        pg8::gemm_phase(F.lds, g, S, E);
    } SEAM(1);
    if (IN(2)) REP(2) { lru_phase<false>(F); mconv_phase(F); } SEAM(2);
    if (IN(3)) REP(3) { lru_phase<true>(F); } SEAM(3);
    if (IN(5)) REP(5) {
        const char* xc = (const char*)F.out + (size_t)MTOK * DM * 2;
        AddrQKV g{xc, (long)((const char*)(ws + WS_XM) - xc), (const char*)(ws + WS_WQKV), 1024, 256, 256};
        pg8::StaticOrder S; S.init(MTOK, 12 * 256, F.G, F.bid);
        EpiBf16<DstQKV> E{DstQKV{(char*)(ws + WS_LG), (long)WS_K - (long)WS_LG, (long)WS_XL - (long)WS_LG}};
        pg8::gemm_phase(F.lds, g, S, E);
    } SEAM(5);
    if (IN(6)) REP(6) { mscan_phase(F); } SEAM(6);
    if (IN(7)) { ym_phase(F); } SEAM(7);
    if (IN(8)) {
        pg8::StaticOrder S; S.init(MTOK, 1024, F.G, F.bid);
        { AddrPlain g{(const char*)(ws + WS_OP), (const char*)(ws + WS_WB2), 1024, 1024, 1024};
          EpiMerge<false> E{(bf16*)(ws + WS_XM), (const bf16*)(ws + WS_MG), 0}; pg8::gemm_phase(F.lds, g, S, E); }
        { AddrPlain g{(const char*)F.out, (const char*)(ws + WS_WB2) + (size_t)1024 * 1024 * 2, 1024, 1024, 1024};
          EpiMerge<true> E{(bf16*)(ws + WS_XM), (const bf16*)(ws + WS_MG), 1024}; pg8::gemm_phase(F.lds, g, S, E); }
    } SEAM(8);
    if (IN(9)) {
        AddrPlain g{(const char*)(ws + WS_XM), (const char*)(ws + WS_WOUT2), 1024, 2048, 1024};
        pg8::StaticOrder S; S.init(MTOK, 1024, F.G, F.bid);
        EpiResid E{F.in[0], F.out, (bf16*)(ws + WS_XL), (float*)(ws + WS_SS)};
        pg8::gemm_phase(F.lds, g, S, E);
    } SEAM(9);
    if (IN(10)) REP(10) {
        AddrPlain g{(const char*)(ws + WS_XL), (const char*)(ws + WS_WPQ), 1024, 1024, 1024};
        pg8::StaticOrder S; S.init(MTOK, 2048, F.G, F.bid);
        EpiPQ E{(bf16*)(ws + WS_MG), (const float*)(ws + WS_SS)};
        pg8::gemm_phase(F.lds, g, S, E);
    } SEAM(10);
    if (IN(11)) REP(11) { select_phase(F); }
    if (IN(11) && IN(12)) { asm volatile("s_waitcnt vmcnt(0)" ::: "memory"); __syncthreads(); }
    if (IN(12)) { if ((PROBE_MASK >> 12) & 1) { apply_phase(F, (float*)(ws + WS_MG)); xcd_barrier(bar); } apply_phase(F, F.out); }
#undef REP
#undef IN
#undef SEAM
}

extern "C" void kernel_launch(void* const* d_in, const int* in_sizes, int n_in, void* d_out, int out_size, void* d_ws, size_t ws_size, hipStream_t stream) {
    static int grid = 0;
    if (grid == 0) {
        if (n_in != 26 || in_sizes[0] != MTOK * DM || out_size != MTOK * DM || ws_size < WS_END) { fprintf(stderr, "kernel_launch: unexpected shapes / workspace (%zu < %zu)\n", ws_size, (size_t)WS_END); grid = -1; return; }
        int dev = 0, cus = 0, per_cu = 0;
        if (hipGetDevice(&dev) != hipSuccess || hipDeviceGetAttribute(&cus, hipDeviceAttributeMultiprocessorCount, dev) != hipSuccess) { grid = -1; return; }
        if (hipFuncSetAttribute((const void*)mega_fwd, hipFuncAttributeMaxDynamicSharedMemorySize, LDS_BYTES) != hipSuccess) { fprintf(stderr, "kernel_launch: hipFuncSetAttribute failed\n"); grid = -1; return; }
        if (hipOccupancyMaxActiveBlocksPerMultiprocessor(&per_cu, (const void*)mega_fwd, NTHR, LDS_BYTES) != hipSuccess || per_cu < 1) { fprintf(stderr, "kernel_launch: occupancy query says %d blocks/CU\n", per_cu); (void)hipGetLastError(); grid = -1; return; }
        grid = cus;
    }
    if (grid < 0) return;
    (void)hipMemsetAsync((char*)d_ws + WS_CTL, 0, CTL_ZERO_BYTES, stream);
    Args a{};
    for (int i = 0; i < 26; ++i) a.in[i] = (const float*)d_in[i];
    a.out = (float*)d_out; a.ws = (unsigned char*)d_ws;
#if MK_N_LAUNCHES == 1
    a.ph_lo = 0; a.ph_hi = N_PHASES;
    void* kargs[] = {&a};
    hipError_t e = hipLaunchCooperativeKernel((const void*)mega_fwd, dim3(grid), dim3(NTHR), kargs, LDS_BYTES, stream);
    if (e != hipSuccess) fprintf(stderr, "kernel_launch: cooperative launch failed: %s (grid %d)\n", hipGetErrorString(e), grid);
#else
    for (int p = 0; p < N_PHASES; ++p) { a.ph_lo = p; a.ph_hi = p + 1; hipLaunchKernelGGL(mega_fwd, dim3(grid), dim3(NTHR), LDS_BYTES, stream, a); }
#endif
}
```

```cpp
#include <hip/hip_runtime.h>
#include <cstdio>
#include <cstdint>
#include <math.h>

#ifndef MK_N_LAUNCHES
#define MK_N_LAUNCHES 1
#endif

constexpr int BATCH = 8, SEQ = 4096, DM = 1024, MTOK = BATCH * SEQ;
constexpr int DIN = 6160;
constexpr int NEXP = 16384;
constexpr float EPS = 1e-6f;

constexpr size_t MiB = 1u << 20;
constexpr size_t WS_CTL = 0, CTL_ZERO_BYTES = 1 * MiB;
constexpr size_t WS_WIN = 1 * MiB;
constexpr size_t WS_WQKV = 13 * MiB;
constexpr size_t WS_KEYS = 14 * MiB + 512 * 1024;
constexpr size_t WS_WLRU = 15 * MiB;
constexpr size_t WS_WB2 = 16 * MiB;
constexpr size_t WS_WOUT2 = 20 * MiB;
constexpr size_t WS_WPQ = 24 * MiB;
constexpr size_t WS_GATE = 28 * MiB;
constexpr size_t WS_WGT = 30 * MiB;
constexpr size_t WS_XM = 32 * MiB;
constexpr size_t WS_OP = 96 * MiB;
constexpr size_t WS_XL = 160 * MiB;
constexpr size_t WS_LG = 224 * MiB;
constexpr size_t WS_MG = 288 * MiB;
constexpr size_t WS_K = 416 * MiB;
constexpr size_t WS_AGG = 480 * MiB;
constexpr size_t WS_SS = 488 * MiB;
constexpr size_t WS_END = 489 * MiB;

constexpr int CW_BAR = 4096;

constexpr int RING_BYTES = 131072;
constexpr int LDS_BYTES = 147456;
constexpr int LDSCTL_OFF = LDS_BYTES - 512, MISC_OFF = LDSCTL_OFF + 320;
constexpr int NWAVES = 8, NTHR = 512;

#define GAS __attribute__((address_space(1)))
#define LAS __attribute__((address_space(3)))
typedef unsigned short bf16;
typedef unsigned v4u __attribute__((ext_vector_type(4)));
typedef unsigned v2u __attribute__((ext_vector_type(2)));
typedef float f32x4 __attribute__((ext_vector_type(4)));
typedef float f32x2 __attribute__((ext_vector_type(2)));
typedef short bf16x8 __attribute__((ext_vector_type(8)));
typedef GAS unsigned gu32;
#define RLX_AGENT __ATOMIC_RELAXED, __HIP_MEMORY_SCOPE_AGENT
#define LDS_WAIT() asm volatile("s_waitcnt lgkmcnt(0)" ::: "memory")
#define VM_WAIT() asm volatile("s_waitcnt vmcnt(0)" ::: "memory")

__device__ __forceinline__ unsigned f2bf(float f) { unsigned u = __builtin_bit_cast(unsigned, f); return (u + 0x7fffu + ((u >> 16) & 1u)) >> 16; }
__device__ __forceinline__ unsigned pk2(float lo, float hi) { return f2bf(lo) | (f2bf(hi) << 16); }
__device__ __forceinline__ float bf2f(unsigned short h) { return __builtin_bit_cast(float, (unsigned)h << 16); }
__device__ __forceinline__ float bflo(unsigned w) { return __builtin_bit_cast(float, w << 16); }
__device__ __forceinline__ float bfhi(unsigned w) { return __builtin_bit_cast(float, w & 0xffff0000u); }
__device__ __forceinline__ float wave_sum(float v) {
#pragma unroll
  for (int o = 1; o < 64; o <<= 1) v += __shfl_xor(v, o);
  return v;
}
__device__ __forceinline__ float sigmoidf_(float x) { return __builtin_amdgcn_rcpf(1.f + __builtin_amdgcn_exp2f(x * -1.44269504089f)); }
__device__ __forceinline__ float gelu_erf(float x) { return 0.5f * x * (1.f + erff(x * 0.70710678118654752f)); }
__device__ __forceinline__ float gelu_fast(float v) {
    const float av = fabsf(v), t = __builtin_amdgcn_rcpf(av * 0.2316418882f + 1.0f);
    float q = t * 0.5307027145f + (-0.7265760135f); q = q * t + 0.7107068705f; q = q * t + (-0.142248368f); q = q * t + 0.127414796f; q = q * t;
    const float e = __builtin_amdgcn_exp2f((v * v) * (-0.72134752044f));
    const float m = v * (q * e);
    return v < 0.f ? m : v - m;
}
__device__ __forceinline__ float softplusf_(float x) { return fmaxf(x, 0.f) + log1pf(expf(-fabsf(x))); }

namespace pg8 {
#define PG8_LAS __attribute__((address_space(3)))
typedef unsigned short bf16_t;
typedef unsigned u32x4 __attribute__((ext_vector_type(4)));
constexpr int BM = 256, BK = 64, HALF = 128, HTB = HALF * BK * 2, STAGE_BYTES = 8 * HTB, NXCD = 8;

__host__ __device__ __forceinline__ int lds_byte(int r, int c) { const int st = (r >> 4) * 2 + (c >> 5), rr = r & 15, cc = c & 31, ob = rr * 64 + cc * 2; return st * 1024 + (ob ^ (((ob >> 9) & 1) << 5)); }
__host__ __device__ __forceinline__ void stage_rc(int b, int& R, int& C) { const int st = b / 1024, sb = b % 1024, swz = sb ^ (((sb >> 9) & 1) << 5); R = (st >> 1) * 16 + swz / 64; C = (st & 1) * 32 + (swz % 64) / 2; }
__host__ __device__ __forceinline__ int perm32(int rho) { const int n = rho >> 4, i = rho & 15; return 8 * (i >> 2) + 4 * n + (i & 3); }

struct Unit { int pm, pn; };
struct StaticOrder {
    int nM, nN, nwg, G, c, WGM;
    __host__ __device__ void init(int M, int N, int G_, int c_, int wgm = 8) { nM = M / BM; nN = N / BM; nwg = nM * nN; G = G_; c = c_; WGM = wgm; }
    __host__ __device__ bool next(int i, Unit& u) const {
        const long L = (long)i * G + c; if (L >= nwg) return false;
        int wgid = (int)L; { const int q = nwg / NXCD, r = nwg % NXCD, xcd = wgid % NXCD, off = wgid / NXCD; wgid = (xcd < r ? xcd * (q + 1) : r * (q + 1) + (xcd - r) * q) + off; }
        const int nig = WGM * nN, gid = wgid / nig, fm = gid * WGM, gsz = (nM - fm) < WGM ? (nM - fm) : WGM;
        u.pm = fm + ((wgid % nig) % gsz); u.pn = (wgid % nig) / gsz; return true;
    }
};

__device__ __forceinline__ unsigned cvt_pk_bf16(float lo, float hi) { unsigned r; asm volatile("v_cvt_pk_bf16_f32 %0, %1, %2" : "=v"(r) : "v"(lo), "v"(hi)); return r; }

template <class Epi, class Addr>
__device__ __forceinline__ void gemm_phase(PG8_LAS unsigned char* lds, const Addr g, const StaticOrder& S, const Epi& E) {
    const int tid = threadIdx.x, wid = __builtin_amdgcn_readfirstlane(tid >> 6), lane = tid & 63, wr = wid >> 2, wc = wid & 3, fr = lane & 15, fq = lane >> 4;
    const int K = g.K, nt = K / BK;
    unsigned voffA[2], voffB[2];
#pragma unroll
    for (int i = 0; i < 2; ++i) { int R, C; stage_rc(tid * 16 + i * 8192, R, C); const int Rb = Epi::PERM ? ((R & ~31) + perm32(R & 31)) : R;
        voffA[i] = (unsigned)(R * g.lda + C) * 2u; voffB[i] = (unsigned)(Rb * g.ldb + C) * 2u; }
    const size_t kstep = (size_t)(BK * 2);
    const size_t hsA = (size_t)HALF * g.lda * 2, hsB = (size_t)HALF * g.ldb * 2;
    const unsigned ldsw = (unsigned)wid * 1024u;
    const int aoff = lds_byte(wr * 64 + fr, fq * 8), boff = lds_byte(wc * 32 + fr, fq * 8);
#define PG8_SA(b, h) (((b) * 2 + (h)) * HTB)
#define PG8_SB(b, h) ((4 + (b) * 2 + (h)) * HTB)
#define PG8_STAGE(bufoff, gbase, voff) do { _Pragma("unroll") for (int _i = 0; _i < 2; ++_i) \
        __builtin_amdgcn_global_load_lds((const unsigned*)((const char*)(gbase) + (voff)[_i]), (PG8_LAS unsigned*)(lds + (bufoff) + ldsw + _i * 8192), 16, 0, 0); } while (0)
#define PG8_LDA(dst, b, h) do { _Pragma("unroll") for (int m = 0; m < 4; ++m) _Pragma("unroll") for (int k = 0; k < 2; ++k) dst[m][k] = *(const PG8_LAS bf16x8*)(lds + PG8_SA(b, h) + aoff + m * 2048 + k * 1024); } while (0)
#define PG8_LDB(dst, b, h) do { _Pragma("unroll") for (int n = 0; n < 2; ++n) _Pragma("unroll") for (int k = 0; k < 2; ++k) dst[n][k] = *(const PG8_LAS bf16x8*)(lds + PG8_SB(b, h) + boff + n * 2048 + k * 1024); } while (0)
#define PG8_MMA(ai, bj, At, Bt) do { __builtin_amdgcn_s_setprio(1); _Pragma("unroll") for (int m = 0; m < 4; ++m) _Pragma("unroll") for (int n = 0; n < 2; ++n) _Pragma("unroll") for (int k = 0; k < 2; ++k) \
        acc[ai][bj][m][n] = __builtin_amdgcn_mfma_f32_16x16x32_bf16(Bt[n][k], At[m][k], acc[ai][bj][m][n], 0, 0, 0); __builtin_amdgcn_s_setprio(0); } while (0)
#define PG8_WAIT_V(n) asm volatile("s_waitcnt vmcnt(" #n ")" ::: "memory")
#define PG8_WAIT_L(n) asm volatile("s_waitcnt lgkmcnt(" #n ")" ::: "memory")
#define PG8_BAR __builtin_amdgcn_s_barrier()
#define PG8_SCHED __builtin_amdgcn_sched_barrier(0)
    Unit cur, nxt; int ui = 0;
    if (!S.next(0, cur)) return;
    f32x4 acc[2][2][4][2];
#pragma unroll
    for (int a = 0; a < 2; ++a)
#pragma unroll
        for (int b = 0; b < 2; ++b)
#pragma unroll
            for (int m = 0; m < 4; ++m)
#pragma unroll
                for (int n = 0; n < 2; ++n) acc[a][b][m][n] = (f32x4){0.f, 0.f, 0.f, 0.f};
    bf16x8 At[4][2], B0[2][2], B1[2][2];
    const char* cA = g.a(cur); const char* cB = g.b(cur);
    PG8_STAGE(PG8_SB(0, 0), cB, voffB); PG8_STAGE(PG8_SB(0, 1), cB + hsB, voffB); PG8_STAGE(PG8_SA(0, 0), cA, voffA); PG8_STAGE(PG8_SA(0, 1), cA + hsA, voffA);
    if (wr == 1) PG8_BAR;
    PG8_WAIT_V(2); PG8_BAR;
    PG8_STAGE(PG8_SB(1, 0), cB + kstep, voffB); PG8_STAGE(PG8_SA(1, 0), cA + kstep, voffA); PG8_STAGE(PG8_SB(1, 1), cB + hsB + kstep, voffB);
    PG8_WAIT_V(6); PG8_BAR;
    for (;;) {
        const bool has_next = S.next(ui + 1, nxt);
        const char* nA = has_next ? g.a(nxt) : cA; const char* nB = has_next ? g.b(nxt) : cB;
#pragma unroll 1
        for (int t = 0; t < nt; t += 2) {
            const bool last = (t == nt - 2);
            const char* a1 = cA + (size_t)(t + 1) * kstep;
            const char* a2 = last ? nA : cA + (size_t)(t + 2) * kstep; const char* b2 = last ? nB : cB + (size_t)(t + 2) * kstep;
            const char* a3 = a2 + kstep; const char* b3 = b2 + kstep;
            PG8_LDB(B0, 0, 0); PG8_LDB(B1, 0, 1); PG8_SCHED; PG8_LDA(At, 0, 0); PG8_STAGE(PG8_SA(1, 1), a1 + hsA, voffA);
            PG8_WAIT_V(8); PG8_WAIT_L(0); PG8_BAR; PG8_MMA(0, 0, At, B0); PG8_MMA(0, 1, At, B1); PG8_BAR; PG8_SCHED;
            PG8_LDA(At, 0, 1); PG8_STAGE(PG8_SB(0, 0), b2, voffB); PG8_STAGE(PG8_SB(0, 1), b2 + hsB, voffB); PG8_STAGE(PG8_SA(0, 0), a2, voffA);
            PG8_WAIT_V(8); PG8_WAIT_L(0); PG8_BAR; PG8_MMA(1, 0, At, B0); PG8_MMA(1, 1, At, B1); PG8_BAR; PG8_SCHED;
            PG8_LDB(B0, 1, 0); PG8_LDB(B1, 1, 1); PG8_SCHED; PG8_LDA(At, 1, 0); PG8_STAGE(PG8_SA(0, 1), a2 + hsA, voffA);
            PG8_WAIT_V(8); PG8_WAIT_L(0); PG8_BAR; PG8_MMA(0, 0, At, B0); PG8_MMA(0, 1, At, B1); PG8_BAR; PG8_SCHED;
            PG8_LDA(At, 1, 1); PG8_STAGE(PG8_SB(1, 0), b3, voffB); PG8_STAGE(PG8_SB(1, 1), b3 + hsB, voffB); PG8_STAGE(PG8_SA(1, 0), a3, voffA);
            PG8_WAIT_V(8); PG8_WAIT_L(0); PG8_BAR; PG8_MMA(1, 0, At, B0); PG8_MMA(1, 1, At, B1); PG8_BAR; PG8_SCHED;
        }
        if (wr == 0) PG8_BAR;
        E(acc, cur, wr, wc, fr, fq);
        if (!has_next) break;
#pragma unroll
        for (int a = 0; a < 2; ++a)
#pragma unroll
            for (int b = 0; b < 2; ++b)
#pragma unroll
                for (int m = 0; m < 4; ++m)
#pragma unroll
                    for (int n = 0; n < 2; ++n) acc[a][b][m][n] = (f32x4){0.f, 0.f, 0.f, 0.f};
        cur = nxt; cA = nA; cB = nB; ++ui;
        if (wr == 1) PG8_BAR;
    }
    PG8_WAIT_V(0);
    PG8_BAR;
#undef PG8_SA
#undef PG8_SB
#undef PG8_STAGE
#undef PG8_LDA
#undef PG8_LDB
#undef PG8_MMA
#undef PG8_WAIT_V
#undef PG8_WAIT_L
#undef PG8_BAR
#undef PG8_SCHED
}
}

#define XB_TMO      128
#define XB_XCNT(j)  (256  + 64 * (j))
#define XB_XSUB(j)  (1280 + 64 * (j))
#define XB_XGEN(j)  (2304 + 64 * (j))
#define XB_TOP      3328
#define XB_TOPGEN   3392
#define XCD_BAR_WORDS 3456
#define XB_SPIN_CAP (1u << 18)
__device__ __forceinline__ unsigned xb_ld(unsigned* p)              { return __hip_atomic_load(p, __ATOMIC_RELAXED, __HIP_MEMORY_SCOPE_AGENT); }
__device__ __forceinline__ unsigned xb_add(unsigned* p, unsigned v) { return __hip_atomic_fetch_add(p, v, __ATOMIC_RELAXED, __HIP_MEMORY_SCOPE_AGENT); }
__device__ __forceinline__ unsigned xb_xcc_id() { return (unsigned)__builtin_amdgcn_s_getreg((3 << 11) | 20) & 0xFu; }
#define XB_SPIN(cond, bar) do { unsigned _sp = 0; while (cond) { __builtin_amdgcn_s_sleep(1); \
    if ((++_sp & 255u) == 0u) { if (xb_ld(&(bar)[XB_TMO])) break; if (_sp > XB_SPIN_CAP) { atomicAdd(&(bar)[XB_TMO], 1u); break; } } } } while (0)
struct XcdBarrier { unsigned* bar; unsigned x; volatile LAS unsigned* st; };
__device__ __forceinline__ XcdBarrier xcd_barrier_post(unsigned* bar, volatile LAS unsigned* st) {
    XcdBarrier b; b.bar = bar; b.x = xb_xcc_id(); b.st = st;
    if (threadIdx.x == 0) (void)xb_add(&bar[XB_XCNT(b.x)], 1u);
    return b;
}
__device__ __forceinline__ void xcd_barrier_complete(unsigned* bar, unsigned x, unsigned& nloc, unsigned& nx) {
    const unsigned G = gridDim.x * gridDim.y * gridDim.z;
    unsigned sum, cnt, mine, sp = 0u;
    for (;;) {
        sum = 0u; cnt = 0u; mine = 0u;
#pragma unroll
        for (unsigned j = 0; j < 16; ++j) { const unsigned c = xb_ld(&bar[XB_XCNT(j)]); sum += c; cnt += (c > 0u) ? 1u : 0u; mine = (j == x) ? c : mine; }
        if (sum == G) break;
        __builtin_amdgcn_s_sleep(1);
        if ((++sp & 255u) == 0u) { if (xb_ld(&bar[XB_TMO])) break; if (sp > XB_SPIN_CAP) { atomicAdd(&bar[XB_TMO], 1u); break; } }
    }
    nloc = mine > 0u ? mine : 1u; nx = cnt > 0u ? cnt : 1u;
}
__device__ __forceinline__ void xcd_barrier(const XcdBarrier& b) {
    asm volatile("s_waitcnt vmcnt(0)" ::: "memory");
    __syncthreads();
    if (threadIdx.x == 0) {
        unsigned* bar = b.bar;
        __builtin_amdgcn_s_waitcnt(0);
        unsigned nloc = b.st[0], nx = b.st[1];
        if (nloc == 0u) { xcd_barrier_complete(bar, b.x, nloc, nx); b.st[0] = nloc; b.st[1] = nx; }
        const unsigned old = xb_add(&bar[XB_XSUB(b.x)], 1u);
        const unsigned gen = old / nloc;
        if (old + 1u == (gen + 1u) * nloc) {
            __builtin_amdgcn_fence(__ATOMIC_RELEASE, "agent");
            asm volatile("s_waitcnt vmcnt(0)" ::: "memory");
            const unsigned og = xb_add(&bar[XB_TOP], 1u);
            const unsigned tg = og / nx;
            if (og + 1u == (tg + 1u) * nx) xb_add(&bar[XB_TOPGEN], 1u);
            else XB_SPIN(xb_ld(&bar[XB_TOPGEN]) == tg, bar);
            __builtin_amdgcn_fence(__ATOMIC_ACQUIRE, "agent");
            xb_add(&bar[XB_XGEN(b.x)], 1u);
            asm volatile("s_waitcnt vmcnt(0)" ::: "memory");
        } else {
            XB_SPIN(xb_ld(&bar[XB_XGEN(b.x)]) == gen, bar);
            __builtin_amdgcn_fence(__ATOMIC_ACQUIRE, "agent");
            asm volatile("s_waitcnt vmcnt(0)" ::: "memory");
        }
    }
    __syncthreads();
}

struct Args { const float* in[26]; float* out; unsigned char* ws; int ph_lo, ph_hi; };
struct Frame {
    LAS unsigned char* lds;
    int tid, lane, wave, G, bid;
    const float* const* in; float* out; unsigned char* ws;
};

__device__ __forceinline__ void tr_item(const float* W, int ldw, bf16* WT, int ldt, float scale, const float* kscale, LAS float* scr, int k0, int lane) {
#pragma unroll 8
    for (int i = 0; i < 32; ++i) { const int kk = 2 * i + (lane >> 5); float v = W[(size_t)(k0 + kk) * ldw + (lane & 31)] * scale; if (kscale) v *= kscale[k0 + kk]; scr[kk * 33 + (lane & 31)] = v; }
    LDS_WAIT(); asm volatile("" ::: "memory");
    const int c = lane & 7;
#pragma unroll
    for (int j = 0; j < 4; ++j) { const int n = (lane >> 3) + 8 * j; const LAS float* s = scr + (8 * c) * 33 + n;
        v4u o; o.x = pk2(s[0 * 33], s[1 * 33]); o.y = pk2(s[2 * 33], s[3 * 33]); o.z = pk2(s[4 * 33], s[5 * 33]); o.w = pk2(s[6 * 33], s[7 * 33]);
        *(GAS v4u*)(WT + (size_t)n * ldt + k0 + 8 * c) = o; }
    LDS_WAIT(); asm volatile("" ::: "memory");
}

__device__ __forceinline__ void p0_prologue(Frame& F) {
    LAS float* scr = (LAS float*)(F.lds + F.wave * 16384);
    const int gw = F.bid * NWAVES + F.wave, NGW = F.G * NWAVES;
    unsigned char* ws = F.ws;
    const float* w_in = F.in[2];
    constexpr int I_WIN = 16 * 192, I_QKV = 12 * 32, I_LRU = 32 * 8, I_WB = 2 * 512, I_WO = 2 * 512, I_PQ = 16 * 64;
    constexpr int NITEMS = I_WIN + I_QKV + I_LRU + I_WB + I_WO + I_PQ;
    for (int it = gw; it < NITEMS; it += NGW) {
        int r = it;
        if (r < I_WIN) { const int kb = r / 192, nb = r % 192, n0 = nb * 32, sc = n0 < 2048 ? n0 : n0 + 16;
            tr_item(w_in + sc, DIN, (bf16*)(ws + WS_WIN) + (size_t)n0 * 1024, 1024, 1.f, nullptr, scr, kb * 64, F.lane); continue; }
        r -= I_WIN;
        if (r < I_QKV) { const int mat = r / 32, rr = r % 32, kb = rr / 8, nb = rr % 8, g = mat >> 2, h = mat & 3;
            const float* W = F.in[6 + g] + (size_t)h * 65536 + nb * 32;
            tr_item(W, 256, (bf16*)(ws + WS_WQKV) + (size_t)mat * 65536 + (size_t)(nb * 32) * 256, 256, g == 1 ? 0.0625f : 1.f, nullptr, scr, kb * 64, F.lane); continue; }
        r -= I_QKV;
        if (r < I_LRU) { const int mat = r / 8, rr = r % 8, kb = rr / 4, nb = rr % 4, gate = mat & 1, db = mat >> 1;
            const float* W = F.in[gate ? 14 : 12] + (size_t)db * 16384 + nb * 32;
            tr_item(W, 128, (bf16*)(ws + WS_WLRU) + (size_t)mat * 16384 + (size_t)(nb * 32) * 128, 128, 1.f, nullptr, scr, kb * 64, F.lane); continue; }
        r -= I_LRU;
        if (r < I_WB) { const int mat = r / 512, rr = r % 512, kb = rr / 32, nb = rr % 32;
            const float* W = F.in[17 + mat] + nb * 32;
            tr_item(W, 1024, (bf16*)(ws + WS_WB2) + (size_t)(mat * 1024 + nb * 32) * 1024, 1024, 1.f, nullptr, scr, kb * 64, F.lane); continue; }
        r -= I_WB;
        if (r < I_WO) { const int cp = r / 512, rr = r % 512, kb = rr / 32, nb = rr % 32;
            const float* W = F.in[19] + nb * 32;
            tr_item(W, 1024, (bf16*)(ws + WS_WOUT2) + (size_t)(nb * 32) * 2048 + cp * 1024, 2048, 1.f, nullptr, scr, kb * 64, F.lane); continue; }
        r -= I_WO;
        { const int kb = r / 64, nb = r % 64;
            const float* W = F.in[21] + nb * 32;
            tr_item(W, 2048, (bf16*)(ws + WS_WPQ) + (size_t)(nb * 32) * 1024, 1024, 1.f, F.in[20], scr, kb * 64, F.lane); }
    }
    { const int gt = F.bid * NTHR + F.tid, NGT = F.G * NTHR;
      const float4* ks = (const float4*)F.in[22]; v2u* kd = (v2u*)(ws + WS_KEYS);
      for (int i = gt; i < 8 * 2 * 128 * 128 / 4; i += NGT) { const float4 v = ks[i]; v2u o; o.x = pk2(v.x, v.y); o.y = pk2(v.z, v.w); kd[i] = o; }
      float* ss = (float*)(ws + WS_SS);
      for (int i = gt; i < MTOK; i += NGT) ss[i] = 0.f; }
    { const int gt = F.bid * NTHR + F.tid;
      if (gt < 16 * 128) { const int c = gt >> 7, k8 = gt & 127; v4u o; unsigned wv[4];
#pragma unroll
          for (int j = 0; j < 4; ++j) wv[j] = pk2(w_in[(size_t)(k8 * 8 + 2 * j) * DIN + 2048 + c], w_in[(size_t)(k8 * 8 + 2 * j + 1) * DIN + 2048 + c]);
          o.x = wv[0]; o.y = wv[1]; o.z = wv[2]; o.w = wv[3]; *(v4u*)((bf16*)(ws + WS_WGT) + c * 1024 + k8 * 8) = o; } }
    const float* x = F.in[0]; const float* g1 = F.in[1];
    bf16* XN = (bf16*)(ws + WS_K);
    f32x4 gv[4];
#pragma unroll
    for (int j = 0; j < 4; ++j) gv[j] = ((const f32x4*)g1)[F.lane + 64 * j];
    for (int m = 2 * gw; m < MTOK; m += 2 * NGW) {
        const f32x4* xr0 = (const f32x4*)(x + (size_t)m * DM) + F.lane; const f32x4* xr1 = xr0 + DM / 4;
        f32x4 v0[4], v1[4]; float s0 = 0.f, s1 = 0.f;
#pragma unroll
        for (int j = 0; j < 4; ++j) { v0[j] = xr0[64 * j]; v1[j] = xr1[64 * j]; }
#pragma unroll
        for (int j = 0; j < 4; ++j) { s0 += (v0[j].x * v0[j].x + v0[j].y * v0[j].y) + (v0[j].z * v0[j].z + v0[j].w * v0[j].w); s1 += (v1[j].x * v1[j].x + v1[j].y * v1[j].y) + (v1[j].z * v1[j].z + v1[j].w * v1[j].w); }
        const float r0 = rsqrtf(wave_sum(s0) * (1.f / DM) + EPS), r1 = rsqrtf(wave_sum(s1) * (1.f / DM) + EPS);
        unsigned long long* o0 = (unsigned long long*)(XN + (size_t)m * DM) + F.lane; unsigned long long* o1 = o0 + DM / 4;
#pragma unroll
        for (int j = 0; j < 4; ++j) { const f32x4 a = v0[j] * r0 * gv[j], c = v1[j] * r1 * gv[j];
            o0[64 * j] = (unsigned long long)pk2(a.x, a.y) | ((unsigned long long)pk2(a.z, a.w) << 32);
            o1[64 * j] = (unsigned long long)pk2(c.x, c.y) | ((unsigned long long)pk2(c.z, c.w) << 32); }
    }
}
__device__ __forceinline__ void gates_phase(Frame& F) {
    const bf16* XN = (const bf16*)(F.ws + WS_K); const bf16* WGT = (const bf16*)(F.ws + WS_WGT); float* GT = (float*)(F.ws + WS_GATE);
    const int lane = F.lane, fr = lane & 15, fq = lane >> 4;
    const f32x4 bg4 = *(const f32x4*)(F.in[3] + 4 * fq);
    for (int task = F.bid * NWAVES + F.wave; task < MTOK / 16; task += F.G * NWAVES) {
        const size_t m0 = (size_t)task * 16;
        f32x4 acc = (f32x4){0.f, 0.f, 0.f, 0.f};
#pragma unroll 8
        for (int ks = 0; ks < 32; ++ks) {
            const bf16x8 wfr = *(const bf16x8*)(WGT + fr * 1024 + 32 * ks + 8 * fq);
            const bf16x8 xfr = *(const bf16x8*)(XN + (m0 + fr) * DM + 32 * ks + 8 * fq);
            acc = __builtin_amdgcn_mfma_f32_16x16x32_bf16(wfr, xfr, acc, 0, 0, 0);
        }
        *(f32x4*)(GT + (m0 + fr) * 16 + 4 * fq) = acc + bg4;
    }
}

struct AddrPlain {
    const char* A; const char* Bt; int lda, ldb, K;
    __device__ __forceinline__ const char* a(const pg8::Unit& u) const { return A + (size_t)u.pm * 256 * lda * 2; }
    __device__ __forceinline__ const char* b(const pg8::Unit& u) const { return Bt + (size_t)u.pn * 256 * ldb * 2; }
};
struct AddrQKV {
    const char* XC; long dXM; const char* W; int lda, ldb, K;
    __device__ __forceinline__ const char* a(const pg8::Unit& u) const { return XC + (u.pn < 8 ? 0l : dXM) + ((size_t)u.pm * 256 * 1024 + (u.pn & 3) * 256) * 2; }
    __device__ __forceinline__ const char* b(const pg8::Unit& u) const { return W + (size_t)u.pn * 65536 * 2; }
};
struct AddrBranch {
    const char* YM; long dYL; const char* W; int lda, ldb, K;
    __device__ __forceinline__ const char* a(const pg8::Unit& u) const { return YM + (u.pn < 4 ? 0l : dYL) + (size_t)u.pm * 256 * 1024 * 2; }
    __device__ __forceinline__ const char* b(const pg8::Unit& u) const { return W + (size_t)u.pn * 256 * 1024 * 2; }
};

struct DstP1 { unsigned char* ws;
    __device__ __forceinline__ bf16* get(int pn, int& ld, int& col0) const {
        const bool mg = pn >= 16; ld = mg ? 2048 : 1024; col0 = mg ? (pn - 16) * 256 : (pn & 3) * 256;
        return (bf16*)(ws + (mg ? WS_MG : WS_XM + (size_t)(pn >> 2) * 64 * MiB)); } };
struct DstQKV { char* q; long dk, dv;
    __device__ __forceinline__ bf16* get(int pn, int& ld, int& col0) const { ld = 1024; col0 = (pn & 3) * 256; return (bf16*)(q + (pn >= 4 ? (pn >= 8 ? dv : dk) : 0l)); } };
template <class Dst> struct EpiBf16 {
    static constexpr bool PERM = true;
    Dst dst;
    __device__ __forceinline__ void operator()(const f32x4 (&acc)[2][2][4][2], const pg8::Unit& u, int wr, int wc, int fr, int fq) const {
        int ld, colt; bf16* base = dst.get(u.pn, ld, colt);
        const int row0 = u.pm * 256 + wr * 64 + fr, col0 = colt + wc * 32 + 8 * fq;
#pragma unroll
        for (int ai = 0; ai < 2; ++ai)
#pragma unroll
            for (int m = 0; m < 4; ++m) { bf16* rowp = base + (size_t)(row0 + ai * 128 + m * 16) * ld + col0;
#pragma unroll
                for (int bj = 0; bj < 2; ++bj) { const f32x4 v0 = acc[ai][bj][m][0], v1 = acc[ai][bj][m][1];
                    v4u w; w.x = pg8::cvt_pk_bf16(v0[0], v0[1]); w.y = pg8::cvt_pk_bf16(v0[2], v0[3]); w.z = pg8::cvt_pk_bf16(v1[0], v1[1]); w.w = pg8::cvt_pk_bf16(v1[2], v1[3]);
                    *(v4u*)(rowp + bj * 128) = w; } }
    }
};
template <bool ADD> struct EpiMerge {
    static constexpr bool PERM = true;
    bf16* MRG; const bf16* MG; int gcol;
    __device__ __forceinline__ void operator()(const f32x4 (&acc)[2][2][4][2], const pg8::Unit& u, int wr, int wc, int fr, int fq) const {
        const int row0 = u.pm * 256 + wr * 64 + fr, col0 = u.pn * 256 + wc * 32 + 8 * fq;
#pragma unroll
        for (int ai = 0; ai < 2; ++ai)
#pragma unroll
            for (int m = 0; m < 4; ++m) { const size_t row = (size_t)(row0 + ai * 128 + m * 16); bf16* rowp = MRG + row * 1024 + col0; const bf16* gp = MG + row * 2048 + gcol + col0;
#pragma unroll
                for (int bj = 0; bj < 2; ++bj) { const f32x4 v0 = acc[ai][bj][m][0], v1 = acc[ai][bj][m][1];
                    const v4u g = *(const v4u*)(gp + bj * 128);
                    float o[8] = {v0[0] * sigmoidf_(bflo(g.x)), v0[1] * sigmoidf_(bfhi(g.x)), v0[2] * sigmoidf_(bflo(g.y)), v0[3] * sigmoidf_(bfhi(g.y)),
                                  v1[0] * sigmoidf_(bflo(g.z)), v1[1] * sigmoidf_(bfhi(g.z)), v1[2] * sigmoidf_(bflo(g.w)), v1[3] * sigmoidf_(bfhi(g.w))};
                    if (ADD) { const v4u t = *(const v4u*)(rowp + bj * 128);
                        o[0] += bflo(t.x); o[1] += bfhi(t.x); o[2] += bflo(t.y); o[3] += bfhi(t.y); o[4] += bflo(t.z); o[5] += bfhi(t.z); o[6] += bflo(t.w); o[7] += bfhi(t.w); }
                    v4u w; w.x = pg8::cvt_pk_bf16(o[0], o[1]); w.y = pg8::cvt_pk_bf16(o[2], o[3]); w.z = pg8::cvt_pk_bf16(o[4], o[5]); w.w = pg8::cvt_pk_bf16(o[6], o[7]);
                    *(v4u*)(rowp + bj * 128) = w; } }
    }
};
struct EpiResid {
    static constexpr bool PERM = false;
    const float* x; float* x1; bf16* x1b; float* ss;
    __device__ __forceinline__ void operator()(const f32x4 (&acc)[2][2][4][2], const pg8::Unit& u, int wr, int wc, int fr, int fq) const {
        const int row0 = u.pm * 256 + wr * 64 + fr, col0 = u.pn * 256 + wc * 32 + 4 * fq;
#pragma unroll
        for (int ai = 0; ai < 2; ++ai)
#pragma unroll
            for (int m = 0; m < 4; ++m) { const int row = row0 + ai * 128 + m * 16; const size_t off = (size_t)row * DM + col0; float s = 0.f;
#pragma unroll
                for (int bj = 0; bj < 2; ++bj)
#pragma unroll
                    for (int n = 0; n < 2; ++n) { const size_t o = off + bj * 128 + n * 16; const f32x4 v = *(const f32x4*)(x + o) + acc[ai][bj][m][n];
                        *(f32x4*)(x1 + o) = v; v2u w; w.x = pg8::cvt_pk_bf16(v[0], v[1]); w.y = pg8::cvt_pk_bf16(v[2], v[3]); *(v2u*)(x1b + o) = w;
                        s += (v[0] * v[0] + v[1] * v[1]) + (v[2] * v[2] + v[3] * v[3]); }
                s += __shfl_xor(s, 16); s += __shfl_xor(s, 32);
                if (fq == 0) atomicAdd(ss + row, s); }
    }
};
struct EpiPQ {
    static constexpr bool PERM = true;
    bf16* pq; const float* ss;
    __device__ __forceinline__ void operator()(const f32x4 (&acc)[2][2][4][2], const pg8::Unit& u, int wr, int wc, int fr, int fq) const {
        const int row0 = u.pm * 256 + wr * 64 + fr, col0 = u.pn * 256 + wc * 32 + 8 * fq;
#pragma unroll
        for (int ai = 0; ai < 2; ++ai)
#pragma unroll
            for (int m = 0; m < 4; ++m) { const int row = row0 + ai * 128 + m * 16; bf16* rowp = pq + (size_t)row * 2048 + col0;
                const float r = rsqrtf(ss[row] * (1.f / DM) + EPS);
#pragma unroll
                for (int bj = 0; bj < 2; ++bj) { const f32x4 v0 = acc[ai][bj][m][0] * r, v1 = acc[ai][bj][m][1] * r;
                    v4u w; w.x = pg8::cvt_pk_bf16(v0[0], v0[1]); w.y = pg8::cvt_pk_bf16(v0[2], v0[3]); w.z = pg8::cvt_pk_bf16(v1[0], v1[1]); w.w = pg8::cvt_pk_bf16(v1[2], v1[3]);
                    *(v4u*)(rowp + bj * 128) = w; } }
    }
};

template <bool PB> __device__ __forceinline__ void lru_phase(Frame& F) {
    const bf16* XL = (const bf16*)(F.ws + WS_XL); const bf16* LG = (const bf16*)(F.ws + WS_LG); bf16* YL = (bf16*)F.out;
    f32x2* AGG = (f32x2*)(F.ws + WS_AGG);
    const bf16* WL = (const bf16*)(F.ws + WS_WLRU);
    const float* cw = F.in[10]; const float* cb = F.in[11];
    constexpr int O_XCB = 0, O_XCF = 17408, O_A = 51200, O_U = 84992, FST = 528;
    LAS unsigned char* L = F.lds;
    const int tid = F.tid, lane = F.lane, w = F.wave, fr = lane & 15, fq = lane >> 4;
    int cur_blk = -1;
    bf16x8 wf[2][2][4];
    f32x4 br4[2], bi4[2], sp4[2];
    v4u rawreg[3];
#define RAW_LOAD(bb, tt0, bk) do { _Pragma("unroll") for (int r_ = 0; r_ < 3; ++r_) { const int e_ = tid + NTHR * r_, row_ = e_ >> 4, c16_ = e_ & 15, t_ = (tt0) - 2 + row_; \
            v4u v_ = {0u, 0u, 0u, 0u}; if (e_ < 68 * 16 && t_ >= 0 && t_ < SEQ) v_ = *(const v4u*)(XL + ((size_t)(bb) * SEQ + t_) * DM + (bk) * 128 + c16_ * 8); rawreg[r_] = v_; } } while (0)
    constexpr int O_CARRY = 118784, O_CW = 135168, O_SUB = 137728;
    const bool carry_tab = PB && (F.G == 256);
    if (carry_tab) {
        const int ch = tid & 127, bq = tid >> 7, s0 = F.bid >> 3, blk0 = F.bid & 7;
        LAS float* CT = (LAS float*)(L + O_CARRY);
#define FOLD(agp, j0, j1, stp, hv) do { int js_ = (j0); const int n_ = ((j1) - (j0)) * (stp); int k_ = 0; \
            for (; k_ + 8 <= n_; k_ += 8) { f32x2 ah_[8]; _Pragma("unroll") for (int q_ = 0; q_ < 8; ++q_) ah_[q_] = (agp)[(size_t)(js_ + q_ * (stp)) * 2 * DM]; \
                _Pragma("unroll") for (int q_ = 0; q_ < 8; ++q_) hv = ah_[q_][0] * hv + ah_[q_][1]; js_ += 8 * (stp); } \
            for (; k_ < n_; ++k_) { const f32x2 a1_ = (agp)[(size_t)js_ * 2 * DM]; hv = a1_[0] * hv + a1_[1]; js_ += (stp); } } while (0)
        for (int bb = 2 * bq; bb < 2 * bq + 2; ++bb) {
            const f32x2* ag0 = AGG + ((size_t)(bb * 64) * 2 + 0) * DM + blk0 * 128 + ch; const f32x2* ag1 = AGG + ((size_t)(bb * 64) * 2 + 1) * DM + blk0 * 128 + ch;
            float h = 0.f;
            FOLD(ag0, 0, s0, 1, h); CT[((bb * 2 + 0) * 2 + 0) * 128 + ch] = h;
            FOLD(ag0, s0, s0 + 32, 1, h); CT[((bb * 2 + 1) * 2 + 0) * 128 + ch] = h;
            h = 0.f;
            FOLD(ag1, 63, s0 + 32, -1, h); CT[((bb * 2 + 1) * 2 + 1) * 128 + ch] = h;
            FOLD(ag1, s0 + 32, s0, -1, h); CT[((bb * 2 + 0) * 2 + 1) * 128 + ch] = h;
        }
        __syncthreads();
#undef FOLD
    }
    for (int i = 0;; ++i) {
        const int idx = i * F.G + F.bid; if (idx >= 4096) break;
        const int blk = idx & 7, j = idx >> 3, b = j >> 6, seg = j & 63, t0 = seg * 64;
        const size_t mrow0 = (size_t)b * SEQ + t0;
        if (blk != cur_blk) {
            cur_blk = blk;
#pragma unroll
            for (int d = 0; d < 2; ++d) {
#pragma unroll
                for (int g = 0; g < 2; ++g)
#pragma unroll
                    for (int ks = 0; ks < 4; ++ks)
                        wf[d][g][ks] = *(const bf16x8*)(WL + ((size_t)((d * 8 + blk) * 2 + g) * 128 + 16 * w + fr) * 128 + 32 * ks + 8 * fq);
                const int ch = blk * 128 + 16 * w + 4 * fq;
                br4[d] = *(const f32x4*)(F.in[13] + d * DM + ch); bi4[d] = *(const f32x4*)(F.in[15] + d * DM + ch);
                const f32x4 lm = *(const f32x4*)(F.in[16] + d * DM + ch);
#pragma unroll
                for (int e = 0; e < 4; ++e) sp4[d][e] = -8.f * 1.44269504089f * softplusf_(-lm[e]);
            }
            __syncthreads();
            for (int e = tid; e < 5 * 128; e += NTHR) { const int jt = e >> 7, cc = e & 127; ((LAS float*)(L + O_CW))[e] = (jt < 4) ? cw[jt * DM + blk * 128 + cc] : cb[blk * 128 + cc]; }
        }
        if (i == 0) RAW_LOAD(b, t0, blk);
#pragma unroll
        for (int r = 0; r < 3; ++r) { const int e = tid + NTHR * r; if (e < 68 * 16) *(LAS v4u*)(L + O_A + (e >> 4) * 256 + (e & 15) * 16) = rawreg[r]; }
        __syncthreads();
        { const int idx2 = (i + 1) * F.G + F.bid; if (idx2 < 4096) { const int j2 = idx2 >> 3; RAW_LOAD(j2 >> 6, (j2 & 63) * 64, idx2 & 7); } }
        v4u lgreg[2];
        if (PB) {
#pragma unroll
            for (int r = 0; r < 2; ++r) { const int e = tid + NTHR * r; lgreg[r] = *(const v4u*)(LG + (mrow0 + (e >> 4)) * DM + blk * 128 + (e & 15) * 8); } }
        for (int e = tid; e < 64 * 16; e += NTHR) { const int tl = e >> 4, c16 = e & 15;
            float y[8];
            { const f32x4 a = *(const LAS f32x4*)(L + O_CW + 4 * 512 + c16 * 32), bq = *(const LAS f32x4*)(L + O_CW + 4 * 512 + c16 * 32 + 16); y[0] = a[0]; y[1] = a[1]; y[2] = a[2]; y[3] = a[3]; y[4] = bq[0]; y[5] = bq[1]; y[6] = bq[2]; y[7] = bq[3]; }
#pragma unroll
            for (int jt = 0; jt < 4; ++jt) { const v4u r = *(const LAS v4u*)(L + O_A + (tl + jt) * 256 + c16 * 16);
                const f32x4 wa = *(const LAS f32x4*)(L + O_CW + jt * 512 + c16 * 32), wb = *(const LAS f32x4*)(L + O_CW + jt * 512 + c16 * 32 + 16);
                y[0] += wa[0] * bflo(r.x); y[1] += wa[1] * bfhi(r.x); y[2] += wa[2] * bflo(r.y); y[3] += wa[3] * bfhi(r.y);
                y[4] += wb[0] * bflo(r.z); y[5] += wb[1] * bfhi(r.z); y[6] += wb[2] * bflo(r.w); y[7] += wb[3] * bfhi(r.w); }
            *(LAS f32x4*)(L + O_XCF + tl * FST + c16 * 32) = (f32x4){y[0], y[1], y[2], y[3]};
            *(LAS f32x4*)(L + O_XCF + tl * FST + c16 * 32 + 16) = (f32x4){y[4], y[5], y[6], y[7]};
            v4u o; o.x = pk2(y[0], y[1]); o.y = pk2(y[2], y[3]); o.z = pk2(y[4], y[5]); o.w = pk2(y[6], y[7]);
            *(LAS v4u*)(L + O_XCB + tl * 272 + c16 * 16) = o; }
        __syncthreads();
        float carry0 = 0.f, carry1 = 0.f;
        if (carry_tab) { const LAS float* CT = (const LAS float*)(L + O_CARRY); carry0 = CT[((b * 2 + (seg >> 5)) * 2 + 0) * 128 + (tid & 127)]; carry1 = CT[((b * 2 + (seg >> 5)) * 2 + 1) * 128 + (tid & 127)]; }
        else if (PB) {
            const int ch = blk * 128 + (tid & 127);
            float h = 0.f;
            const f32x2* ag0 = AGG + ((size_t)(b * 64) * 2 + 0) * DM + ch; const f32x2* ag1 = AGG + ((size_t)(b * 64) * 2 + 1) * DM + ch;
            int js = 0;
            for (; js + 8 <= seg; js += 8) { f32x2 ah[8];
#pragma unroll
                for (int q = 0; q < 8; ++q) ah[q] = ag0[(size_t)(js + q) * 2 * DM];
#pragma unroll
                for (int q = 0; q < 8; ++q) h = ah[q][0] * h + ah[q][1]; }
            for (; js < seg; ++js) { const f32x2 ah = ag0[(size_t)js * 2 * DM]; h = ah[0] * h + ah[1]; }
            carry0 = h; h = 0.f;
            js = 63;
            for (; js - 8 >= seg; js -= 8) { f32x2 ah[8];
#pragma unroll
                for (int q = 0; q < 8; ++q) ah[q] = ag1[(size_t)(js - q) * 2 * DM];
#pragma unroll
                for (int q = 0; q < 8; ++q) h = ah[q][0] * h + ah[q][1]; }
            for (; js > seg; --js) { const f32x2 ah = ag1[(size_t)js * 2 * DM]; h = ah[0] * h + ah[1]; }
            carry1 = h;
        }
#pragma unroll
        for (int d = 0; d < 2; ++d) {
            const int o_a = (d == 0) ? O_A : O_XCF;
            f32x4 aR[4], aI[4];
#pragma unroll
            for (int mt = 0; mt < 4; ++mt) { aR[mt] = (f32x4){0.f, 0.f, 0.f, 0.f}; aI[mt] = (f32x4){0.f, 0.f, 0.f, 0.f}; }
#pragma unroll
            for (int ks = 0; ks < 4; ++ks)
#pragma unroll
                for (int mt = 0; mt < 4; ++mt) { const bf16x8 xb = *(const LAS bf16x8*)(L + O_XCB + (16 * mt + fr) * 272 + (32 * ks + 8 * fq) * 2);
                    aR[mt] = __builtin_amdgcn_mfma_f32_16x16x32_bf16(wf[d][0][ks], xb, aR[mt], 0, 0, 0);
                    aI[mt] = __builtin_amdgcn_mfma_f32_16x16x32_bf16(wf[d][1][ks], xb, aI[mt], 0, 0, 0); }
#pragma unroll
            for (int mt = 0; mt < 4; ++mt) { const int tl = 16 * mt + fr, cl = 16 * w + 4 * fq;
                const f32x4 xc = *(const LAS f32x4*)(L + O_XCF + tl * FST + cl * 4);
                f32x4 av, uv;
#pragma unroll
                for (int e = 0; e < 4; ++e) { const float r = sigmoidf_(aR[mt][e] + br4[d][e]), ig = sigmoidf_(aI[mt][e] + bi4[d][e]);
                    const float a_ = __builtin_amdgcn_exp2f(r * sp4[d][e]); av[e] = a_; uv[e] = __builtin_amdgcn_sqrtf(fmaxf(1.f - a_ * a_, 0.f)) * (ig * xc[e]); }
                *(LAS f32x4*)(L + o_a + tl * FST + cl * 4) = av; *(LAS f32x4*)(L + O_U + tl * FST + cl * 4) = uv; }
            __syncthreads();
            {
                const int c = tid & 127, sub = tid >> 7;
                LAS float* pa = (LAS float*)(L + o_a) + c; const LAS float* pu = (const LAS float*)(L + O_U) + c;
                LAS f32x2* SUBT = (LAS f32x2*)(L + O_SUB);
                float h = 0.f, A = 1.f;
#pragma unroll
                for (int s2 = 0; s2 < 16; ++s2) { const int tl = d ? (16 * sub + 15 - s2) : (16 * sub + s2); const float a = pa[tl * 132], u = pu[tl * 132]; h = a * h + u; A *= a; }
                SUBT[sub * 128 + c] = (f32x2){A, h};
                __syncthreads();
                if (!PB) {
                    if (sub == 0) { float HH = 0.f, AA = 1.f;
#pragma unroll
                        for (int q = 0; q < 4; ++q) { const f32x2 ah = SUBT[(d ? 3 - q : q) * 128 + c]; HH = ah[0] * HH + ah[1]; AA *= ah[0]; }
                        AGG[((size_t)(b * 64 + seg) * 2 + d) * DM + blk * 128 + c] = (f32x2){AA, HH}; }
                } else {
                    float hc = d ? carry1 : carry0;
#pragma unroll
                    for (int q = 0; q < 3; ++q) { const int jq = d ? 3 - q : q; const f32x2 ah = SUBT[jq * 128 + c]; if (d ? (jq > sub) : (jq < sub)) hc = ah[0] * hc + ah[1]; }
                    if (d == 0) {
#pragma unroll
                        for (int s2 = 0; s2 < 16; ++s2) { const int tl = 16 * sub + s2; hc = pa[tl * 132] * hc + pu[tl * 132]; pa[tl * 132] = hc; }
                    } else { LAS float* ph = (LAS float*)(L + O_A) + c;
#pragma unroll
                        for (int s2 = 0; s2 < 16; ++s2) { const int tl = 16 * sub + 15 - s2; hc = pa[tl * 132] * hc + pu[tl * 132]; ph[tl * 132] += hc; } }
                }
            }
            __syncthreads();
        }
        if (PB) {
#pragma unroll
            for (int r = 0; r < 2; ++r) { const int e = tid + NTHR * r, row = e >> 4, c16 = e & 15;
                const v4u g = lgreg[r];
                const f32x4 h0 = *(const LAS f32x4*)(L + O_A + row * FST + c16 * 32), h1 = *(const LAS f32x4*)(L + O_A + row * FST + c16 * 32 + 16);
                v4u o;
                o.x = pk2(h0[0] * gelu_fast(bflo(g.x)), h0[1] * gelu_fast(bfhi(g.x))); o.y = pk2(h0[2] * gelu_fast(bflo(g.y)), h0[3] * gelu_fast(bfhi(g.y)));
                o.z = pk2(h1[0] * gelu_fast(bflo(g.z)), h1[1] * gelu_fast(bfhi(g.z))); o.w = pk2(h1[2] * gelu_fast(bflo(g.w)), h1[3] * gelu_fast(bfhi(g.w)));
                *(v4u*)(YL + (mrow0 + row) * DM + blk * 128 + c16 * 8) = o; }
            __syncthreads();
        }
    }
#undef RAW_LOAD
}

__device__ __forceinline__ void mconv_phase(Frame& F) {
    const bf16* XM = (const bf16*)(F.ws + WS_XM); bf16* XC = (bf16*)F.out + (size_t)MTOK * DM;
    const float* cw = F.in[4]; const float* cb = F.in[5];
    const int NT = MTOK / 32 * 128;
    for (int g = F.bid * NTHR + F.tid; g < NT; g += F.G * NTHR) {
        const int chunk = g & 127, run = g >> 7, c0 = chunk * 8, m0 = run * 32, t0 = m0 & (SEQ - 1);
        float w[4][8], bias[8];
#pragma unroll
        for (int j = 0; j < 4; ++j) { const f32x4 a = *(const f32x4*)(cw + j * DM + c0), b = *(const f32x4*)(cw + j * DM + c0 + 4);
            w[j][0] = a[0]; w[j][1] = a[1]; w[j][2] = a[2]; w[j][3] = a[3]; w[j][4] = b[0]; w[j][5] = b[1]; w[j][6] = b[2]; w[j][7] = b[3]; }
        { const f32x4 a = *(const f32x4*)(cb + c0), b = *(const f32x4*)(cb + c0 + 4);
            bias[0] = a[0]; bias[1] = a[1]; bias[2] = a[2]; bias[3] = a[3]; bias[4] = b[0]; bias[5] = b[1]; bias[6] = b[2]; bias[7] = b[3]; }
        v4u win[4];
        const v4u zero = {0u, 0u, 0u, 0u};
        win[0] = zero;
        win[1] = (t0 >= 2) ? *(const v4u*)(XM + (size_t)(m0 - 2) * DM + c0) : zero;
        win[2] = (t0 >= 1) ? *(const v4u*)(XM + (size_t)(m0 - 1) * DM + c0) : zero;
        win[3] = *(const v4u*)(XM + (size_t)m0 * DM + c0);
#pragma unroll 4
        for (int i = 0; i < 32; ++i) {
            win[0] = win[1]; win[1] = win[2]; win[2] = win[3];
            win[3] = (t0 + i + 1 < SEQ) ? *(const v4u*)(XM + (size_t)(m0 + i + 1) * DM + c0) : zero;
            float y[8];
#pragma unroll
            for (int e = 0; e < 8; ++e) y[e] = bias[e];
#pragma unroll
            for (int j = 0; j < 4; ++j) {
                const unsigned p0 = win[j].x, p1 = win[j].y, p2 = win[j].z, p3 = win[j].w;
                y[0] += w[j][0] * bflo(p0); y[1] += w[j][1] * bfhi(p0); y[2] += w[j][2] * bflo(p1); y[3] += w[j][3] * bfhi(p1);
                y[4] += w[j][4] * bflo(p2); y[5] += w[j][5] * bfhi(p2); y[6] += w[j][6] * bflo(p3); y[7] += w[j][7] * bfhi(p3);
            }
#pragma unroll
            for (int e = 0; e < 8; ++e) y[e] = y[e] * sigmoidf_(y[e]);
            v4u o; o.x = pk2(y[0], y[1]); o.y = pk2(y[2], y[3]); o.z = pk2(y[4], y[5]); o.w = pk2(y[6], y[7]);
            *(v4u*)(XC + (size_t)(m0 + i) * DM + c0) = o;
        }
    }
}

typedef short s16x4 __attribute__((ext_vector_type(4)));
__device__ __forceinline__ bf16x8 tr_read_pair(unsigned a0, unsigned a1) {
    s16x4 r0, r1;
    asm volatile("ds_read_b64_tr_b16 %0, %2\n\tds_read_b64_tr_b16 %1, %3\n\ts_waitcnt lgkmcnt(0)" : "=&v"(r0), "=&v"(r1) : "v"(a0), "v"(a1) : "memory");
    return __builtin_shufflevector(r0, r1, 0, 1, 2, 3, 4, 5, 6, 7);
}
__device__ __forceinline__ float dpp_shr(float oldv, float x, int n) {
    const int o = __builtin_bit_cast(int, oldv), v = __builtin_bit_cast(int, x);
    int r;
    if (n == 1) r = __builtin_amdgcn_update_dpp(o, v, 0x111, 0xf, 0xf, false);
    else if (n == 2) r = __builtin_amdgcn_update_dpp(o, v, 0x112, 0xf, 0xf, false);
    else if (n == 4) r = __builtin_amdgcn_update_dpp(o, v, 0x114, 0xf, 0xf, false);
    else r = __builtin_amdgcn_update_dpp(o, v, 0x118, 0xf, 0xf, false);
    return __builtin_bit_cast(float, r);
}
__device__ __forceinline__ float rdlane(float x, int l) { return __builtin_bit_cast(float, __builtin_amdgcn_readlane(__builtin_bit_cast(int, x), l)); }
__device__ __forceinline__ float wave_incl_sum(float x, int lane) {
    x += dpp_shr(0.f, x, 1); x += dpp_shr(0.f, x, 2); x += dpp_shr(0.f, x, 4); x += dpp_shr(0.f, x, 8);
    const float t0 = rdlane(x, 15), t1 = rdlane(x, 31), t2 = rdlane(x, 47);
    return x + (lane >= 16 ? t0 : 0.f) + (lane >= 32 ? t1 : 0.f) + (lane >= 48 ? t2 : 0.f);
}
__device__ __forceinline__ float wave_incl_max(float x, int lane) {
    const float NI = -INFINITY;
    x = fmaxf(x, dpp_shr(NI, x, 1)); x = fmaxf(x, dpp_shr(NI, x, 2)); x = fmaxf(x, dpp_shr(NI, x, 4)); x = fmaxf(x, dpp_shr(NI, x, 8));
    const float t0 = rdlane(x, 15), t1 = rdlane(x, 31), t2 = rdlane(x, 47);
    return fmaxf(fmaxf(x, lane >= 16 ? t0 : NI), fmaxf(lane >= 32 ? t1 : NI, lane >= 48 ? t2 : NI));
}
__device__ __forceinline__ void mscan_phase(Frame& F) {
    const bf16* Q = (const bf16*)(F.ws + WS_LG); const bf16* K = (const bf16*)(F.ws + WS_K); const bf16* V = (const bf16*)(F.ws + WS_XL);
    const float* GT = (const float*)(F.ws + WS_GATE);
    constexpr int KS = 0, CTI = 33792, VT = 67584, VWT = 86016, PB = 104448, TAB = 113664, NT = 116736, NPART = 117760, DENT = 119808;
    constexpr int KST = 528, VST = 144, TABSZ = 1536;
    LAS unsigned char* L = F.lds;
    const int tid = F.tid, lane = F.lane, w = F.wave, fr = lane & 15, fq = lane >> 4, pt = w & 3, wg = w >> 2;
    for (int item = F.bid; item < 256; item += F.G) {
        const int es = item & 3, dir = (item >> 2) & 1, h = (item >> 3) & 3, b = item >> 5;
        bf16* H = dir ? ((bf16*)F.out + (size_t)MTOK * DM) : (bf16*)(F.ws + WS_XM);
        const size_t rowbase = (size_t)b * SEQ;
#define TOF(c, p) (dir ? (SEQ - 1 - 64 * (c) - (p)) : (64 * (c) + (p)))
        for (int e = tid; e < (33792 + 1024) / 4; e += NTHR) { if (e < 33792 / 4) ((LAS unsigned*)(L + CTI))[e] = 0u; else ((LAS unsigned*)(L + NT))[e - 33792 / 4] = 0u; }
        float m_run = 0.f;
        float gi_n = 0.f, gf_n = 0.f;
        if (w == 0) { const size_t m = rowbase + TOF(0, lane); gi_n = GT[m * 16 + dir * 8 + h]; gf_n = GT[m * 16 + dir * 8 + 4 + h]; }
#define G1_TABLES(setp) do { \
            const float logf_ = fminf(gf_n, 0.f) - __logf(1.f + __expf(-fabsf(gf_n))); const float b_ = wave_incl_sum(logf_, lane); const float a_ = gi_n - b_; \
            const float M_ = fmaxf(m_run, wave_incl_max(a_, lane)); const float Mend_ = rdlane(M_, 63), g_ = rdlane(b_, 63); \
            LAS float* T_ = (LAS float*)(setp); T_[lane] = a_; T_[64 + lane] = M_; T_[128 + lane] = __expf(m_run - M_); T_[192 + lane] = __expf(-(b_ + M_)); T_[256 + lane] = __expf(a_ - Mend_); \
            if (lane == 0) { T_[320] = __expf(m_run - Mend_); T_[321] = g_ + Mend_; } \
            m_run = g_ + Mend_; } while (0)
        if (w == 0) G1_TABLES(L + TAB);
        __syncthreads();
        bf16x8 qf[8];
        v4u kreg[4]; v4u vreg;
#define LOAD_KV(c) do { _Pragma("unroll") for (int r_ = 0; r_ < 4; ++r_) { const int i_ = tid + NTHR * r_, s_ = i_ >> 5, c16_ = i_ & 31; \
                kreg[r_] = *(const v4u*)(K + (rowbase + TOF(c, s_)) * DM + h * 256 + c16_ * 8); } \
            { const int s_ = tid & 63, e8_ = tid >> 6; vreg = *(const v4u*)(V + (rowbase + TOF(c, s_)) * DM + h * 256 + es * 64 + e8_ * 8); } } while (0)
#define STORE_KV(setidx) do { _Pragma("unroll") for (int r_ = 0; r_ < 4; ++r_) { const int i_ = tid + NTHR * r_, s_ = i_ >> 5, c16_ = i_ & 31; \
                *(LAS v4u*)(L + KS + s_ * KST + c16_ * 16) = kreg[r_]; } \
            { const int s_ = tid & 63, e8_ = tid >> 6; const float ws_ = ((const LAS float*)(L + TAB + (setidx) * TABSZ))[256 + s_]; \
              LAS bf16* vt_ = (LAS bf16*)(L + VT + (setidx) * 9216); LAS bf16* vw_ = (LAS bf16*)(L + VWT + (setidx) * 9216); \
              const unsigned wv_[4] = {vreg.x, vreg.y, vreg.z, vreg.w}; \
              _Pragma("unroll") for (int j_ = 0; j_ < 4; ++j_) { const float lo_ = bflo(wv_[j_]), hi_ = bfhi(wv_[j_]); const int e_ = e8_ * 8 + 2 * j_; \
                vt_[e_ * 72 + s_] = (bf16)(wv_[j_] & 0xffffu); vt_[(e_ + 1) * 72 + s_] = (bf16)(wv_[j_] >> 16); \
                vw_[e_ * 72 + s_] = (bf16)f2bf(lo_ * ws_); vw_[(e_ + 1) * 72 + s_] = (bf16)f2bf(hi_ * ws_); } } } while (0)
#define LOAD_Q(c) do { const size_t m_ = rowbase + TOF(c, 16 * pt + fr); _Pragma("unroll") for (int ks_ = 0; ks_ < 8; ++ks_) \
                qf[ks_] = *(const bf16x8*)(Q + m_ * DM + h * 256 + 32 * ks_ + 8 * fq); } while (0)
        LOAD_KV(0); LOAD_Q(0);
        STORE_KV(0);
        f32x4 Cacc[8];
#pragma unroll
        for (int i = 0; i < 8; ++i) Cacc[i] = (f32x4){0.f, 0.f, 0.f, 0.f};
        __syncthreads();
        for (int c = 0; c < 64; ++c) {
            const int cur = c & 1, nxt = cur ^ 1;
            const bool has_next = (c + 1 < 64);
            const LAS float* T = (const LAS float*)(L + TAB + cur * TABSZ);
            if (has_next) { LOAD_KV(c + 1); if (w == 0) { const size_t m = rowbase + TOF(c + 1, lane); gi_n = GT[m * 16 + dir * 8 + h]; gf_n = GT[m * 16 + dir * 8 + 4 + h]; } }
            const int p = 16 * pt + fr;
            const float Mp = T[64 + p], wi_p = T[128 + p];
            float cs = 0.f;
#pragma unroll
            for (int i = 0; i < 2; ++i) { const int st = 2 * wg + i;
                v2u pw = {0u, 0u};
                if (st <= pt) {
                    f32x4 sa = (f32x4){0.f, 0.f, 0.f, 0.f};
#pragma unroll
                    for (int ks = 0; ks < 8; ++ks) { const bf16x8 kf = *(const LAS bf16x8*)(L + KS + (16 * st + fr) * KST + (32 * ks + 8 * fq) * 2);
                        sa = __builtin_amdgcn_mfma_f32_16x16x32_bf16(kf, qf[ks], sa, 0, 0, 0); }
                    const f32x4 a4 = *(const LAS f32x4*)(T + 16 * st + 4 * fq);
                    float pv[4];
#pragma unroll
                    for (int r = 0; r < 4; ++r) { const int s_ = 16 * st + 4 * fq + r; const float wgt = (s_ <= p) ? __expf(a4[r] - Mp) : 0.f; pv[r] = sa[r] * wgt; cs += pv[r]; }
                    pw.x = pk2(pv[0], pv[1]); pw.y = pk2(pv[2], pv[3]);
                }
                *(LAS v2u*)(L + PB + p * VST + (16 * st + 4 * fq) * 2) = pw; }
            f32x4 O[2];
#pragma unroll
            for (int i = 0; i < 2; ++i) { const int et = 2 * wg + i; O[i] = (f32x4){0.f, 0.f, 0.f, 0.f};
#pragma unroll
                for (int ks = 0; ks < 8; ++ks) { const bf16x8 cf = *(const LAS bf16x8*)(L + CTI + (16 * et + fr) * KST + (32 * ks + 8 * fq) * 2);
                    O[i] = __builtin_amdgcn_mfma_f32_16x16x32_bf16(cf, qf[ks], O[i], 0, 0, 0); } }
            float di = 0.f;
#define DEN_INTER(ks) do { const f32x4 n0 = *(const LAS f32x4*)(L + NT + (32 * (ks) + 8 * fq) * 4), n1 = *(const LAS f32x4*)(L + NT + (32 * (ks) + 8 * fq) * 4 + 16); \
                const v4u qw = __builtin_bit_cast(v4u, qf[ks]); \
                di += bflo(qw.x) * n0[0] + bfhi(qw.x) * n0[1] + bflo(qw.y) * n0[2] + bfhi(qw.y) * n0[3] + bflo(qw.z) * n1[0] + bfhi(qw.z) * n1[1] + bflo(qw.w) * n1[2] + bfhi(qw.w) * n1[3]; } while (0)
            if (wg == 0) { DEN_INTER(0); DEN_INTER(1); DEN_INTER(2); DEN_INTER(3); }
            else { DEN_INTER(4); DEN_INTER(5); DEN_INTER(6); DEN_INTER(7); }
#undef DEN_INTER
            di += __shfl_xor(di, 16); di += __shfl_xor(di, 32);
            cs += __shfl_xor(cs, 16); cs += __shfl_xor(cs, 32);
            if (fq == 0) ((LAS float*)(L + DENT))[wg * 64 + p] = wi_p * di + cs;
            if (has_next) LOAD_Q(c + 1);
            if (has_next && w == 0) G1_TABLES(L + TAB + nxt * TABSZ);
            __syncthreads();
#pragma unroll
            for (int i = 0; i < 2; ++i) { const int et = 2 * wg + i; O[i] = O[i] * wi_p;
#pragma unroll
                for (int ks = 0; ks < 2; ++ks) { const bf16x8 vf = *(const LAS bf16x8*)(L + VT + cur * 9216 + (16 * et + fr) * VST + (32 * ks + 8 * fq) * 2);
                    const bf16x8 pf = *(const LAS bf16x8*)(L + PB + p * VST + (32 * ks + 8 * fq) * 2);
                    O[i] = __builtin_amdgcn_mfma_f32_16x16x32_bf16(vf, pf, O[i], 0, 0, 0); } }
            { const float den = ((const LAS float*)(L + DENT))[p] + ((const LAS float*)(L + DENT))[64 + p];
              const float inv = 1.f / fmaxf(fabsf(den), T[192 + p]);
              const size_t m = rowbase + TOF(c, p);
#pragma unroll
              for (int i = 0; i < 2; ++i) { const int et = 2 * wg + i; v2u o; o.x = pk2(O[i][0] * inv, O[i][1] * inv); o.y = pk2(O[i][2] * inv, O[i][3] * inv);
                  *(v2u*)(H + m * DM + h * 256 + es * 64 + 16 * et + 4 * fq) = o; } }
            { const float decay = T[320];
              const bf16x8 vw0 = *(const LAS bf16x8*)(L + VWT + cur * 9216 + (16 * pt + fr) * VST + (8 * fq) * 2);
              const bf16x8 vw1 = *(const LAS bf16x8*)(L + VWT + cur * 9216 + (16 * pt + fr) * VST + (32 + 8 * fq) * 2);
              const int l16 = lane & 15, q4 = l16 >> 2, p4 = l16 & 3;
              const unsigned kb = (unsigned)(uintptr_t)(L + KS) + (unsigned)((8 * fq + q4) * KST + 4 * p4 * 2);
#pragma unroll
              for (int dtl = 0; dtl < 8; dtl += 2) { const int dt = 8 * wg + dtl; const unsigned a0 = kb + dt * 32;
                  s16x4 r0, r1, r2, r3, r4, r5, r6, r7;
                  asm volatile("ds_read_b64_tr_b16 %0, %8\n\tds_read_b64_tr_b16 %1, %8 offset:2112\n\tds_read_b64_tr_b16 %2, %8 offset:16896\n\tds_read_b64_tr_b16 %3, %8 offset:19008\n\t"
                               "ds_read_b64_tr_b16 %4, %8 offset:32\n\tds_read_b64_tr_b16 %5, %8 offset:2144\n\tds_read_b64_tr_b16 %6, %8 offset:16928\n\tds_read_b64_tr_b16 %7, %8 offset:19040\n\ts_waitcnt lgkmcnt(0)"
                               : "=&v"(r0), "=&v"(r1), "=&v"(r2), "=&v"(r3), "=&v"(r4), "=&v"(r5), "=&v"(r6), "=&v"(r7) : "v"(a0) : "memory");
                  const bf16x8 k0 = __builtin_shufflevector(r0, r1, 0, 1, 2, 3, 4, 5, 6, 7), k1 = __builtin_shufflevector(r2, r3, 0, 1, 2, 3, 4, 5, 6, 7);
                  const bf16x8 k2 = __builtin_shufflevector(r4, r5, 0, 1, 2, 3, 4, 5, 6, 7), k3 = __builtin_shufflevector(r6, r7, 0, 1, 2, 3, 4, 5, 6, 7);
                  Cacc[dtl] = Cacc[dtl] * decay; Cacc[dtl + 1] = Cacc[dtl + 1] * decay;
                  Cacc[dtl] = __builtin_amdgcn_mfma_f32_16x16x32_bf16(k0, vw0, Cacc[dtl], 0, 0, 0);
                  Cacc[dtl + 1] = __builtin_amdgcn_mfma_f32_16x16x32_bf16(k2, vw0, Cacc[dtl + 1], 0, 0, 0);
                  Cacc[dtl] = __builtin_amdgcn_mfma_f32_16x16x32_bf16(k1, vw1, Cacc[dtl], 0, 0, 0);
                  Cacc[dtl + 1] = __builtin_amdgcn_mfma_f32_16x16x32_bf16(k3, vw1, Cacc[dtl + 1], 0, 0, 0); } }
            { const int d = tid & 255, hf2 = tid >> 8; float np = 0.f;
#pragma unroll 8
              for (int s2 = 0; s2 < 32; ++s2) { const int s_ = hf2 * 32 + s2; np += T[256 + s_] * bf2f(*(const LAS bf16*)(L + KS + s_ * KST + d * 2)); }
              ((LAS float*)(L + NPART))[hf2 * 256 + d] = np; }
            __syncthreads();
            { const float decay = T[320];
#pragma unroll
              for (int dtl = 0; dtl < 8; ++dtl) { const int dt = 8 * wg + dtl; v2u o; o.x = pk2(Cacc[dtl][0], Cacc[dtl][1]); o.y = pk2(Cacc[dtl][2], Cacc[dtl][3]);
                  *(LAS v2u*)(L + CTI + (16 * pt + fr) * KST + (16 * dt + 4 * fq) * 2) = o; }
              if (tid < 256) { LAS float* nt = (LAS float*)(L + NT); const LAS float* np = (const LAS float*)(L + NPART); nt[tid] = decay * nt[tid] + np[tid] + np[256 + tid]; } }
            if (has_next) STORE_KV(nxt);
            __syncthreads();
        }
#undef TOF
#undef G1_TABLES
#undef LOAD_KV
#undef STORE_KV
#undef LOAD_Q
    }
}

__device__ __forceinline__ void ym_phase(Frame& F) {
    const bf16* HF = (const bf16*)(F.ws + WS_XM); const bf16* HB = (const bf16*)F.out + (size_t)MTOK * DM; bf16* OP = (bf16*)(F.ws + WS_OP);
    const float* ng = F.in[9];
    const int gw = F.bid * NWAVES + F.wave, NGW = F.G * NWAVES;
    for (int m = gw; m < MTOK; m += NGW) {
#pragma unroll
        for (int hd = 0; hd < 4; ++hd) {
            const size_t o = (size_t)m * DM + hd * 256 + F.lane * 4;
            const v2u a = *(const v2u*)(HF + o), b = *(const v2u*)(HB + o), op = *(const v2u*)(OP + o);
            const float v0 = bflo(a.x) + bflo(b.x), v1 = bfhi(a.x) + bfhi(b.x), v2 = bflo(a.y) + bflo(b.y), v3 = bfhi(a.y) + bfhi(b.y);
            const float r = rsqrtf(wave_sum((v0 * v0 + v1 * v1) + (v2 * v2 + v3 * v3)) * (1.f / 256.f) + EPS);
            const f32x4 g = *(const f32x4*)(ng + hd * 256 + F.lane * 4);
            v2u w; w.x = pk2(sigmoidf_(bflo(op.x)) * v0 * r * g[0], sigmoidf_(bfhi(op.x)) * v1 * r * g[1]);
            w.y = pk2(sigmoidf_(bflo(op.y)) * v2 * r * g[2], sigmoidf_(bfhi(op.y)) * v3 * r * g[3]);
            *(v2u*)(OP + o) = w;
        }
    }
    {
        float* usc = (float*)(F.ws + WS_LG + 16 * MiB); float* vsc = usc + NEXP;
        for (int row = gw; row < 2 * NEXP; row += NGW) {
            const bool isv = row >= NEXP; const int r = isv ? row - NEXP : row;
            const f32x4* src = (const f32x4*)(F.in[isv ? 24 : 23] + (size_t)r * DM) + F.lane * 4;
            f32x4 a[4]; float ss = 0.f;
#pragma unroll
            for (int j = 0; j < 4; ++j) { a[j] = src[j]; ss += (a[j][0] * a[j][0] + a[j][1] * a[j][1]) + (a[j][2] * a[j][2] + a[j][3] * a[j][3]); }
            const float rms = sqrtf(wave_sum(ss) * (1.f / DM));
            const float sc = fmaxf(rms * 0.5f, 1e-30f), inv = 1.f / sc;
            unsigned o[2] = {0u, 0u};
#pragma unroll
            for (int j = 0; j < 4; ++j) { const f32x4 q = a[j] * inv;
                if (j & 1) { o[j >> 1] = __builtin_amdgcn_cvt_scalef32_pk_fp4_f32(o[j >> 1], q[0], q[1], 1.0f, 2); o[j >> 1] = __builtin_amdgcn_cvt_scalef32_pk_fp4_f32(o[j >> 1], q[2], q[3], 1.0f, 3); }
                else       { o[j >> 1] = __builtin_amdgcn_cvt_scalef32_pk_fp4_f32(o[j >> 1], q[0], q[1], 1.0f, 0); o[j >> 1] = __builtin_amdgcn_cvt_scalef32_pk_fp4_f32(o[j >> 1], q[2], q[3], 1.0f, 1); } }
            *(v2u*)(F.ws + WS_LG + (isv ? 8 * MiB : 0) + (size_t)r * (DM / 2) + F.lane * 8) = (v2u){o[0], o[1]};
            if (F.lane == 0) (isv ? vsc : usc)[r] = sc;
        }
    }
}

typedef float f32x16 __attribute__((ext_vector_type(16)));
#define TOPK_INSERT(L, xv) do { const float x_ = (xv); \
    L[15] = __builtin_amdgcn_fmed3f(L[14], L[15], x_); L[14] = __builtin_amdgcn_fmed3f(L[13], L[14], x_); L[13] = __builtin_amdgcn_fmed3f(L[12], L[13], x_); L[12] = __builtin_amdgcn_fmed3f(L[11], L[12], x_); \
    L[11] = __builtin_amdgcn_fmed3f(L[10], L[11], x_); L[10] = __builtin_amdgcn_fmed3f(L[9], L[10], x_); L[9] = __builtin_amdgcn_fmed3f(L[8], L[9], x_); L[8] = __builtin_amdgcn_fmed3f(L[7], L[8], x_); \
    L[7] = __builtin_amdgcn_fmed3f(L[6], L[7], x_); L[6] = __builtin_amdgcn_fmed3f(L[5], L[6], x_); L[5] = __builtin_amdgcn_fmed3f(L[4], L[5], x_); L[4] = __builtin_amdgcn_fmed3f(L[3], L[4], x_); \
    L[3] = __builtin_amdgcn_fmed3f(L[2], L[3], x_); L[2] = __builtin_amdgcn_fmed3f(L[1], L[2], x_); L[1] = __builtin_amdgcn_fmed3f(L[0], L[1], x_); L[0] = fmaxf(L[0], x_); } while (0)
template <int I> struct CandRow {
    static __device__ __forceinline__ void run(const float (&L0)[16], const float (&L1)[16], float (&R)[16]) {
        constexpr int NJ = 16 / (I + 1);
#pragma unroll
        for (int j = 0; j < NJ; ++j) { const float sm = L0[I] + L1[j];
            const float pk = __builtin_bit_cast(float, (__builtin_bit_cast(unsigned, sm) & 0xffffff00u) | (unsigned)(I * 16 + j)); TOPK_INSERT(R, pk); }
        if constexpr (I < 15) CandRow<I + 1>::run(L0, L1, R);
    }
};
__device__ __forceinline__ unsigned pick4(unsigned d0, unsigned d1, unsigned d2, unsigned d3, int i) {
    const int q = i >> 2; unsigned d = d0; d = (q == 1) ? d1 : d; d = (q == 2) ? d2 : d; d = (q == 3) ? d3 : d; return (d >> (8 * (i & 3))) & 127u;
}
__device__ __forceinline__ void select_phase(Frame& F) {
    const bf16* PQ = (const bf16*)(F.ws + WS_MG); const bf16* KEYS = (const bf16*)(F.ws + WS_KEYS);
    int* IDX = (int*)(F.ws + WS_K); float* GW = (float*)(F.ws + WS_K + 16 * MiB);
    LAS unsigned char* L = F.lds;
    const int tid = F.tid, lane = F.lane, w = F.wave, l31 = lane & 31, hh = lane >> 5;
    const float NEG_INF = -INFINITY;
    for (int grp = F.bid; grp < MTOK / 128; grp += F.G) {
        const int tb = grp * 4 + (w & 3);
        const size_t m = (size_t)tb * 32 + l31;
        for (int hp = 0; hp < 4; ++hp) {
            __syncthreads();
#pragma unroll 4
            for (int r = 0; r < 16; ++r) { const int e = tid + NTHR * r, R = e >> 4, c = e & 15;
                *(LAS v4u*)(L + R * 256 + ((c ^ (R & 15)) * 16)) = *(const v4u*)(KEYS + ((size_t)(hp * 512 + R) * 128 + c * 8)); }
            __syncthreads();
            const int hl = w >> 2, h = 2 * hp + hl;
            float L0[16], L1[16];
#pragma unroll
            for (int p = 0; p < 2; ++p) {
                bf16x8 qf[8];
#pragma unroll
                for (int ks = 0; ks < 8; ++ks) qf[ks] = *(const bf16x8*)(PQ + m * 2048 + h * 256 + p * 128 + 16 * ks + 8 * hh);
                f32x16 acc[4];
#pragma unroll
                for (int kb = 0; kb < 4; ++kb)
#pragma unroll
                    for (int r = 0; r < 16; ++r) acc[kb][r] = 0.f;
#pragma unroll
                for (int ks = 0; ks < 8; ++ks)
#pragma unroll
                    for (int kb = 0; kb < 4; ++kb) { const int R = (hl * 2 + p) * 128 + 32 * kb + l31;
                        const bf16x8 kf = *(const LAS bf16x8*)(L + R * 256 + (((2 * ks + hh) ^ (lane & 15)) * 16));
                        acc[kb] = __builtin_amdgcn_mfma_f32_32x32x16_bf16(kf, qf[ks], acc[kb], 0, 0, 0); }
                float Lc[16];
#pragma unroll
                for (int i = 0; i < 16; ++i) Lc[i] = NEG_INF;
                const unsigned hh4 = (unsigned)hh << 2;
#pragma unroll
                for (int kb = 0; kb < 4; ++kb)
#pragma unroll
                    for (int r = 0; r < 16; ++r) { const unsigned nlo = (unsigned)(32 * kb + (r & 3) + 8 * (r >> 2));
                        const float av_ = acc[kb][r];
                        const float pk = __uint_as_float(((__float_as_uint(av_) & 0xffffff80u) | hh4) | nlo); TOPK_INSERT(Lc, pk); }
                float Lo[16];
#pragma unroll
                for (int i = 0; i < 16; ++i) Lo[i] = __shfl_xor(Lc[i], 32);
#pragma unroll
                for (int i = 0; i < 16; ++i) TOPK_INSERT(Lc, Lo[i]);
#pragma unroll
                for (int i = 0; i < 16; ++i) { if (p == 0) L0[i] = Lc[i]; else L1[i] = Lc[i]; }
            }
            float R[16];
#pragma unroll
            for (int i = 0; i < 16; ++i) R[i] = NEG_INF;
            CandRow<0>::run(L0, L1, R);
            unsigned a0 = 0, a1 = 0, a2 = 0, a3 = 0, b0 = 0, b1 = 0, b2 = 0, b3 = 0;
#pragma unroll
            for (int i = 0; i < 4; ++i) { a0 |= (__builtin_bit_cast(unsigned, L0[i]) & 127u) << (8 * i); a1 |= (__builtin_bit_cast(unsigned, L0[4 + i]) & 127u) << (8 * i);
                a2 |= (__builtin_bit_cast(unsigned, L0[8 + i]) & 127u) << (8 * i); a3 |= (__builtin_bit_cast(unsigned, L0[12 + i]) & 127u) << (8 * i);
                b0 |= (__builtin_bit_cast(unsigned, L1[i]) & 127u) << (8 * i); b1 |= (__builtin_bit_cast(unsigned, L1[4 + i]) & 127u) << (8 * i);
                b2 |= (__builtin_bit_cast(unsigned, L1[8 + i]) & 127u) << (8 * i); b3 |= (__builtin_bit_cast(unsigned, L1[12 + i]) & 127u) << (8 * i); }
            float ex[16]; float sum = 0.f; int id[16];
#pragma unroll
            for (int r = 0; r < 16; ++r) { ex[r] = __expf(R[r] - R[0]); sum += ex[r];
                const unsigned cid = __builtin_bit_cast(unsigned, R[r]) & 255u;
                id[r] = (int)(pick4(a0, a1, a2, a3, (int)(cid >> 4)) * 128u + pick4(b0, b1, b2, b3, (int)(cid & 15u))); }
            const float inv = 1.f / sum;
            if (hh == 0) {
#pragma unroll
                for (int q = 0; q < 4; ++q) {
                    *(int4*)(IDX + m * 128 + h * 16 + 4 * q) = make_int4(id[4 * q], id[4 * q + 1], id[4 * q + 2], id[4 * q + 3]);
                    *(f32x4*)(GW + m * 128 + h * 16 + 4 * q) = (f32x4){ex[4 * q] * inv, ex[4 * q + 1] * inv, ex[4 * q + 2] * inv, ex[4 * q + 3] * inv}; }
            }
        }
    }
}

template <int B> __device__ __forceinline__ f32x2 fp4b(unsigned w) { return __builtin_amdgcn_cvt_scalef32_pk_f32_fp4(w, 1.0f, B); }
__device__ __forceinline__ void apply_phase(Frame& F, float* OUTP) {
    const unsigned char* U8 = F.ws + WS_LG; const unsigned char* V8 = F.ws + WS_LG + 8 * MiB;
    const float* USC = (const float*)(F.ws + WS_LG + 16 * MiB); const float* VSC = USC + NEXP;
    const int* IDX = (const int*)(F.ws + WS_K); const float* GW = (const float*)(F.ws + WS_K + 16 * MiB);
    const float* g2 = F.in[20]; const float* gf = F.in[25];
    const float* X1 = F.out;
    const int lane = F.lane;
    const int gw = F.bid * NWAVES + F.wave, NGW = F.G * NWAVES;
    const bool b5 = (lane & 32) != 0, b4 = (lane & 16) != 0, b3 = (lane & 8) != 0, b2 = (lane & 4) != 0;
    const int eid = ((lane >> 5) & 1) * 8 + ((lane >> 4) & 1) * 4 + ((lane >> 3) & 1) * 2 + ((lane >> 2) & 1);
    for (int grp = F.bid; grp < MTOK / 128; grp += F.G)
    for (int m = grp * 128 + F.wave; m < grp * 128 + 128; m += NWAVES) {
        f32x2 hv[8]; float s = 0.f;
#pragma unroll
        for (int q = 0; q < 4; ++q) { const f32x4 a = *(const f32x4*)(X1 + (size_t)m * DM + lane * 16 + q * 4);
            s += (a[0] * a[0] + a[1] * a[1]) + (a[2] * a[2] + a[3] * a[3]); hv[2 * q] = (f32x2){a[0], a[1]}; hv[2 * q + 1] = (f32x2){a[2], a[3]}; }
        const float r2 = rsqrtf(wave_sum(s) * (1.f / DM) + EPS) ;
#pragma unroll
        for (int q = 0; q < 4; ++q) { const f32x4 g = *(const f32x4*)(g2 + lane * 16 + q * 4);
            hv[2 * q] = hv[2 * q] * (f32x2){g[0] * r2, g[1] * r2}; hv[2 * q + 1] = hv[2 * q + 1] * (f32x2){g[2] * r2, g[3] * r2}; }
        const int i0 = IDX[(size_t)m * 128 + lane], i1 = IDX[(size_t)m * 128 + 64 + lane];
        const float gw0 = GW[(size_t)m * 128 + lane], gw1 = GW[(size_t)m * 128 + 64 + lane];
        f32x2 acc[8];
#pragma unroll
        for (int i = 0; i < 8; ++i) acc[i] = (f32x2){0.f, 0.f};
#pragma unroll 1
        for (int bt = 0; bt < 8; ++bt) {
            const int k0 = bt * 16;
            const int isel = (k0 < 64) ? i0 : i1;
            v2u uu[16], vv[16];
            const int myidx = __shfl(isel, (k0 + eid) & 63);
            const float su = USC[myidx], sv = VSC[myidx];
#pragma unroll
            for (int e = 0; e < 16; ++e) { const size_t ro = (size_t)__builtin_amdgcn_readlane(isel, (k0 + e) & 63) * (DM / 2) + lane * 8;
                uu[e] = *(const v2u*)(U8 + ro); vv[e] = *(const v2u*)(V8 + ro); }
            float x[16];
#pragma unroll
            for (int e = 0; e < 16; ++e) { f32x2 d = fp4b<0>(uu[e].x) * hv[0];
                d = __builtin_elementwise_fma(fp4b<1>(uu[e].x), hv[1], d); d = __builtin_elementwise_fma(fp4b<2>(uu[e].x), hv[2], d); d = __builtin_elementwise_fma(fp4b<3>(uu[e].x), hv[3], d);
                d = __builtin_elementwise_fma(fp4b<0>(uu[e].y), hv[4], d); d = __builtin_elementwise_fma(fp4b<1>(uu[e].y), hv[5], d); d = __builtin_elementwise_fma(fp4b<2>(uu[e].y), hv[6], d);
                d = __builtin_elementwise_fma(fp4b<3>(uu[e].y), hv[7], d); x[e] = d[0] + d[1]; }
            float y[8], z[4], u2[2], t;
#pragma unroll
            for (int j = 0; j < 8; ++j) { const float keep = b5 ? x[8 + j] : x[j], send = b5 ? x[j] : x[8 + j]; y[j] = keep + __shfl_xor(send, 32); }
#pragma unroll
            for (int j = 0; j < 4; ++j) { const float keep = b4 ? y[4 + j] : y[j], send = b4 ? y[j] : y[4 + j]; z[j] = keep + __shfl_xor(send, 16); }
#pragma unroll
            for (int j = 0; j < 2; ++j) { const float keep = b3 ? z[2 + j] : z[j], send = b3 ? z[j] : z[2 + j]; u2[j] = keep + __shfl_xor(send, 8); }
            { const float keep = b2 ? u2[1] : u2[0], send = b2 ? u2[0] : u2[1]; t = keep + __shfl_xor(send, 4); }
            t += __shfl_xor(t, 2); t += __shfl_xor(t, 1);
            const float gk = __shfl((k0 < 64) ? gw0 : gw1, (k0 + eid) & 63);
            const float wl = gk * gelu_fast(t * su) * sv;
#pragma unroll
            for (int e = 0; e < 16; ++e) {
                const float we = __builtin_bit_cast(float, __builtin_amdgcn_readlane(__builtin_bit_cast(int, wl), 32 * (e >> 3) + 16 * ((e >> 2) & 1) + 8 * ((e >> 1) & 1) + 4 * (e & 1)));
                const f32x2 w2 = (f32x2){we, we};
                acc[0] = __builtin_elementwise_fma(fp4b<0>(vv[e].x), w2, acc[0]); acc[1] = __builtin_elementwise_fma(fp4b<1>(vv[e].x), w2, acc[1]);
                acc[2] = __builtin_elementwise_fma(fp4b<2>(vv[e].x), w2, acc[2]); acc[3] = __builtin_elementwise_fma(fp4b<3>(vv[e].x), w2, acc[3]);
                acc[4] = __builtin_elementwise_fma(fp4b<0>(vv[e].y), w2, acc[4]); acc[5] = __builtin_elementwise_fma(fp4b<1>(vv[e].y), w2, acc[5]);
                acc[6] = __builtin_elementwise_fma(fp4b<2>(vv[e].y), w2, acc[6]); acc[7] = __builtin_elementwise_fma(fp4b<3>(vv[e].y), w2, acc[7]);
            }
        }
        float s2 = 0.f;
#pragma unroll
        for (int q = 0; q < 4; ++q) { const f32x4 a = *(const f32x4*)(X1 + (size_t)m * DM + lane * 16 + q * 4);
            acc[2 * q] = acc[2 * q] + (f32x2){a[0], a[1]}; acc[2 * q + 1] = acc[2 * q + 1] + (f32x2){a[2], a[3]};
            s2 += (acc[2 * q][0] * acc[2 * q][0] + acc[2 * q][1] * acc[2 * q][1]) + (acc[2 * q + 1][0] * acc[2 * q + 1][0] + acc[2 * q + 1][1] * acc[2 * q + 1][1]); }
        const float rf = rsqrtf(wave_sum(s2) * (1.f / DM) + EPS);
#pragma unroll
        for (int q = 0; q < 4; ++q) { const f32x4 g = *(const f32x4*)(gf + lane * 16 + q * 4);
            *(f32x4*)(OUTP + (size_t)m * DM + lane * 16 + q * 4) = (f32x4){acc[2 * q][0] * rf * g[0], acc[2 * q][1] * rf * g[1], acc[2 * q + 1][0] * rf * g[2], acc[2 * q + 1][1] * rf * g[3]}; }
    }
}

constexpr int N_PHASES = 13;
__global__ void __launch_bounds__(NTHR, 2) mega_fwd(Args args) {
    extern __shared__ __attribute__((aligned(16))) unsigned char lds[];
    Frame F;
    F.lds = (LAS unsigned char*)lds;
    F.tid = threadIdx.x; F.lane = F.tid & 63; F.wave = __builtin_amdgcn_readfirstlane(F.tid >> 6);
    F.G = gridDim.x; F.bid = blockIdx.x;
    F.in = args.in; F.out = args.out; F.ws = args.ws;
    volatile LAS unsigned* MISC = (volatile LAS unsigned*)(F.lds + MISC_OFF);
    for (int u = F.tid; u < (LDS_BYTES - LDSCTL_OFF) / 4; u += NTHR) ((LAS unsigned*)(F.lds + LDSCTL_OFF))[u] = 0u;
    __syncthreads();
    XcdBarrier bar; bar.bar = (unsigned*)(args.ws + WS_CTL) + CW_BAR; bar.x = 0; bar.st = nullptr;
    const bool one_launch = (args.ph_hi - args.ph_lo) > 1;
    if (one_launch) bar = xcd_barrier_post((unsigned*)(args.ws + WS_CTL) + CW_BAR, MISC + 8);
    const int lo = args.ph_lo, hi = args.ph_hi;
#define IN(k) (lo <= (k) && (k) < hi)
#define SEAM(k) do { if (IN(k) && IN((k) + 1)) xcd_barrier(bar); } while (0)
    unsigned char* ws = args.ws;

#ifndef PROBE_MASK
#define PROBE_MASK 0
#endif
#define REP(k) _Pragma("unroll") for (int rep_ = 0; rep_ < (((PROBE_MASK >> (k)) & 1) ? 2 : 1); ++rep_)
    if (IN(0)) REP(0) { p0_prologue(F); if (rep_ == 0 && ((PROBE_MASK >> 0) & 1)) xcd_barrier(bar); } SEAM(0);
    if (IN(1)) REP(1) {
        AddrPlain g{(const char*)(ws + WS_K), (const char*)(ws + WS_WIN), 1024, 1024, 1024};
        pg8::StaticOrder S; S.init(MTOK, 6144, F.G, F.bid, 4);
        EpiBf16<DstP1> E{DstP1{ws}};
        gates_phase(F);
        pg8::gemm_phase(F.lds, g, S, E);
    } SEAM(1);
    if (IN(2)) REP(2) { lru_phase<false>(F); mconv_phase(F); } SEAM(2);
    if (IN(3)) REP(3) { lru_phase<true>(F); } SEAM(3);
    if (IN(5)) REP(5) {
        const char* xc = (const char*)F.out + (size_t)MTOK * DM * 2;
        AddrQKV g{xc, (long)((const char*)(ws + WS_XM) - xc), (const char*)(ws + WS_WQKV), 1024, 256, 256};
        pg8::StaticOrder S; S.init(MTOK, 12 * 256, F.G, F.bid);
        EpiBf16<DstQKV> E{DstQKV{(char*)(ws + WS_LG), (long)WS_K - (long)WS_LG, (long)WS_XL - (long)WS_LG}};
        pg8::gemm_phase(F.lds, g, S, E);
    } SEAM(5);
    if (IN(6)) REP(6) { mscan_phase(F); } SEAM(6);
    if (IN(7)) { ym_phase(F); } SEAM(7);
    if (IN(8)) {
        pg8::StaticOrder S; S.init(MTOK, 1024, F.G, F.bid);
        { AddrPlain g{(const char*)(ws + WS_OP), (const char*)(ws + WS_WB2), 1024, 1024, 1024};
          EpiMerge<false> E{(bf16*)(ws + WS_XM), (const bf16*)(ws + WS_MG), 0}; pg8::gemm_phase(F.lds, g, S, E); }
        { AddrPlain g{(const char*)F.out, (const char*)(ws + WS_WB2) + (size_t)1024 * 1024 * 2, 1024, 1024, 1024};
          EpiMerge<true> E{(bf16*)(ws + WS_XM), (const bf16*)(ws + WS_MG), 1024}; pg8::gemm_phase(F.lds, g, S, E); }
    } SEAM(8);
    if (IN(9)) {
        AddrPlain g{(const char*)(ws + WS_XM), (const char*)(ws + WS_WOUT2), 1024, 2048, 1024};
        pg8::StaticOrder S; S.init(MTOK, 1024, F.G, F.bid);
        EpiResid E{F.in[0], F.out, (bf16*)(ws + WS_XL), (float*)(ws + WS_SS)};
        pg8::gemm_phase(F.lds, g, S, E);
    } SEAM(9);
    if (IN(10)) REP(10) {
        AddrPlain g{(const char*)(ws + WS_XL), (const char*)(ws + WS_WPQ), 1024, 1024, 1024};
        pg8::StaticOrder S; S.init(MTOK, 2048, F.G, F.bid, 4);
        EpiPQ E{(bf16*)(ws + WS_MG), (const float*)(ws + WS_SS)};
        pg8::gemm_phase(F.lds, g, S, E);
    } SEAM(10);
    if (IN(11)) REP(11) { select_phase(F); }
    if (IN(11) && IN(12)) { asm volatile("s_waitcnt vmcnt(0)" ::: "memory"); __syncthreads(); }
    if (IN(12)) { if ((PROBE_MASK >> 12) & 1) { apply_phase(F, (float*)(ws + WS_MG)); xcd_barrier(bar); } apply_phase(F, F.out); }
#undef REP
#undef IN
#undef SEAM
}

extern "C" void kernel_launch(void* const* d_in, const int* in_sizes, int n_in, void* d_out, int out_size, void* d_ws, size_t ws_size, hipStream_t stream) {
    static int grid = 0;
    if (grid == 0) {
        if (n_in != 26 || in_sizes[0] != MTOK * DM || out_size != MTOK * DM || ws_size < WS_END) { fprintf(stderr, "kernel_launch: unexpected shapes / workspace (%zu < %zu)\n", ws_size, (size_t)WS_END); grid = -1; return; }
        int dev = 0, cus = 0, per_cu = 0;
        if (hipGetDevice(&dev) != hipSuccess || hipDeviceGetAttribute(&cus, hipDeviceAttributeMultiprocessorCount, dev) != hipSuccess) { grid = -1; return; }
        if (hipFuncSetAttribute((const void*)mega_fwd, hipFuncAttributeMaxDynamicSharedMemorySize, LDS_BYTES) != hipSuccess) { fprintf(stderr, "kernel_launch: hipFuncSetAttribute failed\n"); grid = -1; return; }
        if (hipOccupancyMaxActiveBlocksPerMultiprocessor(&per_cu, (const void*)mega_fwd, NTHR, LDS_BYTES) != hipSuccess || per_cu < 1) { fprintf(stderr, "kernel_launch: occupancy query says %d blocks/CU\n", per_cu); (void)hipGetLastError(); grid = -1; return; }
        grid = cus;
    }
    if (grid < 0) return;
    (void)hipMemsetAsync((char*)d_ws + WS_CTL + (size_t)CW_BAR * 4, 0, (size_t)XCD_BAR_WORDS * 4, stream);
    Args a{};
    for (int i = 0; i < 26; ++i) a.in[i] = (const float*)d_in[i];
    a.out = (float*)d_out; a.ws = (unsigned char*)d_ws;
#if MK_N_LAUNCHES == 1
    a.ph_lo = 0; a.ph_hi = N_PHASES;
    void* kargs[] = {&a};
    hipError_t e = hipLaunchCooperativeKernel((const void*)mega_fwd, dim3(grid), dim3(NTHR), kargs, LDS_BYTES, stream);
    if (e != hipSuccess) fprintf(stderr, "kernel_launch: cooperative launch failed: %s (grid %d)\n", hipGetErrorString(e), grid);
#else
    for (int p = 0; p < N_PHASES; ++p) { a.ph_lo = p; a.ph_hi = p + 1; hipLaunchKernelGGL(mega_fwd, dim3(grid), dim3(NTHR), LDS_BYTES, stream, a); }
#endif
}
```

```cpp
#include <hip/hip_runtime.h>
#include <cstdio>
#include <cstdint>
#include <math.h>

#ifndef MK_N_LAUNCHES
#define MK_N_LAUNCHES 1
#endif

constexpr int BATCH = 8, SEQ = 4096, DM = 1024, MTOK = BATCH * SEQ;
constexpr int DIN = 6160;
constexpr int NEXP = 16384;
constexpr float EPS = 1e-6f;

constexpr size_t MiB = 1u << 20;
constexpr size_t WS_CTL = 0, CTL_ZERO_BYTES = 1 * MiB;
constexpr size_t WS_WIN = 1 * MiB;
constexpr size_t WS_WQKV = 13 * MiB;
constexpr size_t WS_KEYS = 14 * MiB + 512 * 1024;
constexpr size_t WS_WLRU = 15 * MiB;
constexpr size_t WS_WB2 = 16 * MiB;
constexpr size_t WS_WOUT2 = 20 * MiB;
constexpr size_t WS_WPQ = 24 * MiB;
constexpr size_t WS_GATE = 28 * MiB;
constexpr size_t WS_WGT = 30 * MiB;
constexpr size_t WS_XM = 32 * MiB;
constexpr size_t WS_OP = 96 * MiB;
constexpr size_t WS_XL = 160 * MiB;
constexpr size_t WS_LG = 224 * MiB;
constexpr size_t WS_MG = 288 * MiB;
constexpr size_t WS_K = 416 * MiB;
constexpr size_t WS_AGG = 480 * MiB;
constexpr size_t WS_SS = 488 * MiB;
constexpr size_t WS_END = 489 * MiB;

constexpr int CW_BAR = 4096;

constexpr int RING_BYTES = 131072;
constexpr int LDS_BYTES = 147456;
constexpr int LDSCTL_OFF = LDS_BYTES - 512, MISC_OFF = LDSCTL_OFF + 320;
constexpr int NWAVES = 8, NTHR = 512;

#define GAS __attribute__((address_space(1)))
#define LAS __attribute__((address_space(3)))
typedef unsigned short bf16;
typedef unsigned v4u __attribute__((ext_vector_type(4)));
typedef unsigned v2u __attribute__((ext_vector_type(2)));
typedef float f32x4 __attribute__((ext_vector_type(4)));
typedef float f32x2 __attribute__((ext_vector_type(2)));
typedef short bf16x8 __attribute__((ext_vector_type(8)));
typedef GAS unsigned gu32;
#define RLX_AGENT __ATOMIC_RELAXED, __HIP_MEMORY_SCOPE_AGENT
#define LDS_WAIT() asm volatile("s_waitcnt lgkmcnt(0)" ::: "memory")
#define VM_WAIT() asm volatile("s_waitcnt vmcnt(0)" ::: "memory")

__device__ __forceinline__ unsigned f2bf(float f) { unsigned u = __builtin_bit_cast(unsigned, f); return (u + 0x7fffu + ((u >> 16) & 1u)) >> 16; }
__device__ __forceinline__ unsigned pk2(float lo, float hi) { return f2bf(lo) | (f2bf(hi) << 16); }
__device__ __forceinline__ float bf2f(unsigned short h) { return __builtin_bit_cast(float, (unsigned)h << 16); }
__device__ __forceinline__ float bflo(unsigned w) { return __builtin_bit_cast(float, w << 16); }
__device__ __forceinline__ float bfhi(unsigned w) { return __builtin_bit_cast(float, w & 0xffff0000u); }
__device__ __forceinline__ float wave_sum(float v) {
#pragma unroll
  for (int o = 1; o < 64; o <<= 1) v += __shfl_xor(v, o);
  return v;
}
__device__ __forceinline__ float sigmoidf_(float x) { return __builtin_amdgcn_rcpf(1.f + __builtin_amdgcn_exp2f(x * -1.44269504089f)); }
__device__ __forceinline__ float gelu_erf(float x) { return 0.5f * x * (1.f + erff(x * 0.70710678118654752f)); }
__device__ __forceinline__ float gelu_fast(float v) {
    const float av = fabsf(v), t = __builtin_amdgcn_rcpf(av * 0.2316418882f + 1.0f);
    float q = t * 0.5307027145f + (-0.7265760135f); q = q * t + 0.7107068705f; q = q * t + (-0.142248368f); q = q * t + 0.127414796f; q = q * t;
    const float e = __builtin_amdgcn_exp2f((v * v) * (-0.72134752044f));
    const float m = v * (q * e);
    return v < 0.f ? m : v - m;
}
__device__ __forceinline__ float softplusf_(float x) { return fmaxf(x, 0.f) + log1pf(expf(-fabsf(x))); }

namespace pg8 {
#define PG8_LAS __attribute__((address_space(3)))
typedef unsigned short bf16_t;
typedef unsigned u32x4 __attribute__((ext_vector_type(4)));
constexpr int BM = 256, BK = 64, HALF = 128, HTB = HALF * BK * 2, STAGE_BYTES = 8 * HTB, NXCD = 8;

__host__ __device__ __forceinline__ int lds_byte(int r, int c) { const int st = (r >> 4) * 2 + (c >> 5), rr = r & 15, cc = c & 31, ob = rr * 64 + cc * 2; return st * 1024 + (ob ^ (((ob >> 9) & 1) << 5)); }
__host__ __device__ __forceinline__ void stage_rc(int b, int& R, int& C) { const int st = b / 1024, sb = b % 1024, swz = sb ^ (((sb >> 9) & 1) << 5); R = (st >> 1) * 16 + swz / 64; C = (st & 1) * 32 + (swz % 64) / 2; }
__host__ __device__ __forceinline__ int perm32(int rho) { const int n = rho >> 4, i = rho & 15; return 8 * (i >> 2) + 4 * n + (i & 3); }

struct Unit { int pm, pn; };
struct StaticOrder {
    int nM, nN, nwg, G, c, WGM;
    __host__ __device__ void init(int M, int N, int G_, int c_, int wgm = 8) { nM = M / BM; nN = N / BM; nwg = nM * nN; G = G_; c = c_; WGM = wgm; }
    __host__ __device__ bool next(int i, Unit& u) const {
        const long L = (long)i * G + c; if (L >= nwg) return false;
        int wgid = (int)L; { const int q = nwg / NXCD, r = nwg % NXCD, xcd = wgid % NXCD, off = wgid / NXCD; wgid = (xcd < r ? xcd * (q + 1) : r * (q + 1) + (xcd - r) * q) + off; }
        const int nig = WGM * nN, gid = wgid / nig, fm = gid * WGM, gsz = (nM - fm) < WGM ? (nM - fm) : WGM;
        u.pm = fm + ((wgid % nig) % gsz); u.pn = (wgid % nig) / gsz; return true;
    }
};

__device__ __forceinline__ unsigned cvt_pk_bf16(float lo, float hi) { unsigned r; asm volatile("v_cvt_pk_bf16_f32 %0, %1, %2" : "=v"(r) : "v"(lo), "v"(hi)); return r; }

template <class Epi, class Addr>
__device__ __forceinline__ void gemm_phase(PG8_LAS unsigned char* lds, const Addr g, const StaticOrder& S, const Epi& E) {
    const int tid = threadIdx.x, wid = __builtin_amdgcn_readfirstlane(tid >> 6), lane = tid & 63, wr = wid >> 2, wc = wid & 3, fr = lane & 15, fq = lane >> 4;
    const int K = g.K, nt = K / BK;
    unsigned voffA[2], voffB[2];
#pragma unroll
    for (int i = 0; i < 2; ++i) { int R, C; stage_rc(tid * 16 + i * 8192, R, C); const int Rb = Epi::PERM ? ((R & ~31) + perm32(R & 31)) : R;
        voffA[i] = (unsigned)(R * g.lda + C) * 2u; voffB[i] = (unsigned)(Rb * g.ldb + C) * 2u; }
    const size_t kstep = (size_t)(BK * 2);
    const size_t hsA = (size_t)HALF * g.lda * 2, hsB = (size_t)HALF * g.ldb * 2;
    const unsigned ldsw = (unsigned)wid * 1024u;
    const int aoff = lds_byte(wr * 64 + fr, fq * 8), boff = lds_byte(wc * 32 + fr, fq * 8);
#define PG8_SA(b, h) (((b) * 2 + (h)) * HTB)
#define PG8_SB(b, h) ((4 + (b) * 2 + (h)) * HTB)
#define PG8_STAGE(bufoff, gbase, voff) do { _Pragma("unroll") for (int _i = 0; _i < 2; ++_i) \
        __builtin_amdgcn_global_load_lds((const unsigned*)((const char*)(gbase) + (voff)[_i]), (PG8_LAS unsigned*)(lds + (bufoff) + ldsw + _i * 8192), 16, 0, 0); } while (0)
#define PG8_LDA(dst, b, h) do { _Pragma("unroll") for (int m = 0; m < 4; ++m) _Pragma("unroll") for (int k = 0; k < 2; ++k) dst[m][k] = *(const PG8_LAS bf16x8*)(lds + PG8_SA(b, h) + aoff + m * 2048 + k * 1024); } while (0)
#define PG8_LDB(dst, b, h) do { _Pragma("unroll") for (int n = 0; n < 2; ++n) _Pragma("unroll") for (int k = 0; k < 2; ++k) dst[n][k] = *(const PG8_LAS bf16x8*)(lds + PG8_SB(b, h) + boff + n * 2048 + k * 1024); } while (0)
#define PG8_MMA(ai, bj, At, Bt) do { __builtin_amdgcn_s_setprio(1); _Pragma("unroll") for (int m = 0; m < 4; ++m) _Pragma("unroll") for (int n = 0; n < 2; ++n) _Pragma("unroll") for (int k = 0; k < 2; ++k) \
        acc[ai][bj][m][n] = __builtin_amdgcn_mfma_f32_16x16x32_bf16(Bt[n][k], At[m][k], acc[ai][bj][m][n], 0, 0, 0); __builtin_amdgcn_s_setprio(0); } while (0)
#define PG8_WAIT_V(n) asm volatile("s_waitcnt vmcnt(" #n ")" ::: "memory")
#define PG8_WAIT_L(n) asm volatile("s_waitcnt lgkmcnt(" #n ")" ::: "memory")
#define PG8_BAR __builtin_amdgcn_s_barrier()
#define PG8_SCHED __builtin_amdgcn_sched_barrier(0)
    Unit cur, nxt; int ui = 0;
    if (!S.next(0, cur)) return;
    f32x4 acc[2][2][4][2];
#pragma unroll
    for (int a = 0; a < 2; ++a)
#pragma unroll
        for (int b = 0; b < 2; ++b)
#pragma unroll
            for (int m = 0; m < 4; ++m)
#pragma unroll
                for (int n = 0; n < 2; ++n) acc[a][b][m][n] = (f32x4){0.f, 0.f, 0.f, 0.f};
    bf16x8 At[4][2], B0[2][2], B1[2][2];
    const char* cA = g.a(cur); const char* cB = g.b(cur);
    PG8_STAGE(PG8_SB(0, 0), cB, voffB); PG8_STAGE(PG8_SB(0, 1), cB + hsB, voffB); PG8_STAGE(PG8_SA(0, 0), cA, voffA); PG8_STAGE(PG8_SA(0, 1), cA + hsA, voffA);
    if (wr == 1) PG8_BAR;
    PG8_WAIT_V(2); PG8_BAR;
    PG8_STAGE(PG8_SB(1, 0), cB + kstep, voffB); PG8_STAGE(PG8_SA(1, 0), cA + kstep, voffA); PG8_STAGE(PG8_SB(1, 1), cB + hsB + kstep, voffB);
    PG8_WAIT_V(6); PG8_BAR;
    for (;;) {
        const bool has_next = S.next(ui + 1, nxt);
        const char* nA = has_next ? g.a(nxt) : cA; const char* nB = has_next ? g.b(nxt) : cB;
#pragma unroll 1
        for (int t = 0; t < nt; t += 2) {
            const bool last = (t == nt - 2);
            const char* a1 = cA + (size_t)(t + 1) * kstep;
            const char* a2 = last ? nA : cA + (size_t)(t + 2) * kstep; const char* b2 = last ? nB : cB + (size_t)(t + 2) * kstep;
            const char* a3 = a2 + kstep; const char* b3 = b2 + kstep;
            PG8_LDB(B0, 0, 0); PG8_LDB(B1, 0, 1); PG8_SCHED; PG8_LDA(At, 0, 0); PG8_STAGE(PG8_SA(1, 1), a1 + hsA, voffA);
            PG8_WAIT_V(8); PG8_WAIT_L(0); PG8_BAR; PG8_MMA(0, 0, At, B0); PG8_MMA(0, 1, At, B1); PG8_BAR; PG8_SCHED;
            PG8_LDA(At, 0, 1); PG8_STAGE(PG8_SB(0, 0), b2, voffB); PG8_STAGE(PG8_SB(0, 1), b2 + hsB, voffB); PG8_STAGE(PG8_SA(0, 0), a2, voffA);
            PG8_WAIT_V(8); PG8_WAIT_L(0); PG8_BAR; PG8_MMA(1, 0, At, B0); PG8_MMA(1, 1, At, B1); PG8_BAR; PG8_SCHED;
            PG8_LDB(B0, 1, 0); PG8_LDB(B1, 1, 1); PG8_SCHED; PG8_LDA(At, 1, 0); PG8_STAGE(PG8_SA(0, 1), a2 + hsA, voffA);
            PG8_WAIT_V(8); PG8_WAIT_L(0); PG8_BAR; PG8_MMA(0, 0, At, B0); PG8_MMA(0, 1, At, B1); PG8_BAR; PG8_SCHED;
            PG8_LDA(At, 1, 1); PG8_STAGE(PG8_SB(1, 0), b3, voffB); PG8_STAGE(PG8_SB(1, 1), b3 + hsB, voffB); PG8_STAGE(PG8_SA(1, 0), a3, voffA);
            PG8_WAIT_V(8); PG8_WAIT_L(0); PG8_BAR; PG8_MMA(1, 0, At, B0); PG8_MMA(1, 1, At, B1); PG8_BAR; PG8_SCHED;
        }
        if (wr == 0) PG8_BAR;
        E(acc, cur, wr, wc, fr, fq);
        if (!has_next) break;
#pragma unroll
        for (int a = 0; a < 2; ++a)
#pragma unroll
            for (int b = 0; b < 2; ++b)
#pragma unroll
                for (int m = 0; m < 4; ++m)
#pragma unroll
                    for (int n = 0; n < 2; ++n) acc[a][b][m][n] = (f32x4){0.f, 0.f, 0.f, 0.f};
        cur = nxt; cA = nA; cB = nB; ++ui;
        if (wr == 1) PG8_BAR;
    }
    PG8_WAIT_V(0);
    PG8_BAR;
#undef PG8_SA
#undef PG8_SB
#undef PG8_STAGE
#undef PG8_LDA
#undef PG8_LDB
#undef PG8_MMA
#undef PG8_WAIT_V
#undef PG8_WAIT_L
#undef PG8_BAR
#undef PG8_SCHED
}
}

#define XB_TMO      128
#define XB_XCNT(j)  (256  + 64 * (j))
#define XB_XSUB(j)  (1280 + 64 * (j))
#define XB_XGEN(j)  (2304 + 64 * (j))
#define XB_TOP      3328
#define XB_TOPGEN   3392
#define XCD_BAR_WORDS 3456
#define XB_SPIN_CAP (1u << 18)
__device__ __forceinline__ unsigned xb_ld(unsigned* p)              { return __hip_atomic_load(p, __ATOMIC_RELAXED, __HIP_MEMORY_SCOPE_AGENT); }
__device__ __forceinline__ unsigned xb_add(unsigned* p, unsigned v) { return __hip_atomic_fetch_add(p, v, __ATOMIC_RELAXED, __HIP_MEMORY_SCOPE_AGENT); }
__device__ __forceinline__ unsigned xb_xcc_id() { return (unsigned)__builtin_amdgcn_s_getreg((3 << 11) | 20) & 0xFu; }
#define XB_SPIN(cond, bar) do { unsigned _sp = 0; while (cond) { __builtin_amdgcn_s_sleep(1); \
    if ((++_sp & 255u) == 0u) { if (xb_ld(&(bar)[XB_TMO])) break; if (_sp > XB_SPIN_CAP) { atomicAdd(&(bar)[XB_TMO], 1u); break; } } } } while (0)
struct XcdBarrier { unsigned* bar; unsigned x; volatile LAS unsigned* st; };
__device__ __forceinline__ XcdBarrier xcd_barrier_post(unsigned* bar, volatile LAS unsigned* st) {
    XcdBarrier b; b.bar = bar; b.x = xb_xcc_id(); b.st = st;
    if (threadIdx.x == 0) (void)xb_add(&bar[XB_XCNT(b.x)], 1u);
    return b;
}
__device__ __forceinline__ void xcd_barrier_complete(unsigned* bar, unsigned x, unsigned& nloc, unsigned& nx) {
    const unsigned G = gridDim.x * gridDim.y * gridDim.z;
    unsigned sum, cnt, mine, sp = 0u;
    for (;;) {
        sum = 0u; cnt = 0u; mine = 0u;
#pragma unroll
        for (unsigned j = 0; j < 16; ++j) { const unsigned c = xb_ld(&bar[XB_XCNT(j)]); sum += c; cnt += (c > 0u) ? 1u : 0u; mine = (j == x) ? c : mine; }
        if (sum == G) break;
        __builtin_amdgcn_s_sleep(1);
        if ((++sp & 255u) == 0u) { if (xb_ld(&bar[XB_TMO])) break; if (sp > XB_SPIN_CAP) { atomicAdd(&bar[XB_TMO], 1u); break; } }
    }
    nloc = mine > 0u ? mine : 1u; nx = cnt > 0u ? cnt : 1u;
}
__device__ __forceinline__ void xcd_barrier(const XcdBarrier& b) {
    asm volatile("s_waitcnt vmcnt(0)" ::: "memory");
    __syncthreads();
    if (threadIdx.x == 0) {
        unsigned* bar = b.bar;
        __builtin_amdgcn_s_waitcnt(0);
        unsigned nloc = b.st[0], nx = b.st[1];
        if (nloc == 0u) { xcd_barrier_complete(bar, b.x, nloc, nx); b.st[0] = nloc; b.st[1] = nx; }
        const unsigned old = xb_add(&bar[XB_XSUB(b.x)], 1u);
        const unsigned gen = old / nloc;
        if (old + 1u == (gen + 1u) * nloc) {
            __builtin_amdgcn_fence(__ATOMIC_RELEASE, "agent");
            asm volatile("s_waitcnt vmcnt(0)" ::: "memory");
            const unsigned og = xb_add(&bar[XB_TOP], 1u);
            const unsigned tg = og / nx;
            if (og + 1u == (tg + 1u) * nx) xb_add(&bar[XB_TOPGEN], 1u);
            else XB_SPIN(xb_ld(&bar[XB_TOPGEN]) == tg, bar);
            __builtin_amdgcn_fence(__ATOMIC_ACQUIRE, "agent");
            xb_add(&bar[XB_XGEN(b.x)], 1u);
            asm volatile("s_waitcnt vmcnt(0)" ::: "memory");
        } else {
            XB_SPIN(xb_ld(&bar[XB_XGEN(b.x)]) == gen, bar);
            __builtin_amdgcn_fence(__ATOMIC_ACQUIRE, "agent");
            asm volatile("s_waitcnt vmcnt(0)" ::: "memory");
        }
    }
    __syncthreads();
}

struct Args { const float* in[26]; float* out; unsigned char* ws; int ph_lo, ph_hi; };
struct Frame {
    LAS unsigned char* lds;
    int tid, lane, wave, G, bid;
    const float* const* in; float* out; unsigned char* ws;
};

__device__ __forceinline__ void tr_item(const float* W, int ldw, bf16* WT, int ldt, float scale, const float* kscale, LAS float* scr, int k0, int lane) {
#pragma unroll 8
    for (int i = 0; i < 32; ++i) { const int kk = 2 * i + (lane >> 5); float v = W[(size_t)(k0 + kk) * ldw + (lane & 31)] * scale; if (kscale) v *= kscale[k0 + kk]; scr[kk * 33 + (lane & 31)] = v; }
    LDS_WAIT(); asm volatile("" ::: "memory");
    const int c = lane & 7;
#pragma unroll
    for (int j = 0; j < 4; ++j) { const int n = (lane >> 3) + 8 * j; const LAS float* s = scr + (8 * c) * 33 + n;
        v4u o; o.x = pk2(s[0 * 33], s[1 * 33]); o.y = pk2(s[2 * 33], s[3 * 33]); o.z = pk2(s[4 * 33], s[5 * 33]); o.w = pk2(s[6 * 33], s[7 * 33]);
        *(GAS v4u*)(WT + (size_t)n * ldt + k0 + 8 * c) = o; }
    LDS_WAIT(); asm volatile("" ::: "memory");
}

__device__ __forceinline__ void p0_prologue(Frame& F) {
    LAS float* scr = (LAS float*)(F.lds + F.wave * 16384);
    const int gw = F.bid * NWAVES + F.wave, NGW = F.G * NWAVES;
    unsigned char* ws = F.ws;
    const float* w_in = F.in[2];
    constexpr int I_WIN = 16 * 192, I_QKV = 12 * 32, I_LRU = 32 * 8, I_WB = 2 * 512, I_WO = 2 * 512, I_PQ = 16 * 64;
    constexpr int NITEMS = I_WIN + I_QKV + I_LRU + I_WB + I_WO + I_PQ;
    for (int it = gw; it < NITEMS; it += NGW) {
        int r = it;
        if (r < I_WIN) { const int kb = r / 192, nb = r % 192, n0 = nb * 32, sc = n0 < 2048 ? n0 : n0 + 16;
            tr_item(w_in + sc, DIN, (bf16*)(ws + WS_WIN) + (size_t)n0 * 1024, 1024, 1.f, nullptr, scr, kb * 64, F.lane); continue; }
        r -= I_WIN;
        if (r < I_QKV) { const int mat = r / 32, rr = r % 32, kb = rr / 8, nb = rr % 8, g = mat >> 2, h = mat & 3;
            const float* W = F.in[6 + g] + (size_t)h * 65536 + nb * 32;
            tr_item(W, 256, (bf16*)(ws + WS_WQKV) + (size_t)mat * 65536 + (size_t)(nb * 32) * 256, 256, g == 1 ? 0.0625f : 1.f, nullptr, scr, kb * 64, F.lane); continue; }
        r -= I_QKV;
        if (r < I_LRU) { const int mat = r / 8, rr = r % 8, kb = rr / 4, nb = rr % 4, gate = mat & 1, db = mat >> 1;
            const float* W = F.in[gate ? 14 : 12] + (size_t)db * 16384 + nb * 32;
            tr_item(W, 128, (bf16*)(ws + WS_WLRU) + (size_t)mat * 16384 + (size_t)(nb * 32) * 128, 128, 1.f, nullptr, scr, kb * 64, F.lane); continue; }
        r -= I_LRU;
        if (r < I_WB) { const int mat = r / 512, rr = r % 512, kb = rr / 32, nb = rr % 32;
            const float* W = F.in[17 + mat] + nb * 32;
            tr_item(W, 1024, (bf16*)(ws + WS_WB2) + (size_t)(mat * 1024 + nb * 32) * 1024, 1024, 1.f, nullptr, scr, kb * 64, F.lane); continue; }
        r -= I_WB;
        if (r < I_WO) { const int cp = r / 512, rr = r % 512, kb = rr / 32, nb = rr % 32;
            const float* W = F.in[19] + nb * 32;
            tr_item(W, 1024, (bf16*)(ws + WS_WOUT2) + (size_t)(nb * 32) * 2048 + cp * 1024, 2048, 1.f, nullptr, scr, kb * 64, F.lane); continue; }
        r -= I_WO;
        { const int kb = r / 64, nb = r % 64;
            const float* W = F.in[21] + nb * 32;
            tr_item(W, 2048, (bf16*)(ws + WS_WPQ) + (size_t)(nb * 32) * 1024, 1024, 1.f, F.in[20], scr, kb * 64, F.lane); }
    }
    { const int gt = F.bid * NTHR + F.tid, NGT = F.G * NTHR;
      const float4* ks = (const float4*)F.in[22]; v2u* kd = (v2u*)(ws + WS_KEYS);
      for (int i = gt; i < 8 * 2 * 128 * 128 / 4; i += NGT) { const float4 v = ks[i]; v2u o; o.x = pk2(v.x, v.y); o.y = pk2(v.z, v.w); kd[i] = o; }
      float* ss = (float*)(ws + WS_SS);
      for (int i = gt; i < MTOK; i += NGT) ss[i] = 0.f; }
    { const int gt = F.bid * NTHR + F.tid;
      if (gt < 16 * 128) { const int c = gt >> 7, k8 = gt & 127; v4u o; unsigned wv[4];
#pragma unroll
          for (int j = 0; j < 4; ++j) wv[j] = pk2(w_in[(size_t)(k8 * 8 + 2 * j) * DIN + 2048 + c], w_in[(size_t)(k8 * 8 + 2 * j + 1) * DIN + 2048 + c]);
          o.x = wv[0]; o.y = wv[1]; o.z = wv[2]; o.w = wv[3]; *(v4u*)((bf16*)(ws + WS_WGT) + c * 1024 + k8 * 8) = o; } }
    const float* x = F.in[0]; const float* g1 = F.in[1];
    bf16* XN = (bf16*)(ws + WS_K);
    f32x4 gv[4];
#pragma unroll
    for (int j = 0; j < 4; ++j) gv[j] = ((const f32x4*)g1)[F.lane + 64 * j];
    for (int m = 2 * gw; m < MTOK; m += 2 * NGW) {
        const f32x4* xr0 = (const f32x4*)(x + (size_t)m * DM) + F.lane; const f32x4* xr1 = xr0 + DM / 4;
        f32x4 v0[4], v1[4]; float s0 = 0.f, s1 = 0.f;
#pragma unroll
        for (int j = 0; j < 4; ++j) { v0[j] = xr0[64 * j]; v1[j] = xr1[64 * j]; }
#pragma unroll
        for (int j = 0; j < 4; ++j) { s0 += (v0[j].x * v0[j].x + v0[j].y * v0[j].y) + (v0[j].z * v0[j].z + v0[j].w * v0[j].w); s1 += (v1[j].x * v1[j].x + v1[j].y * v1[j].y) + (v1[j].z * v1[j].z + v1[j].w * v1[j].w); }
        const float r0 = rsqrtf(wave_sum(s0) * (1.f / DM) + EPS), r1 = rsqrtf(wave_sum(s1) * (1.f / DM) + EPS);
        unsigned long long* o0 = (unsigned long long*)(XN + (size_t)m * DM) + F.lane; unsigned long long* o1 = o0 + DM / 4;
#pragma unroll
        for (int j = 0; j < 4; ++j) { const f32x4 a = v0[j] * r0 * gv[j], c = v1[j] * r1 * gv[j];
            o0[64 * j] = (unsigned long long)pk2(a.x, a.y) | ((unsigned long long)pk2(a.z, a.w) << 32);
            o1[64 * j] = (unsigned long long)pk2(c.x, c.y) | ((unsigned long long)pk2(c.z, c.w) << 32); }
    }
}
__device__ __forceinline__ void gates_phase(Frame& F) {
    const bf16* XN = (const bf16*)(F.ws + WS_K); const bf16* WGT = (const bf16*)(F.ws + WS_WGT); float* GT = (float*)(F.ws + WS_GATE);
    const int lane = F.lane, fr = lane & 15, fq = lane >> 4;
    const f32x4 bg4 = *(const f32x4*)(F.in[3] + 4 * fq);
    for (int task = F.bid * NWAVES + F.wave; task < MTOK / 16; task += F.G * NWAVES) {
        const size_t m0 = (size_t)task * 16;
        f32x4 acc = (f32x4){0.f, 0.f, 0.f, 0.f};
#pragma unroll 8
        for (int ks = 0; ks < 32; ++ks) {
            const bf16x8 wfr = *(const bf16x8*)(WGT + fr * 1024 + 32 * ks + 8 * fq);
            const bf16x8 xfr = *(const bf16x8*)(XN + (m0 + fr) * DM + 32 * ks + 8 * fq);
            acc = __builtin_amdgcn_mfma_f32_16x16x32_bf16(wfr, xfr, acc, 0, 0, 0);
        }
        *(f32x4*)(GT + (m0 + fr) * 16 + 4 * fq) = acc + bg4;
    }
}

struct AddrPlain {
    const char* A; const char* Bt; int lda, ldb, K;
    __device__ __forceinline__ const char* a(const pg8::Unit& u) const { return A + (size_t)u.pm * 256 * lda * 2; }
    __device__ __forceinline__ const char* b(const pg8::Unit& u) const { return Bt + (size_t)u.pn * 256 * ldb * 2; }
};
struct AddrQKV {
    const char* XC; long dXM; const char* W; int lda, ldb, K;
    __device__ __forceinline__ const char* a(const pg8::Unit& u) const { return XC + (u.pn < 8 ? 0l : dXM) + ((size_t)u.pm * 256 * 1024 + (u.pn & 3) * 256) * 2; }
    __device__ __forceinline__ const char* b(const pg8::Unit& u) const { return W + (size_t)u.pn * 65536 * 2; }
};
struct AddrBranch {
    const char* YM; long dYL; const char* W; int lda, ldb, K;
    __device__ __forceinline__ const char* a(const pg8::Unit& u) const { return YM + (u.pn < 4 ? 0l : dYL) + (size_t)u.pm * 256 * 1024 * 2; }
    __device__ __forceinline__ const char* b(const pg8::Unit& u) const { return W + (size_t)u.pn * 256 * 1024 * 2; }
};

struct DstP1 { unsigned char* ws;
    __device__ __forceinline__ bf16* get(int pn, int& ld, int& col0) const {
        const bool mg = pn >= 16; ld = mg ? 2048 : 1024; col0 = mg ? (pn - 16) * 256 : (pn & 3) * 256;
        return (bf16*)(ws + (mg ? WS_MG : WS_XM + (size_t)(pn >> 2) * 64 * MiB)); } };
struct DstQKV { char* q; long dk, dv;
    __device__ __forceinline__ bf16* get(int pn, int& ld, int& col0) const { ld = 1024; col0 = (pn & 3) * 256; return (bf16*)(q + (pn >= 4 ? (pn >= 8 ? dv : dk) : 0l)); } };
template <class Dst> struct EpiBf16 {
    static constexpr bool PERM = true;
    Dst dst;
    __device__ __forceinline__ void operator()(const f32x4 (&acc)[2][2][4][2], const pg8::Unit& u, int wr, int wc, int fr, int fq) const {
        int ld, colt; bf16* base = dst.get(u.pn, ld, colt);
        const int row0 = u.pm * 256 + wr * 64 + fr, col0 = colt + wc * 32 + 8 * fq;
#pragma unroll
        for (int ai = 0; ai < 2; ++ai)
#pragma unroll
            for (int m = 0; m < 4; ++m) { bf16* rowp = base + (size_t)(row0 + ai * 128 + m * 16) * ld + col0;
#pragma unroll
                for (int bj = 0; bj < 2; ++bj) { const f32x4 v0 = acc[ai][bj][m][0], v1 = acc[ai][bj][m][1];
                    v4u w; w.x = pg8::cvt_pk_bf16(v0[0], v0[1]); w.y = pg8::cvt_pk_bf16(v0[2], v0[3]); w.z = pg8::cvt_pk_bf16(v1[0], v1[1]); w.w = pg8::cvt_pk_bf16(v1[2], v1[3]);
                    *(v4u*)(rowp + bj * 128) = w; } }
    }
};
template <bool ADD> struct EpiMerge {
    static constexpr bool PERM = true;
    bf16* MRG; const bf16* MG; int gcol;
    __device__ __forceinline__ void operator()(const f32x4 (&acc)[2][2][4][2], const pg8::Unit& u, int wr, int wc, int fr, int fq) const {
        const int row0 = u.pm * 256 + wr * 64 + fr, col0 = u.pn * 256 + wc * 32 + 8 * fq;
#pragma unroll
        for (int ai = 0; ai < 2; ++ai)
#pragma unroll
            for (int m = 0; m < 4; ++m) { const size_t row = (size_t)(row0 + ai * 128 + m * 16); bf16* rowp = MRG + row * 1024 + col0; const bf16* gp = MG + row * 2048 + gcol + col0;
#pragma unroll
                for (int bj = 0; bj < 2; ++bj) { const f32x4 v0 = acc[ai][bj][m][0], v1 = acc[ai][bj][m][1];
                    const v4u g = *(const v4u*)(gp + bj * 128);
                    float o[8] = {v0[0] * sigmoidf_(bflo(g.x)), v0[1] * sigmoidf_(bfhi(g.x)), v0[2] * sigmoidf_(bflo(g.y)), v0[3] * sigmoidf_(bfhi(g.y)),
                                  v1[0] * sigmoidf_(bflo(g.z)), v1[1] * sigmoidf_(bfhi(g.z)), v1[2] * sigmoidf_(bflo(g.w)), v1[3] * sigmoidf_(bfhi(g.w))};
                    if (ADD) { const v4u t = *(const v4u*)(rowp + bj * 128);
                        o[0] += bflo(t.x); o[1] += bfhi(t.x); o[2] += bflo(t.y); o[3] += bfhi(t.y); o[4] += bflo(t.z); o[5] += bfhi(t.z); o[6] += bflo(t.w); o[7] += bfhi(t.w); }
                    v4u w; w.x = pg8::cvt_pk_bf16(o[0], o[1]); w.y = pg8::cvt_pk_bf16(o[2], o[3]); w.z = pg8::cvt_pk_bf16(o[4], o[5]); w.w = pg8::cvt_pk_bf16(o[6], o[7]);
                    *(v4u*)(rowp + bj * 128) = w; } }
    }
};
struct EpiResid {
    static constexpr bool PERM = false;
    const float* x; float* x1; bf16* x1b; float* ss;
    __device__ __forceinline__ void operator()(const f32x4 (&acc)[2][2][4][2], const pg8::Unit& u, int wr, int wc, int fr, int fq) const {
        const int row0 = u.pm * 256 + wr * 64 + fr, col0 = u.pn * 256 + wc * 32 + 4 * fq;
#pragma unroll
        for (int ai = 0; ai < 2; ++ai)
#pragma unroll
            for (int m = 0; m < 4; ++m) { const int row = row0 + ai * 128 + m * 16; const size_t off = (size_t)row * DM + col0; float s = 0.f;
#pragma unroll
                for (int bj = 0; bj < 2; ++bj)
#pragma unroll
                    for (int n = 0; n < 2; ++n) { const size_t o = off + bj * 128 + n * 16; const f32x4 v = *(const f32x4*)(x + o) + acc[ai][bj][m][n];
                        *(f32x4*)(x1 + o) = v; v2u w; w.x = pg8::cvt_pk_bf16(v[0], v[1]); w.y = pg8::cvt_pk_bf16(v[2], v[3]); *(v2u*)(x1b + o) = w;
                        s += (v[0] * v[0] + v[1] * v[1]) + (v[2] * v[2] + v[3] * v[3]); }
                s += __shfl_xor(s, 16); s += __shfl_xor(s, 32);
                if (fq == 0) atomicAdd(ss + row, s); }
    }
};
struct EpiPQ {
    static constexpr bool PERM = true;
    bf16* pq; const float* ss;
    __device__ __forceinline__ void operator()(const f32x4 (&acc)[2][2][4][2], const pg8::Unit& u, int wr, int wc, int fr, int fq) const {
        const int row0 = u.pm * 256 + wr * 64 + fr, col0 = u.pn * 256 + wc * 32 + 8 * fq;
#pragma unroll
        for (int ai = 0; ai < 2; ++ai)
#pragma unroll
            for (int m = 0; m < 4; ++m) { const int row = row0 + ai * 128 + m * 16; bf16* rowp = pq + (size_t)row * 2048 + col0;
                const float r = rsqrtf(ss[row] * (1.f / DM) + EPS);
#pragma unroll
                for (int bj = 0; bj < 2; ++bj) { const f32x4 v0 = acc[ai][bj][m][0] * r, v1 = acc[ai][bj][m][1] * r;
                    v4u w; w.x = pg8::cvt_pk_bf16(v0[0], v0[1]); w.y = pg8::cvt_pk_bf16(v0[2], v0[3]); w.z = pg8::cvt_pk_bf16(v1[0], v1[1]); w.w = pg8::cvt_pk_bf16(v1[2], v1[3]);
                    *(v4u*)(rowp + bj * 128) = w; } }
    }
};

template <bool PB> __device__ __forceinline__ void lru_phase(Frame& F) {
    const bf16* XL = (const bf16*)(F.ws + WS_XL); const bf16* LG = (const bf16*)(F.ws + WS_LG); bf16* YL = (bf16*)F.out;
    f32x2* AGG = (f32x2*)(F.ws + WS_AGG);
    const bf16* WL = (const bf16*)(F.ws + WS_WLRU);
    const float* cw = F.in[10]; const float* cb = F.in[11];
    constexpr int O_XCB = 0, O_XCF = 17408, O_A = 51200, O_U = 84992, FST = 528;
    LAS unsigned char* L = F.lds;
    const int tid = F.tid, lane = F.lane, w = F.wave, fr = lane & 15, fq = lane >> 4;
    int cur_blk = -1;
    bf16x8 wf[2][2][4];
    f32x4 br4[2], bi4[2], sp4[2];
    v4u rawreg[3];
#define RAW_LOAD(bb, tt0, bk) do { _Pragma("unroll") for (int r_ = 0; r_ < 3; ++r_) { const int e_ = tid + NTHR * r_, row_ = e_ >> 4, c16_ = e_ & 15, t_ = (tt0) - 2 + row_; \
            v4u v_ = {0u, 0u, 0u, 0u}; if (e_ < 68 * 16 && t_ >= 0 && t_ < SEQ) v_ = *(const v4u*)(XL + ((size_t)(bb) * SEQ + t_) * DM + (bk) * 128 + c16_ * 8); rawreg[r_] = v_; } } while (0)
    constexpr int O_CARRY = 118784, O_CW = 135168, O_SUB = 137728;
    const bool carry_tab = PB && (F.G == 256);
    if (carry_tab) {
        const int ch = tid & 127, bq = tid >> 7, s0 = F.bid >> 3, blk0 = F.bid & 7;
        LAS float* CT = (LAS float*)(L + O_CARRY);
#define FOLD(agp, j0, j1, stp, hv) do { int js_ = (j0); const int n_ = ((j1) - (j0)) * (stp); int k_ = 0; \
            for (; k_ + 8 <= n_; k_ += 8) { f32x2 ah_[8]; _Pragma("unroll") for (int q_ = 0; q_ < 8; ++q_) ah_[q_] = (agp)[(size_t)(js_ + q_ * (stp)) * 2 * DM]; \
                _Pragma("unroll") for (int q_ = 0; q_ < 8; ++q_) hv = ah_[q_][0] * hv + ah_[q_][1]; js_ += 8 * (stp); } \
            for (; k_ < n_; ++k_) { const f32x2 a1_ = (agp)[(size_t)js_ * 2 * DM]; hv = a1_[0] * hv + a1_[1]; js_ += (stp); } } while (0)
        for (int bb = 2 * bq; bb < 2 * bq + 2; ++bb) {
            const f32x2* ag0 = AGG + ((size_t)(bb * 64) * 2 + 0) * DM + blk0 * 128 + ch; const f32x2* ag1 = AGG + ((size_t)(bb * 64) * 2 + 1) * DM + blk0 * 128 + ch;
            float h = 0.f;
            FOLD(ag0, 0, s0, 1, h); CT[((bb * 2 + 0) * 2 + 0) * 128 + ch] = h;
            FOLD(ag0, s0, s0 + 32, 1, h); CT[((bb * 2 + 1) * 2 + 0) * 128 + ch] = h;
            h = 0.f;
            FOLD(ag1, 63, s0 + 32, -1, h); CT[((bb * 2 + 1) * 2 + 1) * 128 + ch] = h;
            FOLD(ag1, s0 + 32, s0, -1, h); CT[((bb * 2 + 0) * 2 + 1) * 128 + ch] = h;
        }
        __syncthreads();
#undef FOLD
    }
    for (int i = 0;; ++i) {
        const int idx = i * F.G + F.bid; if (idx >= 4096) break;
        const int blk = idx & 7, j = idx >> 3, b = j >> 6, seg = j & 63, t0 = seg * 64;
        const size_t mrow0 = (size_t)b * SEQ + t0;
        if (blk != cur_blk) {
            cur_blk = blk;
#pragma unroll
            for (int d = 0; d < 2; ++d) {
#pragma unroll
                for (int g = 0; g < 2; ++g)
#pragma unroll
                    for (int ks = 0; ks < 4; ++ks)
                        wf[d][g][ks] = *(const bf16x8*)(WL + ((size_t)((d * 8 + blk) * 2 + g) * 128 + 16 * w + fr) * 128 + 32 * ks + 8 * fq);
                const int ch = blk * 128 + 16 * w + 4 * fq;
                br4[d] = *(const f32x4*)(F.in[13] + d * DM + ch); bi4[d] = *(const f32x4*)(F.in[15] + d * DM + ch);
                const f32x4 lm = *(const f32x4*)(F.in[16] + d * DM + ch);
#pragma unroll
                for (int e = 0; e < 4; ++e) sp4[d][e] = -8.f * 1.44269504089f * softplusf_(-lm[e]);
            }
            __syncthreads();
            for (int e = tid; e < 5 * 128; e += NTHR) { const int jt = e >> 7, cc = e & 127; ((LAS float*)(L + O_CW))[e] = (jt < 4) ? cw[jt * DM + blk * 128 + cc] : cb[blk * 128 + cc]; }
        }
        if (i == 0) RAW_LOAD(b, t0, blk);
#pragma unroll
        for (int r = 0; r < 3; ++r) { const int e = tid + NTHR * r; if (e < 68 * 16) *(LAS v4u*)(L + O_A + (e >> 4) * 256 + (e & 15) * 16) = rawreg[r]; }
        __syncthreads();
        { const int idx2 = (i + 1) * F.G + F.bid; if (idx2 < 4096) { const int j2 = idx2 >> 3; RAW_LOAD(j2 >> 6, (j2 & 63) * 64, idx2 & 7); } }
        v4u lgreg[2];
        if (PB) {
#pragma unroll
            for (int r = 0; r < 2; ++r) { const int e = tid + NTHR * r; lgreg[r] = *(const v4u*)(LG + (mrow0 + (e >> 4)) * DM + blk * 128 + (e & 15) * 8); } }
        for (int e = tid; e < 64 * 16; e += NTHR) { const int tl = e >> 4, c16 = e & 15;
            float y[8];
            { const f32x4 a = *(const LAS f32x4*)(L + O_CW + 4 * 512 + c16 * 32), bq = *(const LAS f32x4*)(L + O_CW + 4 * 512 + c16 * 32 + 16); y[0] = a[0]; y[1] = a[1]; y[2] = a[2]; y[3] = a[3]; y[4] = bq[0]; y[5] = bq[1]; y[6] = bq[2]; y[7] = bq[3]; }
#pragma unroll
            for (int jt = 0; jt < 4; ++jt) { const v4u r = *(const LAS v4u*)(L + O_A + (tl + jt) * 256 + c16 * 16);
                const f32x4 wa = *(const LAS f32x4*)(L + O_CW + jt * 512 + c16 * 32), wb = *(const LAS f32x4*)(L + O_CW + jt * 512 + c16 * 32 + 16);
                y[0] += wa[0] * bflo(r.x); y[1] += wa[1] * bfhi(r.x); y[2] += wa[2] * bflo(r.y); y[3] += wa[3] * bfhi(r.y);
                y[4] += wb[0] * bflo(r.z); y[5] += wb[1] * bfhi(r.z); y[6] += wb[2] * bflo(r.w); y[7] += wb[3] * bfhi(r.w); }
            *(LAS f32x4*)(L + O_XCF + tl * FST + c16 * 32) = (f32x4){y[0], y[1], y[2], y[3]};
            *(LAS f32x4*)(L + O_XCF + tl * FST + c16 * 32 + 16) = (f32x4){y[4], y[5], y[6], y[7]};
            v4u o; o.x = pk2(y[0], y[1]); o.y = pk2(y[2], y[3]); o.z = pk2(y[4], y[5]); o.w = pk2(y[6], y[7]);
            *(LAS v4u*)(L + O_XCB + tl * 272 + c16 * 16) = o; }
        __syncthreads();
        float carry0 = 0.f, carry1 = 0.f;
        if (carry_tab) { const LAS float* CT = (const LAS float*)(L + O_CARRY); carry0 = CT[((b * 2 + (seg >> 5)) * 2 + 0) * 128 + (tid & 127)]; carry1 = CT[((b * 2 + (seg >> 5)) * 2 + 1) * 128 + (tid & 127)]; }
        else if (PB) {
            const int ch = blk * 128 + (tid & 127);
            float h = 0.f;
            const f32x2* ag0 = AGG + ((size_t)(b * 64) * 2 + 0) * DM + ch; const f32x2* ag1 = AGG + ((size_t)(b * 64) * 2 + 1) * DM + ch;
            int js = 0;
            for (; js + 8 <= seg; js += 8) { f32x2 ah[8];
#pragma unroll
                for (int q = 0; q < 8; ++q) ah[q] = ag0[(size_t)(js + q) * 2 * DM];
#pragma unroll
                for (int q = 0; q < 8; ++q) h = ah[q][0] * h + ah[q][1]; }
            for (; js < seg; ++js) { const f32x2 ah = ag0[(size_t)js * 2 * DM]; h = ah[0] * h + ah[1]; }
            carry0 = h; h = 0.f;
            js = 63;
            for (; js - 8 >= seg; js -= 8) { f32x2 ah[8];
#pragma unroll
                for (int q = 0; q < 8; ++q) ah[q] = ag1[(size_t)(js - q) * 2 * DM];
#pragma unroll
                for (int q = 0; q < 8; ++q) h = ah[q][0] * h + ah[q][1]; }
            for (; js > seg; --js) { const f32x2 ah = ag1[(size_t)js * 2 * DM]; h = ah[0] * h + ah[1]; }
            carry1 = h;
        }
#pragma unroll
        for (int d = 0; d < 2; ++d) {
            const int o_a = (d == 0) ? O_A : O_XCF;
            f32x4 aR[4], aI[4];
#pragma unroll
            for (int mt = 0; mt < 4; ++mt) { aR[mt] = (f32x4){0.f, 0.f, 0.f, 0.f}; aI[mt] = (f32x4){0.f, 0.f, 0.f, 0.f}; }
#pragma unroll
            for (int ks = 0; ks < 4; ++ks)
#pragma unroll
                for (int mt = 0; mt < 4; ++mt) { const bf16x8 xb = *(const LAS bf16x8*)(L + O_XCB + (16 * mt + fr) * 272 + (32 * ks + 8 * fq) * 2);
                    aR[mt] = __builtin_amdgcn_mfma_f32_16x16x32_bf16(wf[d][0][ks], xb, aR[mt], 0, 0, 0);
                    aI[mt] = __builtin_amdgcn_mfma_f32_16x16x32_bf16(wf[d][1][ks], xb, aI[mt], 0, 0, 0); }
#pragma unroll
            for (int mt = 0; mt < 4; ++mt) { const int tl = 16 * mt + fr, cl = 16 * w + 4 * fq;
                const f32x4 xc = *(const LAS f32x4*)(L + O_XCF + tl * FST + cl * 4);
                f32x4 av, uv;
#pragma unroll
                for (int e = 0; e < 4; ++e) { const float r = sigmoidf_(aR[mt][e] + br4[d][e]), ig = sigmoidf_(aI[mt][e] + bi4[d][e]);
                    const float a_ = __builtin_amdgcn_exp2f(r * sp4[d][e]); av[e] = a_; uv[e] = __builtin_amdgcn_sqrtf(fmaxf(1.f - a_ * a_, 0.f)) * (ig * xc[e]); }
                *(LAS f32x4*)(L + o_a + tl * FST + cl * 4) = av; *(LAS f32x4*)(L + O_U + tl * FST + cl * 4) = uv; }
            __syncthreads();
            {
                const int c = tid & 127, sub = tid >> 7;
                LAS float* pa = (LAS float*)(L + o_a) + c; const LAS float* pu = (const LAS float*)(L + O_U) + c;
                LAS f32x2* SUBT = (LAS f32x2*)(L + O_SUB);
                float h = 0.f, A = 1.f;
#pragma unroll
                for (int s2 = 0; s2 < 16; ++s2) { const int tl = d ? (16 * sub + 15 - s2) : (16 * sub + s2); const float a = pa[tl * 132], u = pu[tl * 132]; h = a * h + u; A *= a; }
                SUBT[sub * 128 + c] = (f32x2){A, h};
                __syncthreads();
                if (!PB) {
                    if (sub == 0) { float HH = 0.f, AA = 1.f;
#pragma unroll
                        for (int q = 0; q < 4; ++q) { const f32x2 ah = SUBT[(d ? 3 - q : q) * 128 + c]; HH = ah[0] * HH + ah[1]; AA *= ah[0]; }
                        AGG[((size_t)(b * 64 + seg) * 2 + d) * DM + blk * 128 + c] = (f32x2){AA, HH}; }
                } else {
                    float hc = d ? carry1 : carry0;
#pragma unroll
                    for (int q = 0; q < 3; ++q) { const int jq = d ? 3 - q : q; const f32x2 ah = SUBT[jq * 128 + c]; if (d ? (jq > sub) : (jq < sub)) hc = ah[0] * hc + ah[1]; }
                    if (d == 0) {
#pragma unroll
                        for (int s2 = 0; s2 < 16; ++s2) { const int tl = 16 * sub + s2; hc = pa[tl * 132] * hc + pu[tl * 132]; pa[tl * 132] = hc; }
                    } else { LAS float* ph = (LAS float*)(L + O_A) + c;
#pragma unroll
                        for (int s2 = 0; s2 < 16; ++s2) { const int tl = 16 * sub + 15 - s2; hc = pa[tl * 132] * hc + pu[tl * 132]; ph[tl * 132] += hc; } }
                }
            }
            __syncthreads();
        }
        if (PB) {
#pragma unroll
            for (int r = 0; r < 2; ++r) { const int e = tid + NTHR * r, row = e >> 4, c16 = e & 15;
                const v4u g = lgreg[r];
                const f32x4 h0 = *(const LAS f32x4*)(L + O_A + row * FST + c16 * 32), h1 = *(const LAS f32x4*)(L + O_A + row * FST + c16 * 32 + 16);
                v4u o;
                o.x = pk2(h0[0] * gelu_fast(bflo(g.x)), h0[1] * gelu_fast(bfhi(g.x))); o.y = pk2(h0[2] * gelu_fast(bflo(g.y)), h0[3] * gelu_fast(bfhi(g.y)));
                o.z = pk2(h1[0] * gelu_fast(bflo(g.z)), h1[1] * gelu_fast(bfhi(g.z))); o.w = pk2(h1[2] * gelu_fast(bflo(g.w)), h1[3] * gelu_fast(bfhi(g.w)));
                *(v4u*)(YL + (mrow0 + row) * DM + blk * 128 + c16 * 8) = o; }
            __syncthreads();
        }
    }
#undef RAW_LOAD
}

__device__ __forceinline__ void mconv_phase(Frame& F) {
    const bf16* XM = (const bf16*)(F.ws + WS_XM); bf16* XC = (bf16*)F.out + (size_t)MTOK * DM;
    const float* cw = F.in[4]; const float* cb = F.in[5];
    const int NT = MTOK / 32 * 128;
    for (int g = F.bid * NTHR + F.tid; g < NT; g += F.G * NTHR) {
        const int chunk = g & 127, run = g >> 7, c0 = chunk * 8, m0 = run * 32, t0 = m0 & (SEQ - 1);
        float w[4][8], bias[8];
#pragma unroll
        for (int j = 0; j < 4; ++j) { const f32x4 a = *(const f32x4*)(cw + j * DM + c0), b = *(const f32x4*)(cw + j * DM + c0 + 4);
            w[j][0] = a[0]; w[j][1] = a[1]; w[j][2] = a[2]; w[j][3] = a[3]; w[j][4] = b[0]; w[j][5] = b[1]; w[j][6] = b[2]; w[j][7] = b[3]; }
        { const f32x4 a = *(const f32x4*)(cb + c0), b = *(const f32x4*)(cb + c0 + 4);
            bias[0] = a[0]; bias[1] = a[1]; bias[2] = a[2]; bias[3] = a[3]; bias[4] = b[0]; bias[5] = b[1]; bias[6] = b[2]; bias[7] = b[3]; }
        v4u win[4];
        const v4u zero = {0u, 0u, 0u, 0u};
        win[0] = zero;
        win[1] = (t0 >= 2) ? *(const v4u*)(XM + (size_t)(m0 - 2) * DM + c0) : zero;
        win[2] = (t0 >= 1) ? *(const v4u*)(XM + (size_t)(m0 - 1) * DM + c0) : zero;
        win[3] = *(const v4u*)(XM + (size_t)m0 * DM + c0);
#pragma unroll 4
        for (int i = 0; i < 32; ++i) {
            win[0] = win[1]; win[1] = win[2]; win[2] = win[3];
            win[3] = (t0 + i + 1 < SEQ) ? *(const v4u*)(XM + (size_t)(m0 + i + 1) * DM + c0) : zero;
            float y[8];
#pragma unroll
            for (int e = 0; e < 8; ++e) y[e] = bias[e];
#pragma unroll
            for (int j = 0; j < 4; ++j) {
                const unsigned p0 = win[j].x, p1 = win[j].y, p2 = win[j].z, p3 = win[j].w;
                y[0] += w[j][0] * bflo(p0); y[1] += w[j][1] * bfhi(p0); y[2] += w[j][2] * bflo(p1); y[3] += w[j][3] * bfhi(p1);
                y[4] += w[j][4] * bflo(p2); y[5] += w[j][5] * bfhi(p2); y[6] += w[j][6] * bflo(p3); y[7] += w[j][7] * bfhi(p3);
            }
#pragma unroll
            for (int e = 0; e < 8; ++e) y[e] = y[e] * sigmoidf_(y[e]);
            v4u o; o.x = pk2(y[0], y[1]); o.y = pk2(y[2], y[3]); o.z = pk2(y[4], y[5]); o.w = pk2(y[6], y[7]);
            *(v4u*)(XC + (size_t)(m0 + i) * DM + c0) = o;
        }
    }
}

typedef short s16x4 __attribute__((ext_vector_type(4)));
__device__ __forceinline__ bf16x8 tr_read_pair(unsigned a0, unsigned a1) {
    s16x4 r0, r1;
    asm volatile("ds_read_b64_tr_b16 %0, %2\n\tds_read_b64_tr_b16 %1, %3\n\ts_waitcnt lgkmcnt(0)" : "=&v"(r0), "=&v"(r1) : "v"(a0), "v"(a1) : "memory");
    return __builtin_shufflevector(r0, r1, 0, 1, 2, 3, 4, 5, 6, 7);
}
__device__ __forceinline__ float dpp_shr(float oldv, float x, int n) {
    const int o = __builtin_bit_cast(int, oldv), v = __builtin_bit_cast(int, x);
    int r;
    if (n == 1) r = __builtin_amdgcn_update_dpp(o, v, 0x111, 0xf, 0xf, false);
    else if (n == 2) r = __builtin_amdgcn_update_dpp(o, v, 0x112, 0xf, 0xf, false);
    else if (n == 4) r = __builtin_amdgcn_update_dpp(o, v, 0x114, 0xf, 0xf, false);
    else r = __builtin_amdgcn_update_dpp(o, v, 0x118, 0xf, 0xf, false);
    return __builtin_bit_cast(float, r);
}
__device__ __forceinline__ float rdlane(float x, int l) { return __builtin_bit_cast(float, __builtin_amdgcn_readlane(__builtin_bit_cast(int, x), l)); }
__device__ __forceinline__ float wave_incl_sum(float x, int lane) {
    x += dpp_shr(0.f, x, 1); x += dpp_shr(0.f, x, 2); x += dpp_shr(0.f, x, 4); x += dpp_shr(0.f, x, 8);
    const float t0 = rdlane(x, 15), t1 = rdlane(x, 31), t2 = rdlane(x, 47);
    return x + (lane >= 16 ? t0 : 0.f) + (lane >= 32 ? t1 : 0.f) + (lane >= 48 ? t2 : 0.f);
}
__device__ __forceinline__ float wave_incl_max(float x, int lane) {
    const float NI = -INFINITY;
    x = fmaxf(x, dpp_shr(NI, x, 1)); x = fmaxf(x, dpp_shr(NI, x, 2)); x = fmaxf(x, dpp_shr(NI, x, 4)); x = fmaxf(x, dpp_shr(NI, x, 8));
    const float t0 = rdlane(x, 15), t1 = rdlane(x, 31), t2 = rdlane(x, 47);
    return fmaxf(fmaxf(x, lane >= 16 ? t0 : NI), fmaxf(lane >= 32 ? t1 : NI, lane >= 48 ? t2 : NI));
}
__device__ __forceinline__ void mscan_phase(Frame& F) {
    const bf16* Q = (const bf16*)(F.ws + WS_LG); const bf16* K = (const bf16*)(F.ws + WS_K); const bf16* V = (const bf16*)(F.ws + WS_XL);
    const float* GT = (const float*)(F.ws + WS_GATE);
    constexpr int KS = 0, CTI = 33792, VT = 67584, VWT = 86016, PB = 104448, TAB = 113664, NT = 116736, NPART = 117760, DENT = 119808;
    constexpr int KST = 528, VST = 144, TABSZ = 1536;
    LAS unsigned char* L = F.lds;
    const int tid = F.tid, lane = F.lane, w = F.wave, fr = lane & 15, fq = lane >> 4, pt = w & 3, wg = w >> 2;
    for (int item = F.bid; item < 256; item += F.G) {
        const int es = item & 3, dir = (item >> 2) & 1, h = (item >> 3) & 3, b = item >> 5;
        bf16* H = dir ? ((bf16*)F.out + (size_t)MTOK * DM) : (bf16*)(F.ws + WS_XM);
        const size_t rowbase = (size_t)b * SEQ;
#define TOF(c, p) (dir ? (SEQ - 1 - 64 * (c) - (p)) : (64 * (c) + (p)))
        for (int e = tid; e < (33792 + 1024) / 4; e += NTHR) { if (e < 33792 / 4) ((LAS unsigned*)(L + CTI))[e] = 0u; else ((LAS unsigned*)(L + NT))[e - 33792 / 4] = 0u; }
        float m_run = 0.f;
        float gi_n = 0.f, gf_n = 0.f;
        if (w == 0) { const size_t m = rowbase + TOF(0, lane); gi_n = GT[m * 16 + dir * 8 + h]; gf_n = GT[m * 16 + dir * 8 + 4 + h]; }
#define G1_TABLES(setp) do { \
            const float logf_ = fminf(gf_n, 0.f) - __logf(1.f + __expf(-fabsf(gf_n))); const float b_ = wave_incl_sum(logf_, lane); const float a_ = gi_n - b_; \
            const float M_ = fmaxf(m_run, wave_incl_max(a_, lane)); const float Mend_ = rdlane(M_, 63), g_ = rdlane(b_, 63); \
            LAS float* T_ = (LAS float*)(setp); T_[lane] = a_; T_[64 + lane] = M_; T_[128 + lane] = __expf(m_run - M_); T_[192 + lane] = __expf(-(b_ + M_)); T_[256 + lane] = __expf(a_ - Mend_); \
            if (lane == 0) { T_[320] = __expf(m_run - Mend_); T_[321] = g_ + Mend_; } \
            m_run = g_ + Mend_; } while (0)
        if (w == 0) G1_TABLES(L + TAB);
        __syncthreads();
        bf16x8 qf[8];
        v4u kreg[4]; v4u vreg;
#define LOAD_KV(c) do { _Pragma("unroll") for (int r_ = 0; r_ < 4; ++r_) { const int i_ = tid + NTHR * r_, s_ = i_ >> 5, c16_ = i_ & 31; \
                kreg[r_] = *(const v4u*)(K + (rowbase + TOF(c, s_)) * DM + h * 256 + c16_ * 8); } \
            { const int s_ = tid & 63, e8_ = tid >> 6; vreg = *(const v4u*)(V + (rowbase + TOF(c, s_)) * DM + h * 256 + es * 64 + e8_ * 8); } } while (0)
#define STORE_KV(setidx) do { _Pragma("unroll") for (int r_ = 0; r_ < 4; ++r_) { const int i_ = tid + NTHR * r_, s_ = i_ >> 5, c16_ = i_ & 31; \
                *(LAS v4u*)(L + KS + s_ * KST + c16_ * 16) = kreg[r_]; } \
            { const int s_ = tid & 63, e8_ = tid >> 6; const float ws_ = ((const LAS float*)(L + TAB + (setidx) * TABSZ))[256 + s_]; \
              LAS bf16* vt_ = (LAS bf16*)(L + VT + (setidx) * 9216); LAS bf16* vw_ = (LAS bf16*)(L + VWT + (setidx) * 9216); \
              const unsigned wv_[4] = {vreg.x, vreg.y, vreg.z, vreg.w}; \
              _Pragma("unroll") for (int j_ = 0; j_ < 4; ++j_) { const float lo_ = bflo(wv_[j_]), hi_ = bfhi(wv_[j_]); const int e_ = e8_ * 8 + 2 * j_; \
                vt_[e_ * 72 + s_] = (bf16)(wv_[j_] & 0xffffu); vt_[(e_ + 1) * 72 + s_] = (bf16)(wv_[j_] >> 16); \
                vw_[e_ * 72 + s_] = (bf16)f2bf(lo_ * ws_); vw_[(e_ + 1) * 72 + s_] = (bf16)f2bf(hi_ * ws_); } } } while (0)
#define LOAD_Q(c) do { const size_t m_ = rowbase + TOF(c, 16 * pt + fr); _Pragma("unroll") for (int ks_ = 0; ks_ < 8; ++ks_) \
                qf[ks_] = *(const bf16x8*)(Q + m_ * DM + h * 256 + 32 * ks_ + 8 * fq); } while (0)
        LOAD_KV(0); LOAD_Q(0);
        STORE_KV(0);
        f32x4 Cacc[8];
#pragma unroll
        for (int i = 0; i < 8; ++i) Cacc[i] = (f32x4){0.f, 0.f, 0.f, 0.f};
        __syncthreads();
        for (int c = 0; c < 64; ++c) {
            const int cur = c & 1, nxt = cur ^ 1;
            const bool has_next = (c + 1 < 64);
            const LAS float* T = (const LAS float*)(L + TAB + cur * TABSZ);
            if (has_next) { LOAD_KV(c + 1); if (w == 0) { const size_t m = rowbase + TOF(c + 1, lane); gi_n = GT[m * 16 + dir * 8 + h]; gf_n = GT[m * 16 + dir * 8 + 4 + h]; } }
            const int p = 16 * pt + fr;
            const float Mp = T[64 + p], wi_p = T[128 + p];
            float cs = 0.f;
#pragma unroll
            for (int i = 0; i < 2; ++i) { const int st = 2 * wg + i;
                v2u pw = {0u, 0u};
                if (st <= pt) {
                    f32x4 sa = (f32x4){0.f, 0.f, 0.f, 0.f};
#pragma unroll
                    for (int ks = 0; ks < 8; ++ks) { const bf16x8 kf = *(const LAS bf16x8*)(L + KS + (16 * st + fr) * KST + (32 * ks + 8 * fq) * 2);
                        sa = __builtin_amdgcn_mfma_f32_16x16x32_bf16(kf, qf[ks], sa, 0, 0, 0); }
                    const f32x4 a4 = *(const LAS f32x4*)(T + 16 * st + 4 * fq);
                    float pv[4];
#pragma unroll
                    for (int r = 0; r < 4; ++r) { const int s_ = 16 * st + 4 * fq + r; const float wgt = (s_ <= p) ? __expf(a4[r] - Mp) : 0.f; pv[r] = sa[r] * wgt; cs += pv[r]; }
                    pw.x = pk2(pv[0], pv[1]); pw.y = pk2(pv[2], pv[3]);
                }
                *(LAS v2u*)(L + PB + p * VST + (16 * st + 4 * fq) * 2) = pw; }
            f32x4 O[2];
#pragma unroll
            for (int i = 0; i < 2; ++i) { const int et = 2 * wg + i; O[i] = (f32x4){0.f, 0.f, 0.f, 0.f};
#pragma unroll
                for (int ks = 0; ks < 8; ++ks) { const bf16x8 cf = *(const LAS bf16x8*)(L + CTI + (16 * et + fr) * KST + (32 * ks + 8 * fq) * 2);
                    O[i] = __builtin_amdgcn_mfma_f32_16x16x32_bf16(cf, qf[ks], O[i], 0, 0, 0); } }
            float di = 0.f;
#define DEN_INTER(ks) do { const f32x4 n0 = *(const LAS f32x4*)(L + NT + (32 * (ks) + 8 * fq) * 4), n1 = *(const LAS f32x4*)(L + NT + (32 * (ks) + 8 * fq) * 4 + 16); \
                const v4u qw = __builtin_bit_cast(v4u, qf[ks]); \
                di += bflo(qw.x) * n0[0] + bfhi(qw.x) * n0[1] + bflo(qw.y) * n0[2] + bfhi(qw.y) * n0[3] + bflo(qw.z) * n1[0] + bfhi(qw.z) * n1[1] + bflo(qw.w) * n1[2] + bfhi(qw.w) * n1[3]; } while (0)
            if (wg == 0) { DEN_INTER(0); DEN_INTER(1); DEN_INTER(2); DEN_INTER(3); }
            else { DEN_INTER(4); DEN_INTER(5); DEN_INTER(6); DEN_INTER(7); }
#undef DEN_INTER
            di += __shfl_xor(di, 16); di += __shfl_xor(di, 32);
            cs += __shfl_xor(cs, 16); cs += __shfl_xor(cs, 32);
            if (fq == 0) ((LAS float*)(L + DENT))[wg * 64 + p] = wi_p * di + cs;
            if (has_next) LOAD_Q(c + 1);
            if (has_next && w == 0) G1_TABLES(L + TAB + nxt * TABSZ);
            __syncthreads();
#pragma unroll
            for (int i = 0; i < 2; ++i) { const int et = 2 * wg + i; O[i] = O[i] * wi_p;
#pragma unroll
                for (int ks = 0; ks < 2; ++ks) { const bf16x8 vf = *(const LAS bf16x8*)(L + VT + cur * 9216 + (16 * et + fr) * VST + (32 * ks + 8 * fq) * 2);
                    const bf16x8 pf = *(const LAS bf16x8*)(L + PB + p * VST + (32 * ks + 8 * fq) * 2);
                    O[i] = __builtin_amdgcn_mfma_f32_16x16x32_bf16(vf, pf, O[i], 0, 0, 0); } }
            { const float den = ((const LAS float*)(L + DENT))[p] + ((const LAS float*)(L + DENT))[64 + p];
              const float inv = 1.f / fmaxf(fabsf(den), T[192 + p]);
              const size_t m = rowbase + TOF(c, p);
#pragma unroll
              for (int i = 0; i < 2; ++i) { const int et = 2 * wg + i; v2u o; o.x = pk2(O[i][0] * inv, O[i][1] * inv); o.y = pk2(O[i][2] * inv, O[i][3] * inv);
                  *(v2u*)(H + m * DM + h * 256 + es * 64 + 16 * et + 4 * fq) = o; } }
            { const float decay = T[320];
              const bf16x8 vw0 = *(const LAS bf16x8*)(L + VWT + cur * 9216 + (16 * pt + fr) * VST + (8 * fq) * 2);
              const bf16x8 vw1 = *(const LAS bf16x8*)(L + VWT + cur * 9216 + (16 * pt + fr) * VST + (32 + 8 * fq) * 2);
              const int l16 = lane & 15, q4 = l16 >> 2, p4 = l16 & 3;
              const unsigned kb = (unsigned)(uintptr_t)(L + KS) + (unsigned)((8 * fq + q4) * KST + 4 * p4 * 2);
#pragma unroll
              for (int dtl = 0; dtl < 8; dtl += 2) { const int dt = 8 * wg + dtl; const unsigned a0 = kb + dt * 32;
                  s16x4 r0, r1, r2, r3, r4, r5, r6, r7;
                  asm volatile("ds_read_b64_tr_b16 %0, %8\n\tds_read_b64_tr_b16 %1, %8 offset:2112\n\tds_read_b64_tr_b16 %2, %8 offset:16896\n\tds_read_b64_tr_b16 %3, %8 offset:19008\n\t"
                               "ds_read_b64_tr_b16 %4, %8 offset:32\n\tds_read_b64_tr_b16 %5, %8 offset:2144\n\tds_read_b64_tr_b16 %6, %8 offset:16928\n\tds_read_b64_tr_b16 %7, %8 offset:19040\n\ts_waitcnt lgkmcnt(0)"
                               : "=&v"(r0), "=&v"(r1), "=&v"(r2), "=&v"(r3), "=&v"(r4), "=&v"(r5), "=&v"(r6), "=&v"(r7) : "v"(a0) : "memory");
                  const bf16x8 k0 = __builtin_shufflevector(r0, r1, 0, 1, 2, 3, 4, 5, 6, 7), k1 = __builtin_shufflevector(r2, r3, 0, 1, 2, 3, 4, 5, 6, 7);
                  const bf16x8 k2 = __builtin_shufflevector(r4, r5, 0, 1, 2, 3, 4, 5, 6, 7), k3 = __builtin_shufflevector(r6, r7, 0, 1, 2, 3, 4, 5, 6, 7);
                  Cacc[dtl] = Cacc[dtl] * decay; Cacc[dtl + 1] = Cacc[dtl + 1] * decay;
                  Cacc[dtl] = __builtin_amdgcn_mfma_f32_16x16x32_bf16(k0, vw0, Cacc[dtl], 0, 0, 0);
                  Cacc[dtl + 1] = __builtin_amdgcn_mfma_f32_16x16x32_bf16(k2, vw0, Cacc[dtl + 1], 0, 0, 0);
                  Cacc[dtl] = __builtin_amdgcn_mfma_f32_16x16x32_bf16(k1, vw1, Cacc[dtl], 0, 0, 0);
                  Cacc[dtl + 1] = __builtin_amdgcn_mfma_f32_16x16x32_bf16(k3, vw1, Cacc[dtl + 1], 0, 0, 0); } }
            { const int d = tid & 255, hf2 = tid >> 8; float np = 0.f;
#pragma unroll 8
              for (int s2 = 0; s2 < 32; ++s2) { const int s_ = hf2 * 32 + s2; np += T[256 + s_] * bf2f(*(const LAS bf16*)(L + KS + s_ * KST + d * 2)); }
              ((LAS float*)(L + NPART))[hf2 * 256 + d] = np; }
            __syncthreads();
            { const float decay = T[320];
#pragma unroll
              for (int dtl = 0; dtl < 8; ++dtl) { const int dt = 8 * wg + dtl; v2u o; o.x = pk2(Cacc[dtl][0], Cacc[dtl][1]); o.y = pk2(Cacc[dtl][2], Cacc[dtl][3]);
                  *(LAS v2u*)(L + CTI + (16 * pt + fr) * KST + (16 * dt + 4 * fq) * 2) = o; }
              if (tid < 256) { LAS float* nt = (LAS float*)(L + NT); const LAS float* np = (const LAS float*)(L + NPART); nt[tid] = decay * nt[tid] + np[tid] + np[256 + tid]; } }
            if (has_next) STORE_KV(nxt);
            __syncthreads();
        }
#undef TOF
#undef G1_TABLES
#undef LOAD_KV
#undef STORE_KV
#undef LOAD_Q
    }
}

__device__ __forceinline__ void ym_phase(Frame& F) {
    const bf16* HF = (const bf16*)(F.ws + WS_XM); const bf16* HB = (const bf16*)F.out + (size_t)MTOK * DM; bf16* OP = (bf16*)(F.ws + WS_OP);
    const float* ng = F.in[9];
    const int gw = F.bid * NWAVES + F.wave, NGW = F.G * NWAVES;
    for (int m = gw; m < MTOK; m += NGW) {
#pragma unroll
        for (int hd = 0; hd < 4; ++hd) {
            const size_t o = (size_t)m * DM + hd * 256 + F.lane * 4;
            const v2u a = *(const v2u*)(HF + o), b = *(const v2u*)(HB + o), op = *(const v2u*)(OP + o);
            const float v0 = bflo(a.x) + bflo(b.x), v1 = bfhi(a.x) + bfhi(b.x), v2 = bflo(a.y) + bflo(b.y), v3 = bfhi(a.y) + bfhi(b.y);
            const float r = rsqrtf(wave_sum((v0 * v0 + v1 * v1) + (v2 * v2 + v3 * v3)) * (1.f / 256.f) + EPS);
            const f32x4 g = *(const f32x4*)(ng + hd * 256 + F.lane * 4);
            v2u w; w.x = pk2(sigmoidf_(bflo(op.x)) * v0 * r * g[0], sigmoidf_(bfhi(op.x)) * v1 * r * g[1]);
            w.y = pk2(sigmoidf_(bflo(op.y)) * v2 * r * g[2], sigmoidf_(bfhi(op.y)) * v3 * r * g[3]);
            *(v2u*)(OP + o) = w;
        }
    }
    {
        float* usc = (float*)(F.ws + WS_LG + 16 * MiB); float* vsc = usc + NEXP;
        for (int row = gw; row < 2 * NEXP; row += NGW) {
            const bool isv = row >= NEXP; const int r = isv ? row - NEXP : row;
            const f32x4* src = (const f32x4*)(F.in[isv ? 24 : 23] + (size_t)r * DM) + F.lane * 4;
            f32x4 a[4]; float ss = 0.f;
#pragma unroll
            for (int j = 0; j < 4; ++j) { a[j] = src[j]; ss += (a[j][0] * a[j][0] + a[j][1] * a[j][1]) + (a[j][2] * a[j][2] + a[j][3] * a[j][3]); }
            const float rms = sqrtf(wave_sum(ss) * (1.f / DM));
            const float sc = fmaxf(rms * 0.5f, 1e-30f), inv = 1.f / sc;
            unsigned o[2] = {0u, 0u};
#pragma unroll
            for (int j = 0; j < 4; ++j) { const f32x4 q = a[j] * inv;
                if (j & 1) { o[j >> 1] = __builtin_amdgcn_cvt_scalef32_pk_fp4_f32(o[j >> 1], q[0], q[1], 1.0f, 2); o[j >> 1] = __builtin_amdgcn_cvt_scalef32_pk_fp4_f32(o[j >> 1], q[2], q[3], 1.0f, 3); }
                else       { o[j >> 1] = __builtin_amdgcn_cvt_scalef32_pk_fp4_f32(o[j >> 1], q[0], q[1], 1.0f, 0); o[j >> 1] = __builtin_amdgcn_cvt_scalef32_pk_fp4_f32(o[j >> 1], q[2], q[3], 1.0f, 1); } }
            *(v2u*)(F.ws + WS_LG + (isv ? 8 * MiB : 0) + (size_t)r * (DM / 2) + F.lane * 8) = (v2u){o[0], o[1]};
            if (F.lane == 0) (isv ? vsc : usc)[r] = sc;
        }
    }
}

typedef float f32x16 __attribute__((ext_vector_type(16)));
#define TOPK_INSERT(L, xv) do { const float x_ = (xv); \
    L[15] = __builtin_amdgcn_fmed3f(L[14], L[15], x_); L[14] = __builtin_amdgcn_fmed3f(L[13], L[14], x_); L[13] = __builtin_amdgcn_fmed3f(L[12], L[13], x_); L[12] = __builtin_amdgcn_fmed3f(L[11], L[12], x_); \
    L[11] = __builtin_amdgcn_fmed3f(L[10], L[11], x_); L[10] = __builtin_amdgcn_fmed3f(L[9], L[10], x_); L[9] = __builtin_amdgcn_fmed3f(L[8], L[9], x_); L[8] = __builtin_amdgcn_fmed3f(L[7], L[8], x_); \
    L[7] = __builtin_amdgcn_fmed3f(L[6], L[7], x_); L[6] = __builtin_amdgcn_fmed3f(L[5], L[6], x_); L[5] = __builtin_amdgcn_fmed3f(L[4], L[5], x_); L[4] = __builtin_amdgcn_fmed3f(L[3], L[4], x_); \
    L[3] = __builtin_amdgcn_fmed3f(L[2], L[3], x_); L[2] = __builtin_amdgcn_fmed3f(L[1], L[2], x_); L[1] = __builtin_amdgcn_fmed3f(L[0], L[1], x_); L[0] = fmaxf(L[0], x_); } while (0)
template <int I> struct CandRow {
    static __device__ __forceinline__ void run(const float (&L0)[16], const float (&L1)[16], float (&R)[16]) {
        constexpr int NJ = 16 / (I + 1);
#pragma unroll
        for (int j = 0; j < NJ; ++j) { const float sm = L0[I] + L1[j];
            const float pk = __builtin_bit_cast(float, (__builtin_bit_cast(unsigned, sm) & 0xffffff00u) | (unsigned)(I * 16 + j)); TOPK_INSERT(R, pk); }
        if constexpr (I < 15) CandRow<I + 1>::run(L0, L1, R);
    }
};
__device__ __forceinline__ unsigned pick4(unsigned d0, unsigned d1, unsigned d2, unsigned d3, int i) {
    const int q = i >> 2; unsigned d = d0; d = (q == 1) ? d1 : d; d = (q == 2) ? d2 : d; d = (q == 3) ? d3 : d; return (d >> (8 * (i & 3))) & 127u;
}
__device__ __forceinline__ void select_phase(Frame& F) {
    const bf16* PQ = (const bf16*)(F.ws + WS_MG); const bf16* KEYS = (const bf16*)(F.ws + WS_KEYS);
    int* IDX = (int*)(F.ws + WS_K); float* GW = (float*)(F.ws + WS_K + 16 * MiB);
    LAS unsigned char* L = F.lds;
    const int tid = F.tid, lane = F.lane, w = F.wave, l31 = lane & 31, hh = lane >> 5;
    const float NEG_INF = -INFINITY;
    for (int grp = F.bid; grp < MTOK / 128; grp += F.G) {
        const int tb = grp * 4 + (w & 3);
        const size_t m = (size_t)tb * 32 + l31;
        for (int hp = 0; hp < 4; ++hp) {
            __syncthreads();
#pragma unroll 4
            for (int r = 0; r < 16; ++r) { const int e = tid + NTHR * r, R = e >> 4, c = e & 15;
                *(LAS v4u*)(L + R * 256 + ((c ^ (R & 15)) * 16)) = *(const v4u*)(KEYS + ((size_t)(hp * 512 + R) * 128 + c * 8)); }
            __syncthreads();
            const int hl = w >> 2, h = 2 * hp + hl;
            float L0[16], L1[16];
#pragma unroll
            for (int p = 0; p < 2; ++p) {
                bf16x8 qf[8];
#pragma unroll
                for (int ks = 0; ks < 8; ++ks) qf[ks] = *(const bf16x8*)(PQ + m * 2048 + h * 256 + p * 128 + 16 * ks + 8 * hh);
                f32x16 acc[4];
#pragma unroll
                for (int kb = 0; kb < 4; ++kb)
#pragma unroll
                    for (int r = 0; r < 16; ++r) acc[kb][r] = 0.f;
#pragma unroll
                for (int ks = 0; ks < 8; ++ks)
#pragma unroll
                    for (int kb = 0; kb < 4; ++kb) { const int R = (hl * 2 + p) * 128 + 32 * kb + l31;
                        const bf16x8 kf = *(const LAS bf16x8*)(L + R * 256 + (((2 * ks + hh) ^ (lane & 15)) * 16));
                        acc[kb] = __builtin_amdgcn_mfma_f32_32x32x16_bf16(kf, qf[ks], acc[kb], 0, 0, 0); }
                float Lc[16];
#pragma unroll
                for (int i = 0; i < 16; ++i) Lc[i] = NEG_INF;
                const unsigned hh4 = (unsigned)hh << 2;
#pragma unroll
                for (int kb = 0; kb < 4; ++kb)
#pragma unroll
                    for (int r = 0; r < 16; ++r) { const unsigned nlo = (unsigned)(32 * kb + (r & 3) + 8 * (r >> 2));
                        const float av_ = acc[kb][r];
                        const float pk = __uint_as_float(((__float_as_uint(av_) & 0xffffff80u) | hh4) | nlo); TOPK_INSERT(Lc, pk); }
                float Lo[16];
#pragma unroll
                for (int i = 0; i < 16; ++i) Lo[i] = __shfl_xor(Lc[i], 32);
#pragma unroll
                for (int i = 0; i < 16; ++i) TOPK_INSERT(Lc, Lo[i]);
#pragma unroll
                for (int i = 0; i < 16; ++i) { if (p == 0) L0[i] = Lc[i]; else L1[i] = Lc[i]; }
            }
            float R[16];
#pragma unroll
            for (int i = 0; i < 16; ++i) R[i] = NEG_INF;
            CandRow<0>::run(L0, L1, R);
            unsigned a0 = 0, a1 = 0, a2 = 0, a3 = 0, b0 = 0, b1 = 0, b2 = 0, b3 = 0;
#pragma unroll
            for (int i = 0; i < 4; ++i) { a0 |= (__builtin_bit_cast(unsigned, L0[i]) & 127u) << (8 * i); a1 |= (__builtin_bit_cast(unsigned, L0[4 + i]) & 127u) << (8 * i);
                a2 |= (__builtin_bit_cast(unsigned, L0[8 + i]) & 127u) << (8 * i); a3 |= (__builtin_bit_cast(unsigned, L0[12 + i]) & 127u) << (8 * i);
                b0 |= (__builtin_bit_cast(unsigned, L1[i]) & 127u) << (8 * i); b1 |= (__builtin_bit_cast(unsigned, L1[4 + i]) & 127u) << (8 * i);
                b2 |= (__builtin_bit_cast(unsigned, L1[8 + i]) & 127u) << (8 * i); b3 |= (__builtin_bit_cast(unsigned, L1[12 + i]) & 127u) << (8 * i); }
            float ex[16]; float sum = 0.f; int id[16];
#pragma unroll
            for (int r = 0; r < 16; ++r) { ex[r] = __expf(R[r] - R[0]); sum += ex[r];
                const unsigned cid = __builtin_bit_cast(unsigned, R[r]) & 255u;
                id[r] = (int)(pick4(a0, a1, a2, a3, (int)(cid >> 4)) * 128u + pick4(b0, b1, b2, b3, (int)(cid & 15u))); }
            const float inv = 1.f / sum;
            if (hh == 0) {
#pragma unroll
                for (int q = 0; q < 4; ++q) {
                    *(int4*)(IDX + m * 128 + h * 16 + 4 * q) = make_int4(id[4 * q], id[4 * q + 1], id[4 * q + 2], id[4 * q + 3]);
                    *(f32x4*)(GW + m * 128 + h * 16 + 4 * q) = (f32x4){ex[4 * q] * inv, ex[4 * q + 1] * inv, ex[4 * q + 2] * inv, ex[4 * q + 3] * inv}; }
            }
        }
    }
}

template <int B> __device__ __forceinline__ f32x2 fp4b(unsigned w) { return __builtin_amdgcn_cvt_scalef32_pk_f32_fp4(w, 1.0f, B); }
#ifndef AP_CHECK
#define AP_CHECK 0
#endif
typedef int v8i_t __attribute__((ext_vector_type(8)));
#if AP_CHECK == 2
template <int KA> __device__ __forceinline__ v4u dbg_load_a(LAS unsigned char* row, int fq, int ks) {
    if constexpr (KA == 1) return *(const LAS v4u*)(row + 64 * ks + 16 * fq);
    else if constexpr (KA == 2) { const v2u lo = *(const LAS v2u*)(row + 64 * ks + 8 * fq), hi = *(const LAS v2u*)(row + 64 * ks + 32 + 8 * fq); return (v4u){lo.x, lo.y, hi.x, hi.y}; }
    else { v4u r; r.x = *(const LAS unsigned*)(row + 64 * ks + 4 * fq); r.y = *(const LAS unsigned*)(row + 64 * ks + 4 * fq + 16); r.z = *(const LAS unsigned*)(row + 64 * ks + 4 * fq + 32); r.w = *(const LAS unsigned*)(row + 64 * ks + 4 * fq + 48); return r; }
}
template <int KB> __device__ __forceinline__ v8i_t dbg_load_b(LAS unsigned char* H8, int fq, int ks) {
    if constexpr (KB == 1) { const v4u a = *(const LAS v4u*)(H8 + 128 * ks + 32 * fq), b = *(const LAS v4u*)(H8 + 128 * ks + 32 * fq + 16); return (v8i_t){(int)a.x, (int)a.y, (int)a.z, (int)a.w, (int)b.x, (int)b.y, (int)b.z, (int)b.w}; }
    else if constexpr (KB == 2) { const v4u a = *(const LAS v4u*)(H8 + 128 * ks + 16 * fq), b = *(const LAS v4u*)(H8 + 128 * ks + 64 + 16 * fq); return (v8i_t){(int)a.x, (int)a.y, (int)a.z, (int)a.w, (int)b.x, (int)b.y, (int)b.z, (int)b.w}; }
    else { const v2u a = *(const LAS v2u*)(H8 + 128 * ks + 8 * fq), b = *(const LAS v2u*)(H8 + 128 * ks + 8 * fq + 32), c = *(const LAS v2u*)(H8 + 128 * ks + 8 * fq + 64), d = *(const LAS v2u*)(H8 + 128 * ks + 8 * fq + 96);
        return (v8i_t){(int)a.x, (int)a.y, (int)b.x, (int)b.y, (int)c.x, (int)c.y, (int)d.x, (int)d.y}; }
}
__device__ __forceinline__ unsigned nibswap(unsigned x) { return ((x & 0x0F0F0F0Fu) << 4) | ((x >> 4) & 0x0F0F0F0Fu); }
template <int KA, int KB, int SW, int V> __device__ __forceinline__ int dbg_try(LAS unsigned char* UL, LAS unsigned char* H8, int fr, int fq, float ref1, float ref2, float& R) {
    f32x4 d4 = (f32x4){0.f, 0.f, 0.f, 0.f};
#pragma unroll
    for (int ks = 0; ks < 8; ++ks) {
        v4u af = dbg_load_a<KA>(UL + fr * 528, fq, ks);
        if (SW) { af.x = nibswap(af.x); af.y = nibswap(af.y); af.z = nibswap(af.z); af.w = nibswap(af.w); }
        const v8i_t A = {(int)af.x, (int)af.y, (int)af.z, (int)af.w, 0, 0, 0, 0};
        const v8i_t B = dbg_load_b<KB>(H8, fq, ks);
        d4 = __builtin_amdgcn_mfma_scale_f32_16x16x128_f8f6f4(A, B, d4, 4, 0, 0, 0x7F7F7F7F, 0, 0x7F7F7F7F);
    }
    const int sel = fr & 3;
    float t1 = d4[0]; t1 = (sel == 1) ? d4[1] : t1; t1 = (sel == 2) ? d4[2] : t1; t1 = (sel == 3) ? d4[3] : t1;
    const float t2 = d4[0];
    const float tt1 = wave_sum(t1 * t1), tr1 = wave_sum(t1 * ref1), rr1 = wave_sum(ref1 * ref1);
    const float tt2 = wave_sum(t2 * t2), tr2 = wave_sum(t2 * ref2), rr2 = wave_sum(ref2 * ref2);
    int code = 0;
    if (tr1 > 0.f && tr1 * tr1 > 0.96f * tt1 * rr1) { code = 2 * V + 1; R = tr1 / rr1; }
    else if (tr2 > 0.f && tr2 * tr2 > 0.96f * tt2 * rr2) { code = 2 * V + 2; R = tr2 / rr2; }
    return code;
}
#endif
__device__ __forceinline__ void apply_phase(Frame& F, float* OUTP) {
    const unsigned char* U8 = F.ws + WS_LG; const unsigned char* V8 = F.ws + WS_LG + 8 * MiB;
    const float* USC = (const float*)(F.ws + WS_LG + 16 * MiB); const float* VSC = USC + NEXP;
    const int* IDX = (const int*)(F.ws + WS_K); const float* GW = (const float*)(F.ws + WS_K + 16 * MiB);
    const float* g2 = F.in[20]; const float* gf = F.in[25];
    const float* X1 = F.out;
    const int lane = F.lane, fr = lane & 15, fq = lane >> 4;
    constexpr int APW = 16 * 528 + 1024;
    LAS unsigned char* UL = F.lds + F.wave * APW; LAS unsigned char* H8 = UL + 16 * 528;
    const int eid = 4 * fq + (fr & 3);
    for (int grp = F.bid; grp < MTOK / 128; grp += F.G)
    for (int m = grp * 128 + F.wave; m < grp * 128 + 128; m += NWAVES) {
        float s = 0.f; f32x4 xr[4];
#pragma unroll
        for (int q = 0; q < 4; ++q) { xr[q] = *(const f32x4*)(X1 + (size_t)m * DM + lane * 16 + q * 4); s += (xr[q][0] * xr[q][0] + xr[q][1] * xr[q][1]) + (xr[q][2] * xr[q][2] + xr[q][3] * xr[q][3]); }
        const float r2 = rsqrtf(wave_sum(s) * (1.f / DM) + EPS);
#if AP_CHECK
        f32x2 hv[8];
#endif
        { v4u h8;
#pragma unroll
          for (int q = 0; q < 4; ++q) { const f32x4 g = *(const f32x4*)(g2 + lane * 16 + q * 4); const f32x4 hq = xr[q] * r2 * g;
              int pk = 0; pk = __builtin_amdgcn_cvt_pk_fp8_f32(hq[0], hq[1], pk, false); pk = __builtin_amdgcn_cvt_pk_fp8_f32(hq[2], hq[3], pk, true); h8[q] = (unsigned)pk;
#if AP_CHECK
              hv[2 * q] = (f32x2){hq[0], hq[1]}; hv[2 * q + 1] = (f32x2){hq[2], hq[3]};
#endif
          }
          *(LAS v4u*)(H8 + lane * 16) = h8; }
        const int i0 = IDX[(size_t)m * 128 + lane], i1 = IDX[(size_t)m * 128 + 64 + lane];
        const float gw0 = GW[(size_t)m * 128 + lane], gw1 = GW[(size_t)m * 128 + 64 + lane];
        f32x2 acc[8];
#if AP_CHECK
        int dbg_code = 0; float dbg_R = 0.f;
#endif
#pragma unroll
        for (int i = 0; i < 8; ++i) acc[i] = (f32x2){0.f, 0.f};
#pragma unroll 1
        for (int bt = 0; bt < 8; ++bt) {
            const int k0 = bt * 16;
            const int isel = (k0 < 64) ? i0 : i1;
            v2u uu[16], vv[16];
            const int myidx = __shfl(isel, (k0 + eid) & 63);
            const float su = USC[myidx], sv = VSC[myidx];
#pragma unroll
            for (int e = 0; e < 16; ++e) { const size_t ro = (size_t)__builtin_amdgcn_readlane(isel, (k0 + e) & 63) * (DM / 2) + lane * 8;
                uu[e] = *(const v2u*)(U8 + ro); vv[e] = *(const v2u*)(V8 + ro); }
#pragma unroll
            for (int e = 0; e < 16; ++e) *(LAS v2u*)(UL + e * 528 + lane * 8) = uu[e];
            f32x4 d4 = (f32x4){0.f, 0.f, 0.f, 0.f};
#pragma unroll
            for (int ks = 0; ks < 8; ++ks) {
                const v4u af = *(const LAS v4u*)(UL + fr * 528 + 64 * ks + 16 * fq);
                const v4u b0 = *(const LAS v4u*)(H8 + 128 * ks + 16 * fq), b1 = *(const LAS v4u*)(H8 + 128 * ks + 64 + 16 * fq);
                const v8i_t A = {(int)af.x, (int)af.y, (int)af.z, (int)af.w, 0, 0, 0, 0};
                const v8i_t B = {(int)b0.x, (int)b0.y, (int)b0.z, (int)b0.w, (int)b1.x, (int)b1.y, (int)b1.z, (int)b1.w};
                d4 = __builtin_amdgcn_mfma_scale_f32_16x16x128_f8f6f4(A, B, d4, 4  , 0  , 0, 0x7F7F7F7F, 0, 0x7F7F7F7F);
            }
            const int sel = fr & 3;
            float t = d4[0]; t = (sel == 1) ? d4[1] : t; t = (sel == 2) ? d4[2] : t; t = (sel == 3) ? d4[3] : t;
#if AP_CHECK
            { float x[16];
#pragma unroll
              for (int e = 0; e < 16; ++e) { f32x2 d = fp4b<0>(uu[e].x) * hv[0];
                  d = __builtin_elementwise_fma(fp4b<1>(uu[e].x), hv[1], d); d = __builtin_elementwise_fma(fp4b<2>(uu[e].x), hv[2], d); d = __builtin_elementwise_fma(fp4b<3>(uu[e].x), hv[3], d);
                  d = __builtin_elementwise_fma(fp4b<0>(uu[e].y), hv[4], d); d = __builtin_elementwise_fma(fp4b<1>(uu[e].y), hv[5], d); d = __builtin_elementwise_fma(fp4b<2>(uu[e].y), hv[6], d);
                  d = __builtin_elementwise_fma(fp4b<3>(uu[e].y), hv[7], d); x[e] = wave_sum(d[0] + d[1]); }
              float ref = x[0], ref2 = x[0];
#pragma unroll
              for (int e = 1; e < 16; ++e) { ref = (eid == e) ? x[e] : ref; ref2 = (fr == e) ? x[e] : ref2; }
              if (bt == 0) {
                  int c; float R = 0.f;
#define DBG_TRY(KA, KB, SW, V) if (dbg_code == 0) { c = dbg_try<KA, KB, SW, V>(UL, H8, fr, fq, ref, ref2, R); if (c) { dbg_code = c; dbg_R = R; } }
                  DBG_TRY(1, 1, 0, 0) DBG_TRY(1, 2, 0, 1) DBG_TRY(1, 4, 0, 2) DBG_TRY(2, 1, 0, 3) DBG_TRY(2, 2, 0, 4) DBG_TRY(2, 4, 0, 5) DBG_TRY(4, 1, 0, 6) DBG_TRY(4, 2, 0, 7) DBG_TRY(4, 4, 0, 8)
                  DBG_TRY(1, 1, 1, 9) DBG_TRY(1, 2, 1, 10) DBG_TRY(1, 4, 1, 11) DBG_TRY(2, 1, 1, 12) DBG_TRY(2, 2, 1, 13) DBG_TRY(2, 4, 1, 14) DBG_TRY(4, 1, 1, 15) DBG_TRY(4, 2, 1, 16) DBG_TRY(4, 4, 1, 17)
              }
              t = ref; }
#endif
            const float gk = __shfl((k0 < 64) ? gw0 : gw1, (k0 + eid) & 63);
            const float wl = gk * gelu_fast(t * su) * sv;
#pragma unroll
            for (int e = 0; e < 16; ++e) {
                const float we = __builtin_bit_cast(float, __builtin_amdgcn_readlane(__builtin_bit_cast(int, wl), 16 * (e >> 2) + (e & 3)));
                const f32x2 w2 = (f32x2){we, we};
                acc[0] = __builtin_elementwise_fma(fp4b<0>(vv[e].x), w2, acc[0]); acc[1] = __builtin_elementwise_fma(fp4b<1>(vv[e].x), w2, acc[1]);
                acc[2] = __builtin_elementwise_fma(fp4b<2>(vv[e].x), w2, acc[2]); acc[3] = __builtin_elementwise_fma(fp4b<3>(vv[e].x), w2, acc[3]);
                acc[4] = __builtin_elementwise_fma(fp4b<0>(vv[e].y), w2, acc[4]); acc[5] = __builtin_elementwise_fma(fp4b<1>(vv[e].y), w2, acc[5]);
                acc[6] = __builtin_elementwise_fma(fp4b<2>(vv[e].y), w2, acc[6]); acc[7] = __builtin_elementwise_fma(fp4b<3>(vv[e].y), w2, acc[7]);
            }
        }
        float s2 = 0.f;
#pragma unroll
        for (int q = 0; q < 4; ++q) {
            acc[2 * q] = acc[2 * q] + (f32x2){xr[q][0], xr[q][1]}; acc[2 * q + 1] = acc[2 * q + 1] + (f32x2){xr[q][2], xr[q][3]};
            s2 += (acc[2 * q][0] * acc[2 * q][0] + acc[2 * q][1] * acc[2 * q][1]) + (acc[2 * q + 1][0] * acc[2 * q + 1][0] + acc[2 * q + 1][1] * acc[2 * q + 1][1]); }
        const float rf = rsqrtf(wave_sum(s2) * (1.f / DM) + EPS);
#pragma unroll
        for (int q = 0; q < 4; ++q) { const f32x4 g = *(const f32x4*)(gf + lane * 16 + q * 4);
            f32x4 ov = (f32x4){acc[2 * q][0] * rf * g[0], acc[2 * q][1] * rf * g[1], acc[2 * q + 1][0] * rf * g[2], acc[2 * q + 1][1] * rf * g[3]};
#if AP_CHECK
            if (m < 850 * dbg_code) ov = (f32x4){0.f, 0.f, 0.f, 0.f};
            if (m == 0 && lane == 0 && q == 0 && dbg_code) ov[0] = 100.f * dbg_R;
#endif
            *(f32x4*)(OUTP + (size_t)m * DM + lane * 16 + q * 4) = ov; }
    }
}

constexpr int N_PHASES = 13;
__global__ void __launch_bounds__(NTHR, 2) mega_fwd(Args args) {
    extern __shared__ __attribute__((aligned(16))) unsigned char lds[];
    Frame F;
    F.lds = (LAS unsigned char*)lds;
    F.tid = threadIdx.x; F.lane = F.tid & 63; F.wave = __builtin_amdgcn_readfirstlane(F.tid >> 6);
    F.G = gridDim.x; F.bid = blockIdx.x;
    F.in = args.in; F.out = args.out; F.ws = args.ws;
    volatile LAS unsigned* MISC = (volatile LAS unsigned*)(F.lds + MISC_OFF);
    for (int u = F.tid; u < (LDS_BYTES - LDSCTL_OFF) / 4; u += NTHR) ((LAS unsigned*)(F.lds + LDSCTL_OFF))[u] = 0u;
    __syncthreads();
    XcdBarrier bar; bar.bar = (unsigned*)(args.ws + WS_CTL) + CW_BAR; bar.x = 0; bar.st = nullptr;
    const bool one_launch = (args.ph_hi - args.ph_lo) > 1;
    if (one_launch) bar = xcd_barrier_post((unsigned*)(args.ws + WS_CTL) + CW_BAR, MISC + 8);
    const int lo = args.ph_lo, hi = args.ph_hi;
#define IN(k) (lo <= (k) && (k) < hi)
#define SEAM(k) do { if (IN(k) && IN((k) + 1)) xcd_barrier(bar); } while (0)
    unsigned char* ws = args.ws;

#ifndef PROBE_MASK
#define PROBE_MASK 0
#endif
#define REP(k) _Pragma("unroll") for (int rep_ = 0; rep_ < (((PROBE_MASK >> (k)) & 1) ? 2 : 1); ++rep_)
    if (IN(0)) REP(0) { p0_prologue(F); if (rep_ == 0 && ((PROBE_MASK >> 0) & 1)) xcd_barrier(bar); } SEAM(0);
    if (IN(1)) REP(1) {
        AddrPlain g{(const char*)(ws + WS_K), (const char*)(ws + WS_WIN), 1024, 1024, 1024};
        pg8::StaticOrder S; S.init(MTOK, 6144, F.G, F.bid, 4);
        EpiBf16<DstP1> E{DstP1{ws}};
        gates_phase(F);
        pg8::gemm_phase(F.lds, g, S, E);
    } SEAM(1);
    if (IN(2)) REP(2) { lru_phase<false>(F); mconv_phase(F); } SEAM(2);
    if (IN(3)) REP(3) { lru_phase<true>(F); } SEAM(3);
    if (IN(5)) REP(5) {
        const char* xc = (const char*)F.out + (size_t)MTOK * DM * 2;
        AddrQKV g{xc, (long)((const char*)(ws + WS_XM) - xc), (const char*)(ws + WS_WQKV), 1024, 256, 256};
        pg8::StaticOrder S; S.init(MTOK, 12 * 256, F.G, F.bid);
        EpiBf16<DstQKV> E{DstQKV{(char*)(ws + WS_LG), (long)WS_K - (long)WS_LG, (long)WS_XL - (long)WS_LG}};
        pg8::gemm_phase(F.lds, g, S, E);
    } SEAM(5);
    if (IN(6)) REP(6) { mscan_phase(F); } SEAM(6);
    if (IN(7)) { ym_phase(F); } SEAM(7);
    if (IN(8)) {
        pg8::StaticOrder S; S.init(MTOK, 1024, F.G, F.bid);
        { AddrPlain g{(const char*)(ws + WS_OP), (const char*)(ws + WS_WB2), 1024, 1024, 1024};
          EpiMerge<false> E{(bf16*)(ws + WS_XM), (const bf16*)(ws + WS_MG), 0}; pg8::gemm_phase(F.lds, g, S, E); }
        { AddrPlain g{(const char*)F.out, (const char*)(ws + WS_WB2) + (size_t)1024 * 1024 * 2, 1024, 1024, 1024};
          EpiMerge<true> E{(bf16*)(ws + WS_XM), (const bf16*)(ws + WS_MG), 1024}; pg8::gemm_phase(F.lds, g, S, E); }
    } SEAM(8);
    if (IN(9)) {
        AddrPlain g{(const char*)(ws + WS_XM), (const char*)(ws + WS_WOUT2), 1024, 2048, 1024};
        pg8::StaticOrder S; S.init(MTOK, 1024, F.G, F.bid);
        EpiResid E{F.in[0], F.out, (bf16*)(ws + WS_XL), (float*)(ws + WS_SS)};
        pg8::gemm_phase(F.lds, g, S, E);
    } SEAM(9);
    if (IN(10)) REP(10) {
        AddrPlain g{(const char*)(ws + WS_XL), (const char*)(ws + WS_WPQ), 1024, 1024, 1024};
        pg8::StaticOrder S; S.init(MTOK, 2048, F.G, F.bid, 4);
        EpiPQ E{(bf16*)(ws + WS_MG), (const float*)(ws + WS_SS)};
        pg8::gemm_phase(F.lds, g, S, E);
    } SEAM(10);
    if (IN(11)) REP(11) { select_phase(F); }
    if (IN(11) && IN(12)) { asm volatile("s_waitcnt vmcnt(0)" ::: "memory"); __syncthreads(); }
    if (IN(12)) { if ((PROBE_MASK >> 12) & 1) { apply_phase(F, (float*)(ws + WS_MG)); xcd_barrier(bar); } apply_phase(F, F.out); }
#undef REP
#undef IN
#undef SEAM
}

extern "C" void kernel_launch(void* const* d_in, const int* in_sizes, int n_in, void* d_out, int out_size, void* d_ws, size_t ws_size, hipStream_t stream) {
    static int grid = 0;
    if (grid == 0) {
        if (n_in != 26 || in_sizes[0] != MTOK * DM || out_size != MTOK * DM || ws_size < WS_END) { fprintf(stderr, "kernel_launch: unexpected shapes / workspace (%zu < %zu)\n", ws_size, (size_t)WS_END); grid = -1; return; }
        int dev = 0, cus = 0, per_cu = 0;
        if (hipGetDevice(&dev) != hipSuccess || hipDeviceGetAttribute(&cus, hipDeviceAttributeMultiprocessorCount, dev) != hipSuccess) { grid = -1; return; }
        if (hipFuncSetAttribute((const void*)mega_fwd, hipFuncAttributeMaxDynamicSharedMemorySize, LDS_BYTES) != hipSuccess) { fprintf(stderr, "kernel_launch: hipFuncSetAttribute failed\n"); grid = -1; return; }
        if (hipOccupancyMaxActiveBlocksPerMultiprocessor(&per_cu, (const void*)mega_fwd, NTHR, LDS_BYTES) != hipSuccess || per_cu < 1) { fprintf(stderr, "kernel_launch: occupancy query says %d blocks/CU\n", per_cu); (void)hipGetLastError(); grid = -1; return; }
        grid = cus;
    }
    if (grid < 0) return;
    (void)hipMemsetAsync((char*)d_ws + WS_CTL + (size_t)CW_BAR * 4, 0, (size_t)XCD_BAR_WORDS * 4, stream);
    Args a{};
    for (int i = 0; i < 26; ++i) a.in[i] = (const float*)d_in[i];
    a.out = (float*)d_out; a.ws = (unsigned char*)d_ws;
#if MK_N_LAUNCHES == 1
    a.ph_lo = 0; a.ph_hi = N_PHASES;
    void* kargs[] = {&a};
    hipError_t e = hipLaunchCooperativeKernel((const void*)mega_fwd, dim3(grid), dim3(NTHR), kargs, LDS_BYTES, stream);
    if (e != hipSuccess) fprintf(stderr, "kernel_launch: cooperative launch failed: %s (grid %d)\n", hipGetErrorString(e), grid);
#else
    for (int p = 0; p < N_PHASES; ++p) { a.ph_lo = p; a.ph_hi = p + 1; hipLaunchKernelGGL(mega_fwd, dim3(grid), dim3(NTHR), LDS_BYTES, stream, a); }
#endif
}
```

```cpp
#include <hip/hip_runtime.h>
#include <cstdio>
#include <cstdint>
#include <math.h>

#ifndef MK_N_LAUNCHES
#define MK_N_LAUNCHES 1
#endif

constexpr int BATCH = 8, SEQ = 4096, DM = 1024, MTOK = BATCH * SEQ;
constexpr int DIN = 6160;
constexpr int NEXP = 16384;
constexpr float EPS = 1e-6f;

constexpr size_t MiB = 1u << 20;
constexpr size_t WS_CTL = 0, CTL_ZERO_BYTES = 1 * MiB;
constexpr size_t WS_WIN = 1 * MiB;
constexpr size_t WS_WQKV = 13 * MiB;
constexpr size_t WS_KEYS = 14 * MiB + 512 * 1024;
constexpr size_t WS_WLRU = 15 * MiB;
constexpr size_t WS_WB2 = 16 * MiB;
constexpr size_t WS_WOUT2 = 20 * MiB;
constexpr size_t WS_WPQ = 24 * MiB;
constexpr size_t WS_GATE = 28 * MiB;
constexpr size_t WS_WGT = 30 * MiB;
constexpr size_t WS_XM = 32 * MiB;
constexpr size_t WS_OP = 96 * MiB;
constexpr size_t WS_XL = 160 * MiB;
constexpr size_t WS_LG = 224 * MiB;
constexpr size_t WS_MG = 288 * MiB;
constexpr size_t WS_K = 416 * MiB;
constexpr size_t WS_AGG = 480 * MiB;
constexpr size_t WS_SS = 488 * MiB;
constexpr size_t WS_END = 489 * MiB;

constexpr int CW_BAR = 4096;

constexpr int RING_BYTES = 131072;
constexpr int LDS_BYTES = 147456;
constexpr int LDSCTL_OFF = LDS_BYTES - 512, MISC_OFF = LDSCTL_OFF + 320;
constexpr int NWAVES = 8, NTHR = 512;

#define GAS __attribute__((address_space(1)))
#define LAS __attribute__((address_space(3)))
typedef unsigned short bf16;
typedef unsigned v4u __attribute__((ext_vector_type(4)));
typedef unsigned v2u __attribute__((ext_vector_type(2)));
typedef float f32x4 __attribute__((ext_vector_type(4)));
typedef float f32x2 __attribute__((ext_vector_type(2)));
typedef short bf16x8 __attribute__((ext_vector_type(8)));
typedef GAS unsigned gu32;
#define RLX_AGENT __ATOMIC_RELAXED, __HIP_MEMORY_SCOPE_AGENT
#define LDS_WAIT() asm volatile("s_waitcnt lgkmcnt(0)" ::: "memory")
#define VM_WAIT() asm volatile("s_waitcnt vmcnt(0)" ::: "memory")

__device__ __forceinline__ unsigned f2bf(float f) { unsigned u = __builtin_bit_cast(unsigned, f); return (u + 0x7fffu + ((u >> 16) & 1u)) >> 16; }
__device__ __forceinline__ unsigned pk2(float lo, float hi) { return f2bf(lo) | (f2bf(hi) << 16); }
__device__ __forceinline__ float bf2f(unsigned short h) { return __builtin_bit_cast(float, (unsigned)h << 16); }
__device__ __forceinline__ float bflo(unsigned w) { return __builtin_bit_cast(float, w << 16); }
__device__ __forceinline__ float bfhi(unsigned w) { return __builtin_bit_cast(float, w & 0xffff0000u); }
__device__ __forceinline__ float wave_sum(float v) {
#pragma unroll
  for (int o = 1; o < 64; o <<= 1) v += __shfl_xor(v, o);
  return v;
}
__device__ __forceinline__ float sigmoidf_(float x) { return __builtin_amdgcn_rcpf(1.f + __builtin_amdgcn_exp2f(x * -1.44269504089f)); }
__device__ __forceinline__ float gelu_erf(float x) { return 0.5f * x * (1.f + erff(x * 0.70710678118654752f)); }
__device__ __forceinline__ float gelu_fast(float v) {
    const float av = fabsf(v), t = __builtin_amdgcn_rcpf(av * 0.2316418882f + 1.0f);
    float q = t * 0.5307027145f + (-0.7265760135f); q = q * t + 0.7107068705f; q = q * t + (-0.142248368f); q = q * t + 0.127414796f; q = q * t;
    const float e = __builtin_amdgcn_exp2f((v * v) * (-0.72134752044f));
    const float m = v * (q * e);
    return v < 0.f ? m : v - m;
}
__device__ __forceinline__ float softplusf_(float x) { return fmaxf(x, 0.f) + log1pf(expf(-fabsf(x))); }

namespace pg8 {
#define PG8_LAS __attribute__((address_space(3)))
typedef unsigned short bf16_t;
typedef unsigned u32x4 __attribute__((ext_vector_type(4)));
constexpr int BM = 256, BK = 64, HALF = 128, HTB = HALF * BK * 2, STAGE_BYTES = 8 * HTB, NXCD = 8;

__host__ __device__ __forceinline__ int lds_byte(int r, int c) { const int st = (r >> 4) * 2 + (c >> 5), rr = r & 15, cc = c & 31, ob = rr * 64 + cc * 2; return st * 1024 + (ob ^ (((ob >> 9) & 1) << 5)); }
__host__ __device__ __forceinline__ void stage_rc(int b, int& R, int& C) { const int st = b / 1024, sb = b % 1024, swz = sb ^ (((sb >> 9) & 1) << 5); R = (st >> 1) * 16 + swz / 64; C = (st & 1) * 32 + (swz % 64) / 2; }
__host__ __device__ __forceinline__ int perm32(int rho) { const int n = rho >> 4, i = rho & 15; return 8 * (i >> 2) + 4 * n + (i & 3); }

struct Unit { int pm, pn; };
struct StaticOrder {
    int nM, nN, nwg, G, c, WGM;
    __host__ __device__ void init(int M, int N, int G_, int c_, int wgm = 8) { nM = M / BM; nN = N / BM; nwg = nM * nN; G = G_; c = c_; WGM = wgm; }
    __host__ __device__ bool next(int i, Unit& u) const {
        const long L = (long)i * G + c; if (L >= nwg) return false;
        int wgid = (int)L; { const int q = nwg / NXCD, r = nwg % NXCD, xcd = wgid % NXCD, off = wgid / NXCD; wgid = (xcd < r ? xcd * (q + 1) : r * (q + 1) + (xcd - r) * q) + off; }
        const int nig = WGM * nN, gid = wgid / nig, fm = gid * WGM, gsz = (nM - fm) < WGM ? (nM - fm) : WGM;
        u.pm = fm + ((wgid % nig) % gsz); u.pn = (wgid % nig) / gsz; return true;
    }
};

__device__ __forceinline__ unsigned cvt_pk_bf16(float lo, float hi) { unsigned r; asm volatile("v_cvt_pk_bf16_f32 %0, %1, %2" : "=v"(r) : "v"(lo), "v"(hi)); return r; }

template <class Epi, class Addr>
__device__ __forceinline__ void gemm_phase(PG8_LAS unsigned char* lds, const Addr g, const StaticOrder& S, const Epi& E) {
    const int tid = threadIdx.x, wid = __builtin_amdgcn_readfirstlane(tid >> 6), lane = tid & 63, wr = wid >> 2, wc = wid & 3, fr = lane & 15, fq = lane >> 4;
    const int K = g.K, nt = K / BK;
    unsigned voffA[2], voffB[2];
#pragma unroll
    for (int i = 0; i < 2; ++i) { int R, C; stage_rc(tid * 16 + i * 8192, R, C); const int Rb = Epi::PERM ? ((R & ~31) + perm32(R & 31)) : R;
        voffA[i] = (unsigned)(R * g.lda + C) * 2u; voffB[i] = (unsigned)(Rb * g.ldb + C) * 2u; }
    const size_t kstep = (size_t)(BK * 2);
    const size_t hsA = (size_t)HALF * g.lda * 2, hsB = (size_t)HALF * g.ldb * 2;
    const unsigned ldsw = (unsigned)wid * 1024u;
    const int aoff = lds_byte(wr * 64 + fr, fq * 8), boff = lds_byte(wc * 32 + fr, fq * 8);
#define PG8_SA(b, h) (((b) * 2 + (h)) * HTB)
#define PG8_SB(b, h) ((4 + (b) * 2 + (h)) * HTB)
#define PG8_STAGE(bufoff, gbase, voff) do { _Pragma("unroll") for (int _i = 0; _i < 2; ++_i) \
        __builtin_amdgcn_global_load_lds((const unsigned*)((const char*)(gbase) + (voff)[_i]), (PG8_LAS unsigned*)(lds + (bufoff) + ldsw + _i * 8192), 16, 0, 0); } while (0)
#define PG8_LDA(dst, b, h) do { _Pragma("unroll") for (int m = 0; m < 4; ++m) _Pragma("unroll") for (int k = 0; k < 2; ++k) dst[m][k] = *(const PG8_LAS bf16x8*)(lds + PG8_SA(b, h) + aoff + m * 2048 + k * 1024); } while (0)
#define PG8_LDB(dst, b, h) do { _Pragma("unroll") for (int n = 0; n < 2; ++n) _Pragma("unroll") for (int k = 0; k < 2; ++k) dst[n][k] = *(const PG8_LAS bf16x8*)(lds + PG8_SB(b, h) + boff + n * 2048 + k * 1024); } while (0)
#define PG8_MMA(ai, bj, At, Bt) do { __builtin_amdgcn_s_setprio(1); _Pragma("unroll") for (int m = 0; m < 4; ++m) _Pragma("unroll") for (int n = 0; n < 2; ++n) _Pragma("unroll") for (int k = 0; k < 2; ++k) \
        acc[ai][bj][m][n] = __builtin_amdgcn_mfma_f32_16x16x32_bf16(Bt[n][k], At[m][k], acc[ai][bj][m][n], 0, 0, 0); __builtin_amdgcn_s_setprio(0); } while (0)
#define PG8_WAIT_V(n) asm volatile("s_waitcnt vmcnt(" #n ")" ::: "memory")
#define PG8_WAIT_L(n) asm volatile("s_waitcnt lgkmcnt(" #n ")" ::: "memory")
#define PG8_BAR __builtin_amdgcn_s_barrier()
#define PG8_SCHED __builtin_amdgcn_sched_barrier(0)
    Unit cur, nxt; int ui = 0;
    if (!S.next(0, cur)) return;
    f32x4 acc[2][2][4][2];
#pragma unroll
    for (int a = 0; a < 2; ++a)
#pragma unroll
        for (int b = 0; b < 2; ++b)
#pragma unroll
            for (int m = 0; m < 4; ++m)
#pragma unroll
                for (int n = 0; n < 2; ++n) acc[a][b][m][n] = (f32x4){0.f, 0.f, 0.f, 0.f};
    bf16x8 At[4][2], B0[2][2], B1[2][2];
    const char* cA = g.a(cur); const char* cB = g.b(cur);
    PG8_STAGE(PG8_SB(0, 0), cB, voffB); PG8_STAGE(PG8_SB(0, 1), cB + hsB, voffB); PG8_STAGE(PG8_SA(0, 0), cA, voffA); PG8_STAGE(PG8_SA(0, 1), cA + hsA, voffA);
    if (wr == 1) PG8_BAR;
    PG8_WAIT_V(2); PG8_BAR;
    PG8_STAGE(PG8_SB(1, 0), cB + kstep, voffB); PG8_STAGE(PG8_SA(1, 0), cA + kstep, voffA); PG8_STAGE(PG8_SB(1, 1), cB + hsB + kstep, voffB);
    PG8_WAIT_V(6); PG8_BAR;
    for (;;) {
        const bool has_next = S.next(ui + 1, nxt);
        const char* nA = has_next ? g.a(nxt) : cA; const char* nB = has_next ? g.b(nxt) : cB;
#pragma unroll 1
        for (int t = 0; t < nt; t += 2) {
            const bool last = (t == nt - 2);
            const char* a1 = cA + (size_t)(t + 1) * kstep;
            const char* a2 = last ? nA : cA + (size_t)(t + 2) * kstep; const char* b2 = last ? nB : cB + (size_t)(t + 2) * kstep;
            const char* a3 = a2 + kstep; const char* b3 = b2 + kstep;
            PG8_LDB(B0, 0, 0); PG8_LDB(B1, 0, 1); PG8_SCHED; PG8_LDA(At, 0, 0); PG8_STAGE(PG8_SA(1, 1), a1 + hsA, voffA);
            PG8_WAIT_V(8); PG8_WAIT_L(0); PG8_BAR; PG8_MMA(0, 0, At, B0); PG8_MMA(0, 1, At, B1); PG8_BAR; PG8_SCHED;
            PG8_LDA(At, 0, 1); PG8_STAGE(PG8_SB(0, 0), b2, voffB); PG8_STAGE(PG8_SB(0, 1), b2 + hsB, voffB); PG8_STAGE(PG8_SA(0, 0), a2, voffA);
            PG8_WAIT_V(8); PG8_WAIT_L(0); PG8_BAR; PG8_MMA(1, 0, At, B0); PG8_MMA(1, 1, At, B1); PG8_BAR; PG8_SCHED;
            PG8_LDB(B0, 1, 0); PG8_LDB(B1, 1, 1); PG8_SCHED; PG8_LDA(At, 1, 0); PG8_STAGE(PG8_SA(0, 1), a2 + hsA, voffA);
            PG8_WAIT_V(8); PG8_WAIT_L(0); PG8_BAR; PG8_MMA(0, 0, At, B0); PG8_MMA(0, 1, At, B1); PG8_BAR; PG8_SCHED;
            PG8_LDA(At, 1, 1); PG8_STAGE(PG8_SB(1, 0), b3, voffB); PG8_STAGE(PG8_SB(1, 1), b3 + hsB, voffB); PG8_STAGE(PG8_SA(1, 0), a3, voffA);
            PG8_WAIT_V(8); PG8_WAIT_L(0); PG8_BAR; PG8_MMA(1, 0, At, B0); PG8_MMA(1, 1, At, B1); PG8_BAR; PG8_SCHED;
        }
        if (wr == 0) PG8_BAR;
        E(acc, cur, wr, wc, fr, fq);
        if (!has_next) break;
#pragma unroll
        for (int a = 0; a < 2; ++a)
#pragma unroll
            for (int b = 0; b < 2; ++b)
#pragma unroll
                for (int m = 0; m < 4; ++m)
#pragma unroll
                    for (int n = 0; n < 2; ++n) acc[a][b][m][n] = (f32x4){0.f, 0.f, 0.f, 0.f};
        cur = nxt; cA = nA; cB = nB; ++ui;
        if (wr == 1) PG8_BAR;
    }
    PG8_WAIT_V(0);
    PG8_BAR;
#undef PG8_SA
#undef PG8_SB
#undef PG8_STAGE
#undef PG8_LDA
#undef PG8_LDB
#undef PG8_MMA
#undef PG8_WAIT_V
#undef PG8_WAIT_L
#undef PG8_BAR
#undef PG8_SCHED
}
}

#define XB_TMO      128
#define XB_XCNT(j)  (256  + 64 * (j))
#define XB_XSUB(j)  (1280 + 64 * (j))
#define XB_XGEN(j)  (2304 + 64 * (j))
#define XB_TOP      3328
#define XB_TOPGEN   3392
#define XCD_BAR_WORDS 3456
#define XB_SPIN_CAP (1u << 18)
__device__ __forceinline__ unsigned xb_ld(unsigned* p)              { return __hip_atomic_load(p, __ATOMIC_RELAXED, __HIP_MEMORY_SCOPE_AGENT); }
__device__ __forceinline__ unsigned xb_add(unsigned* p, unsigned v) { return __hip_atomic_fetch_add(p, v, __ATOMIC_RELAXED, __HIP_MEMORY_SCOPE_AGENT); }
__device__ __forceinline__ unsigned xb_xcc_id() { return (unsigned)__builtin_amdgcn_s_getreg((3 << 11) | 20) & 0xFu; }
#define XB_SPIN(cond, bar) do { unsigned _sp = 0; while (cond) { __builtin_amdgcn_s_sleep(1); \
    if ((++_sp & 255u) == 0u) { if (xb_ld(&(bar)[XB_TMO])) break; if (_sp > XB_SPIN_CAP) { atomicAdd(&(bar)[XB_TMO], 1u); break; } } } } while (0)
struct XcdBarrier { unsigned* bar; unsigned x; volatile LAS unsigned* st; };
__device__ __forceinline__ XcdBarrier xcd_barrier_post(unsigned* bar, volatile LAS unsigned* st) {
    XcdBarrier b; b.bar = bar; b.x = xb_xcc_id(); b.st = st;
    if (threadIdx.x == 0) (void)xb_add(&bar[XB_XCNT(b.x)], 1u);
    return b;
}
__device__ __forceinline__ void xcd_barrier_complete(unsigned* bar, unsigned x, unsigned& nloc, unsigned& nx) {
    const unsigned G = gridDim.x * gridDim.y * gridDim.z;
    unsigned sum, cnt, mine, sp = 0u;
    for (;;) {
        sum = 0u; cnt = 0u; mine = 0u;
#pragma unroll
        for (unsigned j = 0; j < 16; ++j) { const unsigned c = xb_ld(&bar[XB_XCNT(j)]); sum += c; cnt += (c > 0u) ? 1u : 0u; mine = (j == x) ? c : mine; }
        if (sum == G) break;
        __builtin_amdgcn_s_sleep(1);
        if ((++sp & 255u) == 0u) { if (xb_ld(&bar[XB_TMO])) break; if (sp > XB_SPIN_CAP) { atomicAdd(&bar[XB_TMO], 1u); break; } }
    }
    nloc = mine > 0u ? mine : 1u; nx = cnt > 0u ? cnt : 1u;
}
__device__ __forceinline__ void xcd_barrier(const XcdBarrier& b) {
    asm volatile("s_waitcnt vmcnt(0)" ::: "memory");
    __syncthreads();
    if (threadIdx.x == 0) {
        unsigned* bar = b.bar;
        __builtin_amdgcn_s_waitcnt(0);
        unsigned nloc = b.st[0], nx = b.st[1];
        if (nloc == 0u) { xcd_barrier_complete(bar, b.x, nloc, nx); b.st[0] = nloc; b.st[1] = nx; }
        const unsigned old = xb_add(&bar[XB_XSUB(b.x)], 1u);
        const unsigned gen = old / nloc;
        if (old + 1u == (gen + 1u) * nloc) {
            __builtin_amdgcn_fence(__ATOMIC_RELEASE, "agent");
            asm volatile("s_waitcnt vmcnt(0)" ::: "memory");
            const unsigned og = xb_add(&bar[XB_TOP], 1u);
            const unsigned tg = og / nx;
            if (og + 1u == (tg + 1u) * nx) xb_add(&bar[XB_TOPGEN], 1u);
            else XB_SPIN(xb_ld(&bar[XB_TOPGEN]) == tg, bar);
            __builtin_amdgcn_fence(__ATOMIC_ACQUIRE, "agent");
            xb_add(&bar[XB_XGEN(b.x)], 1u);
            asm volatile("s_waitcnt vmcnt(0)" ::: "memory");
        } else {
            XB_SPIN(xb_ld(&bar[XB_XGEN(b.x)]) == gen, bar);
            __builtin_amdgcn_fence(__ATOMIC_ACQUIRE, "agent");
            asm volatile("s_waitcnt vmcnt(0)" ::: "memory");
        }
    }
    __syncthreads();
}

struct Args { const float* in[26]; float* out; unsigned char* ws; int ph_lo, ph_hi; };
struct Frame {
    LAS unsigned char* lds;
    int tid, lane, wave, G, bid;
    const float* const* in; float* out; unsigned char* ws;
};

__device__ __forceinline__ void tr_item(const float* W, int ldw, bf16* WT, int ldt, float scale, const float* kscale, LAS float* scr, int k0, int lane) {
#pragma unroll 8
    for (int i = 0; i < 32; ++i) { const int kk = 2 * i + (lane >> 5); float v = W[(size_t)(k0 + kk) * ldw + (lane & 31)] * scale; if (kscale) v *= kscale[k0 + kk]; scr[kk * 33 + (lane & 31)] = v; }
    LDS_WAIT(); asm volatile("" ::: "memory");
    const int c = lane & 7;
#pragma unroll
    for (int j = 0; j < 4; ++j) { const int n = (lane >> 3) + 8 * j; const LAS float* s = scr + (8 * c) * 33 + n;
        v4u o; o.x = pk2(s[0 * 33], s[1 * 33]); o.y = pk2(s[2 * 33], s[3 * 33]); o.z = pk2(s[4 * 33], s[5 * 33]); o.w = pk2(s[6 * 33], s[7 * 33]);
        *(GAS v4u*)(WT + (size_t)n * ldt + k0 + 8 * c) = o; }
    LDS_WAIT(); asm volatile("" ::: "memory");
}

__device__ __forceinline__ void p0_prologue(Frame& F) {
    LAS float* scr = (LAS float*)(F.lds + F.wave * 16384);
    const int gw = F.bid * NWAVES + F.wave, NGW = F.G * NWAVES;
    unsigned char* ws = F.ws;
    const float* w_in = F.in[2];
    constexpr int I_WIN = 16 * 192, I_QKV = 12 * 32, I_LRU = 32 * 8, I_WB = 2 * 512, I_WO = 2 * 512, I_PQ = 16 * 64;
    constexpr int NITEMS = I_WIN + I_QKV + I_LRU + I_WB + I_WO + I_PQ;
    for (int it = gw; it < NITEMS; it += NGW) {
        int r = it;
        if (r < I_WIN) { const int kb = r / 192, nb = r % 192, n0 = nb * 32, sc = n0 < 2048 ? n0 : n0 + 16;
            tr_item(w_in + sc, DIN, (bf16*)(ws + WS_WIN) + (size_t)n0 * 1024, 1024, 1.f, nullptr, scr, kb * 64, F.lane); continue; }
        r -= I_WIN;
        if (r < I_QKV) { const int mat = r / 32, rr = r % 32, kb = rr / 8, nb = rr % 8, g = mat >> 2, h = mat & 3;
            const float* W = F.in[6 + g] + (size_t)h * 65536 + nb * 32;
            tr_item(W, 256, (bf16*)(ws + WS_WQKV) + (size_t)mat * 65536 + (size_t)(nb * 32) * 256, 256, g == 1 ? 0.0625f : 1.f, nullptr, scr, kb * 64, F.lane); continue; }
        r -= I_QKV;
        if (r < I_LRU) { const int mat = r / 8, rr = r % 8, kb = rr / 4, nb = rr % 4, gate = mat & 1, db = mat >> 1;
            const float* W = F.in[gate ? 14 : 12] + (size_t)db * 16384 + nb * 32;
            tr_item(W, 128, (bf16*)(ws + WS_WLRU) + (size_t)mat * 16384 + (size_t)(nb * 32) * 128, 128, 1.f, nullptr, scr, kb * 64, F.lane); continue; }
        r -= I_LRU;
        if (r < I_WB) { const int mat = r / 512, rr = r % 512, kb = rr / 32, nb = rr % 32;
            const float* W = F.in[17 + mat] + nb * 32;
            tr_item(W, 1024, (bf16*)(ws + WS_WB2) + (size_t)(mat * 1024 + nb * 32) * 1024, 1024, 1.f, nullptr, scr, kb * 64, F.lane); continue; }
        r -= I_WB;
        if (r < I_WO) { const int cp = r / 512, rr = r % 512, kb = rr / 32, nb = rr % 32;
            const float* W = F.in[19] + nb * 32;
            tr_item(W, 1024, (bf16*)(ws + WS_WOUT2) + (size_t)(nb * 32) * 2048 + cp * 1024, 2048, 1.f, nullptr, scr, kb * 64, F.lane); continue; }
        r -= I_WO;
        { const int kb = r / 64, nb = r % 64;
            const float* W = F.in[21] + nb * 32;
            tr_item(W, 2048, (bf16*)(ws + WS_WPQ) + (size_t)(nb * 32) * 1024, 1024, 1.f, F.in[20], scr, kb * 64, F.lane); }
    }
    { const int gt = F.bid * NTHR + F.tid, NGT = F.G * NTHR;
      const float4* ks = (const float4*)F.in[22]; v2u* kd = (v2u*)(ws + WS_KEYS);
      for (int i = gt; i < 8 * 2 * 128 * 128 / 4; i += NGT) { const float4 v = ks[i]; v2u o; o.x = pk2(v.x, v.y); o.y = pk2(v.z, v.w); kd[i] = o; }
      float* ss = (float*)(ws + WS_SS);
      for (int i = gt; i < MTOK; i += NGT) ss[i] = 0.f; }
    { const int gt = F.bid * NTHR + F.tid;
      if (gt < 16 * 128) { const int c = gt >> 7, k8 = gt & 127; v4u o; unsigned wv[4];
#pragma unroll
          for (int j = 0; j < 4; ++j) wv[j] = pk2(w_in[(size_t)(k8 * 8 + 2 * j) * DIN + 2048 + c], w_in[(size_t)(k8 * 8 + 2 * j + 1) * DIN + 2048 + c]);
          o.x = wv[0]; o.y = wv[1]; o.z = wv[2]; o.w = wv[3]; *(v4u*)((bf16*)(ws + WS_WGT) + c * 1024 + k8 * 8) = o; } }
    const float* x = F.in[0]; const float* g1 = F.in[1];
    bf16* XN = (bf16*)(ws + WS_K);
    f32x4 gv[4];
#pragma unroll
    for (int j = 0; j < 4; ++j) gv[j] = ((const f32x4*)g1)[F.lane + 64 * j];
    for (int m = 2 * gw; m < MTOK; m += 2 * NGW) {
        const f32x4* xr0 = (const f32x4*)(x + (size_t)m * DM) + F.lane; const f32x4* xr1 = xr0 + DM / 4;
        f32x4 v0[4], v1[4]; float s0 = 0.f, s1 = 0.f;
#pragma unroll
        for (int j = 0; j < 4; ++j) { v0[j] = xr0[64 * j]; v1[j] = xr1[64 * j]; }
#pragma unroll
        for (int j = 0; j < 4; ++j) { s0 += (v0[j].x * v0[j].x + v0[j].y * v0[j].y) + (v0[j].z * v0[j].z + v0[j].w * v0[j].w); s1 += (v1[j].x * v1[j].x + v1[j].y * v1[j].y) + (v1[j].z * v1[j].z + v1[j].w * v1[j].w); }
        const float r0 = rsqrtf(wave_sum(s0) * (1.f / DM) + EPS), r1 = rsqrtf(wave_sum(s1) * (1.f / DM) + EPS);
        unsigned long long* o0 = (unsigned long long*)(XN + (size_t)m * DM) + F.lane; unsigned long long* o1 = o0 + DM / 4;
#pragma unroll
        for (int j = 0; j < 4; ++j) { const f32x4 a = v0[j] * r0 * gv[j], c = v1[j] * r1 * gv[j];
            o0[64 * j] = (unsigned long long)pk2(a.x, a.y) | ((unsigned long long)pk2(a.z, a.w) << 32);
            o1[64 * j] = (unsigned long long)pk2(c.x, c.y) | ((unsigned long long)pk2(c.z, c.w) << 32); }
    }
}
__device__ __forceinline__ void gates_phase(Frame& F) {
    const bf16* XN = (const bf16*)(F.ws + WS_K); const bf16* WGT = (const bf16*)(F.ws + WS_WGT); float* GT = (float*)(F.ws + WS_GATE);
    const int lane = F.lane, fr = lane & 15, fq = lane >> 4;
    const f32x4 bg4 = *(const f32x4*)(F.in[3] + 4 * fq);
    for (int task = F.bid * NWAVES + F.wave; task < MTOK / 16; task += F.G * NWAVES) {
        const size_t m0 = (size_t)task * 16;
        f32x4 acc = (f32x4){0.f, 0.f, 0.f, 0.f};
#pragma unroll 8
        for (int ks = 0; ks < 32; ++ks) {
            const bf16x8 wfr = *(const bf16x8*)(WGT + fr * 1024 + 32 * ks + 8 * fq);
            const bf16x8 xfr = *(const bf16x8*)(XN + (m0 + fr) * DM + 32 * ks + 8 * fq);
            acc = __builtin_amdgcn_mfma_f32_16x16x32_bf16(wfr, xfr, acc, 0, 0, 0);
        }
        *(f32x4*)(GT + (m0 + fr) * 16 + 4 * fq) = acc + bg4;
    }
}

struct AddrPlain {
    const char* A; const char* Bt; int lda, ldb, K;
    __device__ __forceinline__ const char* a(const pg8::Unit& u) const { return A + (size_t)u.pm * 256 * lda * 2; }
    __device__ __forceinline__ const char* b(const pg8::Unit& u) const { return Bt + (size_t)u.pn * 256 * ldb * 2; }
};
struct AddrQKV {
    const char* XC; long dXM; const char* W; int lda, ldb, K;
    __device__ __forceinline__ const char* a(const pg8::Unit& u) const { return XC + (u.pn < 8 ? 0l : dXM) + ((size_t)u.pm * 256 * 1024 + (u.pn & 3) * 256) * 2; }
    __device__ __forceinline__ const char* b(const pg8::Unit& u) const { return W + (size_t)u.pn * 65536 * 2; }
};
struct AddrBranch {
    const char* YM; long dYL; const char* W; int lda, ldb, K;
    __device__ __forceinline__ const char* a(const pg8::Unit& u) const { return YM + (u.pn < 4 ? 0l : dYL) + (size_t)u.pm * 256 * 1024 * 2; }
    __device__ __forceinline__ const char* b(const pg8::Unit& u) const { return W + (size_t)u.pn * 256 * 1024 * 2; }
};

struct DstP1 { unsigned char* ws;
    __device__ __forceinline__ bf16* get(int pn, int& ld, int& col0) const {
        const bool mg = pn >= 16; ld = mg ? 2048 : 1024; col0 = mg ? (pn - 16) * 256 : (pn & 3) * 256;
        return (bf16*)(ws + (mg ? WS_MG : WS_XM + (size_t)(pn >> 2) * 64 * MiB)); } };
struct DstQKV { char* q; long dk, dv;
    __device__ __forceinline__ bf16* get(int pn, int& ld, int& col0) const { ld = 1024; col0 = (pn & 3) * 256; return (bf16*)(q + (pn >= 4 ? (pn >= 8 ? dv : dk) : 0l)); } };
template <class Dst> struct EpiBf16 {
    static constexpr bool PERM = true;
    Dst dst;
    __device__ __forceinline__ void operator()(const f32x4 (&acc)[2][2][4][2], const pg8::Unit& u, int wr, int wc, int fr, int fq) const {
        int ld, colt; bf16* base = dst.get(u.pn, ld, colt);
        const int row0 = u.pm * 256 + wr * 64 + fr, col0 = colt + wc * 32 + 8 * fq;
#pragma unroll
        for (int ai = 0; ai < 2; ++ai)
#pragma unroll
            for (int m = 0; m < 4; ++m) { bf16* rowp = base + (size_t)(row0 + ai * 128 + m * 16) * ld + col0;
#pragma unroll
                for (int bj = 0; bj < 2; ++bj) { const f32x4 v0 = acc[ai][bj][m][0], v1 = acc[ai][bj][m][1];
                    v4u w; w.x = pg8::cvt_pk_bf16(v0[0], v0[1]); w.y = pg8::cvt_pk_bf16(v0[2], v0[3]); w.z = pg8::cvt_pk_bf16(v1[0], v1[1]); w.w = pg8::cvt_pk_bf16(v1[2], v1[3]);
                    *(v4u*)(rowp + bj * 128) = w; } }
    }
};
template <bool ADD> struct EpiMerge {
    static constexpr bool PERM = true;
    bf16* MRG; const bf16* MG; int gcol;
    __device__ __forceinline__ void operator()(const f32x4 (&acc)[2][2][4][2], const pg8::Unit& u, int wr, int wc, int fr, int fq) const {
        const int row0 = u.pm * 256 + wr * 64 + fr, col0 = u.pn * 256 + wc * 32 + 8 * fq;
#pragma unroll
        for (int ai = 0; ai < 2; ++ai)
#pragma unroll
            for (int m = 0; m < 4; ++m) { const size_t row = (size_t)(row0 + ai * 128 + m * 16); bf16* rowp = MRG + row * 1024 + col0; const bf16* gp = MG + row * 2048 + gcol + col0;
#pragma unroll
                for (int bj = 0; bj < 2; ++bj) { const f32x4 v0 = acc[ai][bj][m][0], v1 = acc[ai][bj][m][1];
                    const v4u g = *(const v4u*)(gp + bj * 128);
                    float o[8] = {v0[0] * sigmoidf_(bflo(g.x)), v0[1] * sigmoidf_(bfhi(g.x)), v0[2] * sigmoidf_(bflo(g.y)), v0[3] * sigmoidf_(bfhi(g.y)),
                                  v1[0] * sigmoidf_(bflo(g.z)), v1[1] * sigmoidf_(bfhi(g.z)), v1[2] * sigmoidf_(bflo(g.w)), v1[3] * sigmoidf_(bfhi(g.w))};
                    if (ADD) { const v4u t = *(const v4u*)(rowp + bj * 128);
                        o[0] += bflo(t.x); o[1] += bfhi(t.x); o[2] += bflo(t.y); o[3] += bfhi(t.y); o[4] += bflo(t.z); o[5] += bfhi(t.z); o[6] += bflo(t.w); o[7] += bfhi(t.w); }
                    v4u w; w.x = pg8::cvt_pk_bf16(o[0], o[1]); w.y = pg8::cvt_pk_bf16(o[2], o[3]); w.z = pg8::cvt_pk_bf16(o[4], o[5]); w.w = pg8::cvt_pk_bf16(o[6], o[7]);
                    *(v4u*)(rowp + bj * 128) = w; } }
    }
};
struct EpiResid {
    static constexpr bool PERM = false;
    const float* x; float* x1; bf16* x1b; float* ss;
    __device__ __forceinline__ void operator()(const f32x4 (&acc)[2][2][4][2], const pg8::Unit& u, int wr, int wc, int fr, int fq) const {
        const int row0 = u.pm * 256 + wr * 64 + fr, col0 = u.pn * 256 + wc * 32 + 4 * fq;
#pragma unroll
        for (int ai = 0; ai < 2; ++ai)
#pragma unroll
            for (int m = 0; m < 4; ++m) { const int row = row0 + ai * 128 + m * 16; const size_t off = (size_t)row * DM + col0; float s = 0.f;
#pragma unroll
                for (int bj = 0; bj < 2; ++bj)
#pragma unroll
                    for (int n = 0; n < 2; ++n) { const size_t o = off + bj * 128 + n * 16; const f32x4 v = *(const f32x4*)(x + o) + acc[ai][bj][m][n];
                        *(f32x4*)(x1 + o) = v; v2u w; w.x = pg8::cvt_pk_bf16(v[0], v[1]); w.y = pg8::cvt_pk_bf16(v[2], v[3]); *(v2u*)(x1b + o) = w;
                        s += (v[0] * v[0] + v[1] * v[1]) + (v[2] * v[2] + v[3] * v[3]); }
                s += __shfl_xor(s, 16); s += __shfl_xor(s, 32);
                if (fq == 0) atomicAdd(ss + row, s); }
    }
};
struct EpiPQ {
    static constexpr bool PERM = true;
    bf16* pq; const float* ss;
    __device__ __forceinline__ void operator()(const f32x4 (&acc)[2][2][4][2], const pg8::Unit& u, int wr, int wc, int fr, int fq) const {
        const int row0 = u.pm * 256 + wr * 64 + fr, col0 = u.pn * 256 + wc * 32 + 8 * fq;
#pragma unroll
        for (int ai = 0; ai < 2; ++ai)
#pragma unroll
            for (int m = 0; m < 4; ++m) { const int row = row0 + ai * 128 + m * 16; bf16* rowp = pq + (size_t)row * 2048 + col0;
                const float r = rsqrtf(ss[row] * (1.f / DM) + EPS);
#pragma unroll
                for (int bj = 0; bj < 2; ++bj) { const f32x4 v0 = acc[ai][bj][m][0] * r, v1 = acc[ai][bj][m][1] * r;
                    v4u w; w.x = pg8::cvt_pk_bf16(v0[0], v0[1]); w.y = pg8::cvt_pk_bf16(v0[2], v0[3]); w.z = pg8::cvt_pk_bf16(v1[0], v1[1]); w.w = pg8::cvt_pk_bf16(v1[2], v1[3]);
                    *(v4u*)(rowp + bj * 128) = w; } }
    }
};

template <bool PB> __device__ __forceinline__ void lru_phase(Frame& F) {
    const bf16* XL = (const bf16*)(F.ws + WS_XL); const bf16* LG = (const bf16*)(F.ws + WS_LG); bf16* YL = (bf16*)F.out;
    f32x2* AGG = (f32x2*)(F.ws + WS_AGG);
    const bf16* WL = (const bf16*)(F.ws + WS_WLRU);
    const float* cw = F.in[10]; const float* cb = F.in[11];
    constexpr int O_XCB = 0, O_XCF = 17408, O_A = 51200, O_U = 84992, FST = 528;
    LAS unsigned char* L = F.lds;
    const int tid = F.tid, lane = F.lane, w = F.wave, fr = lane & 15, fq = lane >> 4;
    int cur_blk = -1;
    bf16x8 wf[2][2][4];
    f32x4 br4[2], bi4[2], sp4[2];
    v4u rawreg[3];
#define RAW_LOAD(bb, tt0, bk) do { _Pragma("unroll") for (int r_ = 0; r_ < 3; ++r_) { const int e_ = tid + NTHR * r_, row_ = e_ >> 4, c16_ = e_ & 15, t_ = (tt0) - 2 + row_; \
            v4u v_ = {0u, 0u, 0u, 0u}; if (e_ < 68 * 16 && t_ >= 0 && t_ < SEQ) v_ = *(const v4u*)(XL + ((size_t)(bb) * SEQ + t_) * DM + (bk) * 128 + c16_ * 8); rawreg[r_] = v_; } } while (0)
    constexpr int O_CARRY = 118784, O_CW = 135168, O_SUB = 137728;
    const bool carry_tab = PB && (F.G == 256);
    if (carry_tab) {
        const int ch = tid & 127, bq = tid >> 7, s0 = F.bid >> 3, blk0 = F.bid & 7;
        LAS float* CT = (LAS float*)(L + O_CARRY);
#define FOLD(agp, j0, j1, stp, hv) do { int js_ = (j0); const int n_ = ((j1) - (j0)) * (stp); int k_ = 0; \
            for (; k_ + 8 <= n_; k_ += 8) { f32x2 ah_[8]; _Pragma("unroll") for (int q_ = 0; q_ < 8; ++q_) ah_[q_] = (agp)[(size_t)(js_ + q_ * (stp)) * 2 * DM]; \
                _Pragma("unroll") for (int q_ = 0; q_ < 8; ++q_) hv = ah_[q_][0] * hv + ah_[q_][1]; js_ += 8 * (stp); } \
            for (; k_ < n_; ++k_) { const f32x2 a1_ = (agp)[(size_t)js_ * 2 * DM]; hv = a1_[0] * hv + a1_[1]; js_ += (stp); } } while (0)
        for (int bb = 2 * bq; bb < 2 * bq + 2; ++bb) {
            const f32x2* ag0 = AGG + ((size_t)(bb * 64) * 2 + 0) * DM + blk0 * 128 + ch; const f32x2* ag1 = AGG + ((size_t)(bb * 64) * 2 + 1) * DM + blk0 * 128 + ch;
            float h = 0.f;
            FOLD(ag0, 0, s0, 1, h); CT[((bb * 2 + 0) * 2 + 0) * 128 + ch] = h;
            FOLD(ag0, s0, s0 + 32, 1, h); CT[((bb * 2 + 1) * 2 + 0) * 128 + ch] = h;
            h = 0.f;
            FOLD(ag1, 63, s0 + 32, -1, h); CT[((bb * 2 + 1) * 2 + 1) * 128 + ch] = h;
            FOLD(ag1, s0 + 32, s0, -1, h); CT[((bb * 2 + 0) * 2 + 1) * 128 + ch] = h;
        }
        __syncthreads();
#undef FOLD
    }
    for (int i = 0;; ++i) {
        const int idx = i * F.G + F.bid; if (idx >= 4096) break;
        const int blk = idx & 7, j = idx >> 3, b = j >> 6, seg = j & 63, t0 = seg * 64;
        const size_t mrow0 = (size_t)b * SEQ + t0;
        if (blk != cur_blk) {
            cur_blk = blk;
#pragma unroll
            for (int d = 0; d < 2; ++d) {
#pragma unroll
                for (int g = 0; g < 2; ++g)
#pragma unroll
                    for (int ks = 0; ks < 4; ++ks)
                        wf[d][g][ks] = *(const bf16x8*)(WL + ((size_t)((d * 8 + blk) * 2 + g) * 128 + 16 * w + fr) * 128 + 32 * ks + 8 * fq);
                const int ch = blk * 128 + 16 * w + 4 * fq;
                br4[d] = *(const f32x4*)(F.in[13] + d * DM + ch); bi4[d] = *(const f32x4*)(F.in[15] + d * DM + ch);
                const f32x4 lm = *(const f32x4*)(F.in[16] + d * DM + ch);
#pragma unroll
                for (int e = 0; e < 4; ++e) sp4[d][e] = -8.f * 1.44269504089f * softplusf_(-lm[e]);
            }
            __syncthreads();
            for (int e = tid; e < 5 * 128; e += NTHR) { const int jt = e >> 7, cc = e & 127; ((LAS float*)(L + O_CW))[e] = (jt < 4) ? cw[jt * DM + blk * 128 + cc] : cb[blk * 128 + cc]; }
        }
        if (i == 0) RAW_LOAD(b, t0, blk);
#pragma unroll
        for (int r = 0; r < 3; ++r) { const int e = tid + NTHR * r; if (e < 68 * 16) *(LAS v4u*)(L + O_A + (e >> 4) * 256 + (e & 15) * 16) = rawreg[r]; }
        __syncthreads();
        { const int idx2 = (i + 1) * F.G + F.bid; if (idx2 < 4096) { const int j2 = idx2 >> 3; RAW_LOAD(j2 >> 6, (j2 & 63) * 64, idx2 & 7); } }
        v4u lgreg[2];
        if (PB) {
#pragma unroll
            for (int r = 0; r < 2; ++r) { const int e = tid + NTHR * r; lgreg[r] = *(const v4u*)(LG + (mrow0 + (e >> 4)) * DM + blk * 128 + (e & 15) * 8); } }
        for (int e = tid; e < 64 * 16; e += NTHR) { const int tl = e >> 4, c16 = e & 15;
            float y[8];
            { const f32x4 a = *(const LAS f32x4*)(L + O_CW + 4 * 512 + c16 * 32), bq = *(const LAS f32x4*)(L + O_CW + 4 * 512 + c16 * 32 + 16); y[0] = a[0]; y[1] = a[1]; y[2] = a[2]; y[3] = a[3]; y[4] = bq[0]; y[5] = bq[1]; y[6] = bq[2]; y[7] = bq[3]; }
#pragma unroll
            for (int jt = 0; jt < 4; ++jt) { const v4u r = *(const LAS v4u*)(L + O_A + (tl + jt) * 256 + c16 * 16);
                const f32x4 wa = *(const LAS f32x4*)(L + O_CW + jt * 512 + c16 * 32), wb = *(const LAS f32x4*)(L + O_CW + jt * 512 + c16 * 32 + 16);
                y[0] += wa[0] * bflo(r.x); y[1] += wa[1] * bfhi(r.x); y[2] += wa[2] * bflo(r.y); y[3] += wa[3] * bfhi(r.y);
                y[4] += wb[0] * bflo(r.z); y[5] += wb[1] * bfhi(r.z); y[6] += wb[2] * bflo(r.w); y[7] += wb[3] * bfhi(r.w); }
            *(LAS f32x4*)(L + O_XCF + tl * FST + c16 * 32) = (f32x4){y[0], y[1], y[2], y[3]};
            *(LAS f32x4*)(L + O_XCF + tl * FST + c16 * 32 + 16) = (f32x4){y[4], y[5], y[6], y[7]};
            v4u o; o.x = pk2(y[0], y[1]); o.y = pk2(y[2], y[3]); o.z = pk2(y[4], y[5]); o.w = pk2(y[6], y[7]);
            *(LAS v4u*)(L + O_XCB + tl * 272 + c16 * 16) = o; }
        __syncthreads();
        float carry0 = 0.f, carry1 = 0.f;
        if (carry_tab) { const LAS float* CT = (const LAS float*)(L + O_CARRY); carry0 = CT[((b * 2 + (seg >> 5)) * 2 + 0) * 128 + (tid & 127)]; carry1 = CT[((b * 2 + (seg >> 5)) * 2 + 1) * 128 + (tid & 127)]; }
        else if (PB) {
            const int ch = blk * 128 + (tid & 127);
            float h = 0.f;
            const f32x2* ag0 = AGG + ((size_t)(b * 64) * 2 + 0) * DM + ch; const f32x2* ag1 = AGG + ((size_t)(b * 64) * 2 + 1) * DM + ch;
            int js = 0;
            for (; js + 8 <= seg; js += 8) { f32x2 ah[8];
#pragma unroll
                for (int q = 0; q < 8; ++q) ah[q] = ag0[(size_t)(js + q) * 2 * DM];
#pragma unroll
                for (int q = 0; q < 8; ++q) h = ah[q][0] * h + ah[q][1]; }
            for (; js < seg; ++js) { const f32x2 ah = ag0[(size_t)js * 2 * DM]; h = ah[0] * h + ah[1]; }
            carry0 = h; h = 0.f;
            js = 63;
            for (; js - 8 >= seg; js -= 8) { f32x2 ah[8];
#pragma unroll
                for (int q = 0; q < 8; ++q) ah[q] = ag1[(size_t)(js - q) * 2 * DM];
#pragma unroll
                for (int q = 0; q < 8; ++q) h = ah[q][0] * h + ah[q][1]; }
            for (; js > seg; --js) { const f32x2 ah = ag1[(size_t)js * 2 * DM]; h = ah[0] * h + ah[1]; }
            carry1 = h;
        }
#pragma unroll
        for (int d = 0; d < 2; ++d) {
            const int o_a = (d == 0) ? O_A : O_XCF;
            f32x4 aR[4], aI[4];
#pragma unroll
            for (int mt = 0; mt < 4; ++mt) { aR[mt] = (f32x4){0.f, 0.f, 0.f, 0.f}; aI[mt] = (f32x4){0.f, 0.f, 0.f, 0.f}; }
#pragma unroll
            for (int ks = 0; ks < 4; ++ks)
#pragma unroll
                for (int mt = 0; mt < 4; ++mt) { const bf16x8 xb = *(const LAS bf16x8*)(L + O_XCB + (16 * mt + fr) * 272 + (32 * ks + 8 * fq) * 2);
                    aR[mt] = __builtin_amdgcn_mfma_f32_16x16x32_bf16(wf[d][0][ks], xb, aR[mt], 0, 0, 0);
                    aI[mt] = __builtin_amdgcn_mfma_f32_16x16x32_bf16(wf[d][1][ks], xb, aI[mt], 0, 0, 0); }
#pragma unroll
            for (int mt = 0; mt < 4; ++mt) { const int tl = 16 * mt + fr, cl = 16 * w + 4 * fq;
                const f32x4 xc = *(const LAS f32x4*)(L + O_XCF + tl * FST + cl * 4);
                f32x4 av, uv;
#pragma unroll
                for (int e = 0; e < 4; ++e) { const float r = sigmoidf_(aR[mt][e] + br4[d][e]), ig = sigmoidf_(aI[mt][e] + bi4[d][e]);
                    const float a_ = __builtin_amdgcn_exp2f(r * sp4[d][e]); av[e] = a_; uv[e] = __builtin_amdgcn_sqrtf(fmaxf(1.f - a_ * a_, 0.f)) * (ig * xc[e]); }
                *(LAS f32x4*)(L + o_a + tl * FST + cl * 4) = av; *(LAS f32x4*)(L + O_U + tl * FST + cl * 4) = uv; }
            __syncthreads();
            {
                const int c = tid & 127, sub = tid >> 7;
                LAS float* pa = (LAS float*)(L + o_a) + c; const LAS float* pu = (const LAS float*)(L + O_U) + c;
                LAS f32x2* SUBT = (LAS f32x2*)(L + O_SUB);
                float h = 0.f, A = 1.f;
#pragma unroll
                for (int s2 = 0; s2 < 16; ++s2) { const int tl = d ? (16 * sub + 15 - s2) : (16 * sub + s2); const float a = pa[tl * 132], u = pu[tl * 132]; h = a * h + u; A *= a; }
                SUBT[sub * 128 + c] = (f32x2){A, h};
                __syncthreads();
                if (!PB) {
                    if (sub == 0) { float HH = 0.f, AA = 1.f;
#pragma unroll
                        for (int q = 0; q < 4; ++q) { const f32x2 ah = SUBT[(d ? 3 - q : q) * 128 + c]; HH = ah[0] * HH + ah[1]; AA *= ah[0]; }
                        AGG[((size_t)(b * 64 + seg) * 2 + d) * DM + blk * 128 + c] = (f32x2){AA, HH}; }
                } else {
                    float hc = d ? carry1 : carry0;
#pragma unroll
                    for (int q = 0; q < 3; ++q) { const int jq = d ? 3 - q : q; const f32x2 ah = SUBT[jq * 128 + c]; if (d ? (jq > sub) : (jq < sub)) hc = ah[0] * hc + ah[1]; }
                    if (d == 0) {
#pragma unroll
                        for (int s2 = 0; s2 < 16; ++s2) { const int tl = 16 * sub + s2; hc = pa[tl * 132] * hc + pu[tl * 132]; pa[tl * 132] = hc; }
                    } else { LAS float* ph = (LAS float*)(L + O_A) + c;
#pragma unroll
                        for (int s2 = 0; s2 < 16; ++s2) { const int tl = 16 * sub + 15 - s2; hc = pa[tl * 132] * hc + pu[tl * 132]; ph[tl * 132] += hc; } }
                }
            }
            __syncthreads();
        }
        if (PB) {
#pragma unroll
            for (int r = 0; r < 2; ++r) { const int e = tid + NTHR * r, row = e >> 4, c16 = e & 15;
                const v4u g = lgreg[r];
                const f32x4 h0 = *(const LAS f32x4*)(L + O_A + row * FST + c16 * 32), h1 = *(const LAS f32x4*)(L + O_A + row * FST + c16 * 32 + 16);
                v4u o;
                o.x = pk2(h0[0] * gelu_fast(bflo(g.x)), h0[1] * gelu_fast(bfhi(g.x))); o.y = pk2(h0[2] * gelu_fast(bflo(g.y)), h0[3] * gelu_fast(bfhi(g.y)));
                o.z = pk2(h1[0] * gelu_fast(bflo(g.z)), h1[1] * gelu_fast(bfhi(g.z))); o.w = pk2(h1[2] * gelu_fast(bflo(g.w)), h1[3] * gelu_fast(bfhi(g.w)));
                *(v4u*)(YL + (mrow0 + row) * DM + blk * 128 + c16 * 8) = o; }
            __syncthreads();
        }
    }
#undef RAW_LOAD
}

__device__ __forceinline__ void mconv_phase(Frame& F) {
    const bf16* XM = (const bf16*)(F.ws + WS_XM); bf16* XC = (bf16*)F.out + (size_t)MTOK * DM;
    const float* cw = F.in[4]; const float* cb = F.in[5];
    const int NT = MTOK / 32 * 128;
    for (int g = F.bid * NTHR + F.tid; g < NT; g += F.G * NTHR) {
        const int chunk = g & 127, run = g >> 7, c0 = chunk * 8, m0 = run * 32, t0 = m0 & (SEQ - 1);
        float w[4][8], bias[8];
#pragma unroll
        for (int j = 0; j < 4; ++j) { const f32x4 a = *(const f32x4*)(cw + j * DM + c0), b = *(const f32x4*)(cw + j * DM + c0 + 4);
            w[j][0] = a[0]; w[j][1] = a[1]; w[j][2] = a[2]; w[j][3] = a[3]; w[j][4] = b[0]; w[j][5] = b[1]; w[j][6] = b[2]; w[j][7] = b[3]; }
        { const f32x4 a = *(const f32x4*)(cb + c0), b = *(const f32x4*)(cb + c0 + 4);
            bias[0] = a[0]; bias[1] = a[1]; bias[2] = a[2]; bias[3] = a[3]; bias[4] = b[0]; bias[5] = b[1]; bias[6] = b[2]; bias[7] = b[3]; }
        v4u win[4];
        const v4u zero = {0u, 0u, 0u, 0u};
        win[0] = zero;
        win[1] = (t0 >= 2) ? *(const v4u*)(XM + (size_t)(m0 - 2) * DM + c0) : zero;
        win[2] = (t0 >= 1) ? *(const v4u*)(XM + (size_t)(m0 - 1) * DM + c0) : zero;
        win[3] = *(const v4u*)(XM + (size_t)m0 * DM + c0);
#pragma unroll 4
        for (int i = 0; i < 32; ++i) {
            win[0] = win[1]; win[1] = win[2]; win[2] = win[3];
            win[3] = (t0 + i + 1 < SEQ) ? *(const v4u*)(XM + (size_t)(m0 + i + 1) * DM + c0) : zero;
            float y[8];
#pragma unroll
            for (int e = 0; e < 8; ++e) y[e] = bias[e];
#pragma unroll
            for (int j = 0; j < 4; ++j) {
                const unsigned p0 = win[j].x, p1 = win[j].y, p2 = win[j].z, p3 = win[j].w;
                y[0] += w[j][0] * bflo(p0); y[1] += w[j][1] * bfhi(p0); y[2] += w[j][2] * bflo(p1); y[3] += w[j][3] * bfhi(p1);
                y[4] += w[j][4] * bflo(p2); y[5] += w[j][5] * bfhi(p2); y[6] += w[j][6] * bflo(p3); y[7] += w[j][7] * bfhi(p3);
            }
#pragma unroll
            for (int e = 0; e < 8; ++e) y[e] = y[e] * sigmoidf_(y[e]);
            v4u o; o.x = pk2(y[0], y[1]); o.y = pk2(y[2], y[3]); o.z = pk2(y[4], y[5]); o.w = pk2(y[6], y[7]);
            *(v4u*)(XC + (size_t)(m0 + i) * DM + c0) = o;
        }
    }
}

typedef short s16x4 __attribute__((ext_vector_type(4)));
__device__ __forceinline__ bf16x8 tr_read_pair(unsigned a0, unsigned a1) {
    s16x4 r0, r1;
    asm volatile("ds_read_b64_tr_b16 %0, %2\n\tds_read_b64_tr_b16 %1, %3\n\ts_waitcnt lgkmcnt(0)" : "=&v"(r0), "=&v"(r1) : "v"(a0), "v"(a1) : "memory");
    return __builtin_shufflevector(r0, r1, 0, 1, 2, 3, 4, 5, 6, 7);
}
__device__ __forceinline__ float dpp_shr(float oldv, float x, int n) {
    const int o = __builtin_bit_cast(int, oldv), v = __builtin_bit_cast(int, x);
    int r;
    if (n == 1) r = __builtin_amdgcn_update_dpp(o, v, 0x111, 0xf, 0xf, false);
    else if (n == 2) r = __builtin_amdgcn_update_dpp(o, v, 0x112, 0xf, 0xf, false);
    else if (n == 4) r = __builtin_amdgcn_update_dpp(o, v, 0x114, 0xf, 0xf, false);
    else r = __builtin_amdgcn_update_dpp(o, v, 0x118, 0xf, 0xf, false);
    return __builtin_bit_cast(float, r);
}
__device__ __forceinline__ float rdlane(float x, int l) { return __builtin_bit_cast(float, __builtin_amdgcn_readlane(__builtin_bit_cast(int, x), l)); }
__device__ __forceinline__ float wave_incl_sum(float x, int lane) {
    x += dpp_shr(0.f, x, 1); x += dpp_shr(0.f, x, 2); x += dpp_shr(0.f, x, 4); x += dpp_shr(0.f, x, 8);
    const float t0 = rdlane(x, 15), t1 = rdlane(x, 31), t2 = rdlane(x, 47);
    return x + (lane >= 16 ? t0 : 0.f) + (lane >= 32 ? t1 : 0.f) + (lane >= 48 ? t2 : 0.f);
}
__device__ __forceinline__ float wave_incl_max(float x, int lane) {
    const float NI = -INFINITY;
    x = fmaxf(x, dpp_shr(NI, x, 1)); x = fmaxf(x, dpp_shr(NI, x, 2)); x = fmaxf(x, dpp_shr(NI, x, 4)); x = fmaxf(x, dpp_shr(NI, x, 8));
    const float t0 = rdlane(x, 15), t1 = rdlane(x, 31), t2 = rdlane(x, 47);
    return fmaxf(fmaxf(x, lane >= 16 ? t0 : NI), fmaxf(lane >= 32 ? t1 : NI, lane >= 48 ? t2 : NI));
}
__device__ __forceinline__ void mscan_phase(Frame& F) {
    const bf16* Q = (const bf16*)(F.ws + WS_LG); const bf16* K = (const bf16*)(F.ws + WS_K); const bf16* V = (const bf16*)(F.ws + WS_XL);
    const float* GT = (const float*)(F.ws + WS_GATE);
    constexpr int KS = 0, CTI = 33792, VT = 67584, VWT = 86016, PB = 104448, TAB = 113664, NT = 116736, NPART = 117760, DENT = 119808;
    constexpr int KST = 528, VST = 144, TABSZ = 1536;
    LAS unsigned char* L = F.lds;
    const int tid = F.tid, lane = F.lane, w = F.wave, fr = lane & 15, fq = lane >> 4, pt = w & 3, wg = w >> 2;
    for (int item = F.bid; item < 256; item += F.G) {
        const int es = item & 3, dir = (item >> 2) & 1, h = (item >> 3) & 3, b = item >> 5;
        bf16* H = dir ? ((bf16*)F.out + (size_t)MTOK * DM) : (bf16*)(F.ws + WS_XM);
        const size_t rowbase = (size_t)b * SEQ;
#define TOF(c, p) (dir ? (SEQ - 1 - 64 * (c) - (p)) : (64 * (c) + (p)))
        for (int e = tid; e < (33792 + 1024) / 4; e += NTHR) { if (e < 33792 / 4) ((LAS unsigned*)(L + CTI))[e] = 0u; else ((LAS unsigned*)(L + NT))[e - 33792 / 4] = 0u; }
        float m_run = 0.f;
        float gi_n = 0.f, gf_n = 0.f;
        if (w == 0) { const size_t m = rowbase + TOF(0, lane); gi_n = GT[m * 16 + dir * 8 + h]; gf_n = GT[m * 16 + dir * 8 + 4 + h]; }
#define G1_TABLES(setp) do { \
            const float logf_ = fminf(gf_n, 0.f) - __logf(1.f + __expf(-fabsf(gf_n))); const float b_ = wave_incl_sum(logf_, lane); const float a_ = gi_n - b_; \
            const float M_ = fmaxf(m_run, wave_incl_max(a_, lane)); const float Mend_ = rdlane(M_, 63), g_ = rdlane(b_, 63); \
            LAS float* T_ = (LAS float*)(setp); T_[lane] = a_; T_[64 + lane] = M_; T_[128 + lane] = __expf(m_run - M_); T_[192 + lane] = __expf(-(b_ + M_)); T_[256 + lane] = __expf(a_ - Mend_); \
            if (lane == 0) { T_[320] = __expf(m_run - Mend_); T_[321] = g_ + Mend_; } \
            m_run = g_ + Mend_; } while (0)
        if (w == 0) G1_TABLES(L + TAB);
        __syncthreads();
        bf16x8 qf[8];
        v4u kreg[4]; v4u vreg;
#define LOAD_KV(c) do { _Pragma("unroll") for (int r_ = 0; r_ < 4; ++r_) { const int i_ = tid + NTHR * r_, s_ = i_ >> 5, c16_ = i_ & 31; \
                kreg[r_] = *(const v4u*)(K + (rowbase + TOF(c, s_)) * DM + h * 256 + c16_ * 8); } \
            { const int s_ = tid & 63, e8_ = tid >> 6; vreg = *(const v4u*)(V + (rowbase + TOF(c, s_)) * DM + h * 256 + es * 64 + e8_ * 8); } } while (0)
#define STORE_KV(setidx) do { _Pragma("unroll") for (int r_ = 0; r_ < 4; ++r_) { const int i_ = tid + NTHR * r_, s_ = i_ >> 5, c16_ = i_ & 31; \
                *(LAS v4u*)(L + KS + s_ * KST + c16_ * 16) = kreg[r_]; } \
            { const int s_ = tid & 63, e8_ = tid >> 6; const float ws_ = ((const LAS float*)(L + TAB + (setidx) * TABSZ))[256 + s_]; \
              LAS bf16* vt_ = (LAS bf16*)(L + VT + (setidx) * 9216); LAS bf16* vw_ = (LAS bf16*)(L + VWT + (setidx) * 9216); \
              const unsigned wv_[4] = {vreg.x, vreg.y, vreg.z, vreg.w}; \
              _Pragma("unroll") for (int j_ = 0; j_ < 4; ++j_) { const float lo_ = bflo(wv_[j_]), hi_ = bfhi(wv_[j_]); const int e_ = e8_ * 8 + 2 * j_; \
                vt_[e_ * 72 + s_] = (bf16)(wv_[j_] & 0xffffu); vt_[(e_ + 1) * 72 + s_] = (bf16)(wv_[j_] >> 16); \
                vw_[e_ * 72 + s_] = (bf16)f2bf(lo_ * ws_); vw_[(e_ + 1) * 72 + s_] = (bf16)f2bf(hi_ * ws_); } } } while (0)
#define LOAD_Q(c) do { const size_t m_ = rowbase + TOF(c, 16 * pt + fr); _Pragma("unroll") for (int ks_ = 0; ks_ < 8; ++ks_) \
                qf[ks_] = *(const bf16x8*)(Q + m_ * DM + h * 256 + 32 * ks_ + 8 * fq); } while (0)
        LOAD_KV(0); LOAD_Q(0);
        STORE_KV(0);
        f32x4 Cacc[8];
#pragma unroll
        for (int i = 0; i < 8; ++i) Cacc[i] = (f32x4){0.f, 0.f, 0.f, 0.f};
        __syncthreads();
        for (int c = 0; c < 64; ++c) {
            const int cur = c & 1, nxt = cur ^ 1;
            const bool has_next = (c + 1 < 64);
            const LAS float* T = (const LAS float*)(L + TAB + cur * TABSZ);
            if (has_next) { LOAD_KV(c + 1); if (w == 0) { const size_t m = rowbase + TOF(c + 1, lane); gi_n = GT[m * 16 + dir * 8 + h]; gf_n = GT[m * 16 + dir * 8 + 4 + h]; } }
            const int p = 16 * pt + fr;
            const float Mp = T[64 + p], wi_p = T[128 + p];
            float cs = 0.f;
#pragma unroll
            for (int i = 0; i < 2; ++i) { const int st = 2 * wg + i;
                v2u pw = {0u, 0u};
                if (st <= pt) {
                    f32x4 sa = (f32x4){0.f, 0.f, 0.f, 0.f};
#pragma unroll
                    for (int ks = 0; ks < 8; ++ks) { const bf16x8 kf = *(const LAS bf16x8*)(L + KS + (16 * st + fr) * KST + (32 * ks + 8 * fq) * 2);
                        sa = __builtin_amdgcn_mfma_f32_16x16x32_bf16(kf, qf[ks], sa, 0, 0, 0); }
                    const f32x4 a4 = *(const LAS f32x4*)(T + 16 * st + 4 * fq);
                    float pv[4];
#pragma unroll
                    for (int r = 0; r < 4; ++r) { const int s_ = 16 * st + 4 * fq + r; const float wgt = (s_ <= p) ? __expf(a4[r] - Mp) : 0.f; pv[r] = sa[r] * wgt; cs += pv[r]; }
                    pw.x = pk2(pv[0], pv[1]); pw.y = pk2(pv[2], pv[3]);
                }
                *(LAS v2u*)(L + PB + p * VST + (16 * st + 4 * fq) * 2) = pw; }
            f32x4 O[2];
#pragma unroll
            for (int i = 0; i < 2; ++i) { const int et = 2 * wg + i; O[i] = (f32x4){0.f, 0.f, 0.f, 0.f};
#pragma unroll
                for (int ks = 0; ks < 8; ++ks) { const bf16x8 cf = *(const LAS bf16x8*)(L + CTI + (16 * et + fr) * KST + (32 * ks + 8 * fq) * 2);
                    O[i] = __builtin_amdgcn_mfma_f32_16x16x32_bf16(cf, qf[ks], O[i], 0, 0, 0); } }
            float di = 0.f;
#define DEN_INTER(ks) do { const f32x4 n0 = *(const LAS f32x4*)(L + NT + (32 * (ks) + 8 * fq) * 4), n1 = *(const LAS f32x4*)(L + NT + (32 * (ks) + 8 * fq) * 4 + 16); \
                const v4u qw = __builtin_bit_cast(v4u, qf[ks]); \
                di += bflo(qw.x) * n0[0] + bfhi(qw.x) * n0[1] + bflo(qw.y) * n0[2] + bfhi(qw.y) * n0[3] + bflo(qw.z) * n1[0] + bfhi(qw.z) * n1[1] + bflo(qw.w) * n1[2] + bfhi(qw.w) * n1[3]; } while (0)
            if (wg == 0) { DEN_INTER(0); DEN_INTER(1); DEN_INTER(2); DEN_INTER(3); }
            else { DEN_INTER(4); DEN_INTER(5); DEN_INTER(6); DEN_INTER(7); }
#undef DEN_INTER
            di += __shfl_xor(di, 16); di += __shfl_xor(di, 32);
            cs += __shfl_xor(cs, 16); cs += __shfl_xor(cs, 32);
            if (fq == 0) ((LAS float*)(L + DENT))[wg * 64 + p] = wi_p * di + cs;
            if (has_next) LOAD_Q(c + 1);
            if (has_next && w == 0) G1_TABLES(L + TAB + nxt * TABSZ);
            __syncthreads();
#pragma unroll
            for (int i = 0; i < 2; ++i) { const int et = 2 * wg + i; O[i] = O[i] * wi_p;
#pragma unroll
                for (int ks = 0; ks < 2; ++ks) { const bf16x8 vf = *(const LAS bf16x8*)(L + VT + cur * 9216 + (16 * et + fr) * VST + (32 * ks + 8 * fq) * 2);
                    const bf16x8 pf = *(const LAS bf16x8*)(L + PB + p * VST + (32 * ks + 8 * fq) * 2);
                    O[i] = __builtin_amdgcn_mfma_f32_16x16x32_bf16(vf, pf, O[i], 0, 0, 0); } }
            { const float den = ((const LAS float*)(L + DENT))[p] + ((const LAS float*)(L + DENT))[64 + p];
              const float inv = 1.f / fmaxf(fabsf(den), T[192 + p]);
              const size_t m = rowbase + TOF(c, p);
#pragma unroll
              for (int i = 0; i < 2; ++i) { const int et = 2 * wg + i; v2u o; o.x = pk2(O[i][0] * inv, O[i][1] * inv); o.y = pk2(O[i][2] * inv, O[i][3] * inv);
                  *(v2u*)(H + m * DM + h * 256 + es * 64 + 16 * et + 4 * fq) = o; } }
            { const float decay = T[320];
              const bf16x8 vw0 = *(const LAS bf16x8*)(L + VWT + cur * 9216 + (16 * pt + fr) * VST + (8 * fq) * 2);
              const bf16x8 vw1 = *(const LAS bf16x8*)(L + VWT + cur * 9216 + (16 * pt + fr) * VST + (32 + 8 * fq) * 2);
              const int l16 = lane & 15, q4 = l16 >> 2, p4 = l16 & 3;
              const unsigned kb = (unsigned)(uintptr_t)(L + KS) + (unsigned)((8 * fq + q4) * KST + 4 * p4 * 2);
#pragma unroll
              for (int dtl = 0; dtl < 8; dtl += 2) { const int dt = 8 * wg + dtl; const unsigned a0 = kb + dt * 32;
                  s16x4 r0, r1, r2, r3, r4, r5, r6, r7;
                  asm volatile("ds_read_b64_tr_b16 %0, %8\n\tds_read_b64_tr_b16 %1, %8 offset:2112\n\tds_read_b64_tr_b16 %2, %8 offset:16896\n\tds_read_b64_tr_b16 %3, %8 offset:19008\n\t"
                               "ds_read_b64_tr_b16 %4, %8 offset:32\n\tds_read_b64_tr_b16 %5, %8 offset:2144\n\tds_read_b64_tr_b16 %6, %8 offset:16928\n\tds_read_b64_tr_b16 %7, %8 offset:19040\n\ts_waitcnt lgkmcnt(0)"
                               : "=&v"(r0), "=&v"(r1), "=&v"(r2), "=&v"(r3), "=&v"(r4), "=&v"(r5), "=&v"(r6), "=&v"(r7) : "v"(a0) : "memory");
                  const bf16x8 k0 = __builtin_shufflevector(r0, r1, 0, 1, 2, 3, 4, 5, 6, 7), k1 = __builtin_shufflevector(r2, r3, 0, 1, 2, 3, 4, 5, 6, 7);
                  const bf16x8 k2 = __builtin_shufflevector(r4, r5, 0, 1, 2, 3, 4, 5, 6, 7), k3 = __builtin_shufflevector(r6, r7, 0, 1, 2, 3, 4, 5, 6, 7);
                  Cacc[dtl] = Cacc[dtl] * decay; Cacc[dtl + 1] = Cacc[dtl + 1] * decay;
                  Cacc[dtl] = __builtin_amdgcn_mfma_f32_16x16x32_bf16(k0, vw0, Cacc[dtl], 0, 0, 0);
                  Cacc[dtl + 1] = __builtin_amdgcn_mfma_f32_16x16x32_bf16(k2, vw0, Cacc[dtl + 1], 0, 0, 0);
                  Cacc[dtl] = __builtin_amdgcn_mfma_f32_16x16x32_bf16(k1, vw1, Cacc[dtl], 0, 0, 0);
                  Cacc[dtl + 1] = __builtin_amdgcn_mfma_f32_16x16x32_bf16(k3, vw1, Cacc[dtl + 1], 0, 0, 0); } }
            { const int d = tid & 255, hf2 = tid >> 8; float np = 0.f;
#pragma unroll 8
              for (int s2 = 0; s2 < 32; ++s2) { const int s_ = hf2 * 32 + s2; np += T[256 + s_] * bf2f(*(const LAS bf16*)(L + KS + s_ * KST + d * 2)); }
              ((LAS float*)(L + NPART))[hf2 * 256 + d] = np; }
            __syncthreads();
            { const float decay = T[320];
#pragma unroll
              for (int dtl = 0; dtl < 8; ++dtl) { const int dt = 8 * wg + dtl; v2u o; o.x = pk2(Cacc[dtl][0], Cacc[dtl][1]); o.y = pk2(Cacc[dtl][2], Cacc[dtl][3]);
                  *(LAS v2u*)(L + CTI + (16 * pt + fr) * KST + (16 * dt + 4 * fq) * 2) = o; }
              if (tid < 256) { LAS float* nt = (LAS float*)(L + NT); const LAS float* np = (const LAS float*)(L + NPART); nt[tid] = decay * nt[tid] + np[tid] + np[256 + tid]; } }
            if (has_next) STORE_KV(nxt);
            __syncthreads();
        }
#undef TOF
#undef G1_TABLES
#undef LOAD_KV
#undef STORE_KV
#undef LOAD_Q
    }
}

__device__ __forceinline__ void ym_phase(Frame& F) {
    const bf16* HF = (const bf16*)(F.ws + WS_XM); const bf16* HB = (const bf16*)F.out + (size_t)MTOK * DM; bf16* OP = (bf16*)(F.ws + WS_OP);
    const float* ng = F.in[9];
    const int gw = F.bid * NWAVES + F.wave, NGW = F.G * NWAVES;
    for (int m = gw; m < MTOK; m += NGW) {
#pragma unroll
        for (int hd = 0; hd < 4; ++hd) {
            const size_t o = (size_t)m * DM + hd * 256 + F.lane * 4;
            const v2u a = *(const v2u*)(HF + o), b = *(const v2u*)(HB + o), op = *(const v2u*)(OP + o);
            const float v0 = bflo(a.x) + bflo(b.x), v1 = bfhi(a.x) + bfhi(b.x), v2 = bflo(a.y) + bflo(b.y), v3 = bfhi(a.y) + bfhi(b.y);
            const float r = rsqrtf(wave_sum((v0 * v0 + v1 * v1) + (v2 * v2 + v3 * v3)) * (1.f / 256.f) + EPS);
            const f32x4 g = *(const f32x4*)(ng + hd * 256 + F.lane * 4);
            v2u w; w.x = pk2(sigmoidf_(bflo(op.x)) * v0 * r * g[0], sigmoidf_(bfhi(op.x)) * v1 * r * g[1]);
            w.y = pk2(sigmoidf_(bflo(op.y)) * v2 * r * g[2], sigmoidf_(bfhi(op.y)) * v3 * r * g[3]);
            *(v2u*)(OP + o) = w;
        }
    }
    {
        float* usc = (float*)(F.ws + WS_LG + 16 * MiB); float* vsc = usc + NEXP;
        for (int row = gw; row < 2 * NEXP; row += NGW) {
            const bool isv = row >= NEXP; const int r = isv ? row - NEXP : row;
            const f32x4* src = (const f32x4*)(F.in[isv ? 24 : 23] + (size_t)r * DM) + F.lane * 4;
            f32x4 a[4]; float ss = 0.f;
#pragma unroll
            for (int j = 0; j < 4; ++j) { a[j] = src[j]; ss += (a[j][0] * a[j][0] + a[j][1] * a[j][1]) + (a[j][2] * a[j][2] + a[j][3] * a[j][3]); }
            const float rms = sqrtf(wave_sum(ss) * (1.f / DM));
            const float sc = fmaxf(rms * 0.5f, 1e-30f), inv = 1.f / sc;
            unsigned o[2] = {0u, 0u};
#pragma unroll
            for (int j = 0; j < 4; ++j) { const f32x4 q = a[j] * inv;
                if (j & 1) { o[j >> 1] = __builtin_amdgcn_cvt_scalef32_pk_fp4_f32(o[j >> 1], q[0], q[1], 1.0f, 2); o[j >> 1] = __builtin_amdgcn_cvt_scalef32_pk_fp4_f32(o[j >> 1], q[2], q[3], 1.0f, 3); }
                else       { o[j >> 1] = __builtin_amdgcn_cvt_scalef32_pk_fp4_f32(o[j >> 1], q[0], q[1], 1.0f, 0); o[j >> 1] = __builtin_amdgcn_cvt_scalef32_pk_fp4_f32(o[j >> 1], q[2], q[3], 1.0f, 1); } }
            *(v2u*)(F.ws + WS_LG + (isv ? 8 * MiB : 0) + (size_t)r * (DM / 2) + F.lane * 8) = (v2u){o[0], o[1]};
            if (F.lane == 0) (isv ? vsc : usc)[r] = sc;
        }
    }
}

typedef float f32x16 __attribute__((ext_vector_type(16)));
#define TOPK_INSERT(L, xv) do { const float x_ = (xv); \
    L[15] = __builtin_amdgcn_fmed3f(L[14], L[15], x_); L[14] = __builtin_amdgcn_fmed3f(L[13], L[14], x_); L[13] = __builtin_amdgcn_fmed3f(L[12], L[13], x_); L[12] = __builtin_amdgcn_fmed3f(L[11], L[12], x_); \
    L[11] = __builtin_amdgcn_fmed3f(L[10], L[11], x_); L[10] = __builtin_amdgcn_fmed3f(L[9], L[10], x_); L[9] = __builtin_amdgcn_fmed3f(L[8], L[9], x_); L[8] = __builtin_amdgcn_fmed3f(L[7], L[8], x_); \
    L[7] = __builtin_amdgcn_fmed3f(L[6], L[7], x_); L[6] = __builtin_amdgcn_fmed3f(L[5], L[6], x_); L[5] = __builtin_amdgcn_fmed3f(L[4], L[5], x_); L[4] = __builtin_amdgcn_fmed3f(L[3], L[4], x_); \
    L[3] = __builtin_amdgcn_fmed3f(L[2], L[3], x_); L[2] = __builtin_amdgcn_fmed3f(L[1], L[2], x_); L[1] = __builtin_amdgcn_fmed3f(L[0], L[1], x_); L[0] = fmaxf(L[0], x_); } while (0)
template <int I> struct CandRow {
    static __device__ __forceinline__ void run(const float (&L0)[16], const float (&L1)[16], float (&R)[16]) {
        constexpr int NJ = 16 / (I + 1);
#pragma unroll
        for (int j = 0; j < NJ; ++j) { const float sm = L0[I] + L1[j];
            const float pk = __builtin_bit_cast(float, (__builtin_bit_cast(unsigned, sm) & 0xffffff00u) | (unsigned)(I * 16 + j)); TOPK_INSERT(R, pk); }
        if constexpr (I < 15) CandRow<I + 1>::run(L0, L1, R);
    }
};
__device__ __forceinline__ unsigned pick4(unsigned d0, unsigned d1, unsigned d2, unsigned d3, int i) {
    const int q = i >> 2; unsigned d = d0; d = (q == 1) ? d1 : d; d = (q == 2) ? d2 : d; d = (q == 3) ? d3 : d; return (d >> (8 * (i & 3))) & 127u;
}
__device__ __forceinline__ void select_phase(Frame& F) {
    const bf16* PQ = (const bf16*)(F.ws + WS_MG); const bf16* KEYS = (const bf16*)(F.ws + WS_KEYS);
    int* IDX = (int*)(F.ws + WS_K); float* GW = (float*)(F.ws + WS_K + 16 * MiB);
    LAS unsigned char* L = F.lds;
    const int tid = F.tid, lane = F.lane, w = F.wave, l31 = lane & 31, hh = lane >> 5;
    const float NEG_INF = -INFINITY;
    for (int grp = F.bid; grp < MTOK / 128; grp += F.G) {
        const int tb = grp * 4 + (w & 3);
        const size_t m = (size_t)tb * 32 + l31;
        for (int hp = 0; hp < 4; ++hp) {
            __syncthreads();
#pragma unroll 4
            for (int r = 0; r < 16; ++r) { const int e = tid + NTHR * r, R = e >> 4, c = e & 15;
                *(LAS v4u*)(L + R * 256 + ((c ^ (R & 15)) * 16)) = *(const v4u*)(KEYS + ((size_t)(hp * 512 + R) * 128 + c * 8)); }
            __syncthreads();
            const int hl = w >> 2, h = 2 * hp + hl;
            float L0[16], L1[16];
#pragma unroll
            for (int p = 0; p < 2; ++p) {
                bf16x8 qf[8];
#pragma unroll
                for (int ks = 0; ks < 8; ++ks) qf[ks] = *(const bf16x8*)(PQ + m * 2048 + h * 256 + p * 128 + 16 * ks + 8 * hh);
                f32x16 acc[4];
#pragma unroll
                for (int kb = 0; kb < 4; ++kb)
#pragma unroll
                    for (int r = 0; r < 16; ++r) acc[kb][r] = 0.f;
#pragma unroll
                for (int ks = 0; ks < 8; ++ks)
#pragma unroll
                    for (int kb = 0; kb < 4; ++kb) { const int R = (hl * 2 + p) * 128 + 32 * kb + l31;
                        const bf16x8 kf = *(const LAS bf16x8*)(L + R * 256 + (((2 * ks + hh) ^ (lane & 15)) * 16));
                        acc[kb] = __builtin_amdgcn_mfma_f32_32x32x16_bf16(kf, qf[ks], acc[kb], 0, 0, 0); }
                float Lc[16];
#pragma unroll
                for (int i = 0; i < 16; ++i) Lc[i] = NEG_INF;
                const unsigned hh4 = (unsigned)hh << 2;
#pragma unroll
                for (int kb = 0; kb < 4; ++kb)
#pragma unroll
                    for (int r = 0; r < 16; ++r) { const unsigned nlo = (unsigned)(32 * kb + (r & 3) + 8 * (r >> 2));
                        const float av_ = acc[kb][r];
                        const float pk = __uint_as_float(((__float_as_uint(av_) & 0xffffff80u) | hh4) | nlo); TOPK_INSERT(Lc, pk); }
                float Lo[16];
#pragma unroll
                for (int i = 0; i < 16; ++i) Lo[i] = __shfl_xor(Lc[i], 32);
#pragma unroll
                for (int i = 0; i < 16; ++i) TOPK_INSERT(Lc, Lo[i]);
#pragma unroll
                for (int i = 0; i < 16; ++i) { if (p == 0) L0[i] = Lc[i]; else L1[i] = Lc[i]; }
            }
            float R[16];
#pragma unroll
            for (int i = 0; i < 16; ++i) R[i] = NEG_INF;
            CandRow<0>::run(L0, L1, R);
            unsigned a0 = 0, a1 = 0, a2 = 0, a3 = 0, b0 = 0, b1 = 0, b2 = 0, b3 = 0;
#pragma unroll
            for (int i = 0; i < 4; ++i) { a0 |= (__builtin_bit_cast(unsigned, L0[i]) & 127u) << (8 * i); a1 |= (__builtin_bit_cast(unsigned, L0[4 + i]) & 127u) << (8 * i);
                a2 |= (__builtin_bit_cast(unsigned, L0[8 + i]) & 127u) << (8 * i); a3 |= (__builtin_bit_cast(unsigned, L0[12 + i]) & 127u) << (8 * i);
                b0 |= (__builtin_bit_cast(unsigned, L1[i]) & 127u) << (8 * i); b1 |= (__builtin_bit_cast(unsigned, L1[4 + i]) & 127u) << (8 * i);
                b2 |= (__builtin_bit_cast(unsigned, L1[8 + i]) & 127u) << (8 * i); b3 |= (__builtin_bit_cast(unsigned, L1[12 + i]) & 127u) << (8 * i); }
            float ex[16]; float sum = 0.f; int id[16];
#pragma unroll
            for (int r = 0; r < 16; ++r) { ex[r] = __expf(R[r] - R[0]); sum += ex[r];
                const unsigned cid = __builtin_bit_cast(unsigned, R[r]) & 255u;
                id[r] = (int)(pick4(a0, a1, a2, a3, (int)(cid >> 4)) * 128u + pick4(b0, b1, b2, b3, (int)(cid & 15u))); }
            const float inv = 1.f / sum;
            if (hh == 0) {
#pragma unroll
                for (int q = 0; q < 4; ++q) {
                    *(int4*)(IDX + m * 128 + h * 16 + 4 * q) = make_int4(id[4 * q], id[4 * q + 1], id[4 * q + 2], id[4 * q + 3]);
                    *(f32x4*)(GW + m * 128 + h * 16 + 4 * q) = (f32x4){ex[4 * q] * inv, ex[4 * q + 1] * inv, ex[4 * q + 2] * inv, ex[4 * q + 3] * inv}; }
            }
        }
    }
}

template <int B> __device__ __forceinline__ f32x2 fp4b(unsigned w) { return __builtin_amdgcn_cvt_scalef32_pk_f32_fp4(w, 1.0f, B); }
typedef int v8i_t __attribute__((ext_vector_type(8)));
#define AP_SLOT(e) (4 * (((e) >> 1) & 3) + 2 * ((e) >> 3) + ((e) & 1))
__device__ __forceinline__ void apply_phase(Frame& F, float* OUTP) {
    const unsigned char* U8 = F.ws + WS_LG; const unsigned char* V8 = F.ws + WS_LG + 8 * MiB;
    const float* USC = (const float*)(F.ws + WS_LG + 16 * MiB); const float* VSC = USC + NEXP;
    const int* IDX = (const int*)(F.ws + WS_K); const float* GW = (const float*)(F.ws + WS_K + 16 * MiB);
    const float* g2 = F.in[20]; const float* gf = F.in[25];
    const float* X1 = F.out;
    const int lane = F.lane, fr = lane & 15, fq = lane >> 4;
    constexpr int APW = 2 * 16 * 528 + 1024;
    LAS unsigned char* UL = F.lds + F.wave * APW; LAS unsigned char* VL = UL + 16 * 528; LAS unsigned char* H8 = VL + 16 * 528;
    const int pe = 2 * fq + (fr & 1) + 8 * ((fr >> 1) & 1);
    const int bsh = 8 * (fr & 3); const unsigned mlo = fr < 4 ? ~0u : 0u, mhi = (fr >= 4 && fr < 8) ? ~0u : 0u;
    for (int grp = F.bid; grp < MTOK / 128; grp += F.G)
    for (int m = grp * 128 + F.wave; m < grp * 128 + 128; m += NWAVES) {
        float s = 0.f; f32x4 xr[4];
#pragma unroll
        for (int q = 0; q < 4; ++q) { xr[q] = *(const f32x4*)(X1 + (size_t)m * DM + lane * 16 + q * 4); s += (xr[q][0] * xr[q][0] + xr[q][1] * xr[q][1]) + (xr[q][2] * xr[q][2] + xr[q][3] * xr[q][3]); }
        const float r2 = rsqrtf(wave_sum(s) * (1.f / DM) + EPS);
        { v4u h8;
#pragma unroll
          for (int q = 0; q < 4; ++q) { const f32x4 g = *(const f32x4*)(g2 + lane * 16 + q * 4); const f32x4 hq = xr[q] * r2 * g;
              int pk = 0; pk = __builtin_amdgcn_cvt_pk_fp8_f32(hq[0], hq[1], pk, false); pk = __builtin_amdgcn_cvt_pk_fp8_f32(hq[2], hq[3], pk, true); h8[q] = (unsigned)pk; }
          *(LAS v4u*)(H8 + lane * 16) = h8; }
        const int i0 = IDX[(size_t)m * 128 + lane], i1 = IDX[(size_t)m * 128 + 64 + lane];
        const float gw0 = GW[(size_t)m * 128 + lane], gw1 = GW[(size_t)m * 128 + 64 + lane];
        f32x4 oacc[8];
#pragma unroll
        for (int i = 0; i < 8; ++i) oacc[i] = (f32x4){0.f, 0.f, 0.f, 0.f};
#pragma unroll 1
        for (int bt = 0; bt < 8; ++bt) {
            const int k0 = bt * 16;
            const int isel = (k0 < 64) ? i0 : i1;
            v2u uu[16], vv[16];
            const int myidx = __shfl(isel, (k0 + pe) & 63);
            const float su = USC[myidx], sv = VSC[myidx];
#pragma unroll
            for (int e = 0; e < 16; ++e) { const size_t ro = (size_t)__builtin_amdgcn_readlane(isel, (k0 + e) & 63) * (DM / 2) + lane * 8;
                uu[e] = *(const v2u*)(U8 + ro); vv[e] = *(const v2u*)(V8 + ro); }
#pragma unroll
            for (int e = 0; e < 16; ++e) { *(LAS v2u*)(UL + AP_SLOT(e) * 528 + lane * 8) = uu[e]; *(LAS v2u*)(VL + e * 528 + lane * 8) = vv[e]; }
            f32x4 da = (f32x4){0.f, 0.f, 0.f, 0.f}, db = (f32x4){0.f, 0.f, 0.f, 0.f};
#pragma unroll
            for (int ks = 0; ks < 8; ++ks) {
                const v4u af = *(const LAS v4u*)(UL + fr * 528 + 64 * ks + 16 * fq);
                const v4u b0 = *(const LAS v4u*)(H8 + 128 * ks + 16 * fq), b1 = *(const LAS v4u*)(H8 + 128 * ks + 64 + 16 * fq);
                const v8i_t A = {(int)af.x, (int)af.y, (int)af.z, (int)af.w, 0, 0, 0, 0};
                const v8i_t B = {(int)b0.x, (int)b0.y, (int)b0.z, (int)b0.w, (int)b1.x, (int)b1.y, (int)b1.z, (int)b1.w};
                if (ks & 1) db = __builtin_amdgcn_mfma_scale_f32_16x16x128_f8f6f4(A, B, db, 4  , 0  , 0, 0x7F7F7F7F, 0, 0x7F7F7F7F);
                else        da = __builtin_amdgcn_mfma_scale_f32_16x16x128_f8f6f4(A, B, da, 4, 0, 0, 0x7F7F7F7F, 0, 0x7F7F7F7F);
            }
            const f32x4 d4 = da + db;
            const int sel = fr & 3;
            float t = d4[0]; t = (sel == 1) ? d4[1] : t; t = (sel == 2) ? d4[2] : t; t = (sel == 3) ? d4[3] : t;
            const float gk = __shfl((k0 < 64) ? gw0 : gw1, (k0 + pe) & 63);
            const float wl = gk * gelu_fast(t * su) * sv;
            float wm = fabsf(wl); wm = fmaxf(wm, __shfl_xor(wm, 1)); wm = fmaxf(wm, __shfl_xor(wm, 2)); wm = fmaxf(wm, __shfl_xor(wm, 16)); wm = fmaxf(wm, __shfl_xor(wm, 32));
            int E = (int)(__float_as_uint(wm) >> 23); E = E < 8 ? 8 : E;
            const float wq = wl * __uint_as_float((unsigned)(261 - E) << 23);
            const int scb = (E - 7) * 0x01010101;
            v8i_t Bw;
#define AP_WQ(tq, ctrl) { const float wt = __builtin_bit_cast(float, __builtin_amdgcn_update_dpp(0, __builtin_bit_cast(int, wq), ctrl, 0xf, 0xf, false)); \
                const unsigned p8 = (unsigned)__builtin_amdgcn_cvt_pk_fp8_f32(wt, 0.f, 0, false) << bsh; Bw[2 * tq] = (int)(p8 & mlo); Bw[2 * tq + 1] = (int)(p8 & mhi); }
            AP_WQ(0, 0x00) AP_WQ(1, 0x55) AP_WQ(2, 0xAA) AP_WQ(3, 0xFF)
#pragma unroll
            for (int c = 0; c < 8; ++c) {
                v4u av;
                av.x = *(const LAS unsigned*)(VL + (4 * fq + 0) * 528 + 64 * c + 4 * fr); av.y = *(const LAS unsigned*)(VL + (4 * fq + 1) * 528 + 64 * c + 4 * fr);
                av.z = *(const LAS unsigned*)(VL + (4 * fq + 2) * 528 + 64 * c + 4 * fr); av.w = *(const LAS unsigned*)(VL + (4 * fq + 3) * 528 + 64 * c + 4 * fr);
                const v8i_t A = {(int)av.x, (int)av.y, (int)av.z, (int)av.w, 0, 0, 0, 0};
                oacc[c] = __builtin_amdgcn_mfma_scale_f32_16x16x128_f8f6f4(A, Bw, oacc[c], 4, 0, 0, 0x7F7F7F7F, 0, scb);
            }
        }
        if (fr < 8) {
#pragma unroll
            for (int c = 0; c < 8; ++c)
#pragma unroll
                for (int r = 0; r < 4; ++r) { const float o = oacc[c][r]; *(LAS unsigned*)(UL + 4 * ((4 * c + fq) * 40 + 8 * r + fr)) = __float_as_uint(o); }
        }
        float s2 = 0.f; f32x4 ov[4];
#pragma unroll
        for (int q = 0; q < 4; ++q) { const v4u ou = *(const LAS v4u*)(UL + 4 * ((lane >> 1) * 40 + (lane & 1) * 16 + 4 * q));
            ov[q] = (f32x4){__uint_as_float(ou.x), __uint_as_float(ou.y), __uint_as_float(ou.z), __uint_as_float(ou.w)} + xr[q];
            s2 += (ov[q][0] * ov[q][0] + ov[q][1] * ov[q][1]) + (ov[q][2] * ov[q][2] + ov[q][3] * ov[q][3]); }
        const float rf = rsqrtf(wave_sum(s2) * (1.f / DM) + EPS);
#pragma unroll
        for (int q = 0; q < 4; ++q) { const f32x4 g = *(const f32x4*)(gf + lane * 16 + q * 4);
            *(f32x4*)(OUTP + (size_t)m * DM + lane * 16 + q * 4) = ov[q] * rf * g; }
    }
}

constexpr int N_PHASES = 13;
__global__ void __launch_bounds__(NTHR, 2) mega_fwd(Args args) {
    extern __shared__ __attribute__((aligned(16))) unsigned char lds[];
    Frame F;
    F.lds = (LAS unsigned char*)lds;
    F.tid = threadIdx.x; F.lane = F.tid & 63; F.wave = __builtin_amdgcn_readfirstlane(F.tid >> 6);
    F.G = gridDim.x; F.bid = blockIdx.x;
    F.in = args.in; F.out = args.out; F.ws = args.ws;
    volatile LAS unsigned* MISC = (volatile LAS unsigned*)(F.lds + MISC_OFF);
    for (int u = F.tid; u < (LDS_BYTES - LDSCTL_OFF) / 4; u += NTHR) ((LAS unsigned*)(F.lds + LDSCTL_OFF))[u] = 0u;
    __syncthreads();
    XcdBarrier bar; bar.bar = (unsigned*)(args.ws + WS_CTL) + CW_BAR; bar.x = 0; bar.st = nullptr;
    const bool one_launch = (args.ph_hi - args.ph_lo) > 1;
    if (one_launch) bar = xcd_barrier_post((unsigned*)(args.ws + WS_CTL) + CW_BAR, MISC + 8);
    const int lo = args.ph_lo, hi = args.ph_hi;
#define IN(k) (lo <= (k) && (k) < hi)
#define SEAM(k) do { if (IN(k) && IN((k) + 1)) xcd_barrier(bar); } while (0)
    unsigned char* ws = args.ws;

#ifndef PROBE_MASK
#define PROBE_MASK 0
#endif
#define REP(k) _Pragma("unroll") for (int rep_ = 0; rep_ < (((PROBE_MASK >> (k)) & 1) ? 2 : 1); ++rep_)
    if (IN(0)) REP(0) { p0_prologue(F); if (rep_ == 0 && ((PROBE_MASK >> 0) & 1)) xcd_barrier(bar); } SEAM(0);
    if (IN(1)) REP(1) {
        AddrPlain g{(const char*)(ws + WS_K), (const char*)(ws + WS_WIN), 1024, 1024, 1024};
        pg8::StaticOrder S; S.init(MTOK, 6144, F.G, F.bid, 4);
        EpiBf16<DstP1> E{DstP1{ws}};
        gates_phase(F);
        pg8::gemm_phase(F.lds, g, S, E);
    } SEAM(1);
    if (IN(2)) REP(2) { lru_phase<false>(F); mconv_phase(F); } SEAM(2);
    if (IN(3)) REP(3) { lru_phase<true>(F); } SEAM(3);
    if (IN(5)) REP(5) {
        const char* xc = (const char*)F.out + (size_t)MTOK * DM * 2;
        AddrQKV g{xc, (long)((const char*)(ws + WS_XM) - xc), (const char*)(ws + WS_WQKV), 1024, 256, 256};
        pg8::StaticOrder S; S.init(MTOK, 12 * 256, F.G, F.bid);
        EpiBf16<DstQKV> E{DstQKV{(char*)(ws + WS_LG), (long)WS_K - (long)WS_LG, (long)WS_XL - (long)WS_LG}};
        pg8::gemm_phase(F.lds, g, S, E);
    } SEAM(5);
    if (IN(6)) REP(6) { mscan_phase(F); } SEAM(6);
    if (IN(7)) { ym_phase(F); } SEAM(7);
    if (IN(8)) {
        pg8::StaticOrder S; S.init(MTOK, 1024, F.G, F.bid);
        { AddrPlain g{(const char*)(ws + WS_OP), (const char*)(ws + WS_WB2), 1024, 1024, 1024};
          EpiMerge<false> E{(bf16*)(ws + WS_XM), (const bf16*)(ws + WS_MG), 0}; pg8::gemm_phase(F.lds, g, S, E); }
        { AddrPlain g{(const char*)F.out, (const char*)(ws + WS_WB2) + (size_t)1024 * 1024 * 2, 1024, 1024, 1024};
          EpiMerge<true> E{(bf16*)(ws + WS_XM), (const bf16*)(ws + WS_MG), 1024}; pg8::gemm_phase(F.lds, g, S, E); }
    } SEAM(8);
    if (IN(9)) {
        AddrPlain g{(const char*)(ws + WS_XM), (const char*)(ws + WS_WOUT2), 1024, 2048, 1024};
        pg8::StaticOrder S; S.init(MTOK, 1024, F.G, F.bid);
        EpiResid E{F.in[0], F.out, (bf16*)(ws + WS_XL), (float*)(ws + WS_SS)};
        pg8::gemm_phase(F.lds, g, S, E);
    } SEAM(9);
    if (IN(10)) REP(10) {
        AddrPlain g{(const char*)(ws + WS_XL), (const char*)(ws + WS_WPQ), 1024, 1024, 1024};
        pg8::StaticOrder S; S.init(MTOK, 2048, F.G, F.bid, 4);
        EpiPQ E{(bf16*)(ws + WS_MG), (const float*)(ws + WS_SS)};
        pg8::gemm_phase(F.lds, g, S, E);
    } SEAM(10);
    if (IN(11)) REP(11) { select_phase(F); }
    if (IN(11) && IN(12)) { asm volatile("s_waitcnt vmcnt(0)" ::: "memory"); __syncthreads(); }
    if (IN(12)) { if ((PROBE_MASK >> 12) & 1) { apply_phase(F, (float*)(ws + WS_MG)); xcd_barrier(bar); } apply_phase(F, F.out); }
#undef REP
#undef IN
#undef SEAM
}

extern "C" void kernel_launch(void* const* d_in, const int* in_sizes, int n_in, void* d_out, int out_size, void* d_ws, size_t ws_size, hipStream_t stream) {
    static int grid = 0;
    if (grid == 0) {
        if (n_in != 26 || in_sizes[0] != MTOK * DM || out_size != MTOK * DM || ws_size < WS_END) { fprintf(stderr, "kernel_launch: unexpected shapes / workspace (%zu < %zu)\n", ws_size, (size_t)WS_END); grid = -1; return; }
        int dev = 0, cus = 0, per_cu = 0;
        if (hipGetDevice(&dev) != hipSuccess || hipDeviceGetAttribute(&cus, hipDeviceAttributeMultiprocessorCount, dev) != hipSuccess) { grid = -1; return; }
        if (hipFuncSetAttribute((const void*)mega_fwd, hipFuncAttributeMaxDynamicSharedMemorySize, LDS_BYTES) != hipSuccess) { fprintf(stderr, "kernel_launch: hipFuncSetAttribute failed\n"); grid = -1; return; }
        if (hipOccupancyMaxActiveBlocksPerMultiprocessor(&per_cu, (const void*)mega_fwd, NTHR, LDS_BYTES) != hipSuccess || per_cu < 1) { fprintf(stderr, "kernel_launch: occupancy query says %d blocks/CU\n", per_cu); (void)hipGetLastError(); grid = -1; return; }
        grid = cus;
    }
    if (grid < 0) return;
    (void)hipMemsetAsync((char*)d_ws + WS_CTL + (size_t)CW_BAR * 4, 0, (size_t)XCD_BAR_WORDS * 4, stream);
    Args a{};
    for (int i = 0; i < 26; ++i) a.in[i] = (const float*)d_in[i];
    a.out = (float*)d_out; a.ws = (unsigned char*)d_ws;
#if MK_N_LAUNCHES == 1
    a.ph_lo = 0; a.ph_hi = N_PHASES;
    void* kargs[] = {&a};
    hipError_t e = hipLaunchCooperativeKernel((const void*)mega_fwd, dim3(grid), dim3(NTHR), kargs, LDS_BYTES, stream);
    if (e != hipSuccess) fprintf(stderr, "kernel_launch: cooperative launch failed: %s (grid %d)\n", hipGetErrorString(e), grid);
#else
    for (int p = 0; p < N_PHASES; ++p) { a.ph_lo = p; a.ph_hi = p + 1; hipLaunchKernelGGL(mega_fwd, dim3(grid), dim3(NTHR), LDS_BYTES, stream, a); }
#endif
}
```

```cpp
#include <hip/hip_runtime.h>
#include <cstdio>
#include <cstdint>
#include <math.h>

#ifndef MK_N_LAUNCHES
#define MK_N_LAUNCHES 1
#endif

constexpr int BATCH = 8, SEQ = 4096, DM = 1024, MTOK = BATCH * SEQ;
constexpr int DIN = 6160;
constexpr int NEXP = 16384;
constexpr float EPS = 1e-6f;

constexpr size_t MiB = 1u << 20;
constexpr size_t WS_CTL = 0, CTL_ZERO_BYTES = 1 * MiB;
constexpr size_t WS_WIN = 1 * MiB;
constexpr size_t WS_WQKV = 13 * MiB;
constexpr size_t WS_KEYS = 14 * MiB + 512 * 1024;
constexpr size_t WS_WLRU = 15 * MiB;
constexpr size_t WS_WB2 = 16 * MiB;
constexpr size_t WS_WOUT2 = 20 * MiB;
constexpr size_t WS_WPQ = 24 * MiB;
constexpr size_t WS_GATE = 28 * MiB;
constexpr size_t WS_WGT = 30 * MiB;
constexpr size_t WS_XM = 32 * MiB;
constexpr size_t WS_OP = 96 * MiB;
constexpr size_t WS_XL = 160 * MiB;
constexpr size_t WS_LG = 224 * MiB;
constexpr size_t WS_MG = 288 * MiB;
constexpr size_t WS_K = 416 * MiB;
constexpr size_t WS_AGG = 480 * MiB;
constexpr size_t WS_SS = 488 * MiB;
constexpr size_t WS_WIN8 = 489 * MiB;
constexpr size_t WS_END = 495 * MiB;

constexpr int CW_BAR = 4096;

constexpr int RING_BYTES = 131072;
constexpr int LDS_BYTES = 147456;
constexpr int LDSCTL_OFF = LDS_BYTES - 512, MISC_OFF = LDSCTL_OFF + 320;
constexpr int NWAVES = 8, NTHR = 512;

#define GAS __attribute__((address_space(1)))
#define LAS __attribute__((address_space(3)))
typedef unsigned short bf16;
typedef unsigned v4u __attribute__((ext_vector_type(4)));
typedef unsigned v2u __attribute__((ext_vector_type(2)));
typedef float f32x4 __attribute__((ext_vector_type(4)));
typedef float f32x2 __attribute__((ext_vector_type(2)));
typedef short bf16x8 __attribute__((ext_vector_type(8)));
typedef GAS unsigned gu32;
#define RLX_AGENT __ATOMIC_RELAXED, __HIP_MEMORY_SCOPE_AGENT
#define LDS_WAIT() asm volatile("s_waitcnt lgkmcnt(0)" ::: "memory")
#define VM_WAIT() asm volatile("s_waitcnt vmcnt(0)" ::: "memory")

__device__ __forceinline__ unsigned f2bf(float f) { unsigned u = __builtin_bit_cast(unsigned, f); return (u + 0x7fffu + ((u >> 16) & 1u)) >> 16; }
__device__ __forceinline__ unsigned pk2(float lo, float hi) { return f2bf(lo) | (f2bf(hi) << 16); }
__device__ __forceinline__ float bf2f(unsigned short h) { return __builtin_bit_cast(float, (unsigned)h << 16); }
__device__ __forceinline__ float bflo(unsigned w) { return __builtin_bit_cast(float, w << 16); }
__device__ __forceinline__ float bfhi(unsigned w) { return __builtin_bit_cast(float, w & 0xffff0000u); }
__device__ __forceinline__ float wave_sum(float v) {
#pragma unroll
  for (int o = 1; o < 64; o <<= 1) v += __shfl_xor(v, o);
  return v;
}
__device__ __forceinline__ float sigmoidf_(float x) { return __builtin_amdgcn_rcpf(1.f + __builtin_amdgcn_exp2f(x * -1.44269504089f)); }
__device__ __forceinline__ float gelu_erf(float x) { return 0.5f * x * (1.f + erff(x * 0.70710678118654752f)); }
__device__ __forceinline__ float gelu_fast(float v) {
    const float av = fabsf(v), t = __builtin_amdgcn_rcpf(av * 0.2316418882f + 1.0f);
    float q = t * 0.5307027145f + (-0.7265760135f); q = q * t + 0.7107068705f; q = q * t + (-0.142248368f); q = q * t + 0.127414796f; q = q * t;
    const float e = __builtin_amdgcn_exp2f((v * v) * (-0.72134752044f));
    const float m = v * (q * e);
    return v < 0.f ? m : v - m;
}
__device__ __forceinline__ float softplusf_(float x) { return fmaxf(x, 0.f) + log1pf(expf(-fabsf(x))); }

namespace pg8 {
#define PG8_LAS __attribute__((address_space(3)))
typedef unsigned short bf16_t;
typedef unsigned u32x4 __attribute__((ext_vector_type(4)));
typedef int i32x4_t __attribute__((ext_vector_type(4)));
constexpr int BM = 256, BK = 64, HALF = 128, HTB = HALF * BK * 2, STAGE_BYTES = 8 * HTB, NXCD = 8;

__host__ __device__ __forceinline__ int lds_byte(int r, int c) { const int st = (r >> 4) * 2 + (c >> 5), rr = r & 15, cc = c & 31, ob = rr * 64 + cc * 2; return st * 1024 + (ob ^ (((ob >> 9) & 1) << 5)); }
__host__ __device__ __forceinline__ void stage_rc(int b, int& R, int& C) { const int st = b / 1024, sb = b % 1024, swz = sb ^ (((sb >> 9) & 1) << 5); R = (st >> 1) * 16 + swz / 64; C = (st & 1) * 32 + (swz % 64) / 2; }
__host__ __device__ __forceinline__ int perm32(int rho) { const int n = rho >> 4, i = rho & 15; return 8 * (i >> 2) + 4 * n + (i & 3); }

struct Unit { int pm, pn; };
struct StaticOrder {
    int nM, nN, nwg, G, c, WGM;
    __host__ __device__ void init(int M, int N, int G_, int c_, int wgm = 8) { nM = M / BM; nN = N / BM; nwg = nM * nN; G = G_; c = c_; WGM = wgm; }
    __host__ __device__ bool next(int i, Unit& u) const {
        const long L = (long)i * G + c; if (L >= nwg) return false;
        int wgid = (int)L; { const int q = nwg / NXCD, r = nwg % NXCD, xcd = wgid % NXCD, off = wgid / NXCD; wgid = (xcd < r ? xcd * (q + 1) : r * (q + 1) + (xcd - r) * q) + off; }
        const int nig = WGM * nN, gid = wgid / nig, fm = gid * WGM, gsz = (nM - fm) < WGM ? (nM - fm) : WGM;
        u.pm = fm + ((wgid % nig) % gsz); u.pn = (wgid % nig) / gsz; return true;
    }
};

__device__ __forceinline__ unsigned cvt_pk_bf16(float lo, float hi) { unsigned r; asm volatile("v_cvt_pk_bf16_f32 %0, %1, %2" : "=v"(r) : "v"(lo), "v"(hi)); return r; }

template <class Epi, class Addr, int F8SC = 0>
__device__ __forceinline__ void gemm_phase(PG8_LAS unsigned char* lds, const Addr g, const StaticOrder& S, const Epi& E) {
    const int tid = threadIdx.x, wid = __builtin_amdgcn_readfirstlane(tid >> 6), lane = tid & 63, wr = wid >> 2, wc = wid & 3, fr = lane & 15, fq = lane >> 4;
    const int K = g.K, nt = K / BK;
    unsigned voffA[2], voffB[2];
#pragma unroll
    for (int i = 0; i < 2; ++i) { int R, C; stage_rc(tid * 16 + i * 8192, R, C); const int Rb = Epi::PERM ? ((R & ~31) + perm32(R & 31)) : R;
        voffA[i] = (unsigned)(R * g.lda + C) * 2u; voffB[i] = (unsigned)(Rb * g.ldb + C) * 2u; }
    const size_t kstep = (size_t)(BK * 2);
    const size_t hsA = (size_t)HALF * g.lda * 2, hsB = (size_t)HALF * g.ldb * 2;
    const unsigned ldsw = (unsigned)wid * 1024u;
    const int aoff = lds_byte(wr * 64 + fr, fq * 8), boff = lds_byte(wc * 32 + fr, fq * 8);
#define PG8_SA(b, h) (((b) * 2 + (h)) * HTB)
#define PG8_SB(b, h) ((4 + (b) * 2 + (h)) * HTB)
#define PG8_STAGE(bufoff, gbase, voff) do { _Pragma("unroll") for (int _i = 0; _i < 2; ++_i) \
        __builtin_amdgcn_global_load_lds((const unsigned*)((const char*)(gbase) + (voff)[_i]), (PG8_LAS unsigned*)(lds + (bufoff) + ldsw + _i * 8192), 16, 0, 0); } while (0)
#define PG8_LDA(dst, b, h) do { _Pragma("unroll") for (int m = 0; m < 4; ++m) _Pragma("unroll") for (int k = 0; k < 2; ++k) dst[m][k] = *(const PG8_LAS bf16x8*)(lds + PG8_SA(b, h) + aoff + m * 2048 + k * 1024); } while (0)
#define PG8_LDB(dst, b, h) do { _Pragma("unroll") for (int n = 0; n < 2; ++n) _Pragma("unroll") for (int k = 0; k < 2; ++k) dst[n][k] = *(const PG8_LAS bf16x8*)(lds + PG8_SB(b, h) + boff + n * 2048 + k * 1024); } while (0)
#define PG8_CAT(x0, x1) __builtin_shufflevector(__builtin_bit_cast(i32x4_t, x0), __builtin_bit_cast(i32x4_t, x1), 0, 1, 2, 3, 4, 5, 6, 7)
#define PG8_MMA(ai, bj, At, Bt) do { __builtin_amdgcn_s_setprio(1); \
        if constexpr (F8SC != 0) { _Pragma("unroll") for (int m = 0; m < 4; ++m) _Pragma("unroll") for (int n = 0; n < 2; ++n) \
            asm volatile("v_mfma_f32_16x16x128_f8f6f4 %0, %1, %2, %0" : "+v"(acc[ai][bj][m][n]) : "v"(PG8_CAT(Bt[n][0], Bt[n][1])), "v"(PG8_CAT(At[m][0], At[m][1]))); } \
        else { _Pragma("unroll") for (int m = 0; m < 4; ++m) _Pragma("unroll") for (int n = 0; n < 2; ++n) _Pragma("unroll") for (int k = 0; k < 2; ++k) \
            acc[ai][bj][m][n] = __builtin_amdgcn_mfma_f32_16x16x32_bf16(Bt[n][k], At[m][k], acc[ai][bj][m][n], 0, 0, 0); } \
        __builtin_amdgcn_s_setprio(0); } while (0)
#define PG8_WAIT_V(n) asm volatile("s_waitcnt vmcnt(" #n ")" ::: "memory")
#define PG8_WAIT_L(n) asm volatile("s_waitcnt lgkmcnt(" #n ")" ::: "memory")
#define PG8_BAR __builtin_amdgcn_s_barrier()
#define PG8_SCHED __builtin_amdgcn_sched_barrier(0)
    Unit cur, nxt; int ui = 0;
    if (!S.next(0, cur)) return;
    f32x4 acc[2][2][4][2];
#pragma unroll
    for (int a = 0; a < 2; ++a)
#pragma unroll
        for (int b = 0; b < 2; ++b)
#pragma unroll
            for (int m = 0; m < 4; ++m)
#pragma unroll
                for (int n = 0; n < 2; ++n) acc[a][b][m][n] = (f32x4){0.f, 0.f, 0.f, 0.f};
    bf16x8 At[4][2], B0[2][2], B1[2][2];
    const char* cA = g.a(cur); const char* cB = g.b(cur);
    PG8_STAGE(PG8_SB(0, 0), cB, voffB); PG8_STAGE(PG8_SB(0, 1), cB + hsB, voffB); PG8_STAGE(PG8_SA(0, 0), cA, voffA); PG8_STAGE(PG8_SA(0, 1), cA + hsA, voffA);
    if (wr == 1) PG8_BAR;
    PG8_WAIT_V(2); PG8_BAR;
    PG8_STAGE(PG8_SB(1, 0), cB + kstep, voffB); PG8_STAGE(PG8_SA(1, 0), cA + kstep, voffA); PG8_STAGE(PG8_SB(1, 1), cB + hsB + kstep, voffB);
    PG8_WAIT_V(6); PG8_BAR;
    for (;;) {
        const bool has_next = S.next(ui + 1, nxt);
        const char* nA = has_next ? g.a(nxt) : cA; const char* nB = has_next ? g.b(nxt) : cB;
#pragma unroll 1
        for (int t = 0; t < nt; t += 2) {
            const bool last = (t == nt - 2);
            const char* a1 = cA + (size_t)(t + 1) * kstep;
            const char* a2 = last ? nA : cA + (size_t)(t + 2) * kstep; const char* b2 = last ? nB : cB + (size_t)(t + 2) * kstep;
            const char* a3 = a2 + kstep; const char* b3 = b2 + kstep;
            PG8_LDB(B0, 0, 0); PG8_LDB(B1, 0, 1); PG8_SCHED; PG8_LDA(At, 0, 0); PG8_STAGE(PG8_SA(1, 1), a1 + hsA, voffA);
            PG8_WAIT_V(8); PG8_WAIT_L(0); PG8_BAR; PG8_MMA(0, 0, At, B0); PG8_MMA(0, 1, At, B1); PG8_BAR; PG8_SCHED;
            PG8_LDA(At, 0, 1); PG8_STAGE(PG8_SB(0, 0), b2, voffB); PG8_STAGE(PG8_SB(0, 1), b2 + hsB, voffB); PG8_STAGE(PG8_SA(0, 0), a2, voffA);
            PG8_WAIT_V(8); PG8_WAIT_L(0); PG8_BAR; PG8_MMA(1, 0, At, B0); PG8_MMA(1, 1, At, B1); PG8_BAR; PG8_SCHED;
            PG8_LDB(B0, 1, 0); PG8_LDB(B1, 1, 1); PG8_SCHED; PG8_LDA(At, 1, 0); PG8_STAGE(PG8_SA(0, 1), a2 + hsA, voffA);
            PG8_WAIT_V(8); PG8_WAIT_L(0); PG8_BAR; PG8_MMA(0, 0, At, B0); PG8_MMA(0, 1, At, B1); PG8_BAR; PG8_SCHED;
            PG8_LDA(At, 1, 1); PG8_STAGE(PG8_SB(1, 0), b3, voffB); PG8_STAGE(PG8_SB(1, 1), b3 + hsB, voffB); PG8_STAGE(PG8_SA(1, 0), a3, voffA);
            PG8_WAIT_V(8); PG8_WAIT_L(0); PG8_BAR; PG8_MMA(1, 0, At, B0); PG8_MMA(1, 1, At, B1); PG8_BAR; PG8_SCHED;
        }
        if constexpr (F8SC != 0) asm volatile("s_nop 15\n\ts_nop 15" ::: "memory");
        if (wr == 0) PG8_BAR;
        E(acc, cur, wr, wc, fr, fq);
        if (!has_next) break;
#pragma unroll
        for (int a = 0; a < 2; ++a)
#pragma unroll
            for (int b = 0; b < 2; ++b)
#pragma unroll
                for (int m = 0; m < 4; ++m)
#pragma unroll
                    for (int n = 0; n < 2; ++n) acc[a][b][m][n] = (f32x4){0.f, 0.f, 0.f, 0.f};
        cur = nxt; cA = nA; cB = nB; ++ui;
        if (wr == 1) PG8_BAR;
    }
    PG8_WAIT_V(0);
    PG8_BAR;
#undef PG8_SA
#undef PG8_SB
#undef PG8_STAGE
#undef PG8_LDA
#undef PG8_LDB
#undef PG8_MMA
#undef PG8_CAT
#undef PG8_WAIT_V
#undef PG8_WAIT_L
#undef PG8_BAR
#undef PG8_SCHED
}
}

#define XB_TMO      128
#define XB_XCNT(j)  (256  + 64 * (j))
#define XB_XSUB(j)  (1280 + 64 * (j))
#define XB_XGEN(j)  (2304 + 64 * (j))
#define XB_TOP      3328
#define XB_TOPGEN   3392
#define XCD_BAR_WORDS 3456
#define XB_SPIN_CAP (1u << 18)
__device__ __forceinline__ unsigned xb_ld(unsigned* p)              { return __hip_atomic_load(p, __ATOMIC_RELAXED, __HIP_MEMORY_SCOPE_AGENT); }
__device__ __forceinline__ unsigned xb_add(unsigned* p, unsigned v) { return __hip_atomic_fetch_add(p, v, __ATOMIC_RELAXED, __HIP_MEMORY_SCOPE_AGENT); }
__device__ __forceinline__ unsigned xb_xcc_id() { return (unsigned)__builtin_amdgcn_s_getreg((3 << 11) | 20) & 0xFu; }
#define XB_SPIN(cond, bar) do { unsigned _sp = 0; while (cond) { __builtin_amdgcn_s_sleep(1); \
    if ((++_sp & 255u) == 0u) { if (xb_ld(&(bar)[XB_TMO])) break; if (_sp > XB_SPIN_CAP) { atomicAdd(&(bar)[XB_TMO], 1u); break; } } } } while (0)
struct XcdBarrier { unsigned* bar; unsigned x; volatile LAS unsigned* st; };
__device__ __forceinline__ XcdBarrier xcd_barrier_post(unsigned* bar, volatile LAS unsigned* st) {
    XcdBarrier b; b.bar = bar; b.x = xb_xcc_id(); b.st = st;
    if (threadIdx.x == 0) (void)xb_add(&bar[XB_XCNT(b.x)], 1u);
    return b;
}
__device__ __forceinline__ void xcd_barrier_complete(unsigned* bar, unsigned x, unsigned& nloc, unsigned& nx) {
    const unsigned G = gridDim.x * gridDim.y * gridDim.z;
    unsigned sum, cnt, mine, sp = 0u;
    for (;;) {
        sum = 0u; cnt = 0u; mine = 0u;
#pragma unroll
        for (unsigned j = 0; j < 16; ++j) { const unsigned c = xb_ld(&bar[XB_XCNT(j)]); sum += c; cnt += (c > 0u) ? 1u : 0u; mine = (j == x) ? c : mine; }
        if (sum == G) break;
        __builtin_amdgcn_s_sleep(1);
        if ((++sp & 255u) == 0u) { if (xb_ld(&bar[XB_TMO])) break; if (sp > XB_SPIN_CAP) { atomicAdd(&bar[XB_TMO], 1u); break; } }
    }
    nloc = mine > 0u ? mine : 1u; nx = cnt > 0u ? cnt : 1u;
}
__device__ __forceinline__ void xcd_barrier(const XcdBarrier& b) {
    asm volatile("s_waitcnt vmcnt(0)" ::: "memory");
    __syncthreads();
    if (threadIdx.x == 0) {
        unsigned* bar = b.bar;
        __builtin_amdgcn_s_waitcnt(0);
        unsigned nloc = b.st[0], nx = b.st[1];
        if (nloc == 0u) { xcd_barrier_complete(bar, b.x, nloc, nx); b.st[0] = nloc; b.st[1] = nx; }
        const unsigned old = xb_add(&bar[XB_XSUB(b.x)], 1u);
        const unsigned gen = old / nloc;
        if (old + 1u == (gen + 1u) * nloc) {
            __builtin_amdgcn_fence(__ATOMIC_RELEASE, "agent");
            asm volatile("s_waitcnt vmcnt(0)" ::: "memory");
            const unsigned og = xb_add(&bar[XB_TOP], 1u);
            const unsigned tg = og / nx;
            if (og + 1u == (tg + 1u) * nx) xb_add(&bar[XB_TOPGEN], 1u);
            else XB_SPIN(xb_ld(&bar[XB_TOPGEN]) == tg, bar);
            __builtin_amdgcn_fence(__ATOMIC_ACQUIRE, "agent");
            xb_add(&bar[XB_XGEN(b.x)], 1u);
            asm volatile("s_waitcnt vmcnt(0)" ::: "memory");
        } else {
            XB_SPIN(xb_ld(&bar[XB_XGEN(b.x)]) == gen, bar);
            __builtin_amdgcn_fence(__ATOMIC_ACQUIRE, "agent");
            asm volatile("s_waitcnt vmcnt(0)" ::: "memory");
        }
    }
    __syncthreads();
}

struct Args { const float* in[26]; float* out; unsigned char* ws; int ph_lo, ph_hi; };
struct Frame {
    LAS unsigned char* lds;
    int tid, lane, wave, G, bid;
    const float* const* in; float* out; unsigned char* ws;
};

template <bool F8 = false> __device__ __forceinline__ void tr_item(const float* W, int ldw, bf16* WT, int ldt, float scale, const float* kscale, LAS float* scr, int k0, int lane) {
#pragma unroll 8
    for (int i = 0; i < 32; ++i) { const int kk = 2 * i + (lane >> 5); float v = W[(size_t)(k0 + kk) * ldw + (lane & 31)] * scale; if (kscale) v *= kscale[k0 + kk]; scr[kk * 33 + (lane & 31)] = v; }
    LDS_WAIT(); asm volatile("" ::: "memory");
    const int c = lane & 7;
#pragma unroll
    for (int j = 0; j < 4; ++j) { const int n = (lane >> 3) + 8 * j; const LAS float* s = scr + (8 * c) * 33 + n;
        if constexpr (F8) {
            int p0 = 0, p1 = 0; p0 = __builtin_amdgcn_cvt_pk_fp8_f32(s[0 * 33], s[1 * 33], p0, false); p0 = __builtin_amdgcn_cvt_pk_fp8_f32(s[2 * 33], s[3 * 33], p0, true);
            p1 = __builtin_amdgcn_cvt_pk_fp8_f32(s[4 * 33], s[5 * 33], p1, false); p1 = __builtin_amdgcn_cvt_pk_fp8_f32(s[6 * 33], s[7 * 33], p1, true);
            *(GAS v2u*)((GAS unsigned char*)WT + (size_t)n * ldt + k0 + 8 * c) = (v2u){(unsigned)p0, (unsigned)p1};
        } else {
        v4u o; o.x = pk2(s[0 * 33], s[1 * 33]); o.y = pk2(s[2 * 33], s[3 * 33]); o.z = pk2(s[4 * 33], s[5 * 33]); o.w = pk2(s[6 * 33], s[7 * 33]);
        *(GAS v4u*)(WT + (size_t)n * ldt + k0 + 8 * c) = o; } }
    LDS_WAIT(); asm volatile("" ::: "memory");
}

__device__ __forceinline__ void p0_prologue(Frame& F) {
    LAS float* scr = (LAS float*)(F.lds + F.wave * 16384);
    const int gw = F.bid * NWAVES + F.wave, NGW = F.G * NWAVES;
    unsigned char* ws = F.ws;
    const float* w_in = F.in[2];
    constexpr int I_WIN = 16 * 192, I_QKV = 12 * 32, I_LRU = 32 * 8, I_WB = 2 * 512, I_WO = 2 * 512, I_PQ = 16 * 64;
    constexpr int NITEMS = I_WIN + I_QKV + I_LRU + I_WB + I_WO + I_PQ;
    for (int it = gw; it < NITEMS; it += NGW) {
        int r = it;
        if (r < I_WIN) { const int kb = r / 192, nb = r % 192, n0 = nb * 32, sc = n0 < 2048 ? n0 : n0 + 16;
            if ((n0 >= 1024 && n0 < 2048) || n0 >= 4096) tr_item<true>(w_in + sc, DIN, (bf16*)(ws + WS_WIN8 + (size_t)n0 * 1024), 1024, 1024.f, nullptr, scr, kb * 64, F.lane);
            else tr_item(w_in + sc, DIN, (bf16*)(ws + WS_WIN) + (size_t)n0 * 1024, 1024, 1.f, nullptr, scr, kb * 64, F.lane);
            continue; }
        r -= I_WIN;
        if (r < I_QKV) { const int mat = r / 32, rr = r % 32, kb = rr / 8, nb = rr % 8, g = mat >> 2, h = mat & 3;
            const float* W = F.in[6 + g] + (size_t)h * 65536 + nb * 32;
            tr_item(W, 256, (bf16*)(ws + WS_WQKV) + (size_t)mat * 65536 + (size_t)(nb * 32) * 256, 256, g == 1 ? 0.0625f : 1.f, nullptr, scr, kb * 64, F.lane); continue; }
        r -= I_QKV;
        if (r < I_LRU) { const int mat = r / 8, rr = r % 8, kb = rr / 4, nb = rr % 4, gate = mat & 1, db = mat >> 1;
            const float* W = F.in[gate ? 14 : 12] + (size_t)db * 16384 + nb * 32;
            tr_item(W, 128, (bf16*)(ws + WS_WLRU) + (size_t)mat * 16384 + (size_t)(nb * 32) * 128, 128, 1.f, nullptr, scr, kb * 64, F.lane); continue; }
        r -= I_LRU;
        if (r < I_WB) { const int mat = r / 512, rr = r % 512, kb = rr / 32, nb = rr % 32;
            const float* W = F.in[17 + mat] + nb * 32;
            tr_item(W, 1024, (bf16*)(ws + WS_WB2) + (size_t)(mat * 1024 + nb * 32) * 1024, 1024, 1.f, nullptr, scr, kb * 64, F.lane); continue; }
        r -= I_WB;
        if (r < I_WO) { const int cp = r / 512, rr = r % 512, kb = rr / 32, nb = rr % 32;
            const float* W = F.in[19] + nb * 32;
            tr_item(W, 1024, (bf16*)(ws + WS_WOUT2) + (size_t)(nb * 32) * 2048 + cp * 1024, 2048, 1.f, nullptr, scr, kb * 64, F.lane); continue; }
        r -= I_WO;
        { const int kb = r / 64, nb = r % 64;
            const float* W = F.in[21] + nb * 32;
            tr_item(W, 2048, (bf16*)(ws + WS_WPQ) + (size_t)(nb * 32) * 1024, 1024, 1.f, F.in[20], scr, kb * 64, F.lane); }
    }
    { const int gt = F.bid * NTHR + F.tid, NGT = F.G * NTHR;
      const float4* ks = (const float4*)F.in[22]; v2u* kd = (v2u*)(ws + WS_KEYS);
      for (int i = gt; i < 8 * 2 * 128 * 128 / 4; i += NGT) { const float4 v = ks[i]; v2u o; o.x = pk2(v.x, v.y); o.y = pk2(v.z, v.w); kd[i] = o; }
      float* ss = (float*)(ws + WS_SS);
      for (int i = gt; i < MTOK; i += NGT) ss[i] = 0.f; }
    { const int gt = F.bid * NTHR + F.tid;
      if (gt < 16 * 128) { const int c = gt >> 7, k8 = gt & 127; v4u o; unsigned wv[4];
#pragma unroll
          for (int j = 0; j < 4; ++j) wv[j] = pk2(w_in[(size_t)(k8 * 8 + 2 * j) * DIN + 2048 + c], w_in[(size_t)(k8 * 8 + 2 * j + 1) * DIN + 2048 + c]);
          o.x = wv[0]; o.y = wv[1]; o.z = wv[2]; o.w = wv[3]; *(v4u*)((bf16*)(ws + WS_WGT) + c * 1024 + k8 * 8) = o; } }
    const float* x = F.in[0]; const float* g1 = F.in[1];
    bf16* XN = (bf16*)(ws + WS_K);
    unsigned char* XN8 = (unsigned char*)F.out;
    f32x4 gv[4];
#pragma unroll
    for (int j = 0; j < 4; ++j) gv[j] = ((const f32x4*)g1)[F.lane + 64 * j];
    for (int m = 2 * gw; m < MTOK; m += 2 * NGW) {
        const f32x4* xr0 = (const f32x4*)(x + (size_t)m * DM) + F.lane; const f32x4* xr1 = xr0 + DM / 4;
        f32x4 v0[4], v1[4]; float s0 = 0.f, s1 = 0.f;
#pragma unroll
        for (int j = 0; j < 4; ++j) { v0[j] = xr0[64 * j]; v1[j] = xr1[64 * j]; }
#pragma unroll
        for (int j = 0; j < 4; ++j) { s0 += (v0[j].x * v0[j].x + v0[j].y * v0[j].y) + (v0[j].z * v0[j].z + v0[j].w * v0[j].w); s1 += (v1[j].x * v1[j].x + v1[j].y * v1[j].y) + (v1[j].z * v1[j].z + v1[j].w * v1[j].w); }
        const float r0 = rsqrtf(wave_sum(s0) * (1.f / DM) + EPS), r1 = rsqrtf(wave_sum(s1) * (1.f / DM) + EPS);
        unsigned long long* o0 = (unsigned long long*)(XN + (size_t)m * DM) + F.lane; unsigned long long* o1 = o0 + DM / 4;
        unsigned* q0 = (unsigned*)(XN8 + (size_t)m * DM) + F.lane; unsigned* q1 = q0 + DM / 4;
#pragma unroll
        for (int j = 0; j < 4; ++j) { const f32x4 a = v0[j] * r0 * gv[j], c = v1[j] * r1 * gv[j];
            o0[64 * j] = (unsigned long long)pk2(a.x, a.y) | ((unsigned long long)pk2(a.z, a.w) << 32);
            o1[64 * j] = (unsigned long long)pk2(c.x, c.y) | ((unsigned long long)pk2(c.z, c.w) << 32);
            int pa = 0, pc = 0; pa = __builtin_amdgcn_cvt_pk_fp8_f32(a.x, a.y, pa, false); pa = __builtin_amdgcn_cvt_pk_fp8_f32(a.z, a.w, pa, true);
            pc = __builtin_amdgcn_cvt_pk_fp8_f32(c.x, c.y, pc, false); pc = __builtin_amdgcn_cvt_pk_fp8_f32(c.z, c.w, pc, true);
            q0[64 * j] = (unsigned)pa; q1[64 * j] = (unsigned)pc; }
    }
}
__device__ __forceinline__ void gates_phase(Frame& F) {
    const bf16* XN = (const bf16*)(F.ws + WS_K); const bf16* WGT = (const bf16*)(F.ws + WS_WGT); float* GT = (float*)(F.ws + WS_GATE);
    const int lane = F.lane, fr = lane & 15, fq = lane >> 4;
    const f32x4 bg4 = *(const f32x4*)(F.in[3] + 4 * fq);
    for (int task = F.bid * NWAVES + F.wave; task < MTOK / 16; task += F.G * NWAVES) {
        const size_t m0 = (size_t)task * 16;
        f32x4 acc = (f32x4){0.f, 0.f, 0.f, 0.f};
#pragma unroll 8
        for (int ks = 0; ks < 32; ++ks) {
            const bf16x8 wfr = *(const bf16x8*)(WGT + fr * 1024 + 32 * ks + 8 * fq);
            const bf16x8 xfr = *(const bf16x8*)(XN + (m0 + fr) * DM + 32 * ks + 8 * fq);
            acc = __builtin_amdgcn_mfma_f32_16x16x32_bf16(wfr, xfr, acc, 0, 0, 0);
        }
        *(f32x4*)(GT + (m0 + fr) * 16 + 4 * fq) = acc + bg4;
    }
}

struct AddrPlain {
    const char* A; const char* Bt; int lda, ldb, K;
    __device__ __forceinline__ const char* a(const pg8::Unit& u) const { return A + (size_t)u.pm * 256 * lda * 2; }
    __device__ __forceinline__ const char* b(const pg8::Unit& u) const { return Bt + (size_t)u.pn * 256 * ldb * 2; }
};
struct AddrP1 {
    const char* A; const char* Bt; int lda, ldb, K, lo_add, hi_add;
    __device__ __forceinline__ const char* a(const pg8::Unit& u) const { return A + (size_t)u.pm * 256 * lda * 2; }
    __device__ __forceinline__ const char* b(const pg8::Unit& u) const { return Bt + (size_t)(u.pn + (u.pn < 4 ? lo_add : hi_add)) * 256 * ldb * 2; }
};
struct AddrQKV {
    const char* XC; long dXM; const char* W; int lda, ldb, K;
    __device__ __forceinline__ const char* a(const pg8::Unit& u) const { return XC + (u.pn < 8 ? 0l : dXM) + ((size_t)u.pm * 256 * 1024 + (u.pn & 3) * 256) * 2; }
    __device__ __forceinline__ const char* b(const pg8::Unit& u) const { return W + (size_t)u.pn * 65536 * 2; }
};
struct AddrBranch {
    const char* YM; long dYL; const char* W; int lda, ldb, K;
    __device__ __forceinline__ const char* a(const pg8::Unit& u) const { return YM + (u.pn < 4 ? 0l : dYL) + (size_t)u.pm * 256 * 1024 * 2; }
    __device__ __forceinline__ const char* b(const pg8::Unit& u) const { return W + (size_t)u.pn * 256 * 1024 * 2; }
};

struct DstP1 { unsigned char* ws; int lo_add, hi_add;
    __device__ __forceinline__ bf16* get(int j, int& ld, int& col0) const {
        const int pn = j + (j < 4 ? lo_add : hi_add); const bool mg = pn >= 16; ld = mg ? 2048 : 1024; col0 = mg ? (pn - 16) * 256 : (pn & 3) * 256;
        return (bf16*)(ws + (mg ? WS_MG : WS_XM + (size_t)(pn >> 2) * 64 * MiB)); } };
struct DstQKV { char* q; long dk, dv;
    __device__ __forceinline__ bf16* get(int pn, int& ld, int& col0) const { ld = 1024; col0 = (pn & 3) * 256; return (bf16*)(q + (pn >= 4 ? (pn >= 8 ? dv : dk) : 0l)); } };
template <class Dst, bool MUL = false> struct EpiBf16 {
    static constexpr bool PERM = true;
    Dst dst; float mul;
    __device__ __forceinline__ void operator()(const f32x4 (&acc)[2][2][4][2], const pg8::Unit& u, int wr, int wc, int fr, int fq) const {
        int ld, colt; bf16* base = dst.get(u.pn, ld, colt);
        const int row0 = u.pm * 256 + wr * 64 + fr, col0 = colt + wc * 32 + 8 * fq;
#pragma unroll
        for (int ai = 0; ai < 2; ++ai)
#pragma unroll
            for (int m = 0; m < 4; ++m) { bf16* rowp = base + (size_t)(row0 + ai * 128 + m * 16) * ld + col0;
#pragma unroll
                for (int bj = 0; bj < 2; ++bj) { f32x4 v0 = acc[ai][bj][m][0], v1 = acc[ai][bj][m][1]; if (MUL) { v0 = v0 * mul; v1 = v1 * mul; }
                    v4u w; w.x = pg8::cvt_pk_bf16(v0[0], v0[1]); w.y = pg8::cvt_pk_bf16(v0[2], v0[3]); w.z = pg8::cvt_pk_bf16(v1[0], v1[1]); w.w = pg8::cvt_pk_bf16(v1[2], v1[3]);
                    *(v4u*)(rowp + bj * 128) = w; } }
    }
};
template <bool ADD> struct EpiMerge {
    static constexpr bool PERM = true;
    bf16* MRG; const bf16* MG; int gcol;
    __device__ __forceinline__ void operator()(const f32x4 (&acc)[2][2][4][2], const pg8::Unit& u, int wr, int wc, int fr, int fq) const {
        const int row0 = u.pm * 256 + wr * 64 + fr, col0 = u.pn * 256 + wc * 32 + 8 * fq;
#pragma unroll
        for (int ai = 0; ai < 2; ++ai)
#pragma unroll
            for (int m = 0; m < 4; ++m) { const size_t row = (size_t)(row0 + ai * 128 + m * 16); bf16* rowp = MRG + row * 1024 + col0; const bf16* gp = MG + row * 2048 + gcol + col0;
#pragma unroll
                for (int bj = 0; bj < 2; ++bj) { const f32x4 v0 = acc[ai][bj][m][0], v1 = acc[ai][bj][m][1];
                    const v4u g = *(const v4u*)(gp + bj * 128);
                    float o[8] = {v0[0] * sigmoidf_(bflo(g.x)), v0[1] * sigmoidf_(bfhi(g.x)), v0[2] * sigmoidf_(bflo(g.y)), v0[3] * sigmoidf_(bfhi(g.y)),
                                  v1[0] * sigmoidf_(bflo(g.z)), v1[1] * sigmoidf_(bfhi(g.z)), v1[2] * sigmoidf_(bflo(g.w)), v1[3] * sigmoidf_(bfhi(g.w))};
                    if (ADD) { const v4u t = *(const v4u*)(rowp + bj * 128);
                        o[0] += bflo(t.x); o[1] += bfhi(t.x); o[2] += bflo(t.y); o[3] += bfhi(t.y); o[4] += bflo(t.z); o[5] += bfhi(t.z); o[6] += bflo(t.w); o[7] += bfhi(t.w); }
                    v4u w; w.x = pg8::cvt_pk_bf16(o[0], o[1]); w.y = pg8::cvt_pk_bf16(o[2], o[3]); w.z = pg8::cvt_pk_bf16(o[4], o[5]); w.w = pg8::cvt_pk_bf16(o[6], o[7]);
                    *(v4u*)(rowp + bj * 128) = w; } }
    }
};
struct EpiResid {
    static constexpr bool PERM = false;
    const float* x; float* x1; bf16* x1b; float* ss;
    __device__ __forceinline__ void operator()(const f32x4 (&acc)[2][2][4][2], const pg8::Unit& u, int wr, int wc, int fr, int fq) const {
        const int row0 = u.pm * 256 + wr * 64 + fr, col0 = u.pn * 256 + wc * 32 + 4 * fq;
#pragma unroll
        for (int ai = 0; ai < 2; ++ai)
#pragma unroll
            for (int m = 0; m < 4; ++m) { const int row = row0 + ai * 128 + m * 16; const size_t off = (size_t)row * DM + col0; float s = 0.f;
#pragma unroll
                for (int bj = 0; bj < 2; ++bj)
#pragma unroll
                    for (int n = 0; n < 2; ++n) { const size_t o = off + bj * 128 + n * 16; const f32x4 v = *(const f32x4*)(x + o) + acc[ai][bj][m][n];
                        *(f32x4*)(x1 + o) = v; v2u w; w.x = pg8::cvt_pk_bf16(v[0], v[1]); w.y = pg8::cvt_pk_bf16(v[2], v[3]); *(v2u*)(x1b + o) = w;
                        s += (v[0] * v[0] + v[1] * v[1]) + (v[2] * v[2] + v[3] * v[3]); }
                s += __shfl_xor(s, 16); s += __shfl_xor(s, 32);
                if (fq == 0) atomicAdd(ss + row, s); }
    }
};
struct EpiPQ {
    static constexpr bool PERM = true;
    bf16* pq; const float* ss;
    __device__ __forceinline__ void operator()(const f32x4 (&acc)[2][2][4][2], const pg8::Unit& u, int wr, int wc, int fr, int fq) const {
        const int row0 = u.pm * 256 + wr * 64 + fr, col0 = u.pn * 256 + wc * 32 + 8 * fq;
#pragma unroll
        for (int ai = 0; ai < 2; ++ai)
#pragma unroll
            for (int m = 0; m < 4; ++m) { const int row = row0 + ai * 128 + m * 16; bf16* rowp = pq + (size_t)row * 2048 + col0;
                const float r = rsqrtf(ss[row] * (1.f / DM) + EPS);
#pragma unroll
                for (int bj = 0; bj < 2; ++bj) { const f32x4 v0 = acc[ai][bj][m][0] * r, v1 = acc[ai][bj][m][1] * r;
                    v4u w; w.x = pg8::cvt_pk_bf16(v0[0], v0[1]); w.y = pg8::cvt_pk_bf16(v0[2], v0[3]); w.z = pg8::cvt_pk_bf16(v1[0], v1[1]); w.w = pg8::cvt_pk_bf16(v1[2], v1[3]);
                    *(v4u*)(rowp + bj * 128) = w; } }
    }
};

template <bool PB> __device__ __forceinline__ void lru_phase(Frame& F) {
    const bf16* XL = (const bf16*)(F.ws + WS_XL); const bf16* LG = (const bf16*)(F.ws + WS_LG); bf16* YL = (bf16*)F.out;
    f32x2* AGG = (f32x2*)(F.ws + WS_AGG);
    const bf16* WL = (const bf16*)(F.ws + WS_WLRU);
    const float* cw = F.in[10]; const float* cb = F.in[11];
    constexpr int O_XCB = 0, O_XCF = 17408, O_A = 51200, O_U = 84992, FST = 528;
    LAS unsigned char* L = F.lds;
    const int tid = F.tid, lane = F.lane, w = F.wave, fr = lane & 15, fq = lane >> 4;
    int cur_blk = -1;
    bf16x8 wf[2][2][4];
    f32x4 br4[2], bi4[2], sp4[2];
    v4u rawreg[3];
#define RAW_LOAD(bb, tt0, bk) do { _Pragma("unroll") for (int r_ = 0; r_ < 3; ++r_) { const int e_ = tid + NTHR * r_, row_ = e_ >> 4, c16_ = e_ & 15, t_ = (tt0) - 2 + row_; \
            v4u v_ = {0u, 0u, 0u, 0u}; if (e_ < 68 * 16 && t_ >= 0 && t_ < SEQ) v_ = *(const v4u*)(XL + ((size_t)(bb) * SEQ + t_) * DM + (bk) * 128 + c16_ * 8); rawreg[r_] = v_; } } while (0)
    constexpr int O_CARRY = 118784, O_CW = 135168, O_SUB = 137728;
    const bool carry_tab = PB && (F.G == 256);
    if (carry_tab) {
        const int ch = tid & 127, bq = tid >> 7, s0 = F.bid >> 3, blk0 = F.bid & 7;
        LAS float* CT = (LAS float*)(L + O_CARRY);
#define FOLD(agp, j0, j1, stp, hv) do { int js_ = (j0); const int n_ = ((j1) - (j0)) * (stp); int k_ = 0; \
            for (; k_ + 8 <= n_; k_ += 8) { f32x2 ah_[8]; _Pragma("unroll") for (int q_ = 0; q_ < 8; ++q_) ah_[q_] = (agp)[(size_t)(js_ + q_ * (stp)) * 2 * DM]; \
                _Pragma("unroll") for (int q_ = 0; q_ < 8; ++q_) hv = ah_[q_][0] * hv + ah_[q_][1]; js_ += 8 * (stp); } \
            for (; k_ < n_; ++k_) { const f32x2 a1_ = (agp)[(size_t)js_ * 2 * DM]; hv = a1_[0] * hv + a1_[1]; js_ += (stp); } } while (0)
        for (int bb = 2 * bq; bb < 2 * bq + 2; ++bb) {
            const f32x2* ag0 = AGG + ((size_t)(bb * 64) * 2 + 0) * DM + blk0 * 128 + ch; const f32x2* ag1 = AGG + ((size_t)(bb * 64) * 2 + 1) * DM + blk0 * 128 + ch;
            float h = 0.f;
            FOLD(ag0, 0, s0, 1, h); CT[((bb * 2 + 0) * 2 + 0) * 128 + ch] = h;
            FOLD(ag0, s0, s0 + 32, 1, h); CT[((bb * 2 + 1) * 2 + 0) * 128 + ch] = h;
            h = 0.f;
            FOLD(ag1, 63, s0 + 32, -1, h); CT[((bb * 2 + 1) * 2 + 1) * 128 + ch] = h;
            FOLD(ag1, s0 + 32, s0, -1, h); CT[((bb * 2 + 0) * 2 + 1) * 128 + ch] = h;
        }
        __syncthreads();
#undef FOLD
    }
    for (int i = 0;; ++i) {
        const int idx = i * F.G + F.bid; if (idx >= 4096) break;
        const int blk = idx & 7, j = idx >> 3, b = j >> 6, seg = j & 63, t0 = seg * 64;
        const size_t mrow0 = (size_t)b * SEQ + t0;
        if (blk != cur_blk) {
            cur_blk = blk;
#pragma unroll
            for (int d = 0; d < 2; ++d) {
#pragma unroll
                for (int g = 0; g < 2; ++g)
#pragma unroll
                    for (int ks = 0; ks < 4; ++ks)
                        wf[d][g][ks] = *(const bf16x8*)(WL + ((size_t)((d * 8 + blk) * 2 + g) * 128 + 16 * w + fr) * 128 + 32 * ks + 8 * fq);
                const int ch = blk * 128 + 16 * w + 4 * fq;
                br4[d] = *(const f32x4*)(F.in[13] + d * DM + ch); bi4[d] = *(const f32x4*)(F.in[15] + d * DM + ch);
                const f32x4 lm = *(const f32x4*)(F.in[16] + d * DM + ch);
#pragma unroll
                for (int e = 0; e < 4; ++e) sp4[d][e] = -8.f * 1.44269504089f * softplusf_(-lm[e]);
            }
            __syncthreads();
            for (int e = tid; e < 5 * 128; e += NTHR) { const int jt = e >> 7, cc = e & 127; ((LAS float*)(L + O_CW))[e] = (jt < 4) ? cw[jt * DM + blk * 128 + cc] : cb[blk * 128 + cc]; }
        }
        if (i == 0) RAW_LOAD(b, t0, blk);
#pragma unroll
        for (int r = 0; r < 3; ++r) { const int e = tid + NTHR * r; if (e < 68 * 16) *(LAS v4u*)(L + O_A + (e >> 4) * 256 + (e & 15) * 16) = rawreg[r]; }
        __syncthreads();
        { const int idx2 = (i + 1) * F.G + F.bid; if (idx2 < 4096) { const int j2 = idx2 >> 3; RAW_LOAD(j2 >> 6, (j2 & 63) * 64, idx2 & 7); } }
        v4u lgreg[2];
        if (PB) {
#pragma unroll
            for (int r = 0; r < 2; ++r) { const int e = tid + NTHR * r; lgreg[r] = *(const v4u*)(LG + (mrow0 + (e >> 4)) * DM + blk * 128 + (e & 15) * 8); } }
        for (int e = tid; e < 64 * 16; e += NTHR) { const int tl = e >> 4, c16 = e & 15;
            float y[8];
            { const f32x4 a = *(const LAS f32x4*)(L + O_CW + 4 * 512 + c16 * 32), bq = *(const LAS f32x4*)(L + O_CW + 4 * 512 + c16 * 32 + 16); y[0] = a[0]; y[1] = a[1]; y[2] = a[2]; y[3] = a[3]; y[4] = bq[0]; y[5] = bq[1]; y[6] = bq[2]; y[7] = bq[3]; }
#pragma unroll
            for (int jt = 0; jt < 4; ++jt) { const v4u r = *(const LAS v4u*)(L + O_A + (tl + jt) * 256 + c16 * 16);
                const f32x4 wa = *(const LAS f32x4*)(L + O_CW + jt * 512 + c16 * 32), wb = *(const LAS f32x4*)(L + O_CW + jt * 512 + c16 * 32 + 16);
                y[0] += wa[0] * bflo(r.x); y[1] += wa[1] * bfhi(r.x); y[2] += wa[2] * bflo(r.y); y[3] += wa[3] * bfhi(r.y);
                y[4] += wb[0] * bflo(r.z); y[5] += wb[1] * bfhi(r.z); y[6] += wb[2] * bflo(r.w); y[7] += wb[3] * bfhi(r.w); }
            *(LAS f32x4*)(L + O_XCF + tl * FST + c16 * 32) = (f32x4){y[0], y[1], y[2], y[3]};
            *(LAS f32x4*)(L + O_XCF + tl * FST + c16 * 32 + 16) = (f32x4){y[4], y[5], y[6], y[7]};
            v4u o; o.x = pk2(y[0], y[1]); o.y = pk2(y[2], y[3]); o.z = pk2(y[4], y[5]); o.w = pk2(y[6], y[7]);
            *(LAS v4u*)(L + O_XCB + tl * 272 + c16 * 16) = o; }
        __syncthreads();
        float carry0 = 0.f, carry1 = 0.f;
        if (carry_tab) { const LAS float* CT = (const LAS float*)(L + O_CARRY); carry0 = CT[((b * 2 + (seg >> 5)) * 2 + 0) * 128 + (tid & 127)]; carry1 = CT[((b * 2 + (seg >> 5)) * 2 + 1) * 128 + (tid & 127)]; }
        else if (PB) {
            const int ch = blk * 128 + (tid & 127);
            float h = 0.f;
            const f32x2* ag0 = AGG + ((size_t)(b * 64) * 2 + 0) * DM + ch; const f32x2* ag1 = AGG + ((size_t)(b * 64) * 2 + 1) * DM + ch;
            int js = 0;
            for (; js + 8 <= seg; js += 8) { f32x2 ah[8];
#pragma unroll
                for (int q = 0; q < 8; ++q) ah[q] = ag0[(size_t)(js + q) * 2 * DM];
#pragma unroll
                for (int q = 0; q < 8; ++q) h = ah[q][0] * h + ah[q][1]; }
            for (; js < seg; ++js) { const f32x2 ah = ag0[(size_t)js * 2 * DM]; h = ah[0] * h + ah[1]; }
            carry0 = h; h = 0.f;
            js = 63;
            for (; js - 8 >= seg; js -= 8) { f32x2 ah[8];
#pragma unroll
                for (int q = 0; q < 8; ++q) ah[q] = ag1[(size_t)(js - q) * 2 * DM];
#pragma unroll
                for (int q = 0; q < 8; ++q) h = ah[q][0] * h + ah[q][1]; }
            for (; js > seg; --js) { const f32x2 ah = ag1[(size_t)js * 2 * DM]; h = ah[0] * h + ah[1]; }
            carry1 = h;
        }
#pragma unroll
        for (int d = 0; d < 2; ++d) {
            const int o_a = (d == 0) ? O_A : O_XCF;
            f32x4 aR[4], aI[4];
#pragma unroll
            for (int mt = 0; mt < 4; ++mt) { aR[mt] = (f32x4){0.f, 0.f, 0.f, 0.f}; aI[mt] = (f32x4){0.f, 0.f, 0.f, 0.f}; }
#pragma unroll
            for (int ks = 0; ks < 4; ++ks)
#pragma unroll
                for (int mt = 0; mt < 4; ++mt) { const bf16x8 xb = *(const LAS bf16x8*)(L + O_XCB + (16 * mt + fr) * 272 + (32 * ks + 8 * fq) * 2);
                    aR[mt] = __builtin_amdgcn_mfma_f32_16x16x32_bf16(wf[d][0][ks], xb, aR[mt], 0, 0, 0);
                    aI[mt] = __builtin_amdgcn_mfma_f32_16x16x32_bf16(wf[d][1][ks], xb, aI[mt], 0, 0, 0); }
#pragma unroll
            for (int mt = 0; mt < 4; ++mt) { const int tl = 16 * mt + fr, cl = 16 * w + 4 * fq;
                const f32x4 xc = *(const LAS f32x4*)(L + O_XCF + tl * FST + cl * 4);
                f32x4 av, uv;
#pragma unroll
                for (int e = 0; e < 4; ++e) { const float r = sigmoidf_(aR[mt][e] + br4[d][e]), ig = sigmoidf_(aI[mt][e] + bi4[d][e]);
                    const float a_ = __builtin_amdgcn_exp2f(r * sp4[d][e]); av[e] = a_; uv[e] = __builtin_amdgcn_sqrtf(fmaxf(1.f - a_ * a_, 0.f)) * (ig * xc[e]); }
                *(LAS f32x4*)(L + o_a + tl * FST + cl * 4) = av; *(LAS f32x4*)(L + O_U + tl * FST + cl * 4) = uv; }
            __syncthreads();
            {
                const int c = tid & 127, sub = tid >> 7;
                LAS float* pa = (LAS float*)(L + o_a) + c; const LAS float* pu = (const LAS float*)(L + O_U) + c;
                LAS f32x2* SUBT = (LAS f32x2*)(L + O_SUB);
                float h = 0.f, A = 1.f;
#pragma unroll
                for (int s2 = 0; s2 < 16; ++s2) { const int tl = d ? (16 * sub + 15 - s2) : (16 * sub + s2); const float a = pa[tl * 132], u = pu[tl * 132]; h = a * h + u; A *= a; }
                SUBT[sub * 128 + c] = (f32x2){A, h};
                __syncthreads();
                if (!PB) {
                    if (sub == 0) { float HH = 0.f, AA = 1.f;
#pragma unroll
                        for (int q = 0; q < 4; ++q) { const f32x2 ah = SUBT[(d ? 3 - q : q) * 128 + c]; HH = ah[0] * HH + ah[1]; AA *= ah[0]; }
                        AGG[((size_t)(b * 64 + seg) * 2 + d) * DM + blk * 128 + c] = (f32x2){AA, HH}; }
                } else {
                    float hc = d ? carry1 : carry0;
#pragma unroll
                    for (int q = 0; q < 3; ++q) { const int jq = d ? 3 - q : q; const f32x2 ah = SUBT[jq * 128 + c]; if (d ? (jq > sub) : (jq < sub)) hc = ah[0] * hc + ah[1]; }
                    if (d == 0) {
#pragma unroll
                        for (int s2 = 0; s2 < 16; ++s2) { const int tl = 16 * sub + s2; hc = pa[tl * 132] * hc + pu[tl * 132]; pa[tl * 132] = hc; }
                    } else { LAS float* ph = (LAS float*)(L + O_A) + c;
#pragma unroll
                        for (int s2 = 0; s2 < 16; ++s2) { const int tl = 16 * sub + 15 - s2; hc = pa[tl * 132] * hc + pu[tl * 132]; ph[tl * 132] += hc; } }
                }
            }
            __syncthreads();
        }
        if (PB) {
#pragma unroll
            for (int r = 0; r < 2; ++r) { const int e = tid + NTHR * r, row = e >> 4, c16 = e & 15;
                const v4u g = lgreg[r];
                const f32x4 h0 = *(const LAS f32x4*)(L + O_A + row * FST + c16 * 32), h1 = *(const LAS f32x4*)(L + O_A + row * FST + c16 * 32 + 16);
                v4u o;
                o.x = pk2(h0[0] * gelu_fast(bflo(g.x)), h0[1] * gelu_fast(bfhi(g.x))); o.y = pk2(h0[2] * gelu_fast(bflo(g.y)), h0[3] * gelu_fast(bfhi(g.y)));
                o.z = pk2(h1[0] * gelu_fast(bflo(g.z)), h1[1] * gelu_fast(bfhi(g.z))); o.w = pk2(h1[2] * gelu_fast(bflo(g.w)), h1[3] * gelu_fast(bfhi(g.w)));
                *(v4u*)(YL + (mrow0 + row) * DM + blk * 128 + c16 * 8) = o; }
            __syncthreads();
        }
    }
#undef RAW_LOAD
}

__device__ __forceinline__ void mconv_phase(Frame& F) {
    const bf16* XM = (const bf16*)(F.ws + WS_XM); bf16* XC = (bf16*)F.out + (size_t)MTOK * DM;
    const float* cw = F.in[4]; const float* cb = F.in[5];
    const int NT = MTOK / 32 * 128;
    for (int g = F.bid * NTHR + F.tid; g < NT; g += F.G * NTHR) {
        const int chunk = g & 127, run = g >> 7, c0 = chunk * 8, m0 = run * 32, t0 = m0 & (SEQ - 1);
        float w[4][8], bias[8];
#pragma unroll
        for (int j = 0; j < 4; ++j) { const f32x4 a = *(const f32x4*)(cw + j * DM + c0), b = *(const f32x4*)(cw + j * DM + c0 + 4);
            w[j][0] = a[0]; w[j][1] = a[1]; w[j][2] = a[2]; w[j][3] = a[3]; w[j][4] = b[0]; w[j][5] = b[1]; w[j][6] = b[2]; w[j][7] = b[3]; }
        { const f32x4 a = *(const f32x4*)(cb + c0), b = *(const f32x4*)(cb + c0 + 4);
            bias[0] = a[0]; bias[1] = a[1]; bias[2] = a[2]; bias[3] = a[3]; bias[4] = b[0]; bias[5] = b[1]; bias[6] = b[2]; bias[7] = b[3]; }
        v4u win[4];
        const v4u zero = {0u, 0u, 0u, 0u};
        win[0] = zero;
        win[1] = (t0 >= 2) ? *(const v4u*)(XM + (size_t)(m0 - 2) * DM + c0) : zero;
        win[2] = (t0 >= 1) ? *(const v4u*)(XM + (size_t)(m0 - 1) * DM + c0) : zero;
        win[3] = *(const v4u*)(XM + (size_t)m0 * DM + c0);
#pragma unroll 4
        for (int i = 0; i < 32; ++i) {
            win[0] = win[1]; win[1] = win[2]; win[2] = win[3];
            win[3] = (t0 + i + 1 < SEQ) ? *(const v4u*)(XM + (size_t)(m0 + i + 1) * DM + c0) : zero;
            float y[8];
#pragma unroll
            for (int e = 0; e < 8; ++e) y[e] = bias[e];
#pragma unroll
            for (int j = 0; j < 4; ++j) {
                const unsigned p0 = win[j].x, p1 = win[j].y, p2 = win[j].z, p3 = win[j].w;
                y[0] += w[j][0] * bflo(p0); y[1] += w[j][1] * bfhi(p0); y[2] += w[j][2] * bflo(p1); y[3] += w[j][3] * bfhi(p1);
                y[4] += w[j][4] * bflo(p2); y[5] += w[j][5] * bfhi(p2); y[6] += w[j][6] * bflo(p3); y[7] += w[j][7] * bfhi(p3);
            }
#pragma unroll
            for (int e = 0; e < 8; ++e) y[e] = y[e] * sigmoidf_(y[e]);
            v4u o; o.x = pk2(y[0], y[1]); o.y = pk2(y[2], y[3]); o.z = pk2(y[4], y[5]); o.w = pk2(y[6], y[7]);
            *(v4u*)(XC + (size_t)(m0 + i) * DM + c0) = o;
        }
    }
}

typedef short s16x4 __attribute__((ext_vector_type(4)));
__device__ __forceinline__ bf16x8 tr_read_pair(unsigned a0, unsigned a1) {
    s16x4 r0, r1;
    asm volatile("ds_read_b64_tr_b16 %0, %2\n\tds_read_b64_tr_b16 %1, %3\n\ts_waitcnt lgkmcnt(0)" : "=&v"(r0), "=&v"(r1) : "v"(a0), "v"(a1) : "memory");
    return __builtin_shufflevector(r0, r1, 0, 1, 2, 3, 4, 5, 6, 7);
}
__device__ __forceinline__ float dpp_shr(float oldv, float x, int n) {
    const int o = __builtin_bit_cast(int, oldv), v = __builtin_bit_cast(int, x);
    int r;
    if (n == 1) r = __builtin_amdgcn_update_dpp(o, v, 0x111, 0xf, 0xf, false);
    else if (n == 2) r = __builtin_amdgcn_update_dpp(o, v, 0x112, 0xf, 0xf, false);
    else if (n == 4) r = __builtin_amdgcn_update_dpp(o, v, 0x114, 0xf, 0xf, false);
    else r = __builtin_amdgcn_update_dpp(o, v, 0x118, 0xf, 0xf, false);
    return __builtin_bit_cast(float, r);
}
__device__ __forceinline__ float rdlane(float x, int l) { return __builtin_bit_cast(float, __builtin_amdgcn_readlane(__builtin_bit_cast(int, x), l)); }
__device__ __forceinline__ float wave_incl_sum(float x, int lane) {
    x += dpp_shr(0.f, x, 1); x += dpp_shr(0.f, x, 2); x += dpp_shr(0.f, x, 4); x += dpp_shr(0.f, x, 8);
    const float t0 = rdlane(x, 15), t1 = rdlane(x, 31), t2 = rdlane(x, 47);
    return x + (lane >= 16 ? t0 : 0.f) + (lane >= 32 ? t1 : 0.f) + (lane >= 48 ? t2 : 0.f);
}
__device__ __forceinline__ float wave_incl_max(float x, int lane) {
    const float NI = -INFINITY;
    x = fmaxf(x, dpp_shr(NI, x, 1)); x = fmaxf(x, dpp_shr(NI, x, 2)); x = fmaxf(x, dpp_shr(NI, x, 4)); x = fmaxf(x, dpp_shr(NI, x, 8));
    const float t0 = rdlane(x, 15), t1 = rdlane(x, 31), t2 = rdlane(x, 47);
    return fmaxf(fmaxf(x, lane >= 16 ? t0 : NI), fmaxf(lane >= 32 ? t1 : NI, lane >= 48 ? t2 : NI));
}
__device__ __forceinline__ void mscan_phase(Frame& F) {
    const bf16* Q = (const bf16*)(F.ws + WS_LG); const bf16* K = (const bf16*)(F.ws + WS_K); const bf16* V = (const bf16*)(F.ws + WS_XL);
    const float* GT = (const float*)(F.ws + WS_GATE);
    constexpr int KS = 0, CTI = 33792, VT = 67584, VWT = 86016, PB = 104448, TAB = 113664, NT = 116736, NPART = 117760, DENT = 119808;
    constexpr int KST = 528, VST = 144, TABSZ = 1536;
    LAS unsigned char* L = F.lds;
    const int tid = F.tid, lane = F.lane, w = F.wave, fr = lane & 15, fq = lane >> 4, pt = w & 3, wg = w >> 2;
    for (int item = F.bid; item < 256; item += F.G) {
        const int es = item & 3, dir = (item >> 2) & 1, h = (item >> 3) & 3, b = item >> 5;
        bf16* H = dir ? ((bf16*)F.out + (size_t)MTOK * DM) : (bf16*)(F.ws + WS_XM);
        const size_t rowbase = (size_t)b * SEQ;
#define TOF(c, p) (dir ? (SEQ - 1 - 64 * (c) - (p)) : (64 * (c) + (p)))
        for (int e = tid; e < (33792 + 1024) / 4; e += NTHR) { if (e < 33792 / 4) ((LAS unsigned*)(L + CTI))[e] = 0u; else ((LAS unsigned*)(L + NT))[e - 33792 / 4] = 0u; }
        float m_run = 0.f;
        float gi_n = 0.f, gf_n = 0.f;
        if (w == 0) { const size_t m = rowbase + TOF(0, lane); gi_n = GT[m * 16 + dir * 8 + h]; gf_n = GT[m * 16 + dir * 8 + 4 + h]; }
#define G1_TABLES(setp) do { \
            const float logf_ = fminf(gf_n, 0.f) - __logf(1.f + __expf(-fabsf(gf_n))); const float b_ = wave_incl_sum(logf_, lane); const float a_ = gi_n - b_; \
            const float M_ = fmaxf(m_run, wave_incl_max(a_, lane)); const float Mend_ = rdlane(M_, 63), g_ = rdlane(b_, 63); \
            LAS float* T_ = (LAS float*)(setp); T_[lane] = a_; T_[64 + lane] = M_; T_[128 + lane] = __expf(m_run - M_); T_[192 + lane] = __expf(-(b_ + M_)); T_[256 + lane] = __expf(a_ - Mend_); \
            if (lane == 0) { T_[320] = __expf(m_run - Mend_); T_[321] = g_ + Mend_; } \
            m_run = g_ + Mend_; } while (0)
        if (w == 0) G1_TABLES(L + TAB);
        __syncthreads();
        bf16x8 qf[8];
        v4u kreg[4]; v4u vreg;
#define LOAD_KV(c) do { _Pragma("unroll") for (int r_ = 0; r_ < 4; ++r_) { const int i_ = tid + NTHR * r_, s_ = i_ >> 5, c16_ = i_ & 31; \
                kreg[r_] = *(const v4u*)(K + (rowbase + TOF(c, s_)) * DM + h * 256 + c16_ * 8); } \
            { const int s_ = tid & 63, e8_ = tid >> 6; vreg = *(const v4u*)(V + (rowbase + TOF(c, s_)) * DM + h * 256 + es * 64 + e8_ * 8); } } while (0)
#define STORE_KV(setidx) do { _Pragma("unroll") for (int r_ = 0; r_ < 4; ++r_) { const int i_ = tid + NTHR * r_, s_ = i_ >> 5, c16_ = i_ & 31; \
                *(LAS v4u*)(L + KS + s_ * KST + c16_ * 16) = kreg[r_]; } \
            { const int s_ = tid & 63, e8_ = tid >> 6; const float ws_ = ((const LAS float*)(L + TAB + (setidx) * TABSZ))[256 + s_]; \
              LAS bf16* vt_ = (LAS bf16*)(L + VT + (setidx) * 9216); LAS bf16* vw_ = (LAS bf16*)(L + VWT + (setidx) * 9216); \
              const unsigned wv_[4] = {vreg.x, vreg.y, vreg.z, vreg.w}; \
              _Pragma("unroll") for (int j_ = 0; j_ < 4; ++j_) { const float lo_ = bflo(wv_[j_]), hi_ = bfhi(wv_[j_]); const int e_ = e8_ * 8 + 2 * j_; \
                vt_[e_ * 72 + s_] = (bf16)(wv_[j_] & 0xffffu); vt_[(e_ + 1) * 72 + s_] = (bf16)(wv_[j_] >> 16); \
                vw_[e_ * 72 + s_] = (bf16)f2bf(lo_ * ws_); vw_[(e_ + 1) * 72 + s_] = (bf16)f2bf(hi_ * ws_); } } } while (0)
#define LOAD_Q(c) do { const size_t m_ = rowbase + TOF(c, 16 * pt + fr); _Pragma("unroll") for (int ks_ = 0; ks_ < 8; ++ks_) \
                qf[ks_] = *(const bf16x8*)(Q + m_ * DM + h * 256 + 32 * ks_ + 8 * fq); } while (0)
        LOAD_KV(0); LOAD_Q(0);
        STORE_KV(0);
        f32x4 Cacc[8];
#pragma unroll
        for (int i = 0; i < 8; ++i) Cacc[i] = (f32x4){0.f, 0.f, 0.f, 0.f};
        __syncthreads();
        for (int c = 0; c < 64; ++c) {
            const int cur = c & 1, nxt = cur ^ 1;
            const bool has_next = (c + 1 < 64);
            const LAS float* T = (const LAS float*)(L + TAB + cur * TABSZ);
            if (has_next) { LOAD_KV(c + 1); if (w == 0) { const size_t m = rowbase + TOF(c + 1, lane); gi_n = GT[m * 16 + dir * 8 + h]; gf_n = GT[m * 16 + dir * 8 + 4 + h]; } }
            const int p = 16 * pt + fr;
            const float Mp = T[64 + p], wi_p = T[128 + p];
            float cs = 0.f;
#pragma unroll
            for (int i = 0; i < 2; ++i) { const int st = 2 * wg + i;
                v2u pw = {0u, 0u};
                if (st <= pt) {
                    f32x4 sa = (f32x4){0.f, 0.f, 0.f, 0.f};
#pragma unroll
                    for (int ks = 0; ks < 8; ++ks) { const bf16x8 kf = *(const LAS bf16x8*)(L + KS + (16 * st + fr) * KST + (32 * ks + 8 * fq) * 2);
                        sa = __builtin_amdgcn_mfma_f32_16x16x32_bf16(kf, qf[ks], sa, 0, 0, 0); }
                    const f32x4 a4 = *(const LAS f32x4*)(T + 16 * st + 4 * fq);
                    float pv[4];
#pragma unroll
                    for (int r = 0; r < 4; ++r) { const int s_ = 16 * st + 4 * fq + r; const float wgt = (s_ <= p) ? __expf(a4[r] - Mp) : 0.f; pv[r] = sa[r] * wgt; cs += pv[r]; }
                    pw.x = pk2(pv[0], pv[1]); pw.y = pk2(pv[2], pv[3]);
                }
                *(LAS v2u*)(L + PB + p * VST + (16 * st + 4 * fq) * 2) = pw; }
            f32x4 O[2];
#pragma unroll
            for (int i = 0; i < 2; ++i) { const int et = 2 * wg + i; O[i] = (f32x4){0.f, 0.f, 0.f, 0.f};
#pragma unroll
                for (int ks = 0; ks < 8; ++ks) { const bf16x8 cf = *(const LAS bf16x8*)(L + CTI + (16 * et + fr) * KST + (32 * ks + 8 * fq) * 2);
                    O[i] = __builtin_amdgcn_mfma_f32_16x16x32_bf16(cf, qf[ks], O[i], 0, 0, 0); } }
            float di = 0.f;
#define DEN_INTER(ks) do { const f32x4 n0 = *(const LAS f32x4*)(L + NT + (32 * (ks) + 8 * fq) * 4), n1 = *(const LAS f32x4*)(L + NT + (32 * (ks) + 8 * fq) * 4 + 16); \
                const v4u qw = __builtin_bit_cast(v4u, qf[ks]); \
                di += bflo(qw.x) * n0[0] + bfhi(qw.x) * n0[1] + bflo(qw.y) * n0[2] + bfhi(qw.y) * n0[3] + bflo(qw.z) * n1[0] + bfhi(qw.z) * n1[1] + bflo(qw.w) * n1[2] + bfhi(qw.w) * n1[3]; } while (0)
            if (wg == 0) { DEN_INTER(0); DEN_INTER(1); DEN_INTER(2); DEN_INTER(3); }
            else { DEN_INTER(4); DEN_INTER(5); DEN_INTER(6); DEN_INTER(7); }
#undef DEN_INTER
            di += __shfl_xor(di, 16); di += __shfl_xor(di, 32);
            cs += __shfl_xor(cs, 16); cs += __shfl_xor(cs, 32);
            if (fq == 0) ((LAS float*)(L + DENT))[wg * 64 + p] = wi_p * di + cs;
            if (has_next) LOAD_Q(c + 1);
            if (has_next && w == 0) G1_TABLES(L + TAB + nxt * TABSZ);
            __syncthreads();
#pragma unroll
            for (int i = 0; i < 2; ++i) { const int et = 2 * wg + i; O[i] = O[i] * wi_p;
#pragma unroll
                for (int ks = 0; ks < 2; ++ks) { const bf16x8 vf = *(const LAS bf16x8*)(L + VT + cur * 9216 + (16 * et + fr) * VST + (32 * ks + 8 * fq) * 2);
                    const bf16x8 pf = *(const LAS bf16x8*)(L + PB + p * VST + (32 * ks + 8 * fq) * 2);
                    O[i] = __builtin_amdgcn_mfma_f32_16x16x32_bf16(vf, pf, O[i], 0, 0, 0); } }
            { const float den = ((const LAS float*)(L + DENT))[p] + ((const LAS float*)(L + DENT))[64 + p];
              const float inv = 1.f / fmaxf(fabsf(den), T[192 + p]);
              const size_t m = rowbase + TOF(c, p);
#pragma unroll
              for (int i = 0; i < 2; ++i) { const int et = 2 * wg + i; v2u o; o.x = pk2(O[i][0] * inv, O[i][1] * inv); o.y = pk2(O[i][2] * inv, O[i][3] * inv);
                  *(v2u*)(H + m * DM + h * 256 + es * 64 + 16 * et + 4 * fq) = o; } }
            { const float decay = T[320];
              const bf16x8 vw0 = *(const LAS bf16x8*)(L + VWT + cur * 9216 + (16 * pt + fr) * VST + (8 * fq) * 2);
              const bf16x8 vw1 = *(const LAS bf16x8*)(L + VWT + cur * 9216 + (16 * pt + fr) * VST + (32 + 8 * fq) * 2);
              const int l16 = lane & 15, q4 = l16 >> 2, p4 = l16 & 3;
              const unsigned kb = (unsigned)(uintptr_t)(L + KS) + (unsigned)((8 * fq + q4) * KST + 4 * p4 * 2);
#pragma unroll
              for (int dtl = 0; dtl < 8; dtl += 2) { const int dt = 8 * wg + dtl; const unsigned a0 = kb + dt * 32;
                  s16x4 r0, r1, r2, r3, r4, r5, r6, r7;
                  asm volatile("ds_read_b64_tr_b16 %0, %8\n\tds_read_b64_tr_b16 %1, %8 offset:2112\n\tds_read_b64_tr_b16 %2, %8 offset:16896\n\tds_read_b64_tr_b16 %3, %8 offset:19008\n\t"
                               "ds_read_b64_tr_b16 %4, %8 offset:32\n\tds_read_b64_tr_b16 %5, %8 offset:2144\n\tds_read_b64_tr_b16 %6, %8 offset:16928\n\tds_read_b64_tr_b16 %7, %8 offset:19040\n\ts_waitcnt lgkmcnt(0)"
                               : "=&v"(r0), "=&v"(r1), "=&v"(r2), "=&v"(r3), "=&v"(r4), "=&v"(r5), "=&v"(r6), "=&v"(r7) : "v"(a0) : "memory");
                  const bf16x8 k0 = __builtin_shufflevector(r0, r1, 0, 1, 2, 3, 4, 5, 6, 7), k1 = __builtin_shufflevector(r2, r3, 0, 1, 2, 3, 4, 5, 6, 7);
                  const bf16x8 k2 = __builtin_shufflevector(r4, r5, 0, 1, 2, 3, 4, 5, 6, 7), k3 = __builtin_shufflevector(r6, r7, 0, 1, 2, 3, 4, 5, 6, 7);
                  Cacc[dtl] = Cacc[dtl] * decay; Cacc[dtl + 1] = Cacc[dtl + 1] * decay;
                  Cacc[dtl] = __builtin_amdgcn_mfma_f32_16x16x32_bf16(k0, vw0, Cacc[dtl], 0, 0, 0);
                  Cacc[dtl + 1] = __builtin_amdgcn_mfma_f32_16x16x32_bf16(k2, vw0, Cacc[dtl + 1], 0, 0, 0);
                  Cacc[dtl] = __builtin_amdgcn_mfma_f32_16x16x32_bf16(k1, vw1, Cacc[dtl], 0, 0, 0);
                  Cacc[dtl + 1] = __builtin_amdgcn_mfma_f32_16x16x32_bf16(k3, vw1, Cacc[dtl + 1], 0, 0, 0); } }
            { const int d = tid & 255, hf2 = tid >> 8; float np = 0.f;
#pragma unroll 8
              for (int s2 = 0; s2 < 32; ++s2) { const int s_ = hf2 * 32 + s2; np += T[256 + s_] * bf2f(*(const LAS bf16*)(L + KS + s_ * KST + d * 2)); }
              ((LAS float*)(L + NPART))[hf2 * 256 + d] = np; }
            __syncthreads();
            { const float decay = T[320];
#pragma unroll
              for (int dtl = 0; dtl < 8; ++dtl) { const int dt = 8 * wg + dtl; v2u o; o.x = pk2(Cacc[dtl][0], Cacc[dtl][1]); o.y = pk2(Cacc[dtl][2], Cacc[dtl][3]);
                  *(LAS v2u*)(L + CTI + (16 * pt + fr) * KST + (16 * dt + 4 * fq) * 2) = o; }
              if (tid < 256) { LAS float* nt = (LAS float*)(L + NT); const LAS float* np = (const LAS float*)(L + NPART); nt[tid] = decay * nt[tid] + np[tid] + np[256 + tid]; } }
            if (has_next) STORE_KV(nxt);
            __syncthreads();
        }
#undef TOF
#undef G1_TABLES
#undef LOAD_KV
#undef STORE_KV
#undef LOAD_Q
    }
}

__device__ __forceinline__ void ym_phase(Frame& F) {
    const bf16* HF = (const bf16*)(F.ws + WS_XM); const bf16* HB = (const bf16*)F.out + (size_t)MTOK * DM; bf16* OP = (bf16*)(F.ws + WS_OP);
    const float* ng = F.in[9];
    const int gw = F.bid * NWAVES + F.wave, NGW = F.G * NWAVES;
    for (int m = gw; m < MTOK; m += NGW) {
#pragma unroll
        for (int hd = 0; hd < 4; ++hd) {
            const size_t o = (size_t)m * DM + hd * 256 + F.lane * 4;
            const v2u a = *(const v2u*)(HF + o), b = *(const v2u*)(HB + o), op = *(const v2u*)(OP + o);
            const float v0 = bflo(a.x) + bflo(b.x), v1 = bfhi(a.x) + bfhi(b.x), v2 = bflo(a.y) + bflo(b.y), v3 = bfhi(a.y) + bfhi(b.y);
            const float r = rsqrtf(wave_sum((v0 * v0 + v1 * v1) + (v2 * v2 + v3 * v3)) * (1.f / 256.f) + EPS);
            const f32x4 g = *(const f32x4*)(ng + hd * 256 + F.lane * 4);
            v2u w; w.x = pk2(sigmoidf_(bflo(op.x)) * v0 * r * g[0], sigmoidf_(bfhi(op.x)) * v1 * r * g[1]);
            w.y = pk2(sigmoidf_(bflo(op.y)) * v2 * r * g[2], sigmoidf_(bfhi(op.y)) * v3 * r * g[3]);
            *(v2u*)(OP + o) = w;
        }
    }
    {
        float* usc = (float*)(F.ws + WS_LG + 16 * MiB); float* vsc = usc + NEXP;
        for (int row = gw; row < 2 * NEXP; row += NGW) {
            const bool isv = row >= NEXP; const int r = isv ? row - NEXP : row;
            const f32x4* src = (const f32x4*)(F.in[isv ? 24 : 23] + (size_t)r * DM) + F.lane * 4;
            f32x4 a[4]; float ss = 0.f;
#pragma unroll
            for (int j = 0; j < 4; ++j) { a[j] = src[j]; ss += (a[j][0] * a[j][0] + a[j][1] * a[j][1]) + (a[j][2] * a[j][2] + a[j][3] * a[j][3]); }
            const float rms = sqrtf(wave_sum(ss) * (1.f / DM));
            const float sc = fmaxf(rms * 0.5f, 1e-30f), inv = 1.f / sc;
            unsigned o[2] = {0u, 0u};
#pragma unroll
            for (int j = 0; j < 4; ++j) { const f32x4 q = a[j] * inv;
                if (j & 1) { o[j >> 1] = __builtin_amdgcn_cvt_scalef32_pk_fp4_f32(o[j >> 1], q[0], q[1], 1.0f, 2); o[j >> 1] = __builtin_amdgcn_cvt_scalef32_pk_fp4_f32(o[j >> 1], q[2], q[3], 1.0f, 3); }
                else       { o[j >> 1] = __builtin_amdgcn_cvt_scalef32_pk_fp4_f32(o[j >> 1], q[0], q[1], 1.0f, 0); o[j >> 1] = __builtin_amdgcn_cvt_scalef32_pk_fp4_f32(o[j >> 1], q[2], q[3], 1.0f, 1); } }
            *(v2u*)(F.ws + WS_LG + (isv ? 8 * MiB : 0) + (size_t)r * (DM / 2) + F.lane * 8) = (v2u){o[0], o[1]};
            if (F.lane == 0) (isv ? vsc : usc)[r] = sc;
        }
    }
}

typedef float f32x16 __attribute__((ext_vector_type(16)));
#define TOPK_INSERT(L, xv) do { const float x_ = (xv); \
    L[15] = __builtin_amdgcn_fmed3f(L[14], L[15], x_); L[14] = __builtin_amdgcn_fmed3f(L[13], L[14], x_); L[13] = __builtin_amdgcn_fmed3f(L[12], L[13], x_); L[12] = __builtin_amdgcn_fmed3f(L[11], L[12], x_); \
    L[11] = __builtin_amdgcn_fmed3f(L[10], L[11], x_); L[10] = __builtin_amdgcn_fmed3f(L[9], L[10], x_); L[9] = __builtin_amdgcn_fmed3f(L[8], L[9], x_); L[8] = __builtin_amdgcn_fmed3f(L[7], L[8], x_); \
    L[7] = __builtin_amdgcn_fmed3f(L[6], L[7], x_); L[6] = __builtin_amdgcn_fmed3f(L[5], L[6], x_); L[5] = __builtin_amdgcn_fmed3f(L[4], L[5], x_); L[4] = __builtin_amdgcn_fmed3f(L[3], L[4], x_); \
    L[3] = __builtin_amdgcn_fmed3f(L[2], L[3], x_); L[2] = __builtin_amdgcn_fmed3f(L[1], L[2], x_); L[1] = __builtin_amdgcn_fmed3f(L[0], L[1], x_); L[0] = fmaxf(L[0], x_); } while (0)
template <int I> struct CandRow {
    static __device__ __forceinline__ void run(const float (&L0)[16], const float (&L1)[16], float (&R)[16]) {
        constexpr int NJ = 16 / (I + 1);
#pragma unroll
        for (int j = 0; j < NJ; ++j) { const float sm = L0[I] + L1[j];
            const float pk = __builtin_bit_cast(float, (__builtin_bit_cast(unsigned, sm) & 0xffffff00u) | (unsigned)(I * 16 + j)); TOPK_INSERT(R, pk); }
        if constexpr (I < 15) CandRow<I + 1>::run(L0, L1, R);
    }
};
__device__ __forceinline__ unsigned pick4(unsigned d0, unsigned d1, unsigned d2, unsigned d3, int i) {
    const int q = i >> 2; unsigned d = d0; d = (q == 1) ? d1 : d; d = (q == 2) ? d2 : d; d = (q == 3) ? d3 : d; return (d >> (8 * (i & 3))) & 127u;
}
__device__ __forceinline__ void select_phase(Frame& F) {
    const bf16* PQ = (const bf16*)(F.ws + WS_MG); const bf16* KEYS = (const bf16*)(F.ws + WS_KEYS);
    int* IDX = (int*)(F.ws + WS_K); float* GW = (float*)(F.ws + WS_K + 16 * MiB);
    LAS unsigned char* L = F.lds;
    const int tid = F.tid, lane = F.lane, w = F.wave, l31 = lane & 31, hh = lane >> 5;
    const float NEG_INF = -INFINITY;
    for (int grp = F.bid; grp < MTOK / 128; grp += F.G) {
        const int tb = grp * 4 + (w & 3);
        const size_t m = (size_t)tb * 32 + l31;
        for (int hp = 0; hp < 4; ++hp) {
            __syncthreads();
#pragma unroll 4
            for (int r = 0; r < 16; ++r) { const int e = tid + NTHR * r, R = e >> 4, c = e & 15;
                *(LAS v4u*)(L + R * 256 + ((c ^ (R & 15)) * 16)) = *(const v4u*)(KEYS + ((size_t)(hp * 512 + R) * 128 + c * 8)); }
            __syncthreads();
            const int hl = w >> 2, h = 2 * hp + hl;
            float L0[16], L1[16];
#pragma unroll
            for (int p = 0; p < 2; ++p) {
                bf16x8 qf[8];
#pragma unroll
                for (int ks = 0; ks < 8; ++ks) qf[ks] = *(const bf16x8*)(PQ + m * 2048 + h * 256 + p * 128 + 16 * ks + 8 * hh);
                f32x16 acc[4];
#pragma unroll
                for (int kb = 0; kb < 4; ++kb)
#pragma unroll
                    for (int r = 0; r < 16; ++r) acc[kb][r] = 0.f;
#pragma unroll
                for (int ks = 0; ks < 8; ++ks)
#pragma unroll
                    for (int kb = 0; kb < 4; ++kb) { const int R = (hl * 2 + p) * 128 + 32 * kb + l31;
                        const bf16x8 kf = *(const LAS bf16x8*)(L + R * 256 + (((2 * ks + hh) ^ (lane & 15)) * 16));
                        acc[kb] = __builtin_amdgcn_mfma_f32_32x32x16_bf16(kf, qf[ks], acc[kb], 0, 0, 0); }
                float Lc[16];
#pragma unroll
                for (int i = 0; i < 16; ++i) Lc[i] = NEG_INF;
                const unsigned hh4 = (unsigned)hh << 2;
#pragma unroll
                for (int kb = 0; kb < 4; ++kb)
#pragma unroll
                    for (int r = 0; r < 16; ++r) { const unsigned nlo = (unsigned)(32 * kb + (r & 3) + 8 * (r >> 2));
                        const float av_ = acc[kb][r];
                        const float pk = __uint_as_float(((__float_as_uint(av_) & 0xffffff80u) | hh4) | nlo); TOPK_INSERT(Lc, pk); }
                float Lo[16];
#pragma unroll
                for (int i = 0; i < 16; ++i) Lo[i] = __shfl_xor(Lc[i], 32);
#pragma unroll
                for (int i = 0; i < 16; ++i) TOPK_INSERT(Lc, Lo[i]);
#pragma unroll
                for (int i = 0; i < 16; ++i) { if (p == 0) L0[i] = Lc[i]; else L1[i] = Lc[i]; }
            }
            float R[16];
#pragma unroll
            for (int i = 0; i < 16; ++i) R[i] = NEG_INF;
            CandRow<0>::run(L0, L1, R);
            unsigned a0 = 0, a1 = 0, a2 = 0, a3 = 0, b0 = 0, b1 = 0, b2 = 0, b3 = 0;
#pragma unroll
            for (int i = 0; i < 4; ++i) { a0 |= (__builtin_bit_cast(unsigned, L0[i]) & 127u) << (8 * i); a1 |= (__builtin_bit_cast(unsigned, L0[4 + i]) & 127u) << (8 * i);
                a2 |= (__builtin_bit_cast(unsigned, L0[8 + i]) & 127u) << (8 * i); a3 |= (__builtin_bit_cast(unsigned, L0[12 + i]) & 127u) << (8 * i);
                b0 |= (__builtin_bit_cast(unsigned, L1[i]) & 127u) << (8 * i); b1 |= (__builtin_bit_cast(unsigned, L1[4 + i]) & 127u) << (8 * i);
                b2 |= (__builtin_bit_cast(unsigned, L1[8 + i]) & 127u) << (8 * i); b3 |= (__builtin_bit_cast(unsigned, L1[12 + i]) & 127u) << (8 * i); }
            float ex[16]; float sum = 0.f; int id[16];
#pragma unroll
            for (int r = 0; r < 16; ++r) { ex[r] = __expf(R[r] - R[0]); sum += ex[r];
                const unsigned cid = __builtin_bit_cast(unsigned, R[r]) & 255u;
                id[r] = (int)(pick4(a0, a1, a2, a3, (int)(cid >> 4)) * 128u + pick4(b0, b1, b2, b3, (int)(cid & 15u))); }
            const float inv = 1.f / sum;
            if (hh == 0) {
#pragma unroll
                for (int q = 0; q < 4; ++q) {
                    *(int4*)(IDX + m * 128 + h * 16 + 4 * q) = make_int4(id[4 * q], id[4 * q + 1], id[4 * q + 2], id[4 * q + 3]);
                    *(f32x4*)(GW + m * 128 + h * 16 + 4 * q) = (f32x4){ex[4 * q] * inv, ex[4 * q + 1] * inv, ex[4 * q + 2] * inv, ex[4 * q + 3] * inv}; }
            }
        }
    }
}

template <int B> __device__ __forceinline__ f32x2 fp4b(unsigned w) { return __builtin_amdgcn_cvt_scalef32_pk_f32_fp4(w, 1.0f, B); }
typedef int v8i_t __attribute__((ext_vector_type(8)));
#define AP_SLOT(e) (4 * (((e) >> 1) & 3) + 2 * ((e) >> 3) + ((e) & 1))
__device__ __forceinline__ void apply_phase(Frame& F, float* OUTP) {
    const unsigned char* U8 = F.ws + WS_LG; const unsigned char* V8 = F.ws + WS_LG + 8 * MiB;
    const float* USC = (const float*)(F.ws + WS_LG + 16 * MiB); const float* VSC = USC + NEXP;
    const int* IDX = (const int*)(F.ws + WS_K); const float* GW = (const float*)(F.ws + WS_K + 16 * MiB);
    const float* g2 = F.in[20]; const float* gf = F.in[25];
    const float* X1 = F.out;
    const int lane = F.lane, fr = lane & 15, fq = lane >> 4;
    constexpr int APW = 2 * 16 * 528 + 1024;
    LAS unsigned char* UL = F.lds + F.wave * APW; LAS unsigned char* VL = UL + 16 * 528; LAS unsigned char* H8 = VL + 16 * 528;
    const int pe = 2 * fq + (fr & 1) + 8 * ((fr >> 1) & 1);
    const int bsh = 8 * (fr & 3); const unsigned mlo = fr < 4 ? ~0u : 0u, mhi = (fr >= 4 && fr < 8) ? ~0u : 0u;
#define AP_LOADROWS(SEL, KB) _Pragma("unroll") for (int e = 0; e < 16; ++e) { \
        const size_t ro = (size_t)__builtin_amdgcn_readlane(SEL, ((KB) + e) & 63) * (DM / 2) + lane * 8; uu[e] = *(const v2u*)(U8 + ro); vv[e] = *(const v2u*)(V8 + ro); }
    for (int grp = F.bid; grp < MTOK / 128; grp += F.G) {
        const int mbase = grp * 128 + F.wave;
        int ni0 = IDX[(size_t)mbase * 128 + lane], ni1 = IDX[(size_t)mbase * 128 + 64 + lane];
        float ngw0 = GW[(size_t)mbase * 128 + lane], ngw1 = GW[(size_t)mbase * 128 + 64 + lane];
        f32x4 nxr[4];
#pragma unroll
        for (int q = 0; q < 4; ++q) nxr[q] = *(const f32x4*)(X1 + (size_t)mbase * DM + lane * 16 + q * 4);
        v2u uu[16], vv[16];
        AP_LOADROWS(ni0, 0)
        int i0 = 0, i1 = 0; float gw0 = 0.f, gw1 = 0.f; f32x4 xr[4], oacc[8];
#pragma unroll
        for (int q = 0; q < 4; ++q) xr[q] = (f32x4){0.f, 0.f, 0.f, 0.f};
#pragma unroll
        for (int i = 0; i < 8; ++i) oacc[i] = (f32x4){0.f, 0.f, 0.f, 0.f};
#pragma unroll 1
        for (int it = 0; it < 128; ++it) {
            const int bt = it & 7, m = mbase + 8 * (it >> 3);
            if (bt == 0) {
                i0 = ni0; i1 = ni1; gw0 = ngw0; gw1 = ngw1; float s = 0.f;
#pragma unroll
                for (int q = 0; q < 4; ++q) { xr[q] = nxr[q]; s += (xr[q][0] * xr[q][0] + xr[q][1] * xr[q][1]) + (xr[q][2] * xr[q][2] + xr[q][3] * xr[q][3]); }
                const float r2 = rsqrtf(wave_sum(s) * (1.f / DM) + EPS);
                v4u h8;
#pragma unroll
                for (int q = 0; q < 4; ++q) { const f32x4 g = *(const f32x4*)(g2 + lane * 16 + q * 4); const f32x4 hq = xr[q] * r2 * g;
                    int pk = 0; pk = __builtin_amdgcn_cvt_pk_fp8_f32(hq[0], hq[1], pk, false); pk = __builtin_amdgcn_cvt_pk_fp8_f32(hq[2], hq[3], pk, true); h8[q] = (unsigned)pk; }
                *(LAS v4u*)(H8 + lane * 16) = h8;
#pragma unroll
                for (int i = 0; i < 8; ++i) oacc[i] = (f32x4){0.f, 0.f, 0.f, 0.f};
                const int mn = (it + 8 < 128) ? m + 8 : m;
                ni0 = IDX[(size_t)mn * 128 + lane]; ni1 = IDX[(size_t)mn * 128 + 64 + lane]; ngw0 = GW[(size_t)mn * 128 + lane]; ngw1 = GW[(size_t)mn * 128 + 64 + lane];
#pragma unroll
                for (int q = 0; q < 4; ++q) nxr[q] = *(const f32x4*)(X1 + (size_t)mn * DM + lane * 16 + q * 4);
            }
            const int k0 = bt * 16;
            const int isel = (k0 < 64) ? i0 : i1;
            const int myidx = __shfl(isel, (k0 + pe) & 63);
            const float su = USC[myidx], sv = VSC[myidx];
#pragma unroll
            for (int e = 0; e < 16; ++e) { *(LAS v2u*)(UL + AP_SLOT(e) * 528 + lane * 8) = uu[e]; *(LAS v2u*)(VL + e * 528 + lane * 8) = vv[e]; }
            { const int nk = (k0 + 16) & 127; const int nsel = (bt == 7) ? ni0 : ((nk < 64) ? i0 : i1);
              AP_LOADROWS(nsel, nk) }
            f32x4 da = (f32x4){0.f, 0.f, 0.f, 0.f}, db = (f32x4){0.f, 0.f, 0.f, 0.f};
#pragma unroll
            for (int ks = 0; ks < 8; ++ks) {
                const v4u af = *(const LAS v4u*)(UL + fr * 528 + 64 * ks + 16 * fq);
                const v4u b0 = *(const LAS v4u*)(H8 + 128 * ks + 16 * fq), b1 = *(const LAS v4u*)(H8 + 128 * ks + 64 + 16 * fq);
                const v8i_t A = {(int)af.x, (int)af.y, (int)af.z, (int)af.w, 0, 0, 0, 0};
                const v8i_t B = {(int)b0.x, (int)b0.y, (int)b0.z, (int)b0.w, (int)b1.x, (int)b1.y, (int)b1.z, (int)b1.w};
                if (ks & 1) db = __builtin_amdgcn_mfma_scale_f32_16x16x128_f8f6f4(A, B, db, 4  , 0  , 0, 0x7F7F7F7F, 0, 0x7F7F7F7F);
                else        da = __builtin_amdgcn_mfma_scale_f32_16x16x128_f8f6f4(A, B, da, 4, 0, 0, 0x7F7F7F7F, 0, 0x7F7F7F7F);
            }
            const f32x4 d4 = da + db;
            const int sel = fr & 3;
            float t = d4[0]; t = (sel == 1) ? d4[1] : t; t = (sel == 2) ? d4[2] : t; t = (sel == 3) ? d4[3] : t;
            const float gk = __shfl((k0 < 64) ? gw0 : gw1, (k0 + pe) & 63);
            const float wl = gk * gelu_fast(t * su) * sv;
            float wm = fabsf(wl); wm = fmaxf(wm, __shfl_xor(wm, 1)); wm = fmaxf(wm, __shfl_xor(wm, 2)); wm = fmaxf(wm, __shfl_xor(wm, 16)); wm = fmaxf(wm, __shfl_xor(wm, 32));
            int E = (int)(__float_as_uint(wm) >> 23); E = E < 8 ? 8 : E;
            const float wq = wl * __uint_as_float((unsigned)(261 - E) << 23);
            const int scb = (E - 7) * 0x01010101;
            v8i_t Bw;
#define AP_WQ(tq, ctrl) { const float wt = __builtin_bit_cast(float, __builtin_amdgcn_update_dpp(0, __builtin_bit_cast(int, wq), ctrl, 0xf, 0xf, false)); \
                const unsigned p8 = (unsigned)__builtin_amdgcn_cvt_pk_fp8_f32(wt, 0.f, 0, false) << bsh; Bw[2 * tq] = (int)(p8 & mlo); Bw[2 * tq + 1] = (int)(p8 & mhi); }
            AP_WQ(0, 0x00) AP_WQ(1, 0x55) AP_WQ(2, 0xAA) AP_WQ(3, 0xFF)
#pragma unroll
            for (int c = 0; c < 8; ++c) {
                v4u av;
                av.x = *(const LAS unsigned*)(VL + (4 * fq + 0) * 528 + 64 * c + 4 * fr); av.y = *(const LAS unsigned*)(VL + (4 * fq + 1) * 528 + 64 * c + 4 * fr);
                av.z = *(const LAS unsigned*)(VL + (4 * fq + 2) * 528 + 64 * c + 4 * fr); av.w = *(const LAS unsigned*)(VL + (4 * fq + 3) * 528 + 64 * c + 4 * fr);
                const v8i_t A = {(int)av.x, (int)av.y, (int)av.z, (int)av.w, 0, 0, 0, 0};
                oacc[c] = __builtin_amdgcn_mfma_scale_f32_16x16x128_f8f6f4(A, Bw, oacc[c], 4, 0, 0, 0x7F7F7F7F, 0, scb);
            }
            if (bt == 7) {
                if (fr < 8) {
#pragma unroll
                    for (int c = 0; c < 8; ++c)
#pragma unroll
                        for (int r = 0; r < 4; ++r) { const float o = oacc[c][r]; *(LAS unsigned*)(UL + 4 * ((4 * c + fq) * 40 + 8 * r + fr)) = __float_as_uint(o); }
                }
                float s2 = 0.f; f32x4 ov[4];
#pragma unroll
                for (int q = 0; q < 4; ++q) { const v4u ou = *(const LAS v4u*)(UL + 4 * ((lane >> 1) * 40 + (lane & 1) * 16 + 4 * q));
                    ov[q] = (f32x4){__uint_as_float(ou.x), __uint_as_float(ou.y), __uint_as_float(ou.z), __uint_as_float(ou.w)} + xr[q];
                    s2 += (ov[q][0] * ov[q][0] + ov[q][1] * ov[q][1]) + (ov[q][2] * ov[q][2] + ov[q][3] * ov[q][3]); }
                const float rf = rsqrtf(wave_sum(s2) * (1.f / DM) + EPS);
#pragma unroll
                for (int q = 0; q < 4; ++q) { const f32x4 g = *(const f32x4*)(gf + lane * 16 + q * 4);
                    *(f32x4*)(OUTP + (size_t)m * DM + lane * 16 + q * 4) = ov[q] * rf * g; }
            }
        }
    }
}

constexpr int N_PHASES = 13;
__global__ void __launch_bounds__(NTHR, 2) mega_fwd(Args args) {
    extern __shared__ __attribute__((aligned(16))) unsigned char lds[];
    Frame F;
    F.lds = (LAS unsigned char*)lds;
    F.tid = threadIdx.x; F.lane = F.tid & 63; F.wave = __builtin_amdgcn_readfirstlane(F.tid >> 6);
    F.G = gridDim.x; F.bid = blockIdx.x;
    F.in = args.in; F.out = args.out; F.ws = args.ws;
    volatile LAS unsigned* MISC = (volatile LAS unsigned*)(F.lds + MISC_OFF);
    for (int u = F.tid; u < (LDS_BYTES - LDSCTL_OFF) / 4; u += NTHR) ((LAS unsigned*)(F.lds + LDSCTL_OFF))[u] = 0u;
    __syncthreads();
    XcdBarrier bar; bar.bar = (unsigned*)(args.ws + WS_CTL) + CW_BAR; bar.x = 0; bar.st = nullptr;
    const bool one_launch = (args.ph_hi - args.ph_lo) > 1;
    if (one_launch) bar = xcd_barrier_post((unsigned*)(args.ws + WS_CTL) + CW_BAR, MISC + 8);
    const int lo = args.ph_lo, hi = args.ph_hi;
#define IN(k) (lo <= (k) && (k) < hi)
#define SEAM(k) do { if (IN(k) && IN((k) + 1)) xcd_barrier(bar); } while (0)
    unsigned char* ws = args.ws;

#ifndef PROBE_MASK
#define PROBE_MASK 0
#endif
#define REP(k) _Pragma("unroll") for (int rep_ = 0; rep_ < (((PROBE_MASK >> (k)) & 1) ? 2 : 1); ++rep_)
    if (IN(0)) REP(0) { p0_prologue(F); if (rep_ == 0 && ((PROBE_MASK >> 0) & 1)) xcd_barrier(bar); } SEAM(0);
    if (IN(1)) REP(1) {
        gates_phase(F);
        pg8::StaticOrder S; S.init(MTOK, 3072, F.G, F.bid, 4);
        { AddrP1 g{(const char*)(ws + WS_K), (const char*)(ws + WS_WIN), 1024, 1024, 1024, 0, 4};
          EpiBf16<DstP1> E{DstP1{ws, 0, 4}, 1.f};
          pg8::gemm_phase(F.lds, g, S, E); }
        { AddrP1 g{(const char*)F.out, (const char*)(ws + WS_WIN8), 512, 512, 512, 4, 12};
          EpiBf16<DstP1, true> E{DstP1{ws, 4, 12}, 1.f / 1024.f};
          pg8::gemm_phase<EpiBf16<DstP1, true>, AddrP1, 1>(F.lds, g, S, E); }
    } SEAM(1);
    if (IN(2)) REP(2) { lru_phase<false>(F); mconv_phase(F); } SEAM(2);
    if (IN(3)) REP(3) { lru_phase<true>(F); } SEAM(3);
    if (IN(5)) REP(5) {
        const char* xc = (const char*)F.out + (size_t)MTOK * DM * 2;
        AddrQKV g{xc, (long)((const char*)(ws + WS_XM) - xc), (const char*)(ws + WS_WQKV), 1024, 256, 256};
        pg8::StaticOrder S; S.init(MTOK, 12 * 256, F.G, F.bid);
        EpiBf16<DstQKV> E{DstQKV{(char*)(ws + WS_LG), (long)WS_K - (long)WS_LG, (long)WS_XL - (long)WS_LG}, 1.f};
        pg8::gemm_phase(F.lds, g, S, E);
    } SEAM(5);
    if (IN(6)) REP(6) { mscan_phase(F); } SEAM(6);
    if (IN(7)) { ym_phase(F); } SEAM(7);
    if (IN(8)) {
        pg8::StaticOrder S; S.init(MTOK, 1024, F.G, F.bid);
        { AddrPlain g{(const char*)(ws + WS_OP), (const char*)(ws + WS_WB2), 1024, 1024, 1024};
          EpiMerge<false> E{(bf16*)(ws + WS_XM), (const bf16*)(ws + WS_MG), 0}; pg8::gemm_phase(F.lds, g, S, E); }
        { AddrPlain g{(const char*)F.out, (const char*)(ws + WS_WB2) + (size_t)1024 * 1024 * 2, 1024, 1024, 1024};
          EpiMerge<true> E{(bf16*)(ws + WS_XM), (const bf16*)(ws + WS_MG), 1024}; pg8::gemm_phase(F.lds, g, S, E); }
    } SEAM(8);
    if (IN(9)) {
        AddrPlain g{(const char*)(ws + WS_XM), (const char*)(ws + WS_WOUT2), 1024, 2048, 1024};
        pg8::StaticOrder S; S.init(MTOK, 1024, F.G, F.bid);
        EpiResid E{F.in[0], F.out, (bf16*)(ws + WS_XL), (float*)(ws + WS_SS)};
        pg8::gemm_phase(F.lds, g, S, E);
    } SEAM(9);
    if (IN(10)) REP(10) {
        AddrPlain g{(const char*)(ws + WS_XL), (const char*)(ws + WS_WPQ), 1024, 1024, 1024};
        pg8::StaticOrder S; S.init(MTOK, 2048, F.G, F.bid, 4);
        EpiPQ E{(bf16*)(ws + WS_MG), (const float*)(ws + WS_SS)};
        pg8::gemm_phase(F.lds, g, S, E);
    } SEAM(10);
    if (IN(11)) REP(11) { select_phase(F); }
    if (IN(11) && IN(12)) { asm volatile("s_waitcnt vmcnt(0)" ::: "memory"); __syncthreads(); }
    if (IN(12)) { if ((PROBE_MASK >> 12) & 1) { apply_phase(F, (float*)(ws + WS_MG)); xcd_barrier(bar); } apply_phase(F, F.out); }
#undef REP
#undef IN
#undef SEAM
}

extern "C" void kernel_launch(void* const* d_in, const int* in_sizes, int n_in, void* d_out, int out_size, void* d_ws, size_t ws_size, hipStream_t stream) {
    static int grid = 0;
    if (grid == 0) {
        if (n_in != 26 || in_sizes[0] != MTOK * DM || out_size != MTOK * DM || ws_size < WS_END) { fprintf(stderr, "kernel_launch: unexpected shapes / workspace (%zu < %zu)\n", ws_size, (size_t)WS_END); grid = -1; return; }
        int dev = 0, cus = 0, per_cu = 0;
        if (hipGetDevice(&dev) != hipSuccess || hipDeviceGetAttribute(&cus, hipDeviceAttributeMultiprocessorCount, dev) != hipSuccess) { grid = -1; return; }
        if (hipFuncSetAttribute((const void*)mega_fwd, hipFuncAttributeMaxDynamicSharedMemorySize, LDS_BYTES) != hipSuccess) { fprintf(stderr, "kernel_launch: hipFuncSetAttribute failed\n"); grid = -1; return; }
        if (hipOccupancyMaxActiveBlocksPerMultiprocessor(&per_cu, (const void*)mega_fwd, NTHR, LDS_BYTES) != hipSuccess || per_cu < 1) { fprintf(stderr, "kernel_launch: occupancy query says %d blocks/CU\n", per_cu); (void)hipGetLastError(); grid = -1; return; }
        grid = cus;
    }
    if (grid < 0) return;
    (void)hipMemsetAsync((char*)d_ws + WS_CTL + (size_t)CW_BAR * 4, 0, (size_t)XCD_BAR_WORDS * 4, stream);
    Args a{};
    for (int i = 0; i < 26; ++i) a.in[i] = (const float*)d_in[i];
    a.out = (float*)d_out; a.ws = (unsigned char*)d_ws;
#if MK_N_LAUNCHES == 1
    a.ph_lo = 0; a.ph_hi = N_PHASES;
    void* kargs[] = {&a};
    hipError_t e = hipLaunchCooperativeKernel((const void*)mega_fwd, dim3(grid), dim3(NTHR), kargs, LDS_BYTES, stream);
    if (e != hipSuccess) fprintf(stderr, "kernel_launch: cooperative launch failed: %s (grid %d)\n", hipGetErrorString(e), grid);
#else
    for (int p = 0; p < N_PHASES; ++p) { a.ph_lo = p; a.ph_hi = p + 1; hipLaunchKernelGGL(mega_fwd, dim3(grid), dim3(NTHR), LDS_BYTES, stream, a); }
#endif
}
```

```cpp
#include <hip/hip_runtime.h>
#include <cstdio>
#include <cstdint>
#include <math.h>

#ifndef MK_N_LAUNCHES
#define MK_N_LAUNCHES 1
#endif

constexpr int BATCH = 8, SEQ = 4096, DM = 1024, MTOK = BATCH * SEQ;
constexpr int DIN = 6160;
constexpr int NEXP = 16384;
constexpr float EPS = 1e-6f;

constexpr size_t MiB = 1u << 20;
constexpr size_t WS_CTL = 0, CTL_ZERO_BYTES = 1 * MiB;
constexpr size_t WS_WIN = 1 * MiB;
constexpr size_t WS_WQKV = 13 * MiB;
constexpr size_t WS_KEYS = 14 * MiB + 512 * 1024;
constexpr size_t WS_WLRU = 15 * MiB;
constexpr size_t WS_WB2 = 16 * MiB;
constexpr size_t WS_WOUT2 = 20 * MiB;
constexpr size_t WS_WPQ = 24 * MiB;
constexpr size_t WS_GATE = 28 * MiB;
constexpr size_t WS_WGT = 30 * MiB;
constexpr size_t WS_XM = 32 * MiB;
constexpr size_t WS_OP = 96 * MiB;
constexpr size_t WS_XL = 160 * MiB;
constexpr size_t WS_LG = 224 * MiB;
constexpr size_t WS_MG = 288 * MiB;
constexpr size_t WS_K = 416 * MiB;
constexpr size_t WS_AGG = 480 * MiB;
constexpr size_t WS_SS = 488 * MiB;
constexpr size_t WS_WIN8 = 489 * MiB;
constexpr size_t WS_END = 495 * MiB;

constexpr int CW_BAR = 4096;

constexpr int RING_BYTES = 131072;
constexpr int LDS_BYTES = 147456;
constexpr int LDSCTL_OFF = LDS_BYTES - 512, MISC_OFF = LDSCTL_OFF + 320;
constexpr int NWAVES = 8, NTHR = 512;

#define GAS __attribute__((address_space(1)))
#define LAS __attribute__((address_space(3)))
typedef unsigned short bf16;
typedef unsigned v4u __attribute__((ext_vector_type(4)));
typedef unsigned v2u __attribute__((ext_vector_type(2)));
typedef float f32x4 __attribute__((ext_vector_type(4)));
typedef float f32x2 __attribute__((ext_vector_type(2)));
typedef short bf16x8 __attribute__((ext_vector_type(8)));
typedef GAS unsigned gu32;
#define RLX_AGENT __ATOMIC_RELAXED, __HIP_MEMORY_SCOPE_AGENT
#define LDS_WAIT() asm volatile("s_waitcnt lgkmcnt(0)" ::: "memory")
#define VM_WAIT() asm volatile("s_waitcnt vmcnt(0)" ::: "memory")

__device__ __forceinline__ unsigned f2bf(float f) { unsigned u = __builtin_bit_cast(unsigned, f); return (u + 0x7fffu + ((u >> 16) & 1u)) >> 16; }
__device__ __forceinline__ unsigned pk2(float lo, float hi) { return f2bf(lo) | (f2bf(hi) << 16); }
__device__ __forceinline__ float bf2f(unsigned short h) { return __builtin_bit_cast(float, (unsigned)h << 16); }
__device__ __forceinline__ float bflo(unsigned w) { return __builtin_bit_cast(float, w << 16); }
__device__ __forceinline__ float bfhi(unsigned w) { return __builtin_bit_cast(float, w & 0xffff0000u); }
__device__ __forceinline__ float wave_sum(float v) {
#pragma unroll
  for (int o = 1; o < 64; o <<= 1) v += __shfl_xor(v, o);
  return v;
}
__device__ __forceinline__ float sigmoidf_(float x) { return __builtin_amdgcn_rcpf(1.f + __builtin_amdgcn_exp2f(x * -1.44269504089f)); }
__device__ __forceinline__ float gelu_erf(float x) { return 0.5f * x * (1.f + erff(x * 0.70710678118654752f)); }
__device__ __forceinline__ float gelu_fast(float v) {
    const float av = fabsf(v), t = __builtin_amdgcn_rcpf(av * 0.2316418882f + 1.0f);
    float q = t * 0.5307027145f + (-0.7265760135f); q = q * t + 0.7107068705f; q = q * t + (-0.142248368f); q = q * t + 0.127414796f; q = q * t;
    const float e = __builtin_amdgcn_exp2f((v * v) * (-0.72134752044f));
    const float m = v * (q * e);
    return v < 0.f ? m : v - m;
}
__device__ __forceinline__ float softplusf_(float x) { return fmaxf(x, 0.f) + log1pf(expf(-fabsf(x))); }

namespace pg8 {
#define PG8_LAS __attribute__((address_space(3)))
typedef unsigned short bf16_t;
typedef unsigned u32x4 __attribute__((ext_vector_type(4)));
typedef int i32x4_t __attribute__((ext_vector_type(4)));
constexpr int BM = 256, BK = 64, HALF = 128, HTB = HALF * BK * 2, STAGE_BYTES = 8 * HTB, NXCD = 8;

__host__ __device__ __forceinline__ int lds_byte(int r, int c) { const int st = (r >> 4) * 2 + (c >> 5), rr = r & 15, cc = c & 31, ob = rr * 64 + cc * 2; return st * 1024 + (ob ^ (((ob >> 9) & 1) << 5)); }
__host__ __device__ __forceinline__ void stage_rc(int b, int& R, int& C) { const int st = b / 1024, sb = b % 1024, swz = sb ^ (((sb >> 9) & 1) << 5); R = (st >> 1) * 16 + swz / 64; C = (st & 1) * 32 + (swz % 64) / 2; }
__host__ __device__ __forceinline__ int perm32(int rho) { const int n = rho >> 4, i = rho & 15; return 8 * (i >> 2) + 4 * n + (i & 3); }

struct Unit { int pm, pn; };
struct StaticOrder {
    int nM, nN, nwg, G, c, WGM;
    __host__ __device__ void init(int M, int N, int G_, int c_, int wgm = 8) { nM = M / BM; nN = N / BM; nwg = nM * nN; G = G_; c = c_; WGM = wgm; }
    __host__ __device__ bool next(int i, Unit& u) const {
        const long L = (long)i * G + c; if (L >= nwg) return false;
        int wgid = (int)L; { const int q = nwg / NXCD, r = nwg % NXCD, xcd = wgid % NXCD, off = wgid / NXCD; wgid = (xcd < r ? xcd * (q + 1) : r * (q + 1) + (xcd - r) * q) + off; }
        const int nig = WGM * nN, gid = wgid / nig, fm = gid * WGM, gsz = (nM - fm) < WGM ? (nM - fm) : WGM;
        u.pm = fm + ((wgid % nig) % gsz); u.pn = (wgid % nig) / gsz; return true;
    }
};

__device__ __forceinline__ unsigned cvt_pk_bf16(float lo, float hi) { unsigned r; asm volatile("v_cvt_pk_bf16_f32 %0, %1, %2" : "=v"(r) : "v"(lo), "v"(hi)); return r; }

template <class Epi, class Addr, int F8SC = 0>
__device__ __forceinline__ void gemm_phase(PG8_LAS unsigned char* lds, const Addr g, const StaticOrder& S, const Epi& E) {
    const int tid = threadIdx.x, wid = __builtin_amdgcn_readfirstlane(tid >> 6), lane = tid & 63, wr = wid >> 2, wc = wid & 3, fr = lane & 15, fq = lane >> 4;
    const int K = g.K, nt = K / BK;
    unsigned voffA[2], voffB[2];
#pragma unroll
    for (int i = 0; i < 2; ++i) { int R, C; stage_rc(tid * 16 + i * 8192, R, C); const int Rb = Epi::PERM ? ((R & ~31) + perm32(R & 31)) : R;
        voffA[i] = (unsigned)(R * g.lda + C) * 2u; voffB[i] = (unsigned)(Rb * g.ldb + C) * 2u; }
    const size_t kstep = (size_t)(BK * 2);
    const size_t hsA = (size_t)HALF * g.lda * 2, hsB = (size_t)HALF * g.ldb * 2;
    const unsigned ldsw = (unsigned)wid * 1024u;
    const int aoff = lds_byte(wr * 64 + fr, fq * 8), boff = lds_byte(wc * 32 + fr, fq * 8);
#define PG8_SA(b, h) (((b) * 2 + (h)) * HTB)
#define PG8_SB(b, h) ((4 + (b) * 2 + (h)) * HTB)
#define PG8_STAGE(bufoff, gbase, voff) do { _Pragma("unroll") for (int _i = 0; _i < 2; ++_i) \
        __builtin_amdgcn_global_load_lds((const unsigned*)((const char*)(gbase) + (voff)[_i]), (PG8_LAS unsigned*)(lds + (bufoff) + ldsw + _i * 8192), 16, 0, 0); } while (0)
#define PG8_LDA(dst, b, h) do { _Pragma("unroll") for (int m = 0; m < 4; ++m) _Pragma("unroll") for (int k = 0; k < 2; ++k) dst[m][k] = *(const PG8_LAS bf16x8*)(lds + PG8_SA(b, h) + aoff + m * 2048 + k * 1024); } while (0)
#define PG8_LDB(dst, b, h) do { _Pragma("unroll") for (int n = 0; n < 2; ++n) _Pragma("unroll") for (int k = 0; k < 2; ++k) dst[n][k] = *(const PG8_LAS bf16x8*)(lds + PG8_SB(b, h) + boff + n * 2048 + k * 1024); } while (0)
#define PG8_CAT(x0, x1) __builtin_shufflevector(__builtin_bit_cast(i32x4_t, x0), __builtin_bit_cast(i32x4_t, x1), 0, 1, 2, 3, 4, 5, 6, 7)
#define PG8_MMA(ai, bj, At, Bt) do { __builtin_amdgcn_s_setprio(1); \
        if constexpr (F8SC != 0) { _Pragma("unroll") for (int m = 0; m < 4; ++m) _Pragma("unroll") for (int n = 0; n < 2; ++n) \
            asm volatile("v_mfma_f32_16x16x128_f8f6f4 %0, %1, %2, %0" : "+v"(acc[ai][bj][m][n]) : "v"(PG8_CAT(Bt[n][0], Bt[n][1])), "v"(PG8_CAT(At[m][0], At[m][1]))); } \
        else { _Pragma("unroll") for (int m = 0; m < 4; ++m) _Pragma("unroll") for (int n = 0; n < 2; ++n) _Pragma("unroll") for (int k = 0; k < 2; ++k) \
            acc[ai][bj][m][n] = __builtin_amdgcn_mfma_f32_16x16x32_bf16(Bt[n][k], At[m][k], acc[ai][bj][m][n], 0, 0, 0); } \
        __builtin_amdgcn_s_setprio(0); } while (0)
#define PG8_WAIT_V(n) asm volatile("s_waitcnt vmcnt(" #n ")" ::: "memory")
#define PG8_WAIT_L(n) asm volatile("s_waitcnt lgkmcnt(" #n ")" ::: "memory")
#define PG8_BAR __builtin_amdgcn_s_barrier()
#define PG8_SCHED __builtin_amdgcn_sched_barrier(0)
    Unit cur, nxt; int ui = 0;
    if (!S.next(0, cur)) return;
    f32x4 acc[2][2][4][2];
#pragma unroll
    for (int a = 0; a < 2; ++a)
#pragma unroll
        for (int b = 0; b < 2; ++b)
#pragma unroll
            for (int m = 0; m < 4; ++m)
#pragma unroll
                for (int n = 0; n < 2; ++n) acc[a][b][m][n] = (f32x4){0.f, 0.f, 0.f, 0.f};
    bf16x8 At[4][2], B0[2][2], B1[2][2];
    const char* cA = g.a(cur); const char* cB = g.b(cur);
    PG8_STAGE(PG8_SB(0, 0), cB, voffB); PG8_STAGE(PG8_SB(0, 1), cB + hsB, voffB); PG8_STAGE(PG8_SA(0, 0), cA, voffA); PG8_STAGE(PG8_SA(0, 1), cA + hsA, voffA);
    if (wr == 1) PG8_BAR;
    PG8_WAIT_V(2); PG8_BAR;
    PG8_STAGE(PG8_SB(1, 0), cB + kstep, voffB); PG8_STAGE(PG8_SA(1, 0), cA + kstep, voffA); PG8_STAGE(PG8_SB(1, 1), cB + hsB + kstep, voffB);
    PG8_WAIT_V(6); PG8_BAR;
    for (;;) {
        const bool has_next = S.next(ui + 1, nxt);
        const char* nA = has_next ? g.a(nxt) : cA; const char* nB = has_next ? g.b(nxt) : cB;
#pragma unroll 1
        for (int t = 0; t < nt; t += 2) {
            const bool last = (t == nt - 2);
            const char* a1 = cA + (size_t)(t + 1) * kstep;
            const char* a2 = last ? nA : cA + (size_t)(t + 2) * kstep; const char* b2 = last ? nB : cB + (size_t)(t + 2) * kstep;
            const char* a3 = a2 + kstep; const char* b3 = b2 + kstep;
            PG8_LDB(B0, 0, 0); PG8_LDB(B1, 0, 1); PG8_SCHED; PG8_LDA(At, 0, 0); PG8_STAGE(PG8_SA(1, 1), a1 + hsA, voffA);
            PG8_WAIT_V(8); PG8_WAIT_L(0); PG8_BAR; PG8_MMA(0, 0, At, B0); PG8_MMA(0, 1, At, B1); PG8_BAR; PG8_SCHED;
            PG8_LDA(At, 0, 1); PG8_STAGE(PG8_SB(0, 0), b2, voffB); PG8_STAGE(PG8_SB(0, 1), b2 + hsB, voffB); PG8_STAGE(PG8_SA(0, 0), a2, voffA);
            PG8_WAIT_V(8); PG8_WAIT_L(0); PG8_BAR; PG8_MMA(1, 0, At, B0); PG8_MMA(1, 1, At, B1); PG8_BAR; PG8_SCHED;
            PG8_LDB(B0, 1, 0); PG8_LDB(B1, 1, 1); PG8_SCHED; PG8_LDA(At, 1, 0); PG8_STAGE(PG8_SA(0, 1), a2 + hsA, voffA);
            PG8_WAIT_V(8); PG8_WAIT_L(0); PG8_BAR; PG8_MMA(0, 0, At, B0); PG8_MMA(0, 1, At, B1); PG8_BAR; PG8_SCHED;
            PG8_LDA(At, 1, 1); PG8_STAGE(PG8_SB(1, 0), b3, voffB); PG8_STAGE(PG8_SB(1, 1), b3 + hsB, voffB); PG8_STAGE(PG8_SA(1, 0), a3, voffA);
            PG8_WAIT_V(8); PG8_WAIT_L(0); PG8_BAR; PG8_MMA(1, 0, At, B0); PG8_MMA(1, 1, At, B1); PG8_BAR; PG8_SCHED;
        }
        if constexpr (F8SC != 0) asm volatile("s_nop 15\n\ts_nop 15" ::: "memory");
        if (wr == 0) PG8_BAR;
        E(acc, cur, wr, wc, fr, fq);
        if (!has_next) break;
#pragma unroll
        for (int a = 0; a < 2; ++a)
#pragma unroll
            for (int b = 0; b < 2; ++b)
#pragma unroll
                for (int m = 0; m < 4; ++m)
#pragma unroll
                    for (int n = 0; n < 2; ++n) acc[a][b][m][n] = (f32x4){0.f, 0.f, 0.f, 0.f};
        cur = nxt; cA = nA; cB = nB; ++ui;
        if (wr == 1) PG8_BAR;
    }
    PG8_WAIT_V(0);
    PG8_BAR;
#undef PG8_SA
#undef PG8_SB
#undef PG8_STAGE
#undef PG8_LDA
#undef PG8_LDB
#undef PG8_MMA
#undef PG8_CAT
#undef PG8_WAIT_V
#undef PG8_WAIT_L
#undef PG8_BAR
#undef PG8_SCHED
}
}

#define XB_TMO      128
#define XB_XCNT(j)  (256  + 64 * (j))
#define XB_XSUB(j)  (1280 + 64 * (j))
#define XB_XGEN(j)  (2304 + 64 * (j))
#define XB_TOP      3328
#define XB_TOPGEN   3392
#define XCD_BAR_WORDS 3456
#define XB_SPIN_CAP (1u << 18)
__device__ __forceinline__ unsigned xb_ld(unsigned* p)              { return __hip_atomic_load(p, __ATOMIC_RELAXED, __HIP_MEMORY_SCOPE_AGENT); }
__device__ __forceinline__ unsigned xb_add(unsigned* p, unsigned v) { return __hip_atomic_fetch_add(p, v, __ATOMIC_RELAXED, __HIP_MEMORY_SCOPE_AGENT); }
__device__ __forceinline__ unsigned xb_xcc_id() { return (unsigned)__builtin_amdgcn_s_getreg((3 << 11) | 20) & 0xFu; }
#define XB_SPIN(cond, bar) do { unsigned _sp = 0; while (cond) { __builtin_amdgcn_s_sleep(1); \
    if ((++_sp & 255u) == 0u) { if (xb_ld(&(bar)[XB_TMO])) break; if (_sp > XB_SPIN_CAP) { atomicAdd(&(bar)[XB_TMO], 1u); break; } } } } while (0)
struct XcdBarrier { unsigned* bar; unsigned x; volatile LAS unsigned* st; };
__device__ __forceinline__ XcdBarrier xcd_barrier_post(unsigned* bar, volatile LAS unsigned* st) {
    XcdBarrier b; b.bar = bar; b.x = xb_xcc_id(); b.st = st;
    if (threadIdx.x == 0) (void)xb_add(&bar[XB_XCNT(b.x)], 1u);
    return b;
}
__device__ __forceinline__ void xcd_barrier_complete(unsigned* bar, unsigned x, unsigned& nloc, unsigned& nx) {
    const unsigned G = gridDim.x * gridDim.y * gridDim.z;
    unsigned sum, cnt, mine, sp = 0u;
    for (;;) {
        sum = 0u; cnt = 0u; mine = 0u;
#pragma unroll
        for (unsigned j = 0; j < 16; ++j) { const unsigned c = xb_ld(&bar[XB_XCNT(j)]); sum += c; cnt += (c > 0u) ? 1u : 0u; mine = (j == x) ? c : mine; }
        if (sum == G) break;
        __builtin_amdgcn_s_sleep(1);
        if ((++sp & 255u) == 0u) { if (xb_ld(&bar[XB_TMO])) break; if (sp > XB_SPIN_CAP) { atomicAdd(&bar[XB_TMO], 1u); break; } }
    }
    nloc = mine > 0u ? mine : 1u; nx = cnt > 0u ? cnt : 1u;
}
__device__ __forceinline__ void xcd_barrier(const XcdBarrier& b) {
    asm volatile("s_waitcnt vmcnt(0)" ::: "memory");
    __syncthreads();
    if (threadIdx.x == 0) {
        unsigned* bar = b.bar;
        __builtin_amdgcn_s_waitcnt(0);
        unsigned nloc = b.st[0], nx = b.st[1];
        if (nloc == 0u) { xcd_barrier_complete(bar, b.x, nloc, nx); b.st[0] = nloc; b.st[1] = nx; }
        const unsigned old = xb_add(&bar[XB_XSUB(b.x)], 1u);
        const unsigned gen = old / nloc;
        if (old + 1u == (gen + 1u) * nloc) {
            __builtin_amdgcn_fence(__ATOMIC_RELEASE, "agent");
            asm volatile("s_waitcnt vmcnt(0)" ::: "memory");
            const unsigned og = xb_add(&bar[XB_TOP], 1u);
            const unsigned tg = og / nx;
            if (og + 1u == (tg + 1u) * nx) xb_add(&bar[XB_TOPGEN], 1u);
            else XB_SPIN(xb_ld(&bar[XB_TOPGEN]) == tg, bar);
            __builtin_amdgcn_fence(__ATOMIC_ACQUIRE, "agent");
            xb_add(&bar[XB_XGEN(b.x)], 1u);
            asm volatile("s_waitcnt vmcnt(0)" ::: "memory");
        } else {
            XB_SPIN(xb_ld(&bar[XB_XGEN(b.x)]) == gen, bar);
            __builtin_amdgcn_fence(__ATOMIC_ACQUIRE, "agent");
            asm volatile("s_waitcnt vmcnt(0)" ::: "memory");
        }
    }
    __syncthreads();
}

struct Args { const float* in[26]; float* out; unsigned char* ws; int ph_lo, ph_hi; };
struct Frame {
    LAS unsigned char* lds;
    int tid, lane, wave, G, bid;
    const float* const* in; float* out; unsigned char* ws;
};

template <bool F8 = false> __device__ __forceinline__ void tr_item(const float* W, int ldw, bf16* WT, int ldt, float scale, const float* kscale, LAS float* scr, int k0, int lane) {
#pragma unroll 8
    for (int i = 0; i < 32; ++i) { const int kk = 2 * i + (lane >> 5); float v = W[(size_t)(k0 + kk) * ldw + (lane & 31)] * scale; if (kscale) v *= kscale[k0 + kk]; scr[kk * 33 + (lane & 31)] = v; }
    LDS_WAIT(); asm volatile("" ::: "memory");
    const int c = lane & 7;
#pragma unroll
    for (int j = 0; j < 4; ++j) { const int n = (lane >> 3) + 8 * j; const LAS float* s = scr + (8 * c) * 33 + n;
        if constexpr (F8) {
            int p0 = 0, p1 = 0; p0 = __builtin_amdgcn_cvt_pk_fp8_f32(s[0 * 33], s[1 * 33], p0, false); p0 = __builtin_amdgcn_cvt_pk_fp8_f32(s[2 * 33], s[3 * 33], p0, true);
            p1 = __builtin_amdgcn_cvt_pk_fp8_f32(s[4 * 33], s[5 * 33], p1, false); p1 = __builtin_amdgcn_cvt_pk_fp8_f32(s[6 * 33], s[7 * 33], p1, true);
            *(GAS v2u*)((GAS unsigned char*)WT + (size_t)n * ldt + k0 + 8 * c) = (v2u){(unsigned)p0, (unsigned)p1};
        } else {
        v4u o; o.x = pk2(s[0 * 33], s[1 * 33]); o.y = pk2(s[2 * 33], s[3 * 33]); o.z = pk2(s[4 * 33], s[5 * 33]); o.w = pk2(s[6 * 33], s[7 * 33]);
        *(GAS v4u*)(WT + (size_t)n * ldt + k0 + 8 * c) = o; } }
    LDS_WAIT(); asm volatile("" ::: "memory");
}

__device__ __forceinline__ void p0_prologue(Frame& F) {
    LAS float* scr = (LAS float*)(F.lds + F.wave * 16384);
    const int gw = F.bid * NWAVES + F.wave, NGW = F.G * NWAVES;
    unsigned char* ws = F.ws;
    const float* w_in = F.in[2];
    constexpr int I_WIN = 16 * 192, I_QKV = 12 * 32, I_LRU = 32 * 8, I_WB = 2 * 512, I_WO = 2 * 512, I_PQ = 16 * 64;
    constexpr int NITEMS = I_WIN + I_QKV + I_LRU + I_WB + I_WO + I_PQ;
    for (int it = gw; it < NITEMS; it += NGW) {
        int r = it;
        if (r < I_WIN) { const int kb = r / 192, nb = r % 192, n0 = nb * 32, sc = n0 < 2048 ? n0 : n0 + 16;
            if ((n0 >= 1024 && n0 < 2048) || n0 >= 4096) tr_item<true>(w_in + sc, DIN, (bf16*)(ws + WS_WIN8 + (size_t)n0 * 1024), 1024, 1024.f, nullptr, scr, kb * 64, F.lane);
            else tr_item(w_in + sc, DIN, (bf16*)(ws + WS_WIN) + (size_t)n0 * 1024, 1024, 1.f, nullptr, scr, kb * 64, F.lane);
            continue; }
        r -= I_WIN;
        if (r < I_QKV) { const int mat = r / 32, rr = r % 32, kb = rr / 8, nb = rr % 8, g = mat >> 2, h = mat & 3;
            const float* W = F.in[6 + g] + (size_t)h * 65536 + nb * 32;
            tr_item(W, 256, (bf16*)(ws + WS_WQKV) + (size_t)mat * 65536 + (size_t)(nb * 32) * 256, 256, g == 1 ? 0.0625f : 1.f, nullptr, scr, kb * 64, F.lane); continue; }
        r -= I_QKV;
        if (r < I_LRU) { const int mat = r / 8, rr = r % 8, kb = rr / 4, nb = rr % 4, gate = mat & 1, db = mat >> 1;
            const float* W = F.in[gate ? 14 : 12] + (size_t)db * 16384 + nb * 32;
            tr_item(W, 128, (bf16*)(ws + WS_WLRU) + (size_t)mat * 16384 + (size_t)(nb * 32) * 128, 128, 1.f, nullptr, scr, kb * 64, F.lane); continue; }
        r -= I_LRU;
        if (r < I_WB) { const int mat = r / 512, rr = r % 512, kb = rr / 32, nb = rr % 32;
            const float* W = F.in[17 + mat] + nb * 32;
            tr_item(W, 1024, (bf16*)(ws + WS_WB2) + (size_t)(mat * 1024 + nb * 32) * 1024, 1024, 1.f, nullptr, scr, kb * 64, F.lane); continue; }
        r -= I_WB;
        if (r < I_WO) { const int cp = r / 512, rr = r % 512, kb = rr / 32, nb = rr % 32;
            const float* W = F.in[19] + nb * 32;
            tr_item(W, 1024, (bf16*)(ws + WS_WOUT2) + (size_t)(nb * 32) * 2048 + cp * 1024, 2048, 1.f, nullptr, scr, kb * 64, F.lane); continue; }
        r -= I_WO;
        { const int kb = r / 64, nb = r % 64;
            const float* W = F.in[21] + nb * 32;
            tr_item(W, 2048, (bf16*)(ws + WS_WPQ) + (size_t)(nb * 32) * 1024, 1024, 1.f, F.in[20], scr, kb * 64, F.lane); }
    }
    { const int gt = F.bid * NTHR + F.tid, NGT = F.G * NTHR;
      const float4* ks = (const float4*)F.in[22]; v2u* kd = (v2u*)(ws + WS_KEYS);
      for (int i = gt; i < 8 * 2 * 128 * 128 / 4; i += NGT) { const float4 v = ks[i]; v2u o; o.x = pk2(v.x, v.y); o.y = pk2(v.z, v.w); kd[i] = o; }
      float* ss = (float*)(ws + WS_SS);
      for (int i = gt; i < MTOK; i += NGT) ss[i] = 0.f; }
    { const int gt = F.bid * NTHR + F.tid;
      if (gt < 16 * 128) { const int c = gt >> 7, k8 = gt & 127; v4u o; unsigned wv[4];
#pragma unroll
          for (int j = 0; j < 4; ++j) wv[j] = pk2(w_in[(size_t)(k8 * 8 + 2 * j) * DIN + 2048 + c], w_in[(size_t)(k8 * 8 + 2 * j + 1) * DIN + 2048 + c]);
          o.x = wv[0]; o.y = wv[1]; o.z = wv[2]; o.w = wv[3]; *(v4u*)((bf16*)(ws + WS_WGT) + c * 1024 + k8 * 8) = o; } }
    const float* x = F.in[0]; const float* g1 = F.in[1];
    bf16* XN = (bf16*)(ws + WS_K);
    unsigned char* XN8 = (unsigned char*)F.out;
    f32x4 gv[4];
#pragma unroll
    for (int j = 0; j < 4; ++j) gv[j] = ((const f32x4*)g1)[F.lane + 64 * j];
    for (int m = 2 * gw; m < MTOK; m += 2 * NGW) {
        const f32x4* xr0 = (const f32x4*)(x + (size_t)m * DM) + F.lane; const f32x4* xr1 = xr0 + DM / 4;
        f32x4 v0[4], v1[4]; float s0 = 0.f, s1 = 0.f;
#pragma unroll
        for (int j = 0; j < 4; ++j) { v0[j] = xr0[64 * j]; v1[j] = xr1[64 * j]; }
#pragma unroll
        for (int j = 0; j < 4; ++j) { s0 += (v0[j].x * v0[j].x + v0[j].y * v0[j].y) + (v0[j].z * v0[j].z + v0[j].w * v0[j].w); s1 += (v1[j].x * v1[j].x + v1[j].y * v1[j].y) + (v1[j].z * v1[j].z + v1[j].w * v1[j].w); }
        const float r0 = rsqrtf(wave_sum(s0) * (1.f / DM) + EPS), r1 = rsqrtf(wave_sum(s1) * (1.f / DM) + EPS);
        unsigned long long* o0 = (unsigned long long*)(XN + (size_t)m * DM) + F.lane; unsigned long long* o1 = o0 + DM / 4;
        unsigned* q0 = (unsigned*)(XN8 + (size_t)m * DM) + F.lane; unsigned* q1 = q0 + DM / 4;
#pragma unroll
        for (int j = 0; j < 4; ++j) { const f32x4 a = v0[j] * r0 * gv[j], c = v1[j] * r1 * gv[j];
            o0[64 * j] = (unsigned long long)pk2(a.x, a.y) | ((unsigned long long)pk2(a.z, a.w) << 32);
            o1[64 * j] = (unsigned long long)pk2(c.x, c.y) | ((unsigned long long)pk2(c.z, c.w) << 32);
            int pa = 0, pc = 0; pa = __builtin_amdgcn_cvt_pk_fp8_f32(a.x, a.y, pa, false); pa = __builtin_amdgcn_cvt_pk_fp8_f32(a.z, a.w, pa, true);
            pc = __builtin_amdgcn_cvt_pk_fp8_f32(c.x, c.y, pc, false); pc = __builtin_amdgcn_cvt_pk_fp8_f32(c.z, c.w, pc, true);
            q0[64 * j] = (unsigned)pa; q1[64 * j] = (unsigned)pc; }
    }
}
__device__ __forceinline__ void gates_phase(Frame& F) {
    const bf16* XN = (const bf16*)(F.ws + WS_K); const bf16* WGT = (const bf16*)(F.ws + WS_WGT); float* GT = (float*)(F.ws + WS_GATE);
    const int lane = F.lane, fr = lane & 15, fq = lane >> 4;
    const f32x4 bg4 = *(const f32x4*)(F.in[3] + 4 * fq);
    for (int task = F.bid * NWAVES + F.wave; task < MTOK / 16; task += F.G * NWAVES) {
        const size_t m0 = (size_t)task * 16;
        f32x4 acc = (f32x4){0.f, 0.f, 0.f, 0.f};
#pragma unroll 8
        for (int ks = 0; ks < 32; ++ks) {
            const bf16x8 wfr = *(const bf16x8*)(WGT + fr * 1024 + 32 * ks + 8 * fq);
            const bf16x8 xfr = *(const bf16x8*)(XN + (m0 + fr) * DM + 32 * ks + 8 * fq);
            acc = __builtin_amdgcn_mfma_f32_16x16x32_bf16(wfr, xfr, acc, 0, 0, 0);
        }
        *(f32x4*)(GT + (m0 + fr) * 16 + 4 * fq) = acc + bg4;
    }
}

struct AddrPlain {
    const char* A; const char* Bt; int lda, ldb, K;
    __device__ __forceinline__ const char* a(const pg8::Unit& u) const { return A + (size_t)u.pm * 256 * lda * 2; }
    __device__ __forceinline__ const char* b(const pg8::Unit& u) const { return Bt + (size_t)u.pn * 256 * ldb * 2; }
};
struct AddrP1 {
    const char* A; const char* Bt; int lda, ldb, K, lo_add, hi_add;
    __device__ __forceinline__ const char* a(const pg8::Unit& u) const { return A + (size_t)u.pm * 256 * lda * 2; }
    __device__ __forceinline__ const char* b(const pg8::Unit& u) const { return Bt + (size_t)(u.pn + (u.pn < 4 ? lo_add : hi_add)) * 256 * ldb * 2; }
};
struct AddrQKV {
    const char* XC; long dXM; const char* W; int lda, ldb, K;
    __device__ __forceinline__ const char* a(const pg8::Unit& u) const { return XC + (u.pn < 8 ? 0l : dXM) + ((size_t)u.pm * 256 * 1024 + (u.pn & 3) * 256) * 2; }
    __device__ __forceinline__ const char* b(const pg8::Unit& u) const { return W + (size_t)u.pn * 65536 * 2; }
};
struct AddrBranch {
    const char* YM; long dYL; const char* W; int lda, ldb, K;
    __device__ __forceinline__ const char* a(const pg8::Unit& u) const { return YM + (u.pn < 4 ? 0l : dYL) + (size_t)u.pm * 256 * 1024 * 2; }
    __device__ __forceinline__ const char* b(const pg8::Unit& u) const { return W + (size_t)u.pn * 256 * 1024 * 2; }
};

struct DstP1 { unsigned char* ws; int lo_add, hi_add;
    __device__ __forceinline__ bf16* get(int j, int& ld, int& col0) const {
        const int pn = j + (j < 4 ? lo_add : hi_add); const bool mg = pn >= 16; ld = mg ? 2048 : 1024; col0 = mg ? (pn - 16) * 256 : (pn & 3) * 256;
        return (bf16*)(ws + (mg ? WS_MG : WS_XM + (size_t)(pn >> 2) * 64 * MiB)); } };
struct DstQKV { char* q; long dk, dv;
    __device__ __forceinline__ bf16* get(int pn, int& ld, int& col0) const { ld = 1024; col0 = (pn & 3) * 256; return (bf16*)(q + (pn >= 4 ? (pn >= 8 ? dv : dk) : 0l)); } };
template <class Dst, bool MUL = false> struct EpiBf16 {
    static constexpr bool PERM = true;
    Dst dst; float mul;
    __device__ __forceinline__ void operator()(const f32x4 (&acc)[2][2][4][2], const pg8::Unit& u, int wr, int wc, int fr, int fq) const {
        int ld, colt; bf16* base = dst.get(u.pn, ld, colt);
        const int row0 = u.pm * 256 + wr * 64 + fr, col0 = colt + wc * 32 + 8 * fq;
#pragma unroll
        for (int ai = 0; ai < 2; ++ai)
#pragma unroll
            for (int m = 0; m < 4; ++m) { bf16* rowp = base + (size_t)(row0 + ai * 128 + m * 16) * ld + col0;
#pragma unroll
                for (int bj = 0; bj < 2; ++bj) { f32x4 v0 = acc[ai][bj][m][0], v1 = acc[ai][bj][m][1]; if (MUL) { v0 = v0 * mul; v1 = v1 * mul; }
                    v4u w; w.x = pg8::cvt_pk_bf16(v0[0], v0[1]); w.y = pg8::cvt_pk_bf16(v0[2], v0[3]); w.z = pg8::cvt_pk_bf16(v1[0], v1[1]); w.w = pg8::cvt_pk_bf16(v1[2], v1[3]);
                    *(v4u*)(rowp + bj * 128) = w; } }
    }
};
template <bool ADD> struct EpiMerge {
    static constexpr bool PERM = true;
    bf16* MRG; const bf16* MG; int gcol;
    __device__ __forceinline__ void operator()(const f32x4 (&acc)[2][2][4][2], const pg8::Unit& u, int wr, int wc, int fr, int fq) const {
        const int row0 = u.pm * 256 + wr * 64 + fr, col0 = u.pn * 256 + wc * 32 + 8 * fq;
#pragma unroll
        for (int ai = 0; ai < 2; ++ai)
#pragma unroll
            for (int m = 0; m < 4; ++m) { const size_t row = (size_t)(row0 + ai * 128 + m * 16); bf16* rowp = MRG + row * 1024 + col0; const bf16* gp = MG + row * 2048 + gcol + col0;
#pragma unroll
                for (int bj = 0; bj < 2; ++bj) { const f32x4 v0 = acc[ai][bj][m][0], v1 = acc[ai][bj][m][1];
                    const v4u g = *(const v4u*)(gp + bj * 128);
                    float o[8] = {v0[0] * sigmoidf_(bflo(g.x)), v0[1] * sigmoidf_(bfhi(g.x)), v0[2] * sigmoidf_(bflo(g.y)), v0[3] * sigmoidf_(bfhi(g.y)),
                                  v1[0] * sigmoidf_(bflo(g.z)), v1[1] * sigmoidf_(bfhi(g.z)), v1[2] * sigmoidf_(bflo(g.w)), v1[3] * sigmoidf_(bfhi(g.w))};
                    if (ADD) { const v4u t = *(const v4u*)(rowp + bj * 128);
                        o[0] += bflo(t.x); o[1] += bfhi(t.x); o[2] += bflo(t.y); o[3] += bfhi(t.y); o[4] += bflo(t.z); o[5] += bfhi(t.z); o[6] += bflo(t.w); o[7] += bfhi(t.w); }
                    v4u w; w.x = pg8::cvt_pk_bf16(o[0], o[1]); w.y = pg8::cvt_pk_bf16(o[2], o[3]); w.z = pg8::cvt_pk_bf16(o[4], o[5]); w.w = pg8::cvt_pk_bf16(o[6], o[7]);
                    *(v4u*)(rowp + bj * 128) = w; } }
    }
};
struct EpiResid {
    static constexpr bool PERM = false;
    const float* x; float* x1; bf16* x1b; float* ss;
    __device__ __forceinline__ void operator()(const f32x4 (&acc)[2][2][4][2], const pg8::Unit& u, int wr, int wc, int fr, int fq) const {
        const int row0 = u.pm * 256 + wr * 64 + fr, col0 = u.pn * 256 + wc * 32 + 4 * fq;
#pragma unroll
        for (int ai = 0; ai < 2; ++ai)
#pragma unroll
            for (int m = 0; m < 4; ++m) { const int row = row0 + ai * 128 + m * 16; const size_t off = (size_t)row * DM + col0; float s = 0.f;
#pragma unroll
                for (int bj = 0; bj < 2; ++bj)
#pragma unroll
                    for (int n = 0; n < 2; ++n) { const size_t o = off + bj * 128 + n * 16; const f32x4 v = *(const f32x4*)(x + o) + acc[ai][bj][m][n];
                        *(f32x4*)(x1 + o) = v; v2u w; w.x = pg8::cvt_pk_bf16(v[0], v[1]); w.y = pg8::cvt_pk_bf16(v[2], v[3]); *(v2u*)(x1b + o) = w;
                        s += (v[0] * v[0] + v[1] * v[1]) + (v[2] * v[2] + v[3] * v[3]); }
                s += __shfl_xor(s, 16); s += __shfl_xor(s, 32);
                if (fq == 0) atomicAdd(ss + row, s); }
    }
};
struct EpiPQ {
    static constexpr bool PERM = true;
    bf16* pq; const float* ss;
    __device__ __forceinline__ void operator()(const f32x4 (&acc)[2][2][4][2], const pg8::Unit& u, int wr, int wc, int fr, int fq) const {
        const int row0 = u.pm * 256 + wr * 64 + fr, col0 = u.pn * 256 + wc * 32 + 8 * fq;
#pragma unroll
        for (int ai = 0; ai < 2; ++ai)
#pragma unroll
            for (int m = 0; m < 4; ++m) { const int row = row0 + ai * 128 + m * 16; bf16* rowp = pq + (size_t)row * 2048 + col0;
                const float r = rsqrtf(ss[row] * (1.f / DM) + EPS);
#pragma unroll
                for (int bj = 0; bj < 2; ++bj) { const f32x4 v0 = acc[ai][bj][m][0] * r, v1 = acc[ai][bj][m][1] * r;
                    v4u w; w.x = pg8::cvt_pk_bf16(v0[0], v0[1]); w.y = pg8::cvt_pk_bf16(v0[2], v0[3]); w.z = pg8::cvt_pk_bf16(v1[0], v1[1]); w.w = pg8::cvt_pk_bf16(v1[2], v1[3]);
                    *(v4u*)(rowp + bj * 128) = w; } }
    }
};

template <bool PB> __device__ __forceinline__ void lru_phase(Frame& F) {
    const bf16* XL = (const bf16*)(F.ws + WS_XL); const bf16* LG = (const bf16*)(F.ws + WS_LG); bf16* YL = (bf16*)F.out;
    f32x2* AGG = (f32x2*)(F.ws + WS_AGG);
    const bf16* WL = (const bf16*)(F.ws + WS_WLRU);
    const float* cw = F.in[10]; const float* cb = F.in[11];
    unsigned char* LA0 = F.ws + WS_K; unsigned char* LA1 = LA0 + (size_t)MTOK * DM; bf16* LU0 = (bf16*)F.out; bf16* LU1 = LU0 + (size_t)MTOK * DM;
    v2u ra[2]; v4u ru[2];
    constexpr int O_XCB = 0, O_XCF = 17408, O_A = 51200, O_U = 84992, FST = 528;
    LAS unsigned char* L = F.lds;
    const int tid = F.tid, lane = F.lane, w = F.wave, fr = lane & 15, fq = lane >> 4;
    int cur_blk = -1;
    bf16x8 wf[2][2][4];
    f32x4 br4[2], bi4[2], sp4[2];
    v4u rawreg[3];
#define RAW_LOAD(bb, tt0, bk) do { _Pragma("unroll") for (int r_ = 0; r_ < 3; ++r_) { const int e_ = tid + NTHR * r_, row_ = e_ >> 4, c16_ = e_ & 15, t_ = (tt0) - 2 + row_; \
            v4u v_ = {0u, 0u, 0u, 0u}; if (e_ < 68 * 16 && t_ >= 0 && t_ < SEQ) v_ = *(const v4u*)(XL + ((size_t)(bb) * SEQ + t_) * DM + (bk) * 128 + c16_ * 8); rawreg[r_] = v_; } } while (0)
#define PB_LOAD(ii, dd) do { const int idx_ = (ii) * F.G + F.bid; if (idx_ < 4096) { const int j_ = idx_ >> 3; const size_t mr_ = (size_t)(j_ >> 6) * SEQ + (j_ & 63) * 64; \
            _Pragma("unroll") for (int r_ = 0; r_ < 2; ++r_) { const int e_ = tid + NTHR * r_; const size_t o_ = (mr_ + (e_ >> 4)) * DM + (idx_ & 7) * 128 + (e_ & 15) * 8; \
                ra[r_] = *(const v2u*)(((dd) ? LA1 : LA0) + o_); ru[r_] = *(const v4u*)(((dd) ? LU1 : LU0) + o_); } } } while (0)
    constexpr int O_CARRY = 118784, O_CW = 135168, O_SUB = 137728;
    const bool carry_tab = PB && (F.G == 256);
    if (carry_tab) {
        const int ch = tid & 127, bq = tid >> 7, s0 = F.bid >> 3, blk0 = F.bid & 7;
        LAS float* CT = (LAS float*)(L + O_CARRY);
#define FOLD(agp, j0, j1, stp, hv) do { int js_ = (j0); const int n_ = ((j1) - (j0)) * (stp); int k_ = 0; \
            for (; k_ + 8 <= n_; k_ += 8) { f32x2 ah_[8]; _Pragma("unroll") for (int q_ = 0; q_ < 8; ++q_) ah_[q_] = (agp)[(size_t)(js_ + q_ * (stp)) * 2 * DM]; \
                _Pragma("unroll") for (int q_ = 0; q_ < 8; ++q_) hv = ah_[q_][0] * hv + ah_[q_][1]; js_ += 8 * (stp); } \
            for (; k_ < n_; ++k_) { const f32x2 a1_ = (agp)[(size_t)js_ * 2 * DM]; hv = a1_[0] * hv + a1_[1]; js_ += (stp); } } while (0)
        for (int bb = 2 * bq; bb < 2 * bq + 2; ++bb) {
            const f32x2* ag0 = AGG + ((size_t)(bb * 64) * 2 + 0) * DM + blk0 * 128 + ch; const f32x2* ag1 = AGG + ((size_t)(bb * 64) * 2 + 1) * DM + blk0 * 128 + ch;
            float h = 0.f;
            FOLD(ag0, 0, s0, 1, h); CT[((bb * 2 + 0) * 2 + 0) * 128 + ch] = h;
            FOLD(ag0, s0, s0 + 32, 1, h); CT[((bb * 2 + 1) * 2 + 0) * 128 + ch] = h;
            h = 0.f;
            FOLD(ag1, 63, s0 + 32, -1, h); CT[((bb * 2 + 1) * 2 + 1) * 128 + ch] = h;
            FOLD(ag1, s0 + 32, s0, -1, h); CT[((bb * 2 + 0) * 2 + 1) * 128 + ch] = h;
        }
        __syncthreads();
#undef FOLD
    }
    for (int i = 0;; ++i) {
        const int idx = i * F.G + F.bid; if (idx >= 4096) break;
        const int blk = idx & 7, j = idx >> 3, b = j >> 6, seg = j & 63, t0 = seg * 64;
        const size_t mrow0 = (size_t)b * SEQ + t0;
        if (!PB && blk != cur_blk) {
            cur_blk = blk;
#pragma unroll
            for (int d = 0; d < 2; ++d) {
#pragma unroll
                for (int g = 0; g < 2; ++g)
#pragma unroll
                    for (int ks = 0; ks < 4; ++ks)
                        wf[d][g][ks] = *(const bf16x8*)(WL + ((size_t)((d * 8 + blk) * 2 + g) * 128 + 16 * w + fr) * 128 + 32 * ks + 8 * fq);
                const int ch = blk * 128 + 16 * w + 4 * fq;
                br4[d] = *(const f32x4*)(F.in[13] + d * DM + ch); bi4[d] = *(const f32x4*)(F.in[15] + d * DM + ch);
                const f32x4 lm = *(const f32x4*)(F.in[16] + d * DM + ch);
#pragma unroll
                for (int e = 0; e < 4; ++e) sp4[d][e] = -8.f * 1.44269504089f * softplusf_(-lm[e]);
            }
            __syncthreads();
            for (int e = tid; e < 5 * 128; e += NTHR) { const int jt = e >> 7, cc = e & 127; ((LAS float*)(L + O_CW))[e] = (jt < 4) ? cw[jt * DM + blk * 128 + cc] : cb[blk * 128 + cc]; }
        }
        v4u lgreg[2];
        if (PB) {
            if (i == 0) PB_LOAD(0, 0);
#pragma unroll
            for (int r = 0; r < 2; ++r) { const int e = tid + NTHR * r; lgreg[r] = *(const v4u*)(LG + (mrow0 + (e >> 4)) * DM + blk * 128 + (e & 15) * 8); }
        } else {
        if (i == 0) RAW_LOAD(b, t0, blk);
#pragma unroll
        for (int r = 0; r < 3; ++r) { const int e = tid + NTHR * r; if (e < 68 * 16) *(LAS v4u*)(L + O_A + (e >> 4) * 256 + (e & 15) * 16) = rawreg[r]; }
        __syncthreads();
        { const int idx2 = (i + 1) * F.G + F.bid; if (idx2 < 4096) { const int j2 = idx2 >> 3; RAW_LOAD(j2 >> 6, (j2 & 63) * 64, idx2 & 7); } }
        for (int e = tid; e < 64 * 16; e += NTHR) { const int tl = e >> 4, c16 = e & 15;
            float y[8];
            { const f32x4 a = *(const LAS f32x4*)(L + O_CW + 4 * 512 + c16 * 32), bq = *(const LAS f32x4*)(L + O_CW + 4 * 512 + c16 * 32 + 16); y[0] = a[0]; y[1] = a[1]; y[2] = a[2]; y[3] = a[3]; y[4] = bq[0]; y[5] = bq[1]; y[6] = bq[2]; y[7] = bq[3]; }
#pragma unroll
            for (int jt = 0; jt < 4; ++jt) { const v4u r = *(const LAS v4u*)(L + O_A + (tl + jt) * 256 + c16 * 16);
                const f32x4 wa = *(const LAS f32x4*)(L + O_CW + jt * 512 + c16 * 32), wb = *(const LAS f32x4*)(L + O_CW + jt * 512 + c16 * 32 + 16);
                y[0] += wa[0] * bflo(r.x); y[1] += wa[1] * bfhi(r.x); y[2] += wa[2] * bflo(r.y); y[3] += wa[3] * bfhi(r.y);
                y[4] += wb[0] * bflo(r.z); y[5] += wb[1] * bfhi(r.z); y[6] += wb[2] * bflo(r.w); y[7] += wb[3] * bfhi(r.w); }
            *(LAS f32x4*)(L + O_XCF + tl * FST + c16 * 32) = (f32x4){y[0], y[1], y[2], y[3]};
            *(LAS f32x4*)(L + O_XCF + tl * FST + c16 * 32 + 16) = (f32x4){y[4], y[5], y[6], y[7]};
            v4u o; o.x = pk2(y[0], y[1]); o.y = pk2(y[2], y[3]); o.z = pk2(y[4], y[5]); o.w = pk2(y[6], y[7]);
            *(LAS v4u*)(L + O_XCB + tl * 272 + c16 * 16) = o; }
        __syncthreads();
        }
        float carry0 = 0.f, carry1 = 0.f;
        if (carry_tab) { const LAS float* CT = (const LAS float*)(L + O_CARRY); carry0 = CT[((b * 2 + (seg >> 5)) * 2 + 0) * 128 + (tid & 127)]; carry1 = CT[((b * 2 + (seg >> 5)) * 2 + 1) * 128 + (tid & 127)]; }
        else if (PB) {
            const int ch = blk * 128 + (tid & 127);
            float h = 0.f;
            const f32x2* ag0 = AGG + ((size_t)(b * 64) * 2 + 0) * DM + ch; const f32x2* ag1 = AGG + ((size_t)(b * 64) * 2 + 1) * DM + ch;
            int js = 0;
            for (; js + 8 <= seg; js += 8) { f32x2 ah[8];
#pragma unroll
                for (int q = 0; q < 8; ++q) ah[q] = ag0[(size_t)(js + q) * 2 * DM];
#pragma unroll
                for (int q = 0; q < 8; ++q) h = ah[q][0] * h + ah[q][1]; }
            for (; js < seg; ++js) { const f32x2 ah = ag0[(size_t)js * 2 * DM]; h = ah[0] * h + ah[1]; }
            carry0 = h; h = 0.f;
            js = 63;
            for (; js - 8 >= seg; js -= 8) { f32x2 ah[8];
#pragma unroll
                for (int q = 0; q < 8; ++q) ah[q] = ag1[(size_t)(js - q) * 2 * DM];
#pragma unroll
                for (int q = 0; q < 8; ++q) h = ah[q][0] * h + ah[q][1]; }
            for (; js > seg; --js) { const f32x2 ah = ag1[(size_t)js * 2 * DM]; h = ah[0] * h + ah[1]; }
            carry1 = h;
        }
#pragma unroll
        for (int d = 0; d < 2; ++d) {
            const int o_a = (d == 0) ? O_A : O_XCF;
            if (PB) {
#pragma unroll
                for (int r = 0; r < 2; ++r) { const int e = tid + NTHR * r, row = e >> 4, c16 = e & 15;
                    const f32x2 x0 = __builtin_amdgcn_cvt_pk_f32_fp8((int)ra[r].x, false), x1 = __builtin_amdgcn_cvt_pk_f32_fp8((int)ra[r].x, true);
                    const f32x2 x2 = __builtin_amdgcn_cvt_pk_f32_fp8((int)ra[r].y, false), x3 = __builtin_amdgcn_cvt_pk_f32_fp8((int)ra[r].y, true);
                    constexpr float IS = 1.f / 4096.f;
                    *(LAS f32x4*)(L + o_a + row * FST + c16 * 32) = (f32x4){1.f - x0[0] * IS, 1.f - x0[1] * IS, 1.f - x1[0] * IS, 1.f - x1[1] * IS};
                    *(LAS f32x4*)(L + o_a + row * FST + c16 * 32 + 16) = (f32x4){1.f - x2[0] * IS, 1.f - x2[1] * IS, 1.f - x3[0] * IS, 1.f - x3[1] * IS};
                    *(LAS f32x4*)(L + O_U + row * FST + c16 * 32) = (f32x4){bflo(ru[r].x), bfhi(ru[r].x), bflo(ru[r].y), bfhi(ru[r].y)};
                    *(LAS f32x4*)(L + O_U + row * FST + c16 * 32 + 16) = (f32x4){bflo(ru[r].z), bfhi(ru[r].z), bflo(ru[r].w), bfhi(ru[r].w)}; }
                if (d == 0) PB_LOAD(i, 1); else PB_LOAD(i + 1, 0);
            } else {
            f32x4 aR[4], aI[4];
#pragma unroll
            for (int mt = 0; mt < 4; ++mt) { aR[mt] = (f32x4){0.f, 0.f, 0.f, 0.f}; aI[mt] = (f32x4){0.f, 0.f, 0.f, 0.f}; }
#pragma unroll
            for (int ks = 0; ks < 4; ++ks)
#pragma unroll
                for (int mt = 0; mt < 4; ++mt) { const bf16x8 xb = *(const LAS bf16x8*)(L + O_XCB + (16 * mt + fr) * 272 + (32 * ks + 8 * fq) * 2);
                    aR[mt] = __builtin_amdgcn_mfma_f32_16x16x32_bf16(wf[d][0][ks], xb, aR[mt], 0, 0, 0);
                    aI[mt] = __builtin_amdgcn_mfma_f32_16x16x32_bf16(wf[d][1][ks], xb, aI[mt], 0, 0, 0); }
#pragma unroll
            for (int mt = 0; mt < 4; ++mt) { const int tl = 16 * mt + fr, cl = 16 * w + 4 * fq;
                const f32x4 xc = *(const LAS f32x4*)(L + O_XCF + tl * FST + cl * 4);
                f32x4 av, uv;
#pragma unroll
                for (int e = 0; e < 4; ++e) { const float r = sigmoidf_(aR[mt][e] + br4[d][e]), ig = sigmoidf_(aI[mt][e] + bi4[d][e]);
                    const float a_ = __builtin_amdgcn_exp2f(r * sp4[d][e]); av[e] = a_; uv[e] = __builtin_amdgcn_sqrtf(fmaxf(1.f - a_ * a_, 0.f)) * (ig * xc[e]); }
                *(LAS f32x4*)(L + o_a + tl * FST + cl * 4) = av; *(LAS f32x4*)(L + O_U + tl * FST + cl * 4) = uv;
                { const size_t go = (mrow0 + tl) * DM + blk * 128 + cl;
                  int xa = 0; xa = __builtin_amdgcn_cvt_pk_fp8_f32((1.f - av[0]) * 4096.f, (1.f - av[1]) * 4096.f, xa, false); xa = __builtin_amdgcn_cvt_pk_fp8_f32((1.f - av[2]) * 4096.f, (1.f - av[3]) * 4096.f, xa, true);
                  v2u xu; xu.x = pk2(uv[0], uv[1]); xu.y = pk2(uv[2], uv[3]);
                  *(unsigned*)((d ? LA1 : LA0) + go) = (unsigned)xa; *(v2u*)((d ? LU1 : LU0) + go) = xu; } }
            }
            __syncthreads();
            {
                const int c = tid & 127, sub = tid >> 7;
                LAS float* pa = (LAS float*)(L + o_a) + c; const LAS float* pu = (const LAS float*)(L + O_U) + c;
                LAS f32x2* SUBT = (LAS f32x2*)(L + O_SUB);
                float h = 0.f, A = 1.f;
#pragma unroll
                for (int s2 = 0; s2 < 16; ++s2) { const int tl = d ? (16 * sub + 15 - s2) : (16 * sub + s2); const float a = pa[tl * 132], u = pu[tl * 132]; h = a * h + u; A *= a; }
                SUBT[sub * 128 + c] = (f32x2){A, h};
                __syncthreads();
                if (!PB) {
                    if (sub == 0) { float HH = 0.f, AA = 1.f;
#pragma unroll
                        for (int q = 0; q < 4; ++q) { const f32x2 ah = SUBT[(d ? 3 - q : q) * 128 + c]; HH = ah[0] * HH + ah[1]; AA *= ah[0]; }
                        AGG[((size_t)(b * 64 + seg) * 2 + d) * DM + blk * 128 + c] = (f32x2){AA, HH}; }
                } else {
                    float hc = d ? carry1 : carry0;
#pragma unroll
                    for (int q = 0; q < 3; ++q) { const int jq = d ? 3 - q : q; const f32x2 ah = SUBT[jq * 128 + c]; if (d ? (jq > sub) : (jq < sub)) hc = ah[0] * hc + ah[1]; }
                    if (d == 0) {
#pragma unroll
                        for (int s2 = 0; s2 < 16; ++s2) { const int tl = 16 * sub + s2; hc = pa[tl * 132] * hc + pu[tl * 132]; pa[tl * 132] = hc; }
                    } else { LAS float* ph = (LAS float*)(L + O_A) + c;
#pragma unroll
                        for (int s2 = 0; s2 < 16; ++s2) { const int tl = 16 * sub + 15 - s2; hc = pa[tl * 132] * hc + pu[tl * 132]; ph[tl * 132] += hc; } }
                }
            }
            __syncthreads();
        }
        if (PB) {
#pragma unroll
            for (int r = 0; r < 2; ++r) { const int e = tid + NTHR * r, row = e >> 4, c16 = e & 15;
                const v4u g = lgreg[r];
                const f32x4 h0 = *(const LAS f32x4*)(L + O_A + row * FST + c16 * 32), h1 = *(const LAS f32x4*)(L + O_A + row * FST + c16 * 32 + 16);
                v4u o;
                o.x = pk2(h0[0] * gelu_fast(bflo(g.x)), h0[1] * gelu_fast(bfhi(g.x))); o.y = pk2(h0[2] * gelu_fast(bflo(g.y)), h0[3] * gelu_fast(bfhi(g.y)));
                o.z = pk2(h1[0] * gelu_fast(bflo(g.z)), h1[1] * gelu_fast(bfhi(g.z))); o.w = pk2(h1[2] * gelu_fast(bflo(g.w)), h1[3] * gelu_fast(bfhi(g.w)));
                *(v4u*)(YL + (mrow0 + row) * DM + blk * 128 + c16 * 8) = o; }
            __syncthreads();
        }
    }
#undef RAW_LOAD
#undef PB_LOAD
}

__device__ __forceinline__ void mconv_phase(Frame& F) {
    const bf16* XM = (const bf16*)(F.ws + WS_XM); bf16* XC = (bf16*)F.out + (size_t)MTOK * DM;
    const float* cw = F.in[4]; const float* cb = F.in[5];
    const int NT = MTOK / 32 * 128;
    for (int g = F.bid * NTHR + F.tid; g < NT; g += F.G * NTHR) {
        const int chunk = g & 127, run = g >> 7, c0 = chunk * 8, m0 = run * 32, t0 = m0 & (SEQ - 1);
        float w[4][8], bias[8];
#pragma unroll
        for (int j = 0; j < 4; ++j) { const f32x4 a = *(const f32x4*)(cw + j * DM + c0), b = *(const f32x4*)(cw + j * DM + c0 + 4);
            w[j][0] = a[0]; w[j][1] = a[1]; w[j][2] = a[2]; w[j][3] = a[3]; w[j][4] = b[0]; w[j][5] = b[1]; w[j][6] = b[2]; w[j][7] = b[3]; }
        { const f32x4 a = *(const f32x4*)(cb + c0), b = *(const f32x4*)(cb + c0 + 4);
            bias[0] = a[0]; bias[1] = a[1]; bias[2] = a[2]; bias[3] = a[3]; bias[4] = b[0]; bias[5] = b[1]; bias[6] = b[2]; bias[7] = b[3]; }
        v4u win[4];
        const v4u zero = {0u, 0u, 0u, 0u};
        win[0] = zero;
        win[1] = (t0 >= 2) ? *(const v4u*)(XM + (size_t)(m0 - 2) * DM + c0) : zero;
        win[2] = (t0 >= 1) ? *(const v4u*)(XM + (size_t)(m0 - 1) * DM + c0) : zero;
        win[3] = *(const v4u*)(XM + (size_t)m0 * DM + c0);
#pragma unroll 4
        for (int i = 0; i < 32; ++i) {
            win[0] = win[1]; win[1] = win[2]; win[2] = win[3];
            win[3] = (t0 + i + 1 < SEQ) ? *(const v4u*)(XM + (size_t)(m0 + i + 1) * DM + c0) : zero;
            float y[8];
#pragma unroll
            for (int e = 0; e < 8; ++e) y[e] = bias[e];
#pragma unroll
            for (int j = 0; j < 4; ++j) {
                const unsigned p0 = win[j].x, p1 = win[j].y, p2 = win[j].z, p3 = win[j].w;
                y[0] += w[j][0] * bflo(p0); y[1] += w[j][1] * bfhi(p0); y[2] += w[j][2] * bflo(p1); y[3] += w[j][3] * bfhi(p1);
                y[4] += w[j][4] * bflo(p2); y[5] += w[j][5] * bfhi(p2); y[6] += w[j][6] * bflo(p3); y[7] += w[j][7] * bfhi(p3);
            }
#pragma unroll
            for (int e = 0; e < 8; ++e) y[e] = y[e] * sigmoidf_(y[e]);
            v4u o; o.x = pk2(y[0], y[1]); o.y = pk2(y[2], y[3]); o.z = pk2(y[4], y[5]); o.w = pk2(y[6], y[7]);
            *(v4u*)(XC + (size_t)(m0 + i) * DM + c0) = o;
        }
    }
}

typedef short s16x4 __attribute__((ext_vector_type(4)));
__device__ __forceinline__ bf16x8 tr_read_pair(unsigned a0, unsigned a1) {
    s16x4 r0, r1;
    asm volatile("ds_read_b64_tr_b16 %0, %2\n\tds_read_b64_tr_b16 %1, %3\n\ts_waitcnt lgkmcnt(0)" : "=&v"(r0), "=&v"(r1) : "v"(a0), "v"(a1) : "memory");
    return __builtin_shufflevector(r0, r1, 0, 1, 2, 3, 4, 5, 6, 7);
}
__device__ __forceinline__ float dpp_shr(float oldv, float x, int n) {
    const int o = __builtin_bit_cast(int, oldv), v = __builtin_bit_cast(int, x);
    int r;
    if (n == 1) r = __builtin_amdgcn_update_dpp(o, v, 0x111, 0xf, 0xf, false);
    else if (n == 2) r = __builtin_amdgcn_update_dpp(o, v, 0x112, 0xf, 0xf, false);
    else if (n == 4) r = __builtin_amdgcn_update_dpp(o, v, 0x114, 0xf, 0xf, false);
    else r = __builtin_amdgcn_update_dpp(o, v, 0x118, 0xf, 0xf, false);
    return __builtin_bit_cast(float, r);
}
__device__ __forceinline__ float rdlane(float x, int l) { return __builtin_bit_cast(float, __builtin_amdgcn_readlane(__builtin_bit_cast(int, x), l)); }
__device__ __forceinline__ float wave_incl_sum(float x, int lane) {
    x += dpp_shr(0.f, x, 1); x += dpp_shr(0.f, x, 2); x += dpp_shr(0.f, x, 4); x += dpp_shr(0.f, x, 8);
    const float t0 = rdlane(x, 15), t1 = rdlane(x, 31), t2 = rdlane(x, 47);
    return x + (lane >= 16 ? t0 : 0.f) + (lane >= 32 ? t1 : 0.f) + (lane >= 48 ? t2 : 0.f);
}
__device__ __forceinline__ float wave_incl_max(float x, int lane) {
    const float NI = -INFINITY;
    x = fmaxf(x, dpp_shr(NI, x, 1)); x = fmaxf(x, dpp_shr(NI, x, 2)); x = fmaxf(x, dpp_shr(NI, x, 4)); x = fmaxf(x, dpp_shr(NI, x, 8));
    const float t0 = rdlane(x, 15), t1 = rdlane(x, 31), t2 = rdlane(x, 47);
    return fmaxf(fmaxf(x, lane >= 16 ? t0 : NI), fmaxf(lane >= 32 ? t1 : NI, lane >= 48 ? t2 : NI));
}
__device__ __forceinline__ void mscan_phase(Frame& F) {
    const bf16* Q = (const bf16*)(F.ws + WS_LG); const bf16* K = (const bf16*)(F.ws + WS_K); const bf16* V = (const bf16*)(F.ws + WS_XL);
    const float* GT = (const float*)(F.ws + WS_GATE);
    constexpr int KS = 0, CTI = 33792, VT = 67584, VWT = 86016, PB = 104448, TAB = 113664, NT = 116736, NPART = 117760, DENT = 119808;
    constexpr int KST = 528, VST = 144, TABSZ = 1536;
    LAS unsigned char* L = F.lds;
    const int tid = F.tid, lane = F.lane, w = F.wave, fr = lane & 15, fq = lane >> 4, pt = w & 3, wg = w >> 2;
    for (int item = F.bid; item < 256; item += F.G) {
        const int es = item & 3, dir = (item >> 2) & 1, h = (item >> 3) & 3, b = item >> 5;
        bf16* H = dir ? ((bf16*)F.out + (size_t)MTOK * DM) : (bf16*)(F.ws + WS_XM);
        const size_t rowbase = (size_t)b * SEQ;
#define TOF(c, p) (dir ? (SEQ - 1 - 64 * (c) - (p)) : (64 * (c) + (p)))
        for (int e = tid; e < (33792 + 1024) / 4; e += NTHR) { if (e < 33792 / 4) ((LAS unsigned*)(L + CTI))[e] = 0u; else ((LAS unsigned*)(L + NT))[e - 33792 / 4] = 0u; }
        float m_run = 0.f;
        float gi_n = 0.f, gf_n = 0.f;
        if (w == 0) { const size_t m = rowbase + TOF(0, lane); gi_n = GT[m * 16 + dir * 8 + h]; gf_n = GT[m * 16 + dir * 8 + 4 + h]; }
#define G1_TABLES(setp) do { \
            const float logf_ = fminf(gf_n, 0.f) - __logf(1.f + __expf(-fabsf(gf_n))); const float b_ = wave_incl_sum(logf_, lane); const float a_ = gi_n - b_; \
            const float M_ = fmaxf(m_run, wave_incl_max(a_, lane)); const float Mend_ = rdlane(M_, 63), g_ = rdlane(b_, 63); \
            LAS float* T_ = (LAS float*)(setp); T_[lane] = a_; T_[64 + lane] = M_; T_[128 + lane] = __expf(m_run - M_); T_[192 + lane] = __expf(-(b_ + M_)); T_[256 + lane] = __expf(a_ - Mend_); \
            if (lane == 0) { T_[320] = __expf(m_run - Mend_); T_[321] = g_ + Mend_; } \
            m_run = g_ + Mend_; } while (0)
        if (w == 0) G1_TABLES(L + TAB);
        __syncthreads();
        bf16x8 qf[8];
        v4u kreg[4]; v4u vreg;
#define LOAD_KV(c) do { _Pragma("unroll") for (int r_ = 0; r_ < 4; ++r_) { const int i_ = tid + NTHR * r_, s_ = i_ >> 5, c16_ = i_ & 31; \
                kreg[r_] = *(const v4u*)(K + (rowbase + TOF(c, s_)) * DM + h * 256 + c16_ * 8); } \
            { const int s_ = tid & 63, e8_ = tid >> 6; vreg = *(const v4u*)(V + (rowbase + TOF(c, s_)) * DM + h * 256 + es * 64 + e8_ * 8); } } while (0)
#define STORE_KV(setidx) do { _Pragma("unroll") for (int r_ = 0; r_ < 4; ++r_) { const int i_ = tid + NTHR * r_, s_ = i_ >> 5, c16_ = i_ & 31; \
                *(LAS v4u*)(L + KS + s_ * KST + c16_ * 16) = kreg[r_]; } \
            { const int s_ = tid & 63, e8_ = tid >> 6; const float ws_ = ((const LAS float*)(L + TAB + (setidx) * TABSZ))[256 + s_]; \
              LAS bf16* vt_ = (LAS bf16*)(L + VT + (setidx) * 9216); LAS bf16* vw_ = (LAS bf16*)(L + VWT + (setidx) * 9216); \
              const unsigned wv_[4] = {vreg.x, vreg.y, vreg.z, vreg.w}; \
              _Pragma("unroll") for (int j_ = 0; j_ < 4; ++j_) { const float lo_ = bflo(wv_[j_]), hi_ = bfhi(wv_[j_]); const int e_ = e8_ * 8 + 2 * j_; \
                vt_[e_ * 72 + s_] = (bf16)(wv_[j_] & 0xffffu); vt_[(e_ + 1) * 72 + s_] = (bf16)(wv_[j_] >> 16); \
                vw_[e_ * 72 + s_] = (bf16)f2bf(lo_ * ws_); vw_[(e_ + 1) * 72 + s_] = (bf16)f2bf(hi_ * ws_); } } } while (0)
#define LOAD_Q(c) do { const size_t m_ = rowbase + TOF(c, 16 * pt + fr); _Pragma("unroll") for (int ks_ = 0; ks_ < 8; ++ks_) \
                qf[ks_] = *(const bf16x8*)(Q + m_ * DM + h * 256 + 32 * ks_ + 8 * fq); } while (0)
        LOAD_KV(0); LOAD_Q(0);
        STORE_KV(0);
        f32x4 Cacc[8];
#pragma unroll
        for (int i = 0; i < 8; ++i) Cacc[i] = (f32x4){0.f, 0.f, 0.f, 0.f};
        __syncthreads();
        for (int c = 0; c < 64; ++c) {
            const int cur = c & 1, nxt = cur ^ 1;
            const bool has_next = (c + 1 < 64);
            const LAS float* T = (const LAS float*)(L + TAB + cur * TABSZ);
            if (has_next) { LOAD_KV(c + 1); if (w == 0) { const size_t m = rowbase + TOF(c + 1, lane); gi_n = GT[m * 16 + dir * 8 + h]; gf_n = GT[m * 16 + dir * 8 + 4 + h]; } }
            const int p = 16 * pt + fr;
            const float Mp = T[64 + p], wi_p = T[128 + p];
            float cs = 0.f;
#pragma unroll
            for (int i = 0; i < 2; ++i) { const int st = 2 * wg + i;
                v2u pw = {0u, 0u};
                if (st <= pt) {
                    f32x4 sa = (f32x4){0.f, 0.f, 0.f, 0.f};
#pragma unroll
                    for (int ks = 0; ks < 8; ++ks) { const bf16x8 kf = *(const LAS bf16x8*)(L + KS + (16 * st + fr) * KST + (32 * ks + 8 * fq) * 2);
                        sa = __builtin_amdgcn_mfma_f32_16x16x32_bf16(kf, qf[ks], sa, 0, 0, 0); }
                    const f32x4 a4 = *(const LAS f32x4*)(T + 16 * st + 4 * fq);
                    float pv[4];
#pragma unroll
                    for (int r = 0; r < 4; ++r) { const int s_ = 16 * st + 4 * fq + r; const float wgt = (s_ <= p) ? __expf(a4[r] - Mp) : 0.f; pv[r] = sa[r] * wgt; cs += pv[r]; }
                    pw.x = pk2(pv[0], pv[1]); pw.y = pk2(pv[2], pv[3]);
                }
                *(LAS v2u*)(L + PB + p * VST + (16 * st + 4 * fq) * 2) = pw; }
            f32x4 O[2];
#pragma unroll
            for (int i = 0; i < 2; ++i) { const int et = 2 * wg + i; O[i] = (f32x4){0.f, 0.f, 0.f, 0.f};
#pragma unroll
                for (int ks = 0; ks < 8; ++ks) { const bf16x8 cf = *(const LAS bf16x8*)(L + CTI + (16 * et + fr) * KST + (32 * ks + 8 * fq) * 2);
                    O[i] = __builtin_amdgcn_mfma_f32_16x16x32_bf16(cf, qf[ks], O[i], 0, 0, 0); } }
            float di = 0.f;
#define DEN_INTER(ks) do { const f32x4 n0 = *(const LAS f32x4*)(L + NT + (32 * (ks) + 8 * fq) * 4), n1 = *(const LAS f32x4*)(L + NT + (32 * (ks) + 8 * fq) * 4 + 16); \
                const v4u qw = __builtin_bit_cast(v4u, qf[ks]); \
                di += bflo(qw.x) * n0[0] + bfhi(qw.x) * n0[1] + bflo(qw.y) * n0[2] + bfhi(qw.y) * n0[3] + bflo(qw.z) * n1[0] + bfhi(qw.z) * n1[1] + bflo(qw.w) * n1[2] + bfhi(qw.w) * n1[3]; } while (0)
            if (wg == 0) { DEN_INTER(0); DEN_INTER(1); DEN_INTER(2); DEN_INTER(3); }
            else { DEN_INTER(4); DEN_INTER(5); DEN_INTER(6); DEN_INTER(7); }
#undef DEN_INTER
            di += __shfl_xor(di, 16); di += __shfl_xor(di, 32);
            cs += __shfl_xor(cs, 16); cs += __shfl_xor(cs, 32);
            if (fq == 0) ((LAS float*)(L + DENT))[wg * 64 + p] = wi_p * di + cs;
            if (has_next) LOAD_Q(c + 1);
            if (has_next && w == 0) G1_TABLES(L + TAB + nxt * TABSZ);
            __syncthreads();
#pragma unroll
            for (int i = 0; i < 2; ++i) { const int et = 2 * wg + i; O[i] = O[i] * wi_p;
#pragma unroll
                for (int ks = 0; ks < 2; ++ks) { const bf16x8 vf = *(const LAS bf16x8*)(L + VT + cur * 9216 + (16 * et + fr) * VST + (32 * ks + 8 * fq) * 2);
                    const bf16x8 pf = *(const LAS bf16x8*)(L + PB + p * VST + (32 * ks + 8 * fq) * 2);
                    O[i] = __builtin_amdgcn_mfma_f32_16x16x32_bf16(vf, pf, O[i], 0, 0, 0); } }
            { const float den = ((const LAS float*)(L + DENT))[p] + ((const LAS float*)(L + DENT))[64 + p];
              const float inv = 1.f / fmaxf(fabsf(den), T[192 + p]);
              const size_t m = rowbase + TOF(c, p);
#pragma unroll
              for (int i = 0; i < 2; ++i) { const int et = 2 * wg + i; v2u o; o.x = pk2(O[i][0] * inv, O[i][1] * inv); o.y = pk2(O[i][2] * inv, O[i][3] * inv);
                  *(v2u*)(H + m * DM + h * 256 + es * 64 + 16 * et + 4 * fq) = o; } }
            { const float decay = T[320];
              const bf16x8 vw0 = *(const LAS bf16x8*)(L + VWT + cur * 9216 + (16 * pt + fr) * VST + (8 * fq) * 2);
              const bf16x8 vw1 = *(const LAS bf16x8*)(L + VWT + cur * 9216 + (16 * pt + fr) * VST + (32 + 8 * fq) * 2);
              const int l16 = lane & 15, q4 = l16 >> 2, p4 = l16 & 3;
              const unsigned kb = (unsigned)(uintptr_t)(L + KS) + (unsigned)((8 * fq + q4) * KST + 4 * p4 * 2);
#pragma unroll
              for (int dtl = 0; dtl < 8; dtl += 2) { const int dt = 8 * wg + dtl; const unsigned a0 = kb + dt * 32;
                  s16x4 r0, r1, r2, r3, r4, r5, r6, r7;
                  asm volatile("ds_read_b64_tr_b16 %0, %8\n\tds_read_b64_tr_b16 %1, %8 offset:2112\n\tds_read_b64_tr_b16 %2, %8 offset:16896\n\tds_read_b64_tr_b16 %3, %8 offset:19008\n\t"
                               "ds_read_b64_tr_b16 %4, %8 offset:32\n\tds_read_b64_tr_b16 %5, %8 offset:2144\n\tds_read_b64_tr_b16 %6, %8 offset:16928\n\tds_read_b64_tr_b16 %7, %8 offset:19040\n\ts_waitcnt lgkmcnt(0)"
                               : "=&v"(r0), "=&v"(r1), "=&v"(r2), "=&v"(r3), "=&v"(r4), "=&v"(r5), "=&v"(r6), "=&v"(r7) : "v"(a0) : "memory");
                  const bf16x8 k0 = __builtin_shufflevector(r0, r1, 0, 1, 2, 3, 4, 5, 6, 7), k1 = __builtin_shufflevector(r2, r3, 0, 1, 2, 3, 4, 5, 6, 7);
                  const bf16x8 k2 = __builtin_shufflevector(r4, r5, 0, 1, 2, 3, 4, 5, 6, 7), k3 = __builtin_shufflevector(r6, r7, 0, 1, 2, 3, 4, 5, 6, 7);
                  Cacc[dtl] = Cacc[dtl] * decay; Cacc[dtl + 1] = Cacc[dtl + 1] * decay;
                  Cacc[dtl] = __builtin_amdgcn_mfma_f32_16x16x32_bf16(k0, vw0, Cacc[dtl], 0, 0, 0);
                  Cacc[dtl + 1] = __builtin_amdgcn_mfma_f32_16x16x32_bf16(k2, vw0, Cacc[dtl + 1], 0, 0, 0);
                  Cacc[dtl] = __builtin_amdgcn_mfma_f32_16x16x32_bf16(k1, vw1, Cacc[dtl], 0, 0, 0);
                  Cacc[dtl + 1] = __builtin_amdgcn_mfma_f32_16x16x32_bf16(k3, vw1, Cacc[dtl + 1], 0, 0, 0); } }
            { const int d = tid & 255, hf2 = tid >> 8; float np = 0.f;
#pragma unroll 8
              for (int s2 = 0; s2 < 32; ++s2) { const int s_ = hf2 * 32 + s2; np += T[256 + s_] * bf2f(*(const LAS bf16*)(L + KS + s_ * KST + d * 2)); }
              ((LAS float*)(L + NPART))[hf2 * 256 + d] = np; }
            __syncthreads();
            { const float decay = T[320];
#pragma unroll
              for (int dtl = 0; dtl < 8; ++dtl) { const int dt = 8 * wg + dtl; v2u o; o.x = pk2(Cacc[dtl][0], Cacc[dtl][1]); o.y = pk2(Cacc[dtl][2], Cacc[dtl][3]);
                  *(LAS v2u*)(L + CTI + (16 * pt + fr) * KST + (16 * dt + 4 * fq) * 2) = o; }
              if (tid < 256) { LAS float* nt = (LAS float*)(L + NT); const LAS float* np = (const LAS float*)(L + NPART); nt[tid] = decay * nt[tid] + np[tid] + np[256 + tid]; } }
            if (has_next) STORE_KV(nxt);
            __syncthreads();
        }
#undef TOF
#undef G1_TABLES
#undef LOAD_KV
#undef STORE_KV
#undef LOAD_Q
    }
}

__device__ __forceinline__ void ym_phase(Frame& F) {
    const bf16* HF = (const bf16*)(F.ws + WS_XM); const bf16* HB = (const bf16*)F.out + (size_t)MTOK * DM; bf16* OP = (bf16*)(F.ws + WS_OP);
    const float* ng = F.in[9];
    const int gw = F.bid * NWAVES + F.wave, NGW = F.G * NWAVES;
    for (int m = gw; m < MTOK; m += NGW) {
#pragma unroll
        for (int hd = 0; hd < 4; ++hd) {
            const size_t o = (size_t)m * DM + hd * 256 + F.lane * 4;
            const v2u a = *(const v2u*)(HF + o), b = *(const v2u*)(HB + o), op = *(const v2u*)(OP + o);
            const float v0 = bflo(a.x) + bflo(b.x), v1 = bfhi(a.x) + bfhi(b.x), v2 = bflo(a.y) + bflo(b.y), v3 = bfhi(a.y) + bfhi(b.y);
            const float r = rsqrtf(wave_sum((v0 * v0 + v1 * v1) + (v2 * v2 + v3 * v3)) * (1.f / 256.f) + EPS);
            const f32x4 g = *(const f32x4*)(ng + hd * 256 + F.lane * 4);
            v2u w; w.x = pk2(sigmoidf_(bflo(op.x)) * v0 * r * g[0], sigmoidf_(bfhi(op.x)) * v1 * r * g[1]);
            w.y = pk2(sigmoidf_(bflo(op.y)) * v2 * r * g[2], sigmoidf_(bfhi(op.y)) * v3 * r * g[3]);
            *(v2u*)(OP + o) = w;
        }
    }
    {
        float* usc = (float*)(F.ws + WS_LG + 16 * MiB); float* vsc = usc + NEXP;
        for (int row = gw; row < 2 * NEXP; row += NGW) {
            const bool isv = row >= NEXP; const int r = isv ? row - NEXP : row;
            const f32x4* src = (const f32x4*)(F.in[isv ? 24 : 23] + (size_t)r * DM) + F.lane * 4;
            f32x4 a[4]; float ss = 0.f;
#pragma unroll
            for (int j = 0; j < 4; ++j) { a[j] = src[j]; ss += (a[j][0] * a[j][0] + a[j][1] * a[j][1]) + (a[j][2] * a[j][2] + a[j][3] * a[j][3]); }
            const float rms = sqrtf(wave_sum(ss) * (1.f / DM));
            const float sc = fmaxf(rms * 0.5f, 1e-30f), inv = 1.f / sc;
            unsigned o[2] = {0u, 0u};
#pragma unroll
            for (int j = 0; j < 4; ++j) { const f32x4 q = a[j] * inv;
                if (j & 1) { o[j >> 1] = __builtin_amdgcn_cvt_scalef32_pk_fp4_f32(o[j >> 1], q[0], q[1], 1.0f, 2); o[j >> 1] = __builtin_amdgcn_cvt_scalef32_pk_fp4_f32(o[j >> 1], q[2], q[3], 1.0f, 3); }
                else       { o[j >> 1] = __builtin_amdgcn_cvt_scalef32_pk_fp4_f32(o[j >> 1], q[0], q[1], 1.0f, 0); o[j >> 1] = __builtin_amdgcn_cvt_scalef32_pk_fp4_f32(o[j >> 1], q[2], q[3], 1.0f, 1); } }
            *(v2u*)(F.ws + WS_LG + (isv ? 8 * MiB : 0) + (size_t)r * (DM / 2) + F.lane * 8) = (v2u){o[0], o[1]};
            if (F.lane == 0) (isv ? vsc : usc)[r] = sc;
        }
    }
}

typedef float f32x16 __attribute__((ext_vector_type(16)));
#define TOPK_INSERT(L, xv) do { const float x_ = (xv); \
    L[15] = __builtin_amdgcn_fmed3f(L[14], L[15], x_); L[14] = __builtin_amdgcn_fmed3f(L[13], L[14], x_); L[13] = __builtin_amdgcn_fmed3f(L[12], L[13], x_); L[12] = __builtin_amdgcn_fmed3f(L[11], L[12], x_); \
    L[11] = __builtin_amdgcn_fmed3f(L[10], L[11], x_); L[10] = __builtin_amdgcn_fmed3f(L[9], L[10], x_); L[9] = __builtin_amdgcn_fmed3f(L[8], L[9], x_); L[8] = __builtin_amdgcn_fmed3f(L[7], L[8], x_); \
    L[7] = __builtin_amdgcn_fmed3f(L[6], L[7], x_); L[6] = __builtin_amdgcn_fmed3f(L[5], L[6], x_); L[5] = __builtin_amdgcn_fmed3f(L[4], L[5], x_); L[4] = __builtin_amdgcn_fmed3f(L[3], L[4], x_); \
    L[3] = __builtin_amdgcn_fmed3f(L[2], L[3], x_); L[2] = __builtin_amdgcn_fmed3f(L[1], L[2], x_); L[1] = __builtin_amdgcn_fmed3f(L[0], L[1], x_); L[0] = fmaxf(L[0], x_); } while (0)
template <int I> struct CandRow {
    static __device__ __forceinline__ void run(const float (&L0)[16], const float (&L1)[16], float (&R)[16]) {
        constexpr int NJ = 16 / (I + 1);
#pragma unroll
        for (int j = 0; j < NJ; ++j) { const float sm = L0[I] + L1[j];
            const float pk = __builtin_bit_cast(float, (__builtin_bit_cast(unsigned, sm) & 0xffffff00u) | (unsigned)(I * 16 + j)); TOPK_INSERT(R, pk); }
        if constexpr (I < 15) CandRow<I + 1>::run(L0, L1, R);
    }
};
__device__ __forceinline__ unsigned pick4(unsigned d0, unsigned d1, unsigned d2, unsigned d3, int i) {
    const int q = i >> 2; unsigned d = d0; d = (q == 1) ? d1 : d; d = (q == 2) ? d2 : d; d = (q == 3) ? d3 : d; return (d >> (8 * (i & 3))) & 127u;
}
__device__ __forceinline__ void select_phase(Frame& F) {
    const bf16* PQ = (const bf16*)(F.ws + WS_MG); const bf16* KEYS = (const bf16*)(F.ws + WS_KEYS);
    int* IDX = (int*)(F.ws + WS_K); float* GW = (float*)(F.ws + WS_K + 16 * MiB);
    LAS unsigned char* L = F.lds;
    const int tid = F.tid, lane = F.lane, w = F.wave, l31 = lane & 31, hh = lane >> 5;
    const float NEG_INF = -INFINITY;
    for (int grp = F.bid; grp < MTOK / 128; grp += F.G) {
        const int tb = grp * 4 + (w & 3);
        const size_t m = (size_t)tb * 32 + l31;
        for (int hp = 0; hp < 4; ++hp) {
            __syncthreads();
#pragma unroll 4
            for (int r = 0; r < 16; ++r) { const int e = tid + NTHR * r, R = e >> 4, c = e & 15;
                *(LAS v4u*)(L + R * 256 + ((c ^ (R & 15)) * 16)) = *(const v4u*)(KEYS + ((size_t)(hp * 512 + R) * 128 + c * 8)); }
            __syncthreads();
            const int hl = w >> 2, h = 2 * hp + hl;
            float L0[16], L1[16];
#pragma unroll
            for (int p = 0; p < 2; ++p) {
                bf16x8 qf[8];
#pragma unroll
                for (int ks = 0; ks < 8; ++ks) qf[ks] = *(const bf16x8*)(PQ + m * 2048 + h * 256 + p * 128 + 16 * ks + 8 * hh);
                f32x16 acc[4];
#pragma unroll
                for (int kb = 0; kb < 4; ++kb)
#pragma unroll
                    for (int r = 0; r < 16; ++r) acc[kb][r] = 0.f;
#pragma unroll
                for (int ks = 0; ks < 8; ++ks)
#pragma unroll
                    for (int kb = 0; kb < 4; ++kb) { const int R = (hl * 2 + p) * 128 + 32 * kb + l31;
                        const bf16x8 kf = *(const LAS bf16x8*)(L + R * 256 + (((2 * ks + hh) ^ (lane & 15)) * 16));
                        acc[kb] = __builtin_amdgcn_mfma_f32_32x32x16_bf16(kf, qf[ks], acc[kb], 0, 0, 0); }
                float Lc[16];
#pragma unroll
                for (int i = 0; i < 16; ++i) Lc[i] = NEG_INF;
                const unsigned hh4 = (unsigned)hh << 2;
#pragma unroll
                for (int kb = 0; kb < 4; ++kb)
#pragma unroll
                    for (int r = 0; r < 16; ++r) { const unsigned nlo = (unsigned)(32 * kb + (r & 3) + 8 * (r >> 2));
                        const float av_ = acc[kb][r];
                        const float pk = __uint_as_float(((__float_as_uint(av_) & 0xffffff80u) | hh4) | nlo); TOPK_INSERT(Lc, pk); }
                float Lo[16];
#pragma unroll
                for (int i = 0; i < 16; ++i) Lo[i] = __shfl_xor(Lc[i], 32);
#pragma unroll
                for (int i = 0; i < 16; ++i) TOPK_INSERT(Lc, Lo[i]);
#pragma unroll
                for (int i = 0; i < 16; ++i) { if (p == 0) L0[i] = Lc[i]; else L1[i] = Lc[i]; }
            }
            float R[16];
#pragma unroll
            for (int i = 0; i < 16; ++i) R[i] = NEG_INF;
            CandRow<0>::run(L0, L1, R);
            unsigned a0 = 0, a1 = 0, a2 = 0, a3 = 0, b0 = 0, b1 = 0, b2 = 0, b3 = 0;
#pragma unroll
            for (int i = 0; i < 4; ++i) { a0 |= (__builtin_bit_cast(unsigned, L0[i]) & 127u) << (8 * i); a1 |= (__builtin_bit_cast(unsigned, L0[4 + i]) & 127u) << (8 * i);
                a2 |= (__builtin_bit_cast(unsigned, L0[8 + i]) & 127u) << (8 * i); a3 |= (__builtin_bit_cast(unsigned, L0[12 + i]) & 127u) << (8 * i);
                b0 |= (__builtin_bit_cast(unsigned, L1[i]) & 127u) << (8 * i); b1 |= (__builtin_bit_cast(unsigned, L1[4 + i]) & 127u) << (8 * i);
                b2 |= (__builtin_bit_cast(unsigned, L1[8 + i]) & 127u) << (8 * i); b3 |= (__builtin_bit_cast(unsigned, L1[12 + i]) & 127u) << (8 * i); }
            float ex[16]; float sum = 0.f; int id[16];
#pragma unroll
            for (int r = 0; r < 16; ++r) { ex[r] = __expf(R[r] - R[0]); sum += ex[r];
                const unsigned cid = __builtin_bit_cast(unsigned, R[r]) & 255u;
                id[r] = (int)(pick4(a0, a1, a2, a3, (int)(cid >> 4)) * 128u + pick4(b0, b1, b2, b3, (int)(cid & 15u))); }
            const float inv = 1.f / sum;
            if (hh == 0) {
#pragma unroll
                for (int q = 0; q < 4; ++q) {
                    *(int4*)(IDX + m * 128 + h * 16 + 4 * q) = make_int4(id[4 * q], id[4 * q + 1], id[4 * q + 2], id[4 * q + 3]);
                    *(f32x4*)(GW + m * 128 + h * 16 + 4 * q) = (f32x4){ex[4 * q] * inv, ex[4 * q + 1] * inv, ex[4 * q + 2] * inv, ex[4 * q + 3] * inv}; }
            }
        }
    }
}

template <int B> __device__ __forceinline__ f32x2 fp4b(unsigned w) { return __builtin_amdgcn_cvt_scalef32_pk_f32_fp4(w, 1.0f, B); }
typedef int v8i_t __attribute__((ext_vector_type(8)));
#define AP_SLOT(e) (4 * (((e) >> 1) & 3) + 2 * ((e) >> 3) + ((e) & 1))
__device__ __forceinline__ void apply_phase(Frame& F, float* OUTP) {
    const unsigned char* U8 = F.ws + WS_LG; const unsigned char* V8 = F.ws + WS_LG + 8 * MiB;
    const float* USC = (const float*)(F.ws + WS_LG + 16 * MiB); const float* VSC = USC + NEXP;
    const int* IDX = (const int*)(F.ws + WS_K); const float* GW = (const float*)(F.ws + WS_K + 16 * MiB);
    const float* g2 = F.in[20]; const float* gf = F.in[25];
    const float* X1 = F.out;
    const int lane = F.lane, fr = lane & 15, fq = lane >> 4;
    constexpr int APW = 2 * 16 * 528 + 1024;
    LAS unsigned char* UL = F.lds + F.wave * APW; LAS unsigned char* VL = UL + 16 * 528; LAS unsigned char* H8 = VL + 16 * 528;
    const int pe = 2 * fq + (fr & 1) + 8 * ((fr >> 1) & 1);
    const int bsh = 8 * (fr & 3); const unsigned mlo = fr < 4 ? ~0u : 0u, mhi = (fr >= 4 && fr < 8) ? ~0u : 0u;
#define AP_LOADROWS(SEL, KB) _Pragma("unroll") for (int e = 0; e < 16; ++e) { \
        const size_t ro = (size_t)__builtin_amdgcn_readlane(SEL, ((KB) + e) & 63) * (DM / 2) + lane * 8; uu[e] = *(const v2u*)(U8 + ro); vv[e] = *(const v2u*)(V8 + ro); }
    for (int grp = F.bid; grp < MTOK / 128; grp += F.G) {
        const int mbase = grp * 128 + F.wave;
        int ni0 = IDX[(size_t)mbase * 128 + lane], ni1 = IDX[(size_t)mbase * 128 + 64 + lane];
        float ngw0 = GW[(size_t)mbase * 128 + lane], ngw1 = GW[(size_t)mbase * 128 + 64 + lane];
        f32x4 nxr[4];
#pragma unroll
        for (int q = 0; q < 4; ++q) nxr[q] = *(const f32x4*)(X1 + (size_t)mbase * DM + lane * 16 + q * 4);
        v2u uu[16], vv[16];
        AP_LOADROWS(ni0, 0)
        int i0 = 0, i1 = 0; float gw0 = 0.f, gw1 = 0.f; f32x4 xr[4], oacc[8];
#pragma unroll
        for (int q = 0; q < 4; ++q) xr[q] = (f32x4){0.f, 0.f, 0.f, 0.f};
#pragma unroll
        for (int i = 0; i < 8; ++i) oacc[i] = (f32x4){0.f, 0.f, 0.f, 0.f};
#pragma unroll 1
        for (int it = 0; it < 128; ++it) {
            const int bt = it & 7, m = mbase + 8 * (it >> 3);
            if (bt == 0) {
                i0 = ni0; i1 = ni1; gw0 = ngw0; gw1 = ngw1; float s = 0.f;
#pragma unroll
                for (int q = 0; q < 4; ++q) { xr[q] = nxr[q]; s += (xr[q][0] * xr[q][0] + xr[q][1] * xr[q][1]) + (xr[q][2] * xr[q][2] + xr[q][3] * xr[q][3]); }
                const float r2 = rsqrtf(wave_sum(s) * (1.f / DM) + EPS);
                v4u h8;
#pragma unroll
                for (int q = 0; q < 4; ++q) { const f32x4 g = *(const f32x4*)(g2 + lane * 16 + q * 4); const f32x4 hq = xr[q] * r2 * g;
                    int pk = 0; pk = __builtin_amdgcn_cvt_pk_fp8_f32(hq[0], hq[1], pk, false); pk = __builtin_amdgcn_cvt_pk_fp8_f32(hq[2], hq[3], pk, true); h8[q] = (unsigned)pk; }
                *(LAS v4u*)(H8 + lane * 16) = h8;
#pragma unroll
                for (int i = 0; i < 8; ++i) oacc[i] = (f32x4){0.f, 0.f, 0.f, 0.f};
                const int mn = (it + 8 < 128) ? m + 8 : m;
                ni0 = IDX[(size_t)mn * 128 + lane]; ni1 = IDX[(size_t)mn * 128 + 64 + lane]; ngw0 = GW[(size_t)mn * 128 + lane]; ngw1 = GW[(size_t)mn * 128 + 64 + lane];
#pragma unroll
                for (int q = 0; q < 4; ++q) nxr[q] = *(const f32x4*)(X1 + (size_t)mn * DM + lane * 16 + q * 4);
            }
            const int k0 = bt * 16;
            const int isel = (k0 < 64) ? i0 : i1;
            const int myidx = __shfl(isel, (k0 + pe) & 63);
            const float su = USC[myidx], sv = VSC[myidx];
#pragma unroll
            for (int e = 0; e < 16; ++e) { *(LAS v2u*)(UL + AP_SLOT(e) * 528 + lane * 8) = uu[e]; *(LAS v2u*)(VL + e * 528 + lane * 8) = vv[e]; }
            { const int nk = (k0 + 16) & 127; const int nsel = (bt == 7) ? ni0 : ((nk < 64) ? i0 : i1);
              AP_LOADROWS(nsel, nk) }
            f32x4 da = (f32x4){0.f, 0.f, 0.f, 0.f}, db = (f32x4){0.f, 0.f, 0.f, 0.f};
#pragma unroll
            for (int ks = 0; ks < 8; ++ks) {
                const v4u af = *(const LAS v4u*)(UL + fr * 528 + 64 * ks + 16 * fq);
                const v4u b0 = *(const LAS v4u*)(H8 + 128 * ks + 16 * fq), b1 = *(const LAS v4u*)(H8 + 128 * ks + 64 + 16 * fq);
                const v8i_t A = {(int)af.x, (int)af.y, (int)af.z, (int)af.w, 0, 0, 0, 0};
                const v8i_t B = {(int)b0.x, (int)b0.y, (int)b0.z, (int)b0.w, (int)b1.x, (int)b1.y, (int)b1.z, (int)b1.w};
                if (ks & 1) db = __builtin_amdgcn_mfma_scale_f32_16x16x128_f8f6f4(A, B, db, 4  , 0  , 0, 0x7F7F7F7F, 0, 0x7F7F7F7F);
                else        da = __builtin_amdgcn_mfma_scale_f32_16x16x128_f8f6f4(A, B, da, 4, 0, 0, 0x7F7F7F7F, 0, 0x7F7F7F7F);
            }
            const f32x4 d4 = da + db;
            const int sel = fr & 3;
            float t = d4[0]; t = (sel == 1) ? d4[1] : t; t = (sel == 2) ? d4[2] : t; t = (sel == 3) ? d4[3] : t;
            const float gk = __shfl((k0 < 64) ? gw0 : gw1, (k0 + pe) & 63);
            const float wl = gk * gelu_fast(t * su) * sv;
            float wm = fabsf(wl); wm = fmaxf(wm, __shfl_xor(wm, 1)); wm = fmaxf(wm, __shfl_xor(wm, 2)); wm = fmaxf(wm, __shfl_xor(wm, 16)); wm = fmaxf(wm, __shfl_xor(wm, 32));
            int E = (int)(__float_as_uint(wm) >> 23); E = E < 8 ? 8 : E;
            const float wq = wl * __uint_as_float((unsigned)(261 - E) << 23);
            const int scb = (E - 7) * 0x01010101;
            v8i_t Bw;
#define AP_WQ(tq, ctrl) { const float wt = __builtin_bit_cast(float, __builtin_amdgcn_update_dpp(0, __builtin_bit_cast(int, wq), ctrl, 0xf, 0xf, false)); \
                const unsigned p8 = (unsigned)__builtin_amdgcn_cvt_pk_fp8_f32(wt, 0.f, 0, false) << bsh; Bw[2 * tq] = (int)(p8 & mlo); Bw[2 * tq + 1] = (int)(p8 & mhi); }
            AP_WQ(0, 0x00) AP_WQ(1, 0x55) AP_WQ(2, 0xAA) AP_WQ(3, 0xFF)
#pragma unroll
            for (int c = 0; c < 8; ++c) {
                v4u av;
                av.x = *(const LAS unsigned*)(VL + (4 * fq + 0) * 528 + 64 * c + 4 * fr); av.y = *(const LAS unsigned*)(VL + (4 * fq + 1) * 528 + 64 * c + 4 * fr);
                av.z = *(const LAS unsigned*)(VL + (4 * fq + 2) * 528 + 64 * c + 4 * fr); av.w = *(const LAS unsigned*)(VL + (4 * fq + 3) * 528 + 64 * c + 4 * fr);
                const v8i_t A = {(int)av.x, (int)av.y, (int)av.z, (int)av.w, 0, 0, 0, 0};
                oacc[c] = __builtin_amdgcn_mfma_scale_f32_16x16x128_f8f6f4(A, Bw, oacc[c], 4, 0, 0, 0x7F7F7F7F, 0, scb);
            }
            if (bt == 7) {
                if (fr < 8) {
#pragma unroll
                    for (int c = 0; c < 8; ++c)
#pragma unroll
                        for (int r = 0; r < 4; ++r) { const float o = oacc[c][r]; *(LAS unsigned*)(UL + 4 * ((4 * c + fq) * 40 + 8 * r + fr)) = __float_as_uint(o); }
                }
                float s2 = 0.f; f32x4 ov[4];
#pragma unroll
                for (int q = 0; q < 4; ++q) { const v4u ou = *(const LAS v4u*)(UL + 4 * ((lane >> 1) * 40 + (lane & 1) * 16 + 4 * q));
                    ov[q] = (f32x4){__uint_as_float(ou.x), __uint_as_float(ou.y), __uint_as_float(ou.z), __uint_as_float(ou.w)} + xr[q];
                    s2 += (ov[q][0] * ov[q][0] + ov[q][1] * ov[q][1]) + (ov[q][2] * ov[q][2] + ov[q][3] * ov[q][3]); }
                const float rf = rsqrtf(wave_sum(s2) * (1.f / DM) + EPS);
#pragma unroll
                for (int q = 0; q < 4; ++q) { const f32x4 g = *(const f32x4*)(gf + lane * 16 + q * 4);
                    *(f32x4*)(OUTP + (size_t)m * DM + lane * 16 + q * 4) = ov[q] * rf * g; }
            }
        }
    }
}

constexpr int N_PHASES = 13;
__global__ void __launch_bounds__(NTHR, 2) mega_fwd(Args args) {
    extern __shared__ __attribute__((aligned(16))) unsigned char lds[];
    Frame F;
    F.lds = (LAS unsigned char*)lds;
    F.tid = threadIdx.x; F.lane = F.tid & 63; F.wave = __builtin_amdgcn_readfirstlane(F.tid >> 6);
    F.G = gridDim.x; F.bid = blockIdx.x;
    F.in = args.in; F.out = args.out; F.ws = args.ws;
    volatile LAS unsigned* MISC = (volatile LAS unsigned*)(F.lds + MISC_OFF);
    for (int u = F.tid; u < (LDS_BYTES - LDSCTL_OFF) / 4; u += NTHR) ((LAS unsigned*)(F.lds + LDSCTL_OFF))[u] = 0u;
    __syncthreads();
    XcdBarrier bar; bar.bar = (unsigned*)(args.ws + WS_CTL) + CW_BAR; bar.x = 0; bar.st = nullptr;
    const bool one_launch = (args.ph_hi - args.ph_lo) > 1;
    if (one_launch) bar = xcd_barrier_post((unsigned*)(args.ws + WS_CTL) + CW_BAR, MISC + 8);
    const int lo = args.ph_lo, hi = args.ph_hi;
#define IN(k) (lo <= (k) && (k) < hi)
#define SEAM(k) do { if (IN(k) && IN((k) + 1)) xcd_barrier(bar); } while (0)
    unsigned char* ws = args.ws;

#ifndef PROBE_MASK
#define PROBE_MASK 0
#endif
#define REP(k) _Pragma("unroll") for (int rep_ = 0; rep_ < (((PROBE_MASK >> (k)) & 1) ? 2 : 1); ++rep_)
    if (IN(0)) REP(0) { p0_prologue(F); if (rep_ == 0 && ((PROBE_MASK >> 0) & 1)) xcd_barrier(bar); } SEAM(0);
    if (IN(1)) REP(1) {
        gates_phase(F);
        pg8::StaticOrder S; S.init(MTOK, 3072, F.G, F.bid, 4);
        { AddrP1 g{(const char*)(ws + WS_K), (const char*)(ws + WS_WIN), 1024, 1024, 1024, 0, 4};
          EpiBf16<DstP1> E{DstP1{ws, 0, 4}, 1.f};
          pg8::gemm_phase(F.lds, g, S, E); }
        { AddrP1 g{(const char*)F.out, (const char*)(ws + WS_WIN8), 512, 512, 512, 4, 12};
          EpiBf16<DstP1, true> E{DstP1{ws, 4, 12}, 1.f / 1024.f};
          pg8::gemm_phase<EpiBf16<DstP1, true>, AddrP1, 1>(F.lds, g, S, E); }
    } SEAM(1);
    if (IN(2)) REP(2) { lru_phase<false>(F); } SEAM(2);
    if (IN(3)) REP(3) { lru_phase<true>(F); } SEAM(3);
    if (IN(4)) REP(4) { mconv_phase(F); } SEAM(4);
    if (IN(5)) REP(5) {
        const char* xc = (const char*)F.out + (size_t)MTOK * DM * 2;
        AddrQKV g{xc, (long)((const char*)(ws + WS_XM) - xc), (const char*)(ws + WS_WQKV), 1024, 256, 256};
        pg8::StaticOrder S; S.init(MTOK, 12 * 256, F.G, F.bid);
        EpiBf16<DstQKV> E{DstQKV{(char*)(ws + WS_LG), (long)WS_K - (long)WS_LG, (long)WS_XL - (long)WS_LG}, 1.f};
        pg8::gemm_phase(F.lds, g, S, E);
    } SEAM(5);
    if (IN(6)) REP(6) { mscan_phase(F); } SEAM(6);
    if (IN(7)) { ym_phase(F); } SEAM(7);
    if (IN(8)) {
        pg8::StaticOrder S; S.init(MTOK, 1024, F.G, F.bid);
        { AddrPlain g{(const char*)(ws + WS_OP), (const char*)(ws + WS_WB2), 1024, 1024, 1024};
          EpiMerge<false> E{(bf16*)(ws + WS_XM), (const bf16*)(ws + WS_MG), 0}; pg8::gemm_phase(F.lds, g, S, E); }
        { AddrPlain g{(const char*)F.out, (const char*)(ws + WS_WB2) + (size_t)1024 * 1024 * 2, 1024, 1024, 1024};
          EpiMerge<true> E{(bf16*)(ws + WS_XM), (const bf16*)(ws + WS_MG), 1024}; pg8::gemm_phase(F.lds, g, S, E); }
    } SEAM(8);
    if (IN(9)) {
        AddrPlain g{(const char*)(ws + WS_XM), (const char*)(ws + WS_WOUT2), 1024, 2048, 1024};
        pg8::StaticOrder S; S.init(MTOK, 1024, F.G, F.bid);
        EpiResid E{F.in[0], F.out, (bf16*)(ws + WS_XL), (float*)(ws + WS_SS)};
        pg8::gemm_phase(F.lds, g, S, E);
    } SEAM(9);
    if (IN(10)) REP(10) {
        AddrPlain g{(const char*)(ws + WS_XL), (const char*)(ws + WS_WPQ), 1024, 1024, 1024};
        pg8::StaticOrder S; S.init(MTOK, 2048, F.G, F.bid, 4);
        EpiPQ E{(bf16*)(ws + WS_MG), (const float*)(ws + WS_SS)};
        pg8::gemm_phase(F.lds, g, S, E);
    } SEAM(10);
    if (IN(11)) REP(11) { select_phase(F); }
    if (IN(11) && IN(12)) { asm volatile("s_waitcnt vmcnt(0)" ::: "memory"); __syncthreads(); }
    if (IN(12)) { if ((PROBE_MASK >> 12) & 1) { apply_phase(F, (float*)(ws + WS_MG)); xcd_barrier(bar); } apply_phase(F, F.out); }
#undef REP
#undef IN
#undef SEAM
}

extern "C" void kernel_launch(void* const* d_in, const int* in_sizes, int n_in, void* d_out, int out_size, void* d_ws, size_t ws_size, hipStream_t stream) {
    static int grid = 0;
    if (grid == 0) {
        if (n_in != 26 || in_sizes[0] != MTOK * DM || out_size != MTOK * DM || ws_size < WS_END) { fprintf(stderr, "kernel_launch: unexpected shapes / workspace (%zu < %zu)\n", ws_size, (size_t)WS_END); grid = -1; return; }
        int dev = 0, cus = 0, per_cu = 0;
        if (hipGetDevice(&dev) != hipSuccess || hipDeviceGetAttribute(&cus, hipDeviceAttributeMultiprocessorCount, dev) != hipSuccess) { grid = -1; return; }
        if (hipFuncSetAttribute((const void*)mega_fwd, hipFuncAttributeMaxDynamicSharedMemorySize, LDS_BYTES) != hipSuccess) { fprintf(stderr, "kernel_launch: hipFuncSetAttribute failed\n"); grid = -1; return; }
        if (hipOccupancyMaxActiveBlocksPerMultiprocessor(&per_cu, (const void*)mega_fwd, NTHR, LDS_BYTES) != hipSuccess || per_cu < 1) { fprintf(stderr, "kernel_launch: occupancy query says %d blocks/CU\n", per_cu); (void)hipGetLastError(); grid = -1; return; }
        grid = cus;
    }
    if (grid < 0) return;
    (void)hipMemsetAsync((char*)d_ws + WS_CTL + (size_t)CW_BAR * 4, 0, (size_t)XCD_BAR_WORDS * 4, stream);
    Args a{};
    for (int i = 0; i < 26; ++i) a.in[i] = (const float*)d_in[i];
    a.out = (float*)d_out; a.ws = (unsigned char*)d_ws;
#if MK_N_LAUNCHES == 1
    a.ph_lo = 0; a.ph_hi = N_PHASES;
    void* kargs[] = {&a};
    hipError_t e = hipLaunchCooperativeKernel((const void*)mega_fwd, dim3(grid), dim3(NTHR), kargs, LDS_BYTES, stream);
    if (e != hipSuccess) fprintf(stderr, "kernel_launch: cooperative launch failed: %s (grid %d)\n", hipGetErrorString(e), grid);
#else
    for (int p = 0; p < N_PHASES; ++p) { a.ph_lo = p; a.ph_hi = p + 1; hipLaunchKernelGGL(mega_fwd, dim3(grid), dim3(NTHR), LDS_BYTES, stream, a); }
#endif
}
```

```cpp
#include <hip/hip_runtime.h>
#include <cstdio>
#include <cstdint>
#include <math.h>

#ifndef MK_N_LAUNCHES
#define MK_N_LAUNCHES 1
#endif

constexpr int BATCH = 8, SEQ = 4096, DM = 1024, MTOK = BATCH * SEQ;
constexpr int DIN = 6160;
constexpr int NEXP = 16384;
constexpr float EPS = 1e-6f;

constexpr size_t MiB = 1u << 20;
constexpr size_t WS_CTL = 0, CTL_ZERO_BYTES = 1 * MiB;
constexpr size_t WS_WIN = 1 * MiB;
constexpr size_t WS_WQKV = 13 * MiB;
constexpr size_t WS_KEYS = 14 * MiB + 512 * 1024;
constexpr size_t WS_WLRU = 15 * MiB;
constexpr size_t WS_WB2 = 16 * MiB;
constexpr size_t WS_WOUT2 = 20 * MiB;
constexpr size_t WS_WPQ = 24 * MiB;
constexpr size_t WS_GATE = 28 * MiB;
constexpr size_t WS_WGT = 30 * MiB;
constexpr size_t WS_XM = 32 * MiB;
constexpr size_t WS_OP = 96 * MiB;
constexpr size_t WS_XL = 160 * MiB;
constexpr size_t WS_LG = 224 * MiB;
constexpr size_t WS_MG = 288 * MiB;
constexpr size_t WS_K = 416 * MiB;
constexpr size_t WS_AGG = 480 * MiB;
constexpr size_t WS_SS = 488 * MiB;
constexpr size_t WS_WIN8 = 489 * MiB;
constexpr size_t WS_END = 495 * MiB;

constexpr int CW_BAR = 4096;

constexpr int RING_BYTES = 131072;
constexpr int LDS_BYTES = 147456;
constexpr int LDSCTL_OFF = LDS_BYTES - 512, MISC_OFF = LDSCTL_OFF + 320;
constexpr int NWAVES = 8, NTHR = 512;

#define GAS __attribute__((address_space(1)))
#define LAS __attribute__((address_space(3)))
typedef unsigned short bf16;
typedef unsigned v4u __attribute__((ext_vector_type(4)));
typedef unsigned v2u __attribute__((ext_vector_type(2)));
typedef float f32x4 __attribute__((ext_vector_type(4)));
typedef float f32x2 __attribute__((ext_vector_type(2)));
typedef short bf16x8 __attribute__((ext_vector_type(8)));
typedef GAS unsigned gu32;
#define RLX_AGENT __ATOMIC_RELAXED, __HIP_MEMORY_SCOPE_AGENT
#define LDS_WAIT() asm volatile("s_waitcnt lgkmcnt(0)" ::: "memory")
#define VM_WAIT() asm volatile("s_waitcnt vmcnt(0)" ::: "memory")

__device__ __forceinline__ unsigned f2bf(float f) { unsigned u = __builtin_bit_cast(unsigned, f); return (u + 0x7fffu + ((u >> 16) & 1u)) >> 16; }
__device__ __forceinline__ unsigned pk2(float lo, float hi) { return f2bf(lo) | (f2bf(hi) << 16); }
__device__ __forceinline__ float bf2f(unsigned short h) { return __builtin_bit_cast(float, (unsigned)h << 16); }
__device__ __forceinline__ float bflo(unsigned w) { return __builtin_bit_cast(float, w << 16); }
__device__ __forceinline__ float bfhi(unsigned w) { return __builtin_bit_cast(float, w & 0xffff0000u); }
__device__ __forceinline__ float wave_sum(float v) {
#pragma unroll
  for (int o = 1; o < 64; o <<= 1) v += __shfl_xor(v, o);
  return v;
}
__device__ __forceinline__ float sigmoidf_(float x) { return __builtin_amdgcn_rcpf(1.f + __builtin_amdgcn_exp2f(x * -1.44269504089f)); }
__device__ __forceinline__ float gelu_erf(float x) { return 0.5f * x * (1.f + erff(x * 0.70710678118654752f)); }
__device__ __forceinline__ float gelu_fast(float v) {
    const float av = fabsf(v), t = __builtin_amdgcn_rcpf(av * 0.2316418882f + 1.0f);
    float q = t * 0.5307027145f + (-0.7265760135f); q = q * t + 0.7107068705f; q = q * t + (-0.142248368f); q = q * t + 0.127414796f; q = q * t;
    const float e = __builtin_amdgcn_exp2f((v * v) * (-0.72134752044f));
    const float m = v * (q * e);
    return v < 0.f ? m : v - m;
}
__device__ __forceinline__ float softplusf_(float x) { return fmaxf(x, 0.f) + log1pf(expf(-fabsf(x))); }

namespace pg8 {
#define PG8_LAS __attribute__((address_space(3)))
typedef unsigned short bf16_t;
typedef unsigned u32x4 __attribute__((ext_vector_type(4)));
typedef int i32x4_t __attribute__((ext_vector_type(4)));
constexpr int BM = 256, BK = 64, HALF = 128, HTB = HALF * BK * 2, STAGE_BYTES = 8 * HTB, NXCD = 8;

__host__ __device__ __forceinline__ int lds_byte(int r, int c) { const int st = (r >> 4) * 2 + (c >> 5), rr = r & 15, cc = c & 31, ob = rr * 64 + cc * 2; return st * 1024 + (ob ^ (((ob >> 9) & 1) << 5)); }
__host__ __device__ __forceinline__ void stage_rc(int b, int& R, int& C) { const int st = b / 1024, sb = b % 1024, swz = sb ^ (((sb >> 9) & 1) << 5); R = (st >> 1) * 16 + swz / 64; C = (st & 1) * 32 + (swz % 64) / 2; }
__host__ __device__ __forceinline__ int perm32(int rho) { const int n = rho >> 4, i = rho & 15; return 8 * (i >> 2) + 4 * n + (i & 3); }

struct Unit { int pm, pn; };
struct StaticOrder {
    int nM, nN, nwg, G, c, WGM;
    __host__ __device__ void init(int M, int N, int G_, int c_, int wgm = 8) { nM = M / BM; nN = N / BM; nwg = nM * nN; G = G_; c = c_; WGM = wgm; }
    __host__ __device__ bool next(int i, Unit& u) const {
        const long L = (long)i * G + c; if (L >= nwg) return false;
        int wgid = (int)L; { const int q = nwg / NXCD, r = nwg % NXCD, xcd = wgid % NXCD, off = wgid / NXCD; wgid = (xcd < r ? xcd * (q + 1) : r * (q + 1) + (xcd - r) * q) + off; }
        const int nig = WGM * nN, gid = wgid / nig, fm = gid * WGM, gsz = (nM - fm) < WGM ? (nM - fm) : WGM;
        u.pm = fm + ((wgid % nig) % gsz); u.pn = (wgid % nig) / gsz; return true;
    }
};

__device__ __forceinline__ unsigned cvt_pk_bf16(float lo, float hi) { unsigned r; asm volatile("v_cvt_pk_bf16_f32 %0, %1, %2" : "=v"(r) : "v"(lo), "v"(hi)); return r; }

template <class Epi, class Addr, int F8SC = 0>
__device__ __forceinline__ void gemm_phase(PG8_LAS unsigned char* lds, const Addr g, const StaticOrder& S, const Epi& E) {
    const int tid = threadIdx.x, wid = __builtin_amdgcn_readfirstlane(tid >> 6), lane = tid & 63, wr = wid >> 2, wc = wid & 3, fr = lane & 15, fq = lane >> 4;
    const int K = g.K, nt = K / BK;
    unsigned voffA[2], voffB[2];
#pragma unroll
    for (int i = 0; i < 2; ++i) { int R, C; stage_rc(tid * 16 + i * 8192, R, C); const int Rb = Epi::PERM ? ((R & ~31) + perm32(R & 31)) : R;
        voffA[i] = (unsigned)(R * g.lda + C) * 2u; voffB[i] = (unsigned)(Rb * g.ldb + C) * 2u; }
    const size_t kstep = (size_t)(BK * 2);
    const size_t hsA = (size_t)HALF * g.lda * 2, hsB = (size_t)HALF * g.ldb * 2;
    const unsigned ldsw = (unsigned)wid * 1024u;
    const int aoff = lds_byte(wr * 64 + fr, fq * 8), boff = lds_byte(wc * 32 + fr, fq * 8);
#define PG8_SA(b, h) (((b) * 2 + (h)) * HTB)
#define PG8_SB(b, h) ((4 + (b) * 2 + (h)) * HTB)
#define PG8_STAGE(bufoff, gbase, voff) do { _Pragma("unroll") for (int _i = 0; _i < 2; ++_i) \
        __builtin_amdgcn_global_load_lds((const unsigned*)((const char*)(gbase) + (voff)[_i]), (PG8_LAS unsigned*)(lds + (bufoff) + ldsw + _i * 8192), 16, 0, 0); } while (0)
#define PG8_LDA(dst, b, h) do { _Pragma("unroll") for (int m = 0; m < 4; ++m) _Pragma("unroll") for (int k = 0; k < 2; ++k) dst[m][k] = *(const PG8_LAS bf16x8*)(lds + PG8_SA(b, h) + aoff + m * 2048 + k * 1024); } while (0)
#define PG8_LDB(dst, b, h) do { _Pragma("unroll") for (int n = 0; n < 2; ++n) _Pragma("unroll") for (int k = 0; k < 2; ++k) dst[n][k] = *(const PG8_LAS bf16x8*)(lds + PG8_SB(b, h) + boff + n * 2048 + k * 1024); } while (0)
#define PG8_CAT(x0, x1) __builtin_shufflevector(__builtin_bit_cast(i32x4_t, x0), __builtin_bit_cast(i32x4_t, x1), 0, 1, 2, 3, 4, 5, 6, 7)
#define PG8_MMA(ai, bj, At, Bt) do { __builtin_amdgcn_s_setprio(1); \
        if constexpr (F8SC != 0) { _Pragma("unroll") for (int m = 0; m < 4; ++m) _Pragma("unroll") for (int n = 0; n < 2; ++n) \
            asm volatile("v_mfma_f32_16x16x128_f8f6f4 %0, %1, %2, %0" : "+v"(acc[ai][bj][m][n]) : "v"(PG8_CAT(Bt[n][0], Bt[n][1])), "v"(PG8_CAT(At[m][0], At[m][1]))); } \
        else { _Pragma("unroll") for (int m = 0; m < 4; ++m) _Pragma("unroll") for (int n = 0; n < 2; ++n) _Pragma("unroll") for (int k = 0; k < 2; ++k) \
            acc[ai][bj][m][n] = __builtin_amdgcn_mfma_f32_16x16x32_bf16(Bt[n][k], At[m][k], acc[ai][bj][m][n], 0, 0, 0); } \
        __builtin_amdgcn_s_setprio(0); } while (0)
#define PG8_WAIT_V(n) asm volatile("s_waitcnt vmcnt(" #n ")" ::: "memory")
#define PG8_WAIT_L(n) asm volatile("s_waitcnt lgkmcnt(" #n ")" ::: "memory")
#define PG8_BAR __builtin_amdgcn_s_barrier()
#define PG8_SCHED __builtin_amdgcn_sched_barrier(0)
    Unit cur, nxt; int ui = 0;
    if (!S.next(0, cur)) return;
    f32x4 acc[2][2][4][2];
#pragma unroll
    for (int a = 0; a < 2; ++a)
#pragma unroll
        for (int b = 0; b < 2; ++b)
#pragma unroll
            for (int m = 0; m < 4; ++m)
#pragma unroll
                for (int n = 0; n < 2; ++n) acc[a][b][m][n] = (f32x4){0.f, 0.f, 0.f, 0.f};
    bf16x8 At[4][2], B0[2][2], B1[2][2];
    const char* cA = g.a(cur); const char* cB = g.b(cur);
    PG8_STAGE(PG8_SB(0, 0), cB, voffB); PG8_STAGE(PG8_SB(0, 1), cB + hsB, voffB); PG8_STAGE(PG8_SA(0, 0), cA, voffA); PG8_STAGE(PG8_SA(0, 1), cA + hsA, voffA);
    if (wr == 1) PG8_BAR;
    PG8_WAIT_V(2); PG8_BAR;
    PG8_STAGE(PG8_SB(1, 0), cB + kstep, voffB); PG8_STAGE(PG8_SA(1, 0), cA + kstep, voffA); PG8_STAGE(PG8_SB(1, 1), cB + hsB + kstep, voffB);
    PG8_WAIT_V(6); PG8_BAR;
    for (;;) {
        const bool has_next = S.next(ui + 1, nxt);
        const char* nA = has_next ? g.a(nxt) : cA; const char* nB = has_next ? g.b(nxt) : cB;
#pragma unroll 1
        for (int t = 0; t < nt; t += 2) {
            const bool last = (t == nt - 2);
            const char* a1 = cA + (size_t)(t + 1) * kstep;
            const char* a2 = last ? nA : cA + (size_t)(t + 2) * kstep; const char* b2 = last ? nB : cB + (size_t)(t + 2) * kstep;
            const char* a3 = a2 + kstep; const char* b3 = b2 + kstep;
            PG8_LDB(B0, 0, 0); PG8_LDB(B1, 0, 1); PG8_SCHED; PG8_LDA(At, 0, 0); PG8_STAGE(PG8_SA(1, 1), a1 + hsA, voffA);
            PG8_WAIT_V(8); PG8_WAIT_L(0); PG8_BAR; PG8_MMA(0, 0, At, B0); PG8_MMA(0, 1, At, B1); PG8_BAR; PG8_SCHED;
            PG8_LDA(At, 0, 1); PG8_STAGE(PG8_SB(0, 0), b2, voffB); PG8_STAGE(PG8_SB(0, 1), b2 + hsB, voffB); PG8_STAGE(PG8_SA(0, 0), a2, voffA);
            PG8_WAIT_V(8); PG8_WAIT_L(0); PG8_BAR; PG8_MMA(1, 0, At, B0); PG8_MMA(1, 1, At, B1); PG8_BAR; PG8_SCHED;
            PG8_LDB(B0, 1, 0); PG8_LDB(B1, 1, 1); PG8_SCHED; PG8_LDA(At, 1, 0); PG8_STAGE(PG8_SA(0, 1), a2 + hsA, voffA);
            PG8_WAIT_V(8); PG8_WAIT_L(0); PG8_BAR; PG8_MMA(0, 0, At, B0); PG8_MMA(0, 1, At, B1); PG8_BAR; PG8_SCHED;
            PG8_LDA(At, 1, 1); PG8_STAGE(PG8_SB(1, 0), b3, voffB); PG8_STAGE(PG8_SB(1, 1), b3 + hsB, voffB); PG8_STAGE(PG8_SA(1, 0), a3, voffA);
            PG8_WAIT_V(8); PG8_WAIT_L(0); PG8_BAR; PG8_MMA(1, 0, At, B0); PG8_MMA(1, 1, At, B1); PG8_BAR; PG8_SCHED;
        }
        if constexpr (F8SC != 0) asm volatile("s_nop 15\n\ts_nop 15" ::: "memory");
        if (wr == 0) PG8_BAR;
        E(acc, cur, wr, wc, fr, fq);
        if (!has_next) break;
#pragma unroll
        for (int a = 0; a < 2; ++a)
#pragma unroll
            for (int b = 0; b < 2; ++b)
#pragma unroll
                for (int m = 0; m < 4; ++m)
#pragma unroll
                    for (int n = 0; n < 2; ++n) acc[a][b][m][n] = (f32x4){0.f, 0.f, 0.f, 0.f};
        cur = nxt; cA = nA; cB = nB; ++ui;
        if (wr == 1) PG8_BAR;
    }
    PG8_WAIT_V(0);
    PG8_BAR;
#undef PG8_SA
#undef PG8_SB
#undef PG8_STAGE
#undef PG8_LDA
#undef PG8_LDB
#undef PG8_MMA
#undef PG8_CAT
#undef PG8_WAIT_V
#undef PG8_WAIT_L
#undef PG8_BAR
#undef PG8_SCHED
}
}

#define XB_TMO      128
#define XB_XCNT(j)  (256  + 64 * (j))
#define XB_XSUB(j)  (1280 + 64 * (j))
#define XB_XGEN(j)  (2304 + 64 * (j))
#define XB_TOP      3328
#define XB_TOPGEN   3392
#define XCD_BAR_WORDS 3456
#define XB_SPIN_CAP (1u << 18)
__device__ __forceinline__ unsigned xb_ld(unsigned* p)              { return __hip_atomic_load(p, __ATOMIC_RELAXED, __HIP_MEMORY_SCOPE_AGENT); }
__device__ __forceinline__ unsigned xb_add(unsigned* p, unsigned v) { return __hip_atomic_fetch_add(p, v, __ATOMIC_RELAXED, __HIP_MEMORY_SCOPE_AGENT); }
__device__ __forceinline__ unsigned xb_xcc_id() { return (unsigned)__builtin_amdgcn_s_getreg((3 << 11) | 20) & 0xFu; }
#define XB_SPIN(cond, bar) do { unsigned _sp = 0; while (cond) { __builtin_amdgcn_s_sleep(1); \
    if ((++_sp & 255u) == 0u) { if (xb_ld(&(bar)[XB_TMO])) break; if (_sp > XB_SPIN_CAP) { atomicAdd(&(bar)[XB_TMO], 1u); break; } } } } while (0)
struct XcdBarrier { unsigned* bar; unsigned x; volatile LAS unsigned* st; };
__device__ __forceinline__ XcdBarrier xcd_barrier_post(unsigned* bar, volatile LAS unsigned* st) {
    XcdBarrier b; b.bar = bar; b.x = xb_xcc_id(); b.st = st;
    if (threadIdx.x == 0) (void)xb_add(&bar[XB_XCNT(b.x)], 1u);
    return b;
}
__device__ __forceinline__ void xcd_barrier_complete(unsigned* bar, unsigned x, unsigned& nloc, unsigned& nx) {
    const unsigned G = gridDim.x * gridDim.y * gridDim.z;
    unsigned sum, cnt, mine, sp = 0u;
    for (;;) {
        sum = 0u; cnt = 0u; mine = 0u;
#pragma unroll
        for (unsigned j = 0; j < 16; ++j) { const unsigned c = xb_ld(&bar[XB_XCNT(j)]); sum += c; cnt += (c > 0u) ? 1u : 0u; mine = (j == x) ? c : mine; }
        if (sum == G) break;
        __builtin_amdgcn_s_sleep(1);
        if ((++sp & 255u) == 0u) { if (xb_ld(&bar[XB_TMO])) break; if (sp > XB_SPIN_CAP) { atomicAdd(&bar[XB_TMO], 1u); break; } }
    }
    nloc = mine > 0u ? mine : 1u; nx = cnt > 0u ? cnt : 1u;
}
__device__ __forceinline__ void xcd_barrier(const XcdBarrier& b) {
    asm volatile("s_waitcnt vmcnt(0)" ::: "memory");
    __syncthreads();
    if (threadIdx.x == 0) {
        unsigned* bar = b.bar;
        __builtin_amdgcn_s_waitcnt(0);
        unsigned nloc = b.st[0], nx = b.st[1];
        if (nloc == 0u) { xcd_barrier_complete(bar, b.x, nloc, nx); b.st[0] = nloc; b.st[1] = nx; }
        const unsigned old = xb_add(&bar[XB_XSUB(b.x)], 1u);
        const unsigned gen = old / nloc;
        if (old + 1u == (gen + 1u) * nloc) {
            __builtin_amdgcn_fence(__ATOMIC_RELEASE, "agent");
            asm volatile("s_waitcnt vmcnt(0)" ::: "memory");
            const unsigned og = xb_add(&bar[XB_TOP], 1u);
            const unsigned tg = og / nx;
            if (og + 1u == (tg + 1u) * nx) xb_add(&bar[XB_TOPGEN], 1u);
            else XB_SPIN(xb_ld(&bar[XB_TOPGEN]) == tg, bar);
            __builtin_amdgcn_fence(__ATOMIC_ACQUIRE, "agent");
            xb_add(&bar[XB_XGEN(b.x)], 1u);
            asm volatile("s_waitcnt vmcnt(0)" ::: "memory");
        } else {
            XB_SPIN(xb_ld(&bar[XB_XGEN(b.x)]) == gen, bar);
            __builtin_amdgcn_fence(__ATOMIC_ACQUIRE, "agent");
            asm volatile("s_waitcnt vmcnt(0)" ::: "memory");
        }
    }
    __syncthreads();
}

struct Args { const float* in[26]; float* out; unsigned char* ws; int ph_lo, ph_hi; };
struct Frame {
    LAS unsigned char* lds;
    int tid, lane, wave, G, bid;
    const float* const* in; float* out; unsigned char* ws;
};

template <bool F8 = false> __device__ __forceinline__ void tr_item(const float* W, int ldw, bf16* WT, int ldt, float scale, const float* kscale, LAS float* scr, int k0, int lane) {
#pragma unroll 8
    for (int i = 0; i < 32; ++i) { const int kk = 2 * i + (lane >> 5); float v = W[(size_t)(k0 + kk) * ldw + (lane & 31)] * scale; if (kscale) v *= kscale[k0 + kk]; scr[kk * 33 + (lane & 31)] = v; }
    LDS_WAIT(); asm volatile("" ::: "memory");
    const int c = lane & 7;
#pragma unroll
    for (int j = 0; j < 4; ++j) { const int n = (lane >> 3) + 8 * j; const LAS float* s = scr + (8 * c) * 33 + n;
        if constexpr (F8) {
            int p0 = 0, p1 = 0; p0 = __builtin_amdgcn_cvt_pk_fp8_f32(s[0 * 33], s[1 * 33], p0, false); p0 = __builtin_amdgcn_cvt_pk_fp8_f32(s[2 * 33], s[3 * 33], p0, true);
            p1 = __builtin_amdgcn_cvt_pk_fp8_f32(s[4 * 33], s[5 * 33], p1, false); p1 = __builtin_amdgcn_cvt_pk_fp8_f32(s[6 * 33], s[7 * 33], p1, true);
            *(GAS v2u*)((GAS unsigned char*)WT + (size_t)n * ldt + k0 + 8 * c) = (v2u){(unsigned)p0, (unsigned)p1};
        } else {
        v4u o; o.x = pk2(s[0 * 33], s[1 * 33]); o.y = pk2(s[2 * 33], s[3 * 33]); o.z = pk2(s[4 * 33], s[5 * 33]); o.w = pk2(s[6 * 33], s[7 * 33]);
        *(GAS v4u*)(WT + (size_t)n * ldt + k0 + 8 * c) = o; } }
    LDS_WAIT(); asm volatile("" ::: "memory");
}

__device__ __forceinline__ void p0_prologue(Frame& F) {
    LAS float* scr = (LAS float*)(F.lds + F.wave * 16384);
    const int gw = F.bid * NWAVES + F.wave, NGW = F.G * NWAVES;
    unsigned char* ws = F.ws;
    const float* w_in = F.in[2];
    constexpr int I_WIN = 16 * 192, I_QKV = 12 * 32, I_LRU = 32 * 8, I_WB = 2 * 512, I_WO = 2 * 512, I_PQ = 16 * 64;
    constexpr int NITEMS = I_WIN + I_QKV + I_LRU + I_WB + I_WO + I_PQ;
    for (int it = gw; it < NITEMS; it += NGW) {
        int r = it;
        if (r < I_WIN) { const int kb = r / 192, nb = r % 192, n0 = nb * 32, sc = n0 < 2048 ? n0 : n0 + 16;
            if ((n0 >= 1024 && n0 < 3072) || n0 >= 4096) tr_item<true>(w_in + sc, DIN, (bf16*)(ws + WS_WIN8 + (size_t)n0 * 1024), 1024, 1024.f, nullptr, scr, kb * 64, F.lane);
            else tr_item(w_in + sc, DIN, (bf16*)(ws + WS_WIN) + (size_t)n0 * 1024, 1024, 1.f, nullptr, scr, kb * 64, F.lane);
            continue; }
        r -= I_WIN;
        if (r < I_QKV) { const int mat = r / 32, rr = r % 32, kb = rr / 8, nb = rr % 8, g = mat >> 2, h = mat & 3;
            const float* W = F.in[6 + g] + (size_t)h * 65536 + nb * 32;
            tr_item(W, 256, (bf16*)(ws + WS_WQKV) + (size_t)mat * 65536 + (size_t)(nb * 32) * 256, 256, g == 1 ? 0.0625f : 1.f, nullptr, scr, kb * 64, F.lane); continue; }
        r -= I_QKV;
        if (r < I_LRU) { const int mat = r / 8, rr = r % 8, kb = rr / 4, nb = rr % 4, gate = mat & 1, db = mat >> 1;
            const float* W = F.in[gate ? 14 : 12] + (size_t)db * 16384 + nb * 32;
            tr_item(W, 128, (bf16*)(ws + WS_WLRU) + (size_t)mat * 16384 + (size_t)(nb * 32) * 128, 128, 1.f, nullptr, scr, kb * 64, F.lane); continue; }
        r -= I_LRU;
        if (r < I_WB) { const int mat = r / 512, rr = r % 512, kb = rr / 32, nb = rr % 32;
            const float* W = F.in[17 + mat] + nb * 32;
            tr_item(W, 1024, (bf16*)(ws + WS_WB2) + (size_t)(mat * 1024 + nb * 32) * 1024, 1024, 1.f, nullptr, scr, kb * 64, F.lane); continue; }
        r -= I_WB;
        if (r < I_WO) { const int cp = r / 512, rr = r % 512, kb = rr / 32, nb = rr % 32;
            const float* W = F.in[19] + nb * 32;
            tr_item(W, 1024, (bf16*)(ws + WS_WOUT2) + (size_t)(nb * 32) * 2048 + cp * 1024, 2048, 1.f, nullptr, scr, kb * 64, F.lane); continue; }
        r -= I_WO;
        { const int kb = r / 64, nb = r % 64;
            const float* W = F.in[21] + nb * 32;
            tr_item(W, 2048, (bf16*)(ws + WS_WPQ) + (size_t)(nb * 32) * 1024, 1024, 1.f, F.in[20], scr, kb * 64, F.lane); }
    }
    { const int gt = F.bid * NTHR + F.tid, NGT = F.G * NTHR;
      const float4* ks = (const float4*)F.in[22]; v2u* kd = (v2u*)(ws + WS_KEYS);
      for (int i = gt; i < 8 * 2 * 128 * 128 / 4; i += NGT) { const float4 v = ks[i]; v2u o; o.x = pk2(v.x, v.y); o.y = pk2(v.z, v.w); kd[i] = o; }
      float* ss = (float*)(ws + WS_SS);
      for (int i = gt; i < MTOK; i += NGT) ss[i] = 0.f; }
    { const int gt = F.bid * NTHR + F.tid;
      if (gt < 16 * 128) { const int c = gt >> 7, k8 = gt & 127; v4u o; unsigned wv[4];
#pragma unroll
          for (int j = 0; j < 4; ++j) wv[j] = pk2(w_in[(size_t)(k8 * 8 + 2 * j) * DIN + 2048 + c], w_in[(size_t)(k8 * 8 + 2 * j + 1) * DIN + 2048 + c]);
          o.x = wv[0]; o.y = wv[1]; o.z = wv[2]; o.w = wv[3]; *(v4u*)((bf16*)(ws + WS_WGT) + c * 1024 + k8 * 8) = o; } }
    const float* x = F.in[0]; const float* g1 = F.in[1];
    bf16* XN = (bf16*)(ws + WS_K);
    unsigned char* XN8 = (unsigned char*)F.out;
    f32x4 gv[4];
#pragma unroll
    for (int j = 0; j < 4; ++j) gv[j] = ((const f32x4*)g1)[F.lane + 64 * j];
    for (int m = 2 * gw; m < MTOK; m += 2 * NGW) {
        const f32x4* xr0 = (const f32x4*)(x + (size_t)m * DM) + F.lane; const f32x4* xr1 = xr0 + DM / 4;
        f32x4 v0[4], v1[4]; float s0 = 0.f, s1 = 0.f;
#pragma unroll
        for (int j = 0; j < 4; ++j) { v0[j] = xr0[64 * j]; v1[j] = xr1[64 * j]; }
#pragma unroll
        for (int j = 0; j < 4; ++j) { s0 += (v0[j].x * v0[j].x + v0[j].y * v0[j].y) + (v0[j].z * v0[j].z + v0[j].w * v0[j].w); s1 += (v1[j].x * v1[j].x + v1[j].y * v1[j].y) + (v1[j].z * v1[j].z + v1[j].w * v1[j].w); }
        const float r0 = rsqrtf(wave_sum(s0) * (1.f / DM) + EPS), r1 = rsqrtf(wave_sum(s1) * (1.f / DM) + EPS);
        unsigned long long* o0 = (unsigned long long*)(XN + (size_t)m * DM) + F.lane; unsigned long long* o1 = o0 + DM / 4;
        unsigned* q0 = (unsigned*)(XN8 + (size_t)m * DM) + F.lane; unsigned* q1 = q0 + DM / 4;
#pragma unroll
        for (int j = 0; j < 4; ++j) { const f32x4 a = v0[j] * r0 * gv[j], c = v1[j] * r1 * gv[j];
            o0[64 * j] = (unsigned long long)pk2(a.x, a.y) | ((unsigned long long)pk2(a.z, a.w) << 32);
            o1[64 * j] = (unsigned long long)pk2(c.x, c.y) | ((unsigned long long)pk2(c.z, c.w) << 32);
            int pa = 0, pc = 0; pa = __builtin_amdgcn_cvt_pk_fp8_f32(a.x, a.y, pa, false); pa = __builtin_amdgcn_cvt_pk_fp8_f32(a.z, a.w, pa, true);
            pc = __builtin_amdgcn_cvt_pk_fp8_f32(c.x, c.y, pc, false); pc = __builtin_amdgcn_cvt_pk_fp8_f32(c.z, c.w, pc, true);
            q0[64 * j] = (unsigned)pa; q1[64 * j] = (unsigned)pc; }
    }
}
__device__ __forceinline__ void gates_phase(Frame& F) {
    const bf16* XN = (const bf16*)(F.ws + WS_K); const bf16* WGT = (const bf16*)(F.ws + WS_WGT); float* GT = (float*)(F.ws + WS_GATE);
    const int lane = F.lane, fr = lane & 15, fq = lane >> 4;
    const f32x4 bg4 = *(const f32x4*)(F.in[3] + 4 * fq);
    for (int task = F.bid * NWAVES + F.wave; task < MTOK / 16; task += F.G * NWAVES) {
        const size_t m0 = (size_t)task * 16;
        f32x4 acc = (f32x4){0.f, 0.f, 0.f, 0.f};
#pragma unroll 8
        for (int ks = 0; ks < 32; ++ks) {
            const bf16x8 wfr = *(const bf16x8*)(WGT + fr * 1024 + 32 * ks + 8 * fq);
            const bf16x8 xfr = *(const bf16x8*)(XN + (m0 + fr) * DM + 32 * ks + 8 * fq);
            acc = __builtin_amdgcn_mfma_f32_16x16x32_bf16(wfr, xfr, acc, 0, 0, 0);
        }
        *(f32x4*)(GT + (m0 + fr) * 16 + 4 * fq) = acc + bg4;
    }
}

struct AddrPlain {
    const char* A; const char* Bt; int lda, ldb, K;
    __device__ __forceinline__ const char* a(const pg8::Unit& u) const { return A + (size_t)u.pm * 256 * lda * 2; }
    __device__ __forceinline__ const char* b(const pg8::Unit& u) const { return Bt + (size_t)u.pn * 256 * ldb * 2; }
};
struct AddrP1 {
    const char* A; const char* Bt; int lda, ldb, K, thr, lo_add, hi_add;
    __device__ __forceinline__ const char* a(const pg8::Unit& u) const { return A + (size_t)u.pm * 256 * lda * 2; }
    __device__ __forceinline__ const char* b(const pg8::Unit& u) const { return Bt + (size_t)(u.pn + (u.pn < thr ? lo_add : hi_add)) * 256 * ldb * 2; }
};
struct AddrQKV {
    const char* XC; long dXM; const char* W; int lda, ldb, K;
    __device__ __forceinline__ const char* a(const pg8::Unit& u) const { return XC + (u.pn < 8 ? 0l : dXM) + ((size_t)u.pm * 256 * 1024 + (u.pn & 3) * 256) * 2; }
    __device__ __forceinline__ const char* b(const pg8::Unit& u) const { return W + (size_t)u.pn * 65536 * 2; }
};
struct AddrBranch {
    const char* YM; long dYL; const char* W; int lda, ldb, K;
    __device__ __forceinline__ const char* a(const pg8::Unit& u) const { return YM + (u.pn < 4 ? 0l : dYL) + (size_t)u.pm * 256 * 1024 * 2; }
    __device__ __forceinline__ const char* b(const pg8::Unit& u) const { return W + (size_t)u.pn * 256 * 1024 * 2; }
};

struct DstP1 { unsigned char* ws; int thr, lo_add, hi_add;
    __device__ __forceinline__ bf16* get(int j, int& ld, int& col0) const {
        const int pn = j + (j < thr ? lo_add : hi_add); const bool mg = pn >= 16; ld = mg ? 2048 : 1024; col0 = mg ? (pn - 16) * 256 : (pn & 3) * 256;
        return (bf16*)(ws + (mg ? WS_MG : WS_XM + (size_t)(pn >> 2) * 64 * MiB)); } };
struct DstQKV { char* q; long dk, dv;
    __device__ __forceinline__ bf16* get(int pn, int& ld, int& col0) const { ld = 1024; col0 = (pn & 3) * 256; return (bf16*)(q + (pn >= 4 ? (pn >= 8 ? dv : dk) : 0l)); } };
template <class Dst, bool MUL = false> struct EpiBf16 {
    static constexpr bool PERM = true;
    Dst dst; float mul;
    __device__ __forceinline__ void operator()(const f32x4 (&acc)[2][2][4][2], const pg8::Unit& u, int wr, int wc, int fr, int fq) const {
        int ld, colt; bf16* base = dst.get(u.pn, ld, colt);
        const int row0 = u.pm * 256 + wr * 64 + fr, col0 = colt + wc * 32 + 8 * fq;
#pragma unroll
        for (int ai = 0; ai < 2; ++ai)
#pragma unroll
            for (int m = 0; m < 4; ++m) { bf16* rowp = base + (size_t)(row0 + ai * 128 + m * 16) * ld + col0;
#pragma unroll
                for (int bj = 0; bj < 2; ++bj) { f32x4 v0 = acc[ai][bj][m][0], v1 = acc[ai][bj][m][1]; if (MUL) { v0 = v0 * mul; v1 = v1 * mul; }
                    v4u w; w.x = pg8::cvt_pk_bf16(v0[0], v0[1]); w.y = pg8::cvt_pk_bf16(v0[2], v0[3]); w.z = pg8::cvt_pk_bf16(v1[0], v1[1]); w.w = pg8::cvt_pk_bf16(v1[2], v1[3]);
                    *(v4u*)(rowp + bj * 128) = w; } }
    }
};
template <bool ADD> struct EpiMerge {
    static constexpr bool PERM = true;
    bf16* MRG; const bf16* MG; int gcol;
    __device__ __forceinline__ void operator()(const f32x4 (&acc)[2][2][4][2], const pg8::Unit& u, int wr, int wc, int fr, int fq) const {
        const int row0 = u.pm * 256 + wr * 64 + fr, col0 = u.pn * 256 + wc * 32 + 8 * fq;
#pragma unroll
        for (int ai = 0; ai < 2; ++ai)
#pragma unroll
            for (int m = 0; m < 4; ++m) { const size_t row = (size_t)(row0 + ai * 128 + m * 16); bf16* rowp = MRG + row * 1024 + col0; const bf16* gp = MG + row * 2048 + gcol + col0;
#pragma unroll
                for (int bj = 0; bj < 2; ++bj) { const f32x4 v0 = acc[ai][bj][m][0], v1 = acc[ai][bj][m][1];
                    const v4u g = *(const v4u*)(gp + bj * 128);
                    float o[8] = {v0[0] * sigmoidf_(bflo(g.x)), v0[1] * sigmoidf_(bfhi(g.x)), v0[2] * sigmoidf_(bflo(g.y)), v0[3] * sigmoidf_(bfhi(g.y)),
                                  v1[0] * sigmoidf_(bflo(g.z)), v1[1] * sigmoidf_(bfhi(g.z)), v1[2] * sigmoidf_(bflo(g.w)), v1[3] * sigmoidf_(bfhi(g.w))};
                    if (ADD) { const v4u t = *(const v4u*)(rowp + bj * 128);
                        o[0] += bflo(t.x); o[1] += bfhi(t.x); o[2] += bflo(t.y); o[3] += bfhi(t.y); o[4] += bflo(t.z); o[5] += bfhi(t.z); o[6] += bflo(t.w); o[7] += bfhi(t.w); }
                    v4u w; w.x = pg8::cvt_pk_bf16(o[0], o[1]); w.y = pg8::cvt_pk_bf16(o[2], o[3]); w.z = pg8::cvt_pk_bf16(o[4], o[5]); w.w = pg8::cvt_pk_bf16(o[6], o[7]);
                    *(v4u*)(rowp + bj * 128) = w; } }
    }
};
struct EpiResid {
    static constexpr bool PERM = false;
    const float* x; float* x1; bf16* x1b; float* ss;
    __device__ __forceinline__ void operator()(const f32x4 (&acc)[2][2][4][2], const pg8::Unit& u, int wr, int wc, int fr, int fq) const {
        const int row0 = u.pm * 256 + wr * 64 + fr, col0 = u.pn * 256 + wc * 32 + 4 * fq;
#pragma unroll
        for (int ai = 0; ai < 2; ++ai)
#pragma unroll
            for (int m = 0; m < 4; ++m) { const int row = row0 + ai * 128 + m * 16; const size_t off = (size_t)row * DM + col0; float s = 0.f;
#pragma unroll
                for (int bj = 0; bj < 2; ++bj)
#pragma unroll
                    for (int n = 0; n < 2; ++n) { const size_t o = off + bj * 128 + n * 16; const f32x4 v = *(const f32x4*)(x + o) + acc[ai][bj][m][n];
                        *(f32x4*)(x1 + o) = v; v2u w; w.x = pg8::cvt_pk_bf16(v[0], v[1]); w.y = pg8::cvt_pk_bf16(v[2], v[3]); *(v2u*)(x1b + o) = w;
                        s += (v[0] * v[0] + v[1] * v[1]) + (v[2] * v[2] + v[3] * v[3]); }
                s += __shfl_xor(s, 16); s += __shfl_xor(s, 32);
                if (fq == 0) atomicAdd(ss + row, s); }
    }
};
struct EpiPQ {
    static constexpr bool PERM = true;
    bf16* pq; const float* ss;
    __device__ __forceinline__ void operator()(const f32x4 (&acc)[2][2][4][2], const pg8::Unit& u, int wr, int wc, int fr, int fq) const {
        const int row0 = u.pm * 256 + wr * 64 + fr, col0 = u.pn * 256 + wc * 32 + 8 * fq;
#pragma unroll
        for (int ai = 0; ai < 2; ++ai)
#pragma unroll
            for (int m = 0; m < 4; ++m) { const int row = row0 + ai * 128 + m * 16; bf16* rowp = pq + (size_t)row * 2048 + col0;
                const float r = rsqrtf(ss[row] * (1.f / DM) + EPS);
#pragma unroll
                for (int bj = 0; bj < 2; ++bj) { const f32x4 v0 = acc[ai][bj][m][0] * r, v1 = acc[ai][bj][m][1] * r;
                    v4u w; w.x = pg8::cvt_pk_bf16(v0[0], v0[1]); w.y = pg8::cvt_pk_bf16(v0[2], v0[3]); w.z = pg8::cvt_pk_bf16(v1[0], v1[1]); w.w = pg8::cvt_pk_bf16(v1[2], v1[3]);
                    *(v4u*)(rowp + bj * 128) = w; } }
    }
};

template <bool PB> __device__ __forceinline__ void lru_phase(Frame& F) {
    const bf16* XL = (const bf16*)(F.ws + WS_XL); const bf16* LG = (const bf16*)(F.ws + WS_LG); bf16* YL = (bf16*)F.out;
    f32x2* AGG = (f32x2*)(F.ws + WS_AGG);
    const bf16* WL = (const bf16*)(F.ws + WS_WLRU);
    const float* cw = F.in[10]; const float* cb = F.in[11];
    unsigned char* LA0 = F.ws + WS_K; unsigned char* LA1 = LA0 + (size_t)MTOK * DM; bf16* LU0 = (bf16*)F.out; bf16* LU1 = LU0 + (size_t)MTOK * DM;
    v2u ra[2]; v4u ru[2];
    constexpr int O_XCB = 0, O_XCF = 17408, O_A = 51200, O_U = 84992, FST = 528;
    LAS unsigned char* L = F.lds;
    const int tid = F.tid, lane = F.lane, w = F.wave, fr = lane & 15, fq = lane >> 4;
    int cur_blk = -1;
    bf16x8 wf[2][2][4];
    f32x4 br4[2], bi4[2], sp4[2];
    v4u rawreg[3];
#define RAW_LOAD(bb, tt0, bk) do { _Pragma("unroll") for (int r_ = 0; r_ < 3; ++r_) { const int e_ = tid + NTHR * r_, row_ = e_ >> 4, c16_ = e_ & 15, t_ = (tt0) - 2 + row_; \
            v4u v_ = {0u, 0u, 0u, 0u}; if (e_ < 68 * 16 && t_ >= 0 && t_ < SEQ) v_ = *(const v4u*)(XL + ((size_t)(bb) * SEQ + t_) * DM + (bk) * 128 + c16_ * 8); rawreg[r_] = v_; } } while (0)
#define PB_LOAD(ii, dd) do { const int idx_ = (ii) * F.G + F.bid; if (idx_ < 4096) { const int j_ = idx_ >> 3; const size_t mr_ = (size_t)(j_ >> 6) * SEQ + (j_ & 63) * 64; \
            _Pragma("unroll") for (int r_ = 0; r_ < 2; ++r_) { const int e_ = tid + NTHR * r_; const size_t o_ = (mr_ + (e_ >> 4)) * DM + (idx_ & 7) * 128 + (e_ & 15) * 8; \
                ra[r_] = *(const v2u*)(((dd) ? LA1 : LA0) + o_); ru[r_] = *(const v4u*)(((dd) ? LU1 : LU0) + o_); } } } while (0)
    constexpr int O_CARRY = 118784, O_CW = 135168, O_SUB = 137728;
    const bool carry_tab = PB && (F.G == 256);
    if (carry_tab) {
        const int ch = tid & 127, bq = tid >> 7, s0 = F.bid >> 3, blk0 = F.bid & 7;
        LAS float* CT = (LAS float*)(L + O_CARRY);
#define FOLD(agp, j0, j1, stp, hv) do { int js_ = (j0); const int n_ = ((j1) - (j0)) * (stp); int k_ = 0; \
            for (; k_ + 8 <= n_; k_ += 8) { f32x2 ah_[8]; _Pragma("unroll") for (int q_ = 0; q_ < 8; ++q_) ah_[q_] = (agp)[(size_t)(js_ + q_ * (stp)) * 2 * DM]; \
                _Pragma("unroll") for (int q_ = 0; q_ < 8; ++q_) hv = ah_[q_][0] * hv + ah_[q_][1]; js_ += 8 * (stp); } \
            for (; k_ < n_; ++k_) { const f32x2 a1_ = (agp)[(size_t)js_ * 2 * DM]; hv = a1_[0] * hv + a1_[1]; js_ += (stp); } } while (0)
        for (int bb = 2 * bq; bb < 2 * bq + 2; ++bb) {
            const f32x2* ag0 = AGG + ((size_t)(bb * 64) * 2 + 0) * DM + blk0 * 128 + ch; const f32x2* ag1 = AGG + ((size_t)(bb * 64) * 2 + 1) * DM + blk0 * 128 + ch;
            float h = 0.f;
            FOLD(ag0, 0, s0, 1, h); CT[((bb * 2 + 0) * 2 + 0) * 128 + ch] = h;
            FOLD(ag0, s0, s0 + 32, 1, h); CT[((bb * 2 + 1) * 2 + 0) * 128 + ch] = h;
            h = 0.f;
            FOLD(ag1, 63, s0 + 32, -1, h); CT[((bb * 2 + 1) * 2 + 1) * 128 + ch] = h;
            FOLD(ag1, s0 + 32, s0, -1, h); CT[((bb * 2 + 0) * 2 + 1) * 128 + ch] = h;
        }
        __syncthreads();
#undef FOLD
    }
    for (int i = 0;; ++i) {
        const int idx = i * F.G + F.bid; if (idx >= 4096) break;
        const int blk = idx & 7, j = idx >> 3, b = j >> 6, seg = j & 63, t0 = seg * 64;
        const size_t mrow0 = (size_t)b * SEQ + t0;
        if (!PB && blk != cur_blk) {
            cur_blk = blk;
#pragma unroll
            for (int d = 0; d < 2; ++d) {
#pragma unroll
                for (int g = 0; g < 2; ++g)
#pragma unroll
                    for (int ks = 0; ks < 4; ++ks)
                        wf[d][g][ks] = *(const bf16x8*)(WL + ((size_t)((d * 8 + blk) * 2 + g) * 128 + 16 * w + fr) * 128 + 32 * ks + 8 * fq);
                const int ch = blk * 128 + 16 * w + 4 * fq;
                br4[d] = *(const f32x4*)(F.in[13] + d * DM + ch); bi4[d] = *(const f32x4*)(F.in[15] + d * DM + ch);
                const f32x4 lm = *(const f32x4*)(F.in[16] + d * DM + ch);
#pragma unroll
                for (int e = 0; e < 4; ++e) sp4[d][e] = -8.f * 1.44269504089f * softplusf_(-lm[e]);
            }
            __syncthreads();
            for (int e = tid; e < 5 * 128; e += NTHR) { const int jt = e >> 7, cc = e & 127; ((LAS float*)(L + O_CW))[e] = (jt < 4) ? cw[jt * DM + blk * 128 + cc] : cb[blk * 128 + cc]; }
        }
        v4u lgreg[2];
        if (PB) {
            if (i == 0) PB_LOAD(0, 0);
#pragma unroll
            for (int r = 0; r < 2; ++r) { const int e = tid + NTHR * r; lgreg[r] = *(const v4u*)(LG + (mrow0 + (e >> 4)) * DM + blk * 128 + (e & 15) * 8); }
        } else {
        if (i == 0) RAW_LOAD(b, t0, blk);
#pragma unroll
        for (int r = 0; r < 3; ++r) { const int e = tid + NTHR * r; if (e < 68 * 16) *(LAS v4u*)(L + O_A + (e >> 4) * 256 + (e & 15) * 16) = rawreg[r]; }
        __syncthreads();
        { const int idx2 = (i + 1) * F.G + F.bid; if (idx2 < 4096) { const int j2 = idx2 >> 3; RAW_LOAD(j2 >> 6, (j2 & 63) * 64, idx2 & 7); } }
        for (int e = tid; e < 64 * 16; e += NTHR) { const int tl = e >> 4, c16 = e & 15;
            float y[8];
            { const f32x4 a = *(const LAS f32x4*)(L + O_CW + 4 * 512 + c16 * 32), bq = *(const LAS f32x4*)(L + O_CW + 4 * 512 + c16 * 32 + 16); y[0] = a[0]; y[1] = a[1]; y[2] = a[2]; y[3] = a[3]; y[4] = bq[0]; y[5] = bq[1]; y[6] = bq[2]; y[7] = bq[3]; }
#pragma unroll
            for (int jt = 0; jt < 4; ++jt) { const v4u r = *(const LAS v4u*)(L + O_A + (tl + jt) * 256 + c16 * 16);
                const f32x4 wa = *(const LAS f32x4*)(L + O_CW + jt * 512 + c16 * 32), wb = *(const LAS f32x4*)(L + O_CW + jt * 512 + c16 * 32 + 16);
                y[0] += wa[0] * bflo(r.x); y[1] += wa[1] * bfhi(r.x); y[2] += wa[2] * bflo(r.y); y[3] += wa[3] * bfhi(r.y);
                y[4] += wb[0] * bflo(r.z); y[5] += wb[1] * bfhi(r.z); y[6] += wb[2] * bflo(r.w); y[7] += wb[3] * bfhi(r.w); }
            *(LAS f32x4*)(L + O_XCF + tl * FST + c16 * 32) = (f32x4){y[0], y[1], y[2], y[3]};
            *(LAS f32x4*)(L + O_XCF + tl * FST + c16 * 32 + 16) = (f32x4){y[4], y[5], y[6], y[7]};
            v4u o; o.x = pk2(y[0], y[1]); o.y = pk2(y[2], y[3]); o.z = pk2(y[4], y[5]); o.w = pk2(y[6], y[7]);
            *(LAS v4u*)(L + O_XCB + tl * 272 + c16 * 16) = o; }
        __syncthreads();
        }
        float carry0 = 0.f, carry1 = 0.f;
        if (carry_tab) { const LAS float* CT = (const LAS float*)(L + O_CARRY); carry0 = CT[((b * 2 + (seg >> 5)) * 2 + 0) * 128 + (tid & 127)]; carry1 = CT[((b * 2 + (seg >> 5)) * 2 + 1) * 128 + (tid & 127)]; }
        else if (PB) {
            const int ch = blk * 128 + (tid & 127);
            float h = 0.f;
            const f32x2* ag0 = AGG + ((size_t)(b * 64) * 2 + 0) * DM + ch; const f32x2* ag1 = AGG + ((size_t)(b * 64) * 2 + 1) * DM + ch;
            int js = 0;
            for (; js + 8 <= seg; js += 8) { f32x2 ah[8];
#pragma unroll
                for (int q = 0; q < 8; ++q) ah[q] = ag0[(size_t)(js + q) * 2 * DM];
#pragma unroll
                for (int q = 0; q < 8; ++q) h = ah[q][0] * h + ah[q][1]; }
            for (; js < seg; ++js) { const f32x2 ah = ag0[(size_t)js * 2 * DM]; h = ah[0] * h + ah[1]; }
            carry0 = h; h = 0.f;
            js = 63;
            for (; js - 8 >= seg; js -= 8) { f32x2 ah[8];
#pragma unroll
                for (int q = 0; q < 8; ++q) ah[q] = ag1[(size_t)(js - q) * 2 * DM];
#pragma unroll
                for (int q = 0; q < 8; ++q) h = ah[q][0] * h + ah[q][1]; }
            for (; js > seg; --js) { const f32x2 ah = ag1[(size_t)js * 2 * DM]; h = ah[0] * h + ah[1]; }
            carry1 = h;
        }
#pragma unroll
        for (int d = 0; d < 2; ++d) {
            const int o_a = (d == 0) ? O_A : O_XCF;
            if (PB) {
#pragma unroll
                for (int r = 0; r < 2; ++r) { const int e = tid + NTHR * r, row = e >> 4, c16 = e & 15;
                    const f32x2 x0 = __builtin_amdgcn_cvt_pk_f32_fp8((int)ra[r].x, false), x1 = __builtin_amdgcn_cvt_pk_f32_fp8((int)ra[r].x, true);
                    const f32x2 x2 = __builtin_amdgcn_cvt_pk_f32_fp8((int)ra[r].y, false), x3 = __builtin_amdgcn_cvt_pk_f32_fp8((int)ra[r].y, true);
                    constexpr float IS = 1.f / 4096.f;
                    *(LAS f32x4*)(L + o_a + row * FST + c16 * 32) = (f32x4){1.f - x0[0] * IS, 1.f - x0[1] * IS, 1.f - x1[0] * IS, 1.f - x1[1] * IS};
                    *(LAS f32x4*)(L + o_a + row * FST + c16 * 32 + 16) = (f32x4){1.f - x2[0] * IS, 1.f - x2[1] * IS, 1.f - x3[0] * IS, 1.f - x3[1] * IS};
                    *(LAS f32x4*)(L + O_U + row * FST + c16 * 32) = (f32x4){bflo(ru[r].x), bfhi(ru[r].x), bflo(ru[r].y), bfhi(ru[r].y)};
                    *(LAS f32x4*)(L + O_U + row * FST + c16 * 32 + 16) = (f32x4){bflo(ru[r].z), bfhi(ru[r].z), bflo(ru[r].w), bfhi(ru[r].w)}; }
                if (d == 0) PB_LOAD(i, 1); else PB_LOAD(i + 1, 0);
            } else {
            f32x4 aR[4], aI[4];
#pragma unroll
            for (int mt = 0; mt < 4; ++mt) { aR[mt] = (f32x4){0.f, 0.f, 0.f, 0.f}; aI[mt] = (f32x4){0.f, 0.f, 0.f, 0.f}; }
#pragma unroll
            for (int ks = 0; ks < 4; ++ks)
#pragma unroll
                for (int mt = 0; mt < 4; ++mt) { const bf16x8 xb = *(const LAS bf16x8*)(L + O_XCB + (16 * mt + fr) * 272 + (32 * ks + 8 * fq) * 2);
                    aR[mt] = __builtin_amdgcn_mfma_f32_16x16x32_bf16(wf[d][0][ks], xb, aR[mt], 0, 0, 0);
                    aI[mt] = __builtin_amdgcn_mfma_f32_16x16x32_bf16(wf[d][1][ks], xb, aI[mt], 0, 0, 0); }
#pragma unroll
            for (int mt = 0; mt < 4; ++mt) { const int tl = 16 * mt + fr, cl = 16 * w + 4 * fq;
                const f32x4 xc = *(const LAS f32x4*)(L + O_XCF + tl * FST + cl * 4);
                f32x4 av, uv;
#pragma unroll
                for (int e = 0; e < 4; ++e) { const float r = sigmoidf_(aR[mt][e] + br4[d][e]), ig = sigmoidf_(aI[mt][e] + bi4[d][e]);
                    const float a_ = __builtin_amdgcn_exp2f(r * sp4[d][e]); av[e] = a_; uv[e] = __builtin_amdgcn_sqrtf(fmaxf(1.f - a_ * a_, 0.f)) * (ig * xc[e]); }
                *(LAS f32x4*)(L + o_a + tl * FST + cl * 4) = av; *(LAS f32x4*)(L + O_U + tl * FST + cl * 4) = uv;
                { const size_t go = (mrow0 + tl) * DM + blk * 128 + cl;
                  int xa = 0; xa = __builtin_amdgcn_cvt_pk_fp8_f32((1.f - av[0]) * 4096.f, (1.f - av[1]) * 4096.f, xa, false); xa = __builtin_amdgcn_cvt_pk_fp8_f32((1.f - av[2]) * 4096.f, (1.f - av[3]) * 4096.f, xa, true);
                  v2u xu; xu.x = pk2(uv[0], uv[1]); xu.y = pk2(uv[2], uv[3]);
                  *(unsigned*)((d ? LA1 : LA0) + go) = (unsigned)xa; *(v2u*)((d ? LU1 : LU0) + go) = xu; } }
            }
            __syncthreads();
            {
                const int c = tid & 127, sub = tid >> 7;
                LAS float* pa = (LAS float*)(L + o_a) + c; const LAS float* pu = (const LAS float*)(L + O_U) + c;
                LAS f32x2* SUBT = (LAS f32x2*)(L + O_SUB);
                float h = 0.f, A = 1.f;
#pragma unroll
                for (int s2 = 0; s2 < 16; ++s2) { const int tl = d ? (16 * sub + 15 - s2) : (16 * sub + s2); const float a = pa[tl * 132], u = pu[tl * 132]; h = a * h + u; A *= a; }
                SUBT[sub * 128 + c] = (f32x2){A, h};
                __syncthreads();
                if (!PB) {
                    if (sub == 0) { float HH = 0.f, AA = 1.f;
#pragma unroll
                        for (int q = 0; q < 4; ++q) { const f32x2 ah = SUBT[(d ? 3 - q : q) * 128 + c]; HH = ah[0] * HH + ah[1]; AA *= ah[0]; }
                        AGG[((size_t)(b * 64 + seg) * 2 + d) * DM + blk * 128 + c] = (f32x2){AA, HH}; }
                } else {
                    float hc = d ? carry1 : carry0;
#pragma unroll
                    for (int q = 0; q < 3; ++q) { const int jq = d ? 3 - q : q; const f32x2 ah = SUBT[jq * 128 + c]; if (d ? (jq > sub) : (jq < sub)) hc = ah[0] * hc + ah[1]; }
                    if (d == 0) {
#pragma unroll
                        for (int s2 = 0; s2 < 16; ++s2) { const int tl = 16 * sub + s2; hc = pa[tl * 132] * hc + pu[tl * 132]; pa[tl * 132] = hc; }
                    } else { LAS float* ph = (LAS float*)(L + O_A) + c;
#pragma unroll
                        for (int s2 = 0; s2 < 16; ++s2) { const int tl = 16 * sub + 15 - s2; hc = pa[tl * 132] * hc + pu[tl * 132]; ph[tl * 132] += hc; } }
                }
            }
            __syncthreads();
        }
        if (PB) {
#pragma unroll
            for (int r = 0; r < 2; ++r) { const int e = tid + NTHR * r, row = e >> 4, c16 = e & 15;
                const v4u g = lgreg[r];
                const f32x4 h0 = *(const LAS f32x4*)(L + O_A + row * FST + c16 * 32), h1 = *(const LAS f32x4*)(L + O_A + row * FST + c16 * 32 + 16);
                v4u o;
                o.x = pk2(h0[0] * gelu_fast(bflo(g.x)), h0[1] * gelu_fast(bfhi(g.x))); o.y = pk2(h0[2] * gelu_fast(bflo(g.y)), h0[3] * gelu_fast(bfhi(g.y)));
                o.z = pk2(h1[0] * gelu_fast(bflo(g.z)), h1[1] * gelu_fast(bfhi(g.z))); o.w = pk2(h1[2] * gelu_fast(bflo(g.w)), h1[3] * gelu_fast(bfhi(g.w)));
                *(v4u*)(YL + (mrow0 + row) * DM + blk * 128 + c16 * 8) = o; }
            __syncthreads();
        }
    }
#undef RAW_LOAD
#undef PB_LOAD
}

__device__ __forceinline__ void mconv_phase(Frame& F) {
    const bf16* XM = (const bf16*)(F.ws + WS_XM); bf16* XC = (bf16*)F.out + (size_t)MTOK * DM;
    const float* cw = F.in[4]; const float* cb = F.in[5];
    const int NT = MTOK / 32 * 128;
    for (int g = F.bid * NTHR + F.tid; g < NT; g += F.G * NTHR) {
        const int chunk = g & 127, run = g >> 7, c0 = chunk * 8, m0 = run * 32, t0 = m0 & (SEQ - 1);
        float w[4][8], bias[8];
#pragma unroll
        for (int j = 0; j < 4; ++j) { const f32x4 a = *(const f32x4*)(cw + j * DM + c0), b = *(const f32x4*)(cw + j * DM + c0 + 4);
            w[j][0] = a[0]; w[j][1] = a[1]; w[j][2] = a[2]; w[j][3] = a[3]; w[j][4] = b[0]; w[j][5] = b[1]; w[j][6] = b[2]; w[j][7] = b[3]; }
        { const f32x4 a = *(const f32x4*)(cb + c0), b = *(const f32x4*)(cb + c0 + 4);
            bias[0] = a[0]; bias[1] = a[1]; bias[2] = a[2]; bias[3] = a[3]; bias[4] = b[0]; bias[5] = b[1]; bias[6] = b[2]; bias[7] = b[3]; }
        v4u win[4];
        const v4u zero = {0u, 0u, 0u, 0u};
        win[0] = zero;
        win[1] = (t0 >= 2) ? *(const v4u*)(XM + (size_t)(m0 - 2) * DM + c0) : zero;
        win[2] = (t0 >= 1) ? *(const v4u*)(XM + (size_t)(m0 - 1) * DM + c0) : zero;
        win[3] = *(const v4u*)(XM + (size_t)m0 * DM + c0);
#pragma unroll 4
        for (int i = 0; i < 32; ++i) {
            win[0] = win[1]; win[1] = win[2]; win[2] = win[3];
            win[3] = (t0 + i + 1 < SEQ) ? *(const v4u*)(XM + (size_t)(m0 + i + 1) * DM + c0) : zero;
            float y[8];
#pragma unroll
            for (int e = 0; e < 8; ++e) y[e] = bias[e];
#pragma unroll
            for (int j = 0; j < 4; ++j) {
                const unsigned p0 = win[j].x, p1 = win[j].y, p2 = win[j].z, p3 = win[j].w;
                y[0] += w[j][0] * bflo(p0); y[1] += w[j][1] * bfhi(p0); y[2] += w[j][2] * bflo(p1); y[3] += w[j][3] * bfhi(p1);
                y[4] += w[j][4] * bflo(p2); y[5] += w[j][5] * bfhi(p2); y[6] += w[j][6] * bflo(p3); y[7] += w[j][7] * bfhi(p3);
            }
#pragma unroll
            for (int e = 0; e < 8; ++e) y[e] = y[e] * sigmoidf_(y[e]);
            v4u o; o.x = pk2(y[0], y[1]); o.y = pk2(y[2], y[3]); o.z = pk2(y[4], y[5]); o.w = pk2(y[6], y[7]);
            *(v4u*)(XC + (size_t)(m0 + i) * DM + c0) = o;
        }
    }
}

typedef short s16x4 __attribute__((ext_vector_type(4)));
__device__ __forceinline__ bf16x8 tr_read_pair(unsigned a0, unsigned a1) {
    s16x4 r0, r1;
    asm volatile("ds_read_b64_tr_b16 %0, %2\n\tds_read_b64_tr_b16 %1, %3\n\ts_waitcnt lgkmcnt(0)" : "=&v"(r0), "=&v"(r1) : "v"(a0), "v"(a1) : "memory");
    return __builtin_shufflevector(r0, r1, 0, 1, 2, 3, 4, 5, 6, 7);
}
__device__ __forceinline__ float dpp_shr(float oldv, float x, int n) {
    const int o = __builtin_bit_cast(int, oldv), v = __builtin_bit_cast(int, x);
    int r;
    if (n == 1) r = __builtin_amdgcn_update_dpp(o, v, 0x111, 0xf, 0xf, false);
    else if (n == 2) r = __builtin_amdgcn_update_dpp(o, v, 0x112, 0xf, 0xf, false);
    else if (n == 4) r = __builtin_amdgcn_update_dpp(o, v, 0x114, 0xf, 0xf, false);
    else r = __builtin_amdgcn_update_dpp(o, v, 0x118, 0xf, 0xf, false);
    return __builtin_bit_cast(float, r);
}
__device__ __forceinline__ float rdlane(float x, int l) { return __builtin_bit_cast(float, __builtin_amdgcn_readlane(__builtin_bit_cast(int, x), l)); }
__device__ __forceinline__ float wave_incl_sum(float x, int lane) {
    x += dpp_shr(0.f, x, 1); x += dpp_shr(0.f, x, 2); x += dpp_shr(0.f, x, 4); x += dpp_shr(0.f, x, 8);
    const float t0 = rdlane(x, 15), t1 = rdlane(x, 31), t2 = rdlane(x, 47);
    return x + (lane >= 16 ? t0 : 0.f) + (lane >= 32 ? t1 : 0.f) + (lane >= 48 ? t2 : 0.f);
}
__device__ __forceinline__ float wave_incl_max(float x, int lane) {
    const float NI = -INFINITY;
    x = fmaxf(x, dpp_shr(NI, x, 1)); x = fmaxf(x, dpp_shr(NI, x, 2)); x = fmaxf(x, dpp_shr(NI, x, 4)); x = fmaxf(x, dpp_shr(NI, x, 8));
    const float t0 = rdlane(x, 15), t1 = rdlane(x, 31), t2 = rdlane(x, 47);
    return fmaxf(fmaxf(x, lane >= 16 ? t0 : NI), fmaxf(lane >= 32 ? t1 : NI, lane >= 48 ? t2 : NI));
}
__device__ __forceinline__ void mscan_phase(Frame& F) {
    const bf16* Q = (const bf16*)(F.ws + WS_LG); const bf16* K = (const bf16*)(F.ws + WS_K); const bf16* V = (const bf16*)(F.ws + WS_XL);
    const float* GT = (const float*)(F.ws + WS_GATE);
    constexpr int KS = 0, CTI = 33792, VT = 67584, VWT = 86016, PB = 104448, TAB = 113664, NT = 116736, NPART = 117760, DENT = 119808;
    constexpr int KST = 528, VST = 144, TABSZ = 1536;
    LAS unsigned char* L = F.lds;
    const int tid = F.tid, lane = F.lane, w = F.wave, fr = lane & 15, fq = lane >> 4, pt = w & 3, wg = w >> 2;
    for (int item = F.bid; item < 256; item += F.G) {
        const int es = item & 3, dir = (item >> 2) & 1, h = (item >> 3) & 3, b = item >> 5;
        bf16* H = dir ? ((bf16*)F.out + (size_t)MTOK * DM) : (bf16*)(F.ws + WS_XM);
        const size_t rowbase = (size_t)b * SEQ;
#define TOF(c, p) (dir ? (SEQ - 1 - 64 * (c) - (p)) : (64 * (c) + (p)))
        for (int e = tid; e < (33792 + 1024) / 4; e += NTHR) { if (e < 33792 / 4) ((LAS unsigned*)(L + CTI))[e] = 0u; else ((LAS unsigned*)(L + NT))[e - 33792 / 4] = 0u; }
        float m_run = 0.f;
        float gi_n = 0.f, gf_n = 0.f;
        if (w == 0) { const size_t m = rowbase + TOF(0, lane); gi_n = GT[m * 16 + dir * 8 + h]; gf_n = GT[m * 16 + dir * 8 + 4 + h]; }
#define G1_TABLES(setp) do { \
            const float logf_ = fminf(gf_n, 0.f) - __logf(1.f + __expf(-fabsf(gf_n))); const float b_ = wave_incl_sum(logf_, lane); const float a_ = gi_n - b_; \
            const float M_ = fmaxf(m_run, wave_incl_max(a_, lane)); const float Mend_ = rdlane(M_, 63), g_ = rdlane(b_, 63); \
            LAS float* T_ = (LAS float*)(setp); T_[lane] = a_; T_[64 + lane] = M_; T_[128 + lane] = __expf(m_run - M_); T_[192 + lane] = __expf(-(b_ + M_)); T_[256 + lane] = __expf(a_ - Mend_); \
            if (lane == 0) { T_[320] = __expf(m_run - Mend_); T_[321] = g_ + Mend_; } \
            m_run = g_ + Mend_; } while (0)
        if (w == 0) G1_TABLES(L + TAB);
        __syncthreads();
        bf16x8 qf[8];
        v4u kreg[4]; v4u vreg;
#define LOAD_KV(c) do { _Pragma("unroll") for (int r_ = 0; r_ < 4; ++r_) { const int i_ = tid + NTHR * r_, s_ = i_ >> 5, c16_ = i_ & 31; \
                kreg[r_] = *(const v4u*)(K + (rowbase + TOF(c, s_)) * DM + h * 256 + c16_ * 8); } \
            { const int s_ = tid & 63, e8_ = tid >> 6; vreg = *(const v4u*)(V + (rowbase + TOF(c, s_)) * DM + h * 256 + es * 64 + e8_ * 8); } } while (0)
#define STORE_KV(setidx) do { _Pragma("unroll") for (int r_ = 0; r_ < 4; ++r_) { const int i_ = tid + NTHR * r_, s_ = i_ >> 5, c16_ = i_ & 31; \
                *(LAS v4u*)(L + KS + s_ * KST + c16_ * 16) = kreg[r_]; } \
            { const int s_ = tid & 63, e8_ = tid >> 6; const float ws_ = ((const LAS float*)(L + TAB + (setidx) * TABSZ))[256 + s_]; \
              LAS bf16* vt_ = (LAS bf16*)(L + VT + (setidx) * 9216); LAS bf16* vw_ = (LAS bf16*)(L + VWT + (setidx) * 9216); \
              const unsigned wv_[4] = {vreg.x, vreg.y, vreg.z, vreg.w}; \
              _Pragma("unroll") for (int j_ = 0; j_ < 4; ++j_) { const float lo_ = bflo(wv_[j_]), hi_ = bfhi(wv_[j_]); const int e_ = e8_ * 8 + 2 * j_; \
                vt_[e_ * 72 + s_] = (bf16)(wv_[j_] & 0xffffu); vt_[(e_ + 1) * 72 + s_] = (bf16)(wv_[j_] >> 16); \
                vw_[e_ * 72 + s_] = (bf16)f2bf(lo_ * ws_); vw_[(e_ + 1) * 72 + s_] = (bf16)f2bf(hi_ * ws_); } } } while (0)
#define LOAD_Q(c) do { const size_t m_ = rowbase + TOF(c, 16 * pt + fr); _Pragma("unroll") for (int ks_ = 0; ks_ < 8; ++ks_) \
                qf[ks_] = *(const bf16x8*)(Q + m_ * DM + h * 256 + 32 * ks_ + 8 * fq); } while (0)
        LOAD_KV(0); LOAD_Q(0);
        STORE_KV(0);
        f32x4 Cacc[8];
#pragma unroll
        for (int i = 0; i < 8; ++i) Cacc[i] = (f32x4){0.f, 0.f, 0.f, 0.f};
        __syncthreads();
        for (int c = 0; c < 64; ++c) {
            const int cur = c & 1, nxt = cur ^ 1;
            const bool has_next = (c + 1 < 64);
            const LAS float* T = (const LAS float*)(L + TAB + cur * TABSZ);
            if (has_next) { LOAD_KV(c + 1); if (w == 0) { const size_t m = rowbase + TOF(c + 1, lane); gi_n = GT[m * 16 + dir * 8 + h]; gf_n = GT[m * 16 + dir * 8 + 4 + h]; } }
            const int p = 16 * pt + fr;
            const float Mp = T[64 + p], wi_p = T[128 + p];
            float cs = 0.f;
#pragma unroll
            for (int i = 0; i < 2; ++i) { const int st = 2 * wg + i;
                v2u pw = {0u, 0u};
                if (st <= pt) {
                    f32x4 sa = (f32x4){0.f, 0.f, 0.f, 0.f};
#pragma unroll
                    for (int ks = 0; ks < 8; ++ks) { const bf16x8 kf = *(const LAS bf16x8*)(L + KS + (16 * st + fr) * KST + (32 * ks + 8 * fq) * 2);
                        sa = __builtin_amdgcn_mfma_f32_16x16x32_bf16(kf, qf[ks], sa, 0, 0, 0); }
                    const f32x4 a4 = *(const LAS f32x4*)(T + 16 * st + 4 * fq);
                    float pv[4];
#pragma unroll
                    for (int r = 0; r < 4; ++r) { const int s_ = 16 * st + 4 * fq + r; const float wgt = (s_ <= p) ? __expf(a4[r] - Mp) : 0.f; pv[r] = sa[r] * wgt; cs += pv[r]; }
                    pw.x = pk2(pv[0], pv[1]); pw.y = pk2(pv[2], pv[3]);
                }
                *(LAS v2u*)(L + PB + p * VST + (16 * st + 4 * fq) * 2) = pw; }
            f32x4 O[2];
#pragma unroll
            for (int i = 0; i < 2; ++i) { const int et = 2 * wg + i; O[i] = (f32x4){0.f, 0.f, 0.f, 0.f};
#pragma unroll
                for (int ks = 0; ks < 8; ++ks) { const bf16x8 cf = *(const LAS bf16x8*)(L + CTI + (16 * et + fr) * KST + (32 * ks + 8 * fq) * 2);
                    O[i] = __builtin_amdgcn_mfma_f32_16x16x32_bf16(cf, qf[ks], O[i], 0, 0, 0); } }
            float di = 0.f;
#define DEN_INTER(ks) do { const f32x4 n0 = *(const LAS f32x4*)(L + NT + (32 * (ks) + 8 * fq) * 4), n1 = *(const LAS f32x4*)(L + NT + (32 * (ks) + 8 * fq) * 4 + 16); \
                const v4u qw = __builtin_bit_cast(v4u, qf[ks]); \
                di += bflo(qw.x) * n0[0] + bfhi(qw.x) * n0[1] + bflo(qw.y) * n0[2] + bfhi(qw.y) * n0[3] + bflo(qw.z) * n1[0] + bfhi(qw.z) * n1[1] + bflo(qw.w) * n1[2] + bfhi(qw.w) * n1[3]; } while (0)
            if (wg == 0) { DEN_INTER(0); DEN_INTER(1); DEN_INTER(2); DEN_INTER(3); }
            else { DEN_INTER(4); DEN_INTER(5); DEN_INTER(6); DEN_INTER(7); }
#undef DEN_INTER
            di += __shfl_xor(di, 16); di += __shfl_xor(di, 32);
            cs += __shfl_xor(cs, 16); cs += __shfl_xor(cs, 32);
            if (fq == 0) ((LAS float*)(L + DENT))[wg * 64 + p] = wi_p * di + cs;
            if (has_next) LOAD_Q(c + 1);
            if (has_next && w == 0) G1_TABLES(L + TAB + nxt * TABSZ);
            __syncthreads();
#pragma unroll
            for (int i = 0; i < 2; ++i) { const int et = 2 * wg + i; O[i] = O[i] * wi_p;
#pragma unroll
                for (int ks = 0; ks < 2; ++ks) { const bf16x8 vf = *(const LAS bf16x8*)(L + VT + cur * 9216 + (16 * et + fr) * VST + (32 * ks + 8 * fq) * 2);
                    const bf16x8 pf = *(const LAS bf16x8*)(L + PB + p * VST + (32 * ks + 8 * fq) * 2);
                    O[i] = __builtin_amdgcn_mfma_f32_16x16x32_bf16(vf, pf, O[i], 0, 0, 0); } }
            { const float den = ((const LAS float*)(L + DENT))[p] + ((const LAS float*)(L + DENT))[64 + p];
              const float inv = 1.f / fmaxf(fabsf(den), T[192 + p]);
              const size_t m = rowbase + TOF(c, p);
#pragma unroll
              for (int i = 0; i < 2; ++i) { const int et = 2 * wg + i; v2u o; o.x = pk2(O[i][0] * inv, O[i][1] * inv); o.y = pk2(O[i][2] * inv, O[i][3] * inv);
                  *(v2u*)(H + m * DM + h * 256 + es * 64 + 16 * et + 4 * fq) = o; } }
            { const float decay = T[320];
              const bf16x8 vw0 = *(const LAS bf16x8*)(L + VWT + cur * 9216 + (16 * pt + fr) * VST + (8 * fq) * 2);
              const bf16x8 vw1 = *(const LAS bf16x8*)(L + VWT + cur * 9216 + (16 * pt + fr) * VST + (32 + 8 * fq) * 2);
              const int l16 = lane & 15, q4 = l16 >> 2, p4 = l16 & 3;
              const unsigned kb = (unsigned)(uintptr_t)(L + KS) + (unsigned)((8 * fq + q4) * KST + 4 * p4 * 2);
#pragma unroll
              for (int dtl = 0; dtl < 8; dtl += 2) { const int dt = 8 * wg + dtl; const unsigned a0 = kb + dt * 32;
                  s16x4 r0, r1, r2, r3, r4, r5, r6, r7;
                  asm volatile("ds_read_b64_tr_b16 %0, %8\n\tds_read_b64_tr_b16 %1, %8 offset:2112\n\tds_read_b64_tr_b16 %2, %8 offset:16896\n\tds_read_b64_tr_b16 %3, %8 offset:19008\n\t"
                               "ds_read_b64_tr_b16 %4, %8 offset:32\n\tds_read_b64_tr_b16 %5, %8 offset:2144\n\tds_read_b64_tr_b16 %6, %8 offset:16928\n\tds_read_b64_tr_b16 %7, %8 offset:19040\n\ts_waitcnt lgkmcnt(0)"
                               : "=&v"(r0), "=&v"(r1), "=&v"(r2), "=&v"(r3), "=&v"(r4), "=&v"(r5), "=&v"(r6), "=&v"(r7) : "v"(a0) : "memory");
                  const bf16x8 k0 = __builtin_shufflevector(r0, r1, 0, 1, 2, 3, 4, 5, 6, 7), k1 = __builtin_shufflevector(r2, r3, 0, 1, 2, 3, 4, 5, 6, 7);
                  const bf16x8 k2 = __builtin_shufflevector(r4, r5, 0, 1, 2, 3, 4, 5, 6, 7), k3 = __builtin_shufflevector(r6, r7, 0, 1, 2, 3, 4, 5, 6, 7);
                  Cacc[dtl] = Cacc[dtl] * decay; Cacc[dtl + 1] = Cacc[dtl + 1] * decay;
                  Cacc[dtl] = __builtin_amdgcn_mfma_f32_16x16x32_bf16(k0, vw0, Cacc[dtl], 0, 0, 0);
                  Cacc[dtl + 1] = __builtin_amdgcn_mfma_f32_16x16x32_bf16(k2, vw0, Cacc[dtl + 1], 0, 0, 0);
                  Cacc[dtl] = __builtin_amdgcn_mfma_f32_16x16x32_bf16(k1, vw1, Cacc[dtl], 0, 0, 0);
                  Cacc[dtl + 1] = __builtin_amdgcn_mfma_f32_16x16x32_bf16(k3, vw1, Cacc[dtl + 1], 0, 0, 0); } }
            { const int d = tid & 255, hf2 = tid >> 8; float np = 0.f;
#pragma unroll 8
              for (int s2 = 0; s2 < 32; ++s2) { const int s_ = hf2 * 32 + s2; np += T[256 + s_] * bf2f(*(const LAS bf16*)(L + KS + s_ * KST + d * 2)); }
              ((LAS float*)(L + NPART))[hf2 * 256 + d] = np; }
            __syncthreads();
            { const float decay = T[320];
#pragma unroll
              for (int dtl = 0; dtl < 8; ++dtl) { const int dt = 8 * wg + dtl; v2u o; o.x = pk2(Cacc[dtl][0], Cacc[dtl][1]); o.y = pk2(Cacc[dtl][2], Cacc[dtl][3]);
                  *(LAS v2u*)(L + CTI + (16 * pt + fr) * KST + (16 * dt + 4 * fq) * 2) = o; }
              if (tid < 256) { LAS float* nt = (LAS float*)(L + NT); const LAS float* np = (const LAS float*)(L + NPART); nt[tid] = decay * nt[tid] + np[tid] + np[256 + tid]; } }
            if (has_next) STORE_KV(nxt);
            __syncthreads();
        }
#undef TOF
#undef G1_TABLES
#undef LOAD_KV
#undef STORE_KV
#undef LOAD_Q
    }
}

__device__ __forceinline__ void ym_phase(Frame& F) {
    const bf16* HF = (const bf16*)(F.ws + WS_XM); const bf16* HB = (const bf16*)F.out + (size_t)MTOK * DM; bf16* OP = (bf16*)(F.ws + WS_OP);
    const float* ng = F.in[9];
    const int gw = F.bid * NWAVES + F.wave, NGW = F.G * NWAVES;
    for (int m = gw; m < MTOK; m += NGW) {
#pragma unroll
        for (int hd = 0; hd < 4; ++hd) {
            const size_t o = (size_t)m * DM + hd * 256 + F.lane * 4;
            const v2u a = *(const v2u*)(HF + o), b = *(const v2u*)(HB + o), op = *(const v2u*)(OP + o);
            const float v0 = bflo(a.x) + bflo(b.x), v1 = bfhi(a.x) + bfhi(b.x), v2 = bflo(a.y) + bflo(b.y), v3 = bfhi(a.y) + bfhi(b.y);
            const float r = rsqrtf(wave_sum((v0 * v0 + v1 * v1) + (v2 * v2 + v3 * v3)) * (1.f / 256.f) + EPS);
            const f32x4 g = *(const f32x4*)(ng + hd * 256 + F.lane * 4);
            v2u w; w.x = pk2(sigmoidf_(bflo(op.x)) * v0 * r * g[0], sigmoidf_(bfhi(op.x)) * v1 * r * g[1]);
            w.y = pk2(sigmoidf_(bflo(op.y)) * v2 * r * g[2], sigmoidf_(bfhi(op.y)) * v3 * r * g[3]);
            *(v2u*)(OP + o) = w;
        }
    }
    {
        float* usc = (float*)(F.ws + WS_LG + 16 * MiB); float* vsc = usc + NEXP;
        for (int row = gw; row < 2 * NEXP; row += NGW) {
            const bool isv = row >= NEXP; const int r = isv ? row - NEXP : row;
            const f32x4* src = (const f32x4*)(F.in[isv ? 24 : 23] + (size_t)r * DM) + F.lane * 4;
            f32x4 a[4]; float ss = 0.f;
#pragma unroll
            for (int j = 0; j < 4; ++j) { a[j] = src[j]; ss += (a[j][0] * a[j][0] + a[j][1] * a[j][1]) + (a[j][2] * a[j][2] + a[j][3] * a[j][3]); }
            const float rms = sqrtf(wave_sum(ss) * (1.f / DM));
            const float sc = fmaxf(rms * 0.5f, 1e-30f), inv = 1.f / sc;
            unsigned o[2] = {0u, 0u};
#pragma unroll
            for (int j = 0; j < 4; ++j) { const f32x4 q = a[j] * inv;
                if (j & 1) { o[j >> 1] = __builtin_amdgcn_cvt_scalef32_pk_fp4_f32(o[j >> 1], q[0], q[1], 1.0f, 2); o[j >> 1] = __builtin_amdgcn_cvt_scalef32_pk_fp4_f32(o[j >> 1], q[2], q[3], 1.0f, 3); }
                else       { o[j >> 1] = __builtin_amdgcn_cvt_scalef32_pk_fp4_f32(o[j >> 1], q[0], q[1], 1.0f, 0); o[j >> 1] = __builtin_amdgcn_cvt_scalef32_pk_fp4_f32(o[j >> 1], q[2], q[3], 1.0f, 1); } }
            *(v2u*)(F.ws + WS_LG + (isv ? 8 * MiB : 0) + (size_t)r * (DM / 2) + F.lane * 8) = (v2u){o[0], o[1]};
            if (F.lane == 0) (isv ? vsc : usc)[r] = sc;
        }
    }
}

typedef float f32x16 __attribute__((ext_vector_type(16)));
#define TOPK_INSERT(L, xv) do { const float x_ = (xv); \
    L[15] = __builtin_amdgcn_fmed3f(L[14], L[15], x_); L[14] = __builtin_amdgcn_fmed3f(L[13], L[14], x_); L[13] = __builtin_amdgcn_fmed3f(L[12], L[13], x_); L[12] = __builtin_amdgcn_fmed3f(L[11], L[12], x_); \
    L[11] = __builtin_amdgcn_fmed3f(L[10], L[11], x_); L[10] = __builtin_amdgcn_fmed3f(L[9], L[10], x_); L[9] = __builtin_amdgcn_fmed3f(L[8], L[9], x_); L[8] = __builtin_amdgcn_fmed3f(L[7], L[8], x_); \
    L[7] = __builtin_amdgcn_fmed3f(L[6], L[7], x_); L[6] = __builtin_amdgcn_fmed3f(L[5], L[6], x_); L[5] = __builtin_amdgcn_fmed3f(L[4], L[5], x_); L[4] = __builtin_amdgcn_fmed3f(L[3], L[4], x_); \
    L[3] = __builtin_amdgcn_fmed3f(L[2], L[3], x_); L[2] = __builtin_amdgcn_fmed3f(L[1], L[2], x_); L[1] = __builtin_amdgcn_fmed3f(L[0], L[1], x_); L[0] = fmaxf(L[0], x_); } while (0)
template <int I> struct CandRow {
    static __device__ __forceinline__ void run(const float (&L0)[16], const float (&L1)[16], float (&R)[16]) {
        constexpr int NJ = 16 / (I + 1);
#pragma unroll
        for (int j = 0; j < NJ; ++j) { const float sm = L0[I] + L1[j];
            const float pk = __builtin_bit_cast(float, (__builtin_bit_cast(unsigned, sm) & 0xffffff00u) | (unsigned)(I * 16 + j)); TOPK_INSERT(R, pk); }
        if constexpr (I < 15) CandRow<I + 1>::run(L0, L1, R);
    }
};
__device__ __forceinline__ unsigned pick4(unsigned d0, unsigned d1, unsigned d2, unsigned d3, int i) {
    const int q = i >> 2; unsigned d = d0; d = (q == 1) ? d1 : d; d = (q == 2) ? d2 : d; d = (q == 3) ? d3 : d; return (d >> (8 * (i & 3))) & 127u;
}
__device__ __forceinline__ void select_phase(Frame& F) {
    const bf16* PQ = (const bf16*)(F.ws + WS_MG); const bf16* KEYS = (const bf16*)(F.ws + WS_KEYS);
    int* IDX = (int*)(F.ws + WS_K); float* GW = (float*)(F.ws + WS_K + 16 * MiB);
    LAS unsigned char* L = F.lds;
    const int tid = F.tid, lane = F.lane, w = F.wave, l31 = lane & 31, hh = lane >> 5;
    const float NEG_INF = -INFINITY;
    for (int grp = F.bid; grp < MTOK / 128; grp += F.G) {
        const int tb = grp * 4 + (w & 3);
        const size_t m = (size_t)tb * 32 + l31;
        for (int hp = 0; hp < 4; ++hp) {
            __syncthreads();
#pragma unroll 4
            for (int r = 0; r < 16; ++r) { const int e = tid + NTHR * r, R = e >> 4, c = e & 15;
                *(LAS v4u*)(L + R * 256 + ((c ^ (R & 15)) * 16)) = *(const v4u*)(KEYS + ((size_t)(hp * 512 + R) * 128 + c * 8)); }
            __syncthreads();
            const int hl = w >> 2, h = 2 * hp + hl;
            float L0[16], L1[16];
#pragma unroll
            for (int p = 0; p < 2; ++p) {
                bf16x8 qf[8];
#pragma unroll
                for (int ks = 0; ks < 8; ++ks) qf[ks] = *(const bf16x8*)(PQ + m * 2048 + h * 256 + p * 128 + 16 * ks + 8 * hh);
                f32x16 acc[4];
#pragma unroll
                for (int kb = 0; kb < 4; ++kb)
#pragma unroll
                    for (int r = 0; r < 16; ++r) acc[kb][r] = 0.f;
#pragma unroll
                for (int ks = 0; ks < 8; ++ks)
#pragma unroll
                    for (int kb = 0; kb < 4; ++kb) { const int R = (hl * 2 + p) * 128 + 32 * kb + l31;
                        const bf16x8 kf = *(const LAS bf16x8*)(L + R * 256 + (((2 * ks + hh) ^ (lane & 15)) * 16));
                        acc[kb] = __builtin_amdgcn_mfma_f32_32x32x16_bf16(kf, qf[ks], acc[kb], 0, 0, 0); }
                float Lc[16];
#pragma unroll
                for (int i = 0; i < 16; ++i) Lc[i] = NEG_INF;
                const unsigned hh4 = (unsigned)hh << 2;
#pragma unroll
                for (int kb = 0; kb < 4; ++kb)
#pragma unroll
                    for (int r = 0; r < 16; ++r) { const unsigned nlo = (unsigned)(32 * kb + (r & 3) + 8 * (r >> 2));
                        const float av_ = acc[kb][r];
                        const float pk = __uint_as_float(((__float_as_uint(av_) & 0xffffff80u) | hh4) | nlo); TOPK_INSERT(Lc, pk); }
                float Lo[16];
#pragma unroll
                for (int i = 0; i < 16; ++i) Lo[i] = __shfl_xor(Lc[i], 32);
#pragma unroll
                for (int i = 0; i < 16; ++i) TOPK_INSERT(Lc, Lo[i]);
#pragma unroll
                for (int i = 0; i < 16; ++i) { if (p == 0) L0[i] = Lc[i]; else L1[i] = Lc[i]; }
            }
            float R[16];
#pragma unroll
            for (int i = 0; i < 16; ++i) R[i] = NEG_INF;
            CandRow<0>::run(L0, L1, R);
            unsigned a0 = 0, a1 = 0, a2 = 0, a3 = 0, b0 = 0, b1 = 0, b2 = 0, b3 = 0;
#pragma unroll
            for (int i = 0; i < 4; ++i) { a0 |= (__builtin_bit_cast(unsigned, L0[i]) & 127u) << (8 * i); a1 |= (__builtin_bit_cast(unsigned, L0[4 + i]) & 127u) << (8 * i);
                a2 |= (__builtin_bit_cast(unsigned, L0[8 + i]) & 127u) << (8 * i); a3 |= (__builtin_bit_cast(unsigned, L0[12 + i]) & 127u) << (8 * i);
                b0 |= (__builtin_bit_cast(unsigned, L1[i]) & 127u) << (8 * i); b1 |= (__builtin_bit_cast(unsigned, L1[4 + i]) & 127u) << (8 * i);
                b2 |= (__builtin_bit_cast(unsigned, L1[8 + i]) & 127u) << (8 * i); b3 |= (__builtin_bit_cast(unsigned, L1[12 + i]) & 127u) << (8 * i); }
            float ex[16]; float sum = 0.f; int id[16];
#pragma unroll
            for (int r = 0; r < 16; ++r) { ex[r] = __expf(R[r] - R[0]); sum += ex[r];
                const unsigned cid = __builtin_bit_cast(unsigned, R[r]) & 255u;
                id[r] = (int)(pick4(a0, a1, a2, a3, (int)(cid >> 4)) * 128u + pick4(b0, b1, b2, b3, (int)(cid & 15u))); }
            const float inv = 1.f / sum;
            if (hh == 0) {
#pragma unroll
                for (int q = 0; q < 4; ++q) {
                    *(int4*)(IDX + m * 128 + h * 16 + 4 * q) = make_int4(id[4 * q], id[4 * q + 1], id[4 * q + 2], id[4 * q + 3]);
                    *(f32x4*)(GW + m * 128 + h * 16 + 4 * q) = (f32x4){ex[4 * q] * inv, ex[4 * q + 1] * inv, ex[4 * q + 2] * inv, ex[4 * q + 3] * inv}; }
            }
        }
    }
}

template <int B> __device__ __forceinline__ f32x2 fp4b(unsigned w) { return __builtin_amdgcn_cvt_scalef32_pk_f32_fp4(w, 1.0f, B); }
typedef int v8i_t __attribute__((ext_vector_type(8)));
#define AP_SLOT(e) (4 * (((e) >> 1) & 3) + 2 * ((e) >> 3) + ((e) & 1))
__device__ __forceinline__ void apply_phase(Frame& F, float* OUTP) {
    const unsigned char* U8 = F.ws + WS_LG; const unsigned char* V8 = F.ws + WS_LG + 8 * MiB;
    const float* USC = (const float*)(F.ws + WS_LG + 16 * MiB); const float* VSC = USC + NEXP;
    const int* IDX = (const int*)(F.ws + WS_K); const float* GW = (const float*)(F.ws + WS_K + 16 * MiB);
    const float* g2 = F.in[20]; const float* gf = F.in[25];
    const float* X1 = F.out;
    const int lane = F.lane, fr = lane & 15, fq = lane >> 4;
    constexpr int APW = 2 * 16 * 528 + 1024;
    LAS unsigned char* UL = F.lds + F.wave * APW; LAS unsigned char* VL = UL + 16 * 528; LAS unsigned char* H8 = VL + 16 * 528;
    const int pe = 2 * fq + (fr & 1) + 8 * ((fr >> 1) & 1);
    const int bsh = 8 * (fr & 3); const unsigned mlo = fr < 4 ? ~0u : 0u, mhi = (fr >= 4 && fr < 8) ? ~0u : 0u;
#define AP_LOADROWS(SEL, KB) _Pragma("unroll") for (int e = 0; e < 16; ++e) { \
        const size_t ro = (size_t)__builtin_amdgcn_readlane(SEL, ((KB) + e) & 63) * (DM / 2) + lane * 8; uu[e] = *(const v2u*)(U8 + ro); vv[e] = *(const v2u*)(V8 + ro); }
    for (int grp = F.bid; grp < MTOK / 128; grp += F.G) {
        const int mbase = grp * 128 + F.wave;
        int ni0 = IDX[(size_t)mbase * 128 + lane], ni1 = IDX[(size_t)mbase * 128 + 64 + lane];
        float ngw0 = GW[(size_t)mbase * 128 + lane], ngw1 = GW[(size_t)mbase * 128 + 64 + lane];
        f32x4 nxr[4];
#pragma unroll
        for (int q = 0; q < 4; ++q) nxr[q] = *(const f32x4*)(X1 + (size_t)mbase * DM + lane * 16 + q * 4);
        v2u uu[16], vv[16];
        AP_LOADROWS(ni0, 0)
        int i0 = 0, i1 = 0; float gw0 = 0.f, gw1 = 0.f; f32x4 xr[4], oacc[8];
#pragma unroll
        for (int q = 0; q < 4; ++q) xr[q] = (f32x4){0.f, 0.f, 0.f, 0.f};
#pragma unroll
        for (int i = 0; i < 8; ++i) oacc[i] = (f32x4){0.f, 0.f, 0.f, 0.f};
#pragma unroll 1
        for (int it = 0; it < 128; ++it) {
            const int bt = it & 7, m = mbase + 8 * (it >> 3);
            if (bt == 0) {
                i0 = ni0; i1 = ni1; gw0 = ngw0; gw1 = ngw1; float s = 0.f;
#pragma unroll
                for (int q = 0; q < 4; ++q) { xr[q] = nxr[q]; s += (xr[q][0] * xr[q][0] + xr[q][1] * xr[q][1]) + (xr[q][2] * xr[q][2] + xr[q][3] * xr[q][3]); }
                const float r2 = rsqrtf(wave_sum(s) * (1.f / DM) + EPS);
                v4u h8;
#pragma unroll
                for (int q = 0; q < 4; ++q) { const f32x4 g = *(const f32x4*)(g2 + lane * 16 + q * 4); const f32x4 hq = xr[q] * r2 * g;
                    int pk = 0; pk = __builtin_amdgcn_cvt_pk_fp8_f32(hq[0], hq[1], pk, false); pk = __builtin_amdgcn_cvt_pk_fp8_f32(hq[2], hq[3], pk, true); h8[q] = (unsigned)pk; }
                *(LAS v4u*)(H8 + lane * 16) = h8;
#pragma unroll
                for (int i = 0; i < 8; ++i) oacc[i] = (f32x4){0.f, 0.f, 0.f, 0.f};
                const int mn = (it + 8 < 128) ? m + 8 : m;
                ni0 = IDX[(size_t)mn * 128 + lane]; ni1 = IDX[(size_t)mn * 128 + 64 + lane]; ngw0 = GW[(size_t)mn * 128 + lane]; ngw1 = GW[(size_t)mn * 128 + 64 + lane];
#pragma unroll
                for (int q = 0; q < 4; ++q) nxr[q] = *(const f32x4*)(X1 + (size_t)mn * DM + lane * 16 + q * 4);
            }
            const int k0 = bt * 16;
            const int isel = (k0 < 64) ? i0 : i1;
            const int myidx = __shfl(isel, (k0 + pe) & 63);
            const float su = USC[myidx], sv = VSC[myidx];
#pragma unroll
            for (int e = 0; e < 16; ++e) { *(LAS v2u*)(UL + AP_SLOT(e) * 528 + lane * 8) = uu[e]; *(LAS v2u*)(VL + e * 528 + lane * 8) = vv[e]; }
            { const int nk = (k0 + 16) & 127; const int nsel = (bt == 7) ? ni0 : ((nk < 64) ? i0 : i1);
              AP_LOADROWS(nsel, nk) }
            f32x4 da = (f32x4){0.f, 0.f, 0.f, 0.f}, db = (f32x4){0.f, 0.f, 0.f, 0.f};
#pragma unroll
            for (int ks = 0; ks < 8; ++ks) {
                const v4u af = *(const LAS v4u*)(UL + fr * 528 + 64 * ks + 16 * fq);
                const v4u b0 = *(const LAS v4u*)(H8 + 128 * ks + 16 * fq), b1 = *(const LAS v4u*)(H8 + 128 * ks + 64 + 16 * fq);
                const v8i_t A = {(int)af.x, (int)af.y, (int)af.z, (int)af.w, 0, 0, 0, 0};
                const v8i_t B = {(int)b0.x, (int)b0.y, (int)b0.z, (int)b0.w, (int)b1.x, (int)b1.y, (int)b1.z, (int)b1.w};
                if (ks & 1) db = __builtin_amdgcn_mfma_scale_f32_16x16x128_f8f6f4(A, B, db, 4  , 0  , 0, 0x7F7F7F7F, 0, 0x7F7F7F7F);
                else        da = __builtin_amdgcn_mfma_scale_f32_16x16x128_f8f6f4(A, B, da, 4, 0, 0, 0x7F7F7F7F, 0, 0x7F7F7F7F);
            }
            const f32x4 d4 = da + db;
            const int sel = fr & 3;
            float t = d4[0]; t = (sel == 1) ? d4[1] : t; t = (sel == 2) ? d4[2] : t; t = (sel == 3) ? d4[3] : t;
            const float gk = __shfl((k0 < 64) ? gw0 : gw1, (k0 + pe) & 63);
            const float wl = gk * gelu_fast(t * su) * sv;
            float wm = fabsf(wl); wm = fmaxf(wm, __shfl_xor(wm, 1)); wm = fmaxf(wm, __shfl_xor(wm, 2)); wm = fmaxf(wm, __shfl_xor(wm, 16)); wm = fmaxf(wm, __shfl_xor(wm, 32));
            int E = (int)(__float_as_uint(wm) >> 23); E = E < 8 ? 8 : E;
            const float wq = wl * __uint_as_float((unsigned)(261 - E) << 23);
            const int scb = (E - 7) * 0x01010101;
            v8i_t Bw;
#define AP_WQ(tq, ctrl) { const float wt = __builtin_bit_cast(float, __builtin_amdgcn_update_dpp(0, __builtin_bit_cast(int, wq), ctrl, 0xf, 0xf, false)); \
                const unsigned p8 = (unsigned)__builtin_amdgcn_cvt_pk_fp8_f32(wt, 0.f, 0, false) << bsh; Bw[2 * tq] = (int)(p8 & mlo); Bw[2 * tq + 1] = (int)(p8 & mhi); }
            AP_WQ(0, 0x00) AP_WQ(1, 0x55) AP_WQ(2, 0xAA) AP_WQ(3, 0xFF)
#pragma unroll
            for (int c = 0; c < 8; ++c) {
                v4u av;
                av.x = *(const LAS unsigned*)(VL + (4 * fq + 0) * 528 + 64 * c + 4 * fr); av.y = *(const LAS unsigned*)(VL + (4 * fq + 1) * 528 + 64 * c + 4 * fr);
                av.z = *(const LAS unsigned*)(VL + (4 * fq + 2) * 528 + 64 * c + 4 * fr); av.w = *(const LAS unsigned*)(VL + (4 * fq + 3) * 528 + 64 * c + 4 * fr);
                const v8i_t A = {(int)av.x, (int)av.y, (int)av.z, (int)av.w, 0, 0, 0, 0};
                oacc[c] = __builtin_amdgcn_mfma_scale_f32_16x16x128_f8f6f4(A, Bw, oacc[c], 4, 0, 0, 0x7F7F7F7F, 0, scb);
            }
            if (bt == 7) {
                if (fr < 8) {
#pragma unroll
                    for (int c = 0; c < 8; ++c)
#pragma unroll
                        for (int r = 0; r < 4; ++r) { const float o = oacc[c][r]; *(LAS unsigned*)(UL + 4 * ((4 * c + fq) * 40 + 8 * r + fr)) = __float_as_uint(o); }
                }
                float s2 = 0.f; f32x4 ov[4];
#pragma unroll
                for (int q = 0; q < 4; ++q) { const v4u ou = *(const LAS v4u*)(UL + 4 * ((lane >> 1) * 40 + (lane & 1) * 16 + 4 * q));
                    ov[q] = (f32x4){__uint_as_float(ou.x), __uint_as_float(ou.y), __uint_as_float(ou.z), __uint_as_float(ou.w)} + xr[q];
                    s2 += (ov[q][0] * ov[q][0] + ov[q][1] * ov[q][1]) + (ov[q][2] * ov[q][2] + ov[q][3] * ov[q][3]); }
                const float rf = rsqrtf(wave_sum(s2) * (1.f / DM) + EPS);
#pragma unroll
                for (int q = 0; q < 4; ++q) { const f32x4 g = *(const f32x4*)(gf + lane * 16 + q * 4);
                    *(f32x4*)(OUTP + (size_t)m * DM + lane * 16 + q * 4) = ov[q] * rf * g; }
            }
        }
    }
}

constexpr int N_PHASES = 13;
__global__ void __launch_bounds__(NTHR, 2) mega_fwd(Args args) {
    extern __shared__ __attribute__((aligned(16))) unsigned char lds[];
    Frame F;
    F.lds = (LAS unsigned char*)lds;
    F.tid = threadIdx.x; F.lane = F.tid & 63; F.wave = __builtin_amdgcn_readfirstlane(F.tid >> 6);
    F.G = gridDim.x; F.bid = blockIdx.x;
    F.in = args.in; F.out = args.out; F.ws = args.ws;
    volatile LAS unsigned* MISC = (volatile LAS unsigned*)(F.lds + MISC_OFF);
    for (int u = F.tid; u < (LDS_BYTES - LDSCTL_OFF) / 4; u += NTHR) ((LAS unsigned*)(F.lds + LDSCTL_OFF))[u] = 0u;
    __syncthreads();
    XcdBarrier bar; bar.bar = (unsigned*)(args.ws + WS_CTL) + CW_BAR; bar.x = 0; bar.st = nullptr;
    const bool one_launch = (args.ph_hi - args.ph_lo) > 1;
    if (one_launch) bar = xcd_barrier_post((unsigned*)(args.ws + WS_CTL) + CW_BAR, MISC + 8);
    const int lo = args.ph_lo, hi = args.ph_hi;
#define IN(k) (lo <= (k) && (k) < hi)
#define SEAM(k) do { if (IN(k) && IN((k) + 1)) xcd_barrier(bar); } while (0)
    unsigned char* ws = args.ws;

#ifndef PROBE_MASK
#define PROBE_MASK 0
#endif
#define REP(k) _Pragma("unroll") for (int rep_ = 0; rep_ < (((PROBE_MASK >> (k)) & 1) ? 2 : 1); ++rep_)
    if (IN(0)) REP(0) { p0_prologue(F); if (rep_ == 0 && ((PROBE_MASK >> 0) & 1)) xcd_barrier(bar); } SEAM(0);
    if (IN(1)) REP(1) {
        gates_phase(F);
        { AddrP1 g{(const char*)(ws + WS_K), (const char*)(ws + WS_WIN), 1024, 1024, 1024, 4, 0, 8};
          pg8::StaticOrder S; S.init(MTOK, 2048, F.G, F.bid, 4);
          EpiBf16<DstP1> E{DstP1{ws, 4, 0, 8}, 1.f};
          pg8::gemm_phase(F.lds, g, S, E); }
        { AddrP1 g{(const char*)F.out, (const char*)(ws + WS_WIN8), 512, 512, 512, 8, 4, 8};
          pg8::StaticOrder S; S.init(MTOK, 4096, F.G, F.bid, 4);
          EpiBf16<DstP1, true> E{DstP1{ws, 8, 4, 8}, 1.f / 1024.f};
          pg8::gemm_phase<EpiBf16<DstP1, true>, AddrP1, 1>(F.lds, g, S, E); }
    } SEAM(1);
    if (IN(2)) REP(2) { lru_phase<false>(F); } SEAM(2);
    if (IN(3)) REP(3) { lru_phase<true>(F); } SEAM(3);
    if (IN(4)) REP(4) { mconv_phase(F); } SEAM(4);
    if (IN(5)) REP(5) {
        const char* xc = (const char*)F.out + (size_t)MTOK * DM * 2;
        AddrQKV g{xc, (long)((const char*)(ws + WS_XM) - xc), (const char*)(ws + WS_WQKV), 1024, 256, 256};
        pg8::StaticOrder S; S.init(MTOK, 12 * 256, F.G, F.bid);
        EpiBf16<DstQKV> E{DstQKV{(char*)(ws + WS_LG), (long)WS_K - (long)WS_LG, (long)WS_XL - (long)WS_LG}, 1.f};
        pg8::gemm_phase(F.lds, g, S, E);
    } SEAM(5);
    if (IN(6)) REP(6) { mscan_phase(F); } SEAM(6);
    if (IN(7)) { ym_phase(F); } SEAM(7);
    if (IN(8)) {
        pg8::StaticOrder S; S.init(MTOK, 1024, F.G, F.bid);
        { AddrPlain g{(const char*)(ws + WS_OP), (const char*)(ws + WS_WB2), 1024, 1024, 1024};
          EpiMerge<false> E{(bf16*)(ws + WS_XM), (const bf16*)(ws + WS_MG), 0}; pg8::gemm_phase(F.lds, g, S, E); }
        { AddrPlain g{(const char*)F.out, (const char*)(ws + WS_WB2) + (size_t)1024 * 1024 * 2, 1024, 1024, 1024};
          EpiMerge<true> E{(bf16*)(ws + WS_XM), (const bf16*)(ws + WS_MG), 1024}; pg8::gemm_phase(F.lds, g, S, E); }
    } SEAM(8);
    if (IN(9)) {
        AddrPlain g{(const char*)(ws + WS_XM), (const char*)(ws + WS_WOUT2), 1024, 2048, 1024};
        pg8::StaticOrder S; S.init(MTOK, 1024, F.G, F.bid);
        EpiResid E{F.in[0], F.out, (bf16*)(ws + WS_XL), (float*)(ws + WS_SS)};
        pg8::gemm_phase(F.lds, g, S, E);
    } SEAM(9);
    if (IN(10)) REP(10) {
        AddrPlain g{(const char*)(ws + WS_XL), (const char*)(ws + WS_WPQ), 1024, 1024, 1024};
        pg8::StaticOrder S; S.init(MTOK, 2048, F.G, F.bid, 4);
        EpiPQ E{(bf16*)(ws + WS_MG), (const float*)(ws + WS_SS)};
        pg8::gemm_phase(F.lds, g, S, E);
    } SEAM(10);
    if (IN(11)) REP(11) { select_phase(F); }
    if (IN(11) && IN(12)) { asm volatile("s_waitcnt vmcnt(0)" ::: "memory"); __syncthreads(); }
    if (IN(12)) { if ((PROBE_MASK >> 12) & 1) { apply_phase(F, (float*)(ws + WS_MG)); xcd_barrier(bar); } apply_phase(F, F.out); }
#undef REP
#undef IN
#undef SEAM
}

extern "C" void kernel_launch(void* const* d_in, const int* in_sizes, int n_in, void* d_out, int out_size, void* d_ws, size_t ws_size, hipStream_t stream) {
    static int grid = 0;
    if (grid == 0) {
        if (n_in != 26 || in_sizes[0] != MTOK * DM || out_size != MTOK * DM || ws_size < WS_END) { fprintf(stderr, "kernel_launch: unexpected shapes / workspace (%zu < %zu)\n", ws_size, (size_t)WS_END); grid = -1; return; }
        int dev = 0, cus = 0, per_cu = 0;
        if (hipGetDevice(&dev) != hipSuccess || hipDeviceGetAttribute(&cus, hipDeviceAttributeMultiprocessorCount, dev) != hipSuccess) { grid = -1; return; }
        if (hipFuncSetAttribute((const void*)mega_fwd, hipFuncAttributeMaxDynamicSharedMemorySize, LDS_BYTES) != hipSuccess) { fprintf(stderr, "kernel_launch: hipFuncSetAttribute failed\n"); grid = -1; return; }
        if (hipOccupancyMaxActiveBlocksPerMultiprocessor(&per_cu, (const void*)mega_fwd, NTHR, LDS_BYTES) != hipSuccess || per_cu < 1) { fprintf(stderr, "kernel_launch: occupancy query says %d blocks/CU\n", per_cu); (void)hipGetLastError(); grid = -1; return; }
        grid = cus;
    }
    if (grid < 0) return;
    (void)hipMemsetAsync((char*)d_ws + WS_CTL + (size_t)CW_BAR * 4, 0, (size_t)XCD_BAR_WORDS * 4, stream);
    Args a{};
    for (int i = 0; i < 26; ++i) a.in[i] = (const float*)d_in[i];
    a.out = (float*)d_out; a.ws = (unsigned char*)d_ws;
#if MK_N_LAUNCHES == 1
    a.ph_lo = 0; a.ph_hi = N_PHASES;
    void* kargs[] = {&a};
    hipError_t e = hipLaunchCooperativeKernel((const void*)mega_fwd, dim3(grid), dim3(NTHR), kargs, LDS_BYTES, stream);
    if (e != hipSuccess) fprintf(stderr, "kernel_launch: cooperative launch failed: %s (grid %d)\n", hipGetErrorString(e), grid);
#else
    for (int p = 0; p < N_PHASES; ++p) { a.ph_lo = p; a.ph_hi = p + 1; hipLaunchKernelGGL(mega_fwd, dim3(grid), dim3(NTHR), LDS_BYTES, stream, a); }
#endif
}
```

```cpp
#include <hip/hip_runtime.h>
#include <cstdio>
#include <cstdint>
#include <math.h>

#ifndef MK_N_LAUNCHES
#define MK_N_LAUNCHES 1
#endif

constexpr int BATCH = 8, SEQ = 4096, DM = 1024, MTOK = BATCH * SEQ;
constexpr int DIN = 6160;
constexpr int NEXP = 16384;
constexpr float EPS = 1e-6f;

constexpr size_t MiB = 1u << 20;
constexpr size_t WS_CTL = 0, CTL_ZERO_BYTES = 1 * MiB;
constexpr size_t WS_WIN = 1 * MiB;
constexpr size_t WS_WQKV = 13 * MiB;
constexpr size_t WS_KEYS = 14 * MiB + 512 * 1024;
constexpr size_t WS_WLRU = 15 * MiB;
constexpr size_t WS_WB2 = 16 * MiB;
constexpr size_t WS_WOUT2 = 20 * MiB;
constexpr size_t WS_WPQ = 24 * MiB;
constexpr size_t WS_GATE = 28 * MiB;
constexpr size_t WS_WGT = 30 * MiB;
constexpr size_t WS_XM = 32 * MiB;
constexpr size_t WS_OP = 96 * MiB;
constexpr size_t WS_XL = 160 * MiB;
constexpr size_t WS_LG = 224 * MiB;
constexpr size_t WS_MG = 288 * MiB;
constexpr size_t WS_K = 416 * MiB;
constexpr size_t WS_AGG = 480 * MiB;
constexpr size_t WS_SS = 488 * MiB;
constexpr size_t WS_WIN8 = 489 * MiB;
constexpr size_t WS_END = 495 * MiB;

constexpr int CW_BAR = 4096;

constexpr int RING_BYTES = 131072;
constexpr int LDS_BYTES = 147456;
constexpr int LDSCTL_OFF = LDS_BYTES - 512, MISC_OFF = LDSCTL_OFF + 320;
constexpr int NWAVES = 8, NTHR = 512;

#define GAS __attribute__((address_space(1)))
#define LAS __attribute__((address_space(3)))
typedef unsigned short bf16;
typedef unsigned v4u __attribute__((ext_vector_type(4)));
typedef unsigned v2u __attribute__((ext_vector_type(2)));
typedef float f32x4 __attribute__((ext_vector_type(4)));
typedef float f32x2 __attribute__((ext_vector_type(2)));
typedef short bf16x8 __attribute__((ext_vector_type(8)));
typedef GAS unsigned gu32;
#define RLX_AGENT __ATOMIC_RELAXED, __HIP_MEMORY_SCOPE_AGENT
#define LDS_WAIT() asm volatile("s_waitcnt lgkmcnt(0)" ::: "memory")
#define VM_WAIT() asm volatile("s_waitcnt vmcnt(0)" ::: "memory")

__device__ __forceinline__ unsigned f2bf(float f) { unsigned u = __builtin_bit_cast(unsigned, f); return (u + 0x7fffu + ((u >> 16) & 1u)) >> 16; }
__device__ __forceinline__ unsigned pk2(float lo, float hi) { return f2bf(lo) | (f2bf(hi) << 16); }
__device__ __forceinline__ float bf2f(unsigned short h) { return __builtin_bit_cast(float, (unsigned)h << 16); }
__device__ __forceinline__ float bflo(unsigned w) { return __builtin_bit_cast(float, w << 16); }
__device__ __forceinline__ float bfhi(unsigned w) { return __builtin_bit_cast(float, w & 0xffff0000u); }
__device__ __forceinline__ float wave_sum(float v) {
#pragma unroll
  for (int o = 1; o < 64; o <<= 1) v += __shfl_xor(v, o);
  return v;
}
__device__ __forceinline__ float sigmoidf_(float x) { return __builtin_amdgcn_rcpf(1.f + __builtin_amdgcn_exp2f(x * -1.44269504089f)); }
__device__ __forceinline__ float gelu_erf(float x) { return 0.5f * x * (1.f + erff(x * 0.70710678118654752f)); }
__device__ __forceinline__ float gelu_fast(float v) {
    const float av = fabsf(v), t = __builtin_amdgcn_rcpf(av * 0.2316418882f + 1.0f);
    float q = t * 0.5307027145f + (-0.7265760135f); q = q * t + 0.7107068705f; q = q * t + (-0.142248368f); q = q * t + 0.127414796f; q = q * t;
    const float e = __builtin_amdgcn_exp2f((v * v) * (-0.72134752044f));
    const float m = v * (q * e);
    return v < 0.f ? m : v - m;
}
__device__ __forceinline__ float softplusf_(float x) { return fmaxf(x, 0.f) + log1pf(expf(-fabsf(x))); }

namespace pg8 {
#define PG8_LAS __attribute__((address_space(3)))
typedef unsigned short bf16_t;
typedef unsigned u32x4 __attribute__((ext_vector_type(4)));
typedef int i32x4_t __attribute__((ext_vector_type(4)));
constexpr int BM = 256, BK = 64, HALF = 128, HTB = HALF * BK * 2, STAGE_BYTES = 8 * HTB, NXCD = 8;

__host__ __device__ __forceinline__ int lds_byte(int r, int c) { const int st = (r >> 4) * 2 + (c >> 5), rr = r & 15, cc = c & 31, ob = rr * 64 + cc * 2; return st * 1024 + (ob ^ (((ob >> 9) & 1) << 5)); }
__host__ __device__ __forceinline__ void stage_rc(int b, int& R, int& C) { const int st = b / 1024, sb = b % 1024, swz = sb ^ (((sb >> 9) & 1) << 5); R = (st >> 1) * 16 + swz / 64; C = (st & 1) * 32 + (swz % 64) / 2; }
__host__ __device__ __forceinline__ int perm32(int rho) { const int n = rho >> 4, i = rho & 15; return 8 * (i >> 2) + 4 * n + (i & 3); }

struct Unit { int pm, pn; };
struct StaticOrder {
    int nM, nN, nwg, G, c, WGM;
    __host__ __device__ void init(int M, int N, int G_, int c_, int wgm = 8) { nM = M / BM; nN = N / BM; nwg = nM * nN; G = G_; c = c_; WGM = wgm; }
    __host__ __device__ bool next(int i, Unit& u) const {
        const long L = (long)i * G + c; if (L >= nwg) return false;
        int wgid = (int)L; { const int q = nwg / NXCD, r = nwg % NXCD, xcd = wgid % NXCD, off = wgid / NXCD; wgid = (xcd < r ? xcd * (q + 1) : r * (q + 1) + (xcd - r) * q) + off; }
        const int nig = WGM * nN, gid = wgid / nig, fm = gid * WGM, gsz = (nM - fm) < WGM ? (nM - fm) : WGM;
        u.pm = fm + ((wgid % nig) % gsz); u.pn = (wgid % nig) / gsz; return true;
    }
};

__device__ __forceinline__ unsigned cvt_pk_bf16(float lo, float hi) { unsigned r; asm volatile("v_cvt_pk_bf16_f32 %0, %1, %2" : "=v"(r) : "v"(lo), "v"(hi)); return r; }

template <class Epi, class Addr, int F8SC = 0>
__device__ __forceinline__ void gemm_phase(PG8_LAS unsigned char* lds, const Addr g, const StaticOrder& S, const Epi& E) {
    const int tid = threadIdx.x, wid = __builtin_amdgcn_readfirstlane(tid >> 6), lane = tid & 63, wr = wid >> 2, wc = wid & 3, fr = lane & 15, fq = lane >> 4;
    const int K = g.K, nt = K / BK;
    unsigned voffA[2], voffB[2];
#pragma unroll
    for (int i = 0; i < 2; ++i) { int R, C; stage_rc(tid * 16 + i * 8192, R, C); const int Rb = Epi::PERM ? ((R & ~31) + perm32(R & 31)) : R;
        voffA[i] = (unsigned)(R * g.lda + C) * 2u; voffB[i] = (unsigned)(Rb * g.ldb + C) * 2u; }
    const size_t kstep = (size_t)(BK * 2);
    const size_t hsA = (size_t)HALF * g.lda * 2, hsB = (size_t)HALF * g.ldb * 2;
    const unsigned ldsw = (unsigned)wid * 1024u;
    const int aoff = lds_byte(wr * 64 + fr, fq * 8), boff = lds_byte(wc * 32 + fr, fq * 8);
#define PG8_SA(b, h) (((b) * 2 + (h)) * HTB)
#define PG8_SB(b, h) ((4 + (b) * 2 + (h)) * HTB)
#define PG8_STAGE(bufoff, gbase, voff) do { _Pragma("unroll") for (int _i = 0; _i < 2; ++_i) \
        __builtin_amdgcn_global_load_lds((const unsigned*)((const char*)(gbase) + (voff)[_i]), (PG8_LAS unsigned*)(lds + (bufoff) + ldsw + _i * 8192), 16, 0, 0); } while (0)
#define PG8_LDA(dst, b, h) do { _Pragma("unroll") for (int m = 0; m < 4; ++m) _Pragma("unroll") for (int k = 0; k < 2; ++k) dst[m][k] = *(const PG8_LAS bf16x8*)(lds + PG8_SA(b, h) + aoff + m * 2048 + k * 1024); } while (0)
#define PG8_LDB(dst, b, h) do { _Pragma("unroll") for (int n = 0; n < 2; ++n) _Pragma("unroll") for (int k = 0; k < 2; ++k) dst[n][k] = *(const PG8_LAS bf16x8*)(lds + PG8_SB(b, h) + boff + n * 2048 + k * 1024); } while (0)
#define PG8_CAT(x0, x1) __builtin_shufflevector(__builtin_bit_cast(i32x4_t, x0), __builtin_bit_cast(i32x4_t, x1), 0, 1, 2, 3, 4, 5, 6, 7)
#define PG8_MMA(ai, bj, At, Bt) do { __builtin_amdgcn_s_setprio(1); \
        if constexpr (F8SC != 0) { _Pragma("unroll") for (int m = 0; m < 4; ++m) _Pragma("unroll") for (int n = 0; n < 2; ++n) \
            asm volatile("v_mfma_f32_16x16x128_f8f6f4 %0, %1, %2, %0" : "+v"(acc[ai][bj][m][n]) : "v"(PG8_CAT(Bt[n][0], Bt[n][1])), "v"(PG8_CAT(At[m][0], At[m][1]))); } \
        else { _Pragma("unroll") for (int m = 0; m < 4; ++m) _Pragma("unroll") for (int n = 0; n < 2; ++n) _Pragma("unroll") for (int k = 0; k < 2; ++k) \
            acc[ai][bj][m][n] = __builtin_amdgcn_mfma_f32_16x16x32_bf16(Bt[n][k], At[m][k], acc[ai][bj][m][n], 0, 0, 0); } \
        __builtin_amdgcn_s_setprio(0); } while (0)
#define PG8_WAIT_V(n) asm volatile("s_waitcnt vmcnt(" #n ")" ::: "memory")
#define PG8_WAIT_L(n) asm volatile("s_waitcnt lgkmcnt(" #n ")" ::: "memory")
#define PG8_BAR __builtin_amdgcn_s_barrier()
#define PG8_SCHED __builtin_amdgcn_sched_barrier(0)
    Unit cur, nxt; int ui = 0;
    if (!S.next(0, cur)) return;
    f32x4 acc[2][2][4][2];
#pragma unroll
    for (int a = 0; a < 2; ++a)
#pragma unroll
        for (int b = 0; b < 2; ++b)
#pragma unroll
            for (int m = 0; m < 4; ++m)
#pragma unroll
                for (int n = 0; n < 2; ++n) acc[a][b][m][n] = (f32x4){0.f, 0.f, 0.f, 0.f};
    bf16x8 At[4][2], B0[2][2], B1[2][2];
    const char* cA = g.a(cur); const char* cB = g.b(cur);
    PG8_STAGE(PG8_SB(0, 0), cB, voffB); PG8_STAGE(PG8_SB(0, 1), cB + hsB, voffB); PG8_STAGE(PG8_SA(0, 0), cA, voffA); PG8_STAGE(PG8_SA(0, 1), cA + hsA, voffA);
    if (wr == 1) PG8_BAR;
    PG8_WAIT_V(2); PG8_BAR;
    PG8_STAGE(PG8_SB(1, 0), cB + kstep, voffB); PG8_STAGE(PG8_SA(1, 0), cA + kstep, voffA); PG8_STAGE(PG8_SB(1, 1), cB + hsB + kstep, voffB);
    PG8_WAIT_V(6); PG8_BAR;
    for (;;) {
        const bool has_next = S.next(ui + 1, nxt);
        const char* nA = has_next ? g.a(nxt) : cA; const char* nB = has_next ? g.b(nxt) : cB;
#pragma unroll 1
        for (int t = 0; t < nt; t += 2) {
            const bool last = (t == nt - 2);
            const char* a1 = cA + (size_t)(t + 1) * kstep;
            const char* a2 = last ? nA : cA + (size_t)(t + 2) * kstep; const char* b2 = last ? nB : cB + (size_t)(t + 2) * kstep;
            const char* a3 = a2 + kstep; const char* b3 = b2 + kstep;
            PG8_LDB(B0, 0, 0); PG8_LDB(B1, 0, 1); PG8_SCHED; PG8_LDA(At, 0, 0); PG8_STAGE(PG8_SA(1, 1), a1 + hsA, voffA);
            PG8_WAIT_V(8); PG8_WAIT_L(0); PG8_BAR; PG8_MMA(0, 0, At, B0); PG8_MMA(0, 1, At, B1); PG8_BAR; PG8_SCHED;
            PG8_LDA(At, 0, 1); PG8_STAGE(PG8_SB(0, 0), b2, voffB); PG8_STAGE(PG8_SB(0, 1), b2 + hsB, voffB); PG8_STAGE(PG8_SA(0, 0), a2, voffA);
            PG8_WAIT_V(8); PG8_WAIT_L(0); PG8_BAR; PG8_MMA(1, 0, At, B0); PG8_MMA(1, 1, At, B1); PG8_BAR; PG8_SCHED;
            PG8_LDB(B0, 1, 0); PG8_LDB(B1, 1, 1); PG8_SCHED; PG8_LDA(At, 1, 0); PG8_STAGE(PG8_SA(0, 1), a2 + hsA, voffA);
            PG8_WAIT_V(8); PG8_WAIT_L(0); PG8_BAR; PG8_MMA(0, 0, At, B0); PG8_MMA(0, 1, At, B1); PG8_BAR; PG8_SCHED;
            PG8_LDA(At, 1, 1); PG8_STAGE(PG8_SB(1, 0), b3, voffB); PG8_STAGE(PG8_SB(1, 1), b3 + hsB, voffB); PG8_STAGE(PG8_SA(1, 0), a3, voffA);
            PG8_WAIT_V(8); PG8_WAIT_L(0); PG8_BAR; PG8_MMA(1, 0, At, B0); PG8_MMA(1, 1, At, B1); PG8_BAR; PG8_SCHED;
        }
        if constexpr (F8SC != 0) asm volatile("s_nop 15\n\ts_nop 15" ::: "memory");
        if (wr == 0) PG8_BAR;
        E(acc, cur, wr, wc, fr, fq);
        if (!has_next) break;
#pragma unroll
        for (int a = 0; a < 2; ++a)
#pragma unroll
            for (int b = 0; b < 2; ++b)
#pragma unroll
                for (int m = 0; m < 4; ++m)
#pragma unroll
                    for (int n = 0; n < 2; ++n) acc[a][b][m][n] = (f32x4){0.f, 0.f, 0.f, 0.f};
        cur = nxt; cA = nA; cB = nB; ++ui;
        if (wr == 1) PG8_BAR;
    }
    PG8_WAIT_V(0);
    PG8_BAR;
#undef PG8_SA
#undef PG8_SB
#undef PG8_STAGE
#undef PG8_LDA
#undef PG8_LDB
#undef PG8_MMA
#undef PG8_CAT
#undef PG8_WAIT_V
#undef PG8_WAIT_L
#undef PG8_BAR
#undef PG8_SCHED
}
}

#define XB_TMO      128
#define XB_XCNT(j)  (256  + 64 * (j))
#define XB_XSUB(j)  (1280 + 64 * (j))
#define XB_XGEN(j)  (2304 + 64 * (j))
#define XB_TOP      3328
#define XB_TOPGEN   3392
#define XCD_BAR_WORDS 3456
#define XB_SPIN_CAP (1u << 18)
__device__ __forceinline__ unsigned xb_ld(unsigned* p)              { return __hip_atomic_load(p, __ATOMIC_RELAXED, __HIP_MEMORY_SCOPE_AGENT); }
__device__ __forceinline__ unsigned xb_add(unsigned* p, unsigned v) { return __hip_atomic_fetch_add(p, v, __ATOMIC_RELAXED, __HIP_MEMORY_SCOPE_AGENT); }
__device__ __forceinline__ unsigned xb_xcc_id() { return (unsigned)__builtin_amdgcn_s_getreg((3 << 11) | 20) & 0xFu; }
#define XB_SPIN(cond, bar) do { unsigned _sp = 0; while (cond) { __builtin_amdgcn_s_sleep(1); \
    if ((++_sp & 255u) == 0u) { if (xb_ld(&(bar)[XB_TMO])) break; if (_sp > XB_SPIN_CAP) { atomicAdd(&(bar)[XB_TMO], 1u); break; } } } } while (0)
struct XcdBarrier { unsigned* bar; unsigned x; volatile LAS unsigned* st; };
__device__ __forceinline__ XcdBarrier xcd_barrier_post(unsigned* bar, volatile LAS unsigned* st) {
    XcdBarrier b; b.bar = bar; b.x = xb_xcc_id(); b.st = st;
    if (threadIdx.x == 0) (void)xb_add(&bar[XB_XCNT(b.x)], 1u);
    return b;
}
__device__ __forceinline__ void xcd_barrier_complete(unsigned* bar, unsigned x, unsigned& nloc, unsigned& nx) {
    const unsigned G = gridDim.x * gridDim.y * gridDim.z;
    unsigned sum, cnt, mine, sp = 0u;
    for (;;) {
        sum = 0u; cnt = 0u; mine = 0u;
#pragma unroll
        for (unsigned j = 0; j < 16; ++j) { const unsigned c = xb_ld(&bar[XB_XCNT(j)]); sum += c; cnt += (c > 0u) ? 1u : 0u; mine = (j == x) ? c : mine; }
        if (sum == G) break;
        __builtin_amdgcn_s_sleep(1);
        if ((++sp & 255u) == 0u) { if (xb_ld(&bar[XB_TMO])) break; if (sp > XB_SPIN_CAP) { atomicAdd(&bar[XB_TMO], 1u); break; } }
    }
    nloc = mine > 0u ? mine : 1u; nx = cnt > 0u ? cnt : 1u;
}
__device__ __forceinline__ void xcd_barrier(const XcdBarrier& b) {
    asm volatile("s_waitcnt vmcnt(0)" ::: "memory");
    __syncthreads();
    if (threadIdx.x == 0) {
        unsigned* bar = b.bar;
        __builtin_amdgcn_s_waitcnt(0);
        unsigned nloc = b.st[0], nx = b.st[1];
        if (nloc == 0u) { xcd_barrier_complete(bar, b.x, nloc, nx); b.st[0] = nloc; b.st[1] = nx; }
        const unsigned old = xb_add(&bar[XB_XSUB(b.x)], 1u);
        const unsigned gen = old / nloc;
        if (old + 1u == (gen + 1u) * nloc) {
            __builtin_amdgcn_fence(__ATOMIC_RELEASE, "agent");
            asm volatile("s_waitcnt vmcnt(0)" ::: "memory");
            const unsigned og = xb_add(&bar[XB_TOP], 1u);
            const unsigned tg = og / nx;
            if (og + 1u == (tg + 1u) * nx) xb_add(&bar[XB_TOPGEN], 1u);
            else XB_SPIN(xb_ld(&bar[XB_TOPGEN]) == tg, bar);
            __builtin_amdgcn_fence(__ATOMIC_ACQUIRE, "agent");
            xb_add(&bar[XB_XGEN(b.x)], 1u);
            asm volatile("s_waitcnt vmcnt(0)" ::: "memory");
        } else {
            XB_SPIN(xb_ld(&bar[XB_XGEN(b.x)]) == gen, bar);
            __builtin_amdgcn_fence(__ATOMIC_ACQUIRE, "agent");
            asm volatile("s_waitcnt vmcnt(0)" ::: "memory");
        }
    }
    __syncthreads();
}

struct Args { const float* in[26]; float* out; unsigned char* ws; int ph_lo, ph_hi; };
struct Frame {
    LAS unsigned char* lds;
    int tid, lane, wave, G, bid;
    const float* const* in; float* out; unsigned char* ws;
};

template <bool F8 = false> __device__ __forceinline__ void tr_item(const float* W, int ldw, bf16* WT, int ldt, float scale, const float* kscale, LAS float* scr, int k0, int lane) {
#pragma unroll 8
    for (int i = 0; i < 32; ++i) { const int kk = 2 * i + (lane >> 5); float v = W[(size_t)(k0 + kk) * ldw + (lane & 31)] * scale; if (kscale) v *= kscale[k0 + kk]; scr[kk * 33 + (lane & 31)] = v; }
    LDS_WAIT(); asm volatile("" ::: "memory");
    const int c = lane & 7;
#pragma unroll
    for (int j = 0; j < 4; ++j) { const int n = (lane >> 3) + 8 * j; const LAS float* s = scr + (8 * c) * 33 + n;
        if constexpr (F8) {
            int p0 = 0, p1 = 0; p0 = __builtin_amdgcn_cvt_pk_fp8_f32(s[0 * 33], s[1 * 33], p0, false); p0 = __builtin_amdgcn_cvt_pk_fp8_f32(s[2 * 33], s[3 * 33], p0, true);
            p1 = __builtin_amdgcn_cvt_pk_fp8_f32(s[4 * 33], s[5 * 33], p1, false); p1 = __builtin_amdgcn_cvt_pk_fp8_f32(s[6 * 33], s[7 * 33], p1, true);
            *(GAS v2u*)((GAS unsigned char*)WT + (size_t)n * ldt + k0 + 8 * c) = (v2u){(unsigned)p0, (unsigned)p1};
        } else {
        v4u o; o.x = pk2(s[0 * 33], s[1 * 33]); o.y = pk2(s[2 * 33], s[3 * 33]); o.z = pk2(s[4 * 33], s[5 * 33]); o.w = pk2(s[6 * 33], s[7 * 33]);
        *(GAS v4u*)(WT + (size_t)n * ldt + k0 + 8 * c) = o; } }
    LDS_WAIT(); asm volatile("" ::: "memory");
}

__device__ __forceinline__ void p0_prologue(Frame& F) {
    LAS float* scr = (LAS float*)(F.lds + F.wave * 16384);
    const int gw = F.bid * NWAVES + F.wave, NGW = F.G * NWAVES;
    unsigned char* ws = F.ws;
    const float* w_in = F.in[2];
    constexpr int I_WIN = 16 * 192, I_QKV = 12 * 32, I_LRU = 32 * 8, I_WB = 2 * 512, I_WO = 2 * 512, I_PQ = 16 * 64;
    constexpr int NITEMS = I_WIN + I_QKV + I_LRU + I_WB + I_WO + I_PQ;
    for (int it = gw; it < NITEMS; it += NGW) {
        int r = it;
        if (r < I_WIN) { const int kb = r / 192, nb = r % 192, n0 = nb * 32, sc = n0 < 2048 ? n0 : n0 + 16;
            if ((n0 >= 1024 && n0 < 3072) || n0 >= 4096) tr_item<true>(w_in + sc, DIN, (bf16*)(ws + WS_WIN8 + (size_t)n0 * 1024), 1024, 1024.f, nullptr, scr, kb * 64, F.lane);
            else tr_item(w_in + sc, DIN, (bf16*)(ws + WS_WIN) + (size_t)n0 * 1024, 1024, 1.f, nullptr, scr, kb * 64, F.lane);
            continue; }
        r -= I_WIN;
        if (r < I_QKV) { const int mat = r / 32, rr = r % 32, kb = rr / 8, nb = rr % 8, g = mat >> 2, h = mat & 3;
            const float* W = F.in[6 + g] + (size_t)h * 65536 + nb * 32;
            tr_item(W, 256, (bf16*)(ws + WS_WQKV) + (size_t)mat * 65536 + (size_t)(nb * 32) * 256, 256, g == 1 ? 0.0625f : 1.f, nullptr, scr, kb * 64, F.lane); continue; }
        r -= I_QKV;
        if (r < I_LRU) { const int mat = r / 8, rr = r % 8, kb = rr / 4, nb = rr % 4, gate = mat & 1, db = mat >> 1;
            const float* W = F.in[gate ? 14 : 12] + (size_t)db * 16384 + nb * 32;
            tr_item(W, 128, (bf16*)(ws + WS_WLRU) + (size_t)mat * 16384 + (size_t)(nb * 32) * 128, 128, 1.f, nullptr, scr, kb * 64, F.lane); continue; }
        r -= I_LRU;
        if (r < I_WB) { const int mat = r / 512, rr = r % 512, kb = rr / 32, nb = rr % 32;
            const float* W = F.in[17 + mat] + nb * 32;
            tr_item(W, 1024, (bf16*)(ws + WS_WB2) + (size_t)(mat * 1024 + nb * 32) * 1024, 1024, 1.f, nullptr, scr, kb * 64, F.lane); continue; }
        r -= I_WB;
        if (r < I_WO) { const int cp = r / 512, rr = r % 512, kb = rr / 32, nb = rr % 32;
            const float* W = F.in[19] + nb * 32;
            tr_item(W, 1024, (bf16*)(ws + WS_WOUT2) + (size_t)(nb * 32) * 2048 + cp * 1024, 2048, 1.f, nullptr, scr, kb * 64, F.lane); continue; }
        r -= I_WO;
        { const int kb = r / 64, nb = r % 64;
            const float* W = F.in[21] + nb * 32;
            tr_item(W, 2048, (bf16*)(ws + WS_WPQ) + (size_t)(nb * 32) * 1024, 1024, 1.f, F.in[20], scr, kb * 64, F.lane); }
    }
    { const int gt = F.bid * NTHR + F.tid, NGT = F.G * NTHR;
      const float4* ks = (const float4*)F.in[22]; v2u* kd = (v2u*)(ws + WS_KEYS);
      for (int i = gt; i < 8 * 2 * 128 * 128 / 4; i += NGT) { const float4 v = ks[i]; v2u o; o.x = pk2(v.x, v.y); o.y = pk2(v.z, v.w); kd[i] = o; }
      float* ss = (float*)(ws + WS_SS);
      for (int i = gt; i < MTOK; i += NGT) ss[i] = 0.f; }
    { const int gt = F.bid * NTHR + F.tid;
      if (gt < 16 * 128) { const int c = gt >> 7, k8 = gt & 127; v4u o; unsigned wv[4];
#pragma unroll
          for (int j = 0; j < 4; ++j) wv[j] = pk2(w_in[(size_t)(k8 * 8 + 2 * j) * DIN + 2048 + c], w_in[(size_t)(k8 * 8 + 2 * j + 1) * DIN + 2048 + c]);
          o.x = wv[0]; o.y = wv[1]; o.z = wv[2]; o.w = wv[3]; *(v4u*)((bf16*)(ws + WS_WGT) + c * 1024 + k8 * 8) = o; } }
    const float* x = F.in[0]; const float* g1 = F.in[1];
    bf16* XN = (bf16*)(ws + WS_K);
    unsigned char* XN8 = (unsigned char*)F.out;
    f32x4 gv[4];
#pragma unroll
    for (int j = 0; j < 4; ++j) gv[j] = ((const f32x4*)g1)[F.lane + 64 * j];
    for (int m = 2 * gw; m < MTOK; m += 2 * NGW) {
        const f32x4* xr0 = (const f32x4*)(x + (size_t)m * DM) + F.lane; const f32x4* xr1 = xr0 + DM / 4;
        f32x4 v0[4], v1[4]; float s0 = 0.f, s1 = 0.f;
#pragma unroll
        for (int j = 0; j < 4; ++j) { v0[j] = xr0[64 * j]; v1[j] = xr1[64 * j]; }
#pragma unroll
        for (int j = 0; j < 4; ++j) { s0 += (v0[j].x * v0[j].x + v0[j].y * v0[j].y) + (v0[j].z * v0[j].z + v0[j].w * v0[j].w); s1 += (v1[j].x * v1[j].x + v1[j].y * v1[j].y) + (v1[j].z * v1[j].z + v1[j].w * v1[j].w); }
        const float r0 = rsqrtf(wave_sum(s0) * (1.f / DM) + EPS), r1 = rsqrtf(wave_sum(s1) * (1.f / DM) + EPS);
        unsigned long long* o0 = (unsigned long long*)(XN + (size_t)m * DM) + F.lane; unsigned long long* o1 = o0 + DM / 4;
        unsigned* q0 = (unsigned*)(XN8 + (size_t)m * DM) + F.lane; unsigned* q1 = q0 + DM / 4;
#pragma unroll
        for (int j = 0; j < 4; ++j) { const f32x4 a = v0[j] * r0 * gv[j], c = v1[j] * r1 * gv[j];
            o0[64 * j] = (unsigned long long)pk2(a.x, a.y) | ((unsigned long long)pk2(a.z, a.w) << 32);
            o1[64 * j] = (unsigned long long)pk2(c.x, c.y) | ((unsigned long long)pk2(c.z, c.w) << 32);
            int pa = 0, pc = 0; pa = __builtin_amdgcn_cvt_pk_fp8_f32(a.x, a.y, pa, false); pa = __builtin_amdgcn_cvt_pk_fp8_f32(a.z, a.w, pa, true);
            pc = __builtin_amdgcn_cvt_pk_fp8_f32(c.x, c.y, pc, false); pc = __builtin_amdgcn_cvt_pk_fp8_f32(c.z, c.w, pc, true);
            q0[64 * j] = (unsigned)pa; q1[64 * j] = (unsigned)pc; }
    }
}
__device__ __forceinline__ void gates_phase(Frame& F) {
    const bf16* XN = (const bf16*)(F.ws + WS_K); const bf16* WGT = (const bf16*)(F.ws + WS_WGT); float* GT = (float*)(F.ws + WS_GATE);
    const int lane = F.lane, fr = lane & 15, fq = lane >> 4;
    const f32x4 bg4 = *(const f32x4*)(F.in[3] + 4 * fq);
    for (int task = F.bid * NWAVES + F.wave; task < MTOK / 16; task += F.G * NWAVES) {
        const size_t m0 = (size_t)task * 16;
        f32x4 acc = (f32x4){0.f, 0.f, 0.f, 0.f};
#pragma unroll 8
        for (int ks = 0; ks < 32; ++ks) {
            const bf16x8 wfr = *(const bf16x8*)(WGT + fr * 1024 + 32 * ks + 8 * fq);
            const bf16x8 xfr = *(const bf16x8*)(XN + (m0 + fr) * DM + 32 * ks + 8 * fq);
            acc = __builtin_amdgcn_mfma_f32_16x16x32_bf16(wfr, xfr, acc, 0, 0, 0);
        }
        *(f32x4*)(GT + (m0 + fr) * 16 + 4 * fq) = acc + bg4;
    }
}

struct AddrPlain {
    const char* A; const char* Bt; int lda, ldb, K;
    __device__ __forceinline__ const char* a(const pg8::Unit& u) const { return A + (size_t)u.pm * 256 * lda * 2; }
    __device__ __forceinline__ const char* b(const pg8::Unit& u) const { return Bt + (size_t)u.pn * 256 * ldb * 2; }
};
struct AddrP1 {
    const char* A; const char* Bt; int lda, ldb, K, thr, lo_add, hi_add;
    __device__ __forceinline__ const char* a(const pg8::Unit& u) const { return A + (size_t)u.pm * 256 * lda * 2; }
    __device__ __forceinline__ const char* b(const pg8::Unit& u) const { return Bt + (size_t)(u.pn + (u.pn < thr ? lo_add : hi_add)) * 256 * ldb * 2; }
};
struct AddrQKV {
    const char* XC; long dXM; const char* W; int lda, ldb, K;
    __device__ __forceinline__ const char* a(const pg8::Unit& u) const { return XC + (u.pn < 8 ? 0l : dXM) + ((size_t)u.pm * 256 * 1024 + (u.pn & 3) * 256) * 2; }
    __device__ __forceinline__ const char* b(const pg8::Unit& u) const { return W + (size_t)u.pn * 65536 * 2; }
};
struct AddrBranch {
    const char* YM; long dYL; const char* W; int lda, ldb, K;
    __device__ __forceinline__ const char* a(const pg8::Unit& u) const { return YM + (u.pn < 4 ? 0l : dYL) + (size_t)u.pm * 256 * 1024 * 2; }
    __device__ __forceinline__ const char* b(const pg8::Unit& u) const { return W + (size_t)u.pn * 256 * 1024 * 2; }
};

struct DstP1 { unsigned char* ws; int thr, lo_add, hi_add;
    __device__ __forceinline__ bf16* get(int j, int& ld, int& col0) const {
        const int pn = j + (j < thr ? lo_add : hi_add); const bool mg = pn >= 16; ld = mg ? -2048 : 1024; col0 = mg ? (pn - 16) * 256 : (pn & 3) * 256;
        return (bf16*)(ws + (mg ? WS_MG : WS_XM + (size_t)(pn >> 2) * 64 * MiB)); } };
struct DstQKV { char* q; long dk, dv;
    __device__ __forceinline__ bf16* get(int pn, int& ld, int& col0) const { ld = 1024; col0 = (pn & 3) * 256; return (bf16*)(q + (pn >= 4 ? (pn >= 8 ? dv : dk) : 0l)); } };
template <class Dst, bool MUL = false> struct EpiBf16 {
    static constexpr bool PERM = true;
    Dst dst; float mul;
    __device__ __forceinline__ void operator()(const f32x4 (&acc)[2][2][4][2], const pg8::Unit& u, int wr, int wc, int fr, int fq) const {
        int ld, colt; bf16* base = dst.get(u.pn, ld, colt);
        const int row0 = u.pm * 256 + wr * 64 + fr, col0 = colt + wc * 32 + 8 * fq;
        if (MUL && ld < 0) {
#pragma unroll
            for (int ai = 0; ai < 2; ++ai)
#pragma unroll
                for (int m = 0; m < 4; ++m) { unsigned char* rowp = (unsigned char*)base + (size_t)(row0 + ai * 128 + m * 16) * (-ld) + col0;
#pragma unroll
                    for (int bj = 0; bj < 2; ++bj) { const f32x4 v0 = acc[ai][bj][m][0] * mul, v1 = acc[ai][bj][m][1] * mul;
                        int p0 = 0, p1 = 0; p0 = __builtin_amdgcn_cvt_pk_fp8_f32(v0[0], v0[1], p0, false); p0 = __builtin_amdgcn_cvt_pk_fp8_f32(v0[2], v0[3], p0, true);
                        p1 = __builtin_amdgcn_cvt_pk_fp8_f32(v1[0], v1[1], p1, false); p1 = __builtin_amdgcn_cvt_pk_fp8_f32(v1[2], v1[3], p1, true);
                        *(v2u*)(rowp + bj * 128) = (v2u){(unsigned)p0, (unsigned)p1}; } }
            return;
        }
#pragma unroll
        for (int ai = 0; ai < 2; ++ai)
#pragma unroll
            for (int m = 0; m < 4; ++m) { bf16* rowp = base + (size_t)(row0 + ai * 128 + m * 16) * ld + col0;
#pragma unroll
                for (int bj = 0; bj < 2; ++bj) { f32x4 v0 = acc[ai][bj][m][0], v1 = acc[ai][bj][m][1]; if (MUL) { v0 = v0 * mul; v1 = v1 * mul; }
                    v4u w; w.x = pg8::cvt_pk_bf16(v0[0], v0[1]); w.y = pg8::cvt_pk_bf16(v0[2], v0[3]); w.z = pg8::cvt_pk_bf16(v1[0], v1[1]); w.w = pg8::cvt_pk_bf16(v1[2], v1[3]);
                    *(v4u*)(rowp + bj * 128) = w; } }
    }
};
template <bool ADD> struct EpiMerge {
    static constexpr bool PERM = true;
    bf16* MRG; const unsigned char* MG; int gcol;
    __device__ __forceinline__ void operator()(const f32x4 (&acc)[2][2][4][2], const pg8::Unit& u, int wr, int wc, int fr, int fq) const {
        const int row0 = u.pm * 256 + wr * 64 + fr, col0 = u.pn * 256 + wc * 32 + 8 * fq;
#pragma unroll
        for (int ai = 0; ai < 2; ++ai)
#pragma unroll
            for (int m = 0; m < 4; ++m) { const size_t row = (size_t)(row0 + ai * 128 + m * 16); bf16* rowp = MRG + row * 1024 + col0; const unsigned char* gp = MG + row * 2048 + gcol + col0;
#pragma unroll
                for (int bj = 0; bj < 2; ++bj) { const f32x4 v0 = acc[ai][bj][m][0], v1 = acc[ai][bj][m][1];
                    const v2u g = *(const v2u*)(gp + bj * 128);
                    const f32x2 g0 = __builtin_amdgcn_cvt_pk_f32_fp8((int)g.x, false), g1 = __builtin_amdgcn_cvt_pk_f32_fp8((int)g.x, true), g2 = __builtin_amdgcn_cvt_pk_f32_fp8((int)g.y, false), g3 = __builtin_amdgcn_cvt_pk_f32_fp8((int)g.y, true);
                    float o[8] = {v0[0] * sigmoidf_(g0[0]), v0[1] * sigmoidf_(g0[1]), v0[2] * sigmoidf_(g1[0]), v0[3] * sigmoidf_(g1[1]),
                                  v1[0] * sigmoidf_(g2[0]), v1[1] * sigmoidf_(g2[1]), v1[2] * sigmoidf_(g3[0]), v1[3] * sigmoidf_(g3[1])};
                    if (ADD) { const v4u t = *(const v4u*)(rowp + bj * 128);
                        o[0] += bflo(t.x); o[1] += bfhi(t.x); o[2] += bflo(t.y); o[3] += bfhi(t.y); o[4] += bflo(t.z); o[5] += bfhi(t.z); o[6] += bflo(t.w); o[7] += bfhi(t.w); }
                    v4u w; w.x = pg8::cvt_pk_bf16(o[0], o[1]); w.y = pg8::cvt_pk_bf16(o[2], o[3]); w.z = pg8::cvt_pk_bf16(o[4], o[5]); w.w = pg8::cvt_pk_bf16(o[6], o[7]);
                    *(v4u*)(rowp + bj * 128) = w; } }
    }
};
struct EpiResid {
    static constexpr bool PERM = false;
    const float* x; float* x1; bf16* x1b; float* ss;
    __device__ __forceinline__ void operator()(const f32x4 (&acc)[2][2][4][2], const pg8::Unit& u, int wr, int wc, int fr, int fq) const {
        const int row0 = u.pm * 256 + wr * 64 + fr, col0 = u.pn * 256 + wc * 32 + 4 * fq;
#pragma unroll
        for (int ai = 0; ai < 2; ++ai)
#pragma unroll
            for (int m = 0; m < 4; ++m) { const int row = row0 + ai * 128 + m * 16; const size_t off = (size_t)row * DM + col0; float s = 0.f;
#pragma unroll
                for (int bj = 0; bj < 2; ++bj)
#pragma unroll
                    for (int n = 0; n < 2; ++n) { const size_t o = off + bj * 128 + n * 16; const f32x4 v = *(const f32x4*)(x + o) + acc[ai][bj][m][n];
                        *(f32x4*)(x1 + o) = v; v2u w; w.x = pg8::cvt_pk_bf16(v[0], v[1]); w.y = pg8::cvt_pk_bf16(v[2], v[3]); *(v2u*)(x1b + o) = w;
                        s += (v[0] * v[0] + v[1] * v[1]) + (v[2] * v[2] + v[3] * v[3]); }
                s += __shfl_xor(s, 16); s += __shfl_xor(s, 32);
                if (fq == 0) atomicAdd(ss + row, s); }
    }
};
struct EpiPQ {
    static constexpr bool PERM = true;
    bf16* pq; const float* ss;
    __device__ __forceinline__ void operator()(const f32x4 (&acc)[2][2][4][2], const pg8::Unit& u, int wr, int wc, int fr, int fq) const {
        const int row0 = u.pm * 256 + wr * 64 + fr, col0 = u.pn * 256 + wc * 32 + 8 * fq;
#pragma unroll
        for (int ai = 0; ai < 2; ++ai)
#pragma unroll
            for (int m = 0; m < 4; ++m) { const int row = row0 + ai * 128 + m * 16; bf16* rowp = pq + (size_t)row * 2048 + col0;
                const float r = rsqrtf(ss[row] * (1.f / DM) + EPS);
#pragma unroll
                for (int bj = 0; bj < 2; ++bj) { const f32x4 v0 = acc[ai][bj][m][0] * r, v1 = acc[ai][bj][m][1] * r;
                    v4u w; w.x = pg8::cvt_pk_bf16(v0[0], v0[1]); w.y = pg8::cvt_pk_bf16(v0[2], v0[3]); w.z = pg8::cvt_pk_bf16(v1[0], v1[1]); w.w = pg8::cvt_pk_bf16(v1[2], v1[3]);
                    *(v4u*)(rowp + bj * 128) = w; } }
    }
};

template <bool PB> __device__ __forceinline__ void lru_phase(Frame& F) {
    const bf16* XL = (const bf16*)(F.ws + WS_XL); const bf16* LG = (const bf16*)(F.ws + WS_LG); bf16* YL = (bf16*)F.out;
    f32x2* AGG = (f32x2*)(F.ws + WS_AGG);
    const bf16* WL = (const bf16*)(F.ws + WS_WLRU);
    const float* cw = F.in[10]; const float* cb = F.in[11];
    unsigned char* LA0 = F.ws + WS_K; unsigned char* LA1 = LA0 + (size_t)MTOK * DM; bf16* LU0 = (bf16*)F.out; bf16* LU1 = LU0 + (size_t)MTOK * DM;
    v2u ra[2]; v4u ru[2];
    constexpr int O_XCB = 0, O_XCF = 17408, O_A = 51200, O_U = 84992, FST = 528;
    LAS unsigned char* L = F.lds;
    const int tid = F.tid, lane = F.lane, w = F.wave, fr = lane & 15, fq = lane >> 4;
    int cur_blk = -1;
    bf16x8 wf[2][2][4];
    f32x4 br4[2], bi4[2], sp4[2];
    v4u rawreg[3];
#define RAW_LOAD(bb, tt0, bk) do { _Pragma("unroll") for (int r_ = 0; r_ < 3; ++r_) { const int e_ = tid + NTHR * r_, row_ = e_ >> 4, c16_ = e_ & 15, t_ = (tt0) - 2 + row_; \
            v4u v_ = {0u, 0u, 0u, 0u}; if (e_ < 68 * 16 && t_ >= 0 && t_ < SEQ) v_ = *(const v4u*)(XL + ((size_t)(bb) * SEQ + t_) * DM + (bk) * 128 + c16_ * 8); rawreg[r_] = v_; } } while (0)
#define PB_LOAD(ii, dd) do { const int idx_ = (ii) * F.G + F.bid; if (idx_ < 4096) { const int j_ = idx_ >> 3; const size_t mr_ = (size_t)(j_ >> 6) * SEQ + (j_ & 63) * 64; \
            _Pragma("unroll") for (int r_ = 0; r_ < 2; ++r_) { const int e_ = tid + NTHR * r_; const size_t o_ = (mr_ + (e_ >> 4)) * DM + (idx_ & 7) * 128 + (e_ & 15) * 8; \
                ra[r_] = *(const v2u*)(((dd) ? LA1 : LA0) + o_); ru[r_] = *(const v4u*)(((dd) ? LU1 : LU0) + o_); } } } while (0)
    constexpr int O_CARRY = 118784, O_CW = 135168, O_SUB = 137728;
    const bool carry_tab = PB && (F.G == 256);
    if (carry_tab) {
        const int ch = tid & 127, bq = tid >> 7, s0 = F.bid >> 3, blk0 = F.bid & 7;
        LAS float* CT = (LAS float*)(L + O_CARRY);
#define FOLD(agp, j0, j1, stp, hv) do { int js_ = (j0); const int n_ = ((j1) - (j0)) * (stp); int k_ = 0; \
            for (; k_ + 8 <= n_; k_ += 8) { f32x2 ah_[8]; _Pragma("unroll") for (int q_ = 0; q_ < 8; ++q_) ah_[q_] = (agp)[(size_t)(js_ + q_ * (stp)) * 2 * DM]; \
                _Pragma("unroll") for (int q_ = 0; q_ < 8; ++q_) hv = ah_[q_][0] * hv + ah_[q_][1]; js_ += 8 * (stp); } \
            for (; k_ < n_; ++k_) { const f32x2 a1_ = (agp)[(size_t)js_ * 2 * DM]; hv = a1_[0] * hv + a1_[1]; js_ += (stp); } } while (0)
        for (int bb = 2 * bq; bb < 2 * bq + 2; ++bb) {
            const f32x2* ag0 = AGG + ((size_t)(bb * 64) * 2 + 0) * DM + blk0 * 128 + ch; const f32x2* ag1 = AGG + ((size_t)(bb * 64) * 2 + 1) * DM + blk0 * 128 + ch;
            float h = 0.f;
            FOLD(ag0, 0, s0, 1, h); CT[((bb * 2 + 0) * 2 + 0) * 128 + ch] = h;
            FOLD(ag0, s0, s0 + 32, 1, h); CT[((bb * 2 + 1) * 2 + 0) * 128 + ch] = h;
            h = 0.f;
            FOLD(ag1, 63, s0 + 32, -1, h); CT[((bb * 2 + 1) * 2 + 1) * 128 + ch] = h;
            FOLD(ag1, s0 + 32, s0, -1, h); CT[((bb * 2 + 0) * 2 + 1) * 128 + ch] = h;
        }
        __syncthreads();
#undef FOLD
    }
    for (int i = 0;; ++i) {
        const int idx = i * F.G + F.bid; if (idx >= 4096) break;
        const int blk = idx & 7, j = idx >> 3, b = j >> 6, seg = j & 63, t0 = seg * 64;
        const size_t mrow0 = (size_t)b * SEQ + t0;
        if (!PB && blk != cur_blk) {
            cur_blk = blk;
#pragma unroll
            for (int d = 0; d < 2; ++d) {
#pragma unroll
                for (int g = 0; g < 2; ++g)
#pragma unroll
                    for (int ks = 0; ks < 4; ++ks)
                        wf[d][g][ks] = *(const bf16x8*)(WL + ((size_t)((d * 8 + blk) * 2 + g) * 128 + 16 * w + fr) * 128 + 32 * ks + 8 * fq);
                const int ch = blk * 128 + 16 * w + 4 * fq;
                br4[d] = *(const f32x4*)(F.in[13] + d * DM + ch); bi4[d] = *(const f32x4*)(F.in[15] + d * DM + ch);
                const f32x4 lm = *(const f32x4*)(F.in[16] + d * DM + ch);
#pragma unroll
                for (int e = 0; e < 4; ++e) sp4[d][e] = -8.f * 1.44269504089f * softplusf_(-lm[e]);
            }
            __syncthreads();
            for (int e = tid; e < 5 * 128; e += NTHR) { const int jt = e >> 7, cc = e & 127; ((LAS float*)(L + O_CW))[e] = (jt < 4) ? cw[jt * DM + blk * 128 + cc] : cb[blk * 128 + cc]; }
        }
        v4u lgreg[2];
        if (PB) {
            if (i == 0) PB_LOAD(0, 0);
#pragma unroll
            for (int r = 0; r < 2; ++r) { const int e = tid + NTHR * r; lgreg[r] = *(const v4u*)(LG + (mrow0 + (e >> 4)) * DM + blk * 128 + (e & 15) * 8); }
        } else {
        if (i == 0) RAW_LOAD(b, t0, blk);
#pragma unroll
        for (int r = 0; r < 3; ++r) { const int e = tid + NTHR * r; if (e < 68 * 16) *(LAS v4u*)(L + O_A + (e >> 4) * 256 + (e & 15) * 16) = rawreg[r]; }
        __syncthreads();
        { const int idx2 = (i + 1) * F.G + F.bid; if (idx2 < 4096) { const int j2 = idx2 >> 3; RAW_LOAD(j2 >> 6, (j2 & 63) * 64, idx2 & 7); } }
        for (int e = tid; e < 64 * 16; e += NTHR) { const int tl = e >> 4, c16 = e & 15;
            float y[8];
            { const f32x4 a = *(const LAS f32x4*)(L + O_CW + 4 * 512 + c16 * 32), bq = *(const LAS f32x4*)(L + O_CW + 4 * 512 + c16 * 32 + 16); y[0] = a[0]; y[1] = a[1]; y[2] = a[2]; y[3] = a[3]; y[4] = bq[0]; y[5] = bq[1]; y[6] = bq[2]; y[7] = bq[3]; }
#pragma unroll
            for (int jt = 0; jt < 4; ++jt) { const v4u r = *(const LAS v4u*)(L + O_A + (tl + jt) * 256 + c16 * 16);
                const f32x4 wa = *(const LAS f32x4*)(L + O_CW + jt * 512 + c16 * 32), wb = *(const LAS f32x4*)(L + O_CW + jt * 512 + c16 * 32 + 16);
                y[0] += wa[0] * bflo(r.x); y[1] += wa[1] * bfhi(r.x); y[2] += wa[2] * bflo(r.y); y[3] += wa[3] * bfhi(r.y);
                y[4] += wb[0] * bflo(r.z); y[5] += wb[1] * bfhi(r.z); y[6] += wb[2] * bflo(r.w); y[7] += wb[3] * bfhi(r.w); }
            *(LAS f32x4*)(L + O_XCF + tl * FST + c16 * 32) = (f32x4){y[0], y[1], y[2], y[3]};
            *(LAS f32x4*)(L + O_XCF + tl * FST + c16 * 32 + 16) = (f32x4){y[4], y[5], y[6], y[7]};
            v4u o; o.x = pk2(y[0], y[1]); o.y = pk2(y[2], y[3]); o.z = pk2(y[4], y[5]); o.w = pk2(y[6], y[7]);
            *(LAS v4u*)(L + O_XCB + tl * 272 + c16 * 16) = o; }
        __syncthreads();
        }
        float carry0 = 0.f, carry1 = 0.f;
        if (carry_tab) { const LAS float* CT = (const LAS float*)(L + O_CARRY); carry0 = CT[((b * 2 + (seg >> 5)) * 2 + 0) * 128 + (tid & 127)]; carry1 = CT[((b * 2 + (seg >> 5)) * 2 + 1) * 128 + (tid & 127)]; }
        else if (PB) {
            const int ch = blk * 128 + (tid & 127);
            float h = 0.f;
            const f32x2* ag0 = AGG + ((size_t)(b * 64) * 2 + 0) * DM + ch; const f32x2* ag1 = AGG + ((size_t)(b * 64) * 2 + 1) * DM + ch;
            int js = 0;
            for (; js + 8 <= seg; js += 8) { f32x2 ah[8];
#pragma unroll
                for (int q = 0; q < 8; ++q) ah[q] = ag0[(size_t)(js + q) * 2 * DM];
#pragma unroll
                for (int q = 0; q < 8; ++q) h = ah[q][0] * h + ah[q][1]; }
            for (; js < seg; ++js) { const f32x2 ah = ag0[(size_t)js * 2 * DM]; h = ah[0] * h + ah[1]; }
            carry0 = h; h = 0.f;
            js = 63;
            for (; js - 8 >= seg; js -= 8) { f32x2 ah[8];
#pragma unroll
                for (int q = 0; q < 8; ++q) ah[q] = ag1[(size_t)(js - q) * 2 * DM];
#pragma unroll
                for (int q = 0; q < 8; ++q) h = ah[q][0] * h + ah[q][1]; }
            for (; js > seg; --js) { const f32x2 ah = ag1[(size_t)js * 2 * DM]; h = ah[0] * h + ah[1]; }
            carry1 = h;
        }
#pragma unroll
        for (int d = 0; d < 2; ++d) {
            const int o_a = (d == 0) ? O_A : O_XCF;
            if (PB) {
#pragma unroll
                for (int r = 0; r < 2; ++r) { const int e = tid + NTHR * r, row = e >> 4, c16 = e & 15;
                    const f32x2 x0 = __builtin_amdgcn_cvt_pk_f32_fp8((int)ra[r].x, false), x1 = __builtin_amdgcn_cvt_pk_f32_fp8((int)ra[r].x, true);
                    const f32x2 x2 = __builtin_amdgcn_cvt_pk_f32_fp8((int)ra[r].y, false), x3 = __builtin_amdgcn_cvt_pk_f32_fp8((int)ra[r].y, true);
                    constexpr float IS = 1.f / 4096.f;
                    *(LAS f32x4*)(L + o_a + row * FST + c16 * 32) = (f32x4){1.f - x0[0] * IS, 1.f - x0[1] * IS, 1.f - x1[0] * IS, 1.f - x1[1] * IS};
                    *(LAS f32x4*)(L + o_a + row * FST + c16 * 32 + 16) = (f32x4){1.f - x2[0] * IS, 1.f - x2[1] * IS, 1.f - x3[0] * IS, 1.f - x3[1] * IS};
                    *(LAS f32x4*)(L + O_U + row * FST + c16 * 32) = (f32x4){bflo(ru[r].x), bfhi(ru[r].x), bflo(ru[r].y), bfhi(ru[r].y)};
                    *(LAS f32x4*)(L + O_U + row * FST + c16 * 32 + 16) = (f32x4){bflo(ru[r].z), bfhi(ru[r].z), bflo(ru[r].w), bfhi(ru[r].w)}; }
                if (d == 0) PB_LOAD(i, 1); else PB_LOAD(i + 1, 0);
            } else {
            f32x4 aR[4], aI[4];
#pragma unroll
            for (int mt = 0; mt < 4; ++mt) { aR[mt] = (f32x4){0.f, 0.f, 0.f, 0.f}; aI[mt] = (f32x4){0.f, 0.f, 0.f, 0.f}; }
#pragma unroll
            for (int ks = 0; ks < 4; ++ks)
#pragma unroll
                for (int mt = 0; mt < 4; ++mt) { const bf16x8 xb = *(const LAS bf16x8*)(L + O_XCB + (16 * mt + fr) * 272 + (32 * ks + 8 * fq) * 2);
                    aR[mt] = __builtin_amdgcn_mfma_f32_16x16x32_bf16(wf[d][0][ks], xb, aR[mt], 0, 0, 0);
                    aI[mt] = __builtin_amdgcn_mfma_f32_16x16x32_bf16(wf[d][1][ks], xb, aI[mt], 0, 0, 0); }
#pragma unroll
            for (int mt = 0; mt < 4; ++mt) { const int tl = 16 * mt + fr, cl = 16 * w + 4 * fq;
                const f32x4 xc = *(const LAS f32x4*)(L + O_XCF + tl * FST + cl * 4);
                f32x4 av, uv;
#pragma unroll
                for (int e = 0; e < 4; ++e) { const float r = sigmoidf_(aR[mt][e] + br4[d][e]), ig = sigmoidf_(aI[mt][e] + bi4[d][e]);
                    const float a_ = __builtin_amdgcn_exp2f(r * sp4[d][e]); av[e] = a_; uv[e] = __builtin_amdgcn_sqrtf(fmaxf(1.f - a_ * a_, 0.f)) * (ig * xc[e]); }
                *(LAS f32x4*)(L + o_a + tl * FST + cl * 4) = av; *(LAS f32x4*)(L + O_U + tl * FST + cl * 4) = uv;
                { const size_t go = (mrow0 + tl) * DM + blk * 128 + cl;
                  int xa = 0; xa = __builtin_amdgcn_cvt_pk_fp8_f32((1.f - av[0]) * 4096.f, (1.f - av[1]) * 4096.f, xa, false); xa = __builtin_amdgcn_cvt_pk_fp8_f32((1.f - av[2]) * 4096.f, (1.f - av[3]) * 4096.f, xa, true);
                  v2u xu; xu.x = pk2(uv[0], uv[1]); xu.y = pk2(uv[2], uv[3]);
                  *(unsigned*)((d ? LA1 : LA0) + go) = (unsigned)xa; *(v2u*)((d ? LU1 : LU0) + go) = xu; } }
            }
            __syncthreads();
            {
                const int c = tid & 127, sub = tid >> 7;
                LAS float* pa = (LAS float*)(L + o_a) + c; const LAS float* pu = (const LAS float*)(L + O_U) + c;
                LAS f32x2* SUBT = (LAS f32x2*)(L + O_SUB);
                float h = 0.f, A = 1.f;
#pragma unroll
                for (int s2 = 0; s2 < 16; ++s2) { const int tl = d ? (16 * sub + 15 - s2) : (16 * sub + s2); const float a = pa[tl * 132], u = pu[tl * 132]; h = a * h + u; A *= a; }
                SUBT[sub * 128 + c] = (f32x2){A, h};
                __syncthreads();
                if (!PB) {
                    if (sub == 0) { float HH = 0.f, AA = 1.f;
#pragma unroll
                        for (int q = 0; q < 4; ++q) { const f32x2 ah = SUBT[(d ? 3 - q : q) * 128 + c]; HH = ah[0] * HH + ah[1]; AA *= ah[0]; }
                        AGG[((size_t)(b * 64 + seg) * 2 + d) * DM + blk * 128 + c] = (f32x2){AA, HH}; }
                } else {
                    float hc = d ? carry1 : carry0;
#pragma unroll
                    for (int q = 0; q < 3; ++q) { const int jq = d ? 3 - q : q; const f32x2 ah = SUBT[jq * 128 + c]; if (d ? (jq > sub) : (jq < sub)) hc = ah[0] * hc + ah[1]; }
                    if (d == 0) {
#pragma unroll
                        for (int s2 = 0; s2 < 16; ++s2) { const int tl = 16 * sub + s2; hc = pa[tl * 132] * hc + pu[tl * 132]; pa[tl * 132] = hc; }
                    } else { LAS float* ph = (LAS float*)(L + O_A) + c;
#pragma unroll
                        for (int s2 = 0; s2 < 16; ++s2) { const int tl = 16 * sub + 15 - s2; hc = pa[tl * 132] * hc + pu[tl * 132]; ph[tl * 132] += hc; } }
                }
            }
            __syncthreads();
        }
        if (PB) {
#pragma unroll
            for (int r = 0; r < 2; ++r) { const int e = tid + NTHR * r, row = e >> 4, c16 = e & 15;
                const v4u g = lgreg[r];
                const f32x4 h0 = *(const LAS f32x4*)(L + O_A + row * FST + c16 * 32), h1 = *(const LAS f32x4*)(L + O_A + row * FST + c16 * 32 + 16);
                v4u o;
                o.x = pk2(h0[0] * gelu_fast(bflo(g.x)), h0[1] * gelu_fast(bfhi(g.x))); o.y = pk2(h0[2] * gelu_fast(bflo(g.y)), h0[3] * gelu_fast(bfhi(g.y)));
                o.z = pk2(h1[0] * gelu_fast(bflo(g.z)), h1[1] * gelu_fast(bfhi(g.z))); o.w = pk2(h1[2] * gelu_fast(bflo(g.w)), h1[3] * gelu_fast(bfhi(g.w)));
                *(v4u*)(YL + (mrow0 + row) * DM + blk * 128 + c16 * 8) = o; }
            __syncthreads();
        }
    }
#undef RAW_LOAD
#undef PB_LOAD
}

__device__ __forceinline__ void mconv_phase(Frame& F) {
    const bf16* XM = (const bf16*)(F.ws + WS_XM); bf16* XC = (bf16*)F.out + (size_t)MTOK * DM;
    const float* cw = F.in[4]; const float* cb = F.in[5];
    const int NT = MTOK / 32 * 128;
    for (int g = F.bid * NTHR + F.tid; g < NT; g += F.G * NTHR) {
        const int chunk = g & 127, run = g >> 7, c0 = chunk * 8, m0 = run * 32, t0 = m0 & (SEQ - 1);
        float w[4][8], bias[8];
#pragma unroll
        for (int j = 0; j < 4; ++j) { const f32x4 a = *(const f32x4*)(cw + j * DM + c0), b = *(const f32x4*)(cw + j * DM + c0 + 4);
            w[j][0] = a[0]; w[j][1] = a[1]; w[j][2] = a[2]; w[j][3] = a[3]; w[j][4] = b[0]; w[j][5] = b[1]; w[j][6] = b[2]; w[j][7] = b[3]; }
        { const f32x4 a = *(const f32x4*)(cb + c0), b = *(const f32x4*)(cb + c0 + 4);
            bias[0] = a[0]; bias[1] = a[1]; bias[2] = a[2]; bias[3] = a[3]; bias[4] = b[0]; bias[5] = b[1]; bias[6] = b[2]; bias[7] = b[3]; }
        v4u win[4];
        const v4u zero = {0u, 0u, 0u, 0u};
        win[0] = zero;
        win[1] = (t0 >= 2) ? *(const v4u*)(XM + (size_t)(m0 - 2) * DM + c0) : zero;
        win[2] = (t0 >= 1) ? *(const v4u*)(XM + (size_t)(m0 - 1) * DM + c0) : zero;
        win[3] = *(const v4u*)(XM + (size_t)m0 * DM + c0);
#pragma unroll 4
        for (int i = 0; i < 32; ++i) {
            win[0] = win[1]; win[1] = win[2]; win[2] = win[3];
            win[3] = (t0 + i + 1 < SEQ) ? *(const v4u*)(XM + (size_t)(m0 + i + 1) * DM + c0) : zero;
            float y[8];
#pragma unroll
            for (int e = 0; e < 8; ++e) y[e] = bias[e];
#pragma unroll
            for (int j = 0; j < 4; ++j) {
                const unsigned p0 = win[j].x, p1 = win[j].y, p2 = win[j].z, p3 = win[j].w;
                y[0] += w[j][0] * bflo(p0); y[1] += w[j][1] * bfhi(p0); y[2] += w[j][2] * bflo(p1); y[3] += w[j][3] * bfhi(p1);
                y[4] += w[j][4] * bflo(p2); y[5] += w[j][5] * bfhi(p2); y[6] += w[j][6] * bflo(p3); y[7] += w[j][7] * bfhi(p3);
            }
#pragma unroll
            for (int e = 0; e < 8; ++e) y[e] = y[e] * sigmoidf_(y[e]);
            v4u o; o.x = pk2(y[0], y[1]); o.y = pk2(y[2], y[3]); o.z = pk2(y[4], y[5]); o.w = pk2(y[6], y[7]);
            *(v4u*)(XC + (size_t)(m0 + i) * DM + c0) = o;
        }
    }
}

typedef short s16x4 __attribute__((ext_vector_type(4)));
__device__ __forceinline__ bf16x8 tr_read_pair(unsigned a0, unsigned a1) {
    s16x4 r0, r1;
    asm volatile("ds_read_b64_tr_b16 %0, %2\n\tds_read_b64_tr_b16 %1, %3\n\ts_waitcnt lgkmcnt(0)" : "=&v"(r0), "=&v"(r1) : "v"(a0), "v"(a1) : "memory");
    return __builtin_shufflevector(r0, r1, 0, 1, 2, 3, 4, 5, 6, 7);
}
__device__ __forceinline__ float dpp_shr(float oldv, float x, int n) {
    const int o = __builtin_bit_cast(int, oldv), v = __builtin_bit_cast(int, x);
    int r;
    if (n == 1) r = __builtin_amdgcn_update_dpp(o, v, 0x111, 0xf, 0xf, false);
    else if (n == 2) r = __builtin_amdgcn_update_dpp(o, v, 0x112, 0xf, 0xf, false);
    else if (n == 4) r = __builtin_amdgcn_update_dpp(o, v, 0x114, 0xf, 0xf, false);
    else r = __builtin_amdgcn_update_dpp(o, v, 0x118, 0xf, 0xf, false);
    return __builtin_bit_cast(float, r);
}
__device__ __forceinline__ float rdlane(float x, int l) { return __builtin_bit_cast(float, __builtin_amdgcn_readlane(__builtin_bit_cast(int, x), l)); }
__device__ __forceinline__ float wave_incl_sum(float x, int lane) {
    x += dpp_shr(0.f, x, 1); x += dpp_shr(0.f, x, 2); x += dpp_shr(0.f, x, 4); x += dpp_shr(0.f, x, 8);
    const float t0 = rdlane(x, 15), t1 = rdlane(x, 31), t2 = rdlane(x, 47);
    return x + (lane >= 16 ? t0 : 0.f) + (lane >= 32 ? t1 : 0.f) + (lane >= 48 ? t2 : 0.f);
}
__device__ __forceinline__ float wave_incl_max(float x, int lane) {
    const float NI = -INFINITY;
    x = fmaxf(x, dpp_shr(NI, x, 1)); x = fmaxf(x, dpp_shr(NI, x, 2)); x = fmaxf(x, dpp_shr(NI, x, 4)); x = fmaxf(x, dpp_shr(NI, x, 8));
    const float t0 = rdlane(x, 15), t1 = rdlane(x, 31), t2 = rdlane(x, 47);
    return fmaxf(fmaxf(x, lane >= 16 ? t0 : NI), fmaxf(lane >= 32 ? t1 : NI, lane >= 48 ? t2 : NI));
}
__device__ __forceinline__ void mscan_phase(Frame& F) {
    const bf16* Q = (const bf16*)(F.ws + WS_LG); const bf16* K = (const bf16*)(F.ws + WS_K); const bf16* V = (const bf16*)(F.ws + WS_XL);
    const float* GT = (const float*)(F.ws + WS_GATE);
    constexpr int KS = 0, CTI = 33792, VT = 67584, VWT = 86016, PB = 104448, TAB = 113664, NT = 116736, NPART = 117760, DENT = 119808;
    constexpr int KST = 528, VST = 144, TABSZ = 1536;
    LAS unsigned char* L = F.lds;
    const int tid = F.tid, lane = F.lane, w = F.wave, fr = lane & 15, fq = lane >> 4, pt = w & 3, wg = w >> 2;
    for (int item = F.bid; item < 256; item += F.G) {
        const int es = item & 3, dir = (item >> 2) & 1, h = (item >> 3) & 3, b = item >> 5;
        bf16* H = dir ? ((bf16*)F.out + (size_t)MTOK * DM) : (bf16*)(F.ws + WS_XM);
        const size_t rowbase = (size_t)b * SEQ;
#define TOF(c, p) (dir ? (SEQ - 1 - 64 * (c) - (p)) : (64 * (c) + (p)))
        for (int e = tid; e < (33792 + 1024) / 4; e += NTHR) { if (e < 33792 / 4) ((LAS unsigned*)(L + CTI))[e] = 0u; else ((LAS unsigned*)(L + NT))[e - 33792 / 4] = 0u; }
        float m_run = 0.f;
        float gi_n = 0.f, gf_n = 0.f;
        if (w == 0) { const size_t m = rowbase + TOF(0, lane); gi_n = GT[m * 16 + dir * 8 + h]; gf_n = GT[m * 16 + dir * 8 + 4 + h]; }
#define G1_TABLES(setp) do { \
            const float logf_ = fminf(gf_n, 0.f) - __logf(1.f + __expf(-fabsf(gf_n))); const float b_ = wave_incl_sum(logf_, lane); const float a_ = gi_n - b_; \
            const float M_ = fmaxf(m_run, wave_incl_max(a_, lane)); const float Mend_ = rdlane(M_, 63), g_ = rdlane(b_, 63); \
            LAS float* T_ = (LAS float*)(setp); T_[lane] = a_; T_[64 + lane] = M_; T_[128 + lane] = __expf(m_run - M_); T_[192 + lane] = __expf(-(b_ + M_)); T_[256 + lane] = __expf(a_ - Mend_); \
            if (lane == 0) { T_[320] = __expf(m_run - Mend_); T_[321] = g_ + Mend_; } \
            m_run = g_ + Mend_; } while (0)
        if (w == 0) G1_TABLES(L + TAB);
        __syncthreads();
        bf16x8 qf[8];
        v4u kreg[4]; v4u vreg;
#define LOAD_KV(c) do { _Pragma("unroll") for (int r_ = 0; r_ < 4; ++r_) { const int i_ = tid + NTHR * r_, s_ = i_ >> 5, c16_ = i_ & 31; \
                kreg[r_] = *(const v4u*)(K + (rowbase + TOF(c, s_)) * DM + h * 256 + c16_ * 8); } \
            { const int s_ = tid & 63, e8_ = tid >> 6; vreg = *(const v4u*)(V + (rowbase + TOF(c, s_)) * DM + h * 256 + es * 64 + e8_ * 8); } } while (0)
#define STORE_KV(setidx) do { _Pragma("unroll") for (int r_ = 0; r_ < 4; ++r_) { const int i_ = tid + NTHR * r_, s_ = i_ >> 5, c16_ = i_ & 31; \
                *(LAS v4u*)(L + KS + s_ * KST + c16_ * 16) = kreg[r_]; } \
            { const int s_ = tid & 63, e8_ = tid >> 6; const float ws_ = ((const LAS float*)(L + TAB + (setidx) * TABSZ))[256 + s_]; \
              LAS bf16* vt_ = (LAS bf16*)(L + VT + (setidx) * 9216); LAS bf16* vw_ = (LAS bf16*)(L + VWT + (setidx) * 9216); \
              const unsigned wv_[4] = {vreg.x, vreg.y, vreg.z, vreg.w}; \
              _Pragma("unroll") for (int j_ = 0; j_ < 4; ++j_) { const float lo_ = bflo(wv_[j_]), hi_ = bfhi(wv_[j_]); const int e_ = e8_ * 8 + 2 * j_; \
                vt_[e_ * 72 + s_] = (bf16)(wv_[j_] & 0xffffu); vt_[(e_ + 1) * 72 + s_] = (bf16)(wv_[j_] >> 16); \
                vw_[e_ * 72 + s_] = (bf16)f2bf(lo_ * ws_); vw_[(e_ + 1) * 72 + s_] = (bf16)f2bf(hi_ * ws_); } } } while (0)
#define LOAD_Q(c) do { const size_t m_ = rowbase + TOF(c, 16 * pt + fr); _Pragma("unroll") for (int ks_ = 0; ks_ < 8; ++ks_) \
                qf[ks_] = *(const bf16x8*)(Q + m_ * DM + h * 256 + 32 * ks_ + 8 * fq); } while (0)
        LOAD_KV(0); LOAD_Q(0);
        STORE_KV(0);
        f32x4 Cacc[8], Nacc[2];
#pragma unroll
        for (int i = 0; i < 8; ++i) Cacc[i] = (f32x4){0.f, 0.f, 0.f, 0.f};
        Nacc[0] = (f32x4){0.f, 0.f, 0.f, 0.f}; Nacc[1] = (f32x4){0.f, 0.f, 0.f, 0.f};
        __syncthreads();
        for (int c = 0; c < 64; ++c) {
            const int cur = c & 1, nxt = cur ^ 1;
            const bool has_next = (c + 1 < 64);
            const LAS float* T = (const LAS float*)(L + TAB + cur * TABSZ);
            if (has_next) { LOAD_KV(c + 1); if (w == 0) { const size_t m = rowbase + TOF(c + 1, lane); gi_n = GT[m * 16 + dir * 8 + h]; gf_n = GT[m * 16 + dir * 8 + 4 + h]; } }
            const int p = 16 * pt + fr;
            const float Mp = T[64 + p], wi_p = T[128 + p];
            float cs = 0.f;
#pragma unroll
            for (int i = 0; i < 2; ++i) { const int st = 2 * wg + i;
                v2u pw = {0u, 0u};
                if (st <= pt) {
                    f32x4 sa = (f32x4){0.f, 0.f, 0.f, 0.f};
#pragma unroll
                    for (int ks = 0; ks < 8; ++ks) { const bf16x8 kf = *(const LAS bf16x8*)(L + KS + (16 * st + fr) * KST + (32 * ks + 8 * fq) * 2);
                        sa = __builtin_amdgcn_mfma_f32_16x16x32_bf16(kf, qf[ks], sa, 0, 0, 0); }
                    const f32x4 a4 = *(const LAS f32x4*)(T + 16 * st + 4 * fq);
                    float pv[4];
#pragma unroll
                    for (int r = 0; r < 4; ++r) { const int s_ = 16 * st + 4 * fq + r; const float wgt = (s_ <= p) ? __expf(a4[r] - Mp) : 0.f; pv[r] = sa[r] * wgt; cs += pv[r]; }
                    pw.x = pk2(pv[0], pv[1]); pw.y = pk2(pv[2], pv[3]);
                }
                *(LAS v2u*)(L + PB + p * VST + (16 * st + 4 * fq) * 2) = pw; }
            f32x4 O[2];
#pragma unroll
            for (int i = 0; i < 2; ++i) { const int et = 2 * wg + i; O[i] = (f32x4){0.f, 0.f, 0.f, 0.f};
#pragma unroll
                for (int ks = 0; ks < 8; ++ks) { const bf16x8 cf = *(const LAS bf16x8*)(L + CTI + (16 * et + fr) * KST + (32 * ks + 8 * fq) * 2);
                    O[i] = __builtin_amdgcn_mfma_f32_16x16x32_bf16(cf, qf[ks], O[i], 0, 0, 0); } }
            float di = 0.f;
#define DEN_INTER(ks) do { const f32x4 n0 = *(const LAS f32x4*)(L + NT + (32 * (ks) + 8 * fq) * 4), n1 = *(const LAS f32x4*)(L + NT + (32 * (ks) + 8 * fq) * 4 + 16); \
                const v4u qw = __builtin_bit_cast(v4u, qf[ks]); \
                di += bflo(qw.x) * n0[0] + bfhi(qw.x) * n0[1] + bflo(qw.y) * n0[2] + bfhi(qw.y) * n0[3] + bflo(qw.z) * n1[0] + bfhi(qw.z) * n1[1] + bflo(qw.w) * n1[2] + bfhi(qw.w) * n1[3]; } while (0)
            if (wg == 0) { DEN_INTER(0); DEN_INTER(1); DEN_INTER(2); DEN_INTER(3); }
            else { DEN_INTER(4); DEN_INTER(5); DEN_INTER(6); DEN_INTER(7); }
#undef DEN_INTER
            di += __shfl_xor(di, 16); di += __shfl_xor(di, 32);
            cs += __shfl_xor(cs, 16); cs += __shfl_xor(cs, 32);
            if (fq == 0) ((LAS float*)(L + DENT))[wg * 64 + p] = wi_p * di + cs;
            if (has_next) LOAD_Q(c + 1);
            if (has_next && w == 0) G1_TABLES(L + TAB + nxt * TABSZ);
            __syncthreads();
#pragma unroll
            for (int i = 0; i < 2; ++i) { const int et = 2 * wg + i; O[i] = O[i] * wi_p;
#pragma unroll
                for (int ks = 0; ks < 2; ++ks) { const bf16x8 vf = *(const LAS bf16x8*)(L + VT + cur * 9216 + (16 * et + fr) * VST + (32 * ks + 8 * fq) * 2);
                    const bf16x8 pf = *(const LAS bf16x8*)(L + PB + p * VST + (32 * ks + 8 * fq) * 2);
                    O[i] = __builtin_amdgcn_mfma_f32_16x16x32_bf16(vf, pf, O[i], 0, 0, 0); } }
            { const float den = ((const LAS float*)(L + DENT))[p] + ((const LAS float*)(L + DENT))[64 + p];
              const float inv = 1.f / fmaxf(fabsf(den), T[192 + p]);
              const size_t m = rowbase + TOF(c, p);
#pragma unroll
              for (int i = 0; i < 2; ++i) { const int et = 2 * wg + i; v2u o; o.x = pk2(O[i][0] * inv, O[i][1] * inv); o.y = pk2(O[i][2] * inv, O[i][3] * inv);
                  *(v2u*)(H + m * DM + h * 256 + es * 64 + 16 * et + 4 * fq) = o; } }
            { const float decay = T[320];
              const bf16x8 vw0 = *(const LAS bf16x8*)(L + VWT + cur * 9216 + (16 * pt + fr) * VST + (8 * fq) * 2);
              const bf16x8 vw1 = *(const LAS bf16x8*)(L + VWT + cur * 9216 + (16 * pt + fr) * VST + (32 + 8 * fq) * 2);
              bf16x8 wsf0, wsf1;
              { const f32x4 w0 = *(const LAS f32x4*)(T + 256 + 8 * fq), w1 = *(const LAS f32x4*)(T + 256 + 8 * fq + 4), w2 = *(const LAS f32x4*)(T + 288 + 8 * fq), w3 = *(const LAS f32x4*)(T + 288 + 8 * fq + 4);
                const bool c0 = (fr == 0);
                v4u a, b; a.x = c0 ? pk2(w0[0], w0[1]) : 0u; a.y = c0 ? pk2(w0[2], w0[3]) : 0u; a.z = c0 ? pk2(w1[0], w1[1]) : 0u; a.w = c0 ? pk2(w1[2], w1[3]) : 0u;
                b.x = c0 ? pk2(w2[0], w2[1]) : 0u; b.y = c0 ? pk2(w2[2], w2[3]) : 0u; b.z = c0 ? pk2(w3[0], w3[1]) : 0u; b.w = c0 ? pk2(w3[2], w3[3]) : 0u;
                wsf0 = __builtin_bit_cast(bf16x8, a); wsf1 = __builtin_bit_cast(bf16x8, b); }
              const int l16 = lane & 15, q4 = l16 >> 2, p4 = l16 & 3;
              const unsigned kb = (unsigned)(uintptr_t)(L + KS) + (unsigned)((8 * fq + q4) * KST + 4 * p4 * 2);
#pragma unroll
              for (int dtl = 0; dtl < 8; dtl += 2) { const int dt = 8 * wg + dtl; const unsigned a0 = kb + dt * 32;
                  s16x4 r0, r1, r2, r3, r4, r5, r6, r7;
                  asm volatile("ds_read_b64_tr_b16 %0, %8\n\tds_read_b64_tr_b16 %1, %8 offset:2112\n\tds_read_b64_tr_b16 %2, %8 offset:16896\n\tds_read_b64_tr_b16 %3, %8 offset:19008\n\t"
                               "ds_read_b64_tr_b16 %4, %8 offset:32\n\tds_read_b64_tr_b16 %5, %8 offset:2144\n\tds_read_b64_tr_b16 %6, %8 offset:16928\n\tds_read_b64_tr_b16 %7, %8 offset:19040\n\ts_waitcnt lgkmcnt(0)"
                               : "=&v"(r0), "=&v"(r1), "=&v"(r2), "=&v"(r3), "=&v"(r4), "=&v"(r5), "=&v"(r6), "=&v"(r7) : "v"(a0) : "memory");
                  const bf16x8 k0 = __builtin_shufflevector(r0, r1, 0, 1, 2, 3, 4, 5, 6, 7), k1 = __builtin_shufflevector(r2, r3, 0, 1, 2, 3, 4, 5, 6, 7);
                  const bf16x8 k2 = __builtin_shufflevector(r4, r5, 0, 1, 2, 3, 4, 5, 6, 7), k3 = __builtin_shufflevector(r6, r7, 0, 1, 2, 3, 4, 5, 6, 7);
                  Cacc[dtl] = Cacc[dtl] * decay; Cacc[dtl + 1] = Cacc[dtl + 1] * decay;
                  Cacc[dtl] = __builtin_amdgcn_mfma_f32_16x16x32_bf16(k0, vw0, Cacc[dtl], 0, 0, 0);
                  Cacc[dtl + 1] = __builtin_amdgcn_mfma_f32_16x16x32_bf16(k2, vw0, Cacc[dtl + 1], 0, 0, 0);
                  Cacc[dtl] = __builtin_amdgcn_mfma_f32_16x16x32_bf16(k1, vw1, Cacc[dtl], 0, 0, 0);
                  Cacc[dtl + 1] = __builtin_amdgcn_mfma_f32_16x16x32_bf16(k3, vw1, Cacc[dtl + 1], 0, 0, 0);
                  if (dtl == 2 * pt) {
                      Nacc[0] = Nacc[0] * decay; Nacc[1] = Nacc[1] * decay;
                      Nacc[0] = __builtin_amdgcn_mfma_f32_16x16x32_bf16(k0, wsf0, Nacc[0], 0, 0, 0); Nacc[1] = __builtin_amdgcn_mfma_f32_16x16x32_bf16(k2, wsf0, Nacc[1], 0, 0, 0);
                      Nacc[0] = __builtin_amdgcn_mfma_f32_16x16x32_bf16(k1, wsf1, Nacc[0], 0, 0, 0); Nacc[1] = __builtin_amdgcn_mfma_f32_16x16x32_bf16(k3, wsf1, Nacc[1], 0, 0, 0); } } }
            __syncthreads();
            { const float decay = T[320];
#pragma unroll
              for (int dtl = 0; dtl < 8; ++dtl) { const int dt = 8 * wg + dtl; v2u o; o.x = pk2(Cacc[dtl][0], Cacc[dtl][1]); o.y = pk2(Cacc[dtl][2], Cacc[dtl][3]);
                  *(LAS v2u*)(L + CTI + (16 * pt + fr) * KST + (16 * dt + 4 * fq) * 2) = o; }
              if (fr == 0) { *(LAS f32x4*)(L + NT + (16 * (8 * wg + 2 * pt) + 4 * fq) * 4) = Nacc[0]; *(LAS f32x4*)(L + NT + (16 * (8 * wg + 2 * pt + 1) + 4 * fq) * 4) = Nacc[1]; } }
            if (has_next) STORE_KV(nxt);
            __syncthreads();
        }
#undef TOF
#undef G1_TABLES
#undef LOAD_KV
#undef STORE_KV
#undef LOAD_Q
    }
}

__device__ __forceinline__ void ym_phase(Frame& F) {
    const bf16* HF = (const bf16*)(F.ws + WS_XM); const bf16* HB = (const bf16*)F.out + (size_t)MTOK * DM; bf16* OP = (bf16*)(F.ws + WS_OP);
    const float* ng = F.in[9];
    const int gw = F.bid * NWAVES + F.wave, NGW = F.G * NWAVES;
    for (int m = gw; m < MTOK; m += NGW) {
#pragma unroll
        for (int hd = 0; hd < 4; ++hd) {
            const size_t o = (size_t)m * DM + hd * 256 + F.lane * 4;
            const v2u a = *(const v2u*)(HF + o), b = *(const v2u*)(HB + o), op = *(const v2u*)(OP + o);
            const float v0 = bflo(a.x) + bflo(b.x), v1 = bfhi(a.x) + bfhi(b.x), v2 = bflo(a.y) + bflo(b.y), v3 = bfhi(a.y) + bfhi(b.y);
            const float r = rsqrtf(wave_sum((v0 * v0 + v1 * v1) + (v2 * v2 + v3 * v3)) * (1.f / 256.f) + EPS);
            const f32x4 g = *(const f32x4*)(ng + hd * 256 + F.lane * 4);
            v2u w; w.x = pk2(sigmoidf_(bflo(op.x)) * v0 * r * g[0], sigmoidf_(bfhi(op.x)) * v1 * r * g[1]);
            w.y = pk2(sigmoidf_(bflo(op.y)) * v2 * r * g[2], sigmoidf_(bfhi(op.y)) * v3 * r * g[3]);
            *(v2u*)(OP + o) = w;
        }
    }
    {
        float* usc = (float*)(F.ws + WS_LG + 16 * MiB); float* vsc = usc + NEXP;
        for (int row = gw; row < 2 * NEXP; row += NGW) {
            const bool isv = row >= NEXP; const int r = isv ? row - NEXP : row;
            const f32x4* src = (const f32x4*)(F.in[isv ? 24 : 23] + (size_t)r * DM) + F.lane * 4;
            f32x4 a[4]; float ss = 0.f;
#pragma unroll
            for (int j = 0; j < 4; ++j) { a[j] = src[j]; ss += (a[j][0] * a[j][0] + a[j][1] * a[j][1]) + (a[j][2] * a[j][2] + a[j][3] * a[j][3]); }
            const float rms = sqrtf(wave_sum(ss) * (1.f / DM));
            const float sc = fmaxf(rms * 0.5f, 1e-30f), inv = 1.f / sc;
            unsigned o[2] = {0u, 0u};
#pragma unroll
            for (int j = 0; j < 4; ++j) { const f32x4 q = a[j] * inv;
                if (j & 1) { o[j >> 1] = __builtin_amdgcn_cvt_scalef32_pk_fp4_f32(o[j >> 1], q[0], q[1], 1.0f, 2); o[j >> 1] = __builtin_amdgcn_cvt_scalef32_pk_fp4_f32(o[j >> 1], q[2], q[3], 1.0f, 3); }
                else       { o[j >> 1] = __builtin_amdgcn_cvt_scalef32_pk_fp4_f32(o[j >> 1], q[0], q[1], 1.0f, 0); o[j >> 1] = __builtin_amdgcn_cvt_scalef32_pk_fp4_f32(o[j >> 1], q[2], q[3], 1.0f, 1); } }
            *(v2u*)(F.ws + WS_LG + (isv ? 8 * MiB : 0) + (size_t)r * (DM / 2) + F.lane * 8) = (v2u){o[0], o[1]};
            if (F.lane == 0) (isv ? vsc : usc)[r] = sc;
        }
    }
}

typedef float f32x16 __attribute__((ext_vector_type(16)));
#define TOPK_INSERT(L, xv) do { const float x_ = (xv); \
    L[15] = __builtin_amdgcn_fmed3f(L[14], L[15], x_); L[14] = __builtin_amdgcn_fmed3f(L[13], L[14], x_); L[13] = __builtin_amdgcn_fmed3f(L[12], L[13], x_); L[12] = __builtin_amdgcn_fmed3f(L[11], L[12], x_); \
    L[11] = __builtin_amdgcn_fmed3f(L[10], L[11], x_); L[10] = __builtin_amdgcn_fmed3f(L[9], L[10], x_); L[9] = __builtin_amdgcn_fmed3f(L[8], L[9], x_); L[8] = __builtin_amdgcn_fmed3f(L[7], L[8], x_); \
    L[7] = __builtin_amdgcn_fmed3f(L[6], L[7], x_); L[6] = __builtin_amdgcn_fmed3f(L[5], L[6], x_); L[5] = __builtin_amdgcn_fmed3f(L[4], L[5], x_); L[4] = __builtin_amdgcn_fmed3f(L[3], L[4], x_); \
    L[3] = __builtin_amdgcn_fmed3f(L[2], L[3], x_); L[2] = __builtin_amdgcn_fmed3f(L[1], L[2], x_); L[1] = __builtin_amdgcn_fmed3f(L[0], L[1], x_); L[0] = fmaxf(L[0], x_); } while (0)
template <int I> struct CandRow {
    static __device__ __forceinline__ void run(const float (&L0)[16], const float (&L1)[16], float (&R)[16]) {
        constexpr int NJ = 16 / (I + 1);
#pragma unroll
        for (int j = 0; j < NJ; ++j) { const float sm = L0[I] + L1[j];
            const float pk = __builtin_bit_cast(float, (__builtin_bit_cast(unsigned, sm) & 0xffffff00u) | (unsigned)(I * 16 + j)); TOPK_INSERT(R, pk); }
        if constexpr (I < 15) CandRow<I + 1>::run(L0, L1, R);
    }
};
__device__ __forceinline__ unsigned pick4(unsigned d0, unsigned d1, unsigned d2, unsigned d3, int i) {
    const int q = i >> 2; unsigned d = d0; d = (q == 1) ? d1 : d; d = (q == 2) ? d2 : d; d = (q == 3) ? d3 : d; return (d >> (8 * (i & 3))) & 127u;
}
__device__ __forceinline__ void select_phase(Frame& F) {
    const bf16* PQ = (const bf16*)(F.ws + WS_MG); const bf16* KEYS = (const bf16*)(F.ws + WS_KEYS);
    int* IDX = (int*)(F.ws + WS_K); float* GW = (float*)(F.ws + WS_K + 16 * MiB);
    LAS unsigned char* L = F.lds;
    const int tid = F.tid, lane = F.lane, w = F.wave, l31 = lane & 31, hh = lane >> 5;
    const float NEG_INF = -INFINITY;
    for (int grp = F.bid; grp < MTOK / 128; grp += F.G) {
        const int tb = grp * 4 + (w & 3);
        const size_t m = (size_t)tb * 32 + l31;
        for (int hp = 0; hp < 4; ++hp) {
            __syncthreads();
#pragma unroll 4
            for (int r = 0; r < 16; ++r) { const int e = tid + NTHR * r, R = e >> 4, c = e & 15;
                *(LAS v4u*)(L + R * 256 + ((c ^ (R & 15)) * 16)) = *(const v4u*)(KEYS + ((size_t)(hp * 512 + R) * 128 + c * 8)); }
            __syncthreads();
            const int hl = w >> 2, h = 2 * hp + hl;
            float L0[16], L1[16];
#pragma unroll
            for (int p = 0; p < 2; ++p) {
                bf16x8 qf[8];
#pragma unroll
                for (int ks = 0; ks < 8; ++ks) qf[ks] = *(const bf16x8*)(PQ + m * 2048 + h * 256 + p * 128 + 16 * ks + 8 * hh);
                f32x16 acc[4];
#pragma unroll
                for (int kb = 0; kb < 4; ++kb)
#pragma unroll
                    for (int r = 0; r < 16; ++r) acc[kb][r] = 0.f;
#pragma unroll
                for (int ks = 0; ks < 8; ++ks)
#pragma unroll
                    for (int kb = 0; kb < 4; ++kb) { const int R = (hl * 2 + p) * 128 + 32 * kb + l31;
                        const bf16x8 kf = *(const LAS bf16x8*)(L + R * 256 + (((2 * ks + hh) ^ (lane & 15)) * 16));
                        acc[kb] = __builtin_amdgcn_mfma_f32_32x32x16_bf16(kf, qf[ks], acc[kb], 0, 0, 0); }
                float Lc[16];
#pragma unroll
                for (int i = 0; i < 16; ++i) Lc[i] = NEG_INF;
                const unsigned hh4 = (unsigned)hh << 2;
#pragma unroll
                for (int kb = 0; kb < 4; ++kb)
#pragma unroll
                    for (int r = 0; r < 16; ++r) { const unsigned nlo = (unsigned)(32 * kb + (r & 3) + 8 * (r >> 2));
                        const float av_ = acc[kb][r];
                        const float pk = __uint_as_float(((__float_as_uint(av_) & 0xffffff80u) | hh4) | nlo); TOPK_INSERT(Lc, pk); }
                float Lo[16];
#pragma unroll
                for (int i = 0; i < 16; ++i) Lo[i] = __shfl_xor(Lc[i], 32);
#pragma unroll
                for (int i = 0; i < 16; ++i) TOPK_INSERT(Lc, Lo[i]);
#pragma unroll
                for (int i = 0; i < 16; ++i) { if (p == 0) L0[i] = Lc[i]; else L1[i] = Lc[i]; }
            }
            float R[16];
#pragma unroll
            for (int i = 0; i < 16; ++i) R[i] = NEG_INF;
            CandRow<0>::run(L0, L1, R);
            unsigned a0 = 0, a1 = 0, a2 = 0, a3 = 0, b0 = 0, b1 = 0, b2 = 0, b3 = 0;
#pragma unroll
            for (int i = 0; i < 4; ++i) { a0 |= (__builtin_bit_cast(unsigned, L0[i]) & 127u) << (8 * i); a1 |= (__builtin_bit_cast(unsigned, L0[4 + i]) & 127u) << (8 * i);
                a2 |= (__builtin_bit_cast(unsigned, L0[8 + i]) & 127u) << (8 * i); a3 |= (__builtin_bit_cast(unsigned, L0[12 + i]) & 127u) << (8 * i);
                b0 |= (__builtin_bit_cast(unsigned, L1[i]) & 127u) << (8 * i); b1 |= (__builtin_bit_cast(unsigned, L1[4 + i]) & 127u) << (8 * i);
                b2 |= (__builtin_bit_cast(unsigned, L1[8 + i]) & 127u) << (8 * i); b3 |= (__builtin_bit_cast(unsigned, L1[12 + i]) & 127u) << (8 * i); }
            float ex[16]; float sum = 0.f; int id[16];
#pragma unroll
            for (int r = 0; r < 16; ++r) { ex[r] = __expf(R[r] - R[0]); sum += ex[r];
                const unsigned cid = __builtin_bit_cast(unsigned, R[r]) & 255u;
                id[r] = (int)(pick4(a0, a1, a2, a3, (int)(cid >> 4)) * 128u + pick4(b0, b1, b2, b3, (int)(cid & 15u))); }
            const float inv = 1.f / sum;
            if (hh == 0) {
#pragma unroll
                for (int q = 0; q < 4; ++q) {
                    *(int4*)(IDX + m * 128 + h * 16 + 4 * q) = make_int4(id[4 * q], id[4 * q + 1], id[4 * q + 2], id[4 * q + 3]);
                    *(f32x4*)(GW + m * 128 + h * 16 + 4 * q) = (f32x4){ex[4 * q] * inv, ex[4 * q + 1] * inv, ex[4 * q + 2] * inv, ex[4 * q + 3] * inv}; }
            }
        }
    }
}

template <int B> __device__ __forceinline__ f32x2 fp4b(unsigned w) { return __builtin_amdgcn_cvt_scalef32_pk_f32_fp4(w, 1.0f, B); }
typedef int v8i_t __attribute__((ext_vector_type(8)));
#define AP_SLOT(e) (4 * (((e) >> 1) & 3) + 2 * ((e) >> 3) + ((e) & 1))
__device__ __forceinline__ void apply_phase(Frame& F, float* OUTP) {
    const unsigned char* U8 = F.ws + WS_LG; const unsigned char* V8 = F.ws + WS_LG + 8 * MiB;
    const float* USC = (const float*)(F.ws + WS_LG + 16 * MiB); const float* VSC = USC + NEXP;
    const int* IDX = (const int*)(F.ws + WS_K); const float* GW = (const float*)(F.ws + WS_K + 16 * MiB);
    const float* g2 = F.in[20]; const float* gf = F.in[25];
    const float* X1 = F.out;
    const int lane = F.lane, fr = lane & 15, fq = lane >> 4;
    constexpr int APW = 2 * 16 * 528 + 1024;
    LAS unsigned char* UL = F.lds + F.wave * APW; LAS unsigned char* VL = UL + 16 * 528; LAS unsigned char* H8 = VL + 16 * 528;
    const int pe = 2 * fq + (fr & 1) + 8 * ((fr >> 1) & 1);
    const int bsh = 8 * (fr & 3); const unsigned mlo = fr < 4 ? ~0u : 0u, mhi = (fr >= 4 && fr < 8) ? ~0u : 0u;
#define AP_LOADROWS(SEL, KB) _Pragma("unroll") for (int e = 0; e < 16; ++e) { \
        const size_t ro = (size_t)__builtin_amdgcn_readlane(SEL, ((KB) + e) & 63) * (DM / 2) + lane * 8; uu[e] = *(const v2u*)(U8 + ro); vv[e] = *(const v2u*)(V8 + ro); }
    for (int grp = F.bid; grp < MTOK / 128; grp += F.G) {
        const int mbase = grp * 128 + F.wave;
        int ni0 = IDX[(size_t)mbase * 128 + lane], ni1 = IDX[(size_t)mbase * 128 + 64 + lane];
        float ngw0 = GW[(size_t)mbase * 128 + lane], ngw1 = GW[(size_t)mbase * 128 + 64 + lane];
        f32x4 nxr[4];
#pragma unroll
        for (int q = 0; q < 4; ++q) nxr[q] = *(const f32x4*)(X1 + (size_t)mbase * DM + lane * 16 + q * 4);
        v2u uu[16], vv[16];
        AP_LOADROWS(ni0, 0)
        int i0 = 0, i1 = 0; float gw0 = 0.f, gw1 = 0.f; f32x4 xr[4], oacc[8];
#pragma unroll
        for (int q = 0; q < 4; ++q) xr[q] = (f32x4){0.f, 0.f, 0.f, 0.f};
#pragma unroll
        for (int i = 0; i < 8; ++i) oacc[i] = (f32x4){0.f, 0.f, 0.f, 0.f};
#pragma unroll 1
        for (int it = 0; it < 128; ++it) {
            const int bt = it & 7, m = mbase + 8 * (it >> 3);
            if (bt == 0) {
                i0 = ni0; i1 = ni1; gw0 = ngw0; gw1 = ngw1; float s = 0.f;
#pragma unroll
                for (int q = 0; q < 4; ++q) { xr[q] = nxr[q]; s += (xr[q][0] * xr[q][0] + xr[q][1] * xr[q][1]) + (xr[q][2] * xr[q][2] + xr[q][3] * xr[q][3]); }
                const float r2 = rsqrtf(wave_sum(s) * (1.f / DM) + EPS);
                v4u h8;
#pragma unroll
                for (int q = 0; q < 4; ++q) { const f32x4 g = *(const f32x4*)(g2 + lane * 16 + q * 4); const f32x4 hq = xr[q] * r2 * g;
                    int pk = 0; pk = __builtin_amdgcn_cvt_pk_fp8_f32(hq[0], hq[1], pk, false); pk = __builtin_amdgcn_cvt_pk_fp8_f32(hq[2], hq[3], pk, true); h8[q] = (unsigned)pk; }
                *(LAS v4u*)(H8 + lane * 16) = h8;
#pragma unroll
                for (int i = 0; i < 8; ++i) oacc[i] = (f32x4){0.f, 0.f, 0.f, 0.f};
                const int mn = (it + 8 < 128) ? m + 8 : m;
                ni0 = IDX[(size_t)mn * 128 + lane]; ni1 = IDX[(size_t)mn * 128 + 64 + lane]; ngw0 = GW[(size_t)mn * 128 + lane]; ngw1 = GW[(size_t)mn * 128 + 64 + lane];
#pragma unroll
                for (int q = 0; q < 4; ++q) nxr[q] = *(const f32x4*)(X1 + (size_t)mn * DM + lane * 16 + q * 4);
            }
            const int k0 = bt * 16;
            const int isel = (k0 < 64) ? i0 : i1;
            const int myidx = __shfl(isel, (k0 + pe) & 63);
            const float su = USC[myidx], sv = VSC[myidx];
#pragma unroll
            for (int e = 0; e < 16; ++e) { *(LAS v2u*)(UL + AP_SLOT(e) * 528 + lane * 8) = uu[e]; *(LAS v2u*)(VL + e * 528 + lane * 8) = vv[e]; }
            { const int nk = (k0 + 16) & 127; const int nsel = (bt == 7) ? ni0 : ((nk < 64) ? i0 : i1);
              AP_LOADROWS(nsel, nk) }
            f32x4 da = (f32x4){0.f, 0.f, 0.f, 0.f}, db = (f32x4){0.f, 0.f, 0.f, 0.f};
#pragma unroll
            for (int ks = 0; ks < 8; ++ks) {
                const v4u af = *(const LAS v4u*)(UL + fr * 528 + 64 * ks + 16 * fq);
                const v4u b0 = *(const LAS v4u*)(H8 + 128 * ks + 16 * fq), b1 = *(const LAS v4u*)(H8 + 128 * ks + 64 + 16 * fq);
                const v8i_t A = {(int)af.x, (int)af.y, (int)af.z, (int)af.w, 0, 0, 0, 0};
                const v8i_t B = {(int)b0.x, (int)b0.y, (int)b0.z, (int)b0.w, (int)b1.x, (int)b1.y, (int)b1.z, (int)b1.w};
                if (ks & 1) db = __builtin_amdgcn_mfma_scale_f32_16x16x128_f8f6f4(A, B, db, 4  , 0  , 0, 0x7F7F7F7F, 0, 0x7F7F7F7F);
                else        da = __builtin_amdgcn_mfma_scale_f32_16x16x128_f8f6f4(A, B, da, 4, 0, 0, 0x7F7F7F7F, 0, 0x7F7F7F7F);
            }
            const f32x4 d4 = da + db;
            const int sel = fr & 3;
            float t = d4[0]; t = (sel == 1) ? d4[1] : t; t = (sel == 2) ? d4[2] : t; t = (sel == 3) ? d4[3] : t;
            const float gk = __shfl((k0 < 64) ? gw0 : gw1, (k0 + pe) & 63);
            const float wl = gk * gelu_fast(t * su) * sv;
            float wm = fabsf(wl); wm = fmaxf(wm, __shfl_xor(wm, 1)); wm = fmaxf(wm, __shfl_xor(wm, 2)); wm = fmaxf(wm, __shfl_xor(wm, 16)); wm = fmaxf(wm, __shfl_xor(wm, 32));
            int E = (int)(__float_as_uint(wm) >> 23); E = E < 8 ? 8 : E;
            const float wq = wl * __uint_as_float((unsigned)(261 - E) << 23);
            const int scb = (E - 7) * 0x01010101;
            v8i_t Bw;
#define AP_WQ(tq, ctrl) { const float wt = __builtin_bit_cast(float, __builtin_amdgcn_update_dpp(0, __builtin_bit_cast(int, wq), ctrl, 0xf, 0xf, false)); \
                const unsigned p8 = (unsigned)__builtin_amdgcn_cvt_pk_fp8_f32(wt, 0.f, 0, false) << bsh; Bw[2 * tq] = (int)(p8 & mlo); Bw[2 * tq + 1] = (int)(p8 & mhi); }
            AP_WQ(0, 0x00) AP_WQ(1, 0x55) AP_WQ(2, 0xAA) AP_WQ(3, 0xFF)
#pragma unroll
            for (int c = 0; c < 8; ++c) {
                v4u av;
                av.x = *(const LAS unsigned*)(VL + (4 * fq + 0) * 528 + 64 * c + 4 * fr); av.y = *(const LAS unsigned*)(VL + (4 * fq + 1) * 528 + 64 * c + 4 * fr);
                av.z = *(const LAS unsigned*)(VL + (4 * fq + 2) * 528 + 64 * c + 4 * fr); av.w = *(const LAS unsigned*)(VL + (4 * fq + 3) * 528 + 64 * c + 4 * fr);
                const v8i_t A = {(int)av.x, (int)av.y, (int)av.z, (int)av.w, 0, 0, 0, 0};
                oacc[c] = __builtin_amdgcn_mfma_scale_f32_16x16x128_f8f6f4(A, Bw, oacc[c], 4, 0, 0, 0x7F7F7F7F, 0, scb);
            }
            if (bt == 7) {
                if (fr < 8) {
#pragma unroll
                    for (int c = 0; c < 8; ++c)
#pragma unroll
                        for (int r = 0; r < 4; ++r) { const float o = oacc[c][r]; *(LAS unsigned*)(UL + 4 * ((4 * c + fq) * 40 + 8 * r + fr)) = __float_as_uint(o); }
                }
                float s2 = 0.f; f32x4 ov[4];
#pragma unroll
                for (int q = 0; q < 4; ++q) { const v4u ou = *(const LAS v4u*)(UL + 4 * ((lane >> 1) * 40 + (lane & 1) * 16 + 4 * q));
                    ov[q] = (f32x4){__uint_as_float(ou.x), __uint_as_float(ou.y), __uint_as_float(ou.z), __uint_as_float(ou.w)} + xr[q];
                    s2 += (ov[q][0] * ov[q][0] + ov[q][1] * ov[q][1]) + (ov[q][2] * ov[q][2] + ov[q][3] * ov[q][3]); }
                const float rf = rsqrtf(wave_sum(s2) * (1.f / DM) + EPS);
#pragma unroll
                for (int q = 0; q < 4; ++q) { const f32x4 g = *(const f32x4*)(gf + lane * 16 + q * 4);
                    *(f32x4*)(OUTP + (size_t)m * DM + lane * 16 + q * 4) = ov[q] * rf * g; }
            }
        }
    }
}

constexpr int N_PHASES = 13;
__global__ void __launch_bounds__(NTHR, 2) mega_fwd(Args args) {
    extern __shared__ __attribute__((aligned(16))) unsigned char lds[];
    Frame F;
    F.lds = (LAS unsigned char*)lds;
    F.tid = threadIdx.x; F.lane = F.tid & 63; F.wave = __builtin_amdgcn_readfirstlane(F.tid >> 6);
    F.G = gridDim.x; F.bid = blockIdx.x;
    F.in = args.in; F.out = args.out; F.ws = args.ws;
    volatile LAS unsigned* MISC = (volatile LAS unsigned*)(F.lds + MISC_OFF);
    for (int u = F.tid; u < (LDS_BYTES - LDSCTL_OFF) / 4; u += NTHR) ((LAS unsigned*)(F.lds + LDSCTL_OFF))[u] = 0u;
    __syncthreads();
    XcdBarrier bar; bar.bar = (unsigned*)(args.ws + WS_CTL) + CW_BAR; bar.x = 0; bar.st = nullptr;
    const bool one_launch = (args.ph_hi - args.ph_lo) > 1;
    if (one_launch) bar = xcd_barrier_post((unsigned*)(args.ws + WS_CTL) + CW_BAR, MISC + 8);
    const int lo = args.ph_lo, hi = args.ph_hi;
#define IN(k) (lo <= (k) && (k) < hi)
#define SEAM(k) do { if (IN(k) && IN((k) + 1)) xcd_barrier(bar); } while (0)
    unsigned char* ws = args.ws;

#ifndef PROBE_MASK
#define PROBE_MASK 0
#endif
#define REP(k) _Pragma("unroll") for (int rep_ = 0; rep_ < (((PROBE_MASK >> (k)) & 1) ? 2 : 1); ++rep_)
    if (IN(0)) REP(0) { p0_prologue(F); if (rep_ == 0 && ((PROBE_MASK >> 0) & 1)) xcd_barrier(bar); } SEAM(0);
    if (IN(1)) REP(1) {
        gates_phase(F);
        { AddrP1 g{(const char*)(ws + WS_K), (const char*)(ws + WS_WIN), 1024, 1024, 1024, 4, 0, 8};
          pg8::StaticOrder S; S.init(MTOK, 2048, F.G, F.bid, 4);
          EpiBf16<DstP1> E{DstP1{ws, 4, 0, 8}, 1.f};
          pg8::gemm_phase(F.lds, g, S, E); }
        { AddrP1 g{(const char*)F.out, (const char*)(ws + WS_WIN8), 512, 512, 512, 8, 4, 8};
          pg8::StaticOrder S; S.init(MTOK, 4096, F.G, F.bid, 4);
          EpiBf16<DstP1, true> E{DstP1{ws, 8, 4, 8}, 1.f / 1024.f};
          pg8::gemm_phase<EpiBf16<DstP1, true>, AddrP1, 1>(F.lds, g, S, E); }
    } SEAM(1);
    if (IN(2)) REP(2) { lru_phase<false>(F); } SEAM(2);
    if (IN(3)) REP(3) { lru_phase<true>(F); } SEAM(3);
    if (IN(4)) REP(4) { mconv_phase(F); } SEAM(4);
    if (IN(5)) REP(5) {
        const char* xc = (const char*)F.out + (size_t)MTOK * DM * 2;
        AddrQKV g{xc, (long)((const char*)(ws + WS_XM) - xc), (const char*)(ws + WS_WQKV), 1024, 256, 256};
        pg8::StaticOrder S; S.init(MTOK, 12 * 256, F.G, F.bid);
        EpiBf16<DstQKV> E{DstQKV{(char*)(ws + WS_LG), (long)WS_K - (long)WS_LG, (long)WS_XL - (long)WS_LG}, 1.f};
        pg8::gemm_phase(F.lds, g, S, E);
    } SEAM(5);
    if (IN(6)) REP(6) { mscan_phase(F); } SEAM(6);
    if (IN(7)) { ym_phase(F); } SEAM(7);
    if (IN(8)) {
        pg8::StaticOrder S; S.init(MTOK, 1024, F.G, F.bid);
        { AddrPlain g{(const char*)(ws + WS_OP), (const char*)(ws + WS_WB2), 1024, 1024, 1024};
          EpiMerge<false> E{(bf16*)(ws + WS_XM), (const unsigned char*)(ws + WS_MG), 0}; pg8::gemm_phase(F.lds, g, S, E); }
        { AddrPlain g{(const char*)F.out, (const char*)(ws + WS_WB2) + (size_t)1024 * 1024 * 2, 1024, 1024, 1024};
          EpiMerge<true> E{(bf16*)(ws + WS_XM), (const unsigned char*)(ws + WS_MG), 1024}; pg8::gemm_phase(F.lds, g, S, E); }
    } SEAM(8);
    if (IN(9)) {
        AddrPlain g{(const char*)(ws + WS_XM), (const char*)(ws + WS_WOUT2), 1024, 2048, 1024};
        pg8::StaticOrder S; S.init(MTOK, 1024, F.G, F.bid);
        EpiResid E{F.in[0], F.out, (bf16*)(ws + WS_XL), (float*)(ws + WS_SS)};
        pg8::gemm_phase(F.lds, g, S, E);
    } SEAM(9);
    if (IN(10)) REP(10) {
        AddrPlain g{(const char*)(ws + WS_XL), (const char*)(ws + WS_WPQ), 1024, 1024, 1024};
        pg8::StaticOrder S; S.init(MTOK, 2048, F.G, F.bid, 4);
        EpiPQ E{(bf16*)(ws + WS_MG), (const float*)(ws + WS_SS)};
        pg8::gemm_phase(F.lds, g, S, E);
    } SEAM(10);
    if (IN(11)) REP(11) { select_phase(F); }
    if (IN(11) && IN(12)) { asm volatile("s_waitcnt vmcnt(0)" ::: "memory"); __syncthreads(); }
    if (IN(12)) { if ((PROBE_MASK >> 12) & 1) { apply_phase(F, (float*)(ws + WS_MG)); xcd_barrier(bar); } apply_phase(F, F.out); }
#undef REP
#undef IN
#undef SEAM
}

extern "C" void kernel_launch(void* const* d_in, const int* in_sizes, int n_in, void* d_out, int out_size, void* d_ws, size_t ws_size, hipStream_t stream) {
    static int grid = 0;
    if (grid == 0) {
        if (n_in != 26 || in_sizes[0] != MTOK * DM || out_size != MTOK * DM || ws_size < WS_END) { fprintf(stderr, "kernel_launch: unexpected shapes / workspace (%zu < %zu)\n", ws_size, (size_t)WS_END); grid = -1; return; }
        int dev = 0, cus = 0, per_cu = 0;
        if (hipGetDevice(&dev) != hipSuccess || hipDeviceGetAttribute(&cus, hipDeviceAttributeMultiprocessorCount, dev) != hipSuccess) { grid = -1; return; }
        if (hipFuncSetAttribute((const void*)mega_fwd, hipFuncAttributeMaxDynamicSharedMemorySize, LDS_BYTES) != hipSuccess) { fprintf(stderr, "kernel_launch: hipFuncSetAttribute failed\n"); grid = -1; return; }
        if (hipOccupancyMaxActiveBlocksPerMultiprocessor(&per_cu, (const void*)mega_fwd, NTHR, LDS_BYTES) != hipSuccess || per_cu < 1) { fprintf(stderr, "kernel_launch: occupancy query says %d blocks/CU\n", per_cu); (void)hipGetLastError(); grid = -1; return; }
        grid = cus;
    }
    if (grid < 0) return;
    (void)hipMemsetAsync((char*)d_ws + WS_CTL + (size_t)CW_BAR * 4, 0, (size_t)XCD_BAR_WORDS * 4, stream);
    Args a{};
    for (int i = 0; i < 26; ++i) a.in[i] = (const float*)d_in[i];
    a.out = (float*)d_out; a.ws = (unsigned char*)d_ws;
#if MK_N_LAUNCHES == 1
    a.ph_lo = 0; a.ph_hi = N_PHASES;
    void* kargs[] = {&a};
    hipError_t e = hipLaunchCooperativeKernel((const void*)mega_fwd, dim3(grid), dim3(NTHR), kargs, LDS_BYTES, stream);
    if (e != hipSuccess) fprintf(stderr, "kernel_launch: cooperative launch failed: %s (grid %d)\n", hipGetErrorString(e), grid);
#else
    for (int p = 0; p < N_PHASES; ++p) { a.ph_lo = p; a.ph_hi = p + 1; hipLaunchKernelGGL(mega_fwd, dim3(grid), dim3(NTHR), LDS_BYTES, stream, a); }
#endif
}
```

```cpp
#include <hip/hip_runtime.h>
#include <cstdio>
#include <cstdint>
#include <math.h>

#ifndef MK_N_LAUNCHES
#define MK_N_LAUNCHES 1
#endif

constexpr int BATCH = 8, SEQ = 4096, DM = 1024, MTOK = BATCH * SEQ;
constexpr int DIN = 6160;
constexpr int NEXP = 16384;
constexpr float EPS = 1e-6f;

constexpr size_t MiB = 1u << 20;
constexpr size_t WS_CTL = 0, CTL_ZERO_BYTES = 1 * MiB;
constexpr size_t WS_WIN = 1 * MiB;
constexpr size_t WS_WQKV = 13 * MiB;
constexpr size_t WS_KEYS = 14 * MiB + 512 * 1024;
constexpr size_t WS_WLRU = 15 * MiB;
constexpr size_t WS_WB2 = 16 * MiB;
constexpr size_t WS_WOUT2 = 20 * MiB;
constexpr size_t WS_WPQ = 24 * MiB;
constexpr size_t WS_GATE = 28 * MiB;
constexpr size_t WS_WGT = 30 * MiB;
constexpr size_t WS_XM = 32 * MiB;
constexpr size_t WS_OP = 96 * MiB;
constexpr size_t WS_XL = 160 * MiB;
constexpr size_t WS_LG = 224 * MiB;
constexpr size_t WS_MG = 288 * MiB;
constexpr size_t WS_K = 416 * MiB;
constexpr size_t WS_AGG = 480 * MiB;
constexpr size_t WS_SS = 488 * MiB;
constexpr size_t WS_WIN8 = 489 * MiB;
constexpr size_t WS_END = 495 * MiB;

constexpr int CW_BAR = 4096;

constexpr int RING_BYTES = 131072;
constexpr int LDS_BYTES = 147456;
constexpr int LDSCTL_OFF = LDS_BYTES - 512, MISC_OFF = LDSCTL_OFF + 320;
constexpr int NWAVES = 8, NTHR = 512;

#define GAS __attribute__((address_space(1)))
#define LAS __attribute__((address_space(3)))
typedef unsigned short bf16;
typedef unsigned v4u __attribute__((ext_vector_type(4)));
typedef unsigned v2u __attribute__((ext_vector_type(2)));
typedef float f32x4 __attribute__((ext_vector_type(4)));
typedef float f32x2 __attribute__((ext_vector_type(2)));
typedef short bf16x8 __attribute__((ext_vector_type(8)));
typedef GAS unsigned gu32;
#define RLX_AGENT __ATOMIC_RELAXED, __HIP_MEMORY_SCOPE_AGENT
#define LDS_WAIT() asm volatile("s_waitcnt lgkmcnt(0)" ::: "memory")
#define VM_WAIT() asm volatile("s_waitcnt vmcnt(0)" ::: "memory")

__device__ __forceinline__ unsigned f2bf(float f) { unsigned u = __builtin_bit_cast(unsigned, f); return (u + 0x7fffu + ((u >> 16) & 1u)) >> 16; }
__device__ __forceinline__ unsigned pk2(float lo, float hi) { return f2bf(lo) | (f2bf(hi) << 16); }
__device__ __forceinline__ float bf2f(unsigned short h) { return __builtin_bit_cast(float, (unsigned)h << 16); }
__device__ __forceinline__ float bflo(unsigned w) { return __builtin_bit_cast(float, w << 16); }
__device__ __forceinline__ float bfhi(unsigned w) { return __builtin_bit_cast(float, w & 0xffff0000u); }
__device__ __forceinline__ float wave_sum(float v) {
#pragma unroll
  for (int o = 1; o < 64; o <<= 1) v += __shfl_xor(v, o);
  return v;
}
__device__ __forceinline__ float sigmoidf_(float x) { return __builtin_amdgcn_rcpf(1.f + __builtin_amdgcn_exp2f(x * -1.44269504089f)); }
__device__ __forceinline__ float gelu_erf(float x) { return 0.5f * x * (1.f + erff(x * 0.70710678118654752f)); }
__device__ __forceinline__ float gelu_fast(float v) {
    const float av = fabsf(v), t = __builtin_amdgcn_rcpf(av * 0.2316418882f + 1.0f);
    float q = t * 0.5307027145f + (-0.7265760135f); q = q * t + 0.7107068705f; q = q * t + (-0.142248368f); q = q * t + 0.127414796f; q = q * t;
    const float e = __builtin_amdgcn_exp2f((v * v) * (-0.72134752044f));
    const float m = v * (q * e);
    return v < 0.f ? m : v - m;
}
__device__ __forceinline__ float softplusf_(float x) { return fmaxf(x, 0.f) + log1pf(expf(-fabsf(x))); }

namespace pg8 {
#define PG8_LAS __attribute__((address_space(3)))
typedef unsigned short bf16_t;
typedef unsigned u32x4 __attribute__((ext_vector_type(4)));
typedef int i32x4_t __attribute__((ext_vector_type(4)));
constexpr int BM = 256, BK = 64, HALF = 128, HTB = HALF * BK * 2, STAGE_BYTES = 8 * HTB, NXCD = 8;

__host__ __device__ __forceinline__ int lds_byte(int r, int c) { const int st = (r >> 4) * 2 + (c >> 5), rr = r & 15, cc = c & 31, ob = rr * 64 + cc * 2; return st * 1024 + (ob ^ (((ob >> 9) & 1) << 5)); }
__host__ __device__ __forceinline__ void stage_rc(int b, int& R, int& C) { const int st = b / 1024, sb = b % 1024, swz = sb ^ (((sb >> 9) & 1) << 5); R = (st >> 1) * 16 + swz / 64; C = (st & 1) * 32 + (swz % 64) / 2; }
__host__ __device__ __forceinline__ int perm32(int rho) { const int n = rho >> 4, i = rho & 15; return 8 * (i >> 2) + 4 * n + (i & 3); }

struct Unit { int pm, pn; };
struct StaticOrder {
    int nM, nN, nwg, G, c, WGM;
    __host__ __device__ void init(int M, int N, int G_, int c_, int wgm = 8) { nM = M / BM; nN = N / BM; nwg = nM * nN; G = G_; c = c_; WGM = wgm; }
    __host__ __device__ bool next(int i, Unit& u) const {
        const long L = (long)i * G + c; if (L >= nwg) return false;
        int wgid = (int)L; { const int q = nwg / NXCD, r = nwg % NXCD, xcd = wgid % NXCD, off = wgid / NXCD; wgid = (xcd < r ? xcd * (q + 1) : r * (q + 1) + (xcd - r) * q) + off; }
        const int nig = WGM * nN, gid = wgid / nig, fm = gid * WGM, gsz = (nM - fm) < WGM ? (nM - fm) : WGM;
        u.pm = fm + ((wgid % nig) % gsz); u.pn = (wgid % nig) / gsz; return true;
    }
};

__device__ __forceinline__ unsigned cvt_pk_bf16(float lo, float hi) { unsigned r; asm volatile("v_cvt_pk_bf16_f32 %0, %1, %2" : "=v"(r) : "v"(lo), "v"(hi)); return r; }

template <class Epi, class Addr, int F8SC = 0>
__device__ __forceinline__ void gemm_phase(PG8_LAS unsigned char* lds, const Addr g, const StaticOrder& S, const Epi& E) {
    const int tid = threadIdx.x, wid = __builtin_amdgcn_readfirstlane(tid >> 6), lane = tid & 63, wr = wid >> 2, wc = wid & 3, fr = lane & 15, fq = lane >> 4;
    const int K = g.K, nt = K / BK;
    unsigned voffA[2], voffB[2];
#pragma unroll
    for (int i = 0; i < 2; ++i) { int R, C; stage_rc(tid * 16 + i * 8192, R, C); const int Rb = Epi::PERM ? ((R & ~31) + perm32(R & 31)) : R;
        voffA[i] = (unsigned)(R * g.lda + C) * 2u; voffB[i] = (unsigned)(Rb * g.ldb + C) * 2u; }
    const size_t kstep = (size_t)(BK * 2);
    const size_t hsA = (size_t)HALF * g.lda * 2, hsB = (size_t)HALF * g.ldb * 2;
    const unsigned ldsw = (unsigned)wid * 1024u;
    const int aoff = lds_byte(wr * 64 + fr, fq * 8), boff = lds_byte(wc * 32 + fr, fq * 8);
#define PG8_SA(b, h) (((b) * 2 + (h)) * HTB)
#define PG8_SB(b, h) ((4 + (b) * 2 + (h)) * HTB)
#define PG8_STAGE(bufoff, gbase, voff) do { _Pragma("unroll") for (int _i = 0; _i < 2; ++_i) \
        __builtin_amdgcn_global_load_lds((const unsigned*)((const char*)(gbase) + (voff)[_i]), (PG8_LAS unsigned*)(lds + (bufoff) + ldsw + _i * 8192), 16, 0, 0); } while (0)
#define PG8_LDA(dst, b, h) do { _Pragma("unroll") for (int m = 0; m < 4; ++m) _Pragma("unroll") for (int k = 0; k < 2; ++k) dst[m][k] = *(const PG8_LAS bf16x8*)(lds + PG8_SA(b, h) + aoff + m * 2048 + k * 1024); } while (0)
#define PG8_LDB(dst, b, h) do { _Pragma("unroll") for (int n = 0; n < 2; ++n) _Pragma("unroll") for (int k = 0; k < 2; ++k) dst[n][k] = *(const PG8_LAS bf16x8*)(lds + PG8_SB(b, h) + boff + n * 2048 + k * 1024); } while (0)
#define PG8_CAT(x0, x1) __builtin_shufflevector(__builtin_bit_cast(i32x4_t, x0), __builtin_bit_cast(i32x4_t, x1), 0, 1, 2, 3, 4, 5, 6, 7)
#define PG8_MMA(ai, bj, At, Bt) do { __builtin_amdgcn_s_setprio(1); \
        if constexpr (F8SC != 0) { _Pragma("unroll") for (int m = 0; m < 4; ++m) _Pragma("unroll") for (int n = 0; n < 2; ++n) \
            asm volatile("v_mfma_f32_16x16x128_f8f6f4 %0, %1, %2, %0" : "+v"(acc[ai][bj][m][n]) : "v"(PG8_CAT(Bt[n][0], Bt[n][1])), "v"(PG8_CAT(At[m][0], At[m][1]))); } \
        else { _Pragma("unroll") for (int m = 0; m < 4; ++m) _Pragma("unroll") for (int n = 0; n < 2; ++n) _Pragma("unroll") for (int k = 0; k < 2; ++k) \
            acc[ai][bj][m][n] = __builtin_amdgcn_mfma_f32_16x16x32_bf16(Bt[n][k], At[m][k], acc[ai][bj][m][n], 0, 0, 0); } \
        __builtin_amdgcn_s_setprio(0); } while (0)
#define PG8_WAIT_V(n) asm volatile("s_waitcnt vmcnt(" #n ")" ::: "memory")
#define PG8_WAIT_L(n) asm volatile("s_waitcnt lgkmcnt(" #n ")" ::: "memory")
#define PG8_BAR __builtin_amdgcn_s_barrier()
#define PG8_SCHED __builtin_amdgcn_sched_barrier(0)
    Unit cur, nxt; int ui = 0;
    if (!S.next(0, cur)) return;
    f32x4 acc[2][2][4][2];
#pragma unroll
    for (int a = 0; a < 2; ++a)
#pragma unroll
        for (int b = 0; b < 2; ++b)
#pragma unroll
            for (int m = 0; m < 4; ++m)
#pragma unroll
                for (int n = 0; n < 2; ++n) acc[a][b][m][n] = (f32x4){0.f, 0.f, 0.f, 0.f};
    bf16x8 At[4][2], B0[2][2], B1[2][2];
    const char* cA = g.a(cur); const char* cB = g.b(cur);
    PG8_STAGE(PG8_SB(0, 0), cB, voffB); PG8_STAGE(PG8_SB(0, 1), cB + hsB, voffB); PG8_STAGE(PG8_SA(0, 0), cA, voffA); PG8_STAGE(PG8_SA(0, 1), cA + hsA, voffA);
    if (wr == 1) PG8_BAR;
    PG8_WAIT_V(2); PG8_BAR;
    PG8_STAGE(PG8_SB(1, 0), cB + kstep, voffB); PG8_STAGE(PG8_SA(1, 0), cA + kstep, voffA); PG8_STAGE(PG8_SB(1, 1), cB + hsB + kstep, voffB);
    PG8_WAIT_V(6); PG8_BAR;
    for (;;) {
        const bool has_next = S.next(ui + 1, nxt);
        const char* nA = has_next ? g.a(nxt) : cA; const char* nB = has_next ? g.b(nxt) : cB;
#pragma unroll 1
        for (int t = 0; t < nt; t += 2) {
            const bool last = (t == nt - 2);
            const char* a1 = cA + (size_t)(t + 1) * kstep;
            const char* a2 = last ? nA : cA + (size_t)(t + 2) * kstep; const char* b2 = last ? nB : cB + (size_t)(t + 2) * kstep;
            const char* a3 = a2 + kstep; const char* b3 = b2 + kstep;
            PG8_LDB(B0, 0, 0); PG8_LDB(B1, 0, 1); PG8_SCHED; PG8_LDA(At, 0, 0); PG8_STAGE(PG8_SA(1, 1), a1 + hsA, voffA);
            PG8_WAIT_V(8); PG8_WAIT_L(0); PG8_BAR; PG8_MMA(0, 0, At, B0); PG8_MMA(0, 1, At, B1); PG8_BAR; PG8_SCHED;
            PG8_LDA(At, 0, 1); PG8_STAGE(PG8_SB(0, 0), b2, voffB); PG8_STAGE(PG8_SB(0, 1), b2 + hsB, voffB); PG8_STAGE(PG8_SA(0, 0), a2, voffA);
            PG8_WAIT_V(8); PG8_WAIT_L(0); PG8_BAR; PG8_MMA(1, 0, At, B0); PG8_MMA(1, 1, At, B1); PG8_BAR; PG8_SCHED;
            PG8_LDB(B0, 1, 0); PG8_LDB(B1, 1, 1); PG8_SCHED; PG8_LDA(At, 1, 0); PG8_STAGE(PG8_SA(0, 1), a2 + hsA, voffA);
            PG8_WAIT_V(8); PG8_WAIT_L(0); PG8_BAR; PG8_MMA(0, 0, At, B0); PG8_MMA(0, 1, At, B1); PG8_BAR; PG8_SCHED;
            PG8_LDA(At, 1, 1); PG8_STAGE(PG8_SB(1, 0), b3, voffB); PG8_STAGE(PG8_SB(1, 1), b3 + hsB, voffB); PG8_STAGE(PG8_SA(1, 0), a3, voffA);
            PG8_WAIT_V(8); PG8_WAIT_L(0); PG8_BAR; PG8_MMA(1, 0, At, B0); PG8_MMA(1, 1, At, B1); PG8_BAR; PG8_SCHED;
        }
        if constexpr (F8SC != 0) asm volatile("s_nop 15\n\ts_nop 15" ::: "memory");
        if (wr == 0) PG8_BAR;
        E(acc, cur, wr, wc, fr, fq);
        if (!has_next) break;
#pragma unroll
        for (int a = 0; a < 2; ++a)
#pragma unroll
            for (int b = 0; b < 2; ++b)
#pragma unroll
                for (int m = 0; m < 4; ++m)
#pragma unroll
                    for (int n = 0; n < 2; ++n) acc[a][b][m][n] = (f32x4){0.f, 0.f, 0.f, 0.f};
        cur = nxt; cA = nA; cB = nB; ++ui;
        if (wr == 1) PG8_BAR;
    }
    PG8_WAIT_V(0);
    PG8_BAR;
#undef PG8_SA
#undef PG8_SB
#undef PG8_STAGE
#undef PG8_LDA
#undef PG8_LDB
#undef PG8_MMA
#undef PG8_CAT
#undef PG8_WAIT_V
#undef PG8_WAIT_L
#undef PG8_BAR
#undef PG8_SCHED
}
}

#define XB_TMO      128
#define XB_XCNT(j)  (256  + 64 * (j))
#define XB_XSUB(j)  (1280 + 64 * (j))
#define XB_XGEN(j)  (2304 + 64 * (j))
#define XB_TOP      3328
#define XB_TOPGEN   3392
#define XCD_BAR_WORDS 3456
#define XB_SPIN_CAP (1u << 18)
__device__ __forceinline__ unsigned xb_ld(unsigned* p)              { return __hip_atomic_load(p, __ATOMIC_RELAXED, __HIP_MEMORY_SCOPE_AGENT); }
__device__ __forceinline__ unsigned xb_add(unsigned* p, unsigned v) { return __hip_atomic_fetch_add(p, v, __ATOMIC_RELAXED, __HIP_MEMORY_SCOPE_AGENT); }
__device__ __forceinline__ unsigned xb_xcc_id() { return (unsigned)__builtin_amdgcn_s_getreg((3 << 11) | 20) & 0xFu; }
#define XB_SPIN(cond, bar) do { unsigned _sp = 0; while (cond) { __builtin_amdgcn_s_sleep(1); \
    if ((++_sp & 255u) == 0u) { if (xb_ld(&(bar)[XB_TMO])) break; if (_sp > XB_SPIN_CAP) { atomicAdd(&(bar)[XB_TMO], 1u); break; } } } } while (0)
struct XcdBarrier { unsigned* bar; unsigned x; volatile LAS unsigned* st; };
__device__ __forceinline__ XcdBarrier xcd_barrier_post(unsigned* bar, volatile LAS unsigned* st) {
    XcdBarrier b; b.bar = bar; b.x = xb_xcc_id(); b.st = st;
    if (threadIdx.x == 0) (void)xb_add(&bar[XB_XCNT(b.x)], 1u);
    return b;
}
__device__ __forceinline__ void xcd_barrier_complete(unsigned* bar, unsigned x, unsigned& nloc, unsigned& nx) {
    const unsigned G = gridDim.x * gridDim.y * gridDim.z;
    unsigned sum, cnt, mine, sp = 0u;
    for (;;) {
        sum = 0u; cnt = 0u; mine = 0u;
#pragma unroll
        for (unsigned j = 0; j < 16; ++j) { const unsigned c = xb_ld(&bar[XB_XCNT(j)]); sum += c; cnt += (c > 0u) ? 1u : 0u; mine = (j == x) ? c : mine; }
        if (sum == G) break;
        __builtin_amdgcn_s_sleep(1);
        if ((++sp & 255u) == 0u) { if (xb_ld(&bar[XB_TMO])) break; if (sp > XB_SPIN_CAP) { atomicAdd(&bar[XB_TMO], 1u); break; } }
    }
    nloc = mine > 0u ? mine : 1u; nx = cnt > 0u ? cnt : 1u;
}
__device__ __forceinline__ void xcd_barrier(const XcdBarrier& b) {
    asm volatile("s_waitcnt vmcnt(0)" ::: "memory");
    __syncthreads();
    if (threadIdx.x == 0) {
        unsigned* bar = b.bar;
        __builtin_amdgcn_s_waitcnt(0);
        unsigned nloc = b.st[0], nx = b.st[1];
        if (nloc == 0u) { xcd_barrier_complete(bar, b.x, nloc, nx); b.st[0] = nloc; b.st[1] = nx; }
        const unsigned old = xb_add(&bar[XB_XSUB(b.x)], 1u);
        const unsigned gen = old / nloc;
        if (old + 1u == (gen + 1u) * nloc) {
            __builtin_amdgcn_fence(__ATOMIC_RELEASE, "agent");
            asm volatile("s_waitcnt vmcnt(0)" ::: "memory");
            const unsigned og = xb_add(&bar[XB_TOP], 1u);
            const unsigned tg = og / nx;
            if (og + 1u == (tg + 1u) * nx) xb_add(&bar[XB_TOPGEN], 1u);
            else XB_SPIN(xb_ld(&bar[XB_TOPGEN]) == tg, bar);
            __builtin_amdgcn_fence(__ATOMIC_ACQUIRE, "agent");
            xb_add(&bar[XB_XGEN(b.x)], 1u);
            asm volatile("s_waitcnt vmcnt(0)" ::: "memory");
        } else {
            XB_SPIN(xb_ld(&bar[XB_XGEN(b.x)]) == gen, bar);
            __builtin_amdgcn_fence(__ATOMIC_ACQUIRE, "agent");
            asm volatile("s_waitcnt vmcnt(0)" ::: "memory");
        }
    }
    __syncthreads();
}

struct Args { const float* in[26]; float* out; unsigned char* ws; int ph_lo, ph_hi; };
struct Frame {
    LAS unsigned char* lds;
    int tid, lane, wave, G, bid;
    const float* const* in; float* out; unsigned char* ws;
};

template <bool F8 = false> __device__ __forceinline__ void tr_item(const float* W, int ldw, bf16* WT, int ldt, float scale, const float* kscale, LAS float* scr, int k0, int lane) {
#pragma unroll 8
    for (int i = 0; i < 32; ++i) { const int kk = 2 * i + (lane >> 5); float v = W[(size_t)(k0 + kk) * ldw + (lane & 31)] * scale; if (kscale) v *= kscale[k0 + kk]; scr[kk * 33 + (lane & 31)] = v; }
    LDS_WAIT(); asm volatile("" ::: "memory");
    const int c = lane & 7;
#pragma unroll
    for (int j = 0; j < 4; ++j) { const int n = (lane >> 3) + 8 * j; const LAS float* s = scr + (8 * c) * 33 + n;
        if constexpr (F8) {
            int p0 = 0, p1 = 0; p0 = __builtin_amdgcn_cvt_pk_fp8_f32(s[0 * 33], s[1 * 33], p0, false); p0 = __builtin_amdgcn_cvt_pk_fp8_f32(s[2 * 33], s[3 * 33], p0, true);
            p1 = __builtin_amdgcn_cvt_pk_fp8_f32(s[4 * 33], s[5 * 33], p1, false); p1 = __builtin_amdgcn_cvt_pk_fp8_f32(s[6 * 33], s[7 * 33], p1, true);
            *(GAS v2u*)((GAS unsigned char*)WT + (size_t)n * ldt + k0 + 8 * c) = (v2u){(unsigned)p0, (unsigned)p1};
        } else {
        v4u o; o.x = pk2(s[0 * 33], s[1 * 33]); o.y = pk2(s[2 * 33], s[3 * 33]); o.z = pk2(s[4 * 33], s[5 * 33]); o.w = pk2(s[6 * 33], s[7 * 33]);
        *(GAS v4u*)(WT + (size_t)n * ldt + k0 + 8 * c) = o; } }
    LDS_WAIT(); asm volatile("" ::: "memory");
}

__device__ __forceinline__ void p0_prologue(Frame& F) {
    LAS float* scr = (LAS float*)(F.lds + F.wave * 16384);
    const int gw = F.bid * NWAVES + F.wave, NGW = F.G * NWAVES;
    unsigned char* ws = F.ws;
    const float* w_in = F.in[2];
    constexpr int I_WIN = 16 * 192, I_QKV = 12 * 32, I_LRU = 32 * 8, I_WB = 2 * 512, I_WO = 2 * 512, I_PQ = 16 * 64;
    constexpr int NITEMS = I_WIN + I_QKV + I_LRU + I_WB + I_WO + I_PQ;
    for (int it = gw; it < NITEMS; it += NGW) {
        int r = it;
        if (r < I_WIN) { const int kb = r / 192, nb = r % 192, n0 = nb * 32, sc = n0 < 2048 ? n0 : n0 + 16;
            if ((n0 >= 1024 && n0 < 3072) || n0 >= 4096) tr_item<true>(w_in + sc, DIN, (bf16*)(ws + WS_WIN8 + (size_t)n0 * 1024), 1024, 1024.f, nullptr, scr, kb * 64, F.lane);
            else tr_item(w_in + sc, DIN, (bf16*)(ws + WS_WIN) + (size_t)n0 * 1024, 1024, 1.f, nullptr, scr, kb * 64, F.lane);
            continue; }
        r -= I_WIN;
        if (r < I_QKV) { const int mat = r / 32, rr = r % 32, kb = rr / 8, nb = rr % 8, g = mat >> 2, h = mat & 3;
            const float* W = F.in[6 + g] + (size_t)h * 65536 + nb * 32;
            tr_item(W, 256, (bf16*)(ws + WS_WQKV) + (size_t)mat * 65536 + (size_t)(nb * 32) * 256, 256, g == 1 ? 0.0625f : 1.f, nullptr, scr, kb * 64, F.lane); continue; }
        r -= I_QKV;
        if (r < I_LRU) { const int mat = r / 8, rr = r % 8, kb = rr / 4, nb = rr % 4, gate = mat & 1, db = mat >> 1;
            const float* W = F.in[gate ? 14 : 12] + (size_t)db * 16384 + nb * 32;
            tr_item(W, 128, (bf16*)(ws + WS_WLRU) + (size_t)mat * 16384 + (size_t)(nb * 32) * 128, 128, 1.f, nullptr, scr, kb * 64, F.lane); continue; }
        r -= I_LRU;
        if (r < I_WB) { const int mat = r / 512, rr = r % 512, kb = rr / 32, nb = rr % 32;
            const float* W = F.in[17 + mat] + nb * 32;
            tr_item(W, 1024, (bf16*)(ws + WS_WB2) + (size_t)(mat * 1024 + nb * 32) * 1024, 1024, 1.f, nullptr, scr, kb * 64, F.lane); continue; }
        r -= I_WB;
        if (r < I_WO) { const int cp = r / 512, rr = r % 512, kb = rr / 32, nb = rr % 32;
            const float* W = F.in[19] + nb * 32;
            tr_item(W, 1024, (bf16*)(ws + WS_WOUT2) + (size_t)(nb * 32) * 2048 + cp * 1024, 2048, 1.f, nullptr, scr, kb * 64, F.lane); continue; }
        r -= I_WO;
        { const int kb = r / 64, nb = r % 64;
            const float* W = F.in[21] + nb * 32;
            tr_item(W, 2048, (bf16*)(ws + WS_WPQ) + (size_t)(nb * 32) * 1024, 1024, 1.f, F.in[20], scr, kb * 64, F.lane); }
    }
    { const int gt = F.bid * NTHR + F.tid, NGT = F.G * NTHR;
      const float4* ks = (const float4*)F.in[22]; v2u* kd = (v2u*)(ws + WS_KEYS);
      for (int i = gt; i < 8 * 2 * 128 * 128 / 4; i += NGT) { const float4 v = ks[i]; v2u o; o.x = pk2(v.x, v.y); o.y = pk2(v.z, v.w); kd[i] = o; }
      float* ss = (float*)(ws + WS_SS);
      for (int i = gt; i < MTOK; i += NGT) ss[i] = 0.f; }
    { const int gt = F.bid * NTHR + F.tid;
      if (gt < 16 * 128) { const int c = gt >> 7, k8 = gt & 127; v4u o; unsigned wv[4];
#pragma unroll
          for (int j = 0; j < 4; ++j) wv[j] = pk2(w_in[(size_t)(k8 * 8 + 2 * j) * DIN + 2048 + c], w_in[(size_t)(k8 * 8 + 2 * j + 1) * DIN + 2048 + c]);
          o.x = wv[0]; o.y = wv[1]; o.z = wv[2]; o.w = wv[3]; *(v4u*)((bf16*)(ws + WS_WGT) + c * 1024 + k8 * 8) = o; } }
    const float* x = F.in[0]; const float* g1 = F.in[1];
    bf16* XN = (bf16*)(ws + WS_K);
    unsigned char* XN8 = (unsigned char*)F.out;
    f32x4 gv[4];
#pragma unroll
    for (int j = 0; j < 4; ++j) gv[j] = ((const f32x4*)g1)[F.lane + 64 * j];
    for (int m = 2 * gw; m < MTOK; m += 2 * NGW) {
        const f32x4* xr0 = (const f32x4*)(x + (size_t)m * DM) + F.lane; const f32x4* xr1 = xr0 + DM / 4;
        f32x4 v0[4], v1[4]; float s0 = 0.f, s1 = 0.f;
#pragma unroll
        for (int j = 0; j < 4; ++j) { v0[j] = xr0[64 * j]; v1[j] = xr1[64 * j]; }
#pragma unroll
        for (int j = 0; j < 4; ++j) { s0 += (v0[j].x * v0[j].x + v0[j].y * v0[j].y) + (v0[j].z * v0[j].z + v0[j].w * v0[j].w); s1 += (v1[j].x * v1[j].x + v1[j].y * v1[j].y) + (v1[j].z * v1[j].z + v1[j].w * v1[j].w); }
        const float r0 = rsqrtf(wave_sum(s0) * (1.f / DM) + EPS), r1 = rsqrtf(wave_sum(s1) * (1.f / DM) + EPS);
        unsigned long long* o0 = (unsigned long long*)(XN + (size_t)m * DM) + F.lane; unsigned long long* o1 = o0 + DM / 4;
        unsigned* q0 = (unsigned*)(XN8 + (size_t)m * DM) + F.lane; unsigned* q1 = q0 + DM / 4;
#pragma unroll
        for (int j = 0; j < 4; ++j) { const f32x4 a = v0[j] * r0 * gv[j], c = v1[j] * r1 * gv[j];
            o0[64 * j] = (unsigned long long)pk2(a.x, a.y) | ((unsigned long long)pk2(a.z, a.w) << 32);
            o1[64 * j] = (unsigned long long)pk2(c.x, c.y) | ((unsigned long long)pk2(c.z, c.w) << 32);
            int pa = 0, pc = 0; pa = __builtin_amdgcn_cvt_pk_fp8_f32(a.x, a.y, pa, false); pa = __builtin_amdgcn_cvt_pk_fp8_f32(a.z, a.w, pa, true);
            pc = __builtin_amdgcn_cvt_pk_fp8_f32(c.x, c.y, pc, false); pc = __builtin_amdgcn_cvt_pk_fp8_f32(c.z, c.w, pc, true);
            q0[64 * j] = (unsigned)pa; q1[64 * j] = (unsigned)pc; }
    }
}
__device__ __forceinline__ void gates_phase(Frame& F) {
    const bf16* XN = (const bf16*)(F.ws + WS_K); const bf16* WGT = (const bf16*)(F.ws + WS_WGT); float* GT = (float*)(F.ws + WS_GATE);
    const int lane = F.lane, fr = lane & 15, fq = lane >> 4;
    const f32x4 bg4 = *(const f32x4*)(F.in[3] + 4 * fq);
    for (int task = F.bid * NWAVES + F.wave; task < MTOK / 16; task += F.G * NWAVES) {
        const size_t m0 = (size_t)task * 16;
        f32x4 acc = (f32x4){0.f, 0.f, 0.f, 0.f};
#pragma unroll 8
        for (int ks = 0; ks < 32; ++ks) {
            const bf16x8 wfr = *(const bf16x8*)(WGT + fr * 1024 + 32 * ks + 8 * fq);
            const bf16x8 xfr = *(const bf16x8*)(XN + (m0 + fr) * DM + 32 * ks + 8 * fq);
            acc = __builtin_amdgcn_mfma_f32_16x16x32_bf16(wfr, xfr, acc, 0, 0, 0);
        }
        *(f32x4*)(GT + (m0 + fr) * 16 + 4 * fq) = acc + bg4;
    }
}

struct AddrPlain {
    const char* A; const char* Bt; int lda, ldb, K;
    __device__ __forceinline__ const char* a(const pg8::Unit& u) const { return A + (size_t)u.pm * 256 * lda * 2; }
    __device__ __forceinline__ const char* b(const pg8::Unit& u) const { return Bt + (size_t)u.pn * 256 * ldb * 2; }
};
struct AddrP1 {
    const char* A; const char* Bt; int lda, ldb, K, thr, lo_add, hi_add;
    __device__ __forceinline__ const char* a(const pg8::Unit& u) const { return A + (size_t)u.pm * 256 * lda * 2; }
    __device__ __forceinline__ const char* b(const pg8::Unit& u) const { return Bt + (size_t)(u.pn + (u.pn < thr ? lo_add : hi_add)) * 256 * ldb * 2; }
};
struct AddrQKV {
    const char* XC; long dXM; const char* W; int lda, ldb, K;
    __device__ __forceinline__ const char* a(const pg8::Unit& u) const { return XC + (u.pn < 8 ? 0l : dXM) + ((size_t)u.pm * 256 * 1024 + (u.pn & 3) * 256) * 2; }
    __device__ __forceinline__ const char* b(const pg8::Unit& u) const { return W + (size_t)u.pn * 65536 * 2; }
};
struct AddrBranch {
    const char* YM; long dYL; const char* W; int lda, ldb, K;
    __device__ __forceinline__ const char* a(const pg8::Unit& u) const { return YM + (u.pn < 4 ? 0l : dYL) + (size_t)u.pm * 256 * 1024 * 2; }
    __device__ __forceinline__ const char* b(const pg8::Unit& u) const { return W + (size_t)u.pn * 256 * 1024 * 2; }
};

struct DstP1 { unsigned char* ws; int thr, lo_add, hi_add;
    __device__ __forceinline__ bf16* get(int j, int& ld, int& col0) const {
        const int pn = j + (j < thr ? lo_add : hi_add); const bool mg = pn >= 16; ld = mg ? -2048 : 1024; col0 = mg ? (pn - 16) * 256 : (pn & 3) * 256;
        return (bf16*)(ws + (mg ? WS_MG : WS_XM + (size_t)(pn >> 2) * 64 * MiB)); } };
struct DstQKV { char* q; long dk, dv;
    __device__ __forceinline__ bf16* get(int pn, int& ld, int& col0) const { ld = 1024; col0 = (pn & 3) * 256; return (bf16*)(q + (pn >= 4 ? (pn >= 8 ? dv : dk) : 0l)); } };
template <class Dst, bool MUL = false> struct EpiBf16 {
    static constexpr bool PERM = true;
    Dst dst; float mul;
    __device__ __forceinline__ void operator()(const f32x4 (&acc)[2][2][4][2], const pg8::Unit& u, int wr, int wc, int fr, int fq) const {
        int ld, colt; bf16* base = dst.get(u.pn, ld, colt);
        const int row0 = u.pm * 256 + wr * 64 + fr, col0 = colt + wc * 32 + 8 * fq;
        if (MUL && ld < 0) {
#pragma unroll
            for (int ai = 0; ai < 2; ++ai)
#pragma unroll
                for (int m = 0; m < 4; ++m) { unsigned char* rowp = (unsigned char*)base + (size_t)(row0 + ai * 128 + m * 16) * (-ld) + col0;
#pragma unroll
                    for (int bj = 0; bj < 2; ++bj) { const f32x4 v0 = acc[ai][bj][m][0] * mul, v1 = acc[ai][bj][m][1] * mul;
                        int p0 = 0, p1 = 0; p0 = __builtin_amdgcn_cvt_pk_fp8_f32(v0[0], v0[1], p0, false); p0 = __builtin_amdgcn_cvt_pk_fp8_f32(v0[2], v0[3], p0, true);
                        p1 = __builtin_amdgcn_cvt_pk_fp8_f32(v1[0], v1[1], p1, false); p1 = __builtin_amdgcn_cvt_pk_fp8_f32(v1[2], v1[3], p1, true);
                        *(v2u*)(rowp + bj * 128) = (v2u){(unsigned)p0, (unsigned)p1}; } }
            return;
        }
#pragma unroll
        for (int ai = 0; ai < 2; ++ai)
#pragma unroll
            for (int m = 0; m < 4; ++m) { bf16* rowp = base + (size_t)(row0 + ai * 128 + m * 16) * ld + col0;
#pragma unroll
                for (int bj = 0; bj < 2; ++bj) { f32x4 v0 = acc[ai][bj][m][0], v1 = acc[ai][bj][m][1]; if (MUL) { v0 = v0 * mul; v1 = v1 * mul; }
                    v4u w; w.x = pg8::cvt_pk_bf16(v0[0], v0[1]); w.y = pg8::cvt_pk_bf16(v0[2], v0[3]); w.z = pg8::cvt_pk_bf16(v1[0], v1[1]); w.w = pg8::cvt_pk_bf16(v1[2], v1[3]);
                    *(v4u*)(rowp + bj * 128) = w; } }
    }
};
template <bool ADD> struct EpiMerge {
    static constexpr bool PERM = true;
    bf16* MRG; const unsigned char* MG; int gcol;
    __device__ __forceinline__ void operator()(const f32x4 (&acc)[2][2][4][2], const pg8::Unit& u, int wr, int wc, int fr, int fq) const {
        const int row0 = u.pm * 256 + wr * 64 + fr, col0 = u.pn * 256 + wc * 32 + 8 * fq;
#pragma unroll
        for (int ai = 0; ai < 2; ++ai)
#pragma unroll
            for (int m = 0; m < 4; ++m) { const size_t row = (size_t)(row0 + ai * 128 + m * 16); bf16* rowp = MRG + row * 1024 + col0; const unsigned char* gp = MG + row * 2048 + gcol + col0;
#pragma unroll
                for (int bj = 0; bj < 2; ++bj) { const f32x4 v0 = acc[ai][bj][m][0], v1 = acc[ai][bj][m][1];
                    const v2u g = *(const v2u*)(gp + bj * 128);
                    const f32x2 g0 = __builtin_amdgcn_cvt_pk_f32_fp8((int)g.x, false), g1 = __builtin_amdgcn_cvt_pk_f32_fp8((int)g.x, true), g2 = __builtin_amdgcn_cvt_pk_f32_fp8((int)g.y, false), g3 = __builtin_amdgcn_cvt_pk_f32_fp8((int)g.y, true);
                    float o[8] = {v0[0] * sigmoidf_(g0[0]), v0[1] * sigmoidf_(g0[1]), v0[2] * sigmoidf_(g1[0]), v0[3] * sigmoidf_(g1[1]),
                                  v1[0] * sigmoidf_(g2[0]), v1[1] * sigmoidf_(g2[1]), v1[2] * sigmoidf_(g3[0]), v1[3] * sigmoidf_(g3[1])};
                    if (ADD) { const v4u t = *(const v4u*)(rowp + bj * 128);
                        o[0] += bflo(t.x); o[1] += bfhi(t.x); o[2] += bflo(t.y); o[3] += bfhi(t.y); o[4] += bflo(t.z); o[5] += bfhi(t.z); o[6] += bflo(t.w); o[7] += bfhi(t.w); }
                    v4u w; w.x = pg8::cvt_pk_bf16(o[0], o[1]); w.y = pg8::cvt_pk_bf16(o[2], o[3]); w.z = pg8::cvt_pk_bf16(o[4], o[5]); w.w = pg8::cvt_pk_bf16(o[6], o[7]);
                    *(v4u*)(rowp + bj * 128) = w; } }
    }
};
struct EpiResid {
    static constexpr bool PERM = false;
    const float* x; float* x1; bf16* x1b; float* ss;
    __device__ __forceinline__ void operator()(const f32x4 (&acc)[2][2][4][2], const pg8::Unit& u, int wr, int wc, int fr, int fq) const {
        const int row0 = u.pm * 256 + wr * 64 + fr, col0 = u.pn * 256 + wc * 32 + 4 * fq;
#pragma unroll
        for (int ai = 0; ai < 2; ++ai)
#pragma unroll
            for (int m = 0; m < 4; ++m) { const int row = row0 + ai * 128 + m * 16; const size_t off = (size_t)row * DM + col0; float s = 0.f;
#pragma unroll
                for (int bj = 0; bj < 2; ++bj)
#pragma unroll
                    for (int n = 0; n < 2; ++n) { const size_t o = off + bj * 128 + n * 16; const f32x4 v = *(const f32x4*)(x + o) + acc[ai][bj][m][n];
                        *(f32x4*)(x1 + o) = v; v2u w; w.x = pg8::cvt_pk_bf16(v[0], v[1]); w.y = pg8::cvt_pk_bf16(v[2], v[3]); *(v2u*)(x1b + o) = w;
                        s += (v[0] * v[0] + v[1] * v[1]) + (v[2] * v[2] + v[3] * v[3]); }
                s += __shfl_xor(s, 16); s += __shfl_xor(s, 32);
                if (fq == 0) atomicAdd(ss + row, s); }
    }
};
struct EpiPQ {
    static constexpr bool PERM = true;
    bf16* pq; const float* ss;
    __device__ __forceinline__ void operator()(const f32x4 (&acc)[2][2][4][2], const pg8::Unit& u, int wr, int wc, int fr, int fq) const {
        const int row0 = u.pm * 256 + wr * 64 + fr, col0 = u.pn * 256 + wc * 32 + 8 * fq;
#pragma unroll
        for (int ai = 0; ai < 2; ++ai)
#pragma unroll
            for (int m = 0; m < 4; ++m) { const int row = row0 + ai * 128 + m * 16; bf16* rowp = pq + (size_t)row * 2048 + col0;
                const float r = rsqrtf(ss[row] * (1.f / DM) + EPS);
#pragma unroll
                for (int bj = 0; bj < 2; ++bj) { const f32x4 v0 = acc[ai][bj][m][0] * r, v1 = acc[ai][bj][m][1] * r;
                    v4u w; w.x = pg8::cvt_pk_bf16(v0[0], v0[1]); w.y = pg8::cvt_pk_bf16(v0[2], v0[3]); w.z = pg8::cvt_pk_bf16(v1[0], v1[1]); w.w = pg8::cvt_pk_bf16(v1[2], v1[3]);
                    *(v4u*)(rowp + bj * 128) = w; } }
    }
};

template <bool PB> __device__ __forceinline__ void lru_phase(Frame& F) {
    const bf16* XL = (const bf16*)(F.ws + WS_XL); const bf16* LG = (const bf16*)(F.ws + WS_LG); bf16* YL = (bf16*)F.out;
    f32x2* AGG = (f32x2*)(F.ws + WS_AGG);
    const bf16* WL = (const bf16*)(F.ws + WS_WLRU);
    const float* cw = F.in[10]; const float* cb = F.in[11];
    unsigned char* LA0 = F.ws + WS_K; unsigned char* LA1 = LA0 + (size_t)MTOK * DM; bf16* LU0 = (bf16*)F.out; bf16* LU1 = LU0 + (size_t)MTOK * DM;
    v2u ra[2]; v4u ru[2];
    constexpr int O_XCB = 0, O_XCF = 17408, O_A = 51200, O_U = 84992, FST = 528;
    LAS unsigned char* L = F.lds;
    const int tid = F.tid, lane = F.lane, w = F.wave, fr = lane & 15, fq = lane >> 4;
    int cur_blk = -1;
    bf16x8 wf[2][2][4];
    f32x4 br4[2], bi4[2], sp4[2];
    v4u rawreg[3];
#define RAW_LOAD(bb, tt0, bk) do { _Pragma("unroll") for (int r_ = 0; r_ < 3; ++r_) { const int e_ = tid + NTHR * r_, row_ = e_ >> 4, c16_ = e_ & 15, t_ = (tt0) - 2 + row_; \
            v4u v_ = {0u, 0u, 0u, 0u}; if (e_ < 68 * 16 && t_ >= 0 && t_ < SEQ) v_ = *(const v4u*)(XL + ((size_t)(bb) * SEQ + t_) * DM + (bk) * 128 + c16_ * 8); rawreg[r_] = v_; } } while (0)
#define PB_LOAD(ii, dd) do { const int idx_ = (ii) * F.G + F.bid; if (idx_ < 4096) { const int j_ = idx_ >> 3; const size_t mr_ = (size_t)(j_ >> 6) * SEQ + (j_ & 63) * 64; \
            _Pragma("unroll") for (int r_ = 0; r_ < 2; ++r_) { const int e_ = tid + NTHR * r_; const size_t o_ = (mr_ + (e_ >> 4)) * DM + (idx_ & 7) * 128 + (e_ & 15) * 8; \
                ra[r_] = *(const v2u*)(((dd) ? LA1 : LA0) + o_); ru[r_] = *(const v4u*)(((dd) ? LU1 : LU0) + o_); } } } while (0)
    constexpr int O_CARRY = 118784, O_CW = 135168, O_SUB = 137728;
    const bool carry_tab = PB && (F.G == 256);
    if (carry_tab) {
        const int ch = tid & 127, bq = tid >> 7, s0 = F.bid >> 3, blk0 = F.bid & 7;
        LAS float* CT = (LAS float*)(L + O_CARRY);
#define FOLD(agp, j0, j1, stp, hv) do { int js_ = (j0); const int n_ = ((j1) - (j0)) * (stp); int k_ = 0; \
            for (; k_ + 8 <= n_; k_ += 8) { f32x2 ah_[8]; _Pragma("unroll") for (int q_ = 0; q_ < 8; ++q_) ah_[q_] = (agp)[(size_t)(js_ + q_ * (stp)) * 2 * DM]; \
                _Pragma("unroll") for (int q_ = 0; q_ < 8; ++q_) hv = ah_[q_][0] * hv + ah_[q_][1]; js_ += 8 * (stp); } \
            for (; k_ < n_; ++k_) { const f32x2 a1_ = (agp)[(size_t)js_ * 2 * DM]; hv = a1_[0] * hv + a1_[1]; js_ += (stp); } } while (0)
        for (int bb = 2 * bq; bb < 2 * bq + 2; ++bb) {
            const f32x2* ag0 = AGG + ((size_t)(bb * 64) * 2 + 0) * DM + blk0 * 128 + ch; const f32x2* ag1 = AGG + ((size_t)(bb * 64) * 2 + 1) * DM + blk0 * 128 + ch;
            float h = 0.f;
            FOLD(ag0, 0, s0, 1, h); CT[((bb * 2 + 0) * 2 + 0) * 128 + ch] = h;
            FOLD(ag0, s0, s0 + 32, 1, h); CT[((bb * 2 + 1) * 2 + 0) * 128 + ch] = h;
            h = 0.f;
            FOLD(ag1, 63, s0 + 32, -1, h); CT[((bb * 2 + 1) * 2 + 1) * 128 + ch] = h;
            FOLD(ag1, s0 + 32, s0, -1, h); CT[((bb * 2 + 0) * 2 + 1) * 128 + ch] = h;
        }
        __syncthreads();
#undef FOLD
    }
    for (int i = 0;; ++i) {
        const int idx = i * F.G + F.bid; if (idx >= 4096) break;
        const int blk = idx & 7, j = idx >> 3, b = j >> 6, seg = j & 63, t0 = seg * 64;
        const size_t mrow0 = (size_t)b * SEQ + t0;
        if (!PB && blk != cur_blk) {
            cur_blk = blk;
#pragma unroll
            for (int d = 0; d < 2; ++d) {
#pragma unroll
                for (int g = 0; g < 2; ++g)
#pragma unroll
                    for (int ks = 0; ks < 4; ++ks)
                        wf[d][g][ks] = *(const bf16x8*)(WL + ((size_t)((d * 8 + blk) * 2 + g) * 128 + 16 * w + fr) * 128 + 32 * ks + 8 * fq);
                const int ch = blk * 128 + 16 * w + 4 * fq;
                br4[d] = *(const f32x4*)(F.in[13] + d * DM + ch); bi4[d] = *(const f32x4*)(F.in[15] + d * DM + ch);
                const f32x4 lm = *(const f32x4*)(F.in[16] + d * DM + ch);
#pragma unroll
                for (int e = 0; e < 4; ++e) sp4[d][e] = -8.f * 1.44269504089f * softplusf_(-lm[e]);
            }
            __syncthreads();
            for (int e = tid; e < 5 * 128; e += NTHR) { const int jt = e >> 7, cc = e & 127; ((LAS float*)(L + O_CW))[e] = (jt < 4) ? cw[jt * DM + blk * 128 + cc] : cb[blk * 128 + cc]; }
        }
        v4u lgreg[2];
        if (PB) {
            if (i == 0) PB_LOAD(0, 0);
#pragma unroll
            for (int r = 0; r < 2; ++r) { const int e = tid + NTHR * r; lgreg[r] = *(const v4u*)(LG + (mrow0 + (e >> 4)) * DM + blk * 128 + (e & 15) * 8); }
        } else {
        if (i == 0) RAW_LOAD(b, t0, blk);
#pragma unroll
        for (int r = 0; r < 3; ++r) { const int e = tid + NTHR * r; if (e < 68 * 16) *(LAS v4u*)(L + O_A + (e >> 4) * 256 + (e & 15) * 16) = rawreg[r]; }
        __syncthreads();
        { const int idx2 = (i + 1) * F.G + F.bid; if (idx2 < 4096) { const int j2 = idx2 >> 3; RAW_LOAD(j2 >> 6, (j2 & 63) * 64, idx2 & 7); } }
        for (int e = tid; e < 64 * 16; e += NTHR) { const int tl = e >> 4, c16 = e & 15;
            float y[8];
            { const f32x4 a = *(const LAS f32x4*)(L + O_CW + 4 * 512 + c16 * 32), bq = *(const LAS f32x4*)(L + O_CW + 4 * 512 + c16 * 32 + 16); y[0] = a[0]; y[1] = a[1]; y[2] = a[2]; y[3] = a[3]; y[4] = bq[0]; y[5] = bq[1]; y[6] = bq[2]; y[7] = bq[3]; }
#pragma unroll
            for (int jt = 0; jt < 4; ++jt) { const v4u r = *(const LAS v4u*)(L + O_A + (tl + jt) * 256 + c16 * 16);
                const f32x4 wa = *(const LAS f32x4*)(L + O_CW + jt * 512 + c16 * 32), wb = *(const LAS f32x4*)(L + O_CW + jt * 512 + c16 * 32 + 16);
                y[0] += wa[0] * bflo(r.x); y[1] += wa[1] * bfhi(r.x); y[2] += wa[2] * bflo(r.y); y[3] += wa[3] * bfhi(r.y);
                y[4] += wb[0] * bflo(r.z); y[5] += wb[1] * bfhi(r.z); y[6] += wb[2] * bflo(r.w); y[7] += wb[3] * bfhi(r.w); }
            *(LAS f32x4*)(L + O_XCF + tl * FST + c16 * 32) = (f32x4){y[0], y[1], y[2], y[3]};
            *(LAS f32x4*)(L + O_XCF + tl * FST + c16 * 32 + 16) = (f32x4){y[4], y[5], y[6], y[7]};
            v4u o; o.x = pk2(y[0], y[1]); o.y = pk2(y[2], y[3]); o.z = pk2(y[4], y[5]); o.w = pk2(y[6], y[7]);
            *(LAS v4u*)(L + O_XCB + tl * 272 + c16 * 16) = o; }
        __syncthreads();
        }
        float carry0 = 0.f, carry1 = 0.f;
        if (carry_tab) { const LAS float* CT = (const LAS float*)(L + O_CARRY); carry0 = CT[((b * 2 + (seg >> 5)) * 2 + 0) * 128 + (tid & 127)]; carry1 = CT[((b * 2 + (seg >> 5)) * 2 + 1) * 128 + (tid & 127)]; }
        else if (PB) {
            const int ch = blk * 128 + (tid & 127);
            float h = 0.f;
            const f32x2* ag0 = AGG + ((size_t)(b * 64) * 2 + 0) * DM + ch; const f32x2* ag1 = AGG + ((size_t)(b * 64) * 2 + 1) * DM + ch;
            int js = 0;
            for (; js + 8 <= seg; js += 8) { f32x2 ah[8];
#pragma unroll
                for (int q = 0; q < 8; ++q) ah[q] = ag0[(size_t)(js + q) * 2 * DM];
#pragma unroll
                for (int q = 0; q < 8; ++q) h = ah[q][0] * h + ah[q][1]; }
            for (; js < seg; ++js) { const f32x2 ah = ag0[(size_t)js * 2 * DM]; h = ah[0] * h + ah[1]; }
            carry0 = h; h = 0.f;
            js = 63;
            for (; js - 8 >= seg; js -= 8) { f32x2 ah[8];
#pragma unroll
                for (int q = 0; q < 8; ++q) ah[q] = ag1[(size_t)(js - q) * 2 * DM];
#pragma unroll
                for (int q = 0; q < 8; ++q) h = ah[q][0] * h + ah[q][1]; }
            for (; js > seg; --js) { const f32x2 ah = ag1[(size_t)js * 2 * DM]; h = ah[0] * h + ah[1]; }
            carry1 = h;
        }
#pragma unroll
        for (int d = 0; d < 2; ++d) {
            const int o_a = (d == 0) ? O_A : O_XCF;
            if (PB) {
#pragma unroll
                for (int r = 0; r < 2; ++r) { const int e = tid + NTHR * r, row = e >> 4, c16 = e & 15;
                    const f32x2 x0 = __builtin_amdgcn_cvt_pk_f32_fp8((int)ra[r].x, false), x1 = __builtin_amdgcn_cvt_pk_f32_fp8((int)ra[r].x, true);
                    const f32x2 x2 = __builtin_amdgcn_cvt_pk_f32_fp8((int)ra[r].y, false), x3 = __builtin_amdgcn_cvt_pk_f32_fp8((int)ra[r].y, true);
                    constexpr float IS = 1.f / 4096.f;
                    *(LAS f32x4*)(L + o_a + row * FST + c16 * 32) = (f32x4){1.f - x0[0] * IS, 1.f - x0[1] * IS, 1.f - x1[0] * IS, 1.f - x1[1] * IS};
                    *(LAS f32x4*)(L + o_a + row * FST + c16 * 32 + 16) = (f32x4){1.f - x2[0] * IS, 1.f - x2[1] * IS, 1.f - x3[0] * IS, 1.f - x3[1] * IS};
                    *(LAS f32x4*)(L + O_U + row * FST + c16 * 32) = (f32x4){bflo(ru[r].x), bfhi(ru[r].x), bflo(ru[r].y), bfhi(ru[r].y)};
                    *(LAS f32x4*)(L + O_U + row * FST + c16 * 32 + 16) = (f32x4){bflo(ru[r].z), bfhi(ru[r].z), bflo(ru[r].w), bfhi(ru[r].w)}; }
                if (d == 0) PB_LOAD(i, 1); else PB_LOAD(i + 1, 0);
            } else {
            f32x4 aR[4], aI[4];
#pragma unroll
            for (int mt = 0; mt < 4; ++mt) { aR[mt] = (f32x4){0.f, 0.f, 0.f, 0.f}; aI[mt] = (f32x4){0.f, 0.f, 0.f, 0.f}; }
#pragma unroll
            for (int ks = 0; ks < 4; ++ks)
#pragma unroll
                for (int mt = 0; mt < 4; ++mt) { const bf16x8 xb = *(const LAS bf16x8*)(L + O_XCB + (16 * mt + fr) * 272 + (32 * ks + 8 * fq) * 2);
                    aR[mt] = __builtin_amdgcn_mfma_f32_16x16x32_bf16(wf[d][0][ks], xb, aR[mt], 0, 0, 0);
                    aI[mt] = __builtin_amdgcn_mfma_f32_16x16x32_bf16(wf[d][1][ks], xb, aI[mt], 0, 0, 0); }
#pragma unroll
            for (int mt = 0; mt < 4; ++mt) { const int tl = 16 * mt + fr, cl = 16 * w + 4 * fq;
                const f32x4 xc = *(const LAS f32x4*)(L + O_XCF + tl * FST + cl * 4);
                f32x4 av, uv;
#pragma unroll
                for (int e = 0; e < 4; ++e) { const float r = sigmoidf_(aR[mt][e] + br4[d][e]), ig = sigmoidf_(aI[mt][e] + bi4[d][e]);
                    const float a_ = __builtin_amdgcn_exp2f(r * sp4[d][e]); av[e] = a_; uv[e] = __builtin_amdgcn_sqrtf(fmaxf(1.f - a_ * a_, 0.f)) * (ig * xc[e]); }
                *(LAS f32x4*)(L + o_a + tl * FST + cl * 4) = av; *(LAS f32x4*)(L + O_U + tl * FST + cl * 4) = uv;
                { const size_t go = (mrow0 + tl) * DM + blk * 128 + cl;
                  int xa = 0; xa = __builtin_amdgcn_cvt_pk_fp8_f32((1.f - av[0]) * 4096.f, (1.f - av[1]) * 4096.f, xa, false); xa = __builtin_amdgcn_cvt_pk_fp8_f32((1.f - av[2]) * 4096.f, (1.f - av[3]) * 4096.f, xa, true);
                  v2u xu; xu.x = pk2(uv[0], uv[1]); xu.y = pk2(uv[2], uv[3]);
                  *(unsigned*)((d ? LA1 : LA0) + go) = (unsigned)xa; *(v2u*)((d ? LU1 : LU0) + go) = xu; } }
            }
            __syncthreads();
            {
                const int c = tid & 127, sub = tid >> 7;
                LAS float* pa = (LAS float*)(L + o_a) + c; const LAS float* pu = (const LAS float*)(L + O_U) + c;
                LAS f32x2* SUBT = (LAS f32x2*)(L + O_SUB);
                float h = 0.f, A = 1.f;
#pragma unroll
                for (int s2 = 0; s2 < 16; ++s2) { const int tl = d ? (16 * sub + 15 - s2) : (16 * sub + s2); const float a = pa[tl * 132], u = pu[tl * 132]; h = a * h + u; A *= a; }
                SUBT[sub * 128 + c] = (f32x2){A, h};
                __syncthreads();
                if (!PB) {
                    if (sub == 0) { float HH = 0.f, AA = 1.f;
#pragma unroll
                        for (int q = 0; q < 4; ++q) { const f32x2 ah = SUBT[(d ? 3 - q : q) * 128 + c]; HH = ah[0] * HH + ah[1]; AA *= ah[0]; }
                        AGG[((size_t)(b * 64 + seg) * 2 + d) * DM + blk * 128 + c] = (f32x2){AA, HH}; }
                } else {
                    float hc = d ? carry1 : carry0;
#pragma unroll
                    for (int q = 0; q < 3; ++q) { const int jq = d ? 3 - q : q; const f32x2 ah = SUBT[jq * 128 + c]; if (d ? (jq > sub) : (jq < sub)) hc = ah[0] * hc + ah[1]; }
                    if (d == 0) {
#pragma unroll
                        for (int s2 = 0; s2 < 16; ++s2) { const int tl = 16 * sub + s2; hc = pa[tl * 132] * hc + pu[tl * 132]; pa[tl * 132] = hc; }
                    } else { LAS float* ph = (LAS float*)(L + O_A) + c;
#pragma unroll
                        for (int s2 = 0; s2 < 16; ++s2) { const int tl = 16 * sub + 15 - s2; hc = pa[tl * 132] * hc + pu[tl * 132]; ph[tl * 132] += hc; } }
                }
            }
            __syncthreads();
        }
        if (PB) {
#pragma unroll
            for (int r = 0; r < 2; ++r) { const int e = tid + NTHR * r, row = e >> 4, c16 = e & 15;
                const v4u g = lgreg[r];
                const f32x4 h0 = *(const LAS f32x4*)(L + O_A + row * FST + c16 * 32), h1 = *(const LAS f32x4*)(L + O_A + row * FST + c16 * 32 + 16);
                v4u o;
                o.x = pk2(h0[0] * gelu_fast(bflo(g.x)), h0[1] * gelu_fast(bfhi(g.x))); o.y = pk2(h0[2] * gelu_fast(bflo(g.y)), h0[3] * gelu_fast(bfhi(g.y)));
                o.z = pk2(h1[0] * gelu_fast(bflo(g.z)), h1[1] * gelu_fast(bfhi(g.z))); o.w = pk2(h1[2] * gelu_fast(bflo(g.w)), h1[3] * gelu_fast(bfhi(g.w)));
                *(v4u*)(YL + (mrow0 + row) * DM + blk * 128 + c16 * 8) = o; }
            __syncthreads();
        }
    }
#undef RAW_LOAD
#undef PB_LOAD
}

__device__ __forceinline__ void mconv_phase(Frame& F) {
    const bf16* XM = (const bf16*)(F.ws + WS_XM); bf16* XC = (bf16*)F.out + (size_t)MTOK * DM;
    const float* cw = F.in[4]; const float* cb = F.in[5];
    const int NT = MTOK / 32 * 128;
    for (int g = F.bid * NTHR + F.tid; g < NT; g += F.G * NTHR) {
        const int chunk = g & 127, run = g >> 7, c0 = chunk * 8, m0 = run * 32, t0 = m0 & (SEQ - 1);
        float w[4][8], bias[8];
#pragma unroll
        for (int j = 0; j < 4; ++j) { const f32x4 a = *(const f32x4*)(cw + j * DM + c0), b = *(const f32x4*)(cw + j * DM + c0 + 4);
            w[j][0] = a[0]; w[j][1] = a[1]; w[j][2] = a[2]; w[j][3] = a[3]; w[j][4] = b[0]; w[j][5] = b[1]; w[j][6] = b[2]; w[j][7] = b[3]; }
        { const f32x4 a = *(const f32x4*)(cb + c0), b = *(const f32x4*)(cb + c0 + 4);
            bias[0] = a[0]; bias[1] = a[1]; bias[2] = a[2]; bias[3] = a[3]; bias[4] = b[0]; bias[5] = b[1]; bias[6] = b[2]; bias[7] = b[3]; }
        v4u win[4];
        const v4u zero = {0u, 0u, 0u, 0u};
        win[0] = zero;
        win[1] = (t0 >= 2) ? *(const v4u*)(XM + (size_t)(m0 - 2) * DM + c0) : zero;
        win[2] = (t0 >= 1) ? *(const v4u*)(XM + (size_t)(m0 - 1) * DM + c0) : zero;
        win[3] = *(const v4u*)(XM + (size_t)m0 * DM + c0);
#pragma unroll 4
        for (int i = 0; i < 32; ++i) {
            win[0] = win[1]; win[1] = win[2]; win[2] = win[3];
            win[3] = (t0 + i + 1 < SEQ) ? *(const v4u*)(XM + (size_t)(m0 + i + 1) * DM + c0) : zero;
            float y[8];
#pragma unroll
            for (int e = 0; e < 8; ++e) y[e] = bias[e];
#pragma unroll
            for (int j = 0; j < 4; ++j) {
                const unsigned p0 = win[j].x, p1 = win[j].y, p2 = win[j].z, p3 = win[j].w;
                y[0] += w[j][0] * bflo(p0); y[1] += w[j][1] * bfhi(p0); y[2] += w[j][2] * bflo(p1); y[3] += w[j][3] * bfhi(p1);
                y[4] += w[j][4] * bflo(p2); y[5] += w[j][5] * bfhi(p2); y[6] += w[j][6] * bflo(p3); y[7] += w[j][7] * bfhi(p3);
            }
#pragma unroll
            for (int e = 0; e < 8; ++e) y[e] = y[e] * sigmoidf_(y[e]);
            v4u o; o.x = pk2(y[0], y[1]); o.y = pk2(y[2], y[3]); o.z = pk2(y[4], y[5]); o.w = pk2(y[6], y[7]);
            *(v4u*)(XC + (size_t)(m0 + i) * DM + c0) = o;
        }
    }
}

typedef short s16x4 __attribute__((ext_vector_type(4)));
__device__ __forceinline__ bf16x8 tr_read_pair(unsigned a0, unsigned a1) {
    s16x4 r0, r1;
    asm volatile("ds_read_b64_tr_b16 %0, %2\n\tds_read_b64_tr_b16 %1, %3\n\ts_waitcnt lgkmcnt(0)" : "=&v"(r0), "=&v"(r1) : "v"(a0), "v"(a1) : "memory");
    return __builtin_shufflevector(r0, r1, 0, 1, 2, 3, 4, 5, 6, 7);
}
__device__ __forceinline__ float dpp_shr(float oldv, float x, int n) {
    const int o = __builtin_bit_cast(int, oldv), v = __builtin_bit_cast(int, x);
    int r;
    if (n == 1) r = __builtin_amdgcn_update_dpp(o, v, 0x111, 0xf, 0xf, false);
    else if (n == 2) r = __builtin_amdgcn_update_dpp(o, v, 0x112, 0xf, 0xf, false);
    else if (n == 4) r = __builtin_amdgcn_update_dpp(o, v, 0x114, 0xf, 0xf, false);
    else r = __builtin_amdgcn_update_dpp(o, v, 0x118, 0xf, 0xf, false);
    return __builtin_bit_cast(float, r);
}
__device__ __forceinline__ float rdlane(float x, int l) { return __builtin_bit_cast(float, __builtin_amdgcn_readlane(__builtin_bit_cast(int, x), l)); }
__device__ __forceinline__ float wave_incl_sum(float x, int lane) {
    x += dpp_shr(0.f, x, 1); x += dpp_shr(0.f, x, 2); x += dpp_shr(0.f, x, 4); x += dpp_shr(0.f, x, 8);
    const float t0 = rdlane(x, 15), t1 = rdlane(x, 31), t2 = rdlane(x, 47);
    return x + (lane >= 16 ? t0 : 0.f) + (lane >= 32 ? t1 : 0.f) + (lane >= 48 ? t2 : 0.f);
}
__device__ __forceinline__ float wave_incl_max(float x, int lane) {
    const float NI = -INFINITY;
    x = fmaxf(x, dpp_shr(NI, x, 1)); x = fmaxf(x, dpp_shr(NI, x, 2)); x = fmaxf(x, dpp_shr(NI, x, 4)); x = fmaxf(x, dpp_shr(NI, x, 8));
    const float t0 = rdlane(x, 15), t1 = rdlane(x, 31), t2 = rdlane(x, 47);
    return fmaxf(fmaxf(x, lane >= 16 ? t0 : NI), fmaxf(lane >= 32 ? t1 : NI, lane >= 48 ? t2 : NI));
}
__device__ __forceinline__ void mscan_phase(Frame& F) {
    const bf16* Q = (const bf16*)(F.ws + WS_LG); const bf16* K = (const bf16*)(F.ws + WS_K); const bf16* V = (const bf16*)(F.ws + WS_XL);
    const float* GT = (const float*)(F.ws + WS_GATE);
    constexpr int KS = 0, CTI = 33792, VT = 67584, VWT = 86016, PB = 104448, TAB = 113664, NT = 116736, NPART = 117760, DENT = 119808;
    constexpr int KST = 528, VST = 144, TABSZ = 1536;
    LAS unsigned char* L = F.lds;
    const int tid = F.tid, lane = F.lane, w = F.wave, fr = lane & 15, fq = lane >> 4, pt = w & 3, wg = w >> 2;
    for (int item = F.bid; item < 256; item += F.G) {
        const int es = item & 3, dir = (item >> 2) & 1, h = (item >> 3) & 3, b = item >> 5;
        bf16* H = dir ? ((bf16*)F.out + (size_t)MTOK * DM) : (bf16*)(F.ws + WS_XM);
        const size_t rowbase = (size_t)b * SEQ;
#define TOF(c, p) (dir ? (SEQ - 1 - 64 * (c) - (p)) : (64 * (c) + (p)))
        for (int e = tid; e < (33792 + 1024) / 4; e += NTHR) { if (e < 33792 / 4) ((LAS unsigned*)(L + CTI))[e] = 0u; else ((LAS unsigned*)(L + NT))[e - 33792 / 4] = 0u; }
        float m_run = 0.f;
        float gi_n = 0.f, gf_n = 0.f;
        if (w == 4) { const size_t m = rowbase + TOF(0, lane); gi_n = GT[m * 16 + dir * 8 + h]; gf_n = GT[m * 16 + dir * 8 + 4 + h]; }
#define G1_TABLES(setp) do { \
            const float logf_ = fminf(gf_n, 0.f) - __logf(1.f + __expf(-fabsf(gf_n))); const float b_ = wave_incl_sum(logf_, lane); const float a_ = gi_n - b_; \
            const float M_ = fmaxf(m_run, wave_incl_max(a_, lane)); const float Mend_ = rdlane(M_, 63), g_ = rdlane(b_, 63); \
            LAS float* T_ = (LAS float*)(setp); T_[lane] = a_; T_[64 + lane] = M_; T_[128 + lane] = __expf(m_run - M_); T_[192 + lane] = __expf(-(b_ + M_)); T_[256 + lane] = __expf(a_ - Mend_); \
            if (lane == 0) { T_[320] = __expf(m_run - Mend_); T_[321] = g_ + Mend_; } \
            m_run = g_ + Mend_; } while (0)
        if (w == 4) G1_TABLES(L + TAB);
        __syncthreads();
        bf16x8 qf[8];
        v4u kreg[4]; v4u vreg;
#define LOAD_KV(c) do { _Pragma("unroll") for (int r_ = 0; r_ < 4; ++r_) { const int i_ = tid + NTHR * r_, s_ = i_ >> 5, c16_ = i_ & 31; \
                kreg[r_] = *(const v4u*)(K + (rowbase + TOF(c, s_)) * DM + h * 256 + c16_ * 8); } \
            { const int s_ = tid & 63, e8_ = tid >> 6; vreg = *(const v4u*)(V + (rowbase + TOF(c, s_)) * DM + h * 256 + es * 64 + e8_ * 8); } } while (0)
#define STORE_KV(setidx) do { _Pragma("unroll") for (int r_ = 0; r_ < 4; ++r_) { const int i_ = tid + NTHR * r_, s_ = i_ >> 5, c16_ = i_ & 31; \
                *(LAS v4u*)(L + KS + s_ * KST + c16_ * 16) = kreg[r_]; } \
            { const int s_ = tid & 63, e8_ = tid >> 6; const float ws_ = ((const LAS float*)(L + TAB + (setidx) * TABSZ))[256 + s_]; \
              LAS bf16* vt_ = (LAS bf16*)(L + VT + (setidx) * 9216); LAS bf16* vw_ = (LAS bf16*)(L + VWT + (setidx) * 9216); \
              const unsigned wv_[4] = {vreg.x, vreg.y, vreg.z, vreg.w}; \
              _Pragma("unroll") for (int j_ = 0; j_ < 4; ++j_) { const float lo_ = bflo(wv_[j_]), hi_ = bfhi(wv_[j_]); const int e_ = e8_ * 8 + 2 * j_; \
                vt_[e_ * 72 + s_] = (bf16)(wv_[j_] & 0xffffu); vt_[(e_ + 1) * 72 + s_] = (bf16)(wv_[j_] >> 16); \
                vw_[e_ * 72 + s_] = (bf16)f2bf(lo_ * ws_); vw_[(e_ + 1) * 72 + s_] = (bf16)f2bf(hi_ * ws_); } } } while (0)
#define LOAD_Q(c) do { const size_t m_ = rowbase + TOF(c, 16 * pt + fr); _Pragma("unroll") for (int ks_ = 0; ks_ < 8; ++ks_) \
                qf[ks_] = *(const bf16x8*)(Q + m_ * DM + h * 256 + 32 * ks_ + 8 * fq); } while (0)
        LOAD_KV(0); LOAD_Q(0);
        STORE_KV(0);
        f32x4 Cacc[8], Nacc[2];
#pragma unroll
        for (int i = 0; i < 8; ++i) Cacc[i] = (f32x4){0.f, 0.f, 0.f, 0.f};
        Nacc[0] = (f32x4){0.f, 0.f, 0.f, 0.f}; Nacc[1] = (f32x4){0.f, 0.f, 0.f, 0.f};
        __syncthreads();
        for (int c = 0; c < 64; ++c) {
            const int cur = c & 1, nxt = cur ^ 1;
            const bool has_next = (c + 1 < 64);
            const LAS float* T = (const LAS float*)(L + TAB + cur * TABSZ);
            if (has_next) { LOAD_KV(c + 1); if (w == 4) { const size_t m = rowbase + TOF(c + 1, lane); gi_n = GT[m * 16 + dir * 8 + h]; gf_n = GT[m * 16 + dir * 8 + 4 + h]; } }
            const int p = 16 * pt + fr;
            const float Mp = T[64 + p], wi_p = T[128 + p];
            float cs = 0.f;
            f32x4 O[2] = {(f32x4){0.f, 0.f, 0.f, 0.f}, (f32x4){0.f, 0.f, 0.f, 0.f}}, sa[2] = {(f32x4){0.f, 0.f, 0.f, 0.f}, (f32x4){0.f, 0.f, 0.f, 0.f}};
            const bool s0on = (2 * wg <= pt), s1on = (2 * wg + 1 <= pt);
#define KF(i, ks) (*(const LAS bf16x8*)(L + KS + (16 * (2 * wg + (i)) + fr) * KST + (32 * (ks) + 8 * fq) * 2))
#define CF(i, ks) (*(const LAS bf16x8*)(L + CTI + (16 * (2 * wg + (i)) + fr) * KST + (32 * (ks) + 8 * fq) * 2))
            if (s1on) {
#pragma unroll
                for (int ks = 0; ks < 8; ++ks) { const bf16x8 k0 = KF(0, ks), k1 = KF(1, ks), c0 = CF(0, ks), c1 = CF(1, ks);
                    sa[0] = __builtin_amdgcn_mfma_f32_16x16x32_bf16(k0, qf[ks], sa[0], 0, 0, 0); sa[1] = __builtin_amdgcn_mfma_f32_16x16x32_bf16(k1, qf[ks], sa[1], 0, 0, 0);
                    O[0] = __builtin_amdgcn_mfma_f32_16x16x32_bf16(c0, qf[ks], O[0], 0, 0, 0); O[1] = __builtin_amdgcn_mfma_f32_16x16x32_bf16(c1, qf[ks], O[1], 0, 0, 0); }
            } else if (s0on) {
#pragma unroll
                for (int ks = 0; ks < 8; ++ks) { const bf16x8 k0 = KF(0, ks), c0 = CF(0, ks), c1 = CF(1, ks);
                    sa[0] = __builtin_amdgcn_mfma_f32_16x16x32_bf16(k0, qf[ks], sa[0], 0, 0, 0);
                    O[0] = __builtin_amdgcn_mfma_f32_16x16x32_bf16(c0, qf[ks], O[0], 0, 0, 0); O[1] = __builtin_amdgcn_mfma_f32_16x16x32_bf16(c1, qf[ks], O[1], 0, 0, 0); }
            } else {
#pragma unroll
                for (int ks = 0; ks < 8; ++ks) { const bf16x8 c0 = CF(0, ks), c1 = CF(1, ks);
                    O[0] = __builtin_amdgcn_mfma_f32_16x16x32_bf16(c0, qf[ks], O[0], 0, 0, 0); O[1] = __builtin_amdgcn_mfma_f32_16x16x32_bf16(c1, qf[ks], O[1], 0, 0, 0); }
            }
#undef KF
#undef CF
#pragma unroll
            for (int i = 0; i < 2; ++i) { const int st = 2 * wg + i;
                v2u pw = {0u, 0u};
                if (i ? s1on : s0on) {
                    const f32x4 a4 = *(const LAS f32x4*)(T + 16 * st + 4 * fq);
                    float pv[4];
#pragma unroll
                    for (int r = 0; r < 4; ++r) { const int s_ = 16 * st + 4 * fq + r; const float wgt = (s_ <= p) ? __expf(a4[r] - Mp) : 0.f; pv[r] = sa[i][r] * wgt; cs += pv[r]; }
                    pw.x = pk2(pv[0], pv[1]); pw.y = pk2(pv[2], pv[3]);
                }
                *(LAS v2u*)(L + PB + p * VST + (16 * st + 4 * fq) * 2) = pw; }
            float di = 0.f;
#define DEN_INTER(ks) do { const f32x4 n0 = *(const LAS f32x4*)(L + NT + (32 * (ks) + 8 * fq) * 4), n1 = *(const LAS f32x4*)(L + NT + (32 * (ks) + 8 * fq) * 4 + 16); \
                const v4u qw = __builtin_bit_cast(v4u, qf[ks]); \
                di += bflo(qw.x) * n0[0] + bfhi(qw.x) * n0[1] + bflo(qw.y) * n0[2] + bfhi(qw.y) * n0[3] + bflo(qw.z) * n1[0] + bfhi(qw.z) * n1[1] + bflo(qw.w) * n1[2] + bfhi(qw.w) * n1[3]; } while (0)
            if (wg == 0) { DEN_INTER(0); DEN_INTER(1); DEN_INTER(2); DEN_INTER(3); }
            else { DEN_INTER(4); DEN_INTER(5); DEN_INTER(6); DEN_INTER(7); }
#undef DEN_INTER
            di += __shfl_xor(di, 16); di += __shfl_xor(di, 32);
            cs += __shfl_xor(cs, 16); cs += __shfl_xor(cs, 32);
            if (fq == 0) ((LAS float*)(L + DENT))[wg * 64 + p] = wi_p * di + cs;
            if (has_next) LOAD_Q(c + 1);
            if (has_next && w == 4) G1_TABLES(L + TAB + nxt * TABSZ);
            __syncthreads();
#pragma unroll
            for (int i = 0; i < 2; ++i) { const int et = 2 * wg + i; O[i] = O[i] * wi_p;
#pragma unroll
                for (int ks = 0; ks < 2; ++ks) { const bf16x8 vf = *(const LAS bf16x8*)(L + VT + cur * 9216 + (16 * et + fr) * VST + (32 * ks + 8 * fq) * 2);
                    const bf16x8 pf = *(const LAS bf16x8*)(L + PB + p * VST + (32 * ks + 8 * fq) * 2);
                    O[i] = __builtin_amdgcn_mfma_f32_16x16x32_bf16(vf, pf, O[i], 0, 0, 0); } }
            { const float den = ((const LAS float*)(L + DENT))[p] + ((const LAS float*)(L + DENT))[64 + p];
              const float inv = 1.f / fmaxf(fabsf(den), T[192 + p]);
              const size_t m = rowbase + TOF(c, p);
#pragma unroll
              for (int i = 0; i < 2; ++i) { const int et = 2 * wg + i; v2u o; o.x = pk2(O[i][0] * inv, O[i][1] * inv); o.y = pk2(O[i][2] * inv, O[i][3] * inv);
                  *(v2u*)(H + m * DM + h * 256 + es * 64 + 16 * et + 4 * fq) = o; } }
            { const float decay = T[320];
              const bf16x8 vw0 = *(const LAS bf16x8*)(L + VWT + cur * 9216 + (16 * pt + fr) * VST + (8 * fq) * 2);
              const bf16x8 vw1 = *(const LAS bf16x8*)(L + VWT + cur * 9216 + (16 * pt + fr) * VST + (32 + 8 * fq) * 2);
              bf16x8 wsf0, wsf1;
              { const f32x4 w0 = *(const LAS f32x4*)(T + 256 + 8 * fq), w1 = *(const LAS f32x4*)(T + 256 + 8 * fq + 4), w2 = *(const LAS f32x4*)(T + 288 + 8 * fq), w3 = *(const LAS f32x4*)(T + 288 + 8 * fq + 4);
                const bool c0 = (fr == 0);
                v4u a, b; a.x = c0 ? pk2(w0[0], w0[1]) : 0u; a.y = c0 ? pk2(w0[2], w0[3]) : 0u; a.z = c0 ? pk2(w1[0], w1[1]) : 0u; a.w = c0 ? pk2(w1[2], w1[3]) : 0u;
                b.x = c0 ? pk2(w2[0], w2[1]) : 0u; b.y = c0 ? pk2(w2[2], w2[3]) : 0u; b.z = c0 ? pk2(w3[0], w3[1]) : 0u; b.w = c0 ? pk2(w3[2], w3[3]) : 0u;
                wsf0 = __builtin_bit_cast(bf16x8, a); wsf1 = __builtin_bit_cast(bf16x8, b); }
              const int l16 = lane & 15, q4 = l16 >> 2, p4 = l16 & 3;
              const unsigned kb = (unsigned)(uintptr_t)(L + KS) + (unsigned)((8 * fq + q4) * KST + 4 * p4 * 2);
#pragma unroll
              for (int dtl = 0; dtl < 8; dtl += 2) { const int dt = 8 * wg + dtl; const unsigned a0 = kb + dt * 32;
                  s16x4 r0, r1, r2, r3, r4, r5, r6, r7;
                  asm volatile("ds_read_b64_tr_b16 %0, %8\n\tds_read_b64_tr_b16 %1, %8 offset:2112\n\tds_read_b64_tr_b16 %2, %8 offset:16896\n\tds_read_b64_tr_b16 %3, %8 offset:19008\n\t"
                               "ds_read_b64_tr_b16 %4, %8 offset:32\n\tds_read_b64_tr_b16 %5, %8 offset:2144\n\tds_read_b64_tr_b16 %6, %8 offset:16928\n\tds_read_b64_tr_b16 %7, %8 offset:19040\n\ts_waitcnt lgkmcnt(0)"
                               : "=&v"(r0), "=&v"(r1), "=&v"(r2), "=&v"(r3), "=&v"(r4), "=&v"(r5), "=&v"(r6), "=&v"(r7) : "v"(a0) : "memory");
                  const bf16x8 k0 = __builtin_shufflevector(r0, r1, 0, 1, 2, 3, 4, 5, 6, 7), k1 = __builtin_shufflevector(r2, r3, 0, 1, 2, 3, 4, 5, 6, 7);
                  const bf16x8 k2 = __builtin_shufflevector(r4, r5, 0, 1, 2, 3, 4, 5, 6, 7), k3 = __builtin_shufflevector(r6, r7, 0, 1, 2, 3, 4, 5, 6, 7);
                  Cacc[dtl] = Cacc[dtl] * decay; Cacc[dtl + 1] = Cacc[dtl + 1] * decay;
                  Cacc[dtl] = __builtin_amdgcn_mfma_f32_16x16x32_bf16(k0, vw0, Cacc[dtl], 0, 0, 0);
                  Cacc[dtl + 1] = __builtin_amdgcn_mfma_f32_16x16x32_bf16(k2, vw0, Cacc[dtl + 1], 0, 0, 0);
                  Cacc[dtl] = __builtin_amdgcn_mfma_f32_16x16x32_bf16(k1, vw1, Cacc[dtl], 0, 0, 0);
                  Cacc[dtl + 1] = __builtin_amdgcn_mfma_f32_16x16x32_bf16(k3, vw1, Cacc[dtl + 1], 0, 0, 0);
                  if (dtl == 2 * pt) {
                      Nacc[0] = Nacc[0] * decay; Nacc[1] = Nacc[1] * decay;
                      Nacc[0] = __builtin_amdgcn_mfma_f32_16x16x32_bf16(k0, wsf0, Nacc[0], 0, 0, 0); Nacc[1] = __builtin_amdgcn_mfma_f32_16x16x32_bf16(k2, wsf0, Nacc[1], 0, 0, 0);
                      Nacc[0] = __builtin_amdgcn_mfma_f32_16x16x32_bf16(k1, wsf1, Nacc[0], 0, 0, 0); Nacc[1] = __builtin_amdgcn_mfma_f32_16x16x32_bf16(k3, wsf1, Nacc[1], 0, 0, 0); } } }
            __syncthreads();
            { const float decay = T[320];
#pragma unroll
              for (int dtl = 0; dtl < 8; ++dtl) { const int dt = 8 * wg + dtl; v2u o; o.x = pk2(Cacc[dtl][0], Cacc[dtl][1]); o.y = pk2(Cacc[dtl][2], Cacc[dtl][3]);
                  *(LAS v2u*)(L + CTI + (16 * pt + fr) * KST + (16 * dt + 4 * fq) * 2) = o; }
              if (fr == 0) { *(LAS f32x4*)(L + NT + (16 * (8 * wg + 2 * pt) + 4 * fq) * 4) = Nacc[0]; *(LAS f32x4*)(L + NT + (16 * (8 * wg + 2 * pt + 1) + 4 * fq) * 4) = Nacc[1]; } }
            if (has_next) STORE_KV(nxt);
            __syncthreads();
        }
#undef TOF
#undef G1_TABLES
#undef LOAD_KV
#undef STORE_KV
#undef LOAD_Q
    }
}

__device__ __forceinline__ void ym_phase(Frame& F) {
    const bf16* HF = (const bf16*)(F.ws + WS_XM); const bf16* HB = (const bf16*)F.out + (size_t)MTOK * DM; bf16* OP = (bf16*)(F.ws + WS_OP);
    const float* ng = F.in[9];
    const int gw = F.bid * NWAVES + F.wave, NGW = F.G * NWAVES;
    for (int m = gw; m < MTOK; m += NGW) {
#pragma unroll
        for (int hd = 0; hd < 4; ++hd) {
            const size_t o = (size_t)m * DM + hd * 256 + F.lane * 4;
            const v2u a = *(const v2u*)(HF + o), b = *(const v2u*)(HB + o), op = *(const v2u*)(OP + o);
            const float v0 = bflo(a.x) + bflo(b.x), v1 = bfhi(a.x) + bfhi(b.x), v2 = bflo(a.y) + bflo(b.y), v3 = bfhi(a.y) + bfhi(b.y);
            const float r = rsqrtf(wave_sum((v0 * v0 + v1 * v1) + (v2 * v2 + v3 * v3)) * (1.f / 256.f) + EPS);
            const f32x4 g = *(const f32x4*)(ng + hd * 256 + F.lane * 4);
            v2u w; w.x = pk2(sigmoidf_(bflo(op.x)) * v0 * r * g[0], sigmoidf_(bfhi(op.x)) * v1 * r * g[1]);
            w.y = pk2(sigmoidf_(bflo(op.y)) * v2 * r * g[2], sigmoidf_(bfhi(op.y)) * v3 * r * g[3]);
            *(v2u*)(OP + o) = w;
        }
    }
    {
        float* usc = (float*)(F.ws + WS_LG + 16 * MiB); float* vsc = usc + NEXP;
        for (int row = gw; row < 2 * NEXP; row += NGW) {
            const bool isv = row >= NEXP; const int r = isv ? row - NEXP : row;
            const f32x4* src = (const f32x4*)(F.in[isv ? 24 : 23] + (size_t)r * DM) + F.lane * 4;
            f32x4 a[4]; float ss = 0.f;
#pragma unroll
            for (int j = 0; j < 4; ++j) { a[j] = src[j]; ss += (a[j][0] * a[j][0] + a[j][1] * a[j][1]) + (a[j][2] * a[j][2] + a[j][3] * a[j][3]); }
            const float rms = sqrtf(wave_sum(ss) * (1.f / DM));
            const float sc = fmaxf(rms * 0.5f, 1e-30f), inv = 1.f / sc;
            unsigned o[2] = {0u, 0u};
#pragma unroll
            for (int j = 0; j < 4; ++j) { const f32x4 q = a[j] * inv;
                if (j & 1) { o[j >> 1] = __builtin_amdgcn_cvt_scalef32_pk_fp4_f32(o[j >> 1], q[0], q[1], 1.0f, 2); o[j >> 1] = __builtin_amdgcn_cvt_scalef32_pk_fp4_f32(o[j >> 1], q[2], q[3], 1.0f, 3); }
                else       { o[j >> 1] = __builtin_amdgcn_cvt_scalef32_pk_fp4_f32(o[j >> 1], q[0], q[1], 1.0f, 0); o[j >> 1] = __builtin_amdgcn_cvt_scalef32_pk_fp4_f32(o[j >> 1], q[2], q[3], 1.0f, 1); } }
            *(v2u*)(F.ws + WS_LG + (isv ? 8 * MiB : 0) + (size_t)r * (DM / 2) + F.lane * 8) = (v2u){o[0], o[1]};
            if (F.lane == 0) (isv ? vsc : usc)[r] = sc;
        }
    }
}

typedef float f32x16 __attribute__((ext_vector_type(16)));
#define TOPK_INSERT(L, xv) do { const float x_ = (xv); \
    L[15] = __builtin_amdgcn_fmed3f(L[14], L[15], x_); L[14] = __builtin_amdgcn_fmed3f(L[13], L[14], x_); L[13] = __builtin_amdgcn_fmed3f(L[12], L[13], x_); L[12] = __builtin_amdgcn_fmed3f(L[11], L[12], x_); \
    L[11] = __builtin_amdgcn_fmed3f(L[10], L[11], x_); L[10] = __builtin_amdgcn_fmed3f(L[9], L[10], x_); L[9] = __builtin_amdgcn_fmed3f(L[8], L[9], x_); L[8] = __builtin_amdgcn_fmed3f(L[7], L[8], x_); \
    L[7] = __builtin_amdgcn_fmed3f(L[6], L[7], x_); L[6] = __builtin_amdgcn_fmed3f(L[5], L[6], x_); L[5] = __builtin_amdgcn_fmed3f(L[4], L[5], x_); L[4] = __builtin_amdgcn_fmed3f(L[3], L[4], x_); \
    L[3] = __builtin_amdgcn_fmed3f(L[2], L[3], x_); L[2] = __builtin_amdgcn_fmed3f(L[1], L[2], x_); L[1] = __builtin_amdgcn_fmed3f(L[0], L[1], x_); L[0] = fmaxf(L[0], x_); } while (0)
template <int I> struct CandRow {
    static __device__ __forceinline__ void run(const float (&L0)[16], const float (&L1)[16], float (&R)[16]) {
        constexpr int NJ = 16 / (I + 1);
#pragma unroll
        for (int j = 0; j < NJ; ++j) { const float sm = L0[I] + L1[j];
            const float pk = __builtin_bit_cast(float, (__builtin_bit_cast(unsigned, sm) & 0xffffff00u) | (unsigned)(I * 16 + j)); TOPK_INSERT(R, pk); }
        if constexpr (I < 15) CandRow<I + 1>::run(L0, L1, R);
    }
};
__device__ __forceinline__ unsigned pick4(unsigned d0, unsigned d1, unsigned d2, unsigned d3, int i) {
    const int q = i >> 2; unsigned d = d0; d = (q == 1) ? d1 : d; d = (q == 2) ? d2 : d; d = (q == 3) ? d3 : d; return (d >> (8 * (i & 3))) & 127u;
}
__device__ __forceinline__ void select_phase(Frame& F) {
    const bf16* PQ = (const bf16*)(F.ws + WS_MG); const bf16* KEYS = (const bf16*)(F.ws + WS_KEYS);
    int* IDX = (int*)(F.ws + WS_K); float* GW = (float*)(F.ws + WS_K + 16 * MiB);
    LAS unsigned char* L = F.lds;
    const int tid = F.tid, lane = F.lane, w = F.wave, l31 = lane & 31, hh = lane >> 5;
    const float NEG_INF = -INFINITY;
    for (int grp = F.bid; grp < MTOK / 128; grp += F.G) {
        const int tb = grp * 4 + (w & 3);
        const size_t m = (size_t)tb * 32 + l31;
        for (int hp = 0; hp < 4; ++hp) {
            __syncthreads();
#pragma unroll 4
            for (int r = 0; r < 16; ++r) { const int e = tid + NTHR * r, R = e >> 4, c = e & 15;
                *(LAS v4u*)(L + R * 256 + ((c ^ (R & 15)) * 16)) = *(const v4u*)(KEYS + ((size_t)(hp * 512 + R) * 128 + c * 8)); }
            __syncthreads();
            const int hl = w >> 2, h = 2 * hp + hl;
            float L0[16], L1[16];
#pragma unroll
            for (int p = 0; p < 2; ++p) {
                bf16x8 qf[8];
#pragma unroll
                for (int ks = 0; ks < 8; ++ks) qf[ks] = *(const bf16x8*)(PQ + m * 2048 + h * 256 + p * 128 + 16 * ks + 8 * hh);
                f32x16 acc[4];
#pragma unroll
                for (int kb = 0; kb < 4; ++kb)
#pragma unroll
                    for (int r = 0; r < 16; ++r) acc[kb][r] = 0.f;
#pragma unroll
                for (int ks = 0; ks < 8; ++ks)
#pragma unroll
                    for (int kb = 0; kb < 4; ++kb) { const int R = (hl * 2 + p) * 128 + 32 * kb + l31;
                        const bf16x8 kf = *(const LAS bf16x8*)(L + R * 256 + (((2 * ks + hh) ^ (lane & 15)) * 16));
                        acc[kb] = __builtin_amdgcn_mfma_f32_32x32x16_bf16(kf, qf[ks], acc[kb], 0, 0, 0); }
                float Lc[16];
#pragma unroll
                for (int i = 0; i < 16; ++i) Lc[i] = NEG_INF;
                const unsigned hh4 = (unsigned)hh << 2;
#pragma unroll
                for (int kb = 0; kb < 4; ++kb)
#pragma unroll
                    for (int r = 0; r < 16; ++r) { const unsigned nlo = (unsigned)(32 * kb + (r & 3) + 8 * (r >> 2));
                        const float av_ = acc[kb][r];
                        const float pk = __uint_as_float(((__float_as_uint(av_) & 0xffffff80u) | hh4) | nlo); TOPK_INSERT(Lc, pk); }
                float Lo[16];
#pragma unroll
                for (int i = 0; i < 16; ++i) Lo[i] = __shfl_xor(Lc[i], 32);
#pragma unroll
                for (int i = 0; i < 16; ++i) TOPK_INSERT(Lc, Lo[i]);
#pragma unroll
                for (int i = 0; i < 16; ++i) { if (p == 0) L0[i] = Lc[i]; else L1[i] = Lc[i]; }
            }
            float R[16];
#pragma unroll
            for (int i = 0; i < 16; ++i) R[i] = NEG_INF;
            CandRow<0>::run(L0, L1, R);
            unsigned a0 = 0, a1 = 0, a2 = 0, a3 = 0, b0 = 0, b1 = 0, b2 = 0, b3 = 0;
#pragma unroll
            for (int i = 0; i < 4; ++i) { a0 |= (__builtin_bit_cast(unsigned, L0[i]) & 127u) << (8 * i); a1 |= (__builtin_bit_cast(unsigned, L0[4 + i]) & 127u) << (8 * i);
                a2 |= (__builtin_bit_cast(unsigned, L0[8 + i]) & 127u) << (8 * i); a3 |= (__builtin_bit_cast(unsigned, L0[12 + i]) & 127u) << (8 * i);
                b0 |= (__builtin_bit_cast(unsigned, L1[i]) & 127u) << (8 * i); b1 |= (__builtin_bit_cast(unsigned, L1[4 + i]) & 127u) << (8 * i);
                b2 |= (__builtin_bit_cast(unsigned, L1[8 + i]) & 127u) << (8 * i); b3 |= (__builtin_bit_cast(unsigned, L1[12 + i]) & 127u) << (8 * i); }
            float ex[16]; float sum = 0.f; int id[16];
#pragma unroll
            for (int r = 0; r < 16; ++r) { ex[r] = __expf(R[r] - R[0]); sum += ex[r];
                const unsigned cid = __builtin_bit_cast(unsigned, R[r]) & 255u;
                id[r] = (int)(pick4(a0, a1, a2, a3, (int)(cid >> 4)) * 128u + pick4(b0, b1, b2, b3, (int)(cid & 15u))); }
            const float inv = 1.f / sum;
            if (hh == 0) {
#pragma unroll
                for (int q = 0; q < 4; ++q) {
                    *(int4*)(IDX + m * 128 + h * 16 + 4 * q) = make_int4(id[4 * q], id[4 * q + 1], id[4 * q + 2], id[4 * q + 3]);
                    *(f32x4*)(GW + m * 128 + h * 16 + 4 * q) = (f32x4){ex[4 * q] * inv, ex[4 * q + 1] * inv, ex[4 * q + 2] * inv, ex[4 * q + 3] * inv}; }
            }
        }
    }
}

template <int B> __device__ __forceinline__ f32x2 fp4b(unsigned w) { return __builtin_amdgcn_cvt_scalef32_pk_f32_fp4(w, 1.0f, B); }
typedef int v8i_t __attribute__((ext_vector_type(8)));
#define AP_SLOT(e) (4 * (((e) >> 1) & 3) + 2 * ((e) >> 3) + ((e) & 1))
__device__ __forceinline__ void apply_phase(Frame& F, float* OUTP) {
    const unsigned char* U8 = F.ws + WS_LG; const unsigned char* V8 = F.ws + WS_LG + 8 * MiB;
    const float* USC = (const float*)(F.ws + WS_LG + 16 * MiB); const float* VSC = USC + NEXP;
    const int* IDX = (const int*)(F.ws + WS_K); const float* GW = (const float*)(F.ws + WS_K + 16 * MiB);
    const float* g2 = F.in[20]; const float* gf = F.in[25];
    const float* X1 = F.out;
    const int lane = F.lane, fr = lane & 15, fq = lane >> 4;
    constexpr int APW = 2 * 16 * 528 + 1024;
    LAS unsigned char* UL = F.lds + F.wave * APW; LAS unsigned char* VL = UL + 16 * 528; LAS unsigned char* H8 = VL + 16 * 528;
    const int pe = 2 * fq + (fr & 1) + 8 * ((fr >> 1) & 1);
    const int bsh = 8 * (fr & 3); const unsigned mlo = fr < 4 ? ~0u : 0u, mhi = (fr >= 4 && fr < 8) ? ~0u : 0u;
#define AP_LOADROWS(SEL, KB) _Pragma("unroll") for (int e = 0; e < 16; ++e) { \
        const size_t ro = (size_t)__builtin_amdgcn_readlane(SEL, ((KB) + e) & 63) * (DM / 2) + lane * 8; uu[e] = *(const v2u*)(U8 + ro); vv[e] = *(const v2u*)(V8 + ro); }
    for (int grp = F.bid; grp < MTOK / 128; grp += F.G) {
        const int mbase = grp * 128 + F.wave;
        int ni0 = IDX[(size_t)mbase * 128 + lane], ni1 = IDX[(size_t)mbase * 128 + 64 + lane];
        float ngw0 = GW[(size_t)mbase * 128 + lane], ngw1 = GW[(size_t)mbase * 128 + 64 + lane];
        f32x4 nxr[4];
#pragma unroll
        for (int q = 0; q < 4; ++q) nxr[q] = *(const f32x4*)(X1 + (size_t)mbase * DM + lane * 16 + q * 4);
        v2u uu[16], vv[16];
        AP_LOADROWS(ni0, 0)
        int i0 = 0, i1 = 0; float gw0 = 0.f, gw1 = 0.f; f32x4 xr[4], oacc[8];
#pragma unroll
        for (int q = 0; q < 4; ++q) xr[q] = (f32x4){0.f, 0.f, 0.f, 0.f};
#pragma unroll
        for (int i = 0; i < 8; ++i) oacc[i] = (f32x4){0.f, 0.f, 0.f, 0.f};
#pragma unroll 1
        for (int it = 0; it < 128; ++it) {
            const int bt = it & 7, m = mbase + 8 * (it >> 3);
            if (bt == 0) {
                i0 = ni0; i1 = ni1; gw0 = ngw0; gw1 = ngw1; float s = 0.f;
#pragma unroll
                for (int q = 0; q < 4; ++q) { xr[q] = nxr[q]; s += (xr[q][0] * xr[q][0] + xr[q][1] * xr[q][1]) + (xr[q][2] * xr[q][2] + xr[q][3] * xr[q][3]); }
                const float r2 = rsqrtf(wave_sum(s) * (1.f / DM) + EPS);
                v4u h8;
#pragma unroll
                for (int q = 0; q < 4; ++q) { const f32x4 g = *(const f32x4*)(g2 + lane * 16 + q * 4); const f32x4 hq = xr[q] * r2 * g;
                    int pk = 0; pk = __builtin_amdgcn_cvt_pk_fp8_f32(hq[0], hq[1], pk, false); pk = __builtin_amdgcn_cvt_pk_fp8_f32(hq[2], hq[3], pk, true); h8[q] = (unsigned)pk; }
                *(LAS v4u*)(H8 + lane * 16) = h8;
#pragma unroll
                for (int i = 0; i < 8; ++i) oacc[i] = (f32x4){0.f, 0.f, 0.f, 0.f};
                const int mn = (it + 8 < 128) ? m + 8 : m;
                ni0 = IDX[(size_t)mn * 128 + lane]; ni1 = IDX[(size_t)mn * 128 + 64 + lane]; ngw0 = GW[(size_t)mn * 128 + lane]; ngw1 = GW[(size_t)mn * 128 + 64 + lane];
#pragma unroll
                for (int q = 0; q < 4; ++q) nxr[q] = *(const f32x4*)(X1 + (size_t)mn * DM + lane * 16 + q * 4);
            }
            const int k0 = bt * 16;
            const int isel = (k0 < 64) ? i0 : i1;
            const int myidx = __shfl(isel, (k0 + pe) & 63);
            const float su = USC[myidx], sv = VSC[myidx];
#pragma unroll
            for (int e = 0; e < 16; ++e) { *(LAS v2u*)(UL + AP_SLOT(e) * 528 + lane * 8) = uu[e]; *(LAS v2u*)(VL + e * 528 + lane * 8) = vv[e]; }
            { const int nk = (k0 + 16) & 127; const int nsel = (bt == 7) ? ni0 : ((nk < 64) ? i0 : i1);
              AP_LOADROWS(nsel, nk) }
            f32x4 da = (f32x4){0.f, 0.f, 0.f, 0.f}, db = (f32x4){0.f, 0.f, 0.f, 0.f};
#pragma unroll
            for (int ks = 0; ks < 8; ++ks) {
                const v4u af = *(const LAS v4u*)(UL + fr * 528 + 64 * ks + 16 * fq);
                const v4u b0 = *(const LAS v4u*)(H8 + 128 * ks + 16 * fq), b1 = *(const LAS v4u*)(H8 + 128 * ks + 64 + 16 * fq);
                const v8i_t A = {(int)af.x, (int)af.y, (int)af.z, (int)af.w, 0, 0, 0, 0};
                const v8i_t B = {(int)b0.x, (int)b0.y, (int)b0.z, (int)b0.w, (int)b1.x, (int)b1.y, (int)b1.z, (int)b1.w};
                if (ks & 1) db = __builtin_amdgcn_mfma_scale_f32_16x16x128_f8f6f4(A, B, db, 4  , 0  , 0, 0x7F7F7F7F, 0, 0x7F7F7F7F);
                else        da = __builtin_amdgcn_mfma_scale_f32_16x16x128_f8f6f4(A, B, da, 4, 0, 0, 0x7F7F7F7F, 0, 0x7F7F7F7F);
            }
            const f32x4 d4 = da + db;
            const int sel = fr & 3;
            float t = d4[0]; t = (sel == 1) ? d4[1] : t; t = (sel == 2) ? d4[2] : t; t = (sel == 3) ? d4[3] : t;
            const float gk = __shfl((k0 < 64) ? gw0 : gw1, (k0 + pe) & 63);
            const float wl = gk * gelu_fast(t * su) * sv;
            float wm = fabsf(wl); wm = fmaxf(wm, __shfl_xor(wm, 1)); wm = fmaxf(wm, __shfl_xor(wm, 2)); wm = fmaxf(wm, __shfl_xor(wm, 16)); wm = fmaxf(wm, __shfl_xor(wm, 32));
            int E = (int)(__float_as_uint(wm) >> 23); E = E < 8 ? 8 : E;
            const float wq = wl * __uint_as_float((unsigned)(261 - E) << 23);
            const int scb = (E - 7) * 0x01010101;
            v8i_t Bw;
#define AP_WQ(tq, ctrl) { const float wt = __builtin_bit_cast(float, __builtin_amdgcn_update_dpp(0, __builtin_bit_cast(int, wq), ctrl, 0xf, 0xf, false)); \
                const unsigned p8 = (unsigned)__builtin_amdgcn_cvt_pk_fp8_f32(wt, 0.f, 0, false) << bsh; Bw[2 * tq] = (int)(p8 & mlo); Bw[2 * tq + 1] = (int)(p8 & mhi); }
            AP_WQ(0, 0x00) AP_WQ(1, 0x55) AP_WQ(2, 0xAA) AP_WQ(3, 0xFF)
#pragma unroll
            for (int c = 0; c < 8; ++c) {
                v4u av;
                av.x = *(const LAS unsigned*)(VL + (4 * fq + 0) * 528 + 64 * c + 4 * fr); av.y = *(const LAS unsigned*)(VL + (4 * fq + 1) * 528 + 64 * c + 4 * fr);
                av.z = *(const LAS unsigned*)(VL + (4 * fq + 2) * 528 + 64 * c + 4 * fr); av.w = *(const LAS unsigned*)(VL + (4 * fq + 3) * 528 + 64 * c + 4 * fr);
                const v8i_t A = {(int)av.x, (int)av.y, (int)av.z, (int)av.w, 0, 0, 0, 0};
                oacc[c] = __builtin_amdgcn_mfma_scale_f32_16x16x128_f8f6f4(A, Bw, oacc[c], 4, 0, 0, 0x7F7F7F7F, 0, scb);
            }
            if (bt == 7) {
                if (fr < 8) {
#pragma unroll
                    for (int c = 0; c < 8; ++c)
#pragma unroll
                        for (int r = 0; r < 4; ++r) { const float o = oacc[c][r]; *(LAS unsigned*)(UL + 4 * ((4 * c + fq) * 40 + 8 * r + fr)) = __float_as_uint(o); }
                }
                float s2 = 0.f; f32x4 ov[4];
#pragma unroll
                for (int q = 0; q < 4; ++q) { const v4u ou = *(const LAS v4u*)(UL + 4 * ((lane >> 1) * 40 + (lane & 1) * 16 + 4 * q));
                    ov[q] = (f32x4){__uint_as_float(ou.x), __uint_as_float(ou.y), __uint_as_float(ou.z), __uint_as_float(ou.w)} + xr[q];
                    s2 += (ov[q][0] * ov[q][0] + ov[q][1] * ov[q][1]) + (ov[q][2] * ov[q][2] + ov[q][3] * ov[q][3]); }
                const float rf = rsqrtf(wave_sum(s2) * (1.f / DM) + EPS);
#pragma unroll
                for (int q = 0; q < 4; ++q) { const f32x4 g = *(const f32x4*)(gf + lane * 16 + q * 4);
                    *(f32x4*)(OUTP + (size_t)m * DM + lane * 16 + q * 4) = ov[q] * rf * g; }
            }
        }
    }
}

constexpr int N_PHASES = 13;
__global__ void __launch_bounds__(NTHR, 2) mega_fwd(Args args) {
    extern __shared__ __attribute__((aligned(16))) unsigned char lds[];
    Frame F;
    F.lds = (LAS unsigned char*)lds;
    F.tid = threadIdx.x; F.lane = F.tid & 63; F.wave = __builtin_amdgcn_readfirstlane(F.tid >> 6);
    F.G = gridDim.x; F.bid = blockIdx.x;
    F.in = args.in; F.out = args.out; F.ws = args.ws;
    volatile LAS unsigned* MISC = (volatile LAS unsigned*)(F.lds + MISC_OFF);
    for (int u = F.tid; u < (LDS_BYTES - LDSCTL_OFF) / 4; u += NTHR) ((LAS unsigned*)(F.lds + LDSCTL_OFF))[u] = 0u;
    __syncthreads();
    XcdBarrier bar; bar.bar = (unsigned*)(args.ws + WS_CTL) + CW_BAR; bar.x = 0; bar.st = nullptr;
    const bool one_launch = (args.ph_hi - args.ph_lo) > 1;
    if (one_launch) bar = xcd_barrier_post((unsigned*)(args.ws + WS_CTL) + CW_BAR, MISC + 8);
    const int lo = args.ph_lo, hi = args.ph_hi;
#define IN(k) (lo <= (k) && (k) < hi)
#define SEAM(k) do { if (IN(k) && IN((k) + 1)) xcd_barrier(bar); } while (0)
    unsigned char* ws = args.ws;

#ifndef PROBE_MASK
#define PROBE_MASK 0
#endif
#define REP(k) _Pragma("unroll") for (int rep_ = 0; rep_ < (((PROBE_MASK >> (k)) & 1) ? 2 : 1); ++rep_)
    if (IN(0)) REP(0) { p0_prologue(F); if (rep_ == 0 && ((PROBE_MASK >> 0) & 1)) xcd_barrier(bar); } SEAM(0);
    if (IN(1)) REP(1) {
        gates_phase(F);
        { AddrP1 g{(const char*)(ws + WS_K), (const char*)(ws + WS_WIN), 1024, 1024, 1024, 4, 0, 8};
          pg8::StaticOrder S; S.init(MTOK, 2048, F.G, F.bid, 4);
          EpiBf16<DstP1> E{DstP1{ws, 4, 0, 8}, 1.f};
          pg8::gemm_phase(F.lds, g, S, E); }
        { AddrP1 g{(const char*)F.out, (const char*)(ws + WS_WIN8), 512, 512, 512, 8, 4, 8};
          pg8::StaticOrder S; S.init(MTOK, 4096, F.G, F.bid, 4);
          EpiBf16<DstP1, true> E{DstP1{ws, 8, 4, 8}, 1.f / 1024.f};
          pg8::gemm_phase<EpiBf16<DstP1, true>, AddrP1, 1>(F.lds, g, S, E); }
    } SEAM(1);
    if (IN(2)) REP(2) { lru_phase<false>(F); } SEAM(2);
    if (IN(3)) REP(3) { lru_phase<true>(F); } SEAM(3);
    if (IN(4)) REP(4) { mconv_phase(F); } SEAM(4);
    if (IN(5)) REP(5) {
        const char* xc = (const char*)F.out + (size_t)MTOK * DM * 2;
        AddrQKV g{xc, (long)((const char*)(ws + WS_XM) - xc), (const char*)(ws + WS_WQKV), 1024, 256, 256};
        pg8::StaticOrder S; S.init(MTOK, 12 * 256, F.G, F.bid);
        EpiBf16<DstQKV> E{DstQKV{(char*)(ws + WS_LG), (long)WS_K - (long)WS_LG, (long)WS_XL - (long)WS_LG}, 1.f};
        pg8::gemm_phase(F.lds, g, S, E);
    } SEAM(5);
    if (IN(6)) REP(6) { mscan_phase(F); } SEAM(6);
    if (IN(7)) { ym_phase(F); } SEAM(7);
    if (IN(8)) {
        pg8::StaticOrder S; S.init(MTOK, 1024, F.G, F.bid);
        { AddrPlain g{(const char*)(ws + WS_OP), (const char*)(ws + WS_WB2), 1024, 1024, 1024};
          EpiMerge<false> E{(bf16*)(ws + WS_XM), (const unsigned char*)(ws + WS_MG), 0}; pg8::gemm_phase(F.lds, g, S, E); }
        { AddrPlain g{(const char*)F.out, (const char*)(ws + WS_WB2) + (size_t)1024 * 1024 * 2, 1024, 1024, 1024};
          EpiMerge<true> E{(bf16*)(ws + WS_XM), (const unsigned char*)(ws + WS_MG), 1024}; pg8::gemm_phase(F.lds, g, S, E); }
    } SEAM(8);
    if (IN(9)) {
        AddrPlain g{(const char*)(ws + WS_XM), (const char*)(ws + WS_WOUT2), 1024, 2048, 1024};
        pg8::StaticOrder S; S.init(MTOK, 1024, F.G, F.bid);
        EpiResid E{F.in[0], F.out, (bf16*)(ws + WS_XL), (float*)(ws + WS_SS)};
        pg8::gemm_phase(F.lds, g, S, E);
    } SEAM(9);
    if (IN(10)) REP(10) {
        AddrPlain g{(const char*)(ws + WS_XL), (const char*)(ws + WS_WPQ), 1024, 1024, 1024};
        pg8::StaticOrder S; S.init(MTOK, 2048, F.G, F.bid, 4);
        EpiPQ E{(bf16*)(ws + WS_MG), (const float*)(ws + WS_SS)};
        pg8::gemm_phase(F.lds, g, S, E);
    } SEAM(10);
    if (IN(11)) REP(11) { select_phase(F); }
    if (IN(11) && IN(12)) { asm volatile("s_waitcnt vmcnt(0)" ::: "memory"); __syncthreads(); }
    if (IN(12)) { if ((PROBE_MASK >> 12) & 1) { apply_phase(F, (float*)(ws + WS_MG)); xcd_barrier(bar); } apply_phase(F, F.out); }
#undef REP
#undef IN
#undef SEAM
}

extern "C" void kernel_launch(void* const* d_in, const int* in_sizes, int n_in, void* d_out, int out_size, void* d_ws, size_t ws_size, hipStream_t stream) {
    static int grid = 0;
    if (grid == 0) {
        if (n_in != 26 || in_sizes[0] != MTOK * DM || out_size != MTOK * DM || ws_size < WS_END) { fprintf(stderr, "kernel_launch: unexpected shapes / workspace (%zu < %zu)\n", ws_size, (size_t)WS_END); grid = -1; return; }
        int dev = 0, cus = 0, per_cu = 0;
        if (hipGetDevice(&dev) != hipSuccess || hipDeviceGetAttribute(&cus, hipDeviceAttributeMultiprocessorCount, dev) != hipSuccess) { grid = -1; return; }
        if (hipFuncSetAttribute((const void*)mega_fwd, hipFuncAttributeMaxDynamicSharedMemorySize, LDS_BYTES) != hipSuccess) { fprintf(stderr, "kernel_launch: hipFuncSetAttribute failed\n"); grid = -1; return; }
        if (hipOccupancyMaxActiveBlocksPerMultiprocessor(&per_cu, (const void*)mega_fwd, NTHR, LDS_BYTES) != hipSuccess || per_cu < 1) { fprintf(stderr, "kernel_launch: occupancy query says %d blocks/CU\n", per_cu); (void)hipGetLastError(); grid = -1; return; }
        grid = cus;
    }
    if (grid < 0) return;
    (void)hipMemsetAsync((char*)d_ws + WS_CTL + (size_t)CW_BAR * 4, 0, (size_t)XCD_BAR_WORDS * 4, stream);
    Args a{};
    for (int i = 0; i < 26; ++i) a.in[i] = (const float*)d_in[i];
    a.out = (float*)d_out; a.ws = (unsigned char*)d_ws;
#if MK_N_LAUNCHES == 1
    a.ph_lo = 0; a.ph_hi = N_PHASES;
    void* kargs[] = {&a};
    hipError_t e = hipLaunchCooperativeKernel((const void*)mega_fwd, dim3(grid), dim3(NTHR), kargs, LDS_BYTES, stream);
    if (e != hipSuccess) fprintf(stderr, "kernel_launch: cooperative launch failed: %s (grid %d)\n", hipGetErrorString(e), grid);
#else
    for (int p = 0; p < N_PHASES; ++p) { a.ph_lo = p; a.ph_hi = p + 1; hipLaunchKernelGGL(mega_fwd, dim3(grid), dim3(NTHR), LDS_BYTES, stream, a); }
#endif
}
```

```cpp
#include <hip/hip_runtime.h>
#include <cstdio>
#include <cstdint>
#include <math.h>

#ifndef MK_N_LAUNCHES
#define MK_N_LAUNCHES 1
#endif

constexpr int BATCH = 8, SEQ = 4096, DM = 1024, MTOK = BATCH * SEQ;
constexpr int DIN = 6160;
constexpr int NEXP = 16384;
constexpr float EPS = 1e-6f;

constexpr size_t MiB = 1u << 20;
constexpr size_t WS_CTL = 0, CTL_ZERO_BYTES = 1 * MiB;
constexpr size_t WS_WIN = 1 * MiB;
constexpr size_t WS_WQKV = 13 * MiB;
constexpr size_t WS_KEYS = 14 * MiB + 512 * 1024;
constexpr size_t WS_WLRU = 15 * MiB;
constexpr size_t WS_WB2 = 16 * MiB;
constexpr size_t WS_WOUT2 = 20 * MiB;
constexpr size_t WS_WPQ = 24 * MiB;
constexpr size_t WS_GATE = 28 * MiB;
constexpr size_t WS_WGT = 30 * MiB;
constexpr size_t WS_XM = 32 * MiB;
constexpr size_t WS_OP = 96 * MiB;
constexpr size_t WS_XL = 160 * MiB;
constexpr size_t WS_LG = 224 * MiB;
constexpr size_t WS_MG = 288 * MiB;
constexpr size_t WS_K = 416 * MiB;
constexpr size_t WS_AGG = 480 * MiB;
constexpr size_t WS_SS = 488 * MiB;
constexpr size_t WS_WIN8 = 489 * MiB;
constexpr size_t WS_END = 495 * MiB;

constexpr int CW_BAR = 4096;

constexpr int RING_BYTES = 131072;
constexpr int LDS_BYTES = 147456;
constexpr int LDSCTL_OFF = LDS_BYTES - 512, MISC_OFF = LDSCTL_OFF + 320;
constexpr int NWAVES = 8, NTHR = 512;

#define GAS __attribute__((address_space(1)))
#define LAS __attribute__((address_space(3)))
typedef unsigned short bf16;
typedef unsigned v4u __attribute__((ext_vector_type(4)));
typedef unsigned v2u __attribute__((ext_vector_type(2)));
typedef float f32x4 __attribute__((ext_vector_type(4)));
typedef float f32x2 __attribute__((ext_vector_type(2)));
typedef short bf16x8 __attribute__((ext_vector_type(8)));
typedef GAS unsigned gu32;
#define RLX_AGENT __ATOMIC_RELAXED, __HIP_MEMORY_SCOPE_AGENT
#define LDS_WAIT() asm volatile("s_waitcnt lgkmcnt(0)" ::: "memory")
#define VM_WAIT() asm volatile("s_waitcnt vmcnt(0)" ::: "memory")

__device__ __forceinline__ unsigned f2bf(float f) { unsigned u = __builtin_bit_cast(unsigned, f); return (u + 0x7fffu + ((u >> 16) & 1u)) >> 16; }
__device__ __forceinline__ unsigned pk2(float lo, float hi) { return f2bf(lo) | (f2bf(hi) << 16); }
__device__ __forceinline__ float bf2f(unsigned short h) { return __builtin_bit_cast(float, (unsigned)h << 16); }
__device__ __forceinline__ float bflo(unsigned w) { return __builtin_bit_cast(float, w << 16); }
__device__ __forceinline__ float bfhi(unsigned w) { return __builtin_bit_cast(float, w & 0xffff0000u); }
__device__ __forceinline__ float wave_sum(float v) {
#pragma unroll
  for (int o = 1; o < 64; o <<= 1) v += __shfl_xor(v, o);
  return v;
}
__device__ __forceinline__ float sigmoidf_(float x) { return __builtin_amdgcn_rcpf(1.f + __builtin_amdgcn_exp2f(x * -1.44269504089f)); }
__device__ __forceinline__ float gelu_erf(float x) { return 0.5f * x * (1.f + erff(x * 0.70710678118654752f)); }
__device__ __forceinline__ float gelu_fast(float v) {
    const float av = fabsf(v), t = __builtin_amdgcn_rcpf(av * 0.2316418882f + 1.0f);
    float q = t * 0.5307027145f + (-0.7265760135f); q = q * t + 0.7107068705f; q = q * t + (-0.142248368f); q = q * t + 0.127414796f; q = q * t;
    const float e = __builtin_amdgcn_exp2f((v * v) * (-0.72134752044f));
    const float m = v * (q * e);
    return v < 0.f ? m : v - m;
}
__device__ __forceinline__ float softplusf_(float x) { return fmaxf(x, 0.f) + log1pf(expf(-fabsf(x))); }

namespace pg8 {
#define PG8_LAS __attribute__((address_space(3)))
typedef unsigned short bf16_t;
typedef unsigned u32x4 __attribute__((ext_vector_type(4)));
typedef int i32x4_t __attribute__((ext_vector_type(4)));
constexpr int BM = 256, BK = 64, HALF = 128, HTB = HALF * BK * 2, STAGE_BYTES = 8 * HTB, NXCD = 8;

__host__ __device__ __forceinline__ int lds_byte(int r, int c) { const int st = (r >> 4) * 2 + (c >> 5), rr = r & 15, cc = c & 31, ob = rr * 64 + cc * 2; return st * 1024 + (ob ^ (((ob >> 9) & 1) << 5)); }
__host__ __device__ __forceinline__ void stage_rc(int b, int& R, int& C) { const int st = b / 1024, sb = b % 1024, swz = sb ^ (((sb >> 9) & 1) << 5); R = (st >> 1) * 16 + swz / 64; C = (st & 1) * 32 + (swz % 64) / 2; }
__host__ __device__ __forceinline__ int perm32(int rho) { const int n = rho >> 4, i = rho & 15; return 8 * (i >> 2) + 4 * n + (i & 3); }

struct Unit { int pm, pn; };
struct StaticOrder {
    int nM, nN, nwg, G, c, WGM;
    __host__ __device__ void init(int M, int N, int G_, int c_, int wgm = 8) { nM = M / BM; nN = N / BM; nwg = nM * nN; G = G_; c = c_; WGM = wgm; }
    __host__ __device__ bool next(int i, Unit& u) const {
        const long L = (long)i * G + c; if (L >= nwg) return false;
        int wgid = (int)L; { const int q = nwg / NXCD, r = nwg % NXCD, xcd = wgid % NXCD, off = wgid / NXCD; wgid = (xcd < r ? xcd * (q + 1) : r * (q + 1) + (xcd - r) * q) + off; }
        const int nig = WGM * nN, gid = wgid / nig, fm = gid * WGM, gsz = (nM - fm) < WGM ? (nM - fm) : WGM;
        u.pm = fm + ((wgid % nig) % gsz); u.pn = (wgid % nig) / gsz; return true;
    }
};

__device__ __forceinline__ unsigned cvt_pk_bf16(float lo, float hi) { unsigned r; asm volatile("v_cvt_pk_bf16_f32 %0, %1, %2" : "=v"(r) : "v"(lo), "v"(hi)); return r; }

template <class Epi, class Addr, int F8SC = 0>
__device__ __forceinline__ void gemm_phase(PG8_LAS unsigned char* lds, const Addr g, const StaticOrder& S, const Epi& E) {
    const int tid = threadIdx.x, wid = __builtin_amdgcn_readfirstlane(tid >> 6), lane = tid & 63, wr = wid >> 2, wc = wid & 3, fr = lane & 15, fq = lane >> 4;
    const int K = g.K, nt = K / BK;
    unsigned voffA[2], voffB[2];
#pragma unroll
    for (int i = 0; i < 2; ++i) { int R, C; stage_rc(tid * 16 + i * 8192, R, C); const int Rb = Epi::PERM ? ((R & ~31) + perm32(R & 31)) : R;
        voffA[i] = (unsigned)(R * g.lda + C) * 2u; voffB[i] = (unsigned)(Rb * g.ldb + C) * 2u; }
    const size_t kstep = (size_t)(BK * 2);
    const size_t hsA = (size_t)HALF * g.lda * 2, hsB = (size_t)HALF * g.ldb * 2;
    const unsigned ldsw = (unsigned)wid * 1024u;
    const int aoff = lds_byte(wr * 64 + fr, fq * 8), boff = lds_byte(wc * 32 + fr, fq * 8);
#define PG8_SA(b, h) (((b) * 2 + (h)) * HTB)
#define PG8_SB(b, h) ((4 + (b) * 2 + (h)) * HTB)
#define PG8_STAGE(bufoff, gbase, voff) do { _Pragma("unroll") for (int _i = 0; _i < 2; ++_i) \
        __builtin_amdgcn_global_load_lds((const unsigned*)((const char*)(gbase) + (voff)[_i]), (PG8_LAS unsigned*)(lds + (bufoff) + ldsw + _i * 8192), 16, 0, 0); } while (0)
#define PG8_LDA(dst, b, h) do { _Pragma("unroll") for (int m = 0; m < 4; ++m) _Pragma("unroll") for (int k = 0; k < 2; ++k) dst[m][k] = *(const PG8_LAS bf16x8*)(lds + PG8_SA(b, h) + aoff + m * 2048 + k * 1024); } while (0)
#define PG8_LDB(dst, b, h) do { _Pragma("unroll") for (int n = 0; n < 2; ++n) _Pragma("unroll") for (int k = 0; k < 2; ++k) dst[n][k] = *(const PG8_LAS bf16x8*)(lds + PG8_SB(b, h) + boff + n * 2048 + k * 1024); } while (0)
#define PG8_CAT(x0, x1) __builtin_shufflevector(__builtin_bit_cast(i32x4_t, x0), __builtin_bit_cast(i32x4_t, x1), 0, 1, 2, 3, 4, 5, 6, 7)
#define PG8_MMA(ai, bj, At, Bt) do { __builtin_amdgcn_s_setprio(1); \
        if constexpr (F8SC != 0) { _Pragma("unroll") for (int m = 0; m < 4; ++m) _Pragma("unroll") for (int n = 0; n < 2; ++n) \
            asm volatile("v_mfma_f32_16x16x128_f8f6f4 %0, %1, %2, %0" : "+v"(acc[ai][bj][m][n]) : "v"(PG8_CAT(Bt[n][0], Bt[n][1])), "v"(PG8_CAT(At[m][0], At[m][1]))); } \
        else { _Pragma("unroll") for (int m = 0; m < 4; ++m) _Pragma("unroll") for (int n = 0; n < 2; ++n) _Pragma("unroll") for (int k = 0; k < 2; ++k) \
            acc[ai][bj][m][n] = __builtin_amdgcn_mfma_f32_16x16x32_bf16(Bt[n][k], At[m][k], acc[ai][bj][m][n], 0, 0, 0); } \
        __builtin_amdgcn_s_setprio(0); } while (0)
#define PG8_WAIT_V(n) asm volatile("s_waitcnt vmcnt(" #n ")" ::: "memory")
#define PG8_WAIT_L(n) asm volatile("s_waitcnt lgkmcnt(" #n ")" ::: "memory")
#define PG8_BAR __builtin_amdgcn_s_barrier()
#define PG8_SCHED __builtin_amdgcn_sched_barrier(0)
    Unit cur, nxt; int ui = 0;
    if (!S.next(0, cur)) return;
    f32x4 acc[2][2][4][2];
#pragma unroll
    for (int a = 0; a < 2; ++a)
#pragma unroll
        for (int b = 0; b < 2; ++b)
#pragma unroll
            for (int m = 0; m < 4; ++m)
#pragma unroll
                for (int n = 0; n < 2; ++n) acc[a][b][m][n] = (f32x4){0.f, 0.f, 0.f, 0.f};
    bf16x8 At[4][2], B0[2][2], B1[2][2];
    const char* cA = g.a(cur); const char* cB = g.b(cur);
    PG8_STAGE(PG8_SB(0, 0), cB, voffB); PG8_STAGE(PG8_SB(0, 1), cB + hsB, voffB); PG8_STAGE(PG8_SA(0, 0), cA, voffA); PG8_STAGE(PG8_SA(0, 1), cA + hsA, voffA);
    if (wr == 1) PG8_BAR;
    PG8_WAIT_V(2); PG8_BAR;
    PG8_STAGE(PG8_SB(1, 0), cB + kstep, voffB); PG8_STAGE(PG8_SA(1, 0), cA + kstep, voffA); PG8_STAGE(PG8_SB(1, 1), cB + hsB + kstep, voffB);
    PG8_WAIT_V(6); PG8_BAR;
    for (;;) {
        const bool has_next = S.next(ui + 1, nxt);
        const char* nA = has_next ? g.a(nxt) : cA; const char* nB = has_next ? g.b(nxt) : cB;
#pragma unroll 1
        for (int t = 0; t < nt; t += 2) {
            const bool last = (t == nt - 2);
            const char* a1 = cA + (size_t)(t + 1) * kstep;
            const char* a2 = last ? nA : cA + (size_t)(t + 2) * kstep; const char* b2 = last ? nB : cB + (size_t)(t + 2) * kstep;
            const char* a3 = a2 + kstep; const char* b3 = b2 + kstep;
            PG8_LDB(B0, 0, 0); PG8_LDB(B1, 0, 1); PG8_SCHED; PG8_LDA(At, 0, 0); PG8_STAGE(PG8_SA(1, 1), a1 + hsA, voffA);
            PG8_WAIT_V(8); PG8_WAIT_L(0); PG8_BAR; PG8_MMA(0, 0, At, B0); PG8_MMA(0, 1, At, B1); PG8_BAR; PG8_SCHED;
            PG8_LDA(At, 0, 1); PG8_STAGE(PG8_SB(0, 0), b2, voffB); PG8_STAGE(PG8_SB(0, 1), b2 + hsB, voffB); PG8_STAGE(PG8_SA(0, 0), a2, voffA);
            PG8_WAIT_V(8); PG8_WAIT_L(0); PG8_BAR; PG8_MMA(1, 0, At, B0); PG8_MMA(1, 1, At, B1); PG8_BAR; PG8_SCHED;
            PG8_LDB(B0, 1, 0); PG8_LDB(B1, 1, 1); PG8_SCHED; PG8_LDA(At, 1, 0); PG8_STAGE(PG8_SA(0, 1), a2 + hsA, voffA);
            PG8_WAIT_V(8); PG8_WAIT_L(0); PG8_BAR; PG8_MMA(0, 0, At, B0); PG8_MMA(0, 1, At, B1); PG8_BAR; PG8_SCHED;
            PG8_LDA(At, 1, 1); PG8_STAGE(PG8_SB(1, 0), b3, voffB); PG8_STAGE(PG8_SB(1, 1), b3 + hsB, voffB); PG8_STAGE(PG8_SA(1, 0), a3, voffA);
            PG8_WAIT_V(8); PG8_WAIT_L(0); PG8_BAR; PG8_MMA(1, 0, At, B0); PG8_MMA(1, 1, At, B1); PG8_BAR; PG8_SCHED;
        }
        if constexpr (F8SC != 0) asm volatile("s_nop 15\n\ts_nop 15" ::: "memory");
        if (wr == 0) PG8_BAR;
        E(acc, cur, wr, wc, fr, fq);
        if (!has_next) break;
#pragma unroll
        for (int a = 0; a < 2; ++a)
#pragma unroll
            for (int b = 0; b < 2; ++b)
#pragma unroll
                for (int m = 0; m < 4; ++m)
#pragma unroll
                    for (int n = 0; n < 2; ++n) acc[a][b][m][n] = (f32x4){0.f, 0.f, 0.f, 0.f};
        cur = nxt; cA = nA; cB = nB; ++ui;
        if (wr == 1) PG8_BAR;
    }
    PG8_WAIT_V(0);
    PG8_BAR;
#undef PG8_SA
#undef PG8_SB
#undef PG8_STAGE
#undef PG8_LDA
#undef PG8_LDB
#undef PG8_MMA
#undef PG8_CAT
#undef PG8_WAIT_V
#undef PG8_WAIT_L
#undef PG8_BAR
#undef PG8_SCHED
}
}

#define XB_TMO      128
#define XB_XCNT(j)  (256  + 64 * (j))
#define XB_XSUB(j)  (1280 + 64 * (j))
#define XB_XGEN(j)  (2304 + 64 * (j))
#define XB_TOP      3328
#define XB_TOPGEN   3392
#define XCD_BAR_WORDS 3456
#define XB_SPIN_CAP (1u << 18)
__device__ __forceinline__ unsigned xb_ld(unsigned* p)              { return __hip_atomic_load(p, __ATOMIC_RELAXED, __HIP_MEMORY_SCOPE_AGENT); }
__device__ __forceinline__ unsigned xb_add(unsigned* p, unsigned v) { return __hip_atomic_fetch_add(p, v, __ATOMIC_RELAXED, __HIP_MEMORY_SCOPE_AGENT); }
__device__ __forceinline__ unsigned xb_xcc_id() { return (unsigned)__builtin_amdgcn_s_getreg((3 << 11) | 20) & 0xFu; }
#define XB_SPIN(cond, bar) do { unsigned _sp = 0; while (cond) { __builtin_amdgcn_s_sleep(1); \
    if ((++_sp & 255u) == 0u) { if (xb_ld(&(bar)[XB_TMO])) break; if (_sp > XB_SPIN_CAP) { atomicAdd(&(bar)[XB_TMO], 1u); break; } } } } while (0)
struct XcdBarrier { unsigned* bar; unsigned x; volatile LAS unsigned* st; };
__device__ __forceinline__ XcdBarrier xcd_barrier_post(unsigned* bar, volatile LAS unsigned* st) {
    XcdBarrier b; b.bar = bar; b.x = xb_xcc_id(); b.st = st;
    if (threadIdx.x == 0) (void)xb_add(&bar[XB_XCNT(b.x)], 1u);
    return b;
}
__device__ __forceinline__ void xcd_barrier_complete(unsigned* bar, unsigned x, unsigned& nloc, unsigned& nx) {
    const unsigned G = gridDim.x * gridDim.y * gridDim.z;
    unsigned sum, cnt, mine, sp = 0u;
    for (;;) {
        sum = 0u; cnt = 0u; mine = 0u;
#pragma unroll
        for (unsigned j = 0; j < 16; ++j) { const unsigned c = xb_ld(&bar[XB_XCNT(j)]); sum += c; cnt += (c > 0u) ? 1u : 0u; mine = (j == x) ? c : mine; }
        if (sum == G) break;
        __builtin_amdgcn_s_sleep(1);
        if ((++sp & 255u) == 0u) { if (xb_ld(&bar[XB_TMO])) break; if (sp > XB_SPIN_CAP) { atomicAdd(&bar[XB_TMO], 1u); break; } }
    }
    nloc = mine > 0u ? mine : 1u; nx = cnt > 0u ? cnt : 1u;
}
__device__ __forceinline__ void xcd_barrier(const XcdBarrier& b) {
    asm volatile("s_waitcnt vmcnt(0)" ::: "memory");
    __syncthreads();
    if (threadIdx.x == 0) {
        unsigned* bar = b.bar;
        __builtin_amdgcn_s_waitcnt(0);
        unsigned nloc = b.st[0], nx = b.st[1];
        if (nloc == 0u) { xcd_barrier_complete(bar, b.x, nloc, nx); b.st[0] = nloc; b.st[1] = nx; }
        const unsigned old = xb_add(&bar[XB_XSUB(b.x)], 1u);
        const unsigned gen = old / nloc;
        if (old + 1u == (gen + 1u) * nloc) {
            __builtin_amdgcn_fence(__ATOMIC_RELEASE, "agent");
            asm volatile("s_waitcnt vmcnt(0)" ::: "memory");
            const unsigned og = xb_add(&bar[XB_TOP], 1u);
            const unsigned tg = og / nx;
            if (og + 1u == (tg + 1u) * nx) xb_add(&bar[XB_TOPGEN], 1u);
            else XB_SPIN(xb_ld(&bar[XB_TOPGEN]) == tg, bar);
            __builtin_amdgcn_fence(__ATOMIC_ACQUIRE, "agent");
            xb_add(&bar[XB_XGEN(b.x)], 1u);
            asm volatile("s_waitcnt vmcnt(0)" ::: "memory");
        } else {
            XB_SPIN(xb_ld(&bar[XB_XGEN(b.x)]) == gen, bar);
            __builtin_amdgcn_fence(__ATOMIC_ACQUIRE, "agent");
            asm volatile("s_waitcnt vmcnt(0)" ::: "memory");
        }
    }
    __syncthreads();
}

struct Args { const float* in[26]; float* out; unsigned char* ws; int ph_lo, ph_hi; };
struct Frame {
    LAS unsigned char* lds;
    int tid, lane, wave, G, bid;
    const float* const* in; float* out; unsigned char* ws;
};

template <bool F8 = false> __device__ __forceinline__ void tr_item(const float* W, int ldw, bf16* WT, int ldt, float scale, const float* kscale, LAS float* scr, int k0, int lane) {
#pragma unroll 8
    for (int i = 0; i < 32; ++i) { const int kk = 2 * i + (lane >> 5); float v = W[(size_t)(k0 + kk) * ldw + (lane & 31)] * scale; if (kscale) v *= kscale[k0 + kk]; scr[kk * 33 + (lane & 31)] = v; }
    LDS_WAIT(); asm volatile("" ::: "memory");
    const int c = lane & 7;
#pragma unroll
    for (int j = 0; j < 4; ++j) { const int n = (lane >> 3) + 8 * j; const LAS float* s = scr + (8 * c) * 33 + n;
        if constexpr (F8) {
            int p0 = 0, p1 = 0; p0 = __builtin_amdgcn_cvt_pk_fp8_f32(s[0 * 33], s[1 * 33], p0, false); p0 = __builtin_amdgcn_cvt_pk_fp8_f32(s[2 * 33], s[3 * 33], p0, true);
            p1 = __builtin_amdgcn_cvt_pk_fp8_f32(s[4 * 33], s[5 * 33], p1, false); p1 = __builtin_amdgcn_cvt_pk_fp8_f32(s[6 * 33], s[7 * 33], p1, true);
            *(GAS v2u*)((GAS unsigned char*)WT + (size_t)n * ldt + k0 + 8 * c) = (v2u){(unsigned)p0, (unsigned)p1};
        } else {
        v4u o; o.x = pk2(s[0 * 33], s[1 * 33]); o.y = pk2(s[2 * 33], s[3 * 33]); o.z = pk2(s[4 * 33], s[5 * 33]); o.w = pk2(s[6 * 33], s[7 * 33]);
        *(GAS v4u*)(WT + (size_t)n * ldt + k0 + 8 * c) = o; } }
    LDS_WAIT(); asm volatile("" ::: "memory");
}

__device__ __forceinline__ void p0_prologue(Frame& F) {
    LAS float* scr = (LAS float*)(F.lds + F.wave * 16384);
    const int gw = F.bid * NWAVES + F.wave, NGW = F.G * NWAVES;
    unsigned char* ws = F.ws;
    const float* w_in = F.in[2];
    constexpr int I_WIN = 16 * 192, I_QKV = 12 * 32, I_LRU = 32 * 8, I_WB = 2 * 512, I_WO = 2 * 512, I_PQ = 16 * 64;
    constexpr int NITEMS = I_WIN + I_QKV + I_LRU + I_WB + I_WO + I_PQ;
    for (int it = gw; it < NITEMS; it += NGW) {
        int r = it;
        if (r < I_WIN) { const int kb = r / 192, nb = r % 192, n0 = nb * 32, sc = n0 < 2048 ? n0 : n0 + 16;
            if ((n0 >= 1024 && n0 < 3072) || n0 >= 4096) tr_item<true>(w_in + sc, DIN, (bf16*)(ws + WS_WIN8 + (size_t)n0 * 1024), 1024, 1024.f, nullptr, scr, kb * 64, F.lane);
            else tr_item(w_in + sc, DIN, (bf16*)(ws + WS_WIN) + (size_t)n0 * 1024, 1024, 1.f, nullptr, scr, kb * 64, F.lane);
            continue; }
        r -= I_WIN;
        if (r < I_QKV) { const int mat = r / 32, rr = r % 32, kb = rr / 8, nb = rr % 8, g = mat >> 2, h = mat & 3;
            const float* W = F.in[6 + g] + (size_t)h * 65536 + nb * 32;
            tr_item(W, 256, (bf16*)(ws + WS_WQKV) + (size_t)mat * 65536 + (size_t)(nb * 32) * 256, 256, g == 1 ? 0.0625f : 1.f, nullptr, scr, kb * 64, F.lane); continue; }
        r -= I_QKV;
        if (r < I_LRU) { const int mat = r / 8, rr = r % 8, kb = rr / 4, nb = rr % 4, gate = mat & 1, db = mat >> 1;
            const float* W = F.in[gate ? 14 : 12] + (size_t)db * 16384 + nb * 32;
            tr_item(W, 128, (bf16*)(ws + WS_WLRU) + (size_t)mat * 16384 + (size_t)(nb * 32) * 128, 128, 1.f, nullptr, scr, kb * 64, F.lane); continue; }
        r -= I_LRU;
        if (r < I_WB) { const int mat = r / 512, rr = r % 512, kb = rr / 32, nb = rr % 32;
            const float* W = F.in[17 + mat] + nb * 32;
            tr_item(W, 1024, (bf16*)(ws + WS_WB2) + (size_t)(mat * 1024 + nb * 32) * 1024, 1024, 1.f, nullptr, scr, kb * 64, F.lane); continue; }
        r -= I_WB;
        if (r < I_WO) { const int cp = r / 512, rr = r % 512, kb = rr / 32, nb = rr % 32;
            const float* W = F.in[19] + nb * 32;
            tr_item(W, 1024, (bf16*)(ws + WS_WOUT2) + (size_t)(nb * 32) * 2048 + cp * 1024, 2048, 1.f, nullptr, scr, kb * 64, F.lane); continue; }
        r -= I_WO;
        { const int kb = r / 64, nb = r % 64;
            const float* W = F.in[21] + nb * 32;
            tr_item(W, 2048, (bf16*)(ws + WS_WPQ) + (size_t)(nb * 32) * 1024, 1024, 1.f, F.in[20], scr, kb * 64, F.lane); }
    }
    { const int gt = F.bid * NTHR + F.tid, NGT = F.G * NTHR;
      const float4* ks = (const float4*)F.in[22]; v2u* kd = (v2u*)(ws + WS_KEYS);
      for (int i = gt; i < 8 * 2 * 128 * 128 / 4; i += NGT) { const float4 v = ks[i]; v2u o; o.x = pk2(v.x, v.y); o.y = pk2(v.z, v.w); kd[i] = o; }
      float* ss = (float*)(ws + WS_SS);
      for (int i = gt; i < MTOK; i += NGT) ss[i] = 0.f; }
    { const int gt = F.bid * NTHR + F.tid;
      if (gt < 16 * 128) { const int c = gt >> 7, k8 = gt & 127; v4u o; unsigned wv[4];
#pragma unroll
          for (int j = 0; j < 4; ++j) wv[j] = pk2(w_in[(size_t)(k8 * 8 + 2 * j) * DIN + 2048 + c], w_in[(size_t)(k8 * 8 + 2 * j + 1) * DIN + 2048 + c]);
          o.x = wv[0]; o.y = wv[1]; o.z = wv[2]; o.w = wv[3]; *(v4u*)((bf16*)(ws + WS_WGT) + c * 1024 + k8 * 8) = o; } }
    const float* x = F.in[0]; const float* g1 = F.in[1];
    bf16* XN = (bf16*)(ws + WS_K);
    unsigned char* XN8 = (unsigned char*)F.out;
    f32x4 gv[4];
#pragma unroll
    for (int j = 0; j < 4; ++j) gv[j] = ((const f32x4*)g1)[F.lane + 64 * j];
    for (int m = 2 * gw; m < MTOK; m += 2 * NGW) {
        const f32x4* xr0 = (const f32x4*)(x + (size_t)m * DM) + F.lane; const f32x4* xr1 = xr0 + DM / 4;
        f32x4 v0[4], v1[4]; float s0 = 0.f, s1 = 0.f;
#pragma unroll
        for (int j = 0; j < 4; ++j) { v0[j] = xr0[64 * j]; v1[j] = xr1[64 * j]; }
#pragma unroll
        for (int j = 0; j < 4; ++j) { s0 += (v0[j].x * v0[j].x + v0[j].y * v0[j].y) + (v0[j].z * v0[j].z + v0[j].w * v0[j].w); s1 += (v1[j].x * v1[j].x + v1[j].y * v1[j].y) + (v1[j].z * v1[j].z + v1[j].w * v1[j].w); }
        const float r0 = rsqrtf(wave_sum(s0) * (1.f / DM) + EPS), r1 = rsqrtf(wave_sum(s1) * (1.f / DM) + EPS);
        unsigned long long* o0 = (unsigned long long*)(XN + (size_t)m * DM) + F.lane; unsigned long long* o1 = o0 + DM / 4;
        unsigned* q0 = (unsigned*)(XN8 + (size_t)m * DM) + F.lane; unsigned* q1 = q0 + DM / 4;
#pragma unroll
        for (int j = 0; j < 4; ++j) { const f32x4 a = v0[j] * r0 * gv[j], c = v1[j] * r1 * gv[j];
            o0[64 * j] = (unsigned long long)pk2(a.x, a.y) | ((unsigned long long)pk2(a.z, a.w) << 32);
            o1[64 * j] = (unsigned long long)pk2(c.x, c.y) | ((unsigned long long)pk2(c.z, c.w) << 32);
            int pa = 0, pc = 0; pa = __builtin_amdgcn_cvt_pk_fp8_f32(a.x, a.y, pa, false); pa = __builtin_amdgcn_cvt_pk_fp8_f32(a.z, a.w, pa, true);
            pc = __builtin_amdgcn_cvt_pk_fp8_f32(c.x, c.y, pc, false); pc = __builtin_amdgcn_cvt_pk_fp8_f32(c.z, c.w, pc, true);
            q0[64 * j] = (unsigned)pa; q1[64 * j] = (unsigned)pc; }
    }
}
__device__ __forceinline__ void gates_phase(Frame& F) {
    const bf16* XN = (const bf16*)(F.ws + WS_K); const bf16* WGT = (const bf16*)(F.ws + WS_WGT); float* GT = (float*)(F.ws + WS_GATE);
    const int lane = F.lane, fr = lane & 15, fq = lane >> 4;
    const f32x4 bg4 = *(const f32x4*)(F.in[3] + 4 * fq);
    for (int task = F.bid * NWAVES + F.wave; task < MTOK / 16; task += F.G * NWAVES) {
        const size_t m0 = (size_t)task * 16;
        f32x4 acc = (f32x4){0.f, 0.f, 0.f, 0.f};
#pragma unroll 8
        for (int ks = 0; ks < 32; ++ks) {
            const bf16x8 wfr = *(const bf16x8*)(WGT + fr * 1024 + 32 * ks + 8 * fq);
            const bf16x8 xfr = *(const bf16x8*)(XN + (m0 + fr) * DM + 32 * ks + 8 * fq);
            acc = __builtin_amdgcn_mfma_f32_16x16x32_bf16(wfr, xfr, acc, 0, 0, 0);
        }
        *(f32x4*)(GT + (m0 + fr) * 16 + 4 * fq) = acc + bg4;
    }
}

struct AddrPlain {
    const char* A; const char* Bt; int lda, ldb, K;
    __device__ __forceinline__ const char* a(const pg8::Unit& u) const { return A + (size_t)u.pm * 256 * lda * 2; }
    __device__ __forceinline__ const char* b(const pg8::Unit& u) const { return Bt + (size_t)u.pn * 256 * ldb * 2; }
};
struct AddrP1 {
    const char* A; const char* Bt; int lda, ldb, K, thr, lo_add, hi_add;
    __device__ __forceinline__ const char* a(const pg8::Unit& u) const { return A + (size_t)u.pm * 256 * lda * 2; }
    __device__ __forceinline__ const char* b(const pg8::Unit& u) const { return Bt + (size_t)(u.pn + (u.pn < thr ? lo_add : hi_add)) * 256 * ldb * 2; }
};
struct AddrQKV {
    const char* XC; long dXM; const char* W; int lda, ldb, K;
    __device__ __forceinline__ const char* a(const pg8::Unit& u) const { return XC + (u.pn < 8 ? 0l : dXM) + ((size_t)u.pm * 256 * 1024 + (u.pn & 3) * 256) * 2; }
    __device__ __forceinline__ const char* b(const pg8::Unit& u) const { return W + (size_t)u.pn * 65536 * 2; }
};
struct AddrBranch {
    const char* YM; long dYL; const char* W; int lda, ldb, K;
    __device__ __forceinline__ const char* a(const pg8::Unit& u) const { return YM + (u.pn < 4 ? 0l : dYL) + (size_t)u.pm * 256 * 1024 * 2; }
    __device__ __forceinline__ const char* b(const pg8::Unit& u) const { return W + (size_t)u.pn * 256 * 1024 * 2; }
};

struct DstP1 { unsigned char* ws; int thr, lo_add, hi_add;
    __device__ __forceinline__ bf16* get(int j, int& ld, int& col0) const {
        const int pn = j + (j < thr ? lo_add : hi_add); const bool mg = pn >= 16; ld = mg ? -2048 : 1024; col0 = mg ? (pn - 16) * 256 : (pn & 3) * 256;
        return (bf16*)(ws + (mg ? WS_MG : WS_XM + (size_t)(pn >> 2) * 64 * MiB)); } };
struct DstQKV { char* q; long dk, dv;
    __device__ __forceinline__ bf16* get(int pn, int& ld, int& col0) const { ld = 1024; col0 = (pn & 3) * 256; return (bf16*)(q + (pn >= 4 ? (pn >= 8 ? dv : dk) : 0l)); } };
template <class Dst, bool MUL = false> struct EpiBf16 {
    static constexpr bool PERM = true;
    Dst dst; float mul;
    __device__ __forceinline__ void operator()(const f32x4 (&acc)[2][2][4][2], const pg8::Unit& u, int wr, int wc, int fr, int fq) const {
        int ld, colt; bf16* base = dst.get(u.pn, ld, colt);
        const int row0 = u.pm * 256 + wr * 64 + fr, col0 = colt + wc * 32 + 8 * fq;
        if (MUL && ld < 0) {
#pragma unroll
            for (int ai = 0; ai < 2; ++ai)
#pragma unroll
                for (int m = 0; m < 4; ++m) { unsigned char* rowp = (unsigned char*)base + (size_t)(row0 + ai * 128 + m * 16) * (-ld) + col0;
#pragma unroll
                    for (int bj = 0; bj < 2; ++bj) { const f32x4 v0 = acc[ai][bj][m][0] * mul, v1 = acc[ai][bj][m][1] * mul;
                        int p0 = 0, p1 = 0; p0 = __builtin_amdgcn_cvt_pk_fp8_f32(v0[0], v0[1], p0, false); p0 = __builtin_amdgcn_cvt_pk_fp8_f32(v0[2], v0[3], p0, true);
                        p1 = __builtin_amdgcn_cvt_pk_fp8_f32(v1[0], v1[1], p1, false); p1 = __builtin_amdgcn_cvt_pk_fp8_f32(v1[2], v1[3], p1, true);
                        *(v2u*)(rowp + bj * 128) = (v2u){(unsigned)p0, (unsigned)p1}; } }
            return;
        }
#pragma unroll
        for (int ai = 0; ai < 2; ++ai)
#pragma unroll
            for (int m = 0; m < 4; ++m) { bf16* rowp = base + (size_t)(row0 + ai * 128 + m * 16) * ld + col0;
#pragma unroll
                for (int bj = 0; bj < 2; ++bj) { f32x4 v0 = acc[ai][bj][m][0], v1 = acc[ai][bj][m][1]; if (MUL) { v0 = v0 * mul; v1 = v1 * mul; }
                    v4u w; w.x = pg8::cvt_pk_bf16(v0[0], v0[1]); w.y = pg8::cvt_pk_bf16(v0[2], v0[3]); w.z = pg8::cvt_pk_bf16(v1[0], v1[1]); w.w = pg8::cvt_pk_bf16(v1[2], v1[3]);
                    *(v4u*)(rowp + bj * 128) = w; } }
    }
};
template <bool ADD> struct EpiMerge {
    static constexpr bool PERM = true;
    bf16* MRG; const unsigned char* MG; int gcol;
    __device__ __forceinline__ void operator()(const f32x4 (&acc)[2][2][4][2], const pg8::Unit& u, int wr, int wc, int fr, int fq) const {
        const int row0 = u.pm * 256 + wr * 64 + fr, col0 = u.pn * 256 + wc * 32 + 8 * fq;
#pragma unroll
        for (int ai = 0; ai < 2; ++ai)
#pragma unroll
            for (int m = 0; m < 4; ++m) { const size_t row = (size_t)(row0 + ai * 128 + m * 16); bf16* rowp = MRG + row * 1024 + col0; const unsigned char* gp = MG + row * 2048 + gcol + col0;
#pragma unroll
                for (int bj = 0; bj < 2; ++bj) { const f32x4 v0 = acc[ai][bj][m][0], v1 = acc[ai][bj][m][1];
                    const v2u g = *(const v2u*)(gp + bj * 128);
                    const f32x2 g0 = __builtin_amdgcn_cvt_pk_f32_fp8((int)g.x, false), g1 = __builtin_amdgcn_cvt_pk_f32_fp8((int)g.x, true), g2 = __builtin_amdgcn_cvt_pk_f32_fp8((int)g.y, false), g3 = __builtin_amdgcn_cvt_pk_f32_fp8((int)g.y, true);
                    float o[8] = {v0[0] * sigmoidf_(g0[0]), v0[1] * sigmoidf_(g0[1]), v0[2] * sigmoidf_(g1[0]), v0[3] * sigmoidf_(g1[1]),
                                  v1[0] * sigmoidf_(g2[0]), v1[1] * sigmoidf_(g2[1]), v1[2] * sigmoidf_(g3[0]), v1[3] * sigmoidf_(g3[1])};
                    if (ADD) { const v4u t = *(const v4u*)(rowp + bj * 128);
                        o[0] += bflo(t.x); o[1] += bfhi(t.x); o[2] += bflo(t.y); o[3] += bfhi(t.y); o[4] += bflo(t.z); o[5] += bfhi(t.z); o[6] += bflo(t.w); o[7] += bfhi(t.w); }
                    v4u w; w.x = pg8::cvt_pk_bf16(o[0], o[1]); w.y = pg8::cvt_pk_bf16(o[2], o[3]); w.z = pg8::cvt_pk_bf16(o[4], o[5]); w.w = pg8::cvt_pk_bf16(o[6], o[7]);
                    *(v4u*)(rowp + bj * 128) = w; } }
    }
};
struct EpiResid {
    static constexpr bool PERM = false;
    const float* x; float* x1; bf16* x1b; float* ss;
    __device__ __forceinline__ void operator()(const f32x4 (&acc)[2][2][4][2], const pg8::Unit& u, int wr, int wc, int fr, int fq) const {
        const int row0 = u.pm * 256 + wr * 64 + fr, col0 = u.pn * 256 + wc * 32 + 4 * fq;
#pragma unroll
        for (int ai = 0; ai < 2; ++ai)
#pragma unroll
            for (int m = 0; m < 4; ++m) { const int row = row0 + ai * 128 + m * 16; const size_t off = (size_t)row * DM + col0; float s = 0.f;
#pragma unroll
                for (int bj = 0; bj < 2; ++bj)
#pragma unroll
                    for (int n = 0; n < 2; ++n) { const size_t o = off + bj * 128 + n * 16; const f32x4 v = *(const f32x4*)(x + o) + acc[ai][bj][m][n];
                        *(f32x4*)(x1 + o) = v; v2u w; w.x = pg8::cvt_pk_bf16(v[0], v[1]); w.y = pg8::cvt_pk_bf16(v[2], v[3]); *(v2u*)(x1b + o) = w;
                        s += (v[0] * v[0] + v[1] * v[1]) + (v[2] * v[2] + v[3] * v[3]); }
                s += __shfl_xor(s, 16); s += __shfl_xor(s, 32);
                if (fq == 0) atomicAdd(ss + row, s); }
    }
};
struct EpiPQ {
    static constexpr bool PERM = true;
    bf16* pq; const float* ss;
    __device__ __forceinline__ void operator()(const f32x4 (&acc)[2][2][4][2], const pg8::Unit& u, int wr, int wc, int fr, int fq) const {
        const int row0 = u.pm * 256 + wr * 64 + fr, col0 = u.pn * 256 + wc * 32 + 8 * fq;
#pragma unroll
        for (int ai = 0; ai < 2; ++ai)
#pragma unroll
            for (int m = 0; m < 4; ++m) { const int row = row0 + ai * 128 + m * 16; bf16* rowp = pq + (size_t)row * 2048 + col0;
                const float r = rsqrtf(ss[row] * (1.f / DM) + EPS);
#pragma unroll
                for (int bj = 0; bj < 2; ++bj) { const f32x4 v0 = acc[ai][bj][m][0] * r, v1 = acc[ai][bj][m][1] * r;
                    v4u w; w.x = pg8::cvt_pk_bf16(v0[0], v0[1]); w.y = pg8::cvt_pk_bf16(v0[2], v0[3]); w.z = pg8::cvt_pk_bf16(v1[0], v1[1]); w.w = pg8::cvt_pk_bf16(v1[2], v1[3]);
                    *(v4u*)(rowp + bj * 128) = w; } }
    }
};

template <bool PB> __device__ __forceinline__ void lru_phase(Frame& F) {
    const bf16* XL = (const bf16*)(F.ws + WS_XL); const bf16* LG = (const bf16*)(F.ws + WS_LG); bf16* YL = (bf16*)F.out;
    f32x2* AGG = (f32x2*)(F.ws + WS_AGG);
    const bf16* WL = (const bf16*)(F.ws + WS_WLRU);
    const float* cw = F.in[10]; const float* cb = F.in[11];
    unsigned char* LA0 = F.ws + WS_K; unsigned char* LA1 = LA0 + (size_t)MTOK * DM; bf16* LU0 = (bf16*)F.out; bf16* LU1 = LU0 + (size_t)MTOK * DM;
    v2u ra[2]; v4u ru[2];
    constexpr int O_XCB = 0, O_XCF = 17408, O_A = 51200, O_U = 84992, FST = 528;
    LAS unsigned char* L = F.lds;
    const int tid = F.tid, lane = F.lane, w = F.wave, fr = lane & 15, fq = lane >> 4;
    int cur_blk = -1;
    bf16x8 wf[2][2][4];
    f32x4 br4[2], bi4[2], sp4[2];
    v4u rawreg[3];
#define RAW_LOAD(bb, tt0, bk) do { _Pragma("unroll") for (int r_ = 0; r_ < 3; ++r_) { const int e_ = tid + NTHR * r_, row_ = e_ >> 4, c16_ = e_ & 15, t_ = (tt0) - 2 + row_; \
            v4u v_ = {0u, 0u, 0u, 0u}; if (e_ < 68 * 16 && t_ >= 0 && t_ < SEQ) v_ = *(const v4u*)(XL + ((size_t)(bb) * SEQ + t_) * DM + (bk) * 128 + c16_ * 8); rawreg[r_] = v_; } } while (0)
#define PB_LOAD(ii, dd) do { const int idx_ = (ii) * F.G + F.bid; if (idx_ < 4096) { const int j_ = idx_ >> 3; const size_t mr_ = (size_t)(j_ >> 6) * SEQ + (j_ & 63) * 64; \
            _Pragma("unroll") for (int r_ = 0; r_ < 2; ++r_) { const int e_ = tid + NTHR * r_; const size_t o_ = (mr_ + (e_ >> 4)) * DM + (idx_ & 7) * 128 + (e_ & 15) * 8; \
                ra[r_] = *(const v2u*)(((dd) ? LA1 : LA0) + o_); ru[r_] = *(const v4u*)(((dd) ? LU1 : LU0) + o_); } } } while (0)
    constexpr int O_CARRY = 118784, O_CW = 135168, O_SUB = 137728;
    const bool carry_tab = PB && (F.G == 256);
    if (carry_tab) {
        const int ch = tid & 127, bq = tid >> 7, s0 = F.bid >> 3, blk0 = F.bid & 7;
        LAS float* CT = (LAS float*)(L + O_CARRY);
#define FOLD(agp, j0, j1, stp, hv) do { int js_ = (j0); const int n_ = ((j1) - (j0)) * (stp); int k_ = 0; \
            for (; k_ + 8 <= n_; k_ += 8) { f32x2 ah_[8]; _Pragma("unroll") for (int q_ = 0; q_ < 8; ++q_) ah_[q_] = (agp)[(size_t)(js_ + q_ * (stp)) * 2 * DM]; \
                _Pragma("unroll") for (int q_ = 0; q_ < 8; ++q_) hv = ah_[q_][0] * hv + ah_[q_][1]; js_ += 8 * (stp); } \
            for (; k_ < n_; ++k_) { const f32x2 a1_ = (agp)[(size_t)js_ * 2 * DM]; hv = a1_[0] * hv + a1_[1]; js_ += (stp); } } while (0)
        for (int bb = 2 * bq; bb < 2 * bq + 2; ++bb) {
            const f32x2* ag0 = AGG + ((size_t)(bb * 64) * 2 + 0) * DM + blk0 * 128 + ch; const f32x2* ag1 = AGG + ((size_t)(bb * 64) * 2 + 1) * DM + blk0 * 128 + ch;
            float h = 0.f;
            FOLD(ag0, 0, s0, 1, h); CT[((bb * 2 + 0) * 2 + 0) * 128 + ch] = h;
            FOLD(ag0, s0, s0 + 32, 1, h); CT[((bb * 2 + 1) * 2 + 0) * 128 + ch] = h;
            h = 0.f;
            FOLD(ag1, 63, s0 + 32, -1, h); CT[((bb * 2 + 1) * 2 + 1) * 128 + ch] = h;
            FOLD(ag1, s0 + 32, s0, -1, h); CT[((bb * 2 + 0) * 2 + 1) * 128 + ch] = h;
        }
        __syncthreads();
#undef FOLD
    }
    for (int i = 0;; ++i) {
        const int idx = i * F.G + F.bid; if (idx >= 4096) break;
        const int blk = idx & 7, j = idx >> 3, b = j >> 6, seg = j & 63, t0 = seg * 64;
        const size_t mrow0 = (size_t)b * SEQ + t0;
        if (!PB && blk != cur_blk) {
            cur_blk = blk;
#pragma unroll
            for (int d = 0; d < 2; ++d) {
#pragma unroll
                for (int g = 0; g < 2; ++g)
#pragma unroll
                    for (int ks = 0; ks < 4; ++ks)
                        wf[d][g][ks] = *(const bf16x8*)(WL + ((size_t)((d * 8 + blk) * 2 + g) * 128 + 16 * w + fr) * 128 + 32 * ks + 8 * fq);
                const int ch = blk * 128 + 16 * w + 4 * fq;
                br4[d] = *(const f32x4*)(F.in[13] + d * DM + ch); bi4[d] = *(const f32x4*)(F.in[15] + d * DM + ch);
                const f32x4 lm = *(const f32x4*)(F.in[16] + d * DM + ch);
#pragma unroll
                for (int e = 0; e < 4; ++e) sp4[d][e] = -8.f * 1.44269504089f * softplusf_(-lm[e]);
            }
            __syncthreads();
            for (int e = tid; e < 5 * 128; e += NTHR) { const int jt = e >> 7, cc = e & 127; ((LAS float*)(L + O_CW))[e] = (jt < 4) ? cw[jt * DM + blk * 128 + cc] : cb[blk * 128 + cc]; }
        }
        v4u lgreg[2];
        if (PB) {
            if (i == 0) PB_LOAD(0, 0);
#pragma unroll
            for (int r = 0; r < 2; ++r) { const int e = tid + NTHR * r; lgreg[r] = *(const v4u*)(LG + (mrow0 + (e >> 4)) * DM + blk * 128 + (e & 15) * 8); }
        } else {
        if (i == 0) RAW_LOAD(b, t0, blk);
#pragma unroll
        for (int r = 0; r < 3; ++r) { const int e = tid + NTHR * r; if (e < 68 * 16) *(LAS v4u*)(L + O_A + (e >> 4) * 256 + (e & 15) * 16) = rawreg[r]; }
        __syncthreads();
        { const int idx2 = (i + 1) * F.G + F.bid; if (idx2 < 4096) { const int j2 = idx2 >> 3; RAW_LOAD(j2 >> 6, (j2 & 63) * 64, idx2 & 7); } }
        for (int e = tid; e < 64 * 16; e += NTHR) { const int tl = e >> 4, c16 = e & 15;
            float y[8];
            { const f32x4 a = *(const LAS f32x4*)(L + O_CW + 4 * 512 + c16 * 32), bq = *(const LAS f32x4*)(L + O_CW + 4 * 512 + c16 * 32 + 16); y[0] = a[0]; y[1] = a[1]; y[2] = a[2]; y[3] = a[3]; y[4] = bq[0]; y[5] = bq[1]; y[6] = bq[2]; y[7] = bq[3]; }
#pragma unroll
            for (int jt = 0; jt < 4; ++jt) { const v4u r = *(const LAS v4u*)(L + O_A + (tl + jt) * 256 + c16 * 16);
                const f32x4 wa = *(const LAS f32x4*)(L + O_CW + jt * 512 + c16 * 32), wb = *(const LAS f32x4*)(L + O_CW + jt * 512 + c16 * 32 + 16);
                y[0] += wa[0] * bflo(r.x); y[1] += wa[1] * bfhi(r.x); y[2] += wa[2] * bflo(r.y); y[3] += wa[3] * bfhi(r.y);
                y[4] += wb[0] * bflo(r.z); y[5] += wb[1] * bfhi(r.z); y[6] += wb[2] * bflo(r.w); y[7] += wb[3] * bfhi(r.w); }
            *(LAS f32x4*)(L + O_XCF + tl * FST + c16 * 32) = (f32x4){y[0], y[1], y[2], y[3]};
            *(LAS f32x4*)(L + O_XCF + tl * FST + c16 * 32 + 16) = (f32x4){y[4], y[5], y[6], y[7]};
            v4u o; o.x = pk2(y[0], y[1]); o.y = pk2(y[2], y[3]); o.z = pk2(y[4], y[5]); o.w = pk2(y[6], y[7]);
            *(LAS v4u*)(L + O_XCB + tl * 272 + c16 * 16) = o; }
        __syncthreads();
        }
        float carry0 = 0.f, carry1 = 0.f;
        if (carry_tab) { const LAS float* CT = (const LAS float*)(L + O_CARRY); carry0 = CT[((b * 2 + (seg >> 5)) * 2 + 0) * 128 + (tid & 127)]; carry1 = CT[((b * 2 + (seg >> 5)) * 2 + 1) * 128 + (tid & 127)]; }
        else if (PB) {
            const int ch = blk * 128 + (tid & 127);
            float h = 0.f;
            const f32x2* ag0 = AGG + ((size_t)(b * 64) * 2 + 0) * DM + ch; const f32x2* ag1 = AGG + ((size_t)(b * 64) * 2 + 1) * DM + ch;
            int js = 0;
            for (; js + 8 <= seg; js += 8) { f32x2 ah[8];
#pragma unroll
                for (int q = 0; q < 8; ++q) ah[q] = ag0[(size_t)(js + q) * 2 * DM];
#pragma unroll
                for (int q = 0; q < 8; ++q) h = ah[q][0] * h + ah[q][1]; }
            for (; js < seg; ++js) { const f32x2 ah = ag0[(size_t)js * 2 * DM]; h = ah[0] * h + ah[1]; }
            carry0 = h; h = 0.f;
            js = 63;
            for (; js - 8 >= seg; js -= 8) { f32x2 ah[8];
#pragma unroll
                for (int q = 0; q < 8; ++q) ah[q] = ag1[(size_t)(js - q) * 2 * DM];
#pragma unroll
                for (int q = 0; q < 8; ++q) h = ah[q][0] * h + ah[q][1]; }
            for (; js > seg; --js) { const f32x2 ah = ag1[(size_t)js * 2 * DM]; h = ah[0] * h + ah[1]; }
            carry1 = h;
        }
#pragma unroll
        for (int d = 0; d < 2; ++d) {
            const int o_a = (d == 0) ? O_A : O_XCF;
            if (PB) {
#pragma unroll
                for (int r = 0; r < 2; ++r) { const int e = tid + NTHR * r, row = e >> 4, c16 = e & 15;
                    const f32x2 x0 = __builtin_amdgcn_cvt_pk_f32_fp8((int)ra[r].x, false), x1 = __builtin_amdgcn_cvt_pk_f32_fp8((int)ra[r].x, true);
                    const f32x2 x2 = __builtin_amdgcn_cvt_pk_f32_fp8((int)ra[r].y, false), x3 = __builtin_amdgcn_cvt_pk_f32_fp8((int)ra[r].y, true);
                    constexpr float IS = 1.f / 4096.f;
                    *(LAS f32x4*)(L + o_a + row * FST + c16 * 32) = (f32x4){1.f - x0[0] * IS, 1.f - x0[1] * IS, 1.f - x1[0] * IS, 1.f - x1[1] * IS};
                    *(LAS f32x4*)(L + o_a + row * FST + c16 * 32 + 16) = (f32x4){1.f - x2[0] * IS, 1.f - x2[1] * IS, 1.f - x3[0] * IS, 1.f - x3[1] * IS};
                    *(LAS f32x4*)(L + O_U + row * FST + c16 * 32) = (f32x4){bflo(ru[r].x), bfhi(ru[r].x), bflo(ru[r].y), bfhi(ru[r].y)};
                    *(LAS f32x4*)(L + O_U + row * FST + c16 * 32 + 16) = (f32x4){bflo(ru[r].z), bfhi(ru[r].z), bflo(ru[r].w), bfhi(ru[r].w)}; }
                if (d == 0) PB_LOAD(i, 1); else PB_LOAD(i + 1, 0);
            } else {
            f32x4 aR[4], aI[4];
#pragma unroll
            for (int mt = 0; mt < 4; ++mt) { aR[mt] = (f32x4){0.f, 0.f, 0.f, 0.f}; aI[mt] = (f32x4){0.f, 0.f, 0.f, 0.f}; }
#pragma unroll
            for (int ks = 0; ks < 4; ++ks)
#pragma unroll
                for (int mt = 0; mt < 4; ++mt) { const bf16x8 xb = *(const LAS bf16x8*)(L + O_XCB + (16 * mt + fr) * 272 + (32 * ks + 8 * fq) * 2);
                    aR[mt] = __builtin_amdgcn_mfma_f32_16x16x32_bf16(wf[d][0][ks], xb, aR[mt], 0, 0, 0);
                    aI[mt] = __builtin_amdgcn_mfma_f32_16x16x32_bf16(wf[d][1][ks], xb, aI[mt], 0, 0, 0); }
#pragma unroll
            for (int mt = 0; mt < 4; ++mt) { const int tl = 16 * mt + fr, cl = 16 * w + 4 * fq;
                const f32x4 xc = *(const LAS f32x4*)(L + O_XCF + tl * FST + cl * 4);
                f32x4 av, uv;
#pragma unroll
                for (int e = 0; e < 4; ++e) { const float r = sigmoidf_(aR[mt][e] + br4[d][e]), ig = sigmoidf_(aI[mt][e] + bi4[d][e]);
                    const float a_ = __builtin_amdgcn_exp2f(r * sp4[d][e]); av[e] = a_; uv[e] = __builtin_amdgcn_sqrtf(fmaxf(1.f - a_ * a_, 0.f)) * (ig * xc[e]); }
                *(LAS f32x4*)(L + o_a + tl * FST + cl * 4) = av; *(LAS f32x4*)(L + O_U + tl * FST + cl * 4) = uv;
                { const size_t go = (mrow0 + tl) * DM + blk * 128 + cl;
                  int xa = 0; xa = __builtin_amdgcn_cvt_pk_fp8_f32((1.f - av[0]) * 4096.f, (1.f - av[1]) * 4096.f, xa, false); xa = __builtin_amdgcn_cvt_pk_fp8_f32((1.f - av[2]) * 4096.f, (1.f - av[3]) * 4096.f, xa, true);
                  v2u xu; xu.x = pk2(uv[0], uv[1]); xu.y = pk2(uv[2], uv[3]);
                  *(unsigned*)((d ? LA1 : LA0) + go) = (unsigned)xa; *(v2u*)((d ? LU1 : LU0) + go) = xu; } }
            }
            __syncthreads();
            {
                const int c = tid & 127, sub = tid >> 7;
                LAS float* pa = (LAS float*)(L + o_a) + c; const LAS float* pu = (const LAS float*)(L + O_U) + c;
                LAS f32x2* SUBT = (LAS f32x2*)(L + O_SUB);
                float h = 0.f, A = 1.f;
#pragma unroll
                for (int s2 = 0; s2 < 16; ++s2) { const int tl = d ? (16 * sub + 15 - s2) : (16 * sub + s2); const float a = pa[tl * 132], u = pu[tl * 132]; h = a * h + u; A *= a; }
                SUBT[sub * 128 + c] = (f32x2){A, h};
                __syncthreads();
                if (!PB) {
                    if (sub == 0) { float HH = 0.f, AA = 1.f;
#pragma unroll
                        for (int q = 0; q < 4; ++q) { const f32x2 ah = SUBT[(d ? 3 - q : q) * 128 + c]; HH = ah[0] * HH + ah[1]; AA *= ah[0]; }
                        AGG[((size_t)(b * 64 + seg) * 2 + d) * DM + blk * 128 + c] = (f32x2){AA, HH}; }
                } else {
                    float hc = d ? carry1 : carry0;
#pragma unroll
                    for (int q = 0; q < 3; ++q) { const int jq = d ? 3 - q : q; const f32x2 ah = SUBT[jq * 128 + c]; if (d ? (jq > sub) : (jq < sub)) hc = ah[0] * hc + ah[1]; }
                    if (d == 0) {
#pragma unroll
                        for (int s2 = 0; s2 < 16; ++s2) { const int tl = 16 * sub + s2; hc = pa[tl * 132] * hc + pu[tl * 132]; pa[tl * 132] = hc; }
                    } else { LAS float* ph = (LAS float*)(L + O_A) + c;
#pragma unroll
                        for (int s2 = 0; s2 < 16; ++s2) { const int tl = 16 * sub + 15 - s2; hc = pa[tl * 132] * hc + pu[tl * 132]; ph[tl * 132] += hc; } }
                }
            }
            __syncthreads();
        }
        if (PB) {
#pragma unroll
            for (int r = 0; r < 2; ++r) { const int e = tid + NTHR * r, row = e >> 4, c16 = e & 15;
                const v4u g = lgreg[r];
                const f32x4 h0 = *(const LAS f32x4*)(L + O_A + row * FST + c16 * 32), h1 = *(const LAS f32x4*)(L + O_A + row * FST + c16 * 32 + 16);
                v4u o;
                o.x = pk2(h0[0] * gelu_fast(bflo(g.x)), h0[1] * gelu_fast(bfhi(g.x))); o.y = pk2(h0[2] * gelu_fast(bflo(g.y)), h0[3] * gelu_fast(bfhi(g.y)));
                o.z = pk2(h1[0] * gelu_fast(bflo(g.z)), h1[1] * gelu_fast(bfhi(g.z))); o.w = pk2(h1[2] * gelu_fast(bflo(g.w)), h1[3] * gelu_fast(bfhi(g.w)));
                *(v4u*)(YL + (mrow0 + row) * DM + blk * 128 + c16 * 8) = o; }
            __syncthreads();
        }
    }
#undef RAW_LOAD
#undef PB_LOAD
}

__device__ __forceinline__ void mconv_phase(Frame& F) {
    const bf16* XM = (const bf16*)(F.ws + WS_XM); bf16* XC = (bf16*)F.out + (size_t)MTOK * DM;
    const float* cw = F.in[4]; const float* cb = F.in[5];
    const int NT = MTOK / 32 * 128;
    for (int g = F.bid * NTHR + F.tid; g < NT; g += F.G * NTHR) {
        const int chunk = g & 127, run = g >> 7, c0 = chunk * 8, m0 = run * 32, t0 = m0 & (SEQ - 1);
        float w[4][8], bias[8];
#pragma unroll
        for (int j = 0; j < 4; ++j) { const f32x4 a = *(const f32x4*)(cw + j * DM + c0), b = *(const f32x4*)(cw + j * DM + c0 + 4);
            w[j][0] = a[0]; w[j][1] = a[1]; w[j][2] = a[2]; w[j][3] = a[3]; w[j][4] = b[0]; w[j][5] = b[1]; w[j][6] = b[2]; w[j][7] = b[3]; }
        { const f32x4 a = *(const f32x4*)(cb + c0), b = *(const f32x4*)(cb + c0 + 4);
            bias[0] = a[0]; bias[1] = a[1]; bias[2] = a[2]; bias[3] = a[3]; bias[4] = b[0]; bias[5] = b[1]; bias[6] = b[2]; bias[7] = b[3]; }
        v4u win[4];
        const v4u zero = {0u, 0u, 0u, 0u};
        win[0] = zero;
        win[1] = (t0 >= 2) ? *(const v4u*)(XM + (size_t)(m0 - 2) * DM + c0) : zero;
        win[2] = (t0 >= 1) ? *(const v4u*)(XM + (size_t)(m0 - 1) * DM + c0) : zero;
        win[3] = *(const v4u*)(XM + (size_t)m0 * DM + c0);
#pragma unroll 4
        for (int i = 0; i < 32; ++i) {
            win[0] = win[1]; win[1] = win[2]; win[2] = win[3];
            win[3] = (t0 + i + 1 < SEQ) ? *(const v4u*)(XM + (size_t)(m0 + i + 1) * DM + c0) : zero;
            float y[8];
#pragma unroll
            for (int e = 0; e < 8; ++e) y[e] = bias[e];
#pragma unroll
            for (int j = 0; j < 4; ++j) {
                const unsigned p0 = win[j].x, p1 = win[j].y, p2 = win[j].z, p3 = win[j].w;
                y[0] += w[j][0] * bflo(p0); y[1] += w[j][1] * bfhi(p0); y[2] += w[j][2] * bflo(p1); y[3] += w[j][3] * bfhi(p1);
                y[4] += w[j][4] * bflo(p2); y[5] += w[j][5] * bfhi(p2); y[6] += w[j][6] * bflo(p3); y[7] += w[j][7] * bfhi(p3);
            }
#pragma unroll
            for (int e = 0; e < 8; ++e) y[e] = y[e] * sigmoidf_(y[e]);
            v4u o; o.x = pk2(y[0], y[1]); o.y = pk2(y[2], y[3]); o.z = pk2(y[4], y[5]); o.w = pk2(y[6], y[7]);
            *(v4u*)(XC + (size_t)(m0 + i) * DM + c0) = o;
        }
    }
}

typedef short s16x4 __attribute__((ext_vector_type(4)));
__device__ __forceinline__ bf16x8 tr_read_pair(unsigned a0, unsigned a1) {
    s16x4 r0, r1;
    asm volatile("ds_read_b64_tr_b16 %0, %2\n\tds_read_b64_tr_b16 %1, %3\n\ts_waitcnt lgkmcnt(0)" : "=&v"(r0), "=&v"(r1) : "v"(a0), "v"(a1) : "memory");
    return __builtin_shufflevector(r0, r1, 0, 1, 2, 3, 4, 5, 6, 7);
}
__device__ __forceinline__ float dpp_shr(float oldv, float x, int n) {
    const int o = __builtin_bit_cast(int, oldv), v = __builtin_bit_cast(int, x);
    int r;
    if (n == 1) r = __builtin_amdgcn_update_dpp(o, v, 0x111, 0xf, 0xf, false);
    else if (n == 2) r = __builtin_amdgcn_update_dpp(o, v, 0x112, 0xf, 0xf, false);
    else if (n == 4) r = __builtin_amdgcn_update_dpp(o, v, 0x114, 0xf, 0xf, false);
    else r = __builtin_amdgcn_update_dpp(o, v, 0x118, 0xf, 0xf, false);
    return __builtin_bit_cast(float, r);
}
__device__ __forceinline__ float rdlane(float x, int l) { return __builtin_bit_cast(float, __builtin_amdgcn_readlane(__builtin_bit_cast(int, x), l)); }
__device__ __forceinline__ float wave_incl_sum(float x, int lane) {
    x += dpp_shr(0.f, x, 1); x += dpp_shr(0.f, x, 2); x += dpp_shr(0.f, x, 4); x += dpp_shr(0.f, x, 8);
    const float t0 = rdlane(x, 15), t1 = rdlane(x, 31), t2 = rdlane(x, 47);
    return x + (lane >= 16 ? t0 : 0.f) + (lane >= 32 ? t1 : 0.f) + (lane >= 48 ? t2 : 0.f);
}
__device__ __forceinline__ float wave_incl_max(float x, int lane) {
    const float NI = -INFINITY;
    x = fmaxf(x, dpp_shr(NI, x, 1)); x = fmaxf(x, dpp_shr(NI, x, 2)); x = fmaxf(x, dpp_shr(NI, x, 4)); x = fmaxf(x, dpp_shr(NI, x, 8));
    const float t0 = rdlane(x, 15), t1 = rdlane(x, 31), t2 = rdlane(x, 47);
    return fmaxf(fmaxf(x, lane >= 16 ? t0 : NI), fmaxf(lane >= 32 ? t1 : NI, lane >= 48 ? t2 : NI));
}
__device__ __forceinline__ void mscan_phase(Frame& F) {
    const bf16* Q = (const bf16*)(F.ws + WS_LG); const bf16* K = (const bf16*)(F.ws + WS_K); const bf16* V = (const bf16*)(F.ws + WS_XL);
    const float* GT = (const float*)(F.ws + WS_GATE);
    constexpr int KS = 0, CTI = 33792, VT = 67584, VWT = 86016, PB = 104448, TAB = 113664, NT = 116736, NPART = 117760, DENT = 119808;
    constexpr int KST = 528, VST = 144, TABSZ = 1536;
    LAS unsigned char* L = F.lds;
    const int tid = F.tid, lane = F.lane, w = F.wave, fr = lane & 15, fq = lane >> 4, pt = w & 3, wg = w >> 2;
    for (int item = F.bid; item < 256; item += F.G) {
        const int es = item & 3, dir = (item >> 2) & 1, h = (item >> 3) & 3, b = item >> 5;
        bf16* H = dir ? ((bf16*)F.out + (size_t)MTOK * DM) : (bf16*)(F.ws + WS_XM);
        const size_t rowbase = (size_t)b * SEQ;
#define TOF(c, p) (dir ? (SEQ - 1 - 64 * (c) - (p)) : (64 * (c) + (p)))
        for (int e = tid; e < (33792 + 1024) / 4; e += NTHR) { if (e < 33792 / 4) ((LAS unsigned*)(L + CTI))[e] = 0u; else ((LAS unsigned*)(L + NT))[e - 33792 / 4] = 0u; }
        float m_run = 0.f;
        float gi_n = 0.f, gf_n = 0.f;
        if (w == 4) { const size_t m = rowbase + TOF(0, lane); gi_n = GT[m * 16 + dir * 8 + h]; gf_n = GT[m * 16 + dir * 8 + 4 + h]; }
#define G1_TABLES(setp) do { \
            const float logf_ = fminf(gf_n, 0.f) - __logf(1.f + __expf(-fabsf(gf_n))); const float b_ = wave_incl_sum(logf_, lane); const float a_ = gi_n - b_; \
            const float M_ = fmaxf(m_run, wave_incl_max(a_, lane)); const float Mend_ = rdlane(M_, 63), g_ = rdlane(b_, 63); \
            LAS float* T_ = (LAS float*)(setp); T_[lane] = a_; T_[64 + lane] = M_; T_[128 + lane] = __expf(m_run - M_); T_[192 + lane] = __expf(-(b_ + M_)); T_[256 + lane] = __expf(a_ - Mend_); \
            if (lane == 0) { T_[320] = __expf(m_run - Mend_); T_[321] = g_ + Mend_; } \
            m_run = g_ + Mend_; } while (0)
        if (w == 4) G1_TABLES(L + TAB);
        __syncthreads();
        bf16x8 qf[8];
        v4u kreg[4]; v4u vreg;
#define LOAD_KV(c) do { _Pragma("unroll") for (int r_ = 0; r_ < 4; ++r_) { const int i_ = tid + NTHR * r_, s_ = i_ >> 5, c16_ = i_ & 31; \
                kreg[r_] = *(const v4u*)(K + (rowbase + TOF(c, s_)) * DM + h * 256 + c16_ * 8); } \
            { const int s_ = tid & 63, e8_ = tid >> 6; vreg = *(const v4u*)(V + (rowbase + TOF(c, s_)) * DM + h * 256 + es * 64 + e8_ * 8); } } while (0)
#define STORE_KV(setidx) do { _Pragma("unroll") for (int r_ = 0; r_ < 4; ++r_) { const int i_ = tid + NTHR * r_, s_ = i_ >> 5, c16_ = i_ & 31; \
                *(LAS v4u*)(L + KS + s_ * KST + c16_ * 16) = kreg[r_]; } \
            { const int s_ = tid & 63, e8_ = tid >> 6; const float ws_ = ((const LAS float*)(L + TAB + (setidx) * TABSZ))[256 + s_]; \
              LAS bf16* vt_ = (LAS bf16*)(L + VT + (setidx) * 9216); LAS bf16* vw_ = (LAS bf16*)(L + VWT + (setidx) * 9216); \
              const unsigned wv_[4] = {vreg.x, vreg.y, vreg.z, vreg.w}; \
              _Pragma("unroll") for (int j_ = 0; j_ < 4; ++j_) { const float lo_ = bflo(wv_[j_]), hi_ = bfhi(wv_[j_]); const int e_ = e8_ * 8 + 2 * j_; \
                vt_[e_ * 72 + s_] = (bf16)(wv_[j_] & 0xffffu); vt_[(e_ + 1) * 72 + s_] = (bf16)(wv_[j_] >> 16); \
                vw_[e_ * 72 + s_] = (bf16)f2bf(lo_ * ws_); vw_[(e_ + 1) * 72 + s_] = (bf16)f2bf(hi_ * ws_); } } } while (0)
#define LOAD_Q(c) do { const size_t m_ = rowbase + TOF(c, 16 * pt + fr); _Pragma("unroll") for (int ks_ = 0; ks_ < 8; ++ks_) \
                qf[ks_] = *(const bf16x8*)(Q + m_ * DM + h * 256 + 32 * ks_ + 8 * fq); } while (0)
        LOAD_KV(0); LOAD_Q(0);
        STORE_KV(0);
        f32x4 Cacc[8], Nacc[2];
#pragma unroll
        for (int i = 0; i < 8; ++i) Cacc[i] = (f32x4){0.f, 0.f, 0.f, 0.f};
        Nacc[0] = (f32x4){0.f, 0.f, 0.f, 0.f}; Nacc[1] = (f32x4){0.f, 0.f, 0.f, 0.f};
        __syncthreads();
        for (int c = 0; c < 64; ++c) {
            const int cur = c & 1, nxt = cur ^ 1;
            const bool has_next = (c + 1 < 64);
            const LAS float* T = (const LAS float*)(L + TAB + cur * TABSZ);
            if (has_next) { LOAD_KV(c + 1); if (w == 4) { const size_t m = rowbase + TOF(c + 1, lane); gi_n = GT[m * 16 + dir * 8 + h]; gf_n = GT[m * 16 + dir * 8 + 4 + h]; } }
            const int p = 16 * pt + fr;
            const float Mp = T[64 + p], wi_p = T[128 + p];
            float cs = 0.f;
            f32x4 O[2] = {(f32x4){0.f, 0.f, 0.f, 0.f}, (f32x4){0.f, 0.f, 0.f, 0.f}}, sa[2] = {(f32x4){0.f, 0.f, 0.f, 0.f}, (f32x4){0.f, 0.f, 0.f, 0.f}};
            const bool s0on = (2 * wg <= pt), s1on = (2 * wg + 1 <= pt);
#define KF(i, ks) (*(const LAS bf16x8*)(L + KS + (16 * (2 * wg + (i)) + fr) * KST + (32 * (ks) + 8 * fq) * 2))
#define CF(i, ks) (*(const LAS bf16x8*)(L + CTI + (16 * (2 * wg + (i)) + fr) * KST + (32 * (ks) + 8 * fq) * 2))
            if (s1on) {
#pragma unroll
                for (int ks = 0; ks < 8; ++ks) { const bf16x8 k0 = KF(0, ks), k1 = KF(1, ks), c0 = CF(0, ks), c1 = CF(1, ks);
                    sa[0] = __builtin_amdgcn_mfma_f32_16x16x32_bf16(k0, qf[ks], sa[0], 0, 0, 0); sa[1] = __builtin_amdgcn_mfma_f32_16x16x32_bf16(k1, qf[ks], sa[1], 0, 0, 0);
                    O[0] = __builtin_amdgcn_mfma_f32_16x16x32_bf16(c0, qf[ks], O[0], 0, 0, 0); O[1] = __builtin_amdgcn_mfma_f32_16x16x32_bf16(c1, qf[ks], O[1], 0, 0, 0); }
            } else if (s0on) {
#pragma unroll
                for (int ks = 0; ks < 8; ++ks) { const bf16x8 k0 = KF(0, ks), c0 = CF(0, ks), c1 = CF(1, ks);
                    sa[0] = __builtin_amdgcn_mfma_f32_16x16x32_bf16(k0, qf[ks], sa[0], 0, 0, 0);
                    O[0] = __builtin_amdgcn_mfma_f32_16x16x32_bf16(c0, qf[ks], O[0], 0, 0, 0); O[1] = __builtin_amdgcn_mfma_f32_16x16x32_bf16(c1, qf[ks], O[1], 0, 0, 0); }
            } else {
#pragma unroll
                for (int ks = 0; ks < 8; ++ks) { const bf16x8 c0 = CF(0, ks), c1 = CF(1, ks);
                    O[0] = __builtin_amdgcn_mfma_f32_16x16x32_bf16(c0, qf[ks], O[0], 0, 0, 0); O[1] = __builtin_amdgcn_mfma_f32_16x16x32_bf16(c1, qf[ks], O[1], 0, 0, 0); }
            }
#undef KF
#undef CF
#pragma unroll
            for (int i = 0; i < 2; ++i) { const int st = 2 * wg + i;
                v2u pw = {0u, 0u};
                if (i ? s1on : s0on) {
                    const f32x4 a4 = *(const LAS f32x4*)(T + 16 * st + 4 * fq);
                    float pv[4];
#pragma unroll
                    for (int r = 0; r < 4; ++r) { const int s_ = 16 * st + 4 * fq + r; const float wgt = (s_ <= p) ? __expf(a4[r] - Mp) : 0.f; pv[r] = sa[i][r] * wgt; cs += pv[r]; }
                    pw.x = pk2(pv[0], pv[1]); pw.y = pk2(pv[2], pv[3]);
                }
                *(LAS v2u*)(L + PB + p * VST + (16 * st + 4 * fq) * 2) = pw; }
            float di = 0.f;
#define DEN_INTER(ks) do { const f32x4 n0 = *(const LAS f32x4*)(L + NT + (32 * (ks) + 8 * fq) * 4), n1 = *(const LAS f32x4*)(L + NT + (32 * (ks) + 8 * fq) * 4 + 16); \
                const v4u qw = __builtin_bit_cast(v4u, qf[ks]); \
                di += bflo(qw.x) * n0[0] + bfhi(qw.x) * n0[1] + bflo(qw.y) * n0[2] + bfhi(qw.y) * n0[3] + bflo(qw.z) * n1[0] + bfhi(qw.z) * n1[1] + bflo(qw.w) * n1[2] + bfhi(qw.w) * n1[3]; } while (0)
            if (wg == 0) { DEN_INTER(0); DEN_INTER(1); DEN_INTER(2); DEN_INTER(3); }
            else { DEN_INTER(4); DEN_INTER(5); DEN_INTER(6); DEN_INTER(7); }
#undef DEN_INTER
            di += __shfl_xor(di, 16); di += __shfl_xor(di, 32);
            cs += __shfl_xor(cs, 16); cs += __shfl_xor(cs, 32);
            if (fq == 0) ((LAS float*)(L + DENT))[wg * 64 + p] = wi_p * di + cs;
            if (has_next) LOAD_Q(c + 1);
            if (has_next && w == 4) G1_TABLES(L + TAB + nxt * TABSZ);
            __syncthreads();
#pragma unroll
            for (int i = 0; i < 2; ++i) { const int et = 2 * wg + i; O[i] = O[i] * wi_p;
#pragma unroll
                for (int ks = 0; ks < 2; ++ks) { const bf16x8 vf = *(const LAS bf16x8*)(L + VT + cur * 9216 + (16 * et + fr) * VST + (32 * ks + 8 * fq) * 2);
                    const bf16x8 pf = *(const LAS bf16x8*)(L + PB + p * VST + (32 * ks + 8 * fq) * 2);
                    O[i] = __builtin_amdgcn_mfma_f32_16x16x32_bf16(vf, pf, O[i], 0, 0, 0); } }
            { const float den = ((const LAS float*)(L + DENT))[p] + ((const LAS float*)(L + DENT))[64 + p];
              const float inv = 1.f / fmaxf(fabsf(den), T[192 + p]);
              const size_t m = rowbase + TOF(c, p);
#pragma unroll
              for (int i = 0; i < 2; ++i) { const int et = 2 * wg + i; v2u o; o.x = pk2(O[i][0] * inv, O[i][1] * inv); o.y = pk2(O[i][2] * inv, O[i][3] * inv);
                  *(v2u*)(H + m * DM + h * 256 + es * 64 + 16 * et + 4 * fq) = o; } }
            { const float decay = T[320];
              const bf16x8 vw0 = *(const LAS bf16x8*)(L + VWT + cur * 9216 + (16 * pt + fr) * VST + (8 * fq) * 2);
              const bf16x8 vw1 = *(const LAS bf16x8*)(L + VWT + cur * 9216 + (16 * pt + fr) * VST + (32 + 8 * fq) * 2);
              bf16x8 wsf0, wsf1;
              { const f32x4 w0 = *(const LAS f32x4*)(T + 256 + 8 * fq), w1 = *(const LAS f32x4*)(T + 256 + 8 * fq + 4), w2 = *(const LAS f32x4*)(T + 288 + 8 * fq), w3 = *(const LAS f32x4*)(T + 288 + 8 * fq + 4);
                const bool c0 = (fr == 0);
                v4u a, b; a.x = c0 ? pk2(w0[0], w0[1]) : 0u; a.y = c0 ? pk2(w0[2], w0[3]) : 0u; a.z = c0 ? pk2(w1[0], w1[1]) : 0u; a.w = c0 ? pk2(w1[2], w1[3]) : 0u;
                b.x = c0 ? pk2(w2[0], w2[1]) : 0u; b.y = c0 ? pk2(w2[2], w2[3]) : 0u; b.z = c0 ? pk2(w3[0], w3[1]) : 0u; b.w = c0 ? pk2(w3[2], w3[3]) : 0u;
                wsf0 = __builtin_bit_cast(bf16x8, a); wsf1 = __builtin_bit_cast(bf16x8, b); }
              const int l16 = lane & 15, q4 = l16 >> 2, p4 = l16 & 3;
              const unsigned kb = (unsigned)(uintptr_t)(L + KS) + (unsigned)((8 * fq + q4) * KST + 4 * p4 * 2);
#pragma unroll
              for (int dtl = 0; dtl < 8; dtl += 2) { const int dt = 8 * wg + dtl; const unsigned a0 = kb + dt * 32;
                  s16x4 r0, r1, r2, r3, r4, r5, r6, r7;
                  asm volatile("ds_read_b64_tr_b16 %0, %8\n\tds_read_b64_tr_b16 %1, %8 offset:2112\n\tds_read_b64_tr_b16 %2, %8 offset:16896\n\tds_read_b64_tr_b16 %3, %8 offset:19008\n\t"
                               "ds_read_b64_tr_b16 %4, %8 offset:32\n\tds_read_b64_tr_b16 %5, %8 offset:2144\n\tds_read_b64_tr_b16 %6, %8 offset:16928\n\tds_read_b64_tr_b16 %7, %8 offset:19040\n\ts_waitcnt lgkmcnt(0)"
                               : "=&v"(r0), "=&v"(r1), "=&v"(r2), "=&v"(r3), "=&v"(r4), "=&v"(r5), "=&v"(r6), "=&v"(r7) : "v"(a0) : "memory");
                  const bf16x8 k0 = __builtin_shufflevector(r0, r1, 0, 1, 2, 3, 4, 5, 6, 7), k1 = __builtin_shufflevector(r2, r3, 0, 1, 2, 3, 4, 5, 6, 7);
                  const bf16x8 k2 = __builtin_shufflevector(r4, r5, 0, 1, 2, 3, 4, 5, 6, 7), k3 = __builtin_shufflevector(r6, r7, 0, 1, 2, 3, 4, 5, 6, 7);
                  Cacc[dtl] = Cacc[dtl] * decay; Cacc[dtl + 1] = Cacc[dtl + 1] * decay;
                  Cacc[dtl] = __builtin_amdgcn_mfma_f32_16x16x32_bf16(k0, vw0, Cacc[dtl], 0, 0, 0);
                  Cacc[dtl + 1] = __builtin_amdgcn_mfma_f32_16x16x32_bf16(k2, vw0, Cacc[dtl + 1], 0, 0, 0);
                  Cacc[dtl] = __builtin_amdgcn_mfma_f32_16x16x32_bf16(k1, vw1, Cacc[dtl], 0, 0, 0);
                  Cacc[dtl + 1] = __builtin_amdgcn_mfma_f32_16x16x32_bf16(k3, vw1, Cacc[dtl + 1], 0, 0, 0);
                  if (dtl == 2 * pt) {
                      Nacc[0] = Nacc[0] * decay; Nacc[1] = Nacc[1] * decay;
                      Nacc[0] = __builtin_amdgcn_mfma_f32_16x16x32_bf16(k0, wsf0, Nacc[0], 0, 0, 0); Nacc[1] = __builtin_amdgcn_mfma_f32_16x16x32_bf16(k2, wsf0, Nacc[1], 0, 0, 0);
                      Nacc[0] = __builtin_amdgcn_mfma_f32_16x16x32_bf16(k1, wsf1, Nacc[0], 0, 0, 0); Nacc[1] = __builtin_amdgcn_mfma_f32_16x16x32_bf16(k3, wsf1, Nacc[1], 0, 0, 0); } } }
            __syncthreads();
            { const float decay = T[320];
#pragma unroll
              for (int dtl = 0; dtl < 8; ++dtl) { const int dt = 8 * wg + dtl; v2u o; o.x = pk2(Cacc[dtl][0], Cacc[dtl][1]); o.y = pk2(Cacc[dtl][2], Cacc[dtl][3]);
                  *(LAS v2u*)(L + CTI + (16 * pt + fr) * KST + (16 * dt + 4 * fq) * 2) = o; }
              if (fr == 0) { *(LAS f32x4*)(L + NT + (16 * (8 * wg + 2 * pt) + 4 * fq) * 4) = Nacc[0]; *(LAS f32x4*)(L + NT + (16 * (8 * wg + 2 * pt + 1) + 4 * fq) * 4) = Nacc[1]; } }
            if (has_next) STORE_KV(nxt);
            __syncthreads();
        }
#undef TOF
#undef G1_TABLES
#undef LOAD_KV
#undef STORE_KV
#undef LOAD_Q
    }
}

__device__ __forceinline__ void ym_phase(Frame& F) {
    const bf16* HF = (const bf16*)(F.ws + WS_XM); const bf16* HB = (const bf16*)F.out + (size_t)MTOK * DM; bf16* OP = (bf16*)(F.ws + WS_OP);
    const float* ng = F.in[9];
    const int gw = F.bid * NWAVES + F.wave, NGW = F.G * NWAVES;
    for (int m = gw; m < MTOK; m += NGW) {
#pragma unroll
        for (int hd = 0; hd < 4; ++hd) {
            const size_t o = (size_t)m * DM + hd * 256 + F.lane * 4;
            const v2u a = *(const v2u*)(HF + o), b = *(const v2u*)(HB + o), op = *(const v2u*)(OP + o);
            const float v0 = bflo(a.x) + bflo(b.x), v1 = bfhi(a.x) + bfhi(b.x), v2 = bflo(a.y) + bflo(b.y), v3 = bfhi(a.y) + bfhi(b.y);
            const float r = rsqrtf(wave_sum((v0 * v0 + v1 * v1) + (v2 * v2 + v3 * v3)) * (1.f / 256.f) + EPS);
            const f32x4 g = *(const f32x4*)(ng + hd * 256 + F.lane * 4);
            v2u w; w.x = pk2(sigmoidf_(bflo(op.x)) * v0 * r * g[0], sigmoidf_(bfhi(op.x)) * v1 * r * g[1]);
            w.y = pk2(sigmoidf_(bflo(op.y)) * v2 * r * g[2], sigmoidf_(bfhi(op.y)) * v3 * r * g[3]);
            *(v2u*)(OP + o) = w;
        }
    }
    {
        float* usc = (float*)(F.ws + WS_LG + 16 * MiB); float* vsc = usc + NEXP;
        for (int row = gw; row < 2 * NEXP; row += NGW) {
            const bool isv = row >= NEXP; const int r = isv ? row - NEXP : row;
            const f32x4* src = (const f32x4*)(F.in[isv ? 24 : 23] + (size_t)r * DM) + F.lane * 4;
            f32x4 a[4]; float ss = 0.f;
#pragma unroll
            for (int j = 0; j < 4; ++j) { a[j] = src[j]; ss += (a[j][0] * a[j][0] + a[j][1] * a[j][1]) + (a[j][2] * a[j][2] + a[j][3] * a[j][3]); }
            const float rms = sqrtf(wave_sum(ss) * (1.f / DM));
            const float sc = fmaxf(rms * 0.5f, 1e-30f), inv = 1.f / sc;
            unsigned o[2] = {0u, 0u};
#pragma unroll
            for (int j = 0; j < 4; ++j) { const f32x4 q = a[j] * inv;
                if (j & 1) { o[j >> 1] = __builtin_amdgcn_cvt_scalef32_pk_fp4_f32(o[j >> 1], q[0], q[1], 1.0f, 2); o[j >> 1] = __builtin_amdgcn_cvt_scalef32_pk_fp4_f32(o[j >> 1], q[2], q[3], 1.0f, 3); }
                else       { o[j >> 1] = __builtin_amdgcn_cvt_scalef32_pk_fp4_f32(o[j >> 1], q[0], q[1], 1.0f, 0); o[j >> 1] = __builtin_amdgcn_cvt_scalef32_pk_fp4_f32(o[j >> 1], q[2], q[3], 1.0f, 1); } }
            *(v2u*)(F.ws + WS_LG + (isv ? 8 * MiB : 0) + (size_t)r * (DM / 2) + F.lane * 8) = (v2u){o[0], o[1]};
            if (F.lane == 0) (isv ? vsc : usc)[r] = sc;
        }
    }
}

typedef float f32x16 __attribute__((ext_vector_type(16)));
#define TOPK_INSERT(L, xv) do { const float x_ = (xv); \
    L[15] = __builtin_amdgcn_fmed3f(L[14], L[15], x_); L[14] = __builtin_amdgcn_fmed3f(L[13], L[14], x_); L[13] = __builtin_amdgcn_fmed3f(L[12], L[13], x_); L[12] = __builtin_amdgcn_fmed3f(L[11], L[12], x_); \
    L[11] = __builtin_amdgcn_fmed3f(L[10], L[11], x_); L[10] = __builtin_amdgcn_fmed3f(L[9], L[10], x_); L[9] = __builtin_amdgcn_fmed3f(L[8], L[9], x_); L[8] = __builtin_amdgcn_fmed3f(L[7], L[8], x_); \
    L[7] = __builtin_amdgcn_fmed3f(L[6], L[7], x_); L[6] = __builtin_amdgcn_fmed3f(L[5], L[6], x_); L[5] = __builtin_amdgcn_fmed3f(L[4], L[5], x_); L[4] = __builtin_amdgcn_fmed3f(L[3], L[4], x_); \
    L[3] = __builtin_amdgcn_fmed3f(L[2], L[3], x_); L[2] = __builtin_amdgcn_fmed3f(L[1], L[2], x_); L[1] = __builtin_amdgcn_fmed3f(L[0], L[1], x_); L[0] = fmaxf(L[0], x_); } while (0)
#define SEL_CE(L, a, b) do { const float hi_ = fmaxf(L[a], L[b]), lo_ = fminf(L[a], L[b]); L[a] = hi_; L[b] = lo_; } while (0)
#define SORT16_DESC(L) do { SEL_CE(L, 0, 1); SEL_CE(L, 2, 3); SEL_CE(L, 0, 2); SEL_CE(L, 1, 3); SEL_CE(L, 1, 2); SEL_CE(L, 4, 5); SEL_CE(L, 6, 7); SEL_CE(L, 4, 6); SEL_CE(L, 5, 7); SEL_CE(L, 5, 6); SEL_CE(L, 0, 4); SEL_CE(L, 2, 6); SEL_CE(L, 2, 4); SEL_CE(L, 1, 5); SEL_CE(L, 3, 7); SEL_CE(L, 3, 5); SEL_CE(L, 1, 2); SEL_CE(L, 3, 4); SEL_CE(L, 5, 6); SEL_CE(L, 8, 9); SEL_CE(L, 10, 11); SEL_CE(L, 8, 10); SEL_CE(L, 9, 11); SEL_CE(L, 9, 10); SEL_CE(L, 12, 13); SEL_CE(L, 14, 15); SEL_CE(L, 12, 14); SEL_CE(L, 13, 15); SEL_CE(L, 13, 14); SEL_CE(L, 8, 12); SEL_CE(L, 10, 14); SEL_CE(L, 10, 12); SEL_CE(L, 9, 13); SEL_CE(L, 11, 15); SEL_CE(L, 11, 13); SEL_CE(L, 9, 10); SEL_CE(L, 11, 12); SEL_CE(L, 13, 14); SEL_CE(L, 0, 8); SEL_CE(L, 4, 12); SEL_CE(L, 4, 8); SEL_CE(L, 2, 10); SEL_CE(L, 6, 14); SEL_CE(L, 6, 10); SEL_CE(L, 2, 4); SEL_CE(L, 6, 8); SEL_CE(L, 10, 12); SEL_CE(L, 1, 9); SEL_CE(L, 5, 13); SEL_CE(L, 5, 9); SEL_CE(L, 3, 11); SEL_CE(L, 7, 15); SEL_CE(L, 7, 11); SEL_CE(L, 3, 5); SEL_CE(L, 7, 9); SEL_CE(L, 11, 13); SEL_CE(L, 1, 2); SEL_CE(L, 3, 4); SEL_CE(L, 5, 6); SEL_CE(L, 7, 8); SEL_CE(L, 9, 10); SEL_CE(L, 11, 12); SEL_CE(L, 13, 14); } while (0)
#define BMERGE16_DESC(L) do { SEL_CE(L, 0, 8); SEL_CE(L, 1, 9); SEL_CE(L, 2, 10); SEL_CE(L, 3, 11); SEL_CE(L, 4, 12); SEL_CE(L, 5, 13); SEL_CE(L, 6, 14); SEL_CE(L, 7, 15); SEL_CE(L, 0, 4); SEL_CE(L, 1, 5); SEL_CE(L, 2, 6); SEL_CE(L, 3, 7); SEL_CE(L, 8, 12); SEL_CE(L, 9, 13); SEL_CE(L, 10, 14); SEL_CE(L, 11, 15); SEL_CE(L, 0, 2); SEL_CE(L, 1, 3); SEL_CE(L, 4, 6); SEL_CE(L, 5, 7); SEL_CE(L, 8, 10); SEL_CE(L, 9, 11); SEL_CE(L, 12, 14); SEL_CE(L, 13, 15); SEL_CE(L, 0, 1); SEL_CE(L, 2, 3); SEL_CE(L, 4, 5); SEL_CE(L, 6, 7); SEL_CE(L, 8, 9); SEL_CE(L, 10, 11); SEL_CE(L, 12, 13); SEL_CE(L, 14, 15); } while (0)
template <int I> struct CandRow {
    static __device__ __forceinline__ void run(const float (&L0)[16], const float (&L1)[16], float (&R)[16]) {
        constexpr int NJ = 16 / (I + 1);
#pragma unroll
        for (int j = 0; j < NJ; ++j) { const float sm = L0[I] + L1[j];
            const float pk = __builtin_bit_cast(float, (__builtin_bit_cast(unsigned, sm) & 0xffffff00u) | (unsigned)(I * 16 + j)); TOPK_INSERT(R, pk); }
        if constexpr (I < 15) CandRow<I + 1>::run(L0, L1, R);
    }
};
__device__ __forceinline__ unsigned pick4(unsigned d0, unsigned d1, unsigned d2, unsigned d3, int i) {
    const int q = i >> 2; unsigned d = d0; d = (q == 1) ? d1 : d; d = (q == 2) ? d2 : d; d = (q == 3) ? d3 : d; return (d >> (8 * (i & 3))) & 127u;
}
__device__ __forceinline__ void select_phase(Frame& F) {
    const bf16* PQ = (const bf16*)(F.ws + WS_MG); const bf16* KEYS = (const bf16*)(F.ws + WS_KEYS);
    int* IDX = (int*)(F.ws + WS_K); float* GW = (float*)(F.ws + WS_K + 16 * MiB);
    LAS unsigned char* L = F.lds;
    const int tid = F.tid, lane = F.lane, w = F.wave, l31 = lane & 31, hh = lane >> 5;
    const float NEG_INF = -INFINITY;
    for (int grp = F.bid; grp < MTOK / 128; grp += F.G) {
        const int tb = grp * 4 + (w & 3);
        const size_t m = (size_t)tb * 32 + l31;
        for (int hp = 0; hp < 4; ++hp) {
            __syncthreads();
#pragma unroll 4
            for (int r = 0; r < 16; ++r) { const int e = tid + NTHR * r, R = e >> 4, c = e & 15;
                *(LAS v4u*)(L + R * 256 + ((c ^ (R & 15)) * 16)) = *(const v4u*)(KEYS + ((size_t)(hp * 512 + R) * 128 + c * 8)); }
            __syncthreads();
            const int hl = w >> 2, h = 2 * hp + hl;
            float L0[16], L1[16];
#pragma unroll
            for (int p = 0; p < 2; ++p) {
                bf16x8 qf[8];
#pragma unroll
                for (int ks = 0; ks < 8; ++ks) qf[ks] = *(const bf16x8*)(PQ + m * 2048 + h * 256 + p * 128 + 16 * ks + 8 * hh);
                f32x16 acc[4];
#pragma unroll
                for (int kb = 0; kb < 4; ++kb)
#pragma unroll
                    for (int r = 0; r < 16; ++r) acc[kb][r] = 0.f;
#pragma unroll
                for (int ks = 0; ks < 8; ++ks)
#pragma unroll
                    for (int kb = 0; kb < 4; ++kb) { const int R = (hl * 2 + p) * 128 + 32 * kb + l31;
                        const bf16x8 kf = *(const LAS bf16x8*)(L + R * 256 + (((2 * ks + hh) ^ (lane & 15)) * 16));
                        acc[kb] = __builtin_amdgcn_mfma_f32_32x32x16_bf16(kf, qf[ks], acc[kb], 0, 0, 0); }
                float Lc[16];
                const unsigned hh4 = (unsigned)hh << 2;
#pragma unroll
                for (int kb = 0; kb < 4; ++kb) { float Nw[16];
#pragma unroll
                    for (int r = 0; r < 16; ++r) { const unsigned nlo = (unsigned)(32 * kb + (r & 3) + 8 * (r >> 2));
                        const float av_ = acc[kb][r];
                        Nw[r] = __uint_as_float(((__float_as_uint(av_) & 0xffffff80u) | hh4) | nlo); }
                    SORT16_DESC(Nw);
                    if (kb == 0) {
#pragma unroll
                        for (int i = 0; i < 16; ++i) Lc[i] = Nw[i];
                    } else {
#pragma unroll
                        for (int i = 0; i < 16; ++i) Lc[i] = fmaxf(Lc[i], Nw[15 - i]);
                        BMERGE16_DESC(Lc); } }
                { float Lo[16];
#pragma unroll
                  for (int i = 0; i < 16; ++i) Lo[i] = __shfl_xor(Lc[i], 32);
#pragma unroll
                  for (int i = 0; i < 16; ++i) Lc[i] = fmaxf(Lc[i], Lo[15 - i]);
                  BMERGE16_DESC(Lc); }
#pragma unroll
                for (int i = 0; i < 16; ++i) { if (p == 0) L0[i] = Lc[i]; else L1[i] = Lc[i]; }
            }
            float R[16];
#pragma unroll
            for (int j = 0; j < 16; ++j) { const float sm = L0[0] + L1[j]; R[j] = __builtin_bit_cast(float, (__builtin_bit_cast(unsigned, sm) & 0xffffff00u) | (unsigned)j); }
            SORT16_DESC(R);
            CandRow<1>::run(L0, L1, R);
            unsigned a0 = 0, a1 = 0, a2 = 0, a3 = 0, b0 = 0, b1 = 0, b2 = 0, b3 = 0;
#pragma unroll
            for (int i = 0; i < 4; ++i) { a0 |= (__builtin_bit_cast(unsigned, L0[i]) & 127u) << (8 * i); a1 |= (__builtin_bit_cast(unsigned, L0[4 + i]) & 127u) << (8 * i);
                a2 |= (__builtin_bit_cast(unsigned, L0[8 + i]) & 127u) << (8 * i); a3 |= (__builtin_bit_cast(unsigned, L0[12 + i]) & 127u) << (8 * i);
                b0 |= (__builtin_bit_cast(unsigned, L1[i]) & 127u) << (8 * i); b1 |= (__builtin_bit_cast(unsigned, L1[4 + i]) & 127u) << (8 * i);
                b2 |= (__builtin_bit_cast(unsigned, L1[8 + i]) & 127u) << (8 * i); b3 |= (__builtin_bit_cast(unsigned, L1[12 + i]) & 127u) << (8 * i); }
            float ex[16]; float sum = 0.f; int id[16];
#pragma unroll
            for (int r = 0; r < 16; ++r) { ex[r] = __expf(R[r] - R[0]); sum += ex[r];
                const unsigned cid = __builtin_bit_cast(unsigned, R[r]) & 255u;
                id[r] = (int)(pick4(a0, a1, a2, a3, (int)(cid >> 4)) * 128u + pick4(b0, b1, b2, b3, (int)(cid & 15u))); }
            const float inv = 1.f / sum;
            if (hh == 0) {
#pragma unroll
                for (int q = 0; q < 4; ++q) {
                    *(int4*)(IDX + m * 128 + h * 16 + 4 * q) = make_int4(id[4 * q], id[4 * q + 1], id[4 * q + 2], id[4 * q + 3]);
                    *(f32x4*)(GW + m * 128 + h * 16 + 4 * q) = (f32x4){ex[4 * q] * inv, ex[4 * q + 1] * inv, ex[4 * q + 2] * inv, ex[4 * q + 3] * inv}; }
            }
        }
    }
}

template <int B> __device__ __forceinline__ f32x2 fp4b(unsigned w) { return __builtin_amdgcn_cvt_scalef32_pk_f32_fp4(w, 1.0f, B); }
typedef int v8i_t __attribute__((ext_vector_type(8)));
#define AP_SLOT(e) (4 * (((e) >> 1) & 3) + 2 * ((e) >> 3) + ((e) & 1))
__device__ __forceinline__ void apply_phase(Frame& F, float* OUTP) {
    const unsigned char* U8 = F.ws + WS_LG; const unsigned char* V8 = F.ws + WS_LG + 8 * MiB;
    const float* USC = (const float*)(F.ws + WS_LG + 16 * MiB); const float* VSC = USC + NEXP;
    const int* IDX = (const int*)(F.ws + WS_K); const float* GW = (const float*)(F.ws + WS_K + 16 * MiB);
    const float* g2 = F.in[20]; const float* gf = F.in[25];
    const float* X1 = F.out;
    const int lane = F.lane, fr = lane & 15, fq = lane >> 4;
    constexpr int APW = 2 * 16 * 528 + 1024;
    LAS unsigned char* UL = F.lds + F.wave * APW; LAS unsigned char* VL = UL + 16 * 528; LAS unsigned char* H8 = VL + 16 * 528;
    const int pe = 2 * fq + (fr & 1) + 8 * ((fr >> 1) & 1);
    const int bsh = 8 * (fr & 3); const unsigned mlo = fr < 4 ? ~0u : 0u, mhi = (fr >= 4 && fr < 8) ? ~0u : 0u;
#define AP_LOADROWS(SEL, KB) _Pragma("unroll") for (int e = 0; e < 16; ++e) { \
        const size_t ro = (size_t)__builtin_amdgcn_readlane(SEL, ((KB) + e) & 63) * (DM / 2) + lane * 8; uu[e] = *(const v2u*)(U8 + ro); vv[e] = *(const v2u*)(V8 + ro); }
    for (int grp = F.bid; grp < MTOK / 128; grp += F.G) {
        const int mbase = grp * 128 + F.wave;
        int ni0 = IDX[(size_t)mbase * 128 + lane], ni1 = IDX[(size_t)mbase * 128 + 64 + lane];
        float ngw0 = GW[(size_t)mbase * 128 + lane], ngw1 = GW[(size_t)mbase * 128 + 64 + lane];
        f32x4 nxr[4];
#pragma unroll
        for (int q = 0; q < 4; ++q) nxr[q] = *(const f32x4*)(X1 + (size_t)mbase * DM + lane * 16 + q * 4);
        v2u uu[16], vv[16];
        AP_LOADROWS(ni0, 0)
        int i0 = 0, i1 = 0; float gw0 = 0.f, gw1 = 0.f; f32x4 xr[4], oacc[8];
#pragma unroll
        for (int q = 0; q < 4; ++q) xr[q] = (f32x4){0.f, 0.f, 0.f, 0.f};
#pragma unroll
        for (int i = 0; i < 8; ++i) oacc[i] = (f32x4){0.f, 0.f, 0.f, 0.f};
#pragma unroll 1
        for (int it = 0; it < 128; ++it) {
            const int bt = it & 7, m = mbase + 8 * (it >> 3);
            if (bt == 0) {
                i0 = ni0; i1 = ni1; gw0 = ngw0; gw1 = ngw1; float s = 0.f;
#pragma unroll
                for (int q = 0; q < 4; ++q) { xr[q] = nxr[q]; s += (xr[q][0] * xr[q][0] + xr[q][1] * xr[q][1]) + (xr[q][2] * xr[q][2] + xr[q][3] * xr[q][3]); }
                const float r2 = rsqrtf(wave_sum(s) * (1.f / DM) + EPS);
                v4u h8;
#pragma unroll
                for (int q = 0; q < 4; ++q) { const f32x4 g = *(const f32x4*)(g2 + lane * 16 + q * 4); const f32x4 hq = xr[q] * r2 * g;
                    int pk = 0; pk = __builtin_amdgcn_cvt_pk_fp8_f32(hq[0], hq[1], pk, false); pk = __builtin_amdgcn_cvt_pk_fp8_f32(hq[2], hq[3], pk, true); h8[q] = (unsigned)pk; }
                *(LAS v4u*)(H8 + lane * 16) = h8;
#pragma unroll
                for (int i = 0; i < 8; ++i) oacc[i] = (f32x4){0.f, 0.f, 0.f, 0.f};
                const int mn = (it + 8 < 128) ? m + 8 : m;
                ni0 = IDX[(size_t)mn * 128 + lane]; ni1 = IDX[(size_t)mn * 128 + 64 + lane]; ngw0 = GW[(size_t)mn * 128 + lane]; ngw1 = GW[(size_t)mn * 128 + 64 + lane];
#pragma unroll
                for (int q = 0; q < 4; ++q) nxr[q] = *(const f32x4*)(X1 + (size_t)mn * DM + lane * 16 + q * 4);
            }
            const int k0 = bt * 16;
            const int isel = (k0 < 64) ? i0 : i1;
            const int myidx = __shfl(isel, (k0 + pe) & 63);
            const float su = USC[myidx], sv = VSC[myidx];
#pragma unroll
            for (int e = 0; e < 16; ++e) { *(LAS v2u*)(UL + AP_SLOT(e) * 528 + lane * 8) = uu[e]; *(LAS v2u*)(VL + e * 528 + lane * 8) = vv[e]; }
            { const int nk = (k0 + 16) & 127; const int nsel = (bt == 7) ? ni0 : ((nk < 64) ? i0 : i1);
              AP_LOADROWS(nsel, nk) }
            f32x4 da = (f32x4){0.f, 0.f, 0.f, 0.f}, db = (f32x4){0.f, 0.f, 0.f, 0.f};
#pragma unroll
            for (int ks = 0; ks < 8; ++ks) {
                const v4u af = *(const LAS v4u*)(UL + fr * 528 + 64 * ks + 16 * fq);
                const v4u b0 = *(const LAS v4u*)(H8 + 128 * ks + 16 * fq), b1 = *(const LAS v4u*)(H8 + 128 * ks + 64 + 16 * fq);
                const v8i_t A = {(int)af.x, (int)af.y, (int)af.z, (int)af.w, 0, 0, 0, 0};
                const v8i_t B = {(int)b0.x, (int)b0.y, (int)b0.z, (int)b0.w, (int)b1.x, (int)b1.y, (int)b1.z, (int)b1.w};
                if (ks & 1) db = __builtin_amdgcn_mfma_scale_f32_16x16x128_f8f6f4(A, B, db, 4  , 0  , 0, 0x7F7F7F7F, 0, 0x7F7F7F7F);
                else        da = __builtin_amdgcn_mfma_scale_f32_16x16x128_f8f6f4(A, B, da, 4, 0, 0, 0x7F7F7F7F, 0, 0x7F7F7F7F);
            }
            const f32x4 d4 = da + db;
            const int sel = fr & 3;
            float t = d4[0]; t = (sel == 1) ? d4[1] : t; t = (sel == 2) ? d4[2] : t; t = (sel == 3) ? d4[3] : t;
            const float gk = __shfl((k0 < 64) ? gw0 : gw1, (k0 + pe) & 63);
            const float wl = gk * gelu_fast(t * su) * sv;
            float wm = fabsf(wl); wm = fmaxf(wm, __shfl_xor(wm, 1)); wm = fmaxf(wm, __shfl_xor(wm, 2)); wm = fmaxf(wm, __shfl_xor(wm, 16)); wm = fmaxf(wm, __shfl_xor(wm, 32));
            int E = (int)(__float_as_uint(wm) >> 23); E = E < 8 ? 8 : E;
            const float wq = wl * __uint_as_float((unsigned)(261 - E) << 23);
            const int scb = (E - 7) * 0x01010101;
            v8i_t Bw;
#define AP_WQ(tq, ctrl) { const float wt = __builtin_bit_cast(float, __builtin_amdgcn_update_dpp(0, __builtin_bit_cast(int, wq), ctrl, 0xf, 0xf, false)); \
                const unsigned p8 = (unsigned)__builtin_amdgcn_cvt_pk_fp8_f32(wt, 0.f, 0, false) << bsh; Bw[2 * tq] = (int)(p8 & mlo); Bw[2 * tq + 1] = (int)(p8 & mhi); }
            AP_WQ(0, 0x00) AP_WQ(1, 0x55) AP_WQ(2, 0xAA) AP_WQ(3, 0xFF)
#pragma unroll
            for (int c = 0; c < 8; ++c) {
                v4u av;
                av.x = *(const LAS unsigned*)(VL + (4 * fq + 0) * 528 + 64 * c + 4 * fr); av.y = *(const LAS unsigned*)(VL + (4 * fq + 1) * 528 + 64 * c + 4 * fr);
                av.z = *(const LAS unsigned*)(VL + (4 * fq + 2) * 528 + 64 * c + 4 * fr); av.w = *(const LAS unsigned*)(VL + (4 * fq + 3) * 528 + 64 * c + 4 * fr);
                const v8i_t A = {(int)av.x, (int)av.y, (int)av.z, (int)av.w, 0, 0, 0, 0};
                oacc[c] = __builtin_amdgcn_mfma_scale_f32_16x16x128_f8f6f4(A, Bw, oacc[c], 4, 0, 0, 0x7F7F7F7F, 0, scb);
            }
            if (bt == 7) {
                if (fr < 8) {
#pragma unroll
                    for (int c = 0; c < 8; ++c)
#pragma unroll
                        for (int r = 0; r < 4; ++r) { const float o = oacc[c][r]; *(LAS unsigned*)(UL + 4 * ((4 * c + fq) * 40 + 8 * r + fr)) = __float_as_uint(o); }
                }
                float s2 = 0.f; f32x4 ov[4];
#pragma unroll
                for (int q = 0; q < 4; ++q) { const v4u ou = *(const LAS v4u*)(UL + 4 * ((lane >> 1) * 40 + (lane & 1) * 16 + 4 * q));
                    ov[q] = (f32x4){__uint_as_float(ou.x), __uint_as_float(ou.y), __uint_as_float(ou.z), __uint_as_float(ou.w)} + xr[q];
                    s2 += (ov[q][0] * ov[q][0] + ov[q][1] * ov[q][1]) + (ov[q][2] * ov[q][2] + ov[q][3] * ov[q][3]); }
                const float rf = rsqrtf(wave_sum(s2) * (1.f / DM) + EPS);
#pragma unroll
                for (int q = 0; q < 4; ++q) { const f32x4 g = *(const f32x4*)(gf + lane * 16 + q * 4);
                    *(f32x4*)(OUTP + (size_t)m * DM + lane * 16 + q * 4) = ov[q] * rf * g; }
            }
        }
    }
}

constexpr int N_PHASES = 13;
__global__ void __launch_bounds__(NTHR, 2) mega_fwd(Args args) {
    extern __shared__ __attribute__((aligned(16))) unsigned char lds[];
    Frame F;
    F.lds = (LAS unsigned char*)lds;
    F.tid = threadIdx.x; F.lane = F.tid & 63; F.wave = __builtin_amdgcn_readfirstlane(F.tid >> 6);
    F.G = gridDim.x; F.bid = blockIdx.x;
    F.in = args.in; F.out = args.out; F.ws = args.ws;
    volatile LAS unsigned* MISC = (volatile LAS unsigned*)(F.lds + MISC_OFF);
    for (int u = F.tid; u < (LDS_BYTES - LDSCTL_OFF) / 4; u += NTHR) ((LAS unsigned*)(F.lds + LDSCTL_OFF))[u] = 0u;
    __syncthreads();
    XcdBarrier bar; bar.bar = (unsigned*)(args.ws + WS_CTL) + CW_BAR; bar.x = 0; bar.st = nullptr;
    const bool one_launch = (args.ph_hi - args.ph_lo) > 1;
    if (one_launch) bar = xcd_barrier_post((unsigned*)(args.ws + WS_CTL) + CW_BAR, MISC + 8);
    const int lo = args.ph_lo, hi = args.ph_hi;
#define IN(k) (lo <= (k) && (k) < hi)
#define SEAM(k) do { if (IN(k) && IN((k) + 1)) xcd_barrier(bar); } while (0)
    unsigned char* ws = args.ws;

#ifndef PROBE_MASK
#define PROBE_MASK 0
#endif
#define REP(k) _Pragma("unroll") for (int rep_ = 0; rep_ < (((PROBE_MASK >> (k)) & 1) ? 2 : 1); ++rep_)
    if (IN(0)) REP(0) { p0_prologue(F); if (rep_ == 0 && ((PROBE_MASK >> 0) & 1)) xcd_barrier(bar); } SEAM(0);
    if (IN(1)) REP(1) {
        gates_phase(F);
        { AddrP1 g{(const char*)(ws + WS_K), (const char*)(ws + WS_WIN), 1024, 1024, 1024, 4, 0, 8};
          pg8::StaticOrder S; S.init(MTOK, 2048, F.G, F.bid, 4);
          EpiBf16<DstP1> E{DstP1{ws, 4, 0, 8}, 1.f};
          pg8::gemm_phase(F.lds, g, S, E); }
        { AddrP1 g{(const char*)F.out, (const char*)(ws + WS_WIN8), 512, 512, 512, 8, 4, 8};
          pg8::StaticOrder S; S.init(MTOK, 4096, F.G, F.bid, 4);
          EpiBf16<DstP1, true> E{DstP1{ws, 8, 4, 8}, 1.f / 1024.f};
          pg8::gemm_phase<EpiBf16<DstP1, true>, AddrP1, 1>(F.lds, g, S, E); }
    } SEAM(1);
    if (IN(2)) REP(2) { lru_phase<false>(F); } SEAM(2);
    if (IN(3)) REP(3) { lru_phase<true>(F); } SEAM(3);
    if (IN(4)) REP(4) { mconv_phase(F); } SEAM(4);
    if (IN(5)) REP(5) {
        const char* xc = (const char*)F.out + (size_t)MTOK * DM * 2;
        AddrQKV g{xc, (long)((const char*)(ws + WS_XM) - xc), (const char*)(ws + WS_WQKV), 1024, 256, 256};
        pg8::StaticOrder S; S.init(MTOK, 12 * 256, F.G, F.bid);
        EpiBf16<DstQKV> E{DstQKV{(char*)(ws + WS_LG), (long)WS_K - (long)WS_LG, (long)WS_XL - (long)WS_LG}, 1.f};
        pg8::gemm_phase(F.lds, g, S, E);
    } SEAM(5);
    if (IN(6)) REP(6) { mscan_phase(F); } SEAM(6);
    if (IN(7)) { ym_phase(F); } SEAM(7);
    if (IN(8)) {
        pg8::StaticOrder S; S.init(MTOK, 1024, F.G, F.bid);
        { AddrPlain g{(const char*)(ws + WS_OP), (const char*)(ws + WS_WB2), 1024, 1024, 1024};
          EpiMerge<false> E{(bf16*)(ws + WS_XM), (const unsigned char*)(ws + WS_MG), 0}; pg8::gemm_phase(F.lds, g, S, E); }
        { AddrPlain g{(const char*)F.out, (const char*)(ws + WS_WB2) + (size_t)1024 * 1024 * 2, 1024, 1024, 1024};
          EpiMerge<true> E{(bf16*)(ws + WS_XM), (const unsigned char*)(ws + WS_MG), 1024}; pg8::gemm_phase(F.lds, g, S, E); }
    } SEAM(8);
    if (IN(9)) {
        AddrPlain g{(const char*)(ws + WS_XM), (const char*)(ws + WS_WOUT2), 1024, 2048, 1024};
        pg8::StaticOrder S; S.init(MTOK, 1024, F.G, F.bid);
        EpiResid E{F.in[0], F.out, (bf16*)(ws + WS_XL), (float*)(ws + WS_SS)};
        pg8::gemm_phase(F.lds, g, S, E);
    } SEAM(9);
    if (IN(10)) REP(10) {
        AddrPlain g{(const char*)(ws + WS_XL), (const char*)(ws + WS_WPQ), 1024, 1024, 1024};
        pg8::StaticOrder S; S.init(MTOK, 2048, F.G, F.bid, 4);
        EpiPQ E{(bf16*)(ws + WS_MG), (const float*)(ws + WS_SS)};
        pg8::gemm_phase(F.lds, g, S, E);
    } SEAM(10);
    if (IN(11)) REP(11) { select_phase(F); }
    if (IN(11) && IN(12)) { asm volatile("s_waitcnt vmcnt(0)" ::: "memory"); __syncthreads(); }
    if (IN(12)) { if ((PROBE_MASK >> 12) & 1) { apply_phase(F, (float*)(ws + WS_MG)); xcd_barrier(bar); } apply_phase(F, F.out); }
#undef REP
#undef IN
#undef SEAM
}

extern "C" void kernel_launch(void* const* d_in, const int* in_sizes, int n_in, void* d_out, int out_size, void* d_ws, size_t ws_size, hipStream_t stream) {
    static int grid = 0;
    if (grid == 0) {
        if (n_in != 26 || in_sizes[0] != MTOK * DM || out_size != MTOK * DM || ws_size < WS_END) { fprintf(stderr, "kernel_launch: unexpected shapes / workspace (%zu < %zu)\n", ws_size, (size_t)WS_END); grid = -1; return; }
        int dev = 0, cus = 0, per_cu = 0;
        if (hipGetDevice(&dev) != hipSuccess || hipDeviceGetAttribute(&cus, hipDeviceAttributeMultiprocessorCount, dev) != hipSuccess) { grid = -1; return; }
        if (hipFuncSetAttribute((const void*)mega_fwd, hipFuncAttributeMaxDynamicSharedMemorySize, LDS_BYTES) != hipSuccess) { fprintf(stderr, "kernel_launch: hipFuncSetAttribute failed\n"); grid = -1; return; }
        if (hipOccupancyMaxActiveBlocksPerMultiprocessor(&per_cu, (const void*)mega_fwd, NTHR, LDS_BYTES) != hipSuccess || per_cu < 1) { fprintf(stderr, "kernel_launch: occupancy query says %d blocks/CU\n", per_cu); (void)hipGetLastError(); grid = -1; return; }
        grid = cus;
    }
    if (grid < 0) return;
    (void)hipMemsetAsync((char*)d_ws + WS_CTL + (size_t)CW_BAR * 4, 0, (size_t)XCD_BAR_WORDS * 4, stream);
    Args a{};
    for (int i = 0; i < 26; ++i) a.in[i] = (const float*)d_in[i];
    a.out = (float*)d_out; a.ws = (unsigned char*)d_ws;
#if MK_N_LAUNCHES == 1
    a.ph_lo = 0; a.ph_hi = N_PHASES;
    void* kargs[] = {&a};
    hipError_t e = hipLaunchCooperativeKernel((const void*)mega_fwd, dim3(grid), dim3(NTHR), kargs, LDS_BYTES, stream);
    if (e != hipSuccess) fprintf(stderr, "kernel_launch: cooperative launch failed: %s (grid %d)\n", hipGetErrorString(e), grid);
#else
    for (int p = 0; p < N_PHASES; ++p) { a.ph_lo = p; a.ph_hi = p + 1; hipLaunchKernelGGL(mega_fwd, dim3(grid), dim3(NTHR), LDS_BYTES, stream, a); }
#endif
}
```

```cpp
#include <hip/hip_runtime.h>
#include <cstdio>
#include <cstdint>
#include <math.h>

#ifndef MK_N_LAUNCHES
#define MK_N_LAUNCHES 1
#endif

constexpr int BATCH = 8, SEQ = 4096, DM = 1024, MTOK = BATCH * SEQ;
constexpr int DIN = 6160;
constexpr int NEXP = 16384;
constexpr float EPS = 1e-6f;

constexpr size_t MiB = 1u << 20;
constexpr size_t WS_CTL = 0, CTL_ZERO_BYTES = 1 * MiB;
constexpr size_t WS_WIN = 1 * MiB;
constexpr size_t WS_WQKV = 13 * MiB;
constexpr size_t WS_KEYS = 14 * MiB + 512 * 1024;
constexpr size_t WS_WLRU = 15 * MiB;
constexpr size_t WS_WB2 = 16 * MiB;
constexpr size_t WS_WOUT2 = 20 * MiB;
constexpr size_t WS_WPQ = 24 * MiB;
constexpr size_t WS_GATE = 28 * MiB;
constexpr size_t WS_WGT = 30 * MiB;
constexpr size_t WS_XM = 32 * MiB;
constexpr size_t WS_OP = 96 * MiB;
constexpr size_t WS_XL = 160 * MiB;
constexpr size_t WS_LG = 224 * MiB;
constexpr size_t WS_MG = 288 * MiB;
constexpr size_t WS_K = 416 * MiB;
constexpr size_t WS_AGG = 480 * MiB;
constexpr size_t WS_SS = 488 * MiB;
constexpr size_t WS_WIN8 = 489 * MiB;
constexpr size_t WS_END = 495 * MiB;

constexpr int CW_BAR = 4096;

constexpr int RING_BYTES = 131072;
constexpr int LDS_BYTES = 147456;
constexpr int LDSCTL_OFF = LDS_BYTES - 512, MISC_OFF = LDSCTL_OFF + 320;
constexpr int NWAVES = 8, NTHR = 512;

#define GAS __attribute__((address_space(1)))
#define LAS __attribute__((address_space(3)))
typedef unsigned short bf16;
typedef unsigned v4u __attribute__((ext_vector_type(4)));
typedef unsigned v2u __attribute__((ext_vector_type(2)));
typedef float f32x4 __attribute__((ext_vector_type(4)));
typedef float f32x2 __attribute__((ext_vector_type(2)));
typedef short bf16x8 __attribute__((ext_vector_type(8)));
typedef GAS unsigned gu32;
#define RLX_AGENT __ATOMIC_RELAXED, __HIP_MEMORY_SCOPE_AGENT
#define LDS_WAIT() asm volatile("s_waitcnt lgkmcnt(0)" ::: "memory")
#define VM_WAIT() asm volatile("s_waitcnt vmcnt(0)" ::: "memory")

__device__ __forceinline__ unsigned f2bf(float f) { unsigned u = __builtin_bit_cast(unsigned, f); return (u + 0x7fffu + ((u >> 16) & 1u)) >> 16; }
__device__ __forceinline__ unsigned pk2(float lo, float hi) { return f2bf(lo) | (f2bf(hi) << 16); }
__device__ __forceinline__ float bf2f(unsigned short h) { return __builtin_bit_cast(float, (unsigned)h << 16); }
__device__ __forceinline__ float bflo(unsigned w) { return __builtin_bit_cast(float, w << 16); }
__device__ __forceinline__ float bfhi(unsigned w) { return __builtin_bit_cast(float, w & 0xffff0000u); }
__device__ __forceinline__ float wave_sum(float v) {
#pragma unroll
  for (int o = 1; o < 64; o <<= 1) v += __shfl_xor(v, o);
  return v;
}
__device__ __forceinline__ float sigmoidf_(float x) { return __builtin_amdgcn_rcpf(1.f + __builtin_amdgcn_exp2f(x * -1.44269504089f)); }
__device__ __forceinline__ float gelu_erf(float x) { return 0.5f * x * (1.f + erff(x * 0.70710678118654752f)); }
__device__ __forceinline__ float gelu_fast(float v) {
    const float av = fabsf(v), t = __builtin_amdgcn_rcpf(av * 0.2316418882f + 1.0f);
    float q = t * 0.5307027145f + (-0.7265760135f); q = q * t + 0.7107068705f; q = q * t + (-0.142248368f); q = q * t + 0.127414796f; q = q * t;
    const float e = __builtin_amdgcn_exp2f((v * v) * (-0.72134752044f));
    const float m = v * (q * e);
    return v < 0.f ? m : v - m;
}
__device__ __forceinline__ float softplusf_(float x) { return fmaxf(x, 0.f) + log1pf(expf(-fabsf(x))); }

namespace pg8 {
#define PG8_LAS __attribute__((address_space(3)))
typedef unsigned short bf16_t;
typedef unsigned u32x4 __attribute__((ext_vector_type(4)));
typedef int i32x4_t __attribute__((ext_vector_type(4)));
constexpr int BM = 256, BK = 64, HALF = 128, HTB = HALF * BK * 2, STAGE_BYTES = 8 * HTB, NXCD = 8;

__host__ __device__ __forceinline__ int lds_byte(int r, int c) { const int st = (r >> 4) * 2 + (c >> 5), rr = r & 15, cc = c & 31, ob = rr * 64 + cc * 2; return st * 1024 + (ob ^ (((ob >> 9) & 1) << 5)); }
__host__ __device__ __forceinline__ void stage_rc(int b, int& R, int& C) { const int st = b / 1024, sb = b % 1024, swz = sb ^ (((sb >> 9) & 1) << 5); R = (st >> 1) * 16 + swz / 64; C = (st & 1) * 32 + (swz % 64) / 2; }
__host__ __device__ __forceinline__ int perm32(int rho) { const int n = rho >> 4, i = rho & 15; return 8 * (i >> 2) + 4 * n + (i & 3); }

struct Unit { int pm, pn; };
struct StaticOrder {
    int nM, nN, nwg, G, c, WGM;
    __host__ __device__ void init(int M, int N, int G_, int c_, int wgm = 8) { nM = M / BM; nN = N / BM; nwg = nM * nN; G = G_; c = c_; WGM = wgm; }
    __host__ __device__ bool next(int i, Unit& u) const {
        const long L = (long)i * G + c; if (L >= nwg) return false;
        int wgid = (int)L; { const int q = nwg / NXCD, r = nwg % NXCD, xcd = wgid % NXCD, off = wgid / NXCD; wgid = (xcd < r ? xcd * (q + 1) : r * (q + 1) + (xcd - r) * q) + off; }
        const int nig = WGM * nN, gid = wgid / nig, fm = gid * WGM, gsz = (nM - fm) < WGM ? (nM - fm) : WGM;
        u.pm = fm + ((wgid % nig) % gsz); u.pn = (wgid % nig) / gsz; return true;
    }
};

__device__ __forceinline__ unsigned cvt_pk_bf16(float lo, float hi) { unsigned r; asm volatile("v_cvt_pk_bf16_f32 %0, %1, %2" : "=v"(r) : "v"(lo), "v"(hi)); return r; }

template <class Epi, class Addr, int F8SC = 0>
__device__ __forceinline__ void gemm_phase(PG8_LAS unsigned char* lds, const Addr g, const StaticOrder& S, const Epi& E) {
    const int tid = threadIdx.x, wid = __builtin_amdgcn_readfirstlane(tid >> 6), lane = tid & 63, wr = wid >> 2, wc = wid & 3, fr = lane & 15, fq = lane >> 4;
    const int K = g.K, nt = K / BK;
    unsigned voffA[2], voffB[2];
#pragma unroll
    for (int i = 0; i < 2; ++i) { int R, C; stage_rc(tid * 16 + i * 8192, R, C); const int Rb = Epi::PERM ? ((R & ~31) + perm32(R & 31)) : R;
        voffA[i] = (unsigned)(R * g.lda + C) * 2u; voffB[i] = (unsigned)(Rb * g.ldb + C) * 2u; }
    const size_t kstep = (size_t)(BK * 2);
    const size_t hsA = (size_t)HALF * g.lda * 2, hsB = (size_t)HALF * g.ldb * 2;
    const unsigned ldsw = (unsigned)wid * 1024u;
    const int aoff = lds_byte(wr * 64 + fr, fq * 8), boff = lds_byte(wc * 32 + fr, fq * 8);
#define PG8_SA(b, h) (((b) * 2 + (h)) * HTB)
#define PG8_SB(b, h) ((4 + (b) * 2 + (h)) * HTB)
#define PG8_STAGE(bufoff, gbase, voff) do { _Pragma("unroll") for (int _i = 0; _i < 2; ++_i) \
        __builtin_amdgcn_global_load_lds((const unsigned*)((const char*)(gbase) + (voff)[_i]), (PG8_LAS unsigned*)(lds + (bufoff) + ldsw + _i * 8192), 16, 0, 0); } while (0)
#define PG8_LDA(dst, b, h) do { _Pragma("unroll") for (int m = 0; m < 4; ++m) _Pragma("unroll") for (int k = 0; k < 2; ++k) dst[m][k] = *(const PG8_LAS bf16x8*)(lds + PG8_SA(b, h) + aoff + m * 2048 + k * 1024); } while (0)
#define PG8_LDB(dst, b, h) do { _Pragma("unroll") for (int n = 0; n < 2; ++n) _Pragma("unroll") for (int k = 0; k < 2; ++k) dst[n][k] = *(const PG8_LAS bf16x8*)(lds + PG8_SB(b, h) + boff + n * 2048 + k * 1024); } while (0)
#define PG8_CAT(x0, x1) __builtin_shufflevector(__builtin_bit_cast(i32x4_t, x0), __builtin_bit_cast(i32x4_t, x1), 0, 1, 2, 3, 4, 5, 6, 7)
#define PG8_MMA(ai, bj, At, Bt) do { __builtin_amdgcn_s_setprio(1); \
        if constexpr (F8SC != 0) { _Pragma("unroll") for (int m = 0; m < 4; ++m) _Pragma("unroll") for (int n = 0; n < 2; ++n) \
            asm volatile("v_mfma_f32_16x16x128_f8f6f4 %0, %1, %2, %0" : "+v"(acc[ai][bj][m][n]) : "v"(PG8_CAT(Bt[n][0], Bt[n][1])), "v"(PG8_CAT(At[m][0], At[m][1]))); } \
        else { _Pragma("unroll") for (int m = 0; m < 4; ++m) _Pragma("unroll") for (int n = 0; n < 2; ++n) _Pragma("unroll") for (int k = 0; k < 2; ++k) \
            acc[ai][bj][m][n] = __builtin_amdgcn_mfma_f32_16x16x32_bf16(Bt[n][k], At[m][k], acc[ai][bj][m][n], 0, 0, 0); } \
        __builtin_amdgcn_s_setprio(0); } while (0)
#define PG8_WAIT_V(n) asm volatile("s_waitcnt vmcnt(" #n ")" ::: "memory")
#define PG8_WAIT_L(n) asm volatile("s_waitcnt lgkmcnt(" #n ")" ::: "memory")
#define PG8_BAR __builtin_amdgcn_s_barrier()
#define PG8_SCHED __builtin_amdgcn_sched_barrier(0)
    Unit cur, nxt; int ui = 0;
    if (!S.next(0, cur)) return;
    f32x4 acc[2][2][4][2];
#pragma unroll
    for (int a = 0; a < 2; ++a)
#pragma unroll
        for (int b = 0; b < 2; ++b)
#pragma unroll
            for (int m = 0; m < 4; ++m)
#pragma unroll
                for (int n = 0; n < 2; ++n) acc[a][b][m][n] = (f32x4){0.f, 0.f, 0.f, 0.f};
    bf16x8 At[4][2], B0[2][2], B1[2][2];
    const char* cA = g.a(cur); const char* cB = g.b(cur);
    PG8_STAGE(PG8_SB(0, 0), cB, voffB); PG8_STAGE(PG8_SB(0, 1), cB + hsB, voffB); PG8_STAGE(PG8_SA(0, 0), cA, voffA); PG8_STAGE(PG8_SA(0, 1), cA + hsA, voffA);
    if (wr == 1) PG8_BAR;
    PG8_WAIT_V(2); PG8_BAR;
    PG8_STAGE(PG8_SB(1, 0), cB + kstep, voffB); PG8_STAGE(PG8_SA(1, 0), cA + kstep, voffA); PG8_STAGE(PG8_SB(1, 1), cB + hsB + kstep, voffB);
    PG8_WAIT_V(6); PG8_BAR;
    for (;;) {
        const bool has_next = S.next(ui + 1, nxt);
        const char* nA = has_next ? g.a(nxt) : cA; const char* nB = has_next ? g.b(nxt) : cB;
#pragma unroll 1
        for (int t = 0; t < nt; t += 2) {
            const bool last = (t == nt - 2);
            const char* a1 = cA + (size_t)(t + 1) * kstep;
            const char* a2 = last ? nA : cA + (size_t)(t + 2) * kstep; const char* b2 = last ? nB : cB + (size_t)(t + 2) * kstep;
            const char* a3 = a2 + kstep; const char* b3 = b2 + kstep;
            PG8_LDB(B0, 0, 0); PG8_LDB(B1, 0, 1); PG8_SCHED; PG8_LDA(At, 0, 0); PG8_STAGE(PG8_SA(1, 1), a1 + hsA, voffA);
            PG8_WAIT_V(8); PG8_WAIT_L(0); PG8_BAR; PG8_MMA(0, 0, At, B0); PG8_MMA(0, 1, At, B1); PG8_BAR; PG8_SCHED;
            PG8_LDA(At, 0, 1); PG8_STAGE(PG8_SB(0, 0), b2, voffB); PG8_STAGE(PG8_SB(0, 1), b2 + hsB, voffB); PG8_STAGE(PG8_SA(0, 0), a2, voffA);
            PG8_WAIT_V(8); PG8_WAIT_L(0); PG8_BAR; PG8_MMA(1, 0, At, B0); PG8_MMA(1, 1, At, B1); PG8_BAR; PG8_SCHED;
            PG8_LDB(B0, 1, 0); PG8_LDB(B1, 1, 1); PG8_SCHED; PG8_LDA(At, 1, 0); PG8_STAGE(PG8_SA(0, 1), a2 + hsA, voffA);
            PG8_WAIT_V(8); PG8_WAIT_L(0); PG8_BAR; PG8_MMA(0, 0, At, B0); PG8_MMA(0, 1, At, B1); PG8_BAR; PG8_SCHED;
            PG8_LDA(At, 1, 1); PG8_STAGE(PG8_SB(1, 0), b3, voffB); PG8_STAGE(PG8_SB(1, 1), b3 + hsB, voffB); PG8_STAGE(PG8_SA(1, 0), a3, voffA);
            PG8_WAIT_V(8); PG8_WAIT_L(0); PG8_BAR; PG8_MMA(1, 0, At, B0); PG8_MMA(1, 1, At, B1); PG8_BAR; PG8_SCHED;
        }
        if constexpr (F8SC != 0) asm volatile("s_nop 15\n\ts_nop 15" ::: "memory");
        if (wr == 0) PG8_BAR;
        E(acc, cur, wr, wc, fr, fq);
        if (!has_next) break;
#pragma unroll
        for (int a = 0; a < 2; ++a)
#pragma unroll
            for (int b = 0; b < 2; ++b)
#pragma unroll
                for (int m = 0; m < 4; ++m)
#pragma unroll
                    for (int n = 0; n < 2; ++n) acc[a][b][m][n] = (f32x4){0.f, 0.f, 0.f, 0.f};
        cur = nxt; cA = nA; cB = nB; ++ui;
        if (wr == 1) PG8_BAR;
    }
    PG8_WAIT_V(0);
    PG8_BAR;
#undef PG8_SA
#undef PG8_SB
#undef PG8_STAGE
#undef PG8_LDA
#undef PG8_LDB
#undef PG8_MMA
#undef PG8_CAT
#undef PG8_WAIT_V
#undef PG8_WAIT_L
#undef PG8_BAR
#undef PG8_SCHED
}
}

#define XB_TMO      128
#define XB_XCNT(j)  (256  + 64 * (j))
#define XB_XSUB(j)  (1280 + 64 * (j))
#define XB_XGEN(j)  (2304 + 64 * (j))
#define XB_TOP      3328
#define XB_TOPGEN   3392
#define XCD_BAR_WORDS 3456
#define XB_SPIN_CAP (1u << 18)
__device__ __forceinline__ unsigned xb_ld(unsigned* p)              { return __hip_atomic_load(p, __ATOMIC_RELAXED, __HIP_MEMORY_SCOPE_AGENT); }
__device__ __forceinline__ unsigned xb_add(unsigned* p, unsigned v) { return __hip_atomic_fetch_add(p, v, __ATOMIC_RELAXED, __HIP_MEMORY_SCOPE_AGENT); }
__device__ __forceinline__ unsigned xb_xcc_id() { return (unsigned)__builtin_amdgcn_s_getreg((3 << 11) | 20) & 0xFu; }
#define XB_SPIN(cond, bar) do { unsigned _sp = 0; while (cond) { __builtin_amdgcn_s_sleep(1); \
    if ((++_sp & 255u) == 0u) { if (xb_ld(&(bar)[XB_TMO])) break; if (_sp > XB_SPIN_CAP) { atomicAdd(&(bar)[XB_TMO], 1u); break; } } } } while (0)
struct XcdBarrier { unsigned* bar; unsigned x; volatile LAS unsigned* st; };
__device__ __forceinline__ XcdBarrier xcd_barrier_post(unsigned* bar, volatile LAS unsigned* st) {
    XcdBarrier b; b.bar = bar; b.x = xb_xcc_id(); b.st = st;
    if (threadIdx.x == 0) (void)xb_add(&bar[XB_XCNT(b.x)], 1u);
    return b;
}
__device__ __forceinline__ void xcd_barrier_complete(unsigned* bar, unsigned x, unsigned& nloc, unsigned& nx) {
    const unsigned G = gridDim.x * gridDim.y * gridDim.z;
    unsigned sum, cnt, mine, sp = 0u;
    for (;;) {
        sum = 0u; cnt = 0u; mine = 0u;
#pragma unroll
        for (unsigned j = 0; j < 16; ++j) { const unsigned c = xb_ld(&bar[XB_XCNT(j)]); sum += c; cnt += (c > 0u) ? 1u : 0u; mine = (j == x) ? c : mine; }
        if (sum == G) break;
        __builtin_amdgcn_s_sleep(1);
        if ((++sp & 255u) == 0u) { if (xb_ld(&bar[XB_TMO])) break; if (sp > XB_SPIN_CAP) { atomicAdd(&bar[XB_TMO], 1u); break; } }
    }
    nloc = mine > 0u ? mine : 1u; nx = cnt > 0u ? cnt : 1u;
}
__device__ __forceinline__ void xcd_barrier(const XcdBarrier& b) {
    asm volatile("s_waitcnt vmcnt(0)" ::: "memory");
    __syncthreads();
    if (threadIdx.x == 0) {
        unsigned* bar = b.bar;
        __builtin_amdgcn_s_waitcnt(0);
        unsigned nloc = b.st[0], nx = b.st[1];
        if (nloc == 0u) { xcd_barrier_complete(bar, b.x, nloc, nx); b.st[0] = nloc; b.st[1] = nx; }
        const unsigned old = xb_add(&bar[XB_XSUB(b.x)], 1u);
        const unsigned gen = old / nloc;
        if (old + 1u == (gen + 1u) * nloc) {
            __builtin_amdgcn_fence(__ATOMIC_RELEASE, "agent");
            asm volatile("s_waitcnt vmcnt(0)" ::: "memory");
            const unsigned og = xb_add(&bar[XB_TOP], 1u);
            const unsigned tg = og / nx;
            if (og + 1u == (tg + 1u) * nx) xb_add(&bar[XB_TOPGEN], 1u);
            else XB_SPIN(xb_ld(&bar[XB_TOPGEN]) == tg, bar);
            __builtin_amdgcn_fence(__ATOMIC_ACQUIRE, "agent");
            xb_add(&bar[XB_XGEN(b.x)], 1u);
            asm volatile("s_waitcnt vmcnt(0)" ::: "memory");
        } else {
            XB_SPIN(xb_ld(&bar[XB_XGEN(b.x)]) == gen, bar);
            __builtin_amdgcn_fence(__ATOMIC_ACQUIRE, "agent");
            asm volatile("s_waitcnt vmcnt(0)" ::: "memory");
        }
    }
    __syncthreads();
}

struct Args { const float* in[26]; float* out; unsigned char* ws; int ph_lo, ph_hi; };
struct Frame {
    LAS unsigned char* lds;
    int tid, lane, wave, G, bid;
    const float* const* in; float* out; unsigned char* ws;
};

template <bool F8 = false> __device__ __forceinline__ void tr_item(const float* W, int ldw, bf16* WT, int ldt, float scale, const float* kscale, LAS float* scr, int k0, int lane) {
#pragma unroll 8
    for (int i = 0; i < 32; ++i) { const int kk = 2 * i + (lane >> 5); float v = W[(size_t)(k0 + kk) * ldw + (lane & 31)] * scale; if (kscale) v *= kscale[k0 + kk]; scr[kk * 33 + (lane & 31)] = v; }
    LDS_WAIT(); asm volatile("" ::: "memory");
    const int c = lane & 7;
#pragma unroll
    for (int j = 0; j < 4; ++j) { const int n = (lane >> 3) + 8 * j; const LAS float* s = scr + (8 * c) * 33 + n;
        if constexpr (F8) {
            int p0 = 0, p1 = 0; p0 = __builtin_amdgcn_cvt_pk_fp8_f32(s[0 * 33], s[1 * 33], p0, false); p0 = __builtin_amdgcn_cvt_pk_fp8_f32(s[2 * 33], s[3 * 33], p0, true);
            p1 = __builtin_amdgcn_cvt_pk_fp8_f32(s[4 * 33], s[5 * 33], p1, false); p1 = __builtin_amdgcn_cvt_pk_fp8_f32(s[6 * 33], s[7 * 33], p1, true);
            *(GAS v2u*)((GAS unsigned char*)WT + (size_t)n * ldt + k0 + 8 * c) = (v2u){(unsigned)p0, (unsigned)p1};
        } else {
        v4u o; o.x = pk2(s[0 * 33], s[1 * 33]); o.y = pk2(s[2 * 33], s[3 * 33]); o.z = pk2(s[4 * 33], s[5 * 33]); o.w = pk2(s[6 * 33], s[7 * 33]);
        *(GAS v4u*)(WT + (size_t)n * ldt + k0 + 8 * c) = o; } }
    LDS_WAIT(); asm volatile("" ::: "memory");
}

__device__ __forceinline__ void p0_prologue(Frame& F) {
    LAS float* scr = (LAS float*)(F.lds + F.wave * 16384);
    const int gw = F.bid * NWAVES + F.wave, NGW = F.G * NWAVES;
    unsigned char* ws = F.ws;
    const float* w_in = F.in[2];
    constexpr int I_WIN = 16 * 192, I_QKV = 12 * 32, I_LRU = 32 * 8, I_WB = 2 * 512, I_WO = 512, I_PQ = 16 * 64;
    constexpr int NITEMS = I_WIN + I_QKV + I_LRU + I_WB + I_WO + I_PQ;
    for (int it = gw; it < NITEMS; it += NGW) {
        int r = it;
        if (r < I_WIN) { const int kb = r / 192, nb = r % 192, n0 = nb * 32, sc = n0 < 2048 ? n0 : n0 + 16;
            if ((n0 >= 1024 && n0 < 3072) || n0 >= 4096) tr_item<true>(w_in + sc, DIN, (bf16*)(ws + WS_WIN8 + (size_t)n0 * 1024), 1024, 1024.f, nullptr, scr, kb * 64, F.lane);
            else tr_item(w_in + sc, DIN, (bf16*)(ws + WS_WIN) + (size_t)n0 * 1024, 1024, 1.f, nullptr, scr, kb * 64, F.lane);
            continue; }
        r -= I_WIN;
        if (r < I_QKV) { const int mat = r / 32, rr = r % 32, kb = rr / 8, nb = rr % 8, g = mat >> 2, h = mat & 3;
            const float* W = F.in[6 + g] + (size_t)h * 65536 + nb * 32;
            tr_item(W, 256, (bf16*)(ws + WS_WQKV) + (size_t)mat * 65536 + (size_t)(nb * 32) * 256, 256, g == 1 ? 0.0625f : 1.f, nullptr, scr, kb * 64, F.lane); continue; }
        r -= I_QKV;
        if (r < I_LRU) { const int mat = r / 8, rr = r % 8, kb = rr / 4, nb = rr % 4, gate = mat & 1, db = mat >> 1;
            const float* W = F.in[gate ? 14 : 12] + (size_t)db * 16384 + nb * 32;
            tr_item(W, 128, (bf16*)(ws + WS_WLRU) + (size_t)mat * 16384 + (size_t)(nb * 32) * 128, 128, 1.f, nullptr, scr, kb * 64, F.lane); continue; }
        r -= I_LRU;
        if (r < I_WB) { const int mat = r / 512, rr = r % 512, kb = rr / 32, nb = rr % 32;
            const float* W = F.in[17 + mat] + nb * 32;
            tr_item(W, 1024, (bf16*)(ws + WS_WB2) + (size_t)(mat * 1024 + nb * 32) * 1024, 1024, 1.f, nullptr, scr, kb * 64, F.lane); continue; }
        r -= I_WB;
        if (r < I_WO) { const int cp = 0, rr = r, kb = rr / 32, nb = rr % 32;
            const float* W = F.in[19] + nb * 32;
            tr_item(W, 1024, (bf16*)(ws + WS_WOUT2) + (size_t)(nb * 32) * 2048 + cp * 1024, 2048, 1.f, nullptr, scr, kb * 64, F.lane); continue; }
        r -= I_WO;
        { const int kb = r / 64, nb = r % 64;
            const float* W = F.in[21] + nb * 32;
            tr_item(W, 2048, (bf16*)(ws + WS_WPQ) + (size_t)(nb * 32) * 1024, 1024, 1.f, F.in[20], scr, kb * 64, F.lane); }
    }
    { const int gt = F.bid * NTHR + F.tid, NGT = F.G * NTHR;
      const float4* ks = (const float4*)F.in[22]; v2u* kd = (v2u*)(ws + WS_KEYS);
      for (int i = gt; i < 8 * 2 * 128 * 128 / 4; i += NGT) { const float4 v = ks[i]; v2u o; o.x = pk2(v.x, v.y); o.y = pk2(v.z, v.w); kd[i] = o; }
      float* ss = (float*)(ws + WS_SS);
      for (int i = gt; i < MTOK; i += NGT) ss[i] = 0.f; }
    { const int gt = F.bid * NTHR + F.tid;
      if (gt < 16 * 128) { const int c = gt >> 7, k8 = gt & 127; v4u o; unsigned wv[4];
#pragma unroll
          for (int j = 0; j < 4; ++j) wv[j] = pk2(w_in[(size_t)(k8 * 8 + 2 * j) * DIN + 2048 + c], w_in[(size_t)(k8 * 8 + 2 * j + 1) * DIN + 2048 + c]);
          o.x = wv[0]; o.y = wv[1]; o.z = wv[2]; o.w = wv[3]; *(v4u*)((bf16*)(ws + WS_WGT) + c * 1024 + k8 * 8) = o; } }
    const float* x = F.in[0]; const float* g1 = F.in[1];
    bf16* XN = (bf16*)(ws + WS_K);
    unsigned char* XN8 = (unsigned char*)F.out;
    f32x4 gv[4];
#pragma unroll
    for (int j = 0; j < 4; ++j) gv[j] = ((const f32x4*)g1)[F.lane + 64 * j];
    for (int m = 2 * gw; m < MTOK; m += 2 * NGW) {
        const f32x4* xr0 = (const f32x4*)(x + (size_t)m * DM) + F.lane; const f32x4* xr1 = xr0 + DM / 4;
        f32x4 v0[4], v1[4]; float s0 = 0.f, s1 = 0.f;
#pragma unroll
        for (int j = 0; j < 4; ++j) { v0[j] = xr0[64 * j]; v1[j] = xr1[64 * j]; }
#pragma unroll
        for (int j = 0; j < 4; ++j) { s0 += (v0[j].x * v0[j].x + v0[j].y * v0[j].y) + (v0[j].z * v0[j].z + v0[j].w * v0[j].w); s1 += (v1[j].x * v1[j].x + v1[j].y * v1[j].y) + (v1[j].z * v1[j].z + v1[j].w * v1[j].w); }
        const float r0 = rsqrtf(wave_sum(s0) * (1.f / DM) + EPS), r1 = rsqrtf(wave_sum(s1) * (1.f / DM) + EPS);
        unsigned long long* o0 = (unsigned long long*)(XN + (size_t)m * DM) + F.lane; unsigned long long* o1 = o0 + DM / 4;
        unsigned* q0 = (unsigned*)(XN8 + (size_t)m * DM) + F.lane; unsigned* q1 = q0 + DM / 4;
#pragma unroll
        for (int j = 0; j < 4; ++j) { const f32x4 a = v0[j] * r0 * gv[j], c = v1[j] * r1 * gv[j];
            o0[64 * j] = (unsigned long long)pk2(a.x, a.y) | ((unsigned long long)pk2(a.z, a.w) << 32);
            o1[64 * j] = (unsigned long long)pk2(c.x, c.y) | ((unsigned long long)pk2(c.z, c.w) << 32);
            int pa = 0, pc = 0; pa = __builtin_amdgcn_cvt_pk_fp8_f32(a.x, a.y, pa, false); pa = __builtin_amdgcn_cvt_pk_fp8_f32(a.z, a.w, pa, true);
            pc = __builtin_amdgcn_cvt_pk_fp8_f32(c.x, c.y, pc, false); pc = __builtin_amdgcn_cvt_pk_fp8_f32(c.z, c.w, pc, true);
            q0[64 * j] = (unsigned)pa; q1[64 * j] = (unsigned)pc; }
    }
}
__device__ __forceinline__ void gates_phase(Frame& F) {
    const bf16* XN = (const bf16*)(F.ws + WS_K); const bf16* WGT = (const bf16*)(F.ws + WS_WGT); float* GT = (float*)(F.ws + WS_GATE);
    const int lane = F.lane, fr = lane & 15, fq = lane >> 4;
    const f32x4 bg4 = *(const f32x4*)(F.in[3] + 4 * fq);
    for (int task = F.bid * NWAVES + F.wave; task < MTOK / 16; task += F.G * NWAVES) {
        const size_t m0 = (size_t)task * 16;
        f32x4 acc = (f32x4){0.f, 0.f, 0.f, 0.f};
#pragma unroll 8
        for (int ks = 0; ks < 32; ++ks) {
            const bf16x8 wfr = *(const bf16x8*)(WGT + fr * 1024 + 32 * ks + 8 * fq);
            const bf16x8 xfr = *(const bf16x8*)(XN + (m0 + fr) * DM + 32 * ks + 8 * fq);
            acc = __builtin_amdgcn_mfma_f32_16x16x32_bf16(wfr, xfr, acc, 0, 0, 0);
        }
        *(f32x4*)(GT + (m0 + fr) * 16 + 4 * fq) = acc + bg4;
    }
}

struct AddrPlain {
    const char* A; const char* Bt; int lda, ldb, K;
    __device__ __forceinline__ const char* a(const pg8::Unit& u) const { return A + (size_t)u.pm * 256 * lda * 2; }
    __device__ __forceinline__ const char* b(const pg8::Unit& u) const { return Bt + (size_t)u.pn * 256 * ldb * 2; }
};
struct AddrP1 {
    const char* A; const char* Bt; int lda, ldb, K, thr, lo_add, hi_add;
    __device__ __forceinline__ const char* a(const pg8::Unit& u) const { return A + (size_t)u.pm * 256 * lda * 2; }
    __device__ __forceinline__ const char* b(const pg8::Unit& u) const { return Bt + (size_t)(u.pn + (u.pn < thr ? lo_add : hi_add)) * 256 * ldb * 2; }
};
struct AddrQKV {
    const char* XC; long dXM; const char* W; int lda, ldb, K;
    __device__ __forceinline__ const char* a(const pg8::Unit& u) const { return XC + (u.pn < 8 ? 0l : dXM) + ((size_t)u.pm * 256 * 1024 + (u.pn & 3) * 256) * 2; }
    __device__ __forceinline__ const char* b(const pg8::Unit& u) const { return W + (size_t)u.pn * 65536 * 2; }
};
struct AddrBranch {
    const char* YM; long dYL; const char* W; int lda, ldb, K;
    __device__ __forceinline__ const char* a(const pg8::Unit& u) const { return YM + (u.pn < 4 ? 0l : dYL) + (size_t)u.pm * 256 * 1024 * 2; }
    __device__ __forceinline__ const char* b(const pg8::Unit& u) const { return W + (size_t)u.pn * 256 * 1024 * 2; }
};

struct DstP1 { unsigned char* ws; int thr, lo_add, hi_add;
    __device__ __forceinline__ bf16* get(int j, int& ld, int& col0) const {
        const int pn = j + (j < thr ? lo_add : hi_add); const bool mg = pn >= 16; ld = mg ? -2048 : 1024; col0 = mg ? (pn - 16) * 256 : (pn & 3) * 256;
        return (bf16*)(ws + (mg ? WS_MG : WS_XM + (size_t)(pn >> 2) * 64 * MiB)); } };
struct DstQKV { char* q; long dk, dv;
    __device__ __forceinline__ bf16* get(int pn, int& ld, int& col0) const { ld = 1024; col0 = (pn & 3) * 256; return (bf16*)(q + (pn >= 4 ? (pn >= 8 ? dv : dk) : 0l)); } };
template <class Dst, bool MUL = false> struct EpiBf16 {
    static constexpr bool PERM = true;
    Dst dst; float mul;
    __device__ __forceinline__ void operator()(const f32x4 (&acc)[2][2][4][2], const pg8::Unit& u, int wr, int wc, int fr, int fq) const {
        int ld, colt; bf16* base = dst.get(u.pn, ld, colt);
        const int row0 = u.pm * 256 + wr * 64 + fr, col0 = colt + wc * 32 + 8 * fq;
        if (MUL && ld < 0) {
#pragma unroll
            for (int ai = 0; ai < 2; ++ai)
#pragma unroll
                for (int m = 0; m < 4; ++m) { unsigned char* rowp = (unsigned char*)base + (size_t)(row0 + ai * 128 + m * 16) * (-ld) + col0;
#pragma unroll
                    for (int bj = 0; bj < 2; ++bj) { const f32x4 v0 = acc[ai][bj][m][0] * mul, v1 = acc[ai][bj][m][1] * mul;
                        int p0 = 0, p1 = 0; p0 = __builtin_amdgcn_cvt_pk_fp8_f32(v0[0], v0[1], p0, false); p0 = __builtin_amdgcn_cvt_pk_fp8_f32(v0[2], v0[3], p0, true);
                        p1 = __builtin_amdgcn_cvt_pk_fp8_f32(v1[0], v1[1], p1, false); p1 = __builtin_amdgcn_cvt_pk_fp8_f32(v1[2], v1[3], p1, true);
                        *(v2u*)(rowp + bj * 128) = (v2u){(unsigned)p0, (unsigned)p1}; } }
            return;
        }
#pragma unroll
        for (int ai = 0; ai < 2; ++ai)
#pragma unroll
            for (int m = 0; m < 4; ++m) { bf16* rowp = base + (size_t)(row0 + ai * 128 + m * 16) * ld + col0;
#pragma unroll
                for (int bj = 0; bj < 2; ++bj) { f32x4 v0 = acc[ai][bj][m][0], v1 = acc[ai][bj][m][1]; if (MUL) { v0 = v0 * mul; v1 = v1 * mul; }
                    v4u w; w.x = pg8::cvt_pk_bf16(v0[0], v0[1]); w.y = pg8::cvt_pk_bf16(v0[2], v0[3]); w.z = pg8::cvt_pk_bf16(v1[0], v1[1]); w.w = pg8::cvt_pk_bf16(v1[2], v1[3]);
                    *(v4u*)(rowp + bj * 128) = w; } }
    }
};
template <bool ADD> struct EpiMerge {
    static constexpr bool PERM = true;
    bf16* MRG; const unsigned char* MG; int gcol;
    __device__ __forceinline__ void operator()(const f32x4 (&acc)[2][2][4][2], const pg8::Unit& u, int wr, int wc, int fr, int fq) const {
        const int row0 = u.pm * 256 + wr * 64 + fr, col0 = u.pn * 256 + wc * 32 + 8 * fq;
#pragma unroll
        for (int ai = 0; ai < 2; ++ai)
#pragma unroll
            for (int m = 0; m < 4; ++m) { const size_t row = (size_t)(row0 + ai * 128 + m * 16); bf16* rowp = MRG + row * 1024 + col0; const unsigned char* gp = MG + row * 2048 + gcol + col0;
#pragma unroll
                for (int bj = 0; bj < 2; ++bj) { const f32x4 v0 = acc[ai][bj][m][0], v1 = acc[ai][bj][m][1];
                    const v2u g = *(const v2u*)(gp + bj * 128);
                    const f32x2 g0 = __builtin_amdgcn_cvt_pk_f32_fp8((int)g.x, false), g1 = __builtin_amdgcn_cvt_pk_f32_fp8((int)g.x, true), g2 = __builtin_amdgcn_cvt_pk_f32_fp8((int)g.y, false), g3 = __builtin_amdgcn_cvt_pk_f32_fp8((int)g.y, true);
                    float o[8] = {v0[0] * sigmoidf_(g0[0]), v0[1] * sigmoidf_(g0[1]), v0[2] * sigmoidf_(g1[0]), v0[3] * sigmoidf_(g1[1]),
                                  v1[0] * sigmoidf_(g2[0]), v1[1] * sigmoidf_(g2[1]), v1[2] * sigmoidf_(g3[0]), v1[3] * sigmoidf_(g3[1])};
                    if (ADD) { const v4u t = *(const v4u*)(rowp + bj * 128);
                        o[0] += bflo(t.x); o[1] += bfhi(t.x); o[2] += bflo(t.y); o[3] += bfhi(t.y); o[4] += bflo(t.z); o[5] += bfhi(t.z); o[6] += bflo(t.w); o[7] += bfhi(t.w); }
                    v4u w; w.x = pg8::cvt_pk_bf16(o[0], o[1]); w.y = pg8::cvt_pk_bf16(o[2], o[3]); w.z = pg8::cvt_pk_bf16(o[4], o[5]); w.w = pg8::cvt_pk_bf16(o[6], o[7]);
                    *(v4u*)(rowp + bj * 128) = w; } }
    }
};
struct EpiResid {
    static constexpr bool PERM = false;
    const float* x; float* x1; bf16* x1b; float* ss;
    __device__ __forceinline__ void operator()(const f32x4 (&acc)[2][2][4][2], const pg8::Unit& u, int wr, int wc, int fr, int fq) const {
        const int row0 = u.pm * 256 + wr * 64 + fr, col0 = u.pn * 256 + wc * 32 + 4 * fq;
#pragma unroll
        for (int ai = 0; ai < 2; ++ai)
#pragma unroll
            for (int m = 0; m < 4; ++m) { const int row = row0 + ai * 128 + m * 16; const size_t off = (size_t)row * DM + col0; float s = 0.f;
#pragma unroll
                for (int bj = 0; bj < 2; ++bj)
#pragma unroll
                    for (int n = 0; n < 2; ++n) { const size_t o = off + bj * 128 + n * 16; const f32x4 v = *(const f32x4*)(x + o) + acc[ai][bj][m][n];
                        *(f32x4*)(x1 + o) = v; v2u w; w.x = pg8::cvt_pk_bf16(v[0], v[1]); w.y = pg8::cvt_pk_bf16(v[2], v[3]); *(v2u*)(x1b + o) = w;
                        s += (v[0] * v[0] + v[1] * v[1]) + (v[2] * v[2] + v[3] * v[3]); }
                s += __shfl_xor(s, 16); s += __shfl_xor(s, 32);
                if (fq == 0) atomicAdd(ss + row, s); }
    }
};
struct EpiPQ {
    static constexpr bool PERM = true;
    bf16* pq; const float* ss;
    __device__ __forceinline__ void operator()(const f32x4 (&acc)[2][2][4][2], const pg8::Unit& u, int wr, int wc, int fr, int fq) const {
        const int row0 = u.pm * 256 + wr * 64 + fr, col0 = u.pn * 256 + wc * 32 + 8 * fq;
#pragma unroll
        for (int ai = 0; ai < 2; ++ai)
#pragma unroll
            for (int m = 0; m < 4; ++m) { const int row = row0 + ai * 128 + m * 16; bf16* rowp = pq + (size_t)row * 2048 + col0;
                const float r = rsqrtf(ss[row] * (1.f / DM) + EPS);
#pragma unroll
                for (int bj = 0; bj < 2; ++bj) { const f32x4 v0 = acc[ai][bj][m][0] * r, v1 = acc[ai][bj][m][1] * r;
                    v4u w; w.x = pg8::cvt_pk_bf16(v0[0], v0[1]); w.y = pg8::cvt_pk_bf16(v0[2], v0[3]); w.z = pg8::cvt_pk_bf16(v1[0], v1[1]); w.w = pg8::cvt_pk_bf16(v1[2], v1[3]);
                    *(v4u*)(rowp + bj * 128) = w; } }
    }
};

template <bool PB> __device__ __forceinline__ void lru_phase(Frame& F) {
    const bf16* XL = (const bf16*)(F.ws + WS_XL); const bf16* LG = (const bf16*)(F.ws + WS_LG); bf16* YL = (bf16*)F.out;
    f32x2* AGG = (f32x2*)(F.ws + WS_AGG);
    const bf16* WL = (const bf16*)(F.ws + WS_WLRU);
    const float* cw = F.in[10]; const float* cb = F.in[11];
    unsigned char* LA0 = F.ws + WS_K; unsigned char* LA1 = LA0 + (size_t)MTOK * DM; bf16* LU0 = (bf16*)F.out; bf16* LU1 = LU0 + (size_t)MTOK * DM;
    v2u ra[2]; v4u ru[2];
    constexpr int O_XCB = 0, O_XCF = 17408, O_A = 51200, O_U = 84992, FST = 528;
    LAS unsigned char* L = F.lds;
    const int tid = F.tid, lane = F.lane, w = F.wave, fr = lane & 15, fq = lane >> 4;
    int cur_blk = -1;
    bf16x8 wf[2][2][4];
    f32x4 br4[2], bi4[2], sp4[2];
    v4u rawreg[3];
#define RAW_LOAD(bb, tt0, bk) do { _Pragma("unroll") for (int r_ = 0; r_ < 3; ++r_) { const int e_ = tid + NTHR * r_, row_ = e_ >> 4, c16_ = e_ & 15, t_ = (tt0) - 2 + row_; \
            v4u v_ = {0u, 0u, 0u, 0u}; if (e_ < 68 * 16 && t_ >= 0 && t_ < SEQ) v_ = *(const v4u*)(XL + ((size_t)(bb) * SEQ + t_) * DM + (bk) * 128 + c16_ * 8); rawreg[r_] = v_; } } while (0)
#define PB_LOAD(ii, dd) do { const int idx_ = (ii) * F.G + F.bid; if (idx_ < 4096) { const int j_ = idx_ >> 3; const size_t mr_ = (size_t)(j_ >> 6) * SEQ + (j_ & 63) * 64; \
            _Pragma("unroll") for (int r_ = 0; r_ < 2; ++r_) { const int e_ = tid + NTHR * r_; const size_t o_ = (mr_ + (e_ >> 4)) * DM + (idx_ & 7) * 128 + (e_ & 15) * 8; \
                ra[r_] = *(const v2u*)(((dd) ? LA1 : LA0) + o_); ru[r_] = *(const v4u*)(((dd) ? LU1 : LU0) + o_); } } } while (0)
    constexpr int O_CARRY = 118784, O_CW = 135168, O_SUB = 137728;
    const bool carry_tab = PB && (F.G == 256);
    if (carry_tab) {
        const int ch = tid & 127, bq = tid >> 7, s0 = F.bid >> 3, blk0 = F.bid & 7;
        LAS float* CT = (LAS float*)(L + O_CARRY);
#define FOLD(agp, j0, j1, stp, hv) do { int js_ = (j0); const int n_ = ((j1) - (j0)) * (stp); int k_ = 0; \
            for (; k_ + 8 <= n_; k_ += 8) { f32x2 ah_[8]; _Pragma("unroll") for (int q_ = 0; q_ < 8; ++q_) ah_[q_] = (agp)[(size_t)(js_ + q_ * (stp)) * 2 * DM]; \
                _Pragma("unroll") for (int q_ = 0; q_ < 8; ++q_) hv = ah_[q_][0] * hv + ah_[q_][1]; js_ += 8 * (stp); } \
            for (; k_ < n_; ++k_) { const f32x2 a1_ = (agp)[(size_t)js_ * 2 * DM]; hv = a1_[0] * hv + a1_[1]; js_ += (stp); } } while (0)
        for (int bb = 2 * bq; bb < 2 * bq + 2; ++bb) {
            const f32x2* ag0 = AGG + ((size_t)(bb * 64) * 2 + 0) * DM + blk0 * 128 + ch; const f32x2* ag1 = AGG + ((size_t)(bb * 64) * 2 + 1) * DM + blk0 * 128 + ch;
            float h = 0.f;
            FOLD(ag0, 0, s0, 1, h); CT[((bb * 2 + 0) * 2 + 0) * 128 + ch] = h;
            FOLD(ag0, s0, s0 + 32, 1, h); CT[((bb * 2 + 1) * 2 + 0) * 128 + ch] = h;
            h = 0.f;
            FOLD(ag1, 63, s0 + 32, -1, h); CT[((bb * 2 + 1) * 2 + 1) * 128 + ch] = h;
            FOLD(ag1, s0 + 32, s0, -1, h); CT[((bb * 2 + 0) * 2 + 1) * 128 + ch] = h;
        }
        __syncthreads();
#undef FOLD
    }
    for (int i = 0;; ++i) {
        const int idx = i * F.G + F.bid; if (idx >= 4096) break;
        const int blk = idx & 7, j = idx >> 3, b = j >> 6, seg = j & 63, t0 = seg * 64;
        const size_t mrow0 = (size_t)b * SEQ + t0;
        if (!PB && blk != cur_blk) {
            cur_blk = blk;
#pragma unroll
            for (int d = 0; d < 2; ++d) {
#pragma unroll
                for (int g = 0; g < 2; ++g)
#pragma unroll
                    for (int ks = 0; ks < 4; ++ks)
                        wf[d][g][ks] = *(const bf16x8*)(WL + ((size_t)((d * 8 + blk) * 2 + g) * 128 + 16 * w + fr) * 128 + 32 * ks + 8 * fq);
                const int ch = blk * 128 + 16 * w + 4 * fq;
                br4[d] = *(const f32x4*)(F.in[13] + d * DM + ch); bi4[d] = *(const f32x4*)(F.in[15] + d * DM + ch);
                const f32x4 lm = *(const f32x4*)(F.in[16] + d * DM + ch);
#pragma unroll
                for (int e = 0; e < 4; ++e) sp4[d][e] = -8.f * 1.44269504089f * softplusf_(-lm[e]);
            }
            __syncthreads();
            for (int e = tid; e < 5 * 128; e += NTHR) { const int jt = e >> 7, cc = e & 127; ((LAS float*)(L + O_CW))[e] = (jt < 4) ? cw[jt * DM + blk * 128 + cc] : cb[blk * 128 + cc]; }
        }
        v4u lgreg[2];
        if (PB) {
            if (i == 0) PB_LOAD(0, 0);
#pragma unroll
            for (int r = 0; r < 2; ++r) { const int e = tid + NTHR * r; lgreg[r] = *(const v4u*)(LG + (mrow0 + (e >> 4)) * DM + blk * 128 + (e & 15) * 8); }
        } else {
        if (i == 0) RAW_LOAD(b, t0, blk);
#pragma unroll
        for (int r = 0; r < 3; ++r) { const int e = tid + NTHR * r; if (e < 68 * 16) *(LAS v4u*)(L + O_A + (e >> 4) * 256 + (e & 15) * 16) = rawreg[r]; }
        __syncthreads();
        { const int idx2 = (i + 1) * F.G + F.bid; if (idx2 < 4096) { const int j2 = idx2 >> 3; RAW_LOAD(j2 >> 6, (j2 & 63) * 64, idx2 & 7); } }
        for (int e = tid; e < 64 * 16; e += NTHR) { const int tl = e >> 4, c16 = e & 15;
            float y[8];
            { const f32x4 a = *(const LAS f32x4*)(L + O_CW + 4 * 512 + c16 * 32), bq = *(const LAS f32x4*)(L + O_CW + 4 * 512 + c16 * 32 + 16); y[0] = a[0]; y[1] = a[1]; y[2] = a[2]; y[3] = a[3]; y[4] = bq[0]; y[5] = bq[1]; y[6] = bq[2]; y[7] = bq[3]; }
#pragma unroll
            for (int jt = 0; jt < 4; ++jt) { const v4u r = *(const LAS v4u*)(L + O_A + (tl + jt) * 256 + c16 * 16);
                const f32x4 wa = *(const LAS f32x4*)(L + O_CW + jt * 512 + c16 * 32), wb = *(const LAS f32x4*)(L + O_CW + jt * 512 + c16 * 32 + 16);
                y[0] += wa[0] * bflo(r.x); y[1] += wa[1] * bfhi(r.x); y[2] += wa[2] * bflo(r.y); y[3] += wa[3] * bfhi(r.y);
                y[4] += wb[0] * bflo(r.z); y[5] += wb[1] * bfhi(r.z); y[6] += wb[2] * bflo(r.w); y[7] += wb[3] * bfhi(r.w); }
            *(LAS f32x4*)(L + O_XCF + tl * FST + c16 * 32) = (f32x4){y[0], y[1], y[2], y[3]};
            *(LAS f32x4*)(L + O_XCF + tl * FST + c16 * 32 + 16) = (f32x4){y[4], y[5], y[6], y[7]};
            v4u o; o.x = pk2(y[0], y[1]); o.y = pk2(y[2], y[3]); o.z = pk2(y[4], y[5]); o.w = pk2(y[6], y[7]);
            *(LAS v4u*)(L + O_XCB + tl * 272 + c16 * 16) = o; }
        __syncthreads();
        }
        float carry0 = 0.f, carry1 = 0.f;
        if (carry_tab) { const LAS float* CT = (const LAS float*)(L + O_CARRY); carry0 = CT[((b * 2 + (seg >> 5)) * 2 + 0) * 128 + (tid & 127)]; carry1 = CT[((b * 2 + (seg >> 5)) * 2 + 1) * 128 + (tid & 127)]; }
        else if (PB) {
            const int ch = blk * 128 + (tid & 127);
            float h = 0.f;
            const f32x2* ag0 = AGG + ((size_t)(b * 64) * 2 + 0) * DM + ch; const f32x2* ag1 = AGG + ((size_t)(b * 64) * 2 + 1) * DM + ch;
            int js = 0;
            for (; js + 8 <= seg; js += 8) { f32x2 ah[8];
#pragma unroll
                for (int q = 0; q < 8; ++q) ah[q] = ag0[(size_t)(js + q) * 2 * DM];
#pragma unroll
                for (int q = 0; q < 8; ++q) h = ah[q][0] * h + ah[q][1]; }
            for (; js < seg; ++js) { const f32x2 ah = ag0[(size_t)js * 2 * DM]; h = ah[0] * h + ah[1]; }
            carry0 = h; h = 0.f;
            js = 63;
            for (; js - 8 >= seg; js -= 8) { f32x2 ah[8];
#pragma unroll
                for (int q = 0; q < 8; ++q) ah[q] = ag1[(size_t)(js - q) * 2 * DM];
#pragma unroll
                for (int q = 0; q < 8; ++q) h = ah[q][0] * h + ah[q][1]; }
            for (; js > seg; --js) { const f32x2 ah = ag1[(size_t)js * 2 * DM]; h = ah[0] * h + ah[1]; }
            carry1 = h;
        }
#pragma unroll
        for (int d = 0; d < 2; ++d) {
            const int o_a = (d == 0) ? O_A : O_XCF;
            if (PB) {
#pragma unroll
                for (int r = 0; r < 2; ++r) { const int e = tid + NTHR * r, row = e >> 4, c16 = e & 15;
                    const f32x2 x0 = __builtin_amdgcn_cvt_pk_f32_fp8((int)ra[r].x, false), x1 = __builtin_amdgcn_cvt_pk_f32_fp8((int)ra[r].x, true);
                    const f32x2 x2 = __builtin_amdgcn_cvt_pk_f32_fp8((int)ra[r].y, false), x3 = __builtin_amdgcn_cvt_pk_f32_fp8((int)ra[r].y, true);
                    constexpr float IS = 1.f / 4096.f;
                    *(LAS f32x4*)(L + o_a + row * FST + c16 * 32) = (f32x4){1.f - x0[0] * IS, 1.f - x0[1] * IS, 1.f - x1[0] * IS, 1.f - x1[1] * IS};
                    *(LAS f32x4*)(L + o_a + row * FST + c16 * 32 + 16) = (f32x4){1.f - x2[0] * IS, 1.f - x2[1] * IS, 1.f - x3[0] * IS, 1.f - x3[1] * IS};
                    *(LAS f32x4*)(L + O_U + row * FST + c16 * 32) = (f32x4){bflo(ru[r].x), bfhi(ru[r].x), bflo(ru[r].y), bfhi(ru[r].y)};
                    *(LAS f32x4*)(L + O_U + row * FST + c16 * 32 + 16) = (f32x4){bflo(ru[r].z), bfhi(ru[r].z), bflo(ru[r].w), bfhi(ru[r].w)}; }
                if (d == 0) PB_LOAD(i, 1); else PB_LOAD(i + 1, 0);
            } else {
            f32x4 aR[4], aI[4];
#pragma unroll
            for (int mt = 0; mt < 4; ++mt) { aR[mt] = (f32x4){0.f, 0.f, 0.f, 0.f}; aI[mt] = (f32x4){0.f, 0.f, 0.f, 0.f}; }
#pragma unroll
            for (int ks = 0; ks < 4; ++ks)
#pragma unroll
                for (int mt = 0; mt < 4; ++mt) { const bf16x8 xb = *(const LAS bf16x8*)(L + O_XCB + (16 * mt + fr) * 272 + (32 * ks + 8 * fq) * 2);
                    aR[mt] = __builtin_amdgcn_mfma_f32_16x16x32_bf16(wf[d][0][ks], xb, aR[mt], 0, 0, 0);
                    aI[mt] = __builtin_amdgcn_mfma_f32_16x16x32_bf16(wf[d][1][ks], xb, aI[mt], 0, 0, 0); }
#pragma unroll
            for (int mt = 0; mt < 4; ++mt) { const int tl = 16 * mt + fr, cl = 16 * w + 4 * fq;
                const f32x4 xc = *(const LAS f32x4*)(L + O_XCF + tl * FST + cl * 4);
                f32x4 av, uv;
#pragma unroll
                for (int e = 0; e < 4; ++e) { const float r = sigmoidf_(aR[mt][e] + br4[d][e]), ig = sigmoidf_(aI[mt][e] + bi4[d][e]);
                    const float a_ = __builtin_amdgcn_exp2f(r * sp4[d][e]); av[e] = a_; uv[e] = __builtin_amdgcn_sqrtf(fmaxf(1.f - a_ * a_, 0.f)) * (ig * xc[e]); }
                *(LAS f32x4*)(L + o_a + tl * FST + cl * 4) = av; *(LAS f32x4*)(L + O_U + tl * FST + cl * 4) = uv;
                { const size_t go = (mrow0 + tl) * DM + blk * 128 + cl;
                  int xa = 0; xa = __builtin_amdgcn_cvt_pk_fp8_f32((1.f - av[0]) * 4096.f, (1.f - av[1]) * 4096.f, xa, false); xa = __builtin_amdgcn_cvt_pk_fp8_f32((1.f - av[2]) * 4096.f, (1.f - av[3]) * 4096.f, xa, true);
                  v2u xu; xu.x = pk2(uv[0], uv[1]); xu.y = pk2(uv[2], uv[3]);
                  *(unsigned*)((d ? LA1 : LA0) + go) = (unsigned)xa; *(v2u*)((d ? LU1 : LU0) + go) = xu; } }
            }
            __syncthreads();
            {
                const int c = tid & 127, sub = tid >> 7;
                LAS float* pa = (LAS float*)(L + o_a) + c; const LAS float* pu = (const LAS float*)(L + O_U) + c;
                LAS f32x2* SUBT = (LAS f32x2*)(L + O_SUB);
                float h = 0.f, A = 1.f;
#pragma unroll
                for (int s2 = 0; s2 < 16; ++s2) { const int tl = d ? (16 * sub + 15 - s2) : (16 * sub + s2); const float a = pa[tl * 132], u = pu[tl * 132]; h = a * h + u; A *= a; }
                SUBT[sub * 128 + c] = (f32x2){A, h};
                __syncthreads();
                if (!PB) {
                    if (sub == 0) { float HH = 0.f, AA = 1.f;
#pragma unroll
                        for (int q = 0; q < 4; ++q) { const f32x2 ah = SUBT[(d ? 3 - q : q) * 128 + c]; HH = ah[0] * HH + ah[1]; AA *= ah[0]; }
                        AGG[((size_t)(b * 64 + seg) * 2 + d) * DM + blk * 128 + c] = (f32x2){AA, HH}; }
                } else {
                    float hc = d ? carry1 : carry0;
#pragma unroll
                    for (int q = 0; q < 3; ++q) { const int jq = d ? 3 - q : q; const f32x2 ah = SUBT[jq * 128 + c]; if (d ? (jq > sub) : (jq < sub)) hc = ah[0] * hc + ah[1]; }
                    if (d == 0) {
#pragma unroll
                        for (int s2 = 0; s2 < 16; ++s2) { const int tl = 16 * sub + s2; hc = pa[tl * 132] * hc + pu[tl * 132]; pa[tl * 132] = hc; }
                    } else { LAS float* ph = (LAS float*)(L + O_A) + c;
#pragma unroll
                        for (int s2 = 0; s2 < 16; ++s2) { const int tl = 16 * sub + 15 - s2; hc = pa[tl * 132] * hc + pu[tl * 132]; ph[tl * 132] += hc; } }
                }
            }
            __syncthreads();
        }
        if (PB) {
#pragma unroll
            for (int r = 0; r < 2; ++r) { const int e = tid + NTHR * r, row = e >> 4, c16 = e & 15;
                const v4u g = lgreg[r];
                const f32x4 h0 = *(const LAS f32x4*)(L + O_A + row * FST + c16 * 32), h1 = *(const LAS f32x4*)(L + O_A + row * FST + c16 * 32 + 16);
                v4u o;
                o.x = pk2(h0[0] * gelu_fast(bflo(g.x)), h0[1] * gelu_fast(bfhi(g.x))); o.y = pk2(h0[2] * gelu_fast(bflo(g.y)), h0[3] * gelu_fast(bfhi(g.y)));
                o.z = pk2(h1[0] * gelu_fast(bflo(g.z)), h1[1] * gelu_fast(bfhi(g.z))); o.w = pk2(h1[2] * gelu_fast(bflo(g.w)), h1[3] * gelu_fast(bfhi(g.w)));
                *(v4u*)(YL + (mrow0 + row) * DM + blk * 128 + c16 * 8) = o; }
            __syncthreads();
        }
    }
#undef RAW_LOAD
#undef PB_LOAD
}

__device__ __forceinline__ void mconv_phase(Frame& F) {
    const bf16* XM = (const bf16*)(F.ws + WS_XM); bf16* XC = (bf16*)F.out + (size_t)MTOK * DM;
    const float* cw = F.in[4]; const float* cb = F.in[5];
    const int NT = MTOK / 32 * 128;
    for (int g = F.bid * NTHR + F.tid; g < NT; g += F.G * NTHR) {
        const int chunk = g & 127, run = g >> 7, c0 = chunk * 8, m0 = run * 32, t0 = m0 & (SEQ - 1);
        float w[4][8], bias[8];
#pragma unroll
        for (int j = 0; j < 4; ++j) { const f32x4 a = *(const f32x4*)(cw + j * DM + c0), b = *(const f32x4*)(cw + j * DM + c0 + 4);
            w[j][0] = a[0]; w[j][1] = a[1]; w[j][2] = a[2]; w[j][3] = a[3]; w[j][4] = b[0]; w[j][5] = b[1]; w[j][6] = b[2]; w[j][7] = b[3]; }
        { const f32x4 a = *(const f32x4*)(cb + c0), b = *(const f32x4*)(cb + c0 + 4);
            bias[0] = a[0]; bias[1] = a[1]; bias[2] = a[2]; bias[3] = a[3]; bias[4] = b[0]; bias[5] = b[1]; bias[6] = b[2]; bias[7] = b[3]; }
        v4u win[4];
        const v4u zero = {0u, 0u, 0u, 0u};
        win[0] = zero;
        win[1] = (t0 >= 2) ? *(const v4u*)(XM + (size_t)(m0 - 2) * DM + c0) : zero;
        win[2] = (t0 >= 1) ? *(const v4u*)(XM + (size_t)(m0 - 1) * DM + c0) : zero;
        win[3] = *(const v4u*)(XM + (size_t)m0 * DM + c0);
#pragma unroll 4
        for (int i = 0; i < 32; ++i) {
            win[0] = win[1]; win[1] = win[2]; win[2] = win[3];
            win[3] = (t0 + i + 1 < SEQ) ? *(const v4u*)(XM + (size_t)(m0 + i + 1) * DM + c0) : zero;
            float y[8];
#pragma unroll
            for (int e = 0; e < 8; ++e) y[e] = bias[e];
#pragma unroll
            for (int j = 0; j < 4; ++j) {
                const unsigned p0 = win[j].x, p1 = win[j].y, p2 = win[j].z, p3 = win[j].w;
                y[0] += w[j][0] * bflo(p0); y[1] += w[j][1] * bfhi(p0); y[2] += w[j][2] * bflo(p1); y[3] += w[j][3] * bfhi(p1);
                y[4] += w[j][4] * bflo(p2); y[5] += w[j][5] * bfhi(p2); y[6] += w[j][6] * bflo(p3); y[7] += w[j][7] * bfhi(p3);
            }
#pragma unroll
            for (int e = 0; e < 8; ++e) y[e] = y[e] * sigmoidf_(y[e]);
            v4u o; o.x = pk2(y[0], y[1]); o.y = pk2(y[2], y[3]); o.z = pk2(y[4], y[5]); o.w = pk2(y[6], y[7]);
            *(v4u*)(XC + (size_t)(m0 + i) * DM + c0) = o;
        }
    }
}

typedef short s16x4 __attribute__((ext_vector_type(4)));
__device__ __forceinline__ bf16x8 tr_read_pair(unsigned a0, unsigned a1) {
    s16x4 r0, r1;
    asm volatile("ds_read_b64_tr_b16 %0, %2\n\tds_read_b64_tr_b16 %1, %3\n\ts_waitcnt lgkmcnt(0)" : "=&v"(r0), "=&v"(r1) : "v"(a0), "v"(a1) : "memory");
    return __builtin_shufflevector(r0, r1, 0, 1, 2, 3, 4, 5, 6, 7);
}
__device__ __forceinline__ float dpp_shr(float oldv, float x, int n) {
    const int o = __builtin_bit_cast(int, oldv), v = __builtin_bit_cast(int, x);
    int r;
    if (n == 1) r = __builtin_amdgcn_update_dpp(o, v, 0x111, 0xf, 0xf, false);
    else if (n == 2) r = __builtin_amdgcn_update_dpp(o, v, 0x112, 0xf, 0xf, false);
    else if (n == 4) r = __builtin_amdgcn_update_dpp(o, v, 0x114, 0xf, 0xf, false);
    else r = __builtin_amdgcn_update_dpp(o, v, 0x118, 0xf, 0xf, false);
    return __builtin_bit_cast(float, r);
}
__device__ __forceinline__ float rdlane(float x, int l) { return __builtin_bit_cast(float, __builtin_amdgcn_readlane(__builtin_bit_cast(int, x), l)); }
__device__ __forceinline__ float wave_incl_sum(float x, int lane) {
    x += dpp_shr(0.f, x, 1); x += dpp_shr(0.f, x, 2); x += dpp_shr(0.f, x, 4); x += dpp_shr(0.f, x, 8);
    const float t0 = rdlane(x, 15), t1 = rdlane(x, 31), t2 = rdlane(x, 47);
    return x + (lane >= 16 ? t0 : 0.f) + (lane >= 32 ? t1 : 0.f) + (lane >= 48 ? t2 : 0.f);
}
__device__ __forceinline__ float wave_incl_max(float x, int lane) {
    const float NI = -INFINITY;
    x = fmaxf(x, dpp_shr(NI, x, 1)); x = fmaxf(x, dpp_shr(NI, x, 2)); x = fmaxf(x, dpp_shr(NI, x, 4)); x = fmaxf(x, dpp_shr(NI, x, 8));
    const float t0 = rdlane(x, 15), t1 = rdlane(x, 31), t2 = rdlane(x, 47);
    return fmaxf(fmaxf(x, lane >= 16 ? t0 : NI), fmaxf(lane >= 32 ? t1 : NI, lane >= 48 ? t2 : NI));
}
__device__ __forceinline__ void mscan_phase(Frame& F) {
    const bf16* Q = (const bf16*)(F.ws + WS_LG); const bf16* K = (const bf16*)(F.ws + WS_K); const bf16* V = (const bf16*)(F.ws + WS_XL);
    const float* GT = (const float*)(F.ws + WS_GATE);
    constexpr int KS = 0, CTI = 33792, VT = 67584, VWT = 86016, PB = 104448, TAB = 113664, NT = 116736, NPART = 117760, DENT = 119808;
    constexpr int KST = 528, VST = 144, TABSZ = 1536;
    LAS unsigned char* L = F.lds;
    const int tid = F.tid, lane = F.lane, w = F.wave, fr = lane & 15, fq = lane >> 4, pt = w & 3, wg = w >> 2;
    for (int item = F.bid; item < 256; item += F.G) {
        const int es = item & 3, dir = (item >> 2) & 1, h = (item >> 3) & 3, b = item >> 5;
        bf16* H = dir ? ((bf16*)F.out + (size_t)MTOK * DM) : (bf16*)(F.ws + WS_XM);
        const size_t rowbase = (size_t)b * SEQ;
#define TOF(c, p) (dir ? (SEQ - 1 - 64 * (c) - (p)) : (64 * (c) + (p)))
        for (int e = tid; e < (33792 + 1024) / 4; e += NTHR) { if (e < 33792 / 4) ((LAS unsigned*)(L + CTI))[e] = 0u; else ((LAS unsigned*)(L + NT))[e - 33792 / 4] = 0u; }
        float m_run = 0.f;
        float gi_n = 0.f, gf_n = 0.f;
        if (w == 4) { const size_t m = rowbase + TOF(0, lane); gi_n = GT[m * 16 + dir * 8 + h]; gf_n = GT[m * 16 + dir * 8 + 4 + h]; }
#define G1_TABLES(setp) do { \
            const float logf_ = fminf(gf_n, 0.f) - __logf(1.f + __expf(-fabsf(gf_n))); const float b_ = wave_incl_sum(logf_, lane); const float a_ = gi_n - b_; \
            const float M_ = fmaxf(m_run, wave_incl_max(a_, lane)); const float Mend_ = rdlane(M_, 63), g_ = rdlane(b_, 63); \
            LAS float* T_ = (LAS float*)(setp); T_[lane] = a_; T_[64 + lane] = M_; T_[128 + lane] = __expf(m_run - M_); T_[192 + lane] = __expf(-(b_ + M_)); T_[256 + lane] = __expf(a_ - Mend_); \
            if (lane == 0) { T_[320] = __expf(m_run - Mend_); T_[321] = g_ + Mend_; } \
            m_run = g_ + Mend_; } while (0)
        if (w == 4) G1_TABLES(L + TAB);
        __syncthreads();
        bf16x8 qf[8];
        v4u kreg[4]; v4u vreg;
#define LOAD_KV(c) do { _Pragma("unroll") for (int r_ = 0; r_ < 4; ++r_) { const int i_ = tid + NTHR * r_, s_ = i_ >> 5, c16_ = i_ & 31; \
                kreg[r_] = *(const v4u*)(K + (rowbase + TOF(c, s_)) * DM + h * 256 + c16_ * 8); } \
            { const int s_ = tid & 63, e8_ = tid >> 6; vreg = *(const v4u*)(V + (rowbase + TOF(c, s_)) * DM + h * 256 + es * 64 + e8_ * 8); } } while (0)
#define STORE_KV(setidx) do { _Pragma("unroll") for (int r_ = 0; r_ < 4; ++r_) { const int i_ = tid + NTHR * r_, s_ = i_ >> 5, c16_ = i_ & 31; \
                *(LAS v4u*)(L + KS + s_ * KST + c16_ * 16) = kreg[r_]; } \
            { const int s_ = tid & 63, e8_ = tid >> 6; const float ws_ = ((const LAS float*)(L + TAB + (setidx) * TABSZ))[256 + s_]; \
              LAS bf16* vt_ = (LAS bf16*)(L + VT + (setidx) * 9216); LAS bf16* vw_ = (LAS bf16*)(L + VWT + (setidx) * 9216); \
              const unsigned wv_[4] = {vreg.x, vreg.y, vreg.z, vreg.w}; \
              _Pragma("unroll") for (int j_ = 0; j_ < 4; ++j_) { const float lo_ = bflo(wv_[j_]), hi_ = bfhi(wv_[j_]); const int e_ = e8_ * 8 + 2 * j_; \
                vt_[e_ * 72 + s_] = (bf16)(wv_[j_] & 0xffffu); vt_[(e_ + 1) * 72 + s_] = (bf16)(wv_[j_] >> 16); \
                vw_[e_ * 72 + s_] = (bf16)f2bf(lo_ * ws_); vw_[(e_ + 1) * 72 + s_] = (bf16)f2bf(hi_ * ws_); } } } while (0)
#define LOAD_Q(c) do { const size_t m_ = rowbase + TOF(c, 16 * pt + fr); _Pragma("unroll") for (int ks_ = 0; ks_ < 8; ++ks_) \
                qf[ks_] = *(const bf16x8*)(Q + m_ * DM + h * 256 + 32 * ks_ + 8 * fq); } while (0)
        LOAD_KV(0); LOAD_Q(0);
        STORE_KV(0);
        f32x4 Cacc[8], Nacc[2];
#pragma unroll
        for (int i = 0; i < 8; ++i) Cacc[i] = (f32x4){0.f, 0.f, 0.f, 0.f};
        Nacc[0] = (f32x4){0.f, 0.f, 0.f, 0.f}; Nacc[1] = (f32x4){0.f, 0.f, 0.f, 0.f};
        __syncthreads();
        for (int c = 0; c < 64; ++c) {
            const int cur = c & 1, nxt = cur ^ 1;
            const bool has_next = (c + 1 < 64);
            const LAS float* T = (const LAS float*)(L + TAB + cur * TABSZ);
            if (has_next) { LOAD_KV(c + 1); if (w == 4) { const size_t m = rowbase + TOF(c + 1, lane); gi_n = GT[m * 16 + dir * 8 + h]; gf_n = GT[m * 16 + dir * 8 + 4 + h]; } }
            const int p = 16 * pt + fr;
            const float Mp = T[64 + p], wi_p = T[128 + p];
            float cs = 0.f;
            f32x4 O[2] = {(f32x4){0.f, 0.f, 0.f, 0.f}, (f32x4){0.f, 0.f, 0.f, 0.f}}, sa[2] = {(f32x4){0.f, 0.f, 0.f, 0.f}, (f32x4){0.f, 0.f, 0.f, 0.f}};
            const bool s0on = (2 * wg <= pt), s1on = (2 * wg + 1 <= pt);
#define KF(i, ks) (*(const LAS bf16x8*)(L + KS + (16 * (2 * wg + (i)) + fr) * KST + (32 * (ks) + 8 * fq) * 2))
#define CF(i, ks) (*(const LAS bf16x8*)(L + CTI + (16 * (2 * wg + (i)) + fr) * KST + (32 * (ks) + 8 * fq) * 2))
            if (s1on) {
#pragma unroll
                for (int ks = 0; ks < 8; ++ks) { const bf16x8 k0 = KF(0, ks), k1 = KF(1, ks), c0 = CF(0, ks), c1 = CF(1, ks);
                    sa[0] = __builtin_amdgcn_mfma_f32_16x16x32_bf16(k0, qf[ks], sa[0], 0, 0, 0); sa[1] = __builtin_amdgcn_mfma_f32_16x16x32_bf16(k1, qf[ks], sa[1], 0, 0, 0);
                    O[0] = __builtin_amdgcn_mfma_f32_16x16x32_bf16(c0, qf[ks], O[0], 0, 0, 0); O[1] = __builtin_amdgcn_mfma_f32_16x16x32_bf16(c1, qf[ks], O[1], 0, 0, 0); }
            } else if (s0on) {
#pragma unroll
                for (int ks = 0; ks < 8; ++ks) { const bf16x8 k0 = KF(0, ks), c0 = CF(0, ks), c1 = CF(1, ks);
                    sa[0] = __builtin_amdgcn_mfma_f32_16x16x32_bf16(k0, qf[ks], sa[0], 0, 0, 0);
                    O[0] = __builtin_amdgcn_mfma_f32_16x16x32_bf16(c0, qf[ks], O[0], 0, 0, 0); O[1] = __builtin_amdgcn_mfma_f32_16x16x32_bf16(c1, qf[ks], O[1], 0, 0, 0); }
            } else {
#pragma unroll
                for (int ks = 0; ks < 8; ++ks) { const bf16x8 c0 = CF(0, ks), c1 = CF(1, ks);
                    O[0] = __builtin_amdgcn_mfma_f32_16x16x32_bf16(c0, qf[ks], O[0], 0, 0, 0); O[1] = __builtin_amdgcn_mfma_f32_16x16x32_bf16(c1, qf[ks], O[1], 0, 0, 0); }
            }
#undef KF
#undef CF
#pragma unroll
            for (int i = 0; i < 2; ++i) { const int st = 2 * wg + i;
                v2u pw = {0u, 0u};
                if (i ? s1on : s0on) {
                    const f32x4 a4 = *(const LAS f32x4*)(T + 16 * st + 4 * fq);
                    float pv[4];
#pragma unroll
                    for (int r = 0; r < 4; ++r) { const int s_ = 16 * st + 4 * fq + r; const float wgt = (s_ <= p) ? __expf(a4[r] - Mp) : 0.f; pv[r] = sa[i][r] * wgt; cs += pv[r]; }
                    pw.x = pk2(pv[0], pv[1]); pw.y = pk2(pv[2], pv[3]);
                }
                *(LAS v2u*)(L + PB + p * VST + (16 * st + 4 * fq) * 2) = pw; }
            float di = 0.f;
#define DEN_INTER(ks) do { const f32x4 n0 = *(const LAS f32x4*)(L + NT + (32 * (ks) + 8 * fq) * 4), n1 = *(const LAS f32x4*)(L + NT + (32 * (ks) + 8 * fq) * 4 + 16); \
                const v4u qw = __builtin_bit_cast(v4u, qf[ks]); \
                di += bflo(qw.x) * n0[0] + bfhi(qw.x) * n0[1] + bflo(qw.y) * n0[2] + bfhi(qw.y) * n0[3] + bflo(qw.z) * n1[0] + bfhi(qw.z) * n1[1] + bflo(qw.w) * n1[2] + bfhi(qw.w) * n1[3]; } while (0)
            if (wg == 0) { DEN_INTER(0); DEN_INTER(1); DEN_INTER(2); DEN_INTER(3); }
            else { DEN_INTER(4); DEN_INTER(5); DEN_INTER(6); DEN_INTER(7); }
#undef DEN_INTER
            di += __shfl_xor(di, 16); di += __shfl_xor(di, 32);
            cs += __shfl_xor(cs, 16); cs += __shfl_xor(cs, 32);
            if (fq == 0) ((LAS float*)(L + DENT))[wg * 64 + p] = wi_p * di + cs;
            if (has_next) LOAD_Q(c + 1);
            if (has_next && w == 4) G1_TABLES(L + TAB + nxt * TABSZ);
            __syncthreads();
#pragma unroll
            for (int i = 0; i < 2; ++i) { const int et = 2 * wg + i; O[i] = O[i] * wi_p;
#pragma unroll
                for (int ks = 0; ks < 2; ++ks) { const bf16x8 vf = *(const LAS bf16x8*)(L + VT + cur * 9216 + (16 * et + fr) * VST + (32 * ks + 8 * fq) * 2);
                    const bf16x8 pf = *(const LAS bf16x8*)(L + PB + p * VST + (32 * ks + 8 * fq) * 2);
                    O[i] = __builtin_amdgcn_mfma_f32_16x16x32_bf16(vf, pf, O[i], 0, 0, 0); } }
            { const float den = ((const LAS float*)(L + DENT))[p] + ((const LAS float*)(L + DENT))[64 + p];
              const float inv = 1.f / fmaxf(fabsf(den), T[192 + p]);
              const size_t m = rowbase + TOF(c, p);
#pragma unroll
              for (int i = 0; i < 2; ++i) { const int et = 2 * wg + i; v2u o; o.x = pk2(O[i][0] * inv, O[i][1] * inv); o.y = pk2(O[i][2] * inv, O[i][3] * inv);
                  *(v2u*)(H + m * DM + h * 256 + es * 64 + 16 * et + 4 * fq) = o; } }
            { const float decay = T[320];
              const bf16x8 vw0 = *(const LAS bf16x8*)(L + VWT + cur * 9216 + (16 * pt + fr) * VST + (8 * fq) * 2);
              const bf16x8 vw1 = *(const LAS bf16x8*)(L + VWT + cur * 9216 + (16 * pt + fr) * VST + (32 + 8 * fq) * 2);
              bf16x8 wsf0, wsf1;
              { const f32x4 w0 = *(const LAS f32x4*)(T + 256 + 8 * fq), w1 = *(const LAS f32x4*)(T + 256 + 8 * fq + 4), w2 = *(const LAS f32x4*)(T + 288 + 8 * fq), w3 = *(const LAS f32x4*)(T + 288 + 8 * fq + 4);
                const bool c0 = (fr == 0);
                v4u a, b; a.x = c0 ? pk2(w0[0], w0[1]) : 0u; a.y = c0 ? pk2(w0[2], w0[3]) : 0u; a.z = c0 ? pk2(w1[0], w1[1]) : 0u; a.w = c0 ? pk2(w1[2], w1[3]) : 0u;
                b.x = c0 ? pk2(w2[0], w2[1]) : 0u; b.y = c0 ? pk2(w2[2], w2[3]) : 0u; b.z = c0 ? pk2(w3[0], w3[1]) : 0u; b.w = c0 ? pk2(w3[2], w3[3]) : 0u;
                wsf0 = __builtin_bit_cast(bf16x8, a); wsf1 = __builtin_bit_cast(bf16x8, b); }
              const int l16 = lane & 15, q4 = l16 >> 2, p4 = l16 & 3;
              const unsigned kb = (unsigned)(uintptr_t)(L + KS) + (unsigned)((8 * fq + q4) * KST + 4 * p4 * 2);
#define TR_READS "ds_read_b64_tr_b16 %0, %[ad]\n\tds_read_b64_tr_b16 %1, %[ad] offset:2112\n\tds_read_b64_tr_b16 %2, %[ad] offset:16896\n\tds_read_b64_tr_b16 %3, %[ad] offset:19008\n\t" \
                 "ds_read_b64_tr_b16 %4, %[ad] offset:32\n\tds_read_b64_tr_b16 %5, %[ad] offset:2144\n\tds_read_b64_tr_b16 %6, %[ad] offset:16928\n\tds_read_b64_tr_b16 %7, %[ad] offset:19040"
#define TR_OUT(R) "=&v"(R[0]), "=&v"(R[1]), "=&v"(R[2]), "=&v"(R[3]), "=&v"(R[4]), "=&v"(R[5]), "=&v"(R[6]), "=&v"(R[7])
#define TR_INOUT(R) "+v"(R[0]), "+v"(R[1]), "+v"(R[2]), "+v"(R[3]), "+v"(R[4]), "+v"(R[5]), "+v"(R[6]), "+v"(R[7])
              s16x4 rA[8], rB[8];
              { const unsigned a0 = kb + (8 * wg) * 32; asm volatile(TR_READS : TR_OUT(rA) : [ad] "v"(a0) : "memory"); }
#define C_STEP(dtl, RC, RN) do { \
                  if ((dtl) < 6) { const unsigned a1 = kb + (8 * wg + (dtl) + 2) * 32; asm volatile(TR_READS "\n\ts_waitcnt lgkmcnt(8)" : TR_OUT(RN), TR_INOUT(RC) : [ad] "v"(a1) : "memory"); } \
                  else asm volatile("s_waitcnt lgkmcnt(0)" : TR_INOUT(RC) : : "memory"); \
                  const bf16x8 k0 = __builtin_shufflevector(RC[0], RC[1], 0, 1, 2, 3, 4, 5, 6, 7), k1 = __builtin_shufflevector(RC[2], RC[3], 0, 1, 2, 3, 4, 5, 6, 7); \
                  const bf16x8 k2 = __builtin_shufflevector(RC[4], RC[5], 0, 1, 2, 3, 4, 5, 6, 7), k3 = __builtin_shufflevector(RC[6], RC[7], 0, 1, 2, 3, 4, 5, 6, 7); \
                  Cacc[dtl] = Cacc[dtl] * decay; Cacc[(dtl) + 1] = Cacc[(dtl) + 1] * decay; \
                  Cacc[dtl] = __builtin_amdgcn_mfma_f32_16x16x32_bf16(k0, vw0, Cacc[dtl], 0, 0, 0); \
                  Cacc[(dtl) + 1] = __builtin_amdgcn_mfma_f32_16x16x32_bf16(k2, vw0, Cacc[(dtl) + 1], 0, 0, 0); \
                  Cacc[dtl] = __builtin_amdgcn_mfma_f32_16x16x32_bf16(k1, vw1, Cacc[dtl], 0, 0, 0); \
                  Cacc[(dtl) + 1] = __builtin_amdgcn_mfma_f32_16x16x32_bf16(k3, vw1, Cacc[(dtl) + 1], 0, 0, 0); \
                  if ((dtl) == 2 * pt) {                                            \
                      Nacc[0] = Nacc[0] * decay; Nacc[1] = Nacc[1] * decay; \
                      Nacc[0] = __builtin_amdgcn_mfma_f32_16x16x32_bf16(k0, wsf0, Nacc[0], 0, 0, 0); Nacc[1] = __builtin_amdgcn_mfma_f32_16x16x32_bf16(k2, wsf0, Nacc[1], 0, 0, 0); \
                      Nacc[0] = __builtin_amdgcn_mfma_f32_16x16x32_bf16(k1, wsf1, Nacc[0], 0, 0, 0); Nacc[1] = __builtin_amdgcn_mfma_f32_16x16x32_bf16(k3, wsf1, Nacc[1], 0, 0, 0); } } while (0)
              C_STEP(0, rA, rB); C_STEP(2, rB, rA); C_STEP(4, rA, rB); C_STEP(6, rB, rA);
#undef C_STEP
#undef TR_READS
#undef TR_OUT
#undef TR_INOUT
            }
            __syncthreads();
            { const float decay = T[320];
#pragma unroll
              for (int dtl = 0; dtl < 8; ++dtl) { const int dt = 8 * wg + dtl; v2u o; o.x = pk2(Cacc[dtl][0], Cacc[dtl][1]); o.y = pk2(Cacc[dtl][2], Cacc[dtl][3]);
                  *(LAS v2u*)(L + CTI + (16 * pt + fr) * KST + (16 * dt + 4 * fq) * 2) = o; }
              if (fr == 0) { *(LAS f32x4*)(L + NT + (16 * (8 * wg + 2 * pt) + 4 * fq) * 4) = Nacc[0]; *(LAS f32x4*)(L + NT + (16 * (8 * wg + 2 * pt + 1) + 4 * fq) * 4) = Nacc[1]; } }
            if (has_next) STORE_KV(nxt);
            __syncthreads();
        }
#undef TOF
#undef G1_TABLES
#undef LOAD_KV
#undef STORE_KV
#undef LOAD_Q
    }
}

__device__ __forceinline__ void ym_phase(Frame& F) {
    const bf16* HF = (const bf16*)(F.ws + WS_XM); const bf16* HB = (const bf16*)F.out + (size_t)MTOK * DM; bf16* OP = (bf16*)(F.ws + WS_OP);
    const float* ng = F.in[9];
    const int gw = F.bid * NWAVES + F.wave, NGW = F.G * NWAVES;
    for (int m = gw; m < MTOK; m += NGW) {
#pragma unroll
        for (int hd = 0; hd < 4; ++hd) {
            const size_t o = (size_t)m * DM + hd * 256 + F.lane * 4;
            const v2u a = *(const v2u*)(HF + o), b = *(const v2u*)(HB + o), op = *(const v2u*)(OP + o);
            const float v0 = bflo(a.x) + bflo(b.x), v1 = bfhi(a.x) + bfhi(b.x), v2 = bflo(a.y) + bflo(b.y), v3 = bfhi(a.y) + bfhi(b.y);
            const float r = rsqrtf(wave_sum((v0 * v0 + v1 * v1) + (v2 * v2 + v3 * v3)) * (1.f / 256.f) + EPS);
            const f32x4 g = *(const f32x4*)(ng + hd * 256 + F.lane * 4);
            v2u w; w.x = pk2(sigmoidf_(bflo(op.x)) * v0 * r * g[0], sigmoidf_(bfhi(op.x)) * v1 * r * g[1]);
            w.y = pk2(sigmoidf_(bflo(op.y)) * v2 * r * g[2], sigmoidf_(bfhi(op.y)) * v3 * r * g[3]);
            *(v2u*)(OP + o) = w;
        }
    }
    {
        float* usc = (float*)(F.ws + WS_LG + 16 * MiB); float* vsc = usc + NEXP;
        for (int row = gw; row < 2 * NEXP; row += NGW) {
            const bool isv = row >= NEXP; const int r = isv ? row - NEXP : row;
            const f32x4* src = (const f32x4*)(F.in[isv ? 24 : 23] + (size_t)r * DM) + F.lane * 4;
            f32x4 a[4]; float ss = 0.f;
#pragma unroll
            for (int j = 0; j < 4; ++j) { a[j] = src[j]; ss += (a[j][0] * a[j][0] + a[j][1] * a[j][1]) + (a[j][2] * a[j][2] + a[j][3] * a[j][3]); }
            const float rms = sqrtf(wave_sum(ss) * (1.f / DM));
            const float sc = fmaxf(rms * 0.5f, 1e-30f), inv = 1.f / sc;
            unsigned o[2] = {0u, 0u};
#pragma unroll
            for (int j = 0; j < 4; ++j) { const f32x4 q = a[j] * inv;
                if (j & 1) { o[j >> 1] = __builtin_amdgcn_cvt_scalef32_pk_fp4_f32(o[j >> 1], q[0], q[1], 1.0f, 2); o[j >> 1] = __builtin_amdgcn_cvt_scalef32_pk_fp4_f32(o[j >> 1], q[2], q[3], 1.0f, 3); }
                else       { o[j >> 1] = __builtin_amdgcn_cvt_scalef32_pk_fp4_f32(o[j >> 1], q[0], q[1], 1.0f, 0); o[j >> 1] = __builtin_amdgcn_cvt_scalef32_pk_fp4_f32(o[j >> 1], q[2], q[3], 1.0f, 1); } }
            *(v2u*)(F.ws + WS_LG + (isv ? 8 * MiB : 0) + (size_t)r * (DM / 2) + F.lane * 8) = (v2u){o[0], o[1]};
            if (F.lane == 0) (isv ? vsc : usc)[r] = sc;
        }
    }
}

typedef float f32x16 __attribute__((ext_vector_type(16)));
#define TOPK_INSERT(L, xv) do { const float x_ = (xv); \
    L[15] = __builtin_amdgcn_fmed3f(L[14], L[15], x_); L[14] = __builtin_amdgcn_fmed3f(L[13], L[14], x_); L[13] = __builtin_amdgcn_fmed3f(L[12], L[13], x_); L[12] = __builtin_amdgcn_fmed3f(L[11], L[12], x_); \
    L[11] = __builtin_amdgcn_fmed3f(L[10], L[11], x_); L[10] = __builtin_amdgcn_fmed3f(L[9], L[10], x_); L[9] = __builtin_amdgcn_fmed3f(L[8], L[9], x_); L[8] = __builtin_amdgcn_fmed3f(L[7], L[8], x_); \
    L[7] = __builtin_amdgcn_fmed3f(L[6], L[7], x_); L[6] = __builtin_amdgcn_fmed3f(L[5], L[6], x_); L[5] = __builtin_amdgcn_fmed3f(L[4], L[5], x_); L[4] = __builtin_amdgcn_fmed3f(L[3], L[4], x_); \
    L[3] = __builtin_amdgcn_fmed3f(L[2], L[3], x_); L[2] = __builtin_amdgcn_fmed3f(L[1], L[2], x_); L[1] = __builtin_amdgcn_fmed3f(L[0], L[1], x_); L[0] = fmaxf(L[0], x_); } while (0)
#define SEL_CE(L, a, b) do { const float hi_ = fmaxf(L[a], L[b]), lo_ = fminf(L[a], L[b]); L[a] = hi_; L[b] = lo_; } while (0)
#define SORT16_DESC(L) do { SEL_CE(L, 0, 1); SEL_CE(L, 2, 3); SEL_CE(L, 0, 2); SEL_CE(L, 1, 3); SEL_CE(L, 1, 2); SEL_CE(L, 4, 5); SEL_CE(L, 6, 7); SEL_CE(L, 4, 6); SEL_CE(L, 5, 7); SEL_CE(L, 5, 6); SEL_CE(L, 0, 4); SEL_CE(L, 2, 6); SEL_CE(L, 2, 4); SEL_CE(L, 1, 5); SEL_CE(L, 3, 7); SEL_CE(L, 3, 5); SEL_CE(L, 1, 2); SEL_CE(L, 3, 4); SEL_CE(L, 5, 6); SEL_CE(L, 8, 9); SEL_CE(L, 10, 11); SEL_CE(L, 8, 10); SEL_CE(L, 9, 11); SEL_CE(L, 9, 10); SEL_CE(L, 12, 13); SEL_CE(L, 14, 15); SEL_CE(L, 12, 14); SEL_CE(L, 13, 15); SEL_CE(L, 13, 14); SEL_CE(L, 8, 12); SEL_CE(L, 10, 14); SEL_CE(L, 10, 12); SEL_CE(L, 9, 13); SEL_CE(L, 11, 15); SEL_CE(L, 11, 13); SEL_CE(L, 9, 10); SEL_CE(L, 11, 12); SEL_CE(L, 13, 14); SEL_CE(L, 0, 8); SEL_CE(L, 4, 12); SEL_CE(L, 4, 8); SEL_CE(L, 2, 10); SEL_CE(L, 6, 14); SEL_CE(L, 6, 10); SEL_CE(L, 2, 4); SEL_CE(L, 6, 8); SEL_CE(L, 10, 12); SEL_CE(L, 1, 9); SEL_CE(L, 5, 13); SEL_CE(L, 5, 9); SEL_CE(L, 3, 11); SEL_CE(L, 7, 15); SEL_CE(L, 7, 11); SEL_CE(L, 3, 5); SEL_CE(L, 7, 9); SEL_CE(L, 11, 13); SEL_CE(L, 1, 2); SEL_CE(L, 3, 4); SEL_CE(L, 5, 6); SEL_CE(L, 7, 8); SEL_CE(L, 9, 10); SEL_CE(L, 11, 12); SEL_CE(L, 13, 14); } while (0)
#define BMERGE16_DESC(L) do { SEL_CE(L, 0, 8); SEL_CE(L, 1, 9); SEL_CE(L, 2, 10); SEL_CE(L, 3, 11); SEL_CE(L, 4, 12); SEL_CE(L, 5, 13); SEL_CE(L, 6, 14); SEL_CE(L, 7, 15); SEL_CE(L, 0, 4); SEL_CE(L, 1, 5); SEL_CE(L, 2, 6); SEL_CE(L, 3, 7); SEL_CE(L, 8, 12); SEL_CE(L, 9, 13); SEL_CE(L, 10, 14); SEL_CE(L, 11, 15); SEL_CE(L, 0, 2); SEL_CE(L, 1, 3); SEL_CE(L, 4, 6); SEL_CE(L, 5, 7); SEL_CE(L, 8, 10); SEL_CE(L, 9, 11); SEL_CE(L, 12, 14); SEL_CE(L, 13, 15); SEL_CE(L, 0, 1); SEL_CE(L, 2, 3); SEL_CE(L, 4, 5); SEL_CE(L, 6, 7); SEL_CE(L, 8, 9); SEL_CE(L, 10, 11); SEL_CE(L, 12, 13); SEL_CE(L, 14, 15); } while (0)
template <int I> struct CandRow {
    static __device__ __forceinline__ void run(const float (&L0)[16], const float (&L1)[16], float (&R)[16]) {
        constexpr int NJ = 16 / (I + 1);
#pragma unroll
        for (int j = 0; j < NJ; ++j) { const float sm = L0[I] + L1[j];
            const float pk = __builtin_bit_cast(float, (__builtin_bit_cast(unsigned, sm) & 0xffffff00u) | (unsigned)(I * 16 + j)); TOPK_INSERT(R, pk); }
        if constexpr (I < 15) CandRow<I + 1>::run(L0, L1, R);
    }
};
__device__ __forceinline__ unsigned pick4(unsigned d0, unsigned d1, unsigned d2, unsigned d3, int i) {
    const int q = i >> 2; unsigned d = d0; d = (q == 1) ? d1 : d; d = (q == 2) ? d2 : d; d = (q == 3) ? d3 : d; return (d >> (8 * (i & 3))) & 127u;
}
__device__ __forceinline__ void select_phase(Frame& F) {
    const bf16* PQ = (const bf16*)(F.ws + WS_MG); const bf16* KEYS = (const bf16*)(F.ws + WS_KEYS);
    int* IDX = (int*)(F.ws + WS_K); float* GW = (float*)(F.ws + WS_K + 16 * MiB);
    LAS unsigned char* L = F.lds;
    const int tid = F.tid, lane = F.lane, w = F.wave, l31 = lane & 31, hh = lane >> 5;
    const float NEG_INF = -INFINITY;
    for (int grp = F.bid; grp < MTOK / 128; grp += F.G) {
        const int tb = grp * 4 + (w & 3);
        const size_t m = (size_t)tb * 32 + l31;
        for (int hp = 0; hp < 4; ++hp) {
            __syncthreads();
#pragma unroll 4
            for (int r = 0; r < 16; ++r) { const int e = tid + NTHR * r, R = e >> 4, c = e & 15;
                *(LAS v4u*)(L + R * 256 + ((c ^ (R & 15)) * 16)) = *(const v4u*)(KEYS + ((size_t)(hp * 512 + R) * 128 + c * 8)); }
            __syncthreads();
            const int hl = w >> 2, h = 2 * hp + hl;
            float L0[16], L1[16];
#pragma unroll
            for (int p = 0; p < 2; ++p) {
                bf16x8 qf[8];
#pragma unroll
                for (int ks = 0; ks < 8; ++ks) qf[ks] = *(const bf16x8*)(PQ + m * 2048 + h * 256 + p * 128 + 16 * ks + 8 * hh);
                f32x16 acc[4];
#pragma unroll
                for (int kb = 0; kb < 4; ++kb)
#pragma unroll
                    for (int r = 0; r < 16; ++r) acc[kb][r] = 0.f;
#pragma unroll
                for (int ks = 0; ks < 8; ++ks)
#pragma unroll
                    for (int kb = 0; kb < 4; ++kb) { const int R = (hl * 2 + p) * 128 + 32 * kb + l31;
                        const bf16x8 kf = *(const LAS bf16x8*)(L + R * 256 + (((2 * ks + hh) ^ (lane & 15)) * 16));
                        acc[kb] = __builtin_amdgcn_mfma_f32_32x32x16_bf16(kf, qf[ks], acc[kb], 0, 0, 0); }
                float Lc[16];
                const unsigned hh4 = (unsigned)hh << 2;
#pragma unroll
                for (int kb = 0; kb < 4; ++kb) { float Nw[16];
#pragma unroll
                    for (int r = 0; r < 16; ++r) { const unsigned nlo = (unsigned)(32 * kb + (r & 3) + 8 * (r >> 2));
                        const float av_ = acc[kb][r];
                        Nw[r] = __uint_as_float(((__float_as_uint(av_) & 0xffffff80u) | hh4) | nlo); }
                    SORT16_DESC(Nw);
                    if (kb == 0) {
#pragma unroll
                        for (int i = 0; i < 16; ++i) Lc[i] = Nw[i];
                    } else {
#pragma unroll
                        for (int i = 0; i < 16; ++i) Lc[i] = fmaxf(Lc[i], Nw[15 - i]);
                        BMERGE16_DESC(Lc); } }
                { float Lo[16];
#pragma unroll
                  for (int i = 0; i < 16; ++i) Lo[i] = __shfl_xor(Lc[i], 32);
#pragma unroll
                  for (int i = 0; i < 16; ++i) Lc[i] = fmaxf(Lc[i], Lo[15 - i]);
                  BMERGE16_DESC(Lc); }
#pragma unroll
                for (int i = 0; i < 16; ++i) { if (p == 0) L0[i] = Lc[i]; else L1[i] = Lc[i]; }
            }
            float R[16];
#pragma unroll
            for (int j = 0; j < 16; ++j) { const float sm = L0[0] + L1[j]; R[j] = __builtin_bit_cast(float, (__builtin_bit_cast(unsigned, sm) & 0xffffff00u) | (unsigned)j); }
            SORT16_DESC(R);
            CandRow<1>::run(L0, L1, R);
            unsigned a0 = 0, a1 = 0, a2 = 0, a3 = 0, b0 = 0, b1 = 0, b2 = 0, b3 = 0;
#pragma unroll
            for (int i = 0; i < 4; ++i) { a0 |= (__builtin_bit_cast(unsigned, L0[i]) & 127u) << (8 * i); a1 |= (__builtin_bit_cast(unsigned, L0[4 + i]) & 127u) << (8 * i);
                a2 |= (__builtin_bit_cast(unsigned, L0[8 + i]) & 127u) << (8 * i); a3 |= (__builtin_bit_cast(unsigned, L0[12 + i]) & 127u) << (8 * i);
                b0 |= (__builtin_bit_cast(unsigned, L1[i]) & 127u) << (8 * i); b1 |= (__builtin_bit_cast(unsigned, L1[4 + i]) & 127u) << (8 * i);
                b2 |= (__builtin_bit_cast(unsigned, L1[8 + i]) & 127u) << (8 * i); b3 |= (__builtin_bit_cast(unsigned, L1[12 + i]) & 127u) << (8 * i); }
            float ex[16]; float sum = 0.f; int id[16];
#pragma unroll
            for (int r = 0; r < 16; ++r) { ex[r] = __expf(R[r] - R[0]); sum += ex[r];
                const unsigned cid = __builtin_bit_cast(unsigned, R[r]) & 255u;
                id[r] = (int)(pick4(a0, a1, a2, a3, (int)(cid >> 4)) * 128u + pick4(b0, b1, b2, b3, (int)(cid & 15u))); }
            const float inv = 1.f / sum;
            if (hh == 0) {
#pragma unroll
                for (int q = 0; q < 4; ++q) {
                    *(int4*)(IDX + m * 128 + h * 16 + 4 * q) = make_int4(id[4 * q], id[4 * q + 1], id[4 * q + 2], id[4 * q + 3]);
                    *(f32x4*)(GW + m * 128 + h * 16 + 4 * q) = (f32x4){ex[4 * q] * inv, ex[4 * q + 1] * inv, ex[4 * q + 2] * inv, ex[4 * q + 3] * inv}; }
            }
        }
    }
}

template <int B> __device__ __forceinline__ f32x2 fp4b(unsigned w) { return __builtin_amdgcn_cvt_scalef32_pk_f32_fp4(w, 1.0f, B); }
typedef int v8i_t __attribute__((ext_vector_type(8)));
#define AP_SLOT(e) (4 * (((e) >> 1) & 3) + 2 * ((e) >> 3) + ((e) & 1))
__device__ __forceinline__ void apply_phase(Frame& F, float* OUTP) {
    const unsigned char* U8 = F.ws + WS_LG; const unsigned char* V8 = F.ws + WS_LG + 8 * MiB;
    const float* USC = (const float*)(F.ws + WS_LG + 16 * MiB); const float* VSC = USC + NEXP;
    const int* IDX = (const int*)(F.ws + WS_K); const float* GW = (const float*)(F.ws + WS_K + 16 * MiB);
    const float* g2 = F.in[20]; const float* gf = F.in[25];
    const float* X1 = F.out;
    const int lane = F.lane, fr = lane & 15, fq = lane >> 4;
    constexpr int APW = 2 * 16 * 528 + 1024;
    LAS unsigned char* UL = F.lds + F.wave * APW; LAS unsigned char* VL = UL + 16 * 528; LAS unsigned char* H8 = VL + 16 * 528;
    const int pe = 2 * fq + (fr & 1) + 8 * ((fr >> 1) & 1);
    const int bsh = 8 * (fr & 3); const unsigned mlo = fr < 4 ? ~0u : 0u, mhi = (fr >= 4 && fr < 8) ? ~0u : 0u;
#define AP_LOADROWS(SEL, KB) _Pragma("unroll") for (int e = 0; e < 16; ++e) { \
        const size_t ro = (size_t)__builtin_amdgcn_readlane(SEL, ((KB) + e) & 63) * (DM / 2) + lane * 8; uu[e] = *(const v2u*)(U8 + ro); vv[e] = *(const v2u*)(V8 + ro); }
    for (int grp = F.bid; grp < MTOK / 128; grp += F.G) {
        const int mbase = grp * 128 + F.wave;
        int ni0 = IDX[(size_t)mbase * 128 + lane], ni1 = IDX[(size_t)mbase * 128 + 64 + lane];
        float ngw0 = GW[(size_t)mbase * 128 + lane], ngw1 = GW[(size_t)mbase * 128 + 64 + lane];
        f32x4 nxr[4];
#pragma unroll
        for (int q = 0; q < 4; ++q) nxr[q] = *(const f32x4*)(X1 + (size_t)mbase * DM + lane * 16 + q * 4);
        v2u uu[16], vv[16];
        AP_LOADROWS(ni0, 0)
        int i0 = 0, i1 = 0; float gw0 = 0.f, gw1 = 0.f; f32x4 xr[4], oacc[8];
#pragma unroll
        for (int q = 0; q < 4; ++q) xr[q] = (f32x4){0.f, 0.f, 0.f, 0.f};
#pragma unroll
        for (int i = 0; i < 8; ++i) oacc[i] = (f32x4){0.f, 0.f, 0.f, 0.f};
#pragma unroll 1
        for (int it = 0; it < 128; ++it) {
            const int bt = it & 7, m = mbase + 8 * (it >> 3);
            if (bt == 0) {
                i0 = ni0; i1 = ni1; gw0 = ngw0; gw1 = ngw1; float s = 0.f;
#pragma unroll
                for (int q = 0; q < 4; ++q) { xr[q] = nxr[q]; s += (xr[q][0] * xr[q][0] + xr[q][1] * xr[q][1]) + (xr[q][2] * xr[q][2] + xr[q][3] * xr[q][3]); }
                const float r2 = rsqrtf(wave_sum(s) * (1.f / DM) + EPS);
                v4u h8;
#pragma unroll
                for (int q = 0; q < 4; ++q) { const f32x4 g = *(const f32x4*)(g2 + lane * 16 + q * 4); const f32x4 hq = xr[q] * r2 * g;
                    int pk = 0; pk = __builtin_amdgcn_cvt_pk_fp8_f32(hq[0], hq[1], pk, false); pk = __builtin_amdgcn_cvt_pk_fp8_f32(hq[2], hq[3], pk, true); h8[q] = (unsigned)pk; }
                *(LAS v4u*)(H8 + lane * 16) = h8;
#pragma unroll
                for (int i = 0; i < 8; ++i) oacc[i] = (f32x4){0.f, 0.f, 0.f, 0.f};
                const int mn = (it + 8 < 128) ? m + 8 : m;
                ni0 = IDX[(size_t)mn * 128 + lane]; ni1 = IDX[(size_t)mn * 128 + 64 + lane]; ngw0 = GW[(size_t)mn * 128 + lane]; ngw1 = GW[(size_t)mn * 128 + 64 + lane];
#pragma unroll
                for (int q = 0; q < 4; ++q) nxr[q] = *(const f32x4*)(X1 + (size_t)mn * DM + lane * 16 + q * 4);
            }
            const int k0 = bt * 16;
            const int isel = (k0 < 64) ? i0 : i1;
            const int myidx = __shfl(isel, (k0 + pe) & 63);
            const float su = USC[myidx], sv = VSC[myidx];
#pragma unroll
            for (int e = 0; e < 16; ++e) { *(LAS v2u*)(UL + AP_SLOT(e) * 528 + lane * 8) = uu[e]; *(LAS v2u*)(VL + e * 528 + lane * 8) = vv[e]; }
            { const int nk = (k0 + 16) & 127; const int nsel = (bt == 7) ? ni0 : ((nk < 64) ? i0 : i1);
              AP_LOADROWS(nsel, nk) }
            f32x4 da = (f32x4){0.f, 0.f, 0.f, 0.f}, db = (f32x4){0.f, 0.f, 0.f, 0.f};
#pragma unroll
            for (int ks = 0; ks < 8; ++ks) {
                const v4u af = *(const LAS v4u*)(UL + fr * 528 + 64 * ks + 16 * fq);
                const v4u b0 = *(const LAS v4u*)(H8 + 128 * ks + 16 * fq), b1 = *(const LAS v4u*)(H8 + 128 * ks + 64 + 16 * fq);
                const v8i_t A = {(int)af.x, (int)af.y, (int)af.z, (int)af.w, 0, 0, 0, 0};
                const v8i_t B = {(int)b0.x, (int)b0.y, (int)b0.z, (int)b0.w, (int)b1.x, (int)b1.y, (int)b1.z, (int)b1.w};
                if (ks & 1) db = __builtin_amdgcn_mfma_scale_f32_16x16x128_f8f6f4(A, B, db, 4  , 0  , 0, 0x7F7F7F7F, 0, 0x7F7F7F7F);
                else        da = __builtin_amdgcn_mfma_scale_f32_16x16x128_f8f6f4(A, B, da, 4, 0, 0, 0x7F7F7F7F, 0, 0x7F7F7F7F);
            }
            const f32x4 d4 = da + db;
            const int sel = fr & 3;
            float t = d4[0]; t = (sel == 1) ? d4[1] : t; t = (sel == 2) ? d4[2] : t; t = (sel == 3) ? d4[3] : t;
            const float gk = __shfl((k0 < 64) ? gw0 : gw1, (k0 + pe) & 63);
            const float wl = gk * gelu_fast(t * su) * sv;
            float wm = fabsf(wl); wm = fmaxf(wm, __shfl_xor(wm, 1)); wm = fmaxf(wm, __shfl_xor(wm, 2)); wm = fmaxf(wm, __shfl_xor(wm, 16)); wm = fmaxf(wm, __shfl_xor(wm, 32));
            int E = (int)(__float_as_uint(wm) >> 23); E = E < 8 ? 8 : E;
            const float wq = wl * __uint_as_float((unsigned)(261 - E) << 23);
            const int scb = (E - 7) * 0x01010101;
            v8i_t Bw;
#define AP_WQ(tq, ctrl) { const float wt = __builtin_bit_cast(float, __builtin_amdgcn_update_dpp(0, __builtin_bit_cast(int, wq), ctrl, 0xf, 0xf, false)); \
                const unsigned p8 = (unsigned)__builtin_amdgcn_cvt_pk_fp8_f32(wt, 0.f, 0, false) << bsh; Bw[2 * tq] = (int)(p8 & mlo); Bw[2 * tq + 1] = (int)(p8 & mhi); }
            AP_WQ(0, 0x00) AP_WQ(1, 0x55) AP_WQ(2, 0xAA) AP_WQ(3, 0xFF)
#pragma unroll
            for (int c = 0; c < 8; ++c) {
                v4u av;
                av.x = *(const LAS unsigned*)(VL + (4 * fq + 0) * 528 + 64 * c + 4 * fr); av.y = *(const LAS unsigned*)(VL + (4 * fq + 1) * 528 + 64 * c + 4 * fr);
                av.z = *(const LAS unsigned*)(VL + (4 * fq + 2) * 528 + 64 * c + 4 * fr); av.w = *(const LAS unsigned*)(VL + (4 * fq + 3) * 528 + 64 * c + 4 * fr);
                const v8i_t A = {(int)av.x, (int)av.y, (int)av.z, (int)av.w, 0, 0, 0, 0};
                oacc[c] = __builtin_amdgcn_mfma_scale_f32_16x16x128_f8f6f4(A, Bw, oacc[c], 4, 0, 0, 0x7F7F7F7F, 0, scb);
            }
            if (bt == 7) {
                if (fr < 8) {
#pragma unroll
                    for (int c = 0; c < 8; ++c)
#pragma unroll
                        for (int r = 0; r < 4; ++r) { const float o = oacc[c][r]; *(LAS unsigned*)(UL + 4 * ((4 * c + fq) * 40 + 8 * r + fr)) = __float_as_uint(o); }
                }
                float s2 = 0.f; f32x4 ov[4];
#pragma unroll
                for (int q = 0; q < 4; ++q) { const v4u ou = *(const LAS v4u*)(UL + 4 * ((lane >> 1) * 40 + (lane & 1) * 16 + 4 * q));
                    ov[q] = (f32x4){__uint_as_float(ou.x), __uint_as_float(ou.y), __uint_as_float(ou.z), __uint_as_float(ou.w)} + xr[q];
                    s2 += (ov[q][0] * ov[q][0] + ov[q][1] * ov[q][1]) + (ov[q][2] * ov[q][2] + ov[q][3] * ov[q][3]); }
                const float rf = rsqrtf(wave_sum(s2) * (1.f / DM) + EPS);
#pragma unroll
                for (int q = 0; q < 4; ++q) { const f32x4 g = *(const f32x4*)(gf + lane * 16 + q * 4);
                    *(f32x4*)(OUTP + (size_t)m * DM + lane * 16 + q * 4) = ov[q] * rf * g; }
            }
        }
    }
}

constexpr int N_PHASES = 13;
__global__ void __launch_bounds__(NTHR, 2) mega_fwd(Args args) {
    extern __shared__ __attribute__((aligned(16))) unsigned char lds[];
    Frame F;
    F.lds = (LAS unsigned char*)lds;
    F.tid = threadIdx.x; F.lane = F.tid & 63; F.wave = __builtin_amdgcn_readfirstlane(F.tid >> 6);
    F.G = gridDim.x; F.bid = blockIdx.x;
    F.in = args.in; F.out = args.out; F.ws = args.ws;
    volatile LAS unsigned* MISC = (volatile LAS unsigned*)(F.lds + MISC_OFF);
    for (int u = F.tid; u < (LDS_BYTES - LDSCTL_OFF) / 4; u += NTHR) ((LAS unsigned*)(F.lds + LDSCTL_OFF))[u] = 0u;
    __syncthreads();
    XcdBarrier bar; bar.bar = (unsigned*)(args.ws + WS_CTL) + CW_BAR; bar.x = 0; bar.st = nullptr;
    const bool one_launch = (args.ph_hi - args.ph_lo) > 1;
    if (one_launch) bar = xcd_barrier_post((unsigned*)(args.ws + WS_CTL) + CW_BAR, MISC + 8);
    const int lo = args.ph_lo, hi = args.ph_hi;
#define IN(k) (lo <= (k) && (k) < hi)
#define SEAM(k) do { if (IN(k) && IN((k) + 1)) xcd_barrier(bar); } while (0)
    unsigned char* ws = args.ws;

#ifndef PROBE_MASK
#define PROBE_MASK 0
#endif
#define REP(k) _Pragma("unroll") for (int rep_ = 0; rep_ < (((PROBE_MASK >> (k)) & 1) ? 2 : 1); ++rep_)
    if (IN(0)) REP(0) { p0_prologue(F); if (rep_ == 0 && ((PROBE_MASK >> 0) & 1)) xcd_barrier(bar); } SEAM(0);
    if (IN(1)) REP(1) {
        gates_phase(F);
        { AddrP1 g{(const char*)(ws + WS_K), (const char*)(ws + WS_WIN), 1024, 1024, 1024, 4, 0, 8};
          pg8::StaticOrder S; S.init(MTOK, 2048, F.G, F.bid, 4);
          EpiBf16<DstP1> E{DstP1{ws, 4, 0, 8}, 1.f};
          pg8::gemm_phase(F.lds, g, S, E); }
        { AddrP1 g{(const char*)F.out, (const char*)(ws + WS_WIN8), 512, 512, 512, 8, 4, 8};
          pg8::StaticOrder S; S.init(MTOK, 4096, F.G, F.bid, 4);
          EpiBf16<DstP1, true> E{DstP1{ws, 8, 4, 8}, 1.f / 1024.f};
          pg8::gemm_phase<EpiBf16<DstP1, true>, AddrP1, 1>(F.lds, g, S, E); }
    } SEAM(1);
    if (IN(2)) REP(2) { lru_phase<false>(F); } SEAM(2);
    if (IN(3)) REP(3) { lru_phase<true>(F); } SEAM(3);
    if (IN(4)) REP(4) { mconv_phase(F); } SEAM(4);
    if (IN(5)) REP(5) {
        const char* xc = (const char*)F.out + (size_t)MTOK * DM * 2;
        AddrQKV g{xc, (long)((const char*)(ws + WS_XM) - xc), (const char*)(ws + WS_WQKV), 1024, 256, 256};
        pg8::StaticOrder S; S.init(MTOK, 12 * 256, F.G, F.bid);
        EpiBf16<DstQKV> E{DstQKV{(char*)(ws + WS_LG), (long)WS_K - (long)WS_LG, (long)WS_XL - (long)WS_LG}, 1.f};
        pg8::gemm_phase(F.lds, g, S, E);
    } SEAM(5);
    if (IN(6)) REP(6) { mscan_phase(F); } SEAM(6);
    if (IN(7)) { ym_phase(F); } SEAM(7);
    if (IN(8)) {
        pg8::StaticOrder S; S.init(MTOK, 1024, F.G, F.bid);
        { AddrPlain g{(const char*)(ws + WS_OP), (const char*)(ws + WS_WB2), 1024, 1024, 1024};
          EpiMerge<false> E{(bf16*)(ws + WS_XM), (const unsigned char*)(ws + WS_MG), 0}; pg8::gemm_phase(F.lds, g, S, E); }
        { AddrPlain g{(const char*)F.out, (const char*)(ws + WS_WB2) + (size_t)1024 * 1024 * 2, 1024, 1024, 1024};
          EpiMerge<true> E{(bf16*)(ws + WS_XM), (const unsigned char*)(ws + WS_MG), 1024}; pg8::gemm_phase(F.lds, g, S, E); }
    } SEAM(8);
    if (IN(9)) {
        AddrPlain g{(const char*)(ws + WS_XM), (const char*)(ws + WS_WOUT2), 1024, 2048, 1024};
        pg8::StaticOrder S; S.init(MTOK, 1024, F.G, F.bid);
        EpiResid E{F.in[0], F.out, (bf16*)(ws + WS_XL), (float*)(ws + WS_SS)};
        pg8::gemm_phase(F.lds, g, S, E);
    } SEAM(9);
    if (IN(10)) REP(10) {
        AddrPlain g{(const char*)(ws + WS_XL), (const char*)(ws + WS_WPQ), 1024, 1024, 1024};
        pg8::StaticOrder S; S.init(MTOK, 2048, F.G, F.bid, 4);
        EpiPQ E{(bf16*)(ws + WS_MG), (const float*)(ws + WS_SS)};
        pg8::gemm_phase(F.lds, g, S, E);
    } SEAM(10);
    if (IN(11)) REP(11) { select_phase(F); }
    if (IN(11) && IN(12)) { asm volatile("s_waitcnt vmcnt(0)" ::: "memory"); __syncthreads(); }
    if (IN(12)) { if ((PROBE_MASK >> 12) & 1) { apply_phase(F, (float*)(ws + WS_MG)); xcd_barrier(bar); } apply_phase(F, F.out); }
#undef REP
#undef IN
#undef SEAM
}

extern "C" void kernel_launch(void* const* d_in, const int* in_sizes, int n_in, void* d_out, int out_size, void* d_ws, size_t ws_size, hipStream_t stream) {
    static int grid = 0;
    if (grid == 0) {
        if (n_in != 26 || in_sizes[0] != MTOK * DM || out_size != MTOK * DM || ws_size < WS_END) { fprintf(stderr, "kernel_launch: unexpected shapes / workspace (%zu < %zu)\n", ws_size, (size_t)WS_END); grid = -1; return; }
        int dev = 0, cus = 0, per_cu = 0;
        if (hipGetDevice(&dev) != hipSuccess || hipDeviceGetAttribute(&cus, hipDeviceAttributeMultiprocessorCount, dev) != hipSuccess) { grid = -1; return; }
        if (hipFuncSetAttribute((const void*)mega_fwd, hipFuncAttributeMaxDynamicSharedMemorySize, LDS_BYTES) != hipSuccess) { fprintf(stderr, "kernel_launch: hipFuncSetAttribute failed\n"); grid = -1; return; }
        if (hipOccupancyMaxActiveBlocksPerMultiprocessor(&per_cu, (const void*)mega_fwd, NTHR, LDS_BYTES) != hipSuccess || per_cu < 1) { fprintf(stderr, "kernel_launch: occupancy query says %d blocks/CU\n", per_cu); (void)hipGetLastError(); grid = -1; return; }
        grid = cus;
    }
    if (grid < 0) return;
    (void)hipMemsetAsync((char*)d_ws + WS_CTL + (size_t)CW_BAR * 4, 0, (size_t)XCD_BAR_WORDS * 4, stream);
    Args a{};
    for (int i = 0; i < 26; ++i) a.in[i] = (const float*)d_in[i];
    a.out = (float*)d_out; a.ws = (unsigned char*)d_ws;
#if MK_N_LAUNCHES == 1
    a.ph_lo = 0; a.ph_hi = N_PHASES;
    void* kargs[] = {&a};
    hipError_t e = hipLaunchCooperativeKernel((const void*)mega_fwd, dim3(grid), dim3(NTHR), kargs, LDS_BYTES, stream);
    if (e != hipSuccess) fprintf(stderr, "kernel_launch: cooperative launch failed: %s (grid %d)\n", hipGetErrorString(e), grid);
#else
    for (int p = 0; p < N_PHASES; ++p) { a.ph_lo = p; a.ph_hi = p + 1; hipLaunchKernelGGL(mega_fwd, dim3(grid), dim3(NTHR), LDS_BYTES, stream, a); }
#endif
}
```

```cpp
#include <hip/hip_runtime.h>
#include <cstdio>
#include <cstdint>
#include <math.h>

#ifndef MK_N_LAUNCHES
#define MK_N_LAUNCHES 1
#endif

constexpr int BATCH = 8, SEQ = 4096, DM = 1024, MTOK = BATCH * SEQ;
constexpr int DIN = 6160;
constexpr int NEXP = 16384;
constexpr float EPS = 1e-6f;

constexpr size_t MiB = 1u << 20;
constexpr size_t WS_CTL = 0, CTL_ZERO_BYTES = 1 * MiB;
constexpr size_t WS_WIN = 1 * MiB;
constexpr size_t WS_WQKV = 13 * MiB;
constexpr size_t WS_KEYS = 14 * MiB + 512 * 1024;
constexpr size_t WS_WLRU = 15 * MiB;
constexpr size_t WS_WB2 = 16 * MiB;
constexpr size_t WS_WOUT2 = 20 * MiB;
constexpr size_t WS_WPQ = 24 * MiB;
constexpr size_t WS_GATE = 28 * MiB;
constexpr size_t WS_WGT = 30 * MiB;
constexpr size_t WS_XM = 32 * MiB;
constexpr size_t WS_OP = 96 * MiB;
constexpr size_t WS_XL = 160 * MiB;
constexpr size_t WS_LG = 224 * MiB;
constexpr size_t WS_MG = 288 * MiB;
constexpr size_t WS_K = 416 * MiB;
constexpr size_t WS_AGG = 480 * MiB;
constexpr size_t WS_SS = 488 * MiB;
constexpr size_t WS_WIN8 = 489 * MiB;
constexpr size_t WS_END = 495 * MiB;

constexpr int CW_BAR = 4096;

constexpr int RING_BYTES = 131072;
constexpr int LDS_BYTES = 147456;
constexpr int LDSCTL_OFF = LDS_BYTES - 512, MISC_OFF = LDSCTL_OFF + 320;
constexpr int NWAVES = 8, NTHR = 512;

#define GAS __attribute__((address_space(1)))
#define LAS __attribute__((address_space(3)))
typedef unsigned short bf16;
typedef unsigned v4u __attribute__((ext_vector_type(4)));
typedef unsigned v2u __attribute__((ext_vector_type(2)));
typedef float f32x4 __attribute__((ext_vector_type(4)));
typedef float f32x2 __attribute__((ext_vector_type(2)));
typedef short bf16x8 __attribute__((ext_vector_type(8)));
typedef GAS unsigned gu32;
#define RLX_AGENT __ATOMIC_RELAXED, __HIP_MEMORY_SCOPE_AGENT
#define LDS_WAIT() asm volatile("s_waitcnt lgkmcnt(0)" ::: "memory")
#define VM_WAIT() asm volatile("s_waitcnt vmcnt(0)" ::: "memory")

__device__ __forceinline__ unsigned f2bf(float f) { unsigned u = __builtin_bit_cast(unsigned, f); return (u + 0x7fffu + ((u >> 16) & 1u)) >> 16; }
__device__ __forceinline__ unsigned pk2(float lo, float hi) { return f2bf(lo) | (f2bf(hi) << 16); }
__device__ __forceinline__ float bf2f(unsigned short h) { return __builtin_bit_cast(float, (unsigned)h << 16); }
__device__ __forceinline__ float bflo(unsigned w) { return __builtin_bit_cast(float, w << 16); }
__device__ __forceinline__ float bfhi(unsigned w) { return __builtin_bit_cast(float, w & 0xffff0000u); }
__device__ __forceinline__ float wave_sum(float v) {
#pragma unroll
  for (int o = 1; o < 64; o <<= 1) v += __shfl_xor(v, o);
  return v;
}
__device__ __forceinline__ float sigmoidf_(float x) { return __builtin_amdgcn_rcpf(1.f + __builtin_amdgcn_exp2f(x * -1.44269504089f)); }
__device__ __forceinline__ float gelu_erf(float x) { return 0.5f * x * (1.f + erff(x * 0.70710678118654752f)); }
__device__ __forceinline__ float gelu_fast(float v) {
    const float av = fabsf(v), t = __builtin_amdgcn_rcpf(av * 0.2316418882f + 1.0f);
    float q = t * 0.5307027145f + (-0.7265760135f); q = q * t + 0.7107068705f; q = q * t + (-0.142248368f); q = q * t + 0.127414796f; q = q * t;
    const float e = __builtin_amdgcn_exp2f((v * v) * (-0.72134752044f));
    const float m = v * (q * e);
    return v < 0.f ? m : v - m;
}
__device__ __forceinline__ float softplusf_(float x) { return fmaxf(x, 0.f) + log1pf(expf(-fabsf(x))); }

namespace pg8 {
#define PG8_LAS __attribute__((address_space(3)))
typedef unsigned short bf16_t;
typedef unsigned u32x4 __attribute__((ext_vector_type(4)));
typedef int i32x4_t __attribute__((ext_vector_type(4)));
constexpr int BM = 256, BK = 64, HALF = 128, HTB = HALF * BK * 2, STAGE_BYTES = 8 * HTB, NXCD = 8;

__host__ __device__ __forceinline__ int lds_byte(int r, int c) { const int st = (r >> 4) * 2 + (c >> 5), rr = r & 15, cc = c & 31, ob = rr * 64 + cc * 2; return st * 1024 + (ob ^ (((ob >> 9) & 1) << 5)); }
__host__ __device__ __forceinline__ void stage_rc(int b, int& R, int& C) { const int st = b / 1024, sb = b % 1024, swz = sb ^ (((sb >> 9) & 1) << 5); R = (st >> 1) * 16 + swz / 64; C = (st & 1) * 32 + (swz % 64) / 2; }
__host__ __device__ __forceinline__ int perm32(int rho) { const int n = rho >> 4, i = rho & 15; return 8 * (i >> 2) + 4 * n + (i & 3); }

struct Unit { int pm, pn; };
struct StaticOrder {
    int nM, nN, nwg, G, c, WGM;
    __host__ __device__ void init(int M, int N, int G_, int c_, int wgm = 8) { nM = M / BM; nN = N / BM; nwg = nM * nN; G = G_; c = c_; WGM = wgm; }
    __host__ __device__ bool next(int i, Unit& u) const {
        const long L = (long)i * G + c; if (L >= nwg) return false;
        int wgid = (int)L; { const int q = nwg / NXCD, r = nwg % NXCD, xcd = wgid % NXCD, off = wgid / NXCD; wgid = (xcd < r ? xcd * (q + 1) : r * (q + 1) + (xcd - r) * q) + off; }
        const int nig = WGM * nN, gid = wgid / nig, fm = gid * WGM, gsz = (nM - fm) < WGM ? (nM - fm) : WGM;
        u.pm = fm + ((wgid % nig) % gsz); u.pn = (wgid % nig) / gsz; return true;
    }
};

__device__ __forceinline__ unsigned cvt_pk_bf16(float lo, float hi) { unsigned r; asm volatile("v_cvt_pk_bf16_f32 %0, %1, %2" : "=v"(r) : "v"(lo), "v"(hi)); return r; }

template <class Epi, class Addr, int F8SC = 0>
__device__ __forceinline__ void gemm_phase(PG8_LAS unsigned char* lds, const Addr g, const StaticOrder& S, const Epi& E) {
    const int tid = threadIdx.x, wid = __builtin_amdgcn_readfirstlane(tid >> 6), lane = tid & 63, wr = wid >> 2, wc = wid & 3, fr = lane & 15, fq = lane >> 4;
    const int K = g.K, nt = K / BK;
    unsigned voffA[2], voffB[2];
#pragma unroll
    for (int i = 0; i < 2; ++i) { int R, C; stage_rc(tid * 16 + i * 8192, R, C); const int Rb = Epi::PERM ? ((R & ~31) + perm32(R & 31)) : R;
        voffA[i] = (unsigned)(R * g.lda + C) * 2u; voffB[i] = (unsigned)(Rb * g.ldb + C) * 2u; }
    const size_t kstep = (size_t)(BK * 2);
    const size_t hsA = (size_t)HALF * g.lda * 2, hsB = (size_t)HALF * g.ldb * 2;
    const unsigned ldsw = (unsigned)wid * 1024u;
    const int aoff = lds_byte(wr * 64 + fr, fq * 8), boff = lds_byte(wc * 32 + fr, fq * 8);
#define PG8_SA(b, h) (((b) * 2 + (h)) * HTB)
#define PG8_SB(b, h) ((4 + (b) * 2 + (h)) * HTB)
#define PG8_STAGE(bufoff, gbase, voff) do { _Pragma("unroll") for (int _i = 0; _i < 2; ++_i) \
        __builtin_amdgcn_global_load_lds((const unsigned*)((const char*)(gbase) + (voff)[_i]), (PG8_LAS unsigned*)(lds + (bufoff) + ldsw + _i * 8192), 16, 0, 0); } while (0)
#define PG8_LDA(dst, b, h) do { _Pragma("unroll") for (int m = 0; m < 4; ++m) _Pragma("unroll") for (int k = 0; k < 2; ++k) dst[m][k] = *(const PG8_LAS bf16x8*)(lds + PG8_SA(b, h) + aoff + m * 2048 + k * 1024); } while (0)
#define PG8_LDB(dst, b, h) do { _Pragma("unroll") for (int n = 0; n < 2; ++n) _Pragma("unroll") for (int k = 0; k < 2; ++k) dst[n][k] = *(const PG8_LAS bf16x8*)(lds + PG8_SB(b, h) + boff + n * 2048 + k * 1024); } while (0)
#define PG8_CAT(x0, x1) __builtin_shufflevector(__builtin_bit_cast(i32x4_t, x0), __builtin_bit_cast(i32x4_t, x1), 0, 1, 2, 3, 4, 5, 6, 7)
#define PG8_MMA(ai, bj, At, Bt) do { __builtin_amdgcn_s_setprio(1); \
        if constexpr (F8SC != 0) { _Pragma("unroll") for (int m = 0; m < 4; ++m) _Pragma("unroll") for (int n = 0; n < 2; ++n) \
            asm volatile("v_mfma_f32_16x16x128_f8f6f4 %0, %1, %2, %0" : "+v"(acc[ai][bj][m][n]) : "v"(PG8_CAT(Bt[n][0], Bt[n][1])), "v"(PG8_CAT(At[m][0], At[m][1]))); } \
        else { _Pragma("unroll") for (int m = 0; m < 4; ++m) _Pragma("unroll") for (int n = 0; n < 2; ++n) _Pragma("unroll") for (int k = 0; k < 2; ++k) \
            acc[ai][bj][m][n] = __builtin_amdgcn_mfma_f32_16x16x32_bf16(Bt[n][k], At[m][k], acc[ai][bj][m][n], 0, 0, 0); } \
        __builtin_amdgcn_s_setprio(0); } while (0)
#define PG8_WAIT_V(n) asm volatile("s_waitcnt vmcnt(" #n ")" ::: "memory")
#define PG8_WAIT_L(n) asm volatile("s_waitcnt lgkmcnt(" #n ")" ::: "memory")
#define PG8_BAR __builtin_amdgcn_s_barrier()
#define PG8_SCHED __builtin_amdgcn_sched_barrier(0)
    Unit cur, nxt; int ui = 0;
    if (!S.next(0, cur)) return;
    f32x4 acc[2][2][4][2];
#pragma unroll
    for (int a = 0; a < 2; ++a)
#pragma unroll
        for (int b = 0; b < 2; ++b)
#pragma unroll
            for (int m = 0; m < 4; ++m)
#pragma unroll
                for (int n = 0; n < 2; ++n) acc[a][b][m][n] = (f32x4){0.f, 0.f, 0.f, 0.f};
    bf16x8 At[4][2], B0[2][2], B1[2][2];
    const char* cA = g.a(cur); const char* cB = g.b(cur);
    PG8_STAGE(PG8_SB(0, 0), cB, voffB); PG8_STAGE(PG8_SB(0, 1), cB + hsB, voffB); PG8_STAGE(PG8_SA(0, 0), cA, voffA); PG8_STAGE(PG8_SA(0, 1), cA + hsA, voffA);
    if (wr == 1) PG8_BAR;
    PG8_WAIT_V(2); PG8_BAR;
    PG8_STAGE(PG8_SB(1, 0), cB + kstep, voffB); PG8_STAGE(PG8_SA(1, 0), cA + kstep, voffA); PG8_STAGE(PG8_SB(1, 1), cB + hsB + kstep, voffB);
    PG8_WAIT_V(6); PG8_BAR;
    for (;;) {
        const bool has_next = S.next(ui + 1, nxt);
        const char* nA = has_next ? g.a(nxt) : cA; const char* nB = has_next ? g.b(nxt) : cB;
#pragma unroll 1
        for (int t = 0; t < nt; t += 2) {
            const bool last = (t == nt - 2);
            const char* a1 = cA + (size_t)(t + 1) * kstep;
            const char* a2 = last ? nA : cA + (size_t)(t + 2) * kstep; const char* b2 = last ? nB : cB + (size_t)(t + 2) * kstep;
            const char* a3 = a2 + kstep; const char* b3 = b2 + kstep;
            PG8_LDB(B0, 0, 0); PG8_LDB(B1, 0, 1); PG8_SCHED; PG8_LDA(At, 0, 0); PG8_STAGE(PG8_SA(1, 1), a1 + hsA, voffA);
            PG8_WAIT_V(8); PG8_WAIT_L(0); PG8_BAR; PG8_MMA(0, 0, At, B0); PG8_MMA(0, 1, At, B1); PG8_BAR; PG8_SCHED;
            PG8_LDA(At, 0, 1); PG8_STAGE(PG8_SB(0, 0), b2, voffB); PG8_STAGE(PG8_SB(0, 1), b2 + hsB, voffB); PG8_STAGE(PG8_SA(0, 0), a2, voffA);
            PG8_WAIT_V(8); PG8_WAIT_L(0); PG8_BAR; PG8_MMA(1, 0, At, B0); PG8_MMA(1, 1, At, B1); PG8_BAR; PG8_SCHED;
            PG8_LDB(B0, 1, 0); PG8_LDB(B1, 1, 1); PG8_SCHED; PG8_LDA(At, 1, 0); PG8_STAGE(PG8_SA(0, 1), a2 + hsA, voffA);
            PG8_WAIT_V(8); PG8_WAIT_L(0); PG8_BAR; PG8_MMA(0, 0, At, B0); PG8_MMA(0, 1, At, B1); PG8_BAR; PG8_SCHED;
            PG8_LDA(At, 1, 1); PG8_STAGE(PG8_SB(1, 0), b3, voffB); PG8_STAGE(PG8_SB(1, 1), b3 + hsB, voffB); PG8_STAGE(PG8_SA(1, 0), a3, voffA);
            PG8_WAIT_V(8); PG8_WAIT_L(0); PG8_BAR; PG8_MMA(1, 0, At, B0); PG8_MMA(1, 1, At, B1); PG8_BAR; PG8_SCHED;
        }
        if constexpr (F8SC != 0) asm volatile("s_nop 15\n\ts_nop 15" ::: "memory");
        if (wr == 0) PG8_BAR;
        E(acc, cur, wr, wc, fr, fq);
        if (!has_next) break;
#pragma unroll
        for (int a = 0; a < 2; ++a)
#pragma unroll
            for (int b = 0; b < 2; ++b)
#pragma unroll
                for (int m = 0; m < 4; ++m)
#pragma unroll
                    for (int n = 0; n < 2; ++n) acc[a][b][m][n] = (f32x4){0.f, 0.f, 0.f, 0.f};
        cur = nxt; cA = nA; cB = nB; ++ui;
        if (wr == 1) PG8_BAR;
    }
    PG8_WAIT_V(0);
    PG8_BAR;
#undef PG8_SA
#undef PG8_SB
#undef PG8_STAGE
#undef PG8_LDA
#undef PG8_LDB
#undef PG8_MMA
#undef PG8_CAT
#undef PG8_WAIT_V
#undef PG8_WAIT_L
#undef PG8_BAR
#undef PG8_SCHED
}
}

#define XB_TMO      128
#define XB_XCNT(j)  (256  + 64 * (j))
#define XB_XSUB(j)  (1280 + 64 * (j))
#define XB_XGEN(j)  (2304 + 64 * (j))
#define XB_TOP      3328
#define XB_TOPGEN   3392
#define XCD_BAR_WORDS 3456
#define XB_SPIN_CAP (1u << 18)
__device__ __forceinline__ unsigned xb_ld(unsigned* p)              { return __hip_atomic_load(p, __ATOMIC_RELAXED, __HIP_MEMORY_SCOPE_AGENT); }
__device__ __forceinline__ unsigned xb_add(unsigned* p, unsigned v) { return __hip_atomic_fetch_add(p, v, __ATOMIC_RELAXED, __HIP_MEMORY_SCOPE_AGENT); }
__device__ __forceinline__ unsigned xb_xcc_id() { return (unsigned)__builtin_amdgcn_s_getreg((3 << 11) | 20) & 0xFu; }
#define XB_SPIN(cond, bar) do { unsigned _sp = 0; while (cond) { __builtin_amdgcn_s_sleep(1); \
    if ((++_sp & 255u) == 0u) { if (xb_ld(&(bar)[XB_TMO])) break; if (_sp > XB_SPIN_CAP) { atomicAdd(&(bar)[XB_TMO], 1u); break; } } } } while (0)
struct XcdBarrier { unsigned* bar; unsigned x; volatile LAS unsigned* st; };
__device__ __forceinline__ XcdBarrier xcd_barrier_post(unsigned* bar, volatile LAS unsigned* st) {
    XcdBarrier b; b.bar = bar; b.x = xb_xcc_id(); b.st = st;
    if (threadIdx.x == 0) (void)xb_add(&bar[XB_XCNT(b.x)], 1u);
    return b;
}
__device__ __forceinline__ void xcd_barrier_complete(unsigned* bar, unsigned x, unsigned& nloc, unsigned& nx) {
    const unsigned G = gridDim.x * gridDim.y * gridDim.z;
    unsigned sum, cnt, mine, sp = 0u;
    for (;;) {
        sum = 0u; cnt = 0u; mine = 0u;
#pragma unroll
        for (unsigned j = 0; j < 16; ++j) { const unsigned c = xb_ld(&bar[XB_XCNT(j)]); sum += c; cnt += (c > 0u) ? 1u : 0u; mine = (j == x) ? c : mine; }
        if (sum == G) break;
        __builtin_amdgcn_s_sleep(1);
        if ((++sp & 255u) == 0u) { if (xb_ld(&bar[XB_TMO])) break; if (sp > XB_SPIN_CAP) { atomicAdd(&bar[XB_TMO], 1u); break; } }
    }
    nloc = mine > 0u ? mine : 1u; nx = cnt > 0u ? cnt : 1u;
}
__device__ __forceinline__ void xcd_barrier(const XcdBarrier& b) {
    asm volatile("s_waitcnt vmcnt(0)" ::: "memory");
    __syncthreads();
    if (threadIdx.x == 0) {
        unsigned* bar = b.bar;
        __builtin_amdgcn_s_waitcnt(0);
        unsigned nloc = b.st[0], nx = b.st[1];
        if (nloc == 0u) { xcd_barrier_complete(bar, b.x, nloc, nx); b.st[0] = nloc; b.st[1] = nx; }
        const unsigned old = xb_add(&bar[XB_XSUB(b.x)], 1u);
        const unsigned gen = old / nloc;
        if (old + 1u == (gen + 1u) * nloc) {
            __builtin_amdgcn_fence(__ATOMIC_RELEASE, "agent");
            asm volatile("s_waitcnt vmcnt(0)" ::: "memory");
            const unsigned og = xb_add(&bar[XB_TOP], 1u);
            const unsigned tg = og / nx;
            if (og + 1u == (tg + 1u) * nx) xb_add(&bar[XB_TOPGEN], 1u);
            else XB_SPIN(xb_ld(&bar[XB_TOPGEN]) == tg, bar);
            __builtin_amdgcn_fence(__ATOMIC_ACQUIRE, "agent");
            xb_add(&bar[XB_XGEN(b.x)], 1u);
            asm volatile("s_waitcnt vmcnt(0)" ::: "memory");
        } else {
            XB_SPIN(xb_ld(&bar[XB_XGEN(b.x)]) == gen, bar);
            __builtin_amdgcn_fence(__ATOMIC_ACQUIRE, "agent");
            asm volatile("s_waitcnt vmcnt(0)" ::: "memory");
        }
    }
    __syncthreads();
}

struct Args { const float* in[26]; float* out; unsigned char* ws; int ph_lo, ph_hi; };
struct Frame {
    LAS unsigned char* lds;
    int tid, lane, wave, G, bid;
    const float* const* in; float* out; unsigned char* ws;
};

template <bool F8 = false> __device__ __forceinline__ void tr_item(const float* W, int ldw, bf16* WT, int ldt, float scale, const float* kscale, LAS float* scr, int k0, int lane) {
#pragma unroll 8
    for (int i = 0; i < 32; ++i) { const int kk = 2 * i + (lane >> 5); float v = W[(size_t)(k0 + kk) * ldw + (lane & 31)] * scale; if (kscale) v *= kscale[k0 + kk]; scr[kk * 33 + (lane & 31)] = v; }
    LDS_WAIT(); asm volatile("" ::: "memory");
    const int c = lane & 7;
#pragma unroll
    for (int j = 0; j < 4; ++j) { const int n = (lane >> 3) + 8 * j; const LAS float* s = scr + (8 * c) * 33 + n;
        if constexpr (F8) {
            int p0 = 0, p1 = 0; p0 = __builtin_amdgcn_cvt_pk_fp8_f32(s[0 * 33], s[1 * 33], p0, false); p0 = __builtin_amdgcn_cvt_pk_fp8_f32(s[2 * 33], s[3 * 33], p0, true);
            p1 = __builtin_amdgcn_cvt_pk_fp8_f32(s[4 * 33], s[5 * 33], p1, false); p1 = __builtin_amdgcn_cvt_pk_fp8_f32(s[6 * 33], s[7 * 33], p1, true);
            *(GAS v2u*)((GAS unsigned char*)WT + (size_t)n * ldt + k0 + 8 * c) = (v2u){(unsigned)p0, (unsigned)p1};
        } else {
        v4u o; o.x = pk2(s[0 * 33], s[1 * 33]); o.y = pk2(s[2 * 33], s[3 * 33]); o.z = pk2(s[4 * 33], s[5 * 33]); o.w = pk2(s[6 * 33], s[7 * 33]);
        *(GAS v4u*)(WT + (size_t)n * ldt + k0 + 8 * c) = o; } }
    LDS_WAIT(); asm volatile("" ::: "memory");
}

__device__ __forceinline__ void p0_prologue(Frame& F) {
    LAS float* scr = (LAS float*)(F.lds + F.wave * 16384);
    const int gw = F.bid * NWAVES + F.wave, NGW = F.G * NWAVES;
    unsigned char* ws = F.ws;
    const float* w_in = F.in[2];
    constexpr int I_WIN = 16 * 192, I_QKV = 12 * 32, I_LRU = 32 * 8, I_WB = 2 * 512, I_WO = 512, I_PQ = 16 * 64;
    constexpr int NITEMS = I_WIN + I_QKV + I_LRU + I_WB + I_WO + I_PQ;
    for (int it = gw; it < NITEMS; it += NGW) {
        int r = it;
        if (r < I_WIN) { const int kb = r / 192, nb = r % 192, n0 = nb * 32, sc = n0 < 2048 ? n0 : n0 + 16;
            if ((n0 >= 1024 && n0 < 3072) || n0 >= 4096) tr_item<true>(w_in + sc, DIN, (bf16*)(ws + WS_WIN8 + (size_t)n0 * 1024), 1024, 1024.f, nullptr, scr, kb * 64, F.lane);
            else tr_item(w_in + sc, DIN, (bf16*)(ws + WS_WIN) + (size_t)n0 * 1024, 1024, 1.f, nullptr, scr, kb * 64, F.lane);
            continue; }
        r -= I_WIN;
        if (r < I_QKV) { const int mat = r / 32, rr = r % 32, kb = rr / 8, nb = rr % 8, g = mat >> 2, h = mat & 3;
            const float* W = F.in[6 + g] + (size_t)h * 65536 + nb * 32;
            tr_item(W, 256, (bf16*)(ws + WS_WQKV) + (size_t)mat * 65536 + (size_t)(nb * 32) * 256, 256, g == 1 ? 0.0625f : 1.f, nullptr, scr, kb * 64, F.lane); continue; }
        r -= I_QKV;
        if (r < I_LRU) { const int mat = r / 8, rr = r % 8, kb = rr / 4, nb = rr % 4, gate = mat & 1, db = mat >> 1;
            const float* W = F.in[gate ? 14 : 12] + (size_t)db * 16384 + nb * 32;
            tr_item(W, 128, (bf16*)(ws + WS_WLRU) + (size_t)mat * 16384 + (size_t)(nb * 32) * 128, 128, 1.f, nullptr, scr, kb * 64, F.lane); continue; }
        r -= I_LRU;
        if (r < I_WB) { const int mat = r / 512, rr = r % 512, kb = rr / 32, nb = rr % 32;
            const float* W = F.in[17 + mat] + nb * 32;
            tr_item(W, 1024, (bf16*)(ws + WS_WB2) + (size_t)(mat * 1024 + nb * 32) * 1024, 1024, 1.f, nullptr, scr, kb * 64, F.lane); continue; }
        r -= I_WB;
        if (r < I_WO) { const int cp = 0, rr = r, kb = rr / 32, nb = rr % 32;
            const float* W = F.in[19] + nb * 32;
            tr_item(W, 1024, (bf16*)(ws + WS_WOUT2) + (size_t)(nb * 32) * 2048 + cp * 1024, 2048, 1.f, nullptr, scr, kb * 64, F.lane); continue; }
        r -= I_WO;
        { const int kb = r / 64, nb = r % 64;
            const float* W = F.in[21] + nb * 32;
            tr_item(W, 2048, (bf16*)(ws + WS_WPQ) + (size_t)(nb * 32) * 1024, 1024, 1.f, F.in[20], scr, kb * 64, F.lane); }
    }
    { const int gt = F.bid * NTHR + F.tid, NGT = F.G * NTHR;
      const float4* ks = (const float4*)F.in[22]; v2u* kd = (v2u*)(ws + WS_KEYS);
      for (int i = gt; i < 8 * 2 * 128 * 128 / 4; i += NGT) { const float4 v = ks[i]; v2u o; o.x = pk2(v.x, v.y); o.y = pk2(v.z, v.w); kd[i] = o; }
      float* ss = (float*)(ws + WS_SS);
      for (int i = gt; i < MTOK; i += NGT) ss[i] = 0.f; }
    { const int gt = F.bid * NTHR + F.tid;
      if (gt < 16 * 128) { const int c = gt >> 7, k8 = gt & 127; v4u o; unsigned wv[4];
#pragma unroll
          for (int j = 0; j < 4; ++j) wv[j] = pk2(w_in[(size_t)(k8 * 8 + 2 * j) * DIN + 2048 + c], w_in[(size_t)(k8 * 8 + 2 * j + 1) * DIN + 2048 + c]);
          o.x = wv[0]; o.y = wv[1]; o.z = wv[2]; o.w = wv[3]; *(v4u*)((bf16*)(ws + WS_WGT) + c * 1024 + k8 * 8) = o; } }
    const float* x = F.in[0]; const float* g1 = F.in[1];
    bf16* XN = (bf16*)(ws + WS_K);
    unsigned char* XN8 = (unsigned char*)F.out;
    f32x4 gv[4];
#pragma unroll
    for (int j = 0; j < 4; ++j) gv[j] = ((const f32x4*)g1)[F.lane + 64 * j];
    for (int m = 2 * gw; m < MTOK; m += 2 * NGW) {
        const f32x4* xr0 = (const f32x4*)(x + (size_t)m * DM) + F.lane; const f32x4* xr1 = xr0 + DM / 4;
        f32x4 v0[4], v1[4]; float s0 = 0.f, s1 = 0.f;
#pragma unroll
        for (int j = 0; j < 4; ++j) { v0[j] = xr0[64 * j]; v1[j] = xr1[64 * j]; }
#pragma unroll
        for (int j = 0; j < 4; ++j) { s0 += (v0[j].x * v0[j].x + v0[j].y * v0[j].y) + (v0[j].z * v0[j].z + v0[j].w * v0[j].w); s1 += (v1[j].x * v1[j].x + v1[j].y * v1[j].y) + (v1[j].z * v1[j].z + v1[j].w * v1[j].w); }
        const float r0 = rsqrtf(wave_sum(s0) * (1.f / DM) + EPS), r1 = rsqrtf(wave_sum(s1) * (1.f / DM) + EPS);
        unsigned long long* o0 = (unsigned long long*)(XN + (size_t)m * DM) + F.lane; unsigned long long* o1 = o0 + DM / 4;
        unsigned* q0 = (unsigned*)(XN8 + (size_t)m * DM) + F.lane; unsigned* q1 = q0 + DM / 4;
#pragma unroll
        for (int j = 0; j < 4; ++j) { const f32x4 a = v0[j] * r0 * gv[j], c = v1[j] * r1 * gv[j];
            o0[64 * j] = (unsigned long long)pk2(a.x, a.y) | ((unsigned long long)pk2(a.z, a.w) << 32);
            o1[64 * j] = (unsigned long long)pk2(c.x, c.y) | ((unsigned long long)pk2(c.z, c.w) << 32);
            int pa = 0, pc = 0; pa = __builtin_amdgcn_cvt_pk_fp8_f32(a.x, a.y, pa, false); pa = __builtin_amdgcn_cvt_pk_fp8_f32(a.z, a.w, pa, true);
            pc = __builtin_amdgcn_cvt_pk_fp8_f32(c.x, c.y, pc, false); pc = __builtin_amdgcn_cvt_pk_fp8_f32(c.z, c.w, pc, true);
            q0[64 * j] = (unsigned)pa; q1[64 * j] = (unsigned)pc; }
    }
}
__device__ __forceinline__ void gates_phase(Frame& F) {
    const bf16* XN = (const bf16*)(F.ws + WS_K); const bf16* WGT = (const bf16*)(F.ws + WS_WGT); float* GT = (float*)(F.ws + WS_GATE);
    const int lane = F.lane, fr = lane & 15, fq = lane >> 4;
    const f32x4 bg4 = *(const f32x4*)(F.in[3] + 4 * fq);
    for (int task = F.bid * NWAVES + F.wave; task < MTOK / 16; task += F.G * NWAVES) {
        const size_t m0 = (size_t)task * 16;
        f32x4 acc = (f32x4){0.f, 0.f, 0.f, 0.f};
#pragma unroll 8
        for (int ks = 0; ks < 32; ++ks) {
            const bf16x8 wfr = *(const bf16x8*)(WGT + fr * 1024 + 32 * ks + 8 * fq);
            const bf16x8 xfr = *(const bf16x8*)(XN + (m0 + fr) * DM + 32 * ks + 8 * fq);
            acc = __builtin_amdgcn_mfma_f32_16x16x32_bf16(wfr, xfr, acc, 0, 0, 0);
        }
        *(f32x4*)(GT + (m0 + fr) * 16 + 4 * fq) = acc + bg4;
    }
}

struct AddrPlain {
    const char* A; const char* Bt; int lda, ldb, K;
    __device__ __forceinline__ const char* a(const pg8::Unit& u) const { return A + (size_t)u.pm * 256 * lda * 2; }
    __device__ __forceinline__ const char* b(const pg8::Unit& u) const { return Bt + (size_t)u.pn * 256 * ldb * 2; }
};
struct AddrP1 {
    const char* A; const char* Bt; int lda, ldb, K, thr, lo_add, hi_add;
    __device__ __forceinline__ const char* a(const pg8::Unit& u) const { return A + (size_t)u.pm * 256 * lda * 2; }
    __device__ __forceinline__ const char* b(const pg8::Unit& u) const { return Bt + (size_t)(u.pn + (u.pn < thr ? lo_add : hi_add)) * 256 * ldb * 2; }
};
struct AddrQKV {
    const char* XC; long dXM; const char* W; int lda, ldb, K;
    __device__ __forceinline__ const char* a(const pg8::Unit& u) const { return XC + (u.pn < 8 ? 0l : dXM) + ((size_t)u.pm * 256 * 1024 + (u.pn & 3) * 256) * 2; }
    __device__ __forceinline__ const char* b(const pg8::Unit& u) const { return W + (size_t)u.pn * 65536 * 2; }
};
struct AddrBranch {
    const char* YM; long dYL; const char* W; int lda, ldb, K;
    __device__ __forceinline__ const char* a(const pg8::Unit& u) const { return YM + (u.pn < 4 ? 0l : dYL) + (size_t)u.pm * 256 * 1024 * 2; }
    __device__ __forceinline__ const char* b(const pg8::Unit& u) const { return W + (size_t)u.pn * 256 * 1024 * 2; }
};

struct DstP1 { unsigned char* ws; int thr, lo_add, hi_add;
    __device__ __forceinline__ bf16* get(int j, int& ld, int& col0) const {
        const int pn = j + (j < thr ? lo_add : hi_add); const bool mg = pn >= 16; ld = mg ? -2048 : 1024; col0 = mg ? (pn - 16) * 256 : (pn & 3) * 256;
        return (bf16*)(ws + (mg ? WS_MG : WS_XM + (size_t)(pn >> 2) * 64 * MiB)); } };
struct DstQKV { char* q; long dk, dv;
    __device__ __forceinline__ bf16* get(int pn, int& ld, int& col0) const { ld = 1024; col0 = (pn & 3) * 256; return (bf16*)(q + (pn >= 4 ? (pn >= 8 ? dv : dk) : 0l)); } };
template <class Dst, bool MUL = false> struct EpiBf16 {
    static constexpr bool PERM = true;
    Dst dst; float mul;
    __device__ __forceinline__ void operator()(const f32x4 (&acc)[2][2][4][2], const pg8::Unit& u, int wr, int wc, int fr, int fq) const {
        int ld, colt; bf16* base = dst.get(u.pn, ld, colt);
        const int row0 = u.pm * 256 + wr * 64 + fr, col0 = colt + wc * 32 + 8 * fq;
        if (MUL && ld < 0) {
#pragma unroll
            for (int ai = 0; ai < 2; ++ai)
#pragma unroll
                for (int m = 0; m < 4; ++m) { unsigned char* rowp = (unsigned char*)base + (size_t)(row0 + ai * 128 + m * 16) * (-ld) + col0;
#pragma unroll
                    for (int bj = 0; bj < 2; ++bj) { const f32x4 v0 = acc[ai][bj][m][0] * mul, v1 = acc[ai][bj][m][1] * mul;
                        int p0 = 0, p1 = 0; p0 = __builtin_amdgcn_cvt_pk_fp8_f32(v0[0], v0[1], p0, false); p0 = __builtin_amdgcn_cvt_pk_fp8_f32(v0[2], v0[3], p0, true);
                        p1 = __builtin_amdgcn_cvt_pk_fp8_f32(v1[0], v1[1], p1, false); p1 = __builtin_amdgcn_cvt_pk_fp8_f32(v1[2], v1[3], p1, true);
                        *(v2u*)(rowp + bj * 128) = (v2u){(unsigned)p0, (unsigned)p1}; } }
            return;
        }
#pragma unroll
        for (int ai = 0; ai < 2; ++ai)
#pragma unroll
            for (int m = 0; m < 4; ++m) { bf16* rowp = base + (size_t)(row0 + ai * 128 + m * 16) * ld + col0;
#pragma unroll
                for (int bj = 0; bj < 2; ++bj) { f32x4 v0 = acc[ai][bj][m][0], v1 = acc[ai][bj][m][1]; if (MUL) { v0 = v0 * mul; v1 = v1 * mul; }
                    v4u w; w.x = pg8::cvt_pk_bf16(v0[0], v0[1]); w.y = pg8::cvt_pk_bf16(v0[2], v0[3]); w.z = pg8::cvt_pk_bf16(v1[0], v1[1]); w.w = pg8::cvt_pk_bf16(v1[2], v1[3]);
                    *(v4u*)(rowp + bj * 128) = w; } }
    }
};
template <bool ADD> struct EpiMerge {
    static constexpr bool PERM = true;
    bf16* MRG; const unsigned char* MG; int gcol;
    __device__ __forceinline__ void operator()(const f32x4 (&acc)[2][2][4][2], const pg8::Unit& u, int wr, int wc, int fr, int fq) const {
        const int row0 = u.pm * 256 + wr * 64 + fr, col0 = u.pn * 256 + wc * 32 + 8 * fq;
#pragma unroll
        for (int ai = 0; ai < 2; ++ai)
#pragma unroll
            for (int m = 0; m < 4; ++m) { const size_t row = (size_t)(row0 + ai * 128 + m * 16); bf16* rowp = MRG + row * 1024 + col0; const unsigned char* gp = MG + row * 2048 + gcol + col0;
#pragma unroll
                for (int bj = 0; bj < 2; ++bj) { const f32x4 v0 = acc[ai][bj][m][0], v1 = acc[ai][bj][m][1];
                    const v2u g = *(const v2u*)(gp + bj * 128);
                    const f32x2 g0 = __builtin_amdgcn_cvt_pk_f32_fp8((int)g.x, false), g1 = __builtin_amdgcn_cvt_pk_f32_fp8((int)g.x, true), g2 = __builtin_amdgcn_cvt_pk_f32_fp8((int)g.y, false), g3 = __builtin_amdgcn_cvt_pk_f32_fp8((int)g.y, true);
                    float o[8] = {v0[0] * sigmoidf_(g0[0]), v0[1] * sigmoidf_(g0[1]), v0[2] * sigmoidf_(g1[0]), v0[3] * sigmoidf_(g1[1]),
                                  v1[0] * sigmoidf_(g2[0]), v1[1] * sigmoidf_(g2[1]), v1[2] * sigmoidf_(g3[0]), v1[3] * sigmoidf_(g3[1])};
                    if (ADD) { const v4u t = *(const v4u*)(rowp + bj * 128);
                        o[0] += bflo(t.x); o[1] += bfhi(t.x); o[2] += bflo(t.y); o[3] += bfhi(t.y); o[4] += bflo(t.z); o[5] += bfhi(t.z); o[6] += bflo(t.w); o[7] += bfhi(t.w); }
                    v4u w; w.x = pg8::cvt_pk_bf16(o[0], o[1]); w.y = pg8::cvt_pk_bf16(o[2], o[3]); w.z = pg8::cvt_pk_bf16(o[4], o[5]); w.w = pg8::cvt_pk_bf16(o[6], o[7]);
                    *(v4u*)(rowp + bj * 128) = w; } }
    }
};
struct EpiResid {
    static constexpr bool PERM = false;
    const float* x; float* x1; bf16* x1b; float* ss;
    __device__ __forceinline__ void operator()(const f32x4 (&acc)[2][2][4][2], const pg8::Unit& u, int wr, int wc, int fr, int fq) const {
        const int row0 = u.pm * 256 + wr * 64 + fr, col0 = u.pn * 256 + wc * 32 + 4 * fq;
#pragma unroll
        for (int ai = 0; ai < 2; ++ai)
#pragma unroll
            for (int m = 0; m < 4; ++m) { const int row = row0 + ai * 128 + m * 16; const size_t off = (size_t)row * DM + col0; float s = 0.f;
#pragma unroll
                for (int bj = 0; bj < 2; ++bj)
#pragma unroll
                    for (int n = 0; n < 2; ++n) { const size_t o = off + bj * 128 + n * 16; const f32x4 v = *(const f32x4*)(x + o) + acc[ai][bj][m][n];
                        *(f32x4*)(x1 + o) = v; v2u w; w.x = pg8::cvt_pk_bf16(v[0], v[1]); w.y = pg8::cvt_pk_bf16(v[2], v[3]); *(v2u*)(x1b + o) = w;
                        s += (v[0] * v[0] + v[1] * v[1]) + (v[2] * v[2] + v[3] * v[3]); }
                s += __shfl_xor(s, 16); s += __shfl_xor(s, 32);
                if (fq == 0) atomicAdd(ss + row, s); }
    }
};
struct EpiPQ {
    static constexpr bool PERM = true;
    bf16* pq; const float* ss;
    __device__ __forceinline__ void operator()(const f32x4 (&acc)[2][2][4][2], const pg8::Unit& u, int wr, int wc, int fr, int fq) const {
        const int row0 = u.pm * 256 + wr * 64 + fr, col0 = u.pn * 256 + wc * 32 + 8 * fq;
#pragma unroll
        for (int ai = 0; ai < 2; ++ai)
#pragma unroll
            for (int m = 0; m < 4; ++m) { const int row = row0 + ai * 128 + m * 16; bf16* rowp = pq + (size_t)row * 2048 + col0;
                const float r = rsqrtf(ss[row] * (1.f / DM) + EPS);
#pragma unroll
                for (int bj = 0; bj < 2; ++bj) { const f32x4 v0 = acc[ai][bj][m][0] * r, v1 = acc[ai][bj][m][1] * r;
                    v4u w; w.x = pg8::cvt_pk_bf16(v0[0], v0[1]); w.y = pg8::cvt_pk_bf16(v0[2], v0[3]); w.z = pg8::cvt_pk_bf16(v1[0], v1[1]); w.w = pg8::cvt_pk_bf16(v1[2], v1[3]);
                    *(v4u*)(rowp + bj * 128) = w; } }
    }
};

template <bool PB> __device__ __forceinline__ void lru_phase(Frame& F) {
    const bf16* XL = (const bf16*)(F.ws + WS_XL); const bf16* LG = (const bf16*)(F.ws + WS_LG); bf16* YL = (bf16*)F.out;
    f32x2* AGG = (f32x2*)(F.ws + WS_AGG);
    const bf16* WL = (const bf16*)(F.ws + WS_WLRU);
    const float* cw = F.in[10]; const float* cb = F.in[11];
    unsigned char* LA0 = F.ws + WS_K; unsigned char* LA1 = LA0 + (size_t)MTOK * DM; bf16* LU0 = (bf16*)F.out; bf16* LU1 = LU0 + (size_t)MTOK * DM;
    v2u ra[2]; v4u ru[2];
    constexpr int O_XCB = 0, O_XCF = 17408, O_A = 51200, O_U = 84992, FST = 528;
    LAS unsigned char* L = F.lds;
    const int tid = F.tid, lane = F.lane, w = F.wave, fr = lane & 15, fq = lane >> 4;
    int cur_blk = -1;
    bf16x8 wf[2][2][4];
    f32x4 br4[2], bi4[2], sp4[2];
    v4u rawreg[3];
#define RAW_LOAD(bb, tt0, bk) do { _Pragma("unroll") for (int r_ = 0; r_ < 3; ++r_) { const int e_ = tid + NTHR * r_, row_ = e_ >> 4, c16_ = e_ & 15, t_ = (tt0) - 2 + row_; \
            v4u v_ = {0u, 0u, 0u, 0u}; if (e_ < 68 * 16 && t_ >= 0 && t_ < SEQ) v_ = *(const v4u*)(XL + ((size_t)(bb) * SEQ + t_) * DM + (bk) * 128 + c16_ * 8); rawreg[r_] = v_; } } while (0)
#define PB_LOAD(ii, dd) do { const int idx_ = (ii) * F.G + F.bid; if (idx_ < 4096) { const int j_ = idx_ >> 3; const size_t mr_ = (size_t)(j_ >> 6) * SEQ + (j_ & 63) * 64; \
            _Pragma("unroll") for (int r_ = 0; r_ < 2; ++r_) { const int e_ = tid + NTHR * r_; const size_t o_ = (mr_ + (e_ >> 4)) * DM + (idx_ & 7) * 128 + (e_ & 15) * 8; \
                ra[r_] = *(const v2u*)(((dd) ? LA1 : LA0) + o_); ru[r_] = *(const v4u*)(((dd) ? LU1 : LU0) + o_); } } } while (0)
    constexpr int O_CARRY = 118784, O_CW = 135168, O_SUB = 137728;
    const bool carry_tab = PB && (F.G == 256);
    if (carry_tab) {
        const int ch = tid & 127, bq = tid >> 7, s0 = F.bid >> 3, blk0 = F.bid & 7;
        LAS float* CT = (LAS float*)(L + O_CARRY);
#define FOLD(agp, j0, j1, stp, hv) do { int js_ = (j0); const int n_ = ((j1) - (j0)) * (stp); int k_ = 0; \
            for (; k_ + 8 <= n_; k_ += 8) { f32x2 ah_[8]; _Pragma("unroll") for (int q_ = 0; q_ < 8; ++q_) ah_[q_] = (agp)[(size_t)(js_ + q_ * (stp)) * 2 * DM]; \
                _Pragma("unroll") for (int q_ = 0; q_ < 8; ++q_) hv = ah_[q_][0] * hv + ah_[q_][1]; js_ += 8 * (stp); } \
            for (; k_ < n_; ++k_) { const f32x2 a1_ = (agp)[(size_t)js_ * 2 * DM]; hv = a1_[0] * hv + a1_[1]; js_ += (stp); } } while (0)
        for (int bb = 2 * bq; bb < 2 * bq + 2; ++bb) {
            const f32x2* ag0 = AGG + ((size_t)(bb * 64) * 2 + 0) * DM + blk0 * 128 + ch; const f32x2* ag1 = AGG + ((size_t)(bb * 64) * 2 + 1) * DM + blk0 * 128 + ch;
            float h = 0.f;
            FOLD(ag0, 0, s0, 1, h); CT[((bb * 2 + 0) * 2 + 0) * 128 + ch] = h;
            FOLD(ag0, s0, s0 + 32, 1, h); CT[((bb * 2 + 1) * 2 + 0) * 128 + ch] = h;
            h = 0.f;
            FOLD(ag1, 63, s0 + 32, -1, h); CT[((bb * 2 + 1) * 2 + 1) * 128 + ch] = h;
            FOLD(ag1, s0 + 32, s0, -1, h); CT[((bb * 2 + 0) * 2 + 1) * 128 + ch] = h;
        }
        __syncthreads();
#undef FOLD
    }
    for (int i = 0;; ++i) {
        const int idx = i * F.G + F.bid; if (idx >= 4096) break;
        const int blk = idx & 7, j = idx >> 3, b = j >> 6, seg = j & 63, t0 = seg * 64;
        const size_t mrow0 = (size_t)b * SEQ + t0;
        if (!PB && blk != cur_blk) {
            cur_blk = blk;
#pragma unroll
            for (int d = 0; d < 2; ++d) {
#pragma unroll
                for (int g = 0; g < 2; ++g)
#pragma unroll
                    for (int ks = 0; ks < 4; ++ks)
                        wf[d][g][ks] = *(const bf16x8*)(WL + ((size_t)((d * 8 + blk) * 2 + g) * 128 + 16 * w + fr) * 128 + 32 * ks + 8 * fq);
                const int ch = blk * 128 + 16 * w + 4 * fq;
                br4[d] = *(const f32x4*)(F.in[13] + d * DM + ch); bi4[d] = *(const f32x4*)(F.in[15] + d * DM + ch);
                const f32x4 lm = *(const f32x4*)(F.in[16] + d * DM + ch);
#pragma unroll
                for (int e = 0; e < 4; ++e) sp4[d][e] = -8.f * 1.44269504089f * softplusf_(-lm[e]);
            }
            __syncthreads();
            for (int e = tid; e < 5 * 128; e += NTHR) { const int jt = e >> 7, cc = e & 127; ((LAS float*)(L + O_CW))[e] = (jt < 4) ? cw[jt * DM + blk * 128 + cc] : cb[blk * 128 + cc]; }
        }
        v4u lgreg[2];
        if (PB) {
            if (i == 0) PB_LOAD(0, 0);
#pragma unroll
            for (int r = 0; r < 2; ++r) { const int e = tid + NTHR * r; lgreg[r] = *(const v4u*)(LG + (mrow0 + (e >> 4)) * DM + blk * 128 + (e & 15) * 8); }
        } else {
        if (i == 0) RAW_LOAD(b, t0, blk);
#pragma unroll
        for (int r = 0; r < 3; ++r) { const int e = tid + NTHR * r; if (e < 68 * 16) *(LAS v4u*)(L + O_A + (e >> 4) * 256 + (e & 15) * 16) = rawreg[r]; }
        __syncthreads();
        { const int idx2 = (i + 1) * F.G + F.bid; if (idx2 < 4096) { const int j2 = idx2 >> 3; RAW_LOAD(j2 >> 6, (j2 & 63) * 64, idx2 & 7); } }
        for (int e = tid; e < 64 * 16; e += NTHR) { const int tl = e >> 4, c16 = e & 15;
            float y[8];
            { const f32x4 a = *(const LAS f32x4*)(L + O_CW + 4 * 512 + c16 * 32), bq = *(const LAS f32x4*)(L + O_CW + 4 * 512 + c16 * 32 + 16); y[0] = a[0]; y[1] = a[1]; y[2] = a[2]; y[3] = a[3]; y[4] = bq[0]; y[5] = bq[1]; y[6] = bq[2]; y[7] = bq[3]; }
#pragma unroll
            for (int jt = 0; jt < 4; ++jt) { const v4u r = *(const LAS v4u*)(L + O_A + (tl + jt) * 256 + c16 * 16);
                const f32x4 wa = *(const LAS f32x4*)(L + O_CW + jt * 512 + c16 * 32), wb = *(const LAS f32x4*)(L + O_CW + jt * 512 + c16 * 32 + 16);
                y[0] += wa[0] * bflo(r.x); y[1] += wa[1] * bfhi(r.x); y[2] += wa[2] * bflo(r.y); y[3] += wa[3] * bfhi(r.y);
                y[4] += wb[0] * bflo(r.z); y[5] += wb[1] * bfhi(r.z); y[6] += wb[2] * bflo(r.w); y[7] += wb[3] * bfhi(r.w); }
            *(LAS f32x4*)(L + O_XCF + tl * FST + c16 * 32) = (f32x4){y[0], y[1], y[2], y[3]};
            *(LAS f32x4*)(L + O_XCF + tl * FST + c16 * 32 + 16) = (f32x4){y[4], y[5], y[6], y[7]};
            v4u o; o.x = pk2(y[0], y[1]); o.y = pk2(y[2], y[3]); o.z = pk2(y[4], y[5]); o.w = pk2(y[6], y[7]);
            *(LAS v4u*)(L + O_XCB + tl * 272 + c16 * 16) = o; }
        __syncthreads();
        }
        float carry0 = 0.f, carry1 = 0.f;
        if (carry_tab) { const LAS float* CT = (const LAS float*)(L + O_CARRY); carry0 = CT[((b * 2 + (seg >> 5)) * 2 + 0) * 128 + (tid & 127)]; carry1 = CT[((b * 2 + (seg >> 5)) * 2 + 1) * 128 + (tid & 127)]; }
        else if (PB) {
            const int ch = blk * 128 + (tid & 127);
            float h = 0.f;
            const f32x2* ag0 = AGG + ((size_t)(b * 64) * 2 + 0) * DM + ch; const f32x2* ag1 = AGG + ((size_t)(b * 64) * 2 + 1) * DM + ch;
            int js = 0;
            for (; js + 8 <= seg; js += 8) { f32x2 ah[8];
#pragma unroll
                for (int q = 0; q < 8; ++q) ah[q] = ag0[(size_t)(js + q) * 2 * DM];
#pragma unroll
                for (int q = 0; q < 8; ++q) h = ah[q][0] * h + ah[q][1]; }
            for (; js < seg; ++js) { const f32x2 ah = ag0[(size_t)js * 2 * DM]; h = ah[0] * h + ah[1]; }
            carry0 = h; h = 0.f;
            js = 63;
            for (; js - 8 >= seg; js -= 8) { f32x2 ah[8];
#pragma unroll
                for (int q = 0; q < 8; ++q) ah[q] = ag1[(size_t)(js - q) * 2 * DM];
#pragma unroll
                for (int q = 0; q < 8; ++q) h = ah[q][0] * h + ah[q][1]; }
            for (; js > seg; --js) { const f32x2 ah = ag1[(size_t)js * 2 * DM]; h = ah[0] * h + ah[1]; }
            carry1 = h;
        }
#pragma unroll
        for (int d = 0; d < 2; ++d) {
            const int o_a = (d == 0) ? O_A : O_XCF;
            if (PB) {
#pragma unroll
                for (int r = 0; r < 2; ++r) { const int e = tid + NTHR * r, row = e >> 4, c16 = e & 15;
                    const f32x2 x0 = __builtin_amdgcn_cvt_pk_f32_fp8((int)ra[r].x, false), x1 = __builtin_amdgcn_cvt_pk_f32_fp8((int)ra[r].x, true);
                    const f32x2 x2 = __builtin_amdgcn_cvt_pk_f32_fp8((int)ra[r].y, false), x3 = __builtin_amdgcn_cvt_pk_f32_fp8((int)ra[r].y, true);
                    constexpr float IS = 1.f / 4096.f;
                    *(LAS f32x4*)(L + o_a + row * FST + c16 * 32) = (f32x4){1.f - x0[0] * IS, 1.f - x0[1] * IS, 1.f - x1[0] * IS, 1.f - x1[1] * IS};
                    *(LAS f32x4*)(L + o_a + row * FST + c16 * 32 + 16) = (f32x4){1.f - x2[0] * IS, 1.f - x2[1] * IS, 1.f - x3[0] * IS, 1.f - x3[1] * IS};
                    *(LAS f32x4*)(L + O_U + row * FST + c16 * 32) = (f32x4){bflo(ru[r].x), bfhi(ru[r].x), bflo(ru[r].y), bfhi(ru[r].y)};
                    *(LAS f32x4*)(L + O_U + row * FST + c16 * 32 + 16) = (f32x4){bflo(ru[r].z), bfhi(ru[r].z), bflo(ru[r].w), bfhi(ru[r].w)}; }
                if (d == 0) PB_LOAD(i, 1); else PB_LOAD(i + 1, 0);
            } else {
            f32x4 aR[4], aI[4];
#pragma unroll
            for (int mt = 0; mt < 4; ++mt) { aR[mt] = (f32x4){0.f, 0.f, 0.f, 0.f}; aI[mt] = (f32x4){0.f, 0.f, 0.f, 0.f}; }
#pragma unroll
            for (int ks = 0; ks < 4; ++ks)
#pragma unroll
                for (int mt = 0; mt < 4; ++mt) { const bf16x8 xb = *(const LAS bf16x8*)(L + O_XCB + (16 * mt + fr) * 272 + (32 * ks + 8 * fq) * 2);
                    aR[mt] = __builtin_amdgcn_mfma_f32_16x16x32_bf16(wf[d][0][ks], xb, aR[mt], 0, 0, 0);
                    aI[mt] = __builtin_amdgcn_mfma_f32_16x16x32_bf16(wf[d][1][ks], xb, aI[mt], 0, 0, 0); }
#pragma unroll
            for (int mt = 0; mt < 4; ++mt) { const int tl = 16 * mt + fr, cl = 16 * w + 4 * fq;
                const f32x4 xc = *(const LAS f32x4*)(L + O_XCF + tl * FST + cl * 4);
                f32x4 av, uv;
#pragma unroll
                for (int e = 0; e < 4; ++e) { const float r = sigmoidf_(aR[mt][e] + br4[d][e]), ig = sigmoidf_(aI[mt][e] + bi4[d][e]);
                    const float a_ = __builtin_amdgcn_exp2f(r * sp4[d][e]); av[e] = a_; uv[e] = __builtin_amdgcn_sqrtf(fmaxf(1.f - a_ * a_, 0.f)) * (ig * xc[e]); }
                *(LAS f32x4*)(L + o_a + tl * FST + cl * 4) = av; *(LAS f32x4*)(L + O_U + tl * FST + cl * 4) = uv;
                { const size_t go = (mrow0 + tl) * DM + blk * 128 + cl;
                  int xa = 0; xa = __builtin_amdgcn_cvt_pk_fp8_f32((1.f - av[0]) * 4096.f, (1.f - av[1]) * 4096.f, xa, false); xa = __builtin_amdgcn_cvt_pk_fp8_f32((1.f - av[2]) * 4096.f, (1.f - av[3]) * 4096.f, xa, true);
                  v2u xu; xu.x = pk2(uv[0], uv[1]); xu.y = pk2(uv[2], uv[3]);
                  *(unsigned*)((d ? LA1 : LA0) + go) = (unsigned)xa; *(v2u*)((d ? LU1 : LU0) + go) = xu; } }
            }
            __syncthreads();
            {
                const int c = tid & 127, sub = tid >> 7;
                LAS float* pa = (LAS float*)(L + o_a) + c; const LAS float* pu = (const LAS float*)(L + O_U) + c;
                LAS f32x2* SUBT = (LAS f32x2*)(L + O_SUB);
                float h = 0.f, A = 1.f;
#pragma unroll
                for (int s2 = 0; s2 < 16; ++s2) { const int tl = d ? (16 * sub + 15 - s2) : (16 * sub + s2); const float a = pa[tl * 132], u = pu[tl * 132]; h = a * h + u; A *= a; }
                SUBT[sub * 128 + c] = (f32x2){A, h};
                __syncthreads();
                if (!PB) {
                    if (sub == 0) { float HH = 0.f, AA = 1.f;
#pragma unroll
                        for (int q = 0; q < 4; ++q) { const f32x2 ah = SUBT[(d ? 3 - q : q) * 128 + c]; HH = ah[0] * HH + ah[1]; AA *= ah[0]; }
                        AGG[((size_t)(b * 64 + seg) * 2 + d) * DM + blk * 128 + c] = (f32x2){AA, HH}; }
                } else {
                    float hc = d ? carry1 : carry0;
#pragma unroll
                    for (int q = 0; q < 3; ++q) { const int jq = d ? 3 - q : q; const f32x2 ah = SUBT[jq * 128 + c]; if (d ? (jq > sub) : (jq < sub)) hc = ah[0] * hc + ah[1]; }
                    if (d == 0) {
#pragma unroll
                        for (int s2 = 0; s2 < 16; ++s2) { const int tl = 16 * sub + s2; hc = pa[tl * 132] * hc + pu[tl * 132]; pa[tl * 132] = hc; }
                    } else { LAS float* ph = (LAS float*)(L + O_A) + c;
#pragma unroll
                        for (int s2 = 0; s2 < 16; ++s2) { const int tl = 16 * sub + 15 - s2; hc = pa[tl * 132] * hc + pu[tl * 132]; ph[tl * 132] += hc; } }
                }
            }
            __syncthreads();
        }
        if (PB) {
#pragma unroll
            for (int r = 0; r < 2; ++r) { const int e = tid + NTHR * r, row = e >> 4, c16 = e & 15;
                const v4u g = lgreg[r];
                const f32x4 h0 = *(const LAS f32x4*)(L + O_A + row * FST + c16 * 32), h1 = *(const LAS f32x4*)(L + O_A + row * FST + c16 * 32 + 16);
                v4u o;
                o.x = pk2(h0[0] * gelu_fast(bflo(g.x)), h0[1] * gelu_fast(bfhi(g.x))); o.y = pk2(h0[2] * gelu_fast(bflo(g.y)), h0[3] * gelu_fast(bfhi(g.y)));
                o.z = pk2(h1[0] * gelu_fast(bflo(g.z)), h1[1] * gelu_fast(bfhi(g.z))); o.w = pk2(h1[2] * gelu_fast(bflo(g.w)), h1[3] * gelu_fast(bfhi(g.w)));
                *(v4u*)(YL + (mrow0 + row) * DM + blk * 128 + c16 * 8) = o; }
            __syncthreads();
        }
    }
#undef RAW_LOAD
#undef PB_LOAD
}

__device__ __forceinline__ void mconv_phase(Frame& F) {
    const bf16* XM = (const bf16*)(F.ws + WS_XM); bf16* XC = (bf16*)F.out + (size_t)MTOK * DM;
    const float* cw = F.in[4]; const float* cb = F.in[5];
    const int NT = MTOK / 32 * 128;
    for (int g = F.bid * NTHR + F.tid; g < NT; g += F.G * NTHR) {
        const int chunk = g & 127, run = g >> 7, c0 = chunk * 8, m0 = run * 32, t0 = m0 & (SEQ - 1);
        float w[4][8], bias[8];
#pragma unroll
        for (int j = 0; j < 4; ++j) { const f32x4 a = *(const f32x4*)(cw + j * DM + c0), b = *(const f32x4*)(cw + j * DM + c0 + 4);
            w[j][0] = a[0]; w[j][1] = a[1]; w[j][2] = a[2]; w[j][3] = a[3]; w[j][4] = b[0]; w[j][5] = b[1]; w[j][6] = b[2]; w[j][7] = b[3]; }
        { const f32x4 a = *(const f32x4*)(cb + c0), b = *(const f32x4*)(cb + c0 + 4);
            bias[0] = a[0]; bias[1] = a[1]; bias[2] = a[2]; bias[3] = a[3]; bias[4] = b[0]; bias[5] = b[1]; bias[6] = b[2]; bias[7] = b[3]; }
        const v4u zero = {0u, 0u, 0u, 0u};
#pragma unroll 1
        for (int hb = 0; hb < 2; ++hb) {
            const int r0 = m0 + 16 * hb, tt = t0 + 16 * hb;
            v4u rows[19];
            rows[0] = (tt >= 2) ? *(const v4u*)(XM + (size_t)(r0 - 2) * DM + c0) : zero;
            rows[1] = (tt >= 1) ? *(const v4u*)(XM + (size_t)(r0 - 1) * DM + c0) : zero;
#pragma unroll
            for (int i = 0; i < 16; ++i) rows[2 + i] = *(const v4u*)(XM + (size_t)(r0 + i) * DM + c0);
            rows[18] = (tt + 16 < SEQ) ? *(const v4u*)(XM + (size_t)(r0 + 16) * DM + c0) : zero;
#pragma unroll
            for (int i = 0; i < 16; ++i) {
                float y[8];
#pragma unroll
                for (int e = 0; e < 8; ++e) y[e] = bias[e];
#pragma unroll
                for (int j = 0; j < 4; ++j) {
                    const unsigned p0 = rows[i + j].x, p1 = rows[i + j].y, p2 = rows[i + j].z, p3 = rows[i + j].w;
                    y[0] += w[j][0] * bflo(p0); y[1] += w[j][1] * bfhi(p0); y[2] += w[j][2] * bflo(p1); y[3] += w[j][3] * bfhi(p1);
                    y[4] += w[j][4] * bflo(p2); y[5] += w[j][5] * bfhi(p2); y[6] += w[j][6] * bflo(p3); y[7] += w[j][7] * bfhi(p3);
                }
#pragma unroll
                for (int e = 0; e < 8; ++e) y[e] = y[e] * sigmoidf_(y[e]);
                v4u o; o.x = pk2(y[0], y[1]); o.y = pk2(y[2], y[3]); o.z = pk2(y[4], y[5]); o.w = pk2(y[6], y[7]);
                *(v4u*)(XC + (size_t)(r0 + i) * DM + c0) = o;
            }
        }
    }
}

typedef short s16x4 __attribute__((ext_vector_type(4)));
__device__ __forceinline__ bf16x8 tr_read_pair(unsigned a0, unsigned a1) {
    s16x4 r0, r1;
    asm volatile("ds_read_b64_tr_b16 %0, %2\n\tds_read_b64_tr_b16 %1, %3\n\ts_waitcnt lgkmcnt(0)" : "=&v"(r0), "=&v"(r1) : "v"(a0), "v"(a1) : "memory");
    return __builtin_shufflevector(r0, r1, 0, 1, 2, 3, 4, 5, 6, 7);
}
__device__ __forceinline__ float dpp_shr(float oldv, float x, int n) {
    const int o = __builtin_bit_cast(int, oldv), v = __builtin_bit_cast(int, x);
    int r;
    if (n == 1) r = __builtin_amdgcn_update_dpp(o, v, 0x111, 0xf, 0xf, false);
    else if (n == 2) r = __builtin_amdgcn_update_dpp(o, v, 0x112, 0xf, 0xf, false);
    else if (n == 4) r = __builtin_amdgcn_update_dpp(o, v, 0x114, 0xf, 0xf, false);
    else r = __builtin_amdgcn_update_dpp(o, v, 0x118, 0xf, 0xf, false);
    return __builtin_bit_cast(float, r);
}
__device__ __forceinline__ float rdlane(float x, int l) { return __builtin_bit_cast(float, __builtin_amdgcn_readlane(__builtin_bit_cast(int, x), l)); }
__device__ __forceinline__ float wave_incl_sum(float x, int lane) {
    x += dpp_shr(0.f, x, 1); x += dpp_shr(0.f, x, 2); x += dpp_shr(0.f, x, 4); x += dpp_shr(0.f, x, 8);
    const float t0 = rdlane(x, 15), t1 = rdlane(x, 31), t2 = rdlane(x, 47);
    return x + (lane >= 16 ? t0 : 0.f) + (lane >= 32 ? t1 : 0.f) + (lane >= 48 ? t2 : 0.f);
}
__device__ __forceinline__ float wave_incl_max(float x, int lane) {
    const float NI = -INFINITY;
    x = fmaxf(x, dpp_shr(NI, x, 1)); x = fmaxf(x, dpp_shr(NI, x, 2)); x = fmaxf(x, dpp_shr(NI, x, 4)); x = fmaxf(x, dpp_shr(NI, x, 8));
    const float t0 = rdlane(x, 15), t1 = rdlane(x, 31), t2 = rdlane(x, 47);
    return fmaxf(fmaxf(x, lane >= 16 ? t0 : NI), fmaxf(lane >= 32 ? t1 : NI, lane >= 48 ? t2 : NI));
}
__device__ __forceinline__ void mscan_phase(Frame& F) {
    const bf16* Q = (const bf16*)(F.ws + WS_LG); const bf16* K = (const bf16*)(F.ws + WS_K); const bf16* V = (const bf16*)(F.ws + WS_XL);
    const float* GT = (const float*)(F.ws + WS_GATE);
    constexpr int KS = 0, CTI = 33792, VT = 67584, VWT = 86016, PB = 104448, TAB = 113664, NT = 116736, NPART = 117760, DENT = 119808;
    constexpr int KST = 528, VST = 144, TABSZ = 1536;
    LAS unsigned char* L = F.lds;
    const int tid = F.tid, lane = F.lane, w = F.wave, fr = lane & 15, fq = lane >> 4, pt = w & 3, wg = w >> 2;
    for (int item = F.bid; item < 256; item += F.G) {
        const int es = item & 3, dir = (item >> 2) & 1, h = (item >> 3) & 3, b = item >> 5;
        bf16* H = dir ? ((bf16*)F.out + (size_t)MTOK * DM) : (bf16*)(F.ws + WS_XM);
        const size_t rowbase = (size_t)b * SEQ;
#define TOF(c, p) (dir ? (SEQ - 1 - 64 * (c) - (p)) : (64 * (c) + (p)))
        for (int e = tid; e < (33792 + 1024) / 4; e += NTHR) { if (e < 33792 / 4) ((LAS unsigned*)(L + CTI))[e] = 0u; else ((LAS unsigned*)(L + NT))[e - 33792 / 4] = 0u; }
        float m_run = 0.f;
        float gi_n = 0.f, gf_n = 0.f;
        if (w == 4) { const size_t m = rowbase + TOF(0, lane); gi_n = GT[m * 16 + dir * 8 + h]; gf_n = GT[m * 16 + dir * 8 + 4 + h]; }
#define G1_TABLES(setp) do { \
            const float logf_ = fminf(gf_n, 0.f) - __logf(1.f + __expf(-fabsf(gf_n))); const float b_ = wave_incl_sum(logf_, lane); const float a_ = gi_n - b_; \
            const float M_ = fmaxf(m_run, wave_incl_max(a_, lane)); const float Mend_ = rdlane(M_, 63), g_ = rdlane(b_, 63); \
            LAS float* T_ = (LAS float*)(setp); T_[lane] = a_; T_[64 + lane] = M_; T_[128 + lane] = __expf(m_run - M_); T_[192 + lane] = __expf(-(b_ + M_)); T_[256 + lane] = __expf(a_ - Mend_); \
            if (lane == 0) { T_[320] = __expf(m_run - Mend_); T_[321] = g_ + Mend_; } \
            m_run = g_ + Mend_; } while (0)
        if (w == 4) G1_TABLES(L + TAB);
        __syncthreads();
        bf16x8 qf[8];
        v4u kreg[4]; v4u vreg;
#define LOAD_KV(c) do { _Pragma("unroll") for (int r_ = 0; r_ < 4; ++r_) { const int i_ = tid + NTHR * r_, s_ = i_ >> 5, c16_ = i_ & 31; \
                kreg[r_] = *(const v4u*)(K + (rowbase + TOF(c, s_)) * DM + h * 256 + c16_ * 8); } \
            { const int s_ = tid & 63, e8_ = tid >> 6; vreg = *(const v4u*)(V + (rowbase + TOF(c, s_)) * DM + h * 256 + es * 64 + e8_ * 8); } } while (0)
#define STORE_KV(setidx) do { _Pragma("unroll") for (int r_ = 0; r_ < 4; ++r_) { const int i_ = tid + NTHR * r_, s_ = i_ >> 5, c16_ = i_ & 31; \
                *(LAS v4u*)(L + KS + s_ * KST + c16_ * 16) = kreg[r_]; } \
            { const int s_ = tid & 63, e8_ = tid >> 6; const float ws_ = ((const LAS float*)(L + TAB + (setidx) * TABSZ))[256 + s_]; \
              LAS bf16* vt_ = (LAS bf16*)(L + VT + (setidx) * 9216); LAS bf16* vw_ = (LAS bf16*)(L + VWT + (setidx) * 9216); \
              const unsigned wv_[4] = {vreg.x, vreg.y, vreg.z, vreg.w}; \
              _Pragma("unroll") for (int j_ = 0; j_ < 4; ++j_) { const float lo_ = bflo(wv_[j_]), hi_ = bfhi(wv_[j_]); const int e_ = e8_ * 8 + 2 * j_; \
                vt_[e_ * 72 + s_] = (bf16)(wv_[j_] & 0xffffu); vt_[(e_ + 1) * 72 + s_] = (bf16)(wv_[j_] >> 16); \
                vw_[e_ * 72 + s_] = (bf16)f2bf(lo_ * ws_); vw_[(e_ + 1) * 72 + s_] = (bf16)f2bf(hi_ * ws_); } } } while (0)
#define LOAD_Q(c) do { const size_t m_ = rowbase + TOF(c, 16 * pt + fr); _Pragma("unroll") for (int ks_ = 0; ks_ < 8; ++ks_) \
                qf[ks_] = *(const bf16x8*)(Q + m_ * DM + h * 256 + 32 * ks_ + 8 * fq); } while (0)
        LOAD_KV(0); LOAD_Q(0);
        STORE_KV(0);
        f32x4 Cacc[8], Nacc[2];
#pragma unroll
        for (int i = 0; i < 8; ++i) Cacc[i] = (f32x4){0.f, 0.f, 0.f, 0.f};
        Nacc[0] = (f32x4){0.f, 0.f, 0.f, 0.f}; Nacc[1] = (f32x4){0.f, 0.f, 0.f, 0.f};
        __syncthreads();
        for (int c = 0; c < 64; ++c) {
            const int cur = c & 1, nxt = cur ^ 1;
            const bool has_next = (c + 1 < 64);
            const LAS float* T = (const LAS float*)(L + TAB + cur * TABSZ);
            if (has_next) { LOAD_KV(c + 1); if (w == 4) { const size_t m = rowbase + TOF(c + 1, lane); gi_n = GT[m * 16 + dir * 8 + h]; gf_n = GT[m * 16 + dir * 8 + 4 + h]; } }
            const int p = 16 * pt + fr;
            const float Mp = T[64 + p], wi_p = T[128 + p];
            float cs = 0.f;
            f32x4 O[2] = {(f32x4){0.f, 0.f, 0.f, 0.f}, (f32x4){0.f, 0.f, 0.f, 0.f}}, sa[2] = {(f32x4){0.f, 0.f, 0.f, 0.f}, (f32x4){0.f, 0.f, 0.f, 0.f}};
            const bool s0on = (2 * wg <= pt), s1on = (2 * wg + 1 <= pt);
#define KF(i, ks) (*(const LAS bf16x8*)(L + KS + (16 * (2 * wg + (i)) + fr) * KST + (32 * (ks) + 8 * fq) * 2))
#define CF(i, ks) (*(const LAS bf16x8*)(L + CTI + (16 * (2 * wg + (i)) + fr) * KST + (32 * (ks) + 8 * fq) * 2))
            if (s1on) {
#pragma unroll
                for (int ks = 0; ks < 8; ++ks) { const bf16x8 k0 = KF(0, ks), k1 = KF(1, ks), c0 = CF(0, ks), c1 = CF(1, ks);
                    sa[0] = __builtin_amdgcn_mfma_f32_16x16x32_bf16(k0, qf[ks], sa[0], 0, 0, 0); sa[1] = __builtin_amdgcn_mfma_f32_16x16x32_bf16(k1, qf[ks], sa[1], 0, 0, 0);
                    O[0] = __builtin_amdgcn_mfma_f32_16x16x32_bf16(c0, qf[ks], O[0], 0, 0, 0); O[1] = __builtin_amdgcn_mfma_f32_16x16x32_bf16(c1, qf[ks], O[1], 0, 0, 0); }
            } else if (s0on) {
#pragma unroll
                for (int ks = 0; ks < 8; ++ks) { const bf16x8 k0 = KF(0, ks), c0 = CF(0, ks), c1 = CF(1, ks);
                    sa[0] = __builtin_amdgcn_mfma_f32_16x16x32_bf16(k0, qf[ks], sa[0], 0, 0, 0);
                    O[0] = __builtin_amdgcn_mfma_f32_16x16x32_bf16(c0, qf[ks], O[0], 0, 0, 0); O[1] = __builtin_amdgcn_mfma_f32_16x16x32_bf16(c1, qf[ks], O[1], 0, 0, 0); }
            } else {
#pragma unroll
                for (int ks = 0; ks < 8; ++ks) { const bf16x8 c0 = CF(0, ks), c1 = CF(1, ks);
                    O[0] = __builtin_amdgcn_mfma_f32_16x16x32_bf16(c0, qf[ks], O[0], 0, 0, 0); O[1] = __builtin_amdgcn_mfma_f32_16x16x32_bf16(c1, qf[ks], O[1], 0, 0, 0); }
            }
#undef KF
#undef CF
#pragma unroll
            for (int i = 0; i < 2; ++i) { const int st = 2 * wg + i;
                v2u pw = {0u, 0u};
                if (i ? s1on : s0on) {
                    const f32x4 a4 = *(const LAS f32x4*)(T + 16 * st + 4 * fq);
                    float pv[4];
#pragma unroll
                    for (int r = 0; r < 4; ++r) { const int s_ = 16 * st + 4 * fq + r; const float wgt = (s_ <= p) ? __expf(a4[r] - Mp) : 0.f; pv[r] = sa[i][r] * wgt; cs += pv[r]; }
                    pw.x = pk2(pv[0], pv[1]); pw.y = pk2(pv[2], pv[3]);
                }
                *(LAS v2u*)(L + PB + p * VST + (16 * st + 4 * fq) * 2) = pw; }
            float di = 0.f;
#define DEN_INTER(ks) do { const f32x4 n0 = *(const LAS f32x4*)(L + NT + (32 * (ks) + 8 * fq) * 4), n1 = *(const LAS f32x4*)(L + NT + (32 * (ks) + 8 * fq) * 4 + 16); \
                const v4u qw = __builtin_bit_cast(v4u, qf[ks]); \
                di += bflo(qw.x) * n0[0] + bfhi(qw.x) * n0[1] + bflo(qw.y) * n0[2] + bfhi(qw.y) * n0[3] + bflo(qw.z) * n1[0] + bfhi(qw.z) * n1[1] + bflo(qw.w) * n1[2] + bfhi(qw.w) * n1[3]; } while (0)
            if (wg == 0) { DEN_INTER(0); DEN_INTER(1); DEN_INTER(2); DEN_INTER(3); }
            else { DEN_INTER(4); DEN_INTER(5); DEN_INTER(6); DEN_INTER(7); }
#undef DEN_INTER
            di += __shfl_xor(di, 16); di += __shfl_xor(di, 32);
            cs += __shfl_xor(cs, 16); cs += __shfl_xor(cs, 32);
            if (fq == 0) ((LAS float*)(L + DENT))[wg * 64 + p] = wi_p * di + cs;
            if (has_next) LOAD_Q(c + 1);
            if (has_next && w == 4) G1_TABLES(L + TAB + nxt * TABSZ);
            __syncthreads();
#pragma unroll
            for (int i = 0; i < 2; ++i) { const int et = 2 * wg + i; O[i] = O[i] * wi_p;
#pragma unroll
                for (int ks = 0; ks < 2; ++ks) { const bf16x8 vf = *(const LAS bf16x8*)(L + VT + cur * 9216 + (16 * et + fr) * VST + (32 * ks + 8 * fq) * 2);
                    const bf16x8 pf = *(const LAS bf16x8*)(L + PB + p * VST + (32 * ks + 8 * fq) * 2);
                    O[i] = __builtin_amdgcn_mfma_f32_16x16x32_bf16(vf, pf, O[i], 0, 0, 0); } }
            { const float den = ((const LAS float*)(L + DENT))[p] + ((const LAS float*)(L + DENT))[64 + p];
              const float inv = 1.f / fmaxf(fabsf(den), T[192 + p]);
              const size_t m = rowbase + TOF(c, p);
#pragma unroll
              for (int i = 0; i < 2; ++i) { const int et = 2 * wg + i; v2u o; o.x = pk2(O[i][0] * inv, O[i][1] * inv); o.y = pk2(O[i][2] * inv, O[i][3] * inv);
                  *(v2u*)(H + m * DM + h * 256 + es * 64 + 16 * et + 4 * fq) = o; } }
            { const float decay = T[320];
              const bf16x8 vw0 = *(const LAS bf16x8*)(L + VWT + cur * 9216 + (16 * pt + fr) * VST + (8 * fq) * 2);
              const bf16x8 vw1 = *(const LAS bf16x8*)(L + VWT + cur * 9216 + (16 * pt + fr) * VST + (32 + 8 * fq) * 2);
              bf16x8 wsf0, wsf1;
              { const f32x4 w0 = *(const LAS f32x4*)(T + 256 + 8 * fq), w1 = *(const LAS f32x4*)(T + 256 + 8 * fq + 4), w2 = *(const LAS f32x4*)(T + 288 + 8 * fq), w3 = *(const LAS f32x4*)(T + 288 + 8 * fq + 4);
                const bool c0 = (fr == 0);
                v4u a, b; a.x = c0 ? pk2(w0[0], w0[1]) : 0u; a.y = c0 ? pk2(w0[2], w0[3]) : 0u; a.z = c0 ? pk2(w1[0], w1[1]) : 0u; a.w = c0 ? pk2(w1[2], w1[3]) : 0u;
                b.x = c0 ? pk2(w2[0], w2[1]) : 0u; b.y = c0 ? pk2(w2[2], w2[3]) : 0u; b.z = c0 ? pk2(w3[0], w3[1]) : 0u; b.w = c0 ? pk2(w3[2], w3[3]) : 0u;
                wsf0 = __builtin_bit_cast(bf16x8, a); wsf1 = __builtin_bit_cast(bf16x8, b); }
              const int l16 = lane & 15, q4 = l16 >> 2, p4 = l16 & 3;
              const unsigned kb = (unsigned)(uintptr_t)(L + KS) + (unsigned)((8 * fq + q4) * KST + 4 * p4 * 2);
#define TR_READS "ds_read_b64_tr_b16 %0, %[ad]\n\tds_read_b64_tr_b16 %1, %[ad] offset:2112\n\tds_read_b64_tr_b16 %2, %[ad] offset:16896\n\tds_read_b64_tr_b16 %3, %[ad] offset:19008\n\t" \
                 "ds_read_b64_tr_b16 %4, %[ad] offset:32\n\tds_read_b64_tr_b16 %5, %[ad] offset:2144\n\tds_read_b64_tr_b16 %6, %[ad] offset:16928\n\tds_read_b64_tr_b16 %7, %[ad] offset:19040"
#define TR_OUT(R) "=&v"(R[0]), "=&v"(R[1]), "=&v"(R[2]), "=&v"(R[3]), "=&v"(R[4]), "=&v"(R[5]), "=&v"(R[6]), "=&v"(R[7])
#define TR_INOUT(R) "+v"(R[0]), "+v"(R[1]), "+v"(R[2]), "+v"(R[3]), "+v"(R[4]), "+v"(R[5]), "+v"(R[6]), "+v"(R[7])
              s16x4 rA[8], rB[8];
              { const unsigned a0 = kb + (8 * wg) * 32; asm volatile(TR_READS : TR_OUT(rA) : [ad] "v"(a0) : "memory"); }
#define C_STEP(dtl, RC, RN) do { \
                  if ((dtl) < 6) { const unsigned a1 = kb + (8 * wg + (dtl) + 2) * 32; asm volatile(TR_READS "\n\ts_waitcnt lgkmcnt(8)" : TR_OUT(RN), TR_INOUT(RC) : [ad] "v"(a1) : "memory"); } \
                  else asm volatile("s_waitcnt lgkmcnt(0)" : TR_INOUT(RC) : : "memory"); \
                  const bf16x8 k0 = __builtin_shufflevector(RC[0], RC[1], 0, 1, 2, 3, 4, 5, 6, 7), k1 = __builtin_shufflevector(RC[2], RC[3], 0, 1, 2, 3, 4, 5, 6, 7); \
                  const bf16x8 k2 = __builtin_shufflevector(RC[4], RC[5], 0, 1, 2, 3, 4, 5, 6, 7), k3 = __builtin_shufflevector(RC[6], RC[7], 0, 1, 2, 3, 4, 5, 6, 7); \
                  Cacc[dtl] = Cacc[dtl] * decay; Cacc[(dtl) + 1] = Cacc[(dtl) + 1] * decay; \
                  Cacc[dtl] = __builtin_amdgcn_mfma_f32_16x16x32_bf16(k0, vw0, Cacc[dtl], 0, 0, 0); \
                  Cacc[(dtl) + 1] = __builtin_amdgcn_mfma_f32_16x16x32_bf16(k2, vw0, Cacc[(dtl) + 1], 0, 0, 0); \
                  Cacc[dtl] = __builtin_amdgcn_mfma_f32_16x16x32_bf16(k1, vw1, Cacc[dtl], 0, 0, 0); \
                  Cacc[(dtl) + 1] = __builtin_amdgcn_mfma_f32_16x16x32_bf16(k3, vw1, Cacc[(dtl) + 1], 0, 0, 0); \
                  if ((dtl) == 2 * pt) {                                            \
                      Nacc[0] = Nacc[0] * decay; Nacc[1] = Nacc[1] * decay; \
                      Nacc[0] = __builtin_amdgcn_mfma_f32_16x16x32_bf16(k0, wsf0, Nacc[0], 0, 0, 0); Nacc[1] = __builtin_amdgcn_mfma_f32_16x16x32_bf16(k2, wsf0, Nacc[1], 0, 0, 0); \
                      Nacc[0] = __builtin_amdgcn_mfma_f32_16x16x32_bf16(k1, wsf1, Nacc[0], 0, 0, 0); Nacc[1] = __builtin_amdgcn_mfma_f32_16x16x32_bf16(k3, wsf1, Nacc[1], 0, 0, 0); } } while (0)
              C_STEP(0, rA, rB); C_STEP(2, rB, rA); C_STEP(4, rA, rB); C_STEP(6, rB, rA);
#undef C_STEP
#undef TR_READS
#undef TR_OUT
#undef TR_INOUT
            }
            __syncthreads();
            { const float decay = T[320];
#pragma unroll
              for (int dtl = 0; dtl < 8; ++dtl) { const int dt = 8 * wg + dtl; v2u o; o.x = pk2(Cacc[dtl][0], Cacc[dtl][1]); o.y = pk2(Cacc[dtl][2], Cacc[dtl][3]);
                  *(LAS v2u*)(L + CTI + (16 * pt + fr) * KST + (16 * dt + 4 * fq) * 2) = o; }
              if (fr == 0) { *(LAS f32x4*)(L + NT + (16 * (8 * wg + 2 * pt) + 4 * fq) * 4) = Nacc[0]; *(LAS f32x4*)(L + NT + (16 * (8 * wg + 2 * pt + 1) + 4 * fq) * 4) = Nacc[1]; } }
            if (has_next) STORE_KV(nxt);
            __syncthreads();
        }
#undef TOF
#undef G1_TABLES
#undef LOAD_KV
#undef STORE_KV
#undef LOAD_Q
    }
}

__device__ __forceinline__ void ym_phase(Frame& F) {
    const bf16* HF = (const bf16*)(F.ws + WS_XM); const bf16* HB = (const bf16*)F.out + (size_t)MTOK * DM; bf16* OP = (bf16*)(F.ws + WS_OP);
    const float* ng = F.in[9];
    const int gw = F.bid * NWAVES + F.wave, NGW = F.G * NWAVES;
    for (int m = gw; m < MTOK; m += NGW) {
#pragma unroll
        for (int hd = 0; hd < 4; ++hd) {
            const size_t o = (size_t)m * DM + hd * 256 + F.lane * 4;
            const v2u a = *(const v2u*)(HF + o), b = *(const v2u*)(HB + o), op = *(const v2u*)(OP + o);
            const float v0 = bflo(a.x) + bflo(b.x), v1 = bfhi(a.x) + bfhi(b.x), v2 = bflo(a.y) + bflo(b.y), v3 = bfhi(a.y) + bfhi(b.y);
            const float r = rsqrtf(wave_sum((v0 * v0 + v1 * v1) + (v2 * v2 + v3 * v3)) * (1.f / 256.f) + EPS);
            const f32x4 g = *(const f32x4*)(ng + hd * 256 + F.lane * 4);
            v2u w; w.x = pk2(sigmoidf_(bflo(op.x)) * v0 * r * g[0], sigmoidf_(bfhi(op.x)) * v1 * r * g[1]);
            w.y = pk2(sigmoidf_(bflo(op.y)) * v2 * r * g[2], sigmoidf_(bfhi(op.y)) * v3 * r * g[3]);
            *(v2u*)(OP + o) = w;
        }
    }
    {
        float* usc = (float*)(F.ws + WS_LG + 16 * MiB); float* vsc = usc + NEXP;
        for (int row = gw; row < 2 * NEXP; row += NGW) {
            const bool isv = row >= NEXP; const int r = isv ? row - NEXP : row;
            const f32x4* src = (const f32x4*)(F.in[isv ? 24 : 23] + (size_t)r * DM) + F.lane * 4;
            f32x4 a[4]; float ss = 0.f;
#pragma unroll
            for (int j = 0; j < 4; ++j) { a[j] = src[j]; ss += (a[j][0] * a[j][0] + a[j][1] * a[j][1]) + (a[j][2] * a[j][2] + a[j][3] * a[j][3]); }
            const float rms = sqrtf(wave_sum(ss) * (1.f / DM));
            const float sc = fmaxf(rms * 0.5f, 1e-30f), inv = 1.f / sc;
            unsigned o[2] = {0u, 0u};
#pragma unroll
            for (int j = 0; j < 4; ++j) { const f32x4 q = a[j] * inv;
                if (j & 1) { o[j >> 1] = __builtin_amdgcn_cvt_scalef32_pk_fp4_f32(o[j >> 1], q[0], q[1], 1.0f, 2); o[j >> 1] = __builtin_amdgcn_cvt_scalef32_pk_fp4_f32(o[j >> 1], q[2], q[3], 1.0f, 3); }
                else       { o[j >> 1] = __builtin_amdgcn_cvt_scalef32_pk_fp4_f32(o[j >> 1], q[0], q[1], 1.0f, 0); o[j >> 1] = __builtin_amdgcn_cvt_scalef32_pk_fp4_f32(o[j >> 1], q[2], q[3], 1.0f, 1); } }
            *(v2u*)(F.ws + WS_LG + (isv ? 8 * MiB : 0) + (size_t)r * (DM / 2) + F.lane * 8) = (v2u){o[0], o[1]};
            if (F.lane == 0) (isv ? vsc : usc)[r] = sc;
        }
    }
}

typedef float f32x16 __attribute__((ext_vector_type(16)));
#define TOPK_INSERT(L, xv) do { const float x_ = (xv); \
    L[15] = __builtin_amdgcn_fmed3f(L[14], L[15], x_); L[14] = __builtin_amdgcn_fmed3f(L[13], L[14], x_); L[13] = __builtin_amdgcn_fmed3f(L[12], L[13], x_); L[12] = __builtin_amdgcn_fmed3f(L[11], L[12], x_); \
    L[11] = __builtin_amdgcn_fmed3f(L[10], L[11], x_); L[10] = __builtin_amdgcn_fmed3f(L[9], L[10], x_); L[9] = __builtin_amdgcn_fmed3f(L[8], L[9], x_); L[8] = __builtin_amdgcn_fmed3f(L[7], L[8], x_); \
    L[7] = __builtin_amdgcn_fmed3f(L[6], L[7], x_); L[6] = __builtin_amdgcn_fmed3f(L[5], L[6], x_); L[5] = __builtin_amdgcn_fmed3f(L[4], L[5], x_); L[4] = __builtin_amdgcn_fmed3f(L[3], L[4], x_); \
    L[3] = __builtin_amdgcn_fmed3f(L[2], L[3], x_); L[2] = __builtin_amdgcn_fmed3f(L[1], L[2], x_); L[1] = __builtin_amdgcn_fmed3f(L[0], L[1], x_); L[0] = fmaxf(L[0], x_); } while (0)
#define SEL_CE(L, a, b) do { const float hi_ = fmaxf(L[a], L[b]), lo_ = fminf(L[a], L[b]); L[a] = hi_; L[b] = lo_; } while (0)
#define SORT16_DESC(L) do { SEL_CE(L, 0, 1); SEL_CE(L, 2, 3); SEL_CE(L, 0, 2); SEL_CE(L, 1, 3); SEL_CE(L, 1, 2); SEL_CE(L, 4, 5); SEL_CE(L, 6, 7); SEL_CE(L, 4, 6); SEL_CE(L, 5, 7); SEL_CE(L, 5, 6); SEL_CE(L, 0, 4); SEL_CE(L, 2, 6); SEL_CE(L, 2, 4); SEL_CE(L, 1, 5); SEL_CE(L, 3, 7); SEL_CE(L, 3, 5); SEL_CE(L, 1, 2); SEL_CE(L, 3, 4); SEL_CE(L, 5, 6); SEL_CE(L, 8, 9); SEL_CE(L, 10, 11); SEL_CE(L, 8, 10); SEL_CE(L, 9, 11); SEL_CE(L, 9, 10); SEL_CE(L, 12, 13); SEL_CE(L, 14, 15); SEL_CE(L, 12, 14); SEL_CE(L, 13, 15); SEL_CE(L, 13, 14); SEL_CE(L, 8, 12); SEL_CE(L, 10, 14); SEL_CE(L, 10, 12); SEL_CE(L, 9, 13); SEL_CE(L, 11, 15); SEL_CE(L, 11, 13); SEL_CE(L, 9, 10); SEL_CE(L, 11, 12); SEL_CE(L, 13, 14); SEL_CE(L, 0, 8); SEL_CE(L, 4, 12); SEL_CE(L, 4, 8); SEL_CE(L, 2, 10); SEL_CE(L, 6, 14); SEL_CE(L, 6, 10); SEL_CE(L, 2, 4); SEL_CE(L, 6, 8); SEL_CE(L, 10, 12); SEL_CE(L, 1, 9); SEL_CE(L, 5, 13); SEL_CE(L, 5, 9); SEL_CE(L, 3, 11); SEL_CE(L, 7, 15); SEL_CE(L, 7, 11); SEL_CE(L, 3, 5); SEL_CE(L, 7, 9); SEL_CE(L, 11, 13); SEL_CE(L, 1, 2); SEL_CE(L, 3, 4); SEL_CE(L, 5, 6); SEL_CE(L, 7, 8); SEL_CE(L, 9, 10); SEL_CE(L, 11, 12); SEL_CE(L, 13, 14); } while (0)
#define BMERGE16_DESC(L) do { SEL_CE(L, 0, 8); SEL_CE(L, 1, 9); SEL_CE(L, 2, 10); SEL_CE(L, 3, 11); SEL_CE(L, 4, 12); SEL_CE(L, 5, 13); SEL_CE(L, 6, 14); SEL_CE(L, 7, 15); SEL_CE(L, 0, 4); SEL_CE(L, 1, 5); SEL_CE(L, 2, 6); SEL_CE(L, 3, 7); SEL_CE(L, 8, 12); SEL_CE(L, 9, 13); SEL_CE(L, 10, 14); SEL_CE(L, 11, 15); SEL_CE(L, 0, 2); SEL_CE(L, 1, 3); SEL_CE(L, 4, 6); SEL_CE(L, 5, 7); SEL_CE(L, 8, 10); SEL_CE(L, 9, 11); SEL_CE(L, 12, 14); SEL_CE(L, 13, 15); SEL_CE(L, 0, 1); SEL_CE(L, 2, 3); SEL_CE(L, 4, 5); SEL_CE(L, 6, 7); SEL_CE(L, 8, 9); SEL_CE(L, 10, 11); SEL_CE(L, 12, 13); SEL_CE(L, 14, 15); } while (0)
template <int I> struct CandRow {
    static __device__ __forceinline__ void run(const float (&L0)[16], const float (&L1)[16], float (&R)[16]) {
        constexpr int NJ = 16 / (I + 1);
#pragma unroll
        for (int j = 0; j < NJ; ++j) { const float sm = L0[I] + L1[j];
            const float pk = __builtin_bit_cast(float, (__builtin_bit_cast(unsigned, sm) & 0xffffff00u) | (unsigned)(I * 16 + j)); TOPK_INSERT(R, pk); }
        if constexpr (I < 15) CandRow<I + 1>::run(L0, L1, R);
    }
};
__device__ __forceinline__ unsigned pick4(unsigned d0, unsigned d1, unsigned d2, unsigned d3, int i) {
    const int q = i >> 2; unsigned d = d0; d = (q == 1) ? d1 : d; d = (q == 2) ? d2 : d; d = (q == 3) ? d3 : d; return (d >> (8 * (i & 3))) & 127u;
}
__device__ __forceinline__ void select_phase(Frame& F) {
    const bf16* PQ = (const bf16*)(F.ws + WS_MG); const bf16* KEYS = (const bf16*)(F.ws + WS_KEYS);
    int* IDX = (int*)(F.ws + WS_K); float* GW = (float*)(F.ws + WS_K + 16 * MiB);
    LAS unsigned char* L = F.lds;
    const int tid = F.tid, lane = F.lane, w = F.wave, l31 = lane & 31, hh = lane >> 5;
    const float NEG_INF = -INFINITY;
    for (int grp = F.bid; grp < MTOK / 128; grp += F.G) {
        const int tb = grp * 4 + (w & 3);
        const size_t m = (size_t)tb * 32 + l31;
        for (int hp = 0; hp < 4; ++hp) {
            __syncthreads();
#pragma unroll 4
            for (int r = 0; r < 16; ++r) { const int e = tid + NTHR * r, R = e >> 4, c = e & 15;
                *(LAS v4u*)(L + R * 256 + ((c ^ (R & 15)) * 16)) = *(const v4u*)(KEYS + ((size_t)(hp * 512 + R) * 128 + c * 8)); }
            __syncthreads();
            const int hl = w >> 2, h = 2 * hp + hl;
            float L0[16], L1[16];
#pragma unroll
            for (int p = 0; p < 2; ++p) {
                bf16x8 qf[8];
#pragma unroll
                for (int ks = 0; ks < 8; ++ks) qf[ks] = *(const bf16x8*)(PQ + m * 2048 + h * 256 + p * 128 + 16 * ks + 8 * hh);
                f32x16 acc[4];
#pragma unroll
                for (int kb = 0; kb < 4; ++kb)
#pragma unroll
                    for (int r = 0; r < 16; ++r) acc[kb][r] = 0.f;
#pragma unroll
                for (int ks = 0; ks < 8; ++ks)
#pragma unroll
                    for (int kb = 0; kb < 4; ++kb) { const int R = (hl * 2 + p) * 128 + 32 * kb + l31;
                        const bf16x8 kf = *(const LAS bf16x8*)(L + R * 256 + (((2 * ks + hh) ^ (lane & 15)) * 16));
                        acc[kb] = __builtin_amdgcn_mfma_f32_32x32x16_bf16(kf, qf[ks], acc[kb], 0, 0, 0); }
                float Lc[16];
                const unsigned hh4 = (unsigned)hh << 2;
#pragma unroll
                for (int kb = 0; kb < 4; ++kb) { float Nw[16];
#pragma unroll
                    for (int r = 0; r < 16; ++r) { const unsigned nlo = (unsigned)(32 * kb + (r & 3) + 8 * (r >> 2));
                        const float av_ = acc[kb][r];
                        Nw[r] = __uint_as_float(((__float_as_uint(av_) & 0xffffff80u) | hh4) | nlo); }
                    SORT16_DESC(Nw);
                    if (kb == 0) {
#pragma unroll
                        for (int i = 0; i < 16; ++i) Lc[i] = Nw[i];
                    } else {
#pragma unroll
                        for (int i = 0; i < 16; ++i) Lc[i] = fmaxf(Lc[i], Nw[15 - i]);
                        BMERGE16_DESC(Lc); } }
                { float Lo[16];
#pragma unroll
                  for (int i = 0; i < 16; ++i) Lo[i] = __shfl_xor(Lc[i], 32);
#pragma unroll
                  for (int i = 0; i < 16; ++i) Lc[i] = fmaxf(Lc[i], Lo[15 - i]);
                  BMERGE16_DESC(Lc); }
#pragma unroll
                for (int i = 0; i < 16; ++i) { if (p == 0) L0[i] = Lc[i]; else L1[i] = Lc[i]; }
            }
            float R[16];
#pragma unroll
            for (int j = 0; j < 16; ++j) { const float sm = L0[0] + L1[j]; R[j] = __builtin_bit_cast(float, (__builtin_bit_cast(unsigned, sm) & 0xffffff00u) | (unsigned)j); }
            SORT16_DESC(R);
            CandRow<1>::run(L0, L1, R);
            unsigned a0 = 0, a1 = 0, a2 = 0, a3 = 0, b0 = 0, b1 = 0, b2 = 0, b3 = 0;
#pragma unroll
            for (int i = 0; i < 4; ++i) { a0 |= (__builtin_bit_cast(unsigned, L0[i]) & 127u) << (8 * i); a1 |= (__builtin_bit_cast(unsigned, L0[4 + i]) & 127u) << (8 * i);
                a2 |= (__builtin_bit_cast(unsigned, L0[8 + i]) & 127u) << (8 * i); a3 |= (__builtin_bit_cast(unsigned, L0[12 + i]) & 127u) << (8 * i);
                b0 |= (__builtin_bit_cast(unsigned, L1[i]) & 127u) << (8 * i); b1 |= (__builtin_bit_cast(unsigned, L1[4 + i]) & 127u) << (8 * i);
                b2 |= (__builtin_bit_cast(unsigned, L1[8 + i]) & 127u) << (8 * i); b3 |= (__builtin_bit_cast(unsigned, L1[12 + i]) & 127u) << (8 * i); }
            float ex[16]; float sum = 0.f; int id[16];
#pragma unroll
            for (int r = 0; r < 16; ++r) { ex[r] = __expf(R[r] - R[0]); sum += ex[r];
                const unsigned cid = __builtin_bit_cast(unsigned, R[r]) & 255u;
                id[r] = (int)(pick4(a0, a1, a2, a3, (int)(cid >> 4)) * 128u + pick4(b0, b1, b2, b3, (int)(cid & 15u))); }
            const float inv = 1.f / sum;
            if (hh == 0) {
#pragma unroll
                for (int q = 0; q < 4; ++q) {
                    *(int4*)(IDX + m * 128 + h * 16 + 4 * q) = make_int4(id[4 * q], id[4 * q + 1], id[4 * q + 2], id[4 * q + 3]);
                    *(f32x4*)(GW + m * 128 + h * 16 + 4 * q) = (f32x4){ex[4 * q] * inv, ex[4 * q + 1] * inv, ex[4 * q + 2] * inv, ex[4 * q + 3] * inv}; }
            }
        }
    }
}

template <int B> __device__ __forceinline__ f32x2 fp4b(unsigned w) { return __builtin_amdgcn_cvt_scalef32_pk_f32_fp4(w, 1.0f, B); }
typedef int v8i_t __attribute__((ext_vector_type(8)));
#define AP_SLOT(e) (4 * (((e) >> 1) & 3) + 2 * ((e) >> 3) + ((e) & 1))
__device__ __forceinline__ void apply_phase(Frame& F, float* OUTP) {
    const unsigned char* U8 = F.ws + WS_LG; const unsigned char* V8 = F.ws + WS_LG + 8 * MiB;
    const float* USC = (const float*)(F.ws + WS_LG + 16 * MiB); const float* VSC = USC + NEXP;
    const int* IDX = (const int*)(F.ws + WS_K); const float* GW = (const float*)(F.ws + WS_K + 16 * MiB);
    const float* g2 = F.in[20]; const float* gf = F.in[25];
    const float* X1 = F.out;
    const int lane = F.lane, fr = lane & 15, fq = lane >> 4;
    constexpr int APW = 2 * 16 * 528 + 1024;
    LAS unsigned char* UL = F.lds + F.wave * APW; LAS unsigned char* VL = UL + 16 * 528; LAS unsigned char* H8 = VL + 16 * 528;
    const int pe = 2 * fq + (fr & 1) + 8 * ((fr >> 1) & 1);
    const int bsh = 8 * (fr & 3); const unsigned mlo = fr < 4 ? ~0u : 0u, mhi = (fr >= 4 && fr < 8) ? ~0u : 0u;
#define AP_LOADROWS(SEL, KB) _Pragma("unroll") for (int e = 0; e < 16; ++e) { \
        const size_t ro = (size_t)__builtin_amdgcn_readlane(SEL, ((KB) + e) & 63) * (DM / 2) + lane * 8; uu[e] = *(const v2u*)(U8 + ro); vv[e] = *(const v2u*)(V8 + ro); }
    for (int grp = F.bid; grp < MTOK / 128; grp += F.G) {
        const int mbase = grp * 128 + F.wave;
        int ni0 = IDX[(size_t)mbase * 128 + lane], ni1 = IDX[(size_t)mbase * 128 + 64 + lane];
        float ngw0 = GW[(size_t)mbase * 128 + lane], ngw1 = GW[(size_t)mbase * 128 + 64 + lane];
        f32x4 nxr[4];
#pragma unroll
        for (int q = 0; q < 4; ++q) nxr[q] = *(const f32x4*)(X1 + (size_t)mbase * DM + lane * 16 + q * 4);
        v2u uu[16], vv[16];
        AP_LOADROWS(ni0, 0)
        int i0 = 0, i1 = 0; float gw0 = 0.f, gw1 = 0.f; f32x4 xr[4], oacc[8];
#pragma unroll
        for (int q = 0; q < 4; ++q) xr[q] = (f32x4){0.f, 0.f, 0.f, 0.f};
#pragma unroll
        for (int i = 0; i < 8; ++i) oacc[i] = (f32x4){0.f, 0.f, 0.f, 0.f};
#pragma unroll 1
        for (int it = 0; it < 128; ++it) {
            const int bt = it & 7, m = mbase + 8 * (it >> 3);
            if (bt == 0) {
                i0 = ni0; i1 = ni1; gw0 = ngw0; gw1 = ngw1; float s = 0.f;
#pragma unroll
                for (int q = 0; q < 4; ++q) { xr[q] = nxr[q]; s += (xr[q][0] * xr[q][0] + xr[q][1] * xr[q][1]) + (xr[q][2] * xr[q][2] + xr[q][3] * xr[q][3]); }
                const float r2 = rsqrtf(wave_sum(s) * (1.f / DM) + EPS);
                v4u h8;
#pragma unroll
                for (int q = 0; q < 4; ++q) { const f32x4 g = *(const f32x4*)(g2 + lane * 16 + q * 4); const f32x4 hq = xr[q] * r2 * g;
                    int pk = 0; pk = __builtin_amdgcn_cvt_pk_fp8_f32(hq[0], hq[1], pk, false); pk = __builtin_amdgcn_cvt_pk_fp8_f32(hq[2], hq[3], pk, true); h8[q] = (unsigned)pk; }
                *(LAS v4u*)(H8 + lane * 16) = h8;
#pragma unroll
                for (int i = 0; i < 8; ++i) oacc[i] = (f32x4){0.f, 0.f, 0.f, 0.f};
                const int mn = (it + 8 < 128) ? m + 8 : m;
                ni0 = IDX[(size_t)mn * 128 + lane]; ni1 = IDX[(size_t)mn * 128 + 64 + lane]; ngw0 = GW[(size_t)mn * 128 + lane]; ngw1 = GW[(size_t)mn * 128 + 64 + lane];
#pragma unroll
                for (int q = 0; q < 4; ++q) nxr[q] = *(const f32x4*)(X1 + (size_t)mn * DM + lane * 16 + q * 4);
            }
            const int k0 = bt * 16;
            const int isel = (k0 < 64) ? i0 : i1;
            const int myidx = __shfl(isel, (k0 + pe) & 63);
            const float su = USC[myidx], sv = VSC[myidx];
#pragma unroll
            for (int e = 0; e < 16; ++e) { *(LAS v2u*)(UL + AP_SLOT(e) * 528 + lane * 8) = uu[e]; *(LAS v2u*)(VL + e * 528 + lane * 8) = vv[e]; }
            { const int nk = (k0 + 16) & 127; const int nsel = (bt == 7) ? ni0 : ((nk < 64) ? i0 : i1);
              AP_LOADROWS(nsel, nk) }
            f32x4 da = (f32x4){0.f, 0.f, 0.f, 0.f}, db = (f32x4){0.f, 0.f, 0.f, 0.f};
#pragma unroll
            for (int ks = 0; ks < 8; ++ks) {
                const v4u af = *(const LAS v4u*)(UL + fr * 528 + 64 * ks + 16 * fq);
                const v4u b0 = *(const LAS v4u*)(H8 + 128 * ks + 16 * fq), b1 = *(const LAS v4u*)(H8 + 128 * ks + 64 + 16 * fq);
                const v8i_t A = {(int)af.x, (int)af.y, (int)af.z, (int)af.w, 0, 0, 0, 0};
                const v8i_t B = {(int)b0.x, (int)b0.y, (int)b0.z, (int)b0.w, (int)b1.x, (int)b1.y, (int)b1.z, (int)b1.w};
                if (ks & 1) db = __builtin_amdgcn_mfma_scale_f32_16x16x128_f8f6f4(A, B, db, 4  , 0  , 0, 0x7F7F7F7F, 0, 0x7F7F7F7F);
                else        da = __builtin_amdgcn_mfma_scale_f32_16x16x128_f8f6f4(A, B, da, 4, 0, 0, 0x7F7F7F7F, 0, 0x7F7F7F7F);
            }
            const f32x4 d4 = da + db;
            const int sel = fr & 3;
            float t = d4[0]; t = (sel == 1) ? d4[1] : t; t = (sel == 2) ? d4[2] : t; t = (sel == 3) ? d4[3] : t;
            const float gk = __shfl((k0 < 64) ? gw0 : gw1, (k0 + pe) & 63);
            const float wl = gk * gelu_fast(t * su) * sv;
            float wm = fabsf(wl); wm = fmaxf(wm, __shfl_xor(wm, 1)); wm = fmaxf(wm, __shfl_xor(wm, 2)); wm = fmaxf(wm, __shfl_xor(wm, 16)); wm = fmaxf(wm, __shfl_xor(wm, 32));
            int E = (int)(__float_as_uint(wm) >> 23); E = E < 8 ? 8 : E;
            const float wq = wl * __uint_as_float((unsigned)(261 - E) << 23);
            const int scb = (E - 7) * 0x01010101;
            v8i_t Bw;
#define AP_WQ(tq, ctrl) { const float wt = __builtin_bit_cast(float, __builtin_amdgcn_update_dpp(0, __builtin_bit_cast(int, wq), ctrl, 0xf, 0xf, false)); \
                const unsigned p8 = (unsigned)__builtin_amdgcn_cvt_pk_fp8_f32(wt, 0.f, 0, false) << bsh; Bw[2 * tq] = (int)(p8 & mlo); Bw[2 * tq + 1] = (int)(p8 & mhi); }
            AP_WQ(0, 0x00) AP_WQ(1, 0x55) AP_WQ(2, 0xAA) AP_WQ(3, 0xFF)
#pragma unroll
            for (int c = 0; c < 8; ++c) {
                v4u av;
                av.x = *(const LAS unsigned*)(VL + (4 * fq + 0) * 528 + 64 * c + 4 * fr); av.y = *(const LAS unsigned*)(VL + (4 * fq + 1) * 528 + 64 * c + 4 * fr);
                av.z = *(const LAS unsigned*)(VL + (4 * fq + 2) * 528 + 64 * c + 4 * fr); av.w = *(const LAS unsigned*)(VL + (4 * fq + 3) * 528 + 64 * c + 4 * fr);
                const v8i_t A = {(int)av.x, (int)av.y, (int)av.z, (int)av.w, 0, 0, 0, 0};
                oacc[c] = __builtin_amdgcn_mfma_scale_f32_16x16x128_f8f6f4(A, Bw, oacc[c], 4, 0, 0, 0x7F7F7F7F, 0, scb);
            }
            if (bt == 7) {
                if (fr < 8) {
#pragma unroll
                    for (int c = 0; c < 8; ++c)
#pragma unroll
                        for (int r = 0; r < 4; ++r) { const float o = oacc[c][r]; *(LAS unsigned*)(UL + 4 * ((4 * c + fq) * 40 + 8 * r + fr)) = __float_as_uint(o); }
                }
                float s2 = 0.f; f32x4 ov[4];
#pragma unroll
                for (int q = 0; q < 4; ++q) { const v4u ou = *(const LAS v4u*)(UL + 4 * ((lane >> 1) * 40 + (lane & 1) * 16 + 4 * q));
                    ov[q] = (f32x4){__uint_as_float(ou.x), __uint_as_float(ou.y), __uint_as_float(ou.z), __uint_as_float(ou.w)} + xr[q];
                    s2 += (ov[q][0] * ov[q][0] + ov[q][1] * ov[q][1]) + (ov[q][2] * ov[q][2] + ov[q][3] * ov[q][3]); }
                const float rf = rsqrtf(wave_sum(s2) * (1.f / DM) + EPS);
#pragma unroll
                for (int q = 0; q < 4; ++q) { const f32x4 g = *(const f32x4*)(gf + lane * 16 + q * 4);
                    *(f32x4*)(OUTP + (size_t)m * DM + lane * 16 + q * 4) = ov[q] * rf * g; }
            }
        }
    }
}

constexpr int N_PHASES = 13;
__global__ void __launch_bounds__(NTHR, 2) mega_fwd(Args args) {
    extern __shared__ __attribute__((aligned(16))) unsigned char lds[];
    Frame F;
    F.lds = (LAS unsigned char*)lds;
    F.tid = threadIdx.x; F.lane = F.tid & 63; F.wave = __builtin_amdgcn_readfirstlane(F.tid >> 6);
    F.G = gridDim.x; F.bid = blockIdx.x;
    F.in = args.in; F.out = args.out; F.ws = args.ws;
    volatile LAS unsigned* MISC = (volatile LAS unsigned*)(F.lds + MISC_OFF);
    for (int u = F.tid; u < (LDS_BYTES - LDSCTL_OFF) / 4; u += NTHR) ((LAS unsigned*)(F.lds + LDSCTL_OFF))[u] = 0u;
    __syncthreads();
    XcdBarrier bar; bar.bar = (unsigned*)(args.ws + WS_CTL) + CW_BAR; bar.x = 0; bar.st = nullptr;
    const bool one_launch = (args.ph_hi - args.ph_lo) > 1;
    if (one_launch) bar = xcd_barrier_post((unsigned*)(args.ws + WS_CTL) + CW_BAR, MISC + 8);
    const int lo = args.ph_lo, hi = args.ph_hi;
#define IN(k) (lo <= (k) && (k) < hi)
#define SEAM(k) do { if (IN(k) && IN((k) + 1)) xcd_barrier(bar); } while (0)
    unsigned char* ws = args.ws;

#ifndef PROBE_MASK
#define PROBE_MASK 0
#endif
#define REP(k) _Pragma("unroll") for (int rep_ = 0; rep_ < (((PROBE_MASK >> (k)) & 1) ? 2 : 1); ++rep_)
    if (IN(0)) REP(0) { p0_prologue(F); if (rep_ == 0 && ((PROBE_MASK >> 0) & 1)) xcd_barrier(bar); } SEAM(0);
    if (IN(1)) REP(1) {
        gates_phase(F);
        { AddrP1 g{(const char*)(ws + WS_K), (const char*)(ws + WS_WIN), 1024, 1024, 1024, 4, 0, 8};
          pg8::StaticOrder S; S.init(MTOK, 2048, F.G, F.bid, 4);
          EpiBf16<DstP1> E{DstP1{ws, 4, 0, 8}, 1.f};
          pg8::gemm_phase(F.lds, g, S, E); }
        { AddrP1 g{(const char*)F.out, (const char*)(ws + WS_WIN8), 512, 512, 512, 8, 4, 8};
          pg8::StaticOrder S; S.init(MTOK, 4096, F.G, F.bid, 4);
          EpiBf16<DstP1, true> E{DstP1{ws, 8, 4, 8}, 1.f / 1024.f};
          pg8::gemm_phase<EpiBf16<DstP1, true>, AddrP1, 1>(F.lds, g, S, E); }
    } SEAM(1);
    if (IN(2)) REP(2) { lru_phase<false>(F); } SEAM(2);
    if (IN(3)) REP(3) { lru_phase<true>(F); } SEAM(3);
    if (IN(4)) REP(4) { mconv_phase(F); } SEAM(4);
    if (IN(5)) REP(5) {
        const char* xc = (const char*)F.out + (size_t)MTOK * DM * 2;
        AddrQKV g{xc, (long)((const char*)(ws + WS_XM) - xc), (const char*)(ws + WS_WQKV), 1024, 256, 256};
        pg8::StaticOrder S; S.init(MTOK, 12 * 256, F.G, F.bid);
        EpiBf16<DstQKV> E{DstQKV{(char*)(ws + WS_LG), (long)WS_K - (long)WS_LG, (long)WS_XL - (long)WS_LG}, 1.f};
        pg8::gemm_phase(F.lds, g, S, E);
    } SEAM(5);
    if (IN(6)) REP(6) { mscan_phase(F); } SEAM(6);
    if (IN(7)) { ym_phase(F); } SEAM(7);
    if (IN(8)) {
        pg8::StaticOrder S; S.init(MTOK, 1024, F.G, F.bid);
        { AddrPlain g{(const char*)(ws + WS_OP), (const char*)(ws + WS_WB2), 1024, 1024, 1024};
          EpiMerge<false> E{(bf16*)(ws + WS_XM), (const unsigned char*)(ws + WS_MG), 0}; pg8::gemm_phase(F.lds, g, S, E); }
        { AddrPlain g{(const char*)F.out, (const char*)(ws + WS_WB2) + (size_t)1024 * 1024 * 2, 1024, 1024, 1024};
          EpiMerge<true> E{(bf16*)(ws + WS_XM), (const unsigned char*)(ws + WS_MG), 1024}; pg8::gemm_phase(F.lds, g, S, E); }
    } SEAM(8);
    if (IN(9)) {
        AddrPlain g{(const char*)(ws + WS_XM), (const char*)(ws + WS_WOUT2), 1024, 2048, 1024};
        pg8::StaticOrder S; S.init(MTOK, 1024, F.G, F.bid);
        EpiResid E{F.in[0], F.out, (bf16*)(ws + WS_XL), (float*)(ws + WS_SS)};
        pg8::gemm_phase(F.lds, g, S, E);
    } SEAM(9);
    if (IN(10)) REP(10) {
        AddrPlain g{(const char*)(ws + WS_XL), (const char*)(ws + WS_WPQ), 1024, 1024, 1024};
        pg8::StaticOrder S; S.init(MTOK, 2048, F.G, F.bid, 4);
        EpiPQ E{(bf16*)(ws + WS_MG), (const float*)(ws + WS_SS)};
        pg8::gemm_phase(F.lds, g, S, E);
    } SEAM(10);
    if (IN(11)) REP(11) { select_phase(F); }
    if (IN(11) && IN(12)) { asm volatile("s_waitcnt vmcnt(0)" ::: "memory"); __syncthreads(); }
    if (IN(12)) { if ((PROBE_MASK >> 12) & 1) { apply_phase(F, (float*)(ws + WS_MG)); xcd_barrier(bar); } apply_phase(F, F.out); }
#undef REP
#undef IN
#undef SEAM
}

extern "C" void kernel_launch(void* const* d_in, const int* in_sizes, int n_in, void* d_out, int out_size, void* d_ws, size_t ws_size, hipStream_t stream) {
    static int grid = 0;
    if (grid == 0) {
        if (n_in != 26 || in_sizes[0] != MTOK * DM || out_size != MTOK * DM || ws_size < WS_END) { fprintf(stderr, "kernel_launch: unexpected shapes / workspace (%zu < %zu)\n", ws_size, (size_t)WS_END); grid = -1; return; }
        int dev = 0, cus = 0, per_cu = 0;
        if (hipGetDevice(&dev) != hipSuccess || hipDeviceGetAttribute(&cus, hipDeviceAttributeMultiprocessorCount, dev) != hipSuccess) { grid = -1; return; }
        if (hipFuncSetAttribute((const void*)mega_fwd, hipFuncAttributeMaxDynamicSharedMemorySize, LDS_BYTES) != hipSuccess) { fprintf(stderr, "kernel_launch: hipFuncSetAttribute failed\n"); grid = -1; return; }
        if (hipOccupancyMaxActiveBlocksPerMultiprocessor(&per_cu, (const void*)mega_fwd, NTHR, LDS_BYTES) != hipSuccess || per_cu < 1) { fprintf(stderr, "kernel_launch: occupancy query says %d blocks/CU\n", per_cu); (void)hipGetLastError(); grid = -1; return; }
        grid = cus;
    }
    if (grid < 0) return;
    (void)hipMemsetAsync((char*)d_ws + WS_CTL + (size_t)CW_BAR * 4, 0, (size_t)XCD_BAR_WORDS * 4, stream);
    Args a{};
    for (int i = 0; i < 26; ++i) a.in[i] = (const float*)d_in[i];
    a.out = (float*)d_out; a.ws = (unsigned char*)d_ws;
#if MK_N_LAUNCHES == 1
    a.ph_lo = 0; a.ph_hi = N_PHASES;
    void* kargs[] = {&a};
    hipError_t e = hipLaunchCooperativeKernel((const void*)mega_fwd, dim3(grid), dim3(NTHR), kargs, LDS_BYTES, stream);
    if (e != hipSuccess) fprintf(stderr, "kernel_launch: cooperative launch failed: %s (grid %d)\n", hipGetErrorString(e), grid);
#else
    for (int p = 0; p < N_PHASES; ++p) { a.ph_lo = p; a.ph_hi = p + 1; hipLaunchKernelGGL(mega_fwd, dim3(grid), dim3(NTHR), LDS_BYTES, stream, a); }
#endif
}
```

```cpp
#include <hip/hip_runtime.h>
#include <cstdio>
#include <cstdint>
#include <math.h>

#ifndef MK_N_LAUNCHES
#define MK_N_LAUNCHES 1
#endif

constexpr int BATCH = 8, SEQ = 4096, DM = 1024, MTOK = BATCH * SEQ;
constexpr int DIN = 6160;
constexpr int NEXP = 16384;
constexpr float EPS = 1e-6f;

constexpr size_t MiB = 1u << 20;
constexpr size_t WS_CTL = 0, CTL_ZERO_BYTES = 1 * MiB;
constexpr size_t WS_WIN = 1 * MiB;
constexpr size_t WS_WQKV = 13 * MiB;
constexpr size_t WS_KEYS = 14 * MiB + 512 * 1024;
constexpr size_t WS_WLRU = 15 * MiB;
constexpr size_t WS_WB2 = 16 * MiB;
constexpr size_t WS_WOUT2 = 20 * MiB;
constexpr size_t WS_WPQ = 24 * MiB;
constexpr size_t WS_GATE = 28 * MiB;
constexpr size_t WS_WGT = 30 * MiB;
constexpr size_t WS_XM = 32 * MiB;
constexpr size_t WS_OP = 96 * MiB;
constexpr size_t WS_XL = 160 * MiB;
constexpr size_t WS_LG = 224 * MiB;
constexpr size_t WS_MG = 288 * MiB;
constexpr size_t WS_K = 416 * MiB;
constexpr size_t WS_AGG = 480 * MiB;
constexpr size_t WS_SS = 488 * MiB;
constexpr size_t WS_WIN8 = 489 * MiB;
constexpr size_t WS_END = 495 * MiB;

constexpr int CW_BAR = 4096;

constexpr int RING_BYTES = 131072;
constexpr int LDS_BYTES = 147456;
constexpr int LDSCTL_OFF = LDS_BYTES - 512, MISC_OFF = LDSCTL_OFF + 320;
constexpr int NWAVES = 8, NTHR = 512;

#define GAS __attribute__((address_space(1)))
#define LAS __attribute__((address_space(3)))
typedef unsigned short bf16;
typedef unsigned v4u __attribute__((ext_vector_type(4)));
typedef unsigned v2u __attribute__((ext_vector_type(2)));
typedef float f32x4 __attribute__((ext_vector_type(4)));
typedef float f32x2 __attribute__((ext_vector_type(2)));
typedef short bf16x8 __attribute__((ext_vector_type(8)));
typedef GAS unsigned gu32;
#define RLX_AGENT __ATOMIC_RELAXED, __HIP_MEMORY_SCOPE_AGENT
#define LDS_WAIT() asm volatile("s_waitcnt lgkmcnt(0)" ::: "memory")
#define VM_WAIT() asm volatile("s_waitcnt vmcnt(0)" ::: "memory")

__device__ __forceinline__ unsigned f2bf(float f) { unsigned u = __builtin_bit_cast(unsigned, f); return (u + 0x7fffu + ((u >> 16) & 1u)) >> 16; }
__device__ __forceinline__ unsigned pk2(float lo, float hi) { return f2bf(lo) | (f2bf(hi) << 16); }
__device__ __forceinline__ float bf2f(unsigned short h) { return __builtin_bit_cast(float, (unsigned)h << 16); }
__device__ __forceinline__ float bflo(unsigned w) { return __builtin_bit_cast(float, w << 16); }
__device__ __forceinline__ float bfhi(unsigned w) { return __builtin_bit_cast(float, w & 0xffff0000u); }
__device__ __forceinline__ float wave_sum(float v) {
#pragma unroll
  for (int o = 1; o < 64; o <<= 1) v += __shfl_xor(v, o);
  return v;
}
__device__ __forceinline__ float sigmoidf_(float x) { return __builtin_amdgcn_rcpf(1.f + __builtin_amdgcn_exp2f(x * -1.44269504089f)); }
__device__ __forceinline__ float gelu_erf(float x) { return 0.5f * x * (1.f + erff(x * 0.70710678118654752f)); }
__device__ __forceinline__ float gelu_fast(float v) {
    const float av = fabsf(v), t = __builtin_amdgcn_rcpf(av * 0.2316418882f + 1.0f);
    float q = t * 0.5307027145f + (-0.7265760135f); q = q * t + 0.7107068705f; q = q * t + (-0.142248368f); q = q * t + 0.127414796f; q = q * t;
    const float e = __builtin_amdgcn_exp2f((v * v) * (-0.72134752044f));
    const float m = v * (q * e);
    return v < 0.f ? m : v - m;
}
__device__ __forceinline__ float softplusf_(float x) { return fmaxf(x, 0.f) + log1pf(expf(-fabsf(x))); }

namespace pg8 {
#define PG8_LAS __attribute__((address_space(3)))
typedef unsigned short bf16_t;
typedef unsigned u32x4 __attribute__((ext_vector_type(4)));
typedef int i32x4_t __attribute__((ext_vector_type(4)));
constexpr int BM = 256, BK = 64, HALF = 128, HTB = HALF * BK * 2, STAGE_BYTES = 8 * HTB, NXCD = 8;

__host__ __device__ __forceinline__ int lds_byte(int r, int c) { const int st = (r >> 4) * 2 + (c >> 5), rr = r & 15, cc = c & 31, ob = rr * 64 + cc * 2; return st * 1024 + (ob ^ (((ob >> 9) & 1) << 5)); }
__host__ __device__ __forceinline__ void stage_rc(int b, int& R, int& C) { const int st = b / 1024, sb = b % 1024, swz = sb ^ (((sb >> 9) & 1) << 5); R = (st >> 1) * 16 + swz / 64; C = (st & 1) * 32 + (swz % 64) / 2; }
__host__ __device__ __forceinline__ int perm32(int rho) { const int n = rho >> 4, i = rho & 15; return 8 * (i >> 2) + 4 * n + (i & 3); }

struct Unit { int pm, pn; };
struct StaticOrder {
    int nM, nN, nwg, G, c, WGM;
    __host__ __device__ void init(int M, int N, int G_, int c_, int wgm = 8) { nM = M / BM; nN = N / BM; nwg = nM * nN; G = G_; c = c_; WGM = wgm; }
    __host__ __device__ bool next(int i, Unit& u) const {
        const long L = (long)i * G + c; if (L >= nwg) return false;
        int wgid = (int)L; { const int q = nwg / NXCD, r = nwg % NXCD, xcd = wgid % NXCD, off = wgid / NXCD; wgid = (xcd < r ? xcd * (q + 1) : r * (q + 1) + (xcd - r) * q) + off; }
        const int nig = WGM * nN, gid = wgid / nig, fm = gid * WGM, gsz = (nM - fm) < WGM ? (nM - fm) : WGM;
        u.pm = fm + ((wgid % nig) % gsz); u.pn = (wgid % nig) / gsz; return true;
    }
};

__device__ __forceinline__ unsigned cvt_pk_bf16(float lo, float hi) { unsigned r; asm volatile("v_cvt_pk_bf16_f32 %0, %1, %2" : "=v"(r) : "v"(lo), "v"(hi)); return r; }

template <class Epi, class Addr, int F8SC = 0>
__device__ __forceinline__ void gemm_phase(PG8_LAS unsigned char* lds, const Addr g, const StaticOrder& S, const Epi& E) {
    const int tid = threadIdx.x, wid = __builtin_amdgcn_readfirstlane(tid >> 6), lane = tid & 63, wr = wid >> 2, wc = wid & 3, fr = lane & 15, fq = lane >> 4;
    const int K = g.K, nt = K / BK;
    unsigned voffA[2], voffB[2];
#pragma unroll
    for (int i = 0; i < 2; ++i) { int R, C; stage_rc(tid * 16 + i * 8192, R, C); const int Rb = Epi::PERM ? ((R & ~31) + perm32(R & 31)) : R;
        voffA[i] = (unsigned)(R * g.lda + C) * 2u; voffB[i] = (unsigned)(Rb * g.ldb + C) * 2u; }
    const size_t kstep = (size_t)(BK * 2);
    const size_t hsA = (size_t)HALF * g.lda * 2, hsB = (size_t)HALF * g.ldb * 2;
    const unsigned ldsw = (unsigned)wid * 1024u;
    const int aoff = lds_byte(wr * 64 + fr, fq * 8), boff = lds_byte(wc * 32 + fr, fq * 8);
#define PG8_SA(b, h) (((b) * 2 + (h)) * HTB)
#define PG8_SB(b, h) ((4 + (b) * 2 + (h)) * HTB)
#define PG8_STAGE(bufoff, gbase, voff) do { _Pragma("unroll") for (int _i = 0; _i < 2; ++_i) \
        __builtin_amdgcn_global_load_lds((const unsigned*)((const char*)(gbase) + (voff)[_i]), (PG8_LAS unsigned*)(lds + (bufoff) + ldsw + _i * 8192), 16, 0, 0); } while (0)
#define PG8_LDA(dst, b, h) do { _Pragma("unroll") for (int m = 0; m < 4; ++m) _Pragma("unroll") for (int k = 0; k < 2; ++k) dst[m][k] = *(const PG8_LAS bf16x8*)(lds + PG8_SA(b, h) + aoff + m * 2048 + k * 1024); } while (0)
#define PG8_LDB(dst, b, h) do { _Pragma("unroll") for (int n = 0; n < 2; ++n) _Pragma("unroll") for (int k = 0; k < 2; ++k) dst[n][k] = *(const PG8_LAS bf16x8*)(lds + PG8_SB(b, h) + boff + n * 2048 + k * 1024); } while (0)
#define PG8_CAT(x0, x1) __builtin_shufflevector(__builtin_bit_cast(i32x4_t, x0), __builtin_bit_cast(i32x4_t, x1), 0, 1, 2, 3, 4, 5, 6, 7)
#define PG8_MMA(ai, bj, At, Bt) do { __builtin_amdgcn_s_setprio(1); \
        if constexpr (F8SC != 0) { _Pragma("unroll") for (int m = 0; m < 4; ++m) _Pragma("unroll") for (int n = 0; n < 2; ++n) \
            asm volatile("v_mfma_f32_16x16x128_f8f6f4 %0, %1, %2, %0" : "+v"(acc[ai][bj][m][n]) : "v"(PG8_CAT(Bt[n][0], Bt[n][1])), "v"(PG8_CAT(At[m][0], At[m][1]))); } \
        else { _Pragma("unroll") for (int m = 0; m < 4; ++m) _Pragma("unroll") for (int n = 0; n < 2; ++n) _Pragma("unroll") for (int k = 0; k < 2; ++k) \
            acc[ai][bj][m][n] = __builtin_amdgcn_mfma_f32_16x16x32_bf16(Bt[n][k], At[m][k], acc[ai][bj][m][n], 0, 0, 0); } \
        __builtin_amdgcn_s_setprio(0); } while (0)
#define PG8_WAIT_V(n) asm volatile("s_waitcnt vmcnt(" #n ")" ::: "memory")
#define PG8_WAIT_L(n) asm volatile("s_waitcnt lgkmcnt(" #n ")" ::: "memory")
#define PG8_BAR __builtin_amdgcn_s_barrier()
#define PG8_SCHED __builtin_amdgcn_sched_barrier(0)
    Unit cur, nxt; int ui = 0;
    if (!S.next(0, cur)) return;
    f32x4 acc[2][2][4][2];
#pragma unroll
    for (int a = 0; a < 2; ++a)
#pragma unroll
        for (int b = 0; b < 2; ++b)
#pragma unroll
            for (int m = 0; m < 4; ++m)
#pragma unroll
                for (int n = 0; n < 2; ++n) acc[a][b][m][n] = (f32x4){0.f, 0.f, 0.f, 0.f};
    bf16x8 At[4][2], B0[2][2], B1[2][2];
    const char* cA = g.a(cur); const char* cB = g.b(cur);
    PG8_STAGE(PG8_SB(0, 0), cB, voffB); PG8_STAGE(PG8_SB(0, 1), cB + hsB, voffB); PG8_STAGE(PG8_SA(0, 0), cA, voffA); PG8_STAGE(PG8_SA(0, 1), cA + hsA, voffA);
    if (wr == 1) PG8_BAR;
    PG8_WAIT_V(2); PG8_BAR;
    PG8_STAGE(PG8_SB(1, 0), cB + kstep, voffB); PG8_STAGE(PG8_SA(1, 0), cA + kstep, voffA); PG8_STAGE(PG8_SB(1, 1), cB + hsB + kstep, voffB);
    PG8_WAIT_V(6); PG8_BAR;
    for (;;) {
        const bool has_next = S.next(ui + 1, nxt);
        const char* nA = has_next ? g.a(nxt) : cA; const char* nB = has_next ? g.b(nxt) : cB;
#pragma unroll 1
        for (int t = 0; t < nt; t += 2) {
            const bool last = (t == nt - 2);
            const char* a1 = cA + (size_t)(t + 1) * kstep;
            const char* a2 = last ? nA : cA + (size_t)(t + 2) * kstep; const char* b2 = last ? nB : cB + (size_t)(t + 2) * kstep;
            const char* a3 = a2 + kstep; const char* b3 = b2 + kstep;
            PG8_LDB(B0, 0, 0); PG8_LDB(B1, 0, 1); PG8_SCHED; PG8_LDA(At, 0, 0); PG8_STAGE(PG8_SA(1, 1), a1 + hsA, voffA);
            PG8_WAIT_V(8); PG8_WAIT_L(0); PG8_BAR; PG8_MMA(0, 0, At, B0); PG8_MMA(0, 1, At, B1); PG8_BAR; PG8_SCHED;
            PG8_LDA(At, 0, 1); PG8_STAGE(PG8_SB(0, 0), b2, voffB); PG8_STAGE(PG8_SB(0, 1), b2 + hsB, voffB); PG8_STAGE(PG8_SA(0, 0), a2, voffA);
            PG8_WAIT_V(8); PG8_WAIT_L(0); PG8_BAR; PG8_MMA(1, 0, At, B0); PG8_MMA(1, 1, At, B1); PG8_BAR; PG8_SCHED;
            PG8_LDB(B0, 1, 0); PG8_LDB(B1, 1, 1); PG8_SCHED; PG8_LDA(At, 1, 0); PG8_STAGE(PG8_SA(0, 1), a2 + hsA, voffA);
            PG8_WAIT_V(8); PG8_WAIT_L(0); PG8_BAR; PG8_MMA(0, 0, At, B0); PG8_MMA(0, 1, At, B1); PG8_BAR; PG8_SCHED;
            PG8_LDA(At, 1, 1); PG8_STAGE(PG8_SB(1, 0), b3, voffB); PG8_STAGE(PG8_SB(1, 1), b3 + hsB, voffB); PG8_STAGE(PG8_SA(1, 0), a3, voffA);
            PG8_WAIT_V(8); PG8_WAIT_L(0); PG8_BAR; PG8_MMA(1, 0, At, B0); PG8_MMA(1, 1, At, B1); PG8_BAR; PG8_SCHED;
        }
        if constexpr (F8SC != 0) asm volatile("s_nop 15\n\ts_nop 15" ::: "memory");
        if (wr == 0) PG8_BAR;
        E(acc, cur, wr, wc, fr, fq);
        if (!has_next) break;
#pragma unroll
        for (int a = 0; a < 2; ++a)
#pragma unroll
            for (int b = 0; b < 2; ++b)
#pragma unroll
                for (int m = 0; m < 4; ++m)
#pragma unroll
                    for (int n = 0; n < 2; ++n) acc[a][b][m][n] = (f32x4){0.f, 0.f, 0.f, 0.f};
        cur = nxt; cA = nA; cB = nB; ++ui;
        if (wr == 1) PG8_BAR;
    }
    PG8_WAIT_V(0);
    PG8_BAR;
#undef PG8_SA
#undef PG8_SB
#undef PG8_STAGE
#undef PG8_LDA
#undef PG8_LDB
#undef PG8_MMA
#undef PG8_CAT
#undef PG8_WAIT_V
#undef PG8_WAIT_L
#undef PG8_BAR
#undef PG8_SCHED
}
}

#define XB_TMO      128
#define XB_XCNT(j)  (256  + 64 * (j))
#define XB_XSUB(j)  (1280 + 64 * (j))
#define XB_XGEN(j)  (2304 + 64 * (j))
#define XB_TOP      3328
#define XB_TOPGEN   3392
#define XCD_BAR_WORDS 3456
#define XB_SPIN_CAP (1u << 18)
__device__ __forceinline__ unsigned xb_ld(unsigned* p)              { return __hip_atomic_load(p, __ATOMIC_RELAXED, __HIP_MEMORY_SCOPE_AGENT); }
__device__ __forceinline__ unsigned xb_add(unsigned* p, unsigned v) { return __hip_atomic_fetch_add(p, v, __ATOMIC_RELAXED, __HIP_MEMORY_SCOPE_AGENT); }
__device__ __forceinline__ unsigned xb_xcc_id() { return (unsigned)__builtin_amdgcn_s_getreg((3 << 11) | 20) & 0xFu; }
#define XB_SPIN(cond, bar) do { unsigned _sp = 0; while (cond) { __builtin_amdgcn_s_sleep(1); \
    if ((++_sp & 255u) == 0u) { if (xb_ld(&(bar)[XB_TMO])) break; if (_sp > XB_SPIN_CAP) { atomicAdd(&(bar)[XB_TMO], 1u); break; } } } } while (0)
struct XcdBarrier { unsigned* bar; unsigned x; volatile LAS unsigned* st; };
__device__ __forceinline__ XcdBarrier xcd_barrier_post(unsigned* bar, volatile LAS unsigned* st) {
    XcdBarrier b; b.bar = bar; b.x = xb_xcc_id(); b.st = st;
    if (threadIdx.x == 0) (void)xb_add(&bar[XB_XCNT(b.x)], 1u);
    return b;
}
__device__ __forceinline__ void xcd_barrier_complete(unsigned* bar, unsigned x, unsigned& nloc, unsigned& nx) {
    const unsigned G = gridDim.x * gridDim.y * gridDim.z;
    unsigned sum, cnt, mine, sp = 0u;
    for (;;) {
        sum = 0u; cnt = 0u; mine = 0u;
#pragma unroll
        for (unsigned j = 0; j < 16; ++j) { const unsigned c = xb_ld(&bar[XB_XCNT(j)]); sum += c; cnt += (c > 0u) ? 1u : 0u; mine = (j == x) ? c : mine; }
        if (sum == G) break;
        __builtin_amdgcn_s_sleep(1);
        if ((++sp & 255u) == 0u) { if (xb_ld(&bar[XB_TMO])) break; if (sp > XB_SPIN_CAP) { atomicAdd(&bar[XB_TMO], 1u); break; } }
    }
    nloc = mine > 0u ? mine : 1u; nx = cnt > 0u ? cnt : 1u;
}
__device__ __forceinline__ void xcd_barrier(const XcdBarrier& b) {
    asm volatile("s_waitcnt vmcnt(0)" ::: "memory");
    __syncthreads();
    if (threadIdx.x == 0) {
        unsigned* bar = b.bar;
        __builtin_amdgcn_s_waitcnt(0);
        unsigned nloc = b.st[0], nx = b.st[1];
        if (nloc == 0u) { xcd_barrier_complete(bar, b.x, nloc, nx); b.st[0] = nloc; b.st[1] = nx; }
        const unsigned old = xb_add(&bar[XB_XSUB(b.x)], 1u);
        const unsigned gen = old / nloc;
        if (old + 1u == (gen + 1u) * nloc) {
            __builtin_amdgcn_fence(__ATOMIC_RELEASE, "agent");
            asm volatile("s_waitcnt vmcnt(0)" ::: "memory");
            const unsigned og = xb_add(&bar[XB_TOP], 1u);
            const unsigned tg = og / nx;
            if (og + 1u == (tg + 1u) * nx) xb_add(&bar[XB_TOPGEN], 1u);
            else XB_SPIN(xb_ld(&bar[XB_TOPGEN]) == tg, bar);
            __builtin_amdgcn_fence(__ATOMIC_ACQUIRE, "agent");
            xb_add(&bar[XB_XGEN(b.x)], 1u);
            asm volatile("s_waitcnt vmcnt(0)" ::: "memory");
        } else {
            XB_SPIN(xb_ld(&bar[XB_XGEN(b.x)]) == gen, bar);
            __builtin_amdgcn_fence(__ATOMIC_ACQUIRE, "agent");
            asm volatile("s_waitcnt vmcnt(0)" ::: "memory");
        }
    }
    __syncthreads();
}

struct Args { const float* in[26]; float* out; unsigned char* ws; int ph_lo, ph_hi; };
struct Frame {
    LAS unsigned char* lds;
    int tid, lane, wave, G, bid;
    const float* const* in; float* out; unsigned char* ws;
};

template <bool F8 = false> __device__ __forceinline__ void tr_item(const float* W, int ldw, bf16* WT, int ldt, float scale, const float* kscale, LAS float* scr, int k0, int lane) {
#pragma unroll 8
    for (int i = 0; i < 32; ++i) { const int kk = 2 * i + (lane >> 5); float v = W[(size_t)(k0 + kk) * ldw + (lane & 31)] * scale; if (kscale) v *= kscale[k0 + kk]; scr[kk * 33 + (lane & 31)] = v; }
    LDS_WAIT(); asm volatile("" ::: "memory");
    const int c = lane & 7;
#pragma unroll
    for (int j = 0; j < 4; ++j) { const int n = (lane >> 3) + 8 * j; const LAS float* s = scr + (8 * c) * 33 + n;
        if constexpr (F8) {
            int p0 = 0, p1 = 0; p0 = __builtin_amdgcn_cvt_pk_fp8_f32(s[0 * 33], s[1 * 33], p0, false); p0 = __builtin_amdgcn_cvt_pk_fp8_f32(s[2 * 33], s[3 * 33], p0, true);
            p1 = __builtin_amdgcn_cvt_pk_fp8_f32(s[4 * 33], s[5 * 33], p1, false); p1 = __builtin_amdgcn_cvt_pk_fp8_f32(s[6 * 33], s[7 * 33], p1, true);
            *(GAS v2u*)((GAS unsigned char*)WT + (size_t)n * ldt + k0 + 8 * c) = (v2u){(unsigned)p0, (unsigned)p1};
        } else {
        v4u o; o.x = pk2(s[0 * 33], s[1 * 33]); o.y = pk2(s[2 * 33], s[3 * 33]); o.z = pk2(s[4 * 33], s[5 * 33]); o.w = pk2(s[6 * 33], s[7 * 33]);
        *(GAS v4u*)(WT + (size_t)n * ldt + k0 + 8 * c) = o; } }
    LDS_WAIT(); asm volatile("" ::: "memory");
}

__device__ __forceinline__ void p0_prologue(Frame& F) {
    LAS float* scr = (LAS float*)(F.lds + F.wave * 16384);
    const int gw = F.bid * NWAVES + F.wave, NGW = F.G * NWAVES;
    unsigned char* ws = F.ws;
    const float* w_in = F.in[2];
    constexpr int I_WIN = 16 * 192, I_QKV = 12 * 32, I_LRU = 32 * 8, I_WB = 2 * 512, I_WO = 512, I_PQ = 16 * 64;
    constexpr int NITEMS = I_WIN + I_QKV + I_LRU + I_WB + I_WO + I_PQ;
    for (int it = gw; it < NITEMS; it += NGW) {
        int r = it;
        if (r < I_WIN) { const int kb = r / 192, nb = r % 192, n0 = nb * 32, sc = n0 < 2048 ? n0 : n0 + 16;
            if ((n0 >= 1024 && n0 < 3072) || n0 >= 4096) tr_item<true>(w_in + sc, DIN, (bf16*)(ws + WS_WIN8 + (size_t)n0 * 1024), 1024, 1024.f, nullptr, scr, kb * 64, F.lane);
            else tr_item(w_in + sc, DIN, (bf16*)(ws + WS_WIN) + (size_t)n0 * 1024, 1024, 1.f, nullptr, scr, kb * 64, F.lane);
            continue; }
        r -= I_WIN;
        if (r < I_QKV) { const int mat = r / 32, rr = r % 32, kb = rr / 8, nb = rr % 8, g = mat >> 2, h = mat & 3;
            const float* W = F.in[6 + g] + (size_t)h * 65536 + nb * 32;
            tr_item(W, 256, (bf16*)(ws + WS_WQKV) + (size_t)mat * 65536 + (size_t)(nb * 32) * 256, 256, g == 1 ? 0.0625f : 1.f, nullptr, scr, kb * 64, F.lane); continue; }
        r -= I_QKV;
        if (r < I_LRU) { const int mat = r / 8, rr = r % 8, kb = rr / 4, nb = rr % 4, gate = mat & 1, db = mat >> 1;
            const float* W = F.in[gate ? 14 : 12] + (size_t)db * 16384 + nb * 32;
            tr_item(W, 128, (bf16*)(ws + WS_WLRU) + (size_t)mat * 16384 + (size_t)(nb * 32) * 128, 128, 1.f, nullptr, scr, kb * 64, F.lane); continue; }
        r -= I_LRU;
        if (r < I_WB) { const int mat = r / 512, rr = r % 512, kb = rr / 32, nb = rr % 32;
            const float* W = F.in[17 + mat] + nb * 32;
            tr_item(W, 1024, (bf16*)(ws + WS_WB2) + (size_t)(mat * 1024 + nb * 32) * 1024, 1024, 1.f, nullptr, scr, kb * 64, F.lane); continue; }
        r -= I_WB;
        if (r < I_WO) { const int cp = 0, rr = r, kb = rr / 32, nb = rr % 32;
            const float* W = F.in[19] + nb * 32;
            tr_item(W, 1024, (bf16*)(ws + WS_WOUT2) + (size_t)(nb * 32) * 2048 + cp * 1024, 2048, 1.f, nullptr, scr, kb * 64, F.lane); continue; }
        r -= I_WO;
        { const int kb = r / 64, nb = r % 64;
            const float* W = F.in[21] + nb * 32;
            tr_item(W, 2048, (bf16*)(ws + WS_WPQ) + (size_t)(nb * 32) * 1024, 1024, 1.f, F.in[20], scr, kb * 64, F.lane); }
    }
    { const int gt = F.bid * NTHR + F.tid, NGT = F.G * NTHR;
      const float4* ks = (const float4*)F.in[22]; v2u* kd = (v2u*)(ws + WS_KEYS);
      for (int i = gt; i < 8 * 2 * 128 * 128 / 4; i += NGT) { const float4 v = ks[i]; v2u o; o.x = pk2(v.x, v.y); o.y = pk2(v.z, v.w); kd[i] = o; }
      float* ss = (float*)(ws + WS_SS);
      for (int i = gt; i < MTOK; i += NGT) ss[i] = 0.f; }
    { const int gt = F.bid * NTHR + F.tid;
      if (gt < 16 * 128) { const int c = gt >> 7, k8 = gt & 127; v4u o; unsigned wv[4];
#pragma unroll
          for (int j = 0; j < 4; ++j) wv[j] = pk2(w_in[(size_t)(k8 * 8 + 2 * j) * DIN + 2048 + c], w_in[(size_t)(k8 * 8 + 2 * j + 1) * DIN + 2048 + c]);
          o.x = wv[0]; o.y = wv[1]; o.z = wv[2]; o.w = wv[3]; *(v4u*)((bf16*)(ws + WS_WGT) + c * 1024 + k8 * 8) = o; } }
    const float* x = F.in[0]; const float* g1 = F.in[1];
    bf16* XN = (bf16*)(ws + WS_K);
    unsigned char* XN8 = (unsigned char*)F.out;
    f32x4 gv[4];
#pragma unroll
    for (int j = 0; j < 4; ++j) gv[j] = ((const f32x4*)g1)[F.lane + 64 * j];
    for (int m = 2 * gw; m < MTOK; m += 2 * NGW) {
        const f32x4* xr0 = (const f32x4*)(x + (size_t)m * DM) + F.lane; const f32x4* xr1 = xr0 + DM / 4;
        f32x4 v0[4], v1[4]; float s0 = 0.f, s1 = 0.f;
#pragma unroll
        for (int j = 0; j < 4; ++j) { v0[j] = xr0[64 * j]; v1[j] = xr1[64 * j]; }
#pragma unroll
        for (int j = 0; j < 4; ++j) { s0 += (v0[j].x * v0[j].x + v0[j].y * v0[j].y) + (v0[j].z * v0[j].z + v0[j].w * v0[j].w); s1 += (v1[j].x * v1[j].x + v1[j].y * v1[j].y) + (v1[j].z * v1[j].z + v1[j].w * v1[j].w); }
        const float r0 = rsqrtf(wave_sum(s0) * (1.f / DM) + EPS), r1 = rsqrtf(wave_sum(s1) * (1.f / DM) + EPS);
        unsigned long long* o0 = (unsigned long long*)(XN + (size_t)m * DM) + F.lane; unsigned long long* o1 = o0 + DM / 4;
        unsigned* q0 = (unsigned*)(XN8 + (size_t)m * DM) + F.lane; unsigned* q1 = q0 + DM / 4;
#pragma unroll
        for (int j = 0; j < 4; ++j) { const f32x4 a = v0[j] * r0 * gv[j], c = v1[j] * r1 * gv[j];
            o0[64 * j] = (unsigned long long)pk2(a.x, a.y) | ((unsigned long long)pk2(a.z, a.w) << 32);
            o1[64 * j] = (unsigned long long)pk2(c.x, c.y) | ((unsigned long long)pk2(c.z, c.w) << 32);
            int pa = 0, pc = 0; pa = __builtin_amdgcn_cvt_pk_fp8_f32(a.x, a.y, pa, false); pa = __builtin_amdgcn_cvt_pk_fp8_f32(a.z, a.w, pa, true);
            pc = __builtin_amdgcn_cvt_pk_fp8_f32(c.x, c.y, pc, false); pc = __builtin_amdgcn_cvt_pk_fp8_f32(c.z, c.w, pc, true);
            q0[64 * j] = (unsigned)pa; q1[64 * j] = (unsigned)pc; }
    }
}
__device__ __forceinline__ void gates_phase(Frame& F) {
    const bf16* XN = (const bf16*)(F.ws + WS_K); const bf16* WGT = (const bf16*)(F.ws + WS_WGT); float* GT = (float*)(F.ws + WS_GATE);
    const int lane = F.lane, fr = lane & 15, fq = lane >> 4;
    const f32x4 bg4 = *(const f32x4*)(F.in[3] + 4 * fq);
    for (int task = F.bid * NWAVES + F.wave; task < MTOK / 16; task += F.G * NWAVES) {
        const size_t m0 = (size_t)task * 16;
        f32x4 acc = (f32x4){0.f, 0.f, 0.f, 0.f};
#pragma unroll 8
        for (int ks = 0; ks < 32; ++ks) {
            const bf16x8 wfr = *(const bf16x8*)(WGT + fr * 1024 + 32 * ks + 8 * fq);
            const bf16x8 xfr = *(const bf16x8*)(XN + (m0 + fr) * DM + 32 * ks + 8 * fq);
            acc = __builtin_amdgcn_mfma_f32_16x16x32_bf16(wfr, xfr, acc, 0, 0, 0);
        }
        *(f32x4*)(GT + (m0 + fr) * 16 + 4 * fq) = acc + bg4;
    }
}

struct AddrPlain {
    const char* A; const char* Bt; int lda, ldb, K;
    __device__ __forceinline__ const char* a(const pg8::Unit& u) const { return A + (size_t)u.pm * 256 * lda * 2; }
    __device__ __forceinline__ const char* b(const pg8::Unit& u) const { return Bt + (size_t)u.pn * 256 * ldb * 2; }
};
struct AddrP1 {
    const char* A; const char* Bt; int lda, ldb, K, thr, lo_add, hi_add;
    __device__ __forceinline__ const char* a(const pg8::Unit& u) const { return A + (size_t)u.pm * 256 * lda * 2; }
    __device__ __forceinline__ const char* b(const pg8::Unit& u) const { return Bt + (size_t)(u.pn + (u.pn < thr ? lo_add : hi_add)) * 256 * ldb * 2; }
};
struct AddrQKV {
    const char* XC; long dXM; const char* W; int lda, ldb, K;
    __device__ __forceinline__ const char* a(const pg8::Unit& u) const { return XC + (u.pn < 8 ? 0l : dXM) + ((size_t)u.pm * 256 * 1024 + (u.pn & 3) * 256) * 2; }
    __device__ __forceinline__ const char* b(const pg8::Unit& u) const { return W + (size_t)u.pn * 65536 * 2; }
};
struct AddrBranch {
    const char* YM; long dYL; const char* W; int lda, ldb, K;
    __device__ __forceinline__ const char* a(const pg8::Unit& u) const { return YM + (u.pn < 4 ? 0l : dYL) + (size_t)u.pm * 256 * 1024 * 2; }
    __device__ __forceinline__ const char* b(const pg8::Unit& u) const { return W + (size_t)u.pn * 256 * 1024 * 2; }
};

struct DstP1 { unsigned char* ws; int thr, lo_add, hi_add;
    __device__ __forceinline__ bf16* get(int j, int& ld, int& col0) const {
        const int pn = j + (j < thr ? lo_add : hi_add); const bool mg = pn >= 16; ld = mg ? -2048 : 1024; col0 = mg ? (pn - 16) * 256 : (pn & 3) * 256;
        return (bf16*)(ws + (mg ? WS_MG : WS_XM + (size_t)(pn >> 2) * 64 * MiB)); } };
struct DstQKV { char* q; long dk, dv;
    __device__ __forceinline__ bf16* get(int pn, int& ld, int& col0) const { ld = 1024; col0 = (pn & 3) * 256; return (bf16*)(q + (pn >= 4 ? (pn >= 8 ? dv : dk) : 0l)); } };
template <class Dst, bool MUL = false> struct EpiBf16 {
    static constexpr bool PERM = true;
    Dst dst; float mul;
    __device__ __forceinline__ void operator()(const f32x4 (&acc)[2][2][4][2], const pg8::Unit& u, int wr, int wc, int fr, int fq) const {
        int ld, colt; bf16* base = dst.get(u.pn, ld, colt);
        const int row0 = u.pm * 256 + wr * 64 + fr, col0 = colt + wc * 32 + 8 * fq;
        if (MUL && ld < 0) {
#pragma unroll
            for (int ai = 0; ai < 2; ++ai)
#pragma unroll
                for (int m = 0; m < 4; ++m) { unsigned char* rowp = (unsigned char*)base + (size_t)(row0 + ai * 128 + m * 16) * (-ld) + col0;
#pragma unroll
                    for (int bj = 0; bj < 2; ++bj) { const f32x4 v0 = acc[ai][bj][m][0] * mul, v1 = acc[ai][bj][m][1] * mul;
                        int p0 = 0, p1 = 0; p0 = __builtin_amdgcn_cvt_pk_fp8_f32(v0[0], v0[1], p0, false); p0 = __builtin_amdgcn_cvt_pk_fp8_f32(v0[2], v0[3], p0, true);
                        p1 = __builtin_amdgcn_cvt_pk_fp8_f32(v1[0], v1[1], p1, false); p1 = __builtin_amdgcn_cvt_pk_fp8_f32(v1[2], v1[3], p1, true);
                        *(v2u*)(rowp + bj * 128) = (v2u){(unsigned)p0, (unsigned)p1}; } }
            return;
        }
#pragma unroll
        for (int ai = 0; ai < 2; ++ai)
#pragma unroll
            for (int m = 0; m < 4; ++m) { bf16* rowp = base + (size_t)(row0 + ai * 128 + m * 16) * ld + col0;
#pragma unroll
                for (int bj = 0; bj < 2; ++bj) { f32x4 v0 = acc[ai][bj][m][0], v1 = acc[ai][bj][m][1]; if (MUL) { v0 = v0 * mul; v1 = v1 * mul; }
                    v4u w; w.x = pg8::cvt_pk_bf16(v0[0], v0[1]); w.y = pg8::cvt_pk_bf16(v0[2], v0[3]); w.z = pg8::cvt_pk_bf16(v1[0], v1[1]); w.w = pg8::cvt_pk_bf16(v1[2], v1[3]);
                    *(v4u*)(rowp + bj * 128) = w; } }
    }
};
template <bool ADD> struct EpiMerge {
    static constexpr bool PERM = true;
    bf16* MRG; const unsigned char* MG; int gcol;
    __device__ __forceinline__ void operator()(const f32x4 (&acc)[2][2][4][2], const pg8::Unit& u, int wr, int wc, int fr, int fq) const {
        const int row0 = u.pm * 256 + wr * 64 + fr, col0 = u.pn * 256 + wc * 32 + 8 * fq;
#pragma unroll
        for (int ai = 0; ai < 2; ++ai)
#pragma unroll
            for (int m = 0; m < 4; ++m) { const size_t row = (size_t)(row0 + ai * 128 + m * 16); bf16* rowp = MRG + row * 1024 + col0; const unsigned char* gp = MG + row * 2048 + gcol + col0;
#pragma unroll
                for (int bj = 0; bj < 2; ++bj) { const f32x4 v0 = acc[ai][bj][m][0], v1 = acc[ai][bj][m][1];
                    const v2u g = *(const v2u*)(gp + bj * 128);
                    const f32x2 g0 = __builtin_amdgcn_cvt_pk_f32_fp8((int)g.x, false), g1 = __builtin_amdgcn_cvt_pk_f32_fp8((int)g.x, true), g2 = __builtin_amdgcn_cvt_pk_f32_fp8((int)g.y, false), g3 = __builtin_amdgcn_cvt_pk_f32_fp8((int)g.y, true);
                    float o[8] = {v0[0] * sigmoidf_(g0[0]), v0[1] * sigmoidf_(g0[1]), v0[2] * sigmoidf_(g1[0]), v0[3] * sigmoidf_(g1[1]),
                                  v1[0] * sigmoidf_(g2[0]), v1[1] * sigmoidf_(g2[1]), v1[2] * sigmoidf_(g3[0]), v1[3] * sigmoidf_(g3[1])};
                    if (ADD) { const v4u t = *(const v4u*)(rowp + bj * 128);
                        o[0] += bflo(t.x); o[1] += bfhi(t.x); o[2] += bflo(t.y); o[3] += bfhi(t.y); o[4] += bflo(t.z); o[5] += bfhi(t.z); o[6] += bflo(t.w); o[7] += bfhi(t.w); }
                    v4u w; w.x = pg8::cvt_pk_bf16(o[0], o[1]); w.y = pg8::cvt_pk_bf16(o[2], o[3]); w.z = pg8::cvt_pk_bf16(o[4], o[5]); w.w = pg8::cvt_pk_bf16(o[6], o[7]);
                    *(v4u*)(rowp + bj * 128) = w; } }
    }
};
struct EpiResid {
    static constexpr bool PERM = false;
    const float* x; float* x1; bf16* x1b; float* ss;
    __device__ __forceinline__ void operator()(const f32x4 (&acc)[2][2][4][2], const pg8::Unit& u, int wr, int wc, int fr, int fq) const {
        const int row0 = u.pm * 256 + wr * 64 + fr, col0 = u.pn * 256 + wc * 32 + 4 * fq;
#pragma unroll
        for (int ai = 0; ai < 2; ++ai)
#pragma unroll
            for (int m = 0; m < 4; ++m) { const int row = row0 + ai * 128 + m * 16; const size_t off = (size_t)row * DM + col0; float s = 0.f;
#pragma unroll
                for (int bj = 0; bj < 2; ++bj)
#pragma unroll
                    for (int n = 0; n < 2; ++n) { const size_t o = off + bj * 128 + n * 16; const f32x4 v = *(const f32x4*)(x + o) + acc[ai][bj][m][n];
                        *(f32x4*)(x1 + o) = v; v2u w; w.x = pg8::cvt_pk_bf16(v[0], v[1]); w.y = pg8::cvt_pk_bf16(v[2], v[3]); *(v2u*)(x1b + o) = w;
                        s += (v[0] * v[0] + v[1] * v[1]) + (v[2] * v[2] + v[3] * v[3]); }
                s += __shfl_xor(s, 16); s += __shfl_xor(s, 32);
                if (fq == 0) atomicAdd(ss + row, s); }
    }
};
struct EpiPQ {
    static constexpr bool PERM = true;
    bf16* pq; const float* ss;
    __device__ __forceinline__ void operator()(const f32x4 (&acc)[2][2][4][2], const pg8::Unit& u, int wr, int wc, int fr, int fq) const {
        const int row0 = u.pm * 256 + wr * 64 + fr, col0 = u.pn * 256 + wc * 32 + 8 * fq;
#pragma unroll
        for (int ai = 0; ai < 2; ++ai)
#pragma unroll
            for (int m = 0; m < 4; ++m) { const int row = row0 + ai * 128 + m * 16; bf16* rowp = pq + (size_t)row * 2048 + col0;
                const float r = rsqrtf(ss[row] * (1.f / DM) + EPS);
#pragma unroll
                for (int bj = 0; bj < 2; ++bj) { const f32x4 v0 = acc[ai][bj][m][0] * r, v1 = acc[ai][bj][m][1] * r;
                    v4u w; w.x = pg8::cvt_pk_bf16(v0[0], v0[1]); w.y = pg8::cvt_pk_bf16(v0[2], v0[3]); w.z = pg8::cvt_pk_bf16(v1[0], v1[1]); w.w = pg8::cvt_pk_bf16(v1[2], v1[3]);
                    *(v4u*)(rowp + bj * 128) = w; } }
    }
};

template <bool PB> __device__ __forceinline__ void lru_phase(Frame& F) {
    const bf16* XL = (const bf16*)(F.ws + WS_XL); const bf16* LG = (const bf16*)(F.ws + WS_LG); bf16* YL = (bf16*)F.out;
    f32x2* AGG = (f32x2*)(F.ws + WS_AGG);
    const bf16* WL = (const bf16*)(F.ws + WS_WLRU);
    const float* cw = F.in[10]; const float* cb = F.in[11];
    unsigned char* LA0 = F.ws + WS_K; unsigned char* LA1 = LA0 + (size_t)MTOK * DM; bf16* LU0 = (bf16*)F.out; bf16* LU1 = LU0 + (size_t)MTOK * DM;
    v2u ra[2]; v4u ru[2];
    constexpr int O_XCB = 0, O_XCF = 17408, O_A = 51200, O_U = 84992, FST = 528;
    LAS unsigned char* L = F.lds;
    const int tid = F.tid, lane = F.lane, w = F.wave, fr = lane & 15, fq = lane >> 4;
    int cur_blk = -1;
    bf16x8 wf[2][2][4];
    f32x4 br4[2], bi4[2], sp4[2];
    v4u rawreg[3];
#define RAW_LOAD(bb, tt0, bk) do { _Pragma("unroll") for (int r_ = 0; r_ < 3; ++r_) { const int e_ = tid + NTHR * r_, row_ = e_ >> 4, c16_ = e_ & 15, t_ = (tt0) - 2 + row_; \
            v4u v_ = {0u, 0u, 0u, 0u}; if (e_ < 68 * 16 && t_ >= 0 && t_ < SEQ) v_ = *(const v4u*)(XL + ((size_t)(bb) * SEQ + t_) * DM + (bk) * 128 + c16_ * 8); rawreg[r_] = v_; } } while (0)
#define PB_LOAD(ii, dd) do { const int idx_ = (ii) * F.G + F.bid; if (idx_ < 4096) { const int j_ = idx_ >> 3; const size_t mr_ = (size_t)(j_ >> 6) * SEQ + (j_ & 63) * 64; \
            _Pragma("unroll") for (int r_ = 0; r_ < 2; ++r_) { const int e_ = tid + NTHR * r_; const size_t o_ = (mr_ + (e_ >> 4)) * DM + (idx_ & 7) * 128 + (e_ & 15) * 8; \
                ra[r_] = *(const v2u*)(((dd) ? LA1 : LA0) + o_); ru[r_] = *(const v4u*)(((dd) ? LU1 : LU0) + o_); } } } while (0)
    constexpr int O_CARRY = 118784, O_CW = 135168, O_SUB = 137728;
    const bool carry_tab = PB && (F.G == 256);
    if (carry_tab) {
        const int ch = tid & 127, bq = tid >> 7, s0 = F.bid >> 3, blk0 = F.bid & 7;
        LAS float* CT = (LAS float*)(L + O_CARRY);
#define FOLD(agp, j0, j1, stp, hv) do { int js_ = (j0); const int n_ = ((j1) - (j0)) * (stp); int k_ = 0; \
            for (; k_ + 8 <= n_; k_ += 8) { f32x2 ah_[8]; _Pragma("unroll") for (int q_ = 0; q_ < 8; ++q_) ah_[q_] = (agp)[(size_t)(js_ + q_ * (stp)) * 2 * DM]; \
                _Pragma("unroll") for (int q_ = 0; q_ < 8; ++q_) hv = ah_[q_][0] * hv + ah_[q_][1]; js_ += 8 * (stp); } \
            for (; k_ < n_; ++k_) { const f32x2 a1_ = (agp)[(size_t)js_ * 2 * DM]; hv = a1_[0] * hv + a1_[1]; js_ += (stp); } } while (0)
        for (int bb = 2 * bq; bb < 2 * bq + 2; ++bb) {
            const f32x2* ag0 = AGG + ((size_t)(bb * 64) * 2 + 0) * DM + blk0 * 128 + ch; const f32x2* ag1 = AGG + ((size_t)(bb * 64) * 2 + 1) * DM + blk0 * 128 + ch;
            float h = 0.f;
            FOLD(ag0, 0, s0, 1, h); CT[((bb * 2 + 0) * 2 + 0) * 128 + ch] = h;
            FOLD(ag0, s0, s0 + 32, 1, h); CT[((bb * 2 + 1) * 2 + 0) * 128 + ch] = h;
            h = 0.f;
            FOLD(ag1, 63, s0 + 32, -1, h); CT[((bb * 2 + 1) * 2 + 1) * 128 + ch] = h;
            FOLD(ag1, s0 + 32, s0, -1, h); CT[((bb * 2 + 0) * 2 + 1) * 128 + ch] = h;
        }
        __syncthreads();
#undef FOLD
    }
    for (int i = 0;; ++i) {
        const int idx = i * F.G + F.bid; if (idx >= 4096) break;
        const int blk = idx & 7, j = idx >> 3, b = j >> 6, seg = j & 63, t0 = seg * 64;
        const size_t mrow0 = (size_t)b * SEQ + t0;
        if (!PB && blk != cur_blk) {
            cur_blk = blk;
#pragma unroll
            for (int d = 0; d < 2; ++d) {
#pragma unroll
                for (int g = 0; g < 2; ++g)
#pragma unroll
                    for (int ks = 0; ks < 4; ++ks)
                        wf[d][g][ks] = *(const bf16x8*)(WL + ((size_t)((d * 8 + blk) * 2 + g) * 128 + 16 * w + fr) * 128 + 32 * ks + 8 * fq);
                const int ch = blk * 128 + 16 * w + 4 * fq;
                br4[d] = *(const f32x4*)(F.in[13] + d * DM + ch); bi4[d] = *(const f32x4*)(F.in[15] + d * DM + ch);
                const f32x4 lm = *(const f32x4*)(F.in[16] + d * DM + ch);
#pragma unroll
                for (int e = 0; e < 4; ++e) sp4[d][e] = -8.f * 1.44269504089f * softplusf_(-lm[e]);
            }
            __syncthreads();
            for (int e = tid; e < 5 * 128; e += NTHR) { const int jt = e >> 7, cc = e & 127; ((LAS float*)(L + O_CW))[e] = (jt < 4) ? cw[jt * DM + blk * 128 + cc] : cb[blk * 128 + cc]; }
        }
        v4u lgreg[2];
        if (PB) {
            if (i == 0) PB_LOAD(0, 0);
#pragma unroll
            for (int r = 0; r < 2; ++r) { const int e = tid + NTHR * r; lgreg[r] = *(const v4u*)(LG + (mrow0 + (e >> 4)) * DM + blk * 128 + (e & 15) * 8); }
        } else {
        if (i == 0) RAW_LOAD(b, t0, blk);
#pragma unroll
        for (int r = 0; r < 3; ++r) { const int e = tid + NTHR * r; if (e < 68 * 16) *(LAS v4u*)(L + O_A + (e >> 4) * 256 + (e & 15) * 16) = rawreg[r]; }
        __syncthreads();
        { const int idx2 = (i + 1) * F.G + F.bid; if (idx2 < 4096) { const int j2 = idx2 >> 3; RAW_LOAD(j2 >> 6, (j2 & 63) * 64, idx2 & 7); } }
        for (int e = tid; e < 64 * 16; e += NTHR) { const int tl = e >> 4, c16 = e & 15;
            float y[8];
            { const f32x4 a = *(const LAS f32x4*)(L + O_CW + 4 * 512 + c16 * 32), bq = *(const LAS f32x4*)(L + O_CW + 4 * 512 + c16 * 32 + 16); y[0] = a[0]; y[1] = a[1]; y[2] = a[2]; y[3] = a[3]; y[4] = bq[0]; y[5] = bq[1]; y[6] = bq[2]; y[7] = bq[3]; }
#pragma unroll
            for (int jt = 0; jt < 4; ++jt) { const v4u r = *(const LAS v4u*)(L + O_A + (tl + jt) * 256 + c16 * 16);
                const f32x4 wa = *(const LAS f32x4*)(L + O_CW + jt * 512 + c16 * 32), wb = *(const LAS f32x4*)(L + O_CW + jt * 512 + c16 * 32 + 16);
                y[0] += wa[0] * bflo(r.x); y[1] += wa[1] * bfhi(r.x); y[2] += wa[2] * bflo(r.y); y[3] += wa[3] * bfhi(r.y);
                y[4] += wb[0] * bflo(r.z); y[5] += wb[1] * bfhi(r.z); y[6] += wb[2] * bflo(r.w); y[7] += wb[3] * bfhi(r.w); }
            *(LAS f32x4*)(L + O_XCF + tl * FST + c16 * 32) = (f32x4){y[0], y[1], y[2], y[3]};
            *(LAS f32x4*)(L + O_XCF + tl * FST + c16 * 32 + 16) = (f32x4){y[4], y[5], y[6], y[7]};
            v4u o; o.x = pk2(y[0], y[1]); o.y = pk2(y[2], y[3]); o.z = pk2(y[4], y[5]); o.w = pk2(y[6], y[7]);
            *(LAS v4u*)(L + O_XCB + tl * 272 + c16 * 16) = o; }
        __syncthreads();
        }
        float carry0 = 0.f, carry1 = 0.f;
        if (carry_tab) { const LAS float* CT = (const LAS float*)(L + O_CARRY); carry0 = CT[((b * 2 + (seg >> 5)) * 2 + 0) * 128 + (tid & 127)]; carry1 = CT[((b * 2 + (seg >> 5)) * 2 + 1) * 128 + (tid & 127)]; }
        else if (PB) {
            const int ch = blk * 128 + (tid & 127);
            float h = 0.f;
            const f32x2* ag0 = AGG + ((size_t)(b * 64) * 2 + 0) * DM + ch; const f32x2* ag1 = AGG + ((size_t)(b * 64) * 2 + 1) * DM + ch;
            int js = 0;
            for (; js + 8 <= seg; js += 8) { f32x2 ah[8];
#pragma unroll
                for (int q = 0; q < 8; ++q) ah[q] = ag0[(size_t)(js + q) * 2 * DM];
#pragma unroll
                for (int q = 0; q < 8; ++q) h = ah[q][0] * h + ah[q][1]; }
            for (; js < seg; ++js) { const f32x2 ah = ag0[(size_t)js * 2 * DM]; h = ah[0] * h + ah[1]; }
            carry0 = h; h = 0.f;
            js = 63;
            for (; js - 8 >= seg; js -= 8) { f32x2 ah[8];
#pragma unroll
                for (int q = 0; q < 8; ++q) ah[q] = ag1[(size_t)(js - q) * 2 * DM];
#pragma unroll
                for (int q = 0; q < 8; ++q) h = ah[q][0] * h + ah[q][1]; }
            for (; js > seg; --js) { const f32x2 ah = ag1[(size_t)js * 2 * DM]; h = ah[0] * h + ah[1]; }
            carry1 = h;
        }
#pragma unroll
        for (int d = 0; d < 2; ++d) {
            const int o_a = (d == 0) ? O_A : O_XCF;
            if (PB) {
#pragma unroll
                for (int r = 0; r < 2; ++r) { const int e = tid + NTHR * r, row = e >> 4, c16 = e & 15;
                    const f32x2 x0 = __builtin_amdgcn_cvt_pk_f32_fp8((int)ra[r].x, false), x1 = __builtin_amdgcn_cvt_pk_f32_fp8((int)ra[r].x, true);
                    const f32x2 x2 = __builtin_amdgcn_cvt_pk_f32_fp8((int)ra[r].y, false), x3 = __builtin_amdgcn_cvt_pk_f32_fp8((int)ra[r].y, true);
                    constexpr float IS = 1.f / 4096.f;
                    *(LAS f32x4*)(L + o_a + row * FST + c16 * 32) = (f32x4){1.f - x0[0] * IS, 1.f - x0[1] * IS, 1.f - x1[0] * IS, 1.f - x1[1] * IS};
                    *(LAS f32x4*)(L + o_a + row * FST + c16 * 32 + 16) = (f32x4){1.f - x2[0] * IS, 1.f - x2[1] * IS, 1.f - x3[0] * IS, 1.f - x3[1] * IS};
                    *(LAS f32x4*)(L + O_U + row * FST + c16 * 32) = (f32x4){bflo(ru[r].x), bfhi(ru[r].x), bflo(ru[r].y), bfhi(ru[r].y)};
                    *(LAS f32x4*)(L + O_U + row * FST + c16 * 32 + 16) = (f32x4){bflo(ru[r].z), bfhi(ru[r].z), bflo(ru[r].w), bfhi(ru[r].w)}; }
                if (d == 0) PB_LOAD(i, 1); else PB_LOAD(i + 1, 0);
            } else {
            f32x4 aR[4], aI[4];
#pragma unroll
            for (int mt = 0; mt < 4; ++mt) { aR[mt] = (f32x4){0.f, 0.f, 0.f, 0.f}; aI[mt] = (f32x4){0.f, 0.f, 0.f, 0.f}; }
#pragma unroll
            for (int ks = 0; ks < 4; ++ks)
#pragma unroll
                for (int mt = 0; mt < 4; ++mt) { const bf16x8 xb = *(const LAS bf16x8*)(L + O_XCB + (16 * mt + fr) * 272 + (32 * ks + 8 * fq) * 2);
                    aR[mt] = __builtin_amdgcn_mfma_f32_16x16x32_bf16(wf[d][0][ks], xb, aR[mt], 0, 0, 0);
                    aI[mt] = __builtin_amdgcn_mfma_f32_16x16x32_bf16(wf[d][1][ks], xb, aI[mt], 0, 0, 0); }
#pragma unroll
            for (int mt = 0; mt < 4; ++mt) { const int tl = 16 * mt + fr, cl = 16 * w + 4 * fq;
                const f32x4 xc = *(const LAS f32x4*)(L + O_XCF + tl * FST + cl * 4);
                f32x4 av, uv;
#pragma unroll
                for (int e = 0; e < 4; ++e) { const float r = sigmoidf_(aR[mt][e] + br4[d][e]), ig = sigmoidf_(aI[mt][e] + bi4[d][e]);
                    const float a_ = __builtin_amdgcn_exp2f(r * sp4[d][e]); av[e] = a_; uv[e] = __builtin_amdgcn_sqrtf(fmaxf(1.f - a_ * a_, 0.f)) * (ig * xc[e]); }
                *(LAS f32x4*)(L + o_a + tl * FST + cl * 4) = av; *(LAS f32x4*)(L + O_U + tl * FST + cl * 4) = uv;
                { const size_t go = (mrow0 + tl) * DM + blk * 128 + cl;
                  int xa = 0; xa = __builtin_amdgcn_cvt_pk_fp8_f32((1.f - av[0]) * 4096.f, (1.f - av[1]) * 4096.f, xa, false); xa = __builtin_amdgcn_cvt_pk_fp8_f32((1.f - av[2]) * 4096.f, (1.f - av[3]) * 4096.f, xa, true);
                  v2u xu; xu.x = pk2(uv[0], uv[1]); xu.y = pk2(uv[2], uv[3]);
                  *(unsigned*)((d ? LA1 : LA0) + go) = (unsigned)xa; *(v2u*)((d ? LU1 : LU0) + go) = xu; } }
            }
            __syncthreads();
            {
                const int c = tid & 127, sub = tid >> 7;
                LAS float* pa = (LAS float*)(L + o_a) + c; const LAS float* pu = (const LAS float*)(L + O_U) + c;
                LAS f32x2* SUBT = (LAS f32x2*)(L + O_SUB);
                float h = 0.f, A = 1.f;
#pragma unroll
                for (int s2 = 0; s2 < 16; ++s2) { const int tl = d ? (16 * sub + 15 - s2) : (16 * sub + s2); const float a = pa[tl * 132], u = pu[tl * 132]; h = a * h + u; A *= a; }
                SUBT[sub * 128 + c] = (f32x2){A, h};
                __syncthreads();
                if (!PB) {
                    if (sub == 0) { float HH = 0.f, AA = 1.f;
#pragma unroll
                        for (int q = 0; q < 4; ++q) { const f32x2 ah = SUBT[(d ? 3 - q : q) * 128 + c]; HH = ah[0] * HH + ah[1]; AA *= ah[0]; }
                        AGG[((size_t)(b * 64 + seg) * 2 + d) * DM + blk * 128 + c] = (f32x2){AA, HH}; }
                } else {
                    float hc = d ? carry1 : carry0;
#pragma unroll
                    for (int q = 0; q < 3; ++q) { const int jq = d ? 3 - q : q; const f32x2 ah = SUBT[jq * 128 + c]; if (d ? (jq > sub) : (jq < sub)) hc = ah[0] * hc + ah[1]; }
                    if (d == 0) {
#pragma unroll
                        for (int s2 = 0; s2 < 16; ++s2) { const int tl = 16 * sub + s2; hc = pa[tl * 132] * hc + pu[tl * 132]; pa[tl * 132] = hc; }
                    } else { LAS float* ph = (LAS float*)(L + O_A) + c;
#pragma unroll
                        for (int s2 = 0; s2 < 16; ++s2) { const int tl = 16 * sub + 15 - s2; hc = pa[tl * 132] * hc + pu[tl * 132]; ph[tl * 132] += hc; } }
                }
            }
            __syncthreads();
        }
        if (PB) {
#pragma unroll
            for (int r = 0; r < 2; ++r) { const int e = tid + NTHR * r, row = e >> 4, c16 = e & 15;
                const v4u g = lgreg[r];
                const f32x4 h0 = *(const LAS f32x4*)(L + O_A + row * FST + c16 * 32), h1 = *(const LAS f32x4*)(L + O_A + row * FST + c16 * 32 + 16);
                v4u o;
                o.x = pk2(h0[0] * gelu_fast(bflo(g.x)), h0[1] * gelu_fast(bfhi(g.x))); o.y = pk2(h0[2] * gelu_fast(bflo(g.y)), h0[3] * gelu_fast(bfhi(g.y)));
                o.z = pk2(h1[0] * gelu_fast(bflo(g.z)), h1[1] * gelu_fast(bfhi(g.z))); o.w = pk2(h1[2] * gelu_fast(bflo(g.w)), h1[3] * gelu_fast(bfhi(g.w)));
                *(v4u*)(YL + (mrow0 + row) * DM + blk * 128 + c16 * 8) = o; }
            __syncthreads();
        }
    }
#undef RAW_LOAD
#undef PB_LOAD
}

__device__ __forceinline__ void mconv_phase(Frame& F) {
    const bf16* XM = (const bf16*)(F.ws + WS_XM); bf16* XC = (bf16*)F.out + (size_t)MTOK * DM;
    const float* cw = F.in[4]; const float* cb = F.in[5];
    const int NT = MTOK / 32 * 128;
    for (int g = F.bid * NTHR + F.tid; g < NT; g += F.G * NTHR) {
        const int chunk = g & 127, run = g >> 7, c0 = chunk * 8, m0 = run * 32, t0 = m0 & (SEQ - 1);
        float w[4][8], bias[8];
#pragma unroll
        for (int j = 0; j < 4; ++j) { const f32x4 a = *(const f32x4*)(cw + j * DM + c0), b = *(const f32x4*)(cw + j * DM + c0 + 4);
            w[j][0] = a[0]; w[j][1] = a[1]; w[j][2] = a[2]; w[j][3] = a[3]; w[j][4] = b[0]; w[j][5] = b[1]; w[j][6] = b[2]; w[j][7] = b[3]; }
        { const f32x4 a = *(const f32x4*)(cb + c0), b = *(const f32x4*)(cb + c0 + 4);
            bias[0] = a[0]; bias[1] = a[1]; bias[2] = a[2]; bias[3] = a[3]; bias[4] = b[0]; bias[5] = b[1]; bias[6] = b[2]; bias[7] = b[3]; }
        const v4u zero = {0u, 0u, 0u, 0u};
#pragma unroll 1
        for (int hb = 0; hb < 2; ++hb) {
            const int r0 = m0 + 16 * hb, tt = t0 + 16 * hb;
            v4u rows[19];
            rows[0] = (tt >= 2) ? *(const v4u*)(XM + (size_t)(r0 - 2) * DM + c0) : zero;
            rows[1] = (tt >= 1) ? *(const v4u*)(XM + (size_t)(r0 - 1) * DM + c0) : zero;
#pragma unroll
            for (int i = 0; i < 16; ++i) rows[2 + i] = *(const v4u*)(XM + (size_t)(r0 + i) * DM + c0);
            rows[18] = (tt + 16 < SEQ) ? *(const v4u*)(XM + (size_t)(r0 + 16) * DM + c0) : zero;
#pragma unroll
            for (int i = 0; i < 16; ++i) {
                float y[8];
#pragma unroll
                for (int e = 0; e < 8; ++e) y[e] = bias[e];
#pragma unroll
                for (int j = 0; j < 4; ++j) {
                    const unsigned p0 = rows[i + j].x, p1 = rows[i + j].y, p2 = rows[i + j].z, p3 = rows[i + j].w;
                    y[0] += w[j][0] * bflo(p0); y[1] += w[j][1] * bfhi(p0); y[2] += w[j][2] * bflo(p1); y[3] += w[j][3] * bfhi(p1);
                    y[4] += w[j][4] * bflo(p2); y[5] += w[j][5] * bfhi(p2); y[6] += w[j][6] * bflo(p3); y[7] += w[j][7] * bfhi(p3);
                }
#pragma unroll
                for (int e = 0; e < 8; ++e) y[e] = y[e] * sigmoidf_(y[e]);
                v4u o; o.x = pk2(y[0], y[1]); o.y = pk2(y[2], y[3]); o.z = pk2(y[4], y[5]); o.w = pk2(y[6], y[7]);
                *(v4u*)(XC + (size_t)(r0 + i) * DM + c0) = o;
            }
        }
    }
}

typedef short s16x4 __attribute__((ext_vector_type(4)));
__device__ __forceinline__ bf16x8 tr_read_pair(unsigned a0, unsigned a1) {
    s16x4 r0, r1;
    asm volatile("ds_read_b64_tr_b16 %0, %2\n\tds_read_b64_tr_b16 %1, %3\n\ts_waitcnt lgkmcnt(0)" : "=&v"(r0), "=&v"(r1) : "v"(a0), "v"(a1) : "memory");
    return __builtin_shufflevector(r0, r1, 0, 1, 2, 3, 4, 5, 6, 7);
}
__device__ __forceinline__ float dpp_shr(float oldv, float x, int n) {
    const int o = __builtin_bit_cast(int, oldv), v = __builtin_bit_cast(int, x);
    int r;
    if (n == 1) r = __builtin_amdgcn_update_dpp(o, v, 0x111, 0xf, 0xf, false);
    else if (n == 2) r = __builtin_amdgcn_update_dpp(o, v, 0x112, 0xf, 0xf, false);
    else if (n == 4) r = __builtin_amdgcn_update_dpp(o, v, 0x114, 0xf, 0xf, false);
    else r = __builtin_amdgcn_update_dpp(o, v, 0x118, 0xf, 0xf, false);
    return __builtin_bit_cast(float, r);
}
__device__ __forceinline__ float rdlane(float x, int l) { return __builtin_bit_cast(float, __builtin_amdgcn_readlane(__builtin_bit_cast(int, x), l)); }
__device__ __forceinline__ float wave_incl_sum(float x, int lane) {
    x += dpp_shr(0.f, x, 1); x += dpp_shr(0.f, x, 2); x += dpp_shr(0.f, x, 4); x += dpp_shr(0.f, x, 8);
    const float t0 = rdlane(x, 15), t1 = rdlane(x, 31), t2 = rdlane(x, 47);
    return x + (lane >= 16 ? t0 : 0.f) + (lane >= 32 ? t1 : 0.f) + (lane >= 48 ? t2 : 0.f);
}
__device__ __forceinline__ float wave_incl_max(float x, int lane) {
    const float NI = -INFINITY;
    x = fmaxf(x, dpp_shr(NI, x, 1)); x = fmaxf(x, dpp_shr(NI, x, 2)); x = fmaxf(x, dpp_shr(NI, x, 4)); x = fmaxf(x, dpp_shr(NI, x, 8));
    const float t0 = rdlane(x, 15), t1 = rdlane(x, 31), t2 = rdlane(x, 47);
    return fmaxf(fmaxf(x, lane >= 16 ? t0 : NI), fmaxf(lane >= 32 ? t1 : NI, lane >= 48 ? t2 : NI));
}
__device__ __forceinline__ void mscan_phase(Frame& F) {
    const bf16* Q = (const bf16*)(F.ws + WS_LG); const bf16* K = (const bf16*)(F.ws + WS_K); const bf16* V = (const bf16*)(F.ws + WS_XL);
    const float* GT = (const float*)(F.ws + WS_GATE);
    constexpr int KS = 0, CTI = 33792, VT = 67584, VWT = 86016, PB = 104448, TAB = 113664, NT = 116736, NPART = 117760, DENT = 119808;
    constexpr int KST = 528, VST = 144, TABSZ = 1536;
    LAS unsigned char* L = F.lds;
    const int tid = F.tid, lane = F.lane, w = F.wave, fr = lane & 15, fq = lane >> 4, pt = w & 3, wg = w >> 2;
    for (int item = F.bid; item < 256; item += F.G) {
        const int es = item & 3, dir = (item >> 2) & 1, h = (item >> 3) & 3, b = item >> 5;
        bf16* H = dir ? ((bf16*)F.out + (size_t)MTOK * DM) : (bf16*)(F.ws + WS_XM);
        const size_t rowbase = (size_t)b * SEQ;
#define TOF(c, p) (dir ? (SEQ - 1 - 64 * (c) - (p)) : (64 * (c) + (p)))
        for (int e = tid; e < (33792 + 1024) / 4; e += NTHR) { if (e < 33792 / 4) ((LAS unsigned*)(L + CTI))[e] = 0u; else ((LAS unsigned*)(L + NT))[e - 33792 / 4] = 0u; }
        float m_run = 0.f;
        float gi_n = 0.f, gf_n = 0.f;
        if (w == 4) { const size_t m = rowbase + TOF(0, lane); gi_n = GT[m * 16 + dir * 8 + h]; gf_n = GT[m * 16 + dir * 8 + 4 + h]; }
#define G1_TABLES(setp) do { \
            const float logf_ = fminf(gf_n, 0.f) - __logf(1.f + __expf(-fabsf(gf_n))); const float b_ = wave_incl_sum(logf_, lane); const float a_ = gi_n - b_; \
            const float M_ = fmaxf(m_run, wave_incl_max(a_, lane)); const float Mend_ = rdlane(M_, 63), g_ = rdlane(b_, 63); \
            LAS float* T_ = (LAS float*)(setp); T_[lane] = a_; T_[64 + lane] = M_; T_[128 + lane] = __expf(m_run - M_); T_[192 + lane] = __expf(-(b_ + M_)); T_[256 + lane] = __expf(a_ - Mend_); \
            if (lane == 0) { T_[320] = __expf(m_run - Mend_); T_[321] = g_ + Mend_; } \
            m_run = g_ + Mend_; } while (0)
        if (w == 4) G1_TABLES(L + TAB);
        __syncthreads();
        bf16x8 qf[8];
        v4u kreg[4]; v4u vreg;
#define LOAD_KV(c) do { _Pragma("unroll") for (int r_ = 0; r_ < 4; ++r_) { const int i_ = tid + NTHR * r_, s_ = i_ >> 5, c16_ = i_ & 31; \
                kreg[r_] = *(const v4u*)(K + (rowbase + TOF(c, s_)) * DM + h * 256 + c16_ * 8); } \
            { const int s_ = tid & 63, e8_ = tid >> 6; vreg = *(const v4u*)(V + (rowbase + TOF(c, s_)) * DM + h * 256 + es * 64 + e8_ * 8); } } while (0)
#define STORE_KV(setidx) do { _Pragma("unroll") for (int r_ = 0; r_ < 4; ++r_) { const int i_ = tid + NTHR * r_, s_ = i_ >> 5, c16_ = i_ & 31; \
                *(LAS v4u*)(L + KS + s_ * KST + c16_ * 16) = kreg[r_]; } \
            { const int s_ = tid & 63, e8_ = tid >> 6; const float ws_ = ((const LAS float*)(L + TAB + (setidx) * TABSZ))[256 + s_]; \
              LAS bf16* vt_ = (LAS bf16*)(L + VT + (setidx) * 9216); LAS bf16* vw_ = (LAS bf16*)(L + VWT + (setidx) * 9216); \
              const unsigned wv_[4] = {vreg.x, vreg.y, vreg.z, vreg.w}; \
              _Pragma("unroll") for (int j_ = 0; j_ < 4; ++j_) { const float lo_ = bflo(wv_[j_]), hi_ = bfhi(wv_[j_]); const int e_ = e8_ * 8 + 2 * j_; \
                vt_[e_ * 72 + s_] = (bf16)(wv_[j_] & 0xffffu); vt_[(e_ + 1) * 72 + s_] = (bf16)(wv_[j_] >> 16); \
                vw_[e_ * 72 + s_] = (bf16)f2bf(lo_ * ws_); vw_[(e_ + 1) * 72 + s_] = (bf16)f2bf(hi_ * ws_); } } } while (0)
#define LOAD_Q(c) do { const size_t m_ = rowbase + TOF(c, 16 * pt + fr); _Pragma("unroll") for (int ks_ = 0; ks_ < 8; ++ks_) \
                qf[ks_] = *(const bf16x8*)(Q + m_ * DM + h * 256 + 32 * ks_ + 8 * fq); } while (0)
        LOAD_KV(0); LOAD_Q(0);
        STORE_KV(0);
        f32x4 Cacc[8], Nacc[2];
#pragma unroll
        for (int i = 0; i < 8; ++i) Cacc[i] = (f32x4){0.f, 0.f, 0.f, 0.f};
        Nacc[0] = (f32x4){0.f, 0.f, 0.f, 0.f}; Nacc[1] = (f32x4){0.f, 0.f, 0.f, 0.f};
        __syncthreads();
        for (int c = 0; c < 64; ++c) {
            const int cur = c & 1, nxt = cur ^ 1;
            const bool has_next = (c + 1 < 64);
            const LAS float* T = (const LAS float*)(L + TAB + cur * TABSZ);
            if (has_next) { LOAD_KV(c + 1); if (w == 4) { const size_t m = rowbase + TOF(c + 1, lane); gi_n = GT[m * 16 + dir * 8 + h]; gf_n = GT[m * 16 + dir * 8 + 4 + h]; } }
            const int p = 16 * pt + fr;
            const float Mp = T[64 + p], wi_p = T[128 + p];
            float cs = 0.f;
            f32x4 O[2] = {(f32x4){0.f, 0.f, 0.f, 0.f}, (f32x4){0.f, 0.f, 0.f, 0.f}}, sa[2] = {(f32x4){0.f, 0.f, 0.f, 0.f}, (f32x4){0.f, 0.f, 0.f, 0.f}};
            const bool s0on = (2 * wg <= pt), s1on = (2 * wg + 1 <= pt);
#define KF(i, ks) (*(const LAS bf16x8*)(L + KS + (16 * (2 * wg + (i)) + fr) * KST + (32 * (ks) + 8 * fq) * 2))
#define CF(i, ks) (*(const LAS bf16x8*)(L + CTI + (16 * (2 * wg + (i)) + fr) * KST + (32 * (ks) + 8 * fq) * 2))
            if (s1on) {
#pragma unroll
                for (int ks = 0; ks < 8; ++ks) { const bf16x8 k0 = KF(0, ks), k1 = KF(1, ks), c0 = CF(0, ks), c1 = CF(1, ks);
                    sa[0] = __builtin_amdgcn_mfma_f32_16x16x32_bf16(k0, qf[ks], sa[0], 0, 0, 0); sa[1] = __builtin_amdgcn_mfma_f32_16x16x32_bf16(k1, qf[ks], sa[1], 0, 0, 0);
                    O[0] = __builtin_amdgcn_mfma_f32_16x16x32_bf16(c0, qf[ks], O[0], 0, 0, 0); O[1] = __builtin_amdgcn_mfma_f32_16x16x32_bf16(c1, qf[ks], O[1], 0, 0, 0); }
            } else if (s0on) {
#pragma unroll
                for (int ks = 0; ks < 8; ++ks) { const bf16x8 k0 = KF(0, ks), c0 = CF(0, ks), c1 = CF(1, ks);
                    sa[0] = __builtin_amdgcn_mfma_f32_16x16x32_bf16(k0, qf[ks], sa[0], 0, 0, 0);
                    O[0] = __builtin_amdgcn_mfma_f32_16x16x32_bf16(c0, qf[ks], O[0], 0, 0, 0); O[1] = __builtin_amdgcn_mfma_f32_16x16x32_bf16(c1, qf[ks], O[1], 0, 0, 0); }
            } else {
#pragma unroll
                for (int ks = 0; ks < 8; ++ks) { const bf16x8 c0 = CF(0, ks), c1 = CF(1, ks);
                    O[0] = __builtin_amdgcn_mfma_f32_16x16x32_bf16(c0, qf[ks], O[0], 0, 0, 0); O[1] = __builtin_amdgcn_mfma_f32_16x16x32_bf16(c1, qf[ks], O[1], 0, 0, 0); }
            }
#undef KF
#undef CF
#pragma unroll
            for (int i = 0; i < 2; ++i) { const int st = 2 * wg + i;
                v2u pw = {0u, 0u};
                if (i ? s1on : s0on) {
                    const f32x4 a4 = *(const LAS f32x4*)(T + 16 * st + 4 * fq);
                    float pv[4];
#pragma unroll
                    for (int r = 0; r < 4; ++r) { const int s_ = 16 * st + 4 * fq + r; const float wgt = (s_ <= p) ? __expf(a4[r] - Mp) : 0.f; pv[r] = sa[i][r] * wgt; cs += pv[r]; }
                    pw.x = pk2(pv[0], pv[1]); pw.y = pk2(pv[2], pv[3]);
                }
                *(LAS v2u*)(L + PB + p * VST + (16 * st + 4 * fq) * 2) = pw; }
            float di = 0.f;
#define DEN_INTER(ks) do { const f32x4 n0 = *(const LAS f32x4*)(L + NT + (32 * (ks) + 8 * fq) * 4), n1 = *(const LAS f32x4*)(L + NT + (32 * (ks) + 8 * fq) * 4 + 16); \
                const v4u qw = __builtin_bit_cast(v4u, qf[ks]); \
                di += bflo(qw.x) * n0[0] + bfhi(qw.x) * n0[1] + bflo(qw.y) * n0[2] + bfhi(qw.y) * n0[3] + bflo(qw.z) * n1[0] + bfhi(qw.z) * n1[1] + bflo(qw.w) * n1[2] + bfhi(qw.w) * n1[3]; } while (0)
            if (wg == 0) { DEN_INTER(0); DEN_INTER(1); DEN_INTER(2); DEN_INTER(3); }
            else { DEN_INTER(4); DEN_INTER(5); DEN_INTER(6); DEN_INTER(7); }
#undef DEN_INTER
            di += __shfl_xor(di, 16); di += __shfl_xor(di, 32);
            cs += __shfl_xor(cs, 16); cs += __shfl_xor(cs, 32);
            if (fq == 0) ((LAS float*)(L + DENT))[wg * 64 + p] = wi_p * di + cs;
            if (has_next) LOAD_Q(c + 1);
            if (has_next && w == 4) G1_TABLES(L + TAB + nxt * TABSZ);
            __syncthreads();
#pragma unroll
            for (int i = 0; i < 2; ++i) { const int et = 2 * wg + i; O[i] = O[i] * wi_p;
#pragma unroll
                for (int ks = 0; ks < 2; ++ks) { const bf16x8 vf = *(const LAS bf16x8*)(L + VT + cur * 9216 + (16 * et + fr) * VST + (32 * ks + 8 * fq) * 2);
                    const bf16x8 pf = *(const LAS bf16x8*)(L + PB + p * VST + (32 * ks + 8 * fq) * 2);
                    O[i] = __builtin_amdgcn_mfma_f32_16x16x32_bf16(vf, pf, O[i], 0, 0, 0); } }
            { const float den = ((const LAS float*)(L + DENT))[p] + ((const LAS float*)(L + DENT))[64 + p];
              const float inv = 1.f / fmaxf(fabsf(den), T[192 + p]);
              const size_t m = rowbase + TOF(c, p);
#pragma unroll
              for (int i = 0; i < 2; ++i) { const int et = 2 * wg + i; v2u o; o.x = pk2(O[i][0] * inv, O[i][1] * inv); o.y = pk2(O[i][2] * inv, O[i][3] * inv);
                  *(v2u*)(H + m * DM + h * 256 + es * 64 + 16 * et + 4 * fq) = o; } }
            { const float decay = T[320];
              const bf16x8 vw0 = *(const LAS bf16x8*)(L + VWT + cur * 9216 + (16 * pt + fr) * VST + (8 * fq) * 2);
              const bf16x8 vw1 = *(const LAS bf16x8*)(L + VWT + cur * 9216 + (16 * pt + fr) * VST + (32 + 8 * fq) * 2);
              bf16x8 wsf0, wsf1;
              { const f32x4 w0 = *(const LAS f32x4*)(T + 256 + 8 * fq), w1 = *(const LAS f32x4*)(T + 256 + 8 * fq + 4), w2 = *(const LAS f32x4*)(T + 288 + 8 * fq), w3 = *(const LAS f32x4*)(T + 288 + 8 * fq + 4);
                const bool c0 = (fr == 0);
                v4u a, b; a.x = c0 ? pk2(w0[0], w0[1]) : 0u; a.y = c0 ? pk2(w0[2], w0[3]) : 0u; a.z = c0 ? pk2(w1[0], w1[1]) : 0u; a.w = c0 ? pk2(w1[2], w1[3]) : 0u;
                b.x = c0 ? pk2(w2[0], w2[1]) : 0u; b.y = c0 ? pk2(w2[2], w2[3]) : 0u; b.z = c0 ? pk2(w3[0], w3[1]) : 0u; b.w = c0 ? pk2(w3[2], w3[3]) : 0u;
                wsf0 = __builtin_bit_cast(bf16x8, a); wsf1 = __builtin_bit_cast(bf16x8, b); }
              const int l16 = lane & 15, q4 = l16 >> 2, p4 = l16 & 3;
              const unsigned kb = (unsigned)(uintptr_t)(L + KS) + (unsigned)((8 * fq + q4) * KST + 4 * p4 * 2);
#define TR_READS "ds_read_b64_tr_b16 %0, %[ad]\n\tds_read_b64_tr_b16 %1, %[ad] offset:2112\n\tds_read_b64_tr_b16 %2, %[ad] offset:16896\n\tds_read_b64_tr_b16 %3, %[ad] offset:19008\n\t" \
                 "ds_read_b64_tr_b16 %4, %[ad] offset:32\n\tds_read_b64_tr_b16 %5, %[ad] offset:2144\n\tds_read_b64_tr_b16 %6, %[ad] offset:16928\n\tds_read_b64_tr_b16 %7, %[ad] offset:19040"
#define TR_OUT(R) "=&v"(R[0]), "=&v"(R[1]), "=&v"(R[2]), "=&v"(R[3]), "=&v"(R[4]), "=&v"(R[5]), "=&v"(R[6]), "=&v"(R[7])
#define TR_INOUT(R) "+v"(R[0]), "+v"(R[1]), "+v"(R[2]), "+v"(R[3]), "+v"(R[4]), "+v"(R[5]), "+v"(R[6]), "+v"(R[7])
              s16x4 rA[8], rB[8];
              { const unsigned a0 = kb + (8 * wg) * 32; asm volatile(TR_READS : TR_OUT(rA) : [ad] "v"(a0) : "memory"); }
#define C_STEP(dtl, RC, RN) do { \
                  if ((dtl) < 6) { const unsigned a1 = kb + (8 * wg + (dtl) + 2) * 32; asm volatile(TR_READS "\n\ts_waitcnt lgkmcnt(8)" : TR_OUT(RN), TR_INOUT(RC) : [ad] "v"(a1) : "memory"); } \
                  else asm volatile("s_waitcnt lgkmcnt(0)" : TR_INOUT(RC) : : "memory"); \
                  const bf16x8 k0 = __builtin_shufflevector(RC[0], RC[1], 0, 1, 2, 3, 4, 5, 6, 7), k1 = __builtin_shufflevector(RC[2], RC[3], 0, 1, 2, 3, 4, 5, 6, 7); \
                  const bf16x8 k2 = __builtin_shufflevector(RC[4], RC[5], 0, 1, 2, 3, 4, 5, 6, 7), k3 = __builtin_shufflevector(RC[6], RC[7], 0, 1, 2, 3, 4, 5, 6, 7); \
                  Cacc[dtl] = Cacc[dtl] * decay; Cacc[(dtl) + 1] = Cacc[(dtl) + 1] * decay; \
                  Cacc[dtl] = __builtin_amdgcn_mfma_f32_16x16x32_bf16(k0, vw0, Cacc[dtl], 0, 0, 0); \
                  Cacc[(dtl) + 1] = __builtin_amdgcn_mfma_f32_16x16x32_bf16(k2, vw0, Cacc[(dtl) + 1], 0, 0, 0); \
                  Cacc[dtl] = __builtin_amdgcn_mfma_f32_16x16x32_bf16(k1, vw1, Cacc[dtl], 0, 0, 0); \
                  Cacc[(dtl) + 1] = __builtin_amdgcn_mfma_f32_16x16x32_bf16(k3, vw1, Cacc[(dtl) + 1], 0, 0, 0); \
                  if ((dtl) == 2 * pt) {                                            \
                      Nacc[0] = Nacc[0] * decay; Nacc[1] = Nacc[1] * decay; \
                      Nacc[0] = __builtin_amdgcn_mfma_f32_16x16x32_bf16(k0, wsf0, Nacc[0], 0, 0, 0); Nacc[1] = __builtin_amdgcn_mfma_f32_16x16x32_bf16(k2, wsf0, Nacc[1], 0, 0, 0); \
                      Nacc[0] = __builtin_amdgcn_mfma_f32_16x16x32_bf16(k1, wsf1, Nacc[0], 0, 0, 0); Nacc[1] = __builtin_amdgcn_mfma_f32_16x16x32_bf16(k3, wsf1, Nacc[1], 0, 0, 0); } } while (0)
              C_STEP(0, rA, rB); C_STEP(2, rB, rA); C_STEP(4, rA, rB); C_STEP(6, rB, rA);
#undef C_STEP
#undef TR_READS
#undef TR_OUT
#undef TR_INOUT
            }
            __syncthreads();
            { const float decay = T[320];
#pragma unroll
              for (int dtl = 0; dtl < 8; ++dtl) { const int dt = 8 * wg + dtl; v2u o; o.x = pk2(Cacc[dtl][0], Cacc[dtl][1]); o.y = pk2(Cacc[dtl][2], Cacc[dtl][3]);
                  *(LAS v2u*)(L + CTI + (16 * pt + fr) * KST + (16 * dt + 4 * fq) * 2) = o; }
              if (fr == 0) { *(LAS f32x4*)(L + NT + (16 * (8 * wg + 2 * pt) + 4 * fq) * 4) = Nacc[0]; *(LAS f32x4*)(L + NT + (16 * (8 * wg + 2 * pt + 1) + 4 * fq) * 4) = Nacc[1]; } }
            if (has_next) STORE_KV(nxt);
            __syncthreads();
        }
#undef TOF
#undef G1_TABLES
#undef LOAD_KV
#undef STORE_KV
#undef LOAD_Q
    }
}

__device__ __forceinline__ void ym_phase(Frame& F) {
    const bf16* HF = (const bf16*)(F.ws + WS_XM); const bf16* HB = (const bf16*)F.out + (size_t)MTOK * DM; bf16* OP = (bf16*)(F.ws + WS_OP);
    const float* ng = F.in[9];
    const int gw = F.bid * NWAVES + F.wave, NGW = F.G * NWAVES;
    for (int m0 = 2 * gw; m0 < MTOK; m0 += 2 * NGW) {
        v2u ra[2][4], rb[2][4], rop[2][4];
#pragma unroll
        for (int t = 0; t < 2; ++t)
#pragma unroll
            for (int hd = 0; hd < 4; ++hd) { const size_t o = (size_t)(m0 + t) * DM + hd * 256 + F.lane * 4;
                ra[t][hd] = *(const v2u*)(HF + o); rb[t][hd] = *(const v2u*)(HB + o); rop[t][hd] = *(const v2u*)(OP + o); }
#pragma unroll
        for (int t = 0; t < 2; ++t)
#pragma unroll
            for (int hd = 0; hd < 4; ++hd) {
                const size_t o = (size_t)(m0 + t) * DM + hd * 256 + F.lane * 4;
                const v2u a = ra[t][hd], b = rb[t][hd], op = rop[t][hd];
                const float v0 = bflo(a.x) + bflo(b.x), v1 = bfhi(a.x) + bfhi(b.x), v2 = bflo(a.y) + bflo(b.y), v3 = bfhi(a.y) + bfhi(b.y);
                const float r = rsqrtf(wave_sum((v0 * v0 + v1 * v1) + (v2 * v2 + v3 * v3)) * (1.f / 256.f) + EPS);
                const f32x4 g = *(const f32x4*)(ng + hd * 256 + F.lane * 4);
                v2u w; w.x = pk2(sigmoidf_(bflo(op.x)) * v0 * r * g[0], sigmoidf_(bfhi(op.x)) * v1 * r * g[1]);
                w.y = pk2(sigmoidf_(bflo(op.y)) * v2 * r * g[2], sigmoidf_(bfhi(op.y)) * v3 * r * g[3]);
                *(v2u*)(OP + o) = w;
            }
    }
    {
        float* usc = (float*)(F.ws + WS_LG + 16 * MiB); float* vsc = usc + NEXP;
        for (int row0 = 2 * gw; row0 < 2 * NEXP; row0 += 2 * NGW) {
            const bool isv = row0 >= NEXP; const int r0 = isv ? row0 - NEXP : row0;
            f32x4 a[2][4];
#pragma unroll
            for (int t = 0; t < 2; ++t) { const f32x4* src = (const f32x4*)(F.in[isv ? 24 : 23] + (size_t)(r0 + t) * DM) + F.lane * 4;
#pragma unroll
                for (int j = 0; j < 4; ++j) a[t][j] = src[j]; }
#pragma unroll
            for (int t = 0; t < 2; ++t) { const int r = r0 + t; float ss = 0.f;
#pragma unroll
                for (int j = 0; j < 4; ++j) ss += (a[t][j][0] * a[t][j][0] + a[t][j][1] * a[t][j][1]) + (a[t][j][2] * a[t][j][2] + a[t][j][3] * a[t][j][3]);
                const float rms = sqrtf(wave_sum(ss) * (1.f / DM));
                const float sc = fmaxf(rms * 0.5f, 1e-30f), inv = 1.f / sc;
                unsigned o[2] = {0u, 0u};
#pragma unroll
                for (int j = 0; j < 4; ++j) { const f32x4 q = a[t][j] * inv;
                    if (j & 1) { o[j >> 1] = __builtin_amdgcn_cvt_scalef32_pk_fp4_f32(o[j >> 1], q[0], q[1], 1.0f, 2); o[j >> 1] = __builtin_amdgcn_cvt_scalef32_pk_fp4_f32(o[j >> 1], q[2], q[3], 1.0f, 3); }
                    else       { o[j >> 1] = __builtin_amdgcn_cvt_scalef32_pk_fp4_f32(o[j >> 1], q[0], q[1], 1.0f, 0); o[j >> 1] = __builtin_amdgcn_cvt_scalef32_pk_fp4_f32(o[j >> 1], q[2], q[3], 1.0f, 1); } }
                *(v2u*)(F.ws + WS_LG + (isv ? 8 * MiB : 0) + (size_t)r * (DM / 2) + F.lane * 8) = (v2u){o[0], o[1]};
                if (F.lane == 0) (isv ? vsc : usc)[r] = sc; }
        }
    }
}

typedef float f32x16 __attribute__((ext_vector_type(16)));
#define TOPK_INSERT(L, xv) do { const float x_ = (xv); \
    L[15] = __builtin_amdgcn_fmed3f(L[14], L[15], x_); L[14] = __builtin_amdgcn_fmed3f(L[13], L[14], x_); L[13] = __builtin_amdgcn_fmed3f(L[12], L[13], x_); L[12] = __builtin_amdgcn_fmed3f(L[11], L[12], x_); \
    L[11] = __builtin_amdgcn_fmed3f(L[10], L[11], x_); L[10] = __builtin_amdgcn_fmed3f(L[9], L[10], x_); L[9] = __builtin_amdgcn_fmed3f(L[8], L[9], x_); L[8] = __builtin_amdgcn_fmed3f(L[7], L[8], x_); \
    L[7] = __builtin_amdgcn_fmed3f(L[6], L[7], x_); L[6] = __builtin_amdgcn_fmed3f(L[5], L[6], x_); L[5] = __builtin_amdgcn_fmed3f(L[4], L[5], x_); L[4] = __builtin_amdgcn_fmed3f(L[3], L[4], x_); \
    L[3] = __builtin_amdgcn_fmed3f(L[2], L[3], x_); L[2] = __builtin_amdgcn_fmed3f(L[1], L[2], x_); L[1] = __builtin_amdgcn_fmed3f(L[0], L[1], x_); L[0] = fmaxf(L[0], x_); } while (0)
#define SEL_CE(L, a, b) do { const float hi_ = fmaxf(L[a], L[b]), lo_ = fminf(L[a], L[b]); L[a] = hi_; L[b] = lo_; } while (0)
#define SORT16_DESC(L) do { SEL_CE(L, 0, 1); SEL_CE(L, 2, 3); SEL_CE(L, 0, 2); SEL_CE(L, 1, 3); SEL_CE(L, 1, 2); SEL_CE(L, 4, 5); SEL_CE(L, 6, 7); SEL_CE(L, 4, 6); SEL_CE(L, 5, 7); SEL_CE(L, 5, 6); SEL_CE(L, 0, 4); SEL_CE(L, 2, 6); SEL_CE(L, 2, 4); SEL_CE(L, 1, 5); SEL_CE(L, 3, 7); SEL_CE(L, 3, 5); SEL_CE(L, 1, 2); SEL_CE(L, 3, 4); SEL_CE(L, 5, 6); SEL_CE(L, 8, 9); SEL_CE(L, 10, 11); SEL_CE(L, 8, 10); SEL_CE(L, 9, 11); SEL_CE(L, 9, 10); SEL_CE(L, 12, 13); SEL_CE(L, 14, 15); SEL_CE(L, 12, 14); SEL_CE(L, 13, 15); SEL_CE(L, 13, 14); SEL_CE(L, 8, 12); SEL_CE(L, 10, 14); SEL_CE(L, 10, 12); SEL_CE(L, 9, 13); SEL_CE(L, 11, 15); SEL_CE(L, 11, 13); SEL_CE(L, 9, 10); SEL_CE(L, 11, 12); SEL_CE(L, 13, 14); SEL_CE(L, 0, 8); SEL_CE(L, 4, 12); SEL_CE(L, 4, 8); SEL_CE(L, 2, 10); SEL_CE(L, 6, 14); SEL_CE(L, 6, 10); SEL_CE(L, 2, 4); SEL_CE(L, 6, 8); SEL_CE(L, 10, 12); SEL_CE(L, 1, 9); SEL_CE(L, 5, 13); SEL_CE(L, 5, 9); SEL_CE(L, 3, 11); SEL_CE(L, 7, 15); SEL_CE(L, 7, 11); SEL_CE(L, 3, 5); SEL_CE(L, 7, 9); SEL_CE(L, 11, 13); SEL_CE(L, 1, 2); SEL_CE(L, 3, 4); SEL_CE(L, 5, 6); SEL_CE(L, 7, 8); SEL_CE(L, 9, 10); SEL_CE(L, 11, 12); SEL_CE(L, 13, 14); } while (0)
#define BMERGE16_DESC(L) do { SEL_CE(L, 0, 8); SEL_CE(L, 1, 9); SEL_CE(L, 2, 10); SEL_CE(L, 3, 11); SEL_CE(L, 4, 12); SEL_CE(L, 5, 13); SEL_CE(L, 6, 14); SEL_CE(L, 7, 15); SEL_CE(L, 0, 4); SEL_CE(L, 1, 5); SEL_CE(L, 2, 6); SEL_CE(L, 3, 7); SEL_CE(L, 8, 12); SEL_CE(L, 9, 13); SEL_CE(L, 10, 14); SEL_CE(L, 11, 15); SEL_CE(L, 0, 2); SEL_CE(L, 1, 3); SEL_CE(L, 4, 6); SEL_CE(L, 5, 7); SEL_CE(L, 8, 10); SEL_CE(L, 9, 11); SEL_CE(L, 12, 14); SEL_CE(L, 13, 15); SEL_CE(L, 0, 1); SEL_CE(L, 2, 3); SEL_CE(L, 4, 5); SEL_CE(L, 6, 7); SEL_CE(L, 8, 9); SEL_CE(L, 10, 11); SEL_CE(L, 12, 13); SEL_CE(L, 14, 15); } while (0)
template <int I> struct CandRow {
    static __device__ __forceinline__ void run(const float (&L0)[16], const float (&L1)[16], float (&R)[16]) {
        constexpr int NJ = 16 / (I + 1);
#pragma unroll
        for (int j = 0; j < NJ; ++j) { const float sm = L0[I] + L1[j];
            const float pk = __builtin_bit_cast(float, (__builtin_bit_cast(unsigned, sm) & 0xffffff00u) | (unsigned)(I * 16 + j)); TOPK_INSERT(R, pk); }
        if constexpr (I < 15) CandRow<I + 1>::run(L0, L1, R);
    }
};
__device__ __forceinline__ unsigned pick4(unsigned d0, unsigned d1, unsigned d2, unsigned d3, int i) {
    const int q = i >> 2; unsigned d = d0; d = (q == 1) ? d1 : d; d = (q == 2) ? d2 : d; d = (q == 3) ? d3 : d; return (d >> (8 * (i & 3))) & 127u;
}
__device__ __forceinline__ void select_phase(Frame& F) {
    const bf16* PQ = (const bf16*)(F.ws + WS_MG); const bf16* KEYS = (const bf16*)(F.ws + WS_KEYS);
    int* IDX = (int*)(F.ws + WS_K); float* GW = (float*)(F.ws + WS_K + 16 * MiB);
    LAS unsigned char* L = F.lds;
    const int tid = F.tid, lane = F.lane, w = F.wave, l31 = lane & 31, hh = lane >> 5;
    const float NEG_INF = -INFINITY;
    for (int grp = F.bid; grp < MTOK / 128; grp += F.G) {
        const int tb = grp * 4 + (w & 3);
        const size_t m = (size_t)tb * 32 + l31;
        for (int hp = 0; hp < 4; ++hp) {
            __syncthreads();
#pragma unroll 4
            for (int r = 0; r < 16; ++r) { const int e = tid + NTHR * r, R = e >> 4, c = e & 15;
                *(LAS v4u*)(L + R * 256 + ((c ^ (R & 15)) * 16)) = *(const v4u*)(KEYS + ((size_t)(hp * 512 + R) * 128 + c * 8)); }
            __syncthreads();
            const int hl = w >> 2, h = 2 * hp + hl;
            float L0[16], L1[16];
#pragma unroll
            for (int p = 0; p < 2; ++p) {
                bf16x8 qf[8];
#pragma unroll
                for (int ks = 0; ks < 8; ++ks) qf[ks] = *(const bf16x8*)(PQ + m * 2048 + h * 256 + p * 128 + 16 * ks + 8 * hh);
                f32x16 acc[4];
#pragma unroll
                for (int kb = 0; kb < 4; ++kb)
#pragma unroll
                    for (int r = 0; r < 16; ++r) acc[kb][r] = 0.f;
#pragma unroll
                for (int ks = 0; ks < 8; ++ks)
#pragma unroll
                    for (int kb = 0; kb < 4; ++kb) { const int R = (hl * 2 + p) * 128 + 32 * kb + l31;
                        const bf16x8 kf = *(const LAS bf16x8*)(L + R * 256 + (((2 * ks + hh) ^ (lane & 15)) * 16));
                        acc[kb] = __builtin_amdgcn_mfma_f32_32x32x16_bf16(kf, qf[ks], acc[kb], 0, 0, 0); }
                float Lc[16];
                const unsigned hh4 = (unsigned)hh << 2;
#pragma unroll
                for (int kb = 0; kb < 4; ++kb) { float Nw[16];
#pragma unroll
                    for (int r = 0; r < 16; ++r) { const unsigned nlo = (unsigned)(32 * kb + (r & 3) + 8 * (r >> 2));
                        const float av_ = acc[kb][r];
                        Nw[r] = __uint_as_float(((__float_as_uint(av_) & 0xffffff80u) | hh4) | nlo); }
                    SORT16_DESC(Nw);
                    if (kb == 0) {
#pragma unroll
                        for (int i = 0; i < 16; ++i) Lc[i] = Nw[i];
                    } else {
#pragma unroll
                        for (int i = 0; i < 16; ++i) Lc[i] = fmaxf(Lc[i], Nw[15 - i]);
                        BMERGE16_DESC(Lc); } }
                { float Lo[16];
#pragma unroll
                  for (int i = 0; i < 16; ++i) Lo[i] = __shfl_xor(Lc[i], 32);
#pragma unroll
                  for (int i = 0; i < 16; ++i) Lc[i] = fmaxf(Lc[i], Lo[15 - i]);
                  BMERGE16_DESC(Lc); }
#pragma unroll
                for (int i = 0; i < 16; ++i) { if (p == 0) L0[i] = Lc[i]; else L1[i] = Lc[i]; }
            }
            float R[16];
#pragma unroll
            for (int j = 0; j < 16; ++j) { const float sm = L0[0] + L1[j]; R[j] = __builtin_bit_cast(float, (__builtin_bit_cast(unsigned, sm) & 0xffffff00u) | (unsigned)j); }
            SORT16_DESC(R);
            CandRow<1>::run(L0, L1, R);
            unsigned a0 = 0, a1 = 0, a2 = 0, a3 = 0, b0 = 0, b1 = 0, b2 = 0, b3 = 0;
#pragma unroll
            for (int i = 0; i < 4; ++i) { a0 |= (__builtin_bit_cast(unsigned, L0[i]) & 127u) << (8 * i); a1 |= (__builtin_bit_cast(unsigned, L0[4 + i]) & 127u) << (8 * i);
                a2 |= (__builtin_bit_cast(unsigned, L0[8 + i]) & 127u) << (8 * i); a3 |= (__builtin_bit_cast(unsigned, L0[12 + i]) & 127u) << (8 * i);
                b0 |= (__builtin_bit_cast(unsigned, L1[i]) & 127u) << (8 * i); b1 |= (__builtin_bit_cast(unsigned, L1[4 + i]) & 127u) << (8 * i);
                b2 |= (__builtin_bit_cast(unsigned, L1[8 + i]) & 127u) << (8 * i); b3 |= (__builtin_bit_cast(unsigned, L1[12 + i]) & 127u) << (8 * i); }
            float ex[16]; float sum = 0.f; int id[16];
#pragma unroll
            for (int r = 0; r < 16; ++r) { ex[r] = __expf(R[r] - R[0]); sum += ex[r];
                const unsigned cid = __builtin_bit_cast(unsigned, R[r]) & 255u;
                id[r] = (int)(pick4(a0, a1, a2, a3, (int)(cid >> 4)) * 128u + pick4(b0, b1, b2, b3, (int)(cid & 15u))); }
            const float inv = 1.f / sum;
            if (hh == 0) {
#pragma unroll
                for (int q = 0; q < 4; ++q) {
                    *(int4*)(IDX + m * 128 + h * 16 + 4 * q) = make_int4(id[4 * q], id[4 * q + 1], id[4 * q + 2], id[4 * q + 3]);
                    *(f32x4*)(GW + m * 128 + h * 16 + 4 * q) = (f32x4){ex[4 * q] * inv, ex[4 * q + 1] * inv, ex[4 * q + 2] * inv, ex[4 * q + 3] * inv}; }
            }
        }
    }
}

template <int B> __device__ __forceinline__ f32x2 fp4b(unsigned w) { return __builtin_amdgcn_cvt_scalef32_pk_f32_fp4(w, 1.0f, B); }
typedef int v8i_t __attribute__((ext_vector_type(8)));
#define AP_SLOT(e) (4 * (((e) >> 1) & 3) + 2 * ((e) >> 3) + ((e) & 1))
__device__ __forceinline__ void apply_phase(Frame& F, float* OUTP) {
    const unsigned char* U8 = F.ws + WS_LG; const unsigned char* V8 = F.ws + WS_LG + 8 * MiB;
    const float* USC = (const float*)(F.ws + WS_LG + 16 * MiB); const float* VSC = USC + NEXP;
    const int* IDX = (const int*)(F.ws + WS_K); const float* GW = (const float*)(F.ws + WS_K + 16 * MiB);
    const float* g2 = F.in[20]; const float* gf = F.in[25];
    const float* X1 = F.out;
    const int lane = F.lane, fr = lane & 15, fq = lane >> 4;
    constexpr int APW = 2 * 16 * 528 + 1024;
    LAS unsigned char* UL = F.lds + F.wave * APW; LAS unsigned char* VL = UL + 16 * 528; LAS unsigned char* H8 = VL + 16 * 528;
    const int pe = 2 * fq + (fr & 1) + 8 * ((fr >> 1) & 1);
    const int bsh = 8 * (fr & 3); const unsigned mlo = fr < 4 ? ~0u : 0u, mhi = (fr >= 4 && fr < 8) ? ~0u : 0u;
#define AP_LOADROWS(SEL, KB) _Pragma("unroll") for (int e = 0; e < 16; ++e) { \
        const size_t ro = (size_t)__builtin_amdgcn_readlane(SEL, ((KB) + e) & 63) * (DM / 2) + lane * 8; uu[e] = *(const v2u*)(U8 + ro); vv[e] = *(const v2u*)(V8 + ro); }
    for (int grp = F.bid; grp < MTOK / 128; grp += F.G) {
        const int mbase = grp * 128 + F.wave;
        int ni0 = IDX[(size_t)mbase * 128 + lane], ni1 = IDX[(size_t)mbase * 128 + 64 + lane];
        float ngw0 = GW[(size_t)mbase * 128 + lane], ngw1 = GW[(size_t)mbase * 128 + 64 + lane];
        f32x4 nxr[4];
#pragma unroll
        for (int q = 0; q < 4; ++q) nxr[q] = *(const f32x4*)(X1 + (size_t)mbase * DM + lane * 16 + q * 4);
        v2u uu[16], vv[16];
        AP_LOADROWS(ni0, 0)
        int i0 = 0, i1 = 0; float gw0 = 0.f, gw1 = 0.f; f32x4 xr[4], oacc[8];
#pragma unroll
        for (int q = 0; q < 4; ++q) xr[q] = (f32x4){0.f, 0.f, 0.f, 0.f};
#pragma unroll
        for (int i = 0; i < 8; ++i) oacc[i] = (f32x4){0.f, 0.f, 0.f, 0.f};
#pragma unroll 1
        for (int it = 0; it < 128; ++it) {
            const int bt = it & 7, m = mbase + 8 * (it >> 3);
            if (bt == 0) {
                i0 = ni0; i1 = ni1; gw0 = ngw0; gw1 = ngw1; float s = 0.f;
#pragma unroll
                for (int q = 0; q < 4; ++q) { xr[q] = nxr[q]; s += (xr[q][0] * xr[q][0] + xr[q][1] * xr[q][1]) + (xr[q][2] * xr[q][2] + xr[q][3] * xr[q][3]); }
                const float r2 = rsqrtf(wave_sum(s) * (1.f / DM) + EPS);
                v4u h8;
#pragma unroll
                for (int q = 0; q < 4; ++q) { const f32x4 g = *(const f32x4*)(g2 + lane * 16 + q * 4); const f32x4 hq = xr[q] * r2 * g;
                    int pk = 0; pk = __builtin_amdgcn_cvt_pk_fp8_f32(hq[0], hq[1], pk, false); pk = __builtin_amdgcn_cvt_pk_fp8_f32(hq[2], hq[3], pk, true); h8[q] = (unsigned)pk; }
                *(LAS v4u*)(H8 + lane * 16) = h8;
#pragma unroll
                for (int i = 0; i < 8; ++i) oacc[i] = (f32x4){0.f, 0.f, 0.f, 0.f};
                const int mn = (it + 8 < 128) ? m + 8 : m;
                ni0 = IDX[(size_t)mn * 128 + lane]; ni1 = IDX[(size_t)mn * 128 + 64 + lane]; ngw0 = GW[(size_t)mn * 128 + lane]; ngw1 = GW[(size_t)mn * 128 + 64 + lane];
#pragma unroll
                for (int q = 0; q < 4; ++q) nxr[q] = *(const f32x4*)(X1 + (size_t)mn * DM + lane * 16 + q * 4);
            }
            const int k0 = bt * 16;
            const int isel = (k0 < 64) ? i0 : i1;
            const int myidx = __shfl(isel, (k0 + pe) & 63);
            const float su = USC[myidx], sv = VSC[myidx];
#pragma unroll
            for (int e = 0; e < 16; ++e) { *(LAS v2u*)(UL + AP_SLOT(e) * 528 + lane * 8) = uu[e]; *(LAS v2u*)(VL + e * 528 + lane * 8) = vv[e]; }
            { const int nk = (k0 + 16) & 127; const int nsel = (bt == 7) ? ni0 : ((nk < 64) ? i0 : i1);
              AP_LOADROWS(nsel, nk) }
            f32x4 da = (f32x4){0.f, 0.f, 0.f, 0.f}, db = (f32x4){0.f, 0.f, 0.f, 0.f};
#pragma unroll
            for (int ks = 0; ks < 8; ++ks) {
                const v4u af = *(const LAS v4u*)(UL + fr * 528 + 64 * ks + 16 * fq);
                const v4u b0 = *(const LAS v4u*)(H8 + 128 * ks + 16 * fq), b1 = *(const LAS v4u*)(H8 + 128 * ks + 64 + 16 * fq);
                const v8i_t A = {(int)af.x, (int)af.y, (int)af.z, (int)af.w, 0, 0, 0, 0};
                const v8i_t B = {(int)b0.x, (int)b0.y, (int)b0.z, (int)b0.w, (int)b1.x, (int)b1.y, (int)b1.z, (int)b1.w};
                if (ks & 1) db = __builtin_amdgcn_mfma_scale_f32_16x16x128_f8f6f4(A, B, db, 4  , 0  , 0, 0x7F7F7F7F, 0, 0x7F7F7F7F);
                else        da = __builtin_amdgcn_mfma_scale_f32_16x16x128_f8f6f4(A, B, da, 4, 0, 0, 0x7F7F7F7F, 0, 0x7F7F7F7F);
            }
            const f32x4 d4 = da + db;
            const int sel = fr & 3;
            float t = d4[0]; t = (sel == 1) ? d4[1] : t; t = (sel == 2) ? d4[2] : t; t = (sel == 3) ? d4[3] : t;
            const float gk = __shfl((k0 < 64) ? gw0 : gw1, (k0 + pe) & 63);
            const float wl = gk * gelu_fast(t * su) * sv;
            float wm = fabsf(wl); wm = fmaxf(wm, __shfl_xor(wm, 1)); wm = fmaxf(wm, __shfl_xor(wm, 2)); wm = fmaxf(wm, __shfl_xor(wm, 16)); wm = fmaxf(wm, __shfl_xor(wm, 32));
            int E = (int)(__float_as_uint(wm) >> 23); E = E < 8 ? 8 : E;
            const float wq = wl * __uint_as_float((unsigned)(261 - E) << 23);
            const int scb = (E - 7) * 0x01010101;
            v8i_t Bw;
#define AP_WQ(tq, ctrl) { const float wt = __builtin_bit_cast(float, __builtin_amdgcn_update_dpp(0, __builtin_bit_cast(int, wq), ctrl, 0xf, 0xf, false)); \
                const unsigned p8 = (unsigned)__builtin_amdgcn_cvt_pk_fp8_f32(wt, 0.f, 0, false) << bsh; Bw[2 * tq] = (int)(p8 & mlo); Bw[2 * tq + 1] = (int)(p8 & mhi); }
            AP_WQ(0, 0x00) AP_WQ(1, 0x55) AP_WQ(2, 0xAA) AP_WQ(3, 0xFF)
#pragma unroll
            for (int c = 0; c < 8; ++c) {
                v4u av;
                av.x = *(const LAS unsigned*)(VL + (4 * fq + 0) * 528 + 64 * c + 4 * fr); av.y = *(const LAS unsigned*)(VL + (4 * fq + 1) * 528 + 64 * c + 4 * fr);
                av.z = *(const LAS unsigned*)(VL + (4 * fq + 2) * 528 + 64 * c + 4 * fr); av.w = *(const LAS unsigned*)(VL + (4 * fq + 3) * 528 + 64 * c + 4 * fr);
                const v8i_t A = {(int)av.x, (int)av.y, (int)av.z, (int)av.w, 0, 0, 0, 0};
                oacc[c] = __builtin_amdgcn_mfma_scale_f32_16x16x128_f8f6f4(A, Bw, oacc[c], 4, 0, 0, 0x7F7F7F7F, 0, scb);
            }
            if (bt == 7) {
                if (fr < 8) {
#pragma unroll
                    for (int c = 0; c < 8; ++c)
#pragma unroll
                        for (int r = 0; r < 4; ++r) { const float o = oacc[c][r]; *(LAS unsigned*)(UL + 4 * ((4 * c + fq) * 40 + 8 * r + fr)) = __float_as_uint(o); }
                }
                float s2 = 0.f; f32x4 ov[4];
#pragma unroll
                for (int q = 0; q < 4; ++q) { const v4u ou = *(const LAS v4u*)(UL + 4 * ((lane >> 1) * 40 + (lane & 1) * 16 + 4 * q));
                    ov[q] = (f32x4){__uint_as_float(ou.x), __uint_as_float(ou.y), __uint_as_float(ou.z), __uint_as_float(ou.w)} + xr[q];
                    s2 += (ov[q][0] * ov[q][0] + ov[q][1] * ov[q][1]) + (ov[q][2] * ov[q][2] + ov[q][3] * ov[q][3]); }
                const float rf = rsqrtf(wave_sum(s2) * (1.f / DM) + EPS);
#pragma unroll
                for (int q = 0; q < 4; ++q) { const f32x4 g = *(const f32x4*)(gf + lane * 16 + q * 4);
                    *(f32x4*)(OUTP + (size_t)m * DM + lane * 16 + q * 4) = ov[q] * rf * g; }
            }
        }
    }
}

constexpr int N_PHASES = 13;
__global__ void __launch_bounds__(NTHR, 2) mega_fwd(Args args) {
    extern __shared__ __attribute__((aligned(16))) unsigned char lds[];
    Frame F;
    F.lds = (LAS unsigned char*)lds;
    F.tid = threadIdx.x; F.lane = F.tid & 63; F.wave = __builtin_amdgcn_readfirstlane(F.tid >> 6);
    F.G = gridDim.x; F.bid = blockIdx.x;
    F.in = args.in; F.out = args.out; F.ws = args.ws;
    volatile LAS unsigned* MISC = (volatile LAS unsigned*)(F.lds + MISC_OFF);
    for (int u = F.tid; u < (LDS_BYTES - LDSCTL_OFF) / 4; u += NTHR) ((LAS unsigned*)(F.lds + LDSCTL_OFF))[u] = 0u;
    __syncthreads();
    XcdBarrier bar; bar.bar = (unsigned*)(args.ws + WS_CTL) + CW_BAR; bar.x = 0; bar.st = nullptr;
    const bool one_launch = (args.ph_hi - args.ph_lo) > 1;
    if (one_launch) bar = xcd_barrier_post((unsigned*)(args.ws + WS_CTL) + CW_BAR, MISC + 8);
    const int lo = args.ph_lo, hi = args.ph_hi;
#define IN(k) (lo <= (k) && (k) < hi)
#define SEAM(k) do { if (IN(k) && IN((k) + 1)) xcd_barrier(bar); } while (0)
    unsigned char* ws = args.ws;

#ifndef PROBE_MASK
#define PROBE_MASK 0
#endif
#define REP(k) _Pragma("unroll") for (int rep_ = 0; rep_ < (((PROBE_MASK >> (k)) & 1) ? 2 : 1); ++rep_)
    if (IN(0)) REP(0) { p0_prologue(F); if (rep_ == 0 && ((PROBE_MASK >> 0) & 1)) xcd_barrier(bar); } SEAM(0);
    if (IN(1)) REP(1) {
        gates_phase(F);
        { AddrP1 g{(const char*)(ws + WS_K), (const char*)(ws + WS_WIN), 1024, 1024, 1024, 4, 0, 8};
          pg8::StaticOrder S; S.init(MTOK, 2048, F.G, F.bid, 4);
          EpiBf16<DstP1> E{DstP1{ws, 4, 0, 8}, 1.f};
          pg8::gemm_phase(F.lds, g, S, E); }
        { AddrP1 g{(const char*)F.out, (const char*)(ws + WS_WIN8), 512, 512, 512, 8, 4, 8};
          pg8::StaticOrder S; S.init(MTOK, 4096, F.G, F.bid, 4);
          EpiBf16<DstP1, true> E{DstP1{ws, 8, 4, 8}, 1.f / 1024.f};
          pg8::gemm_phase<EpiBf16<DstP1, true>, AddrP1, 1>(F.lds, g, S, E); }
    } SEAM(1);
    if (IN(2)) REP(2) { lru_phase<false>(F); } SEAM(2);
    if (IN(3)) REP(3) { lru_phase<true>(F); } SEAM(3);
    if (IN(4)) REP(4) { mconv_phase(F); } SEAM(4);
    if (IN(5)) REP(5) {
        const char* xc = (const char*)F.out + (size_t)MTOK * DM * 2;
        AddrQKV g{xc, (long)((const char*)(ws + WS_XM) - xc), (const char*)(ws + WS_WQKV), 1024, 256, 256};
        pg8::StaticOrder S; S.init(MTOK, 12 * 256, F.G, F.bid);
        EpiBf16<DstQKV> E{DstQKV{(char*)(ws + WS_LG), (long)WS_K - (long)WS_LG, (long)WS_XL - (long)WS_LG}, 1.f};
        pg8::gemm_phase(F.lds, g, S, E);
    } SEAM(5);
    if (IN(6)) REP(6) { mscan_phase(F); } SEAM(6);
    if (IN(7)) { ym_phase(F); } SEAM(7);
    if (IN(8)) {
        pg8::StaticOrder S; S.init(MTOK, 1024, F.G, F.bid);
        { AddrPlain g{(const char*)(ws + WS_OP), (const char*)(ws + WS_WB2), 1024, 1024, 1024};
          EpiMerge<false> E{(bf16*)(ws + WS_XM), (const unsigned char*)(ws + WS_MG), 0}; pg8::gemm_phase(F.lds, g, S, E); }
        { AddrPlain g{(const char*)F.out, (const char*)(ws + WS_WB2) + (size_t)1024 * 1024 * 2, 1024, 1024, 1024};
          EpiMerge<true> E{(bf16*)(ws + WS_XM), (const unsigned char*)(ws + WS_MG), 1024}; pg8::gemm_phase(F.lds, g, S, E); }
    } SEAM(8);
    if (IN(9)) {
        AddrPlain g{(const char*)(ws + WS_XM), (const char*)(ws + WS_WOUT2), 1024, 2048, 1024};
        pg8::StaticOrder S; S.init(MTOK, 1024, F.G, F.bid);
        EpiResid E{F.in[0], F.out, (bf16*)(ws + WS_XL), (float*)(ws + WS_SS)};
        pg8::gemm_phase(F.lds, g, S, E);
    } SEAM(9);
    if (IN(10)) REP(10) {
        AddrPlain g{(const char*)(ws + WS_XL), (const char*)(ws + WS_WPQ), 1024, 1024, 1024};
        pg8::StaticOrder S; S.init(MTOK, 2048, F.G, F.bid, 4);
        EpiPQ E{(bf16*)(ws + WS_MG), (const float*)(ws + WS_SS)};
        pg8::gemm_phase(F.lds, g, S, E);
    } SEAM(10);
    if (IN(11)) REP(11) { select_phase(F); }
    if (IN(11) && IN(12)) { asm volatile("s_waitcnt vmcnt(0)" ::: "memory"); __syncthreads(); }
    if (IN(12)) { if ((PROBE_MASK >> 12) & 1) { apply_phase(F, (float*)(ws + WS_MG)); xcd_barrier(bar); } apply_phase(F, F.out); }
#undef REP
#undef IN
#undef SEAM
}

extern "C" void kernel_launch(void* const* d_in, const int* in_sizes, int n_in, void* d_out, int out_size, void* d_ws, size_t ws_size, hipStream_t stream) {
    static int grid = 0;
    if (grid == 0) {
        if (n_in != 26 || in_sizes[0] != MTOK * DM || out_size != MTOK * DM || ws_size < WS_END) { fprintf(stderr, "kernel_launch: unexpected shapes / workspace (%zu < %zu)\n", ws_size, (size_t)WS_END); grid = -1; return; }
        int dev = 0, cus = 0, per_cu = 0;
        if (hipGetDevice(&dev) != hipSuccess || hipDeviceGetAttribute(&cus, hipDeviceAttributeMultiprocessorCount, dev) != hipSuccess) { grid = -1; return; }
        if (hipFuncSetAttribute((const void*)mega_fwd, hipFuncAttributeMaxDynamicSharedMemorySize, LDS_BYTES) != hipSuccess) { fprintf(stderr, "kernel_launch: hipFuncSetAttribute failed\n"); grid = -1; return; }
        if (hipOccupancyMaxActiveBlocksPerMultiprocessor(&per_cu, (const void*)mega_fwd, NTHR, LDS_BYTES) != hipSuccess || per_cu < 1) { fprintf(stderr, "kernel_launch: occupancy query says %d blocks/CU\n", per_cu); (void)hipGetLastError(); grid = -1; return; }
        grid = cus;
    }
    if (grid < 0) return;
    (void)hipMemsetAsync((char*)d_ws + WS_CTL + (size_t)CW_BAR * 4, 0, (size_t)XCD_BAR_WORDS * 4, stream);
    Args a{};
    for (int i = 0; i < 26; ++i) a.in[i] = (const float*)d_in[i];
    a.out = (float*)d_out; a.ws = (unsigned char*)d_ws;
#if MK_N_LAUNCHES == 1
    a.ph_lo = 0; a.ph_hi = N_PHASES;
    void* kargs[] = {&a};
    hipError_t e = hipLaunchCooperativeKernel((const void*)mega_fwd, dim3(grid), dim3(NTHR), kargs, LDS_BYTES, stream);
    if (e != hipSuccess) fprintf(stderr, "kernel_launch: cooperative launch failed: %s (grid %d)\n", hipGetErrorString(e), grid);
#else
    for (int p = 0; p < N_PHASES; ++p) { a.ph_lo = p; a.ph_hi = p + 1; hipLaunchKernelGGL(mega_fwd, dim3(grid), dim3(NTHR), LDS_BYTES, stream, a); }
#endif
}
```

```cpp
#include <hip/hip_runtime.h>
#include <cstdio>
#include <cstdint>
#include <math.h>

#ifndef MK_N_LAUNCHES
#define MK_N_LAUNCHES 1
#endif

constexpr int BATCH = 8, SEQ = 4096, DM = 1024, MTOK = BATCH * SEQ;
constexpr int DIN = 6160;
constexpr int NEXP = 16384;
constexpr float EPS = 1e-6f;

constexpr size_t MiB = 1u << 20;
constexpr size_t WS_CTL = 0, CTL_ZERO_BYTES = 1 * MiB;
constexpr size_t WS_WIN = 1 * MiB;
constexpr size_t WS_WQKV = 13 * MiB;
constexpr size_t WS_KEYS = 14 * MiB + 512 * 1024;
constexpr size_t WS_WLRU = 15 * MiB;
constexpr size_t WS_WB2 = 16 * MiB;
constexpr size_t WS_WOUT2 = 20 * MiB;
constexpr size_t WS_WPQ = 24 * MiB;
constexpr size_t WS_GATE = 28 * MiB;
constexpr size_t WS_WGT = 30 * MiB;
constexpr size_t WS_XM = 32 * MiB;
constexpr size_t WS_OP = 96 * MiB;
constexpr size_t WS_XL = 160 * MiB;
constexpr size_t WS_LG = 224 * MiB;
constexpr size_t WS_MG = 288 * MiB;
constexpr size_t WS_K = 416 * MiB;
constexpr size_t WS_AGG = 480 * MiB;
constexpr size_t WS_SS = 488 * MiB;
constexpr size_t WS_WIN8 = 489 * MiB;
constexpr size_t WS_END = 495 * MiB;

constexpr int CW_BAR = 4096;

constexpr int RING_BYTES = 131072;
constexpr int LDS_BYTES = 147456;
constexpr int LDSCTL_OFF = LDS_BYTES - 512, MISC_OFF = LDSCTL_OFF + 320;
constexpr int NWAVES = 8, NTHR = 512;

#define GAS __attribute__((address_space(1)))
#define LAS __attribute__((address_space(3)))
typedef unsigned short bf16;
typedef unsigned v4u __attribute__((ext_vector_type(4)));
typedef unsigned v2u __attribute__((ext_vector_type(2)));
typedef float f32x4 __attribute__((ext_vector_type(4)));
typedef float f32x2 __attribute__((ext_vector_type(2)));
typedef short bf16x8 __attribute__((ext_vector_type(8)));
typedef GAS unsigned gu32;
#define RLX_AGENT __ATOMIC_RELAXED, __HIP_MEMORY_SCOPE_AGENT
#define LDS_WAIT() asm volatile("s_waitcnt lgkmcnt(0)" ::: "memory")
#define VM_WAIT() asm volatile("s_waitcnt vmcnt(0)" ::: "memory")

typedef __bf16 hwbf16x2_t __attribute__((ext_vector_type(2)));
__device__ __forceinline__ unsigned f2bf(float f) { return (unsigned)__builtin_bit_cast(unsigned short, (__bf16)f); }
__device__ __forceinline__ unsigned pk2(float lo, float hi) { typedef float f2_ __attribute__((ext_vector_type(2))); return __builtin_bit_cast(unsigned, __builtin_convertvector((f2_){lo, hi}, hwbf16x2_t)); }
__device__ __forceinline__ float bf2f(unsigned short h) { return __builtin_bit_cast(float, (unsigned)h << 16); }
__device__ __forceinline__ float bflo(unsigned w) { return __builtin_bit_cast(float, w << 16); }
__device__ __forceinline__ float bfhi(unsigned w) { return __builtin_bit_cast(float, w & 0xffff0000u); }
__device__ __forceinline__ float wave_sum(float v) {
#pragma unroll
  for (int o = 1; o < 64; o <<= 1) v += __shfl_xor(v, o);
  return v;
}
__device__ __forceinline__ float sigmoidf_(float x) { return __builtin_amdgcn_rcpf(1.f + __builtin_amdgcn_exp2f(x * -1.44269504089f)); }
__device__ __forceinline__ float gelu_erf(float x) { return 0.5f * x * (1.f + erff(x * 0.70710678118654752f)); }
__device__ __forceinline__ float gelu_fast(float v) {
    const float av = fabsf(v), t = __builtin_amdgcn_rcpf(av * 0.2316418882f + 1.0f);
    float q = t * 0.5307027145f + (-0.7265760135f); q = q * t + 0.7107068705f; q = q * t + (-0.142248368f); q = q * t + 0.127414796f; q = q * t;
    const float e = __builtin_amdgcn_exp2f((v * v) * (-0.72134752044f));
    const float m = v * (q * e);
    return v < 0.f ? m : v - m;
}
__device__ __forceinline__ float softplusf_(float x) { return fmaxf(x, 0.f) + log1pf(expf(-fabsf(x))); }

namespace pg8 {
#define PG8_LAS __attribute__((address_space(3)))
typedef unsigned short bf16_t;
typedef unsigned u32x4 __attribute__((ext_vector_type(4)));
typedef int i32x4_t __attribute__((ext_vector_type(4)));
constexpr int BM = 256, BK = 64, HALF = 128, HTB = HALF * BK * 2, STAGE_BYTES = 8 * HTB, NXCD = 8;

__host__ __device__ __forceinline__ int lds_byte(int r, int c) { const int st = (r >> 4) * 2 + (c >> 5), rr = r & 15, cc = c & 31, ob = rr * 64 + cc * 2; return st * 1024 + (ob ^ (((ob >> 9) & 1) << 5)); }
__host__ __device__ __forceinline__ void stage_rc(int b, int& R, int& C) { const int st = b / 1024, sb = b % 1024, swz = sb ^ (((sb >> 9) & 1) << 5); R = (st >> 1) * 16 + swz / 64; C = (st & 1) * 32 + (swz % 64) / 2; }
__host__ __device__ __forceinline__ int perm32(int rho) { const int n = rho >> 4, i = rho & 15; return 8 * (i >> 2) + 4 * n + (i & 3); }

struct Unit { int pm, pn; };
struct StaticOrder {
    int nM, nN, nwg, G, c, WGM;
    __host__ __device__ void init(int M, int N, int G_, int c_, int wgm = 8) { nM = M / BM; nN = N / BM; nwg = nM * nN; G = G_; c = c_; WGM = wgm; }
    __host__ __device__ bool next(int i, Unit& u) const {
        const long L = (long)i * G + c; if (L >= nwg) return false;
        int wgid = (int)L; { const int q = nwg / NXCD, r = nwg % NXCD, xcd = wgid % NXCD, off = wgid / NXCD; wgid = (xcd < r ? xcd * (q + 1) : r * (q + 1) + (xcd - r) * q) + off; }
        const int nig = WGM * nN, gid = wgid / nig, fm = gid * WGM, gsz = (nM - fm) < WGM ? (nM - fm) : WGM;
        u.pm = fm + ((wgid % nig) % gsz); u.pn = (wgid % nig) / gsz; return true;
    }
};

__device__ __forceinline__ unsigned cvt_pk_bf16(float lo, float hi) { unsigned r; asm volatile("v_cvt_pk_bf16_f32 %0, %1, %2" : "=v"(r) : "v"(lo), "v"(hi)); return r; }

template <class Epi, class Addr, int F8SC = 0, bool TWOPASS = false>
__device__ __forceinline__ void gemm_phase(PG8_LAS unsigned char* lds, const Addr g, const StaticOrder& S, const Epi& E) {
    const int tid = threadIdx.x, wid = __builtin_amdgcn_readfirstlane(tid >> 6), lane = tid & 63, wr = wid >> 2, wc = wid & 3, fr = lane & 15, fq = lane >> 4;
    const int K = g.K, nt = K / BK;
    unsigned voffA[2], voffB[2];
#pragma unroll
    for (int i = 0; i < 2; ++i) { int R, C; stage_rc(tid * 16 + i * 8192, R, C); const int Rb = Epi::PERM ? ((R & ~31) + perm32(R & 31)) : R;
        voffA[i] = (unsigned)(R * g.lda + C) * 2u; voffB[i] = (unsigned)(Rb * g.ldb + C) * 2u; }
    const size_t kstep = (size_t)(BK * 2);
    const size_t hsA = (size_t)HALF * g.lda * 2, hsB = (size_t)HALF * g.ldb * 2;
    const unsigned ldsw = (unsigned)wid * 1024u;
    const int aoff = lds_byte(wr * 64 + fr, fq * 8), boff = lds_byte(wc * 32 + fr, fq * 8);
#define PG8_SA(b, h) (((b) * 2 + (h)) * HTB)
#define PG8_SB(b, h) ((4 + (b) * 2 + (h)) * HTB)
#define PG8_STAGE(bufoff, gbase, voff) do { _Pragma("unroll") for (int _i = 0; _i < 2; ++_i) \
        __builtin_amdgcn_global_load_lds((const unsigned*)((const char*)(gbase) + (voff)[_i]), (PG8_LAS unsigned*)(lds + (bufoff) + ldsw + _i * 8192), 16, 0, 0); } while (0)
#define PG8_LDA(dst, b, h) do { _Pragma("unroll") for (int m = 0; m < 4; ++m) _Pragma("unroll") for (int k = 0; k < 2; ++k) dst[m][k] = *(const PG8_LAS bf16x8*)(lds + PG8_SA(b, h) + aoff + m * 2048 + k * 1024); } while (0)
#define PG8_LDB(dst, b, h) do { _Pragma("unroll") for (int n = 0; n < 2; ++n) _Pragma("unroll") for (int k = 0; k < 2; ++k) dst[n][k] = *(const PG8_LAS bf16x8*)(lds + PG8_SB(b, h) + boff + n * 2048 + k * 1024); } while (0)
#define PG8_CAT(x0, x1) __builtin_shufflevector(__builtin_bit_cast(i32x4_t, x0), __builtin_bit_cast(i32x4_t, x1), 0, 1, 2, 3, 4, 5, 6, 7)
#define PG8_MMA(ai, bj, At, Bt) do { __builtin_amdgcn_s_setprio(1); \
        if constexpr (F8SC != 0) { _Pragma("unroll") for (int m = 0; m < 4; ++m) _Pragma("unroll") for (int n = 0; n < 2; ++n) \
            asm volatile("v_mfma_f32_16x16x128_f8f6f4 %0, %1, %2, %0" : "+v"(acc[ai][bj][m][n]) : "v"(PG8_CAT(Bt[n][0], Bt[n][1])), "v"(PG8_CAT(At[m][0], At[m][1]))); } \
        else { _Pragma("unroll") for (int m = 0; m < 4; ++m) _Pragma("unroll") for (int n = 0; n < 2; ++n) _Pragma("unroll") for (int k = 0; k < 2; ++k) \
            acc[ai][bj][m][n] = __builtin_amdgcn_mfma_f32_16x16x32_bf16(Bt[n][k], At[m][k], acc[ai][bj][m][n], 0, 0, 0); } \
        __builtin_amdgcn_s_setprio(0); } while (0)
#define PG8_WAIT_V(n) asm volatile("s_waitcnt vmcnt(" #n ")" ::: "memory")
#define PG8_WAIT_L(n) asm volatile("s_waitcnt lgkmcnt(" #n ")" ::: "memory")
#define PG8_BAR __builtin_amdgcn_s_barrier()
#define PG8_SCHED __builtin_amdgcn_sched_barrier(0)
    Unit cur, nxt; int ui = 0;
    auto nextu = [&](int i, Unit& u) -> bool { if constexpr (TWOPASS) { if (!S.next(i >> 1, u)) return false; if (i & 1) u.pn += 4; return true; } else return S.next(i, u); };
    if (!nextu(0, cur)) return;
    f32x4 acc[2][2][4][2];
#pragma unroll
    for (int a = 0; a < 2; ++a)
#pragma unroll
        for (int b = 0; b < 2; ++b)
#pragma unroll
            for (int m = 0; m < 4; ++m)
#pragma unroll
                for (int n = 0; n < 2; ++n) acc[a][b][m][n] = (f32x4){0.f, 0.f, 0.f, 0.f};
    bf16x8 At[4][2], B0[2][2], B1[2][2];
    const char* cA = g.a(cur); const char* cB = g.b(cur);
    PG8_STAGE(PG8_SB(0, 0), cB, voffB); PG8_STAGE(PG8_SB(0, 1), cB + hsB, voffB); PG8_STAGE(PG8_SA(0, 0), cA, voffA); PG8_STAGE(PG8_SA(0, 1), cA + hsA, voffA);
    if (wr == 1) PG8_BAR;
    PG8_WAIT_V(2); PG8_BAR;
    PG8_STAGE(PG8_SB(1, 0), cB + kstep, voffB); PG8_STAGE(PG8_SA(1, 0), cA + kstep, voffA); PG8_STAGE(PG8_SB(1, 1), cB + hsB + kstep, voffB);
    PG8_WAIT_V(6); PG8_BAR;
    for (;;) {
        const bool has_next = nextu(ui + 1, nxt);
        const char* nA = has_next ? g.a(nxt) : cA; const char* nB = has_next ? g.b(nxt) : cB;
#pragma unroll 1
        for (int t = 0; t < nt; t += 2) {
            const bool last = (t == nt - 2);
            const char* a1 = cA + (size_t)(t + 1) * kstep;
            const char* a2 = last ? nA : cA + (size_t)(t + 2) * kstep; const char* b2 = last ? nB : cB + (size_t)(t + 2) * kstep;
            const char* a3 = a2 + kstep; const char* b3 = b2 + kstep;
            PG8_LDB(B0, 0, 0); PG8_LDB(B1, 0, 1); PG8_SCHED; PG8_LDA(At, 0, 0); PG8_STAGE(PG8_SA(1, 1), a1 + hsA, voffA);
            PG8_WAIT_V(8); PG8_WAIT_L(0); PG8_BAR; PG8_MMA(0, 0, At, B0); PG8_MMA(0, 1, At, B1); PG8_BAR; PG8_SCHED;
            PG8_LDA(At, 0, 1); PG8_STAGE(PG8_SB(0, 0), b2, voffB); PG8_STAGE(PG8_SB(0, 1), b2 + hsB, voffB); PG8_STAGE(PG8_SA(0, 0), a2, voffA);
            PG8_WAIT_V(8); PG8_WAIT_L(0); PG8_BAR; PG8_MMA(1, 0, At, B0); PG8_MMA(1, 1, At, B1); PG8_BAR; PG8_SCHED;
            PG8_LDB(B0, 1, 0); PG8_LDB(B1, 1, 1); PG8_SCHED; PG8_LDA(At, 1, 0); PG8_STAGE(PG8_SA(0, 1), a2 + hsA, voffA);
            PG8_WAIT_V(8); PG8_WAIT_L(0); PG8_BAR; PG8_MMA(0, 0, At, B0); PG8_MMA(0, 1, At, B1); PG8_BAR; PG8_SCHED;
            PG8_LDA(At, 1, 1); PG8_STAGE(PG8_SB(1, 0), b3, voffB); PG8_STAGE(PG8_SB(1, 1), b3 + hsB, voffB); PG8_STAGE(PG8_SA(1, 0), a3, voffA);
            PG8_WAIT_V(8); PG8_WAIT_L(0); PG8_BAR; PG8_MMA(1, 0, At, B0); PG8_MMA(1, 1, At, B1); PG8_BAR; PG8_SCHED;
        }
        if constexpr (F8SC != 0) asm volatile("s_nop 15\n\ts_nop 15" ::: "memory");
        if (wr == 0) PG8_BAR;
        bool keep = false;
        if constexpr (TWOPASS) { if (!(ui & 1)) { E.mid(acc, cur, wr, wc, fr, fq); keep = true; } }
        if (!keep) E(acc, cur, wr, wc, fr, fq);
        if (!has_next) break;
        if (!keep) {
#pragma unroll
        for (int a = 0; a < 2; ++a)
#pragma unroll
            for (int b = 0; b < 2; ++b)
#pragma unroll
                for (int m = 0; m < 4; ++m)
#pragma unroll
                    for (int n = 0; n < 2; ++n) acc[a][b][m][n] = (f32x4){0.f, 0.f, 0.f, 0.f};
        }
        cur = nxt; cA = nA; cB = nB; ++ui;
        if (wr == 1) PG8_BAR;
    }
    PG8_WAIT_V(0);
    PG8_BAR;
#undef PG8_SA
#undef PG8_SB
#undef PG8_STAGE
#undef PG8_LDA
#undef PG8_LDB
#undef PG8_MMA
#undef PG8_CAT
#undef PG8_WAIT_V
#undef PG8_WAIT_L
#undef PG8_BAR
#undef PG8_SCHED
}
}

#define XB_TMO      128
#define XB_XCNT(j)  (256  + 64 * (j))
#define XB_XSUB(j)  (1280 + 64 * (j))
#define XB_XGEN(j)  (2304 + 64 * (j))
#define XB_TOP      3328
#define XB_TOPGEN   3392
#define XCD_BAR_WORDS 3456
#define XB_SPIN_CAP (1u << 18)
__device__ __forceinline__ unsigned xb_ld(unsigned* p)              { return __hip_atomic_load(p, __ATOMIC_RELAXED, __HIP_MEMORY_SCOPE_AGENT); }
__device__ __forceinline__ unsigned xb_add(unsigned* p, unsigned v) { return __hip_atomic_fetch_add(p, v, __ATOMIC_RELAXED, __HIP_MEMORY_SCOPE_AGENT); }
__device__ __forceinline__ unsigned xb_xcc_id() { return (unsigned)__builtin_amdgcn_s_getreg((3 << 11) | 20) & 0xFu; }
#define XB_SPIN(cond, bar) do { unsigned _sp = 0; while (cond) { __builtin_amdgcn_s_sleep(1); \
    if ((++_sp & 255u) == 0u) { if (xb_ld(&(bar)[XB_TMO])) break; if (_sp > XB_SPIN_CAP) { atomicAdd(&(bar)[XB_TMO], 1u); break; } } } } while (0)
struct XcdBarrier { unsigned* bar; unsigned x; volatile LAS unsigned* st; };
__device__ __forceinline__ XcdBarrier xcd_barrier_post(unsigned* bar, volatile LAS unsigned* st) {
    XcdBarrier b; b.bar = bar; b.x = xb_xcc_id(); b.st = st;
    if (threadIdx.x == 0) (void)xb_add(&bar[XB_XCNT(b.x)], 1u);
    return b;
}
__device__ __forceinline__ void xcd_barrier_complete(unsigned* bar, unsigned x, unsigned& nloc, unsigned& nx) {
    const unsigned G = gridDim.x * gridDim.y * gridDim.z;
    unsigned sum, cnt, mine, sp = 0u;
    for (;;) {
        sum = 0u; cnt = 0u; mine = 0u;
#pragma unroll
        for (unsigned j = 0; j < 16; ++j) { const unsigned c = xb_ld(&bar[XB_XCNT(j)]); sum += c; cnt += (c > 0u) ? 1u : 0u; mine = (j == x) ? c : mine; }
        if (sum == G) break;
        __builtin_amdgcn_s_sleep(1);
        if ((++sp & 255u) == 0u) { if (xb_ld(&bar[XB_TMO])) break; if (sp > XB_SPIN_CAP) { atomicAdd(&bar[XB_TMO], 1u); break; } }
    }
    nloc = mine > 0u ? mine : 1u; nx = cnt > 0u ? cnt : 1u;
}
__device__ __forceinline__ void xcd_barrier(const XcdBarrier& b) {
    asm volatile("s_waitcnt vmcnt(0)" ::: "memory");
    __syncthreads();
    if (threadIdx.x == 0) {
        unsigned* bar = b.bar;
        __builtin_amdgcn_s_waitcnt(0);
        unsigned nloc = b.st[0], nx = b.st[1];
        if (nloc == 0u) { xcd_barrier_complete(bar, b.x, nloc, nx); b.st[0] = nloc; b.st[1] = nx; }
        const unsigned old = xb_add(&bar[XB_XSUB(b.x)], 1u);
        const unsigned gen = old / nloc;
        if (old + 1u == (gen + 1u) * nloc) {
            __builtin_amdgcn_fence(__ATOMIC_RELEASE, "agent");
            asm volatile("s_waitcnt vmcnt(0)" ::: "memory");
            const unsigned og = xb_add(&bar[XB_TOP], 1u);
            const unsigned tg = og / nx;
            if (og + 1u == (tg + 1u) * nx) xb_add(&bar[XB_TOPGEN], 1u);
            else XB_SPIN(xb_ld(&bar[XB_TOPGEN]) == tg, bar);
            __builtin_amdgcn_fence(__ATOMIC_ACQUIRE, "agent");
            xb_add(&bar[XB_XGEN(b.x)], 1u);
            asm volatile("s_waitcnt vmcnt(0)" ::: "memory");
        } else {
            XB_SPIN(xb_ld(&bar[XB_XGEN(b.x)]) == gen, bar);
            __builtin_amdgcn_fence(__ATOMIC_ACQUIRE, "agent");
            asm volatile("s_waitcnt vmcnt(0)" ::: "memory");
        }
    }
    __syncthreads();
}

struct Args { const float* in[26]; float* out; unsigned char* ws; int ph_lo, ph_hi; };
struct Frame {
    LAS unsigned char* lds;
    int tid, lane, wave, G, bid;
    const float* const* in; float* out; unsigned char* ws;
};

template <bool F8 = false> __device__ __forceinline__ void tr_item(const float* W, int ldw, bf16* WT, int ldt, float scale, const float* kscale, LAS float* scr, int k0, int lane) {
    f32x4 tv[8];
#pragma unroll
    for (int i = 0; i < 8; ++i) tv[i] = *(const f32x4*)(W + (size_t)(k0 + 8 * i + (lane >> 3)) * ldw + 4 * (lane & 7));
#pragma unroll
    for (int i = 0; i < 8; ++i) { const int kk = 8 * i + (lane >> 3); float sc = scale; if (kscale) sc *= kscale[k0 + kk];
        LAS float* d = scr + kk * 33 + 4 * (lane & 7); d[0] = tv[i][0] * sc; d[1] = tv[i][1] * sc; d[2] = tv[i][2] * sc; d[3] = tv[i][3] * sc; }
    LDS_WAIT(); asm volatile("" ::: "memory");
    const int c = lane & 7;
#pragma unroll
    for (int j = 0; j < 4; ++j) { const int n = (lane >> 3) + 8 * j; const LAS float* s = scr + (8 * c) * 33 + n;
        if constexpr (F8) {
            int p0 = 0, p1 = 0; p0 = __builtin_amdgcn_cvt_pk_fp8_f32(s[0 * 33], s[1 * 33], p0, false); p0 = __builtin_amdgcn_cvt_pk_fp8_f32(s[2 * 33], s[3 * 33], p0, true);
            p1 = __builtin_amdgcn_cvt_pk_fp8_f32(s[4 * 33], s[5 * 33], p1, false); p1 = __builtin_amdgcn_cvt_pk_fp8_f32(s[6 * 33], s[7 * 33], p1, true);
            *(GAS v2u*)((GAS unsigned char*)WT + (size_t)n * ldt + k0 + 8 * c) = (v2u){(unsigned)p0, (unsigned)p1};
        } else {
        v4u o; o.x = pk2(s[0 * 33], s[1 * 33]); o.y = pk2(s[2 * 33], s[3 * 33]); o.z = pk2(s[4 * 33], s[5 * 33]); o.w = pk2(s[6 * 33], s[7 * 33]);
        *(GAS v4u*)(WT + (size_t)n * ldt + k0 + 8 * c) = o; } }
    LDS_WAIT(); asm volatile("" ::: "memory");
}

__device__ __forceinline__ void p0_prologue(Frame& F) {
    LAS float* scr = (LAS float*)(F.lds + F.wave * 16384);
    const int gw = F.bid * NWAVES + F.wave, NGW = F.G * NWAVES;
    unsigned char* ws = F.ws;
    const float* w_in = F.in[2];
    constexpr int I_WIN = 16 * 192, I_QKV = 12 * 32, I_LRU = 32 * 8, I_WB = 2 * 512, I_WO = 512, I_PQ = 16 * 64;
    constexpr int NITEMS = I_WIN + I_QKV + I_LRU + I_WB + I_WO + I_PQ;
    for (int it = gw; it < NITEMS; it += NGW) {
        int r = it;
        if (r < I_WIN) { const int kb = r / 192, nb = r % 192, n0 = nb * 32, sc = n0 < 2048 ? n0 : n0 + 16;
            if (n0 >= 1024) tr_item<true>(w_in + sc, DIN, (bf16*)(ws + WS_WIN8 + (size_t)n0 * 1024), 1024, 1024.f, nullptr, scr, kb * 64, F.lane);
            else tr_item(w_in + sc, DIN, (bf16*)(ws + WS_WIN) + (size_t)n0 * 1024, 1024, 1.f, nullptr, scr, kb * 64, F.lane);
            continue; }
        r -= I_WIN;
        if (r < I_QKV) { const int mat = r / 32, rr = r % 32, kb = rr / 8, nb = rr % 8, g = mat >> 2, h = mat & 3;
            const float* W = F.in[6 + g] + (size_t)h * 65536 + nb * 32;
            tr_item(W, 256, (bf16*)(ws + WS_WQKV) + (size_t)mat * 65536 + (size_t)(nb * 32) * 256, 256, g == 1 ? 0.0625f : 1.f, nullptr, scr, kb * 64, F.lane); continue; }
        r -= I_QKV;
        if (r < I_LRU) { const int mat = r / 8, rr = r % 8, kb = rr / 4, nb = rr % 4, gate = mat & 1, db = mat >> 1;
            const float* W = F.in[gate ? 14 : 12] + (size_t)db * 16384 + nb * 32;
            tr_item(W, 128, (bf16*)(ws + WS_WLRU) + (size_t)mat * 16384 + (size_t)(nb * 32) * 128, 128, 1.f, nullptr, scr, kb * 64, F.lane); continue; }
        r -= I_LRU;
        if (r < I_WB) { const int mat = r / 512, rr = r % 512, kb = rr / 32, nb = rr % 32;
            const float* W = F.in[17 + mat] + nb * 32;
            tr_item(W, 1024, (bf16*)(ws + WS_WB2) + (size_t)(mat * 1024 + nb * 32) * 1024, 1024, 1.f, nullptr, scr, kb * 64, F.lane); continue; }
        r -= I_WB;
        if (r < I_WO) { const int cp = 0, rr = r, kb = rr / 32, nb = rr % 32;
            const float* W = F.in[19] + nb * 32;
            tr_item(W, 1024, (bf16*)(ws + WS_WOUT2) + (size_t)(nb * 32) * 2048 + cp * 1024, 2048, 1.f, nullptr, scr, kb * 64, F.lane); continue; }
        r -= I_WO;
        {
            const int hp = r >> 6, d0 = (r & 63) * 16, fr = F.lane & 15, fq = F.lane >> 4;
            const float* wq = F.in[21] + (size_t)(d0 + fr) * 2048 + hp * 128 + 8 * fq; const float g = F.in[20][d0 + fr];
            bf16x8 af[4];
#pragma unroll
            for (int ks = 0; ks < 4; ++ks) { const f32x4 a = *(const f32x4*)(wq + 32 * ks) * g, b = *(const f32x4*)(wq + 32 * ks + 4) * g;
                v4u o; o.x = pk2(a[0], a[1]); o.y = pk2(a[2], a[3]); o.z = pk2(b[0], b[1]); o.w = pk2(b[2], b[3]); af[ks] = __builtin_bit_cast(bf16x8, o); }
            const float* kp = F.in[22] + (size_t)hp * 16384 + fr * 128 + 8 * fq;
            bf16* wt = (bf16*)(ws + WS_WPQ) + (size_t)(hp * 128 + fr) * 1024 + d0 + 4 * fq;
#pragma unroll 2
            for (int nt = 0; nt < 8; ++nt) { f32x4 acc = (f32x4){0.f, 0.f, 0.f, 0.f};
#pragma unroll
                for (int ks = 0; ks < 4; ++ks) { const f32x4 a = *(const f32x4*)(kp + nt * 2048 + 32 * ks), b = *(const f32x4*)(kp + nt * 2048 + 32 * ks + 4);
                    v4u o; o.x = pk2(a[0], a[1]); o.y = pk2(a[2], a[3]); o.z = pk2(b[0], b[1]); o.w = pk2(b[2], b[3]);
                    acc = __builtin_amdgcn_mfma_f32_16x16x32_bf16(af[ks], __builtin_bit_cast(bf16x8, o), acc, 0, 0, 0); }
                *(v2u*)(wt + (size_t)nt * 16 * 1024) = (v2u){pk2(acc[0], acc[1]), pk2(acc[2], acc[3])}; } }
    }
    __syncthreads();
    for (int i = 0; i < 32; ++i) { const int idx = F.tid + NTHR * i, c = idx & 15, k = idx >> 4; ((LAS unsigned short*)F.lds)[c * 1032 + k] = (unsigned short)f2bf(w_in[(size_t)k * DIN + 2048 + c]); }
    __syncthreads();
    { const int gt = F.bid * NTHR + F.tid, NGT = F.G * NTHR;
      float* ss = (float*)(ws + WS_SS);
      for (int i = gt; i < MTOK; i += NGT) ss[i] = 0.f; }
    const float* x = F.in[0]; const float* g1 = F.in[1];
    bf16* XN = (bf16*)(ws + WS_K);
    unsigned char* XN8 = (unsigned char*)F.out;
    f32x4 gv[4];
#pragma unroll
    for (int j = 0; j < 4; ++j) gv[j] = ((const f32x4*)g1)[F.lane + 64 * j];
    for (int m = 16 * gw; m < MTOK; m += 16 * NGW)
    for (int mm = m; mm < m + 16; mm += 2) {
        const f32x4* xr0 = (const f32x4*)(x + (size_t)mm * DM) + F.lane; const f32x4* xr1 = xr0 + DM / 4;
        f32x4 v0[4], v1[4]; float s0 = 0.f, s1 = 0.f;
#pragma unroll
        for (int j = 0; j < 4; ++j) { v0[j] = xr0[64 * j]; v1[j] = xr1[64 * j]; }
#pragma unroll
        for (int j = 0; j < 4; ++j) { s0 += (v0[j].x * v0[j].x + v0[j].y * v0[j].y) + (v0[j].z * v0[j].z + v0[j].w * v0[j].w); s1 += (v1[j].x * v1[j].x + v1[j].y * v1[j].y) + (v1[j].z * v1[j].z + v1[j].w * v1[j].w); }
        const float r0 = rsqrtf(wave_sum(s0) * (1.f / DM) + EPS), r1 = rsqrtf(wave_sum(s1) * (1.f / DM) + EPS);
        unsigned long long* o0 = (unsigned long long*)(XN + (size_t)mm * DM) + F.lane; unsigned long long* o1 = o0 + DM / 4;
        unsigned* q0 = (unsigned*)(XN8 + (size_t)mm * DM) + F.lane; unsigned* q1 = q0 + DM / 4;
#pragma unroll
        for (int j = 0; j < 4; ++j) { const f32x4 a = v0[j] * r0 * gv[j], c = v1[j] * r1 * gv[j];
            o0[64 * j] = (unsigned long long)pk2(a.x, a.y) | ((unsigned long long)pk2(a.z, a.w) << 32);
            o1[64 * j] = (unsigned long long)pk2(c.x, c.y) | ((unsigned long long)pk2(c.z, c.w) << 32);
            int pa = 0, pc = 0; pa = __builtin_amdgcn_cvt_pk_fp8_f32(a.x, a.y, pa, false); pa = __builtin_amdgcn_cvt_pk_fp8_f32(a.z, a.w, pa, true);
            pc = __builtin_amdgcn_cvt_pk_fp8_f32(c.x, c.y, pc, false); pc = __builtin_amdgcn_cvt_pk_fp8_f32(c.z, c.w, pc, true);
            q0[64 * j] = (unsigned)pa; q1[64 * j] = (unsigned)pc; }
    }
    VM_WAIT();
    { const int lane = F.lane, fr = lane & 15, fq = lane >> 4; float* GT = (float*)(ws + WS_GATE);
      const f32x4 bg4 = *(const f32x4*)(F.in[3] + 4 * fq);
      for (int m0 = 16 * gw; m0 < MTOK; m0 += 16 * NGW) {
          f32x4 acc = (f32x4){0.f, 0.f, 0.f, 0.f};
#pragma unroll 8
          for (int ks = 0; ks < 32; ++ks) {
              const bf16x8 wfr = *(const LAS bf16x8*)(F.lds + fr * 2064 + (32 * ks + 8 * fq) * 2);
              const bf16x8 xfr = *(const bf16x8*)(XN + (size_t)(m0 + fr) * DM + 32 * ks + 8 * fq);
              acc = __builtin_amdgcn_mfma_f32_16x16x32_bf16(wfr, xfr, acc, 0, 0, 0);
          }
          *(f32x4*)(GT + (size_t)(m0 + fr) * 16 + 4 * fq) = acc + bg4;
      } }
}
__device__ __forceinline__ void gates_phase(Frame& F) {
    const bf16* XN = (const bf16*)(F.ws + WS_K); const bf16* WGT = (const bf16*)(F.ws + WS_WGT); float* GT = (float*)(F.ws + WS_GATE);
    const int lane = F.lane, fr = lane & 15, fq = lane >> 4;
    const f32x4 bg4 = *(const f32x4*)(F.in[3] + 4 * fq);
    for (int task = F.bid * NWAVES + F.wave; task < MTOK / 16; task += F.G * NWAVES) {
        const size_t m0 = (size_t)task * 16;
        f32x4 acc = (f32x4){0.f, 0.f, 0.f, 0.f};
#pragma unroll 8
        for (int ks = 0; ks < 32; ++ks) {
            const bf16x8 wfr = *(const bf16x8*)(WGT + fr * 1024 + 32 * ks + 8 * fq);
            const bf16x8 xfr = *(const bf16x8*)(XN + (m0 + fr) * DM + 32 * ks + 8 * fq);
            acc = __builtin_amdgcn_mfma_f32_16x16x32_bf16(wfr, xfr, acc, 0, 0, 0);
        }
        *(f32x4*)(GT + (m0 + fr) * 16 + 4 * fq) = acc + bg4;
    }
}

struct AddrPlain {
    const char* A; const char* Bt; int lda, ldb, K;
    __device__ __forceinline__ const char* a(const pg8::Unit& u) const { return A + (size_t)u.pm * 256 * lda * 2; }
    __device__ __forceinline__ const char* b(const pg8::Unit& u) const { return Bt + (size_t)u.pn * 256 * ldb * 2; }
};
struct AddrP1 {
    const char* A; const char* Bt; int lda, ldb, K, thr, lo_add, hi_add;
    __device__ __forceinline__ const char* a(const pg8::Unit& u) const { return A + (size_t)u.pm * 256 * lda * 2; }
    __device__ __forceinline__ const char* b(const pg8::Unit& u) const { return Bt + (size_t)(u.pn + (u.pn < thr ? lo_add : hi_add)) * 256 * ldb * 2; }
};
struct AddrQKV {
    const char* XC; long dXM; const char* W; int lda, ldb, K;
    __device__ __forceinline__ const char* a(const pg8::Unit& u) const { return XC + (u.pn < 8 ? 0l : dXM) + ((size_t)u.pm * 256 * 1024 + (u.pn & 3) * 256) * 2; }
    __device__ __forceinline__ const char* b(const pg8::Unit& u) const { return W + (size_t)u.pn * 65536 * 2; }
};
struct AddrBranch {
    const char* YM; long dYL; const char* W; int lda, ldb, K;
    __device__ __forceinline__ const char* a(const pg8::Unit& u) const { return YM + (u.pn < 4 ? 0l : dYL) + (size_t)u.pm * 256 * 1024 * 2; }
    __device__ __forceinline__ const char* b(const pg8::Unit& u) const { return W + (size_t)u.pn * 256 * 1024 * 2; }
};

struct DstP1 { unsigned char* ws; int thr, lo_add, hi_add;
    __device__ __forceinline__ bf16* get(int j, int& ld, int& col0) const {
        const int pn = j + (j < thr ? lo_add : hi_add); const bool mg = pn >= 16; ld = mg ? -2048 : 1024; col0 = mg ? (pn - 16) * 256 : (pn & 3) * 256;
        return (bf16*)(ws + (mg ? WS_MG : WS_XM + (size_t)(pn >> 2) * 64 * MiB)); } };
struct DstQKV { char* q; long dk, dv;
    __device__ __forceinline__ bf16* get(int pn, int& ld, int& col0) const { ld = 1024; col0 = (pn & 3) * 256; return (bf16*)(q + (pn >= 4 ? (pn >= 8 ? dv : dk) : 0l)); } };
template <class Dst, bool MUL = false> struct EpiBf16 {
    static constexpr bool PERM = true;
    Dst dst; float mul;
    __device__ __forceinline__ void operator()(const f32x4 (&acc)[2][2][4][2], const pg8::Unit& u, int wr, int wc, int fr, int fq) const {
        int ld, colt; bf16* base = dst.get(u.pn, ld, colt);
        const int row0 = u.pm * 256 + wr * 64 + fr, col0 = colt + wc * 32 + 8 * fq;
        if (MUL && ld < 0) {
#pragma unroll
            for (int ai = 0; ai < 2; ++ai)
#pragma unroll
                for (int m = 0; m < 4; ++m) { unsigned char* rowp = (unsigned char*)base + (size_t)(row0 + ai * 128 + m * 16) * (-ld) + col0;
#pragma unroll
                    for (int bj = 0; bj < 2; ++bj) { const f32x4 v0 = acc[ai][bj][m][0] * mul, v1 = acc[ai][bj][m][1] * mul;
                        int p0 = 0, p1 = 0; p0 = __builtin_amdgcn_cvt_pk_fp8_f32(v0[0], v0[1], p0, false); p0 = __builtin_amdgcn_cvt_pk_fp8_f32(v0[2], v0[3], p0, true);
                        p1 = __builtin_amdgcn_cvt_pk_fp8_f32(v1[0], v1[1], p1, false); p1 = __builtin_amdgcn_cvt_pk_fp8_f32(v1[2], v1[3], p1, true);
                        *(v2u*)(rowp + bj * 128) = (v2u){(unsigned)p0, (unsigned)p1}; } }
            return;
        }
#pragma unroll
        for (int ai = 0; ai < 2; ++ai)
#pragma unroll
            for (int m = 0; m < 4; ++m) { bf16* rowp = base + (size_t)(row0 + ai * 128 + m * 16) * ld + col0;
#pragma unroll
                for (int bj = 0; bj < 2; ++bj) { f32x4 v0 = acc[ai][bj][m][0], v1 = acc[ai][bj][m][1]; if (MUL) { v0 = v0 * mul; v1 = v1 * mul; }
                    v4u w; w.x = pg8::cvt_pk_bf16(v0[0], v0[1]); w.y = pg8::cvt_pk_bf16(v0[2], v0[3]); w.z = pg8::cvt_pk_bf16(v1[0], v1[1]); w.w = pg8::cvt_pk_bf16(v1[2], v1[3]);
                    *(v4u*)(rowp + bj * 128) = w; } }
    }
};
template <bool ADD> struct EpiMerge {
    static constexpr bool PERM = true;
    bf16* MRG; const unsigned char* MG; int gcol;
    __device__ __forceinline__ void operator()(const f32x4 (&acc)[2][2][4][2], const pg8::Unit& u, int wr, int wc, int fr, int fq) const {
        const int row0 = u.pm * 256 + wr * 64 + fr, col0 = u.pn * 256 + wc * 32 + 8 * fq;
#pragma unroll
        for (int ai = 0; ai < 2; ++ai)
#pragma unroll
            for (int m = 0; m < 4; ++m) { const size_t row = (size_t)(row0 + ai * 128 + m * 16); bf16* rowp = MRG + row * 1024 + col0; const unsigned char* gp = MG + row * 2048 + gcol + col0;
#pragma unroll
                for (int bj = 0; bj < 2; ++bj) { const f32x4 v0 = acc[ai][bj][m][0], v1 = acc[ai][bj][m][1];
                    const v2u g = *(const v2u*)(gp + bj * 128);
                    const f32x2 g0 = __builtin_amdgcn_cvt_pk_f32_fp8((int)g.x, false), g1 = __builtin_amdgcn_cvt_pk_f32_fp8((int)g.x, true), g2 = __builtin_amdgcn_cvt_pk_f32_fp8((int)g.y, false), g3 = __builtin_amdgcn_cvt_pk_f32_fp8((int)g.y, true);
                    float o[8] = {v0[0] * sigmoidf_(g0[0]), v0[1] * sigmoidf_(g0[1]), v0[2] * sigmoidf_(g1[0]), v0[3] * sigmoidf_(g1[1]),
                                  v1[0] * sigmoidf_(g2[0]), v1[1] * sigmoidf_(g2[1]), v1[2] * sigmoidf_(g3[0]), v1[3] * sigmoidf_(g3[1])};
                    if (ADD) { const v4u t = *(const v4u*)(rowp + bj * 128);
                        o[0] += bflo(t.x); o[1] += bfhi(t.x); o[2] += bflo(t.y); o[3] += bfhi(t.y); o[4] += bflo(t.z); o[5] += bfhi(t.z); o[6] += bflo(t.w); o[7] += bfhi(t.w); }
                    v4u w; w.x = pg8::cvt_pk_bf16(o[0], o[1]); w.y = pg8::cvt_pk_bf16(o[2], o[3]); w.z = pg8::cvt_pk_bf16(o[4], o[5]); w.w = pg8::cvt_pk_bf16(o[6], o[7]);
                    *(v4u*)(rowp + bj * 128) = w; } }
    }
};
struct EpiMerge2 {
    static constexpr bool PERM = true;
    bf16* MRG; const unsigned char* MG;
    static __device__ __forceinline__ void dec8(const v2u g, float (&x)[8]) {
        const f32x2 g0 = __builtin_amdgcn_cvt_pk_f32_fp8((int)g.x, false), g1 = __builtin_amdgcn_cvt_pk_f32_fp8((int)g.x, true), g2 = __builtin_amdgcn_cvt_pk_f32_fp8((int)g.y, false), g3 = __builtin_amdgcn_cvt_pk_f32_fp8((int)g.y, true);
        x[0] = g0[0]; x[1] = g0[1]; x[2] = g1[0]; x[3] = g1[1]; x[4] = g2[0]; x[5] = g2[1]; x[6] = g3[0]; x[7] = g3[1]; }
    __device__ __forceinline__ void mid(f32x4 (&acc)[2][2][4][2], const pg8::Unit& u, int wr, int wc, int fr, int fq) const {
        const int row0 = u.pm * 256 + wr * 64 + fr, col0 = u.pn * 256 + wc * 32 + 8 * fq;
#pragma unroll
        for (int ai = 0; ai < 2; ++ai)
#pragma unroll
            for (int m = 0; m < 4; ++m) { const size_t row = (size_t)(row0 + ai * 128 + m * 16); const unsigned char* gp = MG + row * 2048 + col0;
#pragma unroll
                for (int bj = 0; bj < 2; ++bj) { float x1[8], x2[8]; dec8(*(const v2u*)(gp + bj * 128), x1); dec8(*(const v2u*)(gp + 1024 + bj * 128), x2);
                    float rt[8];
#pragma unroll
                    for (int e = 0; e < 8; ++e) rt[e] = (1.f + __builtin_amdgcn_exp2f(fminf(x2[e] * -1.44269504089f, 96.f))) * __builtin_amdgcn_rcpf(1.f + __builtin_amdgcn_exp2f(x1[e] * -1.44269504089f));
                    acc[ai][bj][m][0] = acc[ai][bj][m][0] * (f32x4){rt[0], rt[1], rt[2], rt[3]}; acc[ai][bj][m][1] = acc[ai][bj][m][1] * (f32x4){rt[4], rt[5], rt[6], rt[7]}; } }
    }
    __device__ __forceinline__ void operator()(const f32x4 (&acc)[2][2][4][2], const pg8::Unit& u, int wr, int wc, int fr, int fq) const {
        const int row0 = u.pm * 256 + wr * 64 + fr, col0 = (u.pn - 4) * 256 + wc * 32 + 8 * fq;
#pragma unroll
        for (int ai = 0; ai < 2; ++ai)
#pragma unroll
            for (int m = 0; m < 4; ++m) { const size_t row = (size_t)(row0 + ai * 128 + m * 16); bf16* rowp = MRG + row * 1024 + col0; const unsigned char* gp = MG + row * 2048 + 1024 + col0;
#pragma unroll
                for (int bj = 0; bj < 2; ++bj) { const f32x4 v0 = acc[ai][bj][m][0], v1 = acc[ai][bj][m][1];
                    float x2[8]; dec8(*(const v2u*)(gp + bj * 128), x2);
                    const float o[8] = {v0[0] * sigmoidf_(x2[0]), v0[1] * sigmoidf_(x2[1]), v0[2] * sigmoidf_(x2[2]), v0[3] * sigmoidf_(x2[3]), v1[0] * sigmoidf_(x2[4]), v1[1] * sigmoidf_(x2[5]), v1[2] * sigmoidf_(x2[6]), v1[3] * sigmoidf_(x2[7])};
                    v4u w; w.x = pg8::cvt_pk_bf16(o[0], o[1]); w.y = pg8::cvt_pk_bf16(o[2], o[3]); w.z = pg8::cvt_pk_bf16(o[4], o[5]); w.w = pg8::cvt_pk_bf16(o[6], o[7]);
                    *(v4u*)(rowp + bj * 128) = w; } }
    }
};
struct EpiResid {
    static constexpr bool PERM = true;
    const float* x; float* x1; bf16* x1b; float* ss;
    __device__ __forceinline__ void operator()(const f32x4 (&acc)[2][2][4][2], const pg8::Unit& u, int wr, int wc, int fr, int fq) const {
        const int row0 = u.pm * 256 + wr * 64 + fr, col0 = u.pn * 256 + wc * 32 + 8 * fq;
#pragma unroll
        for (int ai = 0; ai < 2; ++ai)
#pragma unroll
            for (int m = 0; m < 4; ++m) { const int row = row0 + ai * 128 + m * 16; const size_t off = (size_t)row * DM + col0; float s = 0.f;
#pragma unroll
                for (int bj = 0; bj < 2; ++bj) { const size_t o = off + bj * 128;
                    const f32x4 v0 = *(const f32x4*)(x + o) + acc[ai][bj][m][0], v1 = *(const f32x4*)(x + o + 4) + acc[ai][bj][m][1];
                    v4u w; w.x = pg8::cvt_pk_bf16(v0[0], v0[1]); w.y = pg8::cvt_pk_bf16(v0[2], v0[3]); w.z = pg8::cvt_pk_bf16(v1[0], v1[1]); w.w = pg8::cvt_pk_bf16(v1[2], v1[3]);
                    *(v4u*)(x1b + o) = w;
                    s += ((v0[0] * v0[0] + v0[1] * v0[1]) + (v0[2] * v0[2] + v0[3] * v0[3])) + ((v1[0] * v1[0] + v1[1] * v1[1]) + (v1[2] * v1[2] + v1[3] * v1[3])); }
                s += __shfl_xor(s, 16); s += __shfl_xor(s, 32);
                if (fq == 0) atomicAdd(ss + row, s); }
    }
};
struct EpiPQ {
    static constexpr bool PERM = true;
    bf16* pq; const float* ss;
    __device__ __forceinline__ void operator()(const f32x4 (&acc)[2][2][4][2], const pg8::Unit& u, int wr, int wc, int fr, int fq) const {
        const int row0 = u.pm * 256 + wr * 64 + fr, col0 = u.pn * 256 + wc * 32 + 8 * fq;
#pragma unroll
        for (int ai = 0; ai < 2; ++ai)
#pragma unroll
            for (int m = 0; m < 4; ++m) { const int row = row0 + ai * 128 + m * 16; bf16* rowp = pq + (size_t)row * 2048 + col0;
                const float r = rsqrtf(ss[row] * (1.f / DM) + EPS);
#pragma unroll
                for (int bj = 0; bj < 2; ++bj) { const f32x4 v0 = acc[ai][bj][m][0] * r, v1 = acc[ai][bj][m][1] * r;
                    v4u w; w.x = pg8::cvt_pk_bf16(v0[0], v0[1]); w.y = pg8::cvt_pk_bf16(v0[2], v0[3]); w.z = pg8::cvt_pk_bf16(v1[0], v1[1]); w.w = pg8::cvt_pk_bf16(v1[2], v1[3]);
                    *(v4u*)(rowp + bj * 128) = w; } }
    }
};

template <bool PB> __device__ __forceinline__ void lru_phase(Frame& F) {
    const bf16* XL = (const bf16*)(F.ws + WS_XL); const bf16* LG = (const bf16*)(F.ws + WS_LG); bf16* YL = (bf16*)F.out;
    f32x2* AGG = (f32x2*)(F.ws + WS_AGG);
    const bf16* WL = (const bf16*)(F.ws + WS_WLRU);
    const float* cw = F.in[10]; const float* cb = F.in[11];
    unsigned char* LA0 = F.ws + WS_K; unsigned char* LA1 = LA0 + (size_t)MTOK * DM; bf16* LU0 = (bf16*)F.out; bf16* LU1 = LU0 + (size_t)MTOK * DM;
    v2u ra[2]; v4u ru[2];
    constexpr int O_XCB = 0, O_XCF = 17408, O_A = 51200, O_U = 84992, FST = 528;
    LAS unsigned char* L = F.lds;
    const int tid = F.tid, lane = F.lane, w = F.wave, fr = lane & 15, fq = lane >> 4;
    int cur_blk = -1;
    bf16x8 wf[2][2][4];
    f32x4 br4[2], bi4[2], sp4[2];
    v4u rawreg[3];
#define RAW_LOAD(bb, tt0, bk) do { _Pragma("unroll") for (int r_ = 0; r_ < 3; ++r_) { const int e_ = tid + NTHR * r_, row_ = e_ >> 4, c16_ = e_ & 15, t_ = (tt0) - 2 + row_; \
            v4u v_ = {0u, 0u, 0u, 0u}; if (e_ < 68 * 16 && t_ >= 0 && t_ < SEQ) v_ = *(const v4u*)(XL + ((size_t)(bb) * SEQ + t_) * DM + (bk) * 128 + c16_ * 8); rawreg[r_] = v_; } } while (0)
#define PB_LOAD(ii, dd) do { const int idx_ = (ii) * F.G + F.bid; if (idx_ < 4096) { const int j_ = idx_ >> 3; const size_t mr_ = (size_t)(j_ >> 6) * SEQ + (j_ & 63) * 64; \
            _Pragma("unroll") for (int r_ = 0; r_ < 2; ++r_) { const int e_ = tid + NTHR * r_; const size_t o_ = (mr_ + (e_ >> 4)) * DM + (idx_ & 7) * 128 + (e_ & 15) * 8; \
                ra[r_] = *(const v2u*)(((dd) ? LA1 : LA0) + o_); ru[r_] = *(const v4u*)(((dd) ? LU1 : LU0) + o_); } } } while (0)
    constexpr int O_CARRY = 118784, O_CW = 135168, O_SUB = 137728;
    const bool carry_tab = PB && (F.G == 256);
    if (carry_tab) {
        const int ch = tid & 127, bq = tid >> 7, s0 = F.bid >> 3, blk0 = F.bid & 7;
        LAS float* CT = (LAS float*)(L + O_CARRY);
#define FOLD(agp, j0, j1, stp, hv) do { int js_ = (j0); const int n_ = ((j1) - (j0)) * (stp); int k_ = 0; \
            for (; k_ + 8 <= n_; k_ += 8) { f32x2 ah_[8]; _Pragma("unroll") for (int q_ = 0; q_ < 8; ++q_) ah_[q_] = (agp)[(size_t)(js_ + q_ * (stp)) * 2 * DM]; \
                _Pragma("unroll") for (int q_ = 0; q_ < 8; ++q_) hv = ah_[q_][0] * hv + ah_[q_][1]; js_ += 8 * (stp); } \
            for (; k_ < n_; ++k_) { const f32x2 a1_ = (agp)[(size_t)js_ * 2 * DM]; hv = a1_[0] * hv + a1_[1]; js_ += (stp); } } while (0)
        for (int bb = 2 * bq; bb < 2 * bq + 2; ++bb) {
            const f32x2* ag0 = AGG + ((size_t)(bb * 64) * 2 + 0) * DM + blk0 * 128 + ch; const f32x2* ag1 = AGG + ((size_t)(bb * 64) * 2 + 1) * DM + blk0 * 128 + ch;
            float h = 0.f;
            FOLD(ag0, 0, s0, 1, h); CT[((bb * 2 + 0) * 2 + 0) * 128 + ch] = h;
            FOLD(ag0, s0, s0 + 32, 1, h); CT[((bb * 2 + 1) * 2 + 0) * 128 + ch] = h;
            h = 0.f;
            FOLD(ag1, 63, s0 + 32, -1, h); CT[((bb * 2 + 1) * 2 + 1) * 128 + ch] = h;
            FOLD(ag1, s0 + 32, s0, -1, h); CT[((bb * 2 + 0) * 2 + 1) * 128 + ch] = h;
        }
        __syncthreads();
#undef FOLD
    }
    for (int i = 0;; ++i) {
        const int idx = i * F.G + F.bid; if (idx >= 4096) break;
        const int blk = idx & 7, j = idx >> 3, b = j >> 6, seg = j & 63, t0 = seg * 64;
        const size_t mrow0 = (size_t)b * SEQ + t0;
        if (!PB && blk != cur_blk) {
            cur_blk = blk;
#pragma unroll
            for (int d = 0; d < 2; ++d) {
#pragma unroll
                for (int g = 0; g < 2; ++g)
#pragma unroll
                    for (int ks = 0; ks < 4; ++ks)
                        wf[d][g][ks] = *(const bf16x8*)(WL + ((size_t)((d * 8 + blk) * 2 + g) * 128 + 16 * w + fr) * 128 + 32 * ks + 8 * fq);
                const int ch = blk * 128 + 16 * w + 4 * fq;
                br4[d] = *(const f32x4*)(F.in[13] + d * DM + ch); bi4[d] = *(const f32x4*)(F.in[15] + d * DM + ch);
                const f32x4 lm = *(const f32x4*)(F.in[16] + d * DM + ch);
#pragma unroll
                for (int e = 0; e < 4; ++e) sp4[d][e] = -8.f * 1.44269504089f * softplusf_(-lm[e]);
            }
            __syncthreads();
            for (int e = tid; e < 5 * 128; e += NTHR) { const int jt = e >> 7, cc = e & 127; ((LAS float*)(L + O_CW))[e] = (jt < 4) ? cw[jt * DM + blk * 128 + cc] : cb[blk * 128 + cc]; }
        }
        v4u lgreg[2];
        if (PB) {
            if (i == 0) PB_LOAD(0, 0);
#pragma unroll
            for (int r = 0; r < 2; ++r) { const int e = tid + NTHR * r; lgreg[r] = *(const v4u*)(LG + (mrow0 + (e >> 4)) * DM + blk * 128 + (e & 15) * 8); }
        } else {
        if (i == 0) RAW_LOAD(b, t0, blk);
#pragma unroll
        for (int r = 0; r < 3; ++r) { const int e = tid + NTHR * r; if (e < 68 * 16) *(LAS v4u*)(L + O_A + (e >> 4) * 256 + (e & 15) * 16) = rawreg[r]; }
        __syncthreads();
        { const int idx2 = (i + 1) * F.G + F.bid; if (idx2 < 4096) { const int j2 = idx2 >> 3; RAW_LOAD(j2 >> 6, (j2 & 63) * 64, idx2 & 7); } }
        for (int e = tid; e < 64 * 16; e += NTHR) { const int tl = e >> 4, c16 = e & 15;
            float y[8];
            { const f32x4 a = *(const LAS f32x4*)(L + O_CW + 4 * 512 + c16 * 32), bq = *(const LAS f32x4*)(L + O_CW + 4 * 512 + c16 * 32 + 16); y[0] = a[0]; y[1] = a[1]; y[2] = a[2]; y[3] = a[3]; y[4] = bq[0]; y[5] = bq[1]; y[6] = bq[2]; y[7] = bq[3]; }
#pragma unroll
            for (int jt = 0; jt < 4; ++jt) { const v4u r = *(const LAS v4u*)(L + O_A + (tl + jt) * 256 + c16 * 16);
                const f32x4 wa = *(const LAS f32x4*)(L + O_CW + jt * 512 + c16 * 32), wb = *(const LAS f32x4*)(L + O_CW + jt * 512 + c16 * 32 + 16);
                y[0] += wa[0] * bflo(r.x); y[1] += wa[1] * bfhi(r.x); y[2] += wa[2] * bflo(r.y); y[3] += wa[3] * bfhi(r.y);
                y[4] += wb[0] * bflo(r.z); y[5] += wb[1] * bfhi(r.z); y[6] += wb[2] * bflo(r.w); y[7] += wb[3] * bfhi(r.w); }
            *(LAS f32x4*)(L + O_XCF + tl * FST + c16 * 32) = (f32x4){y[0], y[1], y[2], y[3]};
            *(LAS f32x4*)(L + O_XCF + tl * FST + c16 * 32 + 16) = (f32x4){y[4], y[5], y[6], y[7]};
            v4u o; o.x = pk2(y[0], y[1]); o.y = pk2(y[2], y[3]); o.z = pk2(y[4], y[5]); o.w = pk2(y[6], y[7]);
            *(LAS v4u*)(L + O_XCB + tl * 272 + c16 * 16) = o; }
        __syncthreads();
        }
        float carry0 = 0.f, carry1 = 0.f;
        if (carry_tab) { const LAS float* CT = (const LAS float*)(L + O_CARRY); carry0 = CT[((b * 2 + (seg >> 5)) * 2 + 0) * 128 + (tid & 127)]; carry1 = CT[((b * 2 + (seg >> 5)) * 2 + 1) * 128 + (tid & 127)]; }
        else if (PB) {
            const int ch = blk * 128 + (tid & 127);
            float h = 0.f;
            const f32x2* ag0 = AGG + ((size_t)(b * 64) * 2 + 0) * DM + ch; const f32x2* ag1 = AGG + ((size_t)(b * 64) * 2 + 1) * DM + ch;
            int js = 0;
            for (; js + 8 <= seg; js += 8) { f32x2 ah[8];
#pragma unroll
                for (int q = 0; q < 8; ++q) ah[q] = ag0[(size_t)(js + q) * 2 * DM];
#pragma unroll
                for (int q = 0; q < 8; ++q) h = ah[q][0] * h + ah[q][1]; }
            for (; js < seg; ++js) { const f32x2 ah = ag0[(size_t)js * 2 * DM]; h = ah[0] * h + ah[1]; }
            carry0 = h; h = 0.f;
            js = 63;
            for (; js - 8 >= seg; js -= 8) { f32x2 ah[8];
#pragma unroll
                for (int q = 0; q < 8; ++q) ah[q] = ag1[(size_t)(js - q) * 2 * DM];
#pragma unroll
                for (int q = 0; q < 8; ++q) h = ah[q][0] * h + ah[q][1]; }
            for (; js > seg; --js) { const f32x2 ah = ag1[(size_t)js * 2 * DM]; h = ah[0] * h + ah[1]; }
            carry1 = h;
        }
#pragma unroll
        for (int d = 0; d < 2; ++d) {
            const int o_a = (d == 0) ? O_A : O_XCF;
            if (PB) {
#pragma unroll
                for (int r = 0; r < 2; ++r) { const int e = tid + NTHR * r, row = e >> 4, c16 = e & 15;
                    const f32x2 x0 = __builtin_amdgcn_cvt_pk_f32_fp8((int)ra[r].x, false), x1 = __builtin_amdgcn_cvt_pk_f32_fp8((int)ra[r].x, true);
                    const f32x2 x2 = __builtin_amdgcn_cvt_pk_f32_fp8((int)ra[r].y, false), x3 = __builtin_amdgcn_cvt_pk_f32_fp8((int)ra[r].y, true);
                    constexpr float IS = 1.f / 4096.f;
                    *(LAS f32x4*)(L + o_a + row * FST + c16 * 32) = (f32x4){1.f - x0[0] * IS, 1.f - x0[1] * IS, 1.f - x1[0] * IS, 1.f - x1[1] * IS};
                    *(LAS f32x4*)(L + o_a + row * FST + c16 * 32 + 16) = (f32x4){1.f - x2[0] * IS, 1.f - x2[1] * IS, 1.f - x3[0] * IS, 1.f - x3[1] * IS};
                    *(LAS f32x4*)(L + O_U + row * FST + c16 * 32) = (f32x4){bflo(ru[r].x), bfhi(ru[r].x), bflo(ru[r].y), bfhi(ru[r].y)};
                    *(LAS f32x4*)(L + O_U + row * FST + c16 * 32 + 16) = (f32x4){bflo(ru[r].z), bfhi(ru[r].z), bflo(ru[r].w), bfhi(ru[r].w)}; }
                if (d == 0) PB_LOAD(i, 1); else PB_LOAD(i + 1, 0);
            } else {
            f32x4 aR[4], aI[4];
#pragma unroll
            for (int mt = 0; mt < 4; ++mt) { aR[mt] = (f32x4){0.f, 0.f, 0.f, 0.f}; aI[mt] = (f32x4){0.f, 0.f, 0.f, 0.f}; }
#pragma unroll
            for (int ks = 0; ks < 4; ++ks)
#pragma unroll
                for (int mt = 0; mt < 4; ++mt) { const bf16x8 xb = *(const LAS bf16x8*)(L + O_XCB + (16 * mt + fr) * 272 + (32 * ks + 8 * fq) * 2);
                    aR[mt] = __builtin_amdgcn_mfma_f32_16x16x32_bf16(wf[d][0][ks], xb, aR[mt], 0, 0, 0);
                    aI[mt] = __builtin_amdgcn_mfma_f32_16x16x32_bf16(wf[d][1][ks], xb, aI[mt], 0, 0, 0); }
#pragma unroll
            for (int mt = 0; mt < 4; ++mt) { const int tl = 16 * mt + fr, cl = 16 * w + 4 * fq;
                const f32x4 xc = *(const LAS f32x4*)(L + O_XCF + tl * FST + cl * 4);
                f32x4 av, uv;
#pragma unroll
                for (int e = 0; e < 4; ++e) { const float r = sigmoidf_(aR[mt][e] + br4[d][e]), ig = sigmoidf_(aI[mt][e] + bi4[d][e]);
                    const float a_ = __builtin_amdgcn_exp2f(r * sp4[d][e]); av[e] = a_; uv[e] = __builtin_amdgcn_sqrtf(fmaxf(1.f - a_ * a_, 0.f)) * (ig * xc[e]); }
                *(LAS f32x4*)(L + o_a + tl * FST + cl * 4) = av; *(LAS f32x4*)(L + O_U + tl * FST + cl * 4) = uv;
                { const size_t go = (mrow0 + tl) * DM + blk * 128 + cl;
                  int xa = 0; xa = __builtin_amdgcn_cvt_pk_fp8_f32((1.f - av[0]) * 4096.f, (1.f - av[1]) * 4096.f, xa, false); xa = __builtin_amdgcn_cvt_pk_fp8_f32((1.f - av[2]) * 4096.f, (1.f - av[3]) * 4096.f, xa, true);
                  v2u xu; xu.x = pk2(uv[0], uv[1]); xu.y = pk2(uv[2], uv[3]);
                  *(unsigned*)((d ? LA1 : LA0) + go) = (unsigned)xa; *(v2u*)((d ? LU1 : LU0) + go) = xu; } }
            }
            __syncthreads();
            {
                const int c = tid & 127, sub = tid >> 7;
                LAS float* pa = (LAS float*)(L + o_a) + c; const LAS float* pu = (const LAS float*)(L + O_U) + c;
                LAS f32x2* SUBT = (LAS f32x2*)(L + O_SUB);
                float h = 0.f, A = 1.f;
#pragma unroll
                for (int s2 = 0; s2 < 16; ++s2) { const int tl = d ? (16 * sub + 15 - s2) : (16 * sub + s2); const float a = pa[tl * 132], u = pu[tl * 132]; h = a * h + u; A *= a; }
                SUBT[sub * 128 + c] = (f32x2){A, h};
                __syncthreads();
                if (!PB) {
                    if (sub == 0) { float HH = 0.f, AA = 1.f;
#pragma unroll
                        for (int q = 0; q < 4; ++q) { const f32x2 ah = SUBT[(d ? 3 - q : q) * 128 + c]; HH = ah[0] * HH + ah[1]; AA *= ah[0]; }
                        AGG[((size_t)(b * 64 + seg) * 2 + d) * DM + blk * 128 + c] = (f32x2){AA, HH}; }
                } else {
                    float hc = d ? carry1 : carry0;
#pragma unroll
                    for (int q = 0; q < 3; ++q) { const int jq = d ? 3 - q : q; const f32x2 ah = SUBT[jq * 128 + c]; if (d ? (jq > sub) : (jq < sub)) hc = ah[0] * hc + ah[1]; }
                    if (d == 0) {
#pragma unroll
                        for (int s2 = 0; s2 < 16; ++s2) { const int tl = 16 * sub + s2; hc = pa[tl * 132] * hc + pu[tl * 132]; pa[tl * 132] = hc; }
                    } else { LAS float* ph = (LAS float*)(L + O_A) + c;
#pragma unroll
                        for (int s2 = 0; s2 < 16; ++s2) { const int tl = 16 * sub + 15 - s2; hc = pa[tl * 132] * hc + pu[tl * 132]; ph[tl * 132] += hc; } }
                }
            }
            __syncthreads();
        }
        if (PB) {
#pragma unroll
            for (int r = 0; r < 2; ++r) { const int e = tid + NTHR * r, row = e >> 4, c16 = e & 15;
                const v4u g = lgreg[r];
                const f32x4 h0 = *(const LAS f32x4*)(L + O_A + row * FST + c16 * 32), h1 = *(const LAS f32x4*)(L + O_A + row * FST + c16 * 32 + 16);
                v4u o;
                o.x = pk2(h0[0] * gelu_fast(bflo(g.x)), h0[1] * gelu_fast(bfhi(g.x))); o.y = pk2(h0[2] * gelu_fast(bflo(g.y)), h0[3] * gelu_fast(bfhi(g.y)));
                o.z = pk2(h1[0] * gelu_fast(bflo(g.z)), h1[1] * gelu_fast(bfhi(g.z))); o.w = pk2(h1[2] * gelu_fast(bflo(g.w)), h1[3] * gelu_fast(bfhi(g.w)));
                *(v4u*)(YL + (mrow0 + row) * DM + blk * 128 + c16 * 8) = o; }
            __syncthreads();
        }
    }
#undef RAW_LOAD
#undef PB_LOAD
}

__device__ __forceinline__ void qkv_phase(Frame& F) {
    const bf16* W = (const bf16*)(F.ws + WS_WQKV);
    const bf16* XC = (const bf16*)(F.ws + WS_XL); const bf16* XM = (const bf16*)(F.ws + WS_XM);
    bf16* Qd = (bf16*)(F.ws + WS_LG); bf16* Kd = (bf16*)(F.ws + WS_K); bf16* Vd = (bf16*)F.out + (size_t)MTOK * DM;
    LAS unsigned char* L = F.lds;
    const int tid = F.tid, lane = F.lane, w = F.wave, fr = lane & 15, fq = lane >> 4;
    const int per = (1536 + F.G - 1) / F.G, u0 = F.bid * per, u1 = (u0 + per < 1536) ? u0 + per : 1536;
    if (u0 >= u1) return;
    bf16x8 af[8][2], naf[8][2];
#define QKV_LOADA(dst, uu) do { const int gh_ = (uu) >> 7, pm_ = (uu) & 127; const bf16* src_ = ((gh_ >> 2) < 2 ? XC : XM) + (size_t)(pm_ * 256 + 32 * w + fr) * DM + (gh_ & 3) * 256 + 8 * fq; \
        _Pragma("unroll") for (int ks_ = 0; ks_ < 8; ++ks_) _Pragma("unroll") for (int m_ = 0; m_ < 2; ++m_) dst[ks_][m_] = *(const bf16x8*)(src_ + (size_t)(16 * m_) * DM + 32 * ks_); } while (0)
    QKV_LOADA(naf, u0);
    int cur_gh = -1;
#pragma unroll 1
    for (int u = u0; u < u1; ++u) {
        const int gh = u >> 7, pm = u & 127, g = gh >> 2, h = gh & 3;
        if (gh != cur_gh) { cur_gh = gh;
            __syncthreads();
#pragma unroll 4
            for (int it = 0; it < 16; ++it) { const int idx = tid + NTHR * it, R = idx >> 5, ch = idx & 31, n16 = R >> 4, i = R & 15;
                const int c = 32 * (n16 >> 1) + 8 * (i >> 2) + 4 * (n16 & 1) + (i & 3);
                *(LAS v4u*)(L + R * 528 + ch * 16) = *(const v4u*)(W + (size_t)gh * 65536 + (size_t)c * 256 + ch * 8); }
            __syncthreads();
        }
#pragma unroll
        for (int ks = 0; ks < 8; ++ks) { af[ks][0] = naf[ks][0]; af[ks][1] = naf[ks][1]; }
        if (u + 1 < u1) QKV_LOADA(naf, u + 1);
        bf16* dst = (g == 0 ? Qd : (g == 1 ? Kd : Vd)) + (size_t)(pm * 256 + 32 * w + fr) * DM + h * 256 + 8 * fq;
#pragma unroll
        for (int q = 0; q < 4; ++q) {
            f32x4 acc[2][4];
#pragma unroll
            for (int m = 0; m < 2; ++m)
#pragma unroll
                for (int n = 0; n < 4; ++n) acc[m][n] = (f32x4){0.f, 0.f, 0.f, 0.f};
#pragma unroll
            for (int ks = 0; ks < 8; ++ks)
#pragma unroll
                for (int n = 0; n < 4; ++n) { const bf16x8 wf = *(const LAS bf16x8*)(L + (64 * q + 16 * n + fr) * 528 + (32 * ks + 8 * fq) * 2);
                    acc[0][n] = __builtin_amdgcn_mfma_f32_16x16x32_bf16(wf, af[ks][0], acc[0][n], 0, 0, 0);
                    acc[1][n] = __builtin_amdgcn_mfma_f32_16x16x32_bf16(wf, af[ks][1], acc[1][n], 0, 0, 0); }
#pragma unroll
            for (int m = 0; m < 2; ++m)
#pragma unroll
                for (int t = 0; t < 2; ++t) { const f32x4 v0 = acc[m][2 * t], v1 = acc[m][2 * t + 1];
                    v4u o; o.x = pk2(v0[0], v0[1]); o.y = pk2(v0[2], v0[3]); o.z = pk2(v1[0], v1[1]); o.w = pk2(v1[2], v1[3]);
                    *(v4u*)(dst + (size_t)(16 * m) * DM + 64 * q + 32 * t) = o; }
        }
    }
#undef QKV_LOADA
}

__device__ __forceinline__ void qkv_conv_phase(Frame& F) {
    const bf16* W = (const bf16*)(F.ws + WS_WQKV); const bf16* XM = (const bf16*)(F.ws + WS_XM);
    bf16* Qd = (bf16*)(F.ws + WS_LG); bf16* Kd = (bf16*)(F.ws + WS_K); bf16* Vd = (bf16*)F.out + (size_t)MTOK * DM;
    const float* cw = F.in[4]; const float* cb = F.in[5];
    LAS unsigned char* L = F.lds; constexpr int O_TAPS = 256 * 528;
    const int tid = F.tid, lane = F.lane, w = F.wave, fr = lane & 15, fq = lane >> 4;
    const int h = F.bid >> 6, pm0 = 2 * (F.bid & 63);
    for (int e = tid; e < 5 * 256; e += NTHR) { const int j = e >> 8, c = e & 255; ((LAS unsigned short*)(L + O_TAPS))[e] = (unsigned short)f2bf(j < 4 ? cw[j * DM + h * 256 + c] : cb[h * 256 + c]); }
#define QC_LOADW(gh) do { __syncthreads(); _Pragma("unroll 4") for (int it = 0; it < 16; ++it) { const int idx = tid + NTHR * it, R = idx >> 5, ch = idx & 31, n16 = R >> 4, i = R & 15; \
            const int c = 32 * (n16 >> 1) + 8 * (i >> 2) + 4 * (n16 & 1) + (i & 3); \
            *(LAS v4u*)(L + R * 528 + ch * 16) = *(const v4u*)(W + (size_t)(gh) * 65536 + (size_t)c * 256 + ch * 8); } __syncthreads(); } while (0)
#define QC_OFFS(pm, m_) const int T##m_ = (pm) * 256 + 32 * w + 16 * (m_) + fr, tq##m_ = T##m_ & (SEQ - 1); const bool va##m_ = tq##m_ >= 2, vb##m_ = tq##m_ >= 1, vd##m_ = tq##m_ + 1 < SEQ; \
        const unsigned oc##m_ = (unsigned)((T##m_ * DM + h * 256 + 8 * fq) * 2), oa##m_ = oc##m_ - (va##m_ ? 4096u : 0u), ob##m_ = oc##m_ - (vb##m_ ? 2048u : 0u), od##m_ = oc##m_ + (vd##m_ ? 2048u : 0u);
#define QC_RAW(dst, ks_, m_) do { const v4u z_ = {0u, 0u, 0u, 0u}; \
        const v4u xa_ = *(const v4u*)((const char*)XM + oa##m_ + 64 * (ks_)), xb_ = *(const v4u*)((const char*)XM + ob##m_ + 64 * (ks_)), xc_ = *(const v4u*)((const char*)XM + oc##m_ + 64 * (ks_)), xd_ = *(const v4u*)((const char*)XM + od##m_ + 64 * (ks_)); \
        dst[0] = va##m_ ? xa_ : z_; dst[1] = vb##m_ ? xb_ : z_; dst[2] = xc_; dst[3] = vd##m_ ? xd_ : z_; } while (0)
#define QC_TAPS(ks_) f32x2 tw_[4][4], tb_[4]; do { unsigned fo_ = (unsigned)(16 * fq); asm volatile("" : "+v"(fo_));        \
        const v4u b_ = *(const LAS v4u*)(L + O_TAPS + (4 * 256 + 32 * (ks_)) * 2 + fo_); tb_[0] = (f32x2){bflo(b_.x), bfhi(b_.x)}; tb_[1] = (f32x2){bflo(b_.y), bfhi(b_.y)}; tb_[2] = (f32x2){bflo(b_.z), bfhi(b_.z)}; tb_[3] = (f32x2){bflo(b_.w), bfhi(b_.w)}; \
        _Pragma("unroll") for (int j_ = 0; j_ < 4; ++j_) { const v4u t_ = *(const LAS v4u*)(L + O_TAPS + (j_ * 256 + 32 * (ks_)) * 2 + fo_); \
            tw_[j_][0] = (f32x2){bflo(t_.x), bfhi(t_.x)}; tw_[j_][1] = (f32x2){bflo(t_.y), bfhi(t_.y)}; tw_[j_][2] = (f32x2){bflo(t_.z), bfhi(t_.z)}; tw_[j_][3] = (f32x2){bflo(t_.w), bfhi(t_.w)}; } } while (0)
#define QC_CONV(out, raw) do { f32x2 y_[4] = {tb_[0], tb_[1], tb_[2], tb_[3]}; \
        _Pragma("unroll") for (int j_ = 0; j_ < 4; ++j_) { const v4u x_ = raw[j_]; \
            y_[0] = __builtin_elementwise_fma(tw_[j_][0], (f32x2){bflo(x_.x), bfhi(x_.x)}, y_[0]); y_[1] = __builtin_elementwise_fma(tw_[j_][1], (f32x2){bflo(x_.y), bfhi(x_.y)}, y_[1]); \
            y_[2] = __builtin_elementwise_fma(tw_[j_][2], (f32x2){bflo(x_.z), bfhi(x_.z)}, y_[2]); y_[3] = __builtin_elementwise_fma(tw_[j_][3], (f32x2){bflo(x_.w), bfhi(x_.w)}, y_[3]); } \
        unsigned o_[4]; \
        _Pragma("unroll") for (int p_ = 0; p_ < 4; ++p_) { const f32x2 e_ = y_[p_] * -1.44269504089f; \
            const f32x2 d_ = (f32x2){__builtin_amdgcn_exp2f(e_[0]), __builtin_amdgcn_exp2f(e_[1])} + 1.f; const f32x2 r_ = y_[p_] * (f32x2){__builtin_amdgcn_rcpf(d_[0]), __builtin_amdgcn_rcpf(d_[1])}; o_[p_] = pk2(r_[0], r_[1]); } \
        out = __builtin_bit_cast(bf16x8, (v4u){o_[0], o_[1], o_[2], o_[3]}); } while (0)
#define QC_PREP(afc, pm) do { QC_OFFS(pm, 0) QC_OFFS(pm, 1) v4u rwA_[4], rwB_[4]; QC_RAW(rwA_, 0, 0); LAS unsigned char* fl_ = L + w * 16384 + lane * 16; \
        _Pragma("unroll 1") for (int ks_ = 0; ks_ < 8; ++ks_) { bf16x8 o0_, o1_; QC_RAW(rwB_, ks_, 1); QC_TAPS(ks_); QC_CONV(o0_, rwA_); *(LAS bf16x8*)(fl_ + (2 * ks_) * 1024) = o0_; \
            if (ks_ < 7) QC_RAW(rwA_, ks_ + 1, 0); QC_CONV(o1_, rwB_); *(LAS bf16x8*)(fl_ + (2 * ks_ + 1) * 1024) = o1_; } \
        _Pragma("unroll") for (int ks_ = 0; ks_ < 8; ++ks_) { afc[ks_][0] = *(const LAS bf16x8*)(fl_ + (2 * ks_) * 1024); afc[ks_][1] = *(const LAS bf16x8*)(fl_ + (2 * ks_ + 1) * 1024); } } while (0)
#define QC_UNIT(DST, pm, af) do { bf16* dst_ = (DST) + (size_t)((pm) * 256 + 32 * w + fr) * DM + h * 256 + 8 * fq; \
        _Pragma("unroll") for (int q = 0; q < 4; ++q) { f32x4 acc[2][4]; \
            _Pragma("unroll") for (int m = 0; m < 2; ++m) _Pragma("unroll") for (int n = 0; n < 4; ++n) acc[m][n] = (f32x4){0.f, 0.f, 0.f, 0.f}; \
            _Pragma("unroll") for (int ks = 0; ks < 8; ++ks) _Pragma("unroll") for (int n = 0; n < 4; ++n) { const bf16x8 wf = *(const LAS bf16x8*)(L + (64 * q + 16 * n + fr) * 528 + (32 * ks + 8 * fq) * 2); \
                acc[0][n] = __builtin_amdgcn_mfma_f32_16x16x32_bf16(wf, af[ks][0], acc[0][n], 0, 0, 0); acc[1][n] = __builtin_amdgcn_mfma_f32_16x16x32_bf16(wf, af[ks][1], acc[1][n], 0, 0, 0); } \
            _Pragma("unroll") for (int m = 0; m < 2; ++m) _Pragma("unroll") for (int t = 0; t < 2; ++t) { const f32x4 v0 = acc[m][2 * t], v1 = acc[m][2 * t + 1]; \
                v4u o; o.x = pk2(v0[0], v0[1]); o.y = pk2(v0[2], v0[3]); o.z = pk2(v1[0], v1[1]); o.w = pk2(v1[2], v1[3]); \
                *(v4u*)(dst_ + (size_t)(16 * m) * DM + 64 * q + 32 * t) = o; } __builtin_amdgcn_sched_barrier(0); } } while (0)
#define QC_LOADV(dst, pm) do { const bf16* src_ = XM + (size_t)((pm) * 256 + 32 * w + fr) * DM + h * 256 + 8 * fq; \
        _Pragma("unroll") for (int ks_ = 0; ks_ < 8; ++ks_) _Pragma("unroll") for (int m_ = 0; m_ < 2; ++m_) dst[ks_][m_] = *(const bf16x8*)(src_ + (size_t)(16 * m_) * DM + 32 * ks_); } while (0)
    bf16x8 a0[8][2], a1[8][2];
    __syncthreads();
    QC_PREP(a0, pm0); QC_PREP(a1, pm0 + 1);
    QC_LOADW(0 + h); QC_UNIT(Qd, pm0, a0); QC_UNIT(Qd, pm0 + 1, a1);
    QC_LOADW(4 + h); QC_UNIT(Kd, pm0, a0);
    QC_LOADV(a0, pm0);
    QC_UNIT(Kd, pm0 + 1, a1);
    QC_LOADV(a1, pm0 + 1);
    QC_LOADW(8 + h); QC_UNIT(Vd, pm0, a0); QC_UNIT(Vd, pm0 + 1, a1);
#undef QC_LOADW
#undef QC_RAW
#undef QC_OFFS
#undef QC_CONV
#undef QC_TAPS
#undef QC_PREP
#undef QC_UNIT
#undef QC_LOADV
}

__device__ __forceinline__ void mconv_phase(Frame& F) {
    const bf16* XM = (const bf16*)(F.ws + WS_XM); bf16* XC = (bf16*)(F.ws + WS_XL);
    const float* cw = F.in[4]; const float* cb = F.in[5];
    const int NT = MTOK / 32 * 128;
    for (int g = F.bid * NTHR + F.tid; g < NT; g += F.G * NTHR) {
        const int chunk = g & 127, run = g >> 7, c0 = chunk * 8, m0 = run * 32, t0 = m0 & (SEQ - 1);
        float w[4][8], bias[8];
#pragma unroll
        for (int j = 0; j < 4; ++j) { const f32x4 a = *(const f32x4*)(cw + j * DM + c0), b = *(const f32x4*)(cw + j * DM + c0 + 4);
            w[j][0] = a[0]; w[j][1] = a[1]; w[j][2] = a[2]; w[j][3] = a[3]; w[j][4] = b[0]; w[j][5] = b[1]; w[j][6] = b[2]; w[j][7] = b[3]; }
        { const f32x4 a = *(const f32x4*)(cb + c0), b = *(const f32x4*)(cb + c0 + 4);
            bias[0] = a[0]; bias[1] = a[1]; bias[2] = a[2]; bias[3] = a[3]; bias[4] = b[0]; bias[5] = b[1]; bias[6] = b[2]; bias[7] = b[3]; }
        const v4u zero = {0u, 0u, 0u, 0u};
#pragma unroll 1
        for (int hb = 0; hb < 2; ++hb) {
            const int r0 = m0 + 16 * hb, tt = t0 + 16 * hb;
            v4u rows[19];
            rows[0] = (tt >= 2) ? *(const v4u*)(XM + (size_t)(r0 - 2) * DM + c0) : zero;
            rows[1] = (tt >= 1) ? *(const v4u*)(XM + (size_t)(r0 - 1) * DM + c0) : zero;
#pragma unroll
            for (int i = 0; i < 16; ++i) rows[2 + i] = *(const v4u*)(XM + (size_t)(r0 + i) * DM + c0);
            rows[18] = (tt + 16 < SEQ) ? *(const v4u*)(XM + (size_t)(r0 + 16) * DM + c0) : zero;
#pragma unroll
            for (int i = 0; i < 16; ++i) {
                float y[8];
#pragma unroll
                for (int e = 0; e < 8; ++e) y[e] = bias[e];
#pragma unroll
                for (int j = 0; j < 4; ++j) {
                    const unsigned p0 = rows[i + j].x, p1 = rows[i + j].y, p2 = rows[i + j].z, p3 = rows[i + j].w;
                    y[0] += w[j][0] * bflo(p0); y[1] += w[j][1] * bfhi(p0); y[2] += w[j][2] * bflo(p1); y[3] += w[j][3] * bfhi(p1);
                    y[4] += w[j][4] * bflo(p2); y[5] += w[j][5] * bfhi(p2); y[6] += w[j][6] * bflo(p3); y[7] += w[j][7] * bfhi(p3);
                }
#pragma unroll
                for (int e = 0; e < 8; ++e) y[e] = y[e] * sigmoidf_(y[e]);
                v4u o; o.x = pk2(y[0], y[1]); o.y = pk2(y[2], y[3]); o.z = pk2(y[4], y[5]); o.w = pk2(y[6], y[7]);
                *(v4u*)(XC + (size_t)(r0 + i) * DM + c0) = o;
            }
        }
    }
}

typedef short s16x4 __attribute__((ext_vector_type(4)));
__device__ __forceinline__ bf16x8 tr_read_pair(unsigned a0, unsigned a1) {
    s16x4 r0, r1;
    asm volatile("ds_read_b64_tr_b16 %0, %2\n\tds_read_b64_tr_b16 %1, %3\n\ts_waitcnt lgkmcnt(0)" : "=&v"(r0), "=&v"(r1) : "v"(a0), "v"(a1) : "memory");
    return __builtin_shufflevector(r0, r1, 0, 1, 2, 3, 4, 5, 6, 7);
}
__device__ __forceinline__ float dpp_shr(float oldv, float x, int n) {
    const int o = __builtin_bit_cast(int, oldv), v = __builtin_bit_cast(int, x);
    int r;
    if (n == 1) r = __builtin_amdgcn_update_dpp(o, v, 0x111, 0xf, 0xf, false);
    else if (n == 2) r = __builtin_amdgcn_update_dpp(o, v, 0x112, 0xf, 0xf, false);
    else if (n == 4) r = __builtin_amdgcn_update_dpp(o, v, 0x114, 0xf, 0xf, false);
    else r = __builtin_amdgcn_update_dpp(o, v, 0x118, 0xf, 0xf, false);
    return __builtin_bit_cast(float, r);
}
__device__ __forceinline__ float rdlane(float x, int l) { return __builtin_bit_cast(float, __builtin_amdgcn_readlane(__builtin_bit_cast(int, x), l)); }
__device__ __forceinline__ float wave_incl_sum(float x, int lane) {
    x += dpp_shr(0.f, x, 1); x += dpp_shr(0.f, x, 2); x += dpp_shr(0.f, x, 4); x += dpp_shr(0.f, x, 8);
    const float t0 = rdlane(x, 15), t1 = rdlane(x, 31), t2 = rdlane(x, 47);
    return x + (lane >= 16 ? t0 : 0.f) + (lane >= 32 ? t1 : 0.f) + (lane >= 48 ? t2 : 0.f);
}
__device__ __forceinline__ float wave_incl_max(float x, int lane) {
    const float NI = -INFINITY;
    x = fmaxf(x, dpp_shr(NI, x, 1)); x = fmaxf(x, dpp_shr(NI, x, 2)); x = fmaxf(x, dpp_shr(NI, x, 4)); x = fmaxf(x, dpp_shr(NI, x, 8));
    const float t0 = rdlane(x, 15), t1 = rdlane(x, 31), t2 = rdlane(x, 47);
    return fmaxf(fmaxf(x, lane >= 16 ? t0 : NI), fmaxf(lane >= 32 ? t1 : NI, lane >= 48 ? t2 : NI));
}
__device__ __forceinline__ void mscan_phase(Frame& F) {
    const bf16* Q = (const bf16*)(F.ws + WS_LG); const bf16* K = (const bf16*)(F.ws + WS_K); const bf16* V = (const bf16*)F.out + (size_t)MTOK * DM;
    const float* GT = (const float*)(F.ws + WS_GATE);
    constexpr int KS = 0, CTI = 33792, VT = 67584, VWT = 86016, PB = 104448, TAB = 113664, NT = 116736, NPART = 117760, DENT = 119808;
    constexpr int KST = 528, VST = 144, TABSZ = 1536;
    LAS unsigned char* L = F.lds;
    const int tid = F.tid, lane = F.lane, w = F.wave, fr = lane & 15, fq = lane >> 4, pt = w & 3, wg = w >> 2;
    for (int it_ = F.bid; it_ < 256; it_ += F.G) {
        const int item = ((((it_ >> 3) >> 2) * 8 + (it_ & 7)) << 2) | ((it_ >> 3) & 3);
        const int es = item & 3, dir = (item >> 2) & 1, h = (item >> 3) & 3, b = item >> 5;
        bf16* H = dir ? (bf16*)(F.ws + WS_XL) : (bf16*)(F.ws + WS_XM);
        const size_t rowbase = (size_t)b * SEQ;
#define TOF(c, p) (dir ? (SEQ - 1 - 64 * (c) - (p)) : (64 * (c) + (p)))
        for (int e = tid; e < (33792 + 1024) / 4; e += NTHR) { if (e < 33792 / 4) ((LAS unsigned*)(L + CTI))[e] = 0u; else ((LAS unsigned*)(L + NT))[e - 33792 / 4] = 0u; }
        float m_run = 0.f;
        float gi_n = 0.f, gf_n = 0.f;
        if (w == 4) { const size_t m = rowbase + TOF(0, lane); gi_n = GT[m * 16 + dir * 8 + h]; gf_n = GT[m * 16 + dir * 8 + 4 + h]; }
#define G1_TABLES(setp) do { \
            const float logf_ = fminf(gf_n, 0.f) - __logf(1.f + __expf(-fabsf(gf_n))); const float b_ = wave_incl_sum(logf_, lane); const float a_ = gi_n - b_; \
            const float M_ = fmaxf(m_run, wave_incl_max(a_, lane)); const float Mend_ = rdlane(M_, 63), g_ = rdlane(b_, 63); \
            LAS float* T_ = (LAS float*)(setp); T_[lane] = a_; T_[64 + lane] = M_; T_[128 + lane] = __expf(m_run - M_); T_[192 + lane] = __expf(-(b_ + M_)); T_[256 + lane] = __expf(a_ - Mend_); \
            if (lane == 0) { T_[320] = __expf(m_run - Mend_); T_[321] = g_ + Mend_; } \
            m_run = g_ + Mend_; } while (0)
        if (w == 4) G1_TABLES(L + TAB);
        __syncthreads();
        bf16x8 qf[8];
        v4u kreg[4]; v4u vreg;
#define LOAD_KV(c) do { _Pragma("unroll") for (int r_ = 0; r_ < 4; ++r_) { const int i_ = tid + NTHR * r_, s_ = i_ >> 5, c16_ = i_ & 31; \
                kreg[r_] = *(const v4u*)(K + (rowbase + TOF(c, s_)) * DM + h * 256 + c16_ * 8); } \
            { const int s_ = tid & 63, e8_ = tid >> 6; vreg = *(const v4u*)(V + (rowbase + TOF(c, s_)) * DM + h * 256 + es * 64 + e8_ * 8); } } while (0)
#define STORE_KV(setidx) do { _Pragma("unroll") for (int r_ = 0; r_ < 4; ++r_) { const int i_ = tid + NTHR * r_, s_ = i_ >> 5, c16_ = i_ & 31; \
                *(LAS v4u*)(L + KS + s_ * KST + c16_ * 16) = kreg[r_]; } \
            { const int s_ = tid & 63, e8_ = tid >> 6; const float ws_ = ((const LAS float*)(L + TAB + (setidx) * TABSZ))[256 + s_]; \
              LAS bf16* vt_ = (LAS bf16*)(L + VT + (setidx) * 9216); LAS bf16* vw_ = (LAS bf16*)(L + VWT + (setidx) * 9216); \
              const unsigned wv_[4] = {vreg.x, vreg.y, vreg.z, vreg.w}; \
              _Pragma("unroll") for (int j_ = 0; j_ < 4; ++j_) { const float lo_ = bflo(wv_[j_]), hi_ = bfhi(wv_[j_]); const int e_ = e8_ * 8 + 2 * j_; \
                vt_[e_ * 72 + s_] = (bf16)(wv_[j_] & 0xffffu); vt_[(e_ + 1) * 72 + s_] = (bf16)(wv_[j_] >> 16); \
                vw_[e_ * 72 + s_] = (bf16)f2bf(lo_ * ws_); vw_[(e_ + 1) * 72 + s_] = (bf16)f2bf(hi_ * ws_); } } } while (0)
#define LOAD_Q(c) do { const size_t m_ = rowbase + TOF(c, 16 * pt + fr); _Pragma("unroll") for (int ks_ = 0; ks_ < 8; ++ks_) \
                qf[ks_] = *(const bf16x8*)(Q + m_ * DM + h * 256 + 32 * ks_ + 8 * fq); } while (0)
        LOAD_KV(0); LOAD_Q(0);
        STORE_KV(0);
        f32x4 Cacc[8], Nacc[2];
#pragma unroll
        for (int i = 0; i < 8; ++i) Cacc[i] = (f32x4){0.f, 0.f, 0.f, 0.f};
        Nacc[0] = (f32x4){0.f, 0.f, 0.f, 0.f}; Nacc[1] = (f32x4){0.f, 0.f, 0.f, 0.f};
        __syncthreads();
        for (int c = 0; c < 64; ++c) {
            const int cur = c & 1, nxt = cur ^ 1;
            const bool has_next = (c + 1 < 64);
            const LAS float* T = (const LAS float*)(L + TAB + cur * TABSZ);
            if (has_next) { LOAD_KV(c + 1); if (w == 4) { const size_t m = rowbase + TOF(c + 1, lane); gi_n = GT[m * 16 + dir * 8 + h]; gf_n = GT[m * 16 + dir * 8 + 4 + h]; } }
            const int p = 16 * pt + fr;
            const float Mp = T[64 + p], wi_p = T[128 + p];
            float cs = 0.f;
            f32x4 O[2] = {(f32x4){0.f, 0.f, 0.f, 0.f}, (f32x4){0.f, 0.f, 0.f, 0.f}}, sa[2] = {(f32x4){0.f, 0.f, 0.f, 0.f}, (f32x4){0.f, 0.f, 0.f, 0.f}};
            const bool s0on = (2 * wg <= pt), s1on = (2 * wg + 1 <= pt);
#define KF(i, ks) (*(const LAS bf16x8*)(L + KS + (16 * (2 * wg + (i)) + fr) * KST + (32 * (ks) + 8 * fq) * 2))
#define CF(i, ks) (*(const LAS bf16x8*)(L + CTI + (16 * (2 * wg + (i)) + fr) * KST + (32 * (ks) + 8 * fq) * 2))
            if (s1on) {
#pragma unroll
                for (int ks = 0; ks < 8; ++ks) { const bf16x8 k0 = KF(0, ks), k1 = KF(1, ks), c0 = CF(0, ks), c1 = CF(1, ks);
                    sa[0] = __builtin_amdgcn_mfma_f32_16x16x32_bf16(k0, qf[ks], sa[0], 0, 0, 0); sa[1] = __builtin_amdgcn_mfma_f32_16x16x32_bf16(k1, qf[ks], sa[1], 0, 0, 0);
                    O[0] = __builtin_amdgcn_mfma_f32_16x16x32_bf16(c0, qf[ks], O[0], 0, 0, 0); O[1] = __builtin_amdgcn_mfma_f32_16x16x32_bf16(c1, qf[ks], O[1], 0, 0, 0); }
            } else if (s0on) {
#pragma unroll
                for (int ks = 0; ks < 8; ++ks) { const bf16x8 k0 = KF(0, ks), c0 = CF(0, ks), c1 = CF(1, ks);
                    sa[0] = __builtin_amdgcn_mfma_f32_16x16x32_bf16(k0, qf[ks], sa[0], 0, 0, 0);
                    O[0] = __builtin_amdgcn_mfma_f32_16x16x32_bf16(c0, qf[ks], O[0], 0, 0, 0); O[1] = __builtin_amdgcn_mfma_f32_16x16x32_bf16(c1, qf[ks], O[1], 0, 0, 0); }
            } else {
#pragma unroll
                for (int ks = 0; ks < 8; ++ks) { const bf16x8 c0 = CF(0, ks), c1 = CF(1, ks);
                    O[0] = __builtin_amdgcn_mfma_f32_16x16x32_bf16(c0, qf[ks], O[0], 0, 0, 0); O[1] = __builtin_amdgcn_mfma_f32_16x16x32_bf16(c1, qf[ks], O[1], 0, 0, 0); }
            }
#undef KF
#undef CF
#pragma unroll
            for (int i = 0; i < 2; ++i) { const int st = 2 * wg + i;
                v2u pw = {0u, 0u};
                if (i ? s1on : s0on) {
                    const f32x4 a4 = *(const LAS f32x4*)(T + 16 * st + 4 * fq);
                    float pv[4];
#pragma unroll
                    for (int r = 0; r < 4; ++r) { const int s_ = 16 * st + 4 * fq + r; const float wgt = (s_ <= p) ? __expf(a4[r] - Mp) : 0.f; pv[r] = sa[i][r] * wgt; cs += pv[r]; }
                    pw.x = pk2(pv[0], pv[1]); pw.y = pk2(pv[2], pv[3]);
                }
                *(LAS v2u*)(L + PB + p * VST + (16 * st + 4 * fq) * 2) = pw; }
            float di = 0.f;
#define DEN_INTER(ks) do { const f32x4 n0 = *(const LAS f32x4*)(L + NT + (32 * (ks) + 8 * fq) * 4), n1 = *(const LAS f32x4*)(L + NT + (32 * (ks) + 8 * fq) * 4 + 16); \
                const v4u qw = __builtin_bit_cast(v4u, qf[ks]); \
                di += bflo(qw.x) * n0[0] + bfhi(qw.x) * n0[1] + bflo(qw.y) * n0[2] + bfhi(qw.y) * n0[3] + bflo(qw.z) * n1[0] + bfhi(qw.z) * n1[1] + bflo(qw.w) * n1[2] + bfhi(qw.w) * n1[3]; } while (0)
            if (wg == 0) { DEN_INTER(0); DEN_INTER(1); DEN_INTER(2); DEN_INTER(3); }
            else { DEN_INTER(4); DEN_INTER(5); DEN_INTER(6); DEN_INTER(7); }
#undef DEN_INTER
            di += __shfl_xor(di, 16); di += __shfl_xor(di, 32);
            cs += __shfl_xor(cs, 16); cs += __shfl_xor(cs, 32);
            if (fq == 0) ((LAS float*)(L + DENT))[wg * 64 + p] = wi_p * di + cs;
            if (has_next) LOAD_Q(c + 1);
            if (has_next && w == 4) G1_TABLES(L + TAB + nxt * TABSZ);
            { const float decay = T[320];
              const bf16x8 vw0 = *(const LAS bf16x8*)(L + VWT + cur * 9216 + (16 * pt + fr) * VST + (8 * fq) * 2);
              const bf16x8 vw1 = *(const LAS bf16x8*)(L + VWT + cur * 9216 + (16 * pt + fr) * VST + (32 + 8 * fq) * 2);
              bf16x8 wsf0, wsf1;
              { const f32x4 w0 = *(const LAS f32x4*)(T + 256 + 8 * fq), w1 = *(const LAS f32x4*)(T + 256 + 8 * fq + 4), w2 = *(const LAS f32x4*)(T + 288 + 8 * fq), w3 = *(const LAS f32x4*)(T + 288 + 8 * fq + 4);
                const bool c0 = (fr == 0);
                v4u a, b; a.x = c0 ? pk2(w0[0], w0[1]) : 0u; a.y = c0 ? pk2(w0[2], w0[3]) : 0u; a.z = c0 ? pk2(w1[0], w1[1]) : 0u; a.w = c0 ? pk2(w1[2], w1[3]) : 0u;
                b.x = c0 ? pk2(w2[0], w2[1]) : 0u; b.y = c0 ? pk2(w2[2], w2[3]) : 0u; b.z = c0 ? pk2(w3[0], w3[1]) : 0u; b.w = c0 ? pk2(w3[2], w3[3]) : 0u;
                wsf0 = __builtin_bit_cast(bf16x8, a); wsf1 = __builtin_bit_cast(bf16x8, b); }
              const int l16 = lane & 15, q4 = l16 >> 2, p4 = l16 & 3;
              const unsigned kb = (unsigned)(uintptr_t)(L + KS) + (unsigned)((8 * fq + q4) * KST + 4 * p4 * 2);
#define TR_READS "ds_read_b64_tr_b16 %0, %[ad]\n\tds_read_b64_tr_b16 %1, %[ad] offset:2112\n\tds_read_b64_tr_b16 %2, %[ad] offset:16896\n\tds_read_b64_tr_b16 %3, %[ad] offset:19008\n\t" \
                 "ds_read_b64_tr_b16 %4, %[ad] offset:32\n\tds_read_b64_tr_b16 %5, %[ad] offset:2144\n\tds_read_b64_tr_b16 %6, %[ad] offset:16928\n\tds_read_b64_tr_b16 %7, %[ad] offset:19040"
#define TR_OUT(R) "=&v"(R[0]), "=&v"(R[1]), "=&v"(R[2]), "=&v"(R[3]), "=&v"(R[4]), "=&v"(R[5]), "=&v"(R[6]), "=&v"(R[7])
#define TR_INOUT(R) "+v"(R[0]), "+v"(R[1]), "+v"(R[2]), "+v"(R[3]), "+v"(R[4]), "+v"(R[5]), "+v"(R[6]), "+v"(R[7])
              s16x4 rA[8], rB[8];
              { const unsigned a0 = kb + (8 * wg) * 32; asm volatile(TR_READS : TR_OUT(rA) : [ad] "v"(a0) : "memory"); }
#define C_STEP(dtl, RC, RN) do { \
                  if ((dtl) < 6) { const unsigned a1 = kb + (8 * wg + (dtl) + 2) * 32; asm volatile(TR_READS "\n\ts_waitcnt lgkmcnt(8)" : TR_OUT(RN), TR_INOUT(RC) : [ad] "v"(a1) : "memory"); } \
                  else asm volatile("s_waitcnt lgkmcnt(0)" : TR_INOUT(RC) : : "memory"); \
                  const bf16x8 k0 = __builtin_shufflevector(RC[0], RC[1], 0, 1, 2, 3, 4, 5, 6, 7), k1 = __builtin_shufflevector(RC[2], RC[3], 0, 1, 2, 3, 4, 5, 6, 7); \
                  const bf16x8 k2 = __builtin_shufflevector(RC[4], RC[5], 0, 1, 2, 3, 4, 5, 6, 7), k3 = __builtin_shufflevector(RC[6], RC[7], 0, 1, 2, 3, 4, 5, 6, 7); \
                  Cacc[dtl] = Cacc[dtl] * decay; Cacc[(dtl) + 1] = Cacc[(dtl) + 1] * decay; \
                  Cacc[dtl] = __builtin_amdgcn_mfma_f32_16x16x32_bf16(k0, vw0, Cacc[dtl], 0, 0, 0); \
                  Cacc[(dtl) + 1] = __builtin_amdgcn_mfma_f32_16x16x32_bf16(k2, vw0, Cacc[(dtl) + 1], 0, 0, 0); \
                  Cacc[dtl] = __builtin_amdgcn_mfma_f32_16x16x32_bf16(k1, vw1, Cacc[dtl], 0, 0, 0); \
                  Cacc[(dtl) + 1] = __builtin_amdgcn_mfma_f32_16x16x32_bf16(k3, vw1, Cacc[(dtl) + 1], 0, 0, 0); \
                  if ((dtl) == 2 * pt) {                                            \
                      Nacc[0] = Nacc[0] * decay; Nacc[1] = Nacc[1] * decay; \
                      Nacc[0] = __builtin_amdgcn_mfma_f32_16x16x32_bf16(k0, wsf0, Nacc[0], 0, 0, 0); Nacc[1] = __builtin_amdgcn_mfma_f32_16x16x32_bf16(k2, wsf0, Nacc[1], 0, 0, 0); \
                      Nacc[0] = __builtin_amdgcn_mfma_f32_16x16x32_bf16(k1, wsf1, Nacc[0], 0, 0, 0); Nacc[1] = __builtin_amdgcn_mfma_f32_16x16x32_bf16(k3, wsf1, Nacc[1], 0, 0, 0); } } while (0)
              C_STEP(0, rA, rB); C_STEP(2, rB, rA); C_STEP(4, rA, rB); C_STEP(6, rB, rA);
#undef C_STEP
#undef TR_READS
#undef TR_OUT
#undef TR_INOUT
            }
            __syncthreads();
#pragma unroll
            for (int i = 0; i < 2; ++i) { const int et = 2 * wg + i; O[i] = O[i] * wi_p;
#pragma unroll
                for (int ks = 0; ks < 2; ++ks) { const bf16x8 vf = *(const LAS bf16x8*)(L + VT + cur * 9216 + (16 * et + fr) * VST + (32 * ks + 8 * fq) * 2);
                    const bf16x8 pf = *(const LAS bf16x8*)(L + PB + p * VST + (32 * ks + 8 * fq) * 2);
                    O[i] = __builtin_amdgcn_mfma_f32_16x16x32_bf16(vf, pf, O[i], 0, 0, 0); } }
            { const float den = ((const LAS float*)(L + DENT))[p] + ((const LAS float*)(L + DENT))[64 + p];
              const float inv = 1.f / fmaxf(fabsf(den), T[192 + p]);
              const size_t m = rowbase + TOF(c, p);
#pragma unroll
              for (int i = 0; i < 2; ++i) { const int et = 2 * wg + i; v2u o; o.x = pk2(O[i][0] * inv, O[i][1] * inv); o.y = pk2(O[i][2] * inv, O[i][3] * inv);
                  *(v2u*)(H + m * DM + h * 256 + es * 64 + 16 * et + 4 * fq) = o; } }
            { const float decay = T[320];
#pragma unroll
              for (int dtl = 0; dtl < 8; ++dtl) { const int dt = 8 * wg + dtl; v2u o; o.x = pk2(Cacc[dtl][0], Cacc[dtl][1]); o.y = pk2(Cacc[dtl][2], Cacc[dtl][3]);
                  *(LAS v2u*)(L + CTI + (16 * pt + fr) * KST + (16 * dt + 4 * fq) * 2) = o; }
              if (fr == 0) { *(LAS f32x4*)(L + NT + (16 * (8 * wg + 2 * pt) + 4 * fq) * 4) = Nacc[0]; *(LAS f32x4*)(L + NT + (16 * (8 * wg + 2 * pt + 1) + 4 * fq) * 4) = Nacc[1]; } }
            if (has_next) STORE_KV(nxt);
            __syncthreads();
        }
#undef TOF
#undef G1_TABLES
#undef LOAD_KV
#undef STORE_KV
#undef LOAD_Q
    }
}

__device__ __forceinline__ void ym_phase(Frame& F) {
    const bf16* HF = (const bf16*)(F.ws + WS_XM); const bf16* HB = (const bf16*)(F.ws + WS_XL); bf16* OP = (bf16*)(F.ws + WS_OP);
    const float* ng = F.in[9];
    const int gw = F.bid * NWAVES + F.wave, NGW = F.G * NWAVES;
    for (int m0 = 2 * gw; m0 < MTOK; m0 += 2 * NGW) {
        v2u ra[2][4], rb[2][4], rop[2][4];
#pragma unroll
        for (int t = 0; t < 2; ++t)
#pragma unroll
            for (int hd = 0; hd < 4; ++hd) { const size_t o = (size_t)(m0 + t) * DM + hd * 256 + F.lane * 4;
                ra[t][hd] = *(const v2u*)(HF + o); rb[t][hd] = *(const v2u*)(HB + o); rop[t][hd] = *(const v2u*)(OP + o); }
#pragma unroll
        for (int t = 0; t < 2; ++t)
#pragma unroll
            for (int hd = 0; hd < 4; ++hd) {
                const size_t o = (size_t)(m0 + t) * DM + hd * 256 + F.lane * 4;
                const v2u a = ra[t][hd], b = rb[t][hd], op = rop[t][hd];
                const float v0 = bflo(a.x) + bflo(b.x), v1 = bfhi(a.x) + bfhi(b.x), v2 = bflo(a.y) + bflo(b.y), v3 = bfhi(a.y) + bfhi(b.y);
                const float r = rsqrtf(wave_sum((v0 * v0 + v1 * v1) + (v2 * v2 + v3 * v3)) * (1.f / 256.f) + EPS);
                const f32x4 g = *(const f32x4*)(ng + hd * 256 + F.lane * 4);
                v2u w; w.x = pk2(sigmoidf_(bflo(op.x)) * v0 * r * g[0], sigmoidf_(bfhi(op.x)) * v1 * r * g[1]);
                w.y = pk2(sigmoidf_(bflo(op.y)) * v2 * r * g[2], sigmoidf_(bfhi(op.y)) * v3 * r * g[3]);
                *(v2u*)(OP + o) = w;
            }
    }
    {
        float* usc = (float*)(F.ws + WS_LG + 16 * MiB); float* vsc = usc + NEXP;
        for (int row0 = 2 * gw; row0 < 2 * NEXP; row0 += 2 * NGW) {
            const bool isv = row0 >= NEXP; const int r0 = isv ? row0 - NEXP : row0;
            f32x4 a[2][4];
#pragma unroll
            for (int t = 0; t < 2; ++t) { const f32x4* src = (const f32x4*)(F.in[isv ? 24 : 23] + (size_t)(r0 + t) * DM) + F.lane * 4;
#pragma unroll
                for (int j = 0; j < 4; ++j) a[t][j] = src[j]; }
#pragma unroll
            for (int t = 0; t < 2; ++t) { const int r = r0 + t; float ss = 0.f;
#pragma unroll
                for (int j = 0; j < 4; ++j) ss += (a[t][j][0] * a[t][j][0] + a[t][j][1] * a[t][j][1]) + (a[t][j][2] * a[t][j][2] + a[t][j][3] * a[t][j][3]);
                const float rms = sqrtf(wave_sum(ss) * (1.f / DM));
                const float sc = fmaxf(rms * 0.5f, 1e-30f), inv = 1.f / sc;
                unsigned o[2] = {0u, 0u};
#pragma unroll
                for (int j = 0; j < 4; ++j) { const f32x4 q = a[t][j] * inv;
                    if (j & 1) { o[j >> 1] = __builtin_amdgcn_cvt_scalef32_pk_fp4_f32(o[j >> 1], q[0], q[1], 1.0f, 2); o[j >> 1] = __builtin_amdgcn_cvt_scalef32_pk_fp4_f32(o[j >> 1], q[2], q[3], 1.0f, 3); }
                    else       { o[j >> 1] = __builtin_amdgcn_cvt_scalef32_pk_fp4_f32(o[j >> 1], q[0], q[1], 1.0f, 0); o[j >> 1] = __builtin_amdgcn_cvt_scalef32_pk_fp4_f32(o[j >> 1], q[2], q[3], 1.0f, 1); } }
                *(v2u*)(F.ws + WS_LG + (isv ? DM / 2 : 0) + (size_t)r * DM + F.lane * 8) = (v2u){o[0], o[1]};
                if (F.lane == 0) (isv ? vsc : usc)[r] = sc; }
        }
    }
}

typedef float f32x16 __attribute__((ext_vector_type(16)));
#define TOPK_INSERT(L, xv) do { const float x_ = (xv); \
    L[15] = __builtin_amdgcn_fmed3f(L[14], L[15], x_); L[14] = __builtin_amdgcn_fmed3f(L[13], L[14], x_); L[13] = __builtin_amdgcn_fmed3f(L[12], L[13], x_); L[12] = __builtin_amdgcn_fmed3f(L[11], L[12], x_); \
    L[11] = __builtin_amdgcn_fmed3f(L[10], L[11], x_); L[10] = __builtin_amdgcn_fmed3f(L[9], L[10], x_); L[9] = __builtin_amdgcn_fmed3f(L[8], L[9], x_); L[8] = __builtin_amdgcn_fmed3f(L[7], L[8], x_); \
    L[7] = __builtin_amdgcn_fmed3f(L[6], L[7], x_); L[6] = __builtin_amdgcn_fmed3f(L[5], L[6], x_); L[5] = __builtin_amdgcn_fmed3f(L[4], L[5], x_); L[4] = __builtin_amdgcn_fmed3f(L[3], L[4], x_); \
    L[3] = __builtin_amdgcn_fmed3f(L[2], L[3], x_); L[2] = __builtin_amdgcn_fmed3f(L[1], L[2], x_); L[1] = __builtin_amdgcn_fmed3f(L[0], L[1], x_); L[0] = fmaxf(L[0], x_); } while (0)
#define SEL_CE(L, a, b) do { const float hi_ = fmaxf(L[a], L[b]), lo_ = fminf(L[a], L[b]); L[a] = hi_; L[b] = lo_; } while (0)
#define SORT16_DESC(L) do { SEL_CE(L, 0, 1); SEL_CE(L, 2, 3); SEL_CE(L, 0, 2); SEL_CE(L, 1, 3); SEL_CE(L, 1, 2); SEL_CE(L, 4, 5); SEL_CE(L, 6, 7); SEL_CE(L, 4, 6); SEL_CE(L, 5, 7); SEL_CE(L, 5, 6); SEL_CE(L, 0, 4); SEL_CE(L, 2, 6); SEL_CE(L, 2, 4); SEL_CE(L, 1, 5); SEL_CE(L, 3, 7); SEL_CE(L, 3, 5); SEL_CE(L, 1, 2); SEL_CE(L, 3, 4); SEL_CE(L, 5, 6); SEL_CE(L, 8, 9); SEL_CE(L, 10, 11); SEL_CE(L, 8, 10); SEL_CE(L, 9, 11); SEL_CE(L, 9, 10); SEL_CE(L, 12, 13); SEL_CE(L, 14, 15); SEL_CE(L, 12, 14); SEL_CE(L, 13, 15); SEL_CE(L, 13, 14); SEL_CE(L, 8, 12); SEL_CE(L, 10, 14); SEL_CE(L, 10, 12); SEL_CE(L, 9, 13); SEL_CE(L, 11, 15); SEL_CE(L, 11, 13); SEL_CE(L, 9, 10); SEL_CE(L, 11, 12); SEL_CE(L, 13, 14); SEL_CE(L, 0, 8); SEL_CE(L, 4, 12); SEL_CE(L, 4, 8); SEL_CE(L, 2, 10); SEL_CE(L, 6, 14); SEL_CE(L, 6, 10); SEL_CE(L, 2, 4); SEL_CE(L, 6, 8); SEL_CE(L, 10, 12); SEL_CE(L, 1, 9); SEL_CE(L, 5, 13); SEL_CE(L, 5, 9); SEL_CE(L, 3, 11); SEL_CE(L, 7, 15); SEL_CE(L, 7, 11); SEL_CE(L, 3, 5); SEL_CE(L, 7, 9); SEL_CE(L, 11, 13); SEL_CE(L, 1, 2); SEL_CE(L, 3, 4); SEL_CE(L, 5, 6); SEL_CE(L, 7, 8); SEL_CE(L, 9, 10); SEL_CE(L, 11, 12); SEL_CE(L, 13, 14); } while (0)
#define BMERGE16_DESC(L) do { SEL_CE(L, 0, 8); SEL_CE(L, 1, 9); SEL_CE(L, 2, 10); SEL_CE(L, 3, 11); SEL_CE(L, 4, 12); SEL_CE(L, 5, 13); SEL_CE(L, 6, 14); SEL_CE(L, 7, 15); SEL_CE(L, 0, 4); SEL_CE(L, 1, 5); SEL_CE(L, 2, 6); SEL_CE(L, 3, 7); SEL_CE(L, 8, 12); SEL_CE(L, 9, 13); SEL_CE(L, 10, 14); SEL_CE(L, 11, 15); SEL_CE(L, 0, 2); SEL_CE(L, 1, 3); SEL_CE(L, 4, 6); SEL_CE(L, 5, 7); SEL_CE(L, 8, 10); SEL_CE(L, 9, 11); SEL_CE(L, 12, 14); SEL_CE(L, 13, 15); SEL_CE(L, 0, 1); SEL_CE(L, 2, 3); SEL_CE(L, 4, 5); SEL_CE(L, 6, 7); SEL_CE(L, 8, 9); SEL_CE(L, 10, 11); SEL_CE(L, 12, 13); SEL_CE(L, 14, 15); } while (0)
template <int I> struct CandRow {
    static __device__ __forceinline__ void run(const float (&L0)[16], const float (&L1)[16], float (&R)[16]) {
        constexpr int NJ = 16 / (I + 1);
#pragma unroll
        for (int j = 0; j < NJ; ++j) { const float sm = L0[I] + L1[j];
            const float pk = __builtin_bit_cast(float, (__builtin_bit_cast(unsigned, sm) & 0xffffff00u) | (unsigned)(I * 16 + j)); TOPK_INSERT(R, pk); }
        if constexpr (I < 15) CandRow<I + 1>::run(L0, L1, R);
    }
};
__device__ __forceinline__ unsigned pick4(unsigned d0, unsigned d1, unsigned d2, unsigned d3, int i) {
    const int q = i >> 2; unsigned d = d0; d = (q == 1) ? d1 : d; d = (q == 2) ? d2 : d; d = (q == 3) ? d3 : d; return (d >> (8 * (i & 3))) & 127u;
}
__device__ __forceinline__ void select_phase(Frame& F) {
    const bf16* PQ = (const bf16*)(F.ws + WS_MG);
    int* IDX = (int*)(F.ws + WS_K); float* GW = (float*)(F.ws + WS_K + 16 * MiB);
    LAS unsigned char* L = F.lds;
    const int tid = F.tid, lane = F.lane, w = F.wave, l31 = lane & 31, hh = lane >> 5;
    const float NEG_INF = -INFINITY;
    for (int grp = F.bid; grp < MTOK / 128; grp += F.G) {
        const int tb = grp * 4 + (w & 3);
        const size_t m = (size_t)tb * 32 + l31;
        for (int hp = 0; hp < 4; ++hp) {
            const int hl = w >> 2, h = 2 * hp + hl;
            v4u sc[2][8];
#pragma unroll
            for (int p = 0; p < 2; ++p)
#pragma unroll
                for (int j = 0; j < 8; ++j) sc[p][j] = *(const v4u*)(PQ + m * 2048 + h * 256 + p * 128 + 64 * hh + 8 * j);
            float L0[16], L1[16];
#pragma unroll
            for (int p = 0; p < 2; ++p) {
                float Lc[16];
                const unsigned hh64 = (unsigned)hh << 6;
#pragma unroll
                for (int kb = 0; kb < 4; ++kb) { float Nw[16];
#pragma unroll
                    for (int r = 0; r < 16; ++r) { const v4u q4 = sc[p][2 * kb + (r >> 3)]; const int e = r & 7;
                        const unsigned wd = (e >> 1) == 0 ? q4.x : (e >> 1) == 1 ? q4.y : (e >> 1) == 2 ? q4.z : q4.w;
                        const unsigned bits = (e & 1) ? (wd & 0xffff0000u) : (wd << 16);
                        Nw[r] = __uint_as_float(bits | hh64 | (unsigned)(16 * kb + r)); }
                    SORT16_DESC(Nw);
                    if (kb == 0) {
#pragma unroll
                        for (int i = 0; i < 16; ++i) Lc[i] = Nw[i];
                    } else {
#pragma unroll
                        for (int i = 0; i < 16; ++i) Lc[i] = fmaxf(Lc[i], Nw[15 - i]);
                        BMERGE16_DESC(Lc); } }
                { float Lo[16];
#pragma unroll
                  for (int i = 0; i < 16; ++i) Lo[i] = __shfl_xor(Lc[i], 32);
#pragma unroll
                  for (int i = 0; i < 16; ++i) Lc[i] = fmaxf(Lc[i], Lo[15 - i]);
                  BMERGE16_DESC(Lc); }
#pragma unroll
                for (int i = 0; i < 16; ++i) { if (p == 0) L0[i] = Lc[i]; else L1[i] = Lc[i]; }
            }
            float R[16];
#pragma unroll
            for (int j = 0; j < 16; ++j) { const float sm = L0[0] + L1[j]; R[j] = __builtin_bit_cast(float, (__builtin_bit_cast(unsigned, sm) & 0xffffff00u) | (unsigned)j); }
            SORT16_DESC(R);
            CandRow<1>::run(L0, L1, R);
            unsigned a0 = 0, a1 = 0, a2 = 0, a3 = 0, b0 = 0, b1 = 0, b2 = 0, b3 = 0;
#pragma unroll
            for (int i = 0; i < 4; ++i) { a0 |= (__builtin_bit_cast(unsigned, L0[i]) & 127u) << (8 * i); a1 |= (__builtin_bit_cast(unsigned, L0[4 + i]) & 127u) << (8 * i);
                a2 |= (__builtin_bit_cast(unsigned, L0[8 + i]) & 127u) << (8 * i); a3 |= (__builtin_bit_cast(unsigned, L0[12 + i]) & 127u) << (8 * i);
                b0 |= (__builtin_bit_cast(unsigned, L1[i]) & 127u) << (8 * i); b1 |= (__builtin_bit_cast(unsigned, L1[4 + i]) & 127u) << (8 * i);
                b2 |= (__builtin_bit_cast(unsigned, L1[8 + i]) & 127u) << (8 * i); b3 |= (__builtin_bit_cast(unsigned, L1[12 + i]) & 127u) << (8 * i); }
            float ex[16]; float sum = 0.f; int id[16];
#pragma unroll
            for (int r = 0; r < 16; ++r) { ex[r] = __expf(R[r] - R[0]); sum += ex[r];
                const unsigned cid = __builtin_bit_cast(unsigned, R[r]) & 255u;
                id[r] = (int)(pick4(a0, a1, a2, a3, (int)(cid >> 4)) * 128u + pick4(b0, b1, b2, b3, (int)(cid & 15u))); }
            const float inv = 1.f / sum;
            if (hh == 0) {
#pragma unroll
                for (int q = 0; q < 4; ++q) {
                    *(int4*)(IDX + m * 128 + h * 16 + 4 * q) = make_int4(id[4 * q], id[4 * q + 1], id[4 * q + 2], id[4 * q + 3]);
                    *(f32x4*)(GW + m * 128 + h * 16 + 4 * q) = (f32x4){ex[4 * q] * inv, ex[4 * q + 1] * inv, ex[4 * q + 2] * inv, ex[4 * q + 3] * inv}; }
            }
        }
    }
}

template <int B> __device__ __forceinline__ f32x2 fp4b(unsigned w) { return __builtin_amdgcn_cvt_scalef32_pk_f32_fp4(w, 1.0f, B); }
__device__ __forceinline__ void sort128_by_index(int& a0, int& a1, float& g0, float& g1, int lane) {
#define S128_LANE_STAGE(K, J) do { const bool up_ = ((lane & (K)) == 0), low_ = ((lane & (J)) == 0), kmin_ = (up_ == low_); \
        { const int pv_ = __shfl_xor(a0, (J)); const float pg_ = __shfl_xor(g0, (J)); const bool tk_ = kmin_ ? (pv_ < a0) : (pv_ > a0); a0 = tk_ ? pv_ : a0; g0 = tk_ ? pg_ : g0; } \
        { const int pv_ = __shfl_xor(a1, (J)); const float pg_ = __shfl_xor(g1, (J)); const bool tk_ = kmin_ ? (pv_ < a1) : (pv_ > a1); a1 = tk_ ? pv_ : a1; g1 = tk_ ? pg_ : g1; } } while (0)
#define S128_LANE_STAGE_TOP(J) do { const bool low_ = ((lane & (J)) == 0);     \
        { const int pv_ = __shfl_xor(a0, (J)); const float pg_ = __shfl_xor(g0, (J)); const bool tk_ = low_ ? (pv_ < a0) : (pv_ > a0); a0 = tk_ ? pv_ : a0; g0 = tk_ ? pg_ : g0; } \
        { const int pv_ = __shfl_xor(a1, (J)); const float pg_ = __shfl_xor(g1, (J)); const bool tk_ = low_ ? (pv_ < a1) : (pv_ > a1); a1 = tk_ ? pv_ : a1; g1 = tk_ ? pg_ : g1; } } while (0)
    S128_LANE_STAGE(2, 1);
    S128_LANE_STAGE(4, 2); S128_LANE_STAGE(4, 1);
    S128_LANE_STAGE(8, 4); S128_LANE_STAGE(8, 2); S128_LANE_STAGE(8, 1);
    S128_LANE_STAGE(16, 8); S128_LANE_STAGE(16, 4); S128_LANE_STAGE(16, 2); S128_LANE_STAGE(16, 1);
    S128_LANE_STAGE(32, 16); S128_LANE_STAGE(32, 8); S128_LANE_STAGE(32, 4); S128_LANE_STAGE(32, 2); S128_LANE_STAGE(32, 1);
#define S128_K64(J) do { const bool low_ = ((lane & (J)) == 0); \
        { const int pv_ = __shfl_xor(a0, (J)); const float pg_ = __shfl_xor(g0, (J)); const bool tk_ = low_ ? (pv_ < a0) : (pv_ > a0); a0 = tk_ ? pv_ : a0; g0 = tk_ ? pg_ : g0; } \
        { const int pv_ = __shfl_xor(a1, (J)); const float pg_ = __shfl_xor(g1, (J)); const bool tk_ = low_ ? (pv_ > a1) : (pv_ < a1); a1 = tk_ ? pv_ : a1; g1 = tk_ ? pg_ : g1; } } while (0)
    S128_K64(32); S128_K64(16); S128_K64(8); S128_K64(4); S128_K64(2); S128_K64(1);
    { const bool sw_ = a1 < a0; const int t_ = a0; const float tg_ = g0; a0 = sw_ ? a1 : a0; g0 = sw_ ? g1 : g0; a1 = sw_ ? t_ : a1; g1 = sw_ ? tg_ : g1; }
    S128_LANE_STAGE_TOP(32); S128_LANE_STAGE_TOP(16); S128_LANE_STAGE_TOP(8); S128_LANE_STAGE_TOP(4); S128_LANE_STAGE_TOP(2); S128_LANE_STAGE_TOP(1);
#undef S128_LANE_STAGE
#undef S128_LANE_STAGE_TOP
#undef S128_K64
}
typedef int v8i_t __attribute__((ext_vector_type(8)));
#define AP_SLOT(e) (4 * (((e) >> 1) & 3) + 2 * ((e) >> 3) + ((e) & 1))
__device__ __forceinline__ void apply_phase(Frame& F, float* OUTP) {
    const unsigned char* U8 = F.ws + WS_LG; const unsigned char* V8 = F.ws + WS_LG + DM / 2;
    const float* USC = (const float*)(F.ws + WS_LG + 16 * MiB); const float* VSC = USC + NEXP;
    const int* IDX = (const int*)(F.ws + WS_K); const float* GW = (const float*)(F.ws + WS_K + 16 * MiB);
    const float* g2 = F.in[20]; const float* gf = F.in[25];
    const bf16* X1B = (const bf16*)(F.ws + WS_XL);
    const int lane = F.lane, fr = lane & 15, fq = lane >> 4;
    constexpr int APW = 2 * 16 * 528 + 1024;
    LAS unsigned char* UL = F.lds + F.wave * APW; LAS unsigned char* VL = UL + 16 * 528; LAS unsigned char* H8 = VL + 16 * 528;
    const int pe = 2 * fq + (fr & 1) + 8 * ((fr >> 1) & 1);
    const int bsh = 8 * (fr & 3); const unsigned mlo = fr < 4 ? ~0u : 0u, mhi = (fr >= 4 && fr < 8) ? ~0u : 0u;
#define AP_LOADROWS(SEL, KB) _Pragma("unroll") for (int e = 0; e < 16; ++e) { \
        const size_t ro = (size_t)__builtin_amdgcn_readlane(SEL, ((KB) + e) & 63) * DM + lane * 16; uv[e] = *(const v4u*)(U8 + ro); }
    const unsigned uvb = (unsigned)((lane & 31) * 16); const bool isv = lane >= 32;
    for (int grp = F.bid; grp < MTOK / 128; grp += F.G) {
        const int mbase = grp * 128 + F.wave;
        int ni0 = IDX[(size_t)mbase * 128 + lane], ni1 = IDX[(size_t)mbase * 128 + 64 + lane];
        float ngw0 = GW[(size_t)mbase * 128 + lane], ngw1 = GW[(size_t)mbase * 128 + 64 + lane];
        f32x4 nxr[4];
#pragma unroll
        for (int q = 0; q < 4; ++q) { const v2u t = *(const v2u*)(X1B + (size_t)mbase * DM + lane * 16 + q * 4); nxr[q] = (f32x4){bflo(t.x), bfhi(t.x), bflo(t.y), bfhi(t.y)}; }
        sort128_by_index(ni0, ni1, ngw0, ngw1, lane);
        v4u uv[16];
        AP_LOADROWS(ni0, 0)
        int i0 = 0, i1 = 0; float gw0 = 0.f, gw1 = 0.f; f32x4 xr[4], oacc[8];
#pragma unroll
        for (int q = 0; q < 4; ++q) xr[q] = (f32x4){0.f, 0.f, 0.f, 0.f};
#pragma unroll
        for (int i = 0; i < 8; ++i) oacc[i] = (f32x4){0.f, 0.f, 0.f, 0.f};
#pragma unroll 1
        for (int it = 0; it < 128; ++it) {
            const int bt = it & 7, m = mbase + 8 * (it >> 3);
            if (bt == 0) {
                i0 = ni0; i1 = ni1; gw0 = ngw0; gw1 = ngw1; float s = 0.f;
#pragma unroll
                for (int q = 0; q < 4; ++q) { xr[q] = nxr[q]; s += (xr[q][0] * xr[q][0] + xr[q][1] * xr[q][1]) + (xr[q][2] * xr[q][2] + xr[q][3] * xr[q][3]); }
                const float r2 = rsqrtf(wave_sum(s) * (1.f / DM) + EPS);
                v4u h8;
#pragma unroll
                for (int q = 0; q < 4; ++q) { const f32x4 g = *(const f32x4*)(g2 + lane * 16 + q * 4); const f32x4 hq = xr[q] * r2 * g;
                    int pk = 0; pk = __builtin_amdgcn_cvt_pk_fp8_f32(hq[0], hq[1], pk, false); pk = __builtin_amdgcn_cvt_pk_fp8_f32(hq[2], hq[3], pk, true); h8[q] = (unsigned)pk; }
                *(LAS v4u*)(H8 + lane * 16) = h8;
#pragma unroll
                for (int i = 0; i < 8; ++i) oacc[i] = (f32x4){0.f, 0.f, 0.f, 0.f};
                const int mn = (it + 8 < 128) ? m + 8 : m;
                ni0 = IDX[(size_t)mn * 128 + lane]; ni1 = IDX[(size_t)mn * 128 + 64 + lane]; ngw0 = GW[(size_t)mn * 128 + lane]; ngw1 = GW[(size_t)mn * 128 + 64 + lane];
#pragma unroll
                for (int q = 0; q < 4; ++q) { const v2u t = *(const v2u*)(X1B + (size_t)mn * DM + lane * 16 + q * 4); nxr[q] = (f32x4){bflo(t.x), bfhi(t.x), bflo(t.y), bfhi(t.y)}; }
            }
            if (bt == 3) sort128_by_index(ni0, ni1, ngw0, ngw1, lane);
            const int k0 = bt * 16;
            const int isel = (k0 < 64) ? i0 : i1;
            const int myidx = __shfl(isel, (k0 + pe) & 63);
            const float su = USC[myidx], sv = VSC[myidx];
#pragma unroll
            for (int e = 0; e < 16; ++e) *(LAS v4u*)(UL + (isv ? 16 * 528 + e * 528 : AP_SLOT(e) * 528) + uvb) = uv[e];
            { const int nk = (k0 + 16) & 127; const int nsel = (bt == 7) ? ni0 : ((nk < 64) ? i0 : i1);
              AP_LOADROWS(nsel, nk) }
            f32x4 da = (f32x4){0.f, 0.f, 0.f, 0.f}, db = (f32x4){0.f, 0.f, 0.f, 0.f};
#pragma unroll
            for (int ks = 0; ks < 8; ++ks) {
                const v4u af = *(const LAS v4u*)(UL + fr * 528 + 64 * ks + 16 * fq);
                const v4u b0 = *(const LAS v4u*)(H8 + 128 * ks + 16 * fq), b1 = *(const LAS v4u*)(H8 + 128 * ks + 64 + 16 * fq);
                const v8i_t A = {(int)af.x, (int)af.y, (int)af.z, (int)af.w, 0, 0, 0, 0};
                const v8i_t B = {(int)b0.x, (int)b0.y, (int)b0.z, (int)b0.w, (int)b1.x, (int)b1.y, (int)b1.z, (int)b1.w};
                if (ks & 1) db = __builtin_amdgcn_mfma_scale_f32_16x16x128_f8f6f4(A, B, db, 4  , 0  , 0, 0x7F7F7F7F, 0, 0x7F7F7F7F);
                else        da = __builtin_amdgcn_mfma_scale_f32_16x16x128_f8f6f4(A, B, da, 4, 0, 0, 0x7F7F7F7F, 0, 0x7F7F7F7F);
            }
            const f32x4 d4 = da + db;
            const int sel = fr & 3;
            float t = d4[0]; t = (sel == 1) ? d4[1] : t; t = (sel == 2) ? d4[2] : t; t = (sel == 3) ? d4[3] : t;
            const float gk = __shfl((k0 < 64) ? gw0 : gw1, (k0 + pe) & 63);
            const float wl = gk * gelu_fast(t * su) * sv;
            float wm = fabsf(wl); wm = fmaxf(wm, __shfl_xor(wm, 1)); wm = fmaxf(wm, __shfl_xor(wm, 2)); wm = fmaxf(wm, __shfl_xor(wm, 16)); wm = fmaxf(wm, __shfl_xor(wm, 32));
            int E = (int)(__float_as_uint(wm) >> 23); E = E < 8 ? 8 : E;
            const float wq = wl * __uint_as_float((unsigned)(261 - E) << 23);
            const int scb = (E - 7) * 0x01010101;
            v8i_t Bw;
#define AP_WQ(tq, ctrl) { const float wt = __builtin_bit_cast(float, __builtin_amdgcn_update_dpp(0, __builtin_bit_cast(int, wq), ctrl, 0xf, 0xf, false)); \
                const unsigned p8 = (unsigned)__builtin_amdgcn_cvt_pk_fp8_f32(wt, 0.f, 0, false) << bsh; Bw[2 * tq] = (int)(p8 & mlo); Bw[2 * tq + 1] = (int)(p8 & mhi); }
            AP_WQ(0, 0x00) AP_WQ(1, 0x55) AP_WQ(2, 0xAA) AP_WQ(3, 0xFF)
#pragma unroll
            for (int c = 0; c < 8; ++c) {
                v4u av;
                av.x = *(const LAS unsigned*)(VL + (4 * fq + 0) * 528 + 64 * c + 4 * fr); av.y = *(const LAS unsigned*)(VL + (4 * fq + 1) * 528 + 64 * c + 4 * fr);
                av.z = *(const LAS unsigned*)(VL + (4 * fq + 2) * 528 + 64 * c + 4 * fr); av.w = *(const LAS unsigned*)(VL + (4 * fq + 3) * 528 + 64 * c + 4 * fr);
                const v8i_t A = {(int)av.x, (int)av.y, (int)av.z, (int)av.w, 0, 0, 0, 0};
                oacc[c] = __builtin_amdgcn_mfma_scale_f32_16x16x128_f8f6f4(A, Bw, oacc[c], 4, 0, 0, 0x7F7F7F7F, 0, scb);
            }
            if (bt == 7) {
                if (fr < 8) {
#pragma unroll
                    for (int c = 0; c < 8; ++c)
#pragma unroll
                        for (int r = 0; r < 4; ++r) { const float o = oacc[c][r]; *(LAS unsigned*)(UL + 4 * ((4 * c + fq) * 40 + 8 * r + fr)) = __float_as_uint(o); }
                }
                float s2 = 0.f; f32x4 ov[4];
#pragma unroll
                for (int q = 0; q < 4; ++q) { const v4u ou = *(const LAS v4u*)(UL + 4 * ((lane >> 1) * 40 + (lane & 1) * 16 + 4 * q));
                    ov[q] = (f32x4){__uint_as_float(ou.x), __uint_as_float(ou.y), __uint_as_float(ou.z), __uint_as_float(ou.w)} + xr[q];
                    s2 += (ov[q][0] * ov[q][0] + ov[q][1] * ov[q][1]) + (ov[q][2] * ov[q][2] + ov[q][3] * ov[q][3]); }
                const float rf = rsqrtf(wave_sum(s2) * (1.f / DM) + EPS);
#pragma unroll
                for (int q = 0; q < 4; ++q) { const f32x4 g = *(const f32x4*)(gf + lane * 16 + q * 4);
                    *(f32x4*)(OUTP + (size_t)m * DM + lane * 16 + q * 4) = ov[q] * rf * g; }
            }
        }
    }
}

constexpr int N_PHASES = 13;
__global__ void __launch_bounds__(NTHR, 2) mega_fwd(Args args) {
    extern __shared__ __attribute__((aligned(16))) unsigned char lds[];
    Frame F;
    F.lds = (LAS unsigned char*)lds;
    F.tid = threadIdx.x; F.lane = F.tid & 63; F.wave = __builtin_amdgcn_readfirstlane(F.tid >> 6);
    F.G = gridDim.x; F.bid = blockIdx.x;
    F.in = args.in; F.out = args.out; F.ws = args.ws;
    volatile LAS unsigned* MISC = (volatile LAS unsigned*)(F.lds + MISC_OFF);
    for (int u = F.tid; u < (LDS_BYTES - LDSCTL_OFF) / 4; u += NTHR) ((LAS unsigned*)(F.lds + LDSCTL_OFF))[u] = 0u;
    __syncthreads();
    XcdBarrier bar; bar.bar = (unsigned*)(args.ws + WS_CTL) + CW_BAR; bar.x = 0; bar.st = nullptr;
    const bool one_launch = (args.ph_hi - args.ph_lo) > 1;
    if (one_launch) bar = xcd_barrier_post((unsigned*)(args.ws + WS_CTL) + CW_BAR, MISC + 8);
    const int lo = args.ph_lo, hi = args.ph_hi;
#define IN(k) (lo <= (k) && (k) < hi)
#define SEAM(k) do { if (IN(k) && IN((k) + 1)) xcd_barrier(bar); } while (0)
    unsigned char* ws = args.ws;

#ifndef PROBE_MASK
#define PROBE_MASK 0
#endif
#define REP(k) _Pragma("unroll") for (int rep_ = 0; rep_ < (((PROBE_MASK >> (k)) & 1) ? 2 : 1); ++rep_)
    if (IN(0)) REP(0) { p0_prologue(F); if (rep_ == 0 && ((PROBE_MASK >> 0) & 1)) xcd_barrier(bar); } SEAM(0);
    if (IN(1)) REP(1) {
        { AddrP1 g{(const char*)(ws + WS_K), (const char*)(ws + WS_WIN), 1024, 1024, 1024, 4, 0, 0};
          pg8::StaticOrder S; S.init(MTOK, 1024, F.G, F.bid, 4);
          EpiBf16<DstP1> E{DstP1{ws, 4, 0, 0}, 1.f};
          pg8::gemm_phase(F.lds, g, S, E); }
        { AddrP1 g{(const char*)F.out, (const char*)(ws + WS_WIN8), 512, 512, 512, 20, 4, 4};
          pg8::StaticOrder S; S.init(MTOK, 5120, F.G, F.bid, 4);
          EpiBf16<DstP1, true> E{DstP1{ws, 20, 4, 4}, 1.f / 1024.f};
          pg8::gemm_phase<EpiBf16<DstP1, true>, AddrP1, 1>(F.lds, g, S, E); }
    } SEAM(1);
    if (IN(2)) REP(2) { lru_phase<false>(F); } SEAM(2);
    if (IN(3)) REP(3) { lru_phase<true>(F); if (F.G != 256) mconv_phase(F); } SEAM(3);
    if (IN(5)) REP(5) { if (F.G == 256) qkv_conv_phase(F); else qkv_phase(F);
    } SEAM(5);
    if (IN(6)) REP(6) { mscan_phase(F); } SEAM(6);
    if (IN(7)) { ym_phase(F); } SEAM(7);
    if (IN(8)) {
        pg8::StaticOrder S; S.init(MTOK, 1024, F.G, F.bid);
        AddrBranch g{(const char*)(ws + WS_OP), (long)((const char*)F.out - (const char*)(ws + WS_OP)), (const char*)(ws + WS_WB2), 1024, 1024, 1024};
        EpiMerge2 E{(bf16*)(ws + WS_XM), (const unsigned char*)(ws + WS_MG)};
        pg8::gemm_phase<EpiMerge2, AddrBranch, 0, true>(F.lds, g, S, E);
    } SEAM(8);
    if (IN(9)) {
        AddrPlain g{(const char*)(ws + WS_XM), (const char*)(ws + WS_WOUT2), 1024, 2048, 1024};
        pg8::StaticOrder S; S.init(MTOK, 1024, F.G, F.bid);
        EpiResid E{F.in[0], F.out, (bf16*)(ws + WS_XL), (float*)(ws + WS_SS)};
        pg8::gemm_phase(F.lds, g, S, E);
    } SEAM(9);
    if (IN(10)) REP(10) {
        AddrPlain g{(const char*)(ws + WS_XL), (const char*)(ws + WS_WPQ), 1024, 1024, 1024};
        pg8::StaticOrder S; S.init(MTOK, 2048, F.G, F.bid, 4);
        EpiPQ E{(bf16*)(ws + WS_MG), (const float*)(ws + WS_SS)};
        pg8::gemm_phase(F.lds, g, S, E);
    } SEAM(10);
    if (IN(11)) REP(11) { select_phase(F); }
    if (IN(11) && IN(12)) { asm volatile("s_waitcnt vmcnt(0)" ::: "memory"); __syncthreads(); }
    if (IN(12)) { if ((PROBE_MASK >> 12) & 1) { apply_phase(F, (float*)(ws + WS_MG)); xcd_barrier(bar); } apply_phase(F, F.out); }
#undef REP
#undef IN
#undef SEAM
}

extern "C" void kernel_launch(void* const* d_in, const int* in_sizes, int n_in, void* d_out, int out_size, void* d_ws, size_t ws_size, hipStream_t stream) {
    static int grid = 0;
    if (grid == 0) {
        if (n_in != 26 || in_sizes[0] != MTOK * DM || out_size != MTOK * DM || ws_size < WS_END) { fprintf(stderr, "kernel_launch: unexpected shapes / workspace (%zu < %zu)\n", ws_size, (size_t)WS_END); grid = -1; return; }
        int dev = 0, cus = 0, per_cu = 0;
        if (hipGetDevice(&dev) != hipSuccess || hipDeviceGetAttribute(&cus, hipDeviceAttributeMultiprocessorCount, dev) != hipSuccess) { grid = -1; return; }
        if (hipFuncSetAttribute((const void*)mega_fwd, hipFuncAttributeMaxDynamicSharedMemorySize, LDS_BYTES) != hipSuccess) { fprintf(stderr, "kernel_launch: hipFuncSetAttribute failed\n"); grid = -1; return; }
        if (hipOccupancyMaxActiveBlocksPerMultiprocessor(&per_cu, (const void*)mega_fwd, NTHR, LDS_BYTES) != hipSuccess || per_cu < 1) { fprintf(stderr, "kernel_launch: occupancy query says %d blocks/CU\n", per_cu); (void)hipGetLastError(); grid = -1; return; }
        grid = cus;
    }
    if (grid < 0) return;
    (void)hipMemsetAsync((char*)d_ws + WS_CTL + (size_t)CW_BAR * 4, 0, (size_t)XCD_BAR_WORDS * 4, stream);
    Args a{};
    for (int i = 0; i < 26; ++i) a.in[i] = (const float*)d_in[i];
    a.out = (float*)d_out; a.ws = (unsigned char*)d_ws;
#if MK_N_LAUNCHES == 1
    a.ph_lo = 0; a.ph_hi = N_PHASES;
    void* kargs[] = {&a};
    hipError_t e = hipLaunchCooperativeKernel((const void*)mega_fwd, dim3(grid), dim3(NTHR), kargs, LDS_BYTES, stream);
    if (e != hipSuccess) fprintf(stderr, "kernel_launch: cooperative launch failed: %s (grid %d)\n", hipGetErrorString(e), grid);
#else
    for (int p = 0; p < N_PHASES; ++p) { a.ph_lo = p; a.ph_hi = p + 1; hipLaunchKernelGGL(mega_fwd, dim3(grid), dim3(NTHR), LDS_BYTES, stream, a); }
#endif
}
```

```cpp
#include <hip/hip_runtime.h>
#include <cstdio>
#include <cstdint>
#include <math.h>

#ifndef MK_N_LAUNCHES
#define MK_N_LAUNCHES 1
#endif

constexpr int BATCH = 8, SEQ = 4096, DM = 1024, MTOK = BATCH * SEQ;
constexpr int DIN = 6160;
constexpr int NEXP = 16384;
constexpr float EPS = 1e-6f;

constexpr size_t MiB = 1u << 20;
constexpr size_t WS_CTL = 0, CTL_ZERO_BYTES = 1 * MiB;
constexpr size_t WS_WIN = 1 * MiB;
constexpr size_t WS_WQKV = 13 * MiB;
constexpr size_t WS_KEYS = 14 * MiB + 512 * 1024;
constexpr size_t WS_WLRU = 15 * MiB;
constexpr size_t WS_WB2 = 16 * MiB;
constexpr size_t WS_WOUT2 = 20 * MiB;
constexpr size_t WS_WPQ = 24 * MiB;
constexpr size_t WS_GATE = 28 * MiB;
constexpr size_t WS_WGT = 30 * MiB;
constexpr size_t WS_XM = 32 * MiB;
constexpr size_t WS_OP = 96 * MiB;
constexpr size_t WS_XL = 160 * MiB;
constexpr size_t WS_LG = 224 * MiB;
constexpr size_t WS_MG = 288 * MiB;
constexpr size_t WS_K = 416 * MiB;
constexpr size_t WS_AGG = 480 * MiB;
constexpr size_t WS_SS = 488 * MiB;
constexpr size_t WS_WIN8 = 489 * MiB;
constexpr size_t WS_TAB = 495 * MiB;
constexpr size_t WS_END = 512 * MiB;

constexpr int CW_BAR = 4096;

constexpr int RING_BYTES = 131072;
constexpr int LDS_BYTES = 147456;
constexpr int LDSCTL_OFF = LDS_BYTES - 512, MISC_OFF = LDSCTL_OFF + 320;
constexpr int NWAVES = 8, NTHR = 512;

#define GAS __attribute__((address_space(1)))
#define LAS __attribute__((address_space(3)))
typedef unsigned short bf16;
typedef unsigned v4u __attribute__((ext_vector_type(4)));
typedef unsigned v2u __attribute__((ext_vector_type(2)));
typedef float f32x4 __attribute__((ext_vector_type(4)));
typedef float f32x2 __attribute__((ext_vector_type(2)));
typedef short bf16x8 __attribute__((ext_vector_type(8)));
typedef GAS unsigned gu32;
#define RLX_AGENT __ATOMIC_RELAXED, __HIP_MEMORY_SCOPE_AGENT
#define LDS_WAIT() asm volatile("s_waitcnt lgkmcnt(0)" ::: "memory")
#define VM_WAIT() asm volatile("s_waitcnt vmcnt(0)" ::: "memory")

typedef __bf16 hwbf16x2_t __attribute__((ext_vector_type(2)));
__device__ __forceinline__ unsigned f2bf(float f) { return (unsigned)__builtin_bit_cast(unsigned short, (__bf16)f); }
__device__ __forceinline__ unsigned pk2(float lo, float hi) { typedef float f2_ __attribute__((ext_vector_type(2))); return __builtin_bit_cast(unsigned, __builtin_convertvector((f2_){lo, hi}, hwbf16x2_t)); }
__device__ __forceinline__ float bf2f(unsigned short h) { return __builtin_bit_cast(float, (unsigned)h << 16); }
__device__ __forceinline__ float bflo(unsigned w) { return __builtin_bit_cast(float, w << 16); }
__device__ __forceinline__ float bfhi(unsigned w) { return __builtin_bit_cast(float, w & 0xffff0000u); }
__device__ __forceinline__ float wave_sum(float v) {
#pragma unroll
  for (int o = 1; o < 64; o <<= 1) v += __shfl_xor(v, o);
  return v;
}
__device__ __forceinline__ float sigmoidf_(float x) { return __builtin_amdgcn_rcpf(1.f + __builtin_amdgcn_exp2f(x * -1.44269504089f)); }
__device__ __forceinline__ float gelu_erf(float x) { return 0.5f * x * (1.f + erff(x * 0.70710678118654752f)); }
__device__ __forceinline__ float gelu_fast(float v) {
    const float av = fabsf(v), t = __builtin_amdgcn_rcpf(av * 0.2316418882f + 1.0f);
    float q = t * 0.5307027145f + (-0.7265760135f); q = q * t + 0.7107068705f; q = q * t + (-0.142248368f); q = q * t + 0.127414796f; q = q * t;
    const float e = __builtin_amdgcn_exp2f((v * v) * (-0.72134752044f));
    const float m = v * (q * e);
    return v < 0.f ? m : v - m;
}
__device__ __forceinline__ float softplusf_(float x) { return fmaxf(x, 0.f) + log1pf(expf(-fabsf(x))); }

namespace pg8 {
#define PG8_LAS __attribute__((address_space(3)))
typedef unsigned short bf16_t;
typedef unsigned u32x4 __attribute__((ext_vector_type(4)));
typedef int i32x4_t __attribute__((ext_vector_type(4)));
constexpr int BM = 256, BK = 64, HALF = 128, HTB = HALF * BK * 2, STAGE_BYTES = 8 * HTB, NXCD = 8;

__host__ __device__ __forceinline__ int lds_byte(int r, int c) { const int st = (r >> 4) * 2 + (c >> 5), rr = r & 15, cc = c & 31, ob = rr * 64 + cc * 2; return st * 1024 + (ob ^ (((ob >> 9) & 1) << 5)); }
__host__ __device__ __forceinline__ void stage_rc(int b, int& R, int& C) { const int st = b / 1024, sb = b % 1024, swz = sb ^ (((sb >> 9) & 1) << 5); R = (st >> 1) * 16 + swz / 64; C = (st & 1) * 32 + (swz % 64) / 2; }
__host__ __device__ __forceinline__ int perm32(int rho) { const int n = rho >> 4, i = rho & 15; return 8 * (i >> 2) + 4 * n + (i & 3); }

struct Unit { int pm, pn; };
struct StaticOrder {
    int nM, nN, nwg, G, c, WGM;
    __host__ __device__ void init(int M, int N, int G_, int c_, int wgm = 8) { nM = M / BM; nN = N / BM; nwg = nM * nN; G = G_; c = c_; WGM = wgm; }
    __host__ __device__ bool next(int i, Unit& u) const {
        const long L = (long)i * G + c; if (L >= nwg) return false;
        int wgid = (int)L; { const int q = nwg / NXCD, r = nwg % NXCD, xcd = wgid % NXCD, off = wgid / NXCD; wgid = (xcd < r ? xcd * (q + 1) : r * (q + 1) + (xcd - r) * q) + off; }
        const int nig = WGM * nN, gid = wgid / nig, fm = gid * WGM, gsz = (nM - fm) < WGM ? (nM - fm) : WGM;
        u.pm = fm + ((wgid % nig) % gsz); u.pn = (wgid % nig) / gsz; return true;
    }
};

__device__ __forceinline__ unsigned cvt_pk_bf16(float lo, float hi) { unsigned r; asm volatile("v_cvt_pk_bf16_f32 %0, %1, %2" : "=v"(r) : "v"(lo), "v"(hi)); return r; }

template <class Epi, class Addr, int F8SC = 0, bool TWOPASS = false>
__device__ __forceinline__ void gemm_phase(PG8_LAS unsigned char* lds, const Addr g, const StaticOrder& S, const Epi& E) {
    const int tid = threadIdx.x, wid = __builtin_amdgcn_readfirstlane(tid >> 6), lane = tid & 63, wr = wid >> 2, wc = wid & 3, fr = lane & 15, fq = lane >> 4;
    const int K = g.K, nt = K / BK;
    unsigned voffA[2], voffB[2];
#pragma unroll
    for (int i = 0; i < 2; ++i) { int R, C; stage_rc(tid * 16 + i * 8192, R, C); const int Rb = Epi::PERM ? ((R & ~31) + perm32(R & 31)) : R;
        voffA[i] = (unsigned)(R * g.lda + C) * 2u; voffB[i] = (unsigned)(Rb * g.ldb + C) * 2u; }
    const size_t kstep = (size_t)(BK * 2);
    const size_t hsA = (size_t)HALF * g.lda * 2, hsB = (size_t)HALF * g.ldb * 2;
    const unsigned ldsw = (unsigned)wid * 1024u;
    const int aoff = lds_byte(wr * 64 + fr, fq * 8), boff = lds_byte(wc * 32 + fr, fq * 8);
#define PG8_SA(b, h) (((b) * 2 + (h)) * HTB)
#define PG8_SB(b, h) ((4 + (b) * 2 + (h)) * HTB)
#define PG8_STAGE(bufoff, gbase, voff) do { _Pragma("unroll") for (int _i = 0; _i < 2; ++_i) \
        __builtin_amdgcn_global_load_lds((const unsigned*)((const char*)(gbase) + (voff)[_i]), (PG8_LAS unsigned*)(lds + (bufoff) + ldsw + _i * 8192), 16, 0, 0); } while (0)
#define PG8_LDA(dst, b, h) do { _Pragma("unroll") for (int m = 0; m < 4; ++m) _Pragma("unroll") for (int k = 0; k < 2; ++k) dst[m][k] = *(const PG8_LAS bf16x8*)(lds + PG8_SA(b, h) + aoff + m * 2048 + k * 1024); } while (0)
#define PG8_LDB(dst, b, h) do { _Pragma("unroll") for (int n = 0; n < 2; ++n) _Pragma("unroll") for (int k = 0; k < 2; ++k) dst[n][k] = *(const PG8_LAS bf16x8*)(lds + PG8_SB(b, h) + boff + n * 2048 + k * 1024); } while (0)
#define PG8_CAT(x0, x1) __builtin_shufflevector(__builtin_bit_cast(i32x4_t, x0), __builtin_bit_cast(i32x4_t, x1), 0, 1, 2, 3, 4, 5, 6, 7)
#define PG8_MMA(ai, bj, At, Bt) do { __builtin_amdgcn_s_setprio(1); \
        if constexpr (F8SC != 0) { _Pragma("unroll") for (int m = 0; m < 4; ++m) _Pragma("unroll") for (int n = 0; n < 2; ++n) \
            asm volatile("v_mfma_f32_16x16x128_f8f6f4 %0, %1, %2, %0" : "+v"(acc[ai][bj][m][n]) : "v"(PG8_CAT(Bt[n][0], Bt[n][1])), "v"(PG8_CAT(At[m][0], At[m][1]))); } \
        else { _Pragma("unroll") for (int m = 0; m < 4; ++m) _Pragma("unroll") for (int n = 0; n < 2; ++n) _Pragma("unroll") for (int k = 0; k < 2; ++k) \
            acc[ai][bj][m][n] = __builtin_amdgcn_mfma_f32_16x16x32_bf16(Bt[n][k], At[m][k], acc[ai][bj][m][n], 0, 0, 0); } \
        __builtin_amdgcn_s_setprio(0); } while (0)
#define PG8_WAIT_V(n) asm volatile("s_waitcnt vmcnt(" #n ")" ::: "memory")
#define PG8_WAIT_L(n) asm volatile("s_waitcnt lgkmcnt(" #n ")" ::: "memory")
#define PG8_BAR __builtin_amdgcn_s_barrier()
#define PG8_SCHED __builtin_amdgcn_sched_barrier(0)
    Unit cur, nxt; int ui = 0;
    auto nextu = [&](int i, Unit& u) -> bool { if constexpr (TWOPASS) { if (!S.next(i >> 1, u)) return false; if (i & 1) u.pn += 4; return true; } else return S.next(i, u); };
    if (!nextu(0, cur)) return;
    f32x4 acc[2][2][4][2];
#pragma unroll
    for (int a = 0; a < 2; ++a)
#pragma unroll
        for (int b = 0; b < 2; ++b)
#pragma unroll
            for (int m = 0; m < 4; ++m)
#pragma unroll
                for (int n = 0; n < 2; ++n) acc[a][b][m][n] = (f32x4){0.f, 0.f, 0.f, 0.f};
    bf16x8 At[4][2], B0[2][2], B1[2][2];
    const char* cA = g.a(cur); const char* cB = g.b(cur);
    PG8_STAGE(PG8_SB(0, 0), cB, voffB); PG8_STAGE(PG8_SB(0, 1), cB + hsB, voffB); PG8_STAGE(PG8_SA(0, 0), cA, voffA); PG8_STAGE(PG8_SA(0, 1), cA + hsA, voffA);
    if (wr == 1) PG8_BAR;
    PG8_WAIT_V(2); PG8_BAR;
    PG8_STAGE(PG8_SB(1, 0), cB + kstep, voffB); PG8_STAGE(PG8_SA(1, 0), cA + kstep, voffA); PG8_STAGE(PG8_SB(1, 1), cB + hsB + kstep, voffB);
    PG8_WAIT_V(6); PG8_BAR;
    for (;;) {
        const bool has_next = nextu(ui + 1, nxt);
        const char* nA = has_next ? g.a(nxt) : cA; const char* nB = has_next ? g.b(nxt) : cB;
#pragma unroll 1
        for (int t = 0; t < nt; t += 2) {
            const bool last = (t == nt - 2);
            const char* a1 = cA + (size_t)(t + 1) * kstep;
            const char* a2 = last ? nA : cA + (size_t)(t + 2) * kstep; const char* b2 = last ? nB : cB + (size_t)(t + 2) * kstep;
            const char* a3 = a2 + kstep; const char* b3 = b2 + kstep;
            PG8_LDB(B0, 0, 0); PG8_LDB(B1, 0, 1); PG8_SCHED; PG8_LDA(At, 0, 0); PG8_STAGE(PG8_SA(1, 1), a1 + hsA, voffA);
            PG8_WAIT_V(8); PG8_WAIT_L(0); PG8_BAR; PG8_MMA(0, 0, At, B0); PG8_MMA(0, 1, At, B1); PG8_BAR; PG8_SCHED;
            PG8_LDA(At, 0, 1); PG8_STAGE(PG8_SB(0, 0), b2, voffB); PG8_STAGE(PG8_SB(0, 1), b2 + hsB, voffB); PG8_STAGE(PG8_SA(0, 0), a2, voffA);
            PG8_WAIT_V(8); PG8_WAIT_L(0); PG8_BAR; PG8_MMA(1, 0, At, B0); PG8_MMA(1, 1, At, B1); PG8_BAR; PG8_SCHED;
            PG8_LDB(B0, 1, 0); PG8_LDB(B1, 1, 1); PG8_SCHED; PG8_LDA(At, 1, 0); PG8_STAGE(PG8_SA(0, 1), a2 + hsA, voffA);
            PG8_WAIT_V(8); PG8_WAIT_L(0); PG8_BAR; PG8_MMA(0, 0, At, B0); PG8_MMA(0, 1, At, B1); PG8_BAR; PG8_SCHED;
            PG8_LDA(At, 1, 1); PG8_STAGE(PG8_SB(1, 0), b3, voffB); PG8_STAGE(PG8_SB(1, 1), b3 + hsB, voffB); PG8_STAGE(PG8_SA(1, 0), a3, voffA);
            PG8_WAIT_V(8); PG8_WAIT_L(0); PG8_BAR; PG8_MMA(1, 0, At, B0); PG8_MMA(1, 1, At, B1); PG8_BAR; PG8_SCHED;
        }
        if constexpr (F8SC != 0) asm volatile("s_nop 15\n\ts_nop 15" ::: "memory");
        if (wr == 0) PG8_BAR;
        bool keep = false;
        if constexpr (TWOPASS) { if (!(ui & 1)) { E.mid(acc, cur, wr, wc, fr, fq); keep = true; } }
        if (!keep) E(acc, cur, wr, wc, fr, fq);
        if (!has_next) break;
        if (!keep) {
#pragma unroll
        for (int a = 0; a < 2; ++a)
#pragma unroll
            for (int b = 0; b < 2; ++b)
#pragma unroll
                for (int m = 0; m < 4; ++m)
#pragma unroll
                    for (int n = 0; n < 2; ++n) acc[a][b][m][n] = (f32x4){0.f, 0.f, 0.f, 0.f};
        }
        cur = nxt; cA = nA; cB = nB; ++ui;
        if (wr == 1) PG8_BAR;
    }
    PG8_WAIT_V(0);
    PG8_BAR;
#undef PG8_SA
#undef PG8_SB
#undef PG8_STAGE
#undef PG8_LDA
#undef PG8_LDB
#undef PG8_MMA
#undef PG8_CAT
#undef PG8_WAIT_V
#undef PG8_WAIT_L
#undef PG8_BAR
#undef PG8_SCHED
}
}

#define XB_TMO      128
#define XB_XCNT(j)  (256  + 64 * (j))
#define XB_XSUB(j)  (1280 + 64 * (j))
#define XB_XGEN(j)  (2304 + 64 * (j))
#define XB_TOP      3328
#define XB_TOPGEN   3392
#define XCD_BAR_WORDS 3456
#define XB_SPIN_CAP (1u << 18)
__device__ __forceinline__ unsigned xb_ld(unsigned* p)              { return __hip_atomic_load(p, __ATOMIC_RELAXED, __HIP_MEMORY_SCOPE_AGENT); }
__device__ __forceinline__ unsigned xb_add(unsigned* p, unsigned v) { return __hip_atomic_fetch_add(p, v, __ATOMIC_RELAXED, __HIP_MEMORY_SCOPE_AGENT); }
__device__ __forceinline__ unsigned xb_xcc_id() { return (unsigned)__builtin_amdgcn_s_getreg((3 << 11) | 20) & 0xFu; }
#define XB_SPIN(cond, bar) do { unsigned _sp = 0; while (cond) { __builtin_amdgcn_s_sleep(1); \
    if ((++_sp & 255u) == 0u) { if (xb_ld(&(bar)[XB_TMO])) break; if (_sp > XB_SPIN_CAP) { atomicAdd(&(bar)[XB_TMO], 1u); break; } } } } while (0)
struct XcdBarrier { unsigned* bar; unsigned x; volatile LAS unsigned* st; };
__device__ __forceinline__ XcdBarrier xcd_barrier_post(unsigned* bar, volatile LAS unsigned* st) {
    XcdBarrier b; b.bar = bar; b.x = xb_xcc_id(); b.st = st;
    if (threadIdx.x == 0) (void)xb_add(&bar[XB_XCNT(b.x)], 1u);
    return b;
}
__device__ __forceinline__ void xcd_barrier_complete(unsigned* bar, unsigned x, unsigned& nloc, unsigned& nx) {
    const unsigned G = gridDim.x * gridDim.y * gridDim.z;
    unsigned sum, cnt, mine, sp = 0u;
    for (;;) {
        sum = 0u; cnt = 0u; mine = 0u;
#pragma unroll
        for (unsigned j = 0; j < 16; ++j) { const unsigned c = xb_ld(&bar[XB_XCNT(j)]); sum += c; cnt += (c > 0u) ? 1u : 0u; mine = (j == x) ? c : mine; }
        if (sum == G) break;
        __builtin_amdgcn_s_sleep(1);
        if ((++sp & 255u) == 0u) { if (xb_ld(&bar[XB_TMO])) break; if (sp > XB_SPIN_CAP) { atomicAdd(&bar[XB_TMO], 1u); break; } }
    }
    nloc = mine > 0u ? mine : 1u; nx = cnt > 0u ? cnt : 1u;
}
__device__ __forceinline__ void xcd_barrier(const XcdBarrier& b) {
    asm volatile("s_waitcnt vmcnt(0)" ::: "memory");
    __syncthreads();
    if (threadIdx.x == 0) {
        unsigned* bar = b.bar;
        __builtin_amdgcn_s_waitcnt(0);
        unsigned nloc = b.st[0], nx = b.st[1];
        if (nloc == 0u) { xcd_barrier_complete(bar, b.x, nloc, nx); b.st[0] = nloc; b.st[1] = nx; }
        const unsigned old = xb_add(&bar[XB_XSUB(b.x)], 1u);
        const unsigned gen = old / nloc;
        if (old + 1u == (gen + 1u) * nloc) {
            __builtin_amdgcn_fence(__ATOMIC_RELEASE, "agent");
            asm volatile("s_waitcnt vmcnt(0)" ::: "memory");
            const unsigned og = xb_add(&bar[XB_TOP], 1u);
            const unsigned tg = og / nx;
            if (og + 1u == (tg + 1u) * nx) xb_add(&bar[XB_TOPGEN], 1u);
            else XB_SPIN(xb_ld(&bar[XB_TOPGEN]) == tg, bar);
            __builtin_amdgcn_fence(__ATOMIC_ACQUIRE, "agent");
            xb_add(&bar[XB_XGEN(b.x)], 1u);
            asm volatile("s_waitcnt vmcnt(0)" ::: "memory");
        } else {
            XB_SPIN(xb_ld(&bar[XB_XGEN(b.x)]) == gen, bar);
            __builtin_amdgcn_fence(__ATOMIC_ACQUIRE, "agent");
            asm volatile("s_waitcnt vmcnt(0)" ::: "memory");
        }
    }
    __syncthreads();
}

struct Args { const float* in[26]; float* out; unsigned char* ws; int ph_lo, ph_hi; };
struct Frame {
    LAS unsigned char* lds;
    int tid, lane, wave, G, bid;
    const float* const* in; float* out; unsigned char* ws;
};

template <bool F8 = false> __device__ __forceinline__ void tr_item(const float* W, int ldw, bf16* WT, int ldt, float scale, const float* kscale, LAS float* scr, int k0, int lane) {
    f32x4 tv[8];
#pragma unroll
    for (int i = 0; i < 8; ++i) tv[i] = *(const f32x4*)(W + (size_t)(k0 + 8 * i + (lane >> 3)) * ldw + 4 * (lane & 7));
#pragma unroll
    for (int i = 0; i < 8; ++i) { const int kk = 8 * i + (lane >> 3); float sc = scale; if (kscale) sc *= kscale[k0 + kk];
        LAS float* d = scr + kk * 33 + 4 * (lane & 7); d[0] = tv[i][0] * sc; d[1] = tv[i][1] * sc; d[2] = tv[i][2] * sc; d[3] = tv[i][3] * sc; }
    LDS_WAIT(); asm volatile("" ::: "memory");
    const int c = lane & 7;
#pragma unroll
    for (int j = 0; j < 4; ++j) { const int n = (lane >> 3) + 8 * j; const LAS float* s = scr + (8 * c) * 33 + n;
        if constexpr (F8) {
            int p0 = 0, p1 = 0; p0 = __builtin_amdgcn_cvt_pk_fp8_f32(s[0 * 33], s[1 * 33], p0, false); p0 = __builtin_amdgcn_cvt_pk_fp8_f32(s[2 * 33], s[3 * 33], p0, true);
            p1 = __builtin_amdgcn_cvt_pk_fp8_f32(s[4 * 33], s[5 * 33], p1, false); p1 = __builtin_amdgcn_cvt_pk_fp8_f32(s[6 * 33], s[7 * 33], p1, true);
            *(GAS v2u*)((GAS unsigned char*)WT + (size_t)n * ldt + k0 + 8 * c) = (v2u){(unsigned)p0, (unsigned)p1};
        } else {
        v4u o; o.x = pk2(s[0 * 33], s[1 * 33]); o.y = pk2(s[2 * 33], s[3 * 33]); o.z = pk2(s[4 * 33], s[5 * 33]); o.w = pk2(s[6 * 33], s[7 * 33]);
        *(GAS v4u*)(WT + (size_t)n * ldt + k0 + 8 * c) = o; } }
    LDS_WAIT(); asm volatile("" ::: "memory");
}

__device__ __forceinline__ void p0_prologue(Frame& F) {
    LAS float* scr = (LAS float*)(F.lds + F.wave * 16384);
    const int gw = F.bid * NWAVES + F.wave, NGW = F.G * NWAVES;
    unsigned char* ws = F.ws;
    const float* w_in = F.in[2];
    constexpr int I_WIN = 16 * 192, I_QKV = 12 * 32, I_LRU = 32 * 8, I_WB = 2 * 512, I_WO = 512, I_PQ = 16 * 64;
    constexpr int NITEMS = I_WIN + I_QKV + I_LRU + I_WB + I_WO + I_PQ;
    for (int it = gw; it < NITEMS; it += NGW) {
        int r = it;
        if (r < I_WIN) { const int kb = r / 192, nb = r % 192, n0 = nb * 32, sc = n0 < 2048 ? n0 : n0 + 16;
            if (n0 >= 1024) tr_item<true>(w_in + sc, DIN, (bf16*)(ws + WS_WIN8 + (size_t)n0 * 1024), 1024, 1024.f, nullptr, scr, kb * 64, F.lane);
            else tr_item(w_in + sc, DIN, (bf16*)(ws + WS_WIN) + (size_t)n0 * 1024, 1024, 1.f, nullptr, scr, kb * 64, F.lane);
            continue; }
        r -= I_WIN;
        if (r < I_QKV) { const int mat = r / 32, rr = r % 32, kb = rr / 8, nb = rr % 8, g = mat >> 2, h = mat & 3;
            const float* W = F.in[6 + g] + (size_t)h * 65536 + nb * 32;
            tr_item(W, 256, (bf16*)(ws + WS_WQKV) + (size_t)mat * 65536 + (size_t)(nb * 32) * 256, 256, g == 1 ? 0.0625f : 1.f, nullptr, scr, kb * 64, F.lane); continue; }
        r -= I_QKV;
        if (r < I_LRU) { const int mat = r / 8, rr = r % 8, kb = rr / 4, nb = rr % 4, gate = mat & 1, db = mat >> 1;
            const float* W = F.in[gate ? 14 : 12] + (size_t)db * 16384 + nb * 32;
            tr_item(W, 128, (bf16*)(ws + WS_WLRU) + (size_t)mat * 16384 + (size_t)(nb * 32) * 128, 128, 1.f, nullptr, scr, kb * 64, F.lane); continue; }
        r -= I_LRU;
        if (r < I_WB) { const int mat = r / 512, rr = r % 512, kb = rr / 32, nb = rr % 32;
            const float* W = F.in[17 + mat] + nb * 32;
            tr_item(W, 1024, (bf16*)(ws + WS_WB2) + (size_t)(mat * 1024 + nb * 32) * 1024, 1024, 1.f, nullptr, scr, kb * 64, F.lane); continue; }
        r -= I_WB;
        if (r < I_WO) { const int cp = 0, rr = r, kb = rr / 32, nb = rr % 32;
            const float* W = F.in[19] + nb * 32;
            tr_item(W, 1024, (bf16*)(ws + WS_WOUT2) + (size_t)(nb * 32) * 2048 + cp * 1024, 2048, 1.f, nullptr, scr, kb * 64, F.lane); continue; }
        r -= I_WO;
        {
            const int hp = r >> 6, d0 = (r & 63) * 16, fr = F.lane & 15, fq = F.lane >> 4;
            const float* wq = F.in[21] + (size_t)(d0 + fr) * 2048 + hp * 128 + 8 * fq; const float g = F.in[20][d0 + fr];
            bf16x8 af[4];
#pragma unroll
            for (int ks = 0; ks < 4; ++ks) { const f32x4 a = *(const f32x4*)(wq + 32 * ks) * g, b = *(const f32x4*)(wq + 32 * ks + 4) * g;
                v4u o; o.x = pk2(a[0], a[1]); o.y = pk2(a[2], a[3]); o.z = pk2(b[0], b[1]); o.w = pk2(b[2], b[3]); af[ks] = __builtin_bit_cast(bf16x8, o); }
            const float* kp = F.in[22] + (size_t)hp * 16384 + fr * 128 + 8 * fq;
            bf16* wt = (bf16*)(ws + WS_WPQ) + (size_t)(hp * 128 + fr) * 1024 + d0 + 4 * fq;
#pragma unroll 2
            for (int nt = 0; nt < 8; ++nt) { f32x4 acc = (f32x4){0.f, 0.f, 0.f, 0.f};
#pragma unroll
                for (int ks = 0; ks < 4; ++ks) { const f32x4 a = *(const f32x4*)(kp + nt * 2048 + 32 * ks), b = *(const f32x4*)(kp + nt * 2048 + 32 * ks + 4);
                    v4u o; o.x = pk2(a[0], a[1]); o.y = pk2(a[2], a[3]); o.z = pk2(b[0], b[1]); o.w = pk2(b[2], b[3]);
                    acc = __builtin_amdgcn_mfma_f32_16x16x32_bf16(af[ks], __builtin_bit_cast(bf16x8, o), acc, 0, 0, 0); }
                *(v2u*)(wt + (size_t)nt * 16 * 1024) = (v2u){pk2(acc[0], acc[1]), pk2(acc[2], acc[3])}; } }
    }
    __syncthreads();
    for (int i = 0; i < 32; ++i) { const int idx = F.tid + NTHR * i, c = idx & 15, k = idx >> 4; ((LAS unsigned short*)F.lds)[c * 1032 + k] = (unsigned short)f2bf(w_in[(size_t)k * DIN + 2048 + c]); }
    __syncthreads();
    { const int gt = F.bid * NTHR + F.tid, NGT = F.G * NTHR;
      float* ss = (float*)(ws + WS_SS);
      for (int i = gt; i < MTOK; i += NGT) ss[i] = 0.f; }
    const float* x = F.in[0]; const float* g1 = F.in[1];
    bf16* XN = (bf16*)(ws + WS_K);
    unsigned char* XN8 = (unsigned char*)F.out;
    f32x4 gv[4];
#pragma unroll
    for (int j = 0; j < 4; ++j) gv[j] = ((const f32x4*)g1)[F.lane + 64 * j];
    for (int m = 16 * gw; m < MTOK; m += 16 * NGW)
    for (int mm = m; mm < m + 16; mm += 2) {
        const f32x4* xr0 = (const f32x4*)(x + (size_t)mm * DM) + F.lane; const f32x4* xr1 = xr0 + DM / 4;
        f32x4 v0[4], v1[4]; float s0 = 0.f, s1 = 0.f;
#pragma unroll
        for (int j = 0; j < 4; ++j) { v0[j] = xr0[64 * j]; v1[j] = xr1[64 * j]; }
#pragma unroll
        for (int j = 0; j < 4; ++j) { s0 += (v0[j].x * v0[j].x + v0[j].y * v0[j].y) + (v0[j].z * v0[j].z + v0[j].w * v0[j].w); s1 += (v1[j].x * v1[j].x + v1[j].y * v1[j].y) + (v1[j].z * v1[j].z + v1[j].w * v1[j].w); }
        const float r0 = rsqrtf(wave_sum(s0) * (1.f / DM) + EPS), r1 = rsqrtf(wave_sum(s1) * (1.f / DM) + EPS);
        unsigned long long* o0 = (unsigned long long*)(XN + (size_t)mm * DM) + F.lane; unsigned long long* o1 = o0 + DM / 4;
        unsigned* q0 = (unsigned*)(XN8 + (size_t)mm * DM) + F.lane; unsigned* q1 = q0 + DM / 4;
#pragma unroll
        for (int j = 0; j < 4; ++j) { const f32x4 a = v0[j] * r0 * gv[j], c = v1[j] * r1 * gv[j];
            o0[64 * j] = (unsigned long long)pk2(a.x, a.y) | ((unsigned long long)pk2(a.z, a.w) << 32);
            o1[64 * j] = (unsigned long long)pk2(c.x, c.y) | ((unsigned long long)pk2(c.z, c.w) << 32);
            int pa = 0, pc = 0; pa = __builtin_amdgcn_cvt_pk_fp8_f32(a.x, a.y, pa, false); pa = __builtin_amdgcn_cvt_pk_fp8_f32(a.z, a.w, pa, true);
            pc = __builtin_amdgcn_cvt_pk_fp8_f32(c.x, c.y, pc, false); pc = __builtin_amdgcn_cvt_pk_fp8_f32(c.z, c.w, pc, true);
            q0[64 * j] = (unsigned)pa; q1[64 * j] = (unsigned)pc; }
    }
    VM_WAIT();
    { const int lane = F.lane, fr = lane & 15, fq = lane >> 4; float* GT = (float*)(ws + WS_GATE);
      const f32x4 bg4 = *(const f32x4*)(F.in[3] + 4 * fq);
      for (int m0 = 16 * gw; m0 < MTOK; m0 += 16 * NGW) {
          f32x4 acc = (f32x4){0.f, 0.f, 0.f, 0.f};
#pragma unroll 8
          for (int ks = 0; ks < 32; ++ks) {
              const bf16x8 wfr = *(const LAS bf16x8*)(F.lds + fr * 2064 + (32 * ks + 8 * fq) * 2);
              const bf16x8 xfr = *(const bf16x8*)(XN + (size_t)(m0 + fr) * DM + 32 * ks + 8 * fq);
              acc = __builtin_amdgcn_mfma_f32_16x16x32_bf16(wfr, xfr, acc, 0, 0, 0);
          }
          *(f32x4*)(GT + (size_t)(m0 + fr) * 16 + 4 * fq) = acc + bg4;
      } }
}
__device__ __forceinline__ void gates_phase(Frame& F) {
    const bf16* XN = (const bf16*)(F.ws + WS_K); const bf16* WGT = (const bf16*)(F.ws + WS_WGT); float* GT = (float*)(F.ws + WS_GATE);
    const int lane = F.lane, fr = lane & 15, fq = lane >> 4;
    const f32x4 bg4 = *(const f32x4*)(F.in[3] + 4 * fq);
    for (int task = F.bid * NWAVES + F.wave; task < MTOK / 16; task += F.G * NWAVES) {
        const size_t m0 = (size_t)task * 16;
        f32x4 acc = (f32x4){0.f, 0.f, 0.f, 0.f};
#pragma unroll 8
        for (int ks = 0; ks < 32; ++ks) {
            const bf16x8 wfr = *(const bf16x8*)(WGT + fr * 1024 + 32 * ks + 8 * fq);
            const bf16x8 xfr = *(const bf16x8*)(XN + (m0 + fr) * DM + 32 * ks + 8 * fq);
            acc = __builtin_amdgcn_mfma_f32_16x16x32_bf16(wfr, xfr, acc, 0, 0, 0);
        }
        *(f32x4*)(GT + (m0 + fr) * 16 + 4 * fq) = acc + bg4;
    }
}

struct AddrPlain {
    const char* A; const char* Bt; int lda, ldb, K;
    __device__ __forceinline__ const char* a(const pg8::Unit& u) const { return A + (size_t)u.pm * 256 * lda * 2; }
    __device__ __forceinline__ const char* b(const pg8::Unit& u) const { return Bt + (size_t)u.pn * 256 * ldb * 2; }
};
struct AddrP1 {
    const char* A; const char* Bt; int lda, ldb, K, thr, lo_add, hi_add;
    __device__ __forceinline__ const char* a(const pg8::Unit& u) const { return A + (size_t)u.pm * 256 * lda * 2; }
    __device__ __forceinline__ const char* b(const pg8::Unit& u) const { return Bt + (size_t)(u.pn + (u.pn < thr ? lo_add : hi_add)) * 256 * ldb * 2; }
};
struct AddrQKV {
    const char* XC; long dXM; const char* W; int lda, ldb, K;
    __device__ __forceinline__ const char* a(const pg8::Unit& u) const { return XC + (u.pn < 8 ? 0l : dXM) + ((size_t)u.pm * 256 * 1024 + (u.pn & 3) * 256) * 2; }
    __device__ __forceinline__ const char* b(const pg8::Unit& u) const { return W + (size_t)u.pn * 65536 * 2; }
};
struct AddrBranch {
    const char* YM; long dYL; const char* W; int lda, ldb, K;
    __device__ __forceinline__ const char* a(const pg8::Unit& u) const { return YM + (u.pn < 4 ? 0l : dYL) + (size_t)u.pm * 256 * 1024 * 2; }
    __device__ __forceinline__ const char* b(const pg8::Unit& u) const { return W + (size_t)u.pn * 256 * 1024 * 2; }
};

struct DstP1 { unsigned char* ws; int thr, lo_add, hi_add;
    __device__ __forceinline__ bf16* get(int j, int& ld, int& col0) const {
        const int pn = j + (j < thr ? lo_add : hi_add); const bool mg = pn >= 16; ld = mg ? -2048 : 1024; col0 = mg ? (pn - 16) * 256 : (pn & 3) * 256;
        return (bf16*)(ws + (mg ? WS_MG : WS_XM + (size_t)(pn >> 2) * 64 * MiB)); } };
struct DstQKV { char* q; long dk, dv;
    __device__ __forceinline__ bf16* get(int pn, int& ld, int& col0) const { ld = 1024; col0 = (pn & 3) * 256; return (bf16*)(q + (pn >= 4 ? (pn >= 8 ? dv : dk) : 0l)); } };
template <class Dst, bool MUL = false> struct EpiBf16 {
    static constexpr bool PERM = true;
    Dst dst; float mul;
    __device__ __forceinline__ void operator()(const f32x4 (&acc)[2][2][4][2], const pg8::Unit& u, int wr, int wc, int fr, int fq) const {
        int ld, colt; bf16* base = dst.get(u.pn, ld, colt);
        const int row0 = u.pm * 256 + wr * 64 + fr, col0 = colt + wc * 32 + 8 * fq;
        if (MUL && ld < 0) {
#pragma unroll
            for (int ai = 0; ai < 2; ++ai)
#pragma unroll
                for (int m = 0; m < 4; ++m) { unsigned char* rowp = (unsigned char*)base + (size_t)(row0 + ai * 128 + m * 16) * (-ld) + col0;
#pragma unroll
                    for (int bj = 0; bj < 2; ++bj) { const f32x4 v0 = acc[ai][bj][m][0] * mul, v1 = acc[ai][bj][m][1] * mul;
                        int p0 = 0, p1 = 0; p0 = __builtin_amdgcn_cvt_pk_fp8_f32(v0[0], v0[1], p0, false); p0 = __builtin_amdgcn_cvt_pk_fp8_f32(v0[2], v0[3], p0, true);
                        p1 = __builtin_amdgcn_cvt_pk_fp8_f32(v1[0], v1[1], p1, false); p1 = __builtin_amdgcn_cvt_pk_fp8_f32(v1[2], v1[3], p1, true);
                        *(v2u*)(rowp + bj * 128) = (v2u){(unsigned)p0, (unsigned)p1}; } }
            return;
        }
#pragma unroll
        for (int ai = 0; ai < 2; ++ai)
#pragma unroll
            for (int m = 0; m < 4; ++m) { bf16* rowp = base + (size_t)(row0 + ai * 128 + m * 16) * ld + col0;
#pragma unroll
                for (int bj = 0; bj < 2; ++bj) { f32x4 v0 = acc[ai][bj][m][0], v1 = acc[ai][bj][m][1]; if (MUL) { v0 = v0 * mul; v1 = v1 * mul; }
                    v4u w; w.x = pg8::cvt_pk_bf16(v0[0], v0[1]); w.y = pg8::cvt_pk_bf16(v0[2], v0[3]); w.z = pg8::cvt_pk_bf16(v1[0], v1[1]); w.w = pg8::cvt_pk_bf16(v1[2], v1[3]);
                    *(v4u*)(rowp + bj * 128) = w; } }
    }
};
template <bool ADD> struct EpiMerge {
    static constexpr bool PERM = true;
    bf16* MRG; const unsigned char* MG; int gcol;
    __device__ __forceinline__ void operator()(const f32x4 (&acc)[2][2][4][2], const pg8::Unit& u, int wr, int wc, int fr, int fq) const {
        const int row0 = u.pm * 256 + wr * 64 + fr, col0 = u.pn * 256 + wc * 32 + 8 * fq;
#pragma unroll
        for (int ai = 0; ai < 2; ++ai)
#pragma unroll
            for (int m = 0; m < 4; ++m) { const size_t row = (size_t)(row0 + ai * 128 + m * 16); bf16* rowp = MRG + row * 1024 + col0; const unsigned char* gp = MG + row * 2048 + gcol + col0;
#pragma unroll
                for (int bj = 0; bj < 2; ++bj) { const f32x4 v0 = acc[ai][bj][m][0], v1 = acc[ai][bj][m][1];
                    const v2u g = *(const v2u*)(gp + bj * 128);
                    const f32x2 g0 = __builtin_amdgcn_cvt_pk_f32_fp8((int)g.x, false), g1 = __builtin_amdgcn_cvt_pk_f32_fp8((int)g.x, true), g2 = __builtin_amdgcn_cvt_pk_f32_fp8((int)g.y, false), g3 = __builtin_amdgcn_cvt_pk_f32_fp8((int)g.y, true);
                    float o[8] = {v0[0] * sigmoidf_(g0[0]), v0[1] * sigmoidf_(g0[1]), v0[2] * sigmoidf_(g1[0]), v0[3] * sigmoidf_(g1[1]),
                                  v1[0] * sigmoidf_(g2[0]), v1[1] * sigmoidf_(g2[1]), v1[2] * sigmoidf_(g3[0]), v1[3] * sigmoidf_(g3[1])};
                    if (ADD) { const v4u t = *(const v4u*)(rowp + bj * 128);
                        o[0] += bflo(t.x); o[1] += bfhi(t.x); o[2] += bflo(t.y); o[3] += bfhi(t.y); o[4] += bflo(t.z); o[5] += bfhi(t.z); o[6] += bflo(t.w); o[7] += bfhi(t.w); }
                    v4u w; w.x = pg8::cvt_pk_bf16(o[0], o[1]); w.y = pg8::cvt_pk_bf16(o[2], o[3]); w.z = pg8::cvt_pk_bf16(o[4], o[5]); w.w = pg8::cvt_pk_bf16(o[6], o[7]);
                    *(v4u*)(rowp + bj * 128) = w; } }
    }
};
struct EpiMerge2 {
    static constexpr bool PERM = true;
    bf16* MRG; const unsigned char* MG;
    static __device__ __forceinline__ void dec8(const v2u g, float (&x)[8]) {
        const f32x2 g0 = __builtin_amdgcn_cvt_pk_f32_fp8((int)g.x, false), g1 = __builtin_amdgcn_cvt_pk_f32_fp8((int)g.x, true), g2 = __builtin_amdgcn_cvt_pk_f32_fp8((int)g.y, false), g3 = __builtin_amdgcn_cvt_pk_f32_fp8((int)g.y, true);
        x[0] = g0[0]; x[1] = g0[1]; x[2] = g1[0]; x[3] = g1[1]; x[4] = g2[0]; x[5] = g2[1]; x[6] = g3[0]; x[7] = g3[1]; }
    __device__ __forceinline__ void mid(f32x4 (&acc)[2][2][4][2], const pg8::Unit& u, int wr, int wc, int fr, int fq) const {
        const int row0 = u.pm * 256 + wr * 64 + fr, col0 = u.pn * 256 + wc * 32 + 8 * fq;
#pragma unroll
        for (int ai = 0; ai < 2; ++ai)
#pragma unroll
            for (int m = 0; m < 4; ++m) { const size_t row = (size_t)(row0 + ai * 128 + m * 16); const unsigned char* gp = MG + row * 2048 + col0;
#pragma unroll
                for (int bj = 0; bj < 2; ++bj) { float x1[8], x2[8]; dec8(*(const v2u*)(gp + bj * 128), x1); dec8(*(const v2u*)(gp + 1024 + bj * 128), x2);
                    float rt[8];
#pragma unroll
                    for (int e = 0; e < 8; ++e) rt[e] = (1.f + __builtin_amdgcn_exp2f(fminf(x2[e] * -1.44269504089f, 96.f))) * __builtin_amdgcn_rcpf(1.f + __builtin_amdgcn_exp2f(x1[e] * -1.44269504089f));
                    acc[ai][bj][m][0] = acc[ai][bj][m][0] * (f32x4){rt[0], rt[1], rt[2], rt[3]}; acc[ai][bj][m][1] = acc[ai][bj][m][1] * (f32x4){rt[4], rt[5], rt[6], rt[7]}; } }
    }
    __device__ __forceinline__ void operator()(const f32x4 (&acc)[2][2][4][2], const pg8::Unit& u, int wr, int wc, int fr, int fq) const {
        const int row0 = u.pm * 256 + wr * 64 + fr, col0 = (u.pn - 4) * 256 + wc * 32 + 8 * fq;
#pragma unroll
        for (int ai = 0; ai < 2; ++ai)
#pragma unroll
            for (int m = 0; m < 4; ++m) { const size_t row = (size_t)(row0 + ai * 128 + m * 16); bf16* rowp = MRG + row * 1024 + col0; const unsigned char* gp = MG + row * 2048 + 1024 + col0;
#pragma unroll
                for (int bj = 0; bj < 2; ++bj) { const f32x4 v0 = acc[ai][bj][m][0], v1 = acc[ai][bj][m][1];
                    float x2[8]; dec8(*(const v2u*)(gp + bj * 128), x2);
                    const float o[8] = {v0[0] * sigmoidf_(x2[0]), v0[1] * sigmoidf_(x2[1]), v0[2] * sigmoidf_(x2[2]), v0[3] * sigmoidf_(x2[3]), v1[0] * sigmoidf_(x2[4]), v1[1] * sigmoidf_(x2[5]), v1[2] * sigmoidf_(x2[6]), v1[3] * sigmoidf_(x2[7])};
                    v4u w; w.x = pg8::cvt_pk_bf16(o[0], o[1]); w.y = pg8::cvt_pk_bf16(o[2], o[3]); w.z = pg8::cvt_pk_bf16(o[4], o[5]); w.w = pg8::cvt_pk_bf16(o[6], o[7]);
                    *(v4u*)(rowp + bj * 128) = w; } }
    }
};
struct EpiResid {
    static constexpr bool PERM = true;
    const float* x; float* x1; bf16* x1b; float* ss;
    __device__ __forceinline__ void operator()(const f32x4 (&acc)[2][2][4][2], const pg8::Unit& u, int wr, int wc, int fr, int fq) const {
        const int row0 = u.pm * 256 + wr * 64 + fr, col0 = u.pn * 256 + wc * 32 + 8 * fq;
#pragma unroll
        for (int ai = 0; ai < 2; ++ai)
#pragma unroll
            for (int m = 0; m < 4; ++m) { const int row = row0 + ai * 128 + m * 16; const size_t off = (size_t)row * DM + col0; float s = 0.f;
#pragma unroll
                for (int bj = 0; bj < 2; ++bj) { const size_t o = off + bj * 128;
                    const f32x4 v0 = *(const f32x4*)(x + o) + acc[ai][bj][m][0], v1 = *(const f32x4*)(x + o + 4) + acc[ai][bj][m][1];
                    v4u w; w.x = pg8::cvt_pk_bf16(v0[0], v0[1]); w.y = pg8::cvt_pk_bf16(v0[2], v0[3]); w.z = pg8::cvt_pk_bf16(v1[0], v1[1]); w.w = pg8::cvt_pk_bf16(v1[2], v1[3]);
                    *(v4u*)(x1b + o) = w;
                    s += ((v0[0] * v0[0] + v0[1] * v0[1]) + (v0[2] * v0[2] + v0[3] * v0[3])) + ((v1[0] * v1[0] + v1[1] * v1[1]) + (v1[2] * v1[2] + v1[3] * v1[3])); }
                s += __shfl_xor(s, 16); s += __shfl_xor(s, 32);
                if (fq == 0) atomicAdd(ss + row, s); }
    }
};
struct EpiPQ {
    static constexpr bool PERM = true;
    bf16* pq; const float* ss;
    __device__ __forceinline__ void operator()(const f32x4 (&acc)[2][2][4][2], const pg8::Unit& u, int wr, int wc, int fr, int fq) const {
        const int row0 = u.pm * 256 + wr * 64 + fr, col0 = u.pn * 256 + wc * 32 + 8 * fq;
#pragma unroll
        for (int ai = 0; ai < 2; ++ai)
#pragma unroll
            for (int m = 0; m < 4; ++m) { const int row = row0 + ai * 128 + m * 16; bf16* rowp = pq + (size_t)row * 2048 + col0;
                const float r = rsqrtf(ss[row] * (1.f / DM) + EPS);
#pragma unroll
                for (int bj = 0; bj < 2; ++bj) { const f32x4 v0 = acc[ai][bj][m][0] * r, v1 = acc[ai][bj][m][1] * r;
                    v4u w; w.x = pg8::cvt_pk_bf16(v0[0], v0[1]); w.y = pg8::cvt_pk_bf16(v0[2], v0[3]); w.z = pg8::cvt_pk_bf16(v1[0], v1[1]); w.w = pg8::cvt_pk_bf16(v1[2], v1[3]);
                    *(v4u*)(rowp + bj * 128) = w; } }
    }
};

__device__ __forceinline__ void tab_load(const Frame& F, int row, f32x4 (&a)[4]) {
    const bool isv = row >= NEXP; const int r = isv ? row - NEXP : row;
    const f32x4* src = (const f32x4*)((const char*)(F.in[isv ? 24 : 23] + (size_t)r * DM) + (unsigned)(F.lane * 64));
#pragma unroll
    for (int j = 0; j < 4; ++j) a[j] = src[j];
}
__device__ __forceinline__ void tab_convert(const Frame& F, int row, const f32x4 (&a)[4]) {
    const bool isv = row >= NEXP; const int r = isv ? row - NEXP : row;
    float ss = 0.f;
#pragma unroll
    for (int j = 0; j < 4; ++j) ss += (a[j][0] * a[j][0] + a[j][1] * a[j][1]) + (a[j][2] * a[j][2] + a[j][3] * a[j][3]);
    const float rms = sqrtf(wave_sum(ss) * (1.f / DM));
    const float sc = fmaxf(rms * 0.5f, 1e-30f), inv = 1.f / sc;
    unsigned o[2] = {0u, 0u};
#pragma unroll
    for (int j = 0; j < 4; ++j) { const f32x4 q = a[j] * inv;
        if (j & 1) { o[j >> 1] = __builtin_amdgcn_cvt_scalef32_pk_fp4_f32(o[j >> 1], q[0], q[1], 1.0f, 2); o[j >> 1] = __builtin_amdgcn_cvt_scalef32_pk_fp4_f32(o[j >> 1], q[2], q[3], 1.0f, 3); }
        else       { o[j >> 1] = __builtin_amdgcn_cvt_scalef32_pk_fp4_f32(o[j >> 1], q[0], q[1], 1.0f, 0); o[j >> 1] = __builtin_amdgcn_cvt_scalef32_pk_fp4_f32(o[j >> 1], q[2], q[3], 1.0f, 1); } }
    *(v2u*)(F.ws + WS_TAB + (isv ? DM / 2 : 0) + (size_t)r * DM + F.lane * 8) = (v2u){o[0], o[1]};
    if (F.lane == 0) ((float*)(F.ws + WS_TAB + 16 * MiB))[row] = sc;
}
template <bool PB> __device__ __forceinline__ void lru_phase(Frame& F) {
    const bf16* XL = (const bf16*)(F.ws + WS_XL); const bf16* LG = (const bf16*)(F.ws + WS_LG); bf16* YL = (bf16*)F.out;
    f32x2* AGG = (f32x2*)(F.ws + WS_AGG);
    const bf16* WL = (const bf16*)(F.ws + WS_WLRU);
    const float* cw = F.in[10]; const float* cb = F.in[11];
    unsigned char* LA0 = F.ws + WS_K; unsigned char* LA1 = LA0 + (size_t)MTOK * DM; bf16* LU0 = (bf16*)F.out; bf16* LU1 = LU0 + (size_t)MTOK * DM;
    v2u ra[2]; v4u ru[2];
    constexpr int O_XCB = 0, O_XCF = 17408, O_A = 51200, O_U = 84992, FST = 528;
    LAS unsigned char* L = F.lds;
    const int tid = F.tid, lane = F.lane, w = F.wave, fr = lane & 15, fq = lane >> 4;
    int cur_blk = -1, tab_next = 0;
    bf16x8 wf[2][2][4];
    f32x4 br4[2], bi4[2], sp4[2];
    v4u rawreg[3];
#define RAW_LOAD(bb, tt0, bk) do { _Pragma("unroll") for (int r_ = 0; r_ < 3; ++r_) { const int e_ = tid + NTHR * r_, row_ = e_ >> 4, c16_ = e_ & 15, t_ = (tt0) - 2 + row_; \
            v4u v_ = {0u, 0u, 0u, 0u}; if (e_ < 68 * 16 && t_ >= 0 && t_ < SEQ) v_ = *(const v4u*)(XL + ((size_t)(bb) * SEQ + t_) * DM + (bk) * 128 + c16_ * 8); rawreg[r_] = v_; } } while (0)
#define PB_LOAD(ii, dd) do { const int idx_ = (ii) * F.G + F.bid; if (idx_ < 4096) { const int j_ = idx_ >> 3; const size_t mr_ = (size_t)(j_ >> 6) * SEQ + (j_ & 63) * 64; \
            _Pragma("unroll") for (int r_ = 0; r_ < 2; ++r_) { const int e_ = tid + NTHR * r_; const size_t o_ = (mr_ + (e_ >> 4)) * DM + (idx_ & 7) * 128 + (e_ & 15) * 8; \
                ra[r_] = *(const v2u*)(((dd) ? LA1 : LA0) + o_); ru[r_] = *(const v4u*)(((dd) ? LU1 : LU0) + o_); } } } while (0)
    constexpr int O_CARRY = 118784, O_CW = 135168, O_SUB = 137728;
    const bool carry_tab = PB && (F.G == 256);
    if (carry_tab) {
        const int ch = tid & 127, bq = tid >> 7, s0 = F.bid >> 3, blk0 = F.bid & 7;
        LAS float* CT = (LAS float*)(L + O_CARRY);
#define FOLD(agp, j0, j1, stp, hv) do { int js_ = (j0); const int n_ = ((j1) - (j0)) * (stp); int k_ = 0; \
            for (; k_ + 8 <= n_; k_ += 8) { f32x2 ah_[8]; _Pragma("unroll") for (int q_ = 0; q_ < 8; ++q_) ah_[q_] = (agp)[(size_t)(js_ + q_ * (stp)) * 2 * DM]; \
                _Pragma("unroll") for (int q_ = 0; q_ < 8; ++q_) hv = ah_[q_][0] * hv + ah_[q_][1]; js_ += 8 * (stp); } \
            for (; k_ < n_; ++k_) { const f32x2 a1_ = (agp)[(size_t)js_ * 2 * DM]; hv = a1_[0] * hv + a1_[1]; js_ += (stp); } } while (0)
        for (int bb = 2 * bq; bb < 2 * bq + 2; ++bb) {
            const f32x2* ag0 = AGG + ((size_t)(bb * 64) * 2 + 0) * DM + blk0 * 128 + ch; const f32x2* ag1 = AGG + ((size_t)(bb * 64) * 2 + 1) * DM + blk0 * 128 + ch;
            float h = 0.f;
            FOLD(ag0, 0, s0, 1, h); CT[((bb * 2 + 0) * 2 + 0) * 128 + ch] = h;
            FOLD(ag0, s0, s0 + 32, 1, h); CT[((bb * 2 + 1) * 2 + 0) * 128 + ch] = h;
            h = 0.f;
            FOLD(ag1, 63, s0 + 32, -1, h); CT[((bb * 2 + 1) * 2 + 1) * 128 + ch] = h;
            FOLD(ag1, s0 + 32, s0, -1, h); CT[((bb * 2 + 0) * 2 + 1) * 128 + ch] = h;
        }
        __syncthreads();
#undef FOLD
    }
    for (int i = 0;; ++i) {
        const int idx = i * F.G + F.bid; if (idx >= 4096) break;
        const int blk = idx & 7, j = idx >> 3, b = j >> 6, seg = j & 63, t0 = seg * 64;
        const size_t mrow0 = (size_t)b * SEQ + t0;
        f32x4 trow[4]; const int tab_row = __builtin_amdgcn_readfirstlane(i * (F.G * NWAVES) + (F.bid * NWAVES + w));
        if (!PB && blk != cur_blk) {
            cur_blk = blk;
#pragma unroll
            for (int d = 0; d < 2; ++d) {
#pragma unroll
                for (int g = 0; g < 2; ++g)
#pragma unroll
                    for (int ks = 0; ks < 4; ++ks)
                        wf[d][g][ks] = *(const bf16x8*)(WL + ((size_t)((d * 8 + blk) * 2 + g) * 128 + 16 * w + fr) * 128 + 32 * ks + 8 * fq);
                const int ch = blk * 128 + 16 * w + 4 * fq;
                br4[d] = *(const f32x4*)(F.in[13] + d * DM + ch); bi4[d] = *(const f32x4*)(F.in[15] + d * DM + ch);
                const f32x4 lm = *(const f32x4*)(F.in[16] + d * DM + ch);
#pragma unroll
                for (int e = 0; e < 4; ++e) sp4[d][e] = -8.f * 1.44269504089f * softplusf_(-lm[e]);
            }
            __syncthreads();
            for (int e = tid; e < 5 * 128; e += NTHR) { const int jt = e >> 7, cc = e & 127; ((LAS float*)(L + O_CW))[e] = (jt < 4) ? cw[jt * DM + blk * 128 + cc] : cb[blk * 128 + cc]; }
        }
        v4u lgreg[2];
        if (PB) {
            if (i == 0) PB_LOAD(0, 0);
#pragma unroll
            for (int r = 0; r < 2; ++r) { const int e = tid + NTHR * r; lgreg[r] = *(const v4u*)(LG + (mrow0 + (e >> 4)) * DM + blk * 128 + (e & 15) * 8); }
        } else {
        if (i == 0) RAW_LOAD(b, t0, blk);
#pragma unroll
        for (int r = 0; r < 3; ++r) { const int e = tid + NTHR * r; if (e < 68 * 16) *(LAS v4u*)(L + O_A + (e >> 4) * 256 + (e & 15) * 16) = rawreg[r]; }
        __syncthreads();
        { const int idx2 = (i + 1) * F.G + F.bid; if (idx2 < 4096) { const int j2 = idx2 >> 3; RAW_LOAD(j2 >> 6, (j2 & 63) * 64, idx2 & 7); } }
        for (int e = tid; e < 64 * 16; e += NTHR) { const int tl = e >> 4, c16 = e & 15;
            float y[8];
            { const f32x4 a = *(const LAS f32x4*)(L + O_CW + 4 * 512 + c16 * 32), bq = *(const LAS f32x4*)(L + O_CW + 4 * 512 + c16 * 32 + 16); y[0] = a[0]; y[1] = a[1]; y[2] = a[2]; y[3] = a[3]; y[4] = bq[0]; y[5] = bq[1]; y[6] = bq[2]; y[7] = bq[3]; }
#pragma unroll
            for (int jt = 0; jt < 4; ++jt) { const v4u r = *(const LAS v4u*)(L + O_A + (tl + jt) * 256 + c16 * 16);
                const f32x4 wa = *(const LAS f32x4*)(L + O_CW + jt * 512 + c16 * 32), wb = *(const LAS f32x4*)(L + O_CW + jt * 512 + c16 * 32 + 16);
                y[0] += wa[0] * bflo(r.x); y[1] += wa[1] * bfhi(r.x); y[2] += wa[2] * bflo(r.y); y[3] += wa[3] * bfhi(r.y);
                y[4] += wb[0] * bflo(r.z); y[5] += wb[1] * bfhi(r.z); y[6] += wb[2] * bflo(r.w); y[7] += wb[3] * bfhi(r.w); }
            *(LAS f32x4*)(L + O_XCF + tl * FST + c16 * 32) = (f32x4){y[0], y[1], y[2], y[3]};
            *(LAS f32x4*)(L + O_XCF + tl * FST + c16 * 32 + 16) = (f32x4){y[4], y[5], y[6], y[7]};
            v4u o; o.x = pk2(y[0], y[1]); o.y = pk2(y[2], y[3]); o.z = pk2(y[4], y[5]); o.w = pk2(y[6], y[7]);
            *(LAS v4u*)(L + O_XCB + tl * 272 + c16 * 16) = o; }
        __syncthreads();
        }
        float carry0 = 0.f, carry1 = 0.f;
        if (carry_tab) { const LAS float* CT = (const LAS float*)(L + O_CARRY); carry0 = CT[((b * 2 + (seg >> 5)) * 2 + 0) * 128 + (tid & 127)]; carry1 = CT[((b * 2 + (seg >> 5)) * 2 + 1) * 128 + (tid & 127)]; }
        else if (PB) {
            const int ch = blk * 128 + (tid & 127);
            float h = 0.f;
            const f32x2* ag0 = AGG + ((size_t)(b * 64) * 2 + 0) * DM + ch; const f32x2* ag1 = AGG + ((size_t)(b * 64) * 2 + 1) * DM + ch;
            int js = 0;
            for (; js + 8 <= seg; js += 8) { f32x2 ah[8];
#pragma unroll
                for (int q = 0; q < 8; ++q) ah[q] = ag0[(size_t)(js + q) * 2 * DM];
#pragma unroll
                for (int q = 0; q < 8; ++q) h = ah[q][0] * h + ah[q][1]; }
            for (; js < seg; ++js) { const f32x2 ah = ag0[(size_t)js * 2 * DM]; h = ah[0] * h + ah[1]; }
            carry0 = h; h = 0.f;
            js = 63;
            for (; js - 8 >= seg; js -= 8) { f32x2 ah[8];
#pragma unroll
                for (int q = 0; q < 8; ++q) ah[q] = ag1[(size_t)(js - q) * 2 * DM];
#pragma unroll
                for (int q = 0; q < 8; ++q) h = ah[q][0] * h + ah[q][1]; }
            for (; js > seg; --js) { const f32x2 ah = ag1[(size_t)js * 2 * DM]; h = ah[0] * h + ah[1]; }
            carry1 = h;
        }
#pragma unroll
        for (int d = 0; d < 2; ++d) {
            const int o_a = (d == 0) ? O_A : O_XCF;
            if (PB) {
#pragma unroll
                for (int r = 0; r < 2; ++r) { const int e = tid + NTHR * r, row = e >> 4, c16 = e & 15;
                    const f32x2 x0 = __builtin_amdgcn_cvt_pk_f32_fp8((int)ra[r].x, false), x1 = __builtin_amdgcn_cvt_pk_f32_fp8((int)ra[r].x, true);
                    const f32x2 x2 = __builtin_amdgcn_cvt_pk_f32_fp8((int)ra[r].y, false), x3 = __builtin_amdgcn_cvt_pk_f32_fp8((int)ra[r].y, true);
                    constexpr float IS = 1.f / 4096.f;
                    *(LAS f32x4*)(L + o_a + row * FST + c16 * 32) = (f32x4){1.f - x0[0] * IS, 1.f - x0[1] * IS, 1.f - x1[0] * IS, 1.f - x1[1] * IS};
                    *(LAS f32x4*)(L + o_a + row * FST + c16 * 32 + 16) = (f32x4){1.f - x2[0] * IS, 1.f - x2[1] * IS, 1.f - x3[0] * IS, 1.f - x3[1] * IS};
                    *(LAS f32x4*)(L + O_U + row * FST + c16 * 32) = (f32x4){bflo(ru[r].x), bfhi(ru[r].x), bflo(ru[r].y), bfhi(ru[r].y)};
                    *(LAS f32x4*)(L + O_U + row * FST + c16 * 32 + 16) = (f32x4){bflo(ru[r].z), bfhi(ru[r].z), bflo(ru[r].w), bfhi(ru[r].w)}; }
                if (d == 0) { PB_LOAD(i, 1); tab_load(F, tab_row < 2 * NEXP ? tab_row : 2 * NEXP - 1, trow); }
                else PB_LOAD(i + 1, 0);
            } else {
            f32x4 aR[4], aI[4];
#pragma unroll
            for (int mt = 0; mt < 4; ++mt) { aR[mt] = (f32x4){0.f, 0.f, 0.f, 0.f}; aI[mt] = (f32x4){0.f, 0.f, 0.f, 0.f}; }
#pragma unroll
            for (int ks = 0; ks < 4; ++ks)
#pragma unroll
                for (int mt = 0; mt < 4; ++mt) { const bf16x8 xb = *(const LAS bf16x8*)(L + O_XCB + (16 * mt + fr) * 272 + (32 * ks + 8 * fq) * 2);
                    aR[mt] = __builtin_amdgcn_mfma_f32_16x16x32_bf16(wf[d][0][ks], xb, aR[mt], 0, 0, 0);
                    aI[mt] = __builtin_amdgcn_mfma_f32_16x16x32_bf16(wf[d][1][ks], xb, aI[mt], 0, 0, 0); }
#pragma unroll
            for (int mt = 0; mt < 4; ++mt) { const int tl = 16 * mt + fr, cl = 16 * w + 4 * fq;
                const f32x4 xc = *(const LAS f32x4*)(L + O_XCF + tl * FST + cl * 4);
                f32x4 av, uv;
#pragma unroll
                for (int e = 0; e < 4; ++e) { const float r = sigmoidf_(aR[mt][e] + br4[d][e]), ig = sigmoidf_(aI[mt][e] + bi4[d][e]);
                    const float a_ = __builtin_amdgcn_exp2f(r * sp4[d][e]); av[e] = a_; uv[e] = __builtin_amdgcn_sqrtf(fmaxf(1.f - a_ * a_, 0.f)) * (ig * xc[e]); }
                *(LAS f32x4*)(L + o_a + tl * FST + cl * 4) = av; *(LAS f32x4*)(L + O_U + tl * FST + cl * 4) = uv;
                { const size_t go = (mrow0 + tl) * DM + blk * 128 + cl;
                  int xa = 0; xa = __builtin_amdgcn_cvt_pk_fp8_f32((1.f - av[0]) * 4096.f, (1.f - av[1]) * 4096.f, xa, false); xa = __builtin_amdgcn_cvt_pk_fp8_f32((1.f - av[2]) * 4096.f, (1.f - av[3]) * 4096.f, xa, true);
                  v2u xu; xu.x = pk2(uv[0], uv[1]); xu.y = pk2(uv[2], uv[3]);
                  *(unsigned*)((d ? LA1 : LA0) + go) = (unsigned)xa; *(v2u*)((d ? LU1 : LU0) + go) = xu; } }
            }
            __syncthreads();
            {
                const int c = tid & 127, sub = tid >> 7;
                LAS float* pa = (LAS float*)(L + o_a) + c; const LAS float* pu = (const LAS float*)(L + O_U) + c;
                LAS f32x2* SUBT = (LAS f32x2*)(L + O_SUB);
                float h = 0.f, A = 1.f;
#pragma unroll
                for (int s2 = 0; s2 < 16; ++s2) { const int tl = d ? (16 * sub + 15 - s2) : (16 * sub + s2); const float a = pa[tl * 132], u = pu[tl * 132]; h = a * h + u; A *= a; }
                SUBT[sub * 128 + c] = (f32x2){A, h};
                __syncthreads();
                if (!PB) {
                    if (sub == 0) { float HH = 0.f, AA = 1.f;
#pragma unroll
                        for (int q = 0; q < 4; ++q) { const f32x2 ah = SUBT[(d ? 3 - q : q) * 128 + c]; HH = ah[0] * HH + ah[1]; AA *= ah[0]; }
                        AGG[((size_t)(b * 64 + seg) * 2 + d) * DM + blk * 128 + c] = (f32x2){AA, HH}; }
                } else {
                    float hc = d ? carry1 : carry0;
#pragma unroll
                    for (int q = 0; q < 3; ++q) { const int jq = d ? 3 - q : q; const f32x2 ah = SUBT[jq * 128 + c]; if (d ? (jq > sub) : (jq < sub)) hc = ah[0] * hc + ah[1]; }
                    if (d == 0) {
#pragma unroll
                        for (int s2 = 0; s2 < 16; ++s2) { const int tl = 16 * sub + s2; hc = pa[tl * 132] * hc + pu[tl * 132]; pa[tl * 132] = hc; }
                    } else { LAS float* ph = (LAS float*)(L + O_A) + c;
#pragma unroll
                        for (int s2 = 0; s2 < 16; ++s2) { const int tl = 16 * sub + 15 - s2; hc = pa[tl * 132] * hc + pu[tl * 132]; ph[tl * 132] += hc; } }
                }
            }
            __syncthreads();
        }
        if (PB) {
#pragma unroll
            for (int r = 0; r < 2; ++r) { const int e = tid + NTHR * r, row = e >> 4, c16 = e & 15;
                const v4u g = lgreg[r];
                const f32x4 h0 = *(const LAS f32x4*)(L + O_A + row * FST + c16 * 32), h1 = *(const LAS f32x4*)(L + O_A + row * FST + c16 * 32 + 16);
                v4u o;
                o.x = pk2(h0[0] * gelu_fast(bflo(g.x)), h0[1] * gelu_fast(bfhi(g.x))); o.y = pk2(h0[2] * gelu_fast(bflo(g.y)), h0[3] * gelu_fast(bfhi(g.y)));
                o.z = pk2(h1[0] * gelu_fast(bflo(g.z)), h1[1] * gelu_fast(bfhi(g.z))); o.w = pk2(h1[2] * gelu_fast(bflo(g.w)), h1[3] * gelu_fast(bfhi(g.w)));
                *(v4u*)(YL + (mrow0 + row) * DM + blk * 128 + c16 * 8) = o; }
            __syncthreads();
        }
        if (PB) { if (tab_row < 2 * NEXP) tab_convert(F, tab_row, trow); tab_next = i + 1; }
    }
    if (PB) {
        for (int k = tab_next; k * (F.G * NWAVES) + (F.bid * NWAVES + w) < 2 * NEXP; ++k) { f32x4 tr2[4]; const int row = k * (F.G * NWAVES) + (F.bid * NWAVES + w); tab_load(F, row, tr2); tab_convert(F, row, tr2); }
    }
#undef RAW_LOAD
#undef PB_LOAD
}

__device__ __forceinline__ void qkv_phase(Frame& F) {
    const bf16* W = (const bf16*)(F.ws + WS_WQKV);
    const bf16* XC = (const bf16*)(F.ws + WS_XL); const bf16* XM = (const bf16*)(F.ws + WS_XM);
    bf16* Qd = (bf16*)(F.ws + WS_LG); bf16* Kd = (bf16*)(F.ws + WS_K); bf16* Vd = (bf16*)F.out + (size_t)MTOK * DM;
    LAS unsigned char* L = F.lds;
    const int tid = F.tid, lane = F.lane, w = F.wave, fr = lane & 15, fq = lane >> 4;
    const int per = (1536 + F.G - 1) / F.G, u0 = F.bid * per, u1 = (u0 + per < 1536) ? u0 + per : 1536;
    if (u0 >= u1) return;
    bf16x8 af[8][2], naf[8][2];
#define QKV_LOADA(dst, uu) do { const int gh_ = (uu) >> 7, pm_ = (uu) & 127; const bf16* src_ = ((gh_ >> 2) < 2 ? XC : XM) + (size_t)(pm_ * 256 + 32 * w + fr) * DM + (gh_ & 3) * 256 + 8 * fq; \
        _Pragma("unroll") for (int ks_ = 0; ks_ < 8; ++ks_) _Pragma("unroll") for (int m_ = 0; m_ < 2; ++m_) dst[ks_][m_] = *(const bf16x8*)(src_ + (size_t)(16 * m_) * DM + 32 * ks_); } while (0)
    QKV_LOADA(naf, u0);
    int cur_gh = -1;
#pragma unroll 1
    for (int u = u0; u < u1; ++u) {
        const int gh = u >> 7, pm = u & 127, g = gh >> 2, h = gh & 3;
        if (gh != cur_gh) { cur_gh = gh;
            __syncthreads();
#pragma unroll 4
            for (int it = 0; it < 16; ++it) { const int idx = tid + NTHR * it, R = idx >> 5, ch = idx & 31, n16 = R >> 4, i = R & 15;
                const int c = 32 * (n16 >> 1) + 8 * (i >> 2) + 4 * (n16 & 1) + (i & 3);
                *(LAS v4u*)(L + R * 528 + ch * 16) = *(const v4u*)(W + (size_t)gh * 65536 + (size_t)c * 256 + ch * 8); }
            __syncthreads();
        }
#pragma unroll
        for (int ks = 0; ks < 8; ++ks) { af[ks][0] = naf[ks][0]; af[ks][1] = naf[ks][1]; }
        if (u + 1 < u1) QKV_LOADA(naf, u + 1);
        bf16* dst = (g == 0 ? Qd : (g == 1 ? Kd : Vd)) + (size_t)(pm * 256 + 32 * w + fr) * DM + h * 256 + 8 * fq;
#pragma unroll
        for (int q = 0; q < 4; ++q) {
            f32x4 acc[2][4];
#pragma unroll
            for (int m = 0; m < 2; ++m)
#pragma unroll
                for (int n = 0; n < 4; ++n) acc[m][n] = (f32x4){0.f, 0.f, 0.f, 0.f};
#pragma unroll
            for (int ks = 0; ks < 8; ++ks)
#pragma unroll
                for (int n = 0; n < 4; ++n) { const bf16x8 wf = *(const LAS bf16x8*)(L + (64 * q + 16 * n + fr) * 528 + (32 * ks + 8 * fq) * 2);
                    acc[0][n] = __builtin_amdgcn_mfma_f32_16x16x32_bf16(wf, af[ks][0], acc[0][n], 0, 0, 0);
                    acc[1][n] = __builtin_amdgcn_mfma_f32_16x16x32_bf16(wf, af[ks][1], acc[1][n], 0, 0, 0); }
#pragma unroll
            for (int m = 0; m < 2; ++m)
#pragma unroll
                for (int t = 0; t < 2; ++t) { const f32x4 v0 = acc[m][2 * t], v1 = acc[m][2 * t + 1];
                    v4u o; o.x = pk2(v0[0], v0[1]); o.y = pk2(v0[2], v0[3]); o.z = pk2(v1[0], v1[1]); o.w = pk2(v1[2], v1[3]);
                    *(v4u*)(dst + (size_t)(16 * m) * DM + 64 * q + 32 * t) = o; }
        }
    }
#undef QKV_LOADA
}

__device__ __forceinline__ void qkv_conv_phase(Frame& F) {
    const bf16* W = (const bf16*)(F.ws + WS_WQKV); const bf16* XM = (const bf16*)(F.ws + WS_XM);
    bf16* Qd = (bf16*)(F.ws + WS_LG); bf16* Kd = (bf16*)(F.ws + WS_K); bf16* Vd = (bf16*)F.out + (size_t)MTOK * DM;
    const float* cw = F.in[4]; const float* cb = F.in[5];
    LAS unsigned char* L = F.lds; constexpr int O_TAPS = 256 * 528;
    const int tid = F.tid, lane = F.lane, w = F.wave, fr = lane & 15, fq = lane >> 4;
    const int h = F.bid >> 6, pm0 = 2 * (F.bid & 63);
    for (int e = tid; e < 5 * 256; e += NTHR) { const int j = e >> 8, c = e & 255; ((LAS unsigned short*)(L + O_TAPS))[e] = (unsigned short)f2bf(j < 4 ? cw[j * DM + h * 256 + c] : cb[h * 256 + c]); }
#define QC_LOADW(gh) do { __syncthreads(); _Pragma("unroll 4") for (int it = 0; it < 16; ++it) { const int idx = tid + NTHR * it, R = idx >> 5, ch = idx & 31, n16 = R >> 4, i = R & 15; \
            const int c = 32 * (n16 >> 1) + 8 * (i >> 2) + 4 * (n16 & 1) + (i & 3); \
            *(LAS v4u*)(L + R * 528 + ch * 16) = *(const v4u*)(W + (size_t)(gh) * 65536 + (size_t)c * 256 + ch * 8); } __syncthreads(); } while (0)
#define QC_OFFS(pm, m_) const int T##m_ = (pm) * 256 + 32 * w + 16 * (m_) + fr, tq##m_ = T##m_ & (SEQ - 1); const bool va##m_ = tq##m_ >= 2, vb##m_ = tq##m_ >= 1, vd##m_ = tq##m_ + 1 < SEQ; \
        const unsigned oc##m_ = (unsigned)((T##m_ * DM + h * 256 + 8 * fq) * 2), oa##m_ = oc##m_ - (va##m_ ? 4096u : 0u), ob##m_ = oc##m_ - (vb##m_ ? 2048u : 0u), od##m_ = oc##m_ + (vd##m_ ? 2048u : 0u);
#define QC_RAW(dst, ks_, m_) do { const v4u z_ = {0u, 0u, 0u, 0u}; \
        const v4u xa_ = *(const v4u*)((const char*)XM + oa##m_ + 64 * (ks_)), xb_ = *(const v4u*)((const char*)XM + ob##m_ + 64 * (ks_)), xc_ = *(const v4u*)((const char*)XM + oc##m_ + 64 * (ks_)), xd_ = *(const v4u*)((const char*)XM + od##m_ + 64 * (ks_)); \
        dst[0] = va##m_ ? xa_ : z_; dst[1] = vb##m_ ? xb_ : z_; dst[2] = xc_; dst[3] = vd##m_ ? xd_ : z_; } while (0)
#define QC_TAPS(ks_) f32x2 tw_[4][4], tb_[4]; do { unsigned fo_ = (unsigned)(16 * fq); asm volatile("" : "+v"(fo_));        \
        const v4u b_ = *(const LAS v4u*)(L + O_TAPS + (4 * 256 + 32 * (ks_)) * 2 + fo_); tb_[0] = (f32x2){bflo(b_.x), bfhi(b_.x)}; tb_[1] = (f32x2){bflo(b_.y), bfhi(b_.y)}; tb_[2] = (f32x2){bflo(b_.z), bfhi(b_.z)}; tb_[3] = (f32x2){bflo(b_.w), bfhi(b_.w)}; \
        _Pragma("unroll") for (int j_ = 0; j_ < 4; ++j_) { const v4u t_ = *(const LAS v4u*)(L + O_TAPS + (j_ * 256 + 32 * (ks_)) * 2 + fo_); \
            tw_[j_][0] = (f32x2){bflo(t_.x), bfhi(t_.x)}; tw_[j_][1] = (f32x2){bflo(t_.y), bfhi(t_.y)}; tw_[j_][2] = (f32x2){bflo(t_.z), bfhi(t_.z)}; tw_[j_][3] = (f32x2){bflo(t_.w), bfhi(t_.w)}; } } while (0)
#define QC_CONV(out, raw) do { f32x2 y_[4] = {tb_[0], tb_[1], tb_[2], tb_[3]}; \
        _Pragma("unroll") for (int j_ = 0; j_ < 4; ++j_) { const v4u x_ = raw[j_]; \
            y_[0] = __builtin_elementwise_fma(tw_[j_][0], (f32x2){bflo(x_.x), bfhi(x_.x)}, y_[0]); y_[1] = __builtin_elementwise_fma(tw_[j_][1], (f32x2){bflo(x_.y), bfhi(x_.y)}, y_[1]); \
            y_[2] = __builtin_elementwise_fma(tw_[j_][2], (f32x2){bflo(x_.z), bfhi(x_.z)}, y_[2]); y_[3] = __builtin_elementwise_fma(tw_[j_][3], (f32x2){bflo(x_.w), bfhi(x_.w)}, y_[3]); } \
        unsigned o_[4]; \
        _Pragma("unroll") for (int p_ = 0; p_ < 4; ++p_) { const f32x2 e_ = y_[p_] * -1.44269504089f; \
            const f32x2 d_ = (f32x2){__builtin_amdgcn_exp2f(e_[0]), __builtin_amdgcn_exp2f(e_[1])} + 1.f; const f32x2 r_ = y_[p_] * (f32x2){__builtin_amdgcn_rcpf(d_[0]), __builtin_amdgcn_rcpf(d_[1])}; o_[p_] = pk2(r_[0], r_[1]); } \
        out = __builtin_bit_cast(bf16x8, (v4u){o_[0], o_[1], o_[2], o_[3]}); } while (0)
#define QC_PREP(afc, pm) do { QC_OFFS(pm, 0) QC_OFFS(pm, 1) v4u rwA_[4], rwB_[4]; QC_RAW(rwA_, 0, 0); LAS unsigned char* fl_ = L + w * 16384 + lane * 16; \
        _Pragma("unroll 1") for (int ks_ = 0; ks_ < 8; ++ks_) { bf16x8 o0_, o1_; QC_RAW(rwB_, ks_, 1); QC_TAPS(ks_); QC_CONV(o0_, rwA_); *(LAS bf16x8*)(fl_ + (2 * ks_) * 1024) = o0_; \
            if (ks_ < 7) QC_RAW(rwA_, ks_ + 1, 0); QC_CONV(o1_, rwB_); *(LAS bf16x8*)(fl_ + (2 * ks_ + 1) * 1024) = o1_; } \
        _Pragma("unroll") for (int ks_ = 0; ks_ < 8; ++ks_) { afc[ks_][0] = *(const LAS bf16x8*)(fl_ + (2 * ks_) * 1024); afc[ks_][1] = *(const LAS bf16x8*)(fl_ + (2 * ks_ + 1) * 1024); } } while (0)
#define QC_UNIT(DST, pm, af) do { bf16* dst_ = (DST) + (size_t)((pm) * 256 + 32 * w + fr) * DM + h * 256 + 8 * fq; \
        _Pragma("unroll") for (int q = 0; q < 4; ++q) { f32x4 acc[2][4]; \
            _Pragma("unroll") for (int m = 0; m < 2; ++m) _Pragma("unroll") for (int n = 0; n < 4; ++n) acc[m][n] = (f32x4){0.f, 0.f, 0.f, 0.f}; \
            _Pragma("unroll") for (int ks = 0; ks < 8; ++ks) _Pragma("unroll") for (int n = 0; n < 4; ++n) { const bf16x8 wf = *(const LAS bf16x8*)(L + (64 * q + 16 * n + fr) * 528 + (32 * ks + 8 * fq) * 2); \
                acc[0][n] = __builtin_amdgcn_mfma_f32_16x16x32_bf16(wf, af[ks][0], acc[0][n], 0, 0, 0); acc[1][n] = __builtin_amdgcn_mfma_f32_16x16x32_bf16(wf, af[ks][1], acc[1][n], 0, 0, 0); } \
            _Pragma("unroll") for (int m = 0; m < 2; ++m) _Pragma("unroll") for (int t = 0; t < 2; ++t) { const f32x4 v0 = acc[m][2 * t], v1 = acc[m][2 * t + 1]; \
                v4u o; o.x = pk2(v0[0], v0[1]); o.y = pk2(v0[2], v0[3]); o.z = pk2(v1[0], v1[1]); o.w = pk2(v1[2], v1[3]); \
                *(v4u*)(dst_ + (size_t)(16 * m) * DM + 64 * q + 32 * t) = o; } __builtin_amdgcn_sched_barrier(0); } } while (0)
#define QC_LOADV(dst, pm) do { const bf16* src_ = XM + (size_t)((pm) * 256 + 32 * w + fr) * DM + h * 256 + 8 * fq; \
        _Pragma("unroll") for (int ks_ = 0; ks_ < 8; ++ks_) _Pragma("unroll") for (int m_ = 0; m_ < 2; ++m_) dst[ks_][m_] = *(const bf16x8*)(src_ + (size_t)(16 * m_) * DM + 32 * ks_); __builtin_amdgcn_sched_barrier(0); } while (0)
    bf16x8 a0[8][2], a1[8][2];
    __syncthreads();
    QC_PREP(a0, pm0); QC_PREP(a1, pm0 + 1);
    QC_LOADW(0 + h); QC_UNIT(Qd, pm0, a0); QC_UNIT(Qd, pm0 + 1, a1);
    QC_LOADW(4 + h); QC_UNIT(Kd, pm0, a0);
    QC_LOADV(a0, pm0);
    QC_UNIT(Kd, pm0 + 1, a1);
    QC_LOADV(a1, pm0 + 1);
    QC_LOADW(8 + h); QC_UNIT(Vd, pm0, a0); QC_UNIT(Vd, pm0 + 1, a1);
#undef QC_LOADW
#undef QC_RAW
#undef QC_OFFS
#undef QC_CONV
#undef QC_TAPS
#undef QC_PREP
#undef QC_UNIT
#undef QC_LOADV
}

__device__ __forceinline__ void mconv_phase(Frame& F) {
    const bf16* XM = (const bf16*)(F.ws + WS_XM); bf16* XC = (bf16*)(F.ws + WS_XL);
    const float* cw = F.in[4]; const float* cb = F.in[5];
    const int NT = MTOK / 32 * 128;
    for (int g = F.bid * NTHR + F.tid; g < NT; g += F.G * NTHR) {
        const int chunk = g & 127, run = g >> 7, c0 = chunk * 8, m0 = run * 32, t0 = m0 & (SEQ - 1);
        float w[4][8], bias[8];
#pragma unroll
        for (int j = 0; j < 4; ++j) { const f32x4 a = *(const f32x4*)(cw + j * DM + c0), b = *(const f32x4*)(cw + j * DM + c0 + 4);
            w[j][0] = a[0]; w[j][1] = a[1]; w[j][2] = a[2]; w[j][3] = a[3]; w[j][4] = b[0]; w[j][5] = b[1]; w[j][6] = b[2]; w[j][7] = b[3]; }
        { const f32x4 a = *(const f32x4*)(cb + c0), b = *(const f32x4*)(cb + c0 + 4);
            bias[0] = a[0]; bias[1] = a[1]; bias[2] = a[2]; bias[3] = a[3]; bias[4] = b[0]; bias[5] = b[1]; bias[6] = b[2]; bias[7] = b[3]; }
        const v4u zero = {0u, 0u, 0u, 0u};
#pragma unroll 1
        for (int hb = 0; hb < 2; ++hb) {
            const int r0 = m0 + 16 * hb, tt = t0 + 16 * hb;
            v4u rows[19];
            rows[0] = (tt >= 2) ? *(const v4u*)(XM + (size_t)(r0 - 2) * DM + c0) : zero;
            rows[1] = (tt >= 1) ? *(const v4u*)(XM + (size_t)(r0 - 1) * DM + c0) : zero;
#pragma unroll
            for (int i = 0; i < 16; ++i) rows[2 + i] = *(const v4u*)(XM + (size_t)(r0 + i) * DM + c0);
            rows[18] = (tt + 16 < SEQ) ? *(const v4u*)(XM + (size_t)(r0 + 16) * DM + c0) : zero;
#pragma unroll
            for (int i = 0; i < 16; ++i) {
                float y[8];
#pragma unroll
                for (int e = 0; e < 8; ++e) y[e] = bias[e];
#pragma unroll
                for (int j = 0; j < 4; ++j) {
                    const unsigned p0 = rows[i + j].x, p1 = rows[i + j].y, p2 = rows[i + j].z, p3 = rows[i + j].w;
                    y[0] += w[j][0] * bflo(p0); y[1] += w[j][1] * bfhi(p0); y[2] += w[j][2] * bflo(p1); y[3] += w[j][3] * bfhi(p1);
                    y[4] += w[j][4] * bflo(p2); y[5] += w[j][5] * bfhi(p2); y[6] += w[j][6] * bflo(p3); y[7] += w[j][7] * bfhi(p3);
                }
#pragma unroll
                for (int e = 0; e < 8; ++e) y[e] = y[e] * sigmoidf_(y[e]);
                v4u o; o.x = pk2(y[0], y[1]); o.y = pk2(y[2], y[3]); o.z = pk2(y[4], y[5]); o.w = pk2(y[6], y[7]);
                *(v4u*)(XC + (size_t)(r0 + i) * DM + c0) = o;
            }
        }
    }
}

typedef short s16x4 __attribute__((ext_vector_type(4)));
__device__ __forceinline__ bf16x8 tr_read_pair(unsigned a0, unsigned a1) {
    s16x4 r0, r1;
    asm volatile("ds_read_b64_tr_b16 %0, %2\n\tds_read_b64_tr_b16 %1, %3\n\ts_waitcnt lgkmcnt(0)" : "=&v"(r0), "=&v"(r1) : "v"(a0), "v"(a1) : "memory");
    return __builtin_shufflevector(r0, r1, 0, 1, 2, 3, 4, 5, 6, 7);
}
__device__ __forceinline__ float dpp_shr(float oldv, float x, int n) {
    const int o = __builtin_bit_cast(int, oldv), v = __builtin_bit_cast(int, x);
    int r;
    if (n == 1) r = __builtin_amdgcn_update_dpp(o, v, 0x111, 0xf, 0xf, false);
    else if (n == 2) r = __builtin_amdgcn_update_dpp(o, v, 0x112, 0xf, 0xf, false);
    else if (n == 4) r = __builtin_amdgcn_update_dpp(o, v, 0x114, 0xf, 0xf, false);
    else r = __builtin_amdgcn_update_dpp(o, v, 0x118, 0xf, 0xf, false);
    return __builtin_bit_cast(float, r);
}
__device__ __forceinline__ float rdlane(float x, int l) { return __builtin_bit_cast(float, __builtin_amdgcn_readlane(__builtin_bit_cast(int, x), l)); }
__device__ __forceinline__ float wave_incl_sum(float x, int lane) {
    x += dpp_shr(0.f, x, 1); x += dpp_shr(0.f, x, 2); x += dpp_shr(0.f, x, 4); x += dpp_shr(0.f, x, 8);
    const float t0 = rdlane(x, 15), t1 = rdlane(x, 31), t2 = rdlane(x, 47);
    return x + (lane >= 16 ? t0 : 0.f) + (lane >= 32 ? t1 : 0.f) + (lane >= 48 ? t2 : 0.f);
}
__device__ __forceinline__ float wave_incl_max(float x, int lane) {
    const float NI = -INFINITY;
    x = fmaxf(x, dpp_shr(NI, x, 1)); x = fmaxf(x, dpp_shr(NI, x, 2)); x = fmaxf(x, dpp_shr(NI, x, 4)); x = fmaxf(x, dpp_shr(NI, x, 8));
    const float t0 = rdlane(x, 15), t1 = rdlane(x, 31), t2 = rdlane(x, 47);
    return fmaxf(fmaxf(x, lane >= 16 ? t0 : NI), fmaxf(lane >= 32 ? t1 : NI, lane >= 48 ? t2 : NI));
}
__device__ __forceinline__ void mscan_phase(Frame& F) {
    const bf16* Q = (const bf16*)(F.ws + WS_LG); const bf16* K = (const bf16*)(F.ws + WS_K); const bf16* V = (const bf16*)F.out + (size_t)MTOK * DM;
    const float* GT = (const float*)(F.ws + WS_GATE);
    constexpr int KS = 0, CTI = 33792, VT = 67584, VWT = 86016, PB = 104448, TAB = 113664, NT = 116736, NPART = 117760, DENT = 119808;
    constexpr int KST = 528, VST = 144, TABSZ = 1536;
    LAS unsigned char* L = F.lds;
    const int tid = F.tid, lane = F.lane, w = F.wave, fr = lane & 15, fq = lane >> 4, pt = w & 3, wg = w >> 2;
    for (int it_ = F.bid; it_ < 256; it_ += F.G) {
        const int item = ((((it_ >> 3) >> 2) * 8 + (it_ & 7)) << 2) | ((it_ >> 3) & 3);
        const int es = item & 3, dir = (item >> 2) & 1, h = (item >> 3) & 3, b = item >> 5;
        bf16* H = dir ? (bf16*)(F.ws + WS_XL) : (bf16*)(F.ws + WS_XM);
        const size_t rowbase = (size_t)b * SEQ;
#define TOF(c, p) (dir ? (SEQ - 1 - 64 * (c) - (p)) : (64 * (c) + (p)))
        for (int e = tid; e < (33792 + 1024) / 4; e += NTHR) { if (e < 33792 / 4) ((LAS unsigned*)(L + CTI))[e] = 0u; else ((LAS unsigned*)(L + NT))[e - 33792 / 4] = 0u; }
        float m_run = 0.f;
        float gi_n = 0.f, gf_n = 0.f;
        if (w == 4) { const size_t m = rowbase + TOF(0, lane); gi_n = GT[m * 16 + dir * 8 + h]; gf_n = GT[m * 16 + dir * 8 + 4 + h]; }
#define G1_TABLES(setp) do { \
            const float logf_ = fminf(gf_n, 0.f) - __logf(1.f + __expf(-fabsf(gf_n))); const float b_ = wave_incl_sum(logf_, lane); const float a_ = gi_n - b_; \
            const float M_ = fmaxf(m_run, wave_incl_max(a_, lane)); const float Mend_ = rdlane(M_, 63), g_ = rdlane(b_, 63); \
            LAS float* T_ = (LAS float*)(setp); T_[lane] = a_; T_[64 + lane] = M_; T_[128 + lane] = __expf(m_run - M_); T_[192 + lane] = __expf(-(b_ + M_)); T_[256 + lane] = __expf(a_ - Mend_); \
            if (lane == 0) { T_[320] = __expf(m_run - Mend_); T_[321] = g_ + Mend_; } \
            m_run = g_ + Mend_; } while (0)
        if (w == 4) { G1_TABLES(L + TAB); const size_t m = rowbase + TOF(1, lane); gi_n = GT[m * 16 + dir * 8 + h]; gf_n = GT[m * 16 + dir * 8 + 4 + h]; }
        __syncthreads();
        bf16x8 qf[8];
        v4u kreg[4]; v4u vreg;
#define LOAD_KV(c) do { _Pragma("unroll") for (int r_ = 0; r_ < 4; ++r_) { const int i_ = tid + NTHR * r_, s_ = i_ >> 5, c16_ = i_ & 31; \
                kreg[r_] = *(const v4u*)(K + (rowbase + TOF(c, s_)) * DM + h * 256 + c16_ * 8); } \
            { const int s_ = tid & 63, e8_ = tid >> 6; vreg = *(const v4u*)(V + (rowbase + TOF(c, s_)) * DM + h * 256 + es * 64 + e8_ * 8); } } while (0)
#define STORE_KV(setidx) do { _Pragma("unroll") for (int r_ = 0; r_ < 4; ++r_) { const int i_ = tid + NTHR * r_, s_ = i_ >> 5, c16_ = i_ & 31; \
                *(LAS v4u*)(L + KS + s_ * KST + c16_ * 16) = kreg[r_]; } \
            {   \
              const int s_ = tid & 63, e8_ = tid >> 6; const bool od_ = (s_ & 1) != 0; const float ws_ = ((const LAS float*)(L + TAB + (setidx) * TABSZ))[256 + s_]; \
              const float wsp_ = __builtin_bit_cast(float, __builtin_amdgcn_update_dpp(0, __builtin_bit_cast(int, ws_), 0xB1, 0xf, 0xf, false)); \
              const unsigned snd0_ = od_ ? vreg.x : vreg.z, snd1_ = od_ ? vreg.y : vreg.w; \
              const unsigned rc0_ = (unsigned)__builtin_amdgcn_update_dpp(0, (int)snd0_, 0xB1, 0xf, 0xf, false), rc1_ = (unsigned)__builtin_amdgcn_update_dpp(0, (int)snd1_, 0xB1, 0xf, 0xf, false); \
              const unsigned E0_ = od_ ? rc0_ : vreg.x, E1_ = od_ ? rc1_ : vreg.y, O0_ = od_ ? vreg.z : rc0_, O1_ = od_ ? vreg.w : rc1_; \
              const float wE_ = od_ ? wsp_ : ws_, wO_ = od_ ? ws_ : wsp_; \
              const int ro_ = (e8_ * 8 + (od_ ? 4 : 0)) * VST + (s_ & ~1) * 2; \
              LAS unsigned* vt_ = (LAS unsigned*)(L + VT + (setidx) * 9216 + ro_); LAS unsigned* vw_ = (LAS unsigned*)(L + VWT + (setidx) * 9216 + ro_); \
              vt_[0] = (E0_ & 0xffffu) | (O0_ << 16); vt_[36] = (E0_ >> 16) | (O0_ & 0xffff0000u); vt_[72] = (E1_ & 0xffffu) | (O1_ << 16); vt_[108] = (E1_ >> 16) | (O1_ & 0xffff0000u); \
              vw_[0] = pk2(bflo(E0_) * wE_, bflo(O0_) * wO_); vw_[36] = pk2(bfhi(E0_) * wE_, bfhi(O0_) * wO_); vw_[72] = pk2(bflo(E1_) * wE_, bflo(O1_) * wO_); vw_[108] = pk2(bfhi(E1_) * wE_, bfhi(O1_) * wO_); } } while (0)
#define LOAD_Q(c) do { const size_t m_ = rowbase + TOF(c, 16 * pt + fr); _Pragma("unroll") for (int ks_ = 0; ks_ < 8; ++ks_) \
                qf[ks_] = *(const bf16x8*)(Q + m_ * DM + h * 256 + 32 * ks_ + 8 * fq); } while (0)
        LOAD_KV(0); LOAD_Q(0);
        STORE_KV(0);
        f32x4 Cacc[8], Nacc[2];
#pragma unroll
        for (int i = 0; i < 8; ++i) Cacc[i] = (f32x4){0.f, 0.f, 0.f, 0.f};
        Nacc[0] = (f32x4){0.f, 0.f, 0.f, 0.f}; Nacc[1] = (f32x4){0.f, 0.f, 0.f, 0.f};
        __syncthreads();
        for (int c = 0; c < 64; ++c) {
            const int cur = c & 1, nxt = cur ^ 1;
            const bool has_next = (c + 1 < 64);
            const LAS float* T = (const LAS float*)(L + TAB + cur * TABSZ);
            const int p = 16 * pt + fr;
            const float Mp = T[64 + p], wi_p = T[128 + p];
            float cs = 0.f;
            f32x4 O[2] = {(f32x4){0.f, 0.f, 0.f, 0.f}, (f32x4){0.f, 0.f, 0.f, 0.f}}, sa[2] = {(f32x4){0.f, 0.f, 0.f, 0.f}, (f32x4){0.f, 0.f, 0.f, 0.f}};
            const bool s0on = (2 * wg <= pt), s1on = (2 * wg + 1 <= pt);
#define KF(i, ks) (*(const LAS bf16x8*)(L + KS + (16 * (2 * wg + (i)) + fr) * KST + (32 * (ks) + 8 * fq) * 2))
#define CF(i, ks) (*(const LAS bf16x8*)(L + CTI + (16 * (2 * wg + (i)) + fr) * KST + (32 * (ks) + 8 * fq) * 2))
            if (s1on) {
#pragma unroll
                for (int ks = 0; ks < 8; ++ks) { const bf16x8 k0 = KF(0, ks), k1 = KF(1, ks), c0 = CF(0, ks), c1 = CF(1, ks);
                    sa[0] = __builtin_amdgcn_mfma_f32_16x16x32_bf16(k0, qf[ks], sa[0], 0, 0, 0); sa[1] = __builtin_amdgcn_mfma_f32_16x16x32_bf16(k1, qf[ks], sa[1], 0, 0, 0);
                    O[0] = __builtin_amdgcn_mfma_f32_16x16x32_bf16(c0, qf[ks], O[0], 0, 0, 0); O[1] = __builtin_amdgcn_mfma_f32_16x16x32_bf16(c1, qf[ks], O[1], 0, 0, 0); }
            } else if (s0on) {
#pragma unroll
                for (int ks = 0; ks < 8; ++ks) { const bf16x8 k0 = KF(0, ks), c0 = CF(0, ks), c1 = CF(1, ks);
                    sa[0] = __builtin_amdgcn_mfma_f32_16x16x32_bf16(k0, qf[ks], sa[0], 0, 0, 0);
                    O[0] = __builtin_amdgcn_mfma_f32_16x16x32_bf16(c0, qf[ks], O[0], 0, 0, 0); O[1] = __builtin_amdgcn_mfma_f32_16x16x32_bf16(c1, qf[ks], O[1], 0, 0, 0); }
            } else {
#pragma unroll
                for (int ks = 0; ks < 8; ++ks) { const bf16x8 c0 = CF(0, ks), c1 = CF(1, ks);
                    O[0] = __builtin_amdgcn_mfma_f32_16x16x32_bf16(c0, qf[ks], O[0], 0, 0, 0); O[1] = __builtin_amdgcn_mfma_f32_16x16x32_bf16(c1, qf[ks], O[1], 0, 0, 0); }
            }
#undef KF
#undef CF
            float gi_p = 0.f, gf_p = 0.f;
            if (has_next) { LOAD_KV(c + 1); if (w == 4 && c + 2 < 64) { const size_t m = rowbase + TOF(c + 2, lane); gi_p = GT[m * 16 + dir * 8 + h]; gf_p = GT[m * 16 + dir * 8 + 4 + h]; } }
            __builtin_amdgcn_sched_barrier(0);
#pragma unroll
            for (int i = 0; i < 2; ++i) { const int st = 2 * wg + i;
                v2u pw = {0u, 0u};
                if (i ? s1on : s0on) {
                    const f32x4 a4 = *(const LAS f32x4*)(T + 16 * st + 4 * fq);
                    float pv[4];
#pragma unroll
                    for (int r = 0; r < 4; ++r) { const int s_ = 16 * st + 4 * fq + r; const float wgt = (s_ <= p) ? __expf(a4[r] - Mp) : 0.f; pv[r] = sa[i][r] * wgt; cs += pv[r]; }
                    pw.x = pk2(pv[0], pv[1]); pw.y = pk2(pv[2], pv[3]);
                }
                *(LAS v2u*)(L + PB + p * VST + (16 * st + 4 * fq) * 2) = pw; }
            float di = 0.f;
#define DEN_INTER(ks) do { const f32x4 n0 = *(const LAS f32x4*)(L + NT + (32 * (ks) + 8 * fq) * 4), n1 = *(const LAS f32x4*)(L + NT + (32 * (ks) + 8 * fq) * 4 + 16); \
                const v4u qw = __builtin_bit_cast(v4u, qf[ks]); \
                di += bflo(qw.x) * n0[0] + bfhi(qw.x) * n0[1] + bflo(qw.y) * n0[2] + bfhi(qw.y) * n0[3] + bflo(qw.z) * n1[0] + bfhi(qw.z) * n1[1] + bflo(qw.w) * n1[2] + bfhi(qw.w) * n1[3]; } while (0)
            if (wg == 0) { DEN_INTER(0); DEN_INTER(1); DEN_INTER(2); DEN_INTER(3); }
            else { DEN_INTER(4); DEN_INTER(5); DEN_INTER(6); DEN_INTER(7); }
#undef DEN_INTER
            di += __shfl_xor(di, 16); di += __shfl_xor(di, 32);
            cs += __shfl_xor(cs, 16); cs += __shfl_xor(cs, 32);
            if (fq == 0) ((LAS float*)(L + DENT))[wg * 64 + p] = wi_p * di + cs;
            if (has_next) LOAD_Q(c + 1);
            __builtin_amdgcn_sched_barrier(0);
            if (has_next && w == 4) G1_TABLES(L + TAB + nxt * TABSZ);
            { const float decay = T[320];
              const bf16x8 vw0 = *(const LAS bf16x8*)(L + VWT + cur * 9216 + (16 * pt + fr) * VST + (8 * fq) * 2);
              const bf16x8 vw1 = *(const LAS bf16x8*)(L + VWT + cur * 9216 + (16 * pt + fr) * VST + (32 + 8 * fq) * 2);
              bf16x8 wsf0, wsf1;
              { const f32x4 w0 = *(const LAS f32x4*)(T + 256 + 8 * fq), w1 = *(const LAS f32x4*)(T + 256 + 8 * fq + 4), w2 = *(const LAS f32x4*)(T + 288 + 8 * fq), w3 = *(const LAS f32x4*)(T + 288 + 8 * fq + 4);
                const bool c0 = (fr == 0);
                v4u a, b; a.x = c0 ? pk2(w0[0], w0[1]) : 0u; a.y = c0 ? pk2(w0[2], w0[3]) : 0u; a.z = c0 ? pk2(w1[0], w1[1]) : 0u; a.w = c0 ? pk2(w1[2], w1[3]) : 0u;
                b.x = c0 ? pk2(w2[0], w2[1]) : 0u; b.y = c0 ? pk2(w2[2], w2[3]) : 0u; b.z = c0 ? pk2(w3[0], w3[1]) : 0u; b.w = c0 ? pk2(w3[2], w3[3]) : 0u;
                wsf0 = __builtin_bit_cast(bf16x8, a); wsf1 = __builtin_bit_cast(bf16x8, b); }
              const int l16 = lane & 15, q4 = l16 >> 2, p4 = l16 & 3;
              const unsigned kb = (unsigned)(uintptr_t)(L + KS) + (unsigned)((8 * fq + q4) * KST + 4 * p4 * 2);
#define TR_READS "ds_read_b64_tr_b16 %0, %[ad]\n\tds_read_b64_tr_b16 %1, %[ad] offset:2112\n\tds_read_b64_tr_b16 %2, %[ad] offset:16896\n\tds_read_b64_tr_b16 %3, %[ad] offset:19008\n\t" \
                 "ds_read_b64_tr_b16 %4, %[ad] offset:32\n\tds_read_b64_tr_b16 %5, %[ad] offset:2144\n\tds_read_b64_tr_b16 %6, %[ad] offset:16928\n\tds_read_b64_tr_b16 %7, %[ad] offset:19040"
#define TR_OUT(R) "=&v"(R[0]), "=&v"(R[1]), "=&v"(R[2]), "=&v"(R[3]), "=&v"(R[4]), "=&v"(R[5]), "=&v"(R[6]), "=&v"(R[7])
#define TR_INOUT(R) "+v"(R[0]), "+v"(R[1]), "+v"(R[2]), "+v"(R[3]), "+v"(R[4]), "+v"(R[5]), "+v"(R[6]), "+v"(R[7])
              s16x4 rA[8], rB[8];
              { const unsigned a0 = kb + (8 * wg) * 32; asm volatile(TR_READS : TR_OUT(rA) : [ad] "v"(a0) : "memory"); }
#define C_STEP(dtl, RC, RN) do { \
                  if ((dtl) < 6) { const unsigned a1 = kb + (8 * wg + (dtl) + 2) * 32; asm volatile(TR_READS "\n\ts_waitcnt lgkmcnt(8)" : TR_OUT(RN), TR_INOUT(RC) : [ad] "v"(a1) : "memory"); } \
                  else asm volatile("s_waitcnt lgkmcnt(0)" : TR_INOUT(RC) : : "memory"); \
                  const bf16x8 k0 = __builtin_shufflevector(RC[0], RC[1], 0, 1, 2, 3, 4, 5, 6, 7), k1 = __builtin_shufflevector(RC[2], RC[3], 0, 1, 2, 3, 4, 5, 6, 7); \
                  const bf16x8 k2 = __builtin_shufflevector(RC[4], RC[5], 0, 1, 2, 3, 4, 5, 6, 7), k3 = __builtin_shufflevector(RC[6], RC[7], 0, 1, 2, 3, 4, 5, 6, 7); \
                  Cacc[dtl] = Cacc[dtl] * decay; Cacc[(dtl) + 1] = Cacc[(dtl) + 1] * decay; \
                  Cacc[dtl] = __builtin_amdgcn_mfma_f32_16x16x32_bf16(k0, vw0, Cacc[dtl], 0, 0, 0); \
                  Cacc[(dtl) + 1] = __builtin_amdgcn_mfma_f32_16x16x32_bf16(k2, vw0, Cacc[(dtl) + 1], 0, 0, 0); \
                  Cacc[dtl] = __builtin_amdgcn_mfma_f32_16x16x32_bf16(k1, vw1, Cacc[dtl], 0, 0, 0); \
                  Cacc[(dtl) + 1] = __builtin_amdgcn_mfma_f32_16x16x32_bf16(k3, vw1, Cacc[(dtl) + 1], 0, 0, 0); \
                  if ((dtl) == 2 * pt) {                                            \
                      Nacc[0] = Nacc[0] * decay; Nacc[1] = Nacc[1] * decay; \
                      Nacc[0] = __builtin_amdgcn_mfma_f32_16x16x32_bf16(k0, wsf0, Nacc[0], 0, 0, 0); Nacc[1] = __builtin_amdgcn_mfma_f32_16x16x32_bf16(k2, wsf0, Nacc[1], 0, 0, 0); \
                      Nacc[0] = __builtin_amdgcn_mfma_f32_16x16x32_bf16(k1, wsf1, Nacc[0], 0, 0, 0); Nacc[1] = __builtin_amdgcn_mfma_f32_16x16x32_bf16(k3, wsf1, Nacc[1], 0, 0, 0); } } while (0)
              C_STEP(0, rA, rB); C_STEP(2, rB, rA); C_STEP(4, rA, rB); C_STEP(6, rB, rA);
#undef C_STEP
#undef TR_READS
#undef TR_OUT
#undef TR_INOUT
            }
            __syncthreads();
#pragma unroll
            for (int i = 0; i < 2; ++i) { const int et = 2 * wg + i; O[i] = O[i] * wi_p;
#pragma unroll
                for (int ks = 0; ks < 2; ++ks) { const bf16x8 vf = *(const LAS bf16x8*)(L + VT + cur * 9216 + (16 * et + fr) * VST + (32 * ks + 8 * fq) * 2);
                    const bf16x8 pf = *(const LAS bf16x8*)(L + PB + p * VST + (32 * ks + 8 * fq) * 2);
                    O[i] = __builtin_amdgcn_mfma_f32_16x16x32_bf16(vf, pf, O[i], 0, 0, 0); } }
            v2u hout[2];
            { const float den = ((const LAS float*)(L + DENT))[p] + ((const LAS float*)(L + DENT))[64 + p];
              const float inv = 1.f / fmaxf(fabsf(den), T[192 + p]);
#pragma unroll
              for (int i = 0; i < 2; ++i) { hout[i].x = pk2(O[i][0] * inv, O[i][1] * inv); hout[i].y = pk2(O[i][2] * inv, O[i][3] * inv); } }
            { const float decay = T[320];
#pragma unroll
              for (int dtl = 0; dtl < 8; ++dtl) { const int dt = 8 * wg + dtl; v2u o; o.x = pk2(Cacc[dtl][0], Cacc[dtl][1]); o.y = pk2(Cacc[dtl][2], Cacc[dtl][3]);
                  *(LAS v2u*)(L + CTI + (16 * pt + fr) * KST + (16 * dt + 4 * fq) * 2) = o; }
              if (fr == 0) { *(LAS f32x4*)(L + NT + (16 * (8 * wg + 2 * pt) + 4 * fq) * 4) = Nacc[0]; *(LAS f32x4*)(L + NT + (16 * (8 * wg + 2 * pt + 1) + 4 * fq) * 4) = Nacc[1]; } }
            if (has_next) STORE_KV(nxt);
            gi_n = gi_p; gf_n = gf_p;
            { const size_t m = rowbase + TOF(c, p);
#pragma unroll
              for (int i = 0; i < 2; ++i) *(v2u*)(H + m * DM + h * 256 + es * 64 + 16 * (2 * wg + i) + 4 * fq) = hout[i]; }
            __syncthreads();
        }
#undef TOF
#undef G1_TABLES
#undef LOAD_KV
#undef STORE_KV
#undef LOAD_Q
    }
}

__device__ __forceinline__ void ym_phase(Frame& F) {
    const bf16* HF = (const bf16*)(F.ws + WS_XM); const bf16* HB = (const bf16*)(F.ws + WS_XL); bf16* OP = (bf16*)(F.ws + WS_OP);
    const float* ng = F.in[9];
    const int gw = F.bid * NWAVES + F.wave, NGW = F.G * NWAVES;
    for (int m0 = 2 * gw; m0 < MTOK; m0 += 2 * NGW) {
        v2u ra[2][4], rb[2][4], rop[2][4];
#pragma unroll
        for (int t = 0; t < 2; ++t)
#pragma unroll
            for (int hd = 0; hd < 4; ++hd) { const size_t o = (size_t)(m0 + t) * DM + hd * 256 + F.lane * 4;
                ra[t][hd] = *(const v2u*)(HF + o); rb[t][hd] = *(const v2u*)(HB + o); rop[t][hd] = *(const v2u*)(OP + o); }
#pragma unroll
        for (int t = 0; t < 2; ++t)
#pragma unroll
            for (int hd = 0; hd < 4; ++hd) {
                const size_t o = (size_t)(m0 + t) * DM + hd * 256 + F.lane * 4;
                const v2u a = ra[t][hd], b = rb[t][hd], op = rop[t][hd];
                const float v0 = bflo(a.x) + bflo(b.x), v1 = bfhi(a.x) + bfhi(b.x), v2 = bflo(a.y) + bflo(b.y), v3 = bfhi(a.y) + bfhi(b.y);
                const float r = rsqrtf(wave_sum((v0 * v0 + v1 * v1) + (v2 * v2 + v3 * v3)) * (1.f / 256.f) + EPS);
                const f32x4 g = *(const f32x4*)(ng + hd * 256 + F.lane * 4);
                v2u w; w.x = pk2(sigmoidf_(bflo(op.x)) * v0 * r * g[0], sigmoidf_(bfhi(op.x)) * v1 * r * g[1]);
                w.y = pk2(sigmoidf_(bflo(op.y)) * v2 * r * g[2], sigmoidf_(bfhi(op.y)) * v3 * r * g[3]);
                *(v2u*)(OP + o) = w;
            }
    }
}

typedef float f32x16 __attribute__((ext_vector_type(16)));
#define TOPK_INSERT(L, xv) do { const float x_ = (xv); \
    L[15] = __builtin_amdgcn_fmed3f(L[14], L[15], x_); L[14] = __builtin_amdgcn_fmed3f(L[13], L[14], x_); L[13] = __builtin_amdgcn_fmed3f(L[12], L[13], x_); L[12] = __builtin_amdgcn_fmed3f(L[11], L[12], x_); \
    L[11] = __builtin_amdgcn_fmed3f(L[10], L[11], x_); L[10] = __builtin_amdgcn_fmed3f(L[9], L[10], x_); L[9] = __builtin_amdgcn_fmed3f(L[8], L[9], x_); L[8] = __builtin_amdgcn_fmed3f(L[7], L[8], x_); \
    L[7] = __builtin_amdgcn_fmed3f(L[6], L[7], x_); L[6] = __builtin_amdgcn_fmed3f(L[5], L[6], x_); L[5] = __builtin_amdgcn_fmed3f(L[4], L[5], x_); L[4] = __builtin_amdgcn_fmed3f(L[3], L[4], x_); \
    L[3] = __builtin_amdgcn_fmed3f(L[2], L[3], x_); L[2] = __builtin_amdgcn_fmed3f(L[1], L[2], x_); L[1] = __builtin_amdgcn_fmed3f(L[0], L[1], x_); L[0] = fmaxf(L[0], x_); } while (0)
#define SEL_CE(L, a, b) do { const float hi_ = fmaxf(L[a], L[b]), lo_ = fminf(L[a], L[b]); L[a] = hi_; L[b] = lo_; } while (0)
#define SORT16_DESC(L) do { SEL_CE(L, 0, 1); SEL_CE(L, 2, 3); SEL_CE(L, 0, 2); SEL_CE(L, 1, 3); SEL_CE(L, 1, 2); SEL_CE(L, 4, 5); SEL_CE(L, 6, 7); SEL_CE(L, 4, 6); SEL_CE(L, 5, 7); SEL_CE(L, 5, 6); SEL_CE(L, 0, 4); SEL_CE(L, 2, 6); SEL_CE(L, 2, 4); SEL_CE(L, 1, 5); SEL_CE(L, 3, 7); SEL_CE(L, 3, 5); SEL_CE(L, 1, 2); SEL_CE(L, 3, 4); SEL_CE(L, 5, 6); SEL_CE(L, 8, 9); SEL_CE(L, 10, 11); SEL_CE(L, 8, 10); SEL_CE(L, 9, 11); SEL_CE(L, 9, 10); SEL_CE(L, 12, 13); SEL_CE(L, 14, 15); SEL_CE(L, 12, 14); SEL_CE(L, 13, 15); SEL_CE(L, 13, 14); SEL_CE(L, 8, 12); SEL_CE(L, 10, 14); SEL_CE(L, 10, 12); SEL_CE(L, 9, 13); SEL_CE(L, 11, 15); SEL_CE(L, 11, 13); SEL_CE(L, 9, 10); SEL_CE(L, 11, 12); SEL_CE(L, 13, 14); SEL_CE(L, 0, 8); SEL_CE(L, 4, 12); SEL_CE(L, 4, 8); SEL_CE(L, 2, 10); SEL_CE(L, 6, 14); SEL_CE(L, 6, 10); SEL_CE(L, 2, 4); SEL_CE(L, 6, 8); SEL_CE(L, 10, 12); SEL_CE(L, 1, 9); SEL_CE(L, 5, 13); SEL_CE(L, 5, 9); SEL_CE(L, 3, 11); SEL_CE(L, 7, 15); SEL_CE(L, 7, 11); SEL_CE(L, 3, 5); SEL_CE(L, 7, 9); SEL_CE(L, 11, 13); SEL_CE(L, 1, 2); SEL_CE(L, 3, 4); SEL_CE(L, 5, 6); SEL_CE(L, 7, 8); SEL_CE(L, 9, 10); SEL_CE(L, 11, 12); SEL_CE(L, 13, 14); } while (0)
#define BMERGE16_DESC(L) do { SEL_CE(L, 0, 8); SEL_CE(L, 1, 9); SEL_CE(L, 2, 10); SEL_CE(L, 3, 11); SEL_CE(L, 4, 12); SEL_CE(L, 5, 13); SEL_CE(L, 6, 14); SEL_CE(L, 7, 15); SEL_CE(L, 0, 4); SEL_CE(L, 1, 5); SEL_CE(L, 2, 6); SEL_CE(L, 3, 7); SEL_CE(L, 8, 12); SEL_CE(L, 9, 13); SEL_CE(L, 10, 14); SEL_CE(L, 11, 15); SEL_CE(L, 0, 2); SEL_CE(L, 1, 3); SEL_CE(L, 4, 6); SEL_CE(L, 5, 7); SEL_CE(L, 8, 10); SEL_CE(L, 9, 11); SEL_CE(L, 12, 14); SEL_CE(L, 13, 15); SEL_CE(L, 0, 1); SEL_CE(L, 2, 3); SEL_CE(L, 4, 5); SEL_CE(L, 6, 7); SEL_CE(L, 8, 9); SEL_CE(L, 10, 11); SEL_CE(L, 12, 13); SEL_CE(L, 14, 15); } while (0)
template <int I> struct CandRow {
    static __device__ __forceinline__ void run(const float (&L0)[16], const float (&L1)[16], float (&R)[16]) {
        constexpr int NJ = 16 / (I + 1);
#pragma unroll
        for (int j = 0; j < NJ; ++j) { const float sm = L0[I] + L1[j];
            const float pk = __builtin_bit_cast(float, (__builtin_bit_cast(unsigned, sm) & 0xffffff00u) | (unsigned)(I * 16 + j)); TOPK_INSERT(R, pk); }
        if constexpr (I < 15) CandRow<I + 1>::run(L0, L1, R);
    }
};
__device__ __forceinline__ unsigned pick4(unsigned d0, unsigned d1, unsigned d2, unsigned d3, int i) {
    const int q = i >> 2; unsigned d = d0; d = (q == 1) ? d1 : d; d = (q == 2) ? d2 : d; d = (q == 3) ? d3 : d; return (d >> (8 * (i & 3))) & 127u;
}
__device__ __forceinline__ void select_phase(Frame& F) {
    const bf16* PQ = (const bf16*)(F.ws + WS_MG);
    int* IDX = (int*)(F.ws + WS_K); float* GW = (float*)(F.ws + WS_K + 16 * MiB);
    LAS unsigned char* L = F.lds;
    const int tid = F.tid, lane = F.lane, w = F.wave, l31 = lane & 31, hh = lane >> 5;
    const float NEG_INF = -INFINITY;
    for (int grp = F.bid; grp < MTOK / 128; grp += F.G) {
        const int tb = grp * 4 + (w & 3);
        const size_t m = (size_t)tb * 32 + l31;
        for (int hp = 0; hp < 4; ++hp) {
            const int hl = w >> 2, h = 2 * hp + hl;
            v4u sc[2][8];
#pragma unroll
            for (int p = 0; p < 2; ++p)
#pragma unroll
                for (int j = 0; j < 8; ++j) sc[p][j] = *(const v4u*)(PQ + m * 2048 + h * 256 + p * 128 + 64 * hh + 8 * j);
            float L0[16], L1[16];
#pragma unroll
            for (int p = 0; p < 2; ++p) {
                float Lc[16];
                const unsigned hh64 = (unsigned)hh << 6;
#pragma unroll
                for (int kb = 0; kb < 4; ++kb) { float Nw[16];
#pragma unroll
                    for (int r = 0; r < 16; ++r) { const v4u q4 = sc[p][2 * kb + (r >> 3)]; const int e = r & 7;
                        const unsigned wd = (e >> 1) == 0 ? q4.x : (e >> 1) == 1 ? q4.y : (e >> 1) == 2 ? q4.z : q4.w;
                        const unsigned bits = (e & 1) ? (wd & 0xffff0000u) : (wd << 16);
                        Nw[r] = __uint_as_float(bits | hh64 | (unsigned)(16 * kb + r)); }
                    SORT16_DESC(Nw);
                    if (kb == 0) {
#pragma unroll
                        for (int i = 0; i < 16; ++i) Lc[i] = Nw[i];
                    } else {
#pragma unroll
                        for (int i = 0; i < 16; ++i) Lc[i] = fmaxf(Lc[i], Nw[15 - i]);
                        BMERGE16_DESC(Lc); } }
                { float Lo[16];
#pragma unroll
                  for (int i = 0; i < 16; ++i) Lo[i] = __shfl_xor(Lc[i], 32);
#pragma unroll
                  for (int i = 0; i < 16; ++i) Lc[i] = fmaxf(Lc[i], Lo[15 - i]);
                  BMERGE16_DESC(Lc); }
#pragma unroll
                for (int i = 0; i < 16; ++i) { if (p == 0) L0[i] = Lc[i]; else L1[i] = Lc[i]; }
            }
            float R[16];
#pragma unroll
            for (int j = 0; j < 16; ++j) { const float sm = L0[0] + L1[j]; R[j] = __builtin_bit_cast(float, (__builtin_bit_cast(unsigned, sm) & 0xffffff00u) | (unsigned)j); }
            SORT16_DESC(R);
            CandRow<1>::run(L0, L1, R);
            unsigned a0 = 0, a1 = 0, a2 = 0, a3 = 0, b0 = 0, b1 = 0, b2 = 0, b3 = 0;
#pragma unroll
            for (int i = 0; i < 4; ++i) { a0 |= (__builtin_bit_cast(unsigned, L0[i]) & 127u) << (8 * i); a1 |= (__builtin_bit_cast(unsigned, L0[4 + i]) & 127u) << (8 * i);
                a2 |= (__builtin_bit_cast(unsigned, L0[8 + i]) & 127u) << (8 * i); a3 |= (__builtin_bit_cast(unsigned, L0[12 + i]) & 127u) << (8 * i);
                b0 |= (__builtin_bit_cast(unsigned, L1[i]) & 127u) << (8 * i); b1 |= (__builtin_bit_cast(unsigned, L1[4 + i]) & 127u) << (8 * i);
                b2 |= (__builtin_bit_cast(unsigned, L1[8 + i]) & 127u) << (8 * i); b3 |= (__builtin_bit_cast(unsigned, L1[12 + i]) & 127u) << (8 * i); }
            float ex[16]; float sum = 0.f; int id[16];
#pragma unroll
            for (int r = 0; r < 16; ++r) { ex[r] = __expf(R[r] - R[0]); sum += ex[r];
                const unsigned cid = __builtin_bit_cast(unsigned, R[r]) & 255u;
                id[r] = (int)(pick4(a0, a1, a2, a3, (int)(cid >> 4)) * 128u + pick4(b0, b1, b2, b3, (int)(cid & 15u))); }
            const float inv = 1.f / sum;
            if (hh == 0) {
#pragma unroll
                for (int q = 0; q < 4; ++q) {
                    *(int4*)(IDX + m * 128 + h * 16 + 4 * q) = make_int4(id[4 * q], id[4 * q + 1], id[4 * q + 2], id[4 * q + 3]);
                    *(f32x4*)(GW + m * 128 + h * 16 + 4 * q) = (f32x4){ex[4 * q] * inv, ex[4 * q + 1] * inv, ex[4 * q + 2] * inv, ex[4 * q + 3] * inv}; }
            }
        }
    }
}

template <int B> __device__ __forceinline__ f32x2 fp4b(unsigned w) { return __builtin_amdgcn_cvt_scalef32_pk_f32_fp4(w, 1.0f, B); }
__device__ __forceinline__ void sort128_by_index(int& a0, int& a1, float& g0, float& g1, int lane) {
#define S128_LANE_STAGE(K, J) do { const bool up_ = ((lane & (K)) == 0), low_ = ((lane & (J)) == 0), kmin_ = (up_ == low_); \
        { const int pv_ = __shfl_xor(a0, (J)); const float pg_ = __shfl_xor(g0, (J)); const bool tk_ = kmin_ ? (pv_ < a0) : (pv_ > a0); a0 = tk_ ? pv_ : a0; g0 = tk_ ? pg_ : g0; } \
        { const int pv_ = __shfl_xor(a1, (J)); const float pg_ = __shfl_xor(g1, (J)); const bool tk_ = kmin_ ? (pv_ < a1) : (pv_ > a1); a1 = tk_ ? pv_ : a1; g1 = tk_ ? pg_ : g1; } } while (0)
#define S128_LANE_STAGE_TOP(J) do { const bool low_ = ((lane & (J)) == 0);     \
        { const int pv_ = __shfl_xor(a0, (J)); const float pg_ = __shfl_xor(g0, (J)); const bool tk_ = low_ ? (pv_ < a0) : (pv_ > a0); a0 = tk_ ? pv_ : a0; g0 = tk_ ? pg_ : g0; } \
        { const int pv_ = __shfl_xor(a1, (J)); const float pg_ = __shfl_xor(g1, (J)); const bool tk_ = low_ ? (pv_ < a1) : (pv_ > a1); a1 = tk_ ? pv_ : a1; g1 = tk_ ? pg_ : g1; } } while (0)
    S128_LANE_STAGE(2, 1);
    S128_LANE_STAGE(4, 2); S128_LANE_STAGE(4, 1);
    S128_LANE_STAGE(8, 4); S128_LANE_STAGE(8, 2); S128_LANE_STAGE(8, 1);
    S128_LANE_STAGE(16, 8); S128_LANE_STAGE(16, 4); S128_LANE_STAGE(16, 2); S128_LANE_STAGE(16, 1);
    S128_LANE_STAGE(32, 16); S128_LANE_STAGE(32, 8); S128_LANE_STAGE(32, 4); S128_LANE_STAGE(32, 2); S128_LANE_STAGE(32, 1);
#define S128_K64(J) do { const bool low_ = ((lane & (J)) == 0); \
        { const int pv_ = __shfl_xor(a0, (J)); const float pg_ = __shfl_xor(g0, (J)); const bool tk_ = low_ ? (pv_ < a0) : (pv_ > a0); a0 = tk_ ? pv_ : a0; g0 = tk_ ? pg_ : g0; } \
        { const int pv_ = __shfl_xor(a1, (J)); const float pg_ = __shfl_xor(g1, (J)); const bool tk_ = low_ ? (pv_ > a1) : (pv_ < a1); a1 = tk_ ? pv_ : a1; g1 = tk_ ? pg_ : g1; } } while (0)
    S128_K64(32); S128_K64(16); S128_K64(8); S128_K64(4); S128_K64(2); S128_K64(1);
    { const bool sw_ = a1 < a0; const int t_ = a0; const float tg_ = g0; a0 = sw_ ? a1 : a0; g0 = sw_ ? g1 : g0; a1 = sw_ ? t_ : a1; g1 = sw_ ? tg_ : g1; }
    S128_LANE_STAGE_TOP(32); S128_LANE_STAGE_TOP(16); S128_LANE_STAGE_TOP(8); S128_LANE_STAGE_TOP(4); S128_LANE_STAGE_TOP(2); S128_LANE_STAGE_TOP(1);
#undef S128_LANE_STAGE
#undef S128_LANE_STAGE_TOP
#undef S128_K64
}
typedef int v8i_t __attribute__((ext_vector_type(8)));
#define AP_SLOT(e) (4 * (((e) >> 1) & 3) + 2 * ((e) >> 3) + ((e) & 1))
__device__ __forceinline__ void apply_phase(Frame& F, float* OUTP) {
    const unsigned char* U8 = F.ws + WS_TAB; const unsigned char* V8 = F.ws + WS_TAB + DM / 2;
    const float* USC = (const float*)(F.ws + WS_TAB + 16 * MiB); const float* VSC = USC + NEXP;
    const int* IDX = (const int*)(F.ws + WS_K); const float* GW = (const float*)(F.ws + WS_K + 16 * MiB);
    const float* g2 = F.in[20]; const float* gf = F.in[25];
    const bf16* X1B = (const bf16*)(F.ws + WS_XL);
    const int lane = F.lane, fr = lane & 15, fq = lane >> 4;
    constexpr int APW = 2 * 16 * 528 + 1024;
    LAS unsigned char* UL = F.lds + F.wave * APW; LAS unsigned char* VL = UL + 16 * 528; LAS unsigned char* H8 = VL + 16 * 528;
    const int pe = 2 * fq + (fr & 1) + 8 * ((fr >> 1) & 1);
    const int bsh = 8 * (fr & 3); const unsigned mlo = fr < 4 ? ~0u : 0u, mhi = (fr >= 4 && fr < 8) ? ~0u : 0u;
#define AP_LOADROWS(SEL, KB) _Pragma("unroll") for (int e = 0; e < 16; ++e) { \
        const size_t ro = (size_t)__builtin_amdgcn_readlane(SEL, ((KB) + e) & 63) * DM + lane * 16; uv[e] = *(const v4u*)(U8 + ro); }
    const unsigned uvb = (unsigned)((lane & 31) * 16); const bool isv = lane >= 32;
    for (int grp = F.bid; grp < MTOK / 128; grp += F.G) {
        const int mbase = grp * 128 + F.wave;
        int ni0 = IDX[(size_t)mbase * 128 + lane], ni1 = IDX[(size_t)mbase * 128 + 64 + lane];
        float ngw0 = GW[(size_t)mbase * 128 + lane], ngw1 = GW[(size_t)mbase * 128 + 64 + lane];
        f32x4 nxr[4];
#pragma unroll
        for (int q = 0; q < 4; ++q) { const v2u t = *(const v2u*)(X1B + (size_t)mbase * DM + lane * 16 + q * 4); nxr[q] = (f32x4){bflo(t.x), bfhi(t.x), bflo(t.y), bfhi(t.y)}; }
        sort128_by_index(ni0, ni1, ngw0, ngw1, lane);
        v4u uv[16];
        AP_LOADROWS(ni0, 0)
        float nsu, nsv;
        { const int nidx = __shfl(ni0, pe & 63); nsu = USC[nidx]; nsv = VSC[nidx]; }
        int i0 = 0, i1 = 0; float gw0 = 0.f, gw1 = 0.f; f32x4 xr[4], oacc[8];
#pragma unroll
        for (int q = 0; q < 4; ++q) xr[q] = (f32x4){0.f, 0.f, 0.f, 0.f};
#pragma unroll
        for (int i = 0; i < 8; ++i) oacc[i] = (f32x4){0.f, 0.f, 0.f, 0.f};
#pragma unroll 1
        for (int it = 0; it < 128; ++it) {
            const int bt = it & 7, m = mbase + 8 * (it >> 3);
            if (bt == 0) {
                i0 = ni0; i1 = ni1; gw0 = ngw0; gw1 = ngw1; float s = 0.f;
#pragma unroll
                for (int q = 0; q < 4; ++q) { xr[q] = nxr[q]; s += (xr[q][0] * xr[q][0] + xr[q][1] * xr[q][1]) + (xr[q][2] * xr[q][2] + xr[q][3] * xr[q][3]); }
                const float r2 = rsqrtf(wave_sum(s) * (1.f / DM) + EPS);
                v4u h8;
#pragma unroll
                for (int q = 0; q < 4; ++q) { const f32x4 g = *(const f32x4*)(g2 + lane * 16 + q * 4); const f32x4 hq = xr[q] * r2 * g;
                    int pk = 0; pk = __builtin_amdgcn_cvt_pk_fp8_f32(hq[0], hq[1], pk, false); pk = __builtin_amdgcn_cvt_pk_fp8_f32(hq[2], hq[3], pk, true); h8[q] = (unsigned)pk; }
                *(LAS v4u*)(H8 + lane * 16) = h8;
#pragma unroll
                for (int i = 0; i < 8; ++i) oacc[i] = (f32x4){0.f, 0.f, 0.f, 0.f};
                const int mn = (it + 8 < 128) ? m + 8 : m;
                ni0 = IDX[(size_t)mn * 128 + lane]; ni1 = IDX[(size_t)mn * 128 + 64 + lane]; ngw0 = GW[(size_t)mn * 128 + lane]; ngw1 = GW[(size_t)mn * 128 + 64 + lane];
#pragma unroll
                for (int q = 0; q < 4; ++q) { const v2u t = *(const v2u*)(X1B + (size_t)mn * DM + lane * 16 + q * 4); nxr[q] = (f32x4){bflo(t.x), bfhi(t.x), bflo(t.y), bfhi(t.y)}; }
            }
            if (bt == 3) sort128_by_index(ni0, ni1, ngw0, ngw1, lane);
            const int k0 = bt * 16;
            const int isel = (k0 < 64) ? i0 : i1;
            const int myidx = __shfl(isel, (k0 + pe) & 63);
            const float su = nsu, sv = nsv;
#pragma unroll
            for (int e = 0; e < 16; ++e) *(LAS v4u*)(UL + (isv ? 16 * 528 + e * 528 : AP_SLOT(e) * 528) + uvb) = uv[e];
            { const int nk = (k0 + 16) & 127; const int nsel = (bt == 7) ? ni0 : ((nk < 64) ? i0 : i1);
              AP_LOADROWS(nsel, nk)
              const int nidx = __shfl(nsel, (nk + pe) & 63); nsu = USC[nidx]; nsv = VSC[nidx]; }
            __builtin_amdgcn_sched_barrier(0);
            f32x4 da = (f32x4){0.f, 0.f, 0.f, 0.f}, db = (f32x4){0.f, 0.f, 0.f, 0.f};
#pragma unroll
            for (int ks = 0; ks < 8; ++ks) {
                const v4u af = *(const LAS v4u*)(UL + fr * 528 + 64 * ks + 16 * fq);
                const v4u b0 = *(const LAS v4u*)(H8 + 128 * ks + 16 * fq), b1 = *(const LAS v4u*)(H8 + 128 * ks + 64 + 16 * fq);
                const v8i_t A = {(int)af.x, (int)af.y, (int)af.z, (int)af.w, 0, 0, 0, 0};
                const v8i_t B = {(int)b0.x, (int)b0.y, (int)b0.z, (int)b0.w, (int)b1.x, (int)b1.y, (int)b1.z, (int)b1.w};
                if (ks & 1) db = __builtin_amdgcn_mfma_scale_f32_16x16x128_f8f6f4(A, B, db, 4  , 0  , 0, 0x7F7F7F7F, 0, 0x7F7F7F7F);
                else        da = __builtin_amdgcn_mfma_scale_f32_16x16x128_f8f6f4(A, B, da, 4, 0, 0, 0x7F7F7F7F, 0, 0x7F7F7F7F);
            }
            const f32x4 d4 = da + db;
            const int sel = fr & 3;
            float t = d4[0]; t = (sel == 1) ? d4[1] : t; t = (sel == 2) ? d4[2] : t; t = (sel == 3) ? d4[3] : t;
            const float gk = __shfl((k0 < 64) ? gw0 : gw1, (k0 + pe) & 63);
            const float wl = gk * gelu_fast(t * su) * sv;
            float wm = fabsf(wl); wm = fmaxf(wm, __shfl_xor(wm, 1)); wm = fmaxf(wm, __shfl_xor(wm, 2)); wm = fmaxf(wm, __shfl_xor(wm, 16)); wm = fmaxf(wm, __shfl_xor(wm, 32));
            int E = (int)(__float_as_uint(wm) >> 23); E = E < 8 ? 8 : E;
            const float wq = wl * __uint_as_float((unsigned)(261 - E) << 23);
            const int scb = (E - 7) * 0x01010101;
            v8i_t Bw;
#define AP_WQ(tq, ctrl) { const float wt = __builtin_bit_cast(float, __builtin_amdgcn_update_dpp(0, __builtin_bit_cast(int, wq), ctrl, 0xf, 0xf, false)); \
                const unsigned p8 = (unsigned)__builtin_amdgcn_cvt_pk_fp8_f32(wt, 0.f, 0, false) << bsh; Bw[2 * tq] = (int)(p8 & mlo); Bw[2 * tq + 1] = (int)(p8 & mhi); }
            AP_WQ(0, 0x00) AP_WQ(1, 0x55) AP_WQ(2, 0xAA) AP_WQ(3, 0xFF)
#pragma unroll
            for (int c = 0; c < 8; ++c) {
                v4u av;
                av.x = *(const LAS unsigned*)(VL + (4 * fq + 0) * 528 + 64 * c + 4 * fr); av.y = *(const LAS unsigned*)(VL + (4 * fq + 1) * 528 + 64 * c + 4 * fr);
                av.z = *(const LAS unsigned*)(VL + (4 * fq + 2) * 528 + 64 * c + 4 * fr); av.w = *(const LAS unsigned*)(VL + (4 * fq + 3) * 528 + 64 * c + 4 * fr);
                const v8i_t A = {(int)av.x, (int)av.y, (int)av.z, (int)av.w, 0, 0, 0, 0};
                oacc[c] = __builtin_amdgcn_mfma_scale_f32_16x16x128_f8f6f4(A, Bw, oacc[c], 4, 0, 0, 0x7F7F7F7F, 0, scb);
            }
            if (bt == 7) {
                if (fr < 8) {
#pragma unroll
                    for (int c = 0; c < 8; ++c)
#pragma unroll
                        for (int r = 0; r < 4; ++r) { const float o = oacc[c][r]; *(LAS unsigned*)(UL + 4 * ((4 * c + fq) * 40 + 8 * r + fr)) = __float_as_uint(o); }
                }
                float s2 = 0.f; f32x4 ov[4];
#pragma unroll
                for (int q = 0; q < 4; ++q) { const v4u ou = *(const LAS v4u*)(UL + 4 * ((lane >> 1) * 40 + (lane & 1) * 16 + 4 * q));
                    ov[q] = (f32x4){__uint_as_float(ou.x), __uint_as_float(ou.y), __uint_as_float(ou.z), __uint_as_float(ou.w)} + xr[q];
                    s2 += (ov[q][0] * ov[q][0] + ov[q][1] * ov[q][1]) + (ov[q][2] * ov[q][2] + ov[q][3] * ov[q][3]); }
                const float rf = rsqrtf(wave_sum(s2) * (1.f / DM) + EPS);
#pragma unroll
                for (int q = 0; q < 4; ++q) { const f32x4 g = *(const f32x4*)(gf + lane * 16 + q * 4);
                    *(f32x4*)(OUTP + (size_t)m * DM + lane * 16 + q * 4) = ov[q] * rf * g; }
            }
        }
    }
}

constexpr int N_PHASES = 13;
__global__ void __launch_bounds__(NTHR, 2) mega_fwd(Args args) {
    extern __shared__ __attribute__((aligned(16))) unsigned char lds[];
    Frame F;
    F.lds = (LAS unsigned char*)lds;
    F.tid = threadIdx.x; F.lane = F.tid & 63; F.wave = __builtin_amdgcn_readfirstlane(F.tid >> 6);
    F.G = gridDim.x; F.bid = blockIdx.x;
    F.in = args.in; F.out = args.out; F.ws = args.ws;
    volatile LAS unsigned* MISC = (volatile LAS unsigned*)(F.lds + MISC_OFF);
    for (int u = F.tid; u < (LDS_BYTES - LDSCTL_OFF) / 4; u += NTHR) ((LAS unsigned*)(F.lds + LDSCTL_OFF))[u] = 0u;
    __syncthreads();
    XcdBarrier bar; bar.bar = (unsigned*)(args.ws + WS_CTL) + CW_BAR; bar.x = 0; bar.st = nullptr;
    const bool one_launch = (args.ph_hi - args.ph_lo) > 1;
    if (one_launch) bar = xcd_barrier_post((unsigned*)(args.ws + WS_CTL) + CW_BAR, MISC + 8);
    const int lo = args.ph_lo, hi = args.ph_hi;
#define IN(k) (lo <= (k) && (k) < hi)
#define SEAM(k) do { if (IN(k) && IN((k) + 1)) xcd_barrier(bar); } while (0)
    unsigned char* ws = args.ws;

#ifndef PROBE_MASK
#define PROBE_MASK 0
#endif
#define REP(k) _Pragma("unroll") for (int rep_ = 0; rep_ < (((PROBE_MASK >> (k)) & 1) ? 2 : 1); ++rep_)
    if (IN(0)) REP(0) { p0_prologue(F); if (rep_ == 0 && ((PROBE_MASK >> 0) & 1)) xcd_barrier(bar); } SEAM(0);
    if (IN(1)) REP(1) {
        { AddrP1 g{(const char*)(ws + WS_K), (const char*)(ws + WS_WIN), 1024, 1024, 1024, 4, 0, 0};
          pg8::StaticOrder S; S.init(MTOK, 1024, F.G, F.bid, 4);
          EpiBf16<DstP1> E{DstP1{ws, 4, 0, 0}, 1.f};
          pg8::gemm_phase(F.lds, g, S, E); }
        { AddrP1 g{(const char*)F.out, (const char*)(ws + WS_WIN8), 512, 512, 512, 20, 4, 4};
          pg8::StaticOrder S; S.init(MTOK, 5120, F.G, F.bid, 4);
          EpiBf16<DstP1, true> E{DstP1{ws, 20, 4, 4}, 1.f / 1024.f};
          pg8::gemm_phase<EpiBf16<DstP1, true>, AddrP1, 1>(F.lds, g, S, E); }
    } SEAM(1);
    if (IN(2)) REP(2) { lru_phase<false>(F); } SEAM(2);
    if (IN(3)) REP(3) { lru_phase<true>(F); if (F.G != 256) mconv_phase(F); } SEAM(3);
    if (IN(5)) REP(5) { if (F.G == 256) qkv_conv_phase(F); else qkv_phase(F);
    } SEAM(5);
    if (IN(6)) REP(6) { mscan_phase(F); } SEAM(6);
    if (IN(7)) { ym_phase(F); } SEAM(7);
    if (IN(8)) {
        pg8::StaticOrder S; S.init(MTOK, 1024, F.G, F.bid);
        AddrBranch g{(const char*)(ws + WS_OP), (long)((const char*)F.out - (const char*)(ws + WS_OP)), (const char*)(ws + WS_WB2), 1024, 1024, 1024};
        EpiMerge2 E{(bf16*)(ws + WS_XM), (const unsigned char*)(ws + WS_MG)};
        pg8::gemm_phase<EpiMerge2, AddrBranch, 0, true>(F.lds, g, S, E);
    } SEAM(8);
    if (IN(9)) {
        AddrPlain g{(const char*)(ws + WS_XM), (const char*)(ws + WS_WOUT2), 1024, 2048, 1024};
        pg8::StaticOrder S; S.init(MTOK, 1024, F.G, F.bid);
        EpiResid E{F.in[0], F.out, (bf16*)(ws + WS_XL), (float*)(ws + WS_SS)};
        pg8::gemm_phase(F.lds, g, S, E);
    } SEAM(9);
    if (IN(10)) REP(10) {
        AddrPlain g{(const char*)(ws + WS_XL), (const char*)(ws + WS_WPQ), 1024, 1024, 1024};
        pg8::StaticOrder S; S.init(MTOK, 2048, F.G, F.bid, 4);
        EpiPQ E{(bf16*)(ws + WS_MG), (const float*)(ws + WS_SS)};
        pg8::gemm_phase(F.lds, g, S, E);
    } SEAM(10);
    if (IN(11)) REP(11) { select_phase(F); }
    if (IN(11) && IN(12)) { asm volatile("s_waitcnt vmcnt(0)" ::: "memory"); __syncthreads(); }
    if (IN(12)) { if ((PROBE_MASK >> 12) & 1) { apply_phase(F, (float*)(ws + WS_MG)); xcd_barrier(bar); } apply_phase(F, F.out); }
#undef REP
#undef IN
#undef SEAM
}

extern "C" void kernel_launch(void* const* d_in, const int* in_sizes, int n_in, void* d_out, int out_size, void* d_ws, size_t ws_size, hipStream_t stream) {
    static int grid = 0;
    if (grid == 0) {
        if (n_in != 26 || in_sizes[0] != MTOK * DM || out_size != MTOK * DM || ws_size < WS_END) { fprintf(stderr, "kernel_launch: unexpected shapes / workspace (%zu < %zu)\n", ws_size, (size_t)WS_END); grid = -1; return; }
        int dev = 0, cus = 0, per_cu = 0;
        if (hipGetDevice(&dev) != hipSuccess || hipDeviceGetAttribute(&cus, hipDeviceAttributeMultiprocessorCount, dev) != hipSuccess) { grid = -1; return; }
        if (hipFuncSetAttribute((const void*)mega_fwd, hipFuncAttributeMaxDynamicSharedMemorySize, LDS_BYTES) != hipSuccess) { fprintf(stderr, "kernel_launch: hipFuncSetAttribute failed\n"); grid = -1; return; }
        if (hipOccupancyMaxActiveBlocksPerMultiprocessor(&per_cu, (const void*)mega_fwd, NTHR, LDS_BYTES) != hipSuccess || per_cu < 1) { fprintf(stderr, "kernel_launch: occupancy query says %d blocks/CU\n", per_cu); (void)hipGetLastError(); grid = -1; return; }
        grid = cus;
    }
    if (grid < 0) return;
    (void)hipMemsetAsync((char*)d_ws + WS_CTL + (size_t)CW_BAR * 4, 0, (size_t)XCD_BAR_WORDS * 4, stream);
    Args a{};
    for (int i = 0; i < 26; ++i) a.in[i] = (const float*)d_in[i];
    a.out = (float*)d_out; a.ws = (unsigned char*)d_ws;
#if MK_N_LAUNCHES == 1
    a.ph_lo = 0; a.ph_hi = N_PHASES;
    void* kargs[] = {&a};
    hipError_t e = hipLaunchCooperativeKernel((const void*)mega_fwd, dim3(grid), dim3(NTHR), kargs, LDS_BYTES, stream);
    if (e != hipSuccess) fprintf(stderr, "kernel_launch: cooperative launch failed: %s (grid %d)\n", hipGetErrorString(e), grid);
#else
    for (int p = 0; p < N_PHASES; ++p) { a.ph_lo = p; a.ph_hi = p + 1; hipLaunchKernelGGL(mega_fwd, dim3(grid), dim3(NTHR), LDS_BYTES, stream, a); }
#endif
}
```
